# Optimizing an MI355X kernel written in HIP

```python
import math
import jax, jax.numpy as jnp
from jax import lax
import numpy as np

D_MODEL = 1024
BATCH = 16
SEQ = 2048
DEPTH = 1

F32 = jnp.float32
MEM_LEN = 256
NSA_HEADS = 8
NSA_KV_GROUPS = 2
NSA_HPG = NSA_HEADS // NSA_KV_GROUPS
NSA_HEAD_DIM = D_MODEL // 16
NSA_WIDTH = NSA_HEADS * NSA_HEAD_DIM
NSA_KV_WIDTH = NSA_KV_GROUPS * NSA_HEAD_DIM
NSA_CMP_LEN = 32
NSA_CMP_STRIDE = 16
NSA_SEL_BLOCK = 64
NSA_SEL_TOPN = 8
NSA_WINDOW = 512
NSA_QBLOCK = 64
MLSTM_HEADS = 4
MLSTM_HEAD_DIM = D_MODEL // 8
MLSTM_WIDTH = MLSTM_HEADS * MLSTM_HEAD_DIM
MLSTM_CHUNK = 64
MLSTM_CONV = 4
MIX_WIDTH = NSA_WIDTH + MLSTM_WIDTH
IN_SPLIT_SIZES = (NSA_WIDTH,) + (NSA_KV_WIDTH,) * 6 + (3 * NSA_HEADS,) + (MLSTM_WIDTH,) * 4 + (MLSTM_HEADS,) * 2
IN_WIDTH = sum(IN_SPLIT_SIZES)
XATTN_HEADS = 4
XATTN_HEAD_DIM = D_MODEL // XATTN_HEADS
MOE_EXPERTS = 256
MOE_TOPK = 8
MOE_GROUPS = 8
MOE_TOPK_GROUPS = 4
MOE_FF = D_MODEL // 4
MOE_SHARED_FF = MOE_FF
MOE_ROUTE_SCALE = 2.5
MOE_ROW_BLOCK = 128
DEEPNORM_ALPHA = (2.0 * DEPTH) ** 0.25
DEEPNORM_BETA = (8.0 * DEPTH) ** -0.25
LN_EPS = 1e-5
NEG_INF = -1e30
FORCE_BONUS = 1e4

kernel_name = 'hybrid_nsa_mlstm_moe_deepnorm'


def layer_norm(x, g, b):
    xf = x.astype(F32)
    mu = jnp.mean(xf, -1, keepdims=True)
    var = jnp.mean(jnp.square(xf - mu), -1, keepdims=True)
    return ((xf - mu) * lax.rsqrt(var + LN_EPS) * g.astype(F32) + b.astype(F32)).astype(x.dtype)


def masked_softmax(s, mask):
    return jax.nn.softmax(jnp.where(mask, s, NEG_INF), axis=-1)


def nsa_mixer(q, k_cmp, v_cmp, k_sel, v_sel, k_win, v_win, gates,
              pos_k, ck_w1, ck_w2, pos_v, cv_w1, cv_w2):
    B, S = q.shape[:2]
    G, Hg, dk = NSA_KV_GROUPS, NSA_HPG, NSA_HEAD_DIM
    L, STR, BS, W, QB = NSA_CMP_LEN, NSA_CMP_STRIDE, NSA_SEL_BLOCK, NSA_WINDOW, NSA_QBLOCK
    scale = dk ** -0.5
    out_dtype = q.dtype
    q = q.reshape(B, S, G, Hg, dk)
    kv = lambda a: a.reshape(B, S, G, dk)
    k_cmp, v_cmp, k_sel, v_sel, k_win, v_win = map(kv, (k_cmp, v_cmp, k_sel, v_sel, k_win, v_win))
    t = jnp.arange(S)

    n_cmp = (S - L) // STR + 1
    cmp_start = jnp.arange(n_cmp) * STR
    win_idx = cmp_start[:, None] + jnp.arange(L)[None, :]

    def compress(a, pos, w1, w2):
        blocks = a[:, win_idx] + pos[None, None, :, None, :]
        blocks = blocks.transpose(0, 1, 3, 2, 4).reshape(B, n_cmp, G, L * dk)
        return jax.nn.silu(blocks @ w1) @ w2

    kc = compress(k_cmp, pos_k, ck_w1, ck_w2)
    vc = compress(v_cmp, pos_v, cv_w1, cv_w2)
    cmask = (cmp_start + L - 1)[None, :] <= t[:, None]
    s_c = jnp.einsum('bsghd,bcgd->bghsc', q, kc).astype(F32) * scale
    p_c = masked_softmax(s_c, cmask) * cmask
    o_cmp = jnp.einsum('bghsc,bcgd->bsghd', p_c.astype(vc.dtype), vc)

    n_sel = S // BS
    sel_start = jnp.arange(n_sel) * BS
    overlap = ((cmp_start[:, None] < sel_start[None, :] + BS) &
               (cmp_start[:, None] + L > sel_start[None, :])).astype(F32)
    p_slc = jnp.einsum('bghsc,cn->bgsn', p_c, overlap)
    cur = t // BS
    sblk = jnp.arange(n_sel)[None, :]
    valid = sblk <= cur[:, None]
    forced = (sblk == 0) | (sblk == cur[:, None]) | (sblk == cur[:, None] - 1)
    imp = jnp.where(valid, p_slc + jnp.where(forced, FORCE_BONUS, 0.0), NEG_INF)
    top_n = min(NSA_SEL_TOPN, n_sel)
    top_val, top_idx = lax.top_k(imp, top_n)
    top_ok = top_val > 0.5 * NEG_INF

    ksel_blocks = k_sel.reshape(B, n_sel, BS, G, dk).transpose(0, 3, 1, 2, 4)
    vsel_blocks = v_sel.reshape(B, n_sel, BS, G, dk).transpose(0, 3, 1, 2, 4)
    pad = jnp.zeros((B, W, G, dk), k_win.dtype)
    kw_pad = jnp.concatenate([pad, k_win], axis=1)
    vw_pad = jnp.concatenate([pad, v_win], axis=1)
    bi = jnp.arange(B)[:, None, None, None]
    gi = jnp.arange(G)[None, :, None, None]

    def query_block(i):
        qs = i * QB
        qb = lax.dynamic_slice_in_dim(q, qs, QB, axis=1)
        tq = qs + jnp.arange(QB)
        idx = lax.dynamic_slice_in_dim(top_idx, qs, QB, axis=2)
        ok = lax.dynamic_slice_in_dim(top_ok, qs, QB, axis=2)
        ks = ksel_blocks[bi, gi, idx].reshape(B, G, QB, top_n * BS, dk)
        vs = vsel_blocks[bi, gi, idx].reshape(B, G, QB, top_n * BS, dk)
        kpos = (idx[..., None] * BS + jnp.arange(BS)).reshape(B, G, QB, top_n * BS)
        smask = (kpos <= tq[None, None, :, None]) & jnp.repeat(ok, BS, axis=-1)
        s_s = jnp.einsum('bqghd,bgqkd->bghqk', qb, ks).astype(F32) * scale
        p_s = masked_softmax(s_s, smask[:, :, None])
        o_s = jnp.einsum('bghqk,bgqkd->bqghd', p_s.astype(vs.dtype), vs)
        kw = lax.dynamic_slice_in_dim(kw_pad, qs, W + QB, axis=1)
        vw = lax.dynamic_slice_in_dim(vw_pad, qs, W + QB, axis=1)
        wpos = qs - W + jnp.arange(W + QB)
        wmask = (wpos[None, :] <= tq[:, None]) & (wpos[None, :] > tq[:, None] - W) & (wpos[None, :] >= 0)
        s_w = jnp.einsum('bqghd,bkgd->bghqk', qb, kw).astype(F32) * scale
        p_w = masked_softmax(s_w, wmask)
        o_w = jnp.einsum('bghqk,bkgd->bqghd', p_w.astype(vw.dtype), vw)
        return o_s, o_w

    o_sel, o_win = lax.map(query_block, jnp.arange(S // QB))
    unblock = lambda o: jnp.moveaxis(o, 0, 1).reshape(B, S, G, Hg, dk)
    g = jax.nn.sigmoid(gates.astype(F32)).reshape(B, S, G, Hg, 3)
    o = g[..., 0:1] * o_cmp + g[..., 1:2] * unblock(o_sel) + g[..., 2:3] * unblock(o_win)
    return o.reshape(B, S, NSA_WIDTH).astype(out_dtype)


def causal_depthwise_conv(u, w):
    K = w.shape[0]
    return lax.conv_general_dilated(u, w.astype(u.dtype), window_strides=(1,), padding=((K - 1, 0),),
                                    dimension_numbers=('NWC', 'WIO', 'NWC'),
                                    feature_group_count=u.shape[-1])


def mlstm_chunkwise(q, k, v, log_i, log_f):
    B, H, S, dh = q.shape
    L = MLSTM_CHUNK
    nc = S // L
    chunks = lambda a: jnp.moveaxis(a.reshape(B, H, nc, L, *a.shape[3:]), 2, 0)
    causal = jnp.tril(jnp.ones((L, L), bool))

    def step(carry, inp):
        C, n, m = carry
        qc, kc, vc, ic, fc = inp
        b = jnp.cumsum(fc, axis=-1)
        g = b[..., -1]
        d_log = jnp.where(causal, b[..., :, None] - b[..., None, :] + ic[..., None, :], -jnp.inf)
        inter = b + m[..., None]
        m_q = jnp.maximum(inter, jnp.max(d_log, axis=-1))
        w_intra = jnp.exp(d_log - m_q[..., None])
        w_inter = jnp.exp(inter - m_q)
        s = jnp.einsum('bhld,bhmd->bhlm', qc, kc) * w_intra
        num = w_inter[..., None] * jnp.einsum('bhld,bhde->bhle', qc, C) + jnp.einsum('bhlm,bhme->bhle', s, vc)
        den = w_inter * jnp.einsum('bhld,bhd->bhl', qc, n) + jnp.sum(s, axis=-1)
        h = num / jnp.maximum(jnp.abs(den), jnp.exp(-m_q))[..., None]
        log_k = g[..., None] - b + ic
        m_new = jnp.maximum(g + m, jnp.max(log_k, axis=-1))
        wk = jnp.exp(log_k - m_new[..., None])
        decay = jnp.exp(g + m - m_new)
        C_new = decay[..., None, None] * C + jnp.einsum('bhl,bhld,bhle->bhde', wk, kc, vc)
        n_new = decay[..., None] * n + jnp.einsum('bhl,bhld->bhd', wk, kc)
        return (C_new, n_new, m_new), h

    init = (jnp.zeros((B, H, dh, dh), F32), jnp.zeros((B, H, dh), F32), jnp.zeros((B, H), F32))
    _, hs = lax.scan(step, init, (chunks(q), chunks(k), chunks(v), chunks(log_i), chunks(log_f)))
    return jnp.moveaxis(hs, 0, 2).reshape(B, H, S, dh)


def mlstm_mixer(q, k, v, o_pre, i_pre, f_pre, conv_w, i_bias, f_bias, norm_g):
    B, S, _ = q.shape
    H, dh = MLSTM_HEADS, MLSTM_HEAD_DIM
    out_dtype = v.dtype
    qk = jax.nn.silu(causal_depthwise_conv(jnp.concatenate([q, k], axis=-1), conv_w))
    q, k = jnp.split(qk, 2, axis=-1)
    heads = lambda a: a.astype(F32).reshape(B, S, H, dh).transpose(0, 2, 1, 3)
    qh = heads(q) * (dh ** -0.5)
    kh, vh = heads(k), heads(v)
    log_i = (i_pre.astype(F32) + i_bias.astype(F32)).transpose(0, 2, 1)
    log_f = jax.nn.log_sigmoid(f_pre.astype(F32) + f_bias.astype(F32)).transpose(0, 2, 1)
    h = mlstm_chunkwise(qh, kh, vh, log_i, log_f)
    mu = jnp.mean(h, -1, keepdims=True)
    var = jnp.mean(jnp.square(h - mu), -1, keepdims=True)
    hn = ((h - mu) * lax.rsqrt(var + LN_EPS)).transpose(0, 2, 1, 3).reshape(B, S, MLSTM_WIDTH)
    hn = hn * norm_g.astype(F32)
    return (jax.nn.sigmoid(o_pre.astype(F32)) * hn).astype(out_dtype)


def memory_cross_attention(x, mem, wq, wk, wv, wo):
    B, S, _ = x.shape
    M = mem.shape[1]
    q = (x @ wq).reshape(B, S, XATTN_HEADS, XATTN_HEAD_DIM)
    k = (mem @ wk).reshape(B, M, XATTN_HEADS, XATTN_HEAD_DIM)
    v = (mem @ wv).reshape(B, M, XATTN_HEADS, XATTN_HEAD_DIM)
    s = jnp.einsum('bshd,bmhd->bhsm', q, k).astype(F32) * (XATTN_HEAD_DIM ** -0.5)
    p = jax.nn.softmax(s, axis=-1)
    o = jnp.einsum('bhsm,bmhd->bshd', p.astype(v.dtype), v).reshape(B, S, XATTN_HEADS * XATTN_HEAD_DIM)
    return o @ wo


def moe_ffn(x, router_w, router_bias, w1, w3, w2, sw1, sw3, sw2):
    B, S, D = x.shape
    T = B * S
    E, K, RB = MOE_EXPERTS, MOE_TOPK, MOE_ROW_BLOCK
    xt = x.reshape(T, D)
    scores = jax.nn.sigmoid((xt @ router_w).astype(F32))
    biased = scores + router_bias.astype(F32)
    grp_score = jnp.sum(lax.top_k(biased.reshape(T, MOE_GROUPS, E // MOE_GROUPS), 2)[0], axis=-1)
    _, grp_idx = lax.top_k(grp_score, MOE_TOPK_GROUPS)
    grp_mask = jnp.sum(jax.nn.one_hot(grp_idx, MOE_GROUPS, dtype=F32), axis=-2) > 0
    exp_mask = jnp.repeat(grp_mask, E // MOE_GROUPS, axis=-1)
    _, top_idx = lax.top_k(jnp.where(exp_mask, biased, NEG_INF), K)
    top_w = jnp.take_along_axis(scores, top_idx, axis=-1)
    top_w = top_w / jnp.sum(top_w, -1, keepdims=True) * MOE_ROUTE_SCALE
    TK = T * K
    e_flat = top_idx.reshape(TK)
    tok_flat = jnp.repeat(jnp.arange(T, dtype=jnp.int32), K)
    w_flat = top_w.reshape(TK)
    order = jnp.argsort(e_flat)
    e_s, tok_s, w_s = e_flat[order], tok_flat[order], w_flat[order]
    counts = jax.ops.segment_sum(jnp.ones((TK,), jnp.int32), e_flat, num_segments=E)
    offs = jnp.cumsum(counts) - counts
    pcounts = (counts + RB - 1) // RB * RB
    pends = jnp.cumsum(pcounts)
    poffs = pends - pcounts
    dest = poffs[e_s] + jnp.arange(TK, dtype=jnp.int32) - offs[e_s]
    n_blocks = (TK + E * (RB - 1) + RB - 1) // RB
    n_rows = n_blocks * RB
    row_tok = jnp.full((n_rows,), T, jnp.int32).at[dest].set(tok_s)
    row_w = jnp.zeros((n_rows,), F32).at[dest].set(w_s)
    blk_exp = jnp.minimum(jnp.searchsorted(pends, jnp.arange(n_blocks) * RB, side='right'), E - 1)
    xpad = jnp.concatenate([xt, jnp.zeros((1, D), xt.dtype)], axis=0)

    def expert_block(y, inp):
        tok, wt, e = inp
        xb = xpad[tok]
        h = jax.nn.silu(xb @ w1[e]) * (xb @ w3[e])
        return y.at[tok].add(((h @ w2[e]) * wt[:, None]).astype(y.dtype)), None

    y, _ = lax.scan(expert_block, jnp.zeros_like(xpad),
                    (row_tok.reshape(n_blocks, RB), row_w.reshape(n_blocks, RB), blk_exp))
    shared = (jax.nn.silu(xt @ sw1) * (xt @ sw3)) @ sw2
    return (y[:T] + shared).reshape(B, S, D)


def setup_inputs(seed: int = 0) -> dict:
    key = jax.random.key(seed)
    ks = jax.random.split(key, 32)

    def nrm(k, shape, scale):
        return jax.random.normal(k, shape, F32) * scale

    L, dk, Dp = NSA_CMP_LEN, NSA_HEAD_DIM, DEPTH
    return {
        'x': nrm(ks[0], (BATCH, SEQ, D_MODEL), 1.0),
        'mem': nrm(ks[1], (BATCH, MEM_LEN, D_MODEL), 1.0),
        'w_in': nrm(ks[2], (Dp, D_MODEL, IN_WIDTH), D_MODEL ** -0.5),
        'nsa_pos_k': nrm(ks[3], (Dp, L, dk), 0.1),
        'nsa_cmp_k_w1': nrm(ks[4], (Dp, L * dk, dk), (L * dk) ** -0.5),
        'nsa_cmp_k_w2': nrm(ks[5], (Dp, dk, dk), dk ** -0.5),
        'nsa_pos_v': nrm(ks[6], (Dp, L, dk), 0.1),
        'nsa_cmp_v_w1': nrm(ks[7], (Dp, L * dk, dk), (L * dk) ** -0.5),
        'nsa_cmp_v_w2': nrm(ks[8], (Dp, dk, dk), dk ** -0.5),
        'mlstm_conv_w': nrm(ks[9], (Dp, MLSTM_CONV, 1, 2 * MLSTM_WIDTH), MLSTM_CONV ** -0.5),
        'mlstm_i_bias': nrm(ks[10], (Dp, MLSTM_HEADS), 0.1),
        'mlstm_f_bias': jnp.linspace(3.0, 6.0, MLSTM_HEADS, dtype=F32)[None, :] + nrm(ks[11], (Dp, MLSTM_HEADS), 0.1),
        'mlstm_norm_g': 1.0 + nrm(ks[12], (Dp, MLSTM_WIDTH), 0.02),
        'w_out': nrm(ks[13], (Dp, MIX_WIDTH, D_MODEL), MIX_WIDTH ** -0.5 * DEEPNORM_BETA),
        'ln1_g': 1.0 + nrm(ks[14], (Dp, D_MODEL), 0.02),
        'ln1_b': nrm(ks[15], (Dp, D_MODEL), 0.02),
        'xa_wq': nrm(ks[16], (Dp, D_MODEL, XATTN_HEADS * XATTN_HEAD_DIM), D_MODEL ** -0.5),
        'xa_wk': nrm(ks[17], (Dp, D_MODEL, XATTN_HEADS * XATTN_HEAD_DIM), D_MODEL ** -0.5),
        'xa_wv': nrm(ks[18], (Dp, D_MODEL, XATTN_HEADS * XATTN_HEAD_DIM), D_MODEL ** -0.5),
        'xa_wo': nrm(ks[19], (Dp, XATTN_HEADS * XATTN_HEAD_DIM, D_MODEL), (XATTN_HEADS * XATTN_HEAD_DIM) ** -0.5 * DEEPNORM_BETA),
        'ln2_g': 1.0 + nrm(ks[20], (Dp, D_MODEL), 0.02),
        'ln2_b': nrm(ks[21], (Dp, D_MODEL), 0.02),
        'router_w': nrm(ks[22], (Dp, D_MODEL, MOE_EXPERTS), D_MODEL ** -0.5),
        'router_bias': nrm(ks[23], (Dp, MOE_EXPERTS), 0.01),
        'moe_w1': nrm(ks[24], (Dp, MOE_EXPERTS, D_MODEL, MOE_FF), D_MODEL ** -0.5),
        'moe_w3': nrm(ks[25], (Dp, MOE_EXPERTS, D_MODEL, MOE_FF), D_MODEL ** -0.5),
        'moe_w2': nrm(ks[26], (Dp, MOE_EXPERTS, MOE_FF, D_MODEL), MOE_FF ** -0.5 * DEEPNORM_BETA),
        'shared_w1': nrm(ks[27], (Dp, D_MODEL, MOE_SHARED_FF), D_MODEL ** -0.5),
        'shared_w3': nrm(ks[28], (Dp, D_MODEL, MOE_SHARED_FF), D_MODEL ** -0.5),
        'shared_w2': nrm(ks[29], (Dp, MOE_SHARED_FF, D_MODEL), MOE_SHARED_FF ** -0.5 * DEEPNORM_BETA),
        'ln3_g': 1.0 + nrm(ks[30], (Dp, D_MODEL), 0.02),
        'ln3_b': nrm(ks[31], (Dp, D_MODEL), 0.02),
    }


def reference(x, mem, w_in, nsa_pos_k, nsa_cmp_k_w1, nsa_cmp_k_w2, nsa_pos_v, nsa_cmp_v_w1, nsa_cmp_v_w2,
              mlstm_conv_w, mlstm_i_bias, mlstm_f_bias, mlstm_norm_g, w_out, ln1_g, ln1_b,
              xa_wq, xa_wk, xa_wv, xa_wo, ln2_g, ln2_b, router_w, router_bias,
              moe_w1, moe_w3, moe_w2, shared_w1, shared_w3, shared_w2, ln3_g, ln3_b):
    cuts = np.cumsum(IN_SPLIT_SIZES)[:-1].tolist()
    for l in range(DEPTH):
        (nsa_q, k_c, v_c, k_s, v_s, k_w, v_w, nsa_g,
         m_q, m_k, m_v, m_o, m_i, m_f) = jnp.split(x @ w_in[l], cuts, axis=-1)
        y_nsa = nsa_mixer(nsa_q, k_c, v_c, k_s, v_s, k_w, v_w, nsa_g,
                          nsa_pos_k[l], nsa_cmp_k_w1[l], nsa_cmp_k_w2[l],
                          nsa_pos_v[l], nsa_cmp_v_w1[l], nsa_cmp_v_w2[l])
        y_mlstm = mlstm_mixer(m_q, m_k, m_v, m_o, m_i, m_f, mlstm_conv_w[l],
                              mlstm_i_bias[l], mlstm_f_bias[l], mlstm_norm_g[l])
        mix = jnp.concatenate([y_nsa, y_mlstm], axis=-1) @ w_out[l]
        x = layer_norm(DEEPNORM_ALPHA * x + mix, ln1_g[l], ln1_b[l])
        xa = memory_cross_attention(x, mem, xa_wq[l], xa_wk[l], xa_wv[l], xa_wo[l])
        x = layer_norm(DEEPNORM_ALPHA * x + xa, ln2_g[l], ln2_b[l])
        ff = moe_ffn(x, router_w[l], router_bias[l], moe_w1[l], moe_w3[l], moe_w2[l],
                     shared_w1[l], shared_w3[l], shared_w2[l])
        x = layer_norm(DEEPNORM_ALPHA * x + ff, ln3_g[l], ln3_b[l])
    return x
```

```cpp
#include <hip/hip_runtime.h>
#include <hip/hip_cooperative_groups.h>
#include <stdint.h>
#include <stdio.h>
namespace cg = cooperative_groups;

#ifndef MEGA
#define MEGA 1
#endif

typedef unsigned short bf16_t;
typedef short bf16x8 __attribute__((ext_vector_type(8)));
typedef short s16x4 __attribute__((ext_vector_type(4)));
typedef float f32x4 __attribute__((ext_vector_type(4)));
typedef float f32x2 __attribute__((ext_vector_type(2)));
typedef unsigned u32x4 __attribute__((ext_vector_type(4)));
typedef unsigned u32x2 __attribute__((ext_vector_type(2)));
typedef __bf16 bf16x2_t __attribute__((ext_vector_type(2)));

constexpr int T_TOK = 32768, DM = 1024, NB = 16, SEQ = 2048;
constexpr int PW = 3328;
constexpr int PC_Q = 0, PC_KC = 512, PC_VC = 640, PC_KS = 768, PC_VS = 896, PC_KW = 1024, PC_VW = 1152;
constexpr int PC_MQ = 1280, PC_MK = 1792, PC_MV = 2304, PC_MO = 2816;
constexpr float ALPHA = 1.189207115002721f;
constexpr float LN_EPS = 1e-5f;
constexpr int NTHR = 512;
constexpr int LDS_BYTES = 160 * 1024;
constexpr int NEXP = 256, TOPK = 8;
constexpr int LIST_CAP = 32768;

constexpr size_t al256(size_t x) { return (x + 255) & ~(size_t)255; }
constexpr size_t WS_WIN = 0;
constexpr size_t WS_WOUT = WS_WIN + al256((size_t)3360 * 1024 * 2);
constexpr size_t WS_WQ = WS_WOUT + (size_t)1024 * 1024 * 2;
constexpr size_t WS_WKV = WS_WQ + (size_t)1024 * 1024 * 2;
constexpr size_t WS_WO = WS_WKV + (size_t)2048 * 1024 * 2;
constexpr size_t WS_WR = WS_WO + (size_t)1024 * 1024 * 2;
constexpr size_t WS_WS13 = WS_WR + (size_t)256 * 1024 * 2;
constexpr size_t WS_WS2 = WS_WS13 + (size_t)512 * 1024 * 2;
constexpr size_t WS_CK1 = WS_WS2 + (size_t)1024 * 256 * 2;
constexpr size_t WS_CK2 = WS_CK1 + (size_t)64 * 2048 * 2;
constexpr size_t WS_CV1 = WS_CK2 + (size_t)64 * 64 * 2;
constexpr size_t WS_CV2 = WS_CV1 + (size_t)64 * 2048 * 2;
constexpr size_t MB = 1024 * 1024;
constexpr size_t WS_A = al256(WS_CV2 + (size_t)64 * 64 * 2 + 65536);
constexpr size_t WS_P = WS_A;
constexpr size_t WS_R1 = WS_A;
constexpr size_t WS_XQ = WS_A + 128 * MB;
constexpr size_t WS_XO = WS_A + 192 * MB;
constexpr size_t WS_XB = WS_A + 208 * MB;
constexpr size_t WS_MEMB = WS_A + 272 * MB;
constexpr size_t WS_PSM = WS_A + 280 * MB;
constexpr size_t WS_KCMP = WS_A + 284 * MB;
constexpr size_t WS_VCMP = WS_KCMP + (size_t)16 * 2 * 128 * 64 * 2;
constexpr size_t WS_QK = WS_A + 285 * MB;
constexpr size_t WS_MIX = WS_A + 349 * MB;
constexpr size_t WS_KVX = WS_A + 413 * MB;
constexpr size_t WS_X2 = WS_A + 256 * MB;
constexpr size_t WS_HS = WS_A + 320 * MB;
constexpr size_t WS_R1B = WS_A + 208 * MB;
constexpr size_t WS_R2B = WS_A + 128 * MB;
constexpr size_t WS_RSC = WS_A;
constexpr size_t WS_Y = WS_A;
constexpr size_t WS_B = WS_A + al256((size_t)(T_TOK * 8 + 256) * 1024 * 2);
constexpr size_t WS_R2 = WS_B;
constexpr size_t WS_ST1 = WS_R2 + (size_t)T_TOK * 1024 * 4;
constexpr size_t WS_ST2 = WS_ST1 + (size_t)T_TOK * 8 * 4;
constexpr size_t WS_SH = WS_ST2 + (size_t)T_TOK * 8 * 4;
constexpr size_t WS_SELE = WS_SH + (size_t)T_TOK * 1024 * 2;
constexpr size_t WS_SELP = WS_SELE + (size_t)T_TOK * 8 * 4;
constexpr size_t WS_SELW = WS_SELP + (size_t)T_TOK * 8 * 4;
constexpr size_t WS_CNT = WS_SELW + (size_t)T_TOK * 8 * 4;
constexpr size_t WS_TOKL = WS_CNT + 4096;
constexpr size_t WS_WL = WS_TOKL + (size_t)NEXP * LIST_CAP * 4;
constexpr size_t WS_H = WS_WL + (size_t)NEXP * LIST_CAP * 4;
constexpr size_t WS_END = WS_H + (size_t)(T_TOK * 8 + 256) * 256 * 2;
static_assert((size_t)T_TOK * PW * 2 <= 208 * MB, "P region");
static_assert(WS_END <= (size_t)1024 * MB, "workspace must fit 1 GiB");

struct Params {
    const float* in[32];
    float* out;
    char* ws;
};

__device__ __forceinline__ unsigned pk_bf16(float lo, float hi) {
    f32x2 v = {lo, hi};
    bf16x2_t r = __builtin_convertvector(v, bf16x2_t);
    return __builtin_bit_cast(unsigned, r);
}
__device__ __forceinline__ float bf_lo(unsigned u) { return __uint_as_float(u << 16); }
__device__ __forceinline__ float bf_hi(unsigned u) { return __uint_as_float(u & 0xffff0000u); }
__device__ __forceinline__ float bf2f(bf16_t h) { return __uint_as_float(((unsigned)h) << 16); }
__device__ __forceinline__ float sigmoidf_(float x) { return 1.0f / (1.0f + __expf(-x)); }
__device__ __forceinline__ float siluf_(float x) { return x / (1.0f + __expf(-x)); }
__device__ __forceinline__ f32x4 mfma16(bf16x8 a, bf16x8 b, f32x4 c) { return __builtin_amdgcn_mfma_f32_16x16x32_bf16(a, b, c, 0, 0, 0); }
__device__ __forceinline__ bf16x8 as_bf16x8(u32x4 v) { return __builtin_bit_cast(bf16x8, v); }

__device__ __forceinline__ int opaque_tid() { int t = threadIdx.x; asm volatile("" : "+v"(t)); return t; }

__device__ __forceinline__ int tile_off(int row, int chunk) { return row * 128 + ((chunk ^ (row & 7)) << 4); }

typedef __attribute__((address_space(3))) unsigned lds_u32;
typedef __attribute__((address_space(1))) const unsigned glb_u32;

struct LoadBf16Rows {
    const bf16_t* base;
    unsigned off[4];
    int ldst;
    struct Regs { int dummy; };
    __device__ __forceinline__ void init_contig(const bf16_t* b, int ld, int row0) {
        const int tid_ = opaque_tid();
        const int r8 = tid_ >> 3, kc = (tid_ & 7) ^ (r8 & 7);
        ldst = tid_ * 16;
        base = b + (long)row0 * ld;
#pragma unroll
        for (int i = 0; i < 4; ++i) off[i] = (unsigned)((r8 + 64 * i) * ld + kc * 8);
    }
    __device__ __forceinline__ void init_rows(const bf16_t* b, int ld, const int (&rows)[4]) {
        const int tid_ = opaque_tid();
        const int r8 = tid_ >> 3, kc = (tid_ & 7) ^ (r8 & 7);
        ldst = tid_ * 16;
        base = b;
#pragma unroll
        for (int i = 0; i < 4; ++i) off[i] = (unsigned)rows[i] * (unsigned)ld + (unsigned)(kc * 8);
    }
    __device__ __forceinline__ void issue(Regs&, char* s, int kt) const {
#pragma unroll
        for (int i = 0; i < 4; ++i)
            __builtin_amdgcn_global_load_lds((glb_u32*)(base + (size_t)(off[i] + (unsigned)(kt * 64))), (lds_u32*)(s + i * 8192 + ldst), 16, 0, 0);
    }
    __device__ __forceinline__ void commit(const Regs&, char*, int) const {}
};

struct LoadF32KN {
    const float* p;
    int ldn;
    int n, kh;
    struct Regs { float v[32]; };
    __device__ __forceinline__ void issue(Regs& r, char*, int kt) const {
        const float* q = p + (long)kt * 64 * ldn;
#pragma unroll
        for (int j = 0; j < 32; ++j) r.v[j] = q[(long)j * ldn];
    }
    __device__ __forceinline__ void commit(const Regs& r, char* s, int kt) const {
#pragma unroll
        for (int q = 0; q < 4; ++q) {
            u32x4 w;
            w.x = pk_bf16(r.v[8 * q + 0], r.v[8 * q + 1]); w.y = pk_bf16(r.v[8 * q + 2], r.v[8 * q + 3]);
            w.z = pk_bf16(r.v[8 * q + 4], r.v[8 * q + 5]); w.w = pk_bf16(r.v[8 * q + 6], r.v[8 * q + 7]);
            *(u32x4*)(s + tile_off(n, kh * 4 + q)) = w;
        }
    }
};

struct LoadLN {
    LoadBf16Rows raw;
    bf16_t* xbase;
    const float* st;
    const float* gb;
    typedef LoadBf16Rows::Regs Regs;
    __device__ __forceinline__ void issue(Regs& r, char* s, int kt) const { raw.issue(r, s, kt); }
    __device__ __forceinline__ void commit(const Regs&, char* s, int kt) const {
        asm volatile("s_waitcnt vmcnt(0)" ::: "memory");
        const int tid_ = opaque_tid();
        const int r8 = tid_ >> 3, kc = (tid_ & 7) ^ (r8 & 7);
        const f32x4 g0 = *(const f32x4*)(gb + kt * 64 + kc * 8), g1 = *(const f32x4*)(gb + kt * 64 + kc * 8 + 4);
        const f32x4 b0 = *(const f32x4*)(gb + 1024 + kt * 64 + kc * 8), b1 = *(const f32x4*)(gb + 1024 + kt * 64 + kc * 8 + 4);
#pragma unroll
        for (int i = 0; i < 4; ++i) {
            const int row = r8 + 64 * i;
            u32x4* cp = (u32x4*)(s + i * 8192 + tid_ * 16);
            const u32x4 v = *cp;
            const float mean = st[row * 2], rstd = st[row * 2 + 1];
            const f32x4 x0 = (f32x4){bf_lo(v.x), bf_hi(v.x), bf_lo(v.y), bf_hi(v.y)};
            const f32x4 x1 = (f32x4){bf_lo(v.z), bf_hi(v.z), bf_lo(v.w), bf_hi(v.w)};
            const f32x4 y0 = (x0 - mean) * rstd * g0 + b0, y1 = (x1 - mean) * rstd * g1 + b1;
            u32x4 w; w.x = pk_bf16(y0[0], y0[1]); w.y = pk_bf16(y0[2], y0[3]); w.z = pk_bf16(y1[0], y1[1]); w.w = pk_bf16(y1[2], y1[3]);
            *cp = w;
            if (xbase) *(u32x4*)(xbase + (size_t)(row * 1024 + kc * 8 + kt * 64)) = w;
        }
    }
};

constexpr int GEMM_LDS = 131072;
template <class AL, class BL>
__device__ __forceinline__ void gemm_mainloop(char* smem, const AL& al, const BL& bl, int nk, f32x4 (&acc)[8][4]) {
    const int tid_ = opaque_tid();
    const int lane = tid_ & 63, wid = tid_ >> 6;
    const int wr = wid >> 2, wc = wid & 3, fr = lane & 15, fq = lane >> 4;
#pragma unroll
    for (int mi = 0; mi < 8; ++mi)
#pragma unroll
        for (int ni = 0; ni < 4; ++ni) acc[mi][ni] = (f32x4){0.f, 0.f, 0.f, 0.f};
    typename AL::Regs ra; typename BL::Regs rb;
    al.issue(ra, smem, 0); bl.issue(rb, smem + 32768, 0);
    al.commit(ra, smem, 0); bl.commit(rb, smem + 32768, 0);
    __syncthreads();
    for (int kt = 0; kt < nk; ++kt) {
        char* sA = smem + (kt & 1) * 65536; char* sB = sA + 32768;
        char* nA = smem + ((kt + 1) & 1) * 65536; char* nB = nA + 32768;
        if (kt + 1 < nk) { al.issue(ra, nA, kt + 1); bl.issue(rb, nB, kt + 1); }
#pragma unroll
        for (int kk = 0; kk < 2; ++kk) {
            bf16x8 bfr[4];
#pragma unroll
            for (int ni = 0; ni < 4; ++ni) bfr[ni] = *(const bf16x8*)(sB + tile_off(wc * 64 + ni * 16 + fr, kk * 4 + fq));
#pragma unroll
            for (int mi = 0; mi < 8; ++mi) {
                const bf16x8 af = *(const bf16x8*)(sA + tile_off(wr * 128 + mi * 16 + fr, kk * 4 + fq));
#pragma unroll
                for (int ni = 0; ni < 4; ++ni) acc[mi][ni] = mfma16(bfr[ni], af, acc[mi][ni]);
            }
        }
        if (kt + 1 < nk) { al.commit(ra, nA, kt + 1); bl.commit(rb, nB, kt + 1); }
        __syncthreads();
    }
}

__device__ __forceinline__ void epi_store_bf16(const f32x4 (&acc)[8][4], bf16_t* out, long ld, int row0, int col0) {
    const int tid_ = opaque_tid();
    const int lane = tid_ & 63, wid = tid_ >> 6;
    const int wr = wid >> 2, wc = wid & 3, fr = lane & 15, fq = lane >> 4;
#pragma unroll
    for (int mi = 0; mi < 8; ++mi) {
        bf16_t* rp = out + (long)(row0 + wr * 128 + mi * 16 + fr) * ld + col0 + wc * 64 + fq * 4;
#pragma unroll
        for (int ni = 0; ni < 4; ++ni) {
            u32x2 w; w.x = pk_bf16(acc[mi][ni][0], acc[mi][ni][1]); w.y = pk_bf16(acc[mi][ni][2], acc[mi][ni][3]);
            *(u32x2*)(rp + ni * 16) = w;
        }
    }
}

template <bool RES_LN>
__device__ __forceinline__ void epi_residual(f32x4 (&acc)[8][4], char* smem, const float* resid, const float* rstats  ,
                                             const float* g, const float* b, float* rout, bf16_t* rbout, float* stout  , int row0, int nt) {
    const int tid_ = opaque_tid();
    const int lane = tid_ & 63, wid = tid_ >> 6;
    const int wr = wid >> 2, wc = wid & 3, fr = lane & 15, fq = lane >> 4;
    float* sp = (float*)smem;
    const int col0 = nt * 256 + wc * 64 + fq * 4;
#pragma unroll
    for (int mi = 0; mi < 8; ++mi) {
        const int rl = wr * 128 + mi * 16 + fr;
        const long row = row0 + rl;
        float mean = 0.f, rstd = 1.f;
        if (RES_LN) {
            const f32x4 p0 = *(const f32x4*)(rstats + row * 8), p1 = *(const f32x4*)(rstats + row * 8 + 4);
            const float s1 = (p0[0] + p0[2]) + (p1[0] + p1[2]), s2 = (p0[1] + p0[3]) + (p1[1] + p1[3]);
            mean = s1 * (1.0f / 1024.0f);
            const float var = fmaxf(s2 * (1.0f / 1024.0f) - mean * mean, 0.f);
            rstd = rsqrtf(var + LN_EPS);
        }
        float s1 = 0.f, s2 = 0.f;
#pragma unroll
        for (int ni = 0; ni < 4; ++ni) {
            f32x4 x = *(const f32x4*)(resid + row * 1024 + col0 + ni * 16);
            if (RES_LN) x = (x - mean) * rstd * *(const f32x4*)(g + col0 + ni * 16) + *(const f32x4*)(b + col0 + ni * 16);
            const f32x4 v = acc[mi][ni] + ALPHA * x;
            *(f32x4*)(rout + row * 1024 + col0 + ni * 16) = v;
            { u32x2 w; w.x = pk_bf16(v[0], v[1]); w.y = pk_bf16(v[2], v[3]); *(u32x2*)(rbout + row * 1024 + col0 + ni * 16) = w; }
            s1 += (v[0] + v[1]) + (v[2] + v[3]);
            s2 += (v[0] * v[0] + v[1] * v[1]) + (v[2] * v[2] + v[3] * v[3]);
        }
        s1 += __shfl_xor(s1, 16); s1 += __shfl_xor(s1, 32);
        s2 += __shfl_xor(s2, 16); s2 += __shfl_xor(s2, 32);
        if (fq == 0) { sp[(rl * 4 + wc) * 2] = s1; sp[(rl * 4 + wc) * 2 + 1] = s2; }
    }
    __syncthreads();
    if (tid_ < 256) {
        const int rl = tid_;
        const float a1 = (sp[rl * 8] + sp[rl * 8 + 2]) + (sp[rl * 8 + 4] + sp[rl * 8 + 6]);
        const float a2 = (sp[rl * 8 + 1] + sp[rl * 8 + 3]) + (sp[rl * 8 + 5] + sp[rl * 8 + 7]);
        *(f32x2*)(stout + ((long)(row0 + rl) * 4 + nt) * 2) = (f32x2){a1, a2};
    }
    __syncthreads();
}

__device__ __forceinline__ void ln_tile_stats(float* st, const float* rstats, int row0) {
    const int tid_ = opaque_tid();
    if (tid_ < 256) {
        const long row = row0 + tid_;
        const f32x4 p0 = *(const f32x4*)(rstats + row * 8), p1 = *(const f32x4*)(rstats + row * 8 + 4);
        const float s1 = (p0[0] + p0[2]) + (p1[0] + p1[2]), s2 = (p0[1] + p0[3]) + (p1[1] + p1[3]);
        const float mean = s1 * (1.0f / 1024.0f);
        const float var = fmaxf(s2 * (1.0f / 1024.0f) - mean * mean, 0.f);
        st[tid_ * 2] = mean; st[tid_ * 2 + 1] = rsqrtf(var + LN_EPS);
    }
}
__device__ __forceinline__ void ln_load_gb(float* gb, const float* g, const float* b) {
    for (int i = opaque_tid(); i < 1024; i += NTHR) { gb[i] = g[i]; gb[1024 + i] = b[i]; }
}

struct TJob { const float* src; int ldsrc; int K; int col0; int ncols; bf16_t* dst; int mode; int rowoff; };
__device__ __forceinline__ int tjob_row(const TJob& j, int c) {
    if (j.mode == 0) return j.rowoff + c;
    return 256 * (c >> 7) + 32 * ((c & 127) >> 4) + 16 * j.rowoff + (c & 15);
}
__device__ void transpose_tile(char* smem, const TJob& j, int kt, int ct) {
    float* tile = (float*)smem;
    const int tid = opaque_tid();
#pragma unroll
    for (int i = 0; i < 8; ++i) {
        const int e = tid + i * NTHR, kr = e >> 6, c = e & 63;
        const int cc = ct * 64 + c;
        float v = 0.f;
        if (cc < j.ncols) v = j.src[(long)(kt * 64 + kr) * j.ldsrc + j.col0 + cc];
        tile[kr * 65 + c] = v;
    }
    __syncthreads();
#pragma unroll
    for (int i = 0; i < 4; ++i) {
        const int e = tid + i * NTHR, c = e >> 5, k2 = (e & 31) * 2;
        const int cc = ct * 64 + c;
        if (cc < j.ncols) {
            const unsigned w = pk_bf16(tile[k2 * 65 + c], tile[(k2 + 1) * 65 + c]);
            *(unsigned*)(j.dst + (long)tjob_row(j, cc) * j.K + kt * 64 + k2) = w;
        }
    }
    __syncthreads();
}


__device__ __forceinline__ void tjob_run(char* smem, int bid, int nb, const float* src, int ld, int K, int col0, int ncols, bf16_t* dst, int mode, int rowoff) {
    TJob j; j.src = src; j.ldsrc = ld; j.K = K; j.col0 = col0; j.ncols = ncols; j.dst = dst; j.mode = mode; j.rowoff = rowoff;
    const int nkt = K / 64, nct = (ncols + 63) / 64, ntile = nkt * nct;
    for (int t = bid; t < ntile; t += nb) transpose_tile(smem, j, t % nkt, t / nkt);
}

__device__ void cvt_rows_bf16(const float* src, bf16_t* dst, long n8, int bid, int nb) {
    for (long i = (long)bid * NTHR + opaque_tid(); i < n8; i += (long)nb * NTHR) {
        const f32x4 a = *(const f32x4*)(src + i * 8), b = *(const f32x4*)(src + i * 8 + 4);
        u32x4 w; w.x = pk_bf16(a[0], a[1]); w.y = pk_bf16(a[2], a[3]); w.z = pk_bf16(b[0], b[1]); w.w = pk_bf16(b[2], b[3]);
        *(u32x4*)(dst + i * 8) = w;
    }
}

enum { I_X = 0, I_MEM, I_WIN, I_POSK, I_CKW1, I_CKW2, I_POSV, I_CVW1, I_CVW2, I_CONVW, I_IBIAS, I_FBIAS, I_NORMG, I_WOUT, I_LN1G, I_LN1B,
       I_XAWQ, I_XAWK, I_XAWV, I_XAWO, I_LN2G, I_LN2B, I_ROUTW, I_ROUTB, I_MW1, I_MW3, I_MW2, I_SW1, I_SW3, I_SW2, I_LN3G, I_LN3B };

__device__ void phase0(const Params& p, char* smem, int bid, int nb) {
    char* ws = p.ws;
    tjob_run(smem, bid, nb, p.in[I_WIN], 3360, 1024, 0, 1280, (bf16_t*)(ws + WS_WIN), 0, 0);
    tjob_run(smem, bid, nb, p.in[I_WIN], 3360, 1024, 1304, 2048, (bf16_t*)(ws + WS_WIN), 0, 1280);
    tjob_run(smem, bid, nb, p.in[I_WIN], 3360, 1024, 1280, 24, (bf16_t*)(ws + WS_WIN), 0, 3328);
    tjob_run(smem, bid, nb, p.in[I_WIN], 3360, 1024, 3352, 8, (bf16_t*)(ws + WS_WIN), 0, 3352);
    tjob_run(smem, bid, nb, p.in[I_WOUT], 1024, 1024, 0, 1024, (bf16_t*)(ws + WS_WOUT), 0, 0);
    tjob_run(smem, bid, nb, p.in[I_XAWQ], 1024, 1024, 0, 1024, (bf16_t*)(ws + WS_WQ), 0, 0);
    tjob_run(smem, bid, nb, p.in[I_XAWK], 1024, 1024, 0, 1024, (bf16_t*)(ws + WS_WKV), 0, 0);
    tjob_run(smem, bid, nb, p.in[I_XAWV], 1024, 1024, 0, 1024, (bf16_t*)(ws + WS_WKV), 0, 1024);
    tjob_run(smem, bid, nb, p.in[I_XAWO], 1024, 1024, 0, 1024, (bf16_t*)(ws + WS_WO), 0, 0);
    tjob_run(smem, bid, nb, p.in[I_ROUTW], 256, 1024, 0, 256, (bf16_t*)(ws + WS_WR), 0, 0);
    tjob_run(smem, bid, nb, p.in[I_SW1], 256, 1024, 0, 256, (bf16_t*)(ws + WS_WS13), 1, 0);
    tjob_run(smem, bid, nb, p.in[I_SW3], 256, 1024, 0, 256, (bf16_t*)(ws + WS_WS13), 1, 1);
    tjob_run(smem, bid, nb, p.in[I_SW2], 1024, 256, 0, 1024, (bf16_t*)(ws + WS_WS2), 0, 0);
    tjob_run(smem, bid, nb, p.in[I_CKW1], 64, 2048, 0, 64, (bf16_t*)(ws + WS_CK1), 0, 0);
    tjob_run(smem, bid, nb, p.in[I_CKW2], 64, 64, 0, 64, (bf16_t*)(ws + WS_CK2), 0, 0);
    tjob_run(smem, bid, nb, p.in[I_CVW1], 64, 2048, 0, 64, (bf16_t*)(ws + WS_CV1), 0, 0);
    tjob_run(smem, bid, nb, p.in[I_CVW2], 64, 64, 0, 64, (bf16_t*)(ws + WS_CV2), 0, 0);
    cvt_rows_bf16(p.in[I_X], (bf16_t*)(ws + WS_XB), (long)T_TOK * 1024 / 8, bid, nb);
    cvt_rows_bf16(p.in[I_MEM], (bf16_t*)(ws + WS_MEMB), (long)4096 * 1024 / 8, bid, nb);
    if (bid == 0) { int* c = (int*)(ws + WS_CNT); for (int i = opaque_tid(); i < 1024; i += NTHR) c[i] = 0; }
}

__device__ void small_cols_task(const Params& p, int task) {
    const bf16_t* xb = (const bf16_t*)(p.ws + WS_XB);
    const bf16_t* wt = (const bf16_t*)(p.ws + WS_WIN) + (long)3328 * 1024;
    float* psm = (float*)(p.ws + WS_PSM);
    const int tid_ = opaque_tid();
    const int lane = tid_ & 63, wid = tid_ >> 6, fr = lane & 15, fq = lane >> 4;
    const int r0 = task * 256 + wid * 32;
    f32x4 acc[2][2];
#pragma unroll
    for (int mi = 0; mi < 2; ++mi)
#pragma unroll
        for (int ni = 0; ni < 2; ++ni) acc[mi][ni] = (f32x4){0.f, 0.f, 0.f, 0.f};
    const bf16_t* ap0 = xb + (long)(r0 + fr) * 1024 + fq * 8;
    const bf16_t* ap1 = ap0 + 16 * 1024;
    const bf16_t* bp0 = wt + (long)fr * 1024 + fq * 8;
    const bf16_t* bp1 = bp0 + 16 * 1024;
#pragma unroll 4
    for (int ks = 0; ks < 32; ++ks) {
        const bf16x8 a0 = *(const bf16x8*)(ap0 + ks * 32), a1 = *(const bf16x8*)(ap1 + ks * 32);
        const bf16x8 b0 = *(const bf16x8*)(bp0 + ks * 32), b1 = *(const bf16x8*)(bp1 + ks * 32);
        acc[0][0] = mfma16(b0, a0, acc[0][0]); acc[0][1] = mfma16(b1, a0, acc[0][1]);
        acc[1][0] = mfma16(b0, a1, acc[1][0]); acc[1][1] = mfma16(b1, a1, acc[1][1]);
    }
#pragma unroll
    for (int mi = 0; mi < 2; ++mi)
#pragma unroll
        for (int ni = 0; ni < 2; ++ni) *(f32x4*)(psm + (long)(r0 + mi * 16 + fr) * 32 + ni * 16 + fq * 4) = acc[mi][ni];
}

__device__ void phase1(const Params& p, char* smem, int bid, int nb) {
    char* ws = p.ws;
    constexpr int N_INP = 128 * 13, N_KV = 16 * 8, N_SM = 128;
    for (int t = bid; t < N_INP + N_KV + N_SM; t += nb) {
        if (t < N_INP + N_KV) {
            const bool inp = t < N_INP;
            const int tt = inp ? t : t - N_INP;
            const int ntn = inp ? 13 : 8;
            const int mt = tt / ntn, nt = tt % ntn;
            LoadBf16Rows al, bl;
            al.init_contig((const bf16_t*)(ws + (inp ? WS_XB : WS_MEMB)), 1024, mt * 256);
            bl.init_contig((const bf16_t*)(ws + (inp ? WS_WIN : WS_WKV)), 1024, nt * 256);
            f32x4 acc[8][4];
            gemm_mainloop(smem, al, bl, 16, acc);
            if (inp) epi_store_bf16(acc, (bf16_t*)(ws + WS_P), PW, mt * 256, nt * 256);
            else epi_store_bf16(acc, (bf16_t*)(ws + WS_KVX), 2048, mt * 256, nt * 256);
        } else {
            small_cols_task(p, t - N_INP - N_KV);
        }
    }
}

__device__ void compress_task(const Params& p, char* smem, int which, int rb) {
    const char* ws = p.ws;
    const bf16_t* P = (const bf16_t*)(ws + WS_P);
    const float* pos = p.in[which ? I_POSV : I_POSK];
    const bf16_t* w1t = (const bf16_t*)(ws + (which ? WS_CV1 : WS_CK1));
    const bf16_t* w2t = (const bf16_t*)(ws + (which ? WS_CV2 : WS_CK2));
    bf16_t* outp = (bf16_t*)(p.ws + (which ? WS_VCMP : WS_KCMP));
    const int colbase = which ? PC_VC : PC_KC;
    const int tid_ = opaque_tid();
    const int lane = tid_ & 63, wid = tid_ >> 6, fr = lane & 15, fq = lane >> 4;
    const int mi = wid >> 2, ni = wid & 3;
    const int r = rb * 32 + mi * 16 + fr;
    const int b = r / 254, rem = r - b * 254, c = rem >> 1, g = rem & 1;
    const bf16_t* arow = P + (long)(b * 2048 + c * 16) * PW + colbase + g * 64 + fq * 8;
    const bf16_t* brow = w1t + (long)(ni * 16 + fr) * 2048 + fq * 8;
    const float* prow = pos + fq * 8;
    f32x4 acc = (f32x4){0.f, 0.f, 0.f, 0.f};
#pragma unroll 8
    for (int ks = 0; ks < 64; ++ks) {
        const int l = ks >> 1, d0 = (ks & 1) * 32;
        const u32x4 av = *(const u32x4*)(arow + (long)l * PW + d0);
        const f32x4 p0 = *(const f32x4*)(prow + l * 64 + d0), p1 = *(const f32x4*)(prow + l * 64 + d0 + 4);
        u32x4 aw;
        aw.x = pk_bf16(bf_lo(av.x) + p0[0], bf_hi(av.x) + p0[1]); aw.y = pk_bf16(bf_lo(av.y) + p0[2], bf_hi(av.y) + p0[3]);
        aw.z = pk_bf16(bf_lo(av.z) + p1[0], bf_hi(av.z) + p1[1]); aw.w = pk_bf16(bf_lo(av.w) + p1[2], bf_hi(av.w) + p1[3]);
        const bf16x8 bb = *(const bf16x8*)(brow + ks * 32);
        acc = mfma16(bb, as_bf16x8(aw), acc);
    }
    bf16_t* h1 = (bf16_t*)smem;
    {
        u32x2 w; w.x = pk_bf16(siluf_(acc[0]), siluf_(acc[1])); w.y = pk_bf16(siluf_(acc[2]), siluf_(acc[3]));
        *(u32x2*)(h1 + (mi * 16 + fr) * 72 + ni * 16 + fq * 4) = w;
    }
    __syncthreads();
    f32x4 acc2 = (f32x4){0.f, 0.f, 0.f, 0.f};
#pragma unroll
    for (int ks = 0; ks < 2; ++ks) {
        const bf16x8 a = *(const bf16x8*)(h1 + (mi * 16 + fr) * 72 + ks * 32 + fq * 8);
        const bf16x8 bb = *(const bf16x8*)(w2t + (ni * 16 + fr) * 64 + ks * 32 + fq * 8);
        acc2 = mfma16(bb, a, acc2);
    }
    {
        u32x2 w; w.x = pk_bf16(acc2[0], acc2[1]); w.y = pk_bf16(acc2[2], acc2[3]);
        *(u32x2*)(outp + ((long)(b * 2 + g) * 128 + c) * 64 + ni * 16 + fq * 4) = w;
    }
    __syncthreads();
}

__device__ void phase2(const Params& p, char* smem, int bid, int nb) {
    char* ws = p.ws;
    for (int t = bid; t < 254; t += nb) compress_task(p, smem, t / 127, t % 127);
    const int tid_ = opaque_tid();
    if (bid < 32 && tid_ < 32) {
        bf16_t* kc = (bf16_t*)(ws + WS_KCMP) + ((long)bid * 128 + 127) * 64;
        bf16_t* vc = (bf16_t*)(ws + WS_VCMP) + ((long)bid * 128 + 127) * 64;
        ((unsigned*)kc)[tid_] = 0u; ((unsigned*)vc)[tid_] = 0u;
    }
    const bf16_t* P = (const bf16_t*)(ws + WS_P);
    const float* cw = p.in[I_CONVW];
    bf16_t* qk = (bf16_t*)(ws + WS_QK);
    for (long it = (long)bid * NTHR + tid_; it < (long)T_TOK * 128; it += (long)nb * NTHR) {
        const int t = (int)(it >> 7), ch = (int)(it & 127);
        const int s = t & (SEQ - 1);
        float a[8];
#pragma unroll
        for (int e = 0; e < 8; ++e) a[e] = 0.f;
#pragma unroll
        for (int j = 0; j < 4; ++j) {
            if (s - 3 + j >= 0) {
                const u32x4 u = *(const u32x4*)(P + (long)(t - 3 + j) * PW + PC_MQ + ch * 8);
                const f32x4 w0 = *(const f32x4*)(cw + j * 1024 + ch * 8), w1 = *(const f32x4*)(cw + j * 1024 + ch * 8 + 4);
                a[0] += w0[0] * bf_lo(u.x); a[1] += w0[1] * bf_hi(u.x); a[2] += w0[2] * bf_lo(u.y); a[3] += w0[3] * bf_hi(u.y);
                a[4] += w1[0] * bf_lo(u.z); a[5] += w1[1] * bf_hi(u.z); a[6] += w1[2] * bf_lo(u.w); a[7] += w1[3] * bf_hi(u.w);
            }
        }
        const float sc = ch < 64 ? 0.08838834764831845f : 1.0f;
        u32x4 w;
        w.x = pk_bf16(siluf_(a[0]) * sc, siluf_(a[1]) * sc); w.y = pk_bf16(siluf_(a[2]) * sc, siluf_(a[3]) * sc);
        w.z = pk_bf16(siluf_(a[4]) * sc, siluf_(a[5]) * sc); w.w = pk_bf16(siluf_(a[6]) * sc, siluf_(a[7]) * sc);
        *(u32x4*)(qk + (long)t * 1024 + ch * 8) = w;
    }
}

typedef __attribute__((address_space(3))) s16x4 lds_s16x4;
__device__ __forceinline__ s16x4 lds_tr(const char* a) { return __builtin_amdgcn_ds_read_tr16_b64_v4i16((lds_s16x4*)a); }
__device__ __forceinline__ bf16x8 tr_frag_perm(const char* base, int pitch, int rbase, int cbase, int fr, int fq) {
    const char* a0 = base + (rbase + 4 * fq + (fr >> 2)) * pitch + (cbase + 4 * (fr & 3)) * 2;
    const s16x4 lo = lds_tr(a0), hi = lds_tr(a0 + 16 * pitch);
    return (bf16x8){lo[0], lo[1], lo[2], lo[3], hi[0], hi[1], hi[2], hi[3]};
}
__device__ __forceinline__ bf16x8 tr_frag_std(const char* base, int pitch, int rbase, int cbase, int fr, int fq) {
    const char* a0 = base + (rbase + 8 * fq + (fr >> 2)) * pitch + (cbase + 4 * (fr & 3)) * 2;
    const s16x4 lo = lds_tr(a0), hi = lds_tr(a0 + 4 * pitch);
    return (bf16x8){lo[0], lo[1], lo[2], lo[3], hi[0], hi[1], hi[2], hi[3]};
}
__device__ __forceinline__ bf16x8 pack_p(const f32x4 a, const f32x4 b) {
    u32x4 w; w.x = pk_bf16(a[0], a[1]); w.y = pk_bf16(a[2], a[3]); w.z = pk_bf16(b[0], b[1]); w.w = pk_bf16(b[2], b[3]);
    return as_bf16x8(w);
}

__device__ __forceinline__ float dpp_xor1(float v) { return __builtin_bit_cast(float, __builtin_amdgcn_mov_dpp(__builtin_bit_cast(int, v), 0xB1, 0xF, 0xF, true)); }
__device__ __forceinline__ float dpp_xor2(float v) { return __builtin_bit_cast(float, __builtin_amdgcn_mov_dpp(__builtin_bit_cast(int, v), 0x4E, 0xF, 0xF, true)); }

constexpr int NSA_PITCH = 160;
constexpr int NSA_KC = 0, NSA_VC = 20480, NSA_KT = 40960, NSA_VT = 61440, NSA_MISC = 81920, NSA_Y = 83968;

struct NsaState {
    bf16x8 qf[2][2];
    int tl[2];
    unsigned selm[2];
    unsigned wunion, bunion;
};

template <int MODE>
__device__ __forceinline__ void nsa_stream(char* smem, const bf16_t* Pb  , int g, int i, NsaState& st, float gate0, float gate1, const int tid) {
    const int lane = tid & 63, fr = lane & 15, fq = lane >> 4;
    const int kcol = (MODE == 0 ? PC_KS : PC_KW) + g * 64, vcol = (MODE == 0 ? PC_VS : PC_VW) + g * 64;
    const int lrow = tid >> 3, lch = tid & 7;
    const unsigned need = MODE == 0 ? st.bunion : 0xffffffffu;
    const int jlo = MODE == 0 ? 0 : (i - 8 > 0 ? i - 8 : 0);
    f32x4 O[2][4];
    float m[2], l[2];
    int tlq[2];
#pragma unroll
    for (int mt = 0; mt < 2; ++mt) { m[mt] = -1e30f; l[mt] = 0.f; tlq[mt] = st.tl[mt] - 4 * fq;
#pragma unroll
        for (int dt = 0; dt < 4; ++dt) O[mt][dt] = (f32x4){0.f, 0.f, 0.f, 0.f}; }
    int j = jlo;
    while (j <= i && !((need >> j) & 1u)) ++j;
    u32x4 kreg, vreg;
    int buf = 0;
    if (j <= i) {
        const bf16_t* rp = Pb + (long)(j * 64 + lrow) * PW + lch * 8;
        kreg = *(const u32x4*)(rp + kcol); vreg = *(const u32x4*)(rp + vcol);
        *(u32x4*)(smem + NSA_KT + lrow * NSA_PITCH + lch * 16) = kreg;
        *(u32x4*)(smem + NSA_VT + lrow * NSA_PITCH + lch * 16) = vreg;
    }
    __syncthreads();
    while (j <= i) {
        int jn = j + 1;
        while (jn <= i && !((need >> jn) & 1u)) ++jn;
        if (jn <= i) {
            const bf16_t* rp = Pb + (long)(jn * 64 + lrow) * PW + lch * 8;
            kreg = *(const u32x4*)(rp + kcol); vreg = *(const u32x4*)(rp + vcol);
        }
        const char* KT = smem + NSA_KT + buf * 10240;
        const char* VT = smem + NSA_VT + buf * 10240;
        const bool wave_on = MODE == 0 ? (((st.wunion >> j) & 1u) != 0u) : true;
        if (wave_on) {
            f32x4 S[2][4];
            {
                bf16x8 kf[4][2];
#pragma unroll
                for (int nt = 0; nt < 4; ++nt)
#pragma unroll
                    for (int ks = 0; ks < 2; ++ks) kf[nt][ks] = *(const bf16x8*)(KT + (16 * nt + fr) * NSA_PITCH + (ks * 4 + fq) * 16);
#pragma unroll
                for (int mt = 0; mt < 2; ++mt)
#pragma unroll
                    for (int nt = 0; nt < 4; ++nt) {
                        f32x4 s = (f32x4){0.f, 0.f, 0.f, 0.f};
                        s = mfma16(kf[nt][0], st.qf[mt][0], s);
                        s = mfma16(kf[nt][1], st.qf[mt][1], s);
                        S[mt][nt] = s;
                    }
            }
            bf16x8 pf[2][2];
#pragma unroll
            for (int mt = 0; mt < 2; ++mt) {
                const bool rowsel = MODE == 0 ? (((st.selm[mt] >> j) & 1u) != 0u) : true;
                float mx = -INFINITY;
#pragma unroll
                for (int nt = 0; nt < 4; ++nt)
#pragma unroll
                    for (int e = 0; e < 4; ++e) {
                        const int kc = 16 * nt + e;
                        bool ok = rowsel;
                        if (j == i) ok = ok && (kc <= tlq[mt]);
                        if (MODE == 1) { if (j == i - 8) ok = ok && (kc > tlq[mt]); }
                        const float sv = ok ? S[mt][nt][e] * 0.125f : -INFINITY;
                        S[mt][nt][e] = sv;
                        mx = fmaxf(mx, sv);
                    }
                mx = fmaxf(mx, __shfl_xor(mx, 16)); mx = fmaxf(mx, __shfl_xor(mx, 32));
                const float mnew = fmaxf(m[mt], mx);
                const float alpha = __expf(m[mt] - mnew);
                float rs = 0.f;
#pragma unroll
                for (int nt = 0; nt < 4; ++nt)
#pragma unroll
                    for (int e = 0; e < 4; ++e) { const float pv = __expf(S[mt][nt][e] - mnew); S[mt][nt][e] = pv; rs += pv; }
                rs += __shfl_xor(rs, 16); rs += __shfl_xor(rs, 32);
                l[mt] = l[mt] * alpha + rs; m[mt] = mnew;
#pragma unroll
                for (int dt = 0; dt < 4; ++dt) O[mt][dt] = O[mt][dt] * alpha;
                pf[mt][0] = pack_p(S[mt][0], S[mt][1]); pf[mt][1] = pack_p(S[mt][2], S[mt][3]);
            }
#pragma unroll
            for (int ks2 = 0; ks2 < 2; ++ks2)
#pragma unroll
                for (int dt = 0; dt < 4; ++dt) {
                    const bf16x8 vf = tr_frag_perm(VT, NSA_PITCH, 32 * ks2, 16 * dt, fr, fq);
                    O[0][dt] = mfma16(vf, pf[0][ks2], O[0][dt]);
                    O[1][dt] = mfma16(vf, pf[1][ks2], O[1][dt]);
                }
        }
        if (jn <= i) {
            char* KTn = smem + NSA_KT + (buf ^ 1) * 10240; char* VTn = smem + NSA_VT + (buf ^ 1) * 10240;
            *(u32x4*)(KTn + lrow * NSA_PITCH + lch * 16) = kreg;
            *(u32x4*)(VTn + lrow * NSA_PITCH + lch * 16) = vreg;
        }
        __syncthreads();
        buf ^= 1; j = jn;
    }
#pragma unroll
    for (int mt = 0; mt < 2; ++mt) {
        const float gsc = (mt == 0 ? gate0 : gate1) * (l[mt] > 0.f ? 1.0f / l[mt] : 0.f);
#pragma unroll
        for (int dt = 0; dt < 4; ++dt) { f32x4* yp = (f32x4*)(smem + NSA_Y) + (mt * 4 + dt) * NTHR + tid; *yp = *yp + O[mt][dt] * gsc; }
    }
}

__device__ __forceinline__ void nsa_cmp_one(const char* smem, const bf16x8 qf0, const bf16x8 qf1, const int t, const int i, const float gate0, f32x4* yp  , unsigned& selm, const int lane) {
    const int fr = lane & 15, fq = lane >> 4;
        const int cl = (t >= 31 ? ((t - 31) >> 4) : -1) - 4 * fq;
        f32x4 S[8];
#pragma unroll
        for (int nt = 0; nt < 8; ++nt) {
            f32x4 s = (f32x4){0.f, 0.f, 0.f, 0.f};
#pragma unroll
            for (int ks = 0; ks < 2; ++ks) {
                const bf16x8 kf = *(const bf16x8*)(smem + NSA_KC + (16 * nt + fr) * NSA_PITCH + (ks * 4 + fq) * 16);
                s = mfma16(kf, (ks == 0 ? qf0 : qf1), s);
            }
            S[nt] = s;
        }
        float mx = -INFINITY;
#pragma unroll
        for (int nt = 0; nt < 8; ++nt)
#pragma unroll
            for (int e = 0; e < 4; ++e) {
                const float sv = (16 * nt + e <= cl) ? S[nt][e] * 0.125f : -INFINITY;
                S[nt][e] = sv; mx = fmaxf(mx, sv);
            }
        mx = fmaxf(mx, __shfl_xor(mx, 16)); mx = fmaxf(mx, __shfl_xor(mx, 32));
        const float mref = fmaxf(mx, -1e30f);
        float rs = 0.f;
#pragma unroll
        for (int nt = 0; nt < 8; ++nt)
#pragma unroll
            for (int e = 0; e < 4; ++e) { const float pv = __expf(S[nt][e] - mref); S[nt][e] = pv; rs += pv; }
        rs += __shfl_xor(rs, 16); rs += __shfl_xor(rs, 32);
        const float inv = rs > 0.f ? 1.0f / rs : 0.f;
#pragma unroll
        for (int nt = 0; nt < 8; ++nt) S[nt] = S[nt] * inv;
        {
            f32x4 O[4];
#pragma unroll
            for (int dt = 0; dt < 4; ++dt) O[dt] = (f32x4){0.f, 0.f, 0.f, 0.f};
#pragma unroll
            for (int ks2 = 0; ks2 < 4; ++ks2) {
                const bf16x8 pf = pack_p(S[2 * ks2], S[2 * ks2 + 1]);
#pragma unroll
                for (int dt = 0; dt < 4; ++dt) {
                    const bf16x8 vf = tr_frag_perm(smem + NSA_VC, NSA_PITCH, 32 * ks2, 16 * dt, fr, fq);
                    O[dt] = mfma16(vf, pf, O[dt]);
                }
            }
#pragma unroll
            for (int dt = 0; dt < 4; ++dt) yp[dt * NTHR] = O[dt] * gate0;
        }
        float imp[8];
        {
            float own[8], last[8];
#pragma unroll
            for (int nt = 0; nt < 8; ++nt) {
                f32x4 v = S[nt];
#pragma unroll
                for (int e = 0; e < 4; ++e) { v[e] += dpp_xor1(v[e]); v[e] += dpp_xor2(v[e]); }
                own[nt] = (v[0] + v[1]) + (v[2] + v[3]); last[nt] = v[3];
            }
            const int src = (lane + 48) & 63;
#pragma unroll
            for (int nt = 0; nt < 8; ++nt) {
                const float a = __shfl(last[nt], src);
                const float bsh = nt > 0 ? __shfl(last[nt > 0 ? nt - 1 : 0], src) : 0.f;
                const float prevc = fq > 0 ? a : bsh;
                const int n = 4 * nt + fq;
                const float pslc = own[nt] + prevc;
                const bool valid = n <= i;
                const bool forced = (n == 0) || (n == i) || (n == i - 1);
                imp[nt] = valid ? pslc + (forced ? 1e4f : 0.f) : -1e30f;
            }
        }
        unsigned mask = 0u;
#pragma unroll 1
        for (int r = 0; r < 8; ++r) {
            float bv = imp[0]; int bn = fq;
#pragma unroll
            for (int nt = 1; nt < 8; ++nt) { if (imp[nt] > bv) { bv = imp[nt]; bn = 4 * nt + fq; } }
#pragma unroll
            for (int off = 16; off <= 32; off <<= 1) {
                const float ov = __shfl_xor(bv, off); const int on = __shfl_xor(bn, off);
                if (ov > bv || (ov == bv && on < bn)) { bv = ov; bn = on; }
            }
            if (bv > -5e29f) mask |= 1u << bn;
#pragma unroll
            for (int nt = 0; nt < 8; ++nt) if (bn == 4 * nt + fq) imp[nt] = -3.0e38f;
        }
        selm = mask;
}

__device__ void nsa_task(const Params& p, char* smem, int b, int g, int i) {
    const char* ws = p.ws;
    const bf16_t* Pb = (const bf16_t*)(ws + WS_P) + (long)b * SEQ * PW;
    const float* psm = (const float*)(ws + WS_PSM) + (long)b * SEQ * 32;
    int tid = threadIdx.x;
    asm volatile("" : "+v"(tid));
    const int lane = tid & 63, wid = __builtin_amdgcn_readfirstlane(tid >> 6), fr = lane & 15, fq = lane >> 4;
    const int qs = i * 64;
    NsaState st;
    float gate[2][3];
#pragma unroll
    for (int mt = 0; mt < 2; ++mt) {
        st.tl[mt] = 8 * wid + 4 * mt + (fr >> 2);
        const int h = fr & 3;
        const bf16_t* qp = Pb + (long)(qs + st.tl[mt]) * PW + PC_Q + g * 256 + h * 64 + fq * 8;
        st.qf[mt][0] = *(const bf16x8*)(qp); st.qf[mt][1] = *(const bf16x8*)(qp + 32);
        const float* gp = psm + (long)(qs + st.tl[mt]) * 32 + (g * 4 + h) * 3;
        gate[mt][0] = sigmoidf_(gp[0]); gate[mt][1] = sigmoidf_(gp[1]); gate[mt][2] = sigmoidf_(gp[2]);
    }
    {
        const bf16_t* kc = (const bf16_t*)(ws + WS_KCMP) + (long)(b * 2 + g) * 128 * 64;
        const bf16_t* vc = (const bf16_t*)(ws + WS_VCMP) + (long)(b * 2 + g) * 128 * 64;
#pragma unroll
        for (int r = 0; r < 2; ++r) {
            const int e = tid + r * NTHR, row = e >> 3, ch = e & 7;
            *(u32x4*)(smem + NSA_KC + row * NSA_PITCH + ch * 16) = *(const u32x4*)(kc + row * 64 + ch * 8);
            *(u32x4*)(smem + NSA_VC + row * NSA_PITCH + ch * 16) = *(const u32x4*)(vc + row * 64 + ch * 8);
        }
    }
    __syncthreads();
    nsa_cmp_one(smem, st.qf[0][0], st.qf[0][1], qs + st.tl[0], i, gate[0][0], (f32x4*)(smem + NSA_Y) + tid, st.selm[0], lane);
    asm volatile("" ::: "memory");
    __builtin_amdgcn_sched_barrier(0);
    nsa_cmp_one(smem, st.qf[1][0], st.qf[1][1], qs + st.tl[1], i, gate[1][0], (f32x4*)(smem + NSA_Y) + 4 * NTHR + tid, st.selm[1], lane);
    __builtin_amdgcn_sched_barrier(0);
    {
        unsigned u = st.selm[0] | st.selm[1];
        u |= __shfl_xor(u, 4); u |= __shfl_xor(u, 8);
        st.wunion = u;
        unsigned* misc = (unsigned*)(smem + NSA_MISC);
        if (lane == 0) misc[wid] = u;
        __syncthreads();
        unsigned bu = 0u;
#pragma unroll
        for (int w = 0; w < 8; ++w) bu |= misc[w];
        st.bunion = bu;
    }
    nsa_stream<0>(smem, Pb, g, i, st, gate[0][1], gate[1][1], tid);
    nsa_stream<1>(smem, Pb, g, i, st, gate[0][2], gate[1][2], tid);
    bf16_t* mix = (bf16_t*)(p.ws + WS_MIX) + (long)b * SEQ * 1024;
#pragma unroll
    for (int mt = 0; mt < 2; ++mt) {
        bf16_t* op = mix + (long)(qs + st.tl[mt]) * 1024 + g * 256 + (fr & 3) * 64 + fq * 4;
#pragma unroll
        for (int dt = 0; dt < 4; ++dt) {
            const f32x4 yv = *((const f32x4*)(smem + NSA_Y) + (mt * 4 + dt) * NTHR + tid);
            u32x2 w; w.x = pk_bf16(yv[0], yv[1]); w.y = pk_bf16(yv[2], yv[3]);
            *(u32x2*)(op + dt * 16) = w;
        }
    }
    __syncthreads();
}

constexpr int ML_PITCH = 288;
constexpr int ML_Q = 0, ML_K = 18432, ML_V = 36864, ML_VW = 55296, ML_C = 73728, ML_N = 110592, ML_GB = 111104, ML_GA = 119296, ML_GMQ = 127488,
              ML_GS = 135680, ML_ST = 136192;

__device__ __forceinline__ float wave_incl_scan_add(float v, int lane) {
#pragma unroll
    for (int off = 1; off < 64; off <<= 1) { const float o = __shfl_up(v, off); if (lane >= off) v += o; }
    return v;
}
__device__ __forceinline__ float wave_incl_scan_max(float v, int lane) {
#pragma unroll
    for (int off = 1; off < 64; off <<= 1) { const float o = __shfl_up(v, off); if (lane >= off) v = fmaxf(v, o); }
    return v;
}
__device__ __forceinline__ float wave_max(float v) {
#pragma unroll
    for (int off = 32; off >= 1; off >>= 1) v = fmaxf(v, __shfl_xor(v, off));
    return v;
}

__device__ void mlstm_scan(const Params& p, char* smem, int b, int h) {
    const char* ws = p.ws;
    int tid = threadIdx.x;
    asm volatile("" : "+v"(tid));
    const int lane = tid & 63, wid = __builtin_amdgcn_readfirstlane(tid >> 6), fr = lane & 15, fq = lane >> 4;
    const bf16_t* QK = (const bf16_t*)(ws + WS_QK) + (long)b * SEQ * 1024 + h * 128;
    const bf16_t* Pb = (const bf16_t*)(ws + WS_P) + (long)b * SEQ * PW;
    const float* psm = (const float*)(ws + WS_PSM) + (long)b * SEQ * 32;
    bf16_t* mix = (bf16_t*)(p.ws + WS_MIX) + (long)b * SEQ * 1024 + 512 + h * 128;
    float* GB = (float*)(smem + ML_GB); float* GA = (float*)(smem + ML_GA); float* GMQ = (float*)(smem + ML_GMQ);
    float* GS = (float*)(smem + ML_GS);
    float* NV = (float*)(smem + ML_N);
    float* ST = (float*)(smem + ML_ST);
    {
        const float ib = p.in[I_IBIAS][h], fb = p.in[I_FBIAS][h];
        for (int c = wid; c < 32; c += 8) {
            const int t = c * 64 + lane;
            const float ipre = psm[(long)t * 32 + 24 + h], fpre = psm[(long)t * 32 + 28 + h];
            const float li = ipre + ib;
            const float x = fpre + fb;
            const float lf = fminf(x, 0.f) - log1pf(__expf(-fabsf(x)));
            const float bb = wave_incl_scan_add(lf, lane);
            const float aa = li - bb;
            const float g = __shfl(bb, 63);
            const float pm = wave_incl_scan_max(aa, lane);
            const float mloc = wave_max(g + aa);
            GB[t] = bb; GA[t] = aa; GMQ[t] = pm;
            if (lane == 0) { GS[64 + c] = g; GS[96 + c] = mloc; }
        }
    }
    for (int e = tid; e < 36864 / 16; e += NTHR) *(u32x4*)(smem + ML_C + e * 16) = (u32x4){0u, 0u, 0u, 0u};
    if (tid < 128) NV[tid] = 0.f;
    __syncthreads();
    if (tid == 0) {
        float m = 0.f;
        for (int c = 0; c < 32; ++c) { GS[c] = m; const float mn = fmaxf(GS[64 + c] + m, GS[96 + c]); GS[32 + c] = mn; m = mn; }
    }
    __syncthreads();
    for (int t = tid; t < SEQ; t += NTHR) GMQ[t] = GB[t] + fmaxf(GS[t >> 6], GMQ[t]);
    __syncthreads();

    f32x4 Cacc[9];
#pragma unroll
    for (int c9 = 0; c9 < 9; ++c9) Cacc[c9] = (f32x4){0.f, 0.f, 0.f, 0.f};
    const int lrow = tid >> 4, lch = tid & 15;
    u32x4 rq[2], rk[2], rv[2];
#pragma unroll
    for (int i2 = 0; i2 < 2; ++i2) {
        const int row = lrow + 32 * i2;
        rq[i2] = *(const u32x4*)(QK + (long)row * 1024 + lch * 8);
        rk[i2] = *(const u32x4*)(QK + (long)row * 1024 + 512 + lch * 8);
        rv[i2] = *(const u32x4*)(Pb + (long)row * PW + PC_MV + h * 128 + lch * 8);
    }
    const int mt = wid >> 1, half = wid & 1;
#pragma unroll 1
    for (int c = 0; c < 32; ++c) {
        const float m_old = GS[c], m_new = GS[32 + c], gch = GS[64 + c];
#pragma unroll
        for (int i2 = 0; i2 < 2; ++i2) {
            const int row = lrow + 32 * i2;
            *(u32x4*)(smem + ML_Q + row * ML_PITCH + lch * 16) = rq[i2];
            *(u32x4*)(smem + ML_K + row * ML_PITCH + lch * 16) = rk[i2];
            *(u32x4*)(smem + ML_V + row * ML_PITCH + lch * 16) = rv[i2];
            const float wk = __expf(gch + GA[c * 64 + row] - m_new);
            u32x4 w;
            w.x = pk_bf16(bf_lo(rv[i2].x) * wk, bf_hi(rv[i2].x) * wk); w.y = pk_bf16(bf_lo(rv[i2].y) * wk, bf_hi(rv[i2].y) * wk);
            w.z = pk_bf16(bf_lo(rv[i2].z) * wk, bf_hi(rv[i2].z) * wk); w.w = pk_bf16(bf_lo(rv[i2].w) * wk, bf_hi(rv[i2].w) * wk);
            *(u32x4*)(smem + ML_VW + row * ML_PITCH + lch * 16) = w;
        }
        if (tid < 128) {
            const int row = tid >> 1, hf = tid & 1;
            const float wk = __expf(gch + GA[c * 64 + row] - m_new);
            u32x4 w = (u32x4){0u, 0u, 0u, 0u};
            if (hf == 0) w.x = pk_bf16(wk, 0.f);
            *(u32x4*)(smem + ML_VW + row * ML_PITCH + 256 + hf * 16) = w;
        }
        __syncthreads();
        if (c + 1 < 32) {
#pragma unroll
            for (int i2 = 0; i2 < 2; ++i2) {
                const int row = (c + 1) * 64 + lrow + 32 * i2;
                rq[i2] = *(const u32x4*)(QK + (long)row * 1024 + lch * 8);
                rk[i2] = *(const u32x4*)(QK + (long)row * 1024 + 512 + lch * 8);
                rv[i2] = *(const u32x4*)(Pb + (long)row * PW + PC_MV + h * 128 + lch * 8);
            }
        }
        const int l = 16 * mt + fr;
        const float bl = GB[c * 64 + l], mq = GMQ[c * 64 + l];
        const float ul = bl - mq;
        f32x4 hv[4];
        float s1 = 0.f, s2 = 0.f;
        {
            bf16x8 qf[4];
#pragma unroll
            for (int ks = 0; ks < 4; ++ks) qf[ks] = *(const bf16x8*)(smem + ML_Q + l * ML_PITCH + (ks * 4 + fq) * 16);
            f32x4 S[4];
#pragma unroll
            for (int nt = 0; nt < 4; ++nt) {
                f32x4 s = (f32x4){0.f, 0.f, 0.f, 0.f};
#pragma unroll
                for (int ks = 0; ks < 4; ++ks) {
                    const bf16x8 kf = *(const bf16x8*)(smem + ML_K + (16 * nt + fr) * ML_PITCH + (ks * 4 + fq) * 16);
                    s = mfma16(kf, qf[ks], s);
                }
                S[nt] = s;
            }
            float dintra = 0.f;
            const int lq = l - 4 * fq;
#pragma unroll
            for (int nt = 0; nt < 4; ++nt) {
                const f32x4 av = *(const f32x4*)(GA + c * 64 + 16 * nt + 4 * fq);
#pragma unroll
                for (int e = 0; e < 4; ++e) {
                    const float w = (16 * nt + e <= lq) ? __expf(ul + av[e]) : 0.f;
                    const float sv = S[nt][e] * w;
                    S[nt][e] = sv; dintra += sv;
                }
            }
            dintra += __shfl_xor(dintra, 16); dintra += __shfl_xor(dintra, 32);
            float dinter = 0.f;
#pragma unroll
            for (int ks = 0; ks < 4; ++ks) {
                const f32x4 n0 = *(const f32x4*)(NV + ks * 32 + fq * 8), n1 = *(const f32x4*)(NV + ks * 32 + fq * 8 + 4);
                const u32x4 qu = __builtin_bit_cast(u32x4, qf[ks]);
                dinter += bf_lo(qu.x) * n0[0] + bf_hi(qu.x) * n0[1] + bf_lo(qu.y) * n0[2] + bf_hi(qu.y) * n0[3]
                        + bf_lo(qu.z) * n1[0] + bf_hi(qu.z) * n1[1] + bf_lo(qu.w) * n1[2] + bf_hi(qu.w) * n1[3];
            }
            dinter += __shfl_xor(dinter, 16); dinter += __shfl_xor(dinter, 32);
            const float winter = __expf(ul + m_old);
            const float den = winter * dinter + dintra;
            const float rden = 1.0f / fmaxf(fabsf(den), __expf(-mq));
            const bf16x8 pf0 = pack_p(S[0], S[1]), pf1 = pack_p(S[2], S[3]);
#pragma unroll
            for (int c4 = 0; c4 < 4; ++c4) {
                const int et = 4 * half + c4;
                f32x4 num = (f32x4){0.f, 0.f, 0.f, 0.f}, inter = (f32x4){0.f, 0.f, 0.f, 0.f};
                num = mfma16(tr_frag_perm(smem + ML_V, ML_PITCH, 0, 16 * et, fr, fq), pf0, num);
                num = mfma16(tr_frag_perm(smem + ML_V, ML_PITCH, 32, 16 * et, fr, fq), pf1, num);
#pragma unroll
                for (int ks = 0; ks < 4; ++ks) {
                    const bf16x8 cf = *(const bf16x8*)(smem + ML_C + (16 * et + fr) * ML_PITCH + (ks * 4 + fq) * 16);
                    inter = mfma16(cf, qf[ks], inter);
                }
                const f32x4 hh = (inter * winter + num) * rden;
                hv[c4] = hh;
                s1 += (hh[0] + hh[1]) + (hh[2] + hh[3]);
                s2 += (hh[0] * hh[0] + hh[1] * hh[1]) + (hh[2] * hh[2] + hh[3] * hh[3]);
            }
            s1 += __shfl_xor(s1, 16); s1 += __shfl_xor(s1, 32);
            s2 += __shfl_xor(s2, 16); s2 += __shfl_xor(s2, 32);
            if (fq == 0) { ST[(l * 2 + half) * 2] = s1; ST[(l * 2 + half) * 2 + 1] = s2; }
        }
        {
            const float decay = __expf(gch + m_old - m_new);
#pragma unroll
            for (int c9 = 0; c9 < 9; ++c9) Cacc[c9] = Cacc[c9] * decay;
#pragma unroll
            for (int ks2 = 0; ks2 < 2; ++ks2) {
                const bf16x8 kt = tr_frag_std(smem + ML_K, ML_PITCH, 32 * ks2, 16 * wid, fr, fq);
#pragma unroll
                for (int c9 = 0; c9 < 9; ++c9) {
                    const bf16x8 vw = tr_frag_std(smem + ML_VW, ML_PITCH, 32 * ks2, 16 * c9, fr, fq);
                    Cacc[c9] = mfma16(kt, vw, Cacc[c9]);
                }
            }
        }
        __syncthreads();
        {
            const float* sp = ST + l * 4;
            const float t1 = sp[0] + sp[2], t2 = sp[1] + sp[3];
            const float mean = t1 * (1.0f / 128.0f);
            const float var = fmaxf(t2 * (1.0f / 128.0f) - mean * mean, 0.f);
            const float rstd = rsqrtf(var + LN_EPS);
            const long tok = c * 64 + l;
#pragma unroll
            for (int c4 = 0; c4 < 4; ++c4) {
                const int col = 64 * half + 16 * c4 + 4 * fq;
                const u32x2 ou = *(const u32x2*)(Pb + tok * PW + PC_MO + h * 128 + col);
                const f32x4 ng = *(const f32x4*)(p.in[I_NORMG] + h * 128 + col);
                const f32x4 y = (hv[c4] - mean) * rstd * ng;
                u32x2 w;
                w.x = pk_bf16(y[0] * sigmoidf_(bf_lo(ou.x)), y[1] * sigmoidf_(bf_hi(ou.x)));
                w.y = pk_bf16(y[2] * sigmoidf_(bf_lo(ou.y)), y[3] * sigmoidf_(bf_hi(ou.y)));
                *(u32x2*)(mix + tok * 1024 + col) = w;
            }
        }
#pragma unroll
        for (int c9 = 0; c9 < 8; ++c9) {
            u32x2 w; w.x = pk_bf16(Cacc[c9][0], Cacc[c9][1]); w.y = pk_bf16(Cacc[c9][2], Cacc[c9][3]);
            *(u32x2*)(smem + ML_C + (16 * c9 + fr) * ML_PITCH + (16 * wid + 4 * fq) * 2) = w;
        }
        if (fr == 0) *(f32x4*)(NV + 16 * wid + 4 * fq) = Cacc[8];
        __syncthreads();
    }
}

__device__ void phase3(const Params& p, char* smem, int bid, int nb) {
    int* qctr = (int*)(p.ws + WS_CNT) + 256;
    for (int u = bid; u < 64; u += nb) mlstm_scan(p, smem, u >> 2, u & 3);
    volatile int* slot = (volatile int*)(smem + NSA_MISC + 256);
    for (;;) {
        if (opaque_tid() == 0) *slot = atomicAdd(qctr, 1);
        __syncthreads();
        const int k = *slot;
        if (k >= 1024) break;
        nsa_task(p, smem, (k & 31) >> 1, k & 1, 31 - (k >> 5));
    }
}

constexpr int XA_PITCH = 544;
constexpr int XA_K = 0, XA_V = 69632;
__device__ void xattn_task(const Params& p, char* smem, int b, int h, int qb) {
    const char* ws = p.ws;
    int tid = threadIdx.x;
    asm volatile("" : "+v"(tid));
    const int lane = tid & 63, wid = __builtin_amdgcn_readfirstlane(tid >> 6), fr = lane & 15, fq = lane >> 4;
    const bf16_t* XQ = (const bf16_t*)(ws + WS_XQ) + (long)(b * SEQ + qb * 128 + wid * 16 + fr) * 1024 + h * 256 + fq * 8;
    const bf16_t* KV = (const bf16_t*)(ws + WS_KVX) + (long)b * 256 * 2048 + h * 256;
    bf16x8 qf[8];
#pragma unroll
    for (int ks = 0; ks < 8; ++ks) qf[ks] = *(const bf16x8*)(XQ + ks * 32);
    f32x4 O[16];
#pragma unroll
    for (int dt = 0; dt < 16; ++dt) O[dt] = (f32x4){0.f, 0.f, 0.f, 0.f};
    float m = -1e30f, l = 0.f;
    const int lrow = tid >> 5, lch = tid & 31;
    u32x4 rk[4], rv[4];
#pragma unroll
    for (int i2 = 0; i2 < 4; ++i2) {
        const bf16_t* rp = KV + (long)(lrow + 16 * i2) * 2048 + lch * 8;
        rk[i2] = *(const u32x4*)rp; rv[i2] = *(const u32x4*)(rp + 1024);
    }
#pragma unroll
    for (int i2 = 0; i2 < 4; ++i2) {
        *(u32x4*)(smem + XA_K + (lrow + 16 * i2) * XA_PITCH + lch * 16) = rk[i2];
        *(u32x4*)(smem + XA_V + (lrow + 16 * i2) * XA_PITCH + lch * 16) = rv[i2];
    }
    __syncthreads();
#pragma unroll 1
    for (int j = 0; j < 4; ++j) {
        const int buf = j & 1;
        if (j + 1 < 4) {
#pragma unroll
            for (int i2 = 0; i2 < 4; ++i2) {
                const bf16_t* rp = KV + (long)((j + 1) * 64 + lrow + 16 * i2) * 2048 + lch * 8;
                rk[i2] = *(const u32x4*)rp; rv[i2] = *(const u32x4*)(rp + 1024);
            }
        }
        const char* KT = smem + XA_K + buf * 34816;
        const char* VT = smem + XA_V + buf * 34816;
        f32x4 S[4];
#pragma unroll
        for (int nt = 0; nt < 4; ++nt) {
            f32x4 s = (f32x4){0.f, 0.f, 0.f, 0.f};
#pragma unroll
            for (int ks = 0; ks < 8; ++ks) {
                const bf16x8 kf = *(const bf16x8*)(KT + (16 * nt + fr) * XA_PITCH + (ks * 4 + fq) * 16);
                s = mfma16(kf, qf[ks], s);
            }
            S[nt] = s * 0.0625f;
        }
        float mx = -INFINITY;
#pragma unroll
        for (int nt = 0; nt < 4; ++nt)
#pragma unroll
            for (int e = 0; e < 4; ++e) mx = fmaxf(mx, S[nt][e]);
        mx = fmaxf(mx, __shfl_xor(mx, 16)); mx = fmaxf(mx, __shfl_xor(mx, 32));
        const float mnew = fmaxf(m, mx);
        const float alpha = __expf(m - mnew);
        float rs = 0.f;
#pragma unroll
        for (int nt = 0; nt < 4; ++nt)
#pragma unroll
            for (int e = 0; e < 4; ++e) { const float pv = __expf(S[nt][e] - mnew); S[nt][e] = pv; rs += pv; }
        rs += __shfl_xor(rs, 16); rs += __shfl_xor(rs, 32);
        l = l * alpha + rs; m = mnew;
#pragma unroll
        for (int dt = 0; dt < 16; ++dt) O[dt] = O[dt] * alpha;
        const bf16x8 pf0 = pack_p(S[0], S[1]), pf1 = pack_p(S[2], S[3]);
#pragma unroll
        for (int dt = 0; dt < 16; ++dt) {
            O[dt] = mfma16(tr_frag_perm(VT, XA_PITCH, 0, 16 * dt, fr, fq), pf0, O[dt]);
            O[dt] = mfma16(tr_frag_perm(VT, XA_PITCH, 32, 16 * dt, fr, fq), pf1, O[dt]);
        }
        if (j + 1 < 4) {
            char* KTn = smem + XA_K + (buf ^ 1) * 34816; char* VTn = smem + XA_V + (buf ^ 1) * 34816;
#pragma unroll
            for (int i2 = 0; i2 < 4; ++i2) {
                *(u32x4*)(KTn + (lrow + 16 * i2) * XA_PITCH + lch * 16) = rk[i2];
                *(u32x4*)(VTn + (lrow + 16 * i2) * XA_PITCH + lch * 16) = rv[i2];
            }
        }
        __syncthreads();
    }
    const float inv = 1.0f / l;
    bf16_t* op = (bf16_t*)(p.ws + WS_XO) + (long)(b * SEQ + qb * 128 + wid * 16 + fr) * 1024 + h * 256 + fq * 4;
#pragma unroll
    for (int dt = 0; dt < 16; ++dt) {
        u32x2 w; w.x = pk_bf16(O[dt][0] * inv, O[dt][1] * inv); w.y = pk_bf16(O[dt][2] * inv, O[dt][3] * inv);
        *(u32x2*)(op + dt * 16) = w;
    }
}

__device__ void phase6(const Params& p, char* smem, int bid, int nb) {
    for (int t = bid; t < 1024; t += nb) xattn_task(p, smem, t >> 6, (t >> 4) & 3, t & 15);
}

constexpr int LN_ST = 139264, LN_GB = 141312, MOE_TAB = 149504;

__device__ void phase4(const Params& p, char* smem, int bid, int nb) {
    char* ws = p.ws;
    for (int t = bid; t < 512; t += nb) {
        const int mt = t >> 2, nt = t & 3;
        LoadBf16Rows al, bl;
        al.init_contig((const bf16_t*)(ws + WS_MIX), 1024, mt * 256);
        bl.init_contig((const bf16_t*)(ws + WS_WOUT), 1024, nt * 256);
        f32x4 acc[8][4];
        gemm_mainloop(smem, al, bl, 16, acc);
        epi_residual<false>(acc, smem, p.in[I_X], nullptr, nullptr, nullptr, (float*)(ws + WS_R1), (bf16_t*)(ws + WS_R1B), (float*)(ws + WS_ST1), mt * 256, nt);
    }
}

__device__ __forceinline__ void init_ln_loader(LoadLN& al, char* smem, const bf16_t* r, bf16_t* xcopy, int row0) {
    al.raw.init_contig(r, 1024, row0);
    al.xbase = xcopy ? xcopy + (long)row0 * 1024 : nullptr;
    al.st = (const float*)(smem + LN_ST); al.gb = (const float*)(smem + LN_GB);
}

__device__ void phase5(const Params& p, char* smem, int bid, int nb) {
    char* ws = p.ws;
    ln_load_gb((float*)(smem + LN_GB), p.in[I_LN1G], p.in[I_LN1B]);
    for (int t = bid; t < 512; t += nb) {
        const int mt = t >> 2, nt = t & 3;
        ln_tile_stats((float*)(smem + LN_ST), (const float*)(ws + WS_ST1), mt * 256);
        __syncthreads();
        LoadLN al; LoadBf16Rows bl;
        init_ln_loader(al, smem, (const bf16_t*)(ws + WS_R1B), nullptr, mt * 256);
        bl.init_contig((const bf16_t*)(ws + WS_WQ), 1024, nt * 256);
        f32x4 acc[8][4];
        gemm_mainloop(smem, al, bl, 16, acc);
        epi_store_bf16(acc, (bf16_t*)(ws + WS_XQ), 1024, mt * 256, nt * 256);
    }
}

__device__ void phase7(const Params& p, char* smem, int bid, int nb) {
    char* ws = p.ws;
    for (int t = bid; t < 512; t += nb) {
        const int mt = t >> 2, nt = t & 3;
        LoadBf16Rows al, bl;
        al.init_contig((const bf16_t*)(ws + WS_XO), 1024, mt * 256);
        bl.init_contig((const bf16_t*)(ws + WS_WO), 1024, nt * 256);
        f32x4 acc[8][4];
        gemm_mainloop(smem, al, bl, 16, acc);
        epi_residual<true>(acc, smem, (const float*)(ws + WS_R1), (const float*)(ws + WS_ST1), p.in[I_LN1G], p.in[I_LN1B],
                           (float*)(ws + WS_R2), (bf16_t*)(ws + WS_R2B), (float*)(ws + WS_ST2), mt * 256, nt);
    }
}

template <class RowMap>
__device__ __forceinline__ void epi_swiglu(const f32x4 (&acc)[8][4], bf16_t* out, int ld, int nt, const RowMap& rm) {
    const int tid_ = opaque_tid();
    const int lane = tid_ & 63, wid = tid_ >> 6;
    const int wr = wid >> 2, wc = wid & 3, fr = lane & 15, fq = lane >> 4;
#pragma unroll
    for (int mi = 0; mi < 8; ++mi) {
        const long orow = rm(wr * 128 + mi * 16 + fr);
        if (orow >= 0) {
            bf16_t* rp = out + orow * ld + nt * 128 + wc * 32 + fq * 4;
#pragma unroll
            for (int q = 0; q < 2; ++q) {
                const f32x4 a = acc[mi][2 * q], b = acc[mi][2 * q + 1];
                u32x2 w; w.x = pk_bf16(siluf_(a[0]) * b[0], siluf_(a[1]) * b[1]); w.y = pk_bf16(siluf_(a[2]) * b[2], siluf_(a[3]) * b[3]);
                *(u32x2*)(rp + q * 16) = w;
            }
        }
    }
}
struct RowIdent { long row0; __device__ __forceinline__ long operator()(int rl) const { return row0 + rl; } };

__device__ void route_half(const Params& p, char* smem, int tok0) {
    char* ws = p.ws;
    float* sc = (float*)smem;
    int* se = (int*)(sc + 128 * 257);
    float* sw = sc + 128 * 257 + 1024;
    const float* bias = p.in[I_ROUTB];
    const int tid = opaque_tid(), tk = tid >> 2, q = tid & 3;
    float* row = sc + tk * 257;
    float gs0, gs1;
    {
        float a1 = -INFINITY, a2 = -INFINITY, b1 = -INFINITY, b2 = -INFINITY;
#pragma unroll 4
        for (int i = 0; i < 32; ++i) {
            const int ii = (i + 8 * q) & 31;
            const float v = row[64 * q + ii], w = row[64 * q + 32 + ii];
            if (v > a1) { a2 = a1; a1 = v; } else if (v > a2) a2 = v;
            if (w > b1) { b2 = b1; b1 = w; } else if (w > b2) b2 = w;
        }
        gs0 = a1 + a2; gs1 = b1 + b2;
    }
    const int lbase = (tid & 63) & ~3;
    float g8[8];
#pragma unroll
    for (int k = 0; k < 4; ++k) { g8[2 * k] = __shfl(gs0, lbase + k); g8[2 * k + 1] = __shfl(gs1, lbase + k); }
    unsigned gsel = 0u;
#pragma unroll
    for (int a = 0; a < 8; ++a) {
        int rank = 0;
#pragma unroll
        for (int b = 0; b < 8; ++b) rank += (g8[b] > g8[a] || (g8[b] == g8[a] && b < a)) ? 1 : 0;
        if (rank < 4) gsel |= 1u << a;
    }
    const bool on0 = ((gsel >> (2 * q)) & 1u) != 0u, on1 = ((gsel >> (2 * q + 1)) & 1u) != 0u;
    float wsum = 0.f;
#pragma unroll 1
    for (int r = 0; r < 8; ++r) {
        float bv = -INFINITY; int bi = 1 << 30;
        if (on0) {
#pragma unroll 4
            for (int i = 0; i < 32; ++i) { const int idx = 64 * q + ((i + 8 * q) & 31); const float v = row[idx]; if (v > bv || (v == bv && idx < bi)) { bv = v; bi = idx; } }
        }
        if (on1) {
#pragma unroll 4
            for (int i = 0; i < 32; ++i) { const int idx = 64 * q + 32 + ((i + 8 * q) & 31); const float v = row[idx]; if (v > bv || (v == bv && idx < bi)) { bv = v; bi = idx; } }
        }
#pragma unroll
        for (int off = 1; off <= 2; off <<= 1) {
            const float ov = __shfl_xor(bv, off); const int oi = __shfl_xor(bi, off);
            if (ov > bv || (ov == bv && oi < bi)) { bv = ov; bi = oi; }
        }
        bi &= 255;
        const float s = bv - bias[bi];
        wsum += s;
        if ((bi >> 6) == q) row[bi] = -INFINITY;
        if (q == 0) { se[tk * 8 + r] = bi; sw[tk * 8 + r] = s; }
    }
    __syncthreads();
    {
        int* cnt = (int*)(ws + WS_CNT);
        const long t = tok0 + tk;
#pragma unroll
        for (int u = 0; u < 2; ++u) {
            const int k = 2 * q + u;
            const int e = se[tk * 8 + k];
            const float w = sw[tk * 8 + k] / wsum * 2.5f;
            const int pos = atomicAdd(cnt + e, 1);
            ((int*)(ws + WS_SELE))[t * 8 + k] = e;
            ((int*)(ws + WS_SELP))[t * 8 + k] = pos;
            ((float*)(ws + WS_SELW))[t * 8 + k] = w;
            ((int*)(ws + WS_TOKL))[(long)e * LIST_CAP + pos] = (int)t;
            ((float*)(ws + WS_WL))[(long)e * LIST_CAP + pos] = w;
        }
    }
    __syncthreads();
}

__device__ void phase8(const Params& p, char* smem, int bid, int nb) {
    char* ws = p.ws;
    ln_load_gb((float*)(smem + LN_GB), p.in[I_LN2G], p.in[I_LN2B]);
    for (int mt = bid; mt < 128; mt += nb) {
        ln_tile_stats((float*)(smem + LN_ST), (const float*)(ws + WS_ST2), mt * 256);
        __syncthreads();
        float* gsc = (float*)(ws + WS_RSC);
        {
            LoadLN al; LoadBf16Rows bl;
            init_ln_loader(al, smem, (const bf16_t*)(ws + WS_R2B), (bf16_t*)(ws + WS_X2), mt * 256);
            bl.init_contig((const bf16_t*)(ws + WS_WR), 1024, 0);
            f32x4 acc[8][4];
            gemm_mainloop(smem, al, bl, 16, acc);
            const int tid_ = opaque_tid();
            const int lane = tid_ & 63, wid = tid_ >> 6;
            const int wr = wid >> 2, wc = wid & 3, fr = lane & 15, fq = lane >> 4;
            const float* bias = p.in[I_ROUTB];
#pragma unroll
            for (int ni = 0; ni < 4; ++ni) {
                const int col = wc * 64 + ni * 16 + fq * 4;
                const f32x4 bv = *(const f32x4*)(bias + col);
#pragma unroll
                for (int mi = 0; mi < 8; ++mi) {
                    f32x4 v;
#pragma unroll
                    for (int e = 0; e < 4; ++e) v[e] = sigmoidf_(acc[mi][ni][e]) + bv[e];
                    *(f32x4*)(gsc + (long)(mt * 256 + wr * 128 + mi * 16 + fr) * 256 + col) = v;
                }
            }
        }
        __syncthreads();
#pragma unroll 1
        for (int half = 0; half < 2; ++half) {
            float* sc = (float*)smem;
            for (int e4 = opaque_tid(); e4 < 128 * 64; e4 += NTHR) {
                const int r = e4 >> 6, c4 = (e4 & 63) * 4;
                const f32x4 v = *(const f32x4*)(gsc + (long)(mt * 256 + half * 128 + r) * 256 + c4);
                sc[r * 257 + c4] = v[0]; sc[r * 257 + c4 + 1] = v[1]; sc[r * 257 + c4 + 2] = v[2]; sc[r * 257 + c4 + 3] = v[3];
            }
            __syncthreads();
            route_half(p, smem, mt * 256 + half * 128);
        }
    }
    for (int t = (bid + nb - 128 % nb) % nb; t < 256; t += nb) {
        const int mt = t >> 1, nt = t & 1;
        ln_tile_stats((float*)(smem + LN_ST), (const float*)(ws + WS_ST2), mt * 256);
        __syncthreads();
        LoadLN al; LoadBf16Rows bl;
        init_ln_loader(al, smem, (const bf16_t*)(ws + WS_R2B), nullptr, mt * 256);
        bl.init_contig((const bf16_t*)(ws + WS_WS13), 1024, nt * 256);
        f32x4 acc[8][4];
        gemm_mainloop(smem, al, bl, 16, acc);
        RowIdent rm; rm.row0 = (long)mt * 256;
        epi_swiglu(acc, (bf16_t*)(ws + WS_HS), 256, nt, rm);
    }
}

__device__ __forceinline__ void moe_tables(const Params& p, char* smem) {
    int* off = (int*)(smem + MOE_TAB); int* tst = off + 256;
    const int* cnt = (const int*)(p.ws + WS_CNT);
    const int tid = opaque_tid();
    if (tid < 64) {
        int c[4], tl[4], cs = 0, ts = 0;
#pragma unroll
        for (int k = 0; k < 4; ++k) { c[k] = cnt[tid * 4 + k]; tl[k] = (c[k] + 255) >> 8; cs += c[k]; ts += tl[k]; }
        int ics = cs, its = ts;
#pragma unroll
        for (int o = 1; o < 64; o <<= 1) { const int a = __shfl_up(ics, o), b = __shfl_up(its, o); if (tid >= o) { ics += a; its += b; } }
        int eo = ics - cs, et = its - ts;
#pragma unroll
        for (int k = 0; k < 4; ++k) { off[tid * 4 + k] = eo; tst[tid * 4 + k] = et; eo += c[k]; et += tl[k]; }
        if (tid == 63) tst[256] = its;
    }
    __syncthreads();
}
__device__ __forceinline__ int moe_find(const int* tst, int t) {
    int lo = 0, hi = 255;
#pragma unroll 1
    while (lo < hi) { const int mid = (lo + hi + 1) >> 1; if (tst[mid] <= t) lo = mid; else hi = mid - 1; }
    return lo;
}
struct RowMoe { long base; int nvalid; __device__ __forceinline__ long operator()(int rl) const { return rl < nvalid ? base + rl : -1; } };

__device__ void phase9(const Params& p, char* smem, int bid, int nb) {
    char* ws = p.ws;
    moe_tables(p, smem);
    const int* off = (const int*)(smem + MOE_TAB); const int* tst = off + 256;
    const int* cnt = (const int*)(ws + WS_CNT);
    const int ntile = tst[256];
    for (int t = bid; t < ntile * 2; t += nb) {
        const int et = t >> 1, nt = t & 1;
        const int e = moe_find(tst, et), m0 = (et - tst[e]) * 256, ne = cnt[e];
        const int tid = opaque_tid();
        LoadBf16Rows al; LoadF32KN bl;
        {
            const int* tl = (const int*)(ws + WS_TOKL) + (long)e * LIST_CAP;
            int rows[4];
#pragma unroll
            for (int i = 0; i < 4; ++i) { const int r = m0 + (tid >> 3) + 64 * i; rows[i] = r < ne ? tl[r] : 0; }
            al.init_rows((const bf16_t*)(ws + WS_X2), 1024, rows);
        }
        {
            const int n = tid & 255, kh = tid >> 8;
            const int col = 128 * nt + 16 * (n >> 5) + (n & 15);
            const float* w = ((n >> 4) & 1) ? p.in[I_MW3] : p.in[I_MW1];
            bl.p = w + (long)e * 1024 * 256 + col + (long)(kh * 32) * 256; bl.ldn = 256; bl.n = n; bl.kh = kh;
        }
        f32x4 acc[8][4];
        gemm_mainloop(smem, al, bl, 16, acc);
        RowMoe rm; rm.base = (long)off[e] + m0; rm.nvalid = ne - m0;
        epi_swiglu(acc, (bf16_t*)(ws + WS_H), 256, nt, rm);
    }
    for (int t = (bid + nb - (ntile * 2) % nb) % nb; t < 512; t += nb) {
        const int mt = t >> 2, nt = t & 3;
        LoadBf16Rows al, bl;
        al.init_contig((const bf16_t*)(ws + WS_HS), 256, mt * 256);
        bl.init_contig((const bf16_t*)(ws + WS_WS2), 256, nt * 256);
        f32x4 acc[8][4];
        gemm_mainloop(smem, al, bl, 4, acc);
        epi_store_bf16(acc, (bf16_t*)(ws + WS_SH), 1024, mt * 256, nt * 256);
    }
}

__device__ void phase10(const Params& p, char* smem, int bid, int nb) {
    char* ws = p.ws;
    moe_tables(p, smem);
    const int* off = (const int*)(smem + MOE_TAB); const int* tst = off + 256;
    const int* cnt = (const int*)(ws + WS_CNT);
    const int ntile = tst[256];
    for (int t = bid; t < ntile * 4; t += nb) {
        const int et = t >> 2, nt = t & 3;
        const int e = moe_find(tst, et), m0 = (et - tst[e]) * 256, ne = cnt[e];
        const int tid = opaque_tid();
        LoadBf16Rows al; LoadF32KN bl;
        al.init_contig((const bf16_t*)(ws + WS_H), 256, off[e] + m0);
        {
            const int n = tid & 255, kh = tid >> 8;
            bl.p = p.in[I_MW2] + (long)e * 256 * 1024 + nt * 256 + n + (long)(kh * 32) * 1024; bl.ldn = 1024; bl.n = n; bl.kh = kh;
        }
        f32x4 acc[8][4];
        gemm_mainloop(smem, al, bl, 4, acc);
        {
            const int tid2 = opaque_tid();
            const int lane = tid2 & 63, wid = tid2 >> 6;
            const int wr = wid >> 2, wc = wid & 3, fr = lane & 15, fq = lane >> 4;
            const float* wl = (const float*)(ws + WS_WL) + (long)e * LIST_CAP + m0;
            bf16_t* Y = (bf16_t*)(ws + WS_Y) + ((long)off[e] + m0) * 1024 + nt * 256 + wc * 64 + fq * 4;
#pragma unroll
            for (int mi = 0; mi < 8; ++mi) {
                const int rl = wr * 128 + mi * 16 + fr;
                if (m0 + rl < ne) {
                    const float w = wl[rl];
#pragma unroll
                    for (int ni = 0; ni < 4; ++ni) {
                        u32x2 v; v.x = pk_bf16(acc[mi][ni][0] * w, acc[mi][ni][1] * w); v.y = pk_bf16(acc[mi][ni][2] * w, acc[mi][ni][3] * w);
                        *(u32x2*)(Y + (long)rl * 1024 + ni * 16) = v;
                    }
                }
            }
        }
    }
}

__device__ void phase11(const Params& p, char* smem, int bid, int nb) {
    char* ws = p.ws;
    moe_tables(p, smem);
    const int* off = (const int*)(smem + MOE_TAB);
    const int tid = opaque_tid(), lane = tid & 63, wid = tid >> 6;
    const float* r2 = (const float*)(ws + WS_R2);
    const float* st2 = (const float*)(ws + WS_ST2);
    const bf16_t* SH = (const bf16_t*)(ws + WS_SH);
    const bf16_t* Y = (const bf16_t*)(ws + WS_Y);
    const int* sele = (const int*)(ws + WS_SELE); const int* selp = (const int*)(ws + WS_SELP);
    for (int t = bid * 8 + wid; t < T_TOK; t += nb * 8) {
        const f32x4 p0 = *(const f32x4*)(st2 + (long)t * 8), p1 = *(const f32x4*)(st2 + (long)t * 8 + 4);
        const float q1 = (p0[0] + p0[2]) + (p1[0] + p1[2]), q2 = (p0[1] + p0[3]) + (p1[1] + p1[3]);
        const float mean2 = q1 * (1.0f / 1024.0f);
        const float rstd2 = rsqrtf(fmaxf(q2 * (1.0f / 1024.0f) - mean2 * mean2, 0.f) + LN_EPS);
        int yrow[8];
#pragma unroll
        for (int k = 0; k < 8; ++k) yrow[k] = off[sele[(long)t * 8 + k]] + selp[(long)t * 8 + k];
        float v[16];
#pragma unroll
        for (int hseg = 0; hseg < 2; ++hseg) {
            const int col = hseg * 512 + lane * 8;
            const f32x4 a0 = *(const f32x4*)(r2 + (long)t * 1024 + col), a1 = *(const f32x4*)(r2 + (long)t * 1024 + col + 4);
            const f32x4 g0 = *(const f32x4*)(p.in[I_LN2G] + col), g1 = *(const f32x4*)(p.in[I_LN2G] + col + 4);
            const f32x4 b0 = *(const f32x4*)(p.in[I_LN2B] + col), b1 = *(const f32x4*)(p.in[I_LN2B] + col + 4);
            const f32x4 x0 = ((a0 - mean2) * rstd2 * g0 + b0) * ALPHA, x1 = ((a1 - mean2) * rstd2 * g1 + b1) * ALPHA;
            float* vv = v + hseg * 8;
            vv[0] = x0[0]; vv[1] = x0[1]; vv[2] = x0[2]; vv[3] = x0[3]; vv[4] = x1[0]; vv[5] = x1[1]; vv[6] = x1[2]; vv[7] = x1[3];
            const u32x4 s = *(const u32x4*)(SH + (long)t * 1024 + col);
            vv[0] += bf_lo(s.x); vv[1] += bf_hi(s.x); vv[2] += bf_lo(s.y); vv[3] += bf_hi(s.y); vv[4] += bf_lo(s.z); vv[5] += bf_hi(s.z); vv[6] += bf_lo(s.w); vv[7] += bf_hi(s.w);
#pragma unroll
            for (int k = 0; k < 8; ++k) {
                const u32x4 y = *(const u32x4*)(Y + (long)yrow[k] * 1024 + col);
                vv[0] += bf_lo(y.x); vv[1] += bf_hi(y.x); vv[2] += bf_lo(y.y); vv[3] += bf_hi(y.y); vv[4] += bf_lo(y.z); vv[5] += bf_hi(y.z); vv[6] += bf_lo(y.w); vv[7] += bf_hi(y.w);
            }
        }
        float s1 = 0.f;
#pragma unroll
        for (int i = 0; i < 16; ++i) s1 += v[i];
#pragma unroll
        for (int o = 32; o >= 1; o >>= 1) s1 += __shfl_xor(s1, o);
        const float mean = s1 * (1.0f / 1024.0f);
        float s2 = 0.f;
#pragma unroll
        for (int i = 0; i < 16; ++i) { const float d = v[i] - mean; s2 += d * d; }
#pragma unroll
        for (int o = 32; o >= 1; o >>= 1) s2 += __shfl_xor(s2, o);
        const float rstd = rsqrtf(s2 * (1.0f / 1024.0f) + LN_EPS);
#pragma unroll
        for (int hseg = 0; hseg < 2; ++hseg) {
            const int col = hseg * 512 + lane * 8;
            const f32x4 g0 = *(const f32x4*)(p.in[I_LN3G] + col), g1 = *(const f32x4*)(p.in[I_LN3G] + col + 4);
            const f32x4 b0 = *(const f32x4*)(p.in[I_LN3B] + col), b1 = *(const f32x4*)(p.in[I_LN3B] + col + 4);
            const float* vv = v + hseg * 8;
            f32x4 o0, o1;
#pragma unroll
            for (int e = 0; e < 4; ++e) { o0[e] = (vv[e] - mean) * rstd * g0[e] + b0[e]; o1[e] = (vv[4 + e] - mean) * rstd * g1[e] + b1[e]; }
            *(f32x4*)(p.out + (long)t * 1024 + col) = o0; *(f32x4*)(p.out + (long)t * 1024 + col + 4) = o1;
        }
    }
}

#if MEGA
__global__ void __launch_bounds__(NTHR) fwd_mega(Params p) {
    extern __shared__ __attribute__((aligned(16))) char smem[];
    cg::grid_group grid = cg::this_grid();
    const int bid = blockIdx.x, nb = gridDim.x;
    phase0(p, smem, bid, nb);  grid.sync();
    phase1(p, smem, bid, nb);  grid.sync();
    phase2(p, smem, bid, nb);  grid.sync();
    phase3(p, smem, bid, nb);  grid.sync();
    phase4(p, smem, bid, nb);  grid.sync();
    phase5(p, smem, bid, nb);  grid.sync();
    phase6(p, smem, bid, nb);  grid.sync();
    phase7(p, smem, bid, nb);  grid.sync();
    phase8(p, smem, bid, nb);  grid.sync();
    phase9(p, smem, bid, nb);  grid.sync();
    phase10(p, smem, bid, nb); grid.sync();
    phase11(p, smem, bid, nb);
}
#else
#define PHASE_KERNEL(n) __global__ void __launch_bounds__(NTHR) fwd_phase##n(Params p) { extern __shared__ __attribute__((aligned(16))) char smem[]; phase##n(p, smem, blockIdx.x, gridDim.x); }
PHASE_KERNEL(0) PHASE_KERNEL(1) PHASE_KERNEL(2) PHASE_KERNEL(3) PHASE_KERNEL(4) PHASE_KERNEL(5)
PHASE_KERNEL(6) PHASE_KERNEL(7) PHASE_KERNEL(8) PHASE_KERNEL(9) PHASE_KERNEL(10) PHASE_KERNEL(11)
typedef void (*phase_fn)(Params);
#endif

extern "C" void kernel_launch(void* const* d_in, const int* in_sizes, int n_in, void* d_out, int out_size, void* d_ws, size_t ws_size, hipStream_t stream) {
    Params p{};
    for (int i = 0; i < 32; ++i) p.in[i] = (const float*)d_in[i];
    p.out = (float*)d_out;
    p.ws = (char*)d_ws;
    if (n_in != 32 || ws_size < WS_END) { fprintf(stderr, "kernel_launch: unexpected inputs (n_in %d) or workspace too small (%zu < %zu)\n", n_in, ws_size, (size_t)WS_END); return; }
#if MEGA
    static int grid = 0;
    if (!grid) {
        int dev = 0, cus = 0, per_cu = 0;
        (void)hipGetDevice(&dev);
        (void)hipDeviceGetAttribute(&cus, hipDeviceAttributeMultiprocessorCount, dev);
        (void)hipFuncSetAttribute((const void*)fwd_mega, hipFuncAttributeMaxDynamicSharedMemorySize, LDS_BYTES);
        (void)hipOccupancyMaxActiveBlocksPerMultiprocessor(&per_cu, (const void*)fwd_mega, NTHR, LDS_BYTES);
        if (per_cu < 1) { fprintf(stderr, "kernel_launch: occupancy query says %d blocks/CU\n", per_cu); per_cu = 1; }
        grid = cus;
    }
    void* args[] = {&p};
    hipError_t e = hipLaunchCooperativeKernel((const void*)fwd_mega, dim3(grid), dim3(NTHR), args, LDS_BYTES, stream);
    if (e != hipSuccess) fprintf(stderr, "cooperative launch failed: %s (grid %d)\n", hipGetErrorString(e), grid);
#else
    static const phase_fn fns[12] = {fwd_phase0, fwd_phase1, fwd_phase2, fwd_phase3, fwd_phase4, fwd_phase5, fwd_phase6, fwd_phase7, fwd_phase8, fwd_phase9, fwd_phase10, fwd_phase11};
    static bool attr = false;
    if (!attr) { for (int i = 0; i < 12; ++i) (void)hipFuncSetAttribute((const void*)fns[i], hipFuncAttributeMaxDynamicSharedMemorySize, LDS_BYTES); attr = true; }
    for (int i = 0; i < 12; ++i) hipLaunchKernelGGL(fns[i], dim3(256), dim3(NTHR), LDS_BYTES, stream, p);
#endif
}
```

```cpp
#include <hip/hip_runtime.h>
#include <hip/hip_cooperative_groups.h>
#include <stdint.h>
#include <stdio.h>
namespace cg = cooperative_groups;

#ifndef MEGA
#define MEGA 1
#endif

typedef unsigned short bf16_t;
typedef short bf16x8 __attribute__((ext_vector_type(8)));
typedef short s16x4 __attribute__((ext_vector_type(4)));
typedef float f32x4 __attribute__((ext_vector_type(4)));
typedef float f32x2 __attribute__((ext_vector_type(2)));
typedef unsigned u32x4 __attribute__((ext_vector_type(4)));
typedef unsigned u32x2 __attribute__((ext_vector_type(2)));
typedef __bf16 bf16x2_t __attribute__((ext_vector_type(2)));

constexpr int T_TOK = 32768, DM = 1024, NB = 16, SEQ = 2048;
constexpr int PW = 3328;
constexpr int PC_Q = 0, PC_KC = 512, PC_VC = 640, PC_KS = 768, PC_VS = 896, PC_KW = 1024, PC_VW = 1152;
constexpr int PC_MQ = 1280, PC_MK = 1792, PC_MV = 2304, PC_MO = 2816;
constexpr float ALPHA = 1.189207115002721f;
constexpr float LN_EPS = 1e-5f;
constexpr int NTHR = 512;
constexpr int LDS_BYTES = 160 * 1024;
constexpr int NEXP = 256, TOPK = 8;
constexpr int LIST_CAP = 32768;

constexpr size_t al256(size_t x) { return (x + 255) & ~(size_t)255; }
constexpr size_t WS_WIN = 0;
constexpr size_t WS_WOUT = WS_WIN + al256((size_t)3360 * 1024 * 2);
constexpr size_t WS_WQ = WS_WOUT + (size_t)1024 * 1024 * 2;
constexpr size_t WS_WKV = WS_WQ + (size_t)1024 * 1024 * 2;
constexpr size_t WS_WO = WS_WKV + (size_t)2048 * 1024 * 2;
constexpr size_t WS_WR = WS_WO + (size_t)1024 * 1024 * 2;
constexpr size_t WS_WS13 = WS_WR + (size_t)256 * 1024 * 2;
constexpr size_t WS_WS2 = WS_WS13 + (size_t)512 * 1024 * 2;
constexpr size_t WS_CK1 = WS_WS2 + (size_t)1024 * 256 * 2;
constexpr size_t WS_CK2 = WS_CK1 + (size_t)64 * 2048 * 2;
constexpr size_t WS_CV1 = WS_CK2 + (size_t)64 * 64 * 2;
constexpr size_t WS_CV2 = WS_CV1 + (size_t)64 * 2048 * 2;
constexpr size_t MB = 1024 * 1024;
constexpr size_t WS_A = al256(WS_CV2 + (size_t)64 * 64 * 2 + 65536);
constexpr size_t WS_P = WS_A;
constexpr size_t WS_R1 = WS_A;
constexpr size_t WS_XQ = WS_A + 128 * MB;
constexpr size_t WS_XO = WS_A + 192 * MB;
constexpr size_t WS_XB = WS_A + 208 * MB;
constexpr size_t WS_MEMB = WS_A + 272 * MB;
constexpr size_t WS_PSM = WS_A + 280 * MB;
constexpr size_t WS_KCMP = WS_A + 284 * MB;
constexpr size_t WS_VCMP = WS_KCMP + (size_t)16 * 2 * 128 * 64 * 2;
constexpr size_t WS_QK = WS_A + 285 * MB;
constexpr size_t WS_MIX = WS_A + 349 * MB;
constexpr size_t WS_KVX = WS_A + 413 * MB;
constexpr size_t WS_X2 = WS_A + 256 * MB;
constexpr size_t WS_HS = WS_A + 320 * MB;
constexpr size_t WS_R1B = WS_A + 208 * MB;
constexpr size_t WS_R2B = WS_A + 128 * MB;
constexpr size_t WS_RSC = WS_A;
constexpr size_t WS_Y = WS_A;
constexpr size_t WS_B = WS_A + al256((size_t)(T_TOK * 8 + 256) * 1024 * 2);
constexpr size_t WS_R2 = WS_B;
constexpr size_t WS_ST1 = WS_R2 + (size_t)T_TOK * 1024 * 4;
constexpr size_t WS_ST2 = WS_ST1 + (size_t)T_TOK * 8 * 4;
constexpr size_t WS_SH = WS_ST2 + (size_t)T_TOK * 8 * 4;
constexpr size_t WS_SELE = WS_SH + (size_t)T_TOK * 1024 * 2;
constexpr size_t WS_SELP = WS_SELE + (size_t)T_TOK * 8 * 4;
constexpr size_t WS_SELW = WS_SELP + (size_t)T_TOK * 8 * 4;
constexpr size_t WS_CNT = WS_SELW + (size_t)T_TOK * 8 * 4;
constexpr size_t WS_TOKL = WS_CNT + 4096;
constexpr size_t WS_WL = WS_TOKL + (size_t)NEXP * LIST_CAP * 4;
constexpr size_t WS_H = WS_WL + (size_t)NEXP * LIST_CAP * 4;
constexpr size_t WS_BAR = WS_H + (size_t)(T_TOK * 8 + 256) * 256 * 2;
constexpr size_t WS_END = WS_BAR + 16384;
static_assert((size_t)T_TOK * PW * 2 <= 208 * MB, "P region");
static_assert(WS_END <= (size_t)1024 * MB, "workspace must fit 1 GiB");

struct Params {
    const float* in[32];
    float* out;
    char* ws;
};

__device__ __forceinline__ unsigned pk_bf16(float lo, float hi) {
    f32x2 v = {lo, hi};
    bf16x2_t r = __builtin_convertvector(v, bf16x2_t);
    return __builtin_bit_cast(unsigned, r);
}
__device__ __forceinline__ float bf_lo(unsigned u) { return __uint_as_float(u << 16); }
__device__ __forceinline__ float bf_hi(unsigned u) { return __uint_as_float(u & 0xffff0000u); }
__device__ __forceinline__ float bf2f(bf16_t h) { return __uint_as_float(((unsigned)h) << 16); }
__device__ __forceinline__ float sigmoidf_(float x) { return 1.0f / (1.0f + __expf(-x)); }
__device__ __forceinline__ float siluf_(float x) { return x / (1.0f + __expf(-x)); }
__device__ __forceinline__ f32x4 mfma16(bf16x8 a, bf16x8 b, f32x4 c) { return __builtin_amdgcn_mfma_f32_16x16x32_bf16(a, b, c, 0, 0, 0); }
__device__ __forceinline__ bf16x8 as_bf16x8(u32x4 v) { return __builtin_bit_cast(bf16x8, v); }

__device__ __forceinline__ int opaque_tid() { int t = threadIdx.x; asm volatile("" : "+v"(t)); return t; }

__device__ __forceinline__ int tile_off(int row, int chunk) { return row * 128 + ((chunk ^ (row & 7)) << 4); }

typedef __attribute__((address_space(3))) unsigned lds_u32;
typedef __attribute__((address_space(1))) const unsigned glb_u32;

struct LoadBf16Rows {
    const bf16_t* base;
    unsigned off[4];
    int ldst;
    struct Regs { int dummy; };
    __device__ __forceinline__ void init_contig(const bf16_t* b, int ld, int row0) {
        const int tid_ = opaque_tid();
        const int r8 = tid_ >> 3, kc = (tid_ & 7) ^ (r8 & 7);
        ldst = tid_ * 16;
        base = b + (long)row0 * ld;
#pragma unroll
        for (int i = 0; i < 4; ++i) off[i] = (unsigned)((r8 + 64 * i) * ld + kc * 8);
    }
    __device__ __forceinline__ void init_rows(const bf16_t* b, int ld, const int (&rows)[4]) {
        const int tid_ = opaque_tid();
        const int r8 = tid_ >> 3, kc = (tid_ & 7) ^ (r8 & 7);
        ldst = tid_ * 16;
        base = b;
#pragma unroll
        for (int i = 0; i < 4; ++i) off[i] = (unsigned)rows[i] * (unsigned)ld + (unsigned)(kc * 8);
    }
    __device__ __forceinline__ void issue(Regs&, char* s, int kt) const {
#pragma unroll
        for (int i = 0; i < 4; ++i)
            __builtin_amdgcn_global_load_lds((glb_u32*)(base + (size_t)(off[i] + (unsigned)(kt * 64))), (lds_u32*)(s + i * 8192 + ldst), 16, 0, 0);
    }
    __device__ __forceinline__ void commit(const Regs&, char*, int) const {}
};

struct LoadF32KN {
    const float* p;
    int ldn;
    int n, kh;
    struct Regs { float v[32]; };
    __device__ __forceinline__ void issue(Regs& r, char*, int kt) const {
        const float* q = p + (long)kt * 64 * ldn;
#pragma unroll
        for (int j = 0; j < 32; ++j) r.v[j] = q[(long)j * ldn];
    }
    __device__ __forceinline__ void commit(const Regs& r, char* s, int kt) const {
#pragma unroll
        for (int q = 0; q < 4; ++q) {
            u32x4 w;
            w.x = pk_bf16(r.v[8 * q + 0], r.v[8 * q + 1]); w.y = pk_bf16(r.v[8 * q + 2], r.v[8 * q + 3]);
            w.z = pk_bf16(r.v[8 * q + 4], r.v[8 * q + 5]); w.w = pk_bf16(r.v[8 * q + 6], r.v[8 * q + 7]);
            *(u32x4*)(s + tile_off(n, kh * 4 + q)) = w;
        }
    }
};

struct LoadLN {
    LoadBf16Rows raw;
    bf16_t* xbase;
    const float* st;
    const float* gb;
    typedef LoadBf16Rows::Regs Regs;
    __device__ __forceinline__ void issue(Regs& r, char* s, int kt) const { raw.issue(r, s, kt); }
    __device__ __forceinline__ void commit(const Regs&, char* s, int kt) const {
        asm volatile("s_waitcnt vmcnt(0)" ::: "memory");
        const int tid_ = opaque_tid();
        const int r8 = tid_ >> 3, kc = (tid_ & 7) ^ (r8 & 7);
        const f32x4 g0 = *(const f32x4*)(gb + kt * 64 + kc * 8), g1 = *(const f32x4*)(gb + kt * 64 + kc * 8 + 4);
        const f32x4 b0 = *(const f32x4*)(gb + 1024 + kt * 64 + kc * 8), b1 = *(const f32x4*)(gb + 1024 + kt * 64 + kc * 8 + 4);
#pragma unroll
        for (int i = 0; i < 4; ++i) {
            const int row = r8 + 64 * i;
            u32x4* cp = (u32x4*)(s + i * 8192 + tid_ * 16);
            const u32x4 v = *cp;
            const float mean = st[row * 2], rstd = st[row * 2 + 1];
            const f32x4 x0 = (f32x4){bf_lo(v.x), bf_hi(v.x), bf_lo(v.y), bf_hi(v.y)};
            const f32x4 x1 = (f32x4){bf_lo(v.z), bf_hi(v.z), bf_lo(v.w), bf_hi(v.w)};
            const f32x4 y0 = (x0 - mean) * rstd * g0 + b0, y1 = (x1 - mean) * rstd * g1 + b1;
            u32x4 w; w.x = pk_bf16(y0[0], y0[1]); w.y = pk_bf16(y0[2], y0[3]); w.z = pk_bf16(y1[0], y1[1]); w.w = pk_bf16(y1[2], y1[3]);
            *cp = w;
            if (xbase) *(u32x4*)(xbase + (size_t)(row * 1024 + kc * 8 + kt * 64)) = w;
        }
    }
};

constexpr int GEMM_LDS = 131072;
template <class AL, class BL>
__device__ __forceinline__ void gemm_mainloop(char* smem, const AL& al, const BL& bl, int nk, f32x4 (&acc)[8][4]) {
    const int tid_ = opaque_tid();
    const int lane = tid_ & 63, wid = tid_ >> 6;
    const int wr = wid >> 2, wc = wid & 3, fr = lane & 15, fq = lane >> 4;
#pragma unroll
    for (int mi = 0; mi < 8; ++mi)
#pragma unroll
        for (int ni = 0; ni < 4; ++ni) acc[mi][ni] = (f32x4){0.f, 0.f, 0.f, 0.f};
    typename AL::Regs ra; typename BL::Regs rb;
    al.issue(ra, smem, 0); bl.issue(rb, smem + 32768, 0);
    al.commit(ra, smem, 0); bl.commit(rb, smem + 32768, 0);
    __syncthreads();
    for (int kt = 0; kt < nk; ++kt) {
        char* sA = smem + (kt & 1) * 65536; char* sB = sA + 32768;
        char* nA = smem + ((kt + 1) & 1) * 65536; char* nB = nA + 32768;
        if (kt + 1 < nk) { al.issue(ra, nA, kt + 1); bl.issue(rb, nB, kt + 1); }
#pragma unroll
        for (int kk = 0; kk < 2; ++kk) {
            bf16x8 bfr[4];
#pragma unroll
            for (int ni = 0; ni < 4; ++ni) bfr[ni] = *(const bf16x8*)(sB + tile_off(wc * 64 + ni * 16 + fr, kk * 4 + fq));
#pragma unroll
            for (int mi = 0; mi < 8; ++mi) {
                const bf16x8 af = *(const bf16x8*)(sA + tile_off(wr * 128 + mi * 16 + fr, kk * 4 + fq));
#pragma unroll
                for (int ni = 0; ni < 4; ++ni) acc[mi][ni] = mfma16(bfr[ni], af, acc[mi][ni]);
            }
        }
        if (kt + 1 < nk) { al.commit(ra, nA, kt + 1); bl.commit(rb, nB, kt + 1); }
        __syncthreads();
    }
}

__device__ __forceinline__ void epi_store_bf16(const f32x4 (&acc)[8][4], bf16_t* out, long ld, int row0, int col0) {
    const int tid_ = opaque_tid();
    const int lane = tid_ & 63, wid = tid_ >> 6;
    const int wr = wid >> 2, wc = wid & 3, fr = lane & 15, fq = lane >> 4;
#pragma unroll
    for (int mi = 0; mi < 8; ++mi) {
        bf16_t* rp = out + (long)(row0 + wr * 128 + mi * 16 + fr) * ld + col0 + wc * 64 + fq * 4;
#pragma unroll
        for (int ni = 0; ni < 4; ++ni) {
            u32x2 w; w.x = pk_bf16(acc[mi][ni][0], acc[mi][ni][1]); w.y = pk_bf16(acc[mi][ni][2], acc[mi][ni][3]);
            *(u32x2*)(rp + ni * 16) = w;
        }
    }
}

template <bool RES_LN>
__device__ __forceinline__ void epi_residual(f32x4 (&acc)[8][4], char* smem, const float* resid, const float* rstats  ,
                                             const float* g, const float* b, float* rout, bf16_t* rbout, float* stout  , int row0, int nt) {
    const int tid_ = opaque_tid();
    const int lane = tid_ & 63, wid = tid_ >> 6;
    const int wr = wid >> 2, wc = wid & 3, fr = lane & 15, fq = lane >> 4;
    float* sp = (float*)smem;
    const int col0 = nt * 256 + wc * 64 + fq * 4;
#pragma unroll
    for (int mi = 0; mi < 8; ++mi) {
        const int rl = wr * 128 + mi * 16 + fr;
        const long row = row0 + rl;
        float mean = 0.f, rstd = 1.f;
        if (RES_LN) {
            const f32x4 p0 = *(const f32x4*)(rstats + row * 8), p1 = *(const f32x4*)(rstats + row * 8 + 4);
            const float s1 = (p0[0] + p0[2]) + (p1[0] + p1[2]), s2 = (p0[1] + p0[3]) + (p1[1] + p1[3]);
            mean = s1 * (1.0f / 1024.0f);
            const float var = fmaxf(s2 * (1.0f / 1024.0f) - mean * mean, 0.f);
            rstd = rsqrtf(var + LN_EPS);
        }
        float s1 = 0.f, s2 = 0.f;
#pragma unroll
        for (int ni = 0; ni < 4; ++ni) {
            f32x4 x = *(const f32x4*)(resid + row * 1024 + col0 + ni * 16);
            if (RES_LN) x = (x - mean) * rstd * *(const f32x4*)(g + col0 + ni * 16) + *(const f32x4*)(b + col0 + ni * 16);
            const f32x4 v = acc[mi][ni] + ALPHA * x;
            *(f32x4*)(rout + row * 1024 + col0 + ni * 16) = v;
            { u32x2 w; w.x = pk_bf16(v[0], v[1]); w.y = pk_bf16(v[2], v[3]); *(u32x2*)(rbout + row * 1024 + col0 + ni * 16) = w; }
            s1 += (v[0] + v[1]) + (v[2] + v[3]);
            s2 += (v[0] * v[0] + v[1] * v[1]) + (v[2] * v[2] + v[3] * v[3]);
        }
        s1 += __shfl_xor(s1, 16); s1 += __shfl_xor(s1, 32);
        s2 += __shfl_xor(s2, 16); s2 += __shfl_xor(s2, 32);
        if (fq == 0) { sp[(rl * 4 + wc) * 2] = s1; sp[(rl * 4 + wc) * 2 + 1] = s2; }
    }
    __syncthreads();
    if (tid_ < 256) {
        const int rl = tid_;
        const float a1 = (sp[rl * 8] + sp[rl * 8 + 2]) + (sp[rl * 8 + 4] + sp[rl * 8 + 6]);
        const float a2 = (sp[rl * 8 + 1] + sp[rl * 8 + 3]) + (sp[rl * 8 + 5] + sp[rl * 8 + 7]);
        *(f32x2*)(stout + ((long)(row0 + rl) * 4 + nt) * 2) = (f32x2){a1, a2};
    }
    __syncthreads();
}

__device__ __forceinline__ void ln_tile_stats(float* st, const float* rstats, int row0) {
    const int tid_ = opaque_tid();
    if (tid_ < 256) {
        const long row = row0 + tid_;
        const f32x4 p0 = *(const f32x4*)(rstats + row * 8), p1 = *(const f32x4*)(rstats + row * 8 + 4);
        const float s1 = (p0[0] + p0[2]) + (p1[0] + p1[2]), s2 = (p0[1] + p0[3]) + (p1[1] + p1[3]);
        const float mean = s1 * (1.0f / 1024.0f);
        const float var = fmaxf(s2 * (1.0f / 1024.0f) - mean * mean, 0.f);
        st[tid_ * 2] = mean; st[tid_ * 2 + 1] = rsqrtf(var + LN_EPS);
    }
}
__device__ __forceinline__ void ln_load_gb(float* gb, const float* g, const float* b) {
    for (int i = opaque_tid(); i < 1024; i += NTHR) { gb[i] = g[i]; gb[1024 + i] = b[i]; }
}

struct TJob { const float* src; int ldsrc; int K; int col0; int ncols; bf16_t* dst; int mode; int rowoff; };
__device__ __forceinline__ int tjob_row(const TJob& j, int c) {
    if (j.mode == 0) return j.rowoff + c;
    return 256 * (c >> 7) + 32 * ((c & 127) >> 4) + 16 * j.rowoff + (c & 15);
}
__device__ void transpose_tile(char* smem, const TJob& j, int kt, int ct) {
    float* tile = (float*)smem;
    const int tid = opaque_tid();
#pragma unroll
    for (int i = 0; i < 8; ++i) {
        const int e = tid + i * NTHR, kr = e >> 6, c = e & 63;
        const int cc = ct * 64 + c;
        float v = 0.f;
        if (cc < j.ncols) v = j.src[(long)(kt * 64 + kr) * j.ldsrc + j.col0 + cc];
        tile[kr * 65 + c] = v;
    }
    __syncthreads();
#pragma unroll
    for (int i = 0; i < 4; ++i) {
        const int e = tid + i * NTHR, c = e >> 5, k2 = (e & 31) * 2;
        const int cc = ct * 64 + c;
        if (cc < j.ncols) {
            const unsigned w = pk_bf16(tile[k2 * 65 + c], tile[(k2 + 1) * 65 + c]);
            *(unsigned*)(j.dst + (long)tjob_row(j, cc) * j.K + kt * 64 + k2) = w;
        }
    }
    __syncthreads();
}


__device__ __forceinline__ void tjob_run(char* smem, int bid, int nb, const float* src, int ld, int K, int col0, int ncols, bf16_t* dst, int mode, int rowoff) {
    TJob j; j.src = src; j.ldsrc = ld; j.K = K; j.col0 = col0; j.ncols = ncols; j.dst = dst; j.mode = mode; j.rowoff = rowoff;
    const int nkt = K / 64, nct = (ncols + 63) / 64, ntile = nkt * nct;
    for (int t = bid; t < ntile; t += nb) transpose_tile(smem, j, t % nkt, t / nkt);
}

__device__ void cvt_rows_bf16(const float* src, bf16_t* dst, long n8, int bid, int nb) {
    for (long i = (long)bid * NTHR + opaque_tid(); i < n8; i += (long)nb * NTHR) {
        const f32x4 a = *(const f32x4*)(src + i * 8), b = *(const f32x4*)(src + i * 8 + 4);
        u32x4 w; w.x = pk_bf16(a[0], a[1]); w.y = pk_bf16(a[2], a[3]); w.z = pk_bf16(b[0], b[1]); w.w = pk_bf16(b[2], b[3]);
        *(u32x4*)(dst + i * 8) = w;
    }
}

enum { I_X = 0, I_MEM, I_WIN, I_POSK, I_CKW1, I_CKW2, I_POSV, I_CVW1, I_CVW2, I_CONVW, I_IBIAS, I_FBIAS, I_NORMG, I_WOUT, I_LN1G, I_LN1B,
       I_XAWQ, I_XAWK, I_XAWV, I_XAWO, I_LN2G, I_LN2B, I_ROUTW, I_ROUTB, I_MW1, I_MW3, I_MW2, I_SW1, I_SW3, I_SW2, I_LN3G, I_LN3B };

__device__ void phase0(const Params& p, char* smem, int bid, int nb) {
    char* ws = p.ws;
    tjob_run(smem, bid, nb, p.in[I_WIN], 3360, 1024, 0, 1280, (bf16_t*)(ws + WS_WIN), 0, 0);
    tjob_run(smem, bid, nb, p.in[I_WIN], 3360, 1024, 1304, 2048, (bf16_t*)(ws + WS_WIN), 0, 1280);
    tjob_run(smem, bid, nb, p.in[I_WIN], 3360, 1024, 1280, 24, (bf16_t*)(ws + WS_WIN), 0, 3328);
    tjob_run(smem, bid, nb, p.in[I_WIN], 3360, 1024, 3352, 8, (bf16_t*)(ws + WS_WIN), 0, 3352);
    tjob_run(smem, bid, nb, p.in[I_WOUT], 1024, 1024, 0, 1024, (bf16_t*)(ws + WS_WOUT), 0, 0);
    tjob_run(smem, bid, nb, p.in[I_XAWQ], 1024, 1024, 0, 1024, (bf16_t*)(ws + WS_WQ), 0, 0);
    tjob_run(smem, bid, nb, p.in[I_XAWK], 1024, 1024, 0, 1024, (bf16_t*)(ws + WS_WKV), 0, 0);
    tjob_run(smem, bid, nb, p.in[I_XAWV], 1024, 1024, 0, 1024, (bf16_t*)(ws + WS_WKV), 0, 1024);
    tjob_run(smem, bid, nb, p.in[I_XAWO], 1024, 1024, 0, 1024, (bf16_t*)(ws + WS_WO), 0, 0);
    tjob_run(smem, bid, nb, p.in[I_ROUTW], 256, 1024, 0, 256, (bf16_t*)(ws + WS_WR), 0, 0);
    tjob_run(smem, bid, nb, p.in[I_SW1], 256, 1024, 0, 256, (bf16_t*)(ws + WS_WS13), 1, 0);
    tjob_run(smem, bid, nb, p.in[I_SW3], 256, 1024, 0, 256, (bf16_t*)(ws + WS_WS13), 1, 1);
    tjob_run(smem, bid, nb, p.in[I_SW2], 1024, 256, 0, 1024, (bf16_t*)(ws + WS_WS2), 0, 0);
    tjob_run(smem, bid, nb, p.in[I_CKW1], 64, 2048, 0, 64, (bf16_t*)(ws + WS_CK1), 0, 0);
    tjob_run(smem, bid, nb, p.in[I_CKW2], 64, 64, 0, 64, (bf16_t*)(ws + WS_CK2), 0, 0);
    tjob_run(smem, bid, nb, p.in[I_CVW1], 64, 2048, 0, 64, (bf16_t*)(ws + WS_CV1), 0, 0);
    tjob_run(smem, bid, nb, p.in[I_CVW2], 64, 64, 0, 64, (bf16_t*)(ws + WS_CV2), 0, 0);
    cvt_rows_bf16(p.in[I_X], (bf16_t*)(ws + WS_XB), (long)T_TOK * 1024 / 8, bid, nb);
    cvt_rows_bf16(p.in[I_MEM], (bf16_t*)(ws + WS_MEMB), (long)4096 * 1024 / 8, bid, nb);
    if (bid == 0) { int* c = (int*)(ws + WS_CNT); for (int i = opaque_tid(); i < 1024; i += NTHR) c[i] = 0; }
}

__device__ void small_cols_task(const Params& p, int task) {
    const bf16_t* xb = (const bf16_t*)(p.ws + WS_XB);
    const bf16_t* wt = (const bf16_t*)(p.ws + WS_WIN) + (long)3328 * 1024;
    float* psm = (float*)(p.ws + WS_PSM);
    const int tid_ = opaque_tid();
    const int lane = tid_ & 63, wid = tid_ >> 6, fr = lane & 15, fq = lane >> 4;
    const int r0 = task * 256 + wid * 32;
    f32x4 acc[2][2];
#pragma unroll
    for (int mi = 0; mi < 2; ++mi)
#pragma unroll
        for (int ni = 0; ni < 2; ++ni) acc[mi][ni] = (f32x4){0.f, 0.f, 0.f, 0.f};
    const bf16_t* ap0 = xb + (long)(r0 + fr) * 1024 + fq * 8;
    const bf16_t* ap1 = ap0 + 16 * 1024;
    const bf16_t* bp0 = wt + (long)fr * 1024 + fq * 8;
    const bf16_t* bp1 = bp0 + 16 * 1024;
#pragma unroll 4
    for (int ks = 0; ks < 32; ++ks) {
        const bf16x8 a0 = *(const bf16x8*)(ap0 + ks * 32), a1 = *(const bf16x8*)(ap1 + ks * 32);
        const bf16x8 b0 = *(const bf16x8*)(bp0 + ks * 32), b1 = *(const bf16x8*)(bp1 + ks * 32);
        acc[0][0] = mfma16(b0, a0, acc[0][0]); acc[0][1] = mfma16(b1, a0, acc[0][1]);
        acc[1][0] = mfma16(b0, a1, acc[1][0]); acc[1][1] = mfma16(b1, a1, acc[1][1]);
    }
#pragma unroll
    for (int mi = 0; mi < 2; ++mi)
#pragma unroll
        for (int ni = 0; ni < 2; ++ni) *(f32x4*)(psm + (long)(r0 + mi * 16 + fr) * 32 + ni * 16 + fq * 4) = acc[mi][ni];
}

__device__ void phase1(const Params& p, char* smem, int bid, int nb) {
    char* ws = p.ws;
    constexpr int N_INP = 128 * 13, N_KV = 16 * 8, N_SM = 128;
    for (int t = bid; t < N_INP + N_KV + N_SM; t += nb) {
        if (t < N_INP + N_KV) {
            const bool inp = t < N_INP;
            const int tt = inp ? t : t - N_INP;
            const int ntn = inp ? 13 : 8;
            const int mt = tt / ntn, nt = tt % ntn;
            LoadBf16Rows al, bl;
            al.init_contig((const bf16_t*)(ws + (inp ? WS_XB : WS_MEMB)), 1024, mt * 256);
            bl.init_contig((const bf16_t*)(ws + (inp ? WS_WIN : WS_WKV)), 1024, nt * 256);
            f32x4 acc[8][4];
            gemm_mainloop(smem, al, bl, 16, acc);
            if (inp) epi_store_bf16(acc, (bf16_t*)(ws + WS_P), PW, mt * 256, nt * 256);
            else epi_store_bf16(acc, (bf16_t*)(ws + WS_KVX), 2048, mt * 256, nt * 256);
        } else {
            small_cols_task(p, t - N_INP - N_KV);
        }
    }
}

__device__ void compress_task(const Params& p, char* smem, int which, int rb) {
    const char* ws = p.ws;
    const bf16_t* P = (const bf16_t*)(ws + WS_P);
    const float* pos = p.in[which ? I_POSV : I_POSK];
    const bf16_t* w1t = (const bf16_t*)(ws + (which ? WS_CV1 : WS_CK1));
    const bf16_t* w2t = (const bf16_t*)(ws + (which ? WS_CV2 : WS_CK2));
    bf16_t* outp = (bf16_t*)(p.ws + (which ? WS_VCMP : WS_KCMP));
    const int colbase = which ? PC_VC : PC_KC;
    const int tid_ = opaque_tid();
    const int lane = tid_ & 63, wid = tid_ >> 6, fr = lane & 15, fq = lane >> 4;
    const int mi = wid >> 2, ni = wid & 3;
    const int r = rb * 32 + mi * 16 + fr;
    const int b = r / 254, rem = r - b * 254, c = rem >> 1, g = rem & 1;
    const bf16_t* arow = P + (long)(b * 2048 + c * 16) * PW + colbase + g * 64 + fq * 8;
    const bf16_t* brow = w1t + (long)(ni * 16 + fr) * 2048 + fq * 8;
    const float* prow = pos + fq * 8;
    f32x4 acc = (f32x4){0.f, 0.f, 0.f, 0.f};
#pragma unroll 8
    for (int ks = 0; ks < 64; ++ks) {
        const int l = ks >> 1, d0 = (ks & 1) * 32;
        const u32x4 av = *(const u32x4*)(arow + (long)l * PW + d0);
        const f32x4 p0 = *(const f32x4*)(prow + l * 64 + d0), p1 = *(const f32x4*)(prow + l * 64 + d0 + 4);
        u32x4 aw;
        aw.x = pk_bf16(bf_lo(av.x) + p0[0], bf_hi(av.x) + p0[1]); aw.y = pk_bf16(bf_lo(av.y) + p0[2], bf_hi(av.y) + p0[3]);
        aw.z = pk_bf16(bf_lo(av.z) + p1[0], bf_hi(av.z) + p1[1]); aw.w = pk_bf16(bf_lo(av.w) + p1[2], bf_hi(av.w) + p1[3]);
        const bf16x8 bb = *(const bf16x8*)(brow + ks * 32);
        acc = mfma16(bb, as_bf16x8(aw), acc);
    }
    bf16_t* h1 = (bf16_t*)smem;
    {
        u32x2 w; w.x = pk_bf16(siluf_(acc[0]), siluf_(acc[1])); w.y = pk_bf16(siluf_(acc[2]), siluf_(acc[3]));
        *(u32x2*)(h1 + (mi * 16 + fr) * 72 + ni * 16 + fq * 4) = w;
    }
    __syncthreads();
    f32x4 acc2 = (f32x4){0.f, 0.f, 0.f, 0.f};
#pragma unroll
    for (int ks = 0; ks < 2; ++ks) {
        const bf16x8 a = *(const bf16x8*)(h1 + (mi * 16 + fr) * 72 + ks * 32 + fq * 8);
        const bf16x8 bb = *(const bf16x8*)(w2t + (ni * 16 + fr) * 64 + ks * 32 + fq * 8);
        acc2 = mfma16(bb, a, acc2);
    }
    {
        u32x2 w; w.x = pk_bf16(acc2[0], acc2[1]); w.y = pk_bf16(acc2[2], acc2[3]);
        *(u32x2*)(outp + ((long)(b * 2 + g) * 128 + c) * 64 + ni * 16 + fq * 4) = w;
    }
    __syncthreads();
}

__device__ void phase2(const Params& p, char* smem, int bid, int nb) {
    char* ws = p.ws;
    for (int t = bid; t < 254; t += nb) compress_task(p, smem, t / 127, t % 127);
    const int tid_ = opaque_tid();
    if (bid < 32 && tid_ < 32) {
        bf16_t* kc = (bf16_t*)(ws + WS_KCMP) + ((long)bid * 128 + 127) * 64;
        bf16_t* vc = (bf16_t*)(ws + WS_VCMP) + ((long)bid * 128 + 127) * 64;
        ((unsigned*)kc)[tid_] = 0u; ((unsigned*)vc)[tid_] = 0u;
    }
    const bf16_t* P = (const bf16_t*)(ws + WS_P);
    const float* cw = p.in[I_CONVW];
    bf16_t* qk = (bf16_t*)(ws + WS_QK);
    for (long it = (long)bid * NTHR + tid_; it < (long)T_TOK * 128; it += (long)nb * NTHR) {
        const int t = (int)(it >> 7), ch = (int)(it & 127);
        const int s = t & (SEQ - 1);
        float a[8];
#pragma unroll
        for (int e = 0; e < 8; ++e) a[e] = 0.f;
#pragma unroll
        for (int j = 0; j < 4; ++j) {
            if (s - 3 + j >= 0) {
                const u32x4 u = *(const u32x4*)(P + (long)(t - 3 + j) * PW + PC_MQ + ch * 8);
                const f32x4 w0 = *(const f32x4*)(cw + j * 1024 + ch * 8), w1 = *(const f32x4*)(cw + j * 1024 + ch * 8 + 4);
                a[0] += w0[0] * bf_lo(u.x); a[1] += w0[1] * bf_hi(u.x); a[2] += w0[2] * bf_lo(u.y); a[3] += w0[3] * bf_hi(u.y);
                a[4] += w1[0] * bf_lo(u.z); a[5] += w1[1] * bf_hi(u.z); a[6] += w1[2] * bf_lo(u.w); a[7] += w1[3] * bf_hi(u.w);
            }
        }
        const float sc = ch < 64 ? 0.08838834764831845f : 1.0f;
        u32x4 w;
        w.x = pk_bf16(siluf_(a[0]) * sc, siluf_(a[1]) * sc); w.y = pk_bf16(siluf_(a[2]) * sc, siluf_(a[3]) * sc);
        w.z = pk_bf16(siluf_(a[4]) * sc, siluf_(a[5]) * sc); w.w = pk_bf16(siluf_(a[6]) * sc, siluf_(a[7]) * sc);
        *(u32x4*)(qk + (long)t * 1024 + ch * 8) = w;
    }
}

typedef __attribute__((address_space(3))) s16x4 lds_s16x4;
__device__ __forceinline__ s16x4 lds_tr(const char* a) { return __builtin_amdgcn_ds_read_tr16_b64_v4i16((lds_s16x4*)a); }
__device__ __forceinline__ bf16x8 tr_frag_perm(const char* base, int pitch, int rbase, int cbase, int fr, int fq) {
    const char* a0 = base + (rbase + 4 * fq + (fr >> 2)) * pitch + (cbase + 4 * (fr & 3)) * 2;
    const s16x4 lo = lds_tr(a0), hi = lds_tr(a0 + 16 * pitch);
    return (bf16x8){lo[0], lo[1], lo[2], lo[3], hi[0], hi[1], hi[2], hi[3]};
}
__device__ __forceinline__ bf16x8 tr_frag_std(const char* base, int pitch, int rbase, int cbase, int fr, int fq) {
    const char* a0 = base + (rbase + 8 * fq + (fr >> 2)) * pitch + (cbase + 4 * (fr & 3)) * 2;
    const s16x4 lo = lds_tr(a0), hi = lds_tr(a0 + 4 * pitch);
    return (bf16x8){lo[0], lo[1], lo[2], lo[3], hi[0], hi[1], hi[2], hi[3]};
}
__device__ __forceinline__ bf16x8 pack_p(const f32x4 a, const f32x4 b) {
    u32x4 w; w.x = pk_bf16(a[0], a[1]); w.y = pk_bf16(a[2], a[3]); w.z = pk_bf16(b[0], b[1]); w.w = pk_bf16(b[2], b[3]);
    return as_bf16x8(w);
}

__device__ __forceinline__ float dpp_xor1(float v) { return __builtin_bit_cast(float, __builtin_amdgcn_mov_dpp(__builtin_bit_cast(int, v), 0xB1, 0xF, 0xF, true)); }
__device__ __forceinline__ float dpp_xor2(float v) { return __builtin_bit_cast(float, __builtin_amdgcn_mov_dpp(__builtin_bit_cast(int, v), 0x4E, 0xF, 0xF, true)); }

constexpr int NSA_PITCH = 160;
constexpr int NSA_KC = 0, NSA_VC = 20480, NSA_KT = 40960, NSA_VT = 61440, NSA_MISC = 81920, NSA_Y = 83968;

struct NsaState {
    bf16x8 qf[2][2];
    int tl[2];
    unsigned selm[2];
    unsigned wunion, bunion;
};

template <int MODE>
__device__ __forceinline__ void nsa_stream(char* smem, const bf16_t* Pb  , int g, int i, NsaState& st, float gate0, float gate1, const int tid) {
    const int lane = tid & 63, fr = lane & 15, fq = lane >> 4;
    const int kcol = (MODE == 0 ? PC_KS : PC_KW) + g * 64, vcol = (MODE == 0 ? PC_VS : PC_VW) + g * 64;
    const int lrow = tid >> 3, lch = tid & 7;
    const unsigned need = MODE == 0 ? st.bunion : 0xffffffffu;
    const int jlo = MODE == 0 ? 0 : (i - 8 > 0 ? i - 8 : 0);
    f32x4 O[2][4];
    float m[2], l[2];
    int tlq[2];
#pragma unroll
    for (int mt = 0; mt < 2; ++mt) { m[mt] = -1e30f; l[mt] = 0.f; tlq[mt] = st.tl[mt] - 4 * fq;
#pragma unroll
        for (int dt = 0; dt < 4; ++dt) O[mt][dt] = (f32x4){0.f, 0.f, 0.f, 0.f}; }
    int j = jlo;
    while (j <= i && !((need >> j) & 1u)) ++j;
    u32x4 kreg, vreg;
    int buf = 0;
    if (j <= i) {
        const bf16_t* rp = Pb + (long)(j * 64 + lrow) * PW + lch * 8;
        kreg = *(const u32x4*)(rp + kcol); vreg = *(const u32x4*)(rp + vcol);
        *(u32x4*)(smem + NSA_KT + lrow * NSA_PITCH + lch * 16) = kreg;
        *(u32x4*)(smem + NSA_VT + lrow * NSA_PITCH + lch * 16) = vreg;
    }
    __syncthreads();
    while (j <= i) {
        int jn = j + 1;
        while (jn <= i && !((need >> jn) & 1u)) ++jn;
        if (jn <= i) {
            const bf16_t* rp = Pb + (long)(jn * 64 + lrow) * PW + lch * 8;
            kreg = *(const u32x4*)(rp + kcol); vreg = *(const u32x4*)(rp + vcol);
        }
        const char* KT = smem + NSA_KT + buf * 10240;
        const char* VT = smem + NSA_VT + buf * 10240;
        const bool wave_on = MODE == 0 ? (((st.wunion >> j) & 1u) != 0u) : true;
        if (wave_on) {
            f32x4 S[2][4];
            {
                bf16x8 kf[4][2];
#pragma unroll
                for (int nt = 0; nt < 4; ++nt)
#pragma unroll
                    for (int ks = 0; ks < 2; ++ks) kf[nt][ks] = *(const bf16x8*)(KT + (16 * nt + fr) * NSA_PITCH + (ks * 4 + fq) * 16);
#pragma unroll
                for (int mt = 0; mt < 2; ++mt)
#pragma unroll
                    for (int nt = 0; nt < 4; ++nt) {
                        f32x4 s = (f32x4){0.f, 0.f, 0.f, 0.f};
                        s = mfma16(kf[nt][0], st.qf[mt][0], s);
                        s = mfma16(kf[nt][1], st.qf[mt][1], s);
                        S[mt][nt] = s;
                    }
            }
            bf16x8 pf[2][2];
#pragma unroll
            for (int mt = 0; mt < 2; ++mt) {
                const bool rowsel = MODE == 0 ? (((st.selm[mt] >> j) & 1u) != 0u) : true;
                float mx = -INFINITY;
#pragma unroll
                for (int nt = 0; nt < 4; ++nt)
#pragma unroll
                    for (int e = 0; e < 4; ++e) {
                        const int kc = 16 * nt + e;
                        bool ok = rowsel;
                        if (j == i) ok = ok && (kc <= tlq[mt]);
                        if (MODE == 1) { if (j == i - 8) ok = ok && (kc > tlq[mt]); }
                        const float sv = ok ? S[mt][nt][e] * 0.125f : -INFINITY;
                        S[mt][nt][e] = sv;
                        mx = fmaxf(mx, sv);
                    }
                mx = fmaxf(mx, __shfl_xor(mx, 16)); mx = fmaxf(mx, __shfl_xor(mx, 32));
                const float mnew = fmaxf(m[mt], mx);
                const float alpha = __expf(m[mt] - mnew);
                float rs = 0.f;
#pragma unroll
                for (int nt = 0; nt < 4; ++nt)
#pragma unroll
                    for (int e = 0; e < 4; ++e) { const float pv = __expf(S[mt][nt][e] - mnew); S[mt][nt][e] = pv; rs += pv; }
                rs += __shfl_xor(rs, 16); rs += __shfl_xor(rs, 32);
                l[mt] = l[mt] * alpha + rs; m[mt] = mnew;
#pragma unroll
                for (int dt = 0; dt < 4; ++dt) O[mt][dt] = O[mt][dt] * alpha;
                pf[mt][0] = pack_p(S[mt][0], S[mt][1]); pf[mt][1] = pack_p(S[mt][2], S[mt][3]);
            }
#pragma unroll
            for (int ks2 = 0; ks2 < 2; ++ks2)
#pragma unroll
                for (int dt = 0; dt < 4; ++dt) {
                    const bf16x8 vf = tr_frag_perm(VT, NSA_PITCH, 32 * ks2, 16 * dt, fr, fq);
                    O[0][dt] = mfma16(vf, pf[0][ks2], O[0][dt]);
                    O[1][dt] = mfma16(vf, pf[1][ks2], O[1][dt]);
                }
        }
        if (jn <= i) {
            char* KTn = smem + NSA_KT + (buf ^ 1) * 10240; char* VTn = smem + NSA_VT + (buf ^ 1) * 10240;
            *(u32x4*)(KTn + lrow * NSA_PITCH + lch * 16) = kreg;
            *(u32x4*)(VTn + lrow * NSA_PITCH + lch * 16) = vreg;
        }
        __syncthreads();
        buf ^= 1; j = jn;
    }
#pragma unroll
    for (int mt = 0; mt < 2; ++mt) {
        const float gsc = (mt == 0 ? gate0 : gate1) * (l[mt] > 0.f ? 1.0f / l[mt] : 0.f);
#pragma unroll
        for (int dt = 0; dt < 4; ++dt) { f32x4* yp = (f32x4*)(smem + NSA_Y) + (mt * 4 + dt) * NTHR + tid; *yp = *yp + O[mt][dt] * gsc; }
    }
}

__device__ __forceinline__ void nsa_cmp_one(const char* smem, const bf16x8 qf0, const bf16x8 qf1, const int t, const int i, const float gate0, f32x4* yp  , unsigned& selm, const int lane) {
    const int fr = lane & 15, fq = lane >> 4;
        const int cl = (t >= 31 ? ((t - 31) >> 4) : -1) - 4 * fq;
        f32x4 S[8];
#pragma unroll
        for (int nt = 0; nt < 8; ++nt) {
            f32x4 s = (f32x4){0.f, 0.f, 0.f, 0.f};
#pragma unroll
            for (int ks = 0; ks < 2; ++ks) {
                const bf16x8 kf = *(const bf16x8*)(smem + NSA_KC + (16 * nt + fr) * NSA_PITCH + (ks * 4 + fq) * 16);
                s = mfma16(kf, (ks == 0 ? qf0 : qf1), s);
            }
            S[nt] = s;
        }
        float mx = -INFINITY;
#pragma unroll
        for (int nt = 0; nt < 8; ++nt)
#pragma unroll
            for (int e = 0; e < 4; ++e) {
                const float sv = (16 * nt + e <= cl) ? S[nt][e] * 0.125f : -INFINITY;
                S[nt][e] = sv; mx = fmaxf(mx, sv);
            }
        mx = fmaxf(mx, __shfl_xor(mx, 16)); mx = fmaxf(mx, __shfl_xor(mx, 32));
        const float mref = fmaxf(mx, -1e30f);
        float rs = 0.f;
#pragma unroll
        for (int nt = 0; nt < 8; ++nt)
#pragma unroll
            for (int e = 0; e < 4; ++e) { const float pv = __expf(S[nt][e] - mref); S[nt][e] = pv; rs += pv; }
        rs += __shfl_xor(rs, 16); rs += __shfl_xor(rs, 32);
        const float inv = rs > 0.f ? 1.0f / rs : 0.f;
#pragma unroll
        for (int nt = 0; nt < 8; ++nt) S[nt] = S[nt] * inv;
        {
            f32x4 O[4];
#pragma unroll
            for (int dt = 0; dt < 4; ++dt) O[dt] = (f32x4){0.f, 0.f, 0.f, 0.f};
#pragma unroll
            for (int ks2 = 0; ks2 < 4; ++ks2) {
                const bf16x8 pf = pack_p(S[2 * ks2], S[2 * ks2 + 1]);
#pragma unroll
                for (int dt = 0; dt < 4; ++dt) {
                    const bf16x8 vf = tr_frag_perm(smem + NSA_VC, NSA_PITCH, 32 * ks2, 16 * dt, fr, fq);
                    O[dt] = mfma16(vf, pf, O[dt]);
                }
            }
#pragma unroll
            for (int dt = 0; dt < 4; ++dt) yp[dt * NTHR] = O[dt] * gate0;
        }
        float imp[8];
        {
            float own[8], last[8];
#pragma unroll
            for (int nt = 0; nt < 8; ++nt) {
                f32x4 v = S[nt];
#pragma unroll
                for (int e = 0; e < 4; ++e) { v[e] += dpp_xor1(v[e]); v[e] += dpp_xor2(v[e]); }
                own[nt] = (v[0] + v[1]) + (v[2] + v[3]); last[nt] = v[3];
            }
            const int src = (lane + 48) & 63;
#pragma unroll
            for (int nt = 0; nt < 8; ++nt) {
                const float a = __shfl(last[nt], src);
                const float bsh = nt > 0 ? __shfl(last[nt > 0 ? nt - 1 : 0], src) : 0.f;
                const float prevc = fq > 0 ? a : bsh;
                const int n = 4 * nt + fq;
                const float pslc = own[nt] + prevc;
                const bool valid = n <= i;
                const bool forced = (n == 0) || (n == i) || (n == i - 1);
                imp[nt] = valid ? pslc + (forced ? 1e4f : 0.f) : -1e30f;
            }
        }
        unsigned mask = 0u;
#pragma unroll 1
        for (int r = 0; r < 8; ++r) {
            float bv = imp[0]; int bn = fq;
#pragma unroll
            for (int nt = 1; nt < 8; ++nt) { if (imp[nt] > bv) { bv = imp[nt]; bn = 4 * nt + fq; } }
#pragma unroll
            for (int off = 16; off <= 32; off <<= 1) {
                const float ov = __shfl_xor(bv, off); const int on = __shfl_xor(bn, off);
                if (ov > bv || (ov == bv && on < bn)) { bv = ov; bn = on; }
            }
            if (bv > -5e29f) mask |= 1u << bn;
#pragma unroll
            for (int nt = 0; nt < 8; ++nt) if (bn == 4 * nt + fq) imp[nt] = -3.0e38f;
        }
        selm = mask;
}

__device__ void nsa_task(const Params& p, char* smem, int b, int g, int i) {
    const char* ws = p.ws;
    const bf16_t* Pb = (const bf16_t*)(ws + WS_P) + (long)b * SEQ * PW;
    const float* psm = (const float*)(ws + WS_PSM) + (long)b * SEQ * 32;
    int tid = threadIdx.x;
    asm volatile("" : "+v"(tid));
    const int lane = tid & 63, wid = __builtin_amdgcn_readfirstlane(tid >> 6), fr = lane & 15, fq = lane >> 4;
    const int qs = i * 64;
    NsaState st;
    float gate[2][3];
#pragma unroll
    for (int mt = 0; mt < 2; ++mt) {
        st.tl[mt] = 8 * wid + 4 * mt + (fr >> 2);
        const int h = fr & 3;
        const bf16_t* qp = Pb + (long)(qs + st.tl[mt]) * PW + PC_Q + g * 256 + h * 64 + fq * 8;
        st.qf[mt][0] = *(const bf16x8*)(qp); st.qf[mt][1] = *(const bf16x8*)(qp + 32);
        const float* gp = psm + (long)(qs + st.tl[mt]) * 32 + (g * 4 + h) * 3;
        gate[mt][0] = sigmoidf_(gp[0]); gate[mt][1] = sigmoidf_(gp[1]); gate[mt][2] = sigmoidf_(gp[2]);
    }
    {
        const bf16_t* kc = (const bf16_t*)(ws + WS_KCMP) + (long)(b * 2 + g) * 128 * 64;
        const bf16_t* vc = (const bf16_t*)(ws + WS_VCMP) + (long)(b * 2 + g) * 128 * 64;
#pragma unroll
        for (int r = 0; r < 2; ++r) {
            const int e = tid + r * NTHR, row = e >> 3, ch = e & 7;
            *(u32x4*)(smem + NSA_KC + row * NSA_PITCH + ch * 16) = *(const u32x4*)(kc + row * 64 + ch * 8);
            *(u32x4*)(smem + NSA_VC + row * NSA_PITCH + ch * 16) = *(const u32x4*)(vc + row * 64 + ch * 8);
        }
    }
    __syncthreads();
    nsa_cmp_one(smem, st.qf[0][0], st.qf[0][1], qs + st.tl[0], i, gate[0][0], (f32x4*)(smem + NSA_Y) + tid, st.selm[0], lane);
    asm volatile("" ::: "memory");
    __builtin_amdgcn_sched_barrier(0);
    nsa_cmp_one(smem, st.qf[1][0], st.qf[1][1], qs + st.tl[1], i, gate[1][0], (f32x4*)(smem + NSA_Y) + 4 * NTHR + tid, st.selm[1], lane);
    __builtin_amdgcn_sched_barrier(0);
    {
        unsigned u = st.selm[0] | st.selm[1];
        u |= __shfl_xor(u, 4); u |= __shfl_xor(u, 8);
        st.wunion = u;
        unsigned* misc = (unsigned*)(smem + NSA_MISC);
        if (lane == 0) misc[wid] = u;
        __syncthreads();
        unsigned bu = 0u;
#pragma unroll
        for (int w = 0; w < 8; ++w) bu |= misc[w];
        st.bunion = bu;
    }
    nsa_stream<0>(smem, Pb, g, i, st, gate[0][1], gate[1][1], tid);
    nsa_stream<1>(smem, Pb, g, i, st, gate[0][2], gate[1][2], tid);
    bf16_t* mix = (bf16_t*)(p.ws + WS_MIX) + (long)b * SEQ * 1024;
#pragma unroll
    for (int mt = 0; mt < 2; ++mt) {
        bf16_t* op = mix + (long)(qs + st.tl[mt]) * 1024 + g * 256 + (fr & 3) * 64 + fq * 4;
#pragma unroll
        for (int dt = 0; dt < 4; ++dt) {
            const f32x4 yv = *((const f32x4*)(smem + NSA_Y) + (mt * 4 + dt) * NTHR + tid);
            u32x2 w; w.x = pk_bf16(yv[0], yv[1]); w.y = pk_bf16(yv[2], yv[3]);
            *(u32x2*)(op + dt * 16) = w;
        }
    }
    __syncthreads();
}

constexpr int ML_PITCH = 288;
constexpr int ML_Q = 0, ML_K = 18432, ML_V = 36864, ML_VW = 55296, ML_C = 73728, ML_N = 110592, ML_GB = 111104, ML_GA = 119296, ML_GMQ = 127488,
              ML_GS = 135680, ML_ST = 136192;

__device__ __forceinline__ float wave_incl_scan_add(float v, int lane) {
#pragma unroll
    for (int off = 1; off < 64; off <<= 1) { const float o = __shfl_up(v, off); if (lane >= off) v += o; }
    return v;
}
__device__ __forceinline__ float wave_incl_scan_max(float v, int lane) {
#pragma unroll
    for (int off = 1; off < 64; off <<= 1) { const float o = __shfl_up(v, off); if (lane >= off) v = fmaxf(v, o); }
    return v;
}
__device__ __forceinline__ float wave_max(float v) {
#pragma unroll
    for (int off = 32; off >= 1; off >>= 1) v = fmaxf(v, __shfl_xor(v, off));
    return v;
}

__device__ void mlstm_scan(const Params& p, char* smem, int b, int h) {
    const char* ws = p.ws;
    int tid = threadIdx.x;
    asm volatile("" : "+v"(tid));
    const int lane = tid & 63, wid = __builtin_amdgcn_readfirstlane(tid >> 6), fr = lane & 15, fq = lane >> 4;
    const bf16_t* QK = (const bf16_t*)(ws + WS_QK) + (long)b * SEQ * 1024 + h * 128;
    const bf16_t* Pb = (const bf16_t*)(ws + WS_P) + (long)b * SEQ * PW;
    const float* psm = (const float*)(ws + WS_PSM) + (long)b * SEQ * 32;
    bf16_t* mix = (bf16_t*)(p.ws + WS_MIX) + (long)b * SEQ * 1024 + 512 + h * 128;
    float* GB = (float*)(smem + ML_GB); float* GA = (float*)(smem + ML_GA); float* GMQ = (float*)(smem + ML_GMQ);
    float* GS = (float*)(smem + ML_GS);
    float* NV = (float*)(smem + ML_N);
    float* ST = (float*)(smem + ML_ST);
    {
        const float ib = p.in[I_IBIAS][h], fb = p.in[I_FBIAS][h];
        for (int c = wid; c < 32; c += 8) {
            const int t = c * 64 + lane;
            const float ipre = psm[(long)t * 32 + 24 + h], fpre = psm[(long)t * 32 + 28 + h];
            const float li = ipre + ib;
            const float x = fpre + fb;
            const float lf = fminf(x, 0.f) - log1pf(__expf(-fabsf(x)));
            const float bb = wave_incl_scan_add(lf, lane);
            const float aa = li - bb;
            const float g = __shfl(bb, 63);
            const float pm = wave_incl_scan_max(aa, lane);
            const float mloc = wave_max(g + aa);
            GB[t] = bb; GA[t] = aa; GMQ[t] = pm;
            if (lane == 0) { GS[64 + c] = g; GS[96 + c] = mloc; }
        }
    }
    for (int e = tid; e < 36864 / 16; e += NTHR) *(u32x4*)(smem + ML_C + e * 16) = (u32x4){0u, 0u, 0u, 0u};
    if (tid < 128) NV[tid] = 0.f;
    __syncthreads();
    if (tid == 0) {
        float m = 0.f;
        for (int c = 0; c < 32; ++c) { GS[c] = m; const float mn = fmaxf(GS[64 + c] + m, GS[96 + c]); GS[32 + c] = mn; m = mn; }
    }
    __syncthreads();
    for (int t = tid; t < SEQ; t += NTHR) GMQ[t] = GB[t] + fmaxf(GS[t >> 6], GMQ[t]);
    __syncthreads();

    f32x4 Cacc[9];
#pragma unroll
    for (int c9 = 0; c9 < 9; ++c9) Cacc[c9] = (f32x4){0.f, 0.f, 0.f, 0.f};
    const int lrow = tid >> 4, lch = tid & 15;
    u32x4 rq[2], rk[2], rv[2];
#pragma unroll
    for (int i2 = 0; i2 < 2; ++i2) {
        const int row = lrow + 32 * i2;
        rq[i2] = *(const u32x4*)(QK + (long)row * 1024 + lch * 8);
        rk[i2] = *(const u32x4*)(QK + (long)row * 1024 + 512 + lch * 8);
        rv[i2] = *(const u32x4*)(Pb + (long)row * PW + PC_MV + h * 128 + lch * 8);
    }
    const int mt = wid >> 1, half = wid & 1;
#pragma unroll 1
    for (int c = 0; c < 32; ++c) {
        const float m_old = GS[c], m_new = GS[32 + c], gch = GS[64 + c];
#pragma unroll
        for (int i2 = 0; i2 < 2; ++i2) {
            const int row = lrow + 32 * i2;
            *(u32x4*)(smem + ML_Q + row * ML_PITCH + lch * 16) = rq[i2];
            *(u32x4*)(smem + ML_K + row * ML_PITCH + lch * 16) = rk[i2];
            *(u32x4*)(smem + ML_V + row * ML_PITCH + lch * 16) = rv[i2];
            const float wk = __expf(gch + GA[c * 64 + row] - m_new);
            u32x4 w;
            w.x = pk_bf16(bf_lo(rv[i2].x) * wk, bf_hi(rv[i2].x) * wk); w.y = pk_bf16(bf_lo(rv[i2].y) * wk, bf_hi(rv[i2].y) * wk);
            w.z = pk_bf16(bf_lo(rv[i2].z) * wk, bf_hi(rv[i2].z) * wk); w.w = pk_bf16(bf_lo(rv[i2].w) * wk, bf_hi(rv[i2].w) * wk);
            *(u32x4*)(smem + ML_VW + row * ML_PITCH + lch * 16) = w;
        }
        if (tid < 128) {
            const int row = tid >> 1, hf = tid & 1;
            const float wk = __expf(gch + GA[c * 64 + row] - m_new);
            u32x4 w = (u32x4){0u, 0u, 0u, 0u};
            if (hf == 0) w.x = pk_bf16(wk, 0.f);
            *(u32x4*)(smem + ML_VW + row * ML_PITCH + 256 + hf * 16) = w;
        }
        __syncthreads();
        if (c + 1 < 32) {
#pragma unroll
            for (int i2 = 0; i2 < 2; ++i2) {
                const int row = (c + 1) * 64 + lrow + 32 * i2;
                rq[i2] = *(const u32x4*)(QK + (long)row * 1024 + lch * 8);
                rk[i2] = *(const u32x4*)(QK + (long)row * 1024 + 512 + lch * 8);
                rv[i2] = *(const u32x4*)(Pb + (long)row * PW + PC_MV + h * 128 + lch * 8);
            }
        }
        const int l = 16 * mt + fr;
        const float bl = GB[c * 64 + l], mq = GMQ[c * 64 + l];
        const float ul = bl - mq;
        f32x4 hv[4];
        float s1 = 0.f, s2 = 0.f;
        {
            bf16x8 qf[4];
#pragma unroll
            for (int ks = 0; ks < 4; ++ks) qf[ks] = *(const bf16x8*)(smem + ML_Q + l * ML_PITCH + (ks * 4 + fq) * 16);
            f32x4 S[4];
#pragma unroll
            for (int nt = 0; nt < 4; ++nt) {
                f32x4 s = (f32x4){0.f, 0.f, 0.f, 0.f};
#pragma unroll
                for (int ks = 0; ks < 4; ++ks) {
                    const bf16x8 kf = *(const bf16x8*)(smem + ML_K + (16 * nt + fr) * ML_PITCH + (ks * 4 + fq) * 16);
                    s = mfma16(kf, qf[ks], s);
                }
                S[nt] = s;
            }
            float dintra = 0.f;
            const int lq = l - 4 * fq;
#pragma unroll
            for (int nt = 0; nt < 4; ++nt) {
                const f32x4 av = *(const f32x4*)(GA + c * 64 + 16 * nt + 4 * fq);
#pragma unroll
                for (int e = 0; e < 4; ++e) {
                    const float w = (16 * nt + e <= lq) ? __expf(ul + av[e]) : 0.f;
                    const float sv = S[nt][e] * w;
                    S[nt][e] = sv; dintra += sv;
                }
            }
            dintra += __shfl_xor(dintra, 16); dintra += __shfl_xor(dintra, 32);
            float dinter = 0.f;
#pragma unroll
            for (int ks = 0; ks < 4; ++ks) {
                const f32x4 n0 = *(const f32x4*)(NV + ks * 32 + fq * 8), n1 = *(const f32x4*)(NV + ks * 32 + fq * 8 + 4);
                const u32x4 qu = __builtin_bit_cast(u32x4, qf[ks]);
                dinter += bf_lo(qu.x) * n0[0] + bf_hi(qu.x) * n0[1] + bf_lo(qu.y) * n0[2] + bf_hi(qu.y) * n0[3]
                        + bf_lo(qu.z) * n1[0] + bf_hi(qu.z) * n1[1] + bf_lo(qu.w) * n1[2] + bf_hi(qu.w) * n1[3];
            }
            dinter += __shfl_xor(dinter, 16); dinter += __shfl_xor(dinter, 32);
            const float winter = __expf(ul + m_old);
            const float den = winter * dinter + dintra;
            const float rden = 1.0f / fmaxf(fabsf(den), __expf(-mq));
            const bf16x8 pf0 = pack_p(S[0], S[1]), pf1 = pack_p(S[2], S[3]);
#pragma unroll
            for (int c4 = 0; c4 < 4; ++c4) {
                const int et = 4 * half + c4;
                f32x4 num = (f32x4){0.f, 0.f, 0.f, 0.f}, inter = (f32x4){0.f, 0.f, 0.f, 0.f};
                num = mfma16(tr_frag_perm(smem + ML_V, ML_PITCH, 0, 16 * et, fr, fq), pf0, num);
                num = mfma16(tr_frag_perm(smem + ML_V, ML_PITCH, 32, 16 * et, fr, fq), pf1, num);
#pragma unroll
                for (int ks = 0; ks < 4; ++ks) {
                    const bf16x8 cf = *(const bf16x8*)(smem + ML_C + (16 * et + fr) * ML_PITCH + (ks * 4 + fq) * 16);
                    inter = mfma16(cf, qf[ks], inter);
                }
                const f32x4 hh = (inter * winter + num) * rden;
                hv[c4] = hh;
                s1 += (hh[0] + hh[1]) + (hh[2] + hh[3]);
                s2 += (hh[0] * hh[0] + hh[1] * hh[1]) + (hh[2] * hh[2] + hh[3] * hh[3]);
            }
            s1 += __shfl_xor(s1, 16); s1 += __shfl_xor(s1, 32);
            s2 += __shfl_xor(s2, 16); s2 += __shfl_xor(s2, 32);
            if (fq == 0) { ST[(l * 2 + half) * 2] = s1; ST[(l * 2 + half) * 2 + 1] = s2; }
        }
        {
            const float decay = __expf(gch + m_old - m_new);
#pragma unroll
            for (int c9 = 0; c9 < 9; ++c9) Cacc[c9] = Cacc[c9] * decay;
#pragma unroll
            for (int ks2 = 0; ks2 < 2; ++ks2) {
                const bf16x8 kt = tr_frag_std(smem + ML_K, ML_PITCH, 32 * ks2, 16 * wid, fr, fq);
#pragma unroll
                for (int c9 = 0; c9 < 9; ++c9) {
                    const bf16x8 vw = tr_frag_std(smem + ML_VW, ML_PITCH, 32 * ks2, 16 * c9, fr, fq);
                    Cacc[c9] = mfma16(kt, vw, Cacc[c9]);
                }
            }
        }
        __syncthreads();
        {
            const float* sp = ST + l * 4;
            const float t1 = sp[0] + sp[2], t2 = sp[1] + sp[3];
            const float mean = t1 * (1.0f / 128.0f);
            const float var = fmaxf(t2 * (1.0f / 128.0f) - mean * mean, 0.f);
            const float rstd = rsqrtf(var + LN_EPS);
            const long tok = c * 64 + l;
#pragma unroll
            for (int c4 = 0; c4 < 4; ++c4) {
                const int col = 64 * half + 16 * c4 + 4 * fq;
                const u32x2 ou = *(const u32x2*)(Pb + tok * PW + PC_MO + h * 128 + col);
                const f32x4 ng = *(const f32x4*)(p.in[I_NORMG] + h * 128 + col);
                const f32x4 y = (hv[c4] - mean) * rstd * ng;
                u32x2 w;
                w.x = pk_bf16(y[0] * sigmoidf_(bf_lo(ou.x)), y[1] * sigmoidf_(bf_hi(ou.x)));
                w.y = pk_bf16(y[2] * sigmoidf_(bf_lo(ou.y)), y[3] * sigmoidf_(bf_hi(ou.y)));
                *(u32x2*)(mix + tok * 1024 + col) = w;
            }
        }
#pragma unroll
        for (int c9 = 0; c9 < 8; ++c9) {
            u32x2 w; w.x = pk_bf16(Cacc[c9][0], Cacc[c9][1]); w.y = pk_bf16(Cacc[c9][2], Cacc[c9][3]);
            *(u32x2*)(smem + ML_C + (16 * c9 + fr) * ML_PITCH + (16 * wid + 4 * fq) * 2) = w;
        }
        if (fr == 0) *(f32x4*)(NV + 16 * wid + 4 * fq) = Cacc[8];
        __syncthreads();
    }
}

__device__ void phase3(const Params& p, char* smem, int bid, int nb, int rep = 0) {
    int* qctr = (int*)(p.ws + WS_CNT) + 256 + rep;
    for (int u = bid; u < 64; u += nb) mlstm_scan(p, smem, u >> 2, u & 3);
    volatile int* slot = (volatile int*)(smem + NSA_MISC + 256);
    for (;;) {
        if (opaque_tid() == 0) *slot = atomicAdd(qctr, 1);
        __syncthreads();
        const int k = *slot;
        if (k >= 1024) break;
        nsa_task(p, smem, (k & 31) >> 1, k & 1, 31 - (k >> 5));
    }
}

constexpr int XA_PITCH = 544;
constexpr int XA_K = 0, XA_V = 69632;
__device__ void xattn_task(const Params& p, char* smem, int b, int h, int qb) {
    const char* ws = p.ws;
    int tid = threadIdx.x;
    asm volatile("" : "+v"(tid));
    const int lane = tid & 63, wid = __builtin_amdgcn_readfirstlane(tid >> 6), fr = lane & 15, fq = lane >> 4;
    const bf16_t* XQ = (const bf16_t*)(ws + WS_XQ) + (long)(b * SEQ + qb * 128 + wid * 16 + fr) * 1024 + h * 256 + fq * 8;
    const bf16_t* KV = (const bf16_t*)(ws + WS_KVX) + (long)b * 256 * 2048 + h * 256;
    bf16x8 qf[8];
#pragma unroll
    for (int ks = 0; ks < 8; ++ks) qf[ks] = *(const bf16x8*)(XQ + ks * 32);
    f32x4 O[16];
#pragma unroll
    for (int dt = 0; dt < 16; ++dt) O[dt] = (f32x4){0.f, 0.f, 0.f, 0.f};
    float m = -1e30f, l = 0.f;
    const int lrow = tid >> 5, lch = tid & 31;
    u32x4 rk[4], rv[4];
#pragma unroll
    for (int i2 = 0; i2 < 4; ++i2) {
        const bf16_t* rp = KV + (long)(lrow + 16 * i2) * 2048 + lch * 8;
        rk[i2] = *(const u32x4*)rp; rv[i2] = *(const u32x4*)(rp + 1024);
    }
#pragma unroll
    for (int i2 = 0; i2 < 4; ++i2) {
        *(u32x4*)(smem + XA_K + (lrow + 16 * i2) * XA_PITCH + lch * 16) = rk[i2];
        *(u32x4*)(smem + XA_V + (lrow + 16 * i2) * XA_PITCH + lch * 16) = rv[i2];
    }
    __syncthreads();
#pragma unroll 1
    for (int j = 0; j < 4; ++j) {
        const int buf = j & 1;
        if (j + 1 < 4) {
#pragma unroll
            for (int i2 = 0; i2 < 4; ++i2) {
                const bf16_t* rp = KV + (long)((j + 1) * 64 + lrow + 16 * i2) * 2048 + lch * 8;
                rk[i2] = *(const u32x4*)rp; rv[i2] = *(const u32x4*)(rp + 1024);
            }
        }
        const char* KT = smem + XA_K + buf * 34816;
        const char* VT = smem + XA_V + buf * 34816;
        f32x4 S[4];
#pragma unroll
        for (int nt = 0; nt < 4; ++nt) {
            f32x4 s = (f32x4){0.f, 0.f, 0.f, 0.f};
#pragma unroll
            for (int ks = 0; ks < 8; ++ks) {
                const bf16x8 kf = *(const bf16x8*)(KT + (16 * nt + fr) * XA_PITCH + (ks * 4 + fq) * 16);
                s = mfma16(kf, qf[ks], s);
            }
            S[nt] = s * 0.0625f;
        }
        float mx = -INFINITY;
#pragma unroll
        for (int nt = 0; nt < 4; ++nt)
#pragma unroll
            for (int e = 0; e < 4; ++e) mx = fmaxf(mx, S[nt][e]);
        mx = fmaxf(mx, __shfl_xor(mx, 16)); mx = fmaxf(mx, __shfl_xor(mx, 32));
        const float mnew = fmaxf(m, mx);
        const float alpha = __expf(m - mnew);
        float rs = 0.f;
#pragma unroll
        for (int nt = 0; nt < 4; ++nt)
#pragma unroll
            for (int e = 0; e < 4; ++e) { const float pv = __expf(S[nt][e] - mnew); S[nt][e] = pv; rs += pv; }
        rs += __shfl_xor(rs, 16); rs += __shfl_xor(rs, 32);
        l = l * alpha + rs; m = mnew;
#pragma unroll
        for (int dt = 0; dt < 16; ++dt) O[dt] = O[dt] * alpha;
        const bf16x8 pf0 = pack_p(S[0], S[1]), pf1 = pack_p(S[2], S[3]);
#pragma unroll
        for (int dt = 0; dt < 16; ++dt) {
            O[dt] = mfma16(tr_frag_perm(VT, XA_PITCH, 0, 16 * dt, fr, fq), pf0, O[dt]);
            O[dt] = mfma16(tr_frag_perm(VT, XA_PITCH, 32, 16 * dt, fr, fq), pf1, O[dt]);
        }
        if (j + 1 < 4) {
            char* KTn = smem + XA_K + (buf ^ 1) * 34816; char* VTn = smem + XA_V + (buf ^ 1) * 34816;
#pragma unroll
            for (int i2 = 0; i2 < 4; ++i2) {
                *(u32x4*)(KTn + (lrow + 16 * i2) * XA_PITCH + lch * 16) = rk[i2];
                *(u32x4*)(VTn + (lrow + 16 * i2) * XA_PITCH + lch * 16) = rv[i2];
            }
        }
        __syncthreads();
    }
    const float inv = 1.0f / l;
    bf16_t* op = (bf16_t*)(p.ws + WS_XO) + (long)(b * SEQ + qb * 128 + wid * 16 + fr) * 1024 + h * 256 + fq * 4;
#pragma unroll
    for (int dt = 0; dt < 16; ++dt) {
        u32x2 w; w.x = pk_bf16(O[dt][0] * inv, O[dt][1] * inv); w.y = pk_bf16(O[dt][2] * inv, O[dt][3] * inv);
        *(u32x2*)(op + dt * 16) = w;
    }
}

__device__ void phase6(const Params& p, char* smem, int bid, int nb) {
    for (int t = bid; t < 1024; t += nb) xattn_task(p, smem, t >> 6, (t >> 4) & 3, t & 15);
}

constexpr int LN_ST = 139264, LN_GB = 141312, MOE_TAB = 149504;

__device__ void phase4(const Params& p, char* smem, int bid, int nb) {
    char* ws = p.ws;
    for (int t = bid; t < 512; t += nb) {
        const int mt = t >> 2, nt = t & 3;
        LoadBf16Rows al, bl;
        al.init_contig((const bf16_t*)(ws + WS_MIX), 1024, mt * 256);
        bl.init_contig((const bf16_t*)(ws + WS_WOUT), 1024, nt * 256);
        f32x4 acc[8][4];
        gemm_mainloop(smem, al, bl, 16, acc);
        epi_residual<false>(acc, smem, p.in[I_X], nullptr, nullptr, nullptr, (float*)(ws + WS_R1), (bf16_t*)(ws + WS_R1B), (float*)(ws + WS_ST1), mt * 256, nt);
    }
}

__device__ __forceinline__ void init_ln_loader(LoadLN& al, char* smem, const bf16_t* r, bf16_t* xcopy, int row0) {
    al.raw.init_contig(r, 1024, row0);
    al.xbase = xcopy ? xcopy + (long)row0 * 1024 : nullptr;
    al.st = (const float*)(smem + LN_ST); al.gb = (const float*)(smem + LN_GB);
}

__device__ void phase5(const Params& p, char* smem, int bid, int nb) {
    char* ws = p.ws;
    ln_load_gb((float*)(smem + LN_GB), p.in[I_LN1G], p.in[I_LN1B]);
    for (int t = bid; t < 512; t += nb) {
        const int mt = t >> 2, nt = t & 3;
        ln_tile_stats((float*)(smem + LN_ST), (const float*)(ws + WS_ST1), mt * 256);
        __syncthreads();
        LoadLN al; LoadBf16Rows bl;
        init_ln_loader(al, smem, (const bf16_t*)(ws + WS_R1B), nullptr, mt * 256);
        bl.init_contig((const bf16_t*)(ws + WS_WQ), 1024, nt * 256);
        f32x4 acc[8][4];
        gemm_mainloop(smem, al, bl, 16, acc);
        epi_store_bf16(acc, (bf16_t*)(ws + WS_XQ), 1024, mt * 256, nt * 256);
    }
}

__device__ void phase7(const Params& p, char* smem, int bid, int nb) {
    char* ws = p.ws;
    for (int t = bid; t < 512; t += nb) {
        const int mt = t >> 2, nt = t & 3;
        LoadBf16Rows al, bl;
        al.init_contig((const bf16_t*)(ws + WS_XO), 1024, mt * 256);
        bl.init_contig((const bf16_t*)(ws + WS_WO), 1024, nt * 256);
        f32x4 acc[8][4];
        gemm_mainloop(smem, al, bl, 16, acc);
        epi_residual<true>(acc, smem, (const float*)(ws + WS_R1), (const float*)(ws + WS_ST1), p.in[I_LN1G], p.in[I_LN1B],
                           (float*)(ws + WS_R2), (bf16_t*)(ws + WS_R2B), (float*)(ws + WS_ST2), mt * 256, nt);
    }
}

template <class RowMap>
__device__ __forceinline__ void epi_swiglu(const f32x4 (&acc)[8][4], bf16_t* out, int ld, int nt, const RowMap& rm) {
    const int tid_ = opaque_tid();
    const int lane = tid_ & 63, wid = tid_ >> 6;
    const int wr = wid >> 2, wc = wid & 3, fr = lane & 15, fq = lane >> 4;
#pragma unroll
    for (int mi = 0; mi < 8; ++mi) {
        const long orow = rm(wr * 128 + mi * 16 + fr);
        if (orow >= 0) {
            bf16_t* rp = out + orow * ld + nt * 128 + wc * 32 + fq * 4;
#pragma unroll
            for (int q = 0; q < 2; ++q) {
                const f32x4 a = acc[mi][2 * q], b = acc[mi][2 * q + 1];
                u32x2 w; w.x = pk_bf16(siluf_(a[0]) * b[0], siluf_(a[1]) * b[1]); w.y = pk_bf16(siluf_(a[2]) * b[2], siluf_(a[3]) * b[3]);
                *(u32x2*)(rp + q * 16) = w;
            }
        }
    }
}
struct RowIdent { long row0; __device__ __forceinline__ long operator()(int rl) const { return row0 + rl; } };

__device__ void route_half(const Params& p, char* smem, int tok0) {
    char* ws = p.ws;
    float* sc = (float*)smem;
    int* se = (int*)(sc + 128 * 257);
    float* sw = sc + 128 * 257 + 1024;
    const float* bias = p.in[I_ROUTB];
    const int tid = opaque_tid(), tk = tid >> 2, q = tid & 3;
    float* row = sc + tk * 257;
    float gs0, gs1;
    {
        float a1 = -INFINITY, a2 = -INFINITY, b1 = -INFINITY, b2 = -INFINITY;
#pragma unroll 4
        for (int i = 0; i < 32; ++i) {
            const int ii = (i + 8 * q) & 31;
            const float v = row[64 * q + ii], w = row[64 * q + 32 + ii];
            if (v > a1) { a2 = a1; a1 = v; } else if (v > a2) a2 = v;
            if (w > b1) { b2 = b1; b1 = w; } else if (w > b2) b2 = w;
        }
        gs0 = a1 + a2; gs1 = b1 + b2;
    }
    const int lbase = (tid & 63) & ~3;
    float g8[8];
#pragma unroll
    for (int k = 0; k < 4; ++k) { g8[2 * k] = __shfl(gs0, lbase + k); g8[2 * k + 1] = __shfl(gs1, lbase + k); }
    unsigned gsel = 0u;
#pragma unroll
    for (int a = 0; a < 8; ++a) {
        int rank = 0;
#pragma unroll
        for (int b = 0; b < 8; ++b) rank += (g8[b] > g8[a] || (g8[b] == g8[a] && b < a)) ? 1 : 0;
        if (rank < 4) gsel |= 1u << a;
    }
    const bool on0 = ((gsel >> (2 * q)) & 1u) != 0u, on1 = ((gsel >> (2 * q + 1)) & 1u) != 0u;
    float wsum = 0.f;
#pragma unroll 1
    for (int r = 0; r < 8; ++r) {
        float bv = -INFINITY; int bi = 1 << 30;
        if (on0) {
#pragma unroll 4
            for (int i = 0; i < 32; ++i) { const int idx = 64 * q + ((i + 8 * q) & 31); const float v = row[idx]; if (v > bv || (v == bv && idx < bi)) { bv = v; bi = idx; } }
        }
        if (on1) {
#pragma unroll 4
            for (int i = 0; i < 32; ++i) { const int idx = 64 * q + 32 + ((i + 8 * q) & 31); const float v = row[idx]; if (v > bv || (v == bv && idx < bi)) { bv = v; bi = idx; } }
        }
#pragma unroll
        for (int off = 1; off <= 2; off <<= 1) {
            const float ov = __shfl_xor(bv, off); const int oi = __shfl_xor(bi, off);
            if (ov > bv || (ov == bv && oi < bi)) { bv = ov; bi = oi; }
        }
        bi &= 255;
        const float s = bv - bias[bi];
        wsum += s;
        if ((bi >> 6) == q) row[bi] = -INFINITY;
        if (q == 0) { se[tk * 8 + r] = bi; sw[tk * 8 + r] = s; }
    }
    __syncthreads();
    {
        int* cnt = (int*)(ws + WS_CNT);
        const long t = tok0 + tk;
#pragma unroll
        for (int u = 0; u < 2; ++u) {
            const int k = 2 * q + u;
            const int e = se[tk * 8 + k];
            const float w = sw[tk * 8 + k] / wsum * 2.5f;
            const int pos = atomicAdd(cnt + e, 1);
            ((int*)(ws + WS_SELE))[t * 8 + k] = e;
            ((int*)(ws + WS_SELP))[t * 8 + k] = pos;
            ((float*)(ws + WS_SELW))[t * 8 + k] = w;
            ((int*)(ws + WS_TOKL))[(long)e * LIST_CAP + pos] = (int)t;
            ((float*)(ws + WS_WL))[(long)e * LIST_CAP + pos] = w;
        }
    }
    __syncthreads();
}

__device__ void phase8(const Params& p, char* smem, int bid, int nb) {
    char* ws = p.ws;
    ln_load_gb((float*)(smem + LN_GB), p.in[I_LN2G], p.in[I_LN2B]);
    for (int mt = bid; mt < 128; mt += nb) {
        ln_tile_stats((float*)(smem + LN_ST), (const float*)(ws + WS_ST2), mt * 256);
        __syncthreads();
        float* gsc = (float*)(ws + WS_RSC);
        {
            LoadLN al; LoadBf16Rows bl;
            init_ln_loader(al, smem, (const bf16_t*)(ws + WS_R2B), (bf16_t*)(ws + WS_X2), mt * 256);
            bl.init_contig((const bf16_t*)(ws + WS_WR), 1024, 0);
            f32x4 acc[8][4];
            gemm_mainloop(smem, al, bl, 16, acc);
            const int tid_ = opaque_tid();
            const int lane = tid_ & 63, wid = tid_ >> 6;
            const int wr = wid >> 2, wc = wid & 3, fr = lane & 15, fq = lane >> 4;
            const float* bias = p.in[I_ROUTB];
#pragma unroll
            for (int ni = 0; ni < 4; ++ni) {
                const int col = wc * 64 + ni * 16 + fq * 4;
                const f32x4 bv = *(const f32x4*)(bias + col);
#pragma unroll
                for (int mi = 0; mi < 8; ++mi) {
                    f32x4 v;
#pragma unroll
                    for (int e = 0; e < 4; ++e) v[e] = sigmoidf_(acc[mi][ni][e]) + bv[e];
                    *(f32x4*)(gsc + (long)(mt * 256 + wr * 128 + mi * 16 + fr) * 256 + col) = v;
                }
            }
        }
        __syncthreads();
#pragma unroll 1
        for (int half = 0; half < 2; ++half) {
            float* sc = (float*)smem;
            for (int e4 = opaque_tid(); e4 < 128 * 64; e4 += NTHR) {
                const int r = e4 >> 6, c4 = (e4 & 63) * 4;
                const f32x4 v = *(const f32x4*)(gsc + (long)(mt * 256 + half * 128 + r) * 256 + c4);
                sc[r * 257 + c4] = v[0]; sc[r * 257 + c4 + 1] = v[1]; sc[r * 257 + c4 + 2] = v[2]; sc[r * 257 + c4 + 3] = v[3];
            }
            __syncthreads();
            route_half(p, smem, mt * 256 + half * 128);
        }
    }
    for (int t = (bid + nb - 128 % nb) % nb; t < 256; t += nb) {
        const int mt = t >> 1, nt = t & 1;
        ln_tile_stats((float*)(smem + LN_ST), (const float*)(ws + WS_ST2), mt * 256);
        __syncthreads();
        LoadLN al; LoadBf16Rows bl;
        init_ln_loader(al, smem, (const bf16_t*)(ws + WS_R2B), nullptr, mt * 256);
        bl.init_contig((const bf16_t*)(ws + WS_WS13), 1024, nt * 256);
        f32x4 acc[8][4];
        gemm_mainloop(smem, al, bl, 16, acc);
        RowIdent rm; rm.row0 = (long)mt * 256;
        epi_swiglu(acc, (bf16_t*)(ws + WS_HS), 256, nt, rm);
    }
}

__device__ __forceinline__ void moe_tables(const Params& p, char* smem) {
    int* off = (int*)(smem + MOE_TAB); int* tst = off + 256;
    const int* cnt = (const int*)(p.ws + WS_CNT);
    const int tid = opaque_tid();
    if (tid < 64) {
        int c[4], tl[4], cs = 0, ts = 0;
#pragma unroll
        for (int k = 0; k < 4; ++k) { c[k] = cnt[tid * 4 + k]; tl[k] = (c[k] + 255) >> 8; cs += c[k]; ts += tl[k]; }
        int ics = cs, its = ts;
#pragma unroll
        for (int o = 1; o < 64; o <<= 1) { const int a = __shfl_up(ics, o), b = __shfl_up(its, o); if (tid >= o) { ics += a; its += b; } }
        int eo = ics - cs, et = its - ts;
#pragma unroll
        for (int k = 0; k < 4; ++k) { off[tid * 4 + k] = eo; tst[tid * 4 + k] = et; eo += c[k]; et += tl[k]; }
        if (tid == 63) tst[256] = its;
    }
    __syncthreads();
}
__device__ __forceinline__ int moe_find(const int* tst, int t) {
    int lo = 0, hi = 255;
#pragma unroll 1
    while (lo < hi) { const int mid = (lo + hi + 1) >> 1; if (tst[mid] <= t) lo = mid; else hi = mid - 1; }
    return lo;
}
struct RowMoe { long base; int nvalid; __device__ __forceinline__ long operator()(int rl) const { return rl < nvalid ? base + rl : -1; } };

__device__ void phase9(const Params& p, char* smem, int bid, int nb) {
    char* ws = p.ws;
    moe_tables(p, smem);
    const int* off = (const int*)(smem + MOE_TAB); const int* tst = off + 256;
    const int* cnt = (const int*)(ws + WS_CNT);
    const int ntile = tst[256];
    for (int t = bid; t < ntile * 2; t += nb) {
        const int et = t >> 1, nt = t & 1;
        const int e = moe_find(tst, et), m0 = (et - tst[e]) * 256, ne = cnt[e];
        const int tid = opaque_tid();
        LoadBf16Rows al; LoadF32KN bl;
        {
            const int* tl = (const int*)(ws + WS_TOKL) + (long)e * LIST_CAP;
            int rows[4];
#pragma unroll
            for (int i = 0; i < 4; ++i) { const int r = m0 + (tid >> 3) + 64 * i; rows[i] = r < ne ? tl[r] : 0; }
            al.init_rows((const bf16_t*)(ws + WS_X2), 1024, rows);
        }
        {
            const int n = tid & 255, kh = tid >> 8;
            const int col = 128 * nt + 16 * (n >> 5) + (n & 15);
            const float* w = ((n >> 4) & 1) ? p.in[I_MW3] : p.in[I_MW1];
            bl.p = w + (long)e * 1024 * 256 + col + (long)(kh * 32) * 256; bl.ldn = 256; bl.n = n; bl.kh = kh;
        }
        f32x4 acc[8][4];
        gemm_mainloop(smem, al, bl, 16, acc);
        RowMoe rm; rm.base = (long)off[e] + m0; rm.nvalid = ne - m0;
        epi_swiglu(acc, (bf16_t*)(ws + WS_H), 256, nt, rm);
    }
    for (int t = (bid + nb - (ntile * 2) % nb) % nb; t < 512; t += nb) {
        const int mt = t >> 2, nt = t & 3;
        LoadBf16Rows al, bl;
        al.init_contig((const bf16_t*)(ws + WS_HS), 256, mt * 256);
        bl.init_contig((const bf16_t*)(ws + WS_WS2), 256, nt * 256);
        f32x4 acc[8][4];
        gemm_mainloop(smem, al, bl, 4, acc);
        epi_store_bf16(acc, (bf16_t*)(ws + WS_SH), 1024, mt * 256, nt * 256);
    }
}

__device__ void phase10(const Params& p, char* smem, int bid, int nb) {
    char* ws = p.ws;
    moe_tables(p, smem);
    const int* off = (const int*)(smem + MOE_TAB); const int* tst = off + 256;
    const int* cnt = (const int*)(ws + WS_CNT);
    const int ntile = tst[256];
    for (int t = bid; t < ntile * 4; t += nb) {
        const int et = t >> 2, nt = t & 3;
        const int e = moe_find(tst, et), m0 = (et - tst[e]) * 256, ne = cnt[e];
        const int tid = opaque_tid();
        LoadBf16Rows al; LoadF32KN bl;
        al.init_contig((const bf16_t*)(ws + WS_H), 256, off[e] + m0);
        {
            const int n = tid & 255, kh = tid >> 8;
            bl.p = p.in[I_MW2] + (long)e * 256 * 1024 + nt * 256 + n + (long)(kh * 32) * 1024; bl.ldn = 1024; bl.n = n; bl.kh = kh;
        }
        f32x4 acc[8][4];
        gemm_mainloop(smem, al, bl, 4, acc);
        {
            const int tid2 = opaque_tid();
            const int lane = tid2 & 63, wid = tid2 >> 6;
            const int wr = wid >> 2, wc = wid & 3, fr = lane & 15, fq = lane >> 4;
            const float* wl = (const float*)(ws + WS_WL) + (long)e * LIST_CAP + m0;
            bf16_t* Y = (bf16_t*)(ws + WS_Y) + ((long)off[e] + m0) * 1024 + nt * 256 + wc * 64 + fq * 4;
#pragma unroll
            for (int mi = 0; mi < 8; ++mi) {
                const int rl = wr * 128 + mi * 16 + fr;
                if (m0 + rl < ne) {
                    const float w = wl[rl];
#pragma unroll
                    for (int ni = 0; ni < 4; ++ni) {
                        u32x2 v; v.x = pk_bf16(acc[mi][ni][0] * w, acc[mi][ni][1] * w); v.y = pk_bf16(acc[mi][ni][2] * w, acc[mi][ni][3] * w);
                        *(u32x2*)(Y + (long)rl * 1024 + ni * 16) = v;
                    }
                }
            }
        }
    }
}

__device__ void phase11(const Params& p, char* smem, int bid, int nb) {
    char* ws = p.ws;
    moe_tables(p, smem);
    const int* off = (const int*)(smem + MOE_TAB);
    const int tid = opaque_tid(), lane = tid & 63, wid = tid >> 6;
    const float* r2 = (const float*)(ws + WS_R2);
    const float* st2 = (const float*)(ws + WS_ST2);
    const bf16_t* SH = (const bf16_t*)(ws + WS_SH);
    const bf16_t* Y = (const bf16_t*)(ws + WS_Y);
    const int* sele = (const int*)(ws + WS_SELE); const int* selp = (const int*)(ws + WS_SELP);
    for (int t = bid * 8 + wid; t < T_TOK; t += nb * 8) {
        const f32x4 p0 = *(const f32x4*)(st2 + (long)t * 8), p1 = *(const f32x4*)(st2 + (long)t * 8 + 4);
        const float q1 = (p0[0] + p0[2]) + (p1[0] + p1[2]), q2 = (p0[1] + p0[3]) + (p1[1] + p1[3]);
        const float mean2 = q1 * (1.0f / 1024.0f);
        const float rstd2 = rsqrtf(fmaxf(q2 * (1.0f / 1024.0f) - mean2 * mean2, 0.f) + LN_EPS);
        int yrow[8];
#pragma unroll
        for (int k = 0; k < 8; ++k) yrow[k] = off[sele[(long)t * 8 + k]] + selp[(long)t * 8 + k];
        float v[16];
#pragma unroll
        for (int hseg = 0; hseg < 2; ++hseg) {
            const int col = hseg * 512 + lane * 8;
            const f32x4 a0 = *(const f32x4*)(r2 + (long)t * 1024 + col), a1 = *(const f32x4*)(r2 + (long)t * 1024 + col + 4);
            const f32x4 g0 = *(const f32x4*)(p.in[I_LN2G] + col), g1 = *(const f32x4*)(p.in[I_LN2G] + col + 4);
            const f32x4 b0 = *(const f32x4*)(p.in[I_LN2B] + col), b1 = *(const f32x4*)(p.in[I_LN2B] + col + 4);
            const f32x4 x0 = ((a0 - mean2) * rstd2 * g0 + b0) * ALPHA, x1 = ((a1 - mean2) * rstd2 * g1 + b1) * ALPHA;
            float* vv = v + hseg * 8;
            vv[0] = x0[0]; vv[1] = x0[1]; vv[2] = x0[2]; vv[3] = x0[3]; vv[4] = x1[0]; vv[5] = x1[1]; vv[6] = x1[2]; vv[7] = x1[3];
            const u32x4 s = *(const u32x4*)(SH + (long)t * 1024 + col);
            vv[0] += bf_lo(s.x); vv[1] += bf_hi(s.x); vv[2] += bf_lo(s.y); vv[3] += bf_hi(s.y); vv[4] += bf_lo(s.z); vv[5] += bf_hi(s.z); vv[6] += bf_lo(s.w); vv[7] += bf_hi(s.w);
#pragma unroll
            for (int k = 0; k < 8; ++k) {
                const u32x4 y = *(const u32x4*)(Y + (long)yrow[k] * 1024 + col);
                vv[0] += bf_lo(y.x); vv[1] += bf_hi(y.x); vv[2] += bf_lo(y.y); vv[3] += bf_hi(y.y); vv[4] += bf_lo(y.z); vv[5] += bf_hi(y.z); vv[6] += bf_lo(y.w); vv[7] += bf_hi(y.w);
            }
        }
        float s1 = 0.f;
#pragma unroll
        for (int i = 0; i < 16; ++i) s1 += v[i];
#pragma unroll
        for (int o = 32; o >= 1; o >>= 1) s1 += __shfl_xor(s1, o);
        const float mean = s1 * (1.0f / 1024.0f);
        float s2 = 0.f;
#pragma unroll
        for (int i = 0; i < 16; ++i) { const float d = v[i] - mean; s2 += d * d; }
#pragma unroll
        for (int o = 32; o >= 1; o >>= 1) s2 += __shfl_xor(s2, o);
        const float rstd = rsqrtf(s2 * (1.0f / 1024.0f) + LN_EPS);
#pragma unroll
        for (int hseg = 0; hseg < 2; ++hseg) {
            const int col = hseg * 512 + lane * 8;
            const f32x4 g0 = *(const f32x4*)(p.in[I_LN3G] + col), g1 = *(const f32x4*)(p.in[I_LN3G] + col + 4);
            const f32x4 b0 = *(const f32x4*)(p.in[I_LN3B] + col), b1 = *(const f32x4*)(p.in[I_LN3B] + col + 4);
            const float* vv = v + hseg * 8;
            f32x4 o0, o1;
#pragma unroll
            for (int e = 0; e < 4; ++e) { o0[e] = (vv[e] - mean) * rstd * g0[e] + b0[e]; o1[e] = (vv[4 + e] - mean) * rstd * g1[e] + b1[e]; }
            *(f32x4*)(p.out + (long)t * 1024 + col) = o0; *(f32x4*)(p.out + (long)t * 1024 + col + 4) = o1;
        }
    }
}

#if MEGA
#define XB_TMO      128
#define XB_XCNT(j)  (256  + 64 * (j))
#define XB_XSUB(j)  (1280 + 64 * (j))
#define XB_XGEN(j)  (2304 + 64 * (j))
#define XB_TOP      3328
#define XB_TOPGEN   3392
#define XCD_BAR_WORDS 3456
#define XB_SPIN_CAP (1u << 22)
#define LAS __attribute__((address_space(3)))
__device__ __forceinline__ unsigned xb_ld(unsigned* p)              { return __hip_atomic_load(p, __ATOMIC_RELAXED, __HIP_MEMORY_SCOPE_AGENT); }
__device__ __forceinline__ unsigned xb_add(unsigned* p, unsigned v) { return __hip_atomic_fetch_add(p, v, __ATOMIC_RELAXED, __HIP_MEMORY_SCOPE_AGENT); }
__device__ __forceinline__ unsigned xb_xcc_id() { return (unsigned)__builtin_amdgcn_s_getreg((3 << 11) | 20) & 0xFu; }
#define XB_SPIN(cond, bar) do { unsigned _sp = 0; while (cond) { __builtin_amdgcn_s_sleep(1); \
    if ((++_sp & 255u) == 0u) { if (xb_ld(&(bar)[XB_TMO])) break; if (_sp > XB_SPIN_CAP) { atomicAdd(&(bar)[XB_TMO], 1u); break; } } } } while (0)
struct XcdBarrier { unsigned* bar; unsigned x; volatile LAS unsigned* st; };
__device__ __forceinline__ XcdBarrier xcd_barrier_post(unsigned* bar, volatile LAS unsigned* st) {
    XcdBarrier b; b.bar = bar; b.x = xb_xcc_id(); b.st = st;
    if (threadIdx.x == 0) (void)xb_add(&bar[XB_XCNT(b.x)], 1u);
    return b;
}
__device__ __forceinline__ void xcd_barrier_complete(unsigned* bar, unsigned x, unsigned& nloc, unsigned& nx) {
    const unsigned G = gridDim.x * gridDim.y * gridDim.z;
    unsigned sum, cnt, mine, sp = 0u;
    for (;;) {
        sum = 0u; cnt = 0u; mine = 0u;
#pragma unroll
        for (unsigned j = 0; j < 16; ++j) { const unsigned c = xb_ld(&bar[XB_XCNT(j)]); sum += c; cnt += (c > 0u) ? 1u : 0u; mine = (j == x) ? c : mine; }
        if (sum == G) break;
        __builtin_amdgcn_s_sleep(1);
        if ((++sp & 255u) == 0u) { if (xb_ld(&bar[XB_TMO])) break; if (sp > XB_SPIN_CAP) { atomicAdd(&bar[XB_TMO], 1u); break; } }
    }
    nloc = mine > 0u ? mine : 1u; nx = cnt > 0u ? cnt : 1u;
}
__device__ __forceinline__ void xcd_barrier(const XcdBarrier& b) {
    asm volatile("s_waitcnt vmcnt(0)" ::: "memory");
    __syncthreads();
    if (threadIdx.x == 0) {
        unsigned* bar = b.bar;
        __builtin_amdgcn_s_waitcnt(0);
        unsigned nloc = b.st[0], nx = b.st[1];
        if (nloc == 0u) { xcd_barrier_complete(bar, b.x, nloc, nx); b.st[0] = nloc; b.st[1] = nx; }
        const unsigned old = xb_add(&bar[XB_XSUB(b.x)], 1u);
        const unsigned gen = old / nloc;
        if (old + 1u == (gen + 1u) * nloc) {
            __builtin_amdgcn_fence(__ATOMIC_RELEASE, "agent");
            asm volatile("s_waitcnt vmcnt(0)" ::: "memory");
            const unsigned og = xb_add(&bar[XB_TOP], 1u);
            const unsigned tg = og / nx;
            if (og + 1u == (tg + 1u) * nx) xb_add(&bar[XB_TOPGEN], 1u);
            else XB_SPIN(xb_ld(&bar[XB_TOPGEN]) == tg, bar);
            __builtin_amdgcn_fence(__ATOMIC_ACQUIRE, "agent");
            xb_add(&bar[XB_XGEN(b.x)], 1u);
            asm volatile("s_waitcnt vmcnt(0)" ::: "memory");
        } else {
            XB_SPIN(xb_ld(&bar[XB_XGEN(b.x)]) == gen, bar);
            __builtin_amdgcn_fence(__ATOMIC_ACQUIRE, "agent");
            asm volatile("s_waitcnt vmcnt(0)" ::: "memory");
        }
    }
    __syncthreads();
}
__global__ void __launch_bounds__(NTHR) fwd_mega(Params p) {
    extern __shared__ __attribute__((aligned(16))) char smem[];
    cg::grid_group grid = cg::this_grid();
    const int bid = blockIdx.x, nb = gridDim.x;
    volatile LAS unsigned* xst = (volatile LAS unsigned*)(smem + LDS_BYTES - 16);
    if (threadIdx.x < 4) xst[threadIdx.x] = 0u;
    __syncthreads();
    const XcdBarrier xb = xcd_barrier_post((unsigned*)(p.ws + WS_BAR), xst);
#define GSYNC() xcd_barrier(xb)
#ifndef PROBE_REPEAT
#define PROBE_REPEAT 0
#endif
#define REP(n, call) if (PROBE_REPEAT & (1 << n)) { call; GSYNC(); }
    phase0(p, smem, bid, nb);  grid.sync();
    REP(1, phase1(p, smem, bid, nb))
    phase1(p, smem, bid, nb);  GSYNC();
    REP(2, phase2(p, smem, bid, nb))
    phase2(p, smem, bid, nb);  GSYNC();
    REP(3, phase3(p, smem, bid, nb, 1))
    phase3(p, smem, bid, nb);  GSYNC();
    REP(4, phase4(p, smem, bid, nb))
    phase4(p, smem, bid, nb);  GSYNC();
    REP(5, phase5(p, smem, bid, nb))
    phase5(p, smem, bid, nb);  GSYNC();
    REP(6, phase6(p, smem, bid, nb))
    phase6(p, smem, bid, nb);  GSYNC();
    REP(7, phase7(p, smem, bid, nb))
    phase7(p, smem, bid, nb);  GSYNC();
    phase8(p, smem, bid, nb);  GSYNC();
    REP(9, phase9(p, smem, bid, nb))
    phase9(p, smem, bid, nb);  GSYNC();
    REP(10, phase10(p, smem, bid, nb))
    phase10(p, smem, bid, nb); GSYNC();
    REP(11, phase11(p, smem, bid, nb))
    phase11(p, smem, bid, nb);
}
#else
#define PHASE_KERNEL(n) __global__ void __launch_bounds__(NTHR) fwd_phase##n(Params p) { extern __shared__ __attribute__((aligned(16))) char smem[]; phase##n(p, smem, blockIdx.x, gridDim.x); }
PHASE_KERNEL(0) PHASE_KERNEL(1) PHASE_KERNEL(2) PHASE_KERNEL(3) PHASE_KERNEL(4) PHASE_KERNEL(5)
PHASE_KERNEL(6) PHASE_KERNEL(7) PHASE_KERNEL(8) PHASE_KERNEL(9) PHASE_KERNEL(10) PHASE_KERNEL(11)
typedef void (*phase_fn)(Params);
#endif

extern "C" void kernel_launch(void* const* d_in, const int* in_sizes, int n_in, void* d_out, int out_size, void* d_ws, size_t ws_size, hipStream_t stream) {
    Params p{};
    for (int i = 0; i < 32; ++i) p.in[i] = (const float*)d_in[i];
    p.out = (float*)d_out;
    p.ws = (char*)d_ws;
    if (n_in != 32 || ws_size < WS_END) { fprintf(stderr, "kernel_launch: unexpected inputs (n_in %d) or workspace too small (%zu < %zu)\n", n_in, ws_size, (size_t)WS_END); return; }
#if MEGA
    static int grid = 0;
    if (!grid) {
        int dev = 0, cus = 0, per_cu = 0;
        (void)hipGetDevice(&dev);
        (void)hipDeviceGetAttribute(&cus, hipDeviceAttributeMultiprocessorCount, dev);
        (void)hipFuncSetAttribute((const void*)fwd_mega, hipFuncAttributeMaxDynamicSharedMemorySize, LDS_BYTES);
        (void)hipOccupancyMaxActiveBlocksPerMultiprocessor(&per_cu, (const void*)fwd_mega, NTHR, LDS_BYTES);
        if (per_cu < 1) { fprintf(stderr, "kernel_launch: occupancy query says %d blocks/CU\n", per_cu); per_cu = 1; }
        grid = cus;
    }
    (void)hipMemsetAsync((char*)d_ws + WS_BAR, 0, 16384, stream);
    void* args[] = {&p};
    hipError_t e = hipLaunchCooperativeKernel((const void*)fwd_mega, dim3(grid), dim3(NTHR), args, LDS_BYTES, stream);
    if (e != hipSuccess) fprintf(stderr, "cooperative launch failed: %s (grid %d)\n", hipGetErrorString(e), grid);
#else
    static const phase_fn fns[12] = {fwd_phase0, fwd_phase1, fwd_phase2, fwd_phase3, fwd_phase4, fwd_phase5, fwd_phase6, fwd_phase7, fwd_phase8, fwd_phase9, fwd_phase10, fwd_phase11};
    static bool attr = false;
    if (!attr) { for (int i = 0; i < 12; ++i) (void)hipFuncSetAttribute((const void*)fns[i], hipFuncAttributeMaxDynamicSharedMemorySize, LDS_BYTES); attr = true; }
    for (int i = 0; i < 12; ++i) hipLaunchKernelGGL(fns[i], dim3(256), dim3(NTHR), LDS_BYTES, stream, p);
#endif
}
```

```cpp
#include <hip/hip_runtime.h>
#include <hip/hip_cooperative_groups.h>
#include <stdint.h>
#include <stdio.h>
namespace cg = cooperative_groups;

#ifndef MEGA
#define MEGA 1
#endif

typedef unsigned short bf16_t;
typedef short bf16x8 __attribute__((ext_vector_type(8)));
typedef short s16x4 __attribute__((ext_vector_type(4)));
typedef float f32x4 __attribute__((ext_vector_type(4)));
typedef float f32x2 __attribute__((ext_vector_type(2)));
typedef unsigned u32x4 __attribute__((ext_vector_type(4)));
typedef unsigned u32x2 __attribute__((ext_vector_type(2)));
typedef __bf16 bf16x2_t __attribute__((ext_vector_type(2)));

constexpr int T_TOK = 32768, DM = 1024, NB = 16, SEQ = 2048;
constexpr int PW = 3328;
constexpr int PC_Q = 0, PC_KC = 512, PC_VC = 640, PC_KS = 768, PC_VS = 896, PC_KW = 1024, PC_VW = 1152;
constexpr int PC_MQ = 1280, PC_MK = 1792, PC_MV = 2304, PC_MO = 2816;
constexpr float ALPHA = 1.189207115002721f;
constexpr float LN_EPS = 1e-5f;
constexpr int NTHR = 512;
constexpr int LDS_BYTES = 160 * 1024;
constexpr int NEXP = 256, TOPK = 8;
constexpr int LIST_CAP = 32768;

constexpr size_t al256(size_t x) { return (x + 255) & ~(size_t)255; }
constexpr size_t WS_WIN = 0;
constexpr size_t WS_WOUT = WS_WIN + al256((size_t)3360 * 1024 * 2);
constexpr size_t WS_WQ = WS_WOUT + (size_t)1024 * 1024 * 2;
constexpr size_t WS_WKV = WS_WQ + (size_t)1024 * 1024 * 2;
constexpr size_t WS_WO = WS_WKV + (size_t)2048 * 1024 * 2;
constexpr size_t WS_WR = WS_WO + (size_t)1024 * 1024 * 2;
constexpr size_t WS_WS13 = WS_WR + (size_t)256 * 1024 * 2;
constexpr size_t WS_WS2 = WS_WS13 + (size_t)512 * 1024 * 2;
constexpr size_t WS_CK1 = WS_WS2 + (size_t)1024 * 256 * 2;
constexpr size_t WS_CK2 = WS_CK1 + (size_t)64 * 2048 * 2;
constexpr size_t WS_CV1 = WS_CK2 + (size_t)64 * 64 * 2;
constexpr size_t WS_CV2 = WS_CV1 + (size_t)64 * 2048 * 2;
constexpr size_t MB = 1024 * 1024;
constexpr size_t WS_A = al256(WS_CV2 + (size_t)64 * 64 * 2 + 65536);
constexpr size_t WS_P = WS_A;
constexpr size_t WS_R1 = WS_A;
constexpr size_t WS_XQ = WS_A + 128 * MB;
constexpr size_t WS_XO = WS_A + 192 * MB;
constexpr size_t WS_XB = WS_A + 208 * MB;
constexpr size_t WS_MEMB = WS_A + 272 * MB;
constexpr size_t WS_PSM = WS_A + 280 * MB;
constexpr size_t WS_KCMP = WS_A + 284 * MB;
constexpr size_t WS_VCMP = WS_KCMP + (size_t)16 * 2 * 128 * 64 * 2;
constexpr size_t WS_QK = WS_A + 285 * MB;
constexpr size_t WS_MIX = WS_A + 349 * MB;
constexpr size_t WS_KVX = WS_A + 413 * MB;
constexpr size_t WS_X2 = WS_A + 256 * MB;
constexpr size_t WS_HS = WS_A + 320 * MB;
constexpr size_t WS_R1B = WS_A + 208 * MB;
constexpr size_t WS_R2B = WS_A + 128 * MB;
constexpr size_t WS_RSC = WS_A;
constexpr size_t WS_Y = WS_A;
constexpr size_t WS_B = WS_A + al256((size_t)(T_TOK * 8 + 256) * 1024 * 2);
constexpr size_t WS_R2 = WS_B;
constexpr size_t WS_ST1 = WS_R2 + (size_t)T_TOK * 1024 * 4;
constexpr size_t WS_ST2 = WS_ST1 + (size_t)T_TOK * 8 * 4;
constexpr size_t WS_SH = WS_ST2 + (size_t)T_TOK * 8 * 4;
constexpr size_t WS_SELE = WS_SH + (size_t)T_TOK * 1024 * 2;
constexpr size_t WS_SELP = WS_SELE + (size_t)T_TOK * 8 * 4;
constexpr size_t WS_SELW = WS_SELP + (size_t)T_TOK * 8 * 4;
constexpr size_t WS_CNT = WS_SELW + (size_t)T_TOK * 8 * 4;
constexpr size_t WS_TOKL = WS_CNT + 98304;
constexpr size_t WS_WL = WS_TOKL + (size_t)NEXP * LIST_CAP * 4;
constexpr size_t WS_H = WS_WL + (size_t)NEXP * LIST_CAP * 4;
constexpr size_t WS_BAR = WS_H + (size_t)(T_TOK * 8 + 256) * 256 * 2;
constexpr size_t WS_END = WS_BAR + 16384;
static_assert((size_t)T_TOK * PW * 2 <= 208 * MB, "P region");
static_assert(WS_END <= (size_t)1024 * MB, "workspace must fit 1 GiB");

struct Params {
    const float* in[32];
    float* out;
    char* ws;
};

__device__ __forceinline__ unsigned pk_bf16(float lo, float hi) {
    f32x2 v = {lo, hi};
    bf16x2_t r = __builtin_convertvector(v, bf16x2_t);
    return __builtin_bit_cast(unsigned, r);
}
__device__ __forceinline__ float bf_lo(unsigned u) { return __uint_as_float(u << 16); }
__device__ __forceinline__ float bf_hi(unsigned u) { return __uint_as_float(u & 0xffff0000u); }
__device__ __forceinline__ float bf2f(bf16_t h) { return __uint_as_float(((unsigned)h) << 16); }
__device__ __forceinline__ float sigmoidf_(float x) { return 1.0f / (1.0f + __expf(-x)); }
__device__ __forceinline__ float siluf_(float x) { return x / (1.0f + __expf(-x)); }
__device__ __forceinline__ f32x4 mfma16(bf16x8 a, bf16x8 b, f32x4 c) { return __builtin_amdgcn_mfma_f32_16x16x32_bf16(a, b, c, 0, 0, 0); }
__device__ __forceinline__ bf16x8 as_bf16x8(u32x4 v) { return __builtin_bit_cast(bf16x8, v); }

__device__ __forceinline__ int opaque_tid() { int t = threadIdx.x; asm volatile("" : "+v"(t)); return t; }

__device__ __forceinline__ int tile_off(int row, int chunk) { return row * 128 + ((chunk ^ (row & 7)) << 4); }

__device__ __forceinline__ int bperm(int rho) { return (rho & ~31) + 8 * ((rho >> 2) & 3) + 4 * ((rho >> 4) & 1) + (rho & 3); }

typedef __attribute__((address_space(3))) unsigned lds_u32;
typedef __attribute__((address_space(1))) const unsigned glb_u32;

struct LoadBf16Rows {
    const bf16_t* base;
    unsigned off[4];
    int ldst;
    struct Regs { int dummy; };
    __device__ __forceinline__ void init_contig(const bf16_t* b, int ld, int row0) {
        const int tid_ = opaque_tid();
        const int r8 = tid_ >> 3, kc = (tid_ & 7) ^ (r8 & 7);
        ldst = tid_ * 16;
        base = b + (long)row0 * ld;
#pragma unroll
        for (int i = 0; i < 4; ++i) off[i] = (unsigned)((r8 + 64 * i) * ld + kc * 8);
    }
    __device__ __forceinline__ void init_rows(const bf16_t* b, int ld, const int (&rows)[4]) {
        const int tid_ = opaque_tid();
        const int r8 = tid_ >> 3, kc = (tid_ & 7) ^ (r8 & 7);
        ldst = tid_ * 16;
        base = b;
#pragma unroll
        for (int i = 0; i < 4; ++i) off[i] = (unsigned)rows[i] * (unsigned)ld + (unsigned)(kc * 8);
    }
    __device__ __forceinline__ void issue(Regs&, char* s, int kt) const {
#pragma unroll
        for (int i = 0; i < 4; ++i)
            __builtin_amdgcn_global_load_lds((glb_u32*)(base + (size_t)(off[i] + (unsigned)(kt * 64))), (lds_u32*)(s + i * 8192 + ldst), 16, 0, 0);
    }
    __device__ __forceinline__ void commit(const Regs&, char*, int) const {}
};

struct LoadF32KN {
    const float* p;
    int ldn;
    int n, kh;
    struct Regs { float v[32]; };
    __device__ __forceinline__ void issue(Regs& r, char*, int kt) const {
        const float* q = p + (long)kt * 64 * ldn;
#pragma unroll
        for (int j = 0; j < 32; ++j) r.v[j] = q[(long)j * ldn];
    }
    __device__ __forceinline__ void commit(const Regs& r, char* s, int kt) const {
#pragma unroll
        for (int q = 0; q < 4; ++q) {
            u32x4 w;
            w.x = pk_bf16(r.v[8 * q + 0], r.v[8 * q + 1]); w.y = pk_bf16(r.v[8 * q + 2], r.v[8 * q + 3]);
            w.z = pk_bf16(r.v[8 * q + 4], r.v[8 * q + 5]); w.w = pk_bf16(r.v[8 * q + 6], r.v[8 * q + 7]);
            *(u32x4*)(s + tile_off(n, kh * 4 + q)) = w;
        }
    }
};

struct LoadLN {
    LoadBf16Rows raw;
    bf16_t* xbase;
    const float* st;
    const float* gb;
    typedef LoadBf16Rows::Regs Regs;
    __device__ __forceinline__ void issue(Regs& r, char* s, int kt) const { raw.issue(r, s, kt); }
    __device__ __forceinline__ void commit(const Regs&, char* s, int kt) const {
        asm volatile("s_waitcnt vmcnt(0)" ::: "memory");
        const int tid_ = opaque_tid();
        const int r8 = tid_ >> 3, kc = (tid_ & 7) ^ (r8 & 7);
        const f32x4 g0 = *(const f32x4*)(gb + kt * 64 + kc * 8), g1 = *(const f32x4*)(gb + kt * 64 + kc * 8 + 4);
        const f32x4 b0 = *(const f32x4*)(gb + 1024 + kt * 64 + kc * 8), b1 = *(const f32x4*)(gb + 1024 + kt * 64 + kc * 8 + 4);
#pragma unroll
        for (int i = 0; i < 4; ++i) {
            const int row = r8 + 64 * i;
            u32x4* cp = (u32x4*)(s + i * 8192 + tid_ * 16);
            const u32x4 v = *cp;
            const float mean = st[row * 2], rstd = st[row * 2 + 1];
            const f32x4 x0 = (f32x4){bf_lo(v.x), bf_hi(v.x), bf_lo(v.y), bf_hi(v.y)};
            const f32x4 x1 = (f32x4){bf_lo(v.z), bf_hi(v.z), bf_lo(v.w), bf_hi(v.w)};
            const f32x4 y0 = (x0 - mean) * rstd * g0 + b0, y1 = (x1 - mean) * rstd * g1 + b1;
            u32x4 w; w.x = pk_bf16(y0[0], y0[1]); w.y = pk_bf16(y0[2], y0[3]); w.z = pk_bf16(y1[0], y1[1]); w.w = pk_bf16(y1[2], y1[3]);
            *cp = w;
            if (xbase) *(u32x4*)(xbase + (size_t)(row * 1024 + kc * 8 + kt * 64)) = w;
        }
    }
};

constexpr int GEMM_LDS = 131072;
template <class AL, class BL>
__device__ __forceinline__ void gemm_mainloop(char* smem, const AL& al, const BL& bl, int nk, f32x4 (&acc)[8][4]) {
    const int tid_ = opaque_tid();
    const int lane = tid_ & 63, wid = tid_ >> 6;
    const int wr = wid >> 2, wc = wid & 3, fr = lane & 15, fq = lane >> 4;
#pragma unroll
    for (int mi = 0; mi < 8; ++mi)
#pragma unroll
        for (int ni = 0; ni < 4; ++ni) acc[mi][ni] = (f32x4){0.f, 0.f, 0.f, 0.f};
    typename AL::Regs ra; typename BL::Regs rb;
    al.issue(ra, smem, 0); bl.issue(rb, smem + 32768, 0);
    al.commit(ra, smem, 0); bl.commit(rb, smem + 32768, 0);
    __syncthreads();
    for (int kt = 0; kt < nk; ++kt) {
        char* sA = smem + (kt & 1) * 65536; char* sB = sA + 32768;
        char* nA = smem + ((kt + 1) & 1) * 65536; char* nB = nA + 32768;
        if (kt + 1 < nk) { al.issue(ra, nA, kt + 1); bl.issue(rb, nB, kt + 1); }
#pragma unroll
        for (int kk = 0; kk < 2; ++kk) {
            bf16x8 bfr[4];
#pragma unroll
            for (int ni = 0; ni < 4; ++ni) bfr[ni] = *(const bf16x8*)(sB + tile_off(wc * 64 + ni * 16 + fr, kk * 4 + fq));
#pragma unroll
            for (int mi = 0; mi < 8; ++mi) {
                const bf16x8 af = *(const bf16x8*)(sA + tile_off(wr * 128 + mi * 16 + fr, kk * 4 + fq));
#pragma unroll
                for (int ni = 0; ni < 4; ++ni) acc[mi][ni] = mfma16(bfr[ni], af, acc[mi][ni]);
            }
        }
        if (kt + 1 < nk) { al.commit(ra, nA, kt + 1); bl.commit(rb, nB, kt + 1); }
        __syncthreads();
    }
}

__device__ __forceinline__ int swz4(int row) { return (0x78 >> (((row >> 2) & 3) * 2)) & 3; }
struct RingRows {
    const bf16_t* base; unsigned off[2]; int ldst;
    __device__ __forceinline__ void init_contig(const bf16_t* b, int ld, int row0, bool perm = false) {
        const int tid_ = opaque_tid(); const int r = tid_ >> 2, kc = (tid_ & 3) ^ swz4(r);
        ldst = tid_ * 16; base = b + (long)row0 * ld;
#pragma unroll
        for (int i = 0; i < 2; ++i) { const int rr = r + 128 * i; off[i] = (unsigned)((perm ? bperm(rr) : rr) * ld + kc * 8); }
    }
    __device__ __forceinline__ void init_rows(const bf16_t* b, int ld, const int (&rows)[2]) {
        const int tid_ = opaque_tid(); const int r = tid_ >> 2, kc = (tid_ & 3) ^ swz4(r);
        ldst = tid_ * 16; base = b;
#pragma unroll
        for (int i = 0; i < 2; ++i) off[i] = (unsigned)rows[i] * (unsigned)ld + (unsigned)(kc * 8);
    }
    __device__ __forceinline__ void issue(char* s, int kt) const {
#pragma unroll
        for (int i = 0; i < 2; ++i)
            __builtin_amdgcn_global_load_lds((glb_u32*)(base + (size_t)(off[i] + (unsigned)(kt * 32))), (lds_u32*)(s + i * 8192 + ldst), 16, 0, 0);
    }
    __device__ __forceinline__ void commit(char*, int) const {}
};
struct RingLN {
    RingRows raw; bf16_t* xbase; const float* st; const float* gb;
    __device__ __forceinline__ void issue(char* s, int kt) const { raw.issue(s, kt); }
    __device__ __forceinline__ void commit(char* s, int kt) const {
        const int tid_ = opaque_tid(); const int r = tid_ >> 2, kc = (tid_ & 3) ^ swz4(r);
        const f32x4 g0 = *(const f32x4*)(gb + kt * 32 + kc * 8), g1 = *(const f32x4*)(gb + kt * 32 + kc * 8 + 4);
        const f32x4 b0 = *(const f32x4*)(gb + 1024 + kt * 32 + kc * 8), b1 = *(const f32x4*)(gb + 1024 + kt * 32 + kc * 8 + 4);
#pragma unroll
        for (int i = 0; i < 2; ++i) {
            const int row = r + 128 * i;
            u32x4* cp = (u32x4*)(s + i * 8192 + tid_ * 16);
            const u32x4 v = *cp;
            const float mean = st[row * 2], rstd = st[row * 2 + 1];
            const f32x4 x0 = (f32x4){bf_lo(v.x), bf_hi(v.x), bf_lo(v.y), bf_hi(v.y)};
            const f32x4 x1 = (f32x4){bf_lo(v.z), bf_hi(v.z), bf_lo(v.w), bf_hi(v.w)};
            const f32x4 y0 = (x0 - mean) * rstd * g0 + b0, y1 = (x1 - mean) * rstd * g1 + b1;
            u32x4 w; w.x = pk_bf16(y0[0], y0[1]); w.y = pk_bf16(y0[2], y0[3]); w.z = pk_bf16(y1[0], y1[1]); w.w = pk_bf16(y1[2], y1[3]);
            *cp = w;
            if (xbase) *(u32x4*)(xbase + (size_t)(row * 1024 + kc * 8 + kt * 32)) = w;
        }
    }
};
#define RING_WAIT(n) asm volatile("s_waitcnt vmcnt(" #n ")" ::: "memory")
#define RING_BAR() do { __builtin_amdgcn_sched_barrier(0); asm volatile("s_waitcnt lgkmcnt(0)" ::: "memory"); __builtin_amdgcn_s_barrier(); asm volatile("" ::: "memory"); __builtin_amdgcn_sched_barrier(0); } while (0)
template <class AL, class BL, int XMODE = 0  >
__device__ __forceinline__ void gemm_ring(char* smem, const AL& al, const BL& bl, int nk  , f32x4 (&acc)[8][4]) {
    const int tid_ = opaque_tid();
    const int lane = tid_ & 63, wid = __builtin_amdgcn_readfirstlane(tid_ >> 6);
    const int wr = wid >> 2, wc = wid & 3, fr = lane & 15, fq = lane >> 4;
#pragma unroll
    for (int mi = 0; mi < 8; ++mi)
#pragma unroll
        for (int ni = 0; ni < 4; ++ni) acc[mi][ni] = (f32x4){0.f, 0.f, 0.f, 0.f};
    const int aoff = (wr * 128 + fr) * 64 + ((fq ^ swz4(fr)) << 4);
    const int boff = 16384 + (wc * 64 + fr) * 64 + ((fq ^ swz4(fr)) << 4);
    if (XMODE != 1) {
    al.issue(smem, 0); bl.issue(smem + 16384, 0);
    al.issue(smem + 32768, 1); bl.issue(smem + 32768 + 16384, 1);
    al.issue(smem + 65536, 2); bl.issue(smem + 65536 + 16384, 2);
    RING_WAIT(8);
    al.commit(smem, 0); bl.commit(smem + 16384, 0);
    }
    RING_BAR();
    if (wr == 1) RING_BAR();
    for (int kt = 0; kt < nk; ++kt) {
        const char* st = smem + (kt & 3) * 32768;
        if (XMODE != 1 && kt + 3 < nk) { char* s3 = smem + ((kt + 3) & 3) * 32768; al.issue(s3, kt + 3); bl.issue(s3 + 16384, kt + 3); }
        bf16x8 bfr[4], afr[8];
        if (XMODE != 2) {
#pragma unroll
        for (int ni = 0; ni < 4; ++ni) bfr[ni] = *(const bf16x8*)(st + boff + ni * 1024);
#pragma unroll
        for (int mi = 0; mi < 8; ++mi) afr[mi] = *(const bf16x8*)(st + aoff + mi * 1024);
        }
        if (XMODE != 1 && kt + 1 < nk) {
            if (kt + 3 < nk) RING_WAIT(8); else if (kt + 2 < nk) RING_WAIT(4); else RING_WAIT(0);
            char* s1 = smem + ((kt + 1) & 3) * 32768;
            al.commit(s1, kt + 1); bl.commit(s1 + 16384, kt + 1);
        }
        RING_BAR();
        if (XMODE != 2) {
        __builtin_amdgcn_s_setprio(1);
#pragma unroll
        for (int mi = 0; mi < 8; ++mi)
#pragma unroll
            for (int ni = 0; ni < 4; ++ni) acc[mi][ni] = mfma16(bfr[ni], afr[mi], acc[mi][ni]);
        __builtin_amdgcn_s_setprio(0);
        }
        RING_BAR();
    }
    if (wr == 0) RING_BAR();
}

__device__ __forceinline__ void epi_store_bf16(const f32x4 (&acc)[8][4], bf16_t* out, long ld, int row0, int col0) {
    const int tid_ = opaque_tid();
    const int lane = tid_ & 63, wid = tid_ >> 6;
    const int wr = wid >> 2, wc = wid & 3, fr = lane & 15, fq = lane >> 4;
#pragma unroll
    for (int mi = 0; mi < 8; ++mi) {
        bf16_t* rp = out + (long)(row0 + wr * 128 + mi * 16 + fr) * ld + col0 + wc * 64 + fq * 8;
#pragma unroll
        for (int q = 0; q < 2; ++q) {
            u32x4 w; w.x = pk_bf16(acc[mi][2 * q][0], acc[mi][2 * q][1]); w.y = pk_bf16(acc[mi][2 * q][2], acc[mi][2 * q][3]);
            w.z = pk_bf16(acc[mi][2 * q + 1][0], acc[mi][2 * q + 1][1]); w.w = pk_bf16(acc[mi][2 * q + 1][2], acc[mi][2 * q + 1][3]);
            *(u32x4*)(rp + q * 32) = w;
        }
    }
}

template <bool RES_LN>
__device__ __forceinline__ void epi_residual(f32x4 (&acc)[8][4], char* smem, const float* resid, const float* rstats  ,
                                             const float* g, const float* b, float* rout, bf16_t* rbout, float* stout  , int row0, int nt) {
    const int tid_ = opaque_tid();
    const int lane = tid_ & 63, wid = tid_ >> 6;
    const int wr = wid >> 2, wc = wid & 3, fr = lane & 15, fq = lane >> 4;
    float* sp = (float*)smem;
    const int col0 = nt * 256 + wc * 64 + fq * 8;
#pragma unroll
    for (int mi = 0; mi < 8; ++mi) {
        const int rl = wr * 128 + mi * 16 + fr;
        const long row = row0 + rl;
        float mean = 0.f, rstd = 1.f;
        if (RES_LN) {
            const f32x4 p0 = *(const f32x4*)(rstats + row * 8), p1 = *(const f32x4*)(rstats + row * 8 + 4);
            const float s1 = (p0[0] + p0[2]) + (p1[0] + p1[2]), s2 = (p0[1] + p0[3]) + (p1[1] + p1[3]);
            mean = s1 * (1.0f / 1024.0f);
            const float var = fmaxf(s2 * (1.0f / 1024.0f) - mean * mean, 0.f);
            rstd = rsqrtf(var + LN_EPS);
        }
        float s1 = 0.f, s2 = 0.f;
#pragma unroll
        for (int q = 0; q < 2; ++q) {
            const long o = row * 1024 + col0 + q * 32;
            f32x4 x0 = *(const f32x4*)(resid + o), x1 = *(const f32x4*)(resid + o + 4);
            if (RES_LN) {
                x0 = (x0 - mean) * rstd * *(const f32x4*)(g + col0 + q * 32) + *(const f32x4*)(b + col0 + q * 32);
                x1 = (x1 - mean) * rstd * *(const f32x4*)(g + col0 + q * 32 + 4) + *(const f32x4*)(b + col0 + q * 32 + 4);
            }
            const f32x4 v0 = acc[mi][2 * q] + ALPHA * x0, v1 = acc[mi][2 * q + 1] + ALPHA * x1;
            *(f32x4*)(rout + o) = v0; *(f32x4*)(rout + o + 4) = v1;
            { u32x4 w; w.x = pk_bf16(v0[0], v0[1]); w.y = pk_bf16(v0[2], v0[3]); w.z = pk_bf16(v1[0], v1[1]); w.w = pk_bf16(v1[2], v1[3]); *(u32x4*)(rbout + o) = w; }
            s1 += ((v0[0] + v0[1]) + (v0[2] + v0[3])) + ((v1[0] + v1[1]) + (v1[2] + v1[3]));
            s2 += ((v0[0] * v0[0] + v0[1] * v0[1]) + (v0[2] * v0[2] + v0[3] * v0[3])) + ((v1[0] * v1[0] + v1[1] * v1[1]) + (v1[2] * v1[2] + v1[3] * v1[3]));
        }
        s1 += __shfl_xor(s1, 16); s1 += __shfl_xor(s1, 32);
        s2 += __shfl_xor(s2, 16); s2 += __shfl_xor(s2, 32);
        if (fq == 0) { sp[(rl * 4 + wc) * 2] = s1; sp[(rl * 4 + wc) * 2 + 1] = s2; }
    }
    __syncthreads();
    if (tid_ < 256) {
        const int rl = tid_;
        const float a1 = (sp[rl * 8] + sp[rl * 8 + 2]) + (sp[rl * 8 + 4] + sp[rl * 8 + 6]);
        const float a2 = (sp[rl * 8 + 1] + sp[rl * 8 + 3]) + (sp[rl * 8 + 5] + sp[rl * 8 + 7]);
        *(f32x2*)(stout + ((long)(row0 + rl) * 4 + nt) * 2) = (f32x2){a1, a2};
    }
    __syncthreads();
}

__device__ __forceinline__ void ln_tile_stats(float* st, const float* rstats, int row0) {
    const int tid_ = opaque_tid();
    if (tid_ < 256) {
        const long row = row0 + tid_;
        const f32x4 p0 = *(const f32x4*)(rstats + row * 8), p1 = *(const f32x4*)(rstats + row * 8 + 4);
        const float s1 = (p0[0] + p0[2]) + (p1[0] + p1[2]), s2 = (p0[1] + p0[3]) + (p1[1] + p1[3]);
        const float mean = s1 * (1.0f / 1024.0f);
        const float var = fmaxf(s2 * (1.0f / 1024.0f) - mean * mean, 0.f);
        st[tid_ * 2] = mean; st[tid_ * 2 + 1] = rsqrtf(var + LN_EPS);
    }
}
__device__ __forceinline__ void ln_load_gb(float* gb, const float* g, const float* b) {
    for (int i = opaque_tid(); i < 1024; i += NTHR) { gb[i] = g[i]; gb[1024 + i] = b[i]; }
}


struct XcdSlab {
    int x, j, stride;
    __device__ __forceinline__ void init(int bid, int nb) { if ((nb & 7) == 0) { x = bid & 7; j = bid >> 3; stride = nb >> 3; } else { x = -1; j = bid; stride = nb; } }
    __device__ __forceinline__ int m_lo(int nM) const { return x < 0 ? 0 : (x * nM) >> 3; }
    __device__ __forceinline__ int m_hi(int nM) const { return x < 0 ? nM : ((x + 1) * nM) >> 3; }
};
struct TJob { const float* src; int ldsrc; int K; int col0; int ncols; bf16_t* dst; int mode; int rowoff; };
__device__ __forceinline__ int tjob_row(const TJob& j, int c) {
    if (j.mode == 0) return j.rowoff + c;
    const int oc = c & 127;
    return 256 * (c >> 7) + 64 * (oc >> 5) + 16 * (2 * ((oc >> 2) & 1) + j.rowoff) + 4 * ((oc >> 3) & 3) + (oc & 3);
}
__device__ __forceinline__ void transpose_tile(char* smem, const TJob& j, int kt, int ct) {
    float* tile = (float*)smem;
    const int tid = opaque_tid();
#pragma unroll
    for (int i = 0; i < 8; ++i) {
        const int e = tid + i * NTHR, kr = e >> 6, c = e & 63;
        const int cc = ct * 64 + c;
        float v = 0.f;
        if (cc < j.ncols) v = j.src[(long)(kt * 64 + kr) * j.ldsrc + j.col0 + cc];
        tile[kr * 65 + c] = v;
    }
    __syncthreads();
#pragma unroll
    for (int i = 0; i < 4; ++i) {
        const int e = tid + i * NTHR, c = e >> 5, k2 = (e & 31) * 2;
        const int cc = ct * 64 + c;
        if (cc < j.ncols) {
            const unsigned w = pk_bf16(tile[k2 * 65 + c], tile[(k2 + 1) * 65 + c]);
            *(unsigned*)(j.dst + (long)tjob_row(j, cc) * j.K + kt * 64 + k2) = w;
        }
    }
    __syncthreads();
}


__device__ __forceinline__ void tjob_run(char* smem, int bid, int nb, const float* src, int ld, int K, int col0, int ncols, bf16_t* dst, int mode, int rowoff) {
    TJob j; j.src = src; j.ldsrc = ld; j.K = K; j.col0 = col0; j.ncols = ncols; j.dst = dst; j.mode = mode; j.rowoff = rowoff;
    const int nkt = K / 64, nct = (ncols + 63) / 64, ntile = nkt * nct;
    for (int t = bid; t < ntile; t += nb) transpose_tile(smem, j, t % nkt, t / nkt);
}

__device__ __forceinline__ void cvt_rows_bf16(const float* src, bf16_t* dst, long n8, int bid, int nb) {
    for (long i = (long)bid * NTHR + opaque_tid(); i < n8; i += (long)nb * NTHR) {
        const f32x4 a = *(const f32x4*)(src + i * 8), b = *(const f32x4*)(src + i * 8 + 4);
        u32x4 w; w.x = pk_bf16(a[0], a[1]); w.y = pk_bf16(a[2], a[3]); w.z = pk_bf16(b[0], b[1]); w.w = pk_bf16(b[2], b[3]);
        *(u32x4*)(dst + i * 8) = w;
    }
}

enum { I_X = 0, I_MEM, I_WIN, I_POSK, I_CKW1, I_CKW2, I_POSV, I_CVW1, I_CVW2, I_CONVW, I_IBIAS, I_FBIAS, I_NORMG, I_WOUT, I_LN1G, I_LN1B,
       I_XAWQ, I_XAWK, I_XAWV, I_XAWO, I_LN2G, I_LN2B, I_ROUTW, I_ROUTB, I_MW1, I_MW3, I_MW2, I_SW1, I_SW3, I_SW2, I_LN3G, I_LN3B };

__device__ __forceinline__ void phase0(const Params& p, char* smem, int bid, int nb) {
    char* ws = p.ws;
    tjob_run(smem, bid, nb, p.in[I_WIN], 3360, 1024, 0, 1280, (bf16_t*)(ws + WS_WIN), 0, 0);
    tjob_run(smem, bid, nb, p.in[I_WIN], 3360, 1024, 1304, 2048, (bf16_t*)(ws + WS_WIN), 0, 1280);
    tjob_run(smem, bid, nb, p.in[I_WIN], 3360, 1024, 1280, 24, (bf16_t*)(ws + WS_WIN), 0, 3328);
    tjob_run(smem, bid, nb, p.in[I_WIN], 3360, 1024, 3352, 8, (bf16_t*)(ws + WS_WIN), 0, 3352);
    tjob_run(smem, bid, nb, p.in[I_WOUT], 1024, 1024, 0, 1024, (bf16_t*)(ws + WS_WOUT), 0, 0);
    tjob_run(smem, bid, nb, p.in[I_XAWQ], 1024, 1024, 0, 1024, (bf16_t*)(ws + WS_WQ), 0, 0);
    tjob_run(smem, bid, nb, p.in[I_XAWK], 1024, 1024, 0, 1024, (bf16_t*)(ws + WS_WKV), 0, 0);
    tjob_run(smem, bid, nb, p.in[I_XAWV], 1024, 1024, 0, 1024, (bf16_t*)(ws + WS_WKV), 0, 1024);
    tjob_run(smem, bid, nb, p.in[I_XAWO], 1024, 1024, 0, 1024, (bf16_t*)(ws + WS_WO), 0, 0);
    tjob_run(smem, bid, nb, p.in[I_ROUTW], 256, 1024, 0, 256, (bf16_t*)(ws + WS_WR), 0, 0);
    tjob_run(smem, bid, nb, p.in[I_SW1], 256, 1024, 0, 256, (bf16_t*)(ws + WS_WS13), 1, 0);
    tjob_run(smem, bid, nb, p.in[I_SW3], 256, 1024, 0, 256, (bf16_t*)(ws + WS_WS13), 1, 1);
    tjob_run(smem, bid, nb, p.in[I_SW2], 1024, 256, 0, 1024, (bf16_t*)(ws + WS_WS2), 0, 0);
    tjob_run(smem, bid, nb, p.in[I_CKW1], 64, 2048, 0, 64, (bf16_t*)(ws + WS_CK1), 0, 0);
    tjob_run(smem, bid, nb, p.in[I_CKW2], 64, 64, 0, 64, (bf16_t*)(ws + WS_CK2), 0, 0);
    tjob_run(smem, bid, nb, p.in[I_CVW1], 64, 2048, 0, 64, (bf16_t*)(ws + WS_CV1), 0, 0);
    tjob_run(smem, bid, nb, p.in[I_CVW2], 64, 64, 0, 64, (bf16_t*)(ws + WS_CV2), 0, 0);
    cvt_rows_bf16(p.in[I_X], (bf16_t*)(ws + WS_XB), (long)T_TOK * 1024 / 8, bid, nb);
    cvt_rows_bf16(p.in[I_MEM], (bf16_t*)(ws + WS_MEMB), (long)4096 * 1024 / 8, bid, nb);
    { int* c = (int*)(ws + WS_CNT); for (int i = bid * NTHR + opaque_tid(); i < 24576; i += nb * NTHR) c[i] = 0; }
}

__device__ __forceinline__ void small_cols_task(const Params& p, int task) {
    const bf16_t* xb = (const bf16_t*)(p.ws + WS_XB);
    const bf16_t* wt = (const bf16_t*)(p.ws + WS_WIN) + (long)3328 * 1024;
    float* psm = (float*)(p.ws + WS_PSM);
    const int tid_ = opaque_tid();
    const int lane = tid_ & 63, wid = tid_ >> 6, fr = lane & 15, fq = lane >> 4;
    const int r0 = task * 256 + wid * 32;
    f32x4 acc[2][2];
#pragma unroll
    for (int mi = 0; mi < 2; ++mi)
#pragma unroll
        for (int ni = 0; ni < 2; ++ni) acc[mi][ni] = (f32x4){0.f, 0.f, 0.f, 0.f};
    const bf16_t* ap0 = xb + (long)(r0 + fr) * 1024 + fq * 8;
    const bf16_t* ap1 = ap0 + 16 * 1024;
    const bf16_t* bp0 = wt + (long)fr * 1024 + fq * 8;
    const bf16_t* bp1 = bp0 + 16 * 1024;
#pragma unroll 4
    for (int ks = 0; ks < 32; ++ks) {
        const bf16x8 a0 = *(const bf16x8*)(ap0 + ks * 32), a1 = *(const bf16x8*)(ap1 + ks * 32);
        const bf16x8 b0 = *(const bf16x8*)(bp0 + ks * 32), b1 = *(const bf16x8*)(bp1 + ks * 32);
        acc[0][0] = mfma16(b0, a0, acc[0][0]); acc[0][1] = mfma16(b1, a0, acc[0][1]);
        acc[1][0] = mfma16(b0, a1, acc[1][0]); acc[1][1] = mfma16(b1, a1, acc[1][1]);
    }
#pragma unroll
    for (int mi = 0; mi < 2; ++mi)
#pragma unroll
        for (int ni = 0; ni < 2; ++ni) *(f32x4*)(psm + (long)(r0 + mi * 16 + fr) * 32 + ni * 16 + fq * 4) = acc[mi][ni];
}

template <int NOEPI = 0>
__device__ __forceinline__ void phase1(const Params& p, char* smem, int bid, int nb) {
    char* ws = p.ws;
    XcdSlab xs; xs.init(bid, nb);
    const int a_lo = xs.m_lo(128), a_n = (xs.m_hi(128) - a_lo) * 14;
    const int b_lo = xs.m_lo(16), b_n = (xs.m_hi(16) - b_lo) * 8;
    for (int u = xs.j; u < a_n + b_n; u += xs.stride) {
        const bool inp = u < a_n;
        const int uu = inp ? u : u - a_n;
        const int nm = inp ? (xs.m_hi(128) - a_lo) : (xs.m_hi(16) - b_lo);
        const int mt = (inp ? a_lo : b_lo) + uu % nm, nt = uu / nm;
        RingRows al, bl;
        al.init_contig((const bf16_t*)(ws + (inp ? WS_XB : WS_MEMB)), 1024, mt * 256);
        bl.init_contig((const bf16_t*)(ws + (inp ? WS_WIN : WS_WKV)), 1024, nt * 256, true);
        f32x4 acc[8][4];
        gemm_ring(smem, al, bl, 32, acc);
        if (NOEPI) { float s = 0.f;
#pragma unroll
            for (int mi = 0; mi < 8; ++mi)
#pragma unroll
                for (int ni = 0; ni < 4; ++ni) s += acc[mi][ni][0] + acc[mi][ni][1] + acc[mi][ni][2] + acc[mi][ni][3];
            if (s == 123.456f) ((float*)(ws + WS_A + 432 * MB))[opaque_tid()] = s; continue; }
        if (!inp) epi_store_bf16(acc, (bf16_t*)(ws + WS_KVX), 2048, mt * 256, nt * 256);
        else if (nt < 13) epi_store_bf16(acc, (bf16_t*)(ws + WS_P), PW, mt * 256, nt * 256);
        else {
            const int tid_ = opaque_tid();
            const int lane = tid_ & 63, wid = tid_ >> 6, wr = wid >> 2, wc = wid & 3, fr = lane & 15, fq = lane >> 4;
            if (wc == 0) {
                float* psm = (float*)(ws + WS_PSM);
#pragma unroll
                for (int mi = 0; mi < 8; ++mi)
#pragma unroll
                    for (int ni = 0; ni < 2; ++ni) *(f32x4*)(psm + (long)(mt * 256 + wr * 128 + mi * 16 + fr) * 32 + fq * 8 + ni * 4) = acc[mi][ni];
            }
        }
    }
}

__device__ __forceinline__ void compress_task(const Params& p, char* smem, int which, int rb) {
    const char* ws = p.ws;
    const bf16_t* P = (const bf16_t*)(ws + WS_P);
    const float* pos = p.in[which ? I_POSV : I_POSK];
    const bf16_t* w1t = (const bf16_t*)(ws + (which ? WS_CV1 : WS_CK1));
    const bf16_t* w2t = (const bf16_t*)(ws + (which ? WS_CV2 : WS_CK2));
    bf16_t* outp = (bf16_t*)(p.ws + (which ? WS_VCMP : WS_KCMP));
    const int colbase = which ? PC_VC : PC_KC;
    const int tid_ = opaque_tid();
    const int lane = tid_ & 63, wid = tid_ >> 6, fr = lane & 15, fq = lane >> 4;
    const int mi = wid >> 2, ni = wid & 3;
    const int r = rb * 32 + mi * 16 + fr;
    const int b = r / 254, rem = r - b * 254, c = rem >> 1, g = rem & 1;
    const bf16_t* arow = P + (long)(b * 2048 + c * 16) * PW + colbase + g * 64 + fq * 8;
    const bf16_t* brow = w1t + (long)(ni * 16 + fr) * 2048 + fq * 8;
    const float* prow = pos + fq * 8;
    f32x4 acc = (f32x4){0.f, 0.f, 0.f, 0.f};
#pragma unroll 8
    for (int ks = 0; ks < 64; ++ks) {
        const int l = ks >> 1, d0 = (ks & 1) * 32;
        const u32x4 av = *(const u32x4*)(arow + (long)l * PW + d0);
        const f32x4 p0 = *(const f32x4*)(prow + l * 64 + d0), p1 = *(const f32x4*)(prow + l * 64 + d0 + 4);
        u32x4 aw;
        aw.x = pk_bf16(bf_lo(av.x) + p0[0], bf_hi(av.x) + p0[1]); aw.y = pk_bf16(bf_lo(av.y) + p0[2], bf_hi(av.y) + p0[3]);
        aw.z = pk_bf16(bf_lo(av.z) + p1[0], bf_hi(av.z) + p1[1]); aw.w = pk_bf16(bf_lo(av.w) + p1[2], bf_hi(av.w) + p1[3]);
        const bf16x8 bb = *(const bf16x8*)(brow + ks * 32);
        acc = mfma16(bb, as_bf16x8(aw), acc);
    }
    bf16_t* h1 = (bf16_t*)smem;
    {
        u32x2 w; w.x = pk_bf16(siluf_(acc[0]), siluf_(acc[1])); w.y = pk_bf16(siluf_(acc[2]), siluf_(acc[3]));
        *(u32x2*)(h1 + (mi * 16 + fr) * 72 + ni * 16 + fq * 4) = w;
    }
    __syncthreads();
    f32x4 acc2 = (f32x4){0.f, 0.f, 0.f, 0.f};
#pragma unroll
    for (int ks = 0; ks < 2; ++ks) {
        const bf16x8 a = *(const bf16x8*)(h1 + (mi * 16 + fr) * 72 + ks * 32 + fq * 8);
        const bf16x8 bb = *(const bf16x8*)(w2t + (ni * 16 + fr) * 64 + ks * 32 + fq * 8);
        acc2 = mfma16(bb, a, acc2);
    }
    {
        u32x2 w; w.x = pk_bf16(acc2[0], acc2[1]); w.y = pk_bf16(acc2[2], acc2[3]);
        *(u32x2*)(outp + ((long)(b * 2 + g) * 128 + c) * 64 + ni * 16 + fq * 4) = w;
    }
    __syncthreads();
}

__device__ __forceinline__ void phase2(const Params& p, char* smem, int bid, int nb) {
    char* ws = p.ws;
    for (int t = bid; t < 254; t += nb) compress_task(p, smem, t / 127, t % 127);
    const int tid_ = opaque_tid();
    if (bid < 32 && tid_ < 32) {
        bf16_t* kc = (bf16_t*)(ws + WS_KCMP) + ((long)bid * 128 + 127) * 64;
        bf16_t* vc = (bf16_t*)(ws + WS_VCMP) + ((long)bid * 128 + 127) * 64;
        ((unsigned*)kc)[tid_] = 0u; ((unsigned*)vc)[tid_] = 0u;
    }
    const bf16_t* P = (const bf16_t*)(ws + WS_P);
    const float* cw = p.in[I_CONVW];
    bf16_t* qk = (bf16_t*)(ws + WS_QK);
    for (long it = (long)bid * NTHR + tid_; it < (long)T_TOK * 128; it += (long)nb * NTHR) {
        const int t = (int)(it >> 7), ch = (int)(it & 127);
        const int s = t & (SEQ - 1);
        float a[8];
#pragma unroll
        for (int e = 0; e < 8; ++e) a[e] = 0.f;
#pragma unroll
        for (int j = 0; j < 4; ++j) {
            if (s - 3 + j >= 0) {
                const u32x4 u = *(const u32x4*)(P + (long)(t - 3 + j) * PW + PC_MQ + ch * 8);
                const f32x4 w0 = *(const f32x4*)(cw + j * 1024 + ch * 8), w1 = *(const f32x4*)(cw + j * 1024 + ch * 8 + 4);
                a[0] += w0[0] * bf_lo(u.x); a[1] += w0[1] * bf_hi(u.x); a[2] += w0[2] * bf_lo(u.y); a[3] += w0[3] * bf_hi(u.y);
                a[4] += w1[0] * bf_lo(u.z); a[5] += w1[1] * bf_hi(u.z); a[6] += w1[2] * bf_lo(u.w); a[7] += w1[3] * bf_hi(u.w);
            }
        }
        const float sc = ch < 64 ? 0.08838834764831845f : 1.0f;
        u32x4 w;
        w.x = pk_bf16(siluf_(a[0]) * sc, siluf_(a[1]) * sc); w.y = pk_bf16(siluf_(a[2]) * sc, siluf_(a[3]) * sc);
        w.z = pk_bf16(siluf_(a[4]) * sc, siluf_(a[5]) * sc); w.w = pk_bf16(siluf_(a[6]) * sc, siluf_(a[7]) * sc);
        *(u32x4*)(qk + (long)t * 1024 + ch * 8) = w;
    }
}

typedef __attribute__((address_space(3))) s16x4 lds_s16x4;
__device__ __forceinline__ s16x4 lds_tr(const char* a) { return __builtin_amdgcn_ds_read_tr16_b64_v4i16((lds_s16x4*)a); }
__device__ __forceinline__ bf16x8 tr_frag_perm(const char* base, int pitch, int rbase, int cbase, int fr, int fq) {
    const char* a0 = base + (rbase + 4 * fq + (fr >> 2)) * pitch + (cbase + 4 * (fr & 3)) * 2;
    const s16x4 lo = lds_tr(a0), hi = lds_tr(a0 + 16 * pitch);
    return (bf16x8){lo[0], lo[1], lo[2], lo[3], hi[0], hi[1], hi[2], hi[3]};
}
__device__ __forceinline__ bf16x8 tr_frag_std(const char* base, int pitch, int rbase, int cbase, int fr, int fq) {
    const char* a0 = base + (rbase + 8 * fq + (fr >> 2)) * pitch + (cbase + 4 * (fr & 3)) * 2;
    const s16x4 lo = lds_tr(a0), hi = lds_tr(a0 + 4 * pitch);
    return (bf16x8){lo[0], lo[1], lo[2], lo[3], hi[0], hi[1], hi[2], hi[3]};
}
__device__ __forceinline__ bf16x8 pack_p(const f32x4 a, const f32x4 b) {
    u32x4 w; w.x = pk_bf16(a[0], a[1]); w.y = pk_bf16(a[2], a[3]); w.z = pk_bf16(b[0], b[1]); w.w = pk_bf16(b[2], b[3]);
    return as_bf16x8(w);
}

__device__ __forceinline__ float dpp_xor1(float v) { return __builtin_bit_cast(float, __builtin_amdgcn_mov_dpp(__builtin_bit_cast(int, v), 0xB1, 0xF, 0xF, true)); }
__device__ __forceinline__ float dpp_xor2(float v) { return __builtin_bit_cast(float, __builtin_amdgcn_mov_dpp(__builtin_bit_cast(int, v), 0x4E, 0xF, 0xF, true)); }

constexpr int NSA_PITCH = 160;
constexpr int NSA_KC = 0, NSA_VC = 20480, NSA_KT = 40960, NSA_VT = 61440, NSA_MISC = 81920, NSA_Y = 83968;

struct NsaState {
    bf16x8 qf[2][2];
    int tl[2];
    unsigned selm[2];
    unsigned wunion, bunion;
};

template <int MODE>
__device__ __forceinline__ void nsa_stream(char* smem, const bf16_t* Pb  , int g, int i, NsaState& st, float gate0, float gate1, const int tid) {
    const int lane = tid & 63, fr = lane & 15, fq = lane >> 4;
    const int kcol = (MODE == 0 ? PC_KS : PC_KW) + g * 64, vcol = (MODE == 0 ? PC_VS : PC_VW) + g * 64;
    const int lrow = tid >> 3, lch = tid & 7;
    const unsigned need = MODE == 0 ? st.bunion : 0xffffffffu;
    const int jlo = MODE == 0 ? 0 : (i - 8 > 0 ? i - 8 : 0);
    f32x4 O[2][4];
    float m[2], l[2];
    int tlq[2];
#pragma unroll
    for (int mt = 0; mt < 2; ++mt) { m[mt] = -1e30f; l[mt] = 0.f; tlq[mt] = st.tl[mt] - 4 * fq;
#pragma unroll
        for (int dt = 0; dt < 4; ++dt) O[mt][dt] = (f32x4){0.f, 0.f, 0.f, 0.f}; }
    int j = jlo;
    while (j <= i && !((need >> j) & 1u)) ++j;
    u32x4 kreg, vreg;
    int buf = 0;
    if (j <= i) {
        const bf16_t* rp = Pb + (long)(j * 64 + lrow) * PW + lch * 8;
        kreg = *(const u32x4*)(rp + kcol); vreg = *(const u32x4*)(rp + vcol);
        *(u32x4*)(smem + NSA_KT + lrow * NSA_PITCH + lch * 16) = kreg;
        *(u32x4*)(smem + NSA_VT + lrow * NSA_PITCH + lch * 16) = vreg;
    }
    __syncthreads();
    while (j <= i) {
        int jn = j + 1;
        while (jn <= i && !((need >> jn) & 1u)) ++jn;
        if (jn <= i) {
            const bf16_t* rp = Pb + (long)(jn * 64 + lrow) * PW + lch * 8;
            kreg = *(const u32x4*)(rp + kcol); vreg = *(const u32x4*)(rp + vcol);
        }
        const char* KT = smem + NSA_KT + buf * 10240;
        const char* VT = smem + NSA_VT + buf * 10240;
        const bool wave_on = MODE == 0 ? (((st.wunion >> j) & 1u) != 0u) : true;
        if (wave_on) {
            f32x4 S[2][4];
            {
                bf16x8 kf[4][2];
#pragma unroll
                for (int nt = 0; nt < 4; ++nt)
#pragma unroll
                    for (int ks = 0; ks < 2; ++ks) kf[nt][ks] = *(const bf16x8*)(KT + (16 * nt + fr) * NSA_PITCH + (ks * 4 + fq) * 16);
#pragma unroll
                for (int mt = 0; mt < 2; ++mt)
#pragma unroll
                    for (int nt = 0; nt < 4; ++nt) {
                        f32x4 s = (f32x4){0.f, 0.f, 0.f, 0.f};
                        s = mfma16(kf[nt][0], st.qf[mt][0], s);
                        s = mfma16(kf[nt][1], st.qf[mt][1], s);
                        S[mt][nt] = s;
                    }
            }
            bf16x8 pf[2][2];
#pragma unroll
            for (int mt = 0; mt < 2; ++mt) {
                const bool rowsel = MODE == 0 ? (((st.selm[mt] >> j) & 1u) != 0u) : true;
                float mx = -INFINITY;
#pragma unroll
                for (int nt = 0; nt < 4; ++nt)
#pragma unroll
                    for (int e = 0; e < 4; ++e) {
                        const int kc = 16 * nt + e;
                        bool ok = rowsel;
                        if (j == i) ok = ok && (kc <= tlq[mt]);
                        if (MODE == 1) { if (j == i - 8) ok = ok && (kc > tlq[mt]); }
                        const float sv = ok ? S[mt][nt][e] * 0.125f : -INFINITY;
                        S[mt][nt][e] = sv;
                        mx = fmaxf(mx, sv);
                    }
                mx = fmaxf(mx, __shfl_xor(mx, 16)); mx = fmaxf(mx, __shfl_xor(mx, 32));
                const float mnew = fmaxf(m[mt], mx);
                const float alpha = __expf(m[mt] - mnew);
                float rs = 0.f;
#pragma unroll
                for (int nt = 0; nt < 4; ++nt)
#pragma unroll
                    for (int e = 0; e < 4; ++e) { const float pv = __expf(S[mt][nt][e] - mnew); S[mt][nt][e] = pv; rs += pv; }
                rs += __shfl_xor(rs, 16); rs += __shfl_xor(rs, 32);
                l[mt] = l[mt] * alpha + rs; m[mt] = mnew;
#pragma unroll
                for (int dt = 0; dt < 4; ++dt) O[mt][dt] = O[mt][dt] * alpha;
                pf[mt][0] = pack_p(S[mt][0], S[mt][1]); pf[mt][1] = pack_p(S[mt][2], S[mt][3]);
            }
#pragma unroll
            for (int ks2 = 0; ks2 < 2; ++ks2)
#pragma unroll
                for (int dt = 0; dt < 4; ++dt) {
                    const bf16x8 vf = tr_frag_perm(VT, NSA_PITCH, 32 * ks2, 16 * dt, fr, fq);
                    O[0][dt] = mfma16(vf, pf[0][ks2], O[0][dt]);
                    O[1][dt] = mfma16(vf, pf[1][ks2], O[1][dt]);
                }
        }
        if (jn <= i) {
            char* KTn = smem + NSA_KT + (buf ^ 1) * 10240; char* VTn = smem + NSA_VT + (buf ^ 1) * 10240;
            *(u32x4*)(KTn + lrow * NSA_PITCH + lch * 16) = kreg;
            *(u32x4*)(VTn + lrow * NSA_PITCH + lch * 16) = vreg;
        }
        __syncthreads();
        buf ^= 1; j = jn;
    }
#pragma unroll
    for (int mt = 0; mt < 2; ++mt) {
        const float gsc = (mt == 0 ? gate0 : gate1) * (l[mt] > 0.f ? 1.0f / l[mt] : 0.f);
#pragma unroll
        for (int dt = 0; dt < 4; ++dt) { f32x4* yp = (f32x4*)(smem + NSA_Y) + (mt * 4 + dt) * NTHR + tid; *yp = *yp + O[mt][dt] * gsc; }
    }
}

__device__ __forceinline__ void nsa_cmp_one(const char* smem, const bf16x8 qf0, const bf16x8 qf1, const int t, const int i, const float gate0, f32x4* yp  , unsigned& selm, const int lane) {
    const int fr = lane & 15, fq = lane >> 4;
        const int cl = (t >= 31 ? ((t - 31) >> 4) : -1) - 4 * fq;
        f32x4 S[8];
#pragma unroll
        for (int nt = 0; nt < 8; ++nt) {
            f32x4 s = (f32x4){0.f, 0.f, 0.f, 0.f};
#pragma unroll
            for (int ks = 0; ks < 2; ++ks) {
                const bf16x8 kf = *(const bf16x8*)(smem + NSA_KC + (16 * nt + fr) * NSA_PITCH + (ks * 4 + fq) * 16);
                s = mfma16(kf, (ks == 0 ? qf0 : qf1), s);
            }
            S[nt] = s;
        }
        float mx = -INFINITY;
#pragma unroll
        for (int nt = 0; nt < 8; ++nt)
#pragma unroll
            for (int e = 0; e < 4; ++e) {
                const float sv = (16 * nt + e <= cl) ? S[nt][e] * 0.125f : -INFINITY;
                S[nt][e] = sv; mx = fmaxf(mx, sv);
            }
        mx = fmaxf(mx, __shfl_xor(mx, 16)); mx = fmaxf(mx, __shfl_xor(mx, 32));
        const float mref = fmaxf(mx, -1e30f);
        float rs = 0.f;
#pragma unroll
        for (int nt = 0; nt < 8; ++nt)
#pragma unroll
            for (int e = 0; e < 4; ++e) { const float pv = __expf(S[nt][e] - mref); S[nt][e] = pv; rs += pv; }
        rs += __shfl_xor(rs, 16); rs += __shfl_xor(rs, 32);
        const float inv = rs > 0.f ? 1.0f / rs : 0.f;
#pragma unroll
        for (int nt = 0; nt < 8; ++nt) S[nt] = S[nt] * inv;
        {
            f32x4 O[4];
#pragma unroll
            for (int dt = 0; dt < 4; ++dt) O[dt] = (f32x4){0.f, 0.f, 0.f, 0.f};
#pragma unroll
            for (int ks2 = 0; ks2 < 4; ++ks2) {
                const bf16x8 pf = pack_p(S[2 * ks2], S[2 * ks2 + 1]);
#pragma unroll
                for (int dt = 0; dt < 4; ++dt) {
                    const bf16x8 vf = tr_frag_perm(smem + NSA_VC, NSA_PITCH, 32 * ks2, 16 * dt, fr, fq);
                    O[dt] = mfma16(vf, pf, O[dt]);
                }
            }
#pragma unroll
            for (int dt = 0; dt < 4; ++dt) yp[dt * NTHR] = O[dt] * gate0;
        }
        float imp[8];
        {
            float own[8], last[8];
#pragma unroll
            for (int nt = 0; nt < 8; ++nt) {
                f32x4 v = S[nt];
#pragma unroll
                for (int e = 0; e < 4; ++e) { v[e] += dpp_xor1(v[e]); v[e] += dpp_xor2(v[e]); }
                own[nt] = (v[0] + v[1]) + (v[2] + v[3]); last[nt] = v[3];
            }
            const int src = (lane + 48) & 63;
#pragma unroll
            for (int nt = 0; nt < 8; ++nt) {
                const float a = __shfl(last[nt], src);
                const float bsh = nt > 0 ? __shfl(last[nt > 0 ? nt - 1 : 0], src) : 0.f;
                const float prevc = fq > 0 ? a : bsh;
                const int n = 4 * nt + fq;
                const float pslc = own[nt] + prevc;
                const bool valid = n <= i;
                const bool forced = (n == 0) || (n == i) || (n == i - 1);
                imp[nt] = valid ? pslc + (forced ? 1e4f : 0.f) : -1e30f;
            }
        }
        unsigned mask = 0u;
#pragma unroll 1
        for (int r = 0; r < 8; ++r) {
            float bv = imp[0]; int bn = fq;
#pragma unroll
            for (int nt = 1; nt < 8; ++nt) { if (imp[nt] > bv) { bv = imp[nt]; bn = 4 * nt + fq; } }
#pragma unroll
            for (int off = 16; off <= 32; off <<= 1) {
                const float ov = __shfl_xor(bv, off); const int on = __shfl_xor(bn, off);
                if (ov > bv || (ov == bv && on < bn)) { bv = ov; bn = on; }
            }
            if (bv > -5e29f) mask |= 1u << bn;
#pragma unroll
            for (int nt = 0; nt < 8; ++nt) if (bn == 4 * nt + fq) imp[nt] = -3.0e38f;
        }
        selm = mask;
}

__device__ __forceinline__ void nsa_task(const Params& p, char* smem, int b, int g, int i) {
    const char* ws = p.ws;
    const bf16_t* Pb = (const bf16_t*)(ws + WS_P) + (long)b * SEQ * PW;
    const float* psm = (const float*)(ws + WS_PSM) + (long)b * SEQ * 32;
    int tid = threadIdx.x;
    asm volatile("" : "+v"(tid));
    const int lane = tid & 63, wid = __builtin_amdgcn_readfirstlane(tid >> 6), fr = lane & 15, fq = lane >> 4;
    const int qs = i * 64;
    NsaState st;
    float gate[2][3];
#pragma unroll
    for (int mt = 0; mt < 2; ++mt) {
        st.tl[mt] = 8 * wid + 4 * mt + (fr >> 2);
        const int h = fr & 3;
        const bf16_t* qp = Pb + (long)(qs + st.tl[mt]) * PW + PC_Q + g * 256 + h * 64 + fq * 8;
        st.qf[mt][0] = *(const bf16x8*)(qp); st.qf[mt][1] = *(const bf16x8*)(qp + 32);
        const float* gp = psm + (long)(qs + st.tl[mt]) * 32 + (g * 4 + h) * 3;
        gate[mt][0] = sigmoidf_(gp[0]); gate[mt][1] = sigmoidf_(gp[1]); gate[mt][2] = sigmoidf_(gp[2]);
    }
    {
        const bf16_t* kc = (const bf16_t*)(ws + WS_KCMP) + (long)(b * 2 + g) * 128 * 64;
        const bf16_t* vc = (const bf16_t*)(ws + WS_VCMP) + (long)(b * 2 + g) * 128 * 64;
#pragma unroll
        for (int r = 0; r < 2; ++r) {
            const int e = tid + r * NTHR, row = e >> 3, ch = e & 7;
            *(u32x4*)(smem + NSA_KC + row * NSA_PITCH + ch * 16) = *(const u32x4*)(kc + row * 64 + ch * 8);
            *(u32x4*)(smem + NSA_VC + row * NSA_PITCH + ch * 16) = *(const u32x4*)(vc + row * 64 + ch * 8);
        }
    }
    __syncthreads();
    nsa_cmp_one(smem, st.qf[0][0], st.qf[0][1], qs + st.tl[0], i, gate[0][0], (f32x4*)(smem + NSA_Y) + tid, st.selm[0], lane);
    asm volatile("" ::: "memory");
    __builtin_amdgcn_sched_barrier(0);
    nsa_cmp_one(smem, st.qf[1][0], st.qf[1][1], qs + st.tl[1], i, gate[1][0], (f32x4*)(smem + NSA_Y) + 4 * NTHR + tid, st.selm[1], lane);
    __builtin_amdgcn_sched_barrier(0);
    {
        unsigned u = st.selm[0] | st.selm[1];
        u |= __shfl_xor(u, 4); u |= __shfl_xor(u, 8);
        st.wunion = u;
        unsigned* misc = (unsigned*)(smem + NSA_MISC);
        if (lane == 0) misc[wid] = u;
        __syncthreads();
        unsigned bu = 0u;
#pragma unroll
        for (int w = 0; w < 8; ++w) bu |= misc[w];
        st.bunion = bu;
    }
    nsa_stream<0>(smem, Pb, g, i, st, gate[0][1], gate[1][1], tid);
    nsa_stream<1>(smem, Pb, g, i, st, gate[0][2], gate[1][2], tid);
    bf16_t* mix = (bf16_t*)(p.ws + WS_MIX) + (long)b * SEQ * 1024;
#pragma unroll
    for (int mt = 0; mt < 2; ++mt) {
        bf16_t* op = mix + (long)(qs + st.tl[mt]) * 1024 + g * 256 + (fr & 3) * 64 + fq * 4;
#pragma unroll
        for (int dt = 0; dt < 4; ++dt) {
            const f32x4 yv = *((const f32x4*)(smem + NSA_Y) + (mt * 4 + dt) * NTHR + tid);
            u32x2 w; w.x = pk_bf16(yv[0], yv[1]); w.y = pk_bf16(yv[2], yv[3]);
            *(u32x2*)(op + dt * 16) = w;
        }
    }
    __syncthreads();
}

constexpr int ML_PITCH = 288;
constexpr int ML_Q = 0, ML_K = 18432, ML_V = 36864, ML_VW = 55296, ML_C = 73728, ML_N = 110592, ML_GB = 111104, ML_GA = 119296, ML_GMQ = 127488,
              ML_GS = 135680, ML_ST = 136192;

__device__ __forceinline__ float wave_incl_scan_add(float v, int lane) {
#pragma unroll
    for (int off = 1; off < 64; off <<= 1) { const float o = __shfl_up(v, off); if (lane >= off) v += o; }
    return v;
}
__device__ __forceinline__ float wave_incl_scan_max(float v, int lane) {
#pragma unroll
    for (int off = 1; off < 64; off <<= 1) { const float o = __shfl_up(v, off); if (lane >= off) v = fmaxf(v, o); }
    return v;
}
__device__ __forceinline__ float wave_max(float v) {
#pragma unroll
    for (int off = 32; off >= 1; off >>= 1) v = fmaxf(v, __shfl_xor(v, off));
    return v;
}

__device__ __forceinline__ void mlstm_scan(const Params& p, char* smem, int b, int h) {
    const char* ws = p.ws;
    int tid = threadIdx.x;
    asm volatile("" : "+v"(tid));
    const int lane = tid & 63, wid = __builtin_amdgcn_readfirstlane(tid >> 6), fr = lane & 15, fq = lane >> 4;
    const bf16_t* QK = (const bf16_t*)(ws + WS_QK) + (long)b * SEQ * 1024 + h * 128;
    const bf16_t* Pb = (const bf16_t*)(ws + WS_P) + (long)b * SEQ * PW;
    const float* psm = (const float*)(ws + WS_PSM) + (long)b * SEQ * 32;
    bf16_t* mix = (bf16_t*)(p.ws + WS_MIX) + (long)b * SEQ * 1024 + 512 + h * 128;
    float* GB = (float*)(smem + ML_GB); float* GA = (float*)(smem + ML_GA); float* GMQ = (float*)(smem + ML_GMQ);
    float* GS = (float*)(smem + ML_GS);
    float* NV = (float*)(smem + ML_N);
    float* ST = (float*)(smem + ML_ST);
    {
        const float ib = p.in[I_IBIAS][h], fb = p.in[I_FBIAS][h];
        for (int c = wid; c < 32; c += 8) {
            const int t = c * 64 + lane;
            const float ipre = psm[(long)t * 32 + 24 + h], fpre = psm[(long)t * 32 + 28 + h];
            const float li = ipre + ib;
            const float x = fpre + fb;
            const float lf = fminf(x, 0.f) - log1pf(__expf(-fabsf(x)));
            const float bb = wave_incl_scan_add(lf, lane);
            const float aa = li - bb;
            const float g = __shfl(bb, 63);
            const float pm = wave_incl_scan_max(aa, lane);
            const float mloc = wave_max(g + aa);
            GB[t] = bb; GA[t] = aa; GMQ[t] = pm;
            if (lane == 0) { GS[64 + c] = g; GS[96 + c] = mloc; }
        }
    }
    for (int e = tid; e < 36864 / 16; e += NTHR) *(u32x4*)(smem + ML_C + e * 16) = (u32x4){0u, 0u, 0u, 0u};
    if (tid < 128) NV[tid] = 0.f;
    __syncthreads();
    if (tid == 0) {
        float m = 0.f;
        for (int c = 0; c < 32; ++c) { GS[c] = m; const float mn = fmaxf(GS[64 + c] + m, GS[96 + c]); GS[32 + c] = mn; m = mn; }
    }
    __syncthreads();
    for (int t = tid; t < SEQ; t += NTHR) GMQ[t] = GB[t] + fmaxf(GS[t >> 6], GMQ[t]);
    __syncthreads();

    f32x4 Cacc[9];
#pragma unroll
    for (int c9 = 0; c9 < 9; ++c9) Cacc[c9] = (f32x4){0.f, 0.f, 0.f, 0.f};
    const int lrow = tid >> 4, lch = tid & 15;
    u32x4 rq[2], rk[2], rv[2];
#pragma unroll
    for (int i2 = 0; i2 < 2; ++i2) {
        const int row = lrow + 32 * i2;
        rq[i2] = *(const u32x4*)(QK + (long)row * 1024 + lch * 8);
        rk[i2] = *(const u32x4*)(QK + (long)row * 1024 + 512 + lch * 8);
        rv[i2] = *(const u32x4*)(Pb + (long)row * PW + PC_MV + h * 128 + lch * 8);
    }
    const int mt = wid >> 1, half = wid & 1;
#pragma unroll 1
    for (int c = 0; c < 32; ++c) {
        const float m_old = GS[c], m_new = GS[32 + c], gch = GS[64 + c];
#pragma unroll
        for (int i2 = 0; i2 < 2; ++i2) {
            const int row = lrow + 32 * i2;
            *(u32x4*)(smem + ML_Q + row * ML_PITCH + lch * 16) = rq[i2];
            *(u32x4*)(smem + ML_K + row * ML_PITCH + lch * 16) = rk[i2];
            *(u32x4*)(smem + ML_V + row * ML_PITCH + lch * 16) = rv[i2];
            const float wk = __expf(gch + GA[c * 64 + row] - m_new);
            u32x4 w;
            w.x = pk_bf16(bf_lo(rv[i2].x) * wk, bf_hi(rv[i2].x) * wk); w.y = pk_bf16(bf_lo(rv[i2].y) * wk, bf_hi(rv[i2].y) * wk);
            w.z = pk_bf16(bf_lo(rv[i2].z) * wk, bf_hi(rv[i2].z) * wk); w.w = pk_bf16(bf_lo(rv[i2].w) * wk, bf_hi(rv[i2].w) * wk);
            *(u32x4*)(smem + ML_VW + row * ML_PITCH + lch * 16) = w;
        }
        if (tid < 128) {
            const int row = tid >> 1, hf = tid & 1;
            const float wk = __expf(gch + GA[c * 64 + row] - m_new);
            u32x4 w = (u32x4){0u, 0u, 0u, 0u};
            if (hf == 0) w.x = pk_bf16(wk, 0.f);
            *(u32x4*)(smem + ML_VW + row * ML_PITCH + 256 + hf * 16) = w;
        }
        __syncthreads();
        if (c + 1 < 32) {
#pragma unroll
            for (int i2 = 0; i2 < 2; ++i2) {
                const int row = (c + 1) * 64 + lrow + 32 * i2;
                rq[i2] = *(const u32x4*)(QK + (long)row * 1024 + lch * 8);
                rk[i2] = *(const u32x4*)(QK + (long)row * 1024 + 512 + lch * 8);
                rv[i2] = *(const u32x4*)(Pb + (long)row * PW + PC_MV + h * 128 + lch * 8);
            }
        }
        const int l = 16 * mt + fr;
        const float bl = GB[c * 64 + l], mq = GMQ[c * 64 + l];
        const float ul = bl - mq;
        f32x4 hv[4];
        float s1 = 0.f, s2 = 0.f;
        {
            bf16x8 qf[4];
#pragma unroll
            for (int ks = 0; ks < 4; ++ks) qf[ks] = *(const bf16x8*)(smem + ML_Q + l * ML_PITCH + (ks * 4 + fq) * 16);
            f32x4 S[4];
#pragma unroll
            for (int nt = 0; nt < 4; ++nt) {
                f32x4 s = (f32x4){0.f, 0.f, 0.f, 0.f};
#pragma unroll
                for (int ks = 0; ks < 4; ++ks) {
                    const bf16x8 kf = *(const bf16x8*)(smem + ML_K + (16 * nt + fr) * ML_PITCH + (ks * 4 + fq) * 16);
                    s = mfma16(kf, qf[ks], s);
                }
                S[nt] = s;
            }
            float dintra = 0.f;
            const int lq = l - 4 * fq;
#pragma unroll
            for (int nt = 0; nt < 4; ++nt) {
                const f32x4 av = *(const f32x4*)(GA + c * 64 + 16 * nt + 4 * fq);
#pragma unroll
                for (int e = 0; e < 4; ++e) {
                    const float w = (16 * nt + e <= lq) ? __expf(ul + av[e]) : 0.f;
                    const float sv = S[nt][e] * w;
                    S[nt][e] = sv; dintra += sv;
                }
            }
            dintra += __shfl_xor(dintra, 16); dintra += __shfl_xor(dintra, 32);
            float dinter = 0.f;
#pragma unroll
            for (int ks = 0; ks < 4; ++ks) {
                const f32x4 n0 = *(const f32x4*)(NV + ks * 32 + fq * 8), n1 = *(const f32x4*)(NV + ks * 32 + fq * 8 + 4);
                const u32x4 qu = __builtin_bit_cast(u32x4, qf[ks]);
                dinter += bf_lo(qu.x) * n0[0] + bf_hi(qu.x) * n0[1] + bf_lo(qu.y) * n0[2] + bf_hi(qu.y) * n0[3]
                        + bf_lo(qu.z) * n1[0] + bf_hi(qu.z) * n1[1] + bf_lo(qu.w) * n1[2] + bf_hi(qu.w) * n1[3];
            }
            dinter += __shfl_xor(dinter, 16); dinter += __shfl_xor(dinter, 32);
            const float winter = __expf(ul + m_old);
            const float den = winter * dinter + dintra;
            const float rden = 1.0f / fmaxf(fabsf(den), __expf(-mq));
            const bf16x8 pf0 = pack_p(S[0], S[1]), pf1 = pack_p(S[2], S[3]);
#pragma unroll
            for (int c4 = 0; c4 < 4; ++c4) {
                const int et = 4 * half + c4;
                f32x4 num = (f32x4){0.f, 0.f, 0.f, 0.f}, inter = (f32x4){0.f, 0.f, 0.f, 0.f};
                num = mfma16(tr_frag_perm(smem + ML_V, ML_PITCH, 0, 16 * et, fr, fq), pf0, num);
                num = mfma16(tr_frag_perm(smem + ML_V, ML_PITCH, 32, 16 * et, fr, fq), pf1, num);
#pragma unroll
                for (int ks = 0; ks < 4; ++ks) {
                    const bf16x8 cf = *(const bf16x8*)(smem + ML_C + (16 * et + fr) * ML_PITCH + (ks * 4 + fq) * 16);
                    inter = mfma16(cf, qf[ks], inter);
                }
                const f32x4 hh = (inter * winter + num) * rden;
                hv[c4] = hh;
                s1 += (hh[0] + hh[1]) + (hh[2] + hh[3]);
                s2 += (hh[0] * hh[0] + hh[1] * hh[1]) + (hh[2] * hh[2] + hh[3] * hh[3]);
            }
            s1 += __shfl_xor(s1, 16); s1 += __shfl_xor(s1, 32);
            s2 += __shfl_xor(s2, 16); s2 += __shfl_xor(s2, 32);
            if (fq == 0) { ST[(l * 2 + half) * 2] = s1; ST[(l * 2 + half) * 2 + 1] = s2; }
        }
        {
            const float decay = __expf(gch + m_old - m_new);
#pragma unroll
            for (int c9 = 0; c9 < 9; ++c9) Cacc[c9] = Cacc[c9] * decay;
#pragma unroll
            for (int ks2 = 0; ks2 < 2; ++ks2) {
                const bf16x8 kt = tr_frag_std(smem + ML_K, ML_PITCH, 32 * ks2, 16 * wid, fr, fq);
#pragma unroll
                for (int c9 = 0; c9 < 9; ++c9) {
                    const bf16x8 vw = tr_frag_std(smem + ML_VW, ML_PITCH, 32 * ks2, 16 * c9, fr, fq);
                    Cacc[c9] = mfma16(kt, vw, Cacc[c9]);
                }
            }
        }
        __syncthreads();
        {
            const float* sp = ST + l * 4;
            const float t1 = sp[0] + sp[2], t2 = sp[1] + sp[3];
            const float mean = t1 * (1.0f / 128.0f);
            const float var = fmaxf(t2 * (1.0f / 128.0f) - mean * mean, 0.f);
            const float rstd = rsqrtf(var + LN_EPS);
            const long tok = c * 64 + l;
#pragma unroll
            for (int c4 = 0; c4 < 4; ++c4) {
                const int col = 64 * half + 16 * c4 + 4 * fq;
                const u32x2 ou = *(const u32x2*)(Pb + tok * PW + PC_MO + h * 128 + col);
                const f32x4 ng = *(const f32x4*)(p.in[I_NORMG] + h * 128 + col);
                const f32x4 y = (hv[c4] - mean) * rstd * ng;
                u32x2 w;
                w.x = pk_bf16(y[0] * sigmoidf_(bf_lo(ou.x)), y[1] * sigmoidf_(bf_hi(ou.x)));
                w.y = pk_bf16(y[2] * sigmoidf_(bf_lo(ou.y)), y[3] * sigmoidf_(bf_hi(ou.y)));
                *(u32x2*)(mix + tok * 1024 + col) = w;
            }
        }
#pragma unroll
        for (int c9 = 0; c9 < 8; ++c9) {
            u32x2 w; w.x = pk_bf16(Cacc[c9][0], Cacc[c9][1]); w.y = pk_bf16(Cacc[c9][2], Cacc[c9][3]);
            *(u32x2*)(smem + ML_C + (16 * c9 + fr) * ML_PITCH + (16 * wid + 4 * fq) * 2) = w;
        }
        if (fr == 0) *(f32x4*)(NV + 16 * wid + 4 * fq) = Cacc[8];
        __syncthreads();
    }
}

__device__ __forceinline__ void phase3(const Params& p, char* smem, int bid, int nb, int rep = 0) {
    XcdSlab xs; xs.init(bid, nb);
    const int nq = xs.x >= 0 ? 128 : 1024;
    int* qctr = (int*)(p.ws + WS_CNT) + 16384 + ((xs.x >= 0 ? xs.x : 0) + 8 * rep) * 32;
    for (int u = bid; u < 64; u += nb) mlstm_scan(p, smem, u >> 2, u & 3);
    volatile int* slot = (volatile int*)(smem + NSA_MISC + 256);
    for (;;) {
        if (opaque_tid() == 0) *slot = atomicAdd(qctr, 1);
        __syncthreads();
        const int k = *slot;
        if (k >= nq) break;
        if (xs.x >= 0) { const int bg = 4 * xs.x + (k & 3); nsa_task(p, smem, bg >> 1, bg & 1, 31 - (k >> 2)); }
        else nsa_task(p, smem, (k & 31) >> 1, k & 1, 31 - (k >> 5));
    }
}

constexpr int XA_PITCH = 544;
constexpr int XA_K = 0, XA_V = 69632;
__device__ __forceinline__ void xattn_task(const Params& p, char* smem, int b, int h, int qb) {
    const char* ws = p.ws;
    int tid = threadIdx.x;
    asm volatile("" : "+v"(tid));
    const int lane = tid & 63, wid = __builtin_amdgcn_readfirstlane(tid >> 6), fr = lane & 15, fq = lane >> 4;
    const bf16_t* XQ = (const bf16_t*)(ws + WS_XQ) + (long)(b * SEQ + qb * 128 + wid * 16 + fr) * 1024 + h * 256 + fq * 8;
    const bf16_t* KV = (const bf16_t*)(ws + WS_KVX) + (long)b * 256 * 2048 + h * 256;
    bf16x8 qf[8];
#pragma unroll
    for (int ks = 0; ks < 8; ++ks) qf[ks] = *(const bf16x8*)(XQ + ks * 32);
    f32x4 O[16];
#pragma unroll
    for (int dt = 0; dt < 16; ++dt) O[dt] = (f32x4){0.f, 0.f, 0.f, 0.f};
    float m = -1e30f, l = 0.f;
    const int lrow = tid >> 5, lch = tid & 31;
    u32x4 rk[4], rv[4];
#pragma unroll
    for (int i2 = 0; i2 < 4; ++i2) {
        const bf16_t* rp = KV + (long)(lrow + 16 * i2) * 2048 + lch * 8;
        rk[i2] = *(const u32x4*)rp; rv[i2] = *(const u32x4*)(rp + 1024);
    }
#pragma unroll
    for (int i2 = 0; i2 < 4; ++i2) {
        *(u32x4*)(smem + XA_K + (lrow + 16 * i2) * XA_PITCH + lch * 16) = rk[i2];
        *(u32x4*)(smem + XA_V + (lrow + 16 * i2) * XA_PITCH + lch * 16) = rv[i2];
    }
    __syncthreads();
#pragma unroll 1
    for (int j = 0; j < 4; ++j) {
        const int buf = j & 1;
        if (j + 1 < 4) {
#pragma unroll
            for (int i2 = 0; i2 < 4; ++i2) {
                const bf16_t* rp = KV + (long)((j + 1) * 64 + lrow + 16 * i2) * 2048 + lch * 8;
                rk[i2] = *(const u32x4*)rp; rv[i2] = *(const u32x4*)(rp + 1024);
            }
        }
        const char* KT = smem + XA_K + buf * 34816;
        const char* VT = smem + XA_V + buf * 34816;
        f32x4 S[4];
#pragma unroll
        for (int nt = 0; nt < 4; ++nt) {
            f32x4 s = (f32x4){0.f, 0.f, 0.f, 0.f};
#pragma unroll
            for (int ks = 0; ks < 8; ++ks) {
                const bf16x8 kf = *(const bf16x8*)(KT + (16 * nt + fr) * XA_PITCH + (ks * 4 + fq) * 16);
                s = mfma16(kf, qf[ks], s);
            }
            S[nt] = s * 0.0625f;
        }
        float mx = -INFINITY;
#pragma unroll
        for (int nt = 0; nt < 4; ++nt)
#pragma unroll
            for (int e = 0; e < 4; ++e) mx = fmaxf(mx, S[nt][e]);
        mx = fmaxf(mx, __shfl_xor(mx, 16)); mx = fmaxf(mx, __shfl_xor(mx, 32));
        const float mnew = fmaxf(m, mx);
        const float alpha = __expf(m - mnew);
        float rs = 0.f;
#pragma unroll
        for (int nt = 0; nt < 4; ++nt)
#pragma unroll
            for (int e = 0; e < 4; ++e) { const float pv = __expf(S[nt][e] - mnew); S[nt][e] = pv; rs += pv; }
        rs += __shfl_xor(rs, 16); rs += __shfl_xor(rs, 32);
        l = l * alpha + rs; m = mnew;
#pragma unroll
        for (int dt = 0; dt < 16; ++dt) O[dt] = O[dt] * alpha;
        const bf16x8 pf0 = pack_p(S[0], S[1]), pf1 = pack_p(S[2], S[3]);
#pragma unroll
        for (int dt = 0; dt < 16; ++dt) {
            O[dt] = mfma16(tr_frag_perm(VT, XA_PITCH, 0, 16 * dt, fr, fq), pf0, O[dt]);
            O[dt] = mfma16(tr_frag_perm(VT, XA_PITCH, 32, 16 * dt, fr, fq), pf1, O[dt]);
        }
        if (j + 1 < 4) {
            char* KTn = smem + XA_K + (buf ^ 1) * 34816; char* VTn = smem + XA_V + (buf ^ 1) * 34816;
#pragma unroll
            for (int i2 = 0; i2 < 4; ++i2) {
                *(u32x4*)(KTn + (lrow + 16 * i2) * XA_PITCH + lch * 16) = rk[i2];
                *(u32x4*)(VTn + (lrow + 16 * i2) * XA_PITCH + lch * 16) = rv[i2];
            }
        }
        __syncthreads();
    }
    const float inv = 1.0f / l;
    bf16_t* op = (bf16_t*)(p.ws + WS_XO) + (long)(b * SEQ + qb * 128 + wid * 16 + fr) * 1024 + h * 256 + fq * 4;
#pragma unroll
    for (int dt = 0; dt < 16; ++dt) {
        u32x2 w; w.x = pk_bf16(O[dt][0] * inv, O[dt][1] * inv); w.y = pk_bf16(O[dt][2] * inv, O[dt][3] * inv);
        *(u32x2*)(op + dt * 16) = w;
    }
}

__device__ __forceinline__ void phase6(const Params& p, char* smem, int bid, int nb) {
    XcdSlab xs; xs.init(bid, nb);
    const int p_lo = xs.m_lo(64), n_t = (xs.m_hi(64) - p_lo) * 16;
    for (int u = xs.j; u < n_t; u += xs.stride) { const int pr = p_lo + (u >> 4); xattn_task(p, smem, pr >> 2, pr & 3, u & 15); }
}

constexpr int LN_ST = 139264, LN_GB = 141312, MOE_TAB = 149504;

__device__ __forceinline__ void phase4(const Params& p, char* smem, int bid, int nb) {
    char* ws = p.ws;
    XcdSlab xs; xs.init(bid, nb);
    const int m_lo = xs.m_lo(128), n_t = (xs.m_hi(128) - m_lo) * 4;
    for (int u = xs.j; u < n_t; u += xs.stride) {
        const int mt = m_lo + (u >> 2), nt = u & 3;
        RingRows al, bl;
        al.init_contig((const bf16_t*)(ws + WS_MIX), 1024, mt * 256);
        bl.init_contig((const bf16_t*)(ws + WS_WOUT), 1024, nt * 256, true);
        f32x4 acc[8][4];
        gemm_ring(smem, al, bl, 32, acc);
        epi_residual<false>(acc, smem, p.in[I_X], nullptr, nullptr, nullptr, (float*)(ws + WS_R1), (bf16_t*)(ws + WS_R1B), (float*)(ws + WS_ST1), mt * 256, nt);
    }
}

__device__ __forceinline__ void init_ln_loader(RingLN& al, char* smem, const bf16_t* r, bf16_t* xcopy, int row0) {
    al.raw.init_contig(r, 1024, row0);
    al.xbase = xcopy ? xcopy + (long)row0 * 1024 : nullptr;
    al.st = (const float*)(smem + LN_ST); al.gb = (const float*)(smem + LN_GB);
}

__device__ __forceinline__ void phase5(const Params& p, char* smem, int bid, int nb) {
    char* ws = p.ws;
    ln_load_gb((float*)(smem + LN_GB), p.in[I_LN1G], p.in[I_LN1B]);
    XcdSlab xs; xs.init(bid, nb);
    const int m_lo = xs.m_lo(128), n_t = (xs.m_hi(128) - m_lo) * 4;
    for (int u = xs.j; u < n_t; u += xs.stride) {
        const int mt = m_lo + (u >> 2), nt = u & 3;
        ln_tile_stats((float*)(smem + LN_ST), (const float*)(ws + WS_ST1), mt * 256);
        __syncthreads();
        RingLN al; RingRows bl;
        init_ln_loader(al, smem, (const bf16_t*)(ws + WS_R1B), nullptr, mt * 256);
        bl.init_contig((const bf16_t*)(ws + WS_WQ), 1024, nt * 256, true);
        f32x4 acc[8][4];
        gemm_ring(smem, al, bl, 32, acc);
        epi_store_bf16(acc, (bf16_t*)(ws + WS_XQ), 1024, mt * 256, nt * 256);
    }
}

__device__ __forceinline__ void phase7(const Params& p, char* smem, int bid, int nb) {
    char* ws = p.ws;
    XcdSlab xs; xs.init(bid, nb);
    const int m_lo = xs.m_lo(128), n_t = (xs.m_hi(128) - m_lo) * 4;
    for (int u = xs.j; u < n_t; u += xs.stride) {
        const int mt = m_lo + (u >> 2), nt = u & 3;
        RingRows al, bl;
        al.init_contig((const bf16_t*)(ws + WS_XO), 1024, mt * 256);
        bl.init_contig((const bf16_t*)(ws + WS_WO), 1024, nt * 256, true);
        f32x4 acc[8][4];
        gemm_ring(smem, al, bl, 32, acc);
        epi_residual<true>(acc, smem, (const float*)(ws + WS_R1), (const float*)(ws + WS_ST1), p.in[I_LN1G], p.in[I_LN1B],
                           (float*)(ws + WS_R2), (bf16_t*)(ws + WS_R2B), (float*)(ws + WS_ST2), mt * 256, nt);
    }
}

template <class RowMap>
__device__ __forceinline__ void epi_swiglu(const f32x4 (&acc)[8][4], bf16_t* out, int ld, int nt, const RowMap& rm) {
    const int tid_ = opaque_tid();
    const int lane = tid_ & 63, wid = tid_ >> 6;
    const int wr = wid >> 2, wc = wid & 3, fr = lane & 15, fq = lane >> 4;
#pragma unroll
    for (int mi = 0; mi < 8; ++mi) {
        const long orow = rm(wr * 128 + mi * 16 + fr);
        if (orow >= 0) {
            const f32x4 a0 = acc[mi][0], b0 = acc[mi][1], a1 = acc[mi][2], b1 = acc[mi][3];
            u32x4 w;
            w.x = pk_bf16(siluf_(a0[0]) * b0[0], siluf_(a0[1]) * b0[1]); w.y = pk_bf16(siluf_(a0[2]) * b0[2], siluf_(a0[3]) * b0[3]);
            w.z = pk_bf16(siluf_(a1[0]) * b1[0], siluf_(a1[1]) * b1[1]); w.w = pk_bf16(siluf_(a1[2]) * b1[2], siluf_(a1[3]) * b1[3]);
            *(u32x4*)(out + orow * ld + nt * 128 + wc * 32 + fq * 8) = w;
        }
    }
}
struct RowIdent { long row0; __device__ __forceinline__ long operator()(int rl) const { return row0 + rl; } };

__device__ __forceinline__ void route_half(const Params& p, char* smem, int tok0, int rep) {
    char* ws = p.ws;
    float* sc = (float*)smem;
    int* se = (int*)(sc + 128 * 257);
    float* sw = sc + 128 * 257 + 1024;
    const float* bias = p.in[I_ROUTB];
    const int tid = opaque_tid(), tk = tid >> 2, q = tid & 3;
    float* row = sc + tk * 257;
    float gs0, gs1;
    {
        float a1 = -INFINITY, a2 = -INFINITY, b1 = -INFINITY, b2 = -INFINITY;
#pragma unroll 4
        for (int i = 0; i < 32; ++i) {
            const int ii = (i + 8 * q) & 31;
            const float v = row[64 * q + ii], w = row[64 * q + 32 + ii];
            if (v > a1) { a2 = a1; a1 = v; } else if (v > a2) a2 = v;
            if (w > b1) { b2 = b1; b1 = w; } else if (w > b2) b2 = w;
        }
        gs0 = a1 + a2; gs1 = b1 + b2;
    }
    const int lbase = (tid & 63) & ~3;
    float g8[8];
#pragma unroll
    for (int k = 0; k < 4; ++k) { g8[2 * k] = __shfl(gs0, lbase + k); g8[2 * k + 1] = __shfl(gs1, lbase + k); }
    unsigned gsel = 0u;
#pragma unroll
    for (int a = 0; a < 8; ++a) {
        int rank = 0;
#pragma unroll
        for (int b = 0; b < 8; ++b) rank += (g8[b] > g8[a] || (g8[b] == g8[a] && b < a)) ? 1 : 0;
        if (rank < 4) gsel |= 1u << a;
    }
    const bool on0 = ((gsel >> (2 * q)) & 1u) != 0u, on1 = ((gsel >> (2 * q + 1)) & 1u) != 0u;
    float wsum = 0.f;
#pragma unroll 1
    for (int r = 0; r < 8; ++r) {
        float bv = -INFINITY; int bi = 1 << 30;
        if (on0) {
#pragma unroll 4
            for (int i = 0; i < 32; ++i) { const int idx = 64 * q + ((i + 8 * q) & 31); const float v = row[idx]; if (v > bv || (v == bv && idx < bi)) { bv = v; bi = idx; } }
        }
        if (on1) {
#pragma unroll 4
            for (int i = 0; i < 32; ++i) { const int idx = 64 * q + 32 + ((i + 8 * q) & 31); const float v = row[idx]; if (v > bv || (v == bv && idx < bi)) { bv = v; bi = idx; } }
        }
#pragma unroll
        for (int off = 1; off <= 2; off <<= 1) {
            const float ov = __shfl_xor(bv, off); const int oi = __shfl_xor(bi, off);
            if (ov > bv || (ov == bv && oi < bi)) { bv = ov; bi = oi; }
        }
        bi &= 255;
        const float s = bv - bias[bi];
        wsum += s;
        if ((bi >> 6) == q) row[bi] = -INFINITY;
        if (q == 0) { se[tk * 8 + r] = bi; sw[tk * 8 + r] = s; }
    }
    int* lc = (int*)(smem + MOE_TAB); int* gbase = lc + 256;
    if (tid < 256) lc[tid] = 0;
    __syncthreads();
    int mye[2], myr[2];
#pragma unroll
    for (int u = 0; u < 2; ++u) { mye[u] = se[tk * 8 + 2 * q + u]; myr[u] = atomicAdd(lc + mye[u], 1); }
    __syncthreads();
    if (tid < 256) { const int n = lc[tid]; if (n > 0) gbase[tid] = atomicAdd((int*)(ws + WS_CNT) + 8192 * rep + tid * 32, n); }
    __syncthreads();
    {
        const long t = tok0 + tk;
#pragma unroll
        for (int u = 0; u < 2; ++u) {
            const int k = 2 * q + u;
            const int e = mye[u];
            const float w = sw[tk * 8 + k] / wsum * 2.5f;
            const int pos = gbase[e] + myr[u];
            ((int*)(ws + WS_SELE))[t * 8 + k] = e;
            ((int*)(ws + WS_SELP))[t * 8 + k] = pos;
            ((float*)(ws + WS_SELW))[t * 8 + k] = w;
            ((int*)(ws + WS_TOKL))[(long)e * LIST_CAP + pos] = (int)t;
            ((float*)(ws + WS_WL))[(long)e * LIST_CAP + pos] = w;
        }
    }
    __syncthreads();
}

__device__ __forceinline__ void phase8(const Params& p, char* smem, int bid, int nb, int rep = 0) {
    char* ws = p.ws;
    ln_load_gb((float*)(smem + LN_GB), p.in[I_LN2G], p.in[I_LN2B]);
    XcdSlab xs; xs.init(bid, nb);
    const int m_lo = xs.m_lo(128), m_n = xs.m_hi(128) - m_lo;
    for (int u = xs.j; u < m_n; u += xs.stride) {
        const int mt = m_lo + u;
        ln_tile_stats((float*)(smem + LN_ST), (const float*)(ws + WS_ST2), mt * 256);
        __syncthreads();
        float* gsc = (float*)(ws + WS_RSC);
        {
            RingLN al; RingRows bl;
            init_ln_loader(al, smem, (const bf16_t*)(ws + WS_R2B), (bf16_t*)(ws + WS_X2), mt * 256);
            bl.init_contig((const bf16_t*)(ws + WS_WR), 1024, 0, true);
            f32x4 acc[8][4];
            gemm_ring(smem, al, bl, 32, acc);
            const int tid_ = opaque_tid();
            const int lane = tid_ & 63, wid = tid_ >> 6;
            const int wr = wid >> 2, wc = wid & 3, fr = lane & 15, fq = lane >> 4;
            const float* bias = p.in[I_ROUTB];
#pragma unroll
            for (int ni = 0; ni < 4; ++ni) {
                const int col = wc * 64 + (ni >> 1) * 32 + fq * 8 + (ni & 1) * 4;
                const f32x4 bv = *(const f32x4*)(bias + col);
#pragma unroll
                for (int mi = 0; mi < 8; ++mi) {
                    f32x4 v;
#pragma unroll
                    for (int e = 0; e < 4; ++e) v[e] = sigmoidf_(acc[mi][ni][e]) + bv[e];
                    *(f32x4*)(gsc + (long)(mt * 256 + wr * 128 + mi * 16 + fr) * 256 + col) = v;
                }
            }
        }
        __syncthreads();
#pragma unroll 1
        for (int half = 0; half < 2; ++half) {
            float* sc = (float*)smem;
            for (int e4 = opaque_tid(); e4 < 128 * 64; e4 += NTHR) {
                const int r = e4 >> 6, c4 = (e4 & 63) * 4;
                const f32x4 v = *(const f32x4*)(gsc + (long)(mt * 256 + half * 128 + r) * 256 + c4);
                sc[r * 257 + c4] = v[0]; sc[r * 257 + c4 + 1] = v[1]; sc[r * 257 + c4 + 2] = v[2]; sc[r * 257 + c4 + 3] = v[3];
            }
            __syncthreads();
            route_half(p, smem, mt * 256 + half * 128, rep);
        }
    }
    for (int u = (xs.j + xs.stride - m_n % xs.stride) % xs.stride; u < m_n * 2; u += xs.stride) {
        const int mt = m_lo + (u >> 1), nt = u & 1;
        ln_tile_stats((float*)(smem + LN_ST), (const float*)(ws + WS_ST2), mt * 256);
        __syncthreads();
        RingLN al; RingRows bl;
        init_ln_loader(al, smem, (const bf16_t*)(ws + WS_R2B), nullptr, mt * 256);
        bl.init_contig((const bf16_t*)(ws + WS_WS13), 1024, nt * 256);
        f32x4 acc[8][4];
        gemm_ring(smem, al, bl, 32, acc);
        __syncthreads();
        RowIdent rm; rm.row0 = (long)mt * 256;
        epi_swiglu(acc, (bf16_t*)(ws + WS_HS), 256, nt, rm);
    }
}

template <int XMODE>
__device__ __forceinline__ void phase_probe(const Params& p, char* smem, int bid, int nb) {
    char* ws = p.ws;
    XcdSlab xs; xs.init(bid, nb);
    const int m_lo = xs.m_lo(128), n_t = (xs.m_hi(128) - m_lo) * 4;
    for (int u = xs.j; u < n_t; u += xs.stride) {
        const int mt = m_lo + (u >> 2), nt = u & 3;
        RingRows al, bl;
        al.init_contig((const bf16_t*)(ws + WS_MIX), 1024, mt * 256);
        bl.init_contig((const bf16_t*)(ws + WS_WOUT), 1024, nt * 256, true);
        f32x4 acc[8][4];
        gemm_ring<RingRows, RingRows, XMODE>(smem, al, bl, 32, acc);
        epi_store_bf16(acc, (bf16_t*)(ws + WS_A + 432 * MB), 1024, mt * 256, nt * 256);
    }
}

__device__ __forceinline__ void moe_tables(const Params& p, char* smem, const XcdSlab& xs) {
    int* off = (int*)(smem + MOE_TAB); int* tst = off + 256;
    const int* cnt = (const int*)(p.ws + WS_CNT);
    const int tid = opaque_tid();
    if (tid < 64) {
        int c[4], cs = 0;
#pragma unroll
        for (int k = 0; k < 4; ++k) { c[k] = cnt[(tid * 4 + k) * 32]; cs += c[k]; }
        int ics = cs;
#pragma unroll
        for (int o = 1; o < 64; o <<= 1) { const int a = __shfl_up(ics, o); if (tid >= o) ics += a; }
        int eo = ics - cs;
#pragma unroll
        for (int k = 0; k < 4; ++k) { off[tid * 4 + k] = eo; eo += c[k]; }
    } else if (tid < 128) {
        const int l = tid - 64;
        if (xs.x >= 0) {
            const int tl = l < 32 ? ((cnt[(xs.x + 8 * l) * 32] + 255) >> 8) : 0;
            int it = tl;
#pragma unroll
            for (int o = 1; o < 64; o <<= 1) { const int a = __shfl_up(it, o); if (l >= o) it += a; }
            if (l < 32) tst[l] = it - tl;
            if (l == 31) tst[32] = it;
        } else {
            int c[4], ts = 0;
#pragma unroll
            for (int k = 0; k < 4; ++k) { c[k] = (cnt[(l * 4 + k) * 32] + 255) >> 8; ts += c[k]; }
            int its = ts;
#pragma unroll
            for (int o = 1; o < 64; o <<= 1) { const int a = __shfl_up(its, o); if (l >= o) its += a; }
            int et = its - ts;
#pragma unroll
            for (int k = 0; k < 4; ++k) { tst[l * 4 + k] = et; et += c[k]; }
            if (l == 63) tst[256] = its;
        }
    }
    __syncthreads();
}
__device__ __forceinline__ int moe_find(const int* tst, int nloc, int t) {
    int lo = 0, hi = nloc - 1;
#pragma unroll 1
    while (lo < hi) { const int mid = (lo + hi + 1) >> 1; if (tst[mid] <= t) lo = mid; else hi = mid - 1; }
    return lo;
}
struct RowMoe { long base; int nvalid; __device__ __forceinline__ long operator()(int rl) const { return rl < nvalid ? base + rl : -1; } };

__device__ __forceinline__ void phase9(const Params& p, char* smem, int bid, int nb) {
    char* ws = p.ws;
    XcdSlab xs; xs.init(bid, nb);
    moe_tables(p, smem, xs);
    const int* off = (const int*)(smem + MOE_TAB); const int* tst = off + 256;
    const int* cnt = (const int*)(ws + WS_CNT);
    const int nloc = xs.x >= 0 ? 32 : 256;
    const int ntile = tst[nloc];
    for (int t = xs.j; t < ntile * 2; t += xs.stride) {
        const int et = t >> 1, nt = t & 1;
        const int kl = moe_find(tst, nloc, et), e = xs.x >= 0 ? xs.x + 8 * kl : kl, m0 = (et - tst[kl]) * 256, ne = cnt[e * 32];
        const int tid = opaque_tid();
        LoadBf16Rows al; LoadF32KN bl;
        {
            const int* tl = (const int*)(ws + WS_TOKL) + (long)e * LIST_CAP;
            int rows[4];
#pragma unroll
            for (int i = 0; i < 4; ++i) { const int r = m0 + (tid >> 3) + 64 * i; rows[i] = r < ne ? tl[r] : 0; }
            al.init_rows((const bf16_t*)(ws + WS_X2), 1024, rows);
        }
        {
            const int n = tid & 255, kh = tid >> 8;
            const int col = 128 * nt + 32 * (n >> 6) + 8 * ((n >> 2) & 3) + 4 * ((n >> 5) & 1) + (n & 3);
            const float* w = ((n >> 4) & 1) ? p.in[I_MW3] : p.in[I_MW1];
            bl.p = w + (long)e * 1024 * 256 + col + (long)(kh * 32) * 256; bl.ldn = 256; bl.n = n; bl.kh = kh;
        }
        f32x4 acc[8][4];
        gemm_mainloop(smem, al, bl, 16, acc);
        RowMoe rm; rm.base = (long)off[e] + m0; rm.nvalid = ne - m0;
        epi_swiglu(acc, (bf16_t*)(ws + WS_H), 256, nt, rm);
    }
    const int m_lo = xs.m_lo(128), n_t = (xs.m_hi(128) - m_lo) * 4;
    for (int u = (xs.j + xs.stride - (ntile * 2) % xs.stride) % xs.stride; u < n_t; u += xs.stride) {
        const int mt = m_lo + (u >> 2), nt = u & 3;
        RingRows al, bl;
        al.init_contig((const bf16_t*)(ws + WS_HS), 256, mt * 256);
        bl.init_contig((const bf16_t*)(ws + WS_WS2), 256, nt * 256, true);
        f32x4 acc[8][4];
        gemm_ring(smem, al, bl, 8, acc);
        __syncthreads();
        epi_store_bf16(acc, (bf16_t*)(ws + WS_SH), 1024, mt * 256, nt * 256);
    }
}

__device__ __forceinline__ void phase10(const Params& p, char* smem, int bid, int nb) {
    char* ws = p.ws;
    XcdSlab xs; xs.init(bid, nb);
    moe_tables(p, smem, xs);
    const int* off = (const int*)(smem + MOE_TAB); const int* tst = off + 256;
    const int* cnt = (const int*)(ws + WS_CNT);
    const int nloc = xs.x >= 0 ? 32 : 256;
    const int ntile = tst[nloc];
    for (int t = xs.j; t < ntile * 4; t += xs.stride) {
        const int et = t >> 2, nt = t & 3;
        const int kl = moe_find(tst, nloc, et), e = xs.x >= 0 ? xs.x + 8 * kl : kl, m0 = (et - tst[kl]) * 256, ne = cnt[e * 32];
        const int tid = opaque_tid();
        LoadBf16Rows al; LoadF32KN bl;
        al.init_contig((const bf16_t*)(ws + WS_H), 256, off[e] + m0);
        {
            const int n = tid & 255, kh = tid >> 8;
            bl.p = p.in[I_MW2] + (long)e * 256 * 1024 + nt * 256 + bperm(n) + (long)(kh * 32) * 1024; bl.ldn = 1024; bl.n = n; bl.kh = kh;
        }
        f32x4 acc[8][4];
        gemm_mainloop(smem, al, bl, 4, acc);
        {
            const int tid2 = opaque_tid();
            const int lane = tid2 & 63, wid = tid2 >> 6;
            const int wr = wid >> 2, wc = wid & 3, fr = lane & 15, fq = lane >> 4;
            const float* wl = (const float*)(ws + WS_WL) + (long)e * LIST_CAP + m0;
            bf16_t* Y = (bf16_t*)(ws + WS_Y) + ((long)off[e] + m0) * 1024 + nt * 256 + wc * 64 + fq * 8;
#pragma unroll
            for (int mi = 0; mi < 8; ++mi) {
                const int rl = wr * 128 + mi * 16 + fr;
                if (m0 + rl < ne) {
                    const float w = wl[rl];
#pragma unroll
                    for (int q = 0; q < 2; ++q) {
                        u32x4 v; v.x = pk_bf16(acc[mi][2 * q][0] * w, acc[mi][2 * q][1] * w); v.y = pk_bf16(acc[mi][2 * q][2] * w, acc[mi][2 * q][3] * w);
                        v.z = pk_bf16(acc[mi][2 * q + 1][0] * w, acc[mi][2 * q + 1][1] * w); v.w = pk_bf16(acc[mi][2 * q + 1][2] * w, acc[mi][2 * q + 1][3] * w);
                        *(u32x4*)(Y + (long)rl * 1024 + q * 32) = v;
                    }
                }
            }
        }
    }
}

__device__ __forceinline__ void phase11(const Params& p, char* smem, int bid, int nb) {
    char* ws = p.ws;
    XcdSlab xs; xs.init(bid, nb);
    moe_tables(p, smem, xs);
    const int* off = (const int*)(smem + MOE_TAB);
    const int tid = opaque_tid(), lane = tid & 63, wid = tid >> 6;
    const float* r2 = (const float*)(ws + WS_R2);
    const float* st2 = (const float*)(ws + WS_ST2);
    const bf16_t* SH = (const bf16_t*)(ws + WS_SH);
    const bf16_t* Y = (const bf16_t*)(ws + WS_Y);
    const int* sele = (const int*)(ws + WS_SELE); const int* selp = (const int*)(ws + WS_SELP);
    for (int t = bid * 8 + wid; t < T_TOK; t += nb * 8) {
        const f32x4 p0 = *(const f32x4*)(st2 + (long)t * 8), p1 = *(const f32x4*)(st2 + (long)t * 8 + 4);
        const float q1 = (p0[0] + p0[2]) + (p1[0] + p1[2]), q2 = (p0[1] + p0[3]) + (p1[1] + p1[3]);
        const float mean2 = q1 * (1.0f / 1024.0f);
        const float rstd2 = rsqrtf(fmaxf(q2 * (1.0f / 1024.0f) - mean2 * mean2, 0.f) + LN_EPS);
        int yrow[8];
#pragma unroll
        for (int k = 0; k < 8; ++k) yrow[k] = off[sele[(long)t * 8 + k]] + selp[(long)t * 8 + k];
        float v[16];
#pragma unroll
        for (int hseg = 0; hseg < 2; ++hseg) {
            const int col = hseg * 512 + lane * 8;
            const f32x4 a0 = *(const f32x4*)(r2 + (long)t * 1024 + col), a1 = *(const f32x4*)(r2 + (long)t * 1024 + col + 4);
            const f32x4 g0 = *(const f32x4*)(p.in[I_LN2G] + col), g1 = *(const f32x4*)(p.in[I_LN2G] + col + 4);
            const f32x4 b0 = *(const f32x4*)(p.in[I_LN2B] + col), b1 = *(const f32x4*)(p.in[I_LN2B] + col + 4);
            const f32x4 x0 = ((a0 - mean2) * rstd2 * g0 + b0) * ALPHA, x1 = ((a1 - mean2) * rstd2 * g1 + b1) * ALPHA;
            float* vv = v + hseg * 8;
            vv[0] = x0[0]; vv[1] = x0[1]; vv[2] = x0[2]; vv[3] = x0[3]; vv[4] = x1[0]; vv[5] = x1[1]; vv[6] = x1[2]; vv[7] = x1[3];
            const u32x4 s = *(const u32x4*)(SH + (long)t * 1024 + col);
            vv[0] += bf_lo(s.x); vv[1] += bf_hi(s.x); vv[2] += bf_lo(s.y); vv[3] += bf_hi(s.y); vv[4] += bf_lo(s.z); vv[5] += bf_hi(s.z); vv[6] += bf_lo(s.w); vv[7] += bf_hi(s.w);
#pragma unroll
            for (int k = 0; k < 8; ++k) {
                const u32x4 y = *(const u32x4*)(Y + (long)yrow[k] * 1024 + col);
                vv[0] += bf_lo(y.x); vv[1] += bf_hi(y.x); vv[2] += bf_lo(y.y); vv[3] += bf_hi(y.y); vv[4] += bf_lo(y.z); vv[5] += bf_hi(y.z); vv[6] += bf_lo(y.w); vv[7] += bf_hi(y.w);
            }
        }
        float s1 = 0.f;
#pragma unroll
        for (int i = 0; i < 16; ++i) s1 += v[i];
#pragma unroll
        for (int o = 32; o >= 1; o >>= 1) s1 += __shfl_xor(s1, o);
        const float mean = s1 * (1.0f / 1024.0f);
        float s2 = 0.f;
#pragma unroll
        for (int i = 0; i < 16; ++i) { const float d = v[i] - mean; s2 += d * d; }
#pragma unroll
        for (int o = 32; o >= 1; o >>= 1) s2 += __shfl_xor(s2, o);
        const float rstd = rsqrtf(s2 * (1.0f / 1024.0f) + LN_EPS);
#pragma unroll
        for (int hseg = 0; hseg < 2; ++hseg) {
            const int col = hseg * 512 + lane * 8;
            const f32x4 g0 = *(const f32x4*)(p.in[I_LN3G] + col), g1 = *(const f32x4*)(p.in[I_LN3G] + col + 4);
            const f32x4 b0 = *(const f32x4*)(p.in[I_LN3B] + col), b1 = *(const f32x4*)(p.in[I_LN3B] + col + 4);
            const float* vv = v + hseg * 8;
            f32x4 o0, o1;
#pragma unroll
            for (int e = 0; e < 4; ++e) { o0[e] = (vv[e] - mean) * rstd * g0[e] + b0[e]; o1[e] = (vv[4 + e] - mean) * rstd * g1[e] + b1[e]; }
            *(f32x4*)(p.out + (long)t * 1024 + col) = o0; *(f32x4*)(p.out + (long)t * 1024 + col + 4) = o1;
        }
    }
}

#if MEGA
#define XB_TMO      128
#define XB_XCNT(j)  (256  + 64 * (j))
#define XB_XSUB(j)  (1280 + 64 * (j))
#define XB_XGEN(j)  (2304 + 64 * (j))
#define XB_TOP      3328
#define XB_TOPGEN   3392
#define XCD_BAR_WORDS 3456
#define XB_SPIN_CAP (1u << 22)
#define LAS __attribute__((address_space(3)))
__device__ __forceinline__ unsigned xb_ld(unsigned* p)              { return __hip_atomic_load(p, __ATOMIC_RELAXED, __HIP_MEMORY_SCOPE_AGENT); }
__device__ __forceinline__ unsigned xb_add(unsigned* p, unsigned v) { return __hip_atomic_fetch_add(p, v, __ATOMIC_RELAXED, __HIP_MEMORY_SCOPE_AGENT); }
__device__ __forceinline__ unsigned xb_xcc_id() { return (unsigned)__builtin_amdgcn_s_getreg((3 << 11) | 20) & 0xFu; }
#define XB_SPIN(cond, bar) do { unsigned _sp = 0; while (cond) { __builtin_amdgcn_s_sleep(1); \
    if ((++_sp & 255u) == 0u) { if (xb_ld(&(bar)[XB_TMO])) break; if (_sp > XB_SPIN_CAP) { atomicAdd(&(bar)[XB_TMO], 1u); break; } } } } while (0)
struct XcdBarrier { unsigned* bar; unsigned x; volatile LAS unsigned* st; };
__device__ __forceinline__ XcdBarrier xcd_barrier_post(unsigned* bar, volatile LAS unsigned* st) {
    XcdBarrier b; b.bar = bar; b.x = xb_xcc_id(); b.st = st;
    if (threadIdx.x == 0) (void)xb_add(&bar[XB_XCNT(b.x)], 1u);
    return b;
}
__device__ __forceinline__ void xcd_barrier_complete(unsigned* bar, unsigned x, unsigned& nloc, unsigned& nx) {
    const unsigned G = gridDim.x * gridDim.y * gridDim.z;
    unsigned sum, cnt, mine, sp = 0u;
    for (;;) {
        sum = 0u; cnt = 0u; mine = 0u;
#pragma unroll
        for (unsigned j = 0; j < 16; ++j) { const unsigned c = xb_ld(&bar[XB_XCNT(j)]); sum += c; cnt += (c > 0u) ? 1u : 0u; mine = (j == x) ? c : mine; }
        if (sum == G) break;
        __builtin_amdgcn_s_sleep(1);
        if ((++sp & 255u) == 0u) { if (xb_ld(&bar[XB_TMO])) break; if (sp > XB_SPIN_CAP) { atomicAdd(&bar[XB_TMO], 1u); break; } }
    }
    nloc = mine > 0u ? mine : 1u; nx = cnt > 0u ? cnt : 1u;
}
__device__ __forceinline__ void xcd_barrier(const XcdBarrier& b) {
    asm volatile("s_waitcnt vmcnt(0)" ::: "memory");
    __syncthreads();
    if (threadIdx.x == 0) {
        unsigned* bar = b.bar;
        __builtin_amdgcn_s_waitcnt(0);
        unsigned nloc = b.st[0], nx = b.st[1];
        if (nloc == 0u) { xcd_barrier_complete(bar, b.x, nloc, nx); b.st[0] = nloc; b.st[1] = nx; }
        const unsigned old = xb_add(&bar[XB_XSUB(b.x)], 1u);
        const unsigned gen = old / nloc;
        if (old + 1u == (gen + 1u) * nloc) {
            __builtin_amdgcn_fence(__ATOMIC_RELEASE, "agent");
            asm volatile("s_waitcnt vmcnt(0)" ::: "memory");
            const unsigned og = xb_add(&bar[XB_TOP], 1u);
            const unsigned tg = og / nx;
            if (og + 1u == (tg + 1u) * nx) xb_add(&bar[XB_TOPGEN], 1u);
            else XB_SPIN(xb_ld(&bar[XB_TOPGEN]) == tg, bar);
            __builtin_amdgcn_fence(__ATOMIC_ACQUIRE, "agent");
            xb_add(&bar[XB_XGEN(b.x)], 1u);
            asm volatile("s_waitcnt vmcnt(0)" ::: "memory");
        } else {
            XB_SPIN(xb_ld(&bar[XB_XGEN(b.x)]) == gen, bar);
            __builtin_amdgcn_fence(__ATOMIC_ACQUIRE, "agent");
            asm volatile("s_waitcnt vmcnt(0)" ::: "memory");
        }
    }
    __syncthreads();
}
__global__ void __launch_bounds__(NTHR) fwd_mega(Params p) {
    extern __shared__ __attribute__((aligned(16))) char smem[];
    cg::grid_group grid = cg::this_grid();
    const int bid = blockIdx.x, nb = gridDim.x;
    volatile LAS unsigned* xst = (volatile LAS unsigned*)(smem + LDS_BYTES - 16);
    if (threadIdx.x < 4) xst[threadIdx.x] = 0u;
    __syncthreads();
    const XcdBarrier xb = xcd_barrier_post((unsigned*)(p.ws + WS_BAR), xst);
#define GSYNC() xcd_barrier(xb)
#ifndef PROBE_REPEAT
#define PROBE_REPEAT 0
#endif
#define REP(n, call) if (PROBE_REPEAT & (1 << n)) { call; GSYNC(); }
    if (PROBE_REPEAT & 1) { phase0(p, smem, bid, nb); GSYNC(); }
    phase0(p, smem, bid, nb);  grid.sync();
    REP(1, phase1<1>(p, smem, bid, nb))
    phase1(p, smem, bid, nb);  GSYNC();
    REP(2, phase2(p, smem, bid, nb))
    phase2(p, smem, bid, nb);  GSYNC();
    REP(3, phase3(p, smem, bid, nb, 1))
    phase3(p, smem, bid, nb);  GSYNC();
    REP(4, phase4(p, smem, bid, nb))
#ifdef PROBE_X
    phase_probe<PROBE_X>(p, smem, bid, nb); GSYNC();
#endif
    phase4(p, smem, bid, nb);  GSYNC();
    REP(5, phase5(p, smem, bid, nb))
    phase5(p, smem, bid, nb);  GSYNC();
    REP(6, phase6(p, smem, bid, nb))
    phase6(p, smem, bid, nb);  GSYNC();
    REP(7, phase7(p, smem, bid, nb))
    phase7(p, smem, bid, nb);  GSYNC();
    REP(8, phase8(p, smem, bid, nb, 1))
    phase8(p, smem, bid, nb);  GSYNC();
    REP(9, phase9(p, smem, bid, nb))
    phase9(p, smem, bid, nb);  GSYNC();
    REP(10, phase10(p, smem, bid, nb))
    phase10(p, smem, bid, nb); GSYNC();
    REP(11, phase11(p, smem, bid, nb))
    phase11(p, smem, bid, nb);
}
#else
#define PHASE_KERNEL(n) __global__ void __launch_bounds__(NTHR) fwd_phase##n(Params p) { extern __shared__ __attribute__((aligned(16))) char smem[]; phase##n(p, smem, blockIdx.x, gridDim.x); }
PHASE_KERNEL(0) PHASE_KERNEL(1) PHASE_KERNEL(2) PHASE_KERNEL(3) PHASE_KERNEL(4) PHASE_KERNEL(5)
PHASE_KERNEL(6) PHASE_KERNEL(7) PHASE_KERNEL(8) PHASE_KERNEL(9) PHASE_KERNEL(10) PHASE_KERNEL(11)
typedef void (*phase_fn)(Params);
#endif

extern "C" void kernel_launch(void* const* d_in, const int* in_sizes, int n_in, void* d_out, int out_size, void* d_ws, size_t ws_size, hipStream_t stream) {
    Params p{};
    for (int i = 0; i < 32; ++i) p.in[i] = (const float*)d_in[i];
    p.out = (float*)d_out;
    p.ws = (char*)d_ws;
    if (n_in != 32 || ws_size < WS_END) { fprintf(stderr, "kernel_launch: unexpected inputs (n_in %d) or workspace too small (%zu < %zu)\n", n_in, ws_size, (size_t)WS_END); return; }
#if MEGA
    static int grid = 0;
    if (!grid) {
        int dev = 0, cus = 0, per_cu = 0;
        (void)hipGetDevice(&dev);
        (void)hipDeviceGetAttribute(&cus, hipDeviceAttributeMultiprocessorCount, dev);
        (void)hipFuncSetAttribute((const void*)fwd_mega, hipFuncAttributeMaxDynamicSharedMemorySize, LDS_BYTES);
        (void)hipOccupancyMaxActiveBlocksPerMultiprocessor(&per_cu, (const void*)fwd_mega, NTHR, LDS_BYTES);
        if (per_cu < 1) { fprintf(stderr, "kernel_launch: occupancy query says %d blocks/CU\n", per_cu); per_cu = 1; }
        grid = cus;
    }
    (void)hipMemsetAsync((char*)d_ws + WS_BAR, 0, 16384, stream);
    void* args[] = {&p};
    hipError_t e = hipLaunchCooperativeKernel((const void*)fwd_mega, dim3(grid), dim3(NTHR), args, LDS_BYTES, stream);
    if (e != hipSuccess) fprintf(stderr, "cooperative launch failed: %s (grid %d)\n", hipGetErrorString(e), grid);
#else
    static const phase_fn fns[12] = {fwd_phase0, fwd_phase1, fwd_phase2, fwd_phase3, fwd_phase4, fwd_phase5, fwd_phase6, fwd_phase7, fwd_phase8, fwd_phase9, fwd_phase10, fwd_phase11};
    static bool attr = false;
    if (!attr) { for (int i = 0; i < 12; ++i) (void)hipFuncSetAttribute((const void*)fns[i], hipFuncAttributeMaxDynamicSharedMemorySize, LDS_BYTES); attr = true; }
    for (int i = 0; i < 12; ++i) hipLaunchKernelGGL(fns[i], dim3(256), dim3(NTHR), LDS_BYTES, stream, p);
#endif
}
```

```cpp
#include <hip/hip_runtime.h>
#include <hip/hip_cooperative_groups.h>
#include <stdint.h>
#include <stdio.h>
namespace cg = cooperative_groups;

#ifndef MEGA
#define MEGA 1
#endif

typedef unsigned short bf16_t;
typedef short bf16x8 __attribute__((ext_vector_type(8)));
typedef short s16x4 __attribute__((ext_vector_type(4)));
typedef float f32x4 __attribute__((ext_vector_type(4)));
typedef float f32x2 __attribute__((ext_vector_type(2)));
typedef unsigned u32x4 __attribute__((ext_vector_type(4)));
typedef unsigned u32x2 __attribute__((ext_vector_type(2)));
typedef __bf16 bf16x2_t __attribute__((ext_vector_type(2)));

constexpr int T_TOK = 32768, DM = 1024, NB = 16, SEQ = 2048;
constexpr int PW = 3328;
constexpr int PC_Q = 0, PC_KC = 512, PC_VC = 640, PC_KS = 768, PC_VS = 896, PC_KW = 1024, PC_VW = 1152;
constexpr int PC_MQ = 1280, PC_MK = 1792, PC_MV = 2304, PC_MO = 2816;
constexpr float ALPHA = 1.189207115002721f;
constexpr float LN_EPS = 1e-5f;
constexpr int NTHR = 512;
constexpr int LDS_BYTES = 160 * 1024;
constexpr int NEXP = 256, TOPK = 8;
constexpr int LIST_CAP = 32768;

constexpr size_t al256(size_t x) { return (x + 255) & ~(size_t)255; }
constexpr size_t WS_WIN = 0;
constexpr size_t WS_WOUT = WS_WIN + al256((size_t)3360 * 1024 * 2);
constexpr size_t WS_WQ = WS_WOUT + (size_t)1024 * 1024 * 2;
constexpr size_t WS_WKV = WS_WQ + (size_t)1024 * 1024 * 2;
constexpr size_t WS_WO = WS_WKV + (size_t)2048 * 1024 * 2;
constexpr size_t WS_WR = WS_WO + (size_t)1024 * 1024 * 2;
constexpr size_t WS_WS13 = WS_WR + (size_t)256 * 1024 * 2;
constexpr size_t WS_WS2 = WS_WS13 + (size_t)512 * 1024 * 2;
constexpr size_t WS_CK1 = WS_WS2 + (size_t)1024 * 256 * 2;
constexpr size_t WS_CK2 = WS_CK1 + (size_t)64 * 2048 * 2;
constexpr size_t WS_CV1 = WS_CK2 + (size_t)64 * 64 * 2;
constexpr size_t WS_CV2 = WS_CV1 + (size_t)64 * 2048 * 2;
constexpr size_t MB = 1024 * 1024;
constexpr size_t WS_LNP = al256(WS_CV2 + (size_t)64 * 64 * 2);
constexpr size_t WS_LNF = WS_LNP + (size_t)2 * 16 * 1792 * 4;
constexpr size_t WS_A = al256(WS_LNF + (size_t)2 * 1792 * 4 + 65536);
constexpr size_t WS_P = WS_A;
constexpr size_t WS_R1 = WS_A;
constexpr size_t WS_XQ = WS_A + 128 * MB;
constexpr size_t WS_XO = WS_A + 192 * MB;
constexpr size_t WS_XB = WS_A + 208 * MB;
constexpr size_t WS_MEMB = WS_A + 272 * MB;
constexpr size_t WS_PSM = WS_A + 280 * MB;
constexpr size_t WS_KCMP = WS_A + 284 * MB;
constexpr size_t WS_VCMP = WS_KCMP + (size_t)16 * 2 * 128 * 64 * 2;
constexpr size_t WS_QK = WS_A + 285 * MB;
constexpr size_t WS_MIX = WS_A + 349 * MB;
constexpr size_t WS_KVX = WS_A + 413 * MB;
constexpr size_t WS_X2 = WS_A + 256 * MB;
constexpr size_t WS_HS = WS_A + 320 * MB;
constexpr size_t WS_R1B = WS_A + 208 * MB;
constexpr size_t WS_R2B = WS_A + 128 * MB;
constexpr size_t WS_RSC = WS_A;
constexpr size_t WS_Y = WS_A;
constexpr size_t WS_B = WS_A + al256((size_t)(T_TOK * 8 + 256) * 1024 * 2);
constexpr size_t WS_R2 = WS_B;
constexpr size_t WS_ST1 = WS_R2 + (size_t)T_TOK * 1024 * 4;
constexpr size_t WS_ST2 = WS_ST1 + (size_t)T_TOK * 8 * 4;
constexpr size_t WS_SH = WS_ST2 + (size_t)T_TOK * 8 * 4;
constexpr size_t WS_SELE = WS_SH + (size_t)T_TOK * 1024 * 2;
constexpr size_t WS_SELP = WS_SELE + (size_t)T_TOK * 8 * 4;
constexpr size_t WS_SELW = WS_SELP + (size_t)T_TOK * 8 * 4;
constexpr size_t WS_CNT = WS_SELW + (size_t)T_TOK * 8 * 4;
constexpr size_t WS_TOKL = WS_CNT + 98304;
constexpr size_t WS_WL = WS_TOKL + (size_t)NEXP * LIST_CAP * 4;
constexpr size_t WS_H = WS_WL + (size_t)NEXP * LIST_CAP * 4;
constexpr size_t WS_BAR = WS_H + (size_t)(T_TOK * 8 + 256) * 256 * 2;
constexpr size_t WS_END = WS_BAR + 16384;
static_assert((size_t)T_TOK * PW * 2 <= 208 * MB, "P region");
static_assert(WS_END <= (size_t)1024 * MB, "workspace must fit 1 GiB");

struct Params {
    const float* in[32];
    float* out;
    char* ws;
};

__device__ __forceinline__ unsigned pk_bf16(float lo, float hi) {
    f32x2 v = {lo, hi};
    bf16x2_t r = __builtin_convertvector(v, bf16x2_t);
    return __builtin_bit_cast(unsigned, r);
}
__device__ __forceinline__ float bf_lo(unsigned u) { return __uint_as_float(u << 16); }
__device__ __forceinline__ float bf_hi(unsigned u) { return __uint_as_float(u & 0xffff0000u); }
__device__ __forceinline__ float bf2f(bf16_t h) { return __uint_as_float(((unsigned)h) << 16); }
__device__ __forceinline__ float sigmoidf_(float x) { return 1.0f / (1.0f + __expf(-x)); }
__device__ __forceinline__ float siluf_(float x) { return x / (1.0f + __expf(-x)); }
__device__ __forceinline__ f32x4 mfma16(bf16x8 a, bf16x8 b, f32x4 c) { return __builtin_amdgcn_mfma_f32_16x16x32_bf16(a, b, c, 0, 0, 0); }
__device__ __forceinline__ bf16x8 as_bf16x8(u32x4 v) { return __builtin_bit_cast(bf16x8, v); }

__device__ __forceinline__ int opaque_tid() { int t = threadIdx.x; asm volatile("" : "+v"(t)); return t; }

__device__ __forceinline__ int tile_off(int row, int chunk) { return row * 128 + ((chunk ^ (row & 7)) << 4); }

__device__ __forceinline__ int bperm(int rho) { return (rho & ~31) + 8 * ((rho >> 2) & 3) + 4 * ((rho >> 4) & 1) + (rho & 3); }

typedef __attribute__((address_space(3))) unsigned lds_u32;
typedef __attribute__((address_space(1))) const unsigned glb_u32;

struct LoadBf16Rows {
    const bf16_t* base;
    unsigned off[4];
    int ldst;
    struct Regs { int dummy; };
    __device__ __forceinline__ void init_contig(const bf16_t* b, int ld, int row0) {
        const int tid_ = opaque_tid();
        const int r8 = tid_ >> 3, kc = (tid_ & 7) ^ (r8 & 7);
        ldst = tid_ * 16;
        base = b + (long)row0 * ld;
#pragma unroll
        for (int i = 0; i < 4; ++i) off[i] = (unsigned)((r8 + 64 * i) * ld + kc * 8);
    }
    __device__ __forceinline__ void init_rows(const bf16_t* b, int ld, const int (&rows)[4]) {
        const int tid_ = opaque_tid();
        const int r8 = tid_ >> 3, kc = (tid_ & 7) ^ (r8 & 7);
        ldst = tid_ * 16;
        base = b;
#pragma unroll
        for (int i = 0; i < 4; ++i) off[i] = (unsigned)rows[i] * (unsigned)ld + (unsigned)(kc * 8);
    }
    __device__ __forceinline__ void issue(Regs&, char* s, int kt) const {
#pragma unroll
        for (int i = 0; i < 4; ++i)
            __builtin_amdgcn_global_load_lds((glb_u32*)(base + (size_t)(off[i] + (unsigned)(kt * 64))), (lds_u32*)(s + i * 8192 + ldst), 16, 0, 0);
    }
    __device__ __forceinline__ void commit(const Regs&, char*, int) const {}
};

struct LoadF32KN {
    const float* p;
    int ldn;
    int n, kh;
    struct Regs { float v[32]; };
    __device__ __forceinline__ void issue(Regs& r, char*, int kt) const {
        const float* q = p + (long)kt * 64 * ldn;
#pragma unroll
        for (int j = 0; j < 32; ++j) r.v[j] = q[(long)j * ldn];
    }
    __device__ __forceinline__ void commit(const Regs& r, char* s, int kt) const {
#pragma unroll
        for (int q = 0; q < 4; ++q) {
            u32x4 w;
            w.x = pk_bf16(r.v[8 * q + 0], r.v[8 * q + 1]); w.y = pk_bf16(r.v[8 * q + 2], r.v[8 * q + 3]);
            w.z = pk_bf16(r.v[8 * q + 4], r.v[8 * q + 5]); w.w = pk_bf16(r.v[8 * q + 6], r.v[8 * q + 7]);
            *(u32x4*)(s + tile_off(n, kh * 4 + q)) = w;
        }
    }
};

struct LoadLN {
    LoadBf16Rows raw;
    bf16_t* xbase;
    const float* st;
    const float* gb;
    typedef LoadBf16Rows::Regs Regs;
    __device__ __forceinline__ void issue(Regs& r, char* s, int kt) const { raw.issue(r, s, kt); }
    __device__ __forceinline__ void commit(const Regs&, char* s, int kt) const {
        asm volatile("s_waitcnt vmcnt(0)" ::: "memory");
        const int tid_ = opaque_tid();
        const int r8 = tid_ >> 3, kc = (tid_ & 7) ^ (r8 & 7);
        const f32x4 g0 = *(const f32x4*)(gb + kt * 64 + kc * 8), g1 = *(const f32x4*)(gb + kt * 64 + kc * 8 + 4);
        const f32x4 b0 = *(const f32x4*)(gb + 1024 + kt * 64 + kc * 8), b1 = *(const f32x4*)(gb + 1024 + kt * 64 + kc * 8 + 4);
#pragma unroll
        for (int i = 0; i < 4; ++i) {
            const int row = r8 + 64 * i;
            u32x4* cp = (u32x4*)(s + i * 8192 + tid_ * 16);
            const u32x4 v = *cp;
            const float mean = st[row * 2], rstd = st[row * 2 + 1];
            const f32x4 x0 = (f32x4){bf_lo(v.x), bf_hi(v.x), bf_lo(v.y), bf_hi(v.y)};
            const f32x4 x1 = (f32x4){bf_lo(v.z), bf_hi(v.z), bf_lo(v.w), bf_hi(v.w)};
            const f32x4 y0 = (x0 - mean) * rstd * g0 + b0, y1 = (x1 - mean) * rstd * g1 + b1;
            u32x4 w; w.x = pk_bf16(y0[0], y0[1]); w.y = pk_bf16(y0[2], y0[3]); w.z = pk_bf16(y1[0], y1[1]); w.w = pk_bf16(y1[2], y1[3]);
            *cp = w;
            if (xbase) *(u32x4*)(xbase + (size_t)(row * 1024 + kc * 8 + kt * 64)) = w;
        }
    }
};

constexpr int GEMM_LDS = 131072;
template <class AL, class BL>
__device__ __forceinline__ void gemm_mainloop(char* smem, const AL& al, const BL& bl, int nk, f32x4 (&acc)[8][4]) {
    const int tid_ = opaque_tid();
    const int lane = tid_ & 63, wid = tid_ >> 6;
    const int wr = wid >> 2, wc = wid & 3, fr = lane & 15, fq = lane >> 4;
#pragma unroll
    for (int mi = 0; mi < 8; ++mi)
#pragma unroll
        for (int ni = 0; ni < 4; ++ni) acc[mi][ni] = (f32x4){0.f, 0.f, 0.f, 0.f};
    typename AL::Regs ra; typename BL::Regs rb;
    al.issue(ra, smem, 0); bl.issue(rb, smem + 32768, 0);
    al.commit(ra, smem, 0); bl.commit(rb, smem + 32768, 0);
    __syncthreads();
    for (int kt = 0; kt < nk; ++kt) {
        char* sA = smem + (kt & 1) * 65536; char* sB = sA + 32768;
        char* nA = smem + ((kt + 1) & 1) * 65536; char* nB = nA + 32768;
        if (kt + 1 < nk) { al.issue(ra, nA, kt + 1); bl.issue(rb, nB, kt + 1); }
#pragma unroll
        for (int kk = 0; kk < 2; ++kk) {
            bf16x8 bfr[4];
#pragma unroll
            for (int ni = 0; ni < 4; ++ni) bfr[ni] = *(const bf16x8*)(sB + tile_off(wc * 64 + ni * 16 + fr, kk * 4 + fq));
#pragma unroll
            for (int mi = 0; mi < 8; ++mi) {
                const bf16x8 af = *(const bf16x8*)(sA + tile_off(wr * 128 + mi * 16 + fr, kk * 4 + fq));
#pragma unroll
                for (int ni = 0; ni < 4; ++ni) acc[mi][ni] = mfma16(bfr[ni], af, acc[mi][ni]);
            }
        }
        if (kt + 1 < nk) { al.commit(ra, nA, kt + 1); bl.commit(rb, nB, kt + 1); }
        __syncthreads();
    }
}

__device__ __forceinline__ int swz4(int row) { return (0x78 >> (((row >> 2) & 3) * 2)) & 3; }
struct RingRows {
    const bf16_t* base; unsigned off[2]; int ldst;
    __device__ __forceinline__ void init_contig(const bf16_t* b, int ld, int row0, bool perm = false) {
        const int tid_ = opaque_tid(); const int r = tid_ >> 2, kc = (tid_ & 3) ^ swz4(r);
        ldst = tid_ * 16; base = b + (long)row0 * ld;
#pragma unroll
        for (int i = 0; i < 2; ++i) { const int rr = r + 128 * i; off[i] = (unsigned)((perm ? bperm(rr) : rr) * ld + kc * 8); }
    }
    __device__ __forceinline__ void init_rows(const bf16_t* b, int ld, const int (&rows)[2]) {
        const int tid_ = opaque_tid(); const int r = tid_ >> 2, kc = (tid_ & 3) ^ swz4(r);
        ldst = tid_ * 16; base = b;
#pragma unroll
        for (int i = 0; i < 2; ++i) off[i] = (unsigned)rows[i] * (unsigned)ld + (unsigned)(kc * 8);
    }
    __device__ __forceinline__ void issue(char* s, int kt) const {
#pragma unroll
        for (int i = 0; i < 2; ++i)
            __builtin_amdgcn_global_load_lds((glb_u32*)(base + (size_t)(off[i] + (unsigned)(kt * 32))), (lds_u32*)(s + i * 8192 + ldst), 16, 0, 0);
    }
    __device__ __forceinline__ void commit(char*, int) const {}
};
struct RingLN {
    RingRows raw; bf16_t* xbase; const float* st; const float* gb;
    __device__ __forceinline__ void issue(char* s, int kt) const { raw.issue(s, kt); }
    __device__ __forceinline__ void commit(char* s, int kt) const {
        const int tid_ = opaque_tid(); const int r = tid_ >> 2, kc = (tid_ & 3) ^ swz4(r);
        const f32x4 g0 = *(const f32x4*)(gb + kt * 32 + kc * 8), g1 = *(const f32x4*)(gb + kt * 32 + kc * 8 + 4);
        const f32x4 b0 = *(const f32x4*)(gb + 1024 + kt * 32 + kc * 8), b1 = *(const f32x4*)(gb + 1024 + kt * 32 + kc * 8 + 4);
#pragma unroll
        for (int i = 0; i < 2; ++i) {
            const int row = r + 128 * i;
            u32x4* cp = (u32x4*)(s + i * 8192 + tid_ * 16);
            const u32x4 v = *cp;
            const float mean = st[row * 2], rstd = st[row * 2 + 1];
            const f32x4 x0 = (f32x4){bf_lo(v.x), bf_hi(v.x), bf_lo(v.y), bf_hi(v.y)};
            const f32x4 x1 = (f32x4){bf_lo(v.z), bf_hi(v.z), bf_lo(v.w), bf_hi(v.w)};
            const f32x4 y0 = (x0 - mean) * rstd * g0 + b0, y1 = (x1 - mean) * rstd * g1 + b1;
            u32x4 w; w.x = pk_bf16(y0[0], y0[1]); w.y = pk_bf16(y0[2], y0[3]); w.z = pk_bf16(y1[0], y1[1]); w.w = pk_bf16(y1[2], y1[3]);
            *cp = w;
            if (xbase) *(u32x4*)(xbase + (size_t)(row * 1024 + kc * 8 + kt * 32)) = w;
        }
    }
};
#define RING_WAIT(n) asm volatile("s_waitcnt vmcnt(" #n ")" ::: "memory")
#define RING_BAR() do { __builtin_amdgcn_sched_barrier(0); asm volatile("s_waitcnt lgkmcnt(0)" ::: "memory"); __builtin_amdgcn_s_barrier(); asm volatile("" ::: "memory"); __builtin_amdgcn_sched_barrier(0); } while (0)
template <class AL, class BL, int XMODE = 0  >
__device__ __forceinline__ void gemm_ring(char* smem, const AL& al, const BL& bl, int nk  , f32x4 (&acc)[8][4]) {
    const int tid_ = opaque_tid();
    const int lane = tid_ & 63, wid = __builtin_amdgcn_readfirstlane(tid_ >> 6);
    const int wr = wid >> 2, wc = wid & 3, fr = lane & 15, fq = lane >> 4;
#pragma unroll
    for (int mi = 0; mi < 8; ++mi)
#pragma unroll
        for (int ni = 0; ni < 4; ++ni) acc[mi][ni] = (f32x4){0.f, 0.f, 0.f, 0.f};
    const int aoff = (wr * 128 + fr) * 64 + ((fq ^ swz4(fr)) << 4);
    const int boff = 16384 + (wc * 64 + fr) * 64 + ((fq ^ swz4(fr)) << 4);
    if (XMODE != 1) {
    al.issue(smem, 0); bl.issue(smem + 16384, 0);
    al.issue(smem + 32768, 1); bl.issue(smem + 32768 + 16384, 1);
    al.issue(smem + 65536, 2); bl.issue(smem + 65536 + 16384, 2);
    RING_WAIT(8);
    al.commit(smem, 0); bl.commit(smem + 16384, 0);
    }
    RING_BAR();
    if (wr == 1) RING_BAR();
    for (int kt = 0; kt < nk; ++kt) {
        const char* st = smem + (kt & 3) * 32768;
        if (XMODE != 1 && kt + 3 < nk) { char* s3 = smem + ((kt + 3) & 3) * 32768; al.issue(s3, kt + 3); bl.issue(s3 + 16384, kt + 3); }
        bf16x8 bfr[4], afr[8];
        if (XMODE != 2) {
#pragma unroll
        for (int ni = 0; ni < 4; ++ni) bfr[ni] = *(const bf16x8*)(st + boff + ni * 1024);
#pragma unroll
        for (int mi = 0; mi < 8; ++mi) afr[mi] = *(const bf16x8*)(st + aoff + mi * 1024);
        }
        if (XMODE != 1 && kt + 1 < nk) {
            if (kt + 3 < nk) RING_WAIT(8); else if (kt + 2 < nk) RING_WAIT(4); else RING_WAIT(0);
            char* s1 = smem + ((kt + 1) & 3) * 32768;
            al.commit(s1, kt + 1); bl.commit(s1 + 16384, kt + 1);
        }
        RING_BAR();
        if (XMODE != 2) {
        __builtin_amdgcn_s_setprio(1);
#pragma unroll
        for (int mi = 0; mi < 8; ++mi)
#pragma unroll
            for (int ni = 0; ni < 4; ++ni) acc[mi][ni] = mfma16(bfr[ni], afr[mi], acc[mi][ni]);
        __builtin_amdgcn_s_setprio(0);
        }
        RING_BAR();
    }
    if (wr == 0) RING_BAR();
}

constexpr int FB_PITCH = 1088, FB_STAGE = 16384 + 32 * FB_PITCH;
struct RingF32B {
    const float* p; int ldn; int ldst;
    __device__ __forceinline__ void init(const float* W, int ld, int srccol4, int tid_) { const int lane = tid_ & 63, wid = tid_ >> 6; p = W + (long)wid * ld + srccol4; ldn = ld; ldst = wid * FB_PITCH + lane * 16; }
    __device__ __forceinline__ void issue(char* sB, int kt) const {
#pragma unroll
        for (int i = 0; i < 4; ++i)
            __builtin_amdgcn_global_load_lds((glb_u32*)(p + (long)(kt * 32 + i * 8) * ldn), (lds_u32*)(sB + i * 8 * FB_PITCH + (i & 1) * 64 + ldst), 16, 0, 0);
    }
};
template <class AL>
__device__ __forceinline__ void gemm_ring_f32b(char* smem, const AL& al, const RingF32B& bl, int nk  , f32x4 (&acc)[8][4]) {
    const int tid_ = opaque_tid();
    const int lane = tid_ & 63, wid = __builtin_amdgcn_readfirstlane(tid_ >> 6);
    const int wr = wid >> 2, wc = wid & 3, fr = lane & 15, fq = lane >> 4;
#pragma unroll
    for (int mi = 0; mi < 8; ++mi)
#pragma unroll
        for (int ni = 0; ni < 4; ++ni) acc[mi][ni] = (f32x4){0.f, 0.f, 0.f, 0.f};
    const int aoff = (wr * 128 + fr) * 64 + ((fq ^ swz4(fr)) << 4);
    const int boff = 16384 + (8 * fq) * FB_PITCH + (fq & 1) * 64 + (wc * 64 + fr) * 4;
    al.issue(smem, 0); bl.issue(smem + 16384, 0);
    al.issue(smem + FB_STAGE, 1); bl.issue(smem + FB_STAGE + 16384, 1);
    RING_WAIT(6);
    RING_BAR();
    if (wr == 1) RING_BAR();
    int s0 = 0;
    for (int kt = 0; kt < nk; ++kt) {
        const char* st = smem + s0 * FB_STAGE;
        const int s1 = s0 == 2 ? 0 : s0 + 1, s2 = s1 == 2 ? 0 : s1 + 1;
        if (kt + 2 < nk) { char* sn = smem + s2 * FB_STAGE; al.issue(sn, kt + 2); bl.issue(sn + 16384, kt + 2); }
        bf16x8 bfr[4], afr[8];
#pragma unroll
        for (int ni = 0; ni < 4; ++ni) {
            float v[8];
#pragma unroll
            for (int j = 0; j < 8; ++j) v[j] = *(const float*)(st + boff + j * FB_PITCH + ni * 64);
            u32x4 w; w.x = pk_bf16(v[0], v[1]); w.y = pk_bf16(v[2], v[3]); w.z = pk_bf16(v[4], v[5]); w.w = pk_bf16(v[6], v[7]);
            bfr[ni] = as_bf16x8(w);
        }
#pragma unroll
        for (int mi = 0; mi < 8; ++mi) afr[mi] = *(const bf16x8*)(st + aoff + mi * 1024);
        if (kt + 1 < nk) { if (kt + 2 < nk) RING_WAIT(6); else RING_WAIT(0); }
        RING_BAR();
        __builtin_amdgcn_s_setprio(1);
#pragma unroll
        for (int mi = 0; mi < 8; ++mi)
#pragma unroll
            for (int ni = 0; ni < 4; ++ni) acc[mi][ni] = mfma16(bfr[ni], afr[mi], acc[mi][ni]);
        __builtin_amdgcn_s_setprio(0);
        RING_BAR();
        s0 = s1;
    }
    if (wr == 0) RING_BAR();
}

__device__ __forceinline__ void epi_store_bf16(const f32x4 (&acc)[8][4], bf16_t* out, long ld, int row0, int col0) {
    const int tid_ = opaque_tid();
    const int lane = tid_ & 63, wid = tid_ >> 6;
    const int wr = wid >> 2, wc = wid & 3, fr = lane & 15, fq = lane >> 4;
#pragma unroll
    for (int mi = 0; mi < 8; ++mi) {
        bf16_t* rp = out + (long)(row0 + wr * 128 + mi * 16 + fr) * ld + col0 + wc * 64 + fq * 8;
#pragma unroll
        for (int q = 0; q < 2; ++q) {
            u32x4 w; w.x = pk_bf16(acc[mi][2 * q][0], acc[mi][2 * q][1]); w.y = pk_bf16(acc[mi][2 * q][2], acc[mi][2 * q][3]);
            w.z = pk_bf16(acc[mi][2 * q + 1][0], acc[mi][2 * q + 1][1]); w.w = pk_bf16(acc[mi][2 * q + 1][2], acc[mi][2 * q + 1][3]);
            *(u32x4*)(rp + q * 32) = w;
        }
    }
}

template <bool RES_LN>
__device__ __forceinline__ void epi_residual(f32x4 (&acc)[8][4], char* smem, const float* resid, const float* rstats  ,
                                             const float* g, const float* b, float* rout, bf16_t* rbout, float* stout  , int row0, int nt) {
    const int tid_ = opaque_tid();
    const int lane = tid_ & 63, wid = tid_ >> 6;
    const int wr = wid >> 2, wc = wid & 3, fr = lane & 15, fq = lane >> 4;
    float* sp = (float*)smem;
    const int col0 = nt * 256 + wc * 64 + fq * 8;
#pragma unroll
    for (int mi = 0; mi < 8; ++mi) {
        const int rl = wr * 128 + mi * 16 + fr;
        const long row = row0 + rl;
        float mean = 0.f, rstd = 1.f;
        if (RES_LN) {
            const f32x4 p0 = *(const f32x4*)(rstats + row * 8), p1 = *(const f32x4*)(rstats + row * 8 + 4);
            const float s1 = (p0[0] + p0[2]) + (p1[0] + p1[2]), s2 = (p0[1] + p0[3]) + (p1[1] + p1[3]);
            mean = s1 * (1.0f / 1024.0f);
            const float var = fmaxf(s2 * (1.0f / 1024.0f) - mean * mean, 0.f);
            rstd = rsqrtf(var + LN_EPS);
        }
        float s1 = 0.f, s2 = 0.f;
#pragma unroll
        for (int q = 0; q < 2; ++q) {
            const long o = row * 1024 + col0 + q * 32;
            f32x4 x0 = *(const f32x4*)(resid + o), x1 = *(const f32x4*)(resid + o + 4);
            if (RES_LN) {
                x0 = (x0 - mean) * rstd * *(const f32x4*)(g + col0 + q * 32) + *(const f32x4*)(b + col0 + q * 32);
                x1 = (x1 - mean) * rstd * *(const f32x4*)(g + col0 + q * 32 + 4) + *(const f32x4*)(b + col0 + q * 32 + 4);
            }
            const f32x4 v0 = acc[mi][2 * q] + ALPHA * x0, v1 = acc[mi][2 * q + 1] + ALPHA * x1;
            *(f32x4*)(rout + o) = v0; *(f32x4*)(rout + o + 4) = v1;
            { u32x4 w; w.x = pk_bf16(v0[0], v0[1]); w.y = pk_bf16(v0[2], v0[3]); w.z = pk_bf16(v1[0], v1[1]); w.w = pk_bf16(v1[2], v1[3]); *(u32x4*)(rbout + o) = w; }
            s1 += ((v0[0] + v0[1]) + (v0[2] + v0[3])) + ((v1[0] + v1[1]) + (v1[2] + v1[3]));
            s2 += ((v0[0] * v0[0] + v0[1] * v0[1]) + (v0[2] * v0[2] + v0[3] * v0[3])) + ((v1[0] * v1[0] + v1[1] * v1[1]) + (v1[2] * v1[2] + v1[3] * v1[3]));
        }
        s1 += __shfl_xor(s1, 16); s1 += __shfl_xor(s1, 32);
        s2 += __shfl_xor(s2, 16); s2 += __shfl_xor(s2, 32);
        if (fq == 0) { sp[(rl * 4 + wc) * 2] = s1; sp[(rl * 4 + wc) * 2 + 1] = s2; }
    }
    __syncthreads();
    if (tid_ < 256) {
        const int rl = tid_;
        const float a1 = (sp[rl * 8] + sp[rl * 8 + 2]) + (sp[rl * 8 + 4] + sp[rl * 8 + 6]);
        const float a2 = (sp[rl * 8 + 1] + sp[rl * 8 + 3]) + (sp[rl * 8 + 5] + sp[rl * 8 + 7]);
        *(f32x2*)(stout + ((long)(row0 + rl) * 4 + nt) * 2) = (f32x2){a1, a2};
    }
    __syncthreads();
}

__device__ __forceinline__ void ln_tile_stats(float* st, const float* rstats, int row0) {
    const int tid_ = opaque_tid();
    if (tid_ < 256) {
        const long row = row0 + tid_;
        const f32x4 p0 = *(const f32x4*)(rstats + row * 8), p1 = *(const f32x4*)(rstats + row * 8 + 4);
        const float s1 = (p0[0] + p0[2]) + (p1[0] + p1[2]), s2 = (p0[1] + p0[3]) + (p1[1] + p1[3]);
        const float mean = s1 * (1.0f / 1024.0f);
        const float var = fmaxf(s2 * (1.0f / 1024.0f) - mean * mean, 0.f);
        st[tid_ * 2] = mean; st[tid_ * 2 + 1] = rsqrtf(var + LN_EPS);
    }
}
__device__ __forceinline__ void ln_load_gb(float* gb, const float* g, const float* b) {
    for (int i = opaque_tid(); i < 1024; i += NTHR) { gb[i] = g[i]; gb[1024 + i] = b[i]; }
}


struct XcdSlab {
    int x, j, stride;
    __device__ __forceinline__ void init(int bid, int nb) { if ((nb & 7) == 0) { x = bid & 7; j = bid >> 3; stride = nb >> 3; } else { x = -1; j = bid; stride = nb; } }
    __device__ __forceinline__ int m_lo(int nM) const { return x < 0 ? 0 : (x * nM) >> 3; }
    __device__ __forceinline__ int m_hi(int nM) const { return x < 0 ? nM : ((x + 1) * nM) >> 3; }
};

template <int MAP>
__device__ __forceinline__ void ln_correct(f32x4 (&acc)[8][4], const float* rstats  , int row0, const float* cs, const float* bw, int nt) {
    const int tid_ = opaque_tid();
    const int lane = tid_ & 63, wid = tid_ >> 6;
    const int wr = wid >> 2, wc = wid & 3, fr = lane & 15, fq = lane >> 4;
    float mean[8], rstd[8];
#pragma unroll
    for (int mi = 0; mi < 8; ++mi) {
        const long row = row0 + wr * 128 + mi * 16 + fr;
        const f32x4 p0 = *(const f32x4*)(rstats + row * 8), p1 = *(const f32x4*)(rstats + row * 8 + 4);
        const float s1 = (p0[0] + p0[2]) + (p1[0] + p1[2]), s2 = (p0[1] + p0[3]) + (p1[1] + p1[3]);
        mean[mi] = s1 * (1.0f / 1024.0f);
        rstd[mi] = rsqrtf(fmaxf(s2 * (1.0f / 1024.0f) - mean[mi] * mean[mi], 0.f) + LN_EPS);
    }
#pragma unroll
    for (int ni = 0; ni < 4; ++ni) {
        const int col = MAP == 0 ? nt * 256 + wc * 64 + (ni >> 1) * 32 + fq * 8 + (ni & 1) * 4
                                 : (ni & 1) * 256 + nt * 128 + wc * 32 + fq * 8 + (ni >> 1) * 4;
        const f32x4 c4 = *(const f32x4*)(cs + col), b4 = *(const f32x4*)(bw + col);
#pragma unroll
        for (int mi = 0; mi < 8; ++mi) acc[mi][ni] = (acc[mi][ni] - mean[mi] * c4) * rstd[mi] + b4;
    }
}
struct TJob { const float* src; int ldsrc; int K; int col0; int ncols; bf16_t* dst; int mode; int rowoff; const float* g; const float* b; float* part;   };
__device__ __forceinline__ int tjob_row(const TJob& j, int c) {
    if (j.mode == 0) return j.rowoff + c;
    const int oc = c & 127;
    return 256 * (c >> 7) + 64 * (oc >> 5) + 16 * (2 * ((oc >> 2) & 1) + j.rowoff) + 4 * ((oc >> 3) & 3) + (oc & 3);
}
__device__ __forceinline__ void transpose_tile(char* smem, const TJob& j, int kt, int ct) {
    float* tile = (float*)smem;
    float* red = tile + 64 * 65;
    const int tid = opaque_tid();
    float scs = 0.f, sbw = 0.f;
#pragma unroll
    for (int i = 0; i < 8; ++i) {
        const int e = tid + i * NTHR, kr = e >> 6, c = e & 63;
        const int cc = ct * 64 + c;
        float v = 0.f;
        if (cc < j.ncols) v = j.src[(long)(kt * 64 + kr) * j.ldsrc + j.col0 + cc];
        if (j.g) {
            const float gv = j.g[kt * 64 + kr], bv = j.b[kt * 64 + kr];
            sbw += bv * v;
            v *= gv;
            scs += __uint_as_float(pk_bf16(v, 0.f) << 16);
        }
        tile[kr * 65 + c] = v;
    }
    if (j.g) { red[(tid >> 6) * 64 + (tid & 63)] = scs; red[512 + (tid >> 6) * 64 + (tid & 63)] = sbw; }
    __syncthreads();
#pragma unroll
    for (int i = 0; i < 4; ++i) {
        const int e = tid + i * NTHR, c = e >> 5, k2 = (e & 31) * 2;
        const int cc = ct * 64 + c;
        if (cc < j.ncols) {
            const unsigned w = pk_bf16(tile[k2 * 65 + c], tile[(k2 + 1) * 65 + c]);
            *(unsigned*)(j.dst + (long)tjob_row(j, cc) * j.K + kt * 64 + k2) = w;
        }
    }
    if (j.g && tid < 128) {
        const int which = tid >> 6, c = tid & 63;
        float s = 0.f;
#pragma unroll
        for (int w = 0; w < 8; ++w) s += red[which * 512 + w * 64 + c];
        if (ct * 64 + c < j.ncols) j.part[(long)(which * 16 + kt) * 1792 + ct * 64 + c] = s;
    }
    __syncthreads();
}

__device__ __forceinline__ void tjob_run(char* smem, int bid, int nb, const float* src, int ld, int K, int col0, int ncols, bf16_t* dst, int mode, int rowoff,
                                         const float* g = nullptr, const float* b = nullptr, float* part = nullptr) {
    TJob j; j.src = src; j.ldsrc = ld; j.K = K; j.col0 = col0; j.ncols = ncols; j.dst = dst; j.mode = mode; j.rowoff = rowoff; j.g = g; j.b = b; j.part = part;
    const int nkt = K / 64, nct = (ncols + 63) / 64, ntile = nkt * nct;
    for (int t = bid; t < ntile; t += nb) transpose_tile(smem, j, t % nkt, t / nkt);
}

__device__ __forceinline__ void cvt_rows_bf16(const float* src, bf16_t* dst, long n8, int bid, int nb) {
    for (long i = (long)bid * NTHR + opaque_tid(); i < n8; i += (long)nb * NTHR) {
        const f32x4 a = *(const f32x4*)(src + i * 8), b = *(const f32x4*)(src + i * 8 + 4);
        u32x4 w; w.x = pk_bf16(a[0], a[1]); w.y = pk_bf16(a[2], a[3]); w.z = pk_bf16(b[0], b[1]); w.w = pk_bf16(b[2], b[3]);
        *(u32x4*)(dst + i * 8) = w;
    }
}

enum { I_X = 0, I_MEM, I_WIN, I_POSK, I_CKW1, I_CKW2, I_POSV, I_CVW1, I_CVW2, I_CONVW, I_IBIAS, I_FBIAS, I_NORMG, I_WOUT, I_LN1G, I_LN1B,
       I_XAWQ, I_XAWK, I_XAWV, I_XAWO, I_LN2G, I_LN2B, I_ROUTW, I_ROUTB, I_MW1, I_MW3, I_MW2, I_SW1, I_SW3, I_SW2, I_LN3G, I_LN3B };

__device__ __forceinline__ void phase0(const Params& p, char* smem, int bid, int nb) {
    char* ws = p.ws;
    tjob_run(smem, bid, nb, p.in[I_WIN], 3360, 1024, 0, 1280, (bf16_t*)(ws + WS_WIN), 0, 0);
    tjob_run(smem, bid, nb, p.in[I_WIN], 3360, 1024, 1304, 2048, (bf16_t*)(ws + WS_WIN), 0, 1280);
    tjob_run(smem, bid, nb, p.in[I_WIN], 3360, 1024, 1280, 24, (bf16_t*)(ws + WS_WIN), 0, 3328);
    tjob_run(smem, bid, nb, p.in[I_WIN], 3360, 1024, 3352, 8, (bf16_t*)(ws + WS_WIN), 0, 3352);
    tjob_run(smem, bid, nb, p.in[I_WOUT], 1024, 1024, 0, 1024, (bf16_t*)(ws + WS_WOUT), 0, 0);
    float* lnp = (float*)(ws + WS_LNP);
    tjob_run(smem, bid, nb, p.in[I_XAWQ], 1024, 1024, 0, 1024, (bf16_t*)(ws + WS_WQ), 0, 0, p.in[I_LN1G], p.in[I_LN1B], lnp);
    tjob_run(smem, bid, nb, p.in[I_XAWK], 1024, 1024, 0, 1024, (bf16_t*)(ws + WS_WKV), 0, 0);
    tjob_run(smem, bid, nb, p.in[I_XAWV], 1024, 1024, 0, 1024, (bf16_t*)(ws + WS_WKV), 0, 1024);
    tjob_run(smem, bid, nb, p.in[I_XAWO], 1024, 1024, 0, 1024, (bf16_t*)(ws + WS_WO), 0, 0);
    tjob_run(smem, bid, nb, p.in[I_ROUTW], 256, 1024, 0, 256, (bf16_t*)(ws + WS_WR), 0, 0, p.in[I_LN2G], p.in[I_LN2B], lnp + 1024);
    tjob_run(smem, bid, nb, p.in[I_SW1], 256, 1024, 0, 256, (bf16_t*)(ws + WS_WS13), 1, 0, p.in[I_LN2G], p.in[I_LN2B], lnp + 1280);
    tjob_run(smem, bid, nb, p.in[I_SW3], 256, 1024, 0, 256, (bf16_t*)(ws + WS_WS13), 1, 1, p.in[I_LN2G], p.in[I_LN2B], lnp + 1536);
    tjob_run(smem, bid, nb, p.in[I_SW2], 1024, 256, 0, 1024, (bf16_t*)(ws + WS_WS2), 0, 0);
    tjob_run(smem, bid, nb, p.in[I_CKW1], 64, 2048, 0, 64, (bf16_t*)(ws + WS_CK1), 0, 0);
    tjob_run(smem, bid, nb, p.in[I_CKW2], 64, 64, 0, 64, (bf16_t*)(ws + WS_CK2), 0, 0);
    tjob_run(smem, bid, nb, p.in[I_CVW1], 64, 2048, 0, 64, (bf16_t*)(ws + WS_CV1), 0, 0);
    tjob_run(smem, bid, nb, p.in[I_CVW2], 64, 64, 0, 64, (bf16_t*)(ws + WS_CV2), 0, 0);
    cvt_rows_bf16(p.in[I_X], (bf16_t*)(ws + WS_XB), (long)T_TOK * 1024 / 8, bid, nb);
    cvt_rows_bf16(p.in[I_MEM], (bf16_t*)(ws + WS_MEMB), (long)4096 * 1024 / 8, bid, nb);
    { int* c = (int*)(ws + WS_CNT); for (int i = bid * NTHR + opaque_tid(); i < 24576; i += nb * NTHR) c[i] = 0; }
}

__device__ __forceinline__ void small_cols_task(const Params& p, int task) {
    const bf16_t* xb = (const bf16_t*)(p.ws + WS_XB);
    const bf16_t* wt = (const bf16_t*)(p.ws + WS_WIN) + (long)3328 * 1024;
    float* psm = (float*)(p.ws + WS_PSM);
    const int tid_ = opaque_tid();
    const int lane = tid_ & 63, wid = tid_ >> 6, fr = lane & 15, fq = lane >> 4;
    const int r0 = task * 256 + wid * 32;
    f32x4 acc[2][2];
#pragma unroll
    for (int mi = 0; mi < 2; ++mi)
#pragma unroll
        for (int ni = 0; ni < 2; ++ni) acc[mi][ni] = (f32x4){0.f, 0.f, 0.f, 0.f};
    const bf16_t* ap0 = xb + (long)(r0 + fr) * 1024 + fq * 8;
    const bf16_t* ap1 = ap0 + 16 * 1024;
    const bf16_t* bp0 = wt + (long)fr * 1024 + fq * 8;
    const bf16_t* bp1 = bp0 + 16 * 1024;
#pragma unroll 4
    for (int ks = 0; ks < 32; ++ks) {
        const bf16x8 a0 = *(const bf16x8*)(ap0 + ks * 32), a1 = *(const bf16x8*)(ap1 + ks * 32);
        const bf16x8 b0 = *(const bf16x8*)(bp0 + ks * 32), b1 = *(const bf16x8*)(bp1 + ks * 32);
        acc[0][0] = mfma16(b0, a0, acc[0][0]); acc[0][1] = mfma16(b1, a0, acc[0][1]);
        acc[1][0] = mfma16(b0, a1, acc[1][0]); acc[1][1] = mfma16(b1, a1, acc[1][1]);
    }
#pragma unroll
    for (int mi = 0; mi < 2; ++mi)
#pragma unroll
        for (int ni = 0; ni < 2; ++ni) *(f32x4*)(psm + (long)(r0 + mi * 16 + fr) * 32 + ni * 16 + fq * 4) = acc[mi][ni];
}

template <int NOEPI = 0>
__device__ __forceinline__ void phase1(const Params& p, char* smem, int bid, int nb) {
    char* ws = p.ws;
    XcdSlab xs; xs.init(bid, nb);
    const int a_lo = xs.m_lo(128), a_n = (xs.m_hi(128) - a_lo) * 14;
    const int b_lo = xs.m_lo(16), b_n = (xs.m_hi(16) - b_lo) * 8;
    for (int u = xs.j; u < a_n + b_n; u += xs.stride) {
        const bool inp = u < a_n;
        const int uu = inp ? u : u - a_n;
        const int nm = inp ? (xs.m_hi(128) - a_lo) : (xs.m_hi(16) - b_lo);
        const int mt = (inp ? a_lo : b_lo) + uu % nm, nt = uu / nm;
        RingRows al, bl;
        al.init_contig((const bf16_t*)(ws + (inp ? WS_XB : WS_MEMB)), 1024, mt * 256);
        bl.init_contig((const bf16_t*)(ws + (inp ? WS_WIN : WS_WKV)), 1024, nt * 256, true);
        f32x4 acc[8][4];
        gemm_ring(smem, al, bl, 32, acc);
        if (NOEPI) { float s = 0.f;
#pragma unroll
            for (int mi = 0; mi < 8; ++mi)
#pragma unroll
                for (int ni = 0; ni < 4; ++ni) s += acc[mi][ni][0] + acc[mi][ni][1] + acc[mi][ni][2] + acc[mi][ni][3];
            if (s == 123.456f) ((float*)(ws + WS_A + 432 * MB))[opaque_tid()] = s; continue; }
        if (!inp) epi_store_bf16(acc, (bf16_t*)(ws + WS_KVX), 2048, mt * 256, nt * 256);
        else if (nt < 13) epi_store_bf16(acc, (bf16_t*)(ws + WS_P), PW, mt * 256, nt * 256);
        else {
            const int tid_ = opaque_tid();
            const int lane = tid_ & 63, wid = tid_ >> 6, wr = wid >> 2, wc = wid & 3, fr = lane & 15, fq = lane >> 4;
            if (wc == 0) {
                float* psm = (float*)(ws + WS_PSM);
#pragma unroll
                for (int mi = 0; mi < 8; ++mi)
#pragma unroll
                    for (int ni = 0; ni < 2; ++ni) *(f32x4*)(psm + (long)(mt * 256 + wr * 128 + mi * 16 + fr) * 32 + fq * 8 + ni * 4) = acc[mi][ni];
            }
        }
    }
}

__device__ __forceinline__ void compress_task(const Params& p, char* smem, int which, int rb) {
    const char* ws = p.ws;
    const bf16_t* P = (const bf16_t*)(ws + WS_P);
    const float* pos = p.in[which ? I_POSV : I_POSK];
    const bf16_t* w1t = (const bf16_t*)(ws + (which ? WS_CV1 : WS_CK1));
    const bf16_t* w2t = (const bf16_t*)(ws + (which ? WS_CV2 : WS_CK2));
    bf16_t* outp = (bf16_t*)(p.ws + (which ? WS_VCMP : WS_KCMP));
    const int colbase = which ? PC_VC : PC_KC;
    const int tid_ = opaque_tid();
    const int lane = tid_ & 63, wid = tid_ >> 6, fr = lane & 15, fq = lane >> 4;
    const int mi = wid >> 2, ni = wid & 3;
    const int r = rb * 32 + mi * 16 + fr;
    const int b = r / 254, rem = r - b * 254, c = rem >> 1, g = rem & 1;
    const bf16_t* arow = P + (long)(b * 2048 + c * 16) * PW + colbase + g * 64 + fq * 8;
    const bf16_t* brow = w1t + (long)(ni * 16 + fr) * 2048 + fq * 8;
    const float* prow = pos + fq * 8;
    f32x4 acc = (f32x4){0.f, 0.f, 0.f, 0.f};
#pragma unroll 8
    for (int ks = 0; ks < 64; ++ks) {
        const int l = ks >> 1, d0 = (ks & 1) * 32;
        const u32x4 av = *(const u32x4*)(arow + (long)l * PW + d0);
        const f32x4 p0 = *(const f32x4*)(prow + l * 64 + d0), p1 = *(const f32x4*)(prow + l * 64 + d0 + 4);
        u32x4 aw;
        aw.x = pk_bf16(bf_lo(av.x) + p0[0], bf_hi(av.x) + p0[1]); aw.y = pk_bf16(bf_lo(av.y) + p0[2], bf_hi(av.y) + p0[3]);
        aw.z = pk_bf16(bf_lo(av.z) + p1[0], bf_hi(av.z) + p1[1]); aw.w = pk_bf16(bf_lo(av.w) + p1[2], bf_hi(av.w) + p1[3]);
        const bf16x8 bb = *(const bf16x8*)(brow + ks * 32);
        acc = mfma16(bb, as_bf16x8(aw), acc);
    }
    bf16_t* h1 = (bf16_t*)smem;
    {
        u32x2 w; w.x = pk_bf16(siluf_(acc[0]), siluf_(acc[1])); w.y = pk_bf16(siluf_(acc[2]), siluf_(acc[3]));
        *(u32x2*)(h1 + (mi * 16 + fr) * 72 + ni * 16 + fq * 4) = w;
    }
    __syncthreads();
    f32x4 acc2 = (f32x4){0.f, 0.f, 0.f, 0.f};
#pragma unroll
    for (int ks = 0; ks < 2; ++ks) {
        const bf16x8 a = *(const bf16x8*)(h1 + (mi * 16 + fr) * 72 + ks * 32 + fq * 8);
        const bf16x8 bb = *(const bf16x8*)(w2t + (ni * 16 + fr) * 64 + ks * 32 + fq * 8);
        acc2 = mfma16(bb, a, acc2);
    }
    {
        u32x2 w; w.x = pk_bf16(acc2[0], acc2[1]); w.y = pk_bf16(acc2[2], acc2[3]);
        *(u32x2*)(outp + ((long)(b * 2 + g) * 128 + c) * 64 + ni * 16 + fq * 4) = w;
    }
    __syncthreads();
}

__device__ __forceinline__ void phase2(const Params& p, char* smem, int bid, int nb) {
    char* ws = p.ws;
    {
        const int idx = bid * NTHR + opaque_tid();
        if (idx < 2 * 1792) {
            const float* pp = (const float*)(ws + WS_LNP) + (long)(idx / 1792) * 16 * 1792 + idx % 1792;
            float s = 0.f;
#pragma unroll
            for (int k = 0; k < 16; ++k) s += pp[k * 1792];
            ((float*)(ws + WS_LNF))[idx] = s;
        }
    }
    for (int t = bid; t < 254; t += nb) compress_task(p, smem, t / 127, t % 127);
    const int tid_ = opaque_tid();
    if (bid < 32 && tid_ < 32) {
        bf16_t* kc = (bf16_t*)(ws + WS_KCMP) + ((long)bid * 128 + 127) * 64;
        bf16_t* vc = (bf16_t*)(ws + WS_VCMP) + ((long)bid * 128 + 127) * 64;
        ((unsigned*)kc)[tid_] = 0u; ((unsigned*)vc)[tid_] = 0u;
    }
    const bf16_t* P = (const bf16_t*)(ws + WS_P);
    const float* cw = p.in[I_CONVW];
    bf16_t* qk = (bf16_t*)(ws + WS_QK);
    for (long it = (long)bid * NTHR + tid_; it < (long)T_TOK * 128; it += (long)nb * NTHR) {
        const int t = (int)(it >> 7), ch = (int)(it & 127);
        const int s = t & (SEQ - 1);
        float a[8];
#pragma unroll
        for (int e = 0; e < 8; ++e) a[e] = 0.f;
#pragma unroll
        for (int j = 0; j < 4; ++j) {
            if (s - 3 + j >= 0) {
                const u32x4 u = *(const u32x4*)(P + (long)(t - 3 + j) * PW + PC_MQ + ch * 8);
                const f32x4 w0 = *(const f32x4*)(cw + j * 1024 + ch * 8), w1 = *(const f32x4*)(cw + j * 1024 + ch * 8 + 4);
                a[0] += w0[0] * bf_lo(u.x); a[1] += w0[1] * bf_hi(u.x); a[2] += w0[2] * bf_lo(u.y); a[3] += w0[3] * bf_hi(u.y);
                a[4] += w1[0] * bf_lo(u.z); a[5] += w1[1] * bf_hi(u.z); a[6] += w1[2] * bf_lo(u.w); a[7] += w1[3] * bf_hi(u.w);
            }
        }
        const float sc = ch < 64 ? 0.08838834764831845f : 1.0f;
        u32x4 w;
        w.x = pk_bf16(siluf_(a[0]) * sc, siluf_(a[1]) * sc); w.y = pk_bf16(siluf_(a[2]) * sc, siluf_(a[3]) * sc);
        w.z = pk_bf16(siluf_(a[4]) * sc, siluf_(a[5]) * sc); w.w = pk_bf16(siluf_(a[6]) * sc, siluf_(a[7]) * sc);
        *(u32x4*)(qk + (long)t * 1024 + ch * 8) = w;
    }
}

typedef __attribute__((address_space(3))) s16x4 lds_s16x4;
__device__ __forceinline__ s16x4 lds_tr(const char* a) { return __builtin_amdgcn_ds_read_tr16_b64_v4i16((lds_s16x4*)a); }
__device__ __forceinline__ bf16x8 tr_frag_perm(const char* base, int pitch, int rbase, int cbase, int fr, int fq) {
    const char* a0 = base + (rbase + 4 * fq + (fr >> 2)) * pitch + (cbase + 4 * (fr & 3)) * 2;
    const s16x4 lo = lds_tr(a0), hi = lds_tr(a0 + 16 * pitch);
    return (bf16x8){lo[0], lo[1], lo[2], lo[3], hi[0], hi[1], hi[2], hi[3]};
}
__device__ __forceinline__ bf16x8 tr_frag_std(const char* base, int pitch, int rbase, int cbase, int fr, int fq) {
    const char* a0 = base + (rbase + 8 * fq + (fr >> 2)) * pitch + (cbase + 4 * (fr & 3)) * 2;
    const s16x4 lo = lds_tr(a0), hi = lds_tr(a0 + 4 * pitch);
    return (bf16x8){lo[0], lo[1], lo[2], lo[3], hi[0], hi[1], hi[2], hi[3]};
}
__device__ __forceinline__ bf16x8 pack_p(const f32x4 a, const f32x4 b) {
    u32x4 w; w.x = pk_bf16(a[0], a[1]); w.y = pk_bf16(a[2], a[3]); w.z = pk_bf16(b[0], b[1]); w.w = pk_bf16(b[2], b[3]);
    return as_bf16x8(w);
}

__device__ __forceinline__ float dpp_xor1(float v) { return __builtin_bit_cast(float, __builtin_amdgcn_mov_dpp(__builtin_bit_cast(int, v), 0xB1, 0xF, 0xF, true)); }
__device__ __forceinline__ float dpp_xor2(float v) { return __builtin_bit_cast(float, __builtin_amdgcn_mov_dpp(__builtin_bit_cast(int, v), 0x4E, 0xF, 0xF, true)); }

constexpr int NSA_PITCH = 160;
constexpr int NSA_KC = 0, NSA_VC = 20480, NSA_KT = 40960, NSA_VT = 61440, NSA_MISC = 81920, NSA_Y = 83968;

struct NsaState {
    bf16x8 qf[2][2];
    int tl[2];
    unsigned selm[2];
    unsigned wunion, bunion;
};

constexpr int NSA_STG = 16384;
__device__ __forceinline__ float fq_max(float x) {
    auto a = __builtin_amdgcn_permlane16_swap(__float_as_uint(x), __float_as_uint(x), false, false);
    x = __builtin_fmaxf(__uint_as_float(a[0]), __uint_as_float(a[1]));
    auto b = __builtin_amdgcn_permlane32_swap(__float_as_uint(x), __float_as_uint(x), false, false);
    return __builtin_fmaxf(__uint_as_float(b[0]), __uint_as_float(b[1]));
}
__device__ __forceinline__ float fq_sum(float x) {
    auto a = __builtin_amdgcn_permlane16_swap(__float_as_uint(x), __float_as_uint(x), false, false);
    x = __uint_as_float(a[0]) + __uint_as_float(a[1]);
    auto b = __builtin_amdgcn_permlane32_swap(__float_as_uint(x), __float_as_uint(x), false, false);
    return __uint_as_float(b[0]) + __uint_as_float(b[1]);
}
__device__ __forceinline__ bf16x8 tr_frag_perm_swz(const char* base, int rbase, int dt, int fr, int fq) {
    const int R = rbase + 4 * fq + (fr >> 2), c = 2 * dt + ((fr & 3) >> 1);
    const char* a0 = base + R * 128 + ((c ^ (R & 7)) << 4) + 8 * (fr & 1);
    const s16x4 lo = lds_tr(a0), hi = lds_tr(a0 + 16 * 128);
    return (bf16x8){lo[0], lo[1], lo[2], lo[3], hi[0], hi[1], hi[2], hi[3]};
}
#define NSA_WAITV(n) asm volatile("s_waitcnt vmcnt(" #n ")" ::: "memory")
#define NSA_BAR() do { asm volatile("s_waitcnt lgkmcnt(0)" ::: "memory"); __builtin_amdgcn_s_barrier(); asm volatile("" ::: "memory"); } while (0)

template <int MODE>
__device__ __forceinline__ void nsa_stream(char* smem, const bf16_t* Pb  , int g, int i, NsaState& st, float gate0, float gate1, const int tid) {
    const int lane = tid & 63, fr = lane & 15, fq = lane >> 4;
    const int kcol = (MODE == 0 ? PC_KS : PC_KW) + g * 64, vcol = (MODE == 0 ? PC_VS : PC_VW) + g * 64;
    const int lrow = tid >> 3, lch = (tid & 7) ^ (lrow & 7);
    const bf16_t* ksrc = Pb + (long)lrow * PW + kcol + lch * 8;
    const bf16_t* vsrc = Pb + (long)lrow * PW + vcol + lch * 8;
    const int jlo = MODE == 0 ? 0 : (i - 8 > 0 ? i - 8 : 0);
    const unsigned range = (i >= 31 ? 0xffffffffu : ((1u << (i + 1)) - 1u)) & ~((1u << jlo) - 1u);
    const unsigned need = (unsigned)__builtin_amdgcn_readfirstlane((int)((MODE == 0 ? st.bunion : 0xffffffffu) & range));
    f32x4 O[2][4];
    float m[2], l[2];
    int tlq[2];
#pragma unroll
    for (int mt = 0; mt < 2; ++mt) { m[mt] = -1e30f; l[mt] = 0.f; tlq[mt] = st.tl[mt] - 4 * fq;
#pragma unroll
        for (int dt = 0; dt < 4; ++dt) O[mt][dt] = (f32x4){0.f, 0.f, 0.f, 0.f}; }
    unsigned pm = need;
    int nissued = 0;
    auto issue_next = [&]() {
        const int jj = __builtin_ctz(pm); pm &= pm - 1u;
        char* sb = smem + (nissued & 3) * NSA_STG;
        __builtin_amdgcn_global_load_lds((glb_u32*)(ksrc + (long)jj * 64 * PW), (lds_u32*)(sb + tid * 16), 16, 0, 0);
        __builtin_amdgcn_global_load_lds((glb_u32*)(vsrc + (long)jj * 64 * PW), (lds_u32*)(sb + 8192 + tid * 16), 16, 0, 0);
        ++nissued;
    };
    const int L = __builtin_popcount(need);
    if (L > 0) issue_next();
    if (L > 1) issue_next();
    if (L > 2) issue_next();
    if (L > 2) NSA_WAITV(4); else if (L > 1) NSA_WAITV(2); else NSA_WAITV(0);
    NSA_BAR();
    unsigned cm = need;
    for (int n = 0; n < L; ++n) {
        const int j = __builtin_ctz(cm); cm &= cm - 1u;
        if (n + 3 < L) issue_next();
        const char* KT = smem + (n & 3) * NSA_STG;
        const char* VT = KT + 8192;
        const bool wave_on = MODE == 0 ? (((st.wunion >> j) & 1u) != 0u) : true;
        if (wave_on) {
            f32x4 S[2][4];
            {
                bf16x8 kf[4][2];
#pragma unroll
                for (int nt = 0; nt < 4; ++nt)
#pragma unroll
                    for (int ks = 0; ks < 2; ++ks) kf[nt][ks] = *(const bf16x8*)(KT + (16 * nt + fr) * 128 + (((ks * 4 + fq) ^ (fr & 7)) << 4));
#pragma unroll
                for (int mt = 0; mt < 2; ++mt)
#pragma unroll
                    for (int nt = 0; nt < 4; ++nt) {
                        f32x4 s = (f32x4){0.f, 0.f, 0.f, 0.f};
                        s = mfma16(kf[nt][0], st.qf[mt][0], s);
                        s = mfma16(kf[nt][1], st.qf[mt][1], s);
                        S[mt][nt] = s;
                    }
            }
            bf16x8 pf[2][2];
            const bool edge = (j == i) || (MODE == 1 && j == i - 8);
            constexpr float CS = 0.125f * 1.4426950408889634f;
#pragma unroll
            for (int mt = 0; mt < 2; ++mt) {
                const bool rowsel = MODE == 0 ? (((st.selm[mt] >> j) & 1u) != 0u) : true;
                if (edge) {
                    asm volatile("; boundary tile" ::: "memory");
#pragma unroll
                    for (int nt = 0; nt < 4; ++nt)
#pragma unroll
                        for (int e = 0; e < 4; ++e) {
                            const int kc = 16 * nt + e;
                            bool ok = true;
                            if (j == i) ok = ok && (kc <= tlq[mt]);
                            if (MODE == 1) { if (j == i - 8) ok = ok && (kc > tlq[mt]); }
                            S[mt][nt][e] = ok ? S[mt][nt][e] : -INFINITY;
                        }
                }
                float mx = -INFINITY;
#pragma unroll
                for (int nt = 0; nt < 4; ++nt)
#pragma unroll
                    for (int e = 0; e < 4; ++e) mx = __builtin_fmaxf(mx, S[mt][nt][e]);
                mx = fq_max(mx);
                if (MODE == 0) mx = rowsel ? mx : -INFINITY;
                const float mnew = __builtin_fmaxf(m[mt], mx * CS);
                const float alpha = __builtin_amdgcn_exp2f(m[mt] - mnew);
                const float msub = (MODE == 0 && !rowsel) ? INFINITY : mnew;
                float rs = 0.f;
#pragma unroll
                for (int nt = 0; nt < 4; ++nt)
#pragma unroll
                    for (int e = 0; e < 4; ++e) { const float pv = __builtin_amdgcn_exp2f(__builtin_fmaf(S[mt][nt][e], CS, -msub)); S[mt][nt][e] = pv; rs += pv; }
                rs = fq_sum(rs);
                l[mt] = l[mt] * alpha + rs; m[mt] = mnew;
#pragma unroll
                for (int dt = 0; dt < 4; ++dt) O[mt][dt] = O[mt][dt] * alpha;
                pf[mt][0] = pack_p(S[mt][0], S[mt][1]); pf[mt][1] = pack_p(S[mt][2], S[mt][3]);
            }
#pragma unroll
            for (int ks2 = 0; ks2 < 2; ++ks2)
#pragma unroll
                for (int dt = 0; dt < 4; ++dt) {
                    const bf16x8 vf = tr_frag_perm_swz(VT, 32 * ks2, dt, fr, fq);
                    O[0][dt] = mfma16(vf, pf[0][ks2], O[0][dt]);
                    O[1][dt] = mfma16(vf, pf[1][ks2], O[1][dt]);
                }
        }
        if (n + 1 < L) { if (n + 3 < L) NSA_WAITV(4); else if (n + 2 < L) NSA_WAITV(2); else NSA_WAITV(0); }
        NSA_BAR();
    }
#pragma unroll
    for (int mt = 0; mt < 2; ++mt) {
        const float gsc = (mt == 0 ? gate0 : gate1) * (l[mt] > 0.f ? 1.0f / l[mt] : 0.f);
#pragma unroll
        for (int dt = 0; dt < 4; ++dt) { f32x4* yp = (f32x4*)(smem + NSA_Y) + (mt * 4 + dt) * NTHR + tid; *yp = *yp + O[mt][dt] * gsc; }
    }
}

__device__ __forceinline__ void nsa_cmp_one(const char* smem, const bf16x8 qf0, const bf16x8 qf1, const int t, const int i, const float gate0, f32x4* yp  , unsigned& selm, const int lane) {
    const int fr = lane & 15, fq = lane >> 4;
        const int cl = (t >= 31 ? ((t - 31) >> 4) : -1) - 4 * fq;
        f32x4 S[8];
#pragma unroll
        for (int nt = 0; nt < 8; ++nt) {
            f32x4 s = (f32x4){0.f, 0.f, 0.f, 0.f};
#pragma unroll
            for (int ks = 0; ks < 2; ++ks) {
                const bf16x8 kf = *(const bf16x8*)(smem + NSA_KC + (16 * nt + fr) * NSA_PITCH + (ks * 4 + fq) * 16);
                s = mfma16(kf, (ks == 0 ? qf0 : qf1), s);
            }
            S[nt] = s;
        }
        float mx = -INFINITY;
#pragma unroll
        for (int nt = 0; nt < 8; ++nt)
#pragma unroll
            for (int e = 0; e < 4; ++e) {
                const float sv = (16 * nt + e <= cl) ? S[nt][e] * 0.125f : -INFINITY;
                S[nt][e] = sv; mx = fmaxf(mx, sv);
            }
        mx = fmaxf(mx, __shfl_xor(mx, 16)); mx = fmaxf(mx, __shfl_xor(mx, 32));
        const float mref = fmaxf(mx, -1e30f);
        float rs = 0.f;
#pragma unroll
        for (int nt = 0; nt < 8; ++nt)
#pragma unroll
            for (int e = 0; e < 4; ++e) { const float pv = __expf(S[nt][e] - mref); S[nt][e] = pv; rs += pv; }
        rs += __shfl_xor(rs, 16); rs += __shfl_xor(rs, 32);
        const float inv = rs > 0.f ? 1.0f / rs : 0.f;
#pragma unroll
        for (int nt = 0; nt < 8; ++nt) S[nt] = S[nt] * inv;
        {
            f32x4 O[4];
#pragma unroll
            for (int dt = 0; dt < 4; ++dt) O[dt] = (f32x4){0.f, 0.f, 0.f, 0.f};
#pragma unroll
            for (int ks2 = 0; ks2 < 4; ++ks2) {
                const bf16x8 pf = pack_p(S[2 * ks2], S[2 * ks2 + 1]);
#pragma unroll
                for (int dt = 0; dt < 4; ++dt) {
                    const bf16x8 vf = tr_frag_perm(smem + NSA_VC, NSA_PITCH, 32 * ks2, 16 * dt, fr, fq);
                    O[dt] = mfma16(vf, pf, O[dt]);
                }
            }
#pragma unroll
            for (int dt = 0; dt < 4; ++dt) yp[dt * NTHR] = O[dt] * gate0;
        }
        float imp[8];
        {
            float own[8], last[8];
#pragma unroll
            for (int nt = 0; nt < 8; ++nt) {
                f32x4 v = S[nt];
#pragma unroll
                for (int e = 0; e < 4; ++e) { v[e] += dpp_xor1(v[e]); v[e] += dpp_xor2(v[e]); }
                own[nt] = (v[0] + v[1]) + (v[2] + v[3]); last[nt] = v[3];
            }
            const int src = (lane + 48) & 63;
#pragma unroll
            for (int nt = 0; nt < 8; ++nt) {
                const float a = __shfl(last[nt], src);
                const float bsh = nt > 0 ? __shfl(last[nt > 0 ? nt - 1 : 0], src) : 0.f;
                const float prevc = fq > 0 ? a : bsh;
                const int n = 4 * nt + fq;
                const float pslc = own[nt] + prevc;
                const bool valid = n <= i;
                const bool forced = (n == 0) || (n == i) || (n == i - 1);
                imp[nt] = valid ? pslc + (forced ? 1e4f : 0.f) : -1e30f;
            }
        }
        unsigned mask = 0u;
#pragma unroll 1
        for (int r = 0; r < 8; ++r) {
            float bv = imp[0]; int bn = fq;
#pragma unroll
            for (int nt = 1; nt < 8; ++nt) { if (imp[nt] > bv) { bv = imp[nt]; bn = 4 * nt + fq; } }
#pragma unroll
            for (int off = 16; off <= 32; off <<= 1) {
                const float ov = __shfl_xor(bv, off); const int on = __shfl_xor(bn, off);
                if (ov > bv || (ov == bv && on < bn)) { bv = ov; bn = on; }
            }
            if (bv > -5e29f) mask |= 1u << bn;
#pragma unroll
            for (int nt = 0; nt < 8; ++nt) if (bn == 4 * nt + fq) imp[nt] = -3.0e38f;
        }
        selm = mask;
}

template <int NSAV = 7  >
__device__ __forceinline__ void nsa_task(const Params& p, char* smem, int b, int g, int i) {
    const char* ws = p.ws;
    const bf16_t* Pb = (const bf16_t*)(ws + WS_P) + (long)b * SEQ * PW;
    const float* psm = (const float*)(ws + WS_PSM) + (long)b * SEQ * 32;
    int tid = threadIdx.x;
    asm volatile("" : "+v"(tid));
    const int lane = tid & 63, wid = __builtin_amdgcn_readfirstlane(tid >> 6), fr = lane & 15, fq = lane >> 4;
    const int qs = i * 64;
    NsaState st;
    float gate[2][3];
#pragma unroll
    for (int mt = 0; mt < 2; ++mt) {
        st.tl[mt] = 8 * wid + 4 * mt + (fr >> 2);
        const int h = fr & 3;
        const bf16_t* qp = Pb + (long)(qs + st.tl[mt]) * PW + PC_Q + g * 256 + h * 64 + fq * 8;
        st.qf[mt][0] = *(const bf16x8*)(qp); st.qf[mt][1] = *(const bf16x8*)(qp + 32);
        const float* gp = psm + (long)(qs + st.tl[mt]) * 32 + (g * 4 + h) * 3;
        gate[mt][0] = sigmoidf_(gp[0]); gate[mt][1] = sigmoidf_(gp[1]); gate[mt][2] = sigmoidf_(gp[2]);
    }
    {
        const bf16_t* kc = (const bf16_t*)(ws + WS_KCMP) + (long)(b * 2 + g) * 128 * 64;
        const bf16_t* vc = (const bf16_t*)(ws + WS_VCMP) + (long)(b * 2 + g) * 128 * 64;
#pragma unroll
        for (int r = 0; r < 2; ++r) {
            const int e = tid + r * NTHR, row = e >> 3, ch = e & 7;
            *(u32x4*)(smem + NSA_KC + row * NSA_PITCH + ch * 16) = *(const u32x4*)(kc + row * 64 + ch * 8);
            *(u32x4*)(smem + NSA_VC + row * NSA_PITCH + ch * 16) = *(const u32x4*)(vc + row * 64 + ch * 8);
        }
    }
    __syncthreads();
    if (!(NSAV & 1)) { st.selm[0] = 0xffffffffu; st.selm[1] = 0xffffffffu;
#pragma unroll
        for (int d8 = 0; d8 < 8; ++d8) ((f32x4*)(smem + NSA_Y))[d8 * NTHR + tid] = (f32x4){0.f, 0.f, 0.f, 0.f}; }
    if (NSAV & 1) {
    nsa_cmp_one(smem, st.qf[0][0], st.qf[0][1], qs + st.tl[0], i, gate[0][0], (f32x4*)(smem + NSA_Y) + tid, st.selm[0], lane);
    asm volatile("" ::: "memory");
    __builtin_amdgcn_sched_barrier(0);
    nsa_cmp_one(smem, st.qf[1][0], st.qf[1][1], qs + st.tl[1], i, gate[1][0], (f32x4*)(smem + NSA_Y) + 4 * NTHR + tid, st.selm[1], lane);
    __builtin_amdgcn_sched_barrier(0);
    }
    {
        unsigned u = st.selm[0] | st.selm[1];
        u |= __shfl_xor(u, 4); u |= __shfl_xor(u, 8);
        st.wunion = u;
        unsigned* misc = (unsigned*)(smem + NSA_MISC);
        if (lane == 0) misc[wid] = u;
        __syncthreads();
        unsigned bu = 0u;
#pragma unroll
        for (int w = 0; w < 8; ++w) bu |= misc[w];
        st.bunion = bu;
    }
    if (NSAV & 2) nsa_stream<0>(smem, Pb, g, i, st, gate[0][1], gate[1][1], tid);
    if (NSAV & 4) nsa_stream<1>(smem, Pb, g, i, st, gate[0][2], gate[1][2], tid);
    bf16_t* mix = (bf16_t*)(p.ws + WS_MIX) + (long)b * SEQ * 1024;
#pragma unroll
    for (int mt = 0; mt < 2; ++mt) {
        bf16_t* op = mix + (long)(qs + st.tl[mt]) * 1024 + g * 256 + (fr & 3) * 64 + fq * 4;
#pragma unroll
        for (int dt = 0; dt < 4; ++dt) {
            const f32x4 yv = *((const f32x4*)(smem + NSA_Y) + (mt * 4 + dt) * NTHR + tid);
            u32x2 w; w.x = pk_bf16(yv[0], yv[1]); w.y = pk_bf16(yv[2], yv[3]);
            *(u32x2*)(op + dt * 16) = w;
        }
    }
    __syncthreads();
}

constexpr int ML_PITCH = 288;
constexpr int ML_Q = 0, ML_K = 18432, ML_V = 36864, ML_VW = 55296, ML_C = 73728, ML_N = 110592, ML_GB = 111104, ML_GA = 119296, ML_GMQ = 127488,
              ML_GS = 135680, ML_ST = 136192;

__device__ __forceinline__ float wave_incl_scan_add(float v, int lane) {
#pragma unroll
    for (int off = 1; off < 64; off <<= 1) { const float o = __shfl_up(v, off); if (lane >= off) v += o; }
    return v;
}
__device__ __forceinline__ float wave_incl_scan_max(float v, int lane) {
#pragma unroll
    for (int off = 1; off < 64; off <<= 1) { const float o = __shfl_up(v, off); if (lane >= off) v = fmaxf(v, o); }
    return v;
}
__device__ __forceinline__ float wave_max(float v) {
#pragma unroll
    for (int off = 32; off >= 1; off >>= 1) v = fmaxf(v, __shfl_xor(v, off));
    return v;
}

__device__ __forceinline__ void mlstm_scan(const Params& p, char* smem, int b, int h) {
    const char* ws = p.ws;
    int tid = threadIdx.x;
    asm volatile("" : "+v"(tid));
    const int lane = tid & 63, wid = __builtin_amdgcn_readfirstlane(tid >> 6), fr = lane & 15, fq = lane >> 4;
    const bf16_t* QK = (const bf16_t*)(ws + WS_QK) + (long)b * SEQ * 1024 + h * 128;
    const bf16_t* Pb = (const bf16_t*)(ws + WS_P) + (long)b * SEQ * PW;
    const float* psm = (const float*)(ws + WS_PSM) + (long)b * SEQ * 32;
    bf16_t* mix = (bf16_t*)(p.ws + WS_MIX) + (long)b * SEQ * 1024 + 512 + h * 128;
    float* GB = (float*)(smem + ML_GB); float* GA = (float*)(smem + ML_GA); float* GMQ = (float*)(smem + ML_GMQ);
    float* GS = (float*)(smem + ML_GS);
    float* NV = (float*)(smem + ML_N);
    float* ST = (float*)(smem + ML_ST);
    {
        const float ib = p.in[I_IBIAS][h], fb = p.in[I_FBIAS][h];
        for (int c = wid; c < 32; c += 8) {
            const int t = c * 64 + lane;
            const float ipre = psm[(long)t * 32 + 24 + h], fpre = psm[(long)t * 32 + 28 + h];
            const float li = ipre + ib;
            const float x = fpre + fb;
            const float lf = fminf(x, 0.f) - log1pf(__expf(-fabsf(x)));
            const float bb = wave_incl_scan_add(lf, lane);
            const float aa = li - bb;
            const float g = __shfl(bb, 63);
            const float pm = wave_incl_scan_max(aa, lane);
            const float mloc = wave_max(g + aa);
            GB[t] = bb; GA[t] = aa; GMQ[t] = pm;
            if (lane == 0) { GS[64 + c] = g; GS[96 + c] = mloc; }
        }
    }
    for (int e = tid; e < 36864 / 16; e += NTHR) *(u32x4*)(smem + ML_C + e * 16) = (u32x4){0u, 0u, 0u, 0u};
    if (tid < 128) NV[tid] = 0.f;
    __syncthreads();
    if (tid == 0) {
        float m = 0.f;
        for (int c = 0; c < 32; ++c) { GS[c] = m; const float mn = fmaxf(GS[64 + c] + m, GS[96 + c]); GS[32 + c] = mn; m = mn; }
    }
    __syncthreads();
    for (int t = tid; t < SEQ; t += NTHR) GMQ[t] = GB[t] + fmaxf(GS[t >> 6], GMQ[t]);
    __syncthreads();

    f32x4 Cacc[9];
#pragma unroll
    for (int c9 = 0; c9 < 9; ++c9) Cacc[c9] = (f32x4){0.f, 0.f, 0.f, 0.f};
    const int lrow = tid >> 4, lch = tid & 15;
    u32x4 rq[2], rk[2], rv[2];
#pragma unroll
    for (int i2 = 0; i2 < 2; ++i2) {
        const int row = lrow + 32 * i2;
        rq[i2] = *(const u32x4*)(QK + (long)row * 1024 + lch * 8);
        rk[i2] = *(const u32x4*)(QK + (long)row * 1024 + 512 + lch * 8);
        rv[i2] = *(const u32x4*)(Pb + (long)row * PW + PC_MV + h * 128 + lch * 8);
    }
    const int mt = wid >> 1, half = wid & 1;
#pragma unroll 1
    for (int c = 0; c < 32; ++c) {
        const float m_old = GS[c], m_new = GS[32 + c], gch = GS[64 + c];
#pragma unroll
        for (int i2 = 0; i2 < 2; ++i2) {
            const int row = lrow + 32 * i2;
            *(u32x4*)(smem + ML_Q + row * ML_PITCH + lch * 16) = rq[i2];
            *(u32x4*)(smem + ML_K + row * ML_PITCH + lch * 16) = rk[i2];
            *(u32x4*)(smem + ML_V + row * ML_PITCH + lch * 16) = rv[i2];
            const float wk = __expf(gch + GA[c * 64 + row] - m_new);
            u32x4 w;
            w.x = pk_bf16(bf_lo(rv[i2].x) * wk, bf_hi(rv[i2].x) * wk); w.y = pk_bf16(bf_lo(rv[i2].y) * wk, bf_hi(rv[i2].y) * wk);
            w.z = pk_bf16(bf_lo(rv[i2].z) * wk, bf_hi(rv[i2].z) * wk); w.w = pk_bf16(bf_lo(rv[i2].w) * wk, bf_hi(rv[i2].w) * wk);
            *(u32x4*)(smem + ML_VW + row * ML_PITCH + lch * 16) = w;
        }
        if (tid < 128) {
            const int row = tid >> 1, hf = tid & 1;
            const float wk = __expf(gch + GA[c * 64 + row] - m_new);
            u32x4 w = (u32x4){0u, 0u, 0u, 0u};
            if (hf == 0) w.x = pk_bf16(wk, 0.f);
            *(u32x4*)(smem + ML_VW + row * ML_PITCH + 256 + hf * 16) = w;
        }
        __syncthreads();
        if (c + 1 < 32) {
#pragma unroll
            for (int i2 = 0; i2 < 2; ++i2) {
                const int row = (c + 1) * 64 + lrow + 32 * i2;
                rq[i2] = *(const u32x4*)(QK + (long)row * 1024 + lch * 8);
                rk[i2] = *(const u32x4*)(QK + (long)row * 1024 + 512 + lch * 8);
                rv[i2] = *(const u32x4*)(Pb + (long)row * PW + PC_MV + h * 128 + lch * 8);
            }
        }
        const int l = 16 * mt + fr;
        const float bl = GB[c * 64 + l], mq = GMQ[c * 64 + l];
        const float ul = bl - mq;
        f32x4 hv[4];
        float s1 = 0.f, s2 = 0.f;
        {
            bf16x8 qf[4];
#pragma unroll
            for (int ks = 0; ks < 4; ++ks) qf[ks] = *(const bf16x8*)(smem + ML_Q + l * ML_PITCH + (ks * 4 + fq) * 16);
            f32x4 S[4];
#pragma unroll
            for (int nt = 0; nt < 4; ++nt) {
                f32x4 s = (f32x4){0.f, 0.f, 0.f, 0.f};
#pragma unroll
                for (int ks = 0; ks < 4; ++ks) {
                    const bf16x8 kf = *(const bf16x8*)(smem + ML_K + (16 * nt + fr) * ML_PITCH + (ks * 4 + fq) * 16);
                    s = mfma16(kf, qf[ks], s);
                }
                S[nt] = s;
            }
            float dintra = 0.f;
            const int lq = l - 4 * fq;
#pragma unroll
            for (int nt = 0; nt < 4; ++nt) {
                const f32x4 av = *(const f32x4*)(GA + c * 64 + 16 * nt + 4 * fq);
#pragma unroll
                for (int e = 0; e < 4; ++e) {
                    const float w = (16 * nt + e <= lq) ? __expf(ul + av[e]) : 0.f;
                    const float sv = S[nt][e] * w;
                    S[nt][e] = sv; dintra += sv;
                }
            }
            dintra += __shfl_xor(dintra, 16); dintra += __shfl_xor(dintra, 32);
            float dinter = 0.f;
#pragma unroll
            for (int ks = 0; ks < 4; ++ks) {
                const f32x4 n0 = *(const f32x4*)(NV + ks * 32 + fq * 8), n1 = *(const f32x4*)(NV + ks * 32 + fq * 8 + 4);
                const u32x4 qu = __builtin_bit_cast(u32x4, qf[ks]);
                dinter += bf_lo(qu.x) * n0[0] + bf_hi(qu.x) * n0[1] + bf_lo(qu.y) * n0[2] + bf_hi(qu.y) * n0[3]
                        + bf_lo(qu.z) * n1[0] + bf_hi(qu.z) * n1[1] + bf_lo(qu.w) * n1[2] + bf_hi(qu.w) * n1[3];
            }
            dinter += __shfl_xor(dinter, 16); dinter += __shfl_xor(dinter, 32);
            const float winter = __expf(ul + m_old);
            const float den = winter * dinter + dintra;
            const float rden = 1.0f / fmaxf(fabsf(den), __expf(-mq));
            const bf16x8 pf0 = pack_p(S[0], S[1]), pf1 = pack_p(S[2], S[3]);
#pragma unroll
            for (int c4 = 0; c4 < 4; ++c4) {
                const int et = 4 * half + c4;
                f32x4 num = (f32x4){0.f, 0.f, 0.f, 0.f}, inter = (f32x4){0.f, 0.f, 0.f, 0.f};
                num = mfma16(tr_frag_perm(smem + ML_V, ML_PITCH, 0, 16 * et, fr, fq), pf0, num);
                num = mfma16(tr_frag_perm(smem + ML_V, ML_PITCH, 32, 16 * et, fr, fq), pf1, num);
#pragma unroll
                for (int ks = 0; ks < 4; ++ks) {
                    const bf16x8 cf = *(const bf16x8*)(smem + ML_C + (16 * et + fr) * ML_PITCH + (ks * 4 + fq) * 16);
                    inter = mfma16(cf, qf[ks], inter);
                }
                const f32x4 hh = (inter * winter + num) * rden;
                hv[c4] = hh;
                s1 += (hh[0] + hh[1]) + (hh[2] + hh[3]);
                s2 += (hh[0] * hh[0] + hh[1] * hh[1]) + (hh[2] * hh[2] + hh[3] * hh[3]);
            }
            s1 += __shfl_xor(s1, 16); s1 += __shfl_xor(s1, 32);
            s2 += __shfl_xor(s2, 16); s2 += __shfl_xor(s2, 32);
            if (fq == 0) { ST[(l * 2 + half) * 2] = s1; ST[(l * 2 + half) * 2 + 1] = s2; }
        }
        {
            const float decay = __expf(gch + m_old - m_new);
#pragma unroll
            for (int c9 = 0; c9 < 9; ++c9) Cacc[c9] = Cacc[c9] * decay;
#pragma unroll
            for (int ks2 = 0; ks2 < 2; ++ks2) {
                const bf16x8 kt = tr_frag_std(smem + ML_K, ML_PITCH, 32 * ks2, 16 * wid, fr, fq);
#pragma unroll
                for (int c9 = 0; c9 < 9; ++c9) {
                    const bf16x8 vw = tr_frag_std(smem + ML_VW, ML_PITCH, 32 * ks2, 16 * c9, fr, fq);
                    Cacc[c9] = mfma16(kt, vw, Cacc[c9]);
                }
            }
        }
        __syncthreads();
        {
            const float* sp = ST + l * 4;
            const float t1 = sp[0] + sp[2], t2 = sp[1] + sp[3];
            const float mean = t1 * (1.0f / 128.0f);
            const float var = fmaxf(t2 * (1.0f / 128.0f) - mean * mean, 0.f);
            const float rstd = rsqrtf(var + LN_EPS);
            const long tok = c * 64 + l;
#pragma unroll
            for (int c4 = 0; c4 < 4; ++c4) {
                const int col = 64 * half + 16 * c4 + 4 * fq;
                const u32x2 ou = *(const u32x2*)(Pb + tok * PW + PC_MO + h * 128 + col);
                const f32x4 ng = *(const f32x4*)(p.in[I_NORMG] + h * 128 + col);
                const f32x4 y = (hv[c4] - mean) * rstd * ng;
                u32x2 w;
                w.x = pk_bf16(y[0] * sigmoidf_(bf_lo(ou.x)), y[1] * sigmoidf_(bf_hi(ou.x)));
                w.y = pk_bf16(y[2] * sigmoidf_(bf_lo(ou.y)), y[3] * sigmoidf_(bf_hi(ou.y)));
                *(u32x2*)(mix + tok * 1024 + col) = w;
            }
        }
#pragma unroll
        for (int c9 = 0; c9 < 8; ++c9) {
            u32x2 w; w.x = pk_bf16(Cacc[c9][0], Cacc[c9][1]); w.y = pk_bf16(Cacc[c9][2], Cacc[c9][3]);
            *(u32x2*)(smem + ML_C + (16 * c9 + fr) * ML_PITCH + (16 * wid + 4 * fq) * 2) = w;
        }
        if (fr == 0) *(f32x4*)(NV + 16 * wid + 4 * fq) = Cacc[8];
        __syncthreads();
    }
}

template <int PARTS = 3  , int NSAV = 7>
__device__ __forceinline__ void phase3(const Params& p, char* smem, int bid, int nb, int rep = 0) {
    XcdSlab xs; xs.init(bid, nb);
    const int nq = xs.x >= 0 ? 128 : 1024;
    int* qctr = (int*)(p.ws + WS_CNT) + 16384 + ((xs.x >= 0 ? xs.x : 0) + 8 * rep) * 32;
    if (PARTS & 1) for (int u = bid; u < 64; u += nb) mlstm_scan(p, smem, u >> 2, u & 3);
    if (!(PARTS & 2)) return;
    volatile int* slot = (volatile int*)(smem + NSA_MISC + 256);
    for (;;) {
        if (opaque_tid() == 0) *slot = atomicAdd(qctr, 1);
        __syncthreads();
        const int k = __builtin_amdgcn_readfirstlane(*slot);
        if (k >= nq) break;
        if (xs.x >= 0) { const int bg = 4 * xs.x + (k & 3); nsa_task<NSAV>(p, smem, bg >> 1, bg & 1, 31 - (k >> 2)); }
        else nsa_task<NSAV>(p, smem, (k & 31) >> 1, k & 1, 31 - (k >> 5));
    }
}

constexpr int XA_PITCH = 544;
constexpr int XA_K = 0, XA_V = 69632;
__device__ __forceinline__ void xattn_task(const Params& p, char* smem, int b, int h, int qb) {
    const char* ws = p.ws;
    int tid = threadIdx.x;
    asm volatile("" : "+v"(tid));
    const int lane = tid & 63, wid = __builtin_amdgcn_readfirstlane(tid >> 6), fr = lane & 15, fq = lane >> 4;
    const bf16_t* XQ = (const bf16_t*)(ws + WS_XQ) + (long)(b * SEQ + qb * 128 + wid * 16 + fr) * 1024 + h * 256 + fq * 8;
    const bf16_t* KV = (const bf16_t*)(ws + WS_KVX) + (long)b * 256 * 2048 + h * 256;
    bf16x8 qf[8];
#pragma unroll
    for (int ks = 0; ks < 8; ++ks) qf[ks] = *(const bf16x8*)(XQ + ks * 32);
    f32x4 O[16];
#pragma unroll
    for (int dt = 0; dt < 16; ++dt) O[dt] = (f32x4){0.f, 0.f, 0.f, 0.f};
    float m = -1e30f, l = 0.f;
    const int lrow = tid >> 5, lch = tid & 31;
    u32x4 rk[4], rv[4];
#pragma unroll
    for (int i2 = 0; i2 < 4; ++i2) {
        const bf16_t* rp = KV + (long)(lrow + 16 * i2) * 2048 + lch * 8;
        rk[i2] = *(const u32x4*)rp; rv[i2] = *(const u32x4*)(rp + 1024);
    }
#pragma unroll
    for (int i2 = 0; i2 < 4; ++i2) {
        *(u32x4*)(smem + XA_K + (lrow + 16 * i2) * XA_PITCH + lch * 16) = rk[i2];
        *(u32x4*)(smem + XA_V + (lrow + 16 * i2) * XA_PITCH + lch * 16) = rv[i2];
    }
    __syncthreads();
#pragma unroll 1
    for (int j = 0; j < 4; ++j) {
        const int buf = j & 1;
        if (j + 1 < 4) {
#pragma unroll
            for (int i2 = 0; i2 < 4; ++i2) {
                const bf16_t* rp = KV + (long)((j + 1) * 64 + lrow + 16 * i2) * 2048 + lch * 8;
                rk[i2] = *(const u32x4*)rp; rv[i2] = *(const u32x4*)(rp + 1024);
            }
        }
        const char* KT = smem + XA_K + buf * 34816;
        const char* VT = smem + XA_V + buf * 34816;
        f32x4 S[4];
#pragma unroll
        for (int nt = 0; nt < 4; ++nt) {
            f32x4 s = (f32x4){0.f, 0.f, 0.f, 0.f};
#pragma unroll
            for (int ks = 0; ks < 8; ++ks) {
                const bf16x8 kf = *(const bf16x8*)(KT + (16 * nt + fr) * XA_PITCH + (ks * 4 + fq) * 16);
                s = mfma16(kf, qf[ks], s);
            }
            S[nt] = s * 0.0625f;
        }
        float mx = -INFINITY;
#pragma unroll
        for (int nt = 0; nt < 4; ++nt)
#pragma unroll
            for (int e = 0; e < 4; ++e) mx = fmaxf(mx, S[nt][e]);
        mx = fmaxf(mx, __shfl_xor(mx, 16)); mx = fmaxf(mx, __shfl_xor(mx, 32));
        const float mnew = fmaxf(m, mx);
        const float alpha = __expf(m - mnew);
        float rs = 0.f;
#pragma unroll
        for (int nt = 0; nt < 4; ++nt)
#pragma unroll
            for (int e = 0; e < 4; ++e) { const float pv = __expf(S[nt][e] - mnew); S[nt][e] = pv; rs += pv; }
        rs += __shfl_xor(rs, 16); rs += __shfl_xor(rs, 32);
        l = l * alpha + rs; m = mnew;
#pragma unroll
        for (int dt = 0; dt < 16; ++dt) O[dt] = O[dt] * alpha;
        const bf16x8 pf0 = pack_p(S[0], S[1]), pf1 = pack_p(S[2], S[3]);
#pragma unroll
        for (int dt = 0; dt < 16; ++dt) {
            O[dt] = mfma16(tr_frag_perm(VT, XA_PITCH, 0, 16 * dt, fr, fq), pf0, O[dt]);
            O[dt] = mfma16(tr_frag_perm(VT, XA_PITCH, 32, 16 * dt, fr, fq), pf1, O[dt]);
        }
        if (j + 1 < 4) {
            char* KTn = smem + XA_K + (buf ^ 1) * 34816; char* VTn = smem + XA_V + (buf ^ 1) * 34816;
#pragma unroll
            for (int i2 = 0; i2 < 4; ++i2) {
                *(u32x4*)(KTn + (lrow + 16 * i2) * XA_PITCH + lch * 16) = rk[i2];
                *(u32x4*)(VTn + (lrow + 16 * i2) * XA_PITCH + lch * 16) = rv[i2];
            }
        }
        __syncthreads();
    }
    const float inv = 1.0f / l;
    bf16_t* op = (bf16_t*)(p.ws + WS_XO) + (long)(b * SEQ + qb * 128 + wid * 16 + fr) * 1024 + h * 256 + fq * 4;
#pragma unroll
    for (int dt = 0; dt < 16; ++dt) {
        u32x2 w; w.x = pk_bf16(O[dt][0] * inv, O[dt][1] * inv); w.y = pk_bf16(O[dt][2] * inv, O[dt][3] * inv);
        *(u32x2*)(op + dt * 16) = w;
    }
}

__device__ __forceinline__ void phase6(const Params& p, char* smem, int bid, int nb) {
    XcdSlab xs; xs.init(bid, nb);
    const int p_lo = xs.m_lo(64), n_t = (xs.m_hi(64) - p_lo) * 16;
    for (int u = xs.j; u < n_t; u += xs.stride) { const int pr = p_lo + (u >> 4); xattn_task(p, smem, pr >> 2, pr & 3, u & 15); }
}

constexpr int LN_ST = 139264, LN_GB = 141312, MOE_TAB = 153600;

__device__ __forceinline__ void phase4(const Params& p, char* smem, int bid, int nb) {
    char* ws = p.ws;
    XcdSlab xs; xs.init(bid, nb);
    const int m_lo = xs.m_lo(128), n_t = (xs.m_hi(128) - m_lo) * 4;
    for (int u = xs.j; u < n_t; u += xs.stride) {
        const int mt = m_lo + (u >> 2), nt = u & 3;
        RingRows al, bl;
        al.init_contig((const bf16_t*)(ws + WS_MIX), 1024, mt * 256);
        bl.init_contig((const bf16_t*)(ws + WS_WOUT), 1024, nt * 256, true);
        f32x4 acc[8][4];
        gemm_ring(smem, al, bl, 32, acc);
        epi_residual<false>(acc, smem, p.in[I_X], nullptr, nullptr, nullptr, (float*)(ws + WS_R1), (bf16_t*)(ws + WS_R1B), (float*)(ws + WS_ST1), mt * 256, nt);
    }
}

__device__ __forceinline__ void phase5(const Params& p, char* smem, int bid, int nb) {
    char* ws = p.ws;
    const float* lnf = (const float*)(ws + WS_LNF);
    XcdSlab xs; xs.init(bid, nb);
    const int m_lo = xs.m_lo(128), n_t = (xs.m_hi(128) - m_lo) * 4;
    for (int u = xs.j; u < n_t; u += xs.stride) {
        const int mt = m_lo + (u >> 2), nt = u & 3;
        RingRows al, bl;
        al.init_contig((const bf16_t*)(ws + WS_R1B), 1024, mt * 256);
        bl.init_contig((const bf16_t*)(ws + WS_WQ), 1024, nt * 256, true);
        f32x4 acc[8][4];
        gemm_ring(smem, al, bl, 32, acc);
        ln_correct<0>(acc, (const float*)(ws + WS_ST1), mt * 256, lnf, lnf + 1792, nt);
        epi_store_bf16(acc, (bf16_t*)(ws + WS_XQ), 1024, mt * 256, nt * 256);
    }
}

__device__ __forceinline__ void phase7(const Params& p, char* smem, int bid, int nb) {
    char* ws = p.ws;
    XcdSlab xs; xs.init(bid, nb);
    const int m_lo = xs.m_lo(128), n_t = (xs.m_hi(128) - m_lo) * 4;
    for (int u = xs.j; u < n_t; u += xs.stride) {
        const int mt = m_lo + (u >> 2), nt = u & 3;
        RingRows al, bl;
        al.init_contig((const bf16_t*)(ws + WS_XO), 1024, mt * 256);
        bl.init_contig((const bf16_t*)(ws + WS_WO), 1024, nt * 256, true);
        f32x4 acc[8][4];
        gemm_ring(smem, al, bl, 32, acc);
        epi_residual<true>(acc, smem, (const float*)(ws + WS_R1), (const float*)(ws + WS_ST1), p.in[I_LN1G], p.in[I_LN1B],
                           (float*)(ws + WS_R2), (bf16_t*)(ws + WS_R2B), (float*)(ws + WS_ST2), mt * 256, nt);
    }
}

template <class RowMap>
__device__ __forceinline__ void epi_swiglu(const f32x4 (&acc)[8][4], bf16_t* out, int ld, int nt, const RowMap& rm) {
    const int tid_ = opaque_tid();
    const int lane = tid_ & 63, wid = tid_ >> 6;
    const int wr = wid >> 2, wc = wid & 3, fr = lane & 15, fq = lane >> 4;
#pragma unroll
    for (int mi = 0; mi < 8; ++mi) {
        const long orow = rm(wr * 128 + mi * 16 + fr);
        if (orow >= 0) {
            const f32x4 a0 = acc[mi][0], b0 = acc[mi][1], a1 = acc[mi][2], b1 = acc[mi][3];
            u32x4 w;
            w.x = pk_bf16(siluf_(a0[0]) * b0[0], siluf_(a0[1]) * b0[1]); w.y = pk_bf16(siluf_(a0[2]) * b0[2], siluf_(a0[3]) * b0[3]);
            w.z = pk_bf16(siluf_(a1[0]) * b1[0], siluf_(a1[1]) * b1[1]); w.w = pk_bf16(siluf_(a1[2]) * b1[2], siluf_(a1[3]) * b1[3]);
            *(u32x4*)(out + orow * ld + nt * 128 + wc * 32 + fq * 8) = w;
        }
    }
}
struct RowIdent { long row0; __device__ __forceinline__ long operator()(int rl) const { return row0 + rl; } };

__device__ __forceinline__ unsigned dpp_xor1_u(unsigned v) { return (unsigned)__builtin_amdgcn_mov_dpp((int)v, 0xB1, 0xF, 0xF, true); }
__device__ __forceinline__ void route_tile(const Params& p, char* smem, int tok0, int rep) {
    char* ws = p.ws;
    const float* bias = p.in[I_ROUTB];
    const int tid = opaque_tid(), tk = tid >> 1, hf = tid & 1;
    const float* row = (const float*)(ws + WS_RSC) + (long)(tok0 + tk) * 256;
    unsigned key[128];
    float gs[4];
    {
        float v[128];
#pragma unroll
        for (int i = 0; i < 32; ++i) { const f32x4 t = *(const f32x4*)(row + hf * 128 + i * 4); v[4 * i] = t[0]; v[4 * i + 1] = t[1]; v[4 * i + 2] = t[2]; v[4 * i + 3] = t[3]; }
#pragma unroll
        for (int gi = 0; gi < 4; ++gi) {
            float m1 = -INFINITY, m2 = -INFINITY;
#pragma unroll
            for (int i = 0; i < 32; ++i) { const float x = v[32 * gi + i]; m2 = __builtin_fmaxf(m2, __builtin_fminf(m1, x)); m1 = __builtin_fmaxf(m1, x); }
            gs[gi] = m1 + m2;
        }
        float g8[8];
#pragma unroll
        for (int gi = 0; gi < 4; ++gi) { const float o = dpp_xor1(gs[gi]); g8[gi] = hf ? o : gs[gi]; g8[4 + gi] = hf ? gs[gi] : o; }
        unsigned gsel = 0u;
#pragma unroll
        for (int a = 0; a < 8; ++a) {
            int rank = 0;
#pragma unroll
            for (int b = 0; b < 8; ++b) rank += (g8[b] > g8[a] || (g8[b] == g8[a] && b < a)) ? 1 : 0;
            if (rank < 4) gsel |= 1u << a;
        }
#pragma unroll
        for (int gi = 0; gi < 4; ++gi) {
            const bool on = ((gsel >> (4 * hf + gi)) & 1u) != 0u;
#pragma unroll
            for (int i = 0; i < 32; ++i) {
                const unsigned kb = (__float_as_uint(v[32 * gi + i] + 1.0f) & ~0xFFu) | (unsigned)(255 - (128 * hf + 32 * gi + i));
                key[32 * gi + i] = on ? kb : 0u;
            }
        }
    }
    unsigned win[8];
    unsigned prev = 0xFFFFFFFFu;
#pragma unroll
    for (int r = 0; r < 8; ++r) {
        unsigned m = 0u;
#pragma unroll
        for (int i = 0; i < 128; ++i) { const unsigned kk = key[i]; const unsigned c = kk < prev ? kk : 0u; m = m > c ? m : c; }
        const unsigned o = dpp_xor1_u(m);
        m = m > o ? m : o;
        prev = m;
        win[r] = m;
    }
    float sc8[8]; float wsum = 0.f;
#pragma unroll
    for (int r = 0; r < 8; ++r) { const int e = 255 - (int)(win[r] & 255u); sc8[r] = row[e] - bias[e]; wsum += sc8[r]; }
    int* lc = (int*)(smem + MOE_TAB); int* gbase = lc + 256;
    if (tid < 256) lc[tid] = 0;
    __syncthreads();
    int mye[4], myr[4];
    const unsigned hmask = 0u - (unsigned)hf;
#pragma unroll
    for (int u = 0; u < 4; ++u) {
        const unsigned w = win[u] ^ ((win[u] ^ win[4 + u]) & hmask);
        mye[u] = 255 - (int)(w & 255u); myr[u] = atomicAdd(lc + mye[u], 1);
    }
    __syncthreads();
    if (tid < 256) { const int n = lc[tid]; if (n > 0) gbase[tid] = atomicAdd((int*)(ws + WS_CNT) + 8192 * rep + tid * 32, n); }
    __syncthreads();
    {
        const long t = tok0 + tk;
        const float wn = 2.5f / wsum;
#pragma unroll
        for (int u = 0; u < 4; ++u) {
            const int k = 4 * hf + u;
            const int e = mye[u];
            const unsigned s0 = __float_as_uint(sc8[u]), s1 = __float_as_uint(sc8[4 + u]);
            const float w = __uint_as_float(s0 ^ ((s0 ^ s1) & hmask)) * wn;
            const int pos = gbase[e] + myr[u];
            ((int*)(ws + WS_SELE))[t * 8 + k] = e;
            ((int*)(ws + WS_SELP))[t * 8 + k] = pos;
            ((float*)(ws + WS_SELW))[t * 8 + k] = w;
            ((int*)(ws + WS_TOKL))[(long)e * LIST_CAP + pos] = (int)t;
            ((float*)(ws + WS_WL))[(long)e * LIST_CAP + pos] = w;
        }
    }
    __syncthreads();
}

__device__ __forceinline__ void phase8(const Params& p, char* smem, int bid, int nb, int rep = 0) {
    char* ws = p.ws;
    const float* lnf = (const float*)(ws + WS_LNF);
    XcdSlab xs; xs.init(bid, nb);
    const int m_lo = xs.m_lo(128), m_n = xs.m_hi(128) - m_lo;
    for (int u = xs.j; u < m_n; u += xs.stride) {
        const int mt = m_lo + u;
        float* gsc = (float*)(ws + WS_RSC);
        {
            RingRows al, bl;
            al.init_contig((const bf16_t*)(ws + WS_R2B), 1024, mt * 256);
            bl.init_contig((const bf16_t*)(ws + WS_WR), 1024, 0, true);
            f32x4 acc[8][4];
            gemm_ring(smem, al, bl, 32, acc);
            ln_correct<0>(acc, (const float*)(ws + WS_ST2), mt * 256, lnf + 1024, lnf + 1792 + 1024, 0);
            const int tid_ = opaque_tid();
            const int lane = tid_ & 63, wid = tid_ >> 6;
            const int wr = wid >> 2, wc = wid & 3, fr = lane & 15, fq = lane >> 4;
            const float* bias = p.in[I_ROUTB];
#pragma unroll
            for (int ni = 0; ni < 4; ++ni) {
                const int col = wc * 64 + (ni >> 1) * 32 + fq * 8 + (ni & 1) * 4;
                const f32x4 bv = *(const f32x4*)(bias + col);
#pragma unroll
                for (int mi = 0; mi < 8; ++mi) {
                    f32x4 v;
#pragma unroll
                    for (int e = 0; e < 4; ++e) v[e] = sigmoidf_(acc[mi][ni][e]) + bv[e];
                    *(f32x4*)(gsc + (long)(mt * 256 + wr * 128 + mi * 16 + fr) * 256 + col) = v;
                }
            }
        }
        __syncthreads();
        route_tile(p, smem, mt * 256, rep);
    }
    for (int u = (xs.j + xs.stride - m_n % xs.stride) % xs.stride; u < m_n * 2; u += xs.stride) {
        const int mt = m_lo + (u >> 1), nt = u & 1;
        RingRows al, bl;
        al.init_contig((const bf16_t*)(ws + WS_R2B), 1024, mt * 256);
        bl.init_contig((const bf16_t*)(ws + WS_WS13), 1024, nt * 256);
        f32x4 acc[8][4];
        gemm_ring(smem, al, bl, 32, acc);
        ln_correct<1>(acc, (const float*)(ws + WS_ST2), mt * 256, lnf + 1280, lnf + 1792 + 1280, nt);
        RowIdent rm; rm.row0 = (long)mt * 256;
        epi_swiglu(acc, (bf16_t*)(ws + WS_HS), 256, nt, rm);
    }
    {
        const int tid = opaque_tid(), lane = tid & 63, wid = tid >> 6;
        const float* r2 = (const float*)(ws + WS_R2); const float* st2 = (const float*)(ws + WS_ST2);
        bf16_t* x2 = (bf16_t*)(ws + WS_X2);
        for (int t = bid * 8 + wid; t < T_TOK; t += nb * 8) {
            const f32x4 p0 = *(const f32x4*)(st2 + (long)t * 8), p1 = *(const f32x4*)(st2 + (long)t * 8 + 4);
            const float q1 = (p0[0] + p0[2]) + (p1[0] + p1[2]), q2 = (p0[1] + p0[3]) + (p1[1] + p1[3]);
            const float mean = q1 * (1.0f / 1024.0f);
            const float rstd = rsqrtf(fmaxf(q2 * (1.0f / 1024.0f) - mean * mean, 0.f) + LN_EPS);
#pragma unroll
            for (int hseg = 0; hseg < 2; ++hseg) {
                const int col = hseg * 512 + lane * 8;
                const f32x4 a0 = *(const f32x4*)(r2 + (long)t * 1024 + col), a1 = *(const f32x4*)(r2 + (long)t * 1024 + col + 4);
                const f32x4 g0 = *(const f32x4*)(p.in[I_LN2G] + col), g1 = *(const f32x4*)(p.in[I_LN2G] + col + 4);
                const f32x4 b0 = *(const f32x4*)(p.in[I_LN2B] + col), b1 = *(const f32x4*)(p.in[I_LN2B] + col + 4);
                const f32x4 y0 = (a0 - mean) * rstd * g0 + b0, y1 = (a1 - mean) * rstd * g1 + b1;
                u32x4 w; w.x = pk_bf16(y0[0], y0[1]); w.y = pk_bf16(y0[2], y0[3]); w.z = pk_bf16(y1[0], y1[1]); w.w = pk_bf16(y1[2], y1[3]);
                *(u32x4*)(x2 + (long)t * 1024 + col) = w;
            }
        }
    }
}

template <int XMODE>
__device__ __forceinline__ void phase_probe(const Params& p, char* smem, int bid, int nb) {
    char* ws = p.ws;
    XcdSlab xs; xs.init(bid, nb);
    const int m_lo = xs.m_lo(128), n_t = (xs.m_hi(128) - m_lo) * 4;
    for (int u = xs.j; u < n_t; u += xs.stride) {
        const int mt = m_lo + (u >> 2), nt = u & 3;
        RingRows al, bl;
        al.init_contig((const bf16_t*)(ws + WS_MIX), 1024, mt * 256);
        bl.init_contig((const bf16_t*)(ws + WS_WOUT), 1024, nt * 256, true);
        f32x4 acc[8][4];
        gemm_ring<RingRows, RingRows, XMODE>(smem, al, bl, 32, acc);
        epi_store_bf16(acc, (bf16_t*)(ws + WS_A + 432 * MB), 1024, mt * 256, nt * 256);
    }
}

__device__ __forceinline__ void moe_tables(const Params& p, char* smem, const XcdSlab& xs) {
    int* off = (int*)(smem + MOE_TAB); int* tst = off + 256;
    const int* cnt = (const int*)(p.ws + WS_CNT);
    const int tid = opaque_tid();
    if (tid < 64) {
        int c[4], cs = 0;
#pragma unroll
        for (int k = 0; k < 4; ++k) { c[k] = cnt[(tid * 4 + k) * 32]; cs += c[k]; }
        int ics = cs;
#pragma unroll
        for (int o = 1; o < 64; o <<= 1) { const int a = __shfl_up(ics, o); if (tid >= o) ics += a; }
        int eo = ics - cs;
#pragma unroll
        for (int k = 0; k < 4; ++k) { off[tid * 4 + k] = eo; eo += c[k]; }
    } else if (tid < 128) {
        const int l = tid - 64;
        if (xs.x >= 0) {
            const int tl = l < 32 ? ((cnt[(xs.x + 8 * l) * 32] + 255) >> 8) : 0;
            int it = tl;
#pragma unroll
            for (int o = 1; o < 64; o <<= 1) { const int a = __shfl_up(it, o); if (l >= o) it += a; }
            if (l < 32) tst[l] = it - tl;
            if (l == 31) tst[32] = it;
        } else {
            int c[4], ts = 0;
#pragma unroll
            for (int k = 0; k < 4; ++k) { c[k] = (cnt[(l * 4 + k) * 32] + 255) >> 8; ts += c[k]; }
            int its = ts;
#pragma unroll
            for (int o = 1; o < 64; o <<= 1) { const int a = __shfl_up(its, o); if (l >= o) its += a; }
            int et = its - ts;
#pragma unroll
            for (int k = 0; k < 4; ++k) { tst[l * 4 + k] = et; et += c[k]; }
            if (l == 63) tst[256] = its;
        }
    }
    __syncthreads();
}
__device__ __forceinline__ int moe_find(const int* tst, int nloc, int t) {
    int lo = 0, hi = nloc - 1;
#pragma unroll 1
    while (lo < hi) { const int mid = (lo + hi + 1) >> 1; if (tst[mid] <= t) lo = mid; else hi = mid - 1; }
    return lo;
}
struct RowMoe { long base; int nvalid; __device__ __forceinline__ long operator()(int rl) const { return rl < nvalid ? base + rl : -1; } };

__device__ __forceinline__ void phase9(const Params& p, char* smem, int bid, int nb) {
    char* ws = p.ws;
    XcdSlab xs; xs.init(bid, nb);
    moe_tables(p, smem, xs);
    const int* off = (const int*)(smem + MOE_TAB); const int* tst = off + 256;
    const int* cnt = (const int*)(ws + WS_CNT);
    const int nloc = xs.x >= 0 ? 32 : 256;
    const int ntile = tst[nloc];
    for (int t = xs.j; t < ntile * 2; t += xs.stride) {
        const int et = t >> 1, nt = t & 1;
        const int kl = moe_find(tst, nloc, et), e = xs.x >= 0 ? xs.x + 8 * kl : kl, m0 = (et - tst[kl]) * 256, ne = cnt[e * 32];
        const int tid = opaque_tid();
        RingRows al; RingF32B bl;
        {
            const int* tl = (const int*)(ws + WS_TOKL) + (long)e * LIST_CAP;
            int rows[2];
#pragma unroll
            for (int i = 0; i < 2; ++i) { const int r = m0 + (tid >> 2) + 128 * i; rows[i] = r < ne ? tl[r] : 0; }
            al.init_rows((const bf16_t*)(ws + WS_X2), 1024, rows);
        }
        {
            const int n = 4 * (tid & 63);
            const int col = 128 * nt + 32 * (n >> 6) + 8 * ((n >> 2) & 3) + 4 * ((n >> 5) & 1);
            const float* w = ((n >> 4) & 1) ? p.in[I_MW3] : p.in[I_MW1];
            bl.init(w + (long)e * 1024 * 256, 256, col, tid);
        }
        f32x4 acc[8][4];
        gemm_ring_f32b(smem, al, bl, 32, acc);
        RowMoe rm; rm.base = (long)off[e] + m0; rm.nvalid = ne - m0;
        epi_swiglu(acc, (bf16_t*)(ws + WS_H), 256, nt, rm);
    }
    const int m_lo = xs.m_lo(128), n_t = (xs.m_hi(128) - m_lo) * 4;
    for (int u = (xs.j + xs.stride - (ntile * 2) % xs.stride) % xs.stride; u < n_t; u += xs.stride) {
        const int mt = m_lo + (u >> 2), nt = u & 3;
        RingRows al, bl;
        al.init_contig((const bf16_t*)(ws + WS_HS), 256, mt * 256);
        bl.init_contig((const bf16_t*)(ws + WS_WS2), 256, nt * 256, true);
        f32x4 acc[8][4];
        gemm_ring(smem, al, bl, 8, acc);
        __syncthreads();
        epi_store_bf16(acc, (bf16_t*)(ws + WS_SH), 1024, mt * 256, nt * 256);
    }
}

__device__ __forceinline__ void phase10(const Params& p, char* smem, int bid, int nb) {
    char* ws = p.ws;
    XcdSlab xs; xs.init(bid, nb);
    moe_tables(p, smem, xs);
    const int* off = (const int*)(smem + MOE_TAB); const int* tst = off + 256;
    const int* cnt = (const int*)(ws + WS_CNT);
    const int nloc = xs.x >= 0 ? 32 : 256;
    const int ntile = tst[nloc];
    for (int t = xs.j; t < ntile * 4; t += xs.stride) {
        const int et = t >> 2, nt = t & 3;
        const int kl = moe_find(tst, nloc, et), e = xs.x >= 0 ? xs.x + 8 * kl : kl, m0 = (et - tst[kl]) * 256, ne = cnt[e * 32];
        const int tid = opaque_tid();
        RingRows al; RingF32B bl;
        al.init_contig((const bf16_t*)(ws + WS_H), 256, off[e] + m0);
        bl.init(p.in[I_MW2] + (long)e * 256 * 1024, 1024, nt * 256 + bperm(4 * (tid & 63)), tid);
        f32x4 acc[8][4];
        gemm_ring_f32b(smem, al, bl, 8, acc);
        {
            const int tid2 = opaque_tid();
            const int lane = tid2 & 63, wid = tid2 >> 6;
            const int wr = wid >> 2, wc = wid & 3, fr = lane & 15, fq = lane >> 4;
            const float* wl = (const float*)(ws + WS_WL) + (long)e * LIST_CAP + m0;
            bf16_t* Y = (bf16_t*)(ws + WS_Y) + ((long)off[e] + m0) * 1024 + nt * 256 + wc * 64 + fq * 8;
#pragma unroll
            for (int mi = 0; mi < 8; ++mi) {
                const int rl = wr * 128 + mi * 16 + fr;
                if (m0 + rl < ne) {
                    const float w = wl[rl];
#pragma unroll
                    for (int q = 0; q < 2; ++q) {
                        u32x4 v; v.x = pk_bf16(acc[mi][2 * q][0] * w, acc[mi][2 * q][1] * w); v.y = pk_bf16(acc[mi][2 * q][2] * w, acc[mi][2 * q][3] * w);
                        v.z = pk_bf16(acc[mi][2 * q + 1][0] * w, acc[mi][2 * q + 1][1] * w); v.w = pk_bf16(acc[mi][2 * q + 1][2] * w, acc[mi][2 * q + 1][3] * w);
                        *(u32x4*)(Y + (long)rl * 1024 + q * 32) = v;
                    }
                }
            }
        }
    }
}

__device__ __forceinline__ void phase11(const Params& p, char* smem, int bid, int nb) {
    char* ws = p.ws;
    XcdSlab xs; xs.init(bid, nb);
    moe_tables(p, smem, xs);
    const int* off = (const int*)(smem + MOE_TAB);
    const int tid = opaque_tid(), lane = tid & 63, wid = tid >> 6;
    const float* r2 = (const float*)(ws + WS_R2);
    const float* st2 = (const float*)(ws + WS_ST2);
    const bf16_t* SH = (const bf16_t*)(ws + WS_SH);
    const bf16_t* Y = (const bf16_t*)(ws + WS_Y);
    const int* sele = (const int*)(ws + WS_SELE); const int* selp = (const int*)(ws + WS_SELP);
    for (int t = bid * 8 + wid; t < T_TOK; t += nb * 8) {
        const f32x4 p0 = *(const f32x4*)(st2 + (long)t * 8), p1 = *(const f32x4*)(st2 + (long)t * 8 + 4);
        const float q1 = (p0[0] + p0[2]) + (p1[0] + p1[2]), q2 = (p0[1] + p0[3]) + (p1[1] + p1[3]);
        const float mean2 = q1 * (1.0f / 1024.0f);
        const float rstd2 = rsqrtf(fmaxf(q2 * (1.0f / 1024.0f) - mean2 * mean2, 0.f) + LN_EPS);
        int yrow[8];
#pragma unroll
        for (int k = 0; k < 8; ++k) yrow[k] = off[sele[(long)t * 8 + k]] + selp[(long)t * 8 + k];
        float v[16];
#pragma unroll
        for (int hseg = 0; hseg < 2; ++hseg) {
            const int col = hseg * 512 + lane * 8;
            const f32x4 a0 = *(const f32x4*)(r2 + (long)t * 1024 + col), a1 = *(const f32x4*)(r2 + (long)t * 1024 + col + 4);
            const f32x4 g0 = *(const f32x4*)(p.in[I_LN2G] + col), g1 = *(const f32x4*)(p.in[I_LN2G] + col + 4);
            const f32x4 b0 = *(const f32x4*)(p.in[I_LN2B] + col), b1 = *(const f32x4*)(p.in[I_LN2B] + col + 4);
            const f32x4 x0 = ((a0 - mean2) * rstd2 * g0 + b0) * ALPHA, x1 = ((a1 - mean2) * rstd2 * g1 + b1) * ALPHA;
            float* vv = v + hseg * 8;
            vv[0] = x0[0]; vv[1] = x0[1]; vv[2] = x0[2]; vv[3] = x0[3]; vv[4] = x1[0]; vv[5] = x1[1]; vv[6] = x1[2]; vv[7] = x1[3];
            const u32x4 s = *(const u32x4*)(SH + (long)t * 1024 + col);
            vv[0] += bf_lo(s.x); vv[1] += bf_hi(s.x); vv[2] += bf_lo(s.y); vv[3] += bf_hi(s.y); vv[4] += bf_lo(s.z); vv[5] += bf_hi(s.z); vv[6] += bf_lo(s.w); vv[7] += bf_hi(s.w);
#pragma unroll
            for (int k = 0; k < 8; ++k) {
                const u32x4 y = *(const u32x4*)(Y + (long)yrow[k] * 1024 + col);
                vv[0] += bf_lo(y.x); vv[1] += bf_hi(y.x); vv[2] += bf_lo(y.y); vv[3] += bf_hi(y.y); vv[4] += bf_lo(y.z); vv[5] += bf_hi(y.z); vv[6] += bf_lo(y.w); vv[7] += bf_hi(y.w);
            }
        }
        float s1 = 0.f;
#pragma unroll
        for (int i = 0; i < 16; ++i) s1 += v[i];
#pragma unroll
        for (int o = 32; o >= 1; o >>= 1) s1 += __shfl_xor(s1, o);
        const float mean = s1 * (1.0f / 1024.0f);
        float s2 = 0.f;
#pragma unroll
        for (int i = 0; i < 16; ++i) { const float d = v[i] - mean; s2 += d * d; }
#pragma unroll
        for (int o = 32; o >= 1; o >>= 1) s2 += __shfl_xor(s2, o);
        const float rstd = rsqrtf(s2 * (1.0f / 1024.0f) + LN_EPS);
#pragma unroll
        for (int hseg = 0; hseg < 2; ++hseg) {
            const int col = hseg * 512 + lane * 8;
            const f32x4 g0 = *(const f32x4*)(p.in[I_LN3G] + col), g1 = *(const f32x4*)(p.in[I_LN3G] + col + 4);
            const f32x4 b0 = *(const f32x4*)(p.in[I_LN3B] + col), b1 = *(const f32x4*)(p.in[I_LN3B] + col + 4);
            const float* vv = v + hseg * 8;
            f32x4 o0, o1;
#pragma unroll
            for (int e = 0; e < 4; ++e) { o0[e] = (vv[e] - mean) * rstd * g0[e] + b0[e]; o1[e] = (vv[4 + e] - mean) * rstd * g1[e] + b1[e]; }
            *(f32x4*)(p.out + (long)t * 1024 + col) = o0; *(f32x4*)(p.out + (long)t * 1024 + col + 4) = o1;
        }
    }
}

#if MEGA
#define XB_TMO      128
#define XB_XCNT(j)  (256  + 64 * (j))
#define XB_XSUB(j)  (1280 + 64 * (j))
#define XB_XGEN(j)  (2304 + 64 * (j))
#define XB_TOP      3328
#define XB_TOPGEN   3392
#define XCD_BAR_WORDS 3456
#define XB_SPIN_CAP (1u << 22)
#define LAS __attribute__((address_space(3)))
__device__ __forceinline__ unsigned xb_ld(unsigned* p)              { return __hip_atomic_load(p, __ATOMIC_RELAXED, __HIP_MEMORY_SCOPE_AGENT); }
__device__ __forceinline__ unsigned xb_add(unsigned* p, unsigned v) { return __hip_atomic_fetch_add(p, v, __ATOMIC_RELAXED, __HIP_MEMORY_SCOPE_AGENT); }
__device__ __forceinline__ unsigned xb_xcc_id() { return (unsigned)__builtin_amdgcn_s_getreg((3 << 11) | 20) & 0xFu; }
#define XB_SPIN(cond, bar) do { unsigned _sp = 0; while (cond) { __builtin_amdgcn_s_sleep(1); \
    if ((++_sp & 255u) == 0u) { if (xb_ld(&(bar)[XB_TMO])) break; if (_sp > XB_SPIN_CAP) { atomicAdd(&(bar)[XB_TMO], 1u); break; } } } } while (0)
struct XcdBarrier { unsigned* bar; unsigned x; volatile LAS unsigned* st; };
__device__ __forceinline__ XcdBarrier xcd_barrier_post(unsigned* bar, volatile LAS unsigned* st) {
    XcdBarrier b; b.bar = bar; b.x = xb_xcc_id(); b.st = st;
    if (threadIdx.x == 0) (void)xb_add(&bar[XB_XCNT(b.x)], 1u);
    return b;
}
__device__ __forceinline__ void xcd_barrier_complete(unsigned* bar, unsigned x, unsigned& nloc, unsigned& nx) {
    const unsigned G = gridDim.x * gridDim.y * gridDim.z;
    unsigned sum, cnt, mine, sp = 0u;
    for (;;) {
        sum = 0u; cnt = 0u; mine = 0u;
#pragma unroll
        for (unsigned j = 0; j < 16; ++j) { const unsigned c = xb_ld(&bar[XB_XCNT(j)]); sum += c; cnt += (c > 0u) ? 1u : 0u; mine = (j == x) ? c : mine; }
        if (sum == G) break;
        __builtin_amdgcn_s_sleep(1);
        if ((++sp & 255u) == 0u) { if (xb_ld(&bar[XB_TMO])) break; if (sp > XB_SPIN_CAP) { atomicAdd(&bar[XB_TMO], 1u); break; } }
    }
    nloc = mine > 0u ? mine : 1u; nx = cnt > 0u ? cnt : 1u;
}
__device__ __forceinline__ void xcd_barrier(const XcdBarrier& b) {
    asm volatile("s_waitcnt vmcnt(0)" ::: "memory");
    __syncthreads();
    if (threadIdx.x == 0) {
        unsigned* bar = b.bar;
        __builtin_amdgcn_s_waitcnt(0);
        unsigned nloc = b.st[0], nx = b.st[1];
        if (nloc == 0u) { xcd_barrier_complete(bar, b.x, nloc, nx); b.st[0] = nloc; b.st[1] = nx; }
        const unsigned old = xb_add(&bar[XB_XSUB(b.x)], 1u);
        const unsigned gen = old / nloc;
        if (old + 1u == (gen + 1u) * nloc) {
            __builtin_amdgcn_fence(__ATOMIC_RELEASE, "agent");
            asm volatile("s_waitcnt vmcnt(0)" ::: "memory");
            const unsigned og = xb_add(&bar[XB_TOP], 1u);
            const unsigned tg = og / nx;
            if (og + 1u == (tg + 1u) * nx) xb_add(&bar[XB_TOPGEN], 1u);
            else XB_SPIN(xb_ld(&bar[XB_TOPGEN]) == tg, bar);
            __builtin_amdgcn_fence(__ATOMIC_ACQUIRE, "agent");
            xb_add(&bar[XB_XGEN(b.x)], 1u);
            asm volatile("s_waitcnt vmcnt(0)" ::: "memory");
        } else {
            XB_SPIN(xb_ld(&bar[XB_XGEN(b.x)]) == gen, bar);
            __builtin_amdgcn_fence(__ATOMIC_ACQUIRE, "agent");
            asm volatile("s_waitcnt vmcnt(0)" ::: "memory");
        }
    }
    __syncthreads();
}
__global__ void __launch_bounds__(NTHR) fwd_mega(Params p) {
    extern __shared__ __attribute__((aligned(16))) char smem[];
    cg::grid_group grid = cg::this_grid();
    const int bid = blockIdx.x, nb = gridDim.x;
    volatile LAS unsigned* xst = (volatile LAS unsigned*)(smem + LDS_BYTES - 16);
    if (threadIdx.x < 4) xst[threadIdx.x] = 0u;
    __syncthreads();
    const XcdBarrier xb = xcd_barrier_post((unsigned*)(p.ws + WS_BAR), xst);
#define GSYNC() xcd_barrier(xb)
#ifndef PROBE_REPEAT
#define PROBE_REPEAT 0
#endif
#define REP(n, call) if (PROBE_REPEAT & (1 << n)) { call; GSYNC(); }
    if (PROBE_REPEAT & 1) { phase0(p, smem, bid, nb); GSYNC(); }
#ifdef PROBE_XCC
    {
        unsigned* rec = (unsigned*)(p.ws + WS_A + 432 * MB);
        if (threadIdx.x == 0) rec[bid] = xb_xcc_id();
        grid.sync();
        int mism = 0, distinct = 0;
        for (int b = 0; b < nb; ++b) { if (rec[b] != rec[b & 7]) ++mism; }
        for (int a = 0; a < 8; ++a) { bool dup = false; for (int b2 = 0; b2 < a; ++b2) dup = dup || (rec[a] == rec[b2]); if (!dup) ++distinct; }
        const float v = sqrtf((float)(PROBE_XCC == 1 ? mism : distinct) + 1.0f);
        for (long i = (long)bid * NTHR + threadIdx.x; i < (long)T_TOK * 1024; i += (long)nb * NTHR) p.out[i] = v;
        return;
    }
#endif
    phase0(p, smem, bid, nb);  grid.sync();
    REP(1, phase1<1>(p, smem, bid, nb))
    phase1(p, smem, bid, nb);  GSYNC();
    REP(2, phase2(p, smem, bid, nb))
    phase2(p, smem, bid, nb);  GSYNC();
#ifndef PROBE_P3PARTS
#define PROBE_P3PARTS 3
#endif
#ifndef PROBE_NSAV
#define PROBE_NSAV 7
#endif
    REP(3, (phase3<PROBE_P3PARTS, PROBE_NSAV>(p, smem, bid, nb, 1)))
    phase3(p, smem, bid, nb);  GSYNC();
    REP(4, phase4(p, smem, bid, nb))
#ifdef PROBE_X
    phase_probe<PROBE_X>(p, smem, bid, nb); GSYNC();
#endif
    phase4(p, smem, bid, nb);  GSYNC();
    REP(5, phase5(p, smem, bid, nb))
    phase5(p, smem, bid, nb);  GSYNC();
    REP(6, phase6(p, smem, bid, nb))
    phase6(p, smem, bid, nb);  GSYNC();
    REP(7, phase7(p, smem, bid, nb))
    phase7(p, smem, bid, nb);  GSYNC();
    REP(8, phase8(p, smem, bid, nb, 1))
    phase8(p, smem, bid, nb);  GSYNC();
    REP(9, phase9(p, smem, bid, nb))
    phase9(p, smem, bid, nb);  GSYNC();
    REP(10, phase10(p, smem, bid, nb))
    phase10(p, smem, bid, nb); GSYNC();
    REP(11, phase11(p, smem, bid, nb))
    phase11(p, smem, bid, nb);
}
#else
#define PHASE_KERNEL(n) __global__ void __launch_bounds__(NTHR) fwd_phase##n(Params p) { extern __shared__ __attribute__((aligned(16))) char smem[]; phase##n(p, smem, blockIdx.x, gridDim.x); }
PHASE_KERNEL(0) PHASE_KERNEL(1) PHASE_KERNEL(2) PHASE_KERNEL(3) PHASE_KERNEL(4) PHASE_KERNEL(5)
PHASE_KERNEL(6) PHASE_KERNEL(7) PHASE_KERNEL(8) PHASE_KERNEL(9) PHASE_KERNEL(10) PHASE_KERNEL(11)
typedef void (*phase_fn)(Params);
#endif

extern "C" void kernel_launch(void* const* d_in, const int* in_sizes, int n_in, void* d_out, int out_size, void* d_ws, size_t ws_size, hipStream_t stream) {
    Params p{};
    for (int i = 0; i < 32; ++i) p.in[i] = (const float*)d_in[i];
    p.out = (float*)d_out;
    p.ws = (char*)d_ws;
    if (n_in != 32 || ws_size < WS_END) { fprintf(stderr, "kernel_launch: unexpected inputs (n_in %d) or workspace too small (%zu < %zu)\n", n_in, ws_size, (size_t)WS_END); return; }
#if MEGA
    static int grid = 0;
    if (!grid) {
        int dev = 0, cus = 0, per_cu = 0;
        (void)hipGetDevice(&dev);
        (void)hipDeviceGetAttribute(&cus, hipDeviceAttributeMultiprocessorCount, dev);
        (void)hipFuncSetAttribute((const void*)fwd_mega, hipFuncAttributeMaxDynamicSharedMemorySize, LDS_BYTES);
        (void)hipOccupancyMaxActiveBlocksPerMultiprocessor(&per_cu, (const void*)fwd_mega, NTHR, LDS_BYTES);
        if (per_cu < 1) { fprintf(stderr, "kernel_launch: occupancy query says %d blocks/CU\n", per_cu); per_cu = 1; }
        grid = cus;
    }
    (void)hipMemsetAsync((char*)d_ws + WS_BAR, 0, 16384, stream);
    void* args[] = {&p};
    hipError_t e = hipLaunchCooperativeKernel((const void*)fwd_mega, dim3(grid), dim3(NTHR), args, LDS_BYTES, stream);
    if (e != hipSuccess) fprintf(stderr, "cooperative launch failed: %s (grid %d)\n", hipGetErrorString(e), grid);
#else
    static const phase_fn fns[12] = {fwd_phase0, fwd_phase1, fwd_phase2, fwd_phase3, fwd_phase4, fwd_phase5, fwd_phase6, fwd_phase7, fwd_phase8, fwd_phase9, fwd_phase10, fwd_phase11};
    static bool attr = false;
    if (!attr) { for (int i = 0; i < 12; ++i) (void)hipFuncSetAttribute((const void*)fns[i], hipFuncAttributeMaxDynamicSharedMemorySize, LDS_BYTES); attr = true; }
    for (int i = 0; i < 12; ++i) hipLaunchKernelGGL(fns[i], dim3(256), dim3(NTHR), LDS_BYTES, stream, p);
#endif
}
```

```cpp
#include <hip/hip_runtime.h>
#include <hip/hip_cooperative_groups.h>
#include <stdint.h>
#include <stdio.h>
namespace cg = cooperative_groups;

#ifndef MEGA
#define MEGA 1
#endif

typedef unsigned short bf16_t;
typedef short bf16x8 __attribute__((ext_vector_type(8)));
typedef short s16x4 __attribute__((ext_vector_type(4)));
typedef float f32x4 __attribute__((ext_vector_type(4)));
typedef float f32x2 __attribute__((ext_vector_type(2)));
typedef unsigned u32x4 __attribute__((ext_vector_type(4)));
typedef unsigned u32x2 __attribute__((ext_vector_type(2)));
typedef __bf16 bf16x2_t __attribute__((ext_vector_type(2)));

constexpr int T_TOK = 32768, DM = 1024, NB = 16, SEQ = 2048;
constexpr int PW = 3328;
constexpr int PC_Q = 0, PC_KC = 512, PC_VC = 640, PC_KS = 768, PC_VS = 896, PC_KW = 1024, PC_VW = 1152;
constexpr int PC_MQ = 1280, PC_MK = 1792, PC_MV = 2304, PC_MO = 2816;
constexpr float ALPHA = 1.189207115002721f;
constexpr float LN_EPS = 1e-5f;
constexpr int NTHR = 512;
constexpr int LDS_BYTES = 160 * 1024;
constexpr int NEXP = 256, TOPK = 8;
constexpr int LIST_CAP = 32768;

constexpr size_t al256(size_t x) { return (x + 255) & ~(size_t)255; }
constexpr size_t WS_WIN = 0;
constexpr size_t WS_WOUT = WS_WIN + al256((size_t)3360 * 1024 * 2);
constexpr size_t WS_WQ = WS_WOUT + (size_t)1024 * 1024 * 2;
constexpr size_t WS_WKV = WS_WQ + (size_t)1024 * 1024 * 2;
constexpr size_t WS_WO = WS_WKV + (size_t)2048 * 1024 * 2;
constexpr size_t WS_WR = WS_WO + (size_t)1024 * 1024 * 2;
constexpr size_t WS_WS13 = WS_WR + (size_t)256 * 1024 * 2;
constexpr size_t WS_WS2 = WS_WS13 + (size_t)512 * 1024 * 2;
constexpr size_t WS_CK1 = WS_WS2 + (size_t)1024 * 256 * 2;
constexpr size_t WS_CK2 = WS_CK1 + (size_t)64 * 2048 * 2;
constexpr size_t WS_CV1 = WS_CK2 + (size_t)64 * 64 * 2;
constexpr size_t WS_CV2 = WS_CV1 + (size_t)64 * 2048 * 2;
constexpr size_t MB = 1024 * 1024;
constexpr size_t WS_LNP = al256(WS_CV2 + (size_t)64 * 64 * 2);
constexpr size_t WS_LNF = WS_LNP + (size_t)2 * 16 * 1792 * 4;
constexpr size_t WS_A = al256(WS_LNF + (size_t)2 * 1792 * 4 + 65536);
constexpr size_t WS_P = WS_A;
constexpr size_t WS_R1 = WS_A;
constexpr size_t WS_XQ = WS_A + 128 * MB;
constexpr size_t WS_XO = WS_A + 192 * MB;
constexpr size_t WS_XB = WS_A + 208 * MB;
constexpr size_t WS_MEMB = WS_A + 272 * MB;
constexpr size_t WS_PSM = WS_A + 280 * MB;
constexpr size_t WS_KCMP = WS_A + 284 * MB;
constexpr size_t WS_VCMP = WS_KCMP + (size_t)16 * 2 * 128 * 64 * 2;
constexpr size_t WS_QK = WS_A + 285 * MB;
constexpr size_t WS_MIX = WS_A + 349 * MB;
constexpr size_t WS_KVX = WS_A + 413 * MB;
constexpr size_t WS_X2F8 = WS_A + 256 * MB;
constexpr size_t WS_X2 = WS_A + 256 * MB;
constexpr size_t WS_HS = WS_A + 320 * MB;
constexpr size_t WS_R1B = WS_A;
constexpr size_t WS_RSC = WS_A;
constexpr size_t WS_Y = WS_A;
constexpr size_t WS_B = WS_A + al256((size_t)(T_TOK * 8 + 256) * 1024 * 2);
constexpr size_t WS_R2B = WS_B;
constexpr size_t WS_R2 = WS_B;
constexpr size_t WS_ST1 = WS_R2 + (size_t)T_TOK * 1024 * 4;
constexpr size_t WS_ST2 = WS_ST1 + (size_t)T_TOK * 8 * 4;
constexpr size_t WS_SH = WS_ST2 + (size_t)T_TOK * 8 * 4;
constexpr size_t WS_SELE = WS_SH + (size_t)T_TOK * 1024 * 2;
constexpr size_t WS_SELP = WS_SELE + (size_t)T_TOK * 8 * 4;
constexpr size_t WS_SELW = WS_SELP + (size_t)T_TOK * 8 * 4;
constexpr size_t WS_CNT = WS_SELW + (size_t)T_TOK * 8 * 4;
constexpr size_t WS_TOKL = WS_CNT + 98304;
constexpr size_t WS_WL = WS_TOKL + (size_t)NEXP * LIST_CAP * 4;
constexpr size_t WS_H = WS_WL + (size_t)NEXP * LIST_CAP * 4;
constexpr size_t WS_HF8 = WS_H;
constexpr size_t WS_W2F8 = WS_H + (size_t)(T_TOK * 8 + 256) * 256;
constexpr size_t WS_BAR = WS_W2F8 + (size_t)256 * 1024 * 256;
constexpr size_t WS_END = WS_BAR + 16384;
static_assert((size_t)T_TOK * PW * 2 <= 208 * MB, "P region");
static_assert(WS_END <= (size_t)1024 * MB, "workspace must fit 1 GiB");

struct Params {
    const float* in[32];
    float* out;
    char* ws;
};

__device__ __forceinline__ unsigned pk_bf16(float lo, float hi) {
    f32x2 v = {lo, hi};
    bf16x2_t r = __builtin_convertvector(v, bf16x2_t);
    return __builtin_bit_cast(unsigned, r);
}
__device__ __forceinline__ float bf_lo(unsigned u) { return __uint_as_float(u << 16); }
__device__ __forceinline__ float bf_hi(unsigned u) { return __uint_as_float(u & 0xffff0000u); }
__device__ __forceinline__ float bf2f(bf16_t h) { return __uint_as_float(((unsigned)h) << 16); }
__device__ __forceinline__ float sigmoidf_(float x) { return 1.0f / (1.0f + __expf(-x)); }
__device__ __forceinline__ float siluf_(float x) { return x / (1.0f + __expf(-x)); }
__device__ __forceinline__ f32x4 mfma16(bf16x8 a, bf16x8 b, f32x4 c) { return __builtin_amdgcn_mfma_f32_16x16x32_bf16(a, b, c, 0, 0, 0); }
__device__ __forceinline__ bf16x8 as_bf16x8(u32x4 v) { return __builtin_bit_cast(bf16x8, v); }

__device__ __forceinline__ int opaque_tid() { int t = threadIdx.x; asm volatile("" : "+v"(t)); return t; }

__device__ __forceinline__ int tile_off(int row, int chunk) { return row * 128 + ((chunk ^ (row & 7)) << 4); }

__device__ __forceinline__ int bperm(int rho) { return (rho & ~31) + 8 * ((rho >> 2) & 3) + 4 * ((rho >> 4) & 1) + (rho & 3); }

typedef __attribute__((address_space(3))) unsigned lds_u32;
typedef __attribute__((address_space(1))) const unsigned glb_u32;

struct LoadBf16Rows {
    const bf16_t* base;
    unsigned off[4];
    int ldst;
    struct Regs { int dummy; };
    __device__ __forceinline__ void init_contig(const bf16_t* b, int ld, int row0) {
        const int tid_ = opaque_tid();
        const int r8 = tid_ >> 3, kc = (tid_ & 7) ^ (r8 & 7);
        ldst = tid_ * 16;
        base = b + (long)row0 * ld;
#pragma unroll
        for (int i = 0; i < 4; ++i) off[i] = (unsigned)((r8 + 64 * i) * ld + kc * 8);
    }
    __device__ __forceinline__ void init_rows(const bf16_t* b, int ld, const int (&rows)[4]) {
        const int tid_ = opaque_tid();
        const int r8 = tid_ >> 3, kc = (tid_ & 7) ^ (r8 & 7);
        ldst = tid_ * 16;
        base = b;
#pragma unroll
        for (int i = 0; i < 4; ++i) off[i] = (unsigned)rows[i] * (unsigned)ld + (unsigned)(kc * 8);
    }
    __device__ __forceinline__ void issue(Regs&, char* s, int kt) const {
#pragma unroll
        for (int i = 0; i < 4; ++i)
            __builtin_amdgcn_global_load_lds((glb_u32*)(base + (size_t)(off[i] + (unsigned)(kt * 64))), (lds_u32*)(s + i * 8192 + ldst), 16, 0, 0);
    }
    __device__ __forceinline__ void commit(const Regs&, char*, int) const {}
};

struct LoadF32KN {
    const float* p;
    int ldn;
    int n, kh;
    struct Regs { float v[32]; };
    __device__ __forceinline__ void issue(Regs& r, char*, int kt) const {
        const float* q = p + (long)kt * 64 * ldn;
#pragma unroll
        for (int j = 0; j < 32; ++j) r.v[j] = q[(long)j * ldn];
    }
    __device__ __forceinline__ void commit(const Regs& r, char* s, int kt) const {
#pragma unroll
        for (int q = 0; q < 4; ++q) {
            u32x4 w;
            w.x = pk_bf16(r.v[8 * q + 0], r.v[8 * q + 1]); w.y = pk_bf16(r.v[8 * q + 2], r.v[8 * q + 3]);
            w.z = pk_bf16(r.v[8 * q + 4], r.v[8 * q + 5]); w.w = pk_bf16(r.v[8 * q + 6], r.v[8 * q + 7]);
            *(u32x4*)(s + tile_off(n, kh * 4 + q)) = w;
        }
    }
};

struct LoadLN {
    LoadBf16Rows raw;
    bf16_t* xbase;
    const float* st;
    const float* gb;
    typedef LoadBf16Rows::Regs Regs;
    __device__ __forceinline__ void issue(Regs& r, char* s, int kt) const { raw.issue(r, s, kt); }
    __device__ __forceinline__ void commit(const Regs&, char* s, int kt) const {
        asm volatile("s_waitcnt vmcnt(0)" ::: "memory");
        const int tid_ = opaque_tid();
        const int r8 = tid_ >> 3, kc = (tid_ & 7) ^ (r8 & 7);
        const f32x4 g0 = *(const f32x4*)(gb + kt * 64 + kc * 8), g1 = *(const f32x4*)(gb + kt * 64 + kc * 8 + 4);
        const f32x4 b0 = *(const f32x4*)(gb + 1024 + kt * 64 + kc * 8), b1 = *(const f32x4*)(gb + 1024 + kt * 64 + kc * 8 + 4);
#pragma unroll
        for (int i = 0; i < 4; ++i) {
            const int row = r8 + 64 * i;
            u32x4* cp = (u32x4*)(s + i * 8192 + tid_ * 16);
            const u32x4 v = *cp;
            const float mean = st[row * 2], rstd = st[row * 2 + 1];
            const f32x4 x0 = (f32x4){bf_lo(v.x), bf_hi(v.x), bf_lo(v.y), bf_hi(v.y)};
            const f32x4 x1 = (f32x4){bf_lo(v.z), bf_hi(v.z), bf_lo(v.w), bf_hi(v.w)};
            const f32x4 y0 = (x0 - mean) * rstd * g0 + b0, y1 = (x1 - mean) * rstd * g1 + b1;
            u32x4 w; w.x = pk_bf16(y0[0], y0[1]); w.y = pk_bf16(y0[2], y0[3]); w.z = pk_bf16(y1[0], y1[1]); w.w = pk_bf16(y1[2], y1[3]);
            *cp = w;
            if (xbase) *(u32x4*)(xbase + (size_t)(row * 1024 + kc * 8 + kt * 64)) = w;
        }
    }
};

constexpr int GEMM_LDS = 131072;
template <class AL, class BL>
__device__ __forceinline__ void gemm_mainloop(char* smem, const AL& al, const BL& bl, int nk, f32x4 (&acc)[8][4]) {
    const int tid_ = opaque_tid();
    const int lane = tid_ & 63, wid = tid_ >> 6;
    const int wr = wid >> 2, wc = wid & 3, fr = lane & 15, fq = lane >> 4;
#pragma unroll
    for (int mi = 0; mi < 8; ++mi)
#pragma unroll
        for (int ni = 0; ni < 4; ++ni) acc[mi][ni] = (f32x4){0.f, 0.f, 0.f, 0.f};
    typename AL::Regs ra; typename BL::Regs rb;
    al.issue(ra, smem, 0); bl.issue(rb, smem + 32768, 0);
    al.commit(ra, smem, 0); bl.commit(rb, smem + 32768, 0);
    __syncthreads();
    for (int kt = 0; kt < nk; ++kt) {
        char* sA = smem + (kt & 1) * 65536; char* sB = sA + 32768;
        char* nA = smem + ((kt + 1) & 1) * 65536; char* nB = nA + 32768;
        if (kt + 1 < nk) { al.issue(ra, nA, kt + 1); bl.issue(rb, nB, kt + 1); }
#pragma unroll
        for (int kk = 0; kk < 2; ++kk) {
            bf16x8 bfr[4];
#pragma unroll
            for (int ni = 0; ni < 4; ++ni) bfr[ni] = *(const bf16x8*)(sB + tile_off(wc * 64 + ni * 16 + fr, kk * 4 + fq));
#pragma unroll
            for (int mi = 0; mi < 8; ++mi) {
                const bf16x8 af = *(const bf16x8*)(sA + tile_off(wr * 128 + mi * 16 + fr, kk * 4 + fq));
#pragma unroll
                for (int ni = 0; ni < 4; ++ni) acc[mi][ni] = mfma16(bfr[ni], af, acc[mi][ni]);
            }
        }
        if (kt + 1 < nk) { al.commit(ra, nA, kt + 1); bl.commit(rb, nB, kt + 1); }
        __syncthreads();
    }
}

__device__ __forceinline__ int swz4(int row) { return (0x78 >> (((row >> 2) & 3) * 2)) & 3; }
struct RingRows {
    const bf16_t* base; unsigned off[2]; int ldst;
    __device__ __forceinline__ void init_contig(const bf16_t* b, int ld, int row0, bool perm = false) {
        const int tid_ = opaque_tid(); const int r = tid_ >> 2, kc = (tid_ & 3) ^ swz4(r);
        ldst = tid_ * 16; base = b + (long)row0 * ld;
#pragma unroll
        for (int i = 0; i < 2; ++i) { const int rr = r + 128 * i; off[i] = (unsigned)((perm ? bperm(rr) : rr) * ld + kc * 8); }
    }
    __device__ __forceinline__ void init_rows(const bf16_t* b, int ld, const int (&rows)[2]) {
        const int tid_ = opaque_tid(); const int r = tid_ >> 2, kc = (tid_ & 3) ^ swz4(r);
        ldst = tid_ * 16; base = b;
#pragma unroll
        for (int i = 0; i < 2; ++i) off[i] = (unsigned)rows[i] * (unsigned)ld + (unsigned)(kc * 8);
    }
    __device__ __forceinline__ void issue(char* s, int kt) const {
#pragma unroll
        for (int i = 0; i < 2; ++i)
            __builtin_amdgcn_global_load_lds((glb_u32*)(base + (size_t)(off[i] + (unsigned)(kt * 32))), (lds_u32*)(s + i * 8192 + ldst), 16, 0, 0);
    }
    __device__ __forceinline__ void commit(char*, int) const {}
};
struct RingLN {
    RingRows raw; bf16_t* xbase; const float* st; const float* gb;
    __device__ __forceinline__ void issue(char* s, int kt) const { raw.issue(s, kt); }
    __device__ __forceinline__ void commit(char* s, int kt) const {
        const int tid_ = opaque_tid(); const int r = tid_ >> 2, kc = (tid_ & 3) ^ swz4(r);
        const f32x4 g0 = *(const f32x4*)(gb + kt * 32 + kc * 8), g1 = *(const f32x4*)(gb + kt * 32 + kc * 8 + 4);
        const f32x4 b0 = *(const f32x4*)(gb + 1024 + kt * 32 + kc * 8), b1 = *(const f32x4*)(gb + 1024 + kt * 32 + kc * 8 + 4);
#pragma unroll
        for (int i = 0; i < 2; ++i) {
            const int row = r + 128 * i;
            u32x4* cp = (u32x4*)(s + i * 8192 + tid_ * 16);
            const u32x4 v = *cp;
            const float mean = st[row * 2], rstd = st[row * 2 + 1];
            const f32x4 x0 = (f32x4){bf_lo(v.x), bf_hi(v.x), bf_lo(v.y), bf_hi(v.y)};
            const f32x4 x1 = (f32x4){bf_lo(v.z), bf_hi(v.z), bf_lo(v.w), bf_hi(v.w)};
            const f32x4 y0 = (x0 - mean) * rstd * g0 + b0, y1 = (x1 - mean) * rstd * g1 + b1;
            u32x4 w; w.x = pk_bf16(y0[0], y0[1]); w.y = pk_bf16(y0[2], y0[3]); w.z = pk_bf16(y1[0], y1[1]); w.w = pk_bf16(y1[2], y1[3]);
            *cp = w;
            if (xbase) *(u32x4*)(xbase + (size_t)(row * 1024 + kc * 8 + kt * 32)) = w;
        }
    }
};
#define RING_WAIT(n) asm volatile("s_waitcnt vmcnt(" #n ")" ::: "memory")
#define RING_BAR() do { __builtin_amdgcn_sched_barrier(0); asm volatile("s_waitcnt lgkmcnt(0)" ::: "memory"); __builtin_amdgcn_s_barrier(); asm volatile("" ::: "memory"); __builtin_amdgcn_sched_barrier(0); } while (0)
template <class AL, class BL, int XMODE = 0  >
__device__ __forceinline__ void gemm_ring(char* smem, const AL& al, const BL& bl, int nk  , f32x4 (&acc)[8][4]) {
    const int tid_ = opaque_tid();
    const int lane = tid_ & 63, wid = __builtin_amdgcn_readfirstlane(tid_ >> 6);
    const int wr = wid >> 2, wc = wid & 3, fr = lane & 15, fq = lane >> 4;
#pragma unroll
    for (int mi = 0; mi < 8; ++mi)
#pragma unroll
        for (int ni = 0; ni < 4; ++ni) acc[mi][ni] = (f32x4){0.f, 0.f, 0.f, 0.f};
    const int aoff = (wr * 128 + fr) * 64 + ((fq ^ swz4(fr)) << 4);
    const int boff = 16384 + (wc * 64 + fr) * 64 + ((fq ^ swz4(fr)) << 4);
    if (XMODE != 1) {
    al.issue(smem, 0); bl.issue(smem + 16384, 0);
    al.issue(smem + 32768, 1); bl.issue(smem + 32768 + 16384, 1);
    al.issue(smem + 65536, 2); bl.issue(smem + 65536 + 16384, 2);
    RING_WAIT(8);
    al.commit(smem, 0); bl.commit(smem + 16384, 0);
    }
    RING_BAR();
    if (wr == 1) RING_BAR();
    for (int kt = 0; kt < nk; ++kt) {
        const char* st = smem + (kt & 3) * 32768;
        if (XMODE != 1 && kt + 3 < nk) { char* s3 = smem + ((kt + 3) & 3) * 32768; al.issue(s3, kt + 3); bl.issue(s3 + 16384, kt + 3); }
        bf16x8 bfr[4], afr[8];
        if (XMODE != 2) {
#pragma unroll
        for (int ni = 0; ni < 4; ++ni) bfr[ni] = *(const bf16x8*)(st + boff + ni * 1024);
#pragma unroll
        for (int mi = 0; mi < 8; ++mi) afr[mi] = *(const bf16x8*)(st + aoff + mi * 1024);
        }
        if (XMODE != 1 && kt + 1 < nk) {
            if (kt + 3 < nk) RING_WAIT(8); else if (kt + 2 < nk) RING_WAIT(4); else RING_WAIT(0);
            char* s1 = smem + ((kt + 1) & 3) * 32768;
            al.commit(s1, kt + 1); bl.commit(s1 + 16384, kt + 1);
        }
        RING_BAR();
        if (XMODE != 2) {
        __builtin_amdgcn_s_setprio(1);
#pragma unroll
        for (int mi = 0; mi < 8; ++mi)
#pragma unroll
            for (int ni = 0; ni < 4; ++ni) acc[mi][ni] = mfma16(bfr[ni], afr[mi], acc[mi][ni]);
        __builtin_amdgcn_s_setprio(0);
        }
        RING_BAR();
    }
    if (wr == 0) RING_BAR();
}

constexpr int FB_PITCH = 1088, FB_STAGE = 16384 + 32 * FB_PITCH;
struct RingF32B {
    const float* p; int ldn; int ldst;
    __device__ __forceinline__ void init(const float* W, int ld, int srccol4, int tid_) { const int lane = tid_ & 63, wid = tid_ >> 6; p = W + (long)wid * ld + srccol4; ldn = ld; ldst = wid * FB_PITCH + lane * 16; }
    __device__ __forceinline__ void issue(char* sB, int kt) const {
#pragma unroll
        for (int i = 0; i < 4; ++i)
            __builtin_amdgcn_global_load_lds((glb_u32*)(p + (long)(kt * 32 + i * 8) * ldn), (lds_u32*)(sB + i * 8 * FB_PITCH + (i & 1) * 64 + ldst), 16, 0, 0);
    }
};
template <class AL>
__device__ __forceinline__ void gemm_ring_f32b(char* smem, const AL& al, const RingF32B& bl, int nk  , f32x4 (&acc)[8][4]) {
    const int tid_ = opaque_tid();
    const int lane = tid_ & 63, wid = __builtin_amdgcn_readfirstlane(tid_ >> 6);
    const int wr = wid >> 2, wc = wid & 3, fr = lane & 15, fq = lane >> 4;
#pragma unroll
    for (int mi = 0; mi < 8; ++mi)
#pragma unroll
        for (int ni = 0; ni < 4; ++ni) acc[mi][ni] = (f32x4){0.f, 0.f, 0.f, 0.f};
    const int aoff = (wr * 128 + fr) * 64 + ((fq ^ swz4(fr)) << 4);
    const int boff = 16384 + (8 * fq) * FB_PITCH + (fq & 1) * 64 + (wc * 64 + fr) * 4;
    al.issue(smem, 0); bl.issue(smem + 16384, 0);
    al.issue(smem + FB_STAGE, 1); bl.issue(smem + FB_STAGE + 16384, 1);
    RING_WAIT(6);
    RING_BAR();
    if (wr == 1) RING_BAR();
    int s0 = 0;
    for (int kt = 0; kt < nk; ++kt) {
        const char* st = smem + s0 * FB_STAGE;
        const int s1 = s0 == 2 ? 0 : s0 + 1, s2 = s1 == 2 ? 0 : s1 + 1;
        if (kt + 2 < nk) { char* sn = smem + s2 * FB_STAGE; al.issue(sn, kt + 2); bl.issue(sn + 16384, kt + 2); }
        bf16x8 bfr[4], afr[8];
#pragma unroll
        for (int ni = 0; ni < 4; ++ni) {
            float v[8];
#pragma unroll
            for (int j = 0; j < 8; ++j) v[j] = *(const float*)(st + boff + j * FB_PITCH + ni * 64);
            u32x4 w; w.x = pk_bf16(v[0], v[1]); w.y = pk_bf16(v[2], v[3]); w.z = pk_bf16(v[4], v[5]); w.w = pk_bf16(v[6], v[7]);
            bfr[ni] = as_bf16x8(w);
        }
#pragma unroll
        for (int mi = 0; mi < 8; ++mi) afr[mi] = *(const bf16x8*)(st + aoff + mi * 1024);
        if (kt + 1 < nk) { if (kt + 2 < nk) RING_WAIT(6); else RING_WAIT(0); }
        RING_BAR();
        __builtin_amdgcn_s_setprio(1);
#pragma unroll
        for (int mi = 0; mi < 8; ++mi)
#pragma unroll
            for (int ni = 0; ni < 4; ++ni) acc[mi][ni] = mfma16(bfr[ni], afr[mi], acc[mi][ni]);
        __builtin_amdgcn_s_setprio(0);
        RING_BAR();
        s0 = s1;
    }
    if (wr == 0) RING_BAR();
}

__device__ __forceinline__ unsigned pk4_fp8(float a, float b, float c, float d) {
    int r = __builtin_amdgcn_cvt_pk_fp8_f32(a, b, 0, false);
    r = __builtin_amdgcn_cvt_pk_fp8_f32(c, d, r, true);
    return (unsigned)r;
}
struct RingF8 {
    const unsigned char* base; unsigned off[2]; int ldst;
    __device__ __forceinline__ void init_contig(const unsigned char* b, int ldb, long row0, bool perm = false) {
        const int tid_ = opaque_tid(); const int r = tid_ >> 2, kc = (tid_ & 3) ^ ((r >> 2) & 3);
        ldst = tid_ * 16; base = b + row0 * ldb;
#pragma unroll
        for (int i = 0; i < 2; ++i) { const int rr = r + 128 * i; off[i] = (unsigned)((perm ? bperm(rr) : rr) * ldb + kc * 16); }
    }
    __device__ __forceinline__ void init_rows(const unsigned char* b, int ldb, const int (&rows)[2]) {
        const int tid_ = opaque_tid(); const int r = tid_ >> 2, kc = (tid_ & 3) ^ ((r >> 2) & 3);
        ldst = tid_ * 16; base = b;
#pragma unroll
        for (int i = 0; i < 2; ++i) off[i] = (unsigned)rows[i] * (unsigned)ldb + (unsigned)(kc * 16);
    }
    __device__ __forceinline__ void issue(char* s, int kt) const {
#pragma unroll
        for (int i = 0; i < 2; ++i)
            __builtin_amdgcn_global_load_lds((glb_u32*)(base + (size_t)(off[i] + (unsigned)(kt * 64))), (lds_u32*)(s + i * 8192 + ldst), 16, 0, 0);
    }
};
__device__ __forceinline__ void ring_f8_issue3(char* smem, const RingF8& al, const RingF8& bl) {
    al.issue(smem, 0); bl.issue(smem + 16384, 0);
    al.issue(smem + 32768, 1); bl.issue(smem + 32768 + 16384, 1);
    al.issue(smem + 65536, 2); bl.issue(smem + 65536 + 16384, 2);
}
__device__ __forceinline__ void gemm_ring_f8_main(char* smem, const RingF8& al, const RingF8& bl, int nk  , f32x4 (&acc)[8][4]) {
    const int tid_ = opaque_tid();
    const int lane = tid_ & 63, wid = __builtin_amdgcn_readfirstlane(tid_ >> 6);
    const int wr = wid >> 2, wc = wid & 3, fr = lane & 15, fq = lane >> 4;
#pragma unroll
    for (int mi = 0; mi < 8; ++mi)
#pragma unroll
        for (int ni = 0; ni < 4; ++ni) acc[mi][ni] = (f32x4){0.f, 0.f, 0.f, 0.f};
    const int g2 = ((fr >> 2) & 3) << 1;
    const int aoff0 = (wr * 128 + fr) * 64 + ((fq ^ g2) << 3), aoff1 = (wr * 128 + fr) * 64 + (((4 + fq) ^ g2) << 3);
    const int boff0 = 16384 + (wc * 64 + fr) * 64 + ((fq ^ g2) << 3), boff1 = 16384 + (wc * 64 + fr) * 64 + (((4 + fq) ^ g2) << 3);
    RING_WAIT(8);
    RING_BAR();
    if (wr == 1) RING_BAR();
    for (int kt = 0; kt < nk; ++kt) {
        const char* st = smem + (kt & 3) * 32768;
        if (kt + 3 < nk) { char* s3 = smem + ((kt + 3) & 3) * 32768; al.issue(s3, kt + 3); bl.issue(s3 + 16384, kt + 3); }
        long b0[4], b1[4], a0[8], a1[8];
#pragma unroll
        for (int ni = 0; ni < 4; ++ni) { b0[ni] = *(const long*)(st + boff0 + ni * 1024); b1[ni] = *(const long*)(st + boff1 + ni * 1024); }
#pragma unroll
        for (int mi = 0; mi < 8; ++mi) { a0[mi] = *(const long*)(st + aoff0 + mi * 1024); a1[mi] = *(const long*)(st + aoff1 + mi * 1024); }
        if (kt + 1 < nk) { if (kt + 3 < nk) RING_WAIT(8); else if (kt + 2 < nk) RING_WAIT(4); else RING_WAIT(0); }
        RING_BAR();
        __builtin_amdgcn_s_setprio(1);
#pragma unroll
        for (int mi = 0; mi < 8; ++mi)
#pragma unroll
            for (int ni = 0; ni < 4; ++ni) {
                acc[mi][ni] = __builtin_amdgcn_mfma_f32_16x16x32_fp8_fp8(b0[ni], a0[mi], acc[mi][ni], 0, 0, 0);
                acc[mi][ni] = __builtin_amdgcn_mfma_f32_16x16x32_fp8_fp8(b1[ni], a1[mi], acc[mi][ni], 0, 0, 0);
            }
        __builtin_amdgcn_s_setprio(0);
        RING_BAR();
    }
    if (wr == 0) RING_BAR();
}

__device__ __forceinline__ void epi_store_bf16(const f32x4 (&acc)[8][4], bf16_t* out, long ld, int row0, int col0) {
    const int tid_ = opaque_tid();
    const int lane = tid_ & 63, wid = tid_ >> 6;
    const int wr = wid >> 2, wc = wid & 3, fr = lane & 15, fq = lane >> 4;
#pragma unroll
    for (int mi = 0; mi < 8; ++mi) {
        bf16_t* rp = out + (long)(row0 + wr * 128 + mi * 16 + fr) * ld + col0 + wc * 64 + fq * 8;
#pragma unroll
        for (int q = 0; q < 2; ++q) {
            u32x4 w; w.x = pk_bf16(acc[mi][2 * q][0], acc[mi][2 * q][1]); w.y = pk_bf16(acc[mi][2 * q][2], acc[mi][2 * q][3]);
            w.z = pk_bf16(acc[mi][2 * q + 1][0], acc[mi][2 * q + 1][1]); w.w = pk_bf16(acc[mi][2 * q + 1][2], acc[mi][2 * q + 1][3]);
            *(u32x4*)(rp + q * 32) = w;
        }
    }
}

template <bool RES_LN>
__device__ __forceinline__ void epi_residual(f32x4 (&acc)[8][4], char* smem, const float* resid_f32, const bf16_t* resid_bf16, const float* rstats  ,
                                             const float* g, const float* b, bf16_t* rbout, float* stout  , int row0, int nt) {
    const int tid_ = opaque_tid();
    const int lane = tid_ & 63, wid = tid_ >> 6;
    const int wr = wid >> 2, wc = wid & 3, fr = lane & 15, fq = lane >> 4;
    float* sp = (float*)smem;
    const int col0 = nt * 256 + wc * 64 + fq * 8;
#pragma unroll
    for (int mi = 0; mi < 8; ++mi) {
        const int rl = wr * 128 + mi * 16 + fr;
        const long row = row0 + rl;
        float mean = 0.f, rstd = 1.f;
        if (RES_LN) {
            const f32x4 p0 = *(const f32x4*)(rstats + row * 8), p1 = *(const f32x4*)(rstats + row * 8 + 4);
            const float s1 = (p0[0] + p0[2]) + (p1[0] + p1[2]), s2 = (p0[1] + p0[3]) + (p1[1] + p1[3]);
            mean = s1 * (1.0f / 1024.0f);
            const float var = fmaxf(s2 * (1.0f / 1024.0f) - mean * mean, 0.f);
            rstd = rsqrtf(var + LN_EPS);
        }
        float s1 = 0.f, s2 = 0.f;
#pragma unroll
        for (int q = 0; q < 2; ++q) {
            const long o = row * 1024 + col0 + q * 32;
            f32x4 x0, x1;
            if (RES_LN) {
                const u32x4 u = *(const u32x4*)(resid_bf16 + o);
                x0 = (f32x4){bf_lo(u.x), bf_hi(u.x), bf_lo(u.y), bf_hi(u.y)}; x1 = (f32x4){bf_lo(u.z), bf_hi(u.z), bf_lo(u.w), bf_hi(u.w)};
                x0 = (x0 - mean) * rstd * *(const f32x4*)(g + col0 + q * 32) + *(const f32x4*)(b + col0 + q * 32);
                x1 = (x1 - mean) * rstd * *(const f32x4*)(g + col0 + q * 32 + 4) + *(const f32x4*)(b + col0 + q * 32 + 4);
            } else { x0 = *(const f32x4*)(resid_f32 + o); x1 = *(const f32x4*)(resid_f32 + o + 4); }
            const f32x4 v0 = acc[mi][2 * q] + ALPHA * x0, v1 = acc[mi][2 * q + 1] + ALPHA * x1;
            { u32x4 w; w.x = pk_bf16(v0[0], v0[1]); w.y = pk_bf16(v0[2], v0[3]); w.z = pk_bf16(v1[0], v1[1]); w.w = pk_bf16(v1[2], v1[3]); *(u32x4*)(rbout + o) = w; }
            s1 += ((v0[0] + v0[1]) + (v0[2] + v0[3])) + ((v1[0] + v1[1]) + (v1[2] + v1[3]));
            s2 += ((v0[0] * v0[0] + v0[1] * v0[1]) + (v0[2] * v0[2] + v0[3] * v0[3])) + ((v1[0] * v1[0] + v1[1] * v1[1]) + (v1[2] * v1[2] + v1[3] * v1[3]));
        }
        s1 += __shfl_xor(s1, 16); s1 += __shfl_xor(s1, 32);
        s2 += __shfl_xor(s2, 16); s2 += __shfl_xor(s2, 32);
        if (fq == 0) { sp[(rl * 4 + wc) * 2] = s1; sp[(rl * 4 + wc) * 2 + 1] = s2; }
    }
    __syncthreads();
    if (tid_ < 256) {
        const int rl = tid_;
        const float a1 = (sp[rl * 8] + sp[rl * 8 + 2]) + (sp[rl * 8 + 4] + sp[rl * 8 + 6]);
        const float a2 = (sp[rl * 8 + 1] + sp[rl * 8 + 3]) + (sp[rl * 8 + 5] + sp[rl * 8 + 7]);
        *(f32x2*)(stout + ((long)(row0 + rl) * 4 + nt) * 2) = (f32x2){a1, a2};
    }
    __syncthreads();
}

__device__ __forceinline__ void ln_tile_stats(float* st, const float* rstats, int row0) {
    const int tid_ = opaque_tid();
    if (tid_ < 256) {
        const long row = row0 + tid_;
        const f32x4 p0 = *(const f32x4*)(rstats + row * 8), p1 = *(const f32x4*)(rstats + row * 8 + 4);
        const float s1 = (p0[0] + p0[2]) + (p1[0] + p1[2]), s2 = (p0[1] + p0[3]) + (p1[1] + p1[3]);
        const float mean = s1 * (1.0f / 1024.0f);
        const float var = fmaxf(s2 * (1.0f / 1024.0f) - mean * mean, 0.f);
        st[tid_ * 2] = mean; st[tid_ * 2 + 1] = rsqrtf(var + LN_EPS);
    }
}
__device__ __forceinline__ void ln_load_gb(float* gb, const float* g, const float* b) {
    for (int i = opaque_tid(); i < 1024; i += NTHR) { gb[i] = g[i]; gb[1024 + i] = b[i]; }
}


struct XcdSlab {
    int x, j, stride;
    __device__ __forceinline__ void init(int bid, int nb) { if ((nb & 7) == 0) { x = bid & 7; j = bid >> 3; stride = nb >> 3; } else { x = -1; j = bid; stride = nb; } }
    __device__ __forceinline__ int m_lo(int nM) const { return x < 0 ? 0 : (x * nM) >> 3; }
    __device__ __forceinline__ int m_hi(int nM) const { return x < 0 ? nM : ((x + 1) * nM) >> 3; }
};

template <int MAP>
__device__ __forceinline__ void ln_correct(f32x4 (&acc)[8][4], const float* rstats  , int row0, const float* cs, const float* bw, int nt) {
    const int tid_ = opaque_tid();
    const int lane = tid_ & 63, wid = tid_ >> 6;
    const int wr = wid >> 2, wc = wid & 3, fr = lane & 15, fq = lane >> 4;
    float mean[8], rstd[8];
#pragma unroll
    for (int mi = 0; mi < 8; ++mi) {
        const long row = row0 + wr * 128 + mi * 16 + fr;
        const f32x4 p0 = *(const f32x4*)(rstats + row * 8), p1 = *(const f32x4*)(rstats + row * 8 + 4);
        const float s1 = (p0[0] + p0[2]) + (p1[0] + p1[2]), s2 = (p0[1] + p0[3]) + (p1[1] + p1[3]);
        mean[mi] = s1 * (1.0f / 1024.0f);
        rstd[mi] = rsqrtf(fmaxf(s2 * (1.0f / 1024.0f) - mean[mi] * mean[mi], 0.f) + LN_EPS);
    }
#pragma unroll
    for (int ni = 0; ni < 4; ++ni) {
        const int col = MAP == 0 ? nt * 256 + wc * 64 + (ni >> 1) * 32 + fq * 8 + (ni & 1) * 4
                                 : (ni & 1) * 256 + nt * 128 + wc * 32 + fq * 8 + (ni >> 1) * 4;
        const f32x4 c4 = *(const f32x4*)(cs + col), b4 = *(const f32x4*)(bw + col);
#pragma unroll
        for (int mi = 0; mi < 8; ++mi) acc[mi][ni] = (acc[mi][ni] - mean[mi] * c4) * rstd[mi] + b4;
    }
}
struct TJob { const float* src; int ldsrc; int K; int col0; int ncols; bf16_t* dst; int mode; int rowoff; const float* g; const float* b; float* part;   };
__device__ __forceinline__ int tjob_row(const TJob& j, int c) {
    if (j.mode == 0) return j.rowoff + c;
    const int oc = c & 127;
    return 256 * (c >> 7) + 64 * (oc >> 5) + 16 * (2 * ((oc >> 2) & 1) + j.rowoff) + 4 * ((oc >> 3) & 3) + (oc & 3);
}
__device__ __forceinline__ void transpose_tile(char* smem, const TJob& j, int kt, int ct) {
    float* tile = (float*)smem;
    float* red = tile + 64 * 65;
    const int tid = opaque_tid();
    float scs = 0.f, sbw = 0.f;
#pragma unroll
    for (int i = 0; i < 8; ++i) {
        const int e = tid + i * NTHR, kr = e >> 6, c = e & 63;
        const int cc = ct * 64 + c;
        float v = 0.f;
        if (cc < j.ncols) v = j.src[(long)(kt * 64 + kr) * j.ldsrc + j.col0 + cc];
        if (j.g) {
            const float gv = j.g[kt * 64 + kr], bv = j.b[kt * 64 + kr];
            sbw += bv * v;
            v *= gv;
            scs += __uint_as_float(pk_bf16(v, 0.f) << 16);
        }
        tile[kr * 65 + c] = v;
    }
    if (j.g) { red[(tid >> 6) * 64 + (tid & 63)] = scs; red[512 + (tid >> 6) * 64 + (tid & 63)] = sbw; }
    __syncthreads();
#pragma unroll
    for (int i = 0; i < 4; ++i) {
        const int e = tid + i * NTHR, c = e >> 5, k2 = (e & 31) * 2;
        const int cc = ct * 64 + c;
        if (cc < j.ncols) {
            const unsigned w = pk_bf16(tile[k2 * 65 + c], tile[(k2 + 1) * 65 + c]);
            *(unsigned*)(j.dst + (long)tjob_row(j, cc) * j.K + kt * 64 + k2) = w;
        }
    }
    if (j.g && tid < 128) {
        const int which = tid >> 6, c = tid & 63;
        float s = 0.f;
#pragma unroll
        for (int w = 0; w < 8; ++w) s += red[which * 512 + w * 64 + c];
        if (ct * 64 + c < j.ncols) j.part[(long)(which * 16 + kt) * 1792 + ct * 64 + c] = s;
    }
    __syncthreads();
}

__device__ __forceinline__ void tjob_run(char* smem, int bid, int nb, const float* src, int ld, int K, int col0, int ncols, bf16_t* dst, int mode, int rowoff,
                                         const float* g = nullptr, const float* b = nullptr, float* part = nullptr) {
    TJob j; j.src = src; j.ldsrc = ld; j.K = K; j.col0 = col0; j.ncols = ncols; j.dst = dst; j.mode = mode; j.rowoff = rowoff; j.g = g; j.b = b; j.part = part;
    const int nkt = K / 64, nct = (ncols + 63) / 64, ntile = nkt * nct;
    for (int t = bid; t < ntile; t += nb) transpose_tile(smem, j, t % nkt, t / nkt);
}

__device__ __forceinline__ void cvt_rows_bf16(const float* src, bf16_t* dst, long n8, int bid, int nb) {
    for (long i = (long)bid * NTHR + opaque_tid(); i < n8; i += (long)nb * NTHR) {
        const f32x4 a = *(const f32x4*)(src + i * 8), b = *(const f32x4*)(src + i * 8 + 4);
        u32x4 w; w.x = pk_bf16(a[0], a[1]); w.y = pk_bf16(a[2], a[3]); w.z = pk_bf16(b[0], b[1]); w.w = pk_bf16(b[2], b[3]);
        *(u32x4*)(dst + i * 8) = w;
    }
}

enum { I_X = 0, I_MEM, I_WIN, I_POSK, I_CKW1, I_CKW2, I_POSV, I_CVW1, I_CVW2, I_CONVW, I_IBIAS, I_FBIAS, I_NORMG, I_WOUT, I_LN1G, I_LN1B,
       I_XAWQ, I_XAWK, I_XAWV, I_XAWO, I_LN2G, I_LN2B, I_ROUTW, I_ROUTB, I_MW1, I_MW3, I_MW2, I_SW1, I_SW3, I_SW2, I_LN3G, I_LN3B };

__device__ __forceinline__ void phase0(const Params& p, char* smem, int bid, int nb) {
    char* ws = p.ws;
    tjob_run(smem, bid, nb, p.in[I_WIN], 3360, 1024, 0, 1280, (bf16_t*)(ws + WS_WIN), 0, 0);
    tjob_run(smem, bid, nb, p.in[I_WIN], 3360, 1024, 1304, 2048, (bf16_t*)(ws + WS_WIN), 0, 1280);
    tjob_run(smem, bid, nb, p.in[I_WIN], 3360, 1024, 1280, 24, (bf16_t*)(ws + WS_WIN), 0, 3328);
    tjob_run(smem, bid, nb, p.in[I_WIN], 3360, 1024, 3352, 8, (bf16_t*)(ws + WS_WIN), 0, 3352);
    tjob_run(smem, bid, nb, p.in[I_WOUT], 1024, 1024, 0, 1024, (bf16_t*)(ws + WS_WOUT), 0, 0);
    float* lnp = (float*)(ws + WS_LNP);
    tjob_run(smem, bid, nb, p.in[I_XAWQ], 1024, 1024, 0, 1024, (bf16_t*)(ws + WS_WQ), 0, 0, p.in[I_LN1G], p.in[I_LN1B], lnp);
    tjob_run(smem, bid, nb, p.in[I_XAWK], 1024, 1024, 0, 1024, (bf16_t*)(ws + WS_WKV), 0, 0);
    tjob_run(smem, bid, nb, p.in[I_XAWV], 1024, 1024, 0, 1024, (bf16_t*)(ws + WS_WKV), 0, 1024);
    tjob_run(smem, bid, nb, p.in[I_XAWO], 1024, 1024, 0, 1024, (bf16_t*)(ws + WS_WO), 0, 0);
    tjob_run(smem, bid, nb, p.in[I_ROUTW], 256, 1024, 0, 256, (bf16_t*)(ws + WS_WR), 0, 0, p.in[I_LN2G], p.in[I_LN2B], lnp + 1024);
    tjob_run(smem, bid, nb, p.in[I_SW1], 256, 1024, 0, 256, (bf16_t*)(ws + WS_WS13), 1, 0, p.in[I_LN2G], p.in[I_LN2B], lnp + 1280);
    tjob_run(smem, bid, nb, p.in[I_SW3], 256, 1024, 0, 256, (bf16_t*)(ws + WS_WS13), 1, 1, p.in[I_LN2G], p.in[I_LN2B], lnp + 1536);
    tjob_run(smem, bid, nb, p.in[I_SW2], 1024, 256, 0, 1024, (bf16_t*)(ws + WS_WS2), 0, 0);
    tjob_run(smem, bid, nb, p.in[I_CKW1], 64, 2048, 0, 64, (bf16_t*)(ws + WS_CK1), 0, 0);
    tjob_run(smem, bid, nb, p.in[I_CKW2], 64, 64, 0, 64, (bf16_t*)(ws + WS_CK2), 0, 0);
    tjob_run(smem, bid, nb, p.in[I_CVW1], 64, 2048, 0, 64, (bf16_t*)(ws + WS_CV1), 0, 0);
    tjob_run(smem, bid, nb, p.in[I_CVW2], 64, 64, 0, 64, (bf16_t*)(ws + WS_CV2), 0, 0);
    cvt_rows_bf16(p.in[I_X], (bf16_t*)(ws + WS_XB), (long)T_TOK * 1024 / 8, bid, nb);
    cvt_rows_bf16(p.in[I_MEM], (bf16_t*)(ws + WS_MEMB), (long)4096 * 1024 / 8, bid, nb);
    { int* c = (int*)(ws + WS_CNT); for (int i = bid * NTHR + opaque_tid(); i < 24576; i += nb * NTHR) c[i] = 0; }
}

__device__ __forceinline__ void small_cols_task(const Params& p, int task) {
    const bf16_t* xb = (const bf16_t*)(p.ws + WS_XB);
    const bf16_t* wt = (const bf16_t*)(p.ws + WS_WIN) + (long)3328 * 1024;
    float* psm = (float*)(p.ws + WS_PSM);
    const int tid_ = opaque_tid();
    const int lane = tid_ & 63, wid = tid_ >> 6, fr = lane & 15, fq = lane >> 4;
    const int r0 = task * 256 + wid * 32;
    f32x4 acc[2][2];
#pragma unroll
    for (int mi = 0; mi < 2; ++mi)
#pragma unroll
        for (int ni = 0; ni < 2; ++ni) acc[mi][ni] = (f32x4){0.f, 0.f, 0.f, 0.f};
    const bf16_t* ap0 = xb + (long)(r0 + fr) * 1024 + fq * 8;
    const bf16_t* ap1 = ap0 + 16 * 1024;
    const bf16_t* bp0 = wt + (long)fr * 1024 + fq * 8;
    const bf16_t* bp1 = bp0 + 16 * 1024;
#pragma unroll 4
    for (int ks = 0; ks < 32; ++ks) {
        const bf16x8 a0 = *(const bf16x8*)(ap0 + ks * 32), a1 = *(const bf16x8*)(ap1 + ks * 32);
        const bf16x8 b0 = *(const bf16x8*)(bp0 + ks * 32), b1 = *(const bf16x8*)(bp1 + ks * 32);
        acc[0][0] = mfma16(b0, a0, acc[0][0]); acc[0][1] = mfma16(b1, a0, acc[0][1]);
        acc[1][0] = mfma16(b0, a1, acc[1][0]); acc[1][1] = mfma16(b1, a1, acc[1][1]);
    }
#pragma unroll
    for (int mi = 0; mi < 2; ++mi)
#pragma unroll
        for (int ni = 0; ni < 2; ++ni) *(f32x4*)(psm + (long)(r0 + mi * 16 + fr) * 32 + ni * 16 + fq * 4) = acc[mi][ni];
}

template <int NOEPI = 0>
__device__ __forceinline__ void phase1(const Params& p, char* smem, int bid, int nb) {
    char* ws = p.ws;
    XcdSlab xs; xs.init(bid, nb);
    const int a_lo = xs.m_lo(128), a_n = (xs.m_hi(128) - a_lo) * 14;
    const int b_lo = xs.m_lo(16), b_n = (xs.m_hi(16) - b_lo) * 8;
    for (int u = xs.j; u < a_n + b_n; u += xs.stride) {
        const bool inp = u < a_n;
        const int uu = inp ? u : u - a_n;
        const int nm = inp ? (xs.m_hi(128) - a_lo) : (xs.m_hi(16) - b_lo);
        const int mt = (inp ? a_lo : b_lo) + uu % nm, nt = uu / nm;
        RingRows al, bl;
        al.init_contig((const bf16_t*)(ws + (inp ? WS_XB : WS_MEMB)), 1024, mt * 256);
        bl.init_contig((const bf16_t*)(ws + (inp ? WS_WIN : WS_WKV)), 1024, nt * 256, true);
        f32x4 acc[8][4];
        gemm_ring(smem, al, bl, 32, acc);
        if (NOEPI) { float s = 0.f;
#pragma unroll
            for (int mi = 0; mi < 8; ++mi)
#pragma unroll
                for (int ni = 0; ni < 4; ++ni) s += acc[mi][ni][0] + acc[mi][ni][1] + acc[mi][ni][2] + acc[mi][ni][3];
            if (s == 123.456f) ((float*)(ws + WS_A + 432 * MB))[opaque_tid()] = s; continue; }
        if (!inp) epi_store_bf16(acc, (bf16_t*)(ws + WS_KVX), 2048, mt * 256, nt * 256);
        else if (nt < 13) epi_store_bf16(acc, (bf16_t*)(ws + WS_P), PW, mt * 256, nt * 256);
        else {
            const int tid_ = opaque_tid();
            const int lane = tid_ & 63, wid = tid_ >> 6, wr = wid >> 2, wc = wid & 3, fr = lane & 15, fq = lane >> 4;
            if (wc == 0) {
                float* psm = (float*)(ws + WS_PSM);
#pragma unroll
                for (int mi = 0; mi < 8; ++mi)
#pragma unroll
                    for (int ni = 0; ni < 2; ++ni) *(f32x4*)(psm + (long)(mt * 256 + wr * 128 + mi * 16 + fr) * 32 + fq * 8 + ni * 4) = acc[mi][ni];
            }
        }
    }
}

__device__ __forceinline__ void compress_task(const Params& p, char* smem, int which, int rb) {
    const char* ws = p.ws;
    const bf16_t* P = (const bf16_t*)(ws + WS_P);
    const float* pos = p.in[which ? I_POSV : I_POSK];
    const bf16_t* w1t = (const bf16_t*)(ws + (which ? WS_CV1 : WS_CK1));
    const bf16_t* w2t = (const bf16_t*)(ws + (which ? WS_CV2 : WS_CK2));
    bf16_t* outp = (bf16_t*)(p.ws + (which ? WS_VCMP : WS_KCMP));
    const int colbase = which ? PC_VC : PC_KC;
    const int tid_ = opaque_tid();
    const int lane = tid_ & 63, wid = tid_ >> 6, fr = lane & 15, fq = lane >> 4;
    const int mi = wid >> 2, ni = wid & 3;
    const int r = rb * 32 + mi * 16 + fr;
    const int b = r / 254, rem = r - b * 254, c = rem >> 1, g = rem & 1;
    const bf16_t* arow = P + (long)(b * 2048 + c * 16) * PW + colbase + g * 64 + fq * 8;
    const bf16_t* brow = w1t + (long)(ni * 16 + fr) * 2048 + fq * 8;
    const float* prow = pos + fq * 8;
    f32x4 acc = (f32x4){0.f, 0.f, 0.f, 0.f};
#pragma unroll 8
    for (int ks = 0; ks < 64; ++ks) {
        const int l = ks >> 1, d0 = (ks & 1) * 32;
        const u32x4 av = *(const u32x4*)(arow + (long)l * PW + d0);
        const f32x4 p0 = *(const f32x4*)(prow + l * 64 + d0), p1 = *(const f32x4*)(prow + l * 64 + d0 + 4);
        u32x4 aw;
        aw.x = pk_bf16(bf_lo(av.x) + p0[0], bf_hi(av.x) + p0[1]); aw.y = pk_bf16(bf_lo(av.y) + p0[2], bf_hi(av.y) + p0[3]);
        aw.z = pk_bf16(bf_lo(av.z) + p1[0], bf_hi(av.z) + p1[1]); aw.w = pk_bf16(bf_lo(av.w) + p1[2], bf_hi(av.w) + p1[3]);
        const bf16x8 bb = *(const bf16x8*)(brow + ks * 32);
        acc = mfma16(bb, as_bf16x8(aw), acc);
    }
    bf16_t* h1 = (bf16_t*)smem;
    {
        u32x2 w; w.x = pk_bf16(siluf_(acc[0]), siluf_(acc[1])); w.y = pk_bf16(siluf_(acc[2]), siluf_(acc[3]));
        *(u32x2*)(h1 + (mi * 16 + fr) * 72 + ni * 16 + fq * 4) = w;
    }
    __syncthreads();
    f32x4 acc2 = (f32x4){0.f, 0.f, 0.f, 0.f};
#pragma unroll
    for (int ks = 0; ks < 2; ++ks) {
        const bf16x8 a = *(const bf16x8*)(h1 + (mi * 16 + fr) * 72 + ks * 32 + fq * 8);
        const bf16x8 bb = *(const bf16x8*)(w2t + (ni * 16 + fr) * 64 + ks * 32 + fq * 8);
        acc2 = mfma16(bb, a, acc2);
    }
    {
        u32x2 w; w.x = pk_bf16(acc2[0], acc2[1]); w.y = pk_bf16(acc2[2], acc2[3]);
        *(u32x2*)(outp + ((long)(b * 2 + g) * 128 + c) * 64 + ni * 16 + fq * 4) = w;
    }
    __syncthreads();
}

__device__ __forceinline__ void phase2(const Params& p, char* smem, int bid, int nb) {
    char* ws = p.ws;
    {
        const int idx = bid * NTHR + opaque_tid();
        if (idx < 2 * 1792) {
            const float* pp = (const float*)(ws + WS_LNP) + (long)(idx / 1792) * 16 * 1792 + idx % 1792;
            float s = 0.f;
#pragma unroll
            for (int k = 0; k < 16; ++k) s += pp[k * 1792];
            ((float*)(ws + WS_LNF))[idx] = s;
        }
    }
    for (int t = bid; t < 254; t += nb) compress_task(p, smem, t / 127, t % 127);
    const int tid_ = opaque_tid();
    if (bid < 32 && tid_ < 32) {
        bf16_t* kc = (bf16_t*)(ws + WS_KCMP) + ((long)bid * 128 + 127) * 64;
        bf16_t* vc = (bf16_t*)(ws + WS_VCMP) + ((long)bid * 128 + 127) * 64;
        ((unsigned*)kc)[tid_] = 0u; ((unsigned*)vc)[tid_] = 0u;
    }
    const bf16_t* P = (const bf16_t*)(ws + WS_P);
    const float* cw = p.in[I_CONVW];
    bf16_t* qk = (bf16_t*)(ws + WS_QK);
    for (long it = (long)bid * NTHR + tid_; it < (long)T_TOK * 128; it += (long)nb * NTHR) {
        const int t = (int)(it >> 7), ch = (int)(it & 127);
        const int s = t & (SEQ - 1);
        float a[8];
#pragma unroll
        for (int e = 0; e < 8; ++e) a[e] = 0.f;
#pragma unroll
        for (int j = 0; j < 4; ++j) {
            if (s - 3 + j >= 0) {
                const u32x4 u = *(const u32x4*)(P + (long)(t - 3 + j) * PW + PC_MQ + ch * 8);
                const f32x4 w0 = *(const f32x4*)(cw + j * 1024 + ch * 8), w1 = *(const f32x4*)(cw + j * 1024 + ch * 8 + 4);
                a[0] += w0[0] * bf_lo(u.x); a[1] += w0[1] * bf_hi(u.x); a[2] += w0[2] * bf_lo(u.y); a[3] += w0[3] * bf_hi(u.y);
                a[4] += w1[0] * bf_lo(u.z); a[5] += w1[1] * bf_hi(u.z); a[6] += w1[2] * bf_lo(u.w); a[7] += w1[3] * bf_hi(u.w);
            }
        }
        const float sc = ch < 64 ? 0.08838834764831845f : 1.0f;
        u32x4 w;
        w.x = pk_bf16(siluf_(a[0]) * sc, siluf_(a[1]) * sc); w.y = pk_bf16(siluf_(a[2]) * sc, siluf_(a[3]) * sc);
        w.z = pk_bf16(siluf_(a[4]) * sc, siluf_(a[5]) * sc); w.w = pk_bf16(siluf_(a[6]) * sc, siluf_(a[7]) * sc);
        *(u32x4*)(qk + (long)t * 1024 + ch * 8) = w;
    }
}

typedef __attribute__((address_space(3))) s16x4 lds_s16x4;
__device__ __forceinline__ s16x4 lds_tr(const char* a) { return __builtin_amdgcn_ds_read_tr16_b64_v4i16((lds_s16x4*)a); }
__device__ __forceinline__ bf16x8 tr_frag_perm(const char* base, int pitch, int rbase, int cbase, int fr, int fq) {
    const char* a0 = base + (rbase + 4 * fq + (fr >> 2)) * pitch + (cbase + 4 * (fr & 3)) * 2;
    const s16x4 lo = lds_tr(a0), hi = lds_tr(a0 + 16 * pitch);
    return (bf16x8){lo[0], lo[1], lo[2], lo[3], hi[0], hi[1], hi[2], hi[3]};
}
__device__ __forceinline__ bf16x8 tr_frag_std(const char* base, int pitch, int rbase, int cbase, int fr, int fq) {
    const char* a0 = base + (rbase + 8 * fq + (fr >> 2)) * pitch + (cbase + 4 * (fr & 3)) * 2;
    const s16x4 lo = lds_tr(a0), hi = lds_tr(a0 + 4 * pitch);
    return (bf16x8){lo[0], lo[1], lo[2], lo[3], hi[0], hi[1], hi[2], hi[3]};
}
__device__ __forceinline__ bf16x8 pack_p(const f32x4 a, const f32x4 b) {
    u32x4 w; w.x = pk_bf16(a[0], a[1]); w.y = pk_bf16(a[2], a[3]); w.z = pk_bf16(b[0], b[1]); w.w = pk_bf16(b[2], b[3]);
    return as_bf16x8(w);
}

__device__ __forceinline__ float dpp_xor1(float v) { return __builtin_bit_cast(float, __builtin_amdgcn_mov_dpp(__builtin_bit_cast(int, v), 0xB1, 0xF, 0xF, true)); }
__device__ __forceinline__ float dpp_xor2(float v) { return __builtin_bit_cast(float, __builtin_amdgcn_mov_dpp(__builtin_bit_cast(int, v), 0x4E, 0xF, 0xF, true)); }

constexpr int NSA_PITCH = 160;
constexpr int NSA_KC = 0, NSA_VC = 20480, NSA_KT = 40960, NSA_VT = 61440, NSA_MISC = 81920, NSA_Y = 83968;

struct NsaState {
    bf16x8 qf[2][2];
    int tl[2];
    unsigned selm[2];
    unsigned wunion, bunion;
};

constexpr int NSA_STG = 16384;
__device__ __forceinline__ float fq_max(float x) {
    auto a = __builtin_amdgcn_permlane16_swap(__float_as_uint(x), __float_as_uint(x), false, false);
    x = __builtin_fmaxf(__uint_as_float(a[0]), __uint_as_float(a[1]));
    auto b = __builtin_amdgcn_permlane32_swap(__float_as_uint(x), __float_as_uint(x), false, false);
    return __builtin_fmaxf(__uint_as_float(b[0]), __uint_as_float(b[1]));
}
__device__ __forceinline__ float fq_sum(float x) {
    auto a = __builtin_amdgcn_permlane16_swap(__float_as_uint(x), __float_as_uint(x), false, false);
    x = __uint_as_float(a[0]) + __uint_as_float(a[1]);
    auto b = __builtin_amdgcn_permlane32_swap(__float_as_uint(x), __float_as_uint(x), false, false);
    return __uint_as_float(b[0]) + __uint_as_float(b[1]);
}
__device__ __forceinline__ bf16x8 tr_frag_perm_swz(const char* base, int rbase, int dt, int fr, int fq) {
    const int R = rbase + 4 * fq + (fr >> 2), c = 2 * dt + ((fr & 3) >> 1);
    const char* a0 = base + R * 128 + ((c ^ (R & 7)) << 4) + 8 * (fr & 1);
    const s16x4 lo = lds_tr(a0), hi = lds_tr(a0 + 16 * 128);
    return (bf16x8){lo[0], lo[1], lo[2], lo[3], hi[0], hi[1], hi[2], hi[3]};
}
#define NSA_WAITV(n) asm volatile("s_waitcnt vmcnt(" #n ")" ::: "memory")
#define NSA_BAR() do { asm volatile("s_waitcnt lgkmcnt(0)" ::: "memory"); __builtin_amdgcn_s_barrier(); asm volatile("" ::: "memory"); } while (0)

template <int MODE>
__device__ __forceinline__ void nsa_stream(char* smem, const bf16_t* Pb  , int g, int i, NsaState& st, float gate0, float gate1, const int tid) {
    const int lane = tid & 63, fr = lane & 15, fq = lane >> 4;
    const int kcol = (MODE == 0 ? PC_KS : PC_KW) + g * 64, vcol = (MODE == 0 ? PC_VS : PC_VW) + g * 64;
    const int lrow = tid >> 3, lch = (tid & 7) ^ (lrow & 7);
    const bf16_t* ksrc = Pb + (long)lrow * PW + kcol + lch * 8;
    const bf16_t* vsrc = Pb + (long)lrow * PW + vcol + lch * 8;
    const int jlo = MODE == 0 ? 0 : (i - 8 > 0 ? i - 8 : 0);
    const unsigned range = (i >= 31 ? 0xffffffffu : ((1u << (i + 1)) - 1u)) & ~((1u << jlo) - 1u);
    const unsigned need = (unsigned)__builtin_amdgcn_readfirstlane((int)((MODE == 0 ? st.bunion : 0xffffffffu) & range));
    f32x4 O[2][4];
    float m[2], l[2];
    int tlq[2];
#pragma unroll
    for (int mt = 0; mt < 2; ++mt) { m[mt] = -1e30f; l[mt] = 0.f; tlq[mt] = st.tl[mt] - 4 * fq;
#pragma unroll
        for (int dt = 0; dt < 4; ++dt) O[mt][dt] = (f32x4){0.f, 0.f, 0.f, 0.f}; }
    unsigned pm = need;
    int nissued = 0;
    auto issue_next = [&]() {
        const int jj = __builtin_ctz(pm); pm &= pm - 1u;
        char* sb = smem + (nissued & 3) * NSA_STG;
        __builtin_amdgcn_global_load_lds((glb_u32*)(ksrc + (long)jj * 64 * PW), (lds_u32*)(sb + tid * 16), 16, 0, 0);
        __builtin_amdgcn_global_load_lds((glb_u32*)(vsrc + (long)jj * 64 * PW), (lds_u32*)(sb + 8192 + tid * 16), 16, 0, 0);
        ++nissued;
    };
    const int L = __builtin_popcount(need);
    if (L > 0) issue_next();
    if (L > 1) issue_next();
    if (L > 2) issue_next();
    if (L > 2) NSA_WAITV(4); else if (L > 1) NSA_WAITV(2); else NSA_WAITV(0);
    NSA_BAR();
    unsigned cm = need;
    for (int n = 0; n < L; ++n) {
        const int j = __builtin_ctz(cm); cm &= cm - 1u;
        if (n + 3 < L) issue_next();
        const char* KT = smem + (n & 3) * NSA_STG;
        const char* VT = KT + 8192;
        const bool wave_on = MODE == 0 ? (((st.wunion >> j) & 1u) != 0u) : true;
        if (wave_on) {
            f32x4 S[2][4];
            {
                bf16x8 kf[4][2];
#pragma unroll
                for (int nt = 0; nt < 4; ++nt)
#pragma unroll
                    for (int ks = 0; ks < 2; ++ks) kf[nt][ks] = *(const bf16x8*)(KT + (16 * nt + fr) * 128 + (((ks * 4 + fq) ^ (fr & 7)) << 4));
#pragma unroll
                for (int mt = 0; mt < 2; ++mt)
#pragma unroll
                    for (int nt = 0; nt < 4; ++nt) {
                        f32x4 s = (f32x4){0.f, 0.f, 0.f, 0.f};
                        s = mfma16(kf[nt][0], st.qf[mt][0], s);
                        s = mfma16(kf[nt][1], st.qf[mt][1], s);
                        S[mt][nt] = s;
                    }
            }
            bf16x8 pf[2][2];
            const bool edge = (j == i) || (MODE == 1 && j == i - 8);
            constexpr float CS = 0.125f * 1.4426950408889634f;
#pragma unroll
            for (int mt = 0; mt < 2; ++mt) {
                const bool rowsel = MODE == 0 ? (((st.selm[mt] >> j) & 1u) != 0u) : true;
                if (edge) {
                    asm volatile("; boundary tile" ::: "memory");
#pragma unroll
                    for (int nt = 0; nt < 4; ++nt)
#pragma unroll
                        for (int e = 0; e < 4; ++e) {
                            const int kc = 16 * nt + e;
                            bool ok = true;
                            if (j == i) ok = ok && (kc <= tlq[mt]);
                            if (MODE == 1) { if (j == i - 8) ok = ok && (kc > tlq[mt]); }
                            S[mt][nt][e] = ok ? S[mt][nt][e] : -INFINITY;
                        }
                }
                float mx = -INFINITY;
#pragma unroll
                for (int nt = 0; nt < 4; ++nt)
#pragma unroll
                    for (int e = 0; e < 4; ++e) mx = __builtin_fmaxf(mx, S[mt][nt][e]);
                mx = fq_max(mx);
                if (MODE == 0) mx = rowsel ? mx : -INFINITY;
                const float mnew = __builtin_fmaxf(m[mt], mx * CS);
                const float alpha = __builtin_amdgcn_exp2f(m[mt] - mnew);
                const float msub = (MODE == 0 && !rowsel) ? INFINITY : mnew;
                float rs = 0.f;
#pragma unroll
                for (int nt = 0; nt < 4; ++nt)
#pragma unroll
                    for (int e = 0; e < 4; ++e) { const float pv = __builtin_amdgcn_exp2f(__builtin_fmaf(S[mt][nt][e], CS, -msub)); S[mt][nt][e] = pv; rs += pv; }
                rs = fq_sum(rs);
                l[mt] = l[mt] * alpha + rs; m[mt] = mnew;
#pragma unroll
                for (int dt = 0; dt < 4; ++dt) O[mt][dt] = O[mt][dt] * alpha;
                pf[mt][0] = pack_p(S[mt][0], S[mt][1]); pf[mt][1] = pack_p(S[mt][2], S[mt][3]);
            }
#pragma unroll
            for (int ks2 = 0; ks2 < 2; ++ks2)
#pragma unroll
                for (int dt = 0; dt < 4; ++dt) {
                    const bf16x8 vf = tr_frag_perm_swz(VT, 32 * ks2, dt, fr, fq);
                    O[0][dt] = mfma16(vf, pf[0][ks2], O[0][dt]);
                    O[1][dt] = mfma16(vf, pf[1][ks2], O[1][dt]);
                }
        }
        if (n + 1 < L) { if (n + 3 < L) NSA_WAITV(4); else if (n + 2 < L) NSA_WAITV(2); else NSA_WAITV(0); }
        NSA_BAR();
    }
#pragma unroll
    for (int mt = 0; mt < 2; ++mt) {
        const float gsc = (mt == 0 ? gate0 : gate1) * (l[mt] > 0.f ? 1.0f / l[mt] : 0.f);
#pragma unroll
        for (int dt = 0; dt < 4; ++dt) { f32x4* yp = (f32x4*)(smem + NSA_Y) + (mt * 4 + dt) * NTHR + tid; *yp = *yp + O[mt][dt] * gsc; }
    }
}

__device__ __forceinline__ void nsa_cmp_one(const char* smem, const bf16x8 qf0, const bf16x8 qf1, const int t, const int i, const float gate0, f32x4* yp  , unsigned& selm, const int lane) {
    const int fr = lane & 15, fq = lane >> 4;
        const int cl = (t >= 31 ? ((t - 31) >> 4) : -1) - 4 * fq;
        f32x4 S[8];
#pragma unroll
        for (int nt = 0; nt < 8; ++nt) {
            f32x4 s = (f32x4){0.f, 0.f, 0.f, 0.f};
#pragma unroll
            for (int ks = 0; ks < 2; ++ks) {
                const bf16x8 kf = *(const bf16x8*)(smem + NSA_KC + (16 * nt + fr) * NSA_PITCH + (ks * 4 + fq) * 16);
                s = mfma16(kf, (ks == 0 ? qf0 : qf1), s);
            }
            S[nt] = s;
        }
        float mx = -INFINITY;
#pragma unroll
        for (int nt = 0; nt < 8; ++nt)
#pragma unroll
            for (int e = 0; e < 4; ++e) {
                const float sv = (16 * nt + e <= cl) ? S[nt][e] * 0.125f : -INFINITY;
                S[nt][e] = sv; mx = fmaxf(mx, sv);
            }
        mx = fmaxf(mx, __shfl_xor(mx, 16)); mx = fmaxf(mx, __shfl_xor(mx, 32));
        const float mref = fmaxf(mx, -1e30f);
        float rs = 0.f;
#pragma unroll
        for (int nt = 0; nt < 8; ++nt)
#pragma unroll
            for (int e = 0; e < 4; ++e) { const float pv = __expf(S[nt][e] - mref); S[nt][e] = pv; rs += pv; }
        rs += __shfl_xor(rs, 16); rs += __shfl_xor(rs, 32);
        const float inv = rs > 0.f ? 1.0f / rs : 0.f;
#pragma unroll
        for (int nt = 0; nt < 8; ++nt) S[nt] = S[nt] * inv;
        {
            f32x4 O[4];
#pragma unroll
            for (int dt = 0; dt < 4; ++dt) O[dt] = (f32x4){0.f, 0.f, 0.f, 0.f};
#pragma unroll
            for (int ks2 = 0; ks2 < 4; ++ks2) {
                const bf16x8 pf = pack_p(S[2 * ks2], S[2 * ks2 + 1]);
#pragma unroll
                for (int dt = 0; dt < 4; ++dt) {
                    const bf16x8 vf = tr_frag_perm(smem + NSA_VC, NSA_PITCH, 32 * ks2, 16 * dt, fr, fq);
                    O[dt] = mfma16(vf, pf, O[dt]);
                }
            }
#pragma unroll
            for (int dt = 0; dt < 4; ++dt) yp[dt * NTHR] = O[dt] * gate0;
        }
        float imp[8];
        {
            float own[8], last[8];
#pragma unroll
            for (int nt = 0; nt < 8; ++nt) {
                f32x4 v = S[nt];
#pragma unroll
                for (int e = 0; e < 4; ++e) { v[e] += dpp_xor1(v[e]); v[e] += dpp_xor2(v[e]); }
                own[nt] = (v[0] + v[1]) + (v[2] + v[3]); last[nt] = v[3];
            }
            const int src = (lane + 48) & 63;
#pragma unroll
            for (int nt = 0; nt < 8; ++nt) {
                const float a = __shfl(last[nt], src);
                const float bsh = nt > 0 ? __shfl(last[nt > 0 ? nt - 1 : 0], src) : 0.f;
                const float prevc = fq > 0 ? a : bsh;
                const int n = 4 * nt + fq;
                const float pslc = own[nt] + prevc;
                const bool valid = n <= i;
                const bool forced = (n == 0) || (n == i) || (n == i - 1);
                imp[nt] = valid ? pslc + (forced ? 1e4f : 0.f) : -1e30f;
            }
        }
        unsigned mask = 0u;
#pragma unroll 1
        for (int r = 0; r < 8; ++r) {
            float bv = imp[0]; int bn = fq;
#pragma unroll
            for (int nt = 1; nt < 8; ++nt) { if (imp[nt] > bv) { bv = imp[nt]; bn = 4 * nt + fq; } }
#pragma unroll
            for (int off = 16; off <= 32; off <<= 1) {
                const float ov = __shfl_xor(bv, off); const int on = __shfl_xor(bn, off);
                if (ov > bv || (ov == bv && on < bn)) { bv = ov; bn = on; }
            }
            if (bv > -5e29f) mask |= 1u << bn;
#pragma unroll
            for (int nt = 0; nt < 8; ++nt) if (bn == 4 * nt + fq) imp[nt] = -3.0e38f;
        }
        selm = mask;
}

template <int NSAV = 7  >
__device__ __forceinline__ void nsa_task(const Params& p, char* smem, int b, int g, int i) {
    const char* ws = p.ws;
    const bf16_t* Pb = (const bf16_t*)(ws + WS_P) + (long)b * SEQ * PW;
    const float* psm = (const float*)(ws + WS_PSM) + (long)b * SEQ * 32;
    int tid = threadIdx.x;
    asm volatile("" : "+v"(tid));
    const int lane = tid & 63, wid = __builtin_amdgcn_readfirstlane(tid >> 6), fr = lane & 15, fq = lane >> 4;
    const int qs = i * 64;
    NsaState st;
    float gate[2][3];
#pragma unroll
    for (int mt = 0; mt < 2; ++mt) {
        st.tl[mt] = 8 * wid + 4 * mt + (fr >> 2);
        const int h = fr & 3;
        const bf16_t* qp = Pb + (long)(qs + st.tl[mt]) * PW + PC_Q + g * 256 + h * 64 + fq * 8;
        st.qf[mt][0] = *(const bf16x8*)(qp); st.qf[mt][1] = *(const bf16x8*)(qp + 32);
        const float* gp = psm + (long)(qs + st.tl[mt]) * 32 + (g * 4 + h) * 3;
        gate[mt][0] = sigmoidf_(gp[0]); gate[mt][1] = sigmoidf_(gp[1]); gate[mt][2] = sigmoidf_(gp[2]);
    }
    {
        const bf16_t* kc = (const bf16_t*)(ws + WS_KCMP) + (long)(b * 2 + g) * 128 * 64;
        const bf16_t* vc = (const bf16_t*)(ws + WS_VCMP) + (long)(b * 2 + g) * 128 * 64;
#pragma unroll
        for (int r = 0; r < 2; ++r) {
            const int e = tid + r * NTHR, row = e >> 3, ch = e & 7;
            *(u32x4*)(smem + NSA_KC + row * NSA_PITCH + ch * 16) = *(const u32x4*)(kc + row * 64 + ch * 8);
            *(u32x4*)(smem + NSA_VC + row * NSA_PITCH + ch * 16) = *(const u32x4*)(vc + row * 64 + ch * 8);
        }
    }
    __syncthreads();
    if (!(NSAV & 1)) { st.selm[0] = 0xffffffffu; st.selm[1] = 0xffffffffu;
#pragma unroll
        for (int d8 = 0; d8 < 8; ++d8) ((f32x4*)(smem + NSA_Y))[d8 * NTHR + tid] = (f32x4){0.f, 0.f, 0.f, 0.f}; }
    if (NSAV & 1) {
    nsa_cmp_one(smem, st.qf[0][0], st.qf[0][1], qs + st.tl[0], i, gate[0][0], (f32x4*)(smem + NSA_Y) + tid, st.selm[0], lane);
    asm volatile("" ::: "memory");
    __builtin_amdgcn_sched_barrier(0);
    nsa_cmp_one(smem, st.qf[1][0], st.qf[1][1], qs + st.tl[1], i, gate[1][0], (f32x4*)(smem + NSA_Y) + 4 * NTHR + tid, st.selm[1], lane);
    __builtin_amdgcn_sched_barrier(0);
    }
    {
        unsigned u = st.selm[0] | st.selm[1];
        u |= __shfl_xor(u, 4); u |= __shfl_xor(u, 8);
        st.wunion = u;
        unsigned* misc = (unsigned*)(smem + NSA_MISC);
        if (lane == 0) misc[wid] = u;
        __syncthreads();
        unsigned bu = 0u;
#pragma unroll
        for (int w = 0; w < 8; ++w) bu |= misc[w];
        st.bunion = bu;
    }
    if (NSAV & 2) nsa_stream<0>(smem, Pb, g, i, st, gate[0][1], gate[1][1], tid);
    if (NSAV & 4) nsa_stream<1>(smem, Pb, g, i, st, gate[0][2], gate[1][2], tid);
    bf16_t* mix = (bf16_t*)(p.ws + WS_MIX) + (long)b * SEQ * 1024;
#pragma unroll
    for (int mt = 0; mt < 2; ++mt) {
        bf16_t* op = mix + (long)(qs + st.tl[mt]) * 1024 + g * 256 + (fr & 3) * 64 + fq * 4;
#pragma unroll
        for (int dt = 0; dt < 4; ++dt) {
            const f32x4 yv = *((const f32x4*)(smem + NSA_Y) + (mt * 4 + dt) * NTHR + tid);
            u32x2 w; w.x = pk_bf16(yv[0], yv[1]); w.y = pk_bf16(yv[2], yv[3]);
            *(u32x2*)(op + dt * 16) = w;
        }
    }
    __syncthreads();
}

constexpr int ML_PITCH = 288;
constexpr int ML_Q = 0, ML_K = 18432, ML_V = 36864, ML_VW = 55296, ML_C = 73728, ML_N = 110592, ML_GB = 111104, ML_GA = 119296, ML_GMQ = 127488,
              ML_GS = 135680, ML_ST = 136192;

__device__ __forceinline__ float wave_incl_scan_add(float v, int lane) {
#pragma unroll
    for (int off = 1; off < 64; off <<= 1) { const float o = __shfl_up(v, off); if (lane >= off) v += o; }
    return v;
}
__device__ __forceinline__ float wave_incl_scan_max(float v, int lane) {
#pragma unroll
    for (int off = 1; off < 64; off <<= 1) { const float o = __shfl_up(v, off); if (lane >= off) v = fmaxf(v, o); }
    return v;
}
__device__ __forceinline__ float wave_max(float v) {
#pragma unroll
    for (int off = 32; off >= 1; off >>= 1) v = fmaxf(v, __shfl_xor(v, off));
    return v;
}

__device__ __forceinline__ void mlstm_scan(const Params& p, char* smem, int b, int h) {
    const char* ws = p.ws;
    int tid = threadIdx.x;
    asm volatile("" : "+v"(tid));
    const int lane = tid & 63, wid = __builtin_amdgcn_readfirstlane(tid >> 6), fr = lane & 15, fq = lane >> 4;
    const bf16_t* QK = (const bf16_t*)(ws + WS_QK) + (long)b * SEQ * 1024 + h * 128;
    const bf16_t* Pb = (const bf16_t*)(ws + WS_P) + (long)b * SEQ * PW;
    const float* psm = (const float*)(ws + WS_PSM) + (long)b * SEQ * 32;
    bf16_t* mix = (bf16_t*)(p.ws + WS_MIX) + (long)b * SEQ * 1024 + 512 + h * 128;
    float* GB = (float*)(smem + ML_GB); float* GA = (float*)(smem + ML_GA); float* GMQ = (float*)(smem + ML_GMQ);
    float* GS = (float*)(smem + ML_GS);
    float* NV = (float*)(smem + ML_N);
    float* ST = (float*)(smem + ML_ST);
    {
        const float ib = p.in[I_IBIAS][h], fb = p.in[I_FBIAS][h];
        for (int c = wid; c < 32; c += 8) {
            const int t = c * 64 + lane;
            const float ipre = psm[(long)t * 32 + 24 + h], fpre = psm[(long)t * 32 + 28 + h];
            const float li = ipre + ib;
            const float x = fpre + fb;
            const float lf = fminf(x, 0.f) - log1pf(__expf(-fabsf(x)));
            const float bb = wave_incl_scan_add(lf, lane);
            const float aa = li - bb;
            const float g = __shfl(bb, 63);
            const float pm = wave_incl_scan_max(aa, lane);
            const float mloc = wave_max(g + aa);
            GB[t] = bb; GA[t] = aa; GMQ[t] = pm;
            if (lane == 0) { GS[64 + c] = g; GS[96 + c] = mloc; }
        }
    }
    for (int e = tid; e < 36864 / 16; e += NTHR) *(u32x4*)(smem + ML_C + e * 16) = (u32x4){0u, 0u, 0u, 0u};
    if (tid < 128) NV[tid] = 0.f;
    __syncthreads();
    if (tid == 0) {
        float m = 0.f;
        for (int c = 0; c < 32; ++c) { GS[c] = m; const float mn = fmaxf(GS[64 + c] + m, GS[96 + c]); GS[32 + c] = mn; m = mn; }
    }
    __syncthreads();
    for (int t = tid; t < SEQ; t += NTHR) GMQ[t] = GB[t] + fmaxf(GS[t >> 6], GMQ[t]);
    __syncthreads();

    f32x4 Cacc[9];
#pragma unroll
    for (int c9 = 0; c9 < 9; ++c9) Cacc[c9] = (f32x4){0.f, 0.f, 0.f, 0.f};
    const int lrow = tid >> 4, lch = tid & 15;
    u32x4 rq[2], rk[2], rv[2];
#pragma unroll
    for (int i2 = 0; i2 < 2; ++i2) {
        const int row = lrow + 32 * i2;
        rq[i2] = *(const u32x4*)(QK + (long)row * 1024 + lch * 8);
        rk[i2] = *(const u32x4*)(QK + (long)row * 1024 + 512 + lch * 8);
        rv[i2] = *(const u32x4*)(Pb + (long)row * PW + PC_MV + h * 128 + lch * 8);
    }
    const int mt = wid >> 1, half = wid & 1;
#pragma unroll 1
    for (int c = 0; c < 32; ++c) {
        const float m_old = GS[c], m_new = GS[32 + c], gch = GS[64 + c];
#pragma unroll
        for (int i2 = 0; i2 < 2; ++i2) {
            const int row = lrow + 32 * i2;
            *(u32x4*)(smem + ML_Q + row * ML_PITCH + lch * 16) = rq[i2];
            *(u32x4*)(smem + ML_K + row * ML_PITCH + lch * 16) = rk[i2];
            *(u32x4*)(smem + ML_V + row * ML_PITCH + lch * 16) = rv[i2];
            const float wk = __expf(gch + GA[c * 64 + row] - m_new);
            u32x4 w;
            w.x = pk_bf16(bf_lo(rv[i2].x) * wk, bf_hi(rv[i2].x) * wk); w.y = pk_bf16(bf_lo(rv[i2].y) * wk, bf_hi(rv[i2].y) * wk);
            w.z = pk_bf16(bf_lo(rv[i2].z) * wk, bf_hi(rv[i2].z) * wk); w.w = pk_bf16(bf_lo(rv[i2].w) * wk, bf_hi(rv[i2].w) * wk);
            *(u32x4*)(smem + ML_VW + row * ML_PITCH + lch * 16) = w;
        }
        if (tid < 128) {
            const int row = tid >> 1, hf = tid & 1;
            const float wk = __expf(gch + GA[c * 64 + row] - m_new);
            u32x4 w = (u32x4){0u, 0u, 0u, 0u};
            if (hf == 0) w.x = pk_bf16(wk, 0.f);
            *(u32x4*)(smem + ML_VW + row * ML_PITCH + 256 + hf * 16) = w;
        }
        __syncthreads();
        if (c + 1 < 32) {
#pragma unroll
            for (int i2 = 0; i2 < 2; ++i2) {
                const int row = (c + 1) * 64 + lrow + 32 * i2;
                rq[i2] = *(const u32x4*)(QK + (long)row * 1024 + lch * 8);
                rk[i2] = *(const u32x4*)(QK + (long)row * 1024 + 512 + lch * 8);
                rv[i2] = *(const u32x4*)(Pb + (long)row * PW + PC_MV + h * 128 + lch * 8);
            }
        }
        const int l = 16 * mt + fr;
        const float bl = GB[c * 64 + l], mq = GMQ[c * 64 + l];
        const float ul = bl - mq;
        f32x4 hv[4];
        float s1 = 0.f, s2 = 0.f;
        {
            bf16x8 qf[4];
#pragma unroll
            for (int ks = 0; ks < 4; ++ks) qf[ks] = *(const bf16x8*)(smem + ML_Q + l * ML_PITCH + (ks * 4 + fq) * 16);
            f32x4 S[4];
#pragma unroll
            for (int nt = 0; nt < 4; ++nt) {
                f32x4 s = (f32x4){0.f, 0.f, 0.f, 0.f};
#pragma unroll
                for (int ks = 0; ks < 4; ++ks) {
                    const bf16x8 kf = *(const bf16x8*)(smem + ML_K + (16 * nt + fr) * ML_PITCH + (ks * 4 + fq) * 16);
                    s = mfma16(kf, qf[ks], s);
                }
                S[nt] = s;
            }
            float dintra = 0.f;
            const int lq = l - 4 * fq;
#pragma unroll
            for (int nt = 0; nt < 4; ++nt) {
                const f32x4 av = *(const f32x4*)(GA + c * 64 + 16 * nt + 4 * fq);
#pragma unroll
                for (int e = 0; e < 4; ++e) {
                    const float w = (16 * nt + e <= lq) ? __expf(ul + av[e]) : 0.f;
                    const float sv = S[nt][e] * w;
                    S[nt][e] = sv; dintra += sv;
                }
            }
            dintra += __shfl_xor(dintra, 16); dintra += __shfl_xor(dintra, 32);
            float dinter = 0.f;
#pragma unroll
            for (int ks = 0; ks < 4; ++ks) {
                const f32x4 n0 = *(const f32x4*)(NV + ks * 32 + fq * 8), n1 = *(const f32x4*)(NV + ks * 32 + fq * 8 + 4);
                const u32x4 qu = __builtin_bit_cast(u32x4, qf[ks]);
                dinter += bf_lo(qu.x) * n0[0] + bf_hi(qu.x) * n0[1] + bf_lo(qu.y) * n0[2] + bf_hi(qu.y) * n0[3]
                        + bf_lo(qu.z) * n1[0] + bf_hi(qu.z) * n1[1] + bf_lo(qu.w) * n1[2] + bf_hi(qu.w) * n1[3];
            }
            dinter += __shfl_xor(dinter, 16); dinter += __shfl_xor(dinter, 32);
            const float winter = __expf(ul + m_old);
            const float den = winter * dinter + dintra;
            const float rden = 1.0f / fmaxf(fabsf(den), __expf(-mq));
            const bf16x8 pf0 = pack_p(S[0], S[1]), pf1 = pack_p(S[2], S[3]);
#pragma unroll
            for (int c4 = 0; c4 < 4; ++c4) {
                const int et = 4 * half + c4;
                f32x4 num = (f32x4){0.f, 0.f, 0.f, 0.f}, inter = (f32x4){0.f, 0.f, 0.f, 0.f};
                num = mfma16(tr_frag_perm(smem + ML_V, ML_PITCH, 0, 16 * et, fr, fq), pf0, num);
                num = mfma16(tr_frag_perm(smem + ML_V, ML_PITCH, 32, 16 * et, fr, fq), pf1, num);
#pragma unroll
                for (int ks = 0; ks < 4; ++ks) {
                    const bf16x8 cf = *(const bf16x8*)(smem + ML_C + (16 * et + fr) * ML_PITCH + (ks * 4 + fq) * 16);
                    inter = mfma16(cf, qf[ks], inter);
                }
                const f32x4 hh = (inter * winter + num) * rden;
                hv[c4] = hh;
                s1 += (hh[0] + hh[1]) + (hh[2] + hh[3]);
                s2 += (hh[0] * hh[0] + hh[1] * hh[1]) + (hh[2] * hh[2] + hh[3] * hh[3]);
            }
            s1 += __shfl_xor(s1, 16); s1 += __shfl_xor(s1, 32);
            s2 += __shfl_xor(s2, 16); s2 += __shfl_xor(s2, 32);
            if (fq == 0) { ST[(l * 2 + half) * 2] = s1; ST[(l * 2 + half) * 2 + 1] = s2; }
        }
        {
            const float decay = __expf(gch + m_old - m_new);
#pragma unroll
            for (int c9 = 0; c9 < 9; ++c9) Cacc[c9] = Cacc[c9] * decay;
#pragma unroll
            for (int ks2 = 0; ks2 < 2; ++ks2) {
                const bf16x8 kt = tr_frag_std(smem + ML_K, ML_PITCH, 32 * ks2, 16 * wid, fr, fq);
#pragma unroll
                for (int c9 = 0; c9 < 9; ++c9) {
                    const bf16x8 vw = tr_frag_std(smem + ML_VW, ML_PITCH, 32 * ks2, 16 * c9, fr, fq);
                    Cacc[c9] = mfma16(kt, vw, Cacc[c9]);
                }
            }
        }
        __syncthreads();
        {
            const float* sp = ST + l * 4;
            const float t1 = sp[0] + sp[2], t2 = sp[1] + sp[3];
            const float mean = t1 * (1.0f / 128.0f);
            const float var = fmaxf(t2 * (1.0f / 128.0f) - mean * mean, 0.f);
            const float rstd = rsqrtf(var + LN_EPS);
            const long tok = c * 64 + l;
#pragma unroll
            for (int c4 = 0; c4 < 4; ++c4) {
                const int col = 64 * half + 16 * c4 + 4 * fq;
                const u32x2 ou = *(const u32x2*)(Pb + tok * PW + PC_MO + h * 128 + col);
                const f32x4 ng = *(const f32x4*)(p.in[I_NORMG] + h * 128 + col);
                const f32x4 y = (hv[c4] - mean) * rstd * ng;
                u32x2 w;
                w.x = pk_bf16(y[0] * sigmoidf_(bf_lo(ou.x)), y[1] * sigmoidf_(bf_hi(ou.x)));
                w.y = pk_bf16(y[2] * sigmoidf_(bf_lo(ou.y)), y[3] * sigmoidf_(bf_hi(ou.y)));
                *(u32x2*)(mix + tok * 1024 + col) = w;
            }
        }
#pragma unroll
        for (int c9 = 0; c9 < 8; ++c9) {
            u32x2 w; w.x = pk_bf16(Cacc[c9][0], Cacc[c9][1]); w.y = pk_bf16(Cacc[c9][2], Cacc[c9][3]);
            *(u32x2*)(smem + ML_C + (16 * c9 + fr) * ML_PITCH + (16 * wid + 4 * fq) * 2) = w;
        }
        if (fr == 0) *(f32x4*)(NV + 16 * wid + 4 * fq) = Cacc[8];
        __syncthreads();
    }
}


constexpr float W8_SCALE = 64.0f, H8_SCALE = 16.0f, Y8_SCALE = 64.0f;
constexpr int CV_PITCH = 144;
__device__ __forceinline__ void wconv_task(const Params& p, char* smem, int which, int e, int nt) {
    const int tid = opaque_tid();
    const int ng = tid & 63, kg = tid >> 6, n0 = 4 * ng;
    const float* src; int ld, K; unsigned char* dst;
    if (which == 0) {
        const int col = 128 * nt + 32 * (n0 >> 6) + 8 * ((n0 >> 2) & 3) + 4 * ((n0 >> 5) & 1);
        src = (((n0 >> 4) & 1) ? p.in[I_MW3] : p.in[I_MW1]) + (long)e * 1024 * 256 + col; ld = 256; K = 1024;
        dst = (unsigned char*)p.out + ((long)(e * 2 + nt) * 256) * 1024;
    } else {
        src = p.in[I_MW2] + (long)e * 256 * 1024 + nt * 256 + bperm(n0); ld = 1024; K = 256;
        dst = (unsigned char*)(p.ws + WS_W2F8) + ((long)(e * 4 + nt) * 256) * 256;
    }
    for (int kc = 0; kc < K / 128; ++kc) {
        f32x4 v[16];
#pragma unroll
        for (int j = 0; j < 16; ++j) v[j] = *(const f32x4*)(src + (long)(kc * 128 + kg * 16 + j) * ld);
#pragma unroll
        for (int cc = 0; cc < 4; ++cc) {
            u32x4 w;
            w.x = pk4_fp8(v[0][cc] * W8_SCALE, v[1][cc] * W8_SCALE, v[2][cc] * W8_SCALE, v[3][cc] * W8_SCALE);
            w.y = pk4_fp8(v[4][cc] * W8_SCALE, v[5][cc] * W8_SCALE, v[6][cc] * W8_SCALE, v[7][cc] * W8_SCALE);
            w.z = pk4_fp8(v[8][cc] * W8_SCALE, v[9][cc] * W8_SCALE, v[10][cc] * W8_SCALE, v[11][cc] * W8_SCALE);
            w.w = pk4_fp8(v[12][cc] * W8_SCALE, v[13][cc] * W8_SCALE, v[14][cc] * W8_SCALE, v[15][cc] * W8_SCALE);
            *(u32x4*)(smem + (n0 + cc) * CV_PITCH + kg * 16) = w;
        }
        __syncthreads();
#pragma unroll
        for (int i = 0; i < 4; ++i) {
            const int piece = tid + i * NTHR, row = piece >> 3, ch = piece & 7;
            *(u32x4*)(dst + (long)row * K + kc * 128 + ch * 16) = *(const u32x4*)(smem + row * CV_PITCH + ch * 16);
        }
        __syncthreads();
    }
}

template <int PARTS = 7  , int NSAV = 7>
__device__ __forceinline__ void phase3(const Params& p, char* smem, int bid, int nb, int rep = 0) {
    XcdSlab xs; xs.init(bid, nb);
    const int nq = xs.x >= 0 ? 320 : 1024 + 1536;
    int* qctr = (int*)(p.ws + WS_CNT) + 16384 + ((xs.x >= 0 ? xs.x : 0) + 8 * rep) * 32;
    if (PARTS & 1) for (int u = bid; u < 64; u += nb) mlstm_scan(p, smem, u >> 2, u & 3);
    if (!(PARTS & 2)) return;
    volatile int* slot = (volatile int*)(smem + NSA_MISC + 256);
    for (;;) {
        if (opaque_tid() == 0) *slot = atomicAdd(qctr, 1);
        __syncthreads();
        const int k = __builtin_amdgcn_readfirstlane(*slot);
        if (k >= nq) break;
        if (xs.x >= 0) {
            const int r5 = k % 5, q5 = k / 5;
            if (r5 < 2) { const int kk = q5 * 2 + r5; const int bg = 4 * xs.x + (kk & 3); nsa_task<NSAV>(p, smem, bg >> 1, bg & 1, 31 - (kk >> 2)); }
            else if (PARTS & 4) { const int cv = q5 * 3 + (r5 - 2); const int e = xs.x + 8 * (cv / 6), t6 = cv % 6; wconv_task(p, smem, t6 < 2 ? 0 : 1, e, t6 < 2 ? t6 : t6 - 2); }
        } else if (k < 1024) nsa_task<NSAV>(p, smem, (k & 31) >> 1, k & 1, 31 - (k >> 5));
        else if (PARTS & 4) { const int cv = k - 1024; const int e = cv / 6, t6 = cv % 6; wconv_task(p, smem, t6 < 2 ? 0 : 1, e, t6 < 2 ? t6 : t6 - 2); }
    }
}

constexpr int XA_PITCH = 544;
constexpr int XA_K = 0, XA_V = 69632;
__device__ __forceinline__ void xattn_task(const Params& p, char* smem, int b, int h, int qb) {
    const char* ws = p.ws;
    int tid = threadIdx.x;
    asm volatile("" : "+v"(tid));
    const int lane = tid & 63, wid = __builtin_amdgcn_readfirstlane(tid >> 6), fr = lane & 15, fq = lane >> 4;
    const bf16_t* XQ = (const bf16_t*)(ws + WS_XQ) + (long)(b * SEQ + qb * 128 + wid * 16 + fr) * 1024 + h * 256 + fq * 8;
    const bf16_t* KV = (const bf16_t*)(ws + WS_KVX) + (long)b * 256 * 2048 + h * 256;
    bf16x8 qf[8];
#pragma unroll
    for (int ks = 0; ks < 8; ++ks) qf[ks] = *(const bf16x8*)(XQ + ks * 32);
    f32x4 O[16];
#pragma unroll
    for (int dt = 0; dt < 16; ++dt) O[dt] = (f32x4){0.f, 0.f, 0.f, 0.f};
    float m = -1e30f, l = 0.f;
    const int lrow = tid >> 5, lch = tid & 31;
    u32x4 rk[4], rv[4];
#pragma unroll
    for (int i2 = 0; i2 < 4; ++i2) {
        const bf16_t* rp = KV + (long)(lrow + 16 * i2) * 2048 + lch * 8;
        rk[i2] = *(const u32x4*)rp; rv[i2] = *(const u32x4*)(rp + 1024);
    }
#pragma unroll
    for (int i2 = 0; i2 < 4; ++i2) {
        *(u32x4*)(smem + XA_K + (lrow + 16 * i2) * XA_PITCH + lch * 16) = rk[i2];
        *(u32x4*)(smem + XA_V + (lrow + 16 * i2) * XA_PITCH + lch * 16) = rv[i2];
    }
    __syncthreads();
#pragma unroll 1
    for (int j = 0; j < 4; ++j) {
        const int buf = j & 1;
        if (j + 1 < 4) {
#pragma unroll
            for (int i2 = 0; i2 < 4; ++i2) {
                const bf16_t* rp = KV + (long)((j + 1) * 64 + lrow + 16 * i2) * 2048 + lch * 8;
                rk[i2] = *(const u32x4*)rp; rv[i2] = *(const u32x4*)(rp + 1024);
            }
        }
        const char* KT = smem + XA_K + buf * 34816;
        const char* VT = smem + XA_V + buf * 34816;
        f32x4 S[4];
#pragma unroll
        for (int nt = 0; nt < 4; ++nt) {
            f32x4 s = (f32x4){0.f, 0.f, 0.f, 0.f};
#pragma unroll
            for (int ks = 0; ks < 8; ++ks) {
                const bf16x8 kf = *(const bf16x8*)(KT + (16 * nt + fr) * XA_PITCH + (ks * 4 + fq) * 16);
                s = mfma16(kf, qf[ks], s);
            }
            S[nt] = s * 0.0625f;
        }
        float mx = -INFINITY;
#pragma unroll
        for (int nt = 0; nt < 4; ++nt)
#pragma unroll
            for (int e = 0; e < 4; ++e) mx = fmaxf(mx, S[nt][e]);
        mx = fmaxf(mx, __shfl_xor(mx, 16)); mx = fmaxf(mx, __shfl_xor(mx, 32));
        const float mnew = fmaxf(m, mx);
        const float alpha = __expf(m - mnew);
        float rs = 0.f;
#pragma unroll
        for (int nt = 0; nt < 4; ++nt)
#pragma unroll
            for (int e = 0; e < 4; ++e) { const float pv = __expf(S[nt][e] - mnew); S[nt][e] = pv; rs += pv; }
        rs += __shfl_xor(rs, 16); rs += __shfl_xor(rs, 32);
        l = l * alpha + rs; m = mnew;
#pragma unroll
        for (int dt = 0; dt < 16; ++dt) O[dt] = O[dt] * alpha;
        const bf16x8 pf0 = pack_p(S[0], S[1]), pf1 = pack_p(S[2], S[3]);
#pragma unroll
        for (int dt = 0; dt < 16; ++dt) {
            O[dt] = mfma16(tr_frag_perm(VT, XA_PITCH, 0, 16 * dt, fr, fq), pf0, O[dt]);
            O[dt] = mfma16(tr_frag_perm(VT, XA_PITCH, 32, 16 * dt, fr, fq), pf1, O[dt]);
        }
        if (j + 1 < 4) {
            char* KTn = smem + XA_K + (buf ^ 1) * 34816; char* VTn = smem + XA_V + (buf ^ 1) * 34816;
#pragma unroll
            for (int i2 = 0; i2 < 4; ++i2) {
                *(u32x4*)(KTn + (lrow + 16 * i2) * XA_PITCH + lch * 16) = rk[i2];
                *(u32x4*)(VTn + (lrow + 16 * i2) * XA_PITCH + lch * 16) = rv[i2];
            }
        }
        __syncthreads();
    }
    const float inv = 1.0f / l;
    bf16_t* op = (bf16_t*)(p.ws + WS_XO) + (long)(b * SEQ + qb * 128 + wid * 16 + fr) * 1024 + h * 256 + fq * 4;
#pragma unroll
    for (int dt = 0; dt < 16; ++dt) {
        u32x2 w; w.x = pk_bf16(O[dt][0] * inv, O[dt][1] * inv); w.y = pk_bf16(O[dt][2] * inv, O[dt][3] * inv);
        *(u32x2*)(op + dt * 16) = w;
    }
}

__device__ __forceinline__ void phase6(const Params& p, char* smem, int bid, int nb) {
    XcdSlab xs; xs.init(bid, nb);
    const int p_lo = xs.m_lo(64), n_t = (xs.m_hi(64) - p_lo) * 16;
    for (int u = xs.j; u < n_t; u += xs.stride) { const int pr = p_lo + (u >> 4); xattn_task(p, smem, pr >> 2, pr & 3, u & 15); }
}

constexpr int LN_ST = 139264, LN_GB = 141312, MOE_TAB = 153600;

__device__ __forceinline__ void phase4(const Params& p, char* smem, int bid, int nb) {
    char* ws = p.ws;
    XcdSlab xs; xs.init(bid, nb);
    const int m_lo = xs.m_lo(128), n_t = (xs.m_hi(128) - m_lo) * 4;
    for (int u = xs.j; u < n_t; u += xs.stride) {
        const int mt = m_lo + (u >> 2), nt = u & 3;
        RingRows al, bl;
        al.init_contig((const bf16_t*)(ws + WS_MIX), 1024, mt * 256);
        bl.init_contig((const bf16_t*)(ws + WS_WOUT), 1024, nt * 256, true);
        f32x4 acc[8][4];
        gemm_ring(smem, al, bl, 32, acc);
        epi_residual<false>(acc, smem, p.in[I_X], nullptr, nullptr, nullptr, nullptr, (bf16_t*)(ws + WS_R1B), (float*)(ws + WS_ST1), mt * 256, nt);
    }
}

__device__ __forceinline__ void phase5(const Params& p, char* smem, int bid, int nb) {
    char* ws = p.ws;
    const float* lnf = (const float*)(ws + WS_LNF);
    XcdSlab xs; xs.init(bid, nb);
    const int m_lo = xs.m_lo(128), n_t = (xs.m_hi(128) - m_lo) * 4;
    for (int u = xs.j; u < n_t; u += xs.stride) {
        const int mt = m_lo + (u >> 2), nt = u & 3;
        RingRows al, bl;
        al.init_contig((const bf16_t*)(ws + WS_R1B), 1024, mt * 256);
        bl.init_contig((const bf16_t*)(ws + WS_WQ), 1024, nt * 256, true);
        f32x4 acc[8][4];
        gemm_ring(smem, al, bl, 32, acc);
        ln_correct<0>(acc, (const float*)(ws + WS_ST1), mt * 256, lnf, lnf + 1792, nt);
        epi_store_bf16(acc, (bf16_t*)(ws + WS_XQ), 1024, mt * 256, nt * 256);
    }
}

__device__ __forceinline__ void phase7(const Params& p, char* smem, int bid, int nb) {
    char* ws = p.ws;
    XcdSlab xs; xs.init(bid, nb);
    const int m_lo = xs.m_lo(128), n_t = (xs.m_hi(128) - m_lo) * 4;
    for (int u = xs.j; u < n_t; u += xs.stride) {
        const int mt = m_lo + (u >> 2), nt = u & 3;
        RingRows al, bl;
        al.init_contig((const bf16_t*)(ws + WS_XO), 1024, mt * 256);
        bl.init_contig((const bf16_t*)(ws + WS_WO), 1024, nt * 256, true);
        f32x4 acc[8][4];
        gemm_ring(smem, al, bl, 32, acc);
        epi_residual<true>(acc, smem, nullptr, (const bf16_t*)(ws + WS_R1B), (const float*)(ws + WS_ST1), p.in[I_LN1G], p.in[I_LN1B],
                           (bf16_t*)(ws + WS_R2B), (float*)(ws + WS_ST2), mt * 256, nt);
    }
}

template <class RowMap>
__device__ __forceinline__ void epi_swiglu(const f32x4 (&acc)[8][4], bf16_t* out, int ld, int nt, const RowMap& rm) {
    const int tid_ = opaque_tid();
    const int lane = tid_ & 63, wid = tid_ >> 6;
    const int wr = wid >> 2, wc = wid & 3, fr = lane & 15, fq = lane >> 4;
#pragma unroll
    for (int mi = 0; mi < 8; ++mi) {
        const long orow = rm(wr * 128 + mi * 16 + fr);
        if (orow >= 0) {
            const f32x4 a0 = acc[mi][0], b0 = acc[mi][1], a1 = acc[mi][2], b1 = acc[mi][3];
            u32x4 w;
            w.x = pk_bf16(siluf_(a0[0]) * b0[0], siluf_(a0[1]) * b0[1]); w.y = pk_bf16(siluf_(a0[2]) * b0[2], siluf_(a0[3]) * b0[3]);
            w.z = pk_bf16(siluf_(a1[0]) * b1[0], siluf_(a1[1]) * b1[1]); w.w = pk_bf16(siluf_(a1[2]) * b1[2], siluf_(a1[3]) * b1[3]);
            *(u32x4*)(out + orow * ld + nt * 128 + wc * 32 + fq * 8) = w;
        }
    }
}
struct RowIdent { long row0; __device__ __forceinline__ long operator()(int rl) const { return row0 + rl; } };

__device__ __forceinline__ unsigned dpp_xor1_u(unsigned v) { return (unsigned)__builtin_amdgcn_mov_dpp((int)v, 0xB1, 0xF, 0xF, true); }
__device__ __forceinline__ void route_tile(const Params& p, char* smem, int tok0, int rep) {
    char* ws = p.ws;
    const float* bias = p.in[I_ROUTB];
    const int tid = opaque_tid(), tk = tid >> 1, hf = tid & 1;
    const float* row = (const float*)(ws + WS_RSC) + (long)(tok0 + tk) * 256;
    unsigned key[128];
    float gs[4];
    {
        float v[128];
#pragma unroll
        for (int i = 0; i < 32; ++i) { const f32x4 t = *(const f32x4*)(row + hf * 128 + i * 4); v[4 * i] = t[0]; v[4 * i + 1] = t[1]; v[4 * i + 2] = t[2]; v[4 * i + 3] = t[3]; }
#pragma unroll
        for (int gi = 0; gi < 4; ++gi) {
            float m1 = -INFINITY, m2 = -INFINITY;
#pragma unroll
            for (int i = 0; i < 32; ++i) { const float x = v[32 * gi + i]; m2 = __builtin_fmaxf(m2, __builtin_fminf(m1, x)); m1 = __builtin_fmaxf(m1, x); }
            gs[gi] = m1 + m2;
        }
        float g8[8];
#pragma unroll
        for (int gi = 0; gi < 4; ++gi) { const float o = dpp_xor1(gs[gi]); g8[gi] = hf ? o : gs[gi]; g8[4 + gi] = hf ? gs[gi] : o; }
        unsigned gsel = 0u;
#pragma unroll
        for (int a = 0; a < 8; ++a) {
            int rank = 0;
#pragma unroll
            for (int b = 0; b < 8; ++b) rank += (g8[b] > g8[a] || (g8[b] == g8[a] && b < a)) ? 1 : 0;
            if (rank < 4) gsel |= 1u << a;
        }
#pragma unroll
        for (int gi = 0; gi < 4; ++gi) {
            const bool on = ((gsel >> (4 * hf + gi)) & 1u) != 0u;
#pragma unroll
            for (int i = 0; i < 32; ++i) {
                const unsigned kb = (__float_as_uint(v[32 * gi + i] + 1.0f) & ~0xFFu) | (unsigned)(255 - (128 * hf + 32 * gi + i));
                key[32 * gi + i] = on ? kb : 0u;
            }
        }
    }
    unsigned win[8];
    unsigned prev = 0xFFFFFFFFu;
#pragma unroll
    for (int r = 0; r < 8; ++r) {
        unsigned m = 0u;
#pragma unroll
        for (int i = 0; i < 128; ++i) { const unsigned kk = key[i]; const unsigned c = kk < prev ? kk : 0u; m = m > c ? m : c; }
        const unsigned o = dpp_xor1_u(m);
        m = m > o ? m : o;
        prev = m;
        win[r] = m;
    }
    float sc8[8]; float wsum = 0.f;
#pragma unroll
    for (int r = 0; r < 8; ++r) { const int e = 255 - (int)(win[r] & 255u); sc8[r] = row[e] - bias[e]; wsum += sc8[r]; }
    int* lc = (int*)(smem + MOE_TAB); int* gbase = lc + 256;
    if (tid < 256) lc[tid] = 0;
    __syncthreads();
    int mye[4], myr[4];
    const unsigned hmask = 0u - (unsigned)hf;
#pragma unroll
    for (int u = 0; u < 4; ++u) {
        const unsigned w = win[u] ^ ((win[u] ^ win[4 + u]) & hmask);
        mye[u] = 255 - (int)(w & 255u); myr[u] = atomicAdd(lc + mye[u], 1);
    }
    __syncthreads();
    if (tid < 256) { const int n = lc[tid]; if (n > 0) gbase[tid] = atomicAdd((int*)(ws + WS_CNT) + 8192 * rep + tid * 32, n); }
    __syncthreads();
    {
        const long t = tok0 + tk;
        const float wn = 2.5f / wsum;
#pragma unroll
        for (int u = 0; u < 4; ++u) {
            const int k = 4 * hf + u;
            const int e = mye[u];
            const unsigned s0 = __float_as_uint(sc8[u]), s1 = __float_as_uint(sc8[4 + u]);
            const float w = __uint_as_float(s0 ^ ((s0 ^ s1) & hmask)) * wn;
            const int pos = gbase[e] + myr[u];
            ((int*)(ws + WS_SELE))[t * 8 + k] = e;
            ((int*)(ws + WS_SELP))[t * 8 + k] = pos;
            ((float*)(ws + WS_SELW))[t * 8 + k] = w;
            ((int*)(ws + WS_TOKL))[(long)e * LIST_CAP + pos] = (int)t;
            ((float*)(ws + WS_WL))[(long)e * LIST_CAP + pos] = w;
        }
    }
    __syncthreads();
}

__device__ __forceinline__ void phase8(const Params& p, char* smem, int bid, int nb, int rep = 0) {
    char* ws = p.ws;
    const float* lnf = (const float*)(ws + WS_LNF);
    XcdSlab xs; xs.init(bid, nb);
    const int m_lo = xs.m_lo(128), m_n = xs.m_hi(128) - m_lo;
    for (int u = xs.j; u < m_n; u += xs.stride) {
        const int mt = m_lo + u;
        float* gsc = (float*)(ws + WS_RSC);
        {
            RingRows al, bl;
            al.init_contig((const bf16_t*)(ws + WS_R2B), 1024, mt * 256);
            bl.init_contig((const bf16_t*)(ws + WS_WR), 1024, 0, true);
            f32x4 acc[8][4];
            gemm_ring(smem, al, bl, 32, acc);
            ln_correct<0>(acc, (const float*)(ws + WS_ST2), mt * 256, lnf + 1024, lnf + 1792 + 1024, 0);
            const int tid_ = opaque_tid();
            const int lane = tid_ & 63, wid = tid_ >> 6;
            const int wr = wid >> 2, wc = wid & 3, fr = lane & 15, fq = lane >> 4;
            const float* bias = p.in[I_ROUTB];
#pragma unroll
            for (int ni = 0; ni < 4; ++ni) {
                const int col = wc * 64 + (ni >> 1) * 32 + fq * 8 + (ni & 1) * 4;
                const f32x4 bv = *(const f32x4*)(bias + col);
#pragma unroll
                for (int mi = 0; mi < 8; ++mi) {
                    f32x4 v;
#pragma unroll
                    for (int e = 0; e < 4; ++e) v[e] = sigmoidf_(acc[mi][ni][e]) + bv[e];
                    *(f32x4*)(gsc + (long)(mt * 256 + wr * 128 + mi * 16 + fr) * 256 + col) = v;
                }
            }
        }
        __syncthreads();
        route_tile(p, smem, mt * 256, rep);
    }
    for (int u = (xs.j + xs.stride - m_n % xs.stride) % xs.stride; u < m_n * 2; u += xs.stride) {
        const int mt = m_lo + (u >> 1), nt = u & 1;
        RingRows al, bl;
        al.init_contig((const bf16_t*)(ws + WS_R2B), 1024, mt * 256);
        bl.init_contig((const bf16_t*)(ws + WS_WS13), 1024, nt * 256);
        f32x4 acc[8][4];
        gemm_ring(smem, al, bl, 32, acc);
        ln_correct<1>(acc, (const float*)(ws + WS_ST2), mt * 256, lnf + 1280, lnf + 1792 + 1280, nt);
        RowIdent rm; rm.row0 = (long)mt * 256;
        epi_swiglu(acc, (bf16_t*)(ws + WS_HS), 256, nt, rm);
    }
    {
        const int tid = opaque_tid(), lane = tid & 63, wid = tid >> 6;
        const bf16_t* r2 = (const bf16_t*)(ws + WS_R2B); const float* st2 = (const float*)(ws + WS_ST2);
        unsigned char* x2 = (unsigned char*)(ws + WS_X2F8);
        for (int t = bid * 8 + wid; t < T_TOK; t += nb * 8) {
            const f32x4 p0 = *(const f32x4*)(st2 + (long)t * 8), p1 = *(const f32x4*)(st2 + (long)t * 8 + 4);
            const float q1 = (p0[0] + p0[2]) + (p1[0] + p1[2]), q2 = (p0[1] + p0[3]) + (p1[1] + p1[3]);
            const float mean = q1 * (1.0f / 1024.0f);
            const float rstd = rsqrtf(fmaxf(q2 * (1.0f / 1024.0f) - mean * mean, 0.f) + LN_EPS);
#pragma unroll
            for (int hseg = 0; hseg < 2; ++hseg) {
                const int col = hseg * 512 + lane * 8;
                const u32x4 ru = *(const u32x4*)(r2 + (long)t * 1024 + col);
                const f32x4 a0 = (f32x4){bf_lo(ru.x), bf_hi(ru.x), bf_lo(ru.y), bf_hi(ru.y)}, a1 = (f32x4){bf_lo(ru.z), bf_hi(ru.z), bf_lo(ru.w), bf_hi(ru.w)};
                const f32x4 g0 = *(const f32x4*)(p.in[I_LN2G] + col), g1 = *(const f32x4*)(p.in[I_LN2G] + col + 4);
                const f32x4 b0 = *(const f32x4*)(p.in[I_LN2B] + col), b1 = *(const f32x4*)(p.in[I_LN2B] + col + 4);
                const f32x4 y0 = (a0 - mean) * rstd * g0 + b0, y1 = (a1 - mean) * rstd * g1 + b1;
                u32x2 w; w.x = pk4_fp8(y0[0], y0[1], y0[2], y0[3]); w.y = pk4_fp8(y1[0], y1[1], y1[2], y1[3]);
                *(u32x2*)(x2 + (long)t * 1024 + col) = w;
            }
        }
    }
}

template <int XMODE>
__device__ __forceinline__ void phase_probe(const Params& p, char* smem, int bid, int nb) {
    char* ws = p.ws;
    XcdSlab xs; xs.init(bid, nb);
    const int m_lo = xs.m_lo(128), n_t = (xs.m_hi(128) - m_lo) * 4;
    for (int u = xs.j; u < n_t; u += xs.stride) {
        const int mt = m_lo + (u >> 2), nt = u & 3;
        RingRows al, bl;
        al.init_contig((const bf16_t*)(ws + WS_MIX), 1024, mt * 256);
        bl.init_contig((const bf16_t*)(ws + WS_WOUT), 1024, nt * 256, true);
        f32x4 acc[8][4];
        gemm_ring<RingRows, RingRows, XMODE>(smem, al, bl, 32, acc);
        epi_store_bf16(acc, (bf16_t*)(ws + WS_A + 432 * MB), 1024, mt * 256, nt * 256);
    }
}

__device__ __forceinline__ void moe_tables(const Params& p, char* smem, const XcdSlab& xs) {
    int* off = (int*)(smem + MOE_TAB); int* tst = off + 256; int* cntl = tst + 260;
    const int* cnt = (const int*)(p.ws + WS_CNT);
    const int tid = opaque_tid();
    if (tid >= 256) cntl[tid - 256] = cnt[(tid - 256) * 32];
    if (tid < 64) {
        int c[4], cs = 0;
#pragma unroll
        for (int k = 0; k < 4; ++k) { c[k] = cnt[(tid * 4 + k) * 32]; cs += c[k]; }
        int ics = cs;
#pragma unroll
        for (int o = 1; o < 64; o <<= 1) { const int a = __shfl_up(ics, o); if (tid >= o) ics += a; }
        int eo = ics - cs;
#pragma unroll
        for (int k = 0; k < 4; ++k) { off[tid * 4 + k] = eo; eo += c[k]; }
    } else if (tid < 128) {
        const int l = tid - 64;
        if (xs.x >= 0) {
            const int tl = l < 32 ? ((cnt[(xs.x + 8 * l) * 32] + 255) >> 8) : 0;
            int it = tl;
#pragma unroll
            for (int o = 1; o < 64; o <<= 1) { const int a = __shfl_up(it, o); if (l >= o) it += a; }
            if (l < 32) tst[l] = it - tl;
            if (l == 31) tst[32] = it;
        } else {
            int c[4], ts = 0;
#pragma unroll
            for (int k = 0; k < 4; ++k) { c[k] = (cnt[(l * 4 + k) * 32] + 255) >> 8; ts += c[k]; }
            int its = ts;
#pragma unroll
            for (int o = 1; o < 64; o <<= 1) { const int a = __shfl_up(its, o); if (l >= o) its += a; }
            int et = its - ts;
#pragma unroll
            for (int k = 0; k < 4; ++k) { tst[l * 4 + k] = et; et += c[k]; }
            if (l == 63) tst[256] = its;
        }
    }
    __syncthreads();
}
__device__ __forceinline__ int moe_find(const int* tst, int nloc, int t) {
    int lo = 0, hi = nloc - 1;
#pragma unroll 1
    while (lo < hi) { const int mid = (lo + hi + 1) >> 1; if (tst[mid] <= t) lo = mid; else hi = mid - 1; }
    return lo;
}
struct RowMoe { long base; int nvalid; __device__ __forceinline__ long operator()(int rl) const { return rl < nvalid ? base + rl : -1; } };

__device__ __forceinline__ void phase9(const Params& p, char* smem, int bid, int nb) {
    char* ws = p.ws;
    XcdSlab xs; xs.init(bid, nb);
    moe_tables(p, smem, xs);
    const int* off = (const int*)(smem + MOE_TAB); const int* tst = off + 256;
    const int* cnt = (const int*)(ws + WS_CNT);
    const int nloc = xs.x >= 0 ? 32 : 256;
    const int ntile = tst[nloc];
    {
        const int* cntl = tst + 260;
        const int nT = ntile * 2;
        int t = xs.j;
        int e = 0, m0 = 0, ne = 0, nt = 0;
        RingF8 al, bl;
        auto setup = [&](int tt) {
            const int et = tt >> 1; nt = tt & 1;
            const int kl = moe_find(tst, nloc, et); e = xs.x >= 0 ? xs.x + 8 * kl : kl; m0 = (et - tst[kl]) * 256; ne = cntl[e];
            const int tid = opaque_tid();
            const int* tl = (const int*)(ws + WS_TOKL) + (long)e * LIST_CAP;
            int rows[2];
#pragma unroll
            for (int i = 0; i < 2; ++i) { const int r = m0 + (tid >> 2) + 128 * i; rows[i] = r < ne ? tl[r] : 0; }
            al.init_rows((const unsigned char*)(ws + WS_X2F8), 1024, rows);
            bl.init_contig((const unsigned char*)p.out, 1024, (long)(e * 2 + nt) * 256);
        };
        if (t < nT) { setup(t); ring_f8_issue3(smem, al, bl); }
        while (t < nT) {
            const int ce = e, cm0 = m0, cne = ne, cnt_ = nt;
            f32x4 acc[8][4];
            gemm_ring_f8_main(smem, al, bl, 16, acc);
            t += xs.stride;
            if (t < nT) { setup(t); ring_f8_issue3(smem, al, bl); }
            {
                const int tid2 = opaque_tid();
                const int lane = tid2 & 63, wid = tid2 >> 6;
                const int wr = wid >> 2, wc = wid & 3, fr = lane & 15, fq = lane >> 4;
                unsigned char* H = (unsigned char*)(ws + WS_HF8) + ((long)off[ce] + cm0) * 256 + cnt_ * 128 + wc * 32 + fq * 8;
                constexpr float D = 1.0f / W8_SCALE, HS = H8_SCALE / W8_SCALE;
#pragma unroll
                for (int mi = 0; mi < 8; ++mi) {
                    const int rl = wr * 128 + mi * 16 + fr;
                    if (cm0 + rl < cne) {
                        const f32x4 a0 = acc[mi][0] * D, b0 = acc[mi][1] * HS, a1 = acc[mi][2] * D, b1 = acc[mi][3] * HS;
                        u32x2 w;
                        w.x = pk4_fp8(siluf_(a0[0]) * b0[0], siluf_(a0[1]) * b0[1], siluf_(a0[2]) * b0[2], siluf_(a0[3]) * b0[3]);
                        w.y = pk4_fp8(siluf_(a1[0]) * b1[0], siluf_(a1[1]) * b1[1], siluf_(a1[2]) * b1[2], siluf_(a1[3]) * b1[3]);
                        *(u32x2*)(H + (long)rl * 256) = w;
                    }
                }
            }
        }
        asm volatile("s_waitcnt vmcnt(0)" ::: "memory"); __syncthreads();
    }
    const int m_lo = xs.m_lo(128), n_t = (xs.m_hi(128) - m_lo) * 4;
    for (int u = (xs.j + xs.stride - (ntile * 2) % xs.stride) % xs.stride; u < n_t; u += xs.stride) {
        const int mt = m_lo + (u >> 2), nt = u & 3;
        RingRows al, bl;
        al.init_contig((const bf16_t*)(ws + WS_HS), 256, mt * 256);
        bl.init_contig((const bf16_t*)(ws + WS_WS2), 256, nt * 256, true);
        f32x4 acc[8][4];
        gemm_ring(smem, al, bl, 8, acc);
        __syncthreads();
        epi_store_bf16(acc, (bf16_t*)(ws + WS_SH), 1024, mt * 256, nt * 256);
    }
}

__device__ __forceinline__ void phase10(const Params& p, char* smem, int bid, int nb) {
    char* ws = p.ws;
    XcdSlab xs; xs.init(bid, nb);
    moe_tables(p, smem, xs);
    const int* off = (const int*)(smem + MOE_TAB); const int* tst = off + 256;
    const int* cnt = (const int*)(ws + WS_CNT);
    const int nloc = xs.x >= 0 ? 32 : 256;
    const int ntile = tst[nloc];
    {
        const int* cntl = tst + 260;
        const int nT = ntile * 4;
        int t = xs.j;
        int e = 0, m0 = 0, ne = 0, nt = 0;
        RingF8 al, bl;
        auto setup = [&](int tt) {
            const int et = tt >> 2; nt = tt & 3;
            const int kl = moe_find(tst, nloc, et); e = xs.x >= 0 ? xs.x + 8 * kl : kl; m0 = (et - tst[kl]) * 256; ne = cntl[e];
            al.init_contig((const unsigned char*)(ws + WS_HF8), 256, (long)off[e] + m0);
            bl.init_contig((const unsigned char*)(ws + WS_W2F8), 256, (long)(e * 4 + nt) * 256);
        };
        if (t < nT) { setup(t); ring_f8_issue3(smem, al, bl); }
        while (t < nT) {
            const int ce = e, cm0 = m0, cne = ne, cnt_ = nt;
            const int tid2 = opaque_tid();
            const int lane = tid2 & 63, wid = tid2 >> 6;
            const int wr = wid >> 2, wc = wid & 3, fr = lane & 15, fq = lane >> 4;
            f32x4 acc[8][4];
            gemm_ring_f8_main(smem, al, bl, 4, acc);
            t += xs.stride;
            if (t < nT) { setup(t); ring_f8_issue3(smem, al, bl); }
            {
                unsigned char* Y = (unsigned char*)(ws + WS_Y) + ((long)off[ce] + cm0) * 1024 + cnt_ * 256 + wc * 64 + fq * 8;
                const float* wl = (const float*)(ws + WS_WL) + (long)ce * LIST_CAP + cm0;
#pragma unroll
                for (int mi = 0; mi < 8; ++mi) {
                    const int rl = wr * 128 + mi * 16 + fr;
                    if (cm0 + rl < cne) {
                        const float w = wl[rl] * (Y8_SCALE / (W8_SCALE * H8_SCALE));
#pragma unroll
                        for (int q = 0; q < 2; ++q) {
                            const f32x4 u0 = acc[mi][2 * q] * w, u1 = acc[mi][2 * q + 1] * w;
                            u32x2 v; v.x = pk4_fp8(u0[0], u0[1], u0[2], u0[3]); v.y = pk4_fp8(u1[0], u1[1], u1[2], u1[3]);
                            *(u32x2*)(Y + (long)rl * 1024 + q * 32) = v;
                        }
                    }
                }
            }
        }
    }
}

__device__ __forceinline__ void phase11(const Params& p, char* smem, int bid, int nb) {
    char* ws = p.ws;
    XcdSlab xs; xs.init(bid, nb);
    moe_tables(p, smem, xs);
    const int* off = (const int*)(smem + MOE_TAB);
    const int tid = opaque_tid(), lane = tid & 63, wid = tid >> 6;
    const bf16_t* r2 = (const bf16_t*)(ws + WS_R2B);
    const float* st2 = (const float*)(ws + WS_ST2);
    const bf16_t* SH = (const bf16_t*)(ws + WS_SH);
    const unsigned char* Y = (const unsigned char*)(ws + WS_Y);
    const int* sele = (const int*)(ws + WS_SELE); const int* selp = (const int*)(ws + WS_SELP);
    for (int t = bid * 8 + wid; t < T_TOK; t += nb * 8) {
        const f32x4 p0 = *(const f32x4*)(st2 + (long)t * 8), p1 = *(const f32x4*)(st2 + (long)t * 8 + 4);
        const float q1 = (p0[0] + p0[2]) + (p1[0] + p1[2]), q2 = (p0[1] + p0[3]) + (p1[1] + p1[3]);
        const float mean2 = q1 * (1.0f / 1024.0f);
        const float rstd2 = rsqrtf(fmaxf(q2 * (1.0f / 1024.0f) - mean2 * mean2, 0.f) + LN_EPS);
        int yrow[8];
#pragma unroll
        for (int k = 0; k < 8; ++k) yrow[k] = off[sele[(long)t * 8 + k]] + selp[(long)t * 8 + k];
        float v[16];
#pragma unroll
        for (int hseg = 0; hseg < 2; ++hseg) {
            const int col = hseg * 512 + lane * 8;
            const u32x4 ru = *(const u32x4*)(r2 + (long)t * 1024 + col);
            const f32x4 a0 = (f32x4){bf_lo(ru.x), bf_hi(ru.x), bf_lo(ru.y), bf_hi(ru.y)}, a1 = (f32x4){bf_lo(ru.z), bf_hi(ru.z), bf_lo(ru.w), bf_hi(ru.w)};
            const f32x4 g0 = *(const f32x4*)(p.in[I_LN2G] + col), g1 = *(const f32x4*)(p.in[I_LN2G] + col + 4);
            const f32x4 b0 = *(const f32x4*)(p.in[I_LN2B] + col), b1 = *(const f32x4*)(p.in[I_LN2B] + col + 4);
            const f32x4 x0 = ((a0 - mean2) * rstd2 * g0 + b0) * ALPHA, x1 = ((a1 - mean2) * rstd2 * g1 + b1) * ALPHA;
            float* vv = v + hseg * 8;
            vv[0] = x0[0]; vv[1] = x0[1]; vv[2] = x0[2]; vv[3] = x0[3]; vv[4] = x1[0]; vv[5] = x1[1]; vv[6] = x1[2]; vv[7] = x1[3];
            const u32x4 s = *(const u32x4*)(SH + (long)t * 1024 + col);
            vv[0] += bf_lo(s.x); vv[1] += bf_hi(s.x); vv[2] += bf_lo(s.y); vv[3] += bf_hi(s.y); vv[4] += bf_lo(s.z); vv[5] += bf_hi(s.z); vv[6] += bf_lo(s.w); vv[7] += bf_hi(s.w);
            f32x2 ys[4];
#pragma unroll
            for (int e2 = 0; e2 < 4; ++e2) ys[e2] = (f32x2){0.f, 0.f};
#pragma unroll
            for (int k = 0; k < 8; ++k) {
                const u32x2 y = *(const u32x2*)(Y + (long)yrow[k] * 1024 + col);
                ys[0] += __builtin_amdgcn_cvt_pk_f32_fp8((int)y.x, false); ys[1] += __builtin_amdgcn_cvt_pk_f32_fp8((int)y.x, true);
                ys[2] += __builtin_amdgcn_cvt_pk_f32_fp8((int)y.y, false); ys[3] += __builtin_amdgcn_cvt_pk_f32_fp8((int)y.y, true);
            }
#pragma unroll
            for (int e2 = 0; e2 < 4; ++e2) { vv[2 * e2] += ys[e2][0] * (1.0f / Y8_SCALE); vv[2 * e2 + 1] += ys[e2][1] * (1.0f / Y8_SCALE); }
        }
        float s1 = 0.f;
#pragma unroll
        for (int i = 0; i < 16; ++i) s1 += v[i];
#pragma unroll
        for (int o = 32; o >= 1; o >>= 1) s1 += __shfl_xor(s1, o);
        const float mean = s1 * (1.0f / 1024.0f);
        float s2 = 0.f;
#pragma unroll
        for (int i = 0; i < 16; ++i) { const float d = v[i] - mean; s2 += d * d; }
#pragma unroll
        for (int o = 32; o >= 1; o >>= 1) s2 += __shfl_xor(s2, o);
        const float rstd = rsqrtf(s2 * (1.0f / 1024.0f) + LN_EPS);
#pragma unroll
        for (int hseg = 0; hseg < 2; ++hseg) {
            const int col = hseg * 512 + lane * 8;
            const f32x4 g0 = *(const f32x4*)(p.in[I_LN3G] + col), g1 = *(const f32x4*)(p.in[I_LN3G] + col + 4);
            const f32x4 b0 = *(const f32x4*)(p.in[I_LN3B] + col), b1 = *(const f32x4*)(p.in[I_LN3B] + col + 4);
            const float* vv = v + hseg * 8;
            f32x4 o0, o1;
#pragma unroll
            for (int e = 0; e < 4; ++e) { o0[e] = (vv[e] - mean) * rstd * g0[e] + b0[e]; o1[e] = (vv[4 + e] - mean) * rstd * g1[e] + b1[e]; }
            *(f32x4*)(p.out + (long)t * 1024 + col) = o0; *(f32x4*)(p.out + (long)t * 1024 + col + 4) = o1;
        }
    }
}

#if MEGA
#define XB_TMO      128
#define XB_XCNT(j)  (256  + 64 * (j))
#define XB_XSUB(j)  (1280 + 64 * (j))
#define XB_XGEN(j)  (2304 + 64 * (j))
#define XB_TOP      3328
#define XB_TOPGEN   3392
#define XCD_BAR_WORDS 3456
#define XB_SPIN_CAP (1u << 22)
#define LAS __attribute__((address_space(3)))
__device__ __forceinline__ unsigned xb_ld(unsigned* p)              { return __hip_atomic_load(p, __ATOMIC_RELAXED, __HIP_MEMORY_SCOPE_AGENT); }
__device__ __forceinline__ unsigned xb_add(unsigned* p, unsigned v) { return __hip_atomic_fetch_add(p, v, __ATOMIC_RELAXED, __HIP_MEMORY_SCOPE_AGENT); }
__device__ __forceinline__ unsigned xb_xcc_id() { return (unsigned)__builtin_amdgcn_s_getreg((3 << 11) | 20) & 0xFu; }
#define XB_SPIN(cond, bar) do { unsigned _sp = 0; while (cond) { __builtin_amdgcn_s_sleep(1); \
    if ((++_sp & 255u) == 0u) { if (xb_ld(&(bar)[XB_TMO])) break; if (_sp > XB_SPIN_CAP) { atomicAdd(&(bar)[XB_TMO], 1u); break; } } } } while (0)
struct XcdBarrier { unsigned* bar; unsigned x; volatile LAS unsigned* st; };
__device__ __forceinline__ XcdBarrier xcd_barrier_post(unsigned* bar, volatile LAS unsigned* st) {
    XcdBarrier b; b.bar = bar; b.x = xb_xcc_id(); b.st = st;
    if (threadIdx.x == 0) (void)xb_add(&bar[XB_XCNT(b.x)], 1u);
    return b;
}
__device__ __forceinline__ void xcd_barrier_complete(unsigned* bar, unsigned x, unsigned& nloc, unsigned& nx) {
    const unsigned G = gridDim.x * gridDim.y * gridDim.z;
    unsigned sum, cnt, mine, sp = 0u;
    for (;;) {
        sum = 0u; cnt = 0u; mine = 0u;
#pragma unroll
        for (unsigned j = 0; j < 16; ++j) { const unsigned c = xb_ld(&bar[XB_XCNT(j)]); sum += c; cnt += (c > 0u) ? 1u : 0u; mine = (j == x) ? c : mine; }
        if (sum == G) break;
        __builtin_amdgcn_s_sleep(1);
        if ((++sp & 255u) == 0u) { if (xb_ld(&bar[XB_TMO])) break; if (sp > XB_SPIN_CAP) { atomicAdd(&bar[XB_TMO], 1u); break; } }
    }
    nloc = mine > 0u ? mine : 1u; nx = cnt > 0u ? cnt : 1u;
}
__device__ __forceinline__ void xcd_barrier(const XcdBarrier& b) {
    asm volatile("s_waitcnt vmcnt(0)" ::: "memory");
    __syncthreads();
    if (threadIdx.x == 0) {
        unsigned* bar = b.bar;
        __builtin_amdgcn_s_waitcnt(0);
        unsigned nloc = b.st[0], nx = b.st[1];
        if (nloc == 0u) { xcd_barrier_complete(bar, b.x, nloc, nx); b.st[0] = nloc; b.st[1] = nx; }
        const unsigned old = xb_add(&bar[XB_XSUB(b.x)], 1u);
        const unsigned gen = old / nloc;
        if (old + 1u == (gen + 1u) * nloc) {
            __builtin_amdgcn_fence(__ATOMIC_RELEASE, "agent");
            asm volatile("s_waitcnt vmcnt(0)" ::: "memory");
            const unsigned og = xb_add(&bar[XB_TOP], 1u);
            const unsigned tg = og / nx;
            if (og + 1u == (tg + 1u) * nx) xb_add(&bar[XB_TOPGEN], 1u);
            else XB_SPIN(xb_ld(&bar[XB_TOPGEN]) == tg, bar);
            __builtin_amdgcn_fence(__ATOMIC_ACQUIRE, "agent");
            xb_add(&bar[XB_XGEN(b.x)], 1u);
            asm volatile("s_waitcnt vmcnt(0)" ::: "memory");
        } else {
            XB_SPIN(xb_ld(&bar[XB_XGEN(b.x)]) == gen, bar);
            __builtin_amdgcn_fence(__ATOMIC_ACQUIRE, "agent");
            asm volatile("s_waitcnt vmcnt(0)" ::: "memory");
        }
    }
    __syncthreads();
}
__global__ void __launch_bounds__(NTHR) fwd_mega(Params p) {
    extern __shared__ __attribute__((aligned(16))) char smem[];
    cg::grid_group grid = cg::this_grid();
    const int bid = blockIdx.x, nb = gridDim.x;
    volatile LAS unsigned* xst = (volatile LAS unsigned*)(smem + LDS_BYTES - 16);
    if (threadIdx.x < 4) xst[threadIdx.x] = 0u;
    __syncthreads();
    const XcdBarrier xb = xcd_barrier_post((unsigned*)(p.ws + WS_BAR), xst);
#define GSYNC() xcd_barrier(xb)
#ifndef PROBE_REPEAT
#define PROBE_REPEAT 0
#endif
#define REP(n, call) if (PROBE_REPEAT & (1 << n)) { call; GSYNC(); }
    if (PROBE_REPEAT & 1) { phase0(p, smem, bid, nb); GSYNC(); }
#ifdef PROBE_XCC
    {
        unsigned* rec = (unsigned*)(p.ws + WS_A + 432 * MB);
        if (threadIdx.x == 0) rec[bid] = xb_xcc_id();
        grid.sync();
        int mism = 0, distinct = 0;
        for (int b = 0; b < nb; ++b) { if (rec[b] != rec[b & 7]) ++mism; }
        for (int a = 0; a < 8; ++a) { bool dup = false; for (int b2 = 0; b2 < a; ++b2) dup = dup || (rec[a] == rec[b2]); if (!dup) ++distinct; }
        const float v = sqrtf((float)(PROBE_XCC == 1 ? mism : distinct) + 1.0f);
        for (long i = (long)bid * NTHR + threadIdx.x; i < (long)T_TOK * 1024; i += (long)nb * NTHR) p.out[i] = v;
        return;
    }
#endif
    phase0(p, smem, bid, nb);  grid.sync();
    REP(1, phase1<1>(p, smem, bid, nb))
    phase1(p, smem, bid, nb);  GSYNC();
    REP(2, phase2(p, smem, bid, nb))
    phase2(p, smem, bid, nb);  GSYNC();
#ifndef PROBE_P3PARTS
#define PROBE_P3PARTS 7
#endif
#ifndef PROBE_NSAV
#define PROBE_NSAV 7
#endif
    REP(3, (phase3<PROBE_P3PARTS, PROBE_NSAV>(p, smem, bid, nb, 1)))
    phase3(p, smem, bid, nb);  GSYNC();
    REP(4, phase4(p, smem, bid, nb))
#ifdef PROBE_X
    phase_probe<PROBE_X>(p, smem, bid, nb); GSYNC();
#endif
    phase4(p, smem, bid, nb);  GSYNC();
    REP(5, phase5(p, smem, bid, nb))
    phase5(p, smem, bid, nb);  GSYNC();
    REP(6, phase6(p, smem, bid, nb))
    phase6(p, smem, bid, nb);  GSYNC();
    REP(7, phase7(p, smem, bid, nb))
    phase7(p, smem, bid, nb);  GSYNC();
    REP(8, phase8(p, smem, bid, nb, 1))
    phase8(p, smem, bid, nb);  GSYNC();
    REP(9, phase9(p, smem, bid, nb))
    phase9(p, smem, bid, nb);  GSYNC();
    REP(10, phase10(p, smem, bid, nb))
    phase10(p, smem, bid, nb); GSYNC();
    REP(11, phase11(p, smem, bid, nb))
    phase11(p, smem, bid, nb);
}
#else
#define PHASE_KERNEL(n) __global__ void __launch_bounds__(NTHR) fwd_phase##n(Params p) { extern __shared__ __attribute__((aligned(16))) char smem[]; phase##n(p, smem, blockIdx.x, gridDim.x); }
PHASE_KERNEL(0) PHASE_KERNEL(1) PHASE_KERNEL(2) PHASE_KERNEL(3) PHASE_KERNEL(4) PHASE_KERNEL(5)
PHASE_KERNEL(6) PHASE_KERNEL(7) PHASE_KERNEL(8) PHASE_KERNEL(9) PHASE_KERNEL(10) PHASE_KERNEL(11)
typedef void (*phase_fn)(Params);
#endif

extern "C" void kernel_launch(void* const* d_in, const int* in_sizes, int n_in, void* d_out, int out_size, void* d_ws, size_t ws_size, hipStream_t stream) {
    Params p{};
    for (int i = 0; i < 32; ++i) p.in[i] = (const float*)d_in[i];
    p.out = (float*)d_out;
    p.ws = (char*)d_ws;
    if (n_in != 32 || ws_size < WS_END) { fprintf(stderr, "kernel_launch: unexpected inputs (n_in %d) or workspace too small (%zu < %zu)\n", n_in, ws_size, (size_t)WS_END); return; }
#if MEGA
    static int grid = 0;
    if (!grid) {
        int dev = 0, cus = 0, per_cu = 0;
        (void)hipGetDevice(&dev);
        (void)hipDeviceGetAttribute(&cus, hipDeviceAttributeMultiprocessorCount, dev);
        (void)hipFuncSetAttribute((const void*)fwd_mega, hipFuncAttributeMaxDynamicSharedMemorySize, LDS_BYTES);
        (void)hipOccupancyMaxActiveBlocksPerMultiprocessor(&per_cu, (const void*)fwd_mega, NTHR, LDS_BYTES);
        if (per_cu < 1) { fprintf(stderr, "kernel_launch: occupancy query says %d blocks/CU\n", per_cu); per_cu = 1; }
        grid = cus;
    }
    (void)hipMemsetAsync((char*)d_ws + WS_BAR, 0, 16384, stream);
    void* args[] = {&p};
    hipError_t e = hipLaunchCooperativeKernel((const void*)fwd_mega, dim3(grid), dim3(NTHR), args, LDS_BYTES, stream);
    if (e != hipSuccess) fprintf(stderr, "cooperative launch failed: %s (grid %d)\n", hipGetErrorString(e), grid);
#else
    static const phase_fn fns[12] = {fwd_phase0, fwd_phase1, fwd_phase2, fwd_phase3, fwd_phase4, fwd_phase5, fwd_phase6, fwd_phase7, fwd_phase8, fwd_phase9, fwd_phase10, fwd_phase11};
    static bool attr = false;
    if (!attr) { for (int i = 0; i < 12; ++i) (void)hipFuncSetAttribute((const void*)fns[i], hipFuncAttributeMaxDynamicSharedMemorySize, LDS_BYTES); attr = true; }
    for (int i = 0; i < 12; ++i) hipLaunchKernelGGL(fns[i], dim3(256), dim3(NTHR), LDS_BYTES, stream, p);
#endif
}
```

```cpp
#include <hip/hip_runtime.h>
#include <hip/hip_cooperative_groups.h>
#include <stdint.h>
#include <stdio.h>
namespace cg = cooperative_groups;

#ifndef MEGA
#define MEGA 1
#endif

typedef unsigned short bf16_t;
typedef short bf16x8 __attribute__((ext_vector_type(8)));
typedef short s16x4 __attribute__((ext_vector_type(4)));
typedef float f32x4 __attribute__((ext_vector_type(4)));
typedef float f32x2 __attribute__((ext_vector_type(2)));
typedef unsigned u32x4 __attribute__((ext_vector_type(4)));
typedef unsigned u32x2 __attribute__((ext_vector_type(2)));
typedef __bf16 bf16x2_t __attribute__((ext_vector_type(2)));

constexpr int T_TOK = 32768, DM = 1024, NB = 16, SEQ = 2048;
constexpr int PW = 3328;
constexpr int PC_Q = 0, PC_KC = 512, PC_VC = 640, PC_KS = 768, PC_VS = 896, PC_KW = 1024, PC_VW = 1152;
constexpr int PC_MQ = 1280, PC_MK = 1792, PC_MV = 2304, PC_MO = 2816;
constexpr float ALPHA = 1.189207115002721f;
constexpr float LN_EPS = 1e-5f;
constexpr int NTHR = 512;
constexpr int LDS_BYTES = 160 * 1024;
constexpr int NEXP = 256, TOPK = 8;
constexpr int LIST_CAP = 32768;

constexpr size_t al256(size_t x) { return (x + 255) & ~(size_t)255; }
constexpr size_t WS_WIN = 0;
constexpr size_t WS_WOUT = WS_WIN + al256((size_t)3360 * 1024 * 2);
constexpr size_t WS_WQ = WS_WOUT + (size_t)1024 * 1024 * 2;
constexpr size_t WS_WKV = WS_WQ + (size_t)1024 * 1024 * 2;
constexpr size_t WS_WO = WS_WKV + (size_t)2048 * 1024 * 2;
constexpr size_t WS_WR = WS_WO + (size_t)1024 * 1024 * 2;
constexpr size_t WS_WS13 = WS_WR + (size_t)256 * 1024 * 2;
constexpr size_t WS_WS2 = WS_WS13 + (size_t)512 * 1024 * 2;
constexpr size_t WS_CK1 = WS_WS2 + (size_t)1024 * 256 * 2;
constexpr size_t WS_CK2 = WS_CK1 + (size_t)64 * 2048 * 2;
constexpr size_t WS_CV1 = WS_CK2 + (size_t)64 * 64 * 2;
constexpr size_t WS_CV2 = WS_CV1 + (size_t)64 * 2048 * 2;
constexpr size_t MB = 1024 * 1024;
constexpr size_t WS_LNP = al256(WS_CV2 + (size_t)64 * 64 * 2);
constexpr size_t WS_LNF = WS_LNP + (size_t)2 * 16 * 1792 * 4;
constexpr size_t WS_A = al256(WS_LNF + (size_t)2 * 1792 * 4 + 65536);
constexpr size_t WS_P = WS_A;
constexpr size_t WS_R1 = WS_A;
constexpr size_t WS_XQ = WS_A + 128 * MB;
constexpr size_t WS_XO = WS_A + 192 * MB;
constexpr size_t WS_XB = WS_A + 208 * MB;
constexpr size_t WS_MEMB = WS_A + 272 * MB;
constexpr size_t WS_PSM = WS_A + 280 * MB;
constexpr size_t WS_KCMP = WS_A + 284 * MB;
constexpr size_t WS_VCMP = WS_KCMP + (size_t)16 * 2 * 128 * 64 * 2;
constexpr size_t WS_QK = WS_A + 285 * MB;
constexpr size_t WS_MIX = WS_A + 349 * MB;
constexpr size_t WS_KVX = WS_A + 413 * MB;
constexpr size_t WS_X2F8 = WS_A + 256 * MB;
constexpr size_t WS_X2 = WS_A + 256 * MB;
constexpr size_t WS_HS = WS_A + 320 * MB;
constexpr size_t WS_R1B = WS_A;
constexpr size_t WS_RSC = WS_A;
constexpr size_t WS_Y = WS_A;
constexpr size_t WS_B = WS_A + al256((size_t)(T_TOK * 8 + 256) * 1024 * 2);
constexpr size_t WS_R2B = WS_B;
constexpr size_t WS_R2 = WS_B;
constexpr size_t WS_ST1 = WS_R2 + (size_t)T_TOK * 1024 * 4;
constexpr size_t WS_ST2 = WS_ST1 + (size_t)T_TOK * 8 * 4;
constexpr size_t WS_SH = WS_ST2 + (size_t)T_TOK * 8 * 4;
constexpr size_t WS_SELE = WS_SH + (size_t)T_TOK * 1024 * 2;
constexpr size_t WS_SELP = WS_SELE + (size_t)T_TOK * 8 * 4;
constexpr size_t WS_SELW = WS_SELP + (size_t)T_TOK * 8 * 4;
constexpr size_t WS_CNT = WS_SELW + (size_t)T_TOK * 8 * 4;
constexpr size_t WS_TOKL = WS_CNT + 98304;
constexpr size_t WS_WL = WS_TOKL + (size_t)NEXP * LIST_CAP * 4;
constexpr size_t WS_H = WS_WL + (size_t)NEXP * LIST_CAP * 4;
constexpr size_t WS_HF8 = WS_H;
constexpr size_t WS_W2F8 = WS_H + (size_t)(T_TOK * 8 + 256) * 256;
constexpr size_t WS_BAR = WS_W2F8 + (size_t)256 * 1024 * 256;
constexpr size_t WS_END = WS_BAR + 16384;
static_assert((size_t)T_TOK * PW * 2 <= 208 * MB, "P region");
static_assert(WS_END <= (size_t)1024 * MB, "workspace must fit 1 GiB");

struct Params {
    const float* in[32];
    float* out;
    char* ws;
};

__device__ __forceinline__ unsigned pk_bf16(float lo, float hi) {
    f32x2 v = {lo, hi};
    bf16x2_t r = __builtin_convertvector(v, bf16x2_t);
    return __builtin_bit_cast(unsigned, r);
}
__device__ __forceinline__ float bf_lo(unsigned u) { return __uint_as_float(u << 16); }
__device__ __forceinline__ float bf_hi(unsigned u) { return __uint_as_float(u & 0xffff0000u); }
__device__ __forceinline__ float bf2f(bf16_t h) { return __uint_as_float(((unsigned)h) << 16); }
__device__ __forceinline__ float sigmoidf_(float x) { return 1.0f / (1.0f + __expf(-x)); }
__device__ __forceinline__ float siluf_(float x) { return x / (1.0f + __expf(-x)); }
__device__ __forceinline__ f32x4 mfma16(bf16x8 a, bf16x8 b, f32x4 c) { return __builtin_amdgcn_mfma_f32_16x16x32_bf16(a, b, c, 0, 0, 0); }
__device__ __forceinline__ bf16x8 as_bf16x8(u32x4 v) { return __builtin_bit_cast(bf16x8, v); }

__device__ __forceinline__ int opaque_tid() { int t = threadIdx.x; asm volatile("" : "+v"(t)); return t; }

__device__ __forceinline__ int tile_off(int row, int chunk) { return row * 128 + ((chunk ^ (row & 7)) << 4); }

__device__ __forceinline__ int bperm(int rho) { return (rho & ~31) + 8 * ((rho >> 2) & 3) + 4 * ((rho >> 4) & 1) + (rho & 3); }

typedef __attribute__((address_space(3))) unsigned lds_u32;
typedef __attribute__((address_space(1))) const unsigned glb_u32;

struct LoadBf16Rows {
    const bf16_t* base;
    unsigned off[4];
    int ldst;
    struct Regs { int dummy; };
    __device__ __forceinline__ void init_contig(const bf16_t* b, int ld, int row0) {
        const int tid_ = opaque_tid();
        const int r8 = tid_ >> 3, kc = (tid_ & 7) ^ (r8 & 7);
        ldst = tid_ * 16;
        base = b + (long)row0 * ld;
#pragma unroll
        for (int i = 0; i < 4; ++i) off[i] = (unsigned)((r8 + 64 * i) * ld + kc * 8);
    }
    __device__ __forceinline__ void init_rows(const bf16_t* b, int ld, const int (&rows)[4]) {
        const int tid_ = opaque_tid();
        const int r8 = tid_ >> 3, kc = (tid_ & 7) ^ (r8 & 7);
        ldst = tid_ * 16;
        base = b;
#pragma unroll
        for (int i = 0; i < 4; ++i) off[i] = (unsigned)rows[i] * (unsigned)ld + (unsigned)(kc * 8);
    }
    __device__ __forceinline__ void issue(Regs&, char* s, int kt) const {
#pragma unroll
        for (int i = 0; i < 4; ++i)
            __builtin_amdgcn_global_load_lds((glb_u32*)(base + (size_t)(off[i] + (unsigned)(kt * 64))), (lds_u32*)(s + i * 8192 + ldst), 16, 0, 0);
    }
    __device__ __forceinline__ void commit(const Regs&, char*, int) const {}
};

struct LoadF32KN {
    const float* p;
    int ldn;
    int n, kh;
    struct Regs { float v[32]; };
    __device__ __forceinline__ void issue(Regs& r, char*, int kt) const {
        const float* q = p + (long)kt * 64 * ldn;
#pragma unroll
        for (int j = 0; j < 32; ++j) r.v[j] = q[(long)j * ldn];
    }
    __device__ __forceinline__ void commit(const Regs& r, char* s, int kt) const {
#pragma unroll
        for (int q = 0; q < 4; ++q) {
            u32x4 w;
            w.x = pk_bf16(r.v[8 * q + 0], r.v[8 * q + 1]); w.y = pk_bf16(r.v[8 * q + 2], r.v[8 * q + 3]);
            w.z = pk_bf16(r.v[8 * q + 4], r.v[8 * q + 5]); w.w = pk_bf16(r.v[8 * q + 6], r.v[8 * q + 7]);
            *(u32x4*)(s + tile_off(n, kh * 4 + q)) = w;
        }
    }
};

struct LoadLN {
    LoadBf16Rows raw;
    bf16_t* xbase;
    const float* st;
    const float* gb;
    typedef LoadBf16Rows::Regs Regs;
    __device__ __forceinline__ void issue(Regs& r, char* s, int kt) const { raw.issue(r, s, kt); }
    __device__ __forceinline__ void commit(const Regs&, char* s, int kt) const {
        asm volatile("s_waitcnt vmcnt(0)" ::: "memory");
        const int tid_ = opaque_tid();
        const int r8 = tid_ >> 3, kc = (tid_ & 7) ^ (r8 & 7);
        const f32x4 g0 = *(const f32x4*)(gb + kt * 64 + kc * 8), g1 = *(const f32x4*)(gb + kt * 64 + kc * 8 + 4);
        const f32x4 b0 = *(const f32x4*)(gb + 1024 + kt * 64 + kc * 8), b1 = *(const f32x4*)(gb + 1024 + kt * 64 + kc * 8 + 4);
#pragma unroll
        for (int i = 0; i < 4; ++i) {
            const int row = r8 + 64 * i;
            u32x4* cp = (u32x4*)(s + i * 8192 + tid_ * 16);
            const u32x4 v = *cp;
            const float mean = st[row * 2], rstd = st[row * 2 + 1];
            const f32x4 x0 = (f32x4){bf_lo(v.x), bf_hi(v.x), bf_lo(v.y), bf_hi(v.y)};
            const f32x4 x1 = (f32x4){bf_lo(v.z), bf_hi(v.z), bf_lo(v.w), bf_hi(v.w)};
            const f32x4 y0 = (x0 - mean) * rstd * g0 + b0, y1 = (x1 - mean) * rstd * g1 + b1;
            u32x4 w; w.x = pk_bf16(y0[0], y0[1]); w.y = pk_bf16(y0[2], y0[3]); w.z = pk_bf16(y1[0], y1[1]); w.w = pk_bf16(y1[2], y1[3]);
            *cp = w;
            if (xbase) *(u32x4*)(xbase + (size_t)(row * 1024 + kc * 8 + kt * 64)) = w;
        }
    }
};

constexpr int GEMM_LDS = 131072;
template <class AL, class BL>
__device__ __forceinline__ void gemm_mainloop(char* smem, const AL& al, const BL& bl, int nk, f32x4 (&acc)[8][4]) {
    const int tid_ = opaque_tid();
    const int lane = tid_ & 63, wid = tid_ >> 6;
    const int wr = wid >> 2, wc = wid & 3, fr = lane & 15, fq = lane >> 4;
#pragma unroll
    for (int mi = 0; mi < 8; ++mi)
#pragma unroll
        for (int ni = 0; ni < 4; ++ni) acc[mi][ni] = (f32x4){0.f, 0.f, 0.f, 0.f};
    typename AL::Regs ra; typename BL::Regs rb;
    al.issue(ra, smem, 0); bl.issue(rb, smem + 32768, 0);
    al.commit(ra, smem, 0); bl.commit(rb, smem + 32768, 0);
    __syncthreads();
    for (int kt = 0; kt < nk; ++kt) {
        char* sA = smem + (kt & 1) * 65536; char* sB = sA + 32768;
        char* nA = smem + ((kt + 1) & 1) * 65536; char* nB = nA + 32768;
        if (kt + 1 < nk) { al.issue(ra, nA, kt + 1); bl.issue(rb, nB, kt + 1); }
#pragma unroll
        for (int kk = 0; kk < 2; ++kk) {
            bf16x8 bfr[4];
#pragma unroll
            for (int ni = 0; ni < 4; ++ni) bfr[ni] = *(const bf16x8*)(sB + tile_off(wc * 64 + ni * 16 + fr, kk * 4 + fq));
#pragma unroll
            for (int mi = 0; mi < 8; ++mi) {
                const bf16x8 af = *(const bf16x8*)(sA + tile_off(wr * 128 + mi * 16 + fr, kk * 4 + fq));
#pragma unroll
                for (int ni = 0; ni < 4; ++ni) acc[mi][ni] = mfma16(bfr[ni], af, acc[mi][ni]);
            }
        }
        if (kt + 1 < nk) { al.commit(ra, nA, kt + 1); bl.commit(rb, nB, kt + 1); }
        __syncthreads();
    }
}

__device__ __forceinline__ int swz4(int row) { return (0x78 >> (((row >> 2) & 3) * 2)) & 3; }
struct RingRows {
    const bf16_t* base; unsigned off[2]; int ldst;
    __device__ __forceinline__ void init_contig(const bf16_t* b, int ld, int row0, bool perm = false) {
        const int tid_ = opaque_tid(); const int r = tid_ >> 2, kc = (tid_ & 3) ^ swz4(r);
        ldst = tid_ * 16; base = b + (long)row0 * ld;
#pragma unroll
        for (int i = 0; i < 2; ++i) { const int rr = r + 128 * i; off[i] = (unsigned)((perm ? bperm(rr) : rr) * ld + kc * 8); }
    }
    __device__ __forceinline__ void init_rows(const bf16_t* b, int ld, const int (&rows)[2]) {
        const int tid_ = opaque_tid(); const int r = tid_ >> 2, kc = (tid_ & 3) ^ swz4(r);
        ldst = tid_ * 16; base = b;
#pragma unroll
        for (int i = 0; i < 2; ++i) off[i] = (unsigned)rows[i] * (unsigned)ld + (unsigned)(kc * 8);
    }
    __device__ __forceinline__ void issue(char* s, int kt) const {
#pragma unroll
        for (int i = 0; i < 2; ++i)
            __builtin_amdgcn_global_load_lds((glb_u32*)(base + (size_t)(off[i] + (unsigned)(kt * 32))), (lds_u32*)(s + i * 8192 + ldst), 16, 0, 0);
    }
    __device__ __forceinline__ void commit(char*, int) const {}
};
struct RingLN {
    RingRows raw; bf16_t* xbase; const float* st; const float* gb;
    __device__ __forceinline__ void issue(char* s, int kt) const { raw.issue(s, kt); }
    __device__ __forceinline__ void commit(char* s, int kt) const {
        const int tid_ = opaque_tid(); const int r = tid_ >> 2, kc = (tid_ & 3) ^ swz4(r);
        const f32x4 g0 = *(const f32x4*)(gb + kt * 32 + kc * 8), g1 = *(const f32x4*)(gb + kt * 32 + kc * 8 + 4);
        const f32x4 b0 = *(const f32x4*)(gb + 1024 + kt * 32 + kc * 8), b1 = *(const f32x4*)(gb + 1024 + kt * 32 + kc * 8 + 4);
#pragma unroll
        for (int i = 0; i < 2; ++i) {
            const int row = r + 128 * i;
            u32x4* cp = (u32x4*)(s + i * 8192 + tid_ * 16);
            const u32x4 v = *cp;
            const float mean = st[row * 2], rstd = st[row * 2 + 1];
            const f32x4 x0 = (f32x4){bf_lo(v.x), bf_hi(v.x), bf_lo(v.y), bf_hi(v.y)};
            const f32x4 x1 = (f32x4){bf_lo(v.z), bf_hi(v.z), bf_lo(v.w), bf_hi(v.w)};
            const f32x4 y0 = (x0 - mean) * rstd * g0 + b0, y1 = (x1 - mean) * rstd * g1 + b1;
            u32x4 w; w.x = pk_bf16(y0[0], y0[1]); w.y = pk_bf16(y0[2], y0[3]); w.z = pk_bf16(y1[0], y1[1]); w.w = pk_bf16(y1[2], y1[3]);
            *cp = w;
            if (xbase) *(u32x4*)(xbase + (size_t)(row * 1024 + kc * 8 + kt * 32)) = w;
        }
    }
};
#define RING_WAIT(n) asm volatile("s_waitcnt vmcnt(" #n ")" ::: "memory")
#define RING_BAR() do { __builtin_amdgcn_sched_barrier(0); asm volatile("s_waitcnt lgkmcnt(0)" ::: "memory"); __builtin_amdgcn_s_barrier(); asm volatile("" ::: "memory"); __builtin_amdgcn_sched_barrier(0); } while (0)
template <class AL, class BL>
__device__ __forceinline__ void ring_issue3(char* smem, const AL& al, const BL& bl) {
    al.issue(smem, 0); bl.issue(smem + 16384, 0);
    al.issue(smem + 32768, 1); bl.issue(smem + 32768 + 16384, 1);
    al.issue(smem + 65536, 2); bl.issue(smem + 65536 + 16384, 2);
}
template <class AL, class BL, int XMODE = 0  , bool ISSUED = false  >
__device__ __forceinline__ void gemm_ring(char* smem, const AL& al, const BL& bl, int nk  , f32x4 (&acc)[8][4]) {
    const int tid_ = opaque_tid();
    const int lane = tid_ & 63, wid = __builtin_amdgcn_readfirstlane(tid_ >> 6);
    const int wr = wid >> 2, wc = wid & 3, fr = lane & 15, fq = lane >> 4;
#pragma unroll
    for (int mi = 0; mi < 8; ++mi)
#pragma unroll
        for (int ni = 0; ni < 4; ++ni) acc[mi][ni] = (f32x4){0.f, 0.f, 0.f, 0.f};
    const int aoff = (wr * 128 + fr) * 64 + ((fq ^ swz4(fr)) << 4);
    const int boff = 16384 + (wc * 64 + fr) * 64 + ((fq ^ swz4(fr)) << 4);
    if (XMODE != 1) {
    if (!ISSUED) ring_issue3(smem, al, bl);
    RING_WAIT(8);
    al.commit(smem, 0); bl.commit(smem + 16384, 0);
    }
    RING_BAR();
    if (wr == 1) RING_BAR();
    for (int kt = 0; kt < nk; ++kt) {
        const char* st = smem + (kt & 3) * 32768;
        if (XMODE != 1 && kt + 3 < nk) { char* s3 = smem + ((kt + 3) & 3) * 32768; al.issue(s3, kt + 3); bl.issue(s3 + 16384, kt + 3); }
        bf16x8 bfr[4], afr[8];
        if (XMODE != 2) {
#pragma unroll
        for (int ni = 0; ni < 4; ++ni) bfr[ni] = *(const bf16x8*)(st + boff + ni * 1024);
#pragma unroll
        for (int mi = 0; mi < 8; ++mi) afr[mi] = *(const bf16x8*)(st + aoff + mi * 1024);
        }
        if (XMODE != 1 && kt + 1 < nk) {
            if (kt + 3 < nk) RING_WAIT(8); else if (kt + 2 < nk) RING_WAIT(4); else RING_WAIT(0);
            char* s1 = smem + ((kt + 1) & 3) * 32768;
            al.commit(s1, kt + 1); bl.commit(s1 + 16384, kt + 1);
        }
        RING_BAR();
        if (XMODE != 2) {
        __builtin_amdgcn_s_setprio(1);
#pragma unroll
        for (int mi = 0; mi < 8; ++mi)
#pragma unroll
            for (int ni = 0; ni < 4; ++ni) acc[mi][ni] = mfma16(bfr[ni], afr[mi], acc[mi][ni]);
        __builtin_amdgcn_s_setprio(0);
        }
        RING_BAR();
    }
    if (wr == 0) RING_BAR();
}

constexpr int FB_PITCH = 1088, FB_STAGE = 16384 + 32 * FB_PITCH;
struct RingF32B {
    const float* p; int ldn; int ldst;
    __device__ __forceinline__ void init(const float* W, int ld, int srccol4, int tid_) { const int lane = tid_ & 63, wid = tid_ >> 6; p = W + (long)wid * ld + srccol4; ldn = ld; ldst = wid * FB_PITCH + lane * 16; }
    __device__ __forceinline__ void issue(char* sB, int kt) const {
#pragma unroll
        for (int i = 0; i < 4; ++i)
            __builtin_amdgcn_global_load_lds((glb_u32*)(p + (long)(kt * 32 + i * 8) * ldn), (lds_u32*)(sB + i * 8 * FB_PITCH + (i & 1) * 64 + ldst), 16, 0, 0);
    }
};
template <class AL>
__device__ __forceinline__ void gemm_ring_f32b(char* smem, const AL& al, const RingF32B& bl, int nk  , f32x4 (&acc)[8][4]) {
    const int tid_ = opaque_tid();
    const int lane = tid_ & 63, wid = __builtin_amdgcn_readfirstlane(tid_ >> 6);
    const int wr = wid >> 2, wc = wid & 3, fr = lane & 15, fq = lane >> 4;
#pragma unroll
    for (int mi = 0; mi < 8; ++mi)
#pragma unroll
        for (int ni = 0; ni < 4; ++ni) acc[mi][ni] = (f32x4){0.f, 0.f, 0.f, 0.f};
    const int aoff = (wr * 128 + fr) * 64 + ((fq ^ swz4(fr)) << 4);
    const int boff = 16384 + (8 * fq) * FB_PITCH + (fq & 1) * 64 + (wc * 64 + fr) * 4;
    al.issue(smem, 0); bl.issue(smem + 16384, 0);
    al.issue(smem + FB_STAGE, 1); bl.issue(smem + FB_STAGE + 16384, 1);
    RING_WAIT(6);
    RING_BAR();
    if (wr == 1) RING_BAR();
    int s0 = 0;
    for (int kt = 0; kt < nk; ++kt) {
        const char* st = smem + s0 * FB_STAGE;
        const int s1 = s0 == 2 ? 0 : s0 + 1, s2 = s1 == 2 ? 0 : s1 + 1;
        if (kt + 2 < nk) { char* sn = smem + s2 * FB_STAGE; al.issue(sn, kt + 2); bl.issue(sn + 16384, kt + 2); }
        bf16x8 bfr[4], afr[8];
#pragma unroll
        for (int ni = 0; ni < 4; ++ni) {
            float v[8];
#pragma unroll
            for (int j = 0; j < 8; ++j) v[j] = *(const float*)(st + boff + j * FB_PITCH + ni * 64);
            u32x4 w; w.x = pk_bf16(v[0], v[1]); w.y = pk_bf16(v[2], v[3]); w.z = pk_bf16(v[4], v[5]); w.w = pk_bf16(v[6], v[7]);
            bfr[ni] = as_bf16x8(w);
        }
#pragma unroll
        for (int mi = 0; mi < 8; ++mi) afr[mi] = *(const bf16x8*)(st + aoff + mi * 1024);
        if (kt + 1 < nk) { if (kt + 2 < nk) RING_WAIT(6); else RING_WAIT(0); }
        RING_BAR();
        __builtin_amdgcn_s_setprio(1);
#pragma unroll
        for (int mi = 0; mi < 8; ++mi)
#pragma unroll
            for (int ni = 0; ni < 4; ++ni) acc[mi][ni] = mfma16(bfr[ni], afr[mi], acc[mi][ni]);
        __builtin_amdgcn_s_setprio(0);
        RING_BAR();
        s0 = s1;
    }
    if (wr == 0) RING_BAR();
}

__device__ __forceinline__ unsigned pk4_fp8(float a, float b, float c, float d) {
    int r = __builtin_amdgcn_cvt_pk_fp8_f32(a, b, 0, false);
    r = __builtin_amdgcn_cvt_pk_fp8_f32(c, d, r, true);
    return (unsigned)r;
}
struct RingF8 {
    const unsigned char* base; unsigned off[2]; int ldst;
    __device__ __forceinline__ void init_contig(const unsigned char* b, int ldb, long row0, bool perm = false) {
        const int tid_ = opaque_tid(); const int r = tid_ >> 2, kc = (tid_ & 3) ^ ((r >> 2) & 3);
        ldst = tid_ * 16; base = b + row0 * ldb;
#pragma unroll
        for (int i = 0; i < 2; ++i) { const int rr = r + 128 * i; off[i] = (unsigned)((perm ? bperm(rr) : rr) * ldb + kc * 16); }
    }
    __device__ __forceinline__ void init_rows(const unsigned char* b, int ldb, const int (&rows)[2]) {
        const int tid_ = opaque_tid(); const int r = tid_ >> 2, kc = (tid_ & 3) ^ ((r >> 2) & 3);
        ldst = tid_ * 16; base = b;
#pragma unroll
        for (int i = 0; i < 2; ++i) off[i] = (unsigned)rows[i] * (unsigned)ldb + (unsigned)(kc * 16);
    }
    __device__ __forceinline__ void issue(char* s, int kt) const {
#pragma unroll
        for (int i = 0; i < 2; ++i)
            __builtin_amdgcn_global_load_lds((glb_u32*)(base + (size_t)(off[i] + (unsigned)(kt * 64))), (lds_u32*)(s + i * 8192 + ldst), 16, 0, 0);
    }
};
__device__ __forceinline__ void ring_f8_issue3(char* smem, const RingF8& al, const RingF8& bl) {
    al.issue(smem, 0); bl.issue(smem + 16384, 0);
    al.issue(smem + 32768, 1); bl.issue(smem + 32768 + 16384, 1);
    al.issue(smem + 65536, 2); bl.issue(smem + 65536 + 16384, 2);
}
__device__ __forceinline__ void gemm_ring_f8_main(char* smem, const RingF8& al, const RingF8& bl, int nk  , f32x4 (&acc)[8][4]) {
    const int tid_ = opaque_tid();
    const int lane = tid_ & 63, wid = __builtin_amdgcn_readfirstlane(tid_ >> 6);
    const int wr = wid >> 2, wc = wid & 3, fr = lane & 15, fq = lane >> 4;
#pragma unroll
    for (int mi = 0; mi < 8; ++mi)
#pragma unroll
        for (int ni = 0; ni < 4; ++ni) acc[mi][ni] = (f32x4){0.f, 0.f, 0.f, 0.f};
    const int g2 = ((fr >> 2) & 3) << 1;
    const int aoff0 = (wr * 128 + fr) * 64 + ((fq ^ g2) << 3), aoff1 = (wr * 128 + fr) * 64 + (((4 + fq) ^ g2) << 3);
    const int boff0 = 16384 + (wc * 64 + fr) * 64 + ((fq ^ g2) << 3), boff1 = 16384 + (wc * 64 + fr) * 64 + (((4 + fq) ^ g2) << 3);
    RING_WAIT(8);
    RING_BAR();
    if (wr == 1) RING_BAR();
    for (int kt = 0; kt < nk; ++kt) {
        const char* st = smem + (kt & 3) * 32768;
        if (kt + 3 < nk) { char* s3 = smem + ((kt + 3) & 3) * 32768; al.issue(s3, kt + 3); bl.issue(s3 + 16384, kt + 3); }
        long b0[4], b1[4], a0[8], a1[8];
#pragma unroll
        for (int ni = 0; ni < 4; ++ni) { b0[ni] = *(const long*)(st + boff0 + ni * 1024); b1[ni] = *(const long*)(st + boff1 + ni * 1024); }
#pragma unroll
        for (int mi = 0; mi < 8; ++mi) { a0[mi] = *(const long*)(st + aoff0 + mi * 1024); a1[mi] = *(const long*)(st + aoff1 + mi * 1024); }
        if (kt + 1 < nk) { if (kt + 3 < nk) RING_WAIT(8); else if (kt + 2 < nk) RING_WAIT(4); else RING_WAIT(0); }
        RING_BAR();
        __builtin_amdgcn_s_setprio(1);
#pragma unroll
        for (int mi = 0; mi < 8; ++mi)
#pragma unroll
            for (int ni = 0; ni < 4; ++ni) {
                acc[mi][ni] = __builtin_amdgcn_mfma_f32_16x16x32_fp8_fp8(b0[ni], a0[mi], acc[mi][ni], 0, 0, 0);
                acc[mi][ni] = __builtin_amdgcn_mfma_f32_16x16x32_fp8_fp8(b1[ni], a1[mi], acc[mi][ni], 0, 0, 0);
            }
        __builtin_amdgcn_s_setprio(0);
        RING_BAR();
    }
    if (wr == 0) RING_BAR();
}

__device__ __forceinline__ int bperm16(int rho) { return (rho & ~63) + 16 * ((rho >> 2) & 3) + 4 * ((rho >> 4) & 3) + (rho & 3); }

__device__ __forceinline__ void epi_store_bf16(const f32x4 (&acc)[8][4], bf16_t* out, long ld, int row0, int col0) {
    const int tid_ = opaque_tid();
    const int lane = tid_ & 63, wid = tid_ >> 6;
    const int wr = wid >> 2, wc = wid & 3, fr = lane & 15, fq = lane >> 4;
#pragma unroll
    for (int mi = 0; mi < 8; ++mi) {
        bf16_t* rp = out + (long)(row0 + wr * 128 + mi * 16 + fr) * ld + col0 + wc * 64 + fq * 8;
#pragma unroll
        for (int q = 0; q < 2; ++q) {
            u32x4 w; w.x = pk_bf16(acc[mi][2 * q][0], acc[mi][2 * q][1]); w.y = pk_bf16(acc[mi][2 * q][2], acc[mi][2 * q][3]);
            w.z = pk_bf16(acc[mi][2 * q + 1][0], acc[mi][2 * q + 1][1]); w.w = pk_bf16(acc[mi][2 * q + 1][2], acc[mi][2 * q + 1][3]);
            *(u32x4*)(rp + q * 32) = w;
        }
    }
}

template <bool RES_LN>
__device__ __forceinline__ void epi_residual(f32x4 (&acc)[8][4], char* smem, const float* resid_f32, const bf16_t* resid_bf16, const float* rstats  ,
                                             const float* g, const float* b, bf16_t* rbout, float* stout  , int row0, int nt) {
    const int tid_ = opaque_tid();
    const int lane = tid_ & 63, wid = tid_ >> 6;
    const int wr = wid >> 2, wc = wid & 3, fr = lane & 15, fq = lane >> 4;
    float* sp = (float*)(smem + 139264);
    const int col0 = nt * 256 + wc * 64 + fq * 8;
#pragma unroll
    for (int mi = 0; mi < 8; ++mi) {
        const int rl = wr * 128 + mi * 16 + fr;
        const long row = row0 + rl;
        float mean = 0.f, rstd = 1.f;
        if (RES_LN) {
            const f32x4 p0 = *(const f32x4*)(rstats + row * 8), p1 = *(const f32x4*)(rstats + row * 8 + 4);
            const float s1 = (p0[0] + p0[2]) + (p1[0] + p1[2]), s2 = (p0[1] + p0[3]) + (p1[1] + p1[3]);
            mean = s1 * (1.0f / 1024.0f);
            const float var = fmaxf(s2 * (1.0f / 1024.0f) - mean * mean, 0.f);
            rstd = rsqrtf(var + LN_EPS);
        }
        float s1 = 0.f, s2 = 0.f;
#pragma unroll
        for (int q = 0; q < 2; ++q) {
            const long o = row * 1024 + col0 + q * 32;
            f32x4 x0, x1;
            if (RES_LN) {
                const u32x4 u = *(const u32x4*)(resid_bf16 + o);
                x0 = (f32x4){bf_lo(u.x), bf_hi(u.x), bf_lo(u.y), bf_hi(u.y)}; x1 = (f32x4){bf_lo(u.z), bf_hi(u.z), bf_lo(u.w), bf_hi(u.w)};
                x0 = (x0 - mean) * rstd * *(const f32x4*)(g + col0 + q * 32) + *(const f32x4*)(b + col0 + q * 32);
                x1 = (x1 - mean) * rstd * *(const f32x4*)(g + col0 + q * 32 + 4) + *(const f32x4*)(b + col0 + q * 32 + 4);
            } else { x0 = *(const f32x4*)(resid_f32 + o); x1 = *(const f32x4*)(resid_f32 + o + 4); }
            const f32x4 v0 = acc[mi][2 * q] + ALPHA * x0, v1 = acc[mi][2 * q + 1] + ALPHA * x1;
            { u32x4 w; w.x = pk_bf16(v0[0], v0[1]); w.y = pk_bf16(v0[2], v0[3]); w.z = pk_bf16(v1[0], v1[1]); w.w = pk_bf16(v1[2], v1[3]); *(u32x4*)(rbout + o) = w; }
            s1 += ((v0[0] + v0[1]) + (v0[2] + v0[3])) + ((v1[0] + v1[1]) + (v1[2] + v1[3]));
            s2 += ((v0[0] * v0[0] + v0[1] * v0[1]) + (v0[2] * v0[2] + v0[3] * v0[3])) + ((v1[0] * v1[0] + v1[1] * v1[1]) + (v1[2] * v1[2] + v1[3] * v1[3]));
        }
        s1 += __shfl_xor(s1, 16); s1 += __shfl_xor(s1, 32);
        s2 += __shfl_xor(s2, 16); s2 += __shfl_xor(s2, 32);
        if (fq == 0) { sp[(rl * 4 + wc) * 2] = s1; sp[(rl * 4 + wc) * 2 + 1] = s2; }
    }
    __syncthreads();
    if (tid_ < 256) {
        const int rl = tid_;
        const float a1 = (sp[rl * 8] + sp[rl * 8 + 2]) + (sp[rl * 8 + 4] + sp[rl * 8 + 6]);
        const float a2 = (sp[rl * 8 + 1] + sp[rl * 8 + 3]) + (sp[rl * 8 + 5] + sp[rl * 8 + 7]);
        *(f32x2*)(stout + ((long)(row0 + rl) * 4 + nt) * 2) = (f32x2){a1, a2};
    }
    __syncthreads();
}

__device__ __forceinline__ void ln_tile_stats(float* st, const float* rstats, int row0) {
    const int tid_ = opaque_tid();
    if (tid_ < 256) {
        const long row = row0 + tid_;
        const f32x4 p0 = *(const f32x4*)(rstats + row * 8), p1 = *(const f32x4*)(rstats + row * 8 + 4);
        const float s1 = (p0[0] + p0[2]) + (p1[0] + p1[2]), s2 = (p0[1] + p0[3]) + (p1[1] + p1[3]);
        const float mean = s1 * (1.0f / 1024.0f);
        const float var = fmaxf(s2 * (1.0f / 1024.0f) - mean * mean, 0.f);
        st[tid_ * 2] = mean; st[tid_ * 2 + 1] = rsqrtf(var + LN_EPS);
    }
}
__device__ __forceinline__ void ln_load_gb(float* gb, const float* g, const float* b) {
    for (int i = opaque_tid(); i < 1024; i += NTHR) { gb[i] = g[i]; gb[1024 + i] = b[i]; }
}


struct XcdSlab {
    int x, j, stride;
    __device__ __forceinline__ void init(int bid, int nb) { if ((nb & 7) == 0) { x = bid & 7; j = bid >> 3; stride = nb >> 3; } else { x = -1; j = bid; stride = nb; } }
    __device__ __forceinline__ int m_lo(int nM) const { return x < 0 ? 0 : (x * nM) >> 3; }
    __device__ __forceinline__ int m_hi(int nM) const { return x < 0 ? nM : ((x + 1) * nM) >> 3; }
};

template <int MAP>
__device__ __forceinline__ void ln_correct(f32x4 (&acc)[8][4], const float* rstats  , int row0, const float* cs, const float* bw, int nt) {
    const int tid_ = opaque_tid();
    const int lane = tid_ & 63, wid = tid_ >> 6;
    const int wr = wid >> 2, wc = wid & 3, fr = lane & 15, fq = lane >> 4;
    float mean[8], rstd[8];
#pragma unroll
    for (int mi = 0; mi < 8; ++mi) {
        const long row = row0 + wr * 128 + mi * 16 + fr;
        const f32x4 p0 = *(const f32x4*)(rstats + row * 8), p1 = *(const f32x4*)(rstats + row * 8 + 4);
        const float s1 = (p0[0] + p0[2]) + (p1[0] + p1[2]), s2 = (p0[1] + p0[3]) + (p1[1] + p1[3]);
        mean[mi] = s1 * (1.0f / 1024.0f);
        rstd[mi] = rsqrtf(fmaxf(s2 * (1.0f / 1024.0f) - mean[mi] * mean[mi], 0.f) + LN_EPS);
    }
#pragma unroll
    for (int ni = 0; ni < 4; ++ni) {
        const int col = MAP == 0 ? nt * 256 + wc * 64 + (ni >> 1) * 32 + fq * 8 + (ni & 1) * 4
                                 : (ni & 1) * 256 + nt * 128 + wc * 32 + fq * 8 + (ni >> 1) * 4;
        const f32x4 c4 = *(const f32x4*)(cs + col), b4 = *(const f32x4*)(bw + col);
#pragma unroll
        for (int mi = 0; mi < 8; ++mi) acc[mi][ni] = (acc[mi][ni] - mean[mi] * c4) * rstd[mi] + b4;
    }
}
struct TJob { const float* src; int ldsrc; int K; int col0; int ncols; bf16_t* dst; int mode; int rowoff; const float* g; const float* b; float* part;   };
__device__ __forceinline__ int tjob_row(const TJob& j, int c) {
    if (j.mode == 0) return j.rowoff + c;
    const int oc = c & 127;
    return 256 * (c >> 7) + 64 * (oc >> 5) + 16 * (2 * ((oc >> 2) & 1) + j.rowoff) + 4 * ((oc >> 3) & 3) + (oc & 3);
}
__device__ __forceinline__ void transpose_tile(char* smem, const TJob& j, int kt, int ct) {
    float* tile = (float*)smem;
    float* red = tile + 64 * 65;
    const int tid = opaque_tid();
    float scs = 0.f, sbw = 0.f;
#pragma unroll
    for (int i = 0; i < 8; ++i) {
        const int e = tid + i * NTHR, kr = e >> 6, c = e & 63;
        const int cc = ct * 64 + c;
        float v = 0.f;
        if (cc < j.ncols) v = j.src[(long)(kt * 64 + kr) * j.ldsrc + j.col0 + cc];
        if (j.g) {
            const float gv = j.g[kt * 64 + kr], bv = j.b[kt * 64 + kr];
            sbw += bv * v;
            v *= gv;
            scs += __uint_as_float(pk_bf16(v, 0.f) << 16);
        }
        tile[kr * 65 + c] = v;
    }
    if (j.g) { red[(tid >> 6) * 64 + (tid & 63)] = scs; red[512 + (tid >> 6) * 64 + (tid & 63)] = sbw; }
    __syncthreads();
#pragma unroll
    for (int i = 0; i < 4; ++i) {
        const int e = tid + i * NTHR, c = e >> 5, k2 = (e & 31) * 2;
        const int cc = ct * 64 + c;
        if (cc < j.ncols) {
            const unsigned w = pk_bf16(tile[k2 * 65 + c], tile[(k2 + 1) * 65 + c]);
            *(unsigned*)(j.dst + (long)tjob_row(j, cc) * j.K + kt * 64 + k2) = w;
        }
    }
    if (j.g && tid < 128) {
        const int which = tid >> 6, c = tid & 63;
        float s = 0.f;
#pragma unroll
        for (int w = 0; w < 8; ++w) s += red[which * 512 + w * 64 + c];
        if (ct * 64 + c < j.ncols) j.part[(long)(which * 16 + kt) * 1792 + ct * 64 + c] = s;
    }
    __syncthreads();
}

__device__ __forceinline__ void tjob_run(int& g_rot, char* smem, int bid, int nb, const float* src, int ld, int K, int col0, int ncols, bf16_t* dst, int mode, int rowoff,
                                         const float* g = nullptr, const float* b = nullptr, float* part = nullptr) {
    TJob j; j.src = src; j.ldsrc = ld; j.K = K; j.col0 = col0; j.ncols = ncols; j.dst = dst; j.mode = mode; j.rowoff = rowoff; j.g = g; j.b = b; j.part = part;
    const int nkt = K / 64, nct = (ncols + 63) / 64, ntile = nkt * nct;
    const int first = (bid + nb - g_rot % nb) % nb;
    for (int t = first; t < ntile; t += nb) transpose_tile(smem, j, t % nkt, t / nkt);
    g_rot += ntile;
}

__device__ __forceinline__ void cvt_rows_bf16(const float* src, bf16_t* dst, long n8, int bid, int nb) {
    for (long i = (long)bid * NTHR + opaque_tid(); i < n8; i += (long)nb * NTHR) {
        const f32x4 a = *(const f32x4*)(src + i * 8), b = *(const f32x4*)(src + i * 8 + 4);
        u32x4 w; w.x = pk_bf16(a[0], a[1]); w.y = pk_bf16(a[2], a[3]); w.z = pk_bf16(b[0], b[1]); w.w = pk_bf16(b[2], b[3]);
        *(u32x4*)(dst + i * 8) = w;
    }
}

enum { I_X = 0, I_MEM, I_WIN, I_POSK, I_CKW1, I_CKW2, I_POSV, I_CVW1, I_CVW2, I_CONVW, I_IBIAS, I_FBIAS, I_NORMG, I_WOUT, I_LN1G, I_LN1B,
       I_XAWQ, I_XAWK, I_XAWV, I_XAWO, I_LN2G, I_LN2B, I_ROUTW, I_ROUTB, I_MW1, I_MW3, I_MW2, I_SW1, I_SW3, I_SW2, I_LN3G, I_LN3B };

__device__ __forceinline__ void phase0(const Params& p, char* smem, int bid, int nb) {
    char* ws = p.ws;
    int rot = 0;
    tjob_run(rot, smem, bid, nb, p.in[I_WIN], 3360, 1024, 0, 1280, (bf16_t*)(ws + WS_WIN), 0, 0);
    tjob_run(rot, smem, bid, nb, p.in[I_WIN], 3360, 1024, 1304, 2048, (bf16_t*)(ws + WS_WIN), 0, 1280);
    tjob_run(rot, smem, bid, nb, p.in[I_WIN], 3360, 1024, 1280, 24, (bf16_t*)(ws + WS_WIN), 0, 3328);
    tjob_run(rot, smem, bid, nb, p.in[I_WIN], 3360, 1024, 3352, 8, (bf16_t*)(ws + WS_WIN), 0, 3352);
    tjob_run(rot, smem, bid, nb, p.in[I_WOUT], 1024, 1024, 0, 1024, (bf16_t*)(ws + WS_WOUT), 0, 0);
    float* lnp = (float*)(ws + WS_LNP);
    tjob_run(rot, smem, bid, nb, p.in[I_XAWQ], 1024, 1024, 0, 1024, (bf16_t*)(ws + WS_WQ), 0, 0, p.in[I_LN1G], p.in[I_LN1B], lnp);
    tjob_run(rot, smem, bid, nb, p.in[I_XAWK], 1024, 1024, 0, 1024, (bf16_t*)(ws + WS_WKV), 0, 0);
    tjob_run(rot, smem, bid, nb, p.in[I_XAWV], 1024, 1024, 0, 1024, (bf16_t*)(ws + WS_WKV), 0, 1024);
    tjob_run(rot, smem, bid, nb, p.in[I_XAWO], 1024, 1024, 0, 1024, (bf16_t*)(ws + WS_WO), 0, 0);
    tjob_run(rot, smem, bid, nb, p.in[I_ROUTW], 256, 1024, 0, 256, (bf16_t*)(ws + WS_WR), 0, 0, p.in[I_LN2G], p.in[I_LN2B], lnp + 1024);
    tjob_run(rot, smem, bid, nb, p.in[I_SW1], 256, 1024, 0, 256, (bf16_t*)(ws + WS_WS13), 1, 0, p.in[I_LN2G], p.in[I_LN2B], lnp + 1280);
    tjob_run(rot, smem, bid, nb, p.in[I_SW3], 256, 1024, 0, 256, (bf16_t*)(ws + WS_WS13), 1, 1, p.in[I_LN2G], p.in[I_LN2B], lnp + 1536);
    tjob_run(rot, smem, bid, nb, p.in[I_SW2], 1024, 256, 0, 1024, (bf16_t*)(ws + WS_WS2), 0, 0);
    tjob_run(rot, smem, bid, nb, p.in[I_CKW1], 64, 2048, 0, 64, (bf16_t*)(ws + WS_CK1), 0, 0);
    tjob_run(rot, smem, bid, nb, p.in[I_CKW2], 64, 64, 0, 64, (bf16_t*)(ws + WS_CK2), 0, 0);
    tjob_run(rot, smem, bid, nb, p.in[I_CVW1], 64, 2048, 0, 64, (bf16_t*)(ws + WS_CV1), 0, 0);
    tjob_run(rot, smem, bid, nb, p.in[I_CVW2], 64, 64, 0, 64, (bf16_t*)(ws + WS_CV2), 0, 0);
    cvt_rows_bf16(p.in[I_X], (bf16_t*)(ws + WS_XB), (long)T_TOK * 1024 / 8, bid, nb);
    cvt_rows_bf16(p.in[I_MEM], (bf16_t*)(ws + WS_MEMB), (long)4096 * 1024 / 8, bid, nb);
    { int* c = (int*)(ws + WS_CNT); for (int i = bid * NTHR + opaque_tid(); i < 24576; i += nb * NTHR) c[i] = 0; }
}

__device__ __forceinline__ void small_cols_task(const Params& p, int task) {
    const bf16_t* xb = (const bf16_t*)(p.ws + WS_XB);
    const bf16_t* wt = (const bf16_t*)(p.ws + WS_WIN) + (long)3328 * 1024;
    float* psm = (float*)(p.ws + WS_PSM);
    const int tid_ = opaque_tid();
    const int lane = tid_ & 63, wid = tid_ >> 6, fr = lane & 15, fq = lane >> 4;
    const int r0 = task * 256 + wid * 32;
    f32x4 acc[2][2];
#pragma unroll
    for (int mi = 0; mi < 2; ++mi)
#pragma unroll
        for (int ni = 0; ni < 2; ++ni) acc[mi][ni] = (f32x4){0.f, 0.f, 0.f, 0.f};
    const bf16_t* ap0 = xb + (long)(r0 + fr) * 1024 + fq * 8;
    const bf16_t* ap1 = ap0 + 16 * 1024;
    const bf16_t* bp0 = wt + (long)fr * 1024 + fq * 8;
    const bf16_t* bp1 = bp0 + 16 * 1024;
#pragma unroll 4
    for (int ks = 0; ks < 32; ++ks) {
        const bf16x8 a0 = *(const bf16x8*)(ap0 + ks * 32), a1 = *(const bf16x8*)(ap1 + ks * 32);
        const bf16x8 b0 = *(const bf16x8*)(bp0 + ks * 32), b1 = *(const bf16x8*)(bp1 + ks * 32);
        acc[0][0] = mfma16(b0, a0, acc[0][0]); acc[0][1] = mfma16(b1, a0, acc[0][1]);
        acc[1][0] = mfma16(b0, a1, acc[1][0]); acc[1][1] = mfma16(b1, a1, acc[1][1]);
    }
#pragma unroll
    for (int mi = 0; mi < 2; ++mi)
#pragma unroll
        for (int ni = 0; ni < 2; ++ni) *(f32x4*)(psm + (long)(r0 + mi * 16 + fr) * 32 + ni * 16 + fq * 4) = acc[mi][ni];
}

template <int NOEPI = 0>
__device__ __forceinline__ void phase1(const Params& p, char* smem, int bid, int nb) {
    char* ws = p.ws;
    XcdSlab xs; xs.init(bid, nb);
    const int a_lo = xs.m_lo(128), a_n = (xs.m_hi(128) - a_lo) * 14;
    const int b_lo = xs.m_lo(16), b_n = (xs.m_hi(16) - b_lo) * 8;
    bool inp = false; int mt = 0, nt = 0;
    RingRows al, bl;
    auto setup = [&](int u) {
        inp = u < a_n;
        const int uu = inp ? u : u - a_n;
        const int nm = inp ? (xs.m_hi(128) - a_lo) : (xs.m_hi(16) - b_lo);
        mt = (inp ? a_lo : b_lo) + uu % nm; nt = uu / nm;
        al.init_contig((const bf16_t*)(ws + (inp ? WS_XB : WS_MEMB)), 1024, mt * 256);
        bl.init_contig((const bf16_t*)(ws + (inp ? WS_WIN : WS_WKV)), 1024, nt * 256, true);
    };
    int u = xs.j;
    if (u < a_n + b_n) { setup(u); ring_issue3(smem, al, bl); }
    while (u < a_n + b_n) {
        const bool cinp = inp; const int cmt = mt, cnt_ = nt;
        f32x4 acc[8][4];
        gemm_ring<RingRows, RingRows, 0, true>(smem, al, bl, 32, acc);
        u += xs.stride;
        if (u < a_n + b_n) { setup(u); ring_issue3(smem, al, bl); }
        if (NOEPI) { float s = 0.f;
#pragma unroll
            for (int mi = 0; mi < 8; ++mi)
#pragma unroll
                for (int ni = 0; ni < 4; ++ni) s += acc[mi][ni][0] + acc[mi][ni][1] + acc[mi][ni][2] + acc[mi][ni][3];
            if (s == 123.456f) ((float*)(ws + WS_A + 432 * MB))[opaque_tid()] = s; continue; }
        if (!cinp) epi_store_bf16(acc, (bf16_t*)(ws + WS_KVX), 2048, cmt * 256, cnt_ * 256);
        else if (cnt_ < 13) epi_store_bf16(acc, (bf16_t*)(ws + WS_P), PW, cmt * 256, cnt_ * 256);
        else {
            const int tid_ = opaque_tid();
            const int lane = tid_ & 63, wid = tid_ >> 6, wr = wid >> 2, wc = wid & 3, fr = lane & 15, fq = lane >> 4;
            if (wc == 0) {
                float* psm = (float*)(ws + WS_PSM);
#pragma unroll
                for (int mi = 0; mi < 8; ++mi)
#pragma unroll
                    for (int ni = 0; ni < 2; ++ni) *(f32x4*)(psm + (long)(cmt * 256 + wr * 128 + mi * 16 + fr) * 32 + fq * 8 + ni * 4) = acc[mi][ni];
            }
        }
    }
    asm volatile("s_waitcnt vmcnt(0)" ::: "memory");
}

__device__ __forceinline__ void compress_task(const Params& p, char* smem, int which, int rb) {
    const char* ws = p.ws;
    const bf16_t* P = (const bf16_t*)(ws + WS_P);
    const float* pos = p.in[which ? I_POSV : I_POSK];
    const bf16_t* w1t = (const bf16_t*)(ws + (which ? WS_CV1 : WS_CK1));
    const bf16_t* w2t = (const bf16_t*)(ws + (which ? WS_CV2 : WS_CK2));
    bf16_t* outp = (bf16_t*)(p.ws + (which ? WS_VCMP : WS_KCMP));
    const int colbase = which ? PC_VC : PC_KC;
    const int tid_ = opaque_tid();
    const int lane = tid_ & 63, wid = tid_ >> 6, fr = lane & 15, fq = lane >> 4;
    f32x4 acc[2][4];
#pragma unroll
    for (int mi = 0; mi < 2; ++mi)
#pragma unroll
        for (int ni = 0; ni < 4; ++ni) acc[mi][ni] = (f32x4){0.f, 0.f, 0.f, 0.f};
    const bf16_t* arow[2];
#pragma unroll
    for (int mi = 0; mi < 2; ++mi) {
        const int r = rb * 32 + mi * 16 + fr;
        const int b = r / 254, rem = r - b * 254, c = rem >> 1, g = rem & 1;
        arow[mi] = P + (long)(b * 2048 + c * 16) * PW + colbase + g * 64 + fq * 8;
    }
    const bf16_t* brow = w1t + (long)fr * 2048 + fq * 8;
    const float* prow = pos + fq * 8;
#pragma unroll 2
    for (int s = 0; s < 8; ++s) {
        const int ks = wid * 8 + s;
        const int l = ks >> 1, d0 = (ks & 1) * 32;
        const f32x4 p0 = *(const f32x4*)(prow + l * 64 + d0), p1 = *(const f32x4*)(prow + l * 64 + d0 + 4);
        bf16x8 af[2];
#pragma unroll
        for (int mi = 0; mi < 2; ++mi) {
            const u32x4 av = *(const u32x4*)(arow[mi] + (long)l * PW + d0);
            u32x4 aw;
            aw.x = pk_bf16(bf_lo(av.x) + p0[0], bf_hi(av.x) + p0[1]); aw.y = pk_bf16(bf_lo(av.y) + p0[2], bf_hi(av.y) + p0[3]);
            aw.z = pk_bf16(bf_lo(av.z) + p1[0], bf_hi(av.z) + p1[1]); aw.w = pk_bf16(bf_lo(av.w) + p1[2], bf_hi(av.w) + p1[3]);
            af[mi] = as_bf16x8(aw);
        }
#pragma unroll
        for (int ni = 0; ni < 4; ++ni) {
            const bf16x8 bb = *(const bf16x8*)(brow + (long)(ni * 16) * 2048 + ks * 32);
            acc[0][ni] = mfma16(bb, af[0], acc[0][ni]);
            acc[1][ni] = mfma16(bb, af[1], acc[1][ni]);
        }
    }
    f32x4* part = (f32x4*)(smem + 8192);
#pragma unroll
    for (int mi = 0; mi < 2; ++mi)
#pragma unroll
        for (int ni = 0; ni < 4; ++ni) part[(wid * 8 + mi * 4 + ni) * 64 + lane] = acc[mi][ni];
    __syncthreads();
    const int mi = wid >> 2, ni = wid & 3;
    f32x4 a1 = (f32x4){0.f, 0.f, 0.f, 0.f};
#pragma unroll
    for (int w = 0; w < 8; ++w) a1 = a1 + part[(w * 8 + wid) * 64 + lane];
    bf16_t* h1 = (bf16_t*)smem;
    {
        u32x2 w; w.x = pk_bf16(siluf_(a1[0]), siluf_(a1[1])); w.y = pk_bf16(siluf_(a1[2]), siluf_(a1[3]));
        *(u32x2*)(h1 + (mi * 16 + fr) * 72 + ni * 16 + fq * 4) = w;
    }
    __syncthreads();
    f32x4 acc2 = (f32x4){0.f, 0.f, 0.f, 0.f};
#pragma unroll
    for (int ks = 0; ks < 2; ++ks) {
        const bf16x8 a = *(const bf16x8*)(h1 + (mi * 16 + fr) * 72 + ks * 32 + fq * 8);
        const bf16x8 bb = *(const bf16x8*)(w2t + (ni * 16 + fr) * 64 + ks * 32 + fq * 8);
        acc2 = mfma16(bb, a, acc2);
    }
    {
        const int r = rb * 32 + mi * 16 + fr;
        const int b = r / 254, rem = r - b * 254, c = rem >> 1, g = rem & 1;
        u32x2 w; w.x = pk_bf16(acc2[0], acc2[1]); w.y = pk_bf16(acc2[2], acc2[3]);
        *(u32x2*)(outp + ((long)(b * 2 + g) * 128 + c) * 64 + ni * 16 + fq * 4) = w;
    }
    __syncthreads();
}

__device__ __forceinline__ void phase2(const Params& p, char* smem, int bid, int nb) {
    char* ws = p.ws;
    {
        const int idx = bid * NTHR + opaque_tid();
        if (idx < 2 * 1792) {
            const float* pp = (const float*)(ws + WS_LNP) + (long)(idx / 1792) * 16 * 1792 + idx % 1792;
            float s = 0.f;
#pragma unroll
            for (int k = 0; k < 16; ++k) s += pp[k * 1792];
            ((float*)(ws + WS_LNF))[idx] = s;
        }
    }
    for (int t = bid; t < 254; t += nb) compress_task(p, smem, t / 127, t % 127);
    const int tid_ = opaque_tid();
    if (bid < 32 && tid_ < 32) {
        bf16_t* kc = (bf16_t*)(ws + WS_KCMP) + ((long)bid * 128 + 127) * 64;
        bf16_t* vc = (bf16_t*)(ws + WS_VCMP) + ((long)bid * 128 + 127) * 64;
        ((unsigned*)kc)[tid_] = 0u; ((unsigned*)vc)[tid_] = 0u;
    }
    const bf16_t* P = (const bf16_t*)(ws + WS_P);
    const float* cw = p.in[I_CONVW];
    bf16_t* qk = (bf16_t*)(ws + WS_QK);
    for (long it = (long)bid * NTHR + tid_; it < (long)T_TOK * 128; it += (long)nb * NTHR) {
        const int t = (int)(it >> 7), ch = (int)(it & 127);
        const int s = t & (SEQ - 1);
        float a[8];
#pragma unroll
        for (int e = 0; e < 8; ++e) a[e] = 0.f;
#pragma unroll
        for (int j = 0; j < 4; ++j) {
            if (s - 3 + j >= 0) {
                const u32x4 u = *(const u32x4*)(P + (long)(t - 3 + j) * PW + PC_MQ + ch * 8);
                const f32x4 w0 = *(const f32x4*)(cw + j * 1024 + ch * 8), w1 = *(const f32x4*)(cw + j * 1024 + ch * 8 + 4);
                a[0] += w0[0] * bf_lo(u.x); a[1] += w0[1] * bf_hi(u.x); a[2] += w0[2] * bf_lo(u.y); a[3] += w0[3] * bf_hi(u.y);
                a[4] += w1[0] * bf_lo(u.z); a[5] += w1[1] * bf_hi(u.z); a[6] += w1[2] * bf_lo(u.w); a[7] += w1[3] * bf_hi(u.w);
            }
        }
        const float sc = ch < 64 ? 0.08838834764831845f : 1.0f;
        u32x4 w;
        w.x = pk_bf16(siluf_(a[0]) * sc, siluf_(a[1]) * sc); w.y = pk_bf16(siluf_(a[2]) * sc, siluf_(a[3]) * sc);
        w.z = pk_bf16(siluf_(a[4]) * sc, siluf_(a[5]) * sc); w.w = pk_bf16(siluf_(a[6]) * sc, siluf_(a[7]) * sc);
        *(u32x4*)(qk + (long)t * 1024 + ch * 8) = w;
    }
}

typedef __attribute__((address_space(3))) s16x4 lds_s16x4;
__device__ __forceinline__ s16x4 lds_tr(const char* a) { return __builtin_amdgcn_ds_read_tr16_b64_v4i16((lds_s16x4*)a); }
__device__ __forceinline__ bf16x8 tr_frag_perm(const char* base, int pitch, int rbase, int cbase, int fr, int fq) {
    const char* a0 = base + (rbase + 4 * fq + (fr >> 2)) * pitch + (cbase + 4 * (fr & 3)) * 2;
    const s16x4 lo = lds_tr(a0), hi = lds_tr(a0 + 16 * pitch);
    return (bf16x8){lo[0], lo[1], lo[2], lo[3], hi[0], hi[1], hi[2], hi[3]};
}
__device__ __forceinline__ bf16x8 tr_frag_std(const char* base, int pitch, int rbase, int cbase, int fr, int fq) {
    const char* a0 = base + (rbase + 8 * fq + (fr >> 2)) * pitch + (cbase + 4 * (fr & 3)) * 2;
    const s16x4 lo = lds_tr(a0), hi = lds_tr(a0 + 4 * pitch);
    return (bf16x8){lo[0], lo[1], lo[2], lo[3], hi[0], hi[1], hi[2], hi[3]};
}
__device__ __forceinline__ bf16x8 pack_p(const f32x4 a, const f32x4 b) {
    u32x4 w; w.x = pk_bf16(a[0], a[1]); w.y = pk_bf16(a[2], a[3]); w.z = pk_bf16(b[0], b[1]); w.w = pk_bf16(b[2], b[3]);
    return as_bf16x8(w);
}

__device__ __forceinline__ float dpp_xor1(float v) { return __builtin_bit_cast(float, __builtin_amdgcn_mov_dpp(__builtin_bit_cast(int, v), 0xB1, 0xF, 0xF, true)); }
__device__ __forceinline__ float dpp_xor2(float v) { return __builtin_bit_cast(float, __builtin_amdgcn_mov_dpp(__builtin_bit_cast(int, v), 0x4E, 0xF, 0xF, true)); }

constexpr int NSA_PITCH = 160;
constexpr int NSA_KC = 0, NSA_VC = 20480, NSA_KT = 40960, NSA_VT = 61440, NSA_MISC = 81920, NSA_Y = 83968;

struct NsaState {
    bf16x8 qf[2][2];
    int tl[2];
    unsigned selm[2];
    unsigned wunion, bunion;
};

constexpr int NSA_STG = 16384;
__device__ __forceinline__ float fq_max(float x) {
    auto a = __builtin_amdgcn_permlane16_swap(__float_as_uint(x), __float_as_uint(x), false, false);
    x = __builtin_fmaxf(__uint_as_float(a[0]), __uint_as_float(a[1]));
    auto b = __builtin_amdgcn_permlane32_swap(__float_as_uint(x), __float_as_uint(x), false, false);
    return __builtin_fmaxf(__uint_as_float(b[0]), __uint_as_float(b[1]));
}
__device__ __forceinline__ float fq_sum(float x) {
    auto a = __builtin_amdgcn_permlane16_swap(__float_as_uint(x), __float_as_uint(x), false, false);
    x = __uint_as_float(a[0]) + __uint_as_float(a[1]);
    auto b = __builtin_amdgcn_permlane32_swap(__float_as_uint(x), __float_as_uint(x), false, false);
    return __uint_as_float(b[0]) + __uint_as_float(b[1]);
}
__device__ __forceinline__ bf16x8 tr_frag_perm_swz(const char* base, int rbase, int dt, int fr, int fq) {
    const int R = rbase + 4 * fq + (fr >> 2), c = 2 * dt + ((fr & 3) >> 1);
    const char* a0 = base + R * 128 + ((c ^ (R & 7)) << 4) + 8 * (fr & 1);
    const s16x4 lo = lds_tr(a0), hi = lds_tr(a0 + 16 * 128);
    return (bf16x8){lo[0], lo[1], lo[2], lo[3], hi[0], hi[1], hi[2], hi[3]};
}
#define NSA_WAITV(n) asm volatile("s_waitcnt vmcnt(" #n ")" ::: "memory")
#define NSA_BAR() do { asm volatile("s_waitcnt lgkmcnt(0)" ::: "memory"); __builtin_amdgcn_s_barrier(); asm volatile("" ::: "memory"); } while (0)

template <int MODE>
__device__ __forceinline__ void nsa_stream(char* smem, const bf16_t* Pb  , int g, int i, NsaState& st, float gate0, float gate1, const int tid) {
    const int lane = tid & 63, fr = lane & 15, fq = lane >> 4;
    const int kcol = (MODE == 0 ? PC_KS : PC_KW) + g * 64, vcol = (MODE == 0 ? PC_VS : PC_VW) + g * 64;
    const int lrow = tid >> 3, lch = (tid & 7) ^ (lrow & 7);
    const bf16_t* ksrc = Pb + (long)lrow * PW + kcol + lch * 8;
    const bf16_t* vsrc = Pb + (long)lrow * PW + vcol + lch * 8;
    const int jlo = MODE == 0 ? 0 : (i - 8 > 0 ? i - 8 : 0);
    const unsigned range = (i >= 31 ? 0xffffffffu : ((1u << (i + 1)) - 1u)) & ~((1u << jlo) - 1u);
    const unsigned need = (unsigned)__builtin_amdgcn_readfirstlane((int)((MODE == 0 ? st.bunion : 0xffffffffu) & range));
    f32x4 O[2][4];
    float m[2], l[2];
    int tlq[2];
#pragma unroll
    for (int mt = 0; mt < 2; ++mt) { m[mt] = -1e30f; l[mt] = 0.f; tlq[mt] = st.tl[mt] - 4 * fq;
#pragma unroll
        for (int dt = 0; dt < 4; ++dt) O[mt][dt] = (f32x4){0.f, 0.f, 0.f, 0.f}; }
    unsigned pm = need;
    int nissued = 0;
    auto issue_next = [&]() {
        const int jj = __builtin_ctz(pm); pm &= pm - 1u;
        char* sb = smem + (nissued & 3) * NSA_STG;
        __builtin_amdgcn_global_load_lds((glb_u32*)(ksrc + (long)jj * 64 * PW), (lds_u32*)(sb + tid * 16), 16, 0, 0);
        __builtin_amdgcn_global_load_lds((glb_u32*)(vsrc + (long)jj * 64 * PW), (lds_u32*)(sb + 8192 + tid * 16), 16, 0, 0);
        ++nissued;
    };
    const int L = __builtin_popcount(need);
    if (L > 0) issue_next();
    if (L > 1) issue_next();
    if (L > 2) issue_next();
    if (L > 2) NSA_WAITV(4); else if (L > 1) NSA_WAITV(2); else NSA_WAITV(0);
    NSA_BAR();
    unsigned cm = need;
    for (int n = 0; n < L; ++n) {
        const int j = __builtin_ctz(cm); cm &= cm - 1u;
        if (n + 3 < L) issue_next();
        const char* KT = smem + (n & 3) * NSA_STG;
        const char* VT = KT + 8192;
        const bool wave_on = MODE == 0 ? (((st.wunion >> j) & 1u) != 0u) : true;
        if (wave_on) {
            f32x4 S[2][4];
            {
                bf16x8 kf[4][2];
#pragma unroll
                for (int nt = 0; nt < 4; ++nt)
#pragma unroll
                    for (int ks = 0; ks < 2; ++ks) kf[nt][ks] = *(const bf16x8*)(KT + (16 * nt + fr) * 128 + (((ks * 4 + fq) ^ (fr & 7)) << 4));
#pragma unroll
                for (int mt = 0; mt < 2; ++mt)
#pragma unroll
                    for (int nt = 0; nt < 4; ++nt) {
                        f32x4 s = (f32x4){0.f, 0.f, 0.f, 0.f};
                        s = mfma16(kf[nt][0], st.qf[mt][0], s);
                        s = mfma16(kf[nt][1], st.qf[mt][1], s);
                        S[mt][nt] = s;
                    }
            }
            bf16x8 pf[2][2];
            const bool edge = (j == i) || (MODE == 1 && j == i - 8);
            constexpr float CS = 0.125f * 1.4426950408889634f;
#pragma unroll
            for (int mt = 0; mt < 2; ++mt) {
                const bool rowsel = MODE == 0 ? (((st.selm[mt] >> j) & 1u) != 0u) : true;
                if (edge) {
                    asm volatile("; boundary tile" ::: "memory");
#pragma unroll
                    for (int nt = 0; nt < 4; ++nt)
#pragma unroll
                        for (int e = 0; e < 4; ++e) {
                            const int kc = 16 * nt + e;
                            bool ok = true;
                            if (j == i) ok = ok && (kc <= tlq[mt]);
                            if (MODE == 1) { if (j == i - 8) ok = ok && (kc > tlq[mt]); }
                            S[mt][nt][e] = ok ? S[mt][nt][e] : -INFINITY;
                        }
                }
                float mx = -INFINITY;
#pragma unroll
                for (int nt = 0; nt < 4; ++nt)
#pragma unroll
                    for (int e = 0; e < 4; ++e) mx = __builtin_fmaxf(mx, S[mt][nt][e]);
                mx = fq_max(mx);
                if (MODE == 0) mx = rowsel ? mx : -INFINITY;
                const float mnew = __builtin_fmaxf(m[mt], mx * CS);
                const float alpha = __builtin_amdgcn_exp2f(m[mt] - mnew);
                const float msub = (MODE == 0 && !rowsel) ? INFINITY : mnew;
                float rs = 0.f;
#pragma unroll
                for (int nt = 0; nt < 4; ++nt)
#pragma unroll
                    for (int e = 0; e < 4; ++e) { const float pv = __builtin_amdgcn_exp2f(__builtin_fmaf(S[mt][nt][e], CS, -msub)); S[mt][nt][e] = pv; rs += pv; }
                rs = fq_sum(rs);
                l[mt] = l[mt] * alpha + rs; m[mt] = mnew;
#pragma unroll
                for (int dt = 0; dt < 4; ++dt) O[mt][dt] = O[mt][dt] * alpha;
                pf[mt][0] = pack_p(S[mt][0], S[mt][1]); pf[mt][1] = pack_p(S[mt][2], S[mt][3]);
            }
#pragma unroll
            for (int ks2 = 0; ks2 < 2; ++ks2)
#pragma unroll
                for (int dt = 0; dt < 4; ++dt) {
                    const bf16x8 vf = tr_frag_perm_swz(VT, 32 * ks2, dt, fr, fq);
                    O[0][dt] = mfma16(vf, pf[0][ks2], O[0][dt]);
                    O[1][dt] = mfma16(vf, pf[1][ks2], O[1][dt]);
                }
        }
        if (n + 1 < L) { if (n + 3 < L) NSA_WAITV(4); else if (n + 2 < L) NSA_WAITV(2); else NSA_WAITV(0); }
        NSA_BAR();
    }
#pragma unroll
    for (int mt = 0; mt < 2; ++mt) {
        const float gsc = (mt == 0 ? gate0 : gate1) * (l[mt] > 0.f ? 1.0f / l[mt] : 0.f);
#pragma unroll
        for (int dt = 0; dt < 4; ++dt) { f32x4* yp = (f32x4*)(smem + NSA_Y) + (mt * 4 + dt) * NTHR + tid; *yp = *yp + O[mt][dt] * gsc; }
    }
}

__device__ __forceinline__ void nsa_cmp_one(const char* smem, const bf16x8 qf0, const bf16x8 qf1, const int t, const int i, const float gate0, f32x4* yp  , unsigned& selm, const int lane) {
    const int fr = lane & 15, fq = lane >> 4;
        const int cl = (t >= 31 ? ((t - 31) >> 4) : -1) - 4 * fq;
        f32x4 S[8];
#pragma unroll
        for (int nt = 0; nt < 8; ++nt) {
            f32x4 s = (f32x4){0.f, 0.f, 0.f, 0.f};
#pragma unroll
            for (int ks = 0; ks < 2; ++ks) {
                const bf16x8 kf = *(const bf16x8*)(smem + NSA_KC + (16 * nt + fr) * NSA_PITCH + (ks * 4 + fq) * 16);
                s = mfma16(kf, (ks == 0 ? qf0 : qf1), s);
            }
            S[nt] = s;
        }
        float mx = -INFINITY;
#pragma unroll
        for (int nt = 0; nt < 8; ++nt)
#pragma unroll
            for (int e = 0; e < 4; ++e) {
                const float sv = (16 * nt + e <= cl) ? S[nt][e] * 0.125f : -INFINITY;
                S[nt][e] = sv; mx = fmaxf(mx, sv);
            }
        mx = fmaxf(mx, __shfl_xor(mx, 16)); mx = fmaxf(mx, __shfl_xor(mx, 32));
        const float mref = fmaxf(mx, -1e30f);
        float rs = 0.f;
#pragma unroll
        for (int nt = 0; nt < 8; ++nt)
#pragma unroll
            for (int e = 0; e < 4; ++e) { const float pv = __expf(S[nt][e] - mref); S[nt][e] = pv; rs += pv; }
        rs += __shfl_xor(rs, 16); rs += __shfl_xor(rs, 32);
        const float inv = rs > 0.f ? 1.0f / rs : 0.f;
#pragma unroll
        for (int nt = 0; nt < 8; ++nt) S[nt] = S[nt] * inv;
        {
            f32x4 O[4];
#pragma unroll
            for (int dt = 0; dt < 4; ++dt) O[dt] = (f32x4){0.f, 0.f, 0.f, 0.f};
#pragma unroll
            for (int ks2 = 0; ks2 < 4; ++ks2) {
                const bf16x8 pf = pack_p(S[2 * ks2], S[2 * ks2 + 1]);
#pragma unroll
                for (int dt = 0; dt < 4; ++dt) {
                    const bf16x8 vf = tr_frag_perm(smem + NSA_VC, NSA_PITCH, 32 * ks2, 16 * dt, fr, fq);
                    O[dt] = mfma16(vf, pf, O[dt]);
                }
            }
#pragma unroll
            for (int dt = 0; dt < 4; ++dt) yp[dt * NTHR] = O[dt] * gate0;
        }
        float imp[8];
        {
            float own[8], last[8];
#pragma unroll
            for (int nt = 0; nt < 8; ++nt) {
                f32x4 v = S[nt];
#pragma unroll
                for (int e = 0; e < 4; ++e) { v[e] += dpp_xor1(v[e]); v[e] += dpp_xor2(v[e]); }
                own[nt] = (v[0] + v[1]) + (v[2] + v[3]); last[nt] = v[3];
            }
            const int src = (lane + 48) & 63;
#pragma unroll
            for (int nt = 0; nt < 8; ++nt) {
                const float a = __shfl(last[nt], src);
                const float bsh = nt > 0 ? __shfl(last[nt > 0 ? nt - 1 : 0], src) : 0.f;
                const float prevc = fq > 0 ? a : bsh;
                const int n = 4 * nt + fq;
                const float pslc = own[nt] + prevc;
                const bool valid = n <= i;
                const bool forced = (n == 0) || (n == i) || (n == i - 1);
                imp[nt] = valid ? pslc + (forced ? 1e4f : 0.f) : -1e30f;
            }
        }
        unsigned mask = 0u;
#pragma unroll 1
        for (int r = 0; r < 8; ++r) {
            float bv = imp[0]; int bn = fq;
#pragma unroll
            for (int nt = 1; nt < 8; ++nt) { if (imp[nt] > bv) { bv = imp[nt]; bn = 4 * nt + fq; } }
#pragma unroll
            for (int off = 16; off <= 32; off <<= 1) {
                const float ov = __shfl_xor(bv, off); const int on = __shfl_xor(bn, off);
                if (ov > bv || (ov == bv && on < bn)) { bv = ov; bn = on; }
            }
            if (bv > -5e29f) mask |= 1u << bn;
#pragma unroll
            for (int nt = 0; nt < 8; ++nt) if (bn == 4 * nt + fq) imp[nt] = -3.0e38f;
        }
        selm = mask;
}

template <int NSAV = 7  >
__device__ __forceinline__ void nsa_task(const Params& p, char* smem, int b, int g, int i) {
    const char* ws = p.ws;
    const bf16_t* Pb = (const bf16_t*)(ws + WS_P) + (long)b * SEQ * PW;
    const float* psm = (const float*)(ws + WS_PSM) + (long)b * SEQ * 32;
    int tid = threadIdx.x;
    asm volatile("" : "+v"(tid));
    const int lane = tid & 63, wid = __builtin_amdgcn_readfirstlane(tid >> 6), fr = lane & 15, fq = lane >> 4;
    const int qs = i * 64;
    NsaState st;
    float gate[2][3];
#pragma unroll
    for (int mt = 0; mt < 2; ++mt) {
        st.tl[mt] = 8 * wid + 4 * mt + (fr >> 2);
        const int h = fr & 3;
        const bf16_t* qp = Pb + (long)(qs + st.tl[mt]) * PW + PC_Q + g * 256 + h * 64 + fq * 8;
        st.qf[mt][0] = *(const bf16x8*)(qp); st.qf[mt][1] = *(const bf16x8*)(qp + 32);
        const float* gp = psm + (long)(qs + st.tl[mt]) * 32 + (g * 4 + h) * 3;
        gate[mt][0] = sigmoidf_(gp[0]); gate[mt][1] = sigmoidf_(gp[1]); gate[mt][2] = sigmoidf_(gp[2]);
    }
    {
        const bf16_t* kc = (const bf16_t*)(ws + WS_KCMP) + (long)(b * 2 + g) * 128 * 64;
        const bf16_t* vc = (const bf16_t*)(ws + WS_VCMP) + (long)(b * 2 + g) * 128 * 64;
#pragma unroll
        for (int r = 0; r < 2; ++r) {
            const int e = tid + r * NTHR, row = e >> 3, ch = e & 7;
            *(u32x4*)(smem + NSA_KC + row * NSA_PITCH + ch * 16) = *(const u32x4*)(kc + row * 64 + ch * 8);
            *(u32x4*)(smem + NSA_VC + row * NSA_PITCH + ch * 16) = *(const u32x4*)(vc + row * 64 + ch * 8);
        }
    }
    __syncthreads();
    if (!(NSAV & 1)) { st.selm[0] = 0xffffffffu; st.selm[1] = 0xffffffffu;
#pragma unroll
        for (int d8 = 0; d8 < 8; ++d8) ((f32x4*)(smem + NSA_Y))[d8 * NTHR + tid] = (f32x4){0.f, 0.f, 0.f, 0.f}; }
    if (NSAV & 1) {
    nsa_cmp_one(smem, st.qf[0][0], st.qf[0][1], qs + st.tl[0], i, gate[0][0], (f32x4*)(smem + NSA_Y) + tid, st.selm[0], lane);
    asm volatile("" ::: "memory");
    __builtin_amdgcn_sched_barrier(0);
    nsa_cmp_one(smem, st.qf[1][0], st.qf[1][1], qs + st.tl[1], i, gate[1][0], (f32x4*)(smem + NSA_Y) + 4 * NTHR + tid, st.selm[1], lane);
    __builtin_amdgcn_sched_barrier(0);
    }
    {
        unsigned u = st.selm[0] | st.selm[1];
        u |= __shfl_xor(u, 4); u |= __shfl_xor(u, 8);
        st.wunion = u;
        unsigned* misc = (unsigned*)(smem + NSA_MISC);
        if (lane == 0) misc[wid] = u;
        __syncthreads();
        unsigned bu = 0u;
#pragma unroll
        for (int w = 0; w < 8; ++w) bu |= misc[w];
        st.bunion = bu;
    }
    if (NSAV & 2) nsa_stream<0>(smem, Pb, g, i, st, gate[0][1], gate[1][1], tid);
    if (NSAV & 4) nsa_stream<1>(smem, Pb, g, i, st, gate[0][2], gate[1][2], tid);
    bf16_t* mix = (bf16_t*)(p.ws + WS_MIX) + (long)b * SEQ * 1024;
#pragma unroll
    for (int mt = 0; mt < 2; ++mt) {
        bf16_t* op = mix + (long)(qs + st.tl[mt]) * 1024 + g * 256 + (fr & 3) * 64 + fq * 4;
#pragma unroll
        for (int dt = 0; dt < 4; ++dt) {
            const f32x4 yv = *((const f32x4*)(smem + NSA_Y) + (mt * 4 + dt) * NTHR + tid);
            u32x2 w; w.x = pk_bf16(yv[0], yv[1]); w.y = pk_bf16(yv[2], yv[3]);
            *(u32x2*)(op + dt * 16) = w;
        }
    }
    __syncthreads();
}

constexpr int ML_PITCH = 288;
constexpr int ML_Q = 0, ML_K = 18432, ML_V = 36864, ML_VW = 55296, ML_C = 73728, ML_N = 110592, ML_GB = 111104, ML_GA = 119296, ML_GMQ = 127488,
              ML_GS = 135680, ML_ST = 136192;

__device__ __forceinline__ float wave_incl_scan_add(float v, int lane) {
#pragma unroll
    for (int off = 1; off < 64; off <<= 1) { const float o = __shfl_up(v, off); if (lane >= off) v += o; }
    return v;
}
__device__ __forceinline__ float wave_incl_scan_max(float v, int lane) {
#pragma unroll
    for (int off = 1; off < 64; off <<= 1) { const float o = __shfl_up(v, off); if (lane >= off) v = fmaxf(v, o); }
    return v;
}
__device__ __forceinline__ float wave_max(float v) {
#pragma unroll
    for (int off = 32; off >= 1; off >>= 1) v = fmaxf(v, __shfl_xor(v, off));
    return v;
}

__device__ __forceinline__ void mlstm_scan(const Params& p, char* smem, int b, int h) {
    const char* ws = p.ws;
    int tid = threadIdx.x;
    asm volatile("" : "+v"(tid));
    const int lane = tid & 63, wid = __builtin_amdgcn_readfirstlane(tid >> 6), fr = lane & 15, fq = lane >> 4;
    const bf16_t* QK = (const bf16_t*)(ws + WS_QK) + (long)b * SEQ * 1024 + h * 128;
    const bf16_t* Pb = (const bf16_t*)(ws + WS_P) + (long)b * SEQ * PW;
    const float* psm = (const float*)(ws + WS_PSM) + (long)b * SEQ * 32;
    bf16_t* mix = (bf16_t*)(p.ws + WS_MIX) + (long)b * SEQ * 1024 + 512 + h * 128;
    float* GB = (float*)(smem + ML_GB); float* GA = (float*)(smem + ML_GA); float* GMQ = (float*)(smem + ML_GMQ);
    float* GS = (float*)(smem + ML_GS);
    float* NV = (float*)(smem + ML_N);
    float* ST = (float*)(smem + ML_ST);
    {
        const float ib = p.in[I_IBIAS][h], fb = p.in[I_FBIAS][h];
        for (int c = wid; c < 32; c += 8) {
            const int t = c * 64 + lane;
            const float ipre = psm[(long)t * 32 + 24 + h], fpre = psm[(long)t * 32 + 28 + h];
            const float li = ipre + ib;
            const float x = fpre + fb;
            const float lf = fminf(x, 0.f) - log1pf(__expf(-fabsf(x)));
            const float bb = wave_incl_scan_add(lf, lane);
            const float aa = li - bb;
            const float g = __shfl(bb, 63);
            const float pm = wave_incl_scan_max(aa, lane);
            const float mloc = wave_max(g + aa);
            GB[t] = bb; GA[t] = aa; GMQ[t] = pm;
            if (lane == 0) { GS[64 + c] = g; GS[96 + c] = mloc; }
        }
    }
    for (int e = tid; e < 36864 / 16; e += NTHR) *(u32x4*)(smem + ML_C + e * 16) = (u32x4){0u, 0u, 0u, 0u};
    if (tid < 128) NV[tid] = 0.f;
    __syncthreads();
    if (tid == 0) {
        float m = 0.f;
        for (int c = 0; c < 32; ++c) { GS[c] = m; const float mn = fmaxf(GS[64 + c] + m, GS[96 + c]); GS[32 + c] = mn; m = mn; }
    }
    __syncthreads();
    for (int t = tid; t < SEQ; t += NTHR) GMQ[t] = GB[t] + fmaxf(GS[t >> 6], GMQ[t]);
    __syncthreads();

    f32x4 Cacc[9];
#pragma unroll
    for (int c9 = 0; c9 < 9; ++c9) Cacc[c9] = (f32x4){0.f, 0.f, 0.f, 0.f};
    const int lrow = tid >> 4, lch = tid & 15;
    u32x4 rq[2], rk[2], rv[2];
#pragma unroll
    for (int i2 = 0; i2 < 2; ++i2) {
        const int row = lrow + 32 * i2;
        rq[i2] = *(const u32x4*)(QK + (long)row * 1024 + lch * 8);
        rk[i2] = *(const u32x4*)(QK + (long)row * 1024 + 512 + lch * 8);
        rv[i2] = *(const u32x4*)(Pb + (long)row * PW + PC_MV + h * 128 + lch * 8);
    }
    const int mt = wid >> 1, half = wid & 1;
#pragma unroll 1
    for (int c = 0; c < 32; ++c) {
        const float m_old = GS[c], m_new = GS[32 + c], gch = GS[64 + c];
#pragma unroll
        for (int i2 = 0; i2 < 2; ++i2) {
            const int row = lrow + 32 * i2;
            *(u32x4*)(smem + ML_Q + row * ML_PITCH + lch * 16) = rq[i2];
            *(u32x4*)(smem + ML_K + row * ML_PITCH + lch * 16) = rk[i2];
            *(u32x4*)(smem + ML_V + row * ML_PITCH + lch * 16) = rv[i2];
            const float wk = __expf(gch + GA[c * 64 + row] - m_new);
            u32x4 w;
            w.x = pk_bf16(bf_lo(rv[i2].x) * wk, bf_hi(rv[i2].x) * wk); w.y = pk_bf16(bf_lo(rv[i2].y) * wk, bf_hi(rv[i2].y) * wk);
            w.z = pk_bf16(bf_lo(rv[i2].z) * wk, bf_hi(rv[i2].z) * wk); w.w = pk_bf16(bf_lo(rv[i2].w) * wk, bf_hi(rv[i2].w) * wk);
            *(u32x4*)(smem + ML_VW + row * ML_PITCH + lch * 16) = w;
        }
        if (tid < 128) {
            const int row = tid >> 1, hf = tid & 1;
            const float wk = __expf(gch + GA[c * 64 + row] - m_new);
            u32x4 w = (u32x4){0u, 0u, 0u, 0u};
            if (hf == 0) w.x = pk_bf16(wk, 0.f);
            *(u32x4*)(smem + ML_VW + row * ML_PITCH + 256 + hf * 16) = w;
        }
        __syncthreads();
        if (c + 1 < 32) {
#pragma unroll
            for (int i2 = 0; i2 < 2; ++i2) {
                const int row = (c + 1) * 64 + lrow + 32 * i2;
                rq[i2] = *(const u32x4*)(QK + (long)row * 1024 + lch * 8);
                rk[i2] = *(const u32x4*)(QK + (long)row * 1024 + 512 + lch * 8);
                rv[i2] = *(const u32x4*)(Pb + (long)row * PW + PC_MV + h * 128 + lch * 8);
            }
        }
        const int l = 16 * mt + fr;
        const float bl = GB[c * 64 + l], mq = GMQ[c * 64 + l];
        const float ul = bl - mq;
        f32x4 hv[4];
        float s1 = 0.f, s2 = 0.f;
        {
            bf16x8 qf[4];
#pragma unroll
            for (int ks = 0; ks < 4; ++ks) qf[ks] = *(const bf16x8*)(smem + ML_Q + l * ML_PITCH + (ks * 4 + fq) * 16);
            f32x4 S[4];
#pragma unroll
            for (int nt = 0; nt < 4; ++nt) {
                f32x4 s = (f32x4){0.f, 0.f, 0.f, 0.f};
#pragma unroll
                for (int ks = 0; ks < 4; ++ks) {
                    const bf16x8 kf = *(const bf16x8*)(smem + ML_K + (16 * nt + fr) * ML_PITCH + (ks * 4 + fq) * 16);
                    s = mfma16(kf, qf[ks], s);
                }
                S[nt] = s;
            }
            float dintra = 0.f;
            const int lq = l - 4 * fq;
#pragma unroll
            for (int nt = 0; nt < 4; ++nt) {
                const f32x4 av = *(const f32x4*)(GA + c * 64 + 16 * nt + 4 * fq);
#pragma unroll
                for (int e = 0; e < 4; ++e) {
                    const float w = (16 * nt + e <= lq) ? __expf(ul + av[e]) : 0.f;
                    const float sv = S[nt][e] * w;
                    S[nt][e] = sv; dintra += sv;
                }
            }
            dintra += __shfl_xor(dintra, 16); dintra += __shfl_xor(dintra, 32);
            float dinter = 0.f;
#pragma unroll
            for (int ks = 0; ks < 4; ++ks) {
                const f32x4 n0 = *(const f32x4*)(NV + ks * 32 + fq * 8), n1 = *(const f32x4*)(NV + ks * 32 + fq * 8 + 4);
                const u32x4 qu = __builtin_bit_cast(u32x4, qf[ks]);
                dinter += bf_lo(qu.x) * n0[0] + bf_hi(qu.x) * n0[1] + bf_lo(qu.y) * n0[2] + bf_hi(qu.y) * n0[3]
                        + bf_lo(qu.z) * n1[0] + bf_hi(qu.z) * n1[1] + bf_lo(qu.w) * n1[2] + bf_hi(qu.w) * n1[3];
            }
            dinter += __shfl_xor(dinter, 16); dinter += __shfl_xor(dinter, 32);
            const float winter = __expf(ul + m_old);
            const float den = winter * dinter + dintra;
            const float rden = 1.0f / fmaxf(fabsf(den), __expf(-mq));
            const bf16x8 pf0 = pack_p(S[0], S[1]), pf1 = pack_p(S[2], S[3]);
#pragma unroll
            for (int c4 = 0; c4 < 4; ++c4) {
                const int et = 4 * half + c4;
                f32x4 num = (f32x4){0.f, 0.f, 0.f, 0.f}, inter = (f32x4){0.f, 0.f, 0.f, 0.f};
                num = mfma16(tr_frag_perm(smem + ML_V, ML_PITCH, 0, 16 * et, fr, fq), pf0, num);
                num = mfma16(tr_frag_perm(smem + ML_V, ML_PITCH, 32, 16 * et, fr, fq), pf1, num);
#pragma unroll
                for (int ks = 0; ks < 4; ++ks) {
                    const bf16x8 cf = *(const bf16x8*)(smem + ML_C + (16 * et + fr) * ML_PITCH + (ks * 4 + fq) * 16);
                    inter = mfma16(cf, qf[ks], inter);
                }
                const f32x4 hh = (inter * winter + num) * rden;
                hv[c4] = hh;
                s1 += (hh[0] + hh[1]) + (hh[2] + hh[3]);
                s2 += (hh[0] * hh[0] + hh[1] * hh[1]) + (hh[2] * hh[2] + hh[3] * hh[3]);
            }
            s1 += __shfl_xor(s1, 16); s1 += __shfl_xor(s1, 32);
            s2 += __shfl_xor(s2, 16); s2 += __shfl_xor(s2, 32);
            if (fq == 0) { ST[(l * 2 + half) * 2] = s1; ST[(l * 2 + half) * 2 + 1] = s2; }
        }
        {
            const float decay = __expf(gch + m_old - m_new);
#pragma unroll
            for (int c9 = 0; c9 < 9; ++c9) Cacc[c9] = Cacc[c9] * decay;
#pragma unroll
            for (int ks2 = 0; ks2 < 2; ++ks2) {
                const bf16x8 kt = tr_frag_std(smem + ML_K, ML_PITCH, 32 * ks2, 16 * wid, fr, fq);
#pragma unroll
                for (int c9 = 0; c9 < 9; ++c9) {
                    const bf16x8 vw = tr_frag_std(smem + ML_VW, ML_PITCH, 32 * ks2, 16 * c9, fr, fq);
                    Cacc[c9] = mfma16(kt, vw, Cacc[c9]);
                }
            }
        }
        __syncthreads();
        {
            const float* sp = ST + l * 4;
            const float t1 = sp[0] + sp[2], t2 = sp[1] + sp[3];
            const float mean = t1 * (1.0f / 128.0f);
            const float var = fmaxf(t2 * (1.0f / 128.0f) - mean * mean, 0.f);
            const float rstd = rsqrtf(var + LN_EPS);
            const long tok = c * 64 + l;
#pragma unroll
            for (int c4 = 0; c4 < 4; ++c4) {
                const int col = 64 * half + 16 * c4 + 4 * fq;
                const u32x2 ou = *(const u32x2*)(Pb + tok * PW + PC_MO + h * 128 + col);
                const f32x4 ng = *(const f32x4*)(p.in[I_NORMG] + h * 128 + col);
                const f32x4 y = (hv[c4] - mean) * rstd * ng;
                u32x2 w;
                w.x = pk_bf16(y[0] * sigmoidf_(bf_lo(ou.x)), y[1] * sigmoidf_(bf_hi(ou.x)));
                w.y = pk_bf16(y[2] * sigmoidf_(bf_lo(ou.y)), y[3] * sigmoidf_(bf_hi(ou.y)));
                *(u32x2*)(mix + tok * 1024 + col) = w;
            }
        }
#pragma unroll
        for (int c9 = 0; c9 < 8; ++c9) {
            u32x2 w; w.x = pk_bf16(Cacc[c9][0], Cacc[c9][1]); w.y = pk_bf16(Cacc[c9][2], Cacc[c9][3]);
            *(u32x2*)(smem + ML_C + (16 * c9 + fr) * ML_PITCH + (16 * wid + 4 * fq) * 2) = w;
        }
        if (fr == 0) *(f32x4*)(NV + 16 * wid + 4 * fq) = Cacc[8];
        __syncthreads();
    }
}


constexpr float W8_SCALE = 64.0f, H8_SCALE = 16.0f, Y8_SCALE = 64.0f;
constexpr int CV_PITCH = 144;
__device__ __forceinline__ void wconv_task(const Params& p, char* smem, int which, int e, int nt) {
    const int tid = opaque_tid();
    const int ng = tid & 63, kg = tid >> 6, n0 = 4 * ng;
    const float* src; int ld, K; unsigned char* dst;
    if (which == 0) {
        const int col = 128 * nt + 32 * (n0 >> 6) + 8 * ((n0 >> 2) & 3) + 4 * ((n0 >> 5) & 1);
        src = (((n0 >> 4) & 1) ? p.in[I_MW3] : p.in[I_MW1]) + (long)e * 1024 * 256 + col; ld = 256; K = 1024;
        dst = (unsigned char*)p.out + ((long)(e * 2 + nt) * 256) * 1024;
    } else {
        src = p.in[I_MW2] + (long)e * 256 * 1024 + nt * 256 + bperm16(n0); ld = 1024; K = 256;
        dst = (unsigned char*)(p.ws + WS_W2F8) + ((long)(e * 4 + nt) * 256) * 256;
    }
    for (int kc = 0; kc < K / 128; ++kc) {
        f32x4 v[16];
#pragma unroll
        for (int j = 0; j < 16; ++j) v[j] = *(const f32x4*)(src + (long)(kc * 128 + kg * 16 + j) * ld);
#pragma unroll
        for (int cc = 0; cc < 4; ++cc) {
            u32x4 w;
            w.x = pk4_fp8(v[0][cc] * W8_SCALE, v[1][cc] * W8_SCALE, v[2][cc] * W8_SCALE, v[3][cc] * W8_SCALE);
            w.y = pk4_fp8(v[4][cc] * W8_SCALE, v[5][cc] * W8_SCALE, v[6][cc] * W8_SCALE, v[7][cc] * W8_SCALE);
            w.z = pk4_fp8(v[8][cc] * W8_SCALE, v[9][cc] * W8_SCALE, v[10][cc] * W8_SCALE, v[11][cc] * W8_SCALE);
            w.w = pk4_fp8(v[12][cc] * W8_SCALE, v[13][cc] * W8_SCALE, v[14][cc] * W8_SCALE, v[15][cc] * W8_SCALE);
            *(u32x4*)(smem + (n0 + cc) * CV_PITCH + kg * 16) = w;
        }
        __syncthreads();
#pragma unroll
        for (int i = 0; i < 4; ++i) {
            const int piece = tid + i * NTHR, row = piece >> 3, ch = piece & 7;
            *(u32x4*)(dst + (long)row * K + kc * 128 + ch * 16) = *(const u32x4*)(smem + row * CV_PITCH + ch * 16);
        }
        __syncthreads();
    }
}

template <int PARTS = 7  , int NSAV = 7>
__device__ __forceinline__ void phase3(const Params& p, char* smem, int bid, int nb, int rep = 0) {
    XcdSlab xs; xs.init(bid, nb);
    const int nq = xs.x >= 0 ? 320 : 1024 + 1536;
    int* qctr = (int*)(p.ws + WS_CNT) + 16384 + ((xs.x >= 0 ? xs.x : 0) + 8 * rep) * 32;
    if (PARTS & 1) for (int u = bid; u < 64; u += nb) mlstm_scan(p, smem, u >> 2, u & 3);
    if (!(PARTS & 2)) return;
    volatile int* slot = (volatile int*)(smem + NSA_MISC + 256);
    for (;;) {
        if (opaque_tid() == 0) *slot = atomicAdd(qctr, 1);
        __syncthreads();
        const int k = __builtin_amdgcn_readfirstlane(*slot);
        if (k >= nq) break;
        if (xs.x >= 0) {
            const int r5 = k % 5, q5 = k / 5;
            if (r5 < 2) { const int kk = q5 * 2 + r5; const int bg = 4 * xs.x + (kk & 3); nsa_task<NSAV>(p, smem, bg >> 1, bg & 1, 31 - (kk >> 2)); }
            else if (PARTS & 4) { const int cv = q5 * 3 + (r5 - 2); const int e = xs.x + 8 * (cv / 6), t6 = cv % 6; wconv_task(p, smem, t6 < 2 ? 0 : 1, e, t6 < 2 ? t6 : t6 - 2); }
        } else if (k < 1024) nsa_task<NSAV>(p, smem, (k & 31) >> 1, k & 1, 31 - (k >> 5));
        else if (PARTS & 4) { const int cv = k - 1024; const int e = cv / 6, t6 = cv % 6; wconv_task(p, smem, t6 < 2 ? 0 : 1, e, t6 < 2 ? t6 : t6 - 2); }
    }
}

constexpr int XA_PITCH = 544;
constexpr int XA_K = 0, XA_V = 69632;
__device__ __forceinline__ void xattn_task(const Params& p, char* smem, int b, int h, int qb) {
    const char* ws = p.ws;
    int tid = threadIdx.x;
    asm volatile("" : "+v"(tid));
    const int lane = tid & 63, wid = __builtin_amdgcn_readfirstlane(tid >> 6), fr = lane & 15, fq = lane >> 4;
    const bf16_t* XQ = (const bf16_t*)(ws + WS_XQ) + (long)(b * SEQ + qb * 128 + wid * 16 + fr) * 1024 + h * 256 + fq * 8;
    const bf16_t* KV = (const bf16_t*)(ws + WS_KVX) + (long)b * 256 * 2048 + h * 256;
    bf16x8 qf[8];
#pragma unroll
    for (int ks = 0; ks < 8; ++ks) qf[ks] = *(const bf16x8*)(XQ + ks * 32);
    f32x4 O[16];
#pragma unroll
    for (int dt = 0; dt < 16; ++dt) O[dt] = (f32x4){0.f, 0.f, 0.f, 0.f};
    float m = -1e30f, l = 0.f;
    const int lrow = tid >> 5, lch = tid & 31;
    u32x4 rk[4], rv[4];
#pragma unroll
    for (int i2 = 0; i2 < 4; ++i2) {
        const bf16_t* rp = KV + (long)(lrow + 16 * i2) * 2048 + lch * 8;
        rk[i2] = *(const u32x4*)rp; rv[i2] = *(const u32x4*)(rp + 1024);
    }
#pragma unroll
    for (int i2 = 0; i2 < 4; ++i2) {
        *(u32x4*)(smem + XA_K + (lrow + 16 * i2) * XA_PITCH + lch * 16) = rk[i2];
        *(u32x4*)(smem + XA_V + (lrow + 16 * i2) * XA_PITCH + lch * 16) = rv[i2];
    }
    __syncthreads();
#pragma unroll 1
    for (int j = 0; j < 4; ++j) {
        const int buf = j & 1;
        if (j + 1 < 4) {
#pragma unroll
            for (int i2 = 0; i2 < 4; ++i2) {
                const bf16_t* rp = KV + (long)((j + 1) * 64 + lrow + 16 * i2) * 2048 + lch * 8;
                rk[i2] = *(const u32x4*)rp; rv[i2] = *(const u32x4*)(rp + 1024);
            }
        }
        const char* KT = smem + XA_K + buf * 34816;
        const char* VT = smem + XA_V + buf * 34816;
        f32x4 S[4];
#pragma unroll
        for (int nt = 0; nt < 4; ++nt) {
            f32x4 s = (f32x4){0.f, 0.f, 0.f, 0.f};
#pragma unroll
            for (int ks = 0; ks < 8; ++ks) {
                const bf16x8 kf = *(const bf16x8*)(KT + (16 * nt + fr) * XA_PITCH + (ks * 4 + fq) * 16);
                s = mfma16(kf, qf[ks], s);
            }
            S[nt] = s * 0.0625f;
        }
        float mx = -INFINITY;
#pragma unroll
        for (int nt = 0; nt < 4; ++nt)
#pragma unroll
            for (int e = 0; e < 4; ++e) mx = fmaxf(mx, S[nt][e]);
        mx = fmaxf(mx, __shfl_xor(mx, 16)); mx = fmaxf(mx, __shfl_xor(mx, 32));
        const float mnew = fmaxf(m, mx);
        const float alpha = __expf(m - mnew);
        float rs = 0.f;
#pragma unroll
        for (int nt = 0; nt < 4; ++nt)
#pragma unroll
            for (int e = 0; e < 4; ++e) { const float pv = __expf(S[nt][e] - mnew); S[nt][e] = pv; rs += pv; }
        rs += __shfl_xor(rs, 16); rs += __shfl_xor(rs, 32);
        l = l * alpha + rs; m = mnew;
#pragma unroll
        for (int dt = 0; dt < 16; ++dt) O[dt] = O[dt] * alpha;
        const bf16x8 pf0 = pack_p(S[0], S[1]), pf1 = pack_p(S[2], S[3]);
#pragma unroll
        for (int dt = 0; dt < 16; ++dt) {
            O[dt] = mfma16(tr_frag_perm(VT, XA_PITCH, 0, 16 * dt, fr, fq), pf0, O[dt]);
            O[dt] = mfma16(tr_frag_perm(VT, XA_PITCH, 32, 16 * dt, fr, fq), pf1, O[dt]);
        }
        if (j + 1 < 4) {
            char* KTn = smem + XA_K + (buf ^ 1) * 34816; char* VTn = smem + XA_V + (buf ^ 1) * 34816;
#pragma unroll
            for (int i2 = 0; i2 < 4; ++i2) {
                *(u32x4*)(KTn + (lrow + 16 * i2) * XA_PITCH + lch * 16) = rk[i2];
                *(u32x4*)(VTn + (lrow + 16 * i2) * XA_PITCH + lch * 16) = rv[i2];
            }
        }
        __syncthreads();
    }
    const float inv = 1.0f / l;
    bf16_t* op = (bf16_t*)(p.ws + WS_XO) + (long)(b * SEQ + qb * 128 + wid * 16 + fr) * 1024 + h * 256 + fq * 4;
#pragma unroll
    for (int dt = 0; dt < 16; ++dt) {
        u32x2 w; w.x = pk_bf16(O[dt][0] * inv, O[dt][1] * inv); w.y = pk_bf16(O[dt][2] * inv, O[dt][3] * inv);
        *(u32x2*)(op + dt * 16) = w;
    }
}

__device__ __forceinline__ void phase6(const Params& p, char* smem, int bid, int nb) {
    XcdSlab xs; xs.init(bid, nb);
    const int p_lo = xs.m_lo(64), n_t = (xs.m_hi(64) - p_lo) * 16;
    for (int u = xs.j; u < n_t; u += xs.stride) { const int pr = p_lo + (u >> 4); xattn_task(p, smem, pr >> 2, pr & 3, u & 15); }
}

constexpr int LN_ST = 139264, LN_GB = 141312, MOE_TAB = 153600;

template <class EPI>
__device__ __forceinline__ void dense_loop(char* smem, int bid, int nb, const bf16_t* A, int lda, const bf16_t* Bt, int nk, const EPI& epi) {
    XcdSlab xs; xs.init(bid, nb);
    const int m_lo = xs.m_lo(128), n_t = (xs.m_hi(128) - m_lo) * 4;
    int mt = 0, nt = 0;
    RingRows al, bl;
    auto setup = [&](int u) { mt = m_lo + (u >> 2); nt = u & 3; al.init_contig(A, lda, mt * 256); bl.init_contig(Bt, lda, nt * 256, true); };
    int u = xs.j;
    if (u < n_t) { setup(u); ring_issue3(smem, al, bl); }
    while (u < n_t) {
        const int cmt = mt, cnt_ = nt;
        f32x4 acc[8][4];
        gemm_ring<RingRows, RingRows, 0, true>(smem, al, bl, nk, acc);
        u += xs.stride;
        if (u < n_t) { setup(u); ring_issue3(smem, al, bl); }
        epi(acc, cmt, cnt_);
    }
    asm volatile("s_waitcnt vmcnt(0)" ::: "memory");
}

__device__ __forceinline__ void phase4(const Params& p, char* smem, int bid, int nb) {
    char* ws = p.ws;
    dense_loop(smem, bid, nb, (const bf16_t*)(ws + WS_MIX), 1024, (const bf16_t*)(ws + WS_WOUT), 32, [&](f32x4 (&acc)[8][4], int mt, int nt) {
        epi_residual<false>(acc, smem, p.in[I_X], nullptr, nullptr, nullptr, nullptr, (bf16_t*)(ws + WS_R1B), (float*)(ws + WS_ST1), mt * 256, nt);
    });
}

__device__ __forceinline__ void phase5(const Params& p, char* smem, int bid, int nb) {
    char* ws = p.ws;
    const float* lnf = (const float*)(ws + WS_LNF);
    dense_loop(smem, bid, nb, (const bf16_t*)(ws + WS_R1B), 1024, (const bf16_t*)(ws + WS_WQ), 32, [&](f32x4 (&acc)[8][4], int mt, int nt) {
        ln_correct<0>(acc, (const float*)(ws + WS_ST1), mt * 256, lnf, lnf + 1792, nt);
        epi_store_bf16(acc, (bf16_t*)(ws + WS_XQ), 1024, mt * 256, nt * 256);
    });
}

__device__ __forceinline__ void phase7(const Params& p, char* smem, int bid, int nb) {
    char* ws = p.ws;
    dense_loop(smem, bid, nb, (const bf16_t*)(ws + WS_XO), 1024, (const bf16_t*)(ws + WS_WO), 32, [&](f32x4 (&acc)[8][4], int mt, int nt) {
        epi_residual<true>(acc, smem, nullptr, (const bf16_t*)(ws + WS_R1B), (const float*)(ws + WS_ST1), p.in[I_LN1G], p.in[I_LN1B],
                           (bf16_t*)(ws + WS_R2B), (float*)(ws + WS_ST2), mt * 256, nt);
    });
}

template <class RowMap>
__device__ __forceinline__ void epi_swiglu(const f32x4 (&acc)[8][4], bf16_t* out, int ld, int nt, const RowMap& rm) {
    const int tid_ = opaque_tid();
    const int lane = tid_ & 63, wid = tid_ >> 6;
    const int wr = wid >> 2, wc = wid & 3, fr = lane & 15, fq = lane >> 4;
#pragma unroll
    for (int mi = 0; mi < 8; ++mi) {
        const long orow = rm(wr * 128 + mi * 16 + fr);
        if (orow >= 0) {
            const f32x4 a0 = acc[mi][0], b0 = acc[mi][1], a1 = acc[mi][2], b1 = acc[mi][3];
            u32x4 w;
            w.x = pk_bf16(siluf_(a0[0]) * b0[0], siluf_(a0[1]) * b0[1]); w.y = pk_bf16(siluf_(a0[2]) * b0[2], siluf_(a0[3]) * b0[3]);
            w.z = pk_bf16(siluf_(a1[0]) * b1[0], siluf_(a1[1]) * b1[1]); w.w = pk_bf16(siluf_(a1[2]) * b1[2], siluf_(a1[3]) * b1[3]);
            *(u32x4*)(out + orow * ld + nt * 128 + wc * 32 + fq * 8) = w;
        }
    }
}
struct RowIdent { long row0; __device__ __forceinline__ long operator()(int rl) const { return row0 + rl; } };

__device__ __forceinline__ unsigned dpp_xor1_u(unsigned v) { return (unsigned)__builtin_amdgcn_mov_dpp((int)v, 0xB1, 0xF, 0xF, true); }
__device__ __forceinline__ void route_tile(const Params& p, char* smem, int tok0, int rep) {
    char* ws = p.ws;
    const float* bias = p.in[I_ROUTB];
    const int tid = opaque_tid(), tk = tid >> 1, hf = tid & 1;
    const float* row = (const float*)(ws + WS_RSC) + (long)(tok0 + tk) * 256;
    unsigned key[128];
    float gs[4];
    {
        float v[128];
#pragma unroll
        for (int i = 0; i < 32; ++i) { const f32x4 t = *(const f32x4*)(row + hf * 128 + i * 4); v[4 * i] = t[0]; v[4 * i + 1] = t[1]; v[4 * i + 2] = t[2]; v[4 * i + 3] = t[3]; }
#pragma unroll
        for (int gi = 0; gi < 4; ++gi) {
            float m1 = -INFINITY, m2 = -INFINITY;
#pragma unroll
            for (int i = 0; i < 32; ++i) { const float x = v[32 * gi + i]; m2 = __builtin_fmaxf(m2, __builtin_fminf(m1, x)); m1 = __builtin_fmaxf(m1, x); }
            gs[gi] = m1 + m2;
        }
        float g8[8];
#pragma unroll
        for (int gi = 0; gi < 4; ++gi) { const float o = dpp_xor1(gs[gi]); g8[gi] = hf ? o : gs[gi]; g8[4 + gi] = hf ? gs[gi] : o; }
        unsigned gsel = 0u;
#pragma unroll
        for (int a = 0; a < 8; ++a) {
            int rank = 0;
#pragma unroll
            for (int b = 0; b < 8; ++b) rank += (g8[b] > g8[a] || (g8[b] == g8[a] && b < a)) ? 1 : 0;
            if (rank < 4) gsel |= 1u << a;
        }
#pragma unroll
        for (int gi = 0; gi < 4; ++gi) {
            const bool on = ((gsel >> (4 * hf + gi)) & 1u) != 0u;
#pragma unroll
            for (int i = 0; i < 32; ++i) {
                const unsigned kb = (__float_as_uint(v[32 * gi + i] + 1.0f) & ~0xFFu) | (unsigned)(255 - (128 * hf + 32 * gi + i));
                key[32 * gi + i] = on ? kb : 0u;
            }
        }
    }
    unsigned win[8];
    unsigned prev = 0xFFFFFFFFu;
#pragma unroll
    for (int r = 0; r < 8; ++r) {
        unsigned m = 0u;
#pragma unroll
        for (int i = 0; i < 128; ++i) { const unsigned kk = key[i]; const unsigned c = kk < prev ? kk : 0u; m = m > c ? m : c; }
        const unsigned o = dpp_xor1_u(m);
        m = m > o ? m : o;
        prev = m;
        win[r] = m;
    }
    float sc8[8]; float wsum = 0.f;
#pragma unroll
    for (int r = 0; r < 8; ++r) { const int e = 255 - (int)(win[r] & 255u); sc8[r] = row[e] - bias[e]; wsum += sc8[r]; }
    int* lc = (int*)(smem + MOE_TAB); int* gbase = lc + 256;
    if (tid < 256) lc[tid] = 0;
    __syncthreads();
    int mye[4], myr[4];
    const unsigned hmask = 0u - (unsigned)hf;
#pragma unroll
    for (int u = 0; u < 4; ++u) {
        const unsigned w = win[u] ^ ((win[u] ^ win[4 + u]) & hmask);
        mye[u] = 255 - (int)(w & 255u); myr[u] = atomicAdd(lc + mye[u], 1);
    }
    __syncthreads();
    if (tid < 256) { const int n = lc[tid]; if (n > 0) gbase[tid] = atomicAdd((int*)(ws + WS_CNT) + 8192 * rep + tid * 32, n); }
    __syncthreads();
    {
        const long t = tok0 + tk;
        const float wn = 2.5f / wsum;
#pragma unroll
        for (int u = 0; u < 4; ++u) {
            const int k = 4 * hf + u;
            const int e = mye[u];
            const unsigned s0 = __float_as_uint(sc8[u]), s1 = __float_as_uint(sc8[4 + u]);
            const float w = __uint_as_float(s0 ^ ((s0 ^ s1) & hmask)) * wn;
            const int pos = gbase[e] + myr[u];
            ((int*)(ws + WS_SELE))[t * 8 + k] = e;
            ((int*)(ws + WS_SELP))[t * 8 + k] = pos;
            ((float*)(ws + WS_SELW))[t * 8 + k] = w;
            ((int*)(ws + WS_TOKL))[(long)e * LIST_CAP + pos] = (int)t;
            ((float*)(ws + WS_WL))[(long)e * LIST_CAP + pos] = w;
        }
    }
    __syncthreads();
}

__device__ __forceinline__ void phase8(const Params& p, char* smem, int bid, int nb, int rep = 0) {
    char* ws = p.ws;
    const float* lnf = (const float*)(ws + WS_LNF);
    XcdSlab xs; xs.init(bid, nb);
    const int m_lo = xs.m_lo(128), m_n = xs.m_hi(128) - m_lo;
    for (int u = xs.j; u < m_n; u += xs.stride) {
        const int mt = m_lo + u;
        float* gsc = (float*)(ws + WS_RSC);
        {
            RingRows al, bl;
            al.init_contig((const bf16_t*)(ws + WS_R2B), 1024, mt * 256);
            bl.init_contig((const bf16_t*)(ws + WS_WR), 1024, 0, true);
            f32x4 acc[8][4];
            gemm_ring(smem, al, bl, 32, acc);
            ln_correct<0>(acc, (const float*)(ws + WS_ST2), mt * 256, lnf + 1024, lnf + 1792 + 1024, 0);
            const int tid_ = opaque_tid();
            const int lane = tid_ & 63, wid = tid_ >> 6;
            const int wr = wid >> 2, wc = wid & 3, fr = lane & 15, fq = lane >> 4;
            const float* bias = p.in[I_ROUTB];
#pragma unroll
            for (int ni = 0; ni < 4; ++ni) {
                const int col = wc * 64 + (ni >> 1) * 32 + fq * 8 + (ni & 1) * 4;
                const f32x4 bv = *(const f32x4*)(bias + col);
#pragma unroll
                for (int mi = 0; mi < 8; ++mi) {
                    f32x4 v;
#pragma unroll
                    for (int e = 0; e < 4; ++e) v[e] = sigmoidf_(acc[mi][ni][e]) + bv[e];
                    *(f32x4*)(gsc + (long)(mt * 256 + wr * 128 + mi * 16 + fr) * 256 + col) = v;
                }
            }
        }
        __syncthreads();
        route_tile(p, smem, mt * 256, rep);
    }
    for (int u = (xs.j + xs.stride - m_n % xs.stride) % xs.stride; u < m_n * 2; u += xs.stride) {
        const int mt = m_lo + (u >> 1), nt = u & 1;
        RingRows al, bl;
        al.init_contig((const bf16_t*)(ws + WS_R2B), 1024, mt * 256);
        bl.init_contig((const bf16_t*)(ws + WS_WS13), 1024, nt * 256);
        f32x4 acc[8][4];
        gemm_ring(smem, al, bl, 32, acc);
        ln_correct<1>(acc, (const float*)(ws + WS_ST2), mt * 256, lnf + 1280, lnf + 1792 + 1280, nt);
        RowIdent rm; rm.row0 = (long)mt * 256;
        epi_swiglu(acc, (bf16_t*)(ws + WS_HS), 256, nt, rm);
    }
    {
        const int tid = opaque_tid(), lane = tid & 63, wid = tid >> 6;
        const bf16_t* r2 = (const bf16_t*)(ws + WS_R2B); const float* st2 = (const float*)(ws + WS_ST2);
        unsigned char* x2 = (unsigned char*)(ws + WS_X2F8);
        for (int t = bid * 8 + wid; t < T_TOK; t += nb * 8) {
            const f32x4 p0 = *(const f32x4*)(st2 + (long)t * 8), p1 = *(const f32x4*)(st2 + (long)t * 8 + 4);
            const float q1 = (p0[0] + p0[2]) + (p1[0] + p1[2]), q2 = (p0[1] + p0[3]) + (p1[1] + p1[3]);
            const float mean = q1 * (1.0f / 1024.0f);
            const float rstd = rsqrtf(fmaxf(q2 * (1.0f / 1024.0f) - mean * mean, 0.f) + LN_EPS);
#pragma unroll
            for (int hseg = 0; hseg < 2; ++hseg) {
                const int col = hseg * 512 + lane * 8;
                const u32x4 ru = *(const u32x4*)(r2 + (long)t * 1024 + col);
                const f32x4 a0 = (f32x4){bf_lo(ru.x), bf_hi(ru.x), bf_lo(ru.y), bf_hi(ru.y)}, a1 = (f32x4){bf_lo(ru.z), bf_hi(ru.z), bf_lo(ru.w), bf_hi(ru.w)};
                const f32x4 g0 = *(const f32x4*)(p.in[I_LN2G] + col), g1 = *(const f32x4*)(p.in[I_LN2G] + col + 4);
                const f32x4 b0 = *(const f32x4*)(p.in[I_LN2B] + col), b1 = *(const f32x4*)(p.in[I_LN2B] + col + 4);
                const f32x4 y0 = (a0 - mean) * rstd * g0 + b0, y1 = (a1 - mean) * rstd * g1 + b1;
                u32x2 w; w.x = pk4_fp8(y0[0], y0[1], y0[2], y0[3]); w.y = pk4_fp8(y1[0], y1[1], y1[2], y1[3]);
                *(u32x2*)(x2 + (long)t * 1024 + col) = w;
            }
        }
    }
}

template <int XMODE>
__device__ __forceinline__ void phase_probe(const Params& p, char* smem, int bid, int nb) {
    char* ws = p.ws;
    XcdSlab xs; xs.init(bid, nb);
    const int m_lo = xs.m_lo(128), n_t = (xs.m_hi(128) - m_lo) * 4;
    for (int u = xs.j; u < n_t; u += xs.stride) {
        const int mt = m_lo + (u >> 2), nt = u & 3;
        RingRows al, bl;
        al.init_contig((const bf16_t*)(ws + WS_MIX), 1024, mt * 256);
        bl.init_contig((const bf16_t*)(ws + WS_WOUT), 1024, nt * 256, true);
        f32x4 acc[8][4];
        gemm_ring<RingRows, RingRows, XMODE>(smem, al, bl, 32, acc);
        epi_store_bf16(acc, (bf16_t*)(ws + WS_A + 432 * MB), 1024, mt * 256, nt * 256);
    }
}

__device__ __forceinline__ void moe_tables(const Params& p, char* smem, const XcdSlab& xs) {
    int* off = (int*)(smem + MOE_TAB); int* tst = off + 256; int* cntl = tst + 260;
    const int* cnt = (const int*)(p.ws + WS_CNT);
    const int tid = opaque_tid();
    if (tid >= 256) cntl[tid - 256] = cnt[(tid - 256) * 32];
    if (tid < 64) {
        int c[4], cs = 0;
#pragma unroll
        for (int k = 0; k < 4; ++k) { c[k] = cnt[(tid * 4 + k) * 32]; cs += c[k]; }
        int ics = cs;
#pragma unroll
        for (int o = 1; o < 64; o <<= 1) { const int a = __shfl_up(ics, o); if (tid >= o) ics += a; }
        int eo = ics - cs;
#pragma unroll
        for (int k = 0; k < 4; ++k) { off[tid * 4 + k] = eo; eo += c[k]; }
    } else if (tid < 128) {
        const int l = tid - 64;
        if (xs.x >= 0) {
            const int tl = l < 32 ? ((cnt[(xs.x + 8 * l) * 32] + 255) >> 8) : 0;
            int it = tl;
#pragma unroll
            for (int o = 1; o < 64; o <<= 1) { const int a = __shfl_up(it, o); if (l >= o) it += a; }
            if (l < 32) tst[l] = it - tl;
            if (l == 31) tst[32] = it;
        } else {
            int c[4], ts = 0;
#pragma unroll
            for (int k = 0; k < 4; ++k) { c[k] = (cnt[(l * 4 + k) * 32] + 255) >> 8; ts += c[k]; }
            int its = ts;
#pragma unroll
            for (int o = 1; o < 64; o <<= 1) { const int a = __shfl_up(its, o); if (l >= o) its += a; }
            int et = its - ts;
#pragma unroll
            for (int k = 0; k < 4; ++k) { tst[l * 4 + k] = et; et += c[k]; }
            if (l == 63) tst[256] = its;
        }
    }
    __syncthreads();
}
__device__ __forceinline__ int moe_find(const int* tst, int nloc, int t) {
    int lo = 0, hi = nloc - 1;
#pragma unroll 1
    while (lo < hi) { const int mid = (lo + hi + 1) >> 1; if (tst[mid] <= t) lo = mid; else hi = mid - 1; }
    return lo;
}
struct RowMoe { long base; int nvalid; __device__ __forceinline__ long operator()(int rl) const { return rl < nvalid ? base + rl : -1; } };

template <int PARTS9 = 3>
__device__ __forceinline__ void phase9(const Params& p, char* smem, int bid, int nb) {
    char* ws = p.ws;
    XcdSlab xs; xs.init(bid, nb);
    moe_tables(p, smem, xs);
    const int* off = (const int*)(smem + MOE_TAB); const int* tst = off + 256;
    const int* cnt = (const int*)(ws + WS_CNT);
    const int nloc = xs.x >= 0 ? 32 : 256;
    const int ntile = tst[nloc];
    {
        const int* cntl = tst + 260;
        const int nT = ntile * 2;
        int t = xs.j;
        int e = 0, m0 = 0, ne = 0, nt = 0;
        RingF8 al, bl;
        auto setup = [&](int tt) {
            const int et = tt >> 1; nt = tt & 1;
            const int kl = moe_find(tst, nloc, et); e = xs.x >= 0 ? xs.x + 8 * kl : kl; m0 = (et - tst[kl]) * 256; ne = cntl[e];
            const int tid = opaque_tid();
            const int* tl = (const int*)(ws + WS_TOKL) + (long)e * LIST_CAP;
            int rows[2];
#pragma unroll
            for (int i = 0; i < 2; ++i) { const int r = m0 + (tid >> 2) + 128 * i; rows[i] = r < ne ? tl[r] : 0; }
            al.init_rows((const unsigned char*)(ws + WS_X2F8), 1024, rows);
            bl.init_contig((const unsigned char*)p.out, 1024, (long)(e * 2 + nt) * 256);
        };
        if (!(PARTS9 & 1)) t = nT;
        if (t < nT) { setup(t); ring_f8_issue3(smem, al, bl); }
        while (t < nT) {
            const int ce = e, cm0 = m0, cne = ne, cnt_ = nt;
            f32x4 acc[8][4];
            gemm_ring_f8_main(smem, al, bl, 16, acc);
            t += xs.stride;
            if (t < nT) { setup(t); ring_f8_issue3(smem, al, bl); }
            {
                const int tid2 = opaque_tid();
                const int lane = tid2 & 63, wid = tid2 >> 6;
                const int wr = wid >> 2, wc = wid & 3, fr = lane & 15, fq = lane >> 4;
                unsigned char* H = (unsigned char*)(ws + WS_HF8) + ((long)off[ce] + cm0) * 256 + cnt_ * 128 + wc * 32 + fq * 8;
                constexpr float D = 1.0f / W8_SCALE, HS = H8_SCALE / W8_SCALE;
#pragma unroll
                for (int mi = 0; mi < 8; ++mi) {
                    const int rl = wr * 128 + mi * 16 + fr;
                    if (cm0 + rl < cne) {
                        const f32x4 a0 = acc[mi][0] * D, b0 = acc[mi][1] * HS, a1 = acc[mi][2] * D, b1 = acc[mi][3] * HS;
                        u32x2 w;
                        w.x = pk4_fp8(siluf_(a0[0]) * b0[0], siluf_(a0[1]) * b0[1], siluf_(a0[2]) * b0[2], siluf_(a0[3]) * b0[3]);
                        w.y = pk4_fp8(siluf_(a1[0]) * b1[0], siluf_(a1[1]) * b1[1], siluf_(a1[2]) * b1[2], siluf_(a1[3]) * b1[3]);
                        *(u32x2*)(H + (long)rl * 256) = w;
                    }
                }
            }
        }
        asm volatile("s_waitcnt vmcnt(0)" ::: "memory"); __syncthreads();
    }
    const int m_lo = xs.m_lo(128), n_t = (PARTS9 & 2) ? (xs.m_hi(128) - m_lo) * 4 : 0;
    for (int u = (xs.j + xs.stride - (ntile * 2) % xs.stride) % xs.stride; u < n_t; u += xs.stride) {
        const int mt = m_lo + (u >> 2), nt = u & 3;
        RingRows al, bl;
        al.init_contig((const bf16_t*)(ws + WS_HS), 256, mt * 256);
        bl.init_contig((const bf16_t*)(ws + WS_WS2), 256, nt * 256, true);
        f32x4 acc[8][4];
        gemm_ring(smem, al, bl, 8, acc);
        __syncthreads();
        epi_store_bf16(acc, (bf16_t*)(ws + WS_SH), 1024, mt * 256, nt * 256);
    }
}

template <int P10V = 0  >
__device__ __forceinline__ void phase10(const Params& p, char* smem, int bid, int nb) {
    char* ws = p.ws;
    XcdSlab xs; xs.init(bid, nb);
    moe_tables(p, smem, xs);
    const int* off = (const int*)(smem + MOE_TAB); const int* tst = off + 256;
    const int* cnt = (const int*)(ws + WS_CNT);
    const int nloc = xs.x >= 0 ? 32 : 256;
    const int ntile = tst[nloc];
    {
        const int* cntl = tst + 260;
        const int nT = ntile;
        const int tid_ = opaque_tid();
        const int lane = tid_ & 63, wid = __builtin_amdgcn_readfirstlane(tid_ >> 6);
        const int wr = wid >> 2, wc = wid & 3, fr = lane & 15, fq = lane >> 4;
        const int g2 = ((fr >> 2) & 3) << 1;
        const int aoff0 = (wr * 128 + fr) * 64 + ((fq ^ g2) << 3), aoff1 = (wr * 128 + fr) * 64 + (((4 + fq) ^ g2) << 3);
        const int boff0 = (wc * 64 + fr) * 64 + ((fq ^ g2) << 3), boff1 = (wc * 64 + fr) * 64 + (((4 + fq) ^ g2) << 3);
        char* ringB = smem + 65536;
        for (int t = xs.j; t < nT; t += xs.stride) {
            const int kl = moe_find(tst, nloc, t), e = xs.x >= 0 ? xs.x + 8 * kl : kl, m0 = (t - tst[kl]) * 256, ne = cntl[e];
            RingF8 al, bl;
            al.init_contig((const unsigned char*)(ws + WS_HF8), 256, (long)off[e] + m0);
            bl.init_contig((const unsigned char*)(ws + WS_W2F8), 256, (long)(e * 4) * 256);
            const float* wl = (const float*)(ws + WS_WL) + (long)e * LIST_CAP + m0;
            unsigned char* Yb = (unsigned char*)(ws + WS_Y) + ((long)off[e] + m0) * 1024 + wc * 64 + fq * 16;
#pragma unroll
            for (int ks = 0; ks < 4; ++ks) al.issue(smem + ks * 16384, ks);
            auto issueB = [&](int bt, int stg) {
                const int nt_ = bt >> 2, ks_ = bt & 3;
                char* s = ringB + stg * 16384;
#pragma unroll
                for (int i = 0; i < 2; ++i)
                    __builtin_amdgcn_global_load_lds((glb_u32*)(bl.base + (size_t)(bl.off[i] + (unsigned)(nt_ * 65536 + ks_ * 64))), (lds_u32*)(s + i * 8192 + bl.ldst), 16, 0, 0);
            };
            issueB(0, 0); issueB(1, 1); issueB(2, 2); issueB(3, 3);
            RING_WAIT(6);
            RING_BAR();
            if (wr == 1) RING_BAR();
            f32x4 acc[8][4];
#pragma unroll
            for (int mi = 0; mi < 8; ++mi)
#pragma unroll
                for (int ni = 0; ni < 4; ++ni) acc[mi][ni] = (f32x4){0.f, 0.f, 0.f, 0.f};
            int sg = 0;
#pragma unroll 1
            for (int bt = 0; bt < 16; ++bt) {
                const char* sa = smem + (bt & 3) * 16384;
                const char* sb = ringB + sg * 16384;
                { const int s4 = sg == 0 ? 4 : sg - 1; if (bt + 4 < 16) issueB(bt + 4, s4); }
                long b0[4], b1[4], a0[8], a1[8];
#pragma unroll
                for (int ni = 0; ni < 4; ++ni) { b0[ni] = *(const long*)(sb + boff0 + ni * 1024); b1[ni] = *(const long*)(sb + boff1 + ni * 1024); }
#pragma unroll
                for (int mi = 0; mi < 8; ++mi) { a0[mi] = *(const long*)(sa + aoff0 + mi * 1024); a1[mi] = *(const long*)(sa + aoff1 + mi * 1024); }
                if (bt + 1 < 16) { if (bt + 4 < 16) RING_WAIT(6); else if (bt + 3 < 16) RING_WAIT(4); else if (bt + 2 < 16) RING_WAIT(2); else RING_WAIT(0); }
                RING_BAR();
                __builtin_amdgcn_s_setprio(1);
                if (P10V != 2) {
#pragma unroll
                for (int mi = 0; mi < 8; ++mi)
#pragma unroll
                    for (int ni = 0; ni < 4; ++ni) {
                        acc[mi][ni] = __builtin_amdgcn_mfma_f32_16x16x32_fp8_fp8(b0[ni], a0[mi], acc[mi][ni], 0, 0, 0);
                        acc[mi][ni] = __builtin_amdgcn_mfma_f32_16x16x32_fp8_fp8(b1[ni], a1[mi], acc[mi][ni], 0, 0, 0);
                    }
                } else { acc[0][0][0] += (float)(a0[0] + b0[0] + a1[7] + b1[3]); }
                __builtin_amdgcn_s_setprio(0);
                if ((bt & 3) == 3) {
                    const int nt_ = bt >> 2;
#pragma unroll
                    for (int mi = 0; mi < 8; ++mi) {
                        const int rl = wr * 128 + mi * 16 + fr;
                        if (m0 + rl < ne) {
                            const float w = wl[rl] * (Y8_SCALE / (W8_SCALE * H8_SCALE));
                            const f32x4 u0 = acc[mi][0] * w, u1 = acc[mi][1] * w, u2 = acc[mi][2] * w, u3 = acc[mi][3] * w;
                            u32x4 v; v.x = pk4_fp8(u0[0], u0[1], u0[2], u0[3]); v.y = pk4_fp8(u1[0], u1[1], u1[2], u1[3]);
                            v.z = pk4_fp8(u2[0], u2[1], u2[2], u2[3]); v.w = pk4_fp8(u3[0], u3[1], u3[2], u3[3]);
                            if (P10V != 1) *(u32x4*)(Yb + (long)rl * 1024 + nt_ * 256) = v; else if (v.x == 0x12345678u) *(u32x4*)(Yb) = v;
                        }
#pragma unroll
                        for (int ni = 0; ni < 4; ++ni) acc[mi][ni] = (f32x4){0.f, 0.f, 0.f, 0.f};
                    }
                }
                RING_BAR();
                sg = sg == 4 ? 0 : sg + 1;
            }
            if (wr == 0) RING_BAR();
        }
    }
}

__device__ __forceinline__ void phase11(const Params& p, char* smem, int bid, int nb) {
    char* ws = p.ws;
    XcdSlab xs; xs.init(bid, nb);
    moe_tables(p, smem, xs);
    const int* off = (const int*)(smem + MOE_TAB);
    const int tid = opaque_tid(), lane = tid & 63, wid = tid >> 6;
    const bf16_t* r2 = (const bf16_t*)(ws + WS_R2B);
    const float* st2 = (const float*)(ws + WS_ST2);
    const bf16_t* SH = (const bf16_t*)(ws + WS_SH);
    const unsigned char* Y = (const unsigned char*)(ws + WS_Y);
    const int* sele = (const int*)(ws + WS_SELE); const int* selp = (const int*)(ws + WS_SELP);
    for (int t = bid * 8 + wid; t < T_TOK; t += nb * 8) {
        const f32x4 p0 = *(const f32x4*)(st2 + (long)t * 8), p1 = *(const f32x4*)(st2 + (long)t * 8 + 4);
        const float q1 = (p0[0] + p0[2]) + (p1[0] + p1[2]), q2 = (p0[1] + p0[3]) + (p1[1] + p1[3]);
        const float mean2 = q1 * (1.0f / 1024.0f);
        const float rstd2 = rsqrtf(fmaxf(q2 * (1.0f / 1024.0f) - mean2 * mean2, 0.f) + LN_EPS);
        int yrow[8];
#pragma unroll
        for (int k = 0; k < 8; ++k) yrow[k] = off[sele[(long)t * 8 + k]] + selp[(long)t * 8 + k];
        float v[16];
#pragma unroll
        for (int hseg = 0; hseg < 2; ++hseg) {
            const int col = hseg * 512 + lane * 8;
            const u32x4 ru = *(const u32x4*)(r2 + (long)t * 1024 + col);
            const f32x4 a0 = (f32x4){bf_lo(ru.x), bf_hi(ru.x), bf_lo(ru.y), bf_hi(ru.y)}, a1 = (f32x4){bf_lo(ru.z), bf_hi(ru.z), bf_lo(ru.w), bf_hi(ru.w)};
            const f32x4 g0 = *(const f32x4*)(p.in[I_LN2G] + col), g1 = *(const f32x4*)(p.in[I_LN2G] + col + 4);
            const f32x4 b0 = *(const f32x4*)(p.in[I_LN2B] + col), b1 = *(const f32x4*)(p.in[I_LN2B] + col + 4);
            const f32x4 x0 = ((a0 - mean2) * rstd2 * g0 + b0) * ALPHA, x1 = ((a1 - mean2) * rstd2 * g1 + b1) * ALPHA;
            float* vv = v + hseg * 8;
            vv[0] = x0[0]; vv[1] = x0[1]; vv[2] = x0[2]; vv[3] = x0[3]; vv[4] = x1[0]; vv[5] = x1[1]; vv[6] = x1[2]; vv[7] = x1[3];
            const u32x4 s = *(const u32x4*)(SH + (long)t * 1024 + col);
            vv[0] += bf_lo(s.x); vv[1] += bf_hi(s.x); vv[2] += bf_lo(s.y); vv[3] += bf_hi(s.y); vv[4] += bf_lo(s.z); vv[5] += bf_hi(s.z); vv[6] += bf_lo(s.w); vv[7] += bf_hi(s.w);
            f32x2 ys[4];
#pragma unroll
            for (int e2 = 0; e2 < 4; ++e2) ys[e2] = (f32x2){0.f, 0.f};
#pragma unroll
            for (int k = 0; k < 8; ++k) {
                const u32x2 y = *(const u32x2*)(Y + (long)yrow[k] * 1024 + col);
                ys[0] += __builtin_amdgcn_cvt_pk_f32_fp8((int)y.x, false); ys[1] += __builtin_amdgcn_cvt_pk_f32_fp8((int)y.x, true);
                ys[2] += __builtin_amdgcn_cvt_pk_f32_fp8((int)y.y, false); ys[3] += __builtin_amdgcn_cvt_pk_f32_fp8((int)y.y, true);
            }
#pragma unroll
            for (int e2 = 0; e2 < 4; ++e2) { vv[2 * e2] += ys[e2][0] * (1.0f / Y8_SCALE); vv[2 * e2 + 1] += ys[e2][1] * (1.0f / Y8_SCALE); }
        }
        float s1 = 0.f;
#pragma unroll
        for (int i = 0; i < 16; ++i) s1 += v[i];
#pragma unroll
        for (int o = 32; o >= 1; o >>= 1) s1 += __shfl_xor(s1, o);
        const float mean = s1 * (1.0f / 1024.0f);
        float s2 = 0.f;
#pragma unroll
        for (int i = 0; i < 16; ++i) { const float d = v[i] - mean; s2 += d * d; }
#pragma unroll
        for (int o = 32; o >= 1; o >>= 1) s2 += __shfl_xor(s2, o);
        const float rstd = rsqrtf(s2 * (1.0f / 1024.0f) + LN_EPS);
#pragma unroll
        for (int hseg = 0; hseg < 2; ++hseg) {
            const int col = hseg * 512 + lane * 8;
            const f32x4 g0 = *(const f32x4*)(p.in[I_LN3G] + col), g1 = *(const f32x4*)(p.in[I_LN3G] + col + 4);
            const f32x4 b0 = *(const f32x4*)(p.in[I_LN3B] + col), b1 = *(const f32x4*)(p.in[I_LN3B] + col + 4);
            const float* vv = v + hseg * 8;
            f32x4 o0, o1;
#pragma unroll
            for (int e = 0; e < 4; ++e) { o0[e] = (vv[e] - mean) * rstd * g0[e] + b0[e]; o1[e] = (vv[4 + e] - mean) * rstd * g1[e] + b1[e]; }
            *(f32x4*)(p.out + (long)t * 1024 + col) = o0; *(f32x4*)(p.out + (long)t * 1024 + col + 4) = o1;
        }
    }
}

#if MEGA
#define XB_TMO      128
#define XB_XCNT(j)  (256  + 64 * (j))
#define XB_XSUB(j)  (1280 + 64 * (j))
#define XB_XGEN(j)  (2304 + 64 * (j))
#define XB_TOP      3328
#define XB_TOPGEN   3392
#define XCD_BAR_WORDS 3456
#define XB_SPIN_CAP (1u << 22)
#define LAS __attribute__((address_space(3)))
__device__ __forceinline__ unsigned xb_ld(unsigned* p)              { return __hip_atomic_load(p, __ATOMIC_RELAXED, __HIP_MEMORY_SCOPE_AGENT); }
__device__ __forceinline__ unsigned xb_add(unsigned* p, unsigned v) { return __hip_atomic_fetch_add(p, v, __ATOMIC_RELAXED, __HIP_MEMORY_SCOPE_AGENT); }
__device__ __forceinline__ unsigned xb_xcc_id() { return (unsigned)__builtin_amdgcn_s_getreg((3 << 11) | 20) & 0xFu; }
#define XB_SPIN(cond, bar) do { unsigned _sp = 0; while (cond) { __builtin_amdgcn_s_sleep(1); \
    if ((++_sp & 255u) == 0u) { if (xb_ld(&(bar)[XB_TMO])) break; if (_sp > XB_SPIN_CAP) { atomicAdd(&(bar)[XB_TMO], 1u); break; } } } } while (0)
struct XcdBarrier { unsigned* bar; unsigned x; volatile LAS unsigned* st; };
__device__ __forceinline__ XcdBarrier xcd_barrier_post(unsigned* bar, volatile LAS unsigned* st) {
    XcdBarrier b; b.bar = bar; b.x = xb_xcc_id(); b.st = st;
    if (threadIdx.x == 0) (void)xb_add(&bar[XB_XCNT(b.x)], 1u);
    return b;
}
__device__ __forceinline__ void xcd_barrier_complete(unsigned* bar, unsigned x, unsigned& nloc, unsigned& nx) {
    const unsigned G = gridDim.x * gridDim.y * gridDim.z;
    unsigned sum, cnt, mine, sp = 0u;
    for (;;) {
        sum = 0u; cnt = 0u; mine = 0u;
#pragma unroll
        for (unsigned j = 0; j < 16; ++j) { const unsigned c = xb_ld(&bar[XB_XCNT(j)]); sum += c; cnt += (c > 0u) ? 1u : 0u; mine = (j == x) ? c : mine; }
        if (sum == G) break;
        __builtin_amdgcn_s_sleep(1);
        if ((++sp & 255u) == 0u) { if (xb_ld(&bar[XB_TMO])) break; if (sp > XB_SPIN_CAP) { atomicAdd(&bar[XB_TMO], 1u); break; } }
    }
    nloc = mine > 0u ? mine : 1u; nx = cnt > 0u ? cnt : 1u;
}
__device__ __forceinline__ void xcd_barrier(const XcdBarrier& b) {
    asm volatile("s_waitcnt vmcnt(0)" ::: "memory");
    __syncthreads();
    if (threadIdx.x == 0) {
        unsigned* bar = b.bar;
        __builtin_amdgcn_s_waitcnt(0);
        unsigned nloc = b.st[0], nx = b.st[1];
        if (nloc == 0u) { xcd_barrier_complete(bar, b.x, nloc, nx); b.st[0] = nloc; b.st[1] = nx; }
        const unsigned old = xb_add(&bar[XB_XSUB(b.x)], 1u);
        const unsigned gen = old / nloc;
        if (old + 1u == (gen + 1u) * nloc) {
            __builtin_amdgcn_fence(__ATOMIC_RELEASE, "agent");
            asm volatile("s_waitcnt vmcnt(0)" ::: "memory");
            const unsigned og = xb_add(&bar[XB_TOP], 1u);
            const unsigned tg = og / nx;
            if (og + 1u == (tg + 1u) * nx) xb_add(&bar[XB_TOPGEN], 1u);
            else XB_SPIN(xb_ld(&bar[XB_TOPGEN]) == tg, bar);
            __builtin_amdgcn_fence(__ATOMIC_ACQUIRE, "agent");
            xb_add(&bar[XB_XGEN(b.x)], 1u);
            asm volatile("s_waitcnt vmcnt(0)" ::: "memory");
        } else {
            XB_SPIN(xb_ld(&bar[XB_XGEN(b.x)]) == gen, bar);
            __builtin_amdgcn_fence(__ATOMIC_ACQUIRE, "agent");
            asm volatile("s_waitcnt vmcnt(0)" ::: "memory");
        }
    }
    __syncthreads();
}
__global__ void __launch_bounds__(NTHR) fwd_mega(Params p) {
    extern __shared__ __attribute__((aligned(16))) char smem[];
    cg::grid_group grid = cg::this_grid();
    const int bid = blockIdx.x, nb = gridDim.x;
    volatile LAS unsigned* xst = (volatile LAS unsigned*)(smem + LDS_BYTES - 16);
    if (threadIdx.x < 4) xst[threadIdx.x] = 0u;
    __syncthreads();
    const XcdBarrier xb = xcd_barrier_post((unsigned*)(p.ws + WS_BAR), xst);
#define GSYNC() xcd_barrier(xb)
#ifndef PROBE_REPEAT
#define PROBE_REPEAT 0
#endif
#define REP(n, call) if (PROBE_REPEAT & (1 << n)) { call; GSYNC(); }
    if (PROBE_REPEAT & 1) { phase0(p, smem, bid, nb); GSYNC(); }
#ifdef PROBE_XCC
    {
        unsigned* rec = (unsigned*)(p.ws + WS_A + 432 * MB);
        if (threadIdx.x == 0) rec[bid] = xb_xcc_id();
        grid.sync();
        int mism = 0, distinct = 0;
        for (int b = 0; b < nb; ++b) { if (rec[b] != rec[b & 7]) ++mism; }
        for (int a = 0; a < 8; ++a) { bool dup = false; for (int b2 = 0; b2 < a; ++b2) dup = dup || (rec[a] == rec[b2]); if (!dup) ++distinct; }
        const float v = sqrtf((float)(PROBE_XCC == 1 ? mism : distinct) + 1.0f);
        for (long i = (long)bid * NTHR + threadIdx.x; i < (long)T_TOK * 1024; i += (long)nb * NTHR) p.out[i] = v;
        return;
    }
#endif
    phase0(p, smem, bid, nb);  grid.sync();
    REP(1, phase1<1>(p, smem, bid, nb))
    phase1(p, smem, bid, nb);  GSYNC();
    REP(2, phase2(p, smem, bid, nb))
    phase2(p, smem, bid, nb);  GSYNC();
#ifndef PROBE_P3PARTS
#define PROBE_P3PARTS 7
#endif
#ifndef PROBE_NSAV
#define PROBE_NSAV 7
#endif
    REP(3, (phase3<PROBE_P3PARTS, PROBE_NSAV>(p, smem, bid, nb, 1)))
    phase3(p, smem, bid, nb);  GSYNC();
    REP(4, phase4(p, smem, bid, nb))
#ifdef PROBE_X
    phase_probe<PROBE_X>(p, smem, bid, nb); GSYNC();
#endif
    phase4(p, smem, bid, nb);  GSYNC();
    REP(5, phase5(p, smem, bid, nb))
    phase5(p, smem, bid, nb);  GSYNC();
    REP(6, phase6(p, smem, bid, nb))
    phase6(p, smem, bid, nb);  GSYNC();
    REP(7, phase7(p, smem, bid, nb))
    phase7(p, smem, bid, nb);  GSYNC();
    REP(8, phase8(p, smem, bid, nb, 1))
    phase8(p, smem, bid, nb);  GSYNC();
#ifndef PROBE_P9PARTS
#define PROBE_P9PARTS 3
#endif
    REP(9, phase9<PROBE_P9PARTS>(p, smem, bid, nb))
    phase9(p, smem, bid, nb);  GSYNC();
#ifndef PROBE_P10V
#define PROBE_P10V 0
#endif
    REP(10, phase10<PROBE_P10V>(p, smem, bid, nb))
    phase10(p, smem, bid, nb); GSYNC();
    REP(11, phase11(p, smem, bid, nb))
    phase11(p, smem, bid, nb);
}
#else
#define PHASE_KERNEL(n) __global__ void __launch_bounds__(NTHR) fwd_phase##n(Params p) { extern __shared__ __attribute__((aligned(16))) char smem[]; phase##n(p, smem, blockIdx.x, gridDim.x); }
PHASE_KERNEL(0) PHASE_KERNEL(1) PHASE_KERNEL(2) PHASE_KERNEL(3) PHASE_KERNEL(4) PHASE_KERNEL(5)
PHASE_KERNEL(6) PHASE_KERNEL(7) PHASE_KERNEL(8) PHASE_KERNEL(9) PHASE_KERNEL(10) PHASE_KERNEL(11)
typedef void (*phase_fn)(Params);
#endif

extern "C" void kernel_launch(void* const* d_in, const int* in_sizes, int n_in, void* d_out, int out_size, void* d_ws, size_t ws_size, hipStream_t stream) {
    Params p{};
    for (int i = 0; i < 32; ++i) p.in[i] = (const float*)d_in[i];
    p.out = (float*)d_out;
    p.ws = (char*)d_ws;
    if (n_in != 32 || ws_size < WS_END) { fprintf(stderr, "kernel_launch: unexpected inputs (n_in %d) or workspace too small (%zu < %zu)\n", n_in, ws_size, (size_t)WS_END); return; }
#if MEGA
    static int grid = 0;
    if (!grid) {
        int dev = 0, cus = 0, per_cu = 0;
        (void)hipGetDevice(&dev);
        (void)hipDeviceGetAttribute(&cus, hipDeviceAttributeMultiprocessorCount, dev);
        (void)hipFuncSetAttribute((const void*)fwd_mega, hipFuncAttributeMaxDynamicSharedMemorySize, LDS_BYTES);
        (void)hipOccupancyMaxActiveBlocksPerMultiprocessor(&per_cu, (const void*)fwd_mega, NTHR, LDS_BYTES);
        if (per_cu < 1) { fprintf(stderr, "kernel_launch: occupancy query says %d blocks/CU\n", per_cu); per_cu = 1; }
        grid = cus;
    }
    (void)hipMemsetAsync((char*)d_ws + WS_BAR, 0, 16384, stream);
    void* args[] = {&p};
    hipError_t e = hipLaunchCooperativeKernel((const void*)fwd_mega, dim3(grid), dim3(NTHR), args, LDS_BYTES, stream);
    if (e != hipSuccess) fprintf(stderr, "cooperative launch failed: %s (grid %d)\n", hipGetErrorString(e), grid);
#else
    static const phase_fn fns[12] = {fwd_phase0, fwd_phase1, fwd_phase2, fwd_phase3, fwd_phase4, fwd_phase5, fwd_phase6, fwd_phase7, fwd_phase8, fwd_phase9, fwd_phase10, fwd_phase11};
    static bool attr = false;
    if (!attr) { for (int i = 0; i < 12; ++i) (void)hipFuncSetAttribute((const void*)fns[i], hipFuncAttributeMaxDynamicSharedMemorySize, LDS_BYTES); attr = true; }
    for (int i = 0; i < 12; ++i) hipLaunchKernelGGL(fns[i], dim3(256), dim3(NTHR), LDS_BYTES, stream, p);
#endif
}
```

```cpp
#include <hip/hip_runtime.h>
#include <hip/hip_cooperative_groups.h>
#include <stdint.h>
#include <stdio.h>
namespace cg = cooperative_groups;

#ifndef MEGA
#define MEGA 1
#endif

typedef unsigned short bf16_t;
typedef short bf16x8 __attribute__((ext_vector_type(8)));
typedef short s16x4 __attribute__((ext_vector_type(4)));
typedef float f32x4 __attribute__((ext_vector_type(4)));
typedef float f32x2 __attribute__((ext_vector_type(2)));
typedef unsigned u32x4 __attribute__((ext_vector_type(4)));
typedef unsigned u32x2 __attribute__((ext_vector_type(2)));
typedef __bf16 bf16x2_t __attribute__((ext_vector_type(2)));

constexpr int T_TOK = 32768, DM = 1024, NB = 16, SEQ = 2048;
constexpr int PW = 3328;
constexpr int PC_Q = 0, PC_KC = 512, PC_VC = 640, PC_KS = 768, PC_VS = 896, PC_KW = 1024, PC_VW = 1152;
constexpr int PC_MQ = 1280, PC_MK = 1792, PC_MV = 2304, PC_MO = 2816;
constexpr float ALPHA = 1.189207115002721f;
constexpr float LN_EPS = 1e-5f;
constexpr int NTHR = 512;
constexpr int LDS_BYTES = 160 * 1024;
constexpr int NEXP = 256, TOPK = 8;
constexpr int LIST_CAP = 32768;

constexpr size_t al256(size_t x) { return (x + 255) & ~(size_t)255; }
constexpr size_t WS_WIN = 0;
constexpr size_t WS_WOUT = WS_WIN + al256((size_t)3360 * 1024 * 2);
constexpr size_t WS_WQ = WS_WOUT + (size_t)1024 * 1024 * 2;
constexpr size_t WS_WKV = WS_WQ + (size_t)1024 * 1024 * 2;
constexpr size_t WS_WO = WS_WKV + (size_t)2048 * 1024 * 2;
constexpr size_t WS_WR = WS_WO + (size_t)1024 * 1024 * 2;
constexpr size_t WS_WS13 = WS_WR + (size_t)256 * 1024 * 2;
constexpr size_t WS_WS2 = WS_WS13 + (size_t)512 * 1024 * 2;
constexpr size_t WS_CK1 = WS_WS2 + (size_t)1024 * 256 * 2;
constexpr size_t WS_CK2 = WS_CK1 + (size_t)64 * 2048 * 2;
constexpr size_t WS_CV1 = WS_CK2 + (size_t)64 * 64 * 2;
constexpr size_t WS_CV2 = WS_CV1 + (size_t)64 * 2048 * 2;
constexpr size_t MB = 1024 * 1024;
constexpr size_t WS_LNP = al256(WS_CV2 + (size_t)64 * 64 * 2);
constexpr size_t WS_LNF = WS_LNP + (size_t)2 * 16 * 1792 * 4;
constexpr size_t WS_A = al256(WS_LNF + (size_t)2 * 1792 * 4 + 65536);
constexpr size_t WS_P = WS_A;
constexpr size_t WS_R1 = WS_A;
constexpr size_t WS_XQ = WS_A + 128 * MB;
constexpr size_t WS_XO = WS_A + 192 * MB;
constexpr size_t WS_XB = WS_A + 208 * MB;
constexpr size_t WS_MEMB = WS_A + 272 * MB;
constexpr size_t WS_PSM = WS_A + 280 * MB;
constexpr size_t WS_KCMP = WS_A + 284 * MB;
constexpr size_t WS_VCMP = WS_KCMP + (size_t)16 * 2 * 128 * 64 * 2;
constexpr size_t WS_QK = WS_A + 285 * MB;
constexpr size_t WS_MIX = WS_A + 349 * MB;
constexpr size_t WS_KVX = WS_A + 413 * MB;
constexpr size_t WS_X2F8 = WS_A + 256 * MB;
constexpr size_t WS_X2 = WS_A + 256 * MB;
constexpr size_t WS_HS = WS_A + 320 * MB;
constexpr size_t WS_R1B = WS_A;
constexpr size_t WS_RSC = WS_A;
constexpr size_t WS_Y = WS_A;
constexpr size_t WS_B = WS_A + al256((size_t)(T_TOK * 8 + 256) * 1024 * 2);
constexpr size_t WS_R2B = WS_B;
constexpr size_t WS_R2 = WS_B;
constexpr size_t WS_ST1 = WS_R2 + (size_t)T_TOK * 1024 * 4;
constexpr size_t WS_ST2 = WS_ST1 + (size_t)T_TOK * 8 * 4;
constexpr size_t WS_SH = WS_ST2 + (size_t)T_TOK * 8 * 4;
constexpr size_t WS_SELE = WS_SH + (size_t)T_TOK * 1024 * 2;
constexpr size_t WS_SELP = WS_SELE + (size_t)T_TOK * 8 * 4;
constexpr size_t WS_SELW = WS_SELP + (size_t)T_TOK * 8 * 4;
constexpr size_t WS_CNT = WS_SELW + (size_t)T_TOK * 8 * 4;
constexpr size_t WS_TOKL = WS_CNT + 98304;
constexpr size_t WS_WL = WS_TOKL + (size_t)NEXP * LIST_CAP * 4;
constexpr size_t WS_H = WS_WL + (size_t)NEXP * LIST_CAP * 4;
constexpr size_t WS_HF8 = WS_H;
constexpr size_t WS_W2F8 = WS_H + (size_t)(T_TOK * 8 + 256) * 256;
constexpr size_t WS_BAR = WS_W2F8 + (size_t)256 * 1024 * 256;
constexpr size_t WS_END = WS_BAR + 16384;
static_assert((size_t)T_TOK * PW * 2 <= 208 * MB, "P region");
static_assert(WS_END <= (size_t)1024 * MB, "workspace must fit 1 GiB");

struct Params {
    const float* in[32];
    float* out;
    char* ws;
};

__device__ __forceinline__ unsigned pk_bf16(float lo, float hi) {
    f32x2 v = {lo, hi};
    bf16x2_t r = __builtin_convertvector(v, bf16x2_t);
    return __builtin_bit_cast(unsigned, r);
}
__device__ __forceinline__ float bf_lo(unsigned u) { return __uint_as_float(u << 16); }
__device__ __forceinline__ float bf_hi(unsigned u) { return __uint_as_float(u & 0xffff0000u); }
__device__ __forceinline__ float bf2f(bf16_t h) { return __uint_as_float(((unsigned)h) << 16); }
__device__ __forceinline__ float sigmoidf_(float x) { return 1.0f / (1.0f + __expf(-x)); }
__device__ __forceinline__ float siluf_(float x) { return x / (1.0f + __expf(-x)); }
__device__ __forceinline__ f32x4 mfma16(bf16x8 a, bf16x8 b, f32x4 c) { return __builtin_amdgcn_mfma_f32_16x16x32_bf16(a, b, c, 0, 0, 0); }
__device__ __forceinline__ bf16x8 as_bf16x8(u32x4 v) { return __builtin_bit_cast(bf16x8, v); }

__device__ __forceinline__ float fq_max(float x) {
    auto a = __builtin_amdgcn_permlane16_swap(__float_as_uint(x), __float_as_uint(x), false, false);
    x = __builtin_fmaxf(__uint_as_float(a[0]), __uint_as_float(a[1]));
    auto b = __builtin_amdgcn_permlane32_swap(__float_as_uint(x), __float_as_uint(x), false, false);
    return __builtin_fmaxf(__uint_as_float(b[0]), __uint_as_float(b[1]));
}
__device__ __forceinline__ float fq_sum(float x) {
    auto a = __builtin_amdgcn_permlane16_swap(__float_as_uint(x), __float_as_uint(x), false, false);
    x = __uint_as_float(a[0]) + __uint_as_float(a[1]);
    auto b = __builtin_amdgcn_permlane32_swap(__float_as_uint(x), __float_as_uint(x), false, false);
    return __uint_as_float(b[0]) + __uint_as_float(b[1]);
}
__device__ __forceinline__ int opaque_tid() { int t = threadIdx.x; asm volatile("" : "+v"(t)); return t; }

__device__ __forceinline__ int tile_off(int row, int chunk) { return row * 128 + ((chunk ^ (row & 7)) << 4); }

__device__ __forceinline__ int bperm(int rho) { return (rho & ~31) + 8 * ((rho >> 2) & 3) + 4 * ((rho >> 4) & 1) + (rho & 3); }

typedef __attribute__((address_space(3))) unsigned lds_u32;
typedef __attribute__((address_space(1))) const unsigned glb_u32;

struct LoadBf16Rows {
    const bf16_t* base;
    unsigned off[4];
    int ldst;
    struct Regs { int dummy; };
    __device__ __forceinline__ void init_contig(const bf16_t* b, int ld, int row0) {
        const int tid_ = opaque_tid();
        const int r8 = tid_ >> 3, kc = (tid_ & 7) ^ (r8 & 7);
        ldst = tid_ * 16;
        base = b + (long)row0 * ld;
#pragma unroll
        for (int i = 0; i < 4; ++i) off[i] = (unsigned)((r8 + 64 * i) * ld + kc * 8);
    }
    __device__ __forceinline__ void init_rows(const bf16_t* b, int ld, const int (&rows)[4]) {
        const int tid_ = opaque_tid();
        const int r8 = tid_ >> 3, kc = (tid_ & 7) ^ (r8 & 7);
        ldst = tid_ * 16;
        base = b;
#pragma unroll
        for (int i = 0; i < 4; ++i) off[i] = (unsigned)rows[i] * (unsigned)ld + (unsigned)(kc * 8);
    }
    __device__ __forceinline__ void issue(Regs&, char* s, int kt) const {
#pragma unroll
        for (int i = 0; i < 4; ++i)
            __builtin_amdgcn_global_load_lds((glb_u32*)(base + (size_t)(off[i] + (unsigned)(kt * 64))), (lds_u32*)(s + i * 8192 + ldst), 16, 0, 0);
    }
    __device__ __forceinline__ void commit(const Regs&, char*, int) const {}
};

struct LoadF32KN {
    const float* p;
    int ldn;
    int n, kh;
    struct Regs { float v[32]; };
    __device__ __forceinline__ void issue(Regs& r, char*, int kt) const {
        const float* q = p + (long)kt * 64 * ldn;
#pragma unroll
        for (int j = 0; j < 32; ++j) r.v[j] = q[(long)j * ldn];
    }
    __device__ __forceinline__ void commit(const Regs& r, char* s, int kt) const {
#pragma unroll
        for (int q = 0; q < 4; ++q) {
            u32x4 w;
            w.x = pk_bf16(r.v[8 * q + 0], r.v[8 * q + 1]); w.y = pk_bf16(r.v[8 * q + 2], r.v[8 * q + 3]);
            w.z = pk_bf16(r.v[8 * q + 4], r.v[8 * q + 5]); w.w = pk_bf16(r.v[8 * q + 6], r.v[8 * q + 7]);
            *(u32x4*)(s + tile_off(n, kh * 4 + q)) = w;
        }
    }
};

struct LoadLN {
    LoadBf16Rows raw;
    bf16_t* xbase;
    const float* st;
    const float* gb;
    typedef LoadBf16Rows::Regs Regs;
    __device__ __forceinline__ void issue(Regs& r, char* s, int kt) const { raw.issue(r, s, kt); }
    __device__ __forceinline__ void commit(const Regs&, char* s, int kt) const {
        asm volatile("s_waitcnt vmcnt(0)" ::: "memory");
        const int tid_ = opaque_tid();
        const int r8 = tid_ >> 3, kc = (tid_ & 7) ^ (r8 & 7);
        const f32x4 g0 = *(const f32x4*)(gb + kt * 64 + kc * 8), g1 = *(const f32x4*)(gb + kt * 64 + kc * 8 + 4);
        const f32x4 b0 = *(const f32x4*)(gb + 1024 + kt * 64 + kc * 8), b1 = *(const f32x4*)(gb + 1024 + kt * 64 + kc * 8 + 4);
#pragma unroll
        for (int i = 0; i < 4; ++i) {
            const int row = r8 + 64 * i;
            u32x4* cp = (u32x4*)(s + i * 8192 + tid_ * 16);
            const u32x4 v = *cp;
            const float mean = st[row * 2], rstd = st[row * 2 + 1];
            const f32x4 x0 = (f32x4){bf_lo(v.x), bf_hi(v.x), bf_lo(v.y), bf_hi(v.y)};
            const f32x4 x1 = (f32x4){bf_lo(v.z), bf_hi(v.z), bf_lo(v.w), bf_hi(v.w)};
            const f32x4 y0 = (x0 - mean) * rstd * g0 + b0, y1 = (x1 - mean) * rstd * g1 + b1;
            u32x4 w; w.x = pk_bf16(y0[0], y0[1]); w.y = pk_bf16(y0[2], y0[3]); w.z = pk_bf16(y1[0], y1[1]); w.w = pk_bf16(y1[2], y1[3]);
            *cp = w;
            if (xbase) *(u32x4*)(xbase + (size_t)(row * 1024 + kc * 8 + kt * 64)) = w;
        }
    }
};

constexpr int GEMM_LDS = 131072;
template <class AL, class BL>
__device__ __forceinline__ void gemm_mainloop(char* smem, const AL& al, const BL& bl, int nk, f32x4 (&acc)[8][4]) {
    const int tid_ = opaque_tid();
    const int lane = tid_ & 63, wid = tid_ >> 6;
    const int wr = wid >> 2, wc = wid & 3, fr = lane & 15, fq = lane >> 4;
#pragma unroll
    for (int mi = 0; mi < 8; ++mi)
#pragma unroll
        for (int ni = 0; ni < 4; ++ni) acc[mi][ni] = (f32x4){0.f, 0.f, 0.f, 0.f};
    typename AL::Regs ra; typename BL::Regs rb;
    al.issue(ra, smem, 0); bl.issue(rb, smem + 32768, 0);
    al.commit(ra, smem, 0); bl.commit(rb, smem + 32768, 0);
    __syncthreads();
    for (int kt = 0; kt < nk; ++kt) {
        char* sA = smem + (kt & 1) * 65536; char* sB = sA + 32768;
        char* nA = smem + ((kt + 1) & 1) * 65536; char* nB = nA + 32768;
        if (kt + 1 < nk) { al.issue(ra, nA, kt + 1); bl.issue(rb, nB, kt + 1); }
#pragma unroll
        for (int kk = 0; kk < 2; ++kk) {
            bf16x8 bfr[4];
#pragma unroll
            for (int ni = 0; ni < 4; ++ni) bfr[ni] = *(const bf16x8*)(sB + tile_off(wc * 64 + ni * 16 + fr, kk * 4 + fq));
#pragma unroll
            for (int mi = 0; mi < 8; ++mi) {
                const bf16x8 af = *(const bf16x8*)(sA + tile_off(wr * 128 + mi * 16 + fr, kk * 4 + fq));
#pragma unroll
                for (int ni = 0; ni < 4; ++ni) acc[mi][ni] = mfma16(bfr[ni], af, acc[mi][ni]);
            }
        }
        if (kt + 1 < nk) { al.commit(ra, nA, kt + 1); bl.commit(rb, nB, kt + 1); }
        __syncthreads();
    }
}

__device__ __forceinline__ int swz4(int row) { return (0x78 >> (((row >> 2) & 3) * 2)) & 3; }
struct RingRows {
    const bf16_t* base; unsigned off[2]; int ldst;
    __device__ __forceinline__ void init_contig(const bf16_t* b, int ld, int row0, bool perm = false) {
        const int tid_ = opaque_tid(); const int r = tid_ >> 2, kc = (tid_ & 3) ^ swz4(r);
        ldst = tid_ * 16; base = b + (long)row0 * ld;
#pragma unroll
        for (int i = 0; i < 2; ++i) { const int rr = r + 128 * i; off[i] = (unsigned)((perm ? bperm(rr) : rr) * ld + kc * 8); }
    }
    __device__ __forceinline__ void init_rows(const bf16_t* b, int ld, const int (&rows)[2]) {
        const int tid_ = opaque_tid(); const int r = tid_ >> 2, kc = (tid_ & 3) ^ swz4(r);
        ldst = tid_ * 16; base = b;
#pragma unroll
        for (int i = 0; i < 2; ++i) off[i] = (unsigned)rows[i] * (unsigned)ld + (unsigned)(kc * 8);
    }
    __device__ __forceinline__ void issue(char* s, int kt) const {
#pragma unroll
        for (int i = 0; i < 2; ++i)
            __builtin_amdgcn_global_load_lds((glb_u32*)(base + (size_t)(off[i] + (unsigned)(kt * 32))), (lds_u32*)(s + i * 8192 + ldst), 16, 0, 0);
    }
    __device__ __forceinline__ void commit(char*, int) const {}
};
struct RingLN {
    RingRows raw; bf16_t* xbase; const float* st; const float* gb;
    __device__ __forceinline__ void issue(char* s, int kt) const { raw.issue(s, kt); }
    __device__ __forceinline__ void commit(char* s, int kt) const {
        const int tid_ = opaque_tid(); const int r = tid_ >> 2, kc = (tid_ & 3) ^ swz4(r);
        const f32x4 g0 = *(const f32x4*)(gb + kt * 32 + kc * 8), g1 = *(const f32x4*)(gb + kt * 32 + kc * 8 + 4);
        const f32x4 b0 = *(const f32x4*)(gb + 1024 + kt * 32 + kc * 8), b1 = *(const f32x4*)(gb + 1024 + kt * 32 + kc * 8 + 4);
#pragma unroll
        for (int i = 0; i < 2; ++i) {
            const int row = r + 128 * i;
            u32x4* cp = (u32x4*)(s + i * 8192 + tid_ * 16);
            const u32x4 v = *cp;
            const float mean = st[row * 2], rstd = st[row * 2 + 1];
            const f32x4 x0 = (f32x4){bf_lo(v.x), bf_hi(v.x), bf_lo(v.y), bf_hi(v.y)};
            const f32x4 x1 = (f32x4){bf_lo(v.z), bf_hi(v.z), bf_lo(v.w), bf_hi(v.w)};
            const f32x4 y0 = (x0 - mean) * rstd * g0 + b0, y1 = (x1 - mean) * rstd * g1 + b1;
            u32x4 w; w.x = pk_bf16(y0[0], y0[1]); w.y = pk_bf16(y0[2], y0[3]); w.z = pk_bf16(y1[0], y1[1]); w.w = pk_bf16(y1[2], y1[3]);
            *cp = w;
            if (xbase) *(u32x4*)(xbase + (size_t)(row * 1024 + kc * 8 + kt * 32)) = w;
        }
    }
};
#define RING_WAIT(n) asm volatile("s_waitcnt vmcnt(" #n ")" ::: "memory")
#define RING_BAR() do { __builtin_amdgcn_sched_barrier(0); asm volatile("s_waitcnt lgkmcnt(0)" ::: "memory"); __builtin_amdgcn_s_barrier(); asm volatile("" ::: "memory"); __builtin_amdgcn_sched_barrier(0); } while (0)
template <class AL, class BL>
__device__ __forceinline__ void ring_issue3(char* smem, const AL& al, const BL& bl) {
    al.issue(smem, 0); bl.issue(smem + 16384, 0);
    al.issue(smem + 32768, 1); bl.issue(smem + 32768 + 16384, 1);
    al.issue(smem + 65536, 2); bl.issue(smem + 65536 + 16384, 2);
}
template <class AL, class BL, int XMODE = 0  , bool ISSUED = false  >
__device__ __forceinline__ void gemm_ring(char* smem, const AL& al, const BL& bl, int nk  , f32x4 (&acc)[8][4]) {
    const int tid_ = opaque_tid();
    const int lane = tid_ & 63, wid = __builtin_amdgcn_readfirstlane(tid_ >> 6);
    const int wr = wid >> 2, wc = wid & 3, fr = lane & 15, fq = lane >> 4;
#pragma unroll
    for (int mi = 0; mi < 8; ++mi)
#pragma unroll
        for (int ni = 0; ni < 4; ++ni) acc[mi][ni] = (f32x4){0.f, 0.f, 0.f, 0.f};
    const int aoff = (wr * 128 + fr) * 64 + ((fq ^ swz4(fr)) << 4);
    const int boff = 16384 + (wc * 64 + fr) * 64 + ((fq ^ swz4(fr)) << 4);
    if (XMODE != 1) {
    if (!ISSUED) ring_issue3(smem, al, bl);
    RING_WAIT(8);
    al.commit(smem, 0); bl.commit(smem + 16384, 0);
    }
    RING_BAR();
    if (wr == 1) RING_BAR();
    for (int kt = 0; kt < nk; ++kt) {
        const char* st = smem + (kt & 3) * 32768;
        if (XMODE != 1 && kt + 3 < nk) { char* s3 = smem + ((kt + 3) & 3) * 32768; al.issue(s3, kt + 3); bl.issue(s3 + 16384, kt + 3); }
        bf16x8 bfr[4], afr[8];
        if (XMODE != 2) {
#pragma unroll
        for (int ni = 0; ni < 4; ++ni) bfr[ni] = *(const bf16x8*)(st + boff + ni * 1024);
#pragma unroll
        for (int mi = 0; mi < 8; ++mi) afr[mi] = *(const bf16x8*)(st + aoff + mi * 1024);
        }
        if (XMODE != 1 && kt + 1 < nk) {
            if (kt + 3 < nk) RING_WAIT(8); else if (kt + 2 < nk) RING_WAIT(4); else RING_WAIT(0);
            char* s1 = smem + ((kt + 1) & 3) * 32768;
            al.commit(s1, kt + 1); bl.commit(s1 + 16384, kt + 1);
        }
        RING_BAR();
        if (XMODE != 2) {
        __builtin_amdgcn_s_setprio(1);
#pragma unroll
        for (int mi = 0; mi < 8; ++mi)
#pragma unroll
            for (int ni = 0; ni < 4; ++ni) acc[mi][ni] = mfma16(bfr[ni], afr[mi], acc[mi][ni]);
        __builtin_amdgcn_s_setprio(0);
        }
        RING_BAR();
    }
    if (wr == 0) RING_BAR();
}

constexpr int FB_PITCH = 1088, FB_STAGE = 16384 + 32 * FB_PITCH;
struct RingF32B {
    const float* p; int ldn; int ldst;
    __device__ __forceinline__ void init(const float* W, int ld, int srccol4, int tid_) { const int lane = tid_ & 63, wid = tid_ >> 6; p = W + (long)wid * ld + srccol4; ldn = ld; ldst = wid * FB_PITCH + lane * 16; }
    __device__ __forceinline__ void issue(char* sB, int kt) const {
#pragma unroll
        for (int i = 0; i < 4; ++i)
            __builtin_amdgcn_global_load_lds((glb_u32*)(p + (long)(kt * 32 + i * 8) * ldn), (lds_u32*)(sB + i * 8 * FB_PITCH + (i & 1) * 64 + ldst), 16, 0, 0);
    }
};
template <class AL>
__device__ __forceinline__ void gemm_ring_f32b(char* smem, const AL& al, const RingF32B& bl, int nk  , f32x4 (&acc)[8][4]) {
    const int tid_ = opaque_tid();
    const int lane = tid_ & 63, wid = __builtin_amdgcn_readfirstlane(tid_ >> 6);
    const int wr = wid >> 2, wc = wid & 3, fr = lane & 15, fq = lane >> 4;
#pragma unroll
    for (int mi = 0; mi < 8; ++mi)
#pragma unroll
        for (int ni = 0; ni < 4; ++ni) acc[mi][ni] = (f32x4){0.f, 0.f, 0.f, 0.f};
    const int aoff = (wr * 128 + fr) * 64 + ((fq ^ swz4(fr)) << 4);
    const int boff = 16384 + (8 * fq) * FB_PITCH + (fq & 1) * 64 + (wc * 64 + fr) * 4;
    al.issue(smem, 0); bl.issue(smem + 16384, 0);
    al.issue(smem + FB_STAGE, 1); bl.issue(smem + FB_STAGE + 16384, 1);
    RING_WAIT(6);
    RING_BAR();
    if (wr == 1) RING_BAR();
    int s0 = 0;
    for (int kt = 0; kt < nk; ++kt) {
        const char* st = smem + s0 * FB_STAGE;
        const int s1 = s0 == 2 ? 0 : s0 + 1, s2 = s1 == 2 ? 0 : s1 + 1;
        if (kt + 2 < nk) { char* sn = smem + s2 * FB_STAGE; al.issue(sn, kt + 2); bl.issue(sn + 16384, kt + 2); }
        bf16x8 bfr[4], afr[8];
#pragma unroll
        for (int ni = 0; ni < 4; ++ni) {
            float v[8];
#pragma unroll
            for (int j = 0; j < 8; ++j) v[j] = *(const float*)(st + boff + j * FB_PITCH + ni * 64);
            u32x4 w; w.x = pk_bf16(v[0], v[1]); w.y = pk_bf16(v[2], v[3]); w.z = pk_bf16(v[4], v[5]); w.w = pk_bf16(v[6], v[7]);
            bfr[ni] = as_bf16x8(w);
        }
#pragma unroll
        for (int mi = 0; mi < 8; ++mi) afr[mi] = *(const bf16x8*)(st + aoff + mi * 1024);
        if (kt + 1 < nk) { if (kt + 2 < nk) RING_WAIT(6); else RING_WAIT(0); }
        RING_BAR();
        __builtin_amdgcn_s_setprio(1);
#pragma unroll
        for (int mi = 0; mi < 8; ++mi)
#pragma unroll
            for (int ni = 0; ni < 4; ++ni) acc[mi][ni] = mfma16(bfr[ni], afr[mi], acc[mi][ni]);
        __builtin_amdgcn_s_setprio(0);
        RING_BAR();
        s0 = s1;
    }
    if (wr == 0) RING_BAR();
}

__device__ __forceinline__ unsigned pk4_fp8(float a, float b, float c, float d) {
    int r = __builtin_amdgcn_cvt_pk_fp8_f32(a, b, 0, false);
    r = __builtin_amdgcn_cvt_pk_fp8_f32(c, d, r, true);
    return (unsigned)r;
}
struct RingF8 {
    const unsigned char* base; unsigned off[2]; int ldst;
    __device__ __forceinline__ void init_contig(const unsigned char* b, int ldb, long row0, bool perm = false) {
        const int tid_ = opaque_tid(); const int r = tid_ >> 2, kc = (tid_ & 3) ^ ((r >> 2) & 3);
        ldst = tid_ * 16; base = b + row0 * ldb;
#pragma unroll
        for (int i = 0; i < 2; ++i) { const int rr = r + 128 * i; off[i] = (unsigned)((perm ? bperm(rr) : rr) * ldb + kc * 16); }
    }
    __device__ __forceinline__ void init_rows(const unsigned char* b, int ldb, const int (&rows)[2]) {
        const int tid_ = opaque_tid(); const int r = tid_ >> 2, kc = (tid_ & 3) ^ ((r >> 2) & 3);
        ldst = tid_ * 16; base = b;
#pragma unroll
        for (int i = 0; i < 2; ++i) off[i] = (unsigned)rows[i] * (unsigned)ldb + (unsigned)(kc * 16);
    }
    __device__ __forceinline__ void issue(char* s, int kt) const {
#pragma unroll
        for (int i = 0; i < 2; ++i)
            __builtin_amdgcn_global_load_lds((glb_u32*)(base + (size_t)(off[i] + (unsigned)(kt * 64))), (lds_u32*)(s + i * 8192 + ldst), 16, 0, 0);
    }
};
__device__ __forceinline__ void ring_f8_issue3(char* smem, const RingF8& al, const RingF8& bl) {
    al.issue(smem, 0); bl.issue(smem + 16384, 0);
    al.issue(smem + 32768, 1); bl.issue(smem + 32768 + 16384, 1);
    al.issue(smem + 65536, 2); bl.issue(smem + 65536 + 16384, 2);
}
__device__ __forceinline__ void gemm_ring_f8_main(char* smem, const RingF8& al, const RingF8& bl, int nk  , f32x4 (&acc)[8][4]) {
    const int tid_ = opaque_tid();
    const int lane = tid_ & 63, wid = __builtin_amdgcn_readfirstlane(tid_ >> 6);
    const int wr = wid >> 2, wc = wid & 3, fr = lane & 15, fq = lane >> 4;
#pragma unroll
    for (int mi = 0; mi < 8; ++mi)
#pragma unroll
        for (int ni = 0; ni < 4; ++ni) acc[mi][ni] = (f32x4){0.f, 0.f, 0.f, 0.f};
    const int g2 = ((fr >> 2) & 3) << 1;
    const int aoff0 = (wr * 128 + fr) * 64 + ((fq ^ g2) << 3), aoff1 = (wr * 128 + fr) * 64 + (((4 + fq) ^ g2) << 3);
    const int boff0 = 16384 + (wc * 64 + fr) * 64 + ((fq ^ g2) << 3), boff1 = 16384 + (wc * 64 + fr) * 64 + (((4 + fq) ^ g2) << 3);
    RING_WAIT(8);
    RING_BAR();
    if (wr == 1) RING_BAR();
    for (int kt = 0; kt < nk; ++kt) {
        const char* st = smem + (kt & 3) * 32768;
        if (kt + 3 < nk) { char* s3 = smem + ((kt + 3) & 3) * 32768; al.issue(s3, kt + 3); bl.issue(s3 + 16384, kt + 3); }
        long b0[4], b1[4], a0[8], a1[8];
#pragma unroll
        for (int ni = 0; ni < 4; ++ni) { b0[ni] = *(const long*)(st + boff0 + ni * 1024); b1[ni] = *(const long*)(st + boff1 + ni * 1024); }
#pragma unroll
        for (int mi = 0; mi < 8; ++mi) { a0[mi] = *(const long*)(st + aoff0 + mi * 1024); a1[mi] = *(const long*)(st + aoff1 + mi * 1024); }
        if (kt + 1 < nk) { if (kt + 3 < nk) RING_WAIT(8); else if (kt + 2 < nk) RING_WAIT(4); else RING_WAIT(0); }
        RING_BAR();
        __builtin_amdgcn_s_setprio(1);
#pragma unroll
        for (int mi = 0; mi < 8; ++mi)
#pragma unroll
            for (int ni = 0; ni < 4; ++ni) {
                acc[mi][ni] = __builtin_amdgcn_mfma_f32_16x16x32_fp8_fp8(b0[ni], a0[mi], acc[mi][ni], 0, 0, 0);
                acc[mi][ni] = __builtin_amdgcn_mfma_f32_16x16x32_fp8_fp8(b1[ni], a1[mi], acc[mi][ni], 0, 0, 0);
            }
        __builtin_amdgcn_s_setprio(0);
        RING_BAR();
    }
    if (wr == 0) RING_BAR();
}

typedef int i32x8 __attribute__((ext_vector_type(8)));
typedef float f32x16 __attribute__((ext_vector_type(16)));
constexpr int MX_ONE = 0x7f7f7f7f;
__device__ __forceinline__ f32x16 mfma_mx(i32x8 a, i32x8 b, f32x16 c) { return __builtin_amdgcn_mfma_scale_f32_32x32x64_f8f6f4(a, b, c, 0, 0, 0, MX_ONE, 0, MX_ONE); }
__device__ __forceinline__ i32x8 mx_frag(const char* rowp  , int c0off, int c1off) {
    const u32x4 lo = *(const u32x4*)(rowp + c0off), hi = *(const u32x4*)(rowp + c1off);
    return (i32x8){(int)lo.x, (int)lo.y, (int)lo.z, (int)lo.w, (int)hi.x, (int)hi.y, (int)hi.z, (int)hi.w};
}
__device__ __forceinline__ int bperm32(int rho) { return (rho & ~31) + 16 * ((rho >> 2) & 1) + 4 * ((rho >> 3) & 3) + (rho & 3); }
__device__ __forceinline__ void gemm_ring_mx_main(char* smem, const RingF8& al, const RingF8& bl, int nk  , f32x16 (&acc)[4][2]) {
    const int tid_ = opaque_tid();
    const int lane = tid_ & 63, wid = __builtin_amdgcn_readfirstlane(tid_ >> 6);
    const int wr = wid >> 2, wc = wid & 3, r = lane & 31, h = lane >> 5;
#pragma unroll
    for (int mi = 0; mi < 4; ++mi)
#pragma unroll
        for (int nj = 0; nj < 2; ++nj)
#pragma unroll
            for (int q = 0; q < 16; ++q) acc[mi][nj][q] = 0.f;
    const int g = (r >> 2) & 3;
    const int c0 = ((2 * h) ^ g) << 4, c1 = ((2 * h + 1) ^ g) << 4;
    const int arow = (wr * 128 + r) * 64;
    const int brow = 16384 + (wc * 64 + r) * 64;
    RING_WAIT(8);
    RING_BAR();
    if (wr == 1) RING_BAR();
#pragma unroll 1
    for (int kt = 0; kt < nk; ++kt) {
        const char* st = smem + (kt & 3) * 32768;
        if (kt + 3 < nk) { char* s3 = smem + ((kt + 3) & 3) * 32768; al.issue(s3, kt + 3); bl.issue(s3 + 16384, kt + 3); }
        i32x8 bf[2], af[4];
#pragma unroll
        for (int nj = 0; nj < 2; ++nj) bf[nj] = mx_frag(st + brow + nj * 2048, c0, c1);
#pragma unroll
        for (int mi = 0; mi < 4; ++mi) af[mi] = mx_frag(st + arow + mi * 2048, c0, c1);
        if (kt + 1 < nk) { if (kt + 3 < nk) RING_WAIT(8); else if (kt + 2 < nk) RING_WAIT(4); else RING_WAIT(0); }
        RING_BAR();
        __builtin_amdgcn_s_setprio(1);
#pragma unroll
        for (int mi = 0; mi < 4; ++mi)
#pragma unroll
            for (int nj = 0; nj < 2; ++nj) acc[mi][nj] = mfma_mx(bf[nj], af[mi], acc[mi][nj]);
        __builtin_amdgcn_s_setprio(0);
        RING_BAR();
    }
    if (wr == 0) RING_BAR();
}

__device__ __forceinline__ int bperm16(int rho) { return (rho & ~63) + 16 * ((rho >> 2) & 3) + 4 * ((rho >> 4) & 3) + (rho & 3); }

__device__ __forceinline__ void epi_store_bf16(const f32x4 (&acc)[8][4], bf16_t* out, long ld, int row0, int col0) {
    const int tid_ = opaque_tid();
    const int lane = tid_ & 63, wid = tid_ >> 6;
    const int wr = wid >> 2, wc = wid & 3, fr = lane & 15, fq = lane >> 4;
#pragma unroll
    for (int mi = 0; mi < 8; ++mi) {
        bf16_t* rp = out + (long)(row0 + wr * 128 + mi * 16 + fr) * ld + col0 + wc * 64 + fq * 8;
#pragma unroll
        for (int q = 0; q < 2; ++q) {
            u32x4 w; w.x = pk_bf16(acc[mi][2 * q][0], acc[mi][2 * q][1]); w.y = pk_bf16(acc[mi][2 * q][2], acc[mi][2 * q][3]);
            w.z = pk_bf16(acc[mi][2 * q + 1][0], acc[mi][2 * q + 1][1]); w.w = pk_bf16(acc[mi][2 * q + 1][2], acc[mi][2 * q + 1][3]);
            *(u32x4*)(rp + q * 32) = w;
        }
    }
}

template <bool RES_LN>
__device__ __forceinline__ void epi_residual(f32x4 (&acc)[8][4], char* smem, const float* resid_f32, const bf16_t* resid_bf16, const float* rstats  ,
                                             const float* g, const float* b, bf16_t* rbout, float* stout  , int row0, int nt) {
    const int tid_ = opaque_tid();
    const int lane = tid_ & 63, wid = tid_ >> 6;
    const int wr = wid >> 2, wc = wid & 3, fr = lane & 15, fq = lane >> 4;
    float* sp = (float*)(smem + 139264);
    const int col0 = nt * 256 + wc * 64 + fq * 8;
#pragma unroll
    for (int mi = 0; mi < 8; ++mi) {
        const int rl = wr * 128 + mi * 16 + fr;
        const long row = row0 + rl;
        float mean = 0.f, rstd = 1.f;
        if (RES_LN) {
            const f32x4 p0 = *(const f32x4*)(rstats + row * 8), p1 = *(const f32x4*)(rstats + row * 8 + 4);
            const float s1 = (p0[0] + p0[2]) + (p1[0] + p1[2]), s2 = (p0[1] + p0[3]) + (p1[1] + p1[3]);
            mean = s1 * (1.0f / 1024.0f);
            const float var = fmaxf(s2 * (1.0f / 1024.0f) - mean * mean, 0.f);
            rstd = rsqrtf(var + LN_EPS);
        }
        float s1 = 0.f, s2 = 0.f;
#pragma unroll
        for (int q = 0; q < 2; ++q) {
            const long o = row * 1024 + col0 + q * 32;
            f32x4 x0, x1;
            if (RES_LN) {
                const u32x4 u = *(const u32x4*)(resid_bf16 + o);
                x0 = (f32x4){bf_lo(u.x), bf_hi(u.x), bf_lo(u.y), bf_hi(u.y)}; x1 = (f32x4){bf_lo(u.z), bf_hi(u.z), bf_lo(u.w), bf_hi(u.w)};
                x0 = (x0 - mean) * rstd * *(const f32x4*)(g + col0 + q * 32) + *(const f32x4*)(b + col0 + q * 32);
                x1 = (x1 - mean) * rstd * *(const f32x4*)(g + col0 + q * 32 + 4) + *(const f32x4*)(b + col0 + q * 32 + 4);
            } else { x0 = *(const f32x4*)(resid_f32 + o); x1 = *(const f32x4*)(resid_f32 + o + 4); }
            const f32x4 v0 = acc[mi][2 * q] + ALPHA * x0, v1 = acc[mi][2 * q + 1] + ALPHA * x1;
            { u32x4 w; w.x = pk_bf16(v0[0], v0[1]); w.y = pk_bf16(v0[2], v0[3]); w.z = pk_bf16(v1[0], v1[1]); w.w = pk_bf16(v1[2], v1[3]); *(u32x4*)(rbout + o) = w; }
            s1 += ((v0[0] + v0[1]) + (v0[2] + v0[3])) + ((v1[0] + v1[1]) + (v1[2] + v1[3]));
            s2 += ((v0[0] * v0[0] + v0[1] * v0[1]) + (v0[2] * v0[2] + v0[3] * v0[3])) + ((v1[0] * v1[0] + v1[1] * v1[1]) + (v1[2] * v1[2] + v1[3] * v1[3]));
        }
        s1 = fq_sum(s1); s2 = fq_sum(s2);
        if (fq == 0) { sp[(rl * 4 + wc) * 2] = s1; sp[(rl * 4 + wc) * 2 + 1] = s2; }
    }
    __syncthreads();
    if (tid_ < 256) {
        const int rl = tid_;
        const float a1 = (sp[rl * 8] + sp[rl * 8 + 2]) + (sp[rl * 8 + 4] + sp[rl * 8 + 6]);
        const float a2 = (sp[rl * 8 + 1] + sp[rl * 8 + 3]) + (sp[rl * 8 + 5] + sp[rl * 8 + 7]);
        *(f32x2*)(stout + ((long)(row0 + rl) * 4 + nt) * 2) = (f32x2){a1, a2};
    }
    __syncthreads();
}

__device__ __forceinline__ void ln_tile_stats(float* st, const float* rstats, int row0) {
    const int tid_ = opaque_tid();
    if (tid_ < 256) {
        const long row = row0 + tid_;
        const f32x4 p0 = *(const f32x4*)(rstats + row * 8), p1 = *(const f32x4*)(rstats + row * 8 + 4);
        const float s1 = (p0[0] + p0[2]) + (p1[0] + p1[2]), s2 = (p0[1] + p0[3]) + (p1[1] + p1[3]);
        const float mean = s1 * (1.0f / 1024.0f);
        const float var = fmaxf(s2 * (1.0f / 1024.0f) - mean * mean, 0.f);
        st[tid_ * 2] = mean; st[tid_ * 2 + 1] = rsqrtf(var + LN_EPS);
    }
}
__device__ __forceinline__ void ln_load_gb(float* gb, const float* g, const float* b) {
    for (int i = opaque_tid(); i < 1024; i += NTHR) { gb[i] = g[i]; gb[1024 + i] = b[i]; }
}


struct XcdSlab {
    int x, j, stride;
    __device__ __forceinline__ void init(int bid, int nb) { if ((nb & 7) == 0) { x = bid & 7; j = bid >> 3; stride = nb >> 3; } else { x = -1; j = bid; stride = nb; } }
    __device__ __forceinline__ int m_lo(int nM) const { return x < 0 ? 0 : (x * nM) >> 3; }
    __device__ __forceinline__ int m_hi(int nM) const { return x < 0 ? nM : ((x + 1) * nM) >> 3; }
};

template <int MAP>
__device__ __forceinline__ void ln_correct(f32x4 (&acc)[8][4], const float* rstats  , int row0, const float* cs, const float* bw, int nt) {
    const int tid_ = opaque_tid();
    const int lane = tid_ & 63, wid = tid_ >> 6;
    const int wr = wid >> 2, wc = wid & 3, fr = lane & 15, fq = lane >> 4;
    float mean[8], rstd[8];
#pragma unroll
    for (int mi = 0; mi < 8; ++mi) {
        const long row = row0 + wr * 128 + mi * 16 + fr;
        const f32x4 p0 = *(const f32x4*)(rstats + row * 8), p1 = *(const f32x4*)(rstats + row * 8 + 4);
        const float s1 = (p0[0] + p0[2]) + (p1[0] + p1[2]), s2 = (p0[1] + p0[3]) + (p1[1] + p1[3]);
        mean[mi] = s1 * (1.0f / 1024.0f);
        rstd[mi] = rsqrtf(fmaxf(s2 * (1.0f / 1024.0f) - mean[mi] * mean[mi], 0.f) + LN_EPS);
    }
#pragma unroll
    for (int ni = 0; ni < 4; ++ni) {
        const int col = MAP == 0 ? nt * 256 + wc * 64 + (ni >> 1) * 32 + fq * 8 + (ni & 1) * 4
                                 : (ni & 1) * 256 + nt * 128 + wc * 32 + fq * 8 + (ni >> 1) * 4;
        const f32x4 c4 = *(const f32x4*)(cs + col), b4 = *(const f32x4*)(bw + col);
#pragma unroll
        for (int mi = 0; mi < 8; ++mi) acc[mi][ni] = (acc[mi][ni] - mean[mi] * c4) * rstd[mi] + b4;
    }
}
struct TJob { const float* src; int ldsrc; int K; int col0; int ncols; bf16_t* dst; int mode; int rowoff; const float* g; const float* b; float* part;   };
__device__ __forceinline__ int tjob_row(const TJob& j, int c) {
    if (j.mode == 0) return j.rowoff + c;
    const int oc = c & 127;
    return 256 * (c >> 7) + 64 * (oc >> 5) + 16 * (2 * ((oc >> 2) & 1) + j.rowoff) + 4 * ((oc >> 3) & 3) + (oc & 3);
}
__device__ __forceinline__ void transpose_tile(char* smem, const TJob& j, int kt, int ct) {
    float* tile = (float*)smem;
    float* red = tile + 64 * 65;
    const int tid = opaque_tid();
    float scs = 0.f, sbw = 0.f;
#pragma unroll
    for (int i = 0; i < 8; ++i) {
        const int e = tid + i * NTHR, kr = e >> 6, c = e & 63;
        const int cc = ct * 64 + c;
        float v = 0.f;
        if (cc < j.ncols) v = j.src[(long)(kt * 64 + kr) * j.ldsrc + j.col0 + cc];
        if (j.g) {
            const float gv = j.g[kt * 64 + kr], bv = j.b[kt * 64 + kr];
            sbw += bv * v;
            v *= gv;
            scs += __uint_as_float(pk_bf16(v, 0.f) << 16);
        }
        tile[kr * 65 + c] = v;
    }
    if (j.g) { red[(tid >> 6) * 64 + (tid & 63)] = scs; red[512 + (tid >> 6) * 64 + (tid & 63)] = sbw; }
    __syncthreads();
#pragma unroll
    for (int i = 0; i < 4; ++i) {
        const int e = tid + i * NTHR, c = e >> 5, k2 = (e & 31) * 2;
        const int cc = ct * 64 + c;
        if (cc < j.ncols) {
            const unsigned w = pk_bf16(tile[k2 * 65 + c], tile[(k2 + 1) * 65 + c]);
            *(unsigned*)(j.dst + (long)tjob_row(j, cc) * j.K + kt * 64 + k2) = w;
        }
    }
    if (j.g && tid < 128) {
        const int which = tid >> 6, c = tid & 63;
        float s = 0.f;
#pragma unroll
        for (int w = 0; w < 8; ++w) s += red[which * 512 + w * 64 + c];
        if (ct * 64 + c < j.ncols) j.part[(long)(which * 16 + kt) * 1792 + ct * 64 + c] = s;
    }
    __syncthreads();
}

__device__ __forceinline__ void tjob_run(int& g_rot, char* smem, int bid, int nb, const float* src, int ld, int K, int col0, int ncols, bf16_t* dst, int mode, int rowoff,
                                         const float* g = nullptr, const float* b = nullptr, float* part = nullptr) {
    TJob j; j.src = src; j.ldsrc = ld; j.K = K; j.col0 = col0; j.ncols = ncols; j.dst = dst; j.mode = mode; j.rowoff = rowoff; j.g = g; j.b = b; j.part = part;
    const int nkt = K / 64, nct = (ncols + 63) / 64, ntile = nkt * nct;
    const int first = (bid + nb - g_rot % nb) % nb;
    for (int t = first; t < ntile; t += nb) transpose_tile(smem, j, t % nkt, t / nkt);
    g_rot += ntile;
}

__device__ __forceinline__ void cvt_rows_bf16(const float* src, bf16_t* dst, long n8, int bid, int nb) {
    for (long i = (long)bid * NTHR + opaque_tid(); i < n8; i += (long)nb * NTHR) {
        const f32x4 a = *(const f32x4*)(src + i * 8), b = *(const f32x4*)(src + i * 8 + 4);
        u32x4 w; w.x = pk_bf16(a[0], a[1]); w.y = pk_bf16(a[2], a[3]); w.z = pk_bf16(b[0], b[1]); w.w = pk_bf16(b[2], b[3]);
        *(u32x4*)(dst + i * 8) = w;
    }
}

enum { I_X = 0, I_MEM, I_WIN, I_POSK, I_CKW1, I_CKW2, I_POSV, I_CVW1, I_CVW2, I_CONVW, I_IBIAS, I_FBIAS, I_NORMG, I_WOUT, I_LN1G, I_LN1B,
       I_XAWQ, I_XAWK, I_XAWV, I_XAWO, I_LN2G, I_LN2B, I_ROUTW, I_ROUTB, I_MW1, I_MW3, I_MW2, I_SW1, I_SW3, I_SW2, I_LN3G, I_LN3B };

__device__ __forceinline__ void phase0(const Params& p, char* smem, int bid, int nb) {
    char* ws = p.ws;
    int rot = 0;
    tjob_run(rot, smem, bid, nb, p.in[I_WIN], 3360, 1024, 0, 1280, (bf16_t*)(ws + WS_WIN), 0, 0);
    tjob_run(rot, smem, bid, nb, p.in[I_WIN], 3360, 1024, 1304, 2048, (bf16_t*)(ws + WS_WIN), 0, 1280);
    tjob_run(rot, smem, bid, nb, p.in[I_WIN], 3360, 1024, 1280, 24, (bf16_t*)(ws + WS_WIN), 0, 3328);
    tjob_run(rot, smem, bid, nb, p.in[I_WIN], 3360, 1024, 3352, 8, (bf16_t*)(ws + WS_WIN), 0, 3352);
    tjob_run(rot, smem, bid, nb, p.in[I_WOUT], 1024, 1024, 0, 1024, (bf16_t*)(ws + WS_WOUT), 0, 0);
    float* lnp = (float*)(ws + WS_LNP);
    tjob_run(rot, smem, bid, nb, p.in[I_XAWQ], 1024, 1024, 0, 1024, (bf16_t*)(ws + WS_WQ), 0, 0, p.in[I_LN1G], p.in[I_LN1B], lnp);
    tjob_run(rot, smem, bid, nb, p.in[I_XAWK], 1024, 1024, 0, 1024, (bf16_t*)(ws + WS_WKV), 0, 0);
    tjob_run(rot, smem, bid, nb, p.in[I_XAWV], 1024, 1024, 0, 1024, (bf16_t*)(ws + WS_WKV), 0, 1024);
    tjob_run(rot, smem, bid, nb, p.in[I_XAWO], 1024, 1024, 0, 1024, (bf16_t*)(ws + WS_WO), 0, 0);
    tjob_run(rot, smem, bid, nb, p.in[I_ROUTW], 256, 1024, 0, 256, (bf16_t*)(ws + WS_WR), 0, 0, p.in[I_LN2G], p.in[I_LN2B], lnp + 1024);
    tjob_run(rot, smem, bid, nb, p.in[I_SW1], 256, 1024, 0, 256, (bf16_t*)(ws + WS_WS13), 1, 0, p.in[I_LN2G], p.in[I_LN2B], lnp + 1280);
    tjob_run(rot, smem, bid, nb, p.in[I_SW3], 256, 1024, 0, 256, (bf16_t*)(ws + WS_WS13), 1, 1, p.in[I_LN2G], p.in[I_LN2B], lnp + 1536);
    tjob_run(rot, smem, bid, nb, p.in[I_SW2], 1024, 256, 0, 1024, (bf16_t*)(ws + WS_WS2), 0, 0);
    tjob_run(rot, smem, bid, nb, p.in[I_CKW1], 64, 2048, 0, 64, (bf16_t*)(ws + WS_CK1), 0, 0);
    tjob_run(rot, smem, bid, nb, p.in[I_CKW2], 64, 64, 0, 64, (bf16_t*)(ws + WS_CK2), 0, 0);
    tjob_run(rot, smem, bid, nb, p.in[I_CVW1], 64, 2048, 0, 64, (bf16_t*)(ws + WS_CV1), 0, 0);
    tjob_run(rot, smem, bid, nb, p.in[I_CVW2], 64, 64, 0, 64, (bf16_t*)(ws + WS_CV2), 0, 0);
    cvt_rows_bf16(p.in[I_X], (bf16_t*)(ws + WS_XB), (long)T_TOK * 1024 / 8, bid, nb);
    cvt_rows_bf16(p.in[I_MEM], (bf16_t*)(ws + WS_MEMB), (long)4096 * 1024 / 8, bid, nb);
    { int* c = (int*)(ws + WS_CNT); for (int i = bid * NTHR + opaque_tid(); i < 24576; i += nb * NTHR) c[i] = 0; }
}

__device__ __forceinline__ void small_cols_task(const Params& p, int task) {
    const bf16_t* xb = (const bf16_t*)(p.ws + WS_XB);
    const bf16_t* wt = (const bf16_t*)(p.ws + WS_WIN) + (long)3328 * 1024;
    float* psm = (float*)(p.ws + WS_PSM);
    const int tid_ = opaque_tid();
    const int lane = tid_ & 63, wid = tid_ >> 6, fr = lane & 15, fq = lane >> 4;
    const int r0 = task * 256 + wid * 32;
    f32x4 acc[2][2];
#pragma unroll
    for (int mi = 0; mi < 2; ++mi)
#pragma unroll
        for (int ni = 0; ni < 2; ++ni) acc[mi][ni] = (f32x4){0.f, 0.f, 0.f, 0.f};
    const bf16_t* ap0 = xb + (long)(r0 + fr) * 1024 + fq * 8;
    const bf16_t* ap1 = ap0 + 16 * 1024;
    const bf16_t* bp0 = wt + (long)fr * 1024 + fq * 8;
    const bf16_t* bp1 = bp0 + 16 * 1024;
#pragma unroll 4
    for (int ks = 0; ks < 32; ++ks) {
        const bf16x8 a0 = *(const bf16x8*)(ap0 + ks * 32), a1 = *(const bf16x8*)(ap1 + ks * 32);
        const bf16x8 b0 = *(const bf16x8*)(bp0 + ks * 32), b1 = *(const bf16x8*)(bp1 + ks * 32);
        acc[0][0] = mfma16(b0, a0, acc[0][0]); acc[0][1] = mfma16(b1, a0, acc[0][1]);
        acc[1][0] = mfma16(b0, a1, acc[1][0]); acc[1][1] = mfma16(b1, a1, acc[1][1]);
    }
#pragma unroll
    for (int mi = 0; mi < 2; ++mi)
#pragma unroll
        for (int ni = 0; ni < 2; ++ni) *(f32x4*)(psm + (long)(r0 + mi * 16 + fr) * 32 + ni * 16 + fq * 4) = acc[mi][ni];
}

template <int NOEPI = 0>
__device__ __forceinline__ void phase1(const Params& p, char* smem, int bid, int nb) {
    char* ws = p.ws;
    XcdSlab xs; xs.init(bid, nb);
    const int a_lo = xs.m_lo(128), a_n = (xs.m_hi(128) - a_lo) * 14;
    const int b_lo = xs.m_lo(16), b_n = (xs.m_hi(16) - b_lo) * 8;
    bool inp = false; int mt = 0, nt = 0;
    RingRows al, bl;
    auto setup = [&](int u) {
        inp = u < a_n;
        const int uu = inp ? u : u - a_n;
        const int nm = inp ? (xs.m_hi(128) - a_lo) : (xs.m_hi(16) - b_lo);
        mt = (inp ? a_lo : b_lo) + uu % nm; nt = uu / nm;
        al.init_contig((const bf16_t*)(ws + (inp ? WS_XB : WS_MEMB)), 1024, mt * 256);
        bl.init_contig((const bf16_t*)(ws + (inp ? WS_WIN : WS_WKV)), 1024, nt * 256, true);
    };
    int u = xs.j;
    if (u < a_n + b_n) { setup(u); ring_issue3(smem, al, bl); }
    while (u < a_n + b_n) {
        const bool cinp = inp; const int cmt = mt, cnt_ = nt;
        f32x4 acc[8][4];
        gemm_ring<RingRows, RingRows, 0, true>(smem, al, bl, 32, acc);
        u += xs.stride;
        if (u < a_n + b_n) { setup(u); ring_issue3(smem, al, bl); }
        if (NOEPI) { float s = 0.f;
#pragma unroll
            for (int mi = 0; mi < 8; ++mi)
#pragma unroll
                for (int ni = 0; ni < 4; ++ni) s += acc[mi][ni][0] + acc[mi][ni][1] + acc[mi][ni][2] + acc[mi][ni][3];
            if (s == 123.456f) ((float*)(ws + WS_A + 432 * MB))[opaque_tid()] = s; continue; }
        if (!cinp) epi_store_bf16(acc, (bf16_t*)(ws + WS_KVX), 2048, cmt * 256, cnt_ * 256);
        else if (cnt_ < 13) epi_store_bf16(acc, (bf16_t*)(ws + WS_P), PW, cmt * 256, cnt_ * 256);
        else {
            const int tid_ = opaque_tid();
            const int lane = tid_ & 63, wid = tid_ >> 6, wr = wid >> 2, wc = wid & 3, fr = lane & 15, fq = lane >> 4;
            if (wc == 0) {
                float* psm = (float*)(ws + WS_PSM);
#pragma unroll
                for (int mi = 0; mi < 8; ++mi)
#pragma unroll
                    for (int ni = 0; ni < 2; ++ni) *(f32x4*)(psm + (long)(cmt * 256 + wr * 128 + mi * 16 + fr) * 32 + fq * 8 + ni * 4) = acc[mi][ni];
            }
        }
    }
    asm volatile("s_waitcnt vmcnt(0)" ::: "memory");
}

__device__ __forceinline__ void compress_task(const Params& p, char* smem, int which, int rb) {
    const char* ws = p.ws;
    const bf16_t* P = (const bf16_t*)(ws + WS_P);
    const float* pos = p.in[which ? I_POSV : I_POSK];
    const bf16_t* w1t = (const bf16_t*)(ws + (which ? WS_CV1 : WS_CK1));
    const bf16_t* w2t = (const bf16_t*)(ws + (which ? WS_CV2 : WS_CK2));
    bf16_t* outp = (bf16_t*)(p.ws + (which ? WS_VCMP : WS_KCMP));
    const int colbase = which ? PC_VC : PC_KC;
    const int tid_ = opaque_tid();
    const int lane = tid_ & 63, wid = tid_ >> 6, fr = lane & 15, fq = lane >> 4;
    f32x4 acc[2][4];
#pragma unroll
    for (int mi = 0; mi < 2; ++mi)
#pragma unroll
        for (int ni = 0; ni < 4; ++ni) acc[mi][ni] = (f32x4){0.f, 0.f, 0.f, 0.f};
    const bf16_t* arow[2];
#pragma unroll
    for (int mi = 0; mi < 2; ++mi) {
        const int r = rb * 32 + mi * 16 + fr;
        const int b = r / 254, rem = r - b * 254, c = rem >> 1, g = rem & 1;
        arow[mi] = P + (long)(b * 2048 + c * 16) * PW + colbase + g * 64 + fq * 8;
    }
    const bf16_t* brow = w1t + (long)fr * 2048 + fq * 8;
    const float* prow = pos + fq * 8;
#pragma unroll 2
    for (int s = 0; s < 8; ++s) {
        const int ks = wid * 8 + s;
        const int l = ks >> 1, d0 = (ks & 1) * 32;
        const f32x4 p0 = *(const f32x4*)(prow + l * 64 + d0), p1 = *(const f32x4*)(prow + l * 64 + d0 + 4);
        bf16x8 af[2];
#pragma unroll
        for (int mi = 0; mi < 2; ++mi) {
            const u32x4 av = *(const u32x4*)(arow[mi] + (long)l * PW + d0);
            u32x4 aw;
            aw.x = pk_bf16(bf_lo(av.x) + p0[0], bf_hi(av.x) + p0[1]); aw.y = pk_bf16(bf_lo(av.y) + p0[2], bf_hi(av.y) + p0[3]);
            aw.z = pk_bf16(bf_lo(av.z) + p1[0], bf_hi(av.z) + p1[1]); aw.w = pk_bf16(bf_lo(av.w) + p1[2], bf_hi(av.w) + p1[3]);
            af[mi] = as_bf16x8(aw);
        }
#pragma unroll
        for (int ni = 0; ni < 4; ++ni) {
            const bf16x8 bb = *(const bf16x8*)(brow + (long)(ni * 16) * 2048 + ks * 32);
            acc[0][ni] = mfma16(bb, af[0], acc[0][ni]);
            acc[1][ni] = mfma16(bb, af[1], acc[1][ni]);
        }
    }
    f32x4* part = (f32x4*)(smem + 8192);
#pragma unroll
    for (int mi = 0; mi < 2; ++mi)
#pragma unroll
        for (int ni = 0; ni < 4; ++ni) part[(wid * 8 + mi * 4 + ni) * 64 + lane] = acc[mi][ni];
    __syncthreads();
    const int mi = wid >> 2, ni = wid & 3;
    f32x4 a1 = (f32x4){0.f, 0.f, 0.f, 0.f};
#pragma unroll
    for (int w = 0; w < 8; ++w) a1 = a1 + part[(w * 8 + wid) * 64 + lane];
    bf16_t* h1 = (bf16_t*)smem;
    {
        u32x2 w; w.x = pk_bf16(siluf_(a1[0]), siluf_(a1[1])); w.y = pk_bf16(siluf_(a1[2]), siluf_(a1[3]));
        *(u32x2*)(h1 + (mi * 16 + fr) * 72 + ni * 16 + fq * 4) = w;
    }
    __syncthreads();
    f32x4 acc2 = (f32x4){0.f, 0.f, 0.f, 0.f};
#pragma unroll
    for (int ks = 0; ks < 2; ++ks) {
        const bf16x8 a = *(const bf16x8*)(h1 + (mi * 16 + fr) * 72 + ks * 32 + fq * 8);
        const bf16x8 bb = *(const bf16x8*)(w2t + (ni * 16 + fr) * 64 + ks * 32 + fq * 8);
        acc2 = mfma16(bb, a, acc2);
    }
    {
        const int r = rb * 32 + mi * 16 + fr;
        const int b = r / 254, rem = r - b * 254, c = rem >> 1, g = rem & 1;
        u32x2 w; w.x = pk_bf16(acc2[0], acc2[1]); w.y = pk_bf16(acc2[2], acc2[3]);
        *(u32x2*)(outp + ((long)(b * 2 + g) * 128 + c) * 64 + ni * 16 + fq * 4) = w;
    }
    __syncthreads();
}

__device__ __forceinline__ void phase2(const Params& p, char* smem, int bid, int nb) {
    char* ws = p.ws;
    {
        const int idx = bid * NTHR + opaque_tid();
        if (idx < 2 * 1792) {
            const float* pp = (const float*)(ws + WS_LNP) + (long)(idx / 1792) * 16 * 1792 + idx % 1792;
            float s = 0.f;
#pragma unroll
            for (int k = 0; k < 16; ++k) s += pp[k * 1792];
            ((float*)(ws + WS_LNF))[idx] = s;
        }
    }
    for (int t = bid; t < 254; t += nb) compress_task(p, smem, t / 127, t % 127);
    const int tid_ = opaque_tid();
    if (bid < 32 && tid_ < 32) {
        bf16_t* kc = (bf16_t*)(ws + WS_KCMP) + ((long)bid * 128 + 127) * 64;
        bf16_t* vc = (bf16_t*)(ws + WS_VCMP) + ((long)bid * 128 + 127) * 64;
        ((unsigned*)kc)[tid_] = 0u; ((unsigned*)vc)[tid_] = 0u;
    }
    const bf16_t* P = (const bf16_t*)(ws + WS_P);
    const float* cw = p.in[I_CONVW];
    bf16_t* qk = (bf16_t*)(ws + WS_QK);
    for (long it = (long)bid * NTHR + tid_; it < (long)T_TOK * 128; it += (long)nb * NTHR) {
        const int t = (int)(it >> 7), ch = (int)(it & 127);
        const int s = t & (SEQ - 1);
        float a[8];
#pragma unroll
        for (int e = 0; e < 8; ++e) a[e] = 0.f;
#pragma unroll
        for (int j = 0; j < 4; ++j) {
            if (s - 3 + j >= 0) {
                const u32x4 u = *(const u32x4*)(P + (long)(t - 3 + j) * PW + PC_MQ + ch * 8);
                const f32x4 w0 = *(const f32x4*)(cw + j * 1024 + ch * 8), w1 = *(const f32x4*)(cw + j * 1024 + ch * 8 + 4);
                a[0] += w0[0] * bf_lo(u.x); a[1] += w0[1] * bf_hi(u.x); a[2] += w0[2] * bf_lo(u.y); a[3] += w0[3] * bf_hi(u.y);
                a[4] += w1[0] * bf_lo(u.z); a[5] += w1[1] * bf_hi(u.z); a[6] += w1[2] * bf_lo(u.w); a[7] += w1[3] * bf_hi(u.w);
            }
        }
        const float sc = ch < 64 ? 0.08838834764831845f : 1.0f;
        u32x4 w;
        w.x = pk_bf16(siluf_(a[0]) * sc, siluf_(a[1]) * sc); w.y = pk_bf16(siluf_(a[2]) * sc, siluf_(a[3]) * sc);
        w.z = pk_bf16(siluf_(a[4]) * sc, siluf_(a[5]) * sc); w.w = pk_bf16(siluf_(a[6]) * sc, siluf_(a[7]) * sc);
        *(u32x4*)(qk + (long)t * 1024 + ch * 8) = w;
    }
}

typedef __attribute__((address_space(3))) s16x4 lds_s16x4;
__device__ __forceinline__ s16x4 lds_tr(const char* a) { return __builtin_amdgcn_ds_read_tr16_b64_v4i16((lds_s16x4*)a); }
__device__ __forceinline__ bf16x8 tr_frag_perm(const char* base, int pitch, int rbase, int cbase, int fr, int fq) {
    const char* a0 = base + (rbase + 4 * fq + (fr >> 2)) * pitch + (cbase + 4 * (fr & 3)) * 2;
    const s16x4 lo = lds_tr(a0), hi = lds_tr(a0 + 16 * pitch);
    return (bf16x8){lo[0], lo[1], lo[2], lo[3], hi[0], hi[1], hi[2], hi[3]};
}
__device__ __forceinline__ bf16x8 tr_frag_std(const char* base, int pitch, int rbase, int cbase, int fr, int fq) {
    const char* a0 = base + (rbase + 8 * fq + (fr >> 2)) * pitch + (cbase + 4 * (fr & 3)) * 2;
    const s16x4 lo = lds_tr(a0), hi = lds_tr(a0 + 4 * pitch);
    return (bf16x8){lo[0], lo[1], lo[2], lo[3], hi[0], hi[1], hi[2], hi[3]};
}
__device__ __forceinline__ bf16x8 pack_p(const f32x4 a, const f32x4 b) {
    u32x4 w; w.x = pk_bf16(a[0], a[1]); w.y = pk_bf16(a[2], a[3]); w.z = pk_bf16(b[0], b[1]); w.w = pk_bf16(b[2], b[3]);
    return as_bf16x8(w);
}

__device__ __forceinline__ float dpp_xor1(float v) { return __builtin_bit_cast(float, __builtin_amdgcn_mov_dpp(__builtin_bit_cast(int, v), 0xB1, 0xF, 0xF, true)); }
__device__ __forceinline__ float dpp_xor2(float v) { return __builtin_bit_cast(float, __builtin_amdgcn_mov_dpp(__builtin_bit_cast(int, v), 0x4E, 0xF, 0xF, true)); }

constexpr int NSA_PITCH = 160;
constexpr int NSA_KC = 0, NSA_VC = 20480, NSA_KT = 40960, NSA_VT = 61440, NSA_MISC = 81920, NSA_Y = 83968;

struct NsaState {
    bf16x8 qf[2][2];
    int tl[2];
    unsigned selm[2];
    unsigned wunion, bunion;
};

constexpr int NSA_STG = 16384;
__device__ __forceinline__ bf16x8 tr_frag_perm_swz(const char* base, int rbase, int dt, int fr, int fq) {
    const int R = rbase + 4 * fq + (fr >> 2), c = 2 * dt + ((fr & 3) >> 1);
    const char* a0 = base + R * 128 + ((c ^ (R & 7)) << 4) + 8 * (fr & 1);
    const s16x4 lo = lds_tr(a0), hi = lds_tr(a0 + 16 * 128);
    return (bf16x8){lo[0], lo[1], lo[2], lo[3], hi[0], hi[1], hi[2], hi[3]};
}

#define NSA_WAITV(n) asm volatile("s_waitcnt vmcnt(" #n ")" ::: "memory")
#define NSA_BAR() do { asm volatile("s_waitcnt lgkmcnt(0)" ::: "memory"); __builtin_amdgcn_s_barrier(); asm volatile("" ::: "memory"); } while (0)

template <int MODE>
__device__ __forceinline__ void nsa_stream(char* smem, const bf16_t* Pb  , int g, int i, NsaState& st, float gate0, float gate1, const int tid) {
    const int lane = tid & 63, fr = lane & 15, fq = lane >> 4;
    const int kcol = (MODE == 0 ? PC_KS : PC_KW) + g * 64, vcol = (MODE == 0 ? PC_VS : PC_VW) + g * 64;
    const int lrow = tid >> 3, lch = (tid & 7) ^ (lrow & 7);
    const bf16_t* ksrc = Pb + (long)lrow * PW + kcol + lch * 8;
    const bf16_t* vsrc = Pb + (long)lrow * PW + vcol + lch * 8;
    const int jlo = MODE == 0 ? 0 : (i - 8 > 0 ? i - 8 : 0);
    const unsigned range = (i >= 31 ? 0xffffffffu : ((1u << (i + 1)) - 1u)) & ~((1u << jlo) - 1u);
    const unsigned need = (unsigned)__builtin_amdgcn_readfirstlane((int)((MODE == 0 ? st.bunion : 0xffffffffu) & range));
    f32x4 O[2][4];
    float m[2], l[2];
    int tlq[2];
#pragma unroll
    for (int mt = 0; mt < 2; ++mt) { m[mt] = -1e30f; l[mt] = 0.f; tlq[mt] = st.tl[mt] - 4 * fq;
#pragma unroll
        for (int dt = 0; dt < 4; ++dt) O[mt][dt] = (f32x4){0.f, 0.f, 0.f, 0.f}; }
    unsigned pm = need;
    int nissued = 0;
    auto issue_next = [&]() {
        const int jj = __builtin_ctz(pm); pm &= pm - 1u;
        char* sb = smem + (nissued & 3) * NSA_STG;
        __builtin_amdgcn_global_load_lds((glb_u32*)(ksrc + (long)jj * 64 * PW), (lds_u32*)(sb + tid * 16), 16, 0, 0);
        __builtin_amdgcn_global_load_lds((glb_u32*)(vsrc + (long)jj * 64 * PW), (lds_u32*)(sb + 8192 + tid * 16), 16, 0, 0);
        ++nissued;
    };
    const int L = __builtin_popcount(need);
    if (L > 0) issue_next();
    if (L > 1) issue_next();
    if (L > 2) issue_next();
    if (L > 2) NSA_WAITV(4); else if (L > 1) NSA_WAITV(2); else NSA_WAITV(0);
    NSA_BAR();
    unsigned cm = need;
    for (int n = 0; n < L; ++n) {
        const int j = __builtin_ctz(cm); cm &= cm - 1u;
        if (n + 3 < L) issue_next();
        const char* KT = smem + (n & 3) * NSA_STG;
        const char* VT = KT + 8192;
        const bool wave_on = MODE == 0 ? (((st.wunion >> j) & 1u) != 0u) : true;
        if (wave_on) {
            f32x4 S[2][4];
            {
                bf16x8 kf[4][2];
#pragma unroll
                for (int nt = 0; nt < 4; ++nt)
#pragma unroll
                    for (int ks = 0; ks < 2; ++ks) kf[nt][ks] = *(const bf16x8*)(KT + (16 * nt + fr) * 128 + (((ks * 4 + fq) ^ (fr & 7)) << 4));
#pragma unroll
                for (int mt = 0; mt < 2; ++mt)
#pragma unroll
                    for (int nt = 0; nt < 4; ++nt) {
                        f32x4 s = (f32x4){0.f, 0.f, 0.f, 0.f};
                        s = mfma16(kf[nt][0], st.qf[mt][0], s);
                        s = mfma16(kf[nt][1], st.qf[mt][1], s);
                        S[mt][nt] = s;
                    }
            }
            bf16x8 pf[2][2];
            const bool edge = (j == i) || (MODE == 1 && j == i - 8);
            constexpr float CS = 0.125f * 1.4426950408889634f;
#pragma unroll
            for (int mt = 0; mt < 2; ++mt) {
                const bool rowsel = MODE == 0 ? (((st.selm[mt] >> j) & 1u) != 0u) : true;
                if (edge) {
                    asm volatile("; boundary tile" ::: "memory");
#pragma unroll
                    for (int nt = 0; nt < 4; ++nt)
#pragma unroll
                        for (int e = 0; e < 4; ++e) {
                            const int kc = 16 * nt + e;
                            bool ok = true;
                            if (j == i) ok = ok && (kc <= tlq[mt]);
                            if (MODE == 1) { if (j == i - 8) ok = ok && (kc > tlq[mt]); }
                            S[mt][nt][e] = ok ? S[mt][nt][e] : -INFINITY;
                        }
                }
                float mx = -INFINITY;
#pragma unroll
                for (int nt = 0; nt < 4; ++nt)
#pragma unroll
                    for (int e = 0; e < 4; ++e) mx = __builtin_fmaxf(mx, S[mt][nt][e]);
                mx = fq_max(mx);
                if (MODE == 0) mx = rowsel ? mx : -INFINITY;
                const float mnew = __builtin_fmaxf(m[mt], mx * CS);
                const float alpha = __builtin_amdgcn_exp2f(m[mt] - mnew);
                const float msub = (MODE == 0 && !rowsel) ? INFINITY : mnew;
                float rs = 0.f;
#pragma unroll
                for (int nt = 0; nt < 4; ++nt)
#pragma unroll
                    for (int e = 0; e < 4; ++e) { const float pv = __builtin_amdgcn_exp2f(__builtin_fmaf(S[mt][nt][e], CS, -msub)); S[mt][nt][e] = pv; rs += pv; }
                rs = fq_sum(rs);
                l[mt] = l[mt] * alpha + rs; m[mt] = mnew;
#pragma unroll
                for (int dt = 0; dt < 4; ++dt) O[mt][dt] = O[mt][dt] * alpha;
                pf[mt][0] = pack_p(S[mt][0], S[mt][1]); pf[mt][1] = pack_p(S[mt][2], S[mt][3]);
            }
#pragma unroll
            for (int ks2 = 0; ks2 < 2; ++ks2)
#pragma unroll
                for (int dt = 0; dt < 4; ++dt) {
                    const bf16x8 vf = tr_frag_perm_swz(VT, 32 * ks2, dt, fr, fq);
                    O[0][dt] = mfma16(vf, pf[0][ks2], O[0][dt]);
                    O[1][dt] = mfma16(vf, pf[1][ks2], O[1][dt]);
                }
        }
        if (n + 1 < L) { if (n + 3 < L) NSA_WAITV(4); else if (n + 2 < L) NSA_WAITV(2); else NSA_WAITV(0); }
        NSA_BAR();
    }
#pragma unroll
    for (int mt = 0; mt < 2; ++mt) {
        const float gsc = (mt == 0 ? gate0 : gate1) * (l[mt] > 0.f ? 1.0f / l[mt] : 0.f);
#pragma unroll
        for (int dt = 0; dt < 4; ++dt) { f32x4* yp = (f32x4*)(smem + NSA_Y) + (mt * 4 + dt) * NTHR + tid; *yp = *yp + O[mt][dt] * gsc; }
    }
}

__device__ __forceinline__ void nsa_cmp_one(const char* smem, const bf16x8 qf0, const bf16x8 qf1, const int t, const int i, const float gate0, f32x4* yp  , unsigned& selm, const int lane) {
    const int fr = lane & 15, fq = lane >> 4;
        const int cl = (t >= 31 ? ((t - 31) >> 4) : -1) - 4 * fq;
        f32x4 S[8];
#pragma unroll
        for (int nt = 0; nt < 8; ++nt) {
            f32x4 s = (f32x4){0.f, 0.f, 0.f, 0.f};
#pragma unroll
            for (int ks = 0; ks < 2; ++ks) {
                const bf16x8 kf = *(const bf16x8*)(smem + NSA_KC + (16 * nt + fr) * NSA_PITCH + (ks * 4 + fq) * 16);
                s = mfma16(kf, (ks == 0 ? qf0 : qf1), s);
            }
            S[nt] = s;
        }
        float mx = -INFINITY;
#pragma unroll
        for (int nt = 0; nt < 8; ++nt)
#pragma unroll
            for (int e = 0; e < 4; ++e) {
                const float sv = (16 * nt + e <= cl) ? S[nt][e] * 0.125f : -INFINITY;
                S[nt][e] = sv; mx = fmaxf(mx, sv);
            }
        mx = fq_max(mx);
        const float mref = fmaxf(mx, -1e30f);
        float rs = 0.f;
#pragma unroll
        for (int nt = 0; nt < 8; ++nt)
#pragma unroll
            for (int e = 0; e < 4; ++e) { const float pv = __expf(S[nt][e] - mref); S[nt][e] = pv; rs += pv; }
        rs = fq_sum(rs);
        const float inv = rs > 0.f ? 1.0f / rs : 0.f;
#pragma unroll
        for (int nt = 0; nt < 8; ++nt) S[nt] = S[nt] * inv;
        {
            f32x4 O[4];
#pragma unroll
            for (int dt = 0; dt < 4; ++dt) O[dt] = (f32x4){0.f, 0.f, 0.f, 0.f};
#pragma unroll
            for (int ks2 = 0; ks2 < 4; ++ks2) {
                const bf16x8 pf = pack_p(S[2 * ks2], S[2 * ks2 + 1]);
#pragma unroll
                for (int dt = 0; dt < 4; ++dt) {
                    const bf16x8 vf = tr_frag_perm(smem + NSA_VC, NSA_PITCH, 32 * ks2, 16 * dt, fr, fq);
                    O[dt] = mfma16(vf, pf, O[dt]);
                }
            }
#pragma unroll
            for (int dt = 0; dt < 4; ++dt) yp[dt * NTHR] = O[dt] * gate0;
        }
        float imp[8];
        {
            float own[8], last[8];
#pragma unroll
            for (int nt = 0; nt < 8; ++nt) {
                f32x4 v = S[nt];
#pragma unroll
                for (int e = 0; e < 4; ++e) { v[e] += dpp_xor1(v[e]); v[e] += dpp_xor2(v[e]); }
                own[nt] = (v[0] + v[1]) + (v[2] + v[3]); last[nt] = v[3];
            }
            const int src = (lane + 48) & 63;
#pragma unroll
            for (int nt = 0; nt < 8; ++nt) {
                const float a = __shfl(last[nt], src);
                const float bsh = nt > 0 ? __shfl(last[nt > 0 ? nt - 1 : 0], src) : 0.f;
                const float prevc = fq > 0 ? a : bsh;
                const int n = 4 * nt + fq;
                const float pslc = own[nt] + prevc;
                const bool valid = n <= i;
                const bool forced = (n == 0) || (n == i) || (n == i - 1);
                imp[nt] = valid ? pslc + (forced ? 1e4f : 0.f) : -1e30f;
            }
        }
        unsigned mask = 0u;
#pragma unroll 1
        for (int r = 0; r < 8; ++r) {
            float bv = imp[0]; int bn = fq;
#pragma unroll
            for (int nt = 1; nt < 8; ++nt) { if (imp[nt] > bv) { bv = imp[nt]; bn = 4 * nt + fq; } }
#pragma unroll
            for (int off = 16; off <= 32; off <<= 1) {
                const float ov = __shfl_xor(bv, off); const int on = __shfl_xor(bn, off);
                if (ov > bv || (ov == bv && on < bn)) { bv = ov; bn = on; }
            }
            if (bv > -5e29f) mask |= 1u << bn;
#pragma unroll
            for (int nt = 0; nt < 8; ++nt) if (bn == 4 * nt + fq) imp[nt] = -3.0e38f;
        }
        selm = mask;
}

template <int NSAV = 7  >
__device__ __forceinline__ void nsa_task(const Params& p, char* smem, int b, int g, int i) {
    const char* ws = p.ws;
    const bf16_t* Pb = (const bf16_t*)(ws + WS_P) + (long)b * SEQ * PW;
    const float* psm = (const float*)(ws + WS_PSM) + (long)b * SEQ * 32;
    int tid = threadIdx.x;
    asm volatile("" : "+v"(tid));
    const int lane = tid & 63, wid = __builtin_amdgcn_readfirstlane(tid >> 6), fr = lane & 15, fq = lane >> 4;
    const int qs = i * 64;
    NsaState st;
    float gate[2][3];
#pragma unroll
    for (int mt = 0; mt < 2; ++mt) {
        st.tl[mt] = 8 * wid + 4 * mt + (fr >> 2);
        const int h = fr & 3;
        const bf16_t* qp = Pb + (long)(qs + st.tl[mt]) * PW + PC_Q + g * 256 + h * 64 + fq * 8;
        st.qf[mt][0] = *(const bf16x8*)(qp); st.qf[mt][1] = *(const bf16x8*)(qp + 32);
        const float* gp = psm + (long)(qs + st.tl[mt]) * 32 + (g * 4 + h) * 3;
        gate[mt][0] = sigmoidf_(gp[0]); gate[mt][1] = sigmoidf_(gp[1]); gate[mt][2] = sigmoidf_(gp[2]);
    }
    {
        const bf16_t* kc = (const bf16_t*)(ws + WS_KCMP) + (long)(b * 2 + g) * 128 * 64;
        const bf16_t* vc = (const bf16_t*)(ws + WS_VCMP) + (long)(b * 2 + g) * 128 * 64;
#pragma unroll
        for (int r = 0; r < 2; ++r) {
            const int e = tid + r * NTHR, row = e >> 3, ch = e & 7;
            *(u32x4*)(smem + NSA_KC + row * NSA_PITCH + ch * 16) = *(const u32x4*)(kc + row * 64 + ch * 8);
            *(u32x4*)(smem + NSA_VC + row * NSA_PITCH + ch * 16) = *(const u32x4*)(vc + row * 64 + ch * 8);
        }
    }
    __syncthreads();
    if (!(NSAV & 1)) { st.selm[0] = 0xffffffffu; st.selm[1] = 0xffffffffu;
#pragma unroll
        for (int d8 = 0; d8 < 8; ++d8) ((f32x4*)(smem + NSA_Y))[d8 * NTHR + tid] = (f32x4){0.f, 0.f, 0.f, 0.f}; }
    if (NSAV & 1) {
    nsa_cmp_one(smem, st.qf[0][0], st.qf[0][1], qs + st.tl[0], i, gate[0][0], (f32x4*)(smem + NSA_Y) + tid, st.selm[0], lane);
    asm volatile("" ::: "memory");
    __builtin_amdgcn_sched_barrier(0);
    nsa_cmp_one(smem, st.qf[1][0], st.qf[1][1], qs + st.tl[1], i, gate[1][0], (f32x4*)(smem + NSA_Y) + 4 * NTHR + tid, st.selm[1], lane);
    __builtin_amdgcn_sched_barrier(0);
    }
    {
        unsigned u = st.selm[0] | st.selm[1];
        u |= __shfl_xor(u, 4); u |= __shfl_xor(u, 8);
        st.wunion = u;
        unsigned* misc = (unsigned*)(smem + NSA_MISC);
        if (lane == 0) misc[wid] = u;
        __syncthreads();
        unsigned bu = 0u;
#pragma unroll
        for (int w = 0; w < 8; ++w) bu |= misc[w];
        st.bunion = bu;
    }
    if (NSAV & 2) nsa_stream<0>(smem, Pb, g, i, st, gate[0][1], gate[1][1], tid);
    if (NSAV & 4) nsa_stream<1>(smem, Pb, g, i, st, gate[0][2], gate[1][2], tid);
    bf16_t* mix = (bf16_t*)(p.ws + WS_MIX) + (long)b * SEQ * 1024;
#pragma unroll
    for (int mt = 0; mt < 2; ++mt) {
        bf16_t* op = mix + (long)(qs + st.tl[mt]) * 1024 + g * 256 + (fr & 3) * 64 + fq * 4;
#pragma unroll
        for (int dt = 0; dt < 4; ++dt) {
            const f32x4 yv = *((const f32x4*)(smem + NSA_Y) + (mt * 4 + dt) * NTHR + tid);
            u32x2 w; w.x = pk_bf16(yv[0], yv[1]); w.y = pk_bf16(yv[2], yv[3]);
            *(u32x2*)(op + dt * 16) = w;
        }
    }
    __syncthreads();
}

constexpr int ML_PITCH = 288;
constexpr int ML_Q = 0, ML_K = 18432, ML_V = 36864, ML_VW = 55296, ML_C = 73728, ML_N = 110592, ML_GB = 111104, ML_GA = 119296, ML_GMQ = 127488,
              ML_GS = 135680, ML_ST = 136192;

__device__ __forceinline__ float wave_incl_scan_add(float v, int lane) {
#pragma unroll
    for (int off = 1; off < 64; off <<= 1) { const float o = __shfl_up(v, off); if (lane >= off) v += o; }
    return v;
}
__device__ __forceinline__ float wave_incl_scan_max(float v, int lane) {
#pragma unroll
    for (int off = 1; off < 64; off <<= 1) { const float o = __shfl_up(v, off); if (lane >= off) v = fmaxf(v, o); }
    return v;
}
__device__ __forceinline__ float wave_max(float v) {
#pragma unroll
    for (int off = 32; off >= 1; off >>= 1) v = fmaxf(v, __shfl_xor(v, off));
    return v;
}

__device__ __forceinline__ void mlstm_scan(const Params& p, char* smem, int b, int h) {
    const char* ws = p.ws;
    int tid = threadIdx.x;
    asm volatile("" : "+v"(tid));
    const int lane = tid & 63, wid = __builtin_amdgcn_readfirstlane(tid >> 6), fr = lane & 15, fq = lane >> 4;
    const bf16_t* QK = (const bf16_t*)(ws + WS_QK) + (long)b * SEQ * 1024 + h * 128;
    const bf16_t* Pb = (const bf16_t*)(ws + WS_P) + (long)b * SEQ * PW;
    const float* psm = (const float*)(ws + WS_PSM) + (long)b * SEQ * 32;
    bf16_t* mix = (bf16_t*)(p.ws + WS_MIX) + (long)b * SEQ * 1024 + 512 + h * 128;
    float* GB = (float*)(smem + ML_GB); float* GA = (float*)(smem + ML_GA); float* GMQ = (float*)(smem + ML_GMQ);
    float* GS = (float*)(smem + ML_GS);
    float* NV = (float*)(smem + ML_N);
    float* ST = (float*)(smem + ML_ST);
    {
        const float ib = p.in[I_IBIAS][h], fb = p.in[I_FBIAS][h];
        for (int c = wid; c < 32; c += 8) {
            const int t = c * 64 + lane;
            const float ipre = psm[(long)t * 32 + 24 + h], fpre = psm[(long)t * 32 + 28 + h];
            const float li = ipre + ib;
            const float x = fpre + fb;
            const float lf = fminf(x, 0.f) - log1pf(__expf(-fabsf(x)));
            const float bb = wave_incl_scan_add(lf, lane);
            const float aa = li - bb;
            const float g = __shfl(bb, 63);
            const float pm = wave_incl_scan_max(aa, lane);
            const float mloc = wave_max(g + aa);
            GB[t] = bb; GA[t] = aa; GMQ[t] = pm;
            if (lane == 0) { GS[64 + c] = g; GS[96 + c] = mloc; }
        }
    }
    for (int e = tid; e < 36864 / 16; e += NTHR) *(u32x4*)(smem + ML_C + e * 16) = (u32x4){0u, 0u, 0u, 0u};
    if (tid < 128) NV[tid] = 0.f;
    __syncthreads();
    if (tid == 0) {
        float m = 0.f;
        for (int c = 0; c < 32; ++c) { GS[c] = m; const float mn = fmaxf(GS[64 + c] + m, GS[96 + c]); GS[32 + c] = mn; m = mn; }
    }
    __syncthreads();
    for (int t = tid; t < SEQ; t += NTHR) GMQ[t] = GB[t] + fmaxf(GS[t >> 6], GMQ[t]);
    __syncthreads();

    f32x4 Cacc[9];
#pragma unroll
    for (int c9 = 0; c9 < 9; ++c9) Cacc[c9] = (f32x4){0.f, 0.f, 0.f, 0.f};
    const int lrow = tid >> 4, lch = tid & 15;
    u32x4 rq[2], rk[2], rv[2];
#pragma unroll
    for (int i2 = 0; i2 < 2; ++i2) {
        const int row = lrow + 32 * i2;
        rq[i2] = *(const u32x4*)(QK + (long)row * 1024 + lch * 8);
        rk[i2] = *(const u32x4*)(QK + (long)row * 1024 + 512 + lch * 8);
        rv[i2] = *(const u32x4*)(Pb + (long)row * PW + PC_MV + h * 128 + lch * 8);
    }
    const int mt = wid >> 1, half = wid & 1;
#pragma unroll 1
    for (int c = 0; c < 32; ++c) {
        const float m_old = GS[c], m_new = GS[32 + c], gch = GS[64 + c];
#pragma unroll
        for (int i2 = 0; i2 < 2; ++i2) {
            const int row = lrow + 32 * i2;
            *(u32x4*)(smem + ML_Q + row * ML_PITCH + lch * 16) = rq[i2];
            *(u32x4*)(smem + ML_K + row * ML_PITCH + lch * 16) = rk[i2];
            *(u32x4*)(smem + ML_V + row * ML_PITCH + lch * 16) = rv[i2];
            const float wk = __expf(gch + GA[c * 64 + row] - m_new);
            u32x4 w;
            w.x = pk_bf16(bf_lo(rv[i2].x) * wk, bf_hi(rv[i2].x) * wk); w.y = pk_bf16(bf_lo(rv[i2].y) * wk, bf_hi(rv[i2].y) * wk);
            w.z = pk_bf16(bf_lo(rv[i2].z) * wk, bf_hi(rv[i2].z) * wk); w.w = pk_bf16(bf_lo(rv[i2].w) * wk, bf_hi(rv[i2].w) * wk);
            *(u32x4*)(smem + ML_VW + row * ML_PITCH + lch * 16) = w;
        }
        if (tid < 128) {
            const int row = tid >> 1, hf = tid & 1;
            const float wk = __expf(gch + GA[c * 64 + row] - m_new);
            u32x4 w = (u32x4){0u, 0u, 0u, 0u};
            if (hf == 0) w.x = pk_bf16(wk, 0.f);
            *(u32x4*)(smem + ML_VW + row * ML_PITCH + 256 + hf * 16) = w;
        }
        __syncthreads();
        if (c + 1 < 32) {
#pragma unroll
            for (int i2 = 0; i2 < 2; ++i2) {
                const int row = (c + 1) * 64 + lrow + 32 * i2;
                rq[i2] = *(const u32x4*)(QK + (long)row * 1024 + lch * 8);
                rk[i2] = *(const u32x4*)(QK + (long)row * 1024 + 512 + lch * 8);
                rv[i2] = *(const u32x4*)(Pb + (long)row * PW + PC_MV + h * 128 + lch * 8);
            }
        }
        const int l = 16 * mt + fr;
        const float bl = GB[c * 64 + l], mq = GMQ[c * 64 + l];
        const float ul = bl - mq;
        f32x4 hv[4];
        float s1 = 0.f, s2 = 0.f;
        {
            bf16x8 qf[4];
#pragma unroll
            for (int ks = 0; ks < 4; ++ks) qf[ks] = *(const bf16x8*)(smem + ML_Q + l * ML_PITCH + (ks * 4 + fq) * 16);
            f32x4 S[4];
#pragma unroll
            for (int nt = 0; nt < 4; ++nt) {
                f32x4 s = (f32x4){0.f, 0.f, 0.f, 0.f};
#pragma unroll
                for (int ks = 0; ks < 4; ++ks) {
                    const bf16x8 kf = *(const bf16x8*)(smem + ML_K + (16 * nt + fr) * ML_PITCH + (ks * 4 + fq) * 16);
                    s = mfma16(kf, qf[ks], s);
                }
                S[nt] = s;
            }
            float dintra = 0.f;
            const int lq = l - 4 * fq;
#pragma unroll
            for (int nt = 0; nt < 4; ++nt) {
                const f32x4 av = *(const f32x4*)(GA + c * 64 + 16 * nt + 4 * fq);
#pragma unroll
                for (int e = 0; e < 4; ++e) {
                    const float w = (16 * nt + e <= lq) ? __expf(ul + av[e]) : 0.f;
                    const float sv = S[nt][e] * w;
                    S[nt][e] = sv; dintra += sv;
                }
            }
            dintra = fq_sum(dintra);
            float dinter = 0.f;
#pragma unroll
            for (int ks = 0; ks < 4; ++ks) {
                const f32x4 n0 = *(const f32x4*)(NV + ks * 32 + fq * 8), n1 = *(const f32x4*)(NV + ks * 32 + fq * 8 + 4);
                const u32x4 qu = __builtin_bit_cast(u32x4, qf[ks]);
                dinter += bf_lo(qu.x) * n0[0] + bf_hi(qu.x) * n0[1] + bf_lo(qu.y) * n0[2] + bf_hi(qu.y) * n0[3]
                        + bf_lo(qu.z) * n1[0] + bf_hi(qu.z) * n1[1] + bf_lo(qu.w) * n1[2] + bf_hi(qu.w) * n1[3];
            }
            dinter = fq_sum(dinter);
            const float winter = __expf(ul + m_old);
            const float den = winter * dinter + dintra;
            const float rden = 1.0f / fmaxf(fabsf(den), __expf(-mq));
            const bf16x8 pf0 = pack_p(S[0], S[1]), pf1 = pack_p(S[2], S[3]);
#pragma unroll
            for (int c4 = 0; c4 < 4; ++c4) {
                const int et = 4 * half + c4;
                f32x4 num = (f32x4){0.f, 0.f, 0.f, 0.f}, inter = (f32x4){0.f, 0.f, 0.f, 0.f};
                num = mfma16(tr_frag_perm(smem + ML_V, ML_PITCH, 0, 16 * et, fr, fq), pf0, num);
                num = mfma16(tr_frag_perm(smem + ML_V, ML_PITCH, 32, 16 * et, fr, fq), pf1, num);
#pragma unroll
                for (int ks = 0; ks < 4; ++ks) {
                    const bf16x8 cf = *(const bf16x8*)(smem + ML_C + (16 * et + fr) * ML_PITCH + (ks * 4 + fq) * 16);
                    inter = mfma16(cf, qf[ks], inter);
                }
                const f32x4 hh = (inter * winter + num) * rden;
                hv[c4] = hh;
                s1 += (hh[0] + hh[1]) + (hh[2] + hh[3]);
                s2 += (hh[0] * hh[0] + hh[1] * hh[1]) + (hh[2] * hh[2] + hh[3] * hh[3]);
            }
            s1 = fq_sum(s1); s2 = fq_sum(s2);
            if (fq == 0) { ST[(l * 2 + half) * 2] = s1; ST[(l * 2 + half) * 2 + 1] = s2; }
        }
        {
            const float decay = __expf(gch + m_old - m_new);
#pragma unroll
            for (int c9 = 0; c9 < 9; ++c9) Cacc[c9] = Cacc[c9] * decay;
#pragma unroll
            for (int ks2 = 0; ks2 < 2; ++ks2) {
                const bf16x8 kt = tr_frag_std(smem + ML_K, ML_PITCH, 32 * ks2, 16 * wid, fr, fq);
#pragma unroll
                for (int c9 = 0; c9 < 9; ++c9) {
                    const bf16x8 vw = tr_frag_std(smem + ML_VW, ML_PITCH, 32 * ks2, 16 * c9, fr, fq);
                    Cacc[c9] = mfma16(kt, vw, Cacc[c9]);
                }
            }
        }
        __syncthreads();
        {
            const float* sp = ST + l * 4;
            const float t1 = sp[0] + sp[2], t2 = sp[1] + sp[3];
            const float mean = t1 * (1.0f / 128.0f);
            const float var = fmaxf(t2 * (1.0f / 128.0f) - mean * mean, 0.f);
            const float rstd = rsqrtf(var + LN_EPS);
            const long tok = c * 64 + l;
#pragma unroll
            for (int c4 = 0; c4 < 4; ++c4) {
                const int col = 64 * half + 16 * c4 + 4 * fq;
                const u32x2 ou = *(const u32x2*)(Pb + tok * PW + PC_MO + h * 128 + col);
                const f32x4 ng = *(const f32x4*)(p.in[I_NORMG] + h * 128 + col);
                const f32x4 y = (hv[c4] - mean) * rstd * ng;
                u32x2 w;
                w.x = pk_bf16(y[0] * sigmoidf_(bf_lo(ou.x)), y[1] * sigmoidf_(bf_hi(ou.x)));
                w.y = pk_bf16(y[2] * sigmoidf_(bf_lo(ou.y)), y[3] * sigmoidf_(bf_hi(ou.y)));
                *(u32x2*)(mix + tok * 1024 + col) = w;
            }
        }
#pragma unroll
        for (int c9 = 0; c9 < 8; ++c9) {
            u32x2 w; w.x = pk_bf16(Cacc[c9][0], Cacc[c9][1]); w.y = pk_bf16(Cacc[c9][2], Cacc[c9][3]);
            *(u32x2*)(smem + ML_C + (16 * c9 + fr) * ML_PITCH + (16 * wid + 4 * fq) * 2) = w;
        }
        if (fr == 0) *(f32x4*)(NV + 16 * wid + 4 * fq) = Cacc[8];
        __syncthreads();
    }
}


constexpr float W8_SCALE = 64.0f, H8_SCALE = 16.0f, Y8_SCALE = 64.0f;
constexpr int CV_PITCH = 144;
__device__ __forceinline__ void wconv_task(const Params& p, char* smem, int which, int e, int nt) {
    const int tid = opaque_tid();
    const int ng = tid & 63, kg = tid >> 6, n0 = 4 * ng;
    const float* src; int ld, K; unsigned char* dst;
    if (which == 0) {
        const int col = 128 * nt + 32 * (n0 >> 6) + bperm32(n0 & 31);
        src = (((n0 >> 5) & 1) ? p.in[I_MW3] : p.in[I_MW1]) + (long)e * 1024 * 256 + col; ld = 256; K = 1024;
        dst = (unsigned char*)p.out + ((long)(e * 2 + nt) * 256) * 1024;
    } else {
        src = p.in[I_MW2] + (long)e * 256 * 1024 + nt * 256 + bperm32(n0); ld = 1024; K = 256;
        dst = (unsigned char*)(p.ws + WS_W2F8) + ((long)(e * 4 + nt) * 256) * 256;
    }
    for (int kc = 0; kc < K / 128; ++kc) {
        f32x4 v[16];
#pragma unroll
        for (int j = 0; j < 16; ++j) v[j] = *(const f32x4*)(src + (long)(kc * 128 + kg * 16 + j) * ld);
#pragma unroll
        for (int cc = 0; cc < 4; ++cc) {
            u32x4 w;
            w.x = pk4_fp8(v[0][cc] * W8_SCALE, v[1][cc] * W8_SCALE, v[2][cc] * W8_SCALE, v[3][cc] * W8_SCALE);
            w.y = pk4_fp8(v[4][cc] * W8_SCALE, v[5][cc] * W8_SCALE, v[6][cc] * W8_SCALE, v[7][cc] * W8_SCALE);
            w.z = pk4_fp8(v[8][cc] * W8_SCALE, v[9][cc] * W8_SCALE, v[10][cc] * W8_SCALE, v[11][cc] * W8_SCALE);
            w.w = pk4_fp8(v[12][cc] * W8_SCALE, v[13][cc] * W8_SCALE, v[14][cc] * W8_SCALE, v[15][cc] * W8_SCALE);
            *(u32x4*)(smem + (n0 + cc) * CV_PITCH + kg * 16) = w;
        }
        __syncthreads();
#pragma unroll
        for (int i = 0; i < 4; ++i) {
            const int piece = tid + i * NTHR, row = piece >> 3, ch = piece & 7;
            *(u32x4*)(dst + (long)row * K + kc * 128 + ch * 16) = *(const u32x4*)(smem + row * CV_PITCH + ch * 16);
        }
        __syncthreads();
    }
}

template <int PARTS = 7  , int NSAV = 7>
__device__ __forceinline__ void phase3(const Params& p, char* smem, int bid, int nb, int rep = 0) {
    XcdSlab xs; xs.init(bid, nb);
    const int nq = xs.x >= 0 ? 320 : 1024 + 1536;
    int* qctr = (int*)(p.ws + WS_CNT) + 16384 + ((xs.x >= 0 ? xs.x : 0) + 8 * rep) * 32;
    if (PARTS & 1) for (int u = bid; u < 64; u += nb) mlstm_scan(p, smem, u >> 2, u & 3);
    if (!(PARTS & 2)) return;
    volatile int* slot = (volatile int*)(smem + NSA_MISC + 256);
    for (;;) {
        if (opaque_tid() == 0) *slot = atomicAdd(qctr, 1);
        __syncthreads();
        const int k = __builtin_amdgcn_readfirstlane(*slot);
        if (k >= nq) break;
        if (xs.x >= 0) {
            const int r5 = k % 5, q5 = k / 5;
            if (r5 < 2) { const int kk = q5 * 2 + r5; const int bg = 4 * xs.x + (kk & 3); nsa_task<NSAV>(p, smem, bg >> 1, bg & 1, 31 - (kk >> 2)); }
            else if (PARTS & 4) { const int cv = q5 * 3 + (r5 - 2); const int e = xs.x + 8 * (cv / 6), t6 = cv % 6; wconv_task(p, smem, t6 < 2 ? 0 : 1, e, t6 < 2 ? t6 : t6 - 2); }
        } else if (k < 1024) nsa_task<NSAV>(p, smem, (k & 31) >> 1, k & 1, 31 - (k >> 5));
        else if (PARTS & 4) { const int cv = k - 1024; const int e = cv / 6, t6 = cv % 6; wconv_task(p, smem, t6 < 2 ? 0 : 1, e, t6 < 2 ? t6 : t6 - 2); }
    }
}

constexpr int XA_PITCH = 544;
constexpr int XA_K = 0, XA_V = 69632;
__device__ __forceinline__ void xattn_task(const Params& p, char* smem, int b, int h, int qb) {
    const char* ws = p.ws;
    int tid = threadIdx.x;
    asm volatile("" : "+v"(tid));
    const int lane = tid & 63, wid = __builtin_amdgcn_readfirstlane(tid >> 6), fr = lane & 15, fq = lane >> 4;
    const bf16_t* XQ = (const bf16_t*)(ws + WS_XQ) + (long)(b * SEQ + qb * 128 + wid * 16 + fr) * 1024 + h * 256 + fq * 8;
    const bf16_t* KV = (const bf16_t*)(ws + WS_KVX) + (long)b * 256 * 2048 + h * 256;
    bf16x8 qf[8];
#pragma unroll
    for (int ks = 0; ks < 8; ++ks) qf[ks] = *(const bf16x8*)(XQ + ks * 32);
    f32x4 O[16];
#pragma unroll
    for (int dt = 0; dt < 16; ++dt) O[dt] = (f32x4){0.f, 0.f, 0.f, 0.f};
    float m = -1e30f, l = 0.f;
    const int lrow = tid >> 5, lch = tid & 31;
    u32x4 rk[4], rv[4];
#pragma unroll
    for (int i2 = 0; i2 < 4; ++i2) {
        const bf16_t* rp = KV + (long)(lrow + 16 * i2) * 2048 + lch * 8;
        rk[i2] = *(const u32x4*)rp; rv[i2] = *(const u32x4*)(rp + 1024);
    }
#pragma unroll
    for (int i2 = 0; i2 < 4; ++i2) {
        *(u32x4*)(smem + XA_K + (lrow + 16 * i2) * XA_PITCH + lch * 16) = rk[i2];
        *(u32x4*)(smem + XA_V + (lrow + 16 * i2) * XA_PITCH + lch * 16) = rv[i2];
    }
    __syncthreads();
#pragma unroll 1
    for (int j = 0; j < 4; ++j) {
        const int buf = j & 1;
        if (j + 1 < 4) {
#pragma unroll
            for (int i2 = 0; i2 < 4; ++i2) {
                const bf16_t* rp = KV + (long)((j + 1) * 64 + lrow + 16 * i2) * 2048 + lch * 8;
                rk[i2] = *(const u32x4*)rp; rv[i2] = *(const u32x4*)(rp + 1024);
            }
        }
        const char* KT = smem + XA_K + buf * 34816;
        const char* VT = smem + XA_V + buf * 34816;
        f32x4 S[4];
#pragma unroll
        for (int nt = 0; nt < 4; ++nt) {
            f32x4 s = (f32x4){0.f, 0.f, 0.f, 0.f};
#pragma unroll
            for (int ks = 0; ks < 8; ++ks) {
                const bf16x8 kf = *(const bf16x8*)(KT + (16 * nt + fr) * XA_PITCH + (ks * 4 + fq) * 16);
                s = mfma16(kf, qf[ks], s);
            }
            S[nt] = s * 0.0625f;
        }
        float mx = -INFINITY;
#pragma unroll
        for (int nt = 0; nt < 4; ++nt)
#pragma unroll
            for (int e = 0; e < 4; ++e) mx = fmaxf(mx, S[nt][e]);
        mx = fq_max(mx);
        const float mnew = fmaxf(m, mx);
        const float alpha = __expf(m - mnew);
        float rs = 0.f;
#pragma unroll
        for (int nt = 0; nt < 4; ++nt)
#pragma unroll
            for (int e = 0; e < 4; ++e) { const float pv = __expf(S[nt][e] - mnew); S[nt][e] = pv; rs += pv; }
        rs = fq_sum(rs);
        l = l * alpha + rs; m = mnew;
#pragma unroll
        for (int dt = 0; dt < 16; ++dt) O[dt] = O[dt] * alpha;
        const bf16x8 pf0 = pack_p(S[0], S[1]), pf1 = pack_p(S[2], S[3]);
#pragma unroll
        for (int dt = 0; dt < 16; ++dt) {
            O[dt] = mfma16(tr_frag_perm(VT, XA_PITCH, 0, 16 * dt, fr, fq), pf0, O[dt]);
            O[dt] = mfma16(tr_frag_perm(VT, XA_PITCH, 32, 16 * dt, fr, fq), pf1, O[dt]);
        }
        if (j + 1 < 4) {
            char* KTn = smem + XA_K + (buf ^ 1) * 34816; char* VTn = smem + XA_V + (buf ^ 1) * 34816;
#pragma unroll
            for (int i2 = 0; i2 < 4; ++i2) {
                *(u32x4*)(KTn + (lrow + 16 * i2) * XA_PITCH + lch * 16) = rk[i2];
                *(u32x4*)(VTn + (lrow + 16 * i2) * XA_PITCH + lch * 16) = rv[i2];
            }
        }
        __syncthreads();
    }
    const float inv = 1.0f / l;
    bf16_t* op = (bf16_t*)(p.ws + WS_XO) + (long)(b * SEQ + qb * 128 + wid * 16 + fr) * 1024 + h * 256 + fq * 4;
#pragma unroll
    for (int dt = 0; dt < 16; ++dt) {
        u32x2 w; w.x = pk_bf16(O[dt][0] * inv, O[dt][1] * inv); w.y = pk_bf16(O[dt][2] * inv, O[dt][3] * inv);
        *(u32x2*)(op + dt * 16) = w;
    }
}

__device__ __forceinline__ void phase6(const Params& p, char* smem, int bid, int nb) {
    XcdSlab xs; xs.init(bid, nb);
    const int p_lo = xs.m_lo(64), n_t = (xs.m_hi(64) - p_lo) * 16;
    for (int u = xs.j; u < n_t; u += xs.stride) { const int pr = p_lo + (u >> 4); xattn_task(p, smem, pr >> 2, pr & 3, u & 15); }
}

constexpr int LN_ST = 139264, LN_GB = 141312, MOE_TAB = 153600;

template <class EPI>
__device__ __forceinline__ void dense_loop(char* smem, int bid, int nb, const bf16_t* A, int lda, const bf16_t* Bt, int nk, const EPI& epi) {
    XcdSlab xs; xs.init(bid, nb);
    const int m_lo = xs.m_lo(128), n_t = (xs.m_hi(128) - m_lo) * 4;
    int mt = 0, nt = 0;
    RingRows al, bl;
    auto setup = [&](int u) { mt = m_lo + (u >> 2); nt = u & 3; al.init_contig(A, lda, mt * 256); bl.init_contig(Bt, lda, nt * 256, true); };
    int u = xs.j;
    if (u < n_t) { setup(u); ring_issue3(smem, al, bl); }
    while (u < n_t) {
        const int cmt = mt, cnt_ = nt;
        f32x4 acc[8][4];
        gemm_ring<RingRows, RingRows, 0, true>(smem, al, bl, nk, acc);
        u += xs.stride;
        if (u < n_t) { setup(u); ring_issue3(smem, al, bl); }
        epi(acc, cmt, cnt_);
    }
    asm volatile("s_waitcnt vmcnt(0)" ::: "memory");
}

__device__ __forceinline__ void phase4(const Params& p, char* smem, int bid, int nb) {
    char* ws = p.ws;
    dense_loop(smem, bid, nb, (const bf16_t*)(ws + WS_MIX), 1024, (const bf16_t*)(ws + WS_WOUT), 32, [&](f32x4 (&acc)[8][4], int mt, int nt) {
        epi_residual<false>(acc, smem, p.in[I_X], nullptr, nullptr, nullptr, nullptr, (bf16_t*)(ws + WS_R1B), (float*)(ws + WS_ST1), mt * 256, nt);
    });
}

__device__ __forceinline__ void phase5(const Params& p, char* smem, int bid, int nb) {
    char* ws = p.ws;
    const float* lnf = (const float*)(ws + WS_LNF);
    dense_loop(smem, bid, nb, (const bf16_t*)(ws + WS_R1B), 1024, (const bf16_t*)(ws + WS_WQ), 32, [&](f32x4 (&acc)[8][4], int mt, int nt) {
        ln_correct<0>(acc, (const float*)(ws + WS_ST1), mt * 256, lnf, lnf + 1792, nt);
        epi_store_bf16(acc, (bf16_t*)(ws + WS_XQ), 1024, mt * 256, nt * 256);
    });
}

__device__ __forceinline__ void phase7(const Params& p, char* smem, int bid, int nb) {
    char* ws = p.ws;
    dense_loop(smem, bid, nb, (const bf16_t*)(ws + WS_XO), 1024, (const bf16_t*)(ws + WS_WO), 32, [&](f32x4 (&acc)[8][4], int mt, int nt) {
        epi_residual<true>(acc, smem, nullptr, (const bf16_t*)(ws + WS_R1B), (const float*)(ws + WS_ST1), p.in[I_LN1G], p.in[I_LN1B],
                           (bf16_t*)(ws + WS_R2B), (float*)(ws + WS_ST2), mt * 256, nt);
    });
}

template <class RowMap>
__device__ __forceinline__ void epi_swiglu(const f32x4 (&acc)[8][4], bf16_t* out, int ld, int nt, const RowMap& rm) {
    const int tid_ = opaque_tid();
    const int lane = tid_ & 63, wid = tid_ >> 6;
    const int wr = wid >> 2, wc = wid & 3, fr = lane & 15, fq = lane >> 4;
#pragma unroll
    for (int mi = 0; mi < 8; ++mi) {
        const long orow = rm(wr * 128 + mi * 16 + fr);
        if (orow >= 0) {
            const f32x4 a0 = acc[mi][0], b0 = acc[mi][1], a1 = acc[mi][2], b1 = acc[mi][3];
            u32x4 w;
            w.x = pk_bf16(siluf_(a0[0]) * b0[0], siluf_(a0[1]) * b0[1]); w.y = pk_bf16(siluf_(a0[2]) * b0[2], siluf_(a0[3]) * b0[3]);
            w.z = pk_bf16(siluf_(a1[0]) * b1[0], siluf_(a1[1]) * b1[1]); w.w = pk_bf16(siluf_(a1[2]) * b1[2], siluf_(a1[3]) * b1[3]);
            *(u32x4*)(out + orow * ld + nt * 128 + wc * 32 + fq * 8) = w;
        }
    }
}
struct RowIdent { long row0; __device__ __forceinline__ long operator()(int rl) const { return row0 + rl; } };

__device__ __forceinline__ unsigned dpp_xor1_u(unsigned v) { return (unsigned)__builtin_amdgcn_mov_dpp((int)v, 0xB1, 0xF, 0xF, true); }
__device__ __forceinline__ void route_tile(const Params& p, char* smem, int tok0, int rep) {
    char* ws = p.ws;
    const float* bias = p.in[I_ROUTB];
    const int tid = opaque_tid(), tk = tid >> 1, hf = tid & 1;
    const float* row = (const float*)(ws + WS_RSC) + (long)(tok0 + tk) * 256;
    unsigned key[128];
    float gs[4];
    {
        float v[128];
#pragma unroll
        for (int i = 0; i < 32; ++i) { const f32x4 t = *(const f32x4*)(row + hf * 128 + i * 4); v[4 * i] = t[0]; v[4 * i + 1] = t[1]; v[4 * i + 2] = t[2]; v[4 * i + 3] = t[3]; }
#pragma unroll
        for (int gi = 0; gi < 4; ++gi) {
            float m1 = -INFINITY, m2 = -INFINITY;
#pragma unroll
            for (int i = 0; i < 32; ++i) { const float x = v[32 * gi + i]; m2 = __builtin_fmaxf(m2, __builtin_fminf(m1, x)); m1 = __builtin_fmaxf(m1, x); }
            gs[gi] = m1 + m2;
        }
        float g8[8];
#pragma unroll
        for (int gi = 0; gi < 4; ++gi) { const float o = dpp_xor1(gs[gi]); g8[gi] = hf ? o : gs[gi]; g8[4 + gi] = hf ? gs[gi] : o; }
        unsigned gsel = 0u;
#pragma unroll
        for (int a = 0; a < 8; ++a) {
            int rank = 0;
#pragma unroll
            for (int b = 0; b < 8; ++b) rank += (g8[b] > g8[a] || (g8[b] == g8[a] && b < a)) ? 1 : 0;
            if (rank < 4) gsel |= 1u << a;
        }
#pragma unroll
        for (int gi = 0; gi < 4; ++gi) {
            const bool on = ((gsel >> (4 * hf + gi)) & 1u) != 0u;
#pragma unroll
            for (int i = 0; i < 32; ++i) {
                const unsigned kb = (__float_as_uint(v[32 * gi + i] + 1.0f) & ~0xFFu) | (unsigned)(255 - (128 * hf + 32 * gi + i));
                key[32 * gi + i] = on ? kb : 0u;
            }
        }
    }
    unsigned win[8];
    unsigned prev = 0xFFFFFFFFu;
#pragma unroll
    for (int r = 0; r < 8; ++r) {
        unsigned m = 0u;
#pragma unroll
        for (int i = 0; i < 128; ++i) { const unsigned kk = key[i]; const unsigned c = kk < prev ? kk : 0u; m = m > c ? m : c; }
        const unsigned o = dpp_xor1_u(m);
        m = m > o ? m : o;
        prev = m;
        win[r] = m;
    }
    float sc8[8]; float wsum = 0.f;
#pragma unroll
    for (int r = 0; r < 8; ++r) { const int e = 255 - (int)(win[r] & 255u); sc8[r] = row[e] - bias[e]; wsum += sc8[r]; }
    int* lc = (int*)(smem + MOE_TAB); int* gbase = lc + 256;
    if (tid < 256) lc[tid] = 0;
    __syncthreads();
    int mye[4], myr[4];
    const unsigned hmask = 0u - (unsigned)hf;
#pragma unroll
    for (int u = 0; u < 4; ++u) {
        const unsigned w = win[u] ^ ((win[u] ^ win[4 + u]) & hmask);
        mye[u] = 255 - (int)(w & 255u); myr[u] = atomicAdd(lc + mye[u], 1);
    }
    __syncthreads();
    if (tid < 256) { const int n = lc[tid]; if (n > 0) gbase[tid] = atomicAdd((int*)(ws + WS_CNT) + 8192 * rep + tid * 32, n); }
    __syncthreads();
    {
        const long t = tok0 + tk;
        const float wn = 2.5f / wsum;
#pragma unroll
        for (int u = 0; u < 4; ++u) {
            const int k = 4 * hf + u;
            const int e = mye[u];
            const unsigned s0 = __float_as_uint(sc8[u]), s1 = __float_as_uint(sc8[4 + u]);
            const float w = __uint_as_float(s0 ^ ((s0 ^ s1) & hmask)) * wn;
            const int pos = gbase[e] + myr[u];
            ((int*)(ws + WS_SELE))[t * 8 + k] = e;
            ((int*)(ws + WS_SELP))[t * 8 + k] = pos;
            ((float*)(ws + WS_SELW))[t * 8 + k] = w;
            ((int*)(ws + WS_TOKL))[(long)e * LIST_CAP + pos] = (int)t;
            ((float*)(ws + WS_WL))[(long)e * LIST_CAP + pos] = w;
        }
    }
    __syncthreads();
}

__device__ __forceinline__ void phase8(const Params& p, char* smem, int bid, int nb, int rep = 0) {
    char* ws = p.ws;
    const float* lnf = (const float*)(ws + WS_LNF);
    XcdSlab xs; xs.init(bid, nb);
    const int m_lo = xs.m_lo(128), m_n = xs.m_hi(128) - m_lo;
    for (int u = xs.j; u < m_n; u += xs.stride) {
        const int mt = m_lo + u;
        float* gsc = (float*)(ws + WS_RSC);
        {
            RingRows al, bl;
            al.init_contig((const bf16_t*)(ws + WS_R2B), 1024, mt * 256);
            bl.init_contig((const bf16_t*)(ws + WS_WR), 1024, 0, true);
            f32x4 acc[8][4];
            gemm_ring(smem, al, bl, 32, acc);
            ln_correct<0>(acc, (const float*)(ws + WS_ST2), mt * 256, lnf + 1024, lnf + 1792 + 1024, 0);
            const int tid_ = opaque_tid();
            const int lane = tid_ & 63, wid = tid_ >> 6;
            const int wr = wid >> 2, wc = wid & 3, fr = lane & 15, fq = lane >> 4;
            const float* bias = p.in[I_ROUTB];
#pragma unroll
            for (int ni = 0; ni < 4; ++ni) {
                const int col = wc * 64 + (ni >> 1) * 32 + fq * 8 + (ni & 1) * 4;
                const f32x4 bv = *(const f32x4*)(bias + col);
#pragma unroll
                for (int mi = 0; mi < 8; ++mi) {
                    f32x4 v;
#pragma unroll
                    for (int e = 0; e < 4; ++e) v[e] = sigmoidf_(acc[mi][ni][e]) + bv[e];
                    *(f32x4*)(gsc + (long)(mt * 256 + wr * 128 + mi * 16 + fr) * 256 + col) = v;
                }
            }
        }
        __syncthreads();
        route_tile(p, smem, mt * 256, rep);
    }
    for (int u = (xs.j + xs.stride - m_n % xs.stride) % xs.stride; u < m_n * 2; u += xs.stride) {
        const int mt = m_lo + (u >> 1), nt = u & 1;
        RingRows al, bl;
        al.init_contig((const bf16_t*)(ws + WS_R2B), 1024, mt * 256);
        bl.init_contig((const bf16_t*)(ws + WS_WS13), 1024, nt * 256);
        f32x4 acc[8][4];
        gemm_ring(smem, al, bl, 32, acc);
        ln_correct<1>(acc, (const float*)(ws + WS_ST2), mt * 256, lnf + 1280, lnf + 1792 + 1280, nt);
        RowIdent rm; rm.row0 = (long)mt * 256;
        epi_swiglu(acc, (bf16_t*)(ws + WS_HS), 256, nt, rm);
    }
    {
        const int tid = opaque_tid(), lane = tid & 63, wid = tid >> 6;
        const bf16_t* r2 = (const bf16_t*)(ws + WS_R2B); const float* st2 = (const float*)(ws + WS_ST2);
        unsigned char* x2 = (unsigned char*)(ws + WS_X2F8);
        for (int t = bid * 8 + wid; t < T_TOK; t += nb * 8) {
            const f32x4 p0 = *(const f32x4*)(st2 + (long)t * 8), p1 = *(const f32x4*)(st2 + (long)t * 8 + 4);
            const float q1 = (p0[0] + p0[2]) + (p1[0] + p1[2]), q2 = (p0[1] + p0[3]) + (p1[1] + p1[3]);
            const float mean = q1 * (1.0f / 1024.0f);
            const float rstd = rsqrtf(fmaxf(q2 * (1.0f / 1024.0f) - mean * mean, 0.f) + LN_EPS);
#pragma unroll
            for (int hseg = 0; hseg < 2; ++hseg) {
                const int col = hseg * 512 + lane * 8;
                const u32x4 ru = *(const u32x4*)(r2 + (long)t * 1024 + col);
                const f32x4 a0 = (f32x4){bf_lo(ru.x), bf_hi(ru.x), bf_lo(ru.y), bf_hi(ru.y)}, a1 = (f32x4){bf_lo(ru.z), bf_hi(ru.z), bf_lo(ru.w), bf_hi(ru.w)};
                const f32x4 g0 = *(const f32x4*)(p.in[I_LN2G] + col), g1 = *(const f32x4*)(p.in[I_LN2G] + col + 4);
                const f32x4 b0 = *(const f32x4*)(p.in[I_LN2B] + col), b1 = *(const f32x4*)(p.in[I_LN2B] + col + 4);
                const f32x4 y0 = (a0 - mean) * rstd * g0 + b0, y1 = (a1 - mean) * rstd * g1 + b1;
                u32x2 w; w.x = pk4_fp8(y0[0], y0[1], y0[2], y0[3]); w.y = pk4_fp8(y1[0], y1[1], y1[2], y1[3]);
                *(u32x2*)(x2 + (long)t * 1024 + col) = w;
            }
        }
    }
}

template <int XMODE>
__device__ __forceinline__ void phase_probe(const Params& p, char* smem, int bid, int nb) {
    char* ws = p.ws;
    XcdSlab xs; xs.init(bid, nb);
    const int m_lo = xs.m_lo(128), n_t = (xs.m_hi(128) - m_lo) * 4;
    for (int u = xs.j; u < n_t; u += xs.stride) {
        const int mt = m_lo + (u >> 2), nt = u & 3;
        RingRows al, bl;
        al.init_contig((const bf16_t*)(ws + WS_MIX), 1024, mt * 256);
        bl.init_contig((const bf16_t*)(ws + WS_WOUT), 1024, nt * 256, true);
        f32x4 acc[8][4];
        gemm_ring<RingRows, RingRows, XMODE>(smem, al, bl, 32, acc);
        epi_store_bf16(acc, (bf16_t*)(ws + WS_A + 432 * MB), 1024, mt * 256, nt * 256);
    }
}

__device__ __forceinline__ void moe_tables(const Params& p, char* smem, const XcdSlab& xs) {
    int* off = (int*)(smem + MOE_TAB); int* tst = off + 256; int* cntl = tst + 260;
    const int* cnt = (const int*)(p.ws + WS_CNT);
    const int tid = opaque_tid();
    if (tid >= 256) cntl[tid - 256] = cnt[(tid - 256) * 32];
    if (tid < 64) {
        int c[4], cs = 0;
#pragma unroll
        for (int k = 0; k < 4; ++k) { c[k] = cnt[(tid * 4 + k) * 32]; cs += c[k]; }
        int ics = cs;
#pragma unroll
        for (int o = 1; o < 64; o <<= 1) { const int a = __shfl_up(ics, o); if (tid >= o) ics += a; }
        int eo = ics - cs;
#pragma unroll
        for (int k = 0; k < 4; ++k) { off[tid * 4 + k] = eo; eo += c[k]; }
    } else if (tid < 128) {
        const int l = tid - 64;
        if (xs.x >= 0) {
            const int tl = l < 32 ? ((cnt[(xs.x + 8 * l) * 32] + 255) >> 8) : 0;
            int it = tl;
#pragma unroll
            for (int o = 1; o < 64; o <<= 1) { const int a = __shfl_up(it, o); if (l >= o) it += a; }
            if (l < 32) tst[l] = it - tl;
            if (l == 31) tst[32] = it;
        } else {
            int c[4], ts = 0;
#pragma unroll
            for (int k = 0; k < 4; ++k) { c[k] = (cnt[(l * 4 + k) * 32] + 255) >> 8; ts += c[k]; }
            int its = ts;
#pragma unroll
            for (int o = 1; o < 64; o <<= 1) { const int a = __shfl_up(its, o); if (l >= o) its += a; }
            int et = its - ts;
#pragma unroll
            for (int k = 0; k < 4; ++k) { tst[l * 4 + k] = et; et += c[k]; }
            if (l == 63) tst[256] = its;
        }
    }
    __syncthreads();
}
__device__ __forceinline__ int moe_find(const int* tst, int nloc, int t) {
    int lo = 0, hi = nloc - 1;
#pragma unroll 1
    while (lo < hi) { const int mid = (lo + hi + 1) >> 1; if (tst[mid] <= t) lo = mid; else hi = mid - 1; }
    return lo;
}
struct RowMoe { long base; int nvalid; __device__ __forceinline__ long operator()(int rl) const { return rl < nvalid ? base + rl : -1; } };

template <int PARTS9 = 3>
__device__ __forceinline__ void phase9(const Params& p, char* smem, int bid, int nb) {
    char* ws = p.ws;
    XcdSlab xs; xs.init(bid, nb);
    moe_tables(p, smem, xs);
    const int* off = (const int*)(smem + MOE_TAB); const int* tst = off + 256;
    const int* cnt = (const int*)(ws + WS_CNT);
    const int nloc = xs.x >= 0 ? 32 : 256;
    const int ntile = tst[nloc];
    {
        const int* cntl = tst + 260;
        const int nT = ntile * 2;
        int t = xs.j;
        int e = 0, m0 = 0, ne = 0, nt = 0;
        RingF8 al, bl;
        auto setup = [&](int tt) {
            const int et = tt >> 1; nt = tt & 1;
            const int kl = moe_find(tst, nloc, et); e = xs.x >= 0 ? xs.x + 8 * kl : kl; m0 = (et - tst[kl]) * 256; ne = cntl[e];
            const int tid = opaque_tid();
            const int* tl = (const int*)(ws + WS_TOKL) + (long)e * LIST_CAP;
            int rows[2];
#pragma unroll
            for (int i = 0; i < 2; ++i) { const int r = m0 + (tid >> 2) + 128 * i; rows[i] = r < ne ? tl[r] : 0; }
            al.init_rows((const unsigned char*)(ws + WS_X2F8), 1024, rows);
            bl.init_contig((const unsigned char*)p.out, 1024, (long)(e * 2 + nt) * 256);
        };
        if (!(PARTS9 & 1)) t = nT;
        if (t < nT) { setup(t); ring_f8_issue3(smem, al, bl); }
        while (t < nT) {
            const int ce = e, cm0 = m0, cne = ne, cnt_ = nt;
            f32x16 acc[4][2];
            gemm_ring_mx_main(smem, al, bl, 16, acc);
            t += xs.stride;
            if (t < nT) { setup(t); ring_f8_issue3(smem, al, bl); }
            {
                const int tid2 = opaque_tid();
                const int lane = tid2 & 63, wid = tid2 >> 6;
                const int wr = wid >> 2, wc = wid & 3, r = lane & 31, h = lane >> 5;
                unsigned char* H = (unsigned char*)(ws + WS_HF8) + ((long)off[ce] + cm0) * 256 + cnt_ * 128 + wc * 32 + h * 16;
                constexpr float D = 1.0f / W8_SCALE, HS = H8_SCALE / W8_SCALE;
#pragma unroll
                for (int mi = 0; mi < 4; ++mi) {
                    const int rl = wr * 128 + mi * 32 + r;
                    if (cm0 + rl < cne) {
                        float o[16];
#pragma unroll
                        for (int q = 0; q < 16; ++q) o[q] = siluf_(acc[mi][0][q] * D) * (acc[mi][1][q] * HS);
                        u32x4 w; w.x = pk4_fp8(o[0], o[1], o[2], o[3]); w.y = pk4_fp8(o[4], o[5], o[6], o[7]); w.z = pk4_fp8(o[8], o[9], o[10], o[11]); w.w = pk4_fp8(o[12], o[13], o[14], o[15]);
                        *(u32x4*)(H + (long)rl * 256) = w;
                    }
                }
            }
        }
        asm volatile("s_waitcnt vmcnt(0)" ::: "memory"); __syncthreads();
    }
    const int m_lo = xs.m_lo(128), n_t = (PARTS9 & 2) ? (xs.m_hi(128) - m_lo) * 4 : 0;
    for (int u = (xs.j + xs.stride - (ntile * 2) % xs.stride) % xs.stride; u < n_t; u += xs.stride) {
        const int mt = m_lo + (u >> 2), nt = u & 3;
        RingRows al, bl;
        al.init_contig((const bf16_t*)(ws + WS_HS), 256, mt * 256);
        bl.init_contig((const bf16_t*)(ws + WS_WS2), 256, nt * 256, true);
        f32x4 acc[8][4];
        gemm_ring(smem, al, bl, 8, acc);
        __syncthreads();
        epi_store_bf16(acc, (bf16_t*)(ws + WS_SH), 1024, mt * 256, nt * 256);
    }
}

template <int P10V = 0  >
__device__ __forceinline__ void phase10(const Params& p, char* smem, int bid, int nb) {
    char* ws = p.ws;
    XcdSlab xs; xs.init(bid, nb);
    moe_tables(p, smem, xs);
    const int* off = (const int*)(smem + MOE_TAB); const int* tst = off + 256;
    const int* cnt = (const int*)(ws + WS_CNT);
    const int nloc = xs.x >= 0 ? 32 : 256;
    const int ntile = tst[nloc];
    {
        const int* cntl = tst + 260;
        const int nT = ntile;
        const int tid_ = opaque_tid();
        const int lane = tid_ & 63, wid = __builtin_amdgcn_readfirstlane(tid_ >> 6);
        const int wr = wid >> 2, wc = wid & 3, r = lane & 31, h = lane >> 5;
        const int g = (r >> 2) & 3;
        const int c0 = ((2 * h) ^ g) << 4, c1 = ((2 * h + 1) ^ g) << 4;
        const int arow = (wr * 128 + r) * 64;
        const int brow = (wc * 64 + r) * 64;
        char* ringB = smem + 65536;
        for (int t = xs.j; t < nT; t += xs.stride) {
            const int kl = moe_find(tst, nloc, t), e = xs.x >= 0 ? xs.x + 8 * kl : kl, m0 = (t - tst[kl]) * 256, ne = cntl[e];
            RingF8 al, bl;
            al.init_contig((const unsigned char*)(ws + WS_HF8), 256, (long)off[e] + m0);
            bl.init_contig((const unsigned char*)(ws + WS_W2F8), 256, (long)(e * 4) * 256);
            const float* wl = (const float*)(ws + WS_WL) + (long)e * LIST_CAP + m0;
            unsigned char* Yb = (unsigned char*)(ws + WS_Y) + ((long)off[e] + m0) * 1024 + wc * 64 + h * 16;
#pragma unroll
            for (int ks = 0; ks < 4; ++ks) al.issue(smem + ks * 16384, ks);
            auto issueB = [&](int bt, int stg) {
                const int nt_ = bt >> 2, ks_ = bt & 3;
                char* s = ringB + stg * 16384;
#pragma unroll
                for (int i = 0; i < 2; ++i)
                    __builtin_amdgcn_global_load_lds((glb_u32*)(bl.base + (size_t)(bl.off[i] + (unsigned)(nt_ * 65536 + ks_ * 64))), (lds_u32*)(s + i * 8192 + bl.ldst), 16, 0, 0);
            };
            issueB(0, 0); issueB(1, 1); issueB(2, 2); issueB(3, 3);
            RING_WAIT(6);
            RING_BAR();
            if (wr == 1) RING_BAR();
            f32x16 acc[4][2];
#pragma unroll
            for (int mi = 0; mi < 4; ++mi)
#pragma unroll
                for (int nj = 0; nj < 2; ++nj)
#pragma unroll
                    for (int q = 0; q < 16; ++q) acc[mi][nj][q] = 0.f;
            int sg = 0;
#pragma unroll 1
            for (int bt = 0; bt < 16; ++bt) {
                const char* sa = smem + (bt & 3) * 16384;
                const char* sb = ringB + sg * 16384;
                { const int s4 = sg == 0 ? 4 : sg - 1; if (bt + 4 < 16) issueB(bt + 4, s4); }
                i32x8 bf[2], af[4];
#pragma unroll
                for (int nj = 0; nj < 2; ++nj) bf[nj] = mx_frag(sb + brow + nj * 2048, c0, c1);
#pragma unroll
                for (int mi = 0; mi < 4; ++mi) af[mi] = mx_frag(sa + arow + mi * 2048, c0, c1);
                if (bt + 1 < 16) { if (bt + 4 < 16) RING_WAIT(6); else if (bt + 3 < 16) RING_WAIT(4); else if (bt + 2 < 16) RING_WAIT(2); else RING_WAIT(0); }
                RING_BAR();
                __builtin_amdgcn_s_setprio(1);
                if (P10V != 2) {
#pragma unroll
                for (int mi = 0; mi < 4; ++mi)
#pragma unroll
                    for (int nj = 0; nj < 2; ++nj) acc[mi][nj] = mfma_mx(bf[nj], af[mi], acc[mi][nj]);
                } else { acc[0][0][0] += (float)(af[0][0] + bf[0][0] + af[3][7] + bf[1][3]); }
                __builtin_amdgcn_s_setprio(0);
                if ((bt & 3) == 3) {
                    const int nt_ = bt >> 2;
#pragma unroll
                    for (int mi = 0; mi < 4; ++mi) {
                        const int rl = wr * 128 + mi * 32 + r;
                        if (m0 + rl < ne) {
                            const float w = wl[rl] * (Y8_SCALE / (W8_SCALE * H8_SCALE));
#pragma unroll
                            for (int nj = 0; nj < 2; ++nj) {
                                const f32x16 u = acc[mi][nj] * w;
                                u32x4 v; v.x = pk4_fp8(u[0], u[1], u[2], u[3]); v.y = pk4_fp8(u[4], u[5], u[6], u[7]); v.z = pk4_fp8(u[8], u[9], u[10], u[11]); v.w = pk4_fp8(u[12], u[13], u[14], u[15]);
                                if (P10V != 1) *(u32x4*)(Yb + (long)rl * 1024 + nt_ * 256 + nj * 32) = v; else if (v.x == 0x12345678u) *(u32x4*)(Yb) = v;
                            }
                        }
#pragma unroll
                        for (int nj = 0; nj < 2; ++nj)
#pragma unroll
                            for (int q = 0; q < 16; ++q) acc[mi][nj][q] = 0.f;
                    }
                }
                RING_BAR();
                sg = sg == 4 ? 0 : sg + 1;
            }
            if (wr == 0) RING_BAR();
        }
    }
}

__device__ __forceinline__ void phase11(const Params& p, char* smem, int bid, int nb) {
    char* ws = p.ws;
    XcdSlab xs; xs.init(bid, nb);
    moe_tables(p, smem, xs);
    const int* off = (const int*)(smem + MOE_TAB);
    const int tid = opaque_tid(), lane = tid & 63, wid = tid >> 6;
    const bf16_t* r2 = (const bf16_t*)(ws + WS_R2B);
    const float* st2 = (const float*)(ws + WS_ST2);
    const bf16_t* SH = (const bf16_t*)(ws + WS_SH);
    const unsigned char* Y = (const unsigned char*)(ws + WS_Y);
    const int* sele = (const int*)(ws + WS_SELE); const int* selp = (const int*)(ws + WS_SELP);
    for (int t = bid * 8 + wid; t < T_TOK; t += nb * 8) {
        const f32x4 p0 = *(const f32x4*)(st2 + (long)t * 8), p1 = *(const f32x4*)(st2 + (long)t * 8 + 4);
        const float q1 = (p0[0] + p0[2]) + (p1[0] + p1[2]), q2 = (p0[1] + p0[3]) + (p1[1] + p1[3]);
        const float mean2 = q1 * (1.0f / 1024.0f);
        const float rstd2 = rsqrtf(fmaxf(q2 * (1.0f / 1024.0f) - mean2 * mean2, 0.f) + LN_EPS);
        int yrow[8];
#pragma unroll
        for (int k = 0; k < 8; ++k) yrow[k] = off[sele[(long)t * 8 + k]] + selp[(long)t * 8 + k];
        float v[16];
#pragma unroll
        for (int hseg = 0; hseg < 2; ++hseg) {
            const int col = hseg * 512 + lane * 8;
            const u32x4 ru = *(const u32x4*)(r2 + (long)t * 1024 + col);
            const f32x4 a0 = (f32x4){bf_lo(ru.x), bf_hi(ru.x), bf_lo(ru.y), bf_hi(ru.y)}, a1 = (f32x4){bf_lo(ru.z), bf_hi(ru.z), bf_lo(ru.w), bf_hi(ru.w)};
            const f32x4 g0 = *(const f32x4*)(p.in[I_LN2G] + col), g1 = *(const f32x4*)(p.in[I_LN2G] + col + 4);
            const f32x4 b0 = *(const f32x4*)(p.in[I_LN2B] + col), b1 = *(const f32x4*)(p.in[I_LN2B] + col + 4);
            const f32x4 x0 = ((a0 - mean2) * rstd2 * g0 + b0) * ALPHA, x1 = ((a1 - mean2) * rstd2 * g1 + b1) * ALPHA;
            float* vv = v + hseg * 8;
            vv[0] = x0[0]; vv[1] = x0[1]; vv[2] = x0[2]; vv[3] = x0[3]; vv[4] = x1[0]; vv[5] = x1[1]; vv[6] = x1[2]; vv[7] = x1[3];
            const u32x4 s = *(const u32x4*)(SH + (long)t * 1024 + col);
            vv[0] += bf_lo(s.x); vv[1] += bf_hi(s.x); vv[2] += bf_lo(s.y); vv[3] += bf_hi(s.y); vv[4] += bf_lo(s.z); vv[5] += bf_hi(s.z); vv[6] += bf_lo(s.w); vv[7] += bf_hi(s.w);
            f32x2 ys[4];
#pragma unroll
            for (int e2 = 0; e2 < 4; ++e2) ys[e2] = (f32x2){0.f, 0.f};
#pragma unroll
            for (int k = 0; k < 8; ++k) {
                const u32x2 y = *(const u32x2*)(Y + (long)yrow[k] * 1024 + col);
                ys[0] += __builtin_amdgcn_cvt_pk_f32_fp8((int)y.x, false); ys[1] += __builtin_amdgcn_cvt_pk_f32_fp8((int)y.x, true);
                ys[2] += __builtin_amdgcn_cvt_pk_f32_fp8((int)y.y, false); ys[3] += __builtin_amdgcn_cvt_pk_f32_fp8((int)y.y, true);
            }
#pragma unroll
            for (int e2 = 0; e2 < 4; ++e2) { vv[2 * e2] += ys[e2][0] * (1.0f / Y8_SCALE); vv[2 * e2 + 1] += ys[e2][1] * (1.0f / Y8_SCALE); }
        }
        float s1 = 0.f;
#pragma unroll
        for (int i = 0; i < 16; ++i) s1 += v[i];
#pragma unroll
        for (int o = 32; o >= 1; o >>= 1) s1 += __shfl_xor(s1, o);
        const float mean = s1 * (1.0f / 1024.0f);
        float s2 = 0.f;
#pragma unroll
        for (int i = 0; i < 16; ++i) { const float d = v[i] - mean; s2 += d * d; }
#pragma unroll
        for (int o = 32; o >= 1; o >>= 1) s2 += __shfl_xor(s2, o);
        const float rstd = rsqrtf(s2 * (1.0f / 1024.0f) + LN_EPS);
#pragma unroll
        for (int hseg = 0; hseg < 2; ++hseg) {
            const int col = hseg * 512 + lane * 8;
            const f32x4 g0 = *(const f32x4*)(p.in[I_LN3G] + col), g1 = *(const f32x4*)(p.in[I_LN3G] + col + 4);
            const f32x4 b0 = *(const f32x4*)(p.in[I_LN3B] + col), b1 = *(const f32x4*)(p.in[I_LN3B] + col + 4);
            const float* vv = v + hseg * 8;
            f32x4 o0, o1;
#pragma unroll
            for (int e = 0; e < 4; ++e) { o0[e] = (vv[e] - mean) * rstd * g0[e] + b0[e]; o1[e] = (vv[4 + e] - mean) * rstd * g1[e] + b1[e]; }
            *(f32x4*)(p.out + (long)t * 1024 + col) = o0; *(f32x4*)(p.out + (long)t * 1024 + col + 4) = o1;
        }
    }
}

#if MEGA
#define XB_TMO      128
#define XB_XCNT(j)  (256  + 64 * (j))
#define XB_XSUB(j)  (1280 + 64 * (j))
#define XB_XGEN(j)  (2304 + 64 * (j))
#define XB_TOP      3328
#define XB_TOPGEN   3392
#define XCD_BAR_WORDS 3456
#define XB_SPIN_CAP (1u << 22)
#define LAS __attribute__((address_space(3)))
__device__ __forceinline__ unsigned xb_ld(unsigned* p)              { return __hip_atomic_load(p, __ATOMIC_RELAXED, __HIP_MEMORY_SCOPE_AGENT); }
__device__ __forceinline__ unsigned xb_add(unsigned* p, unsigned v) { return __hip_atomic_fetch_add(p, v, __ATOMIC_RELAXED, __HIP_MEMORY_SCOPE_AGENT); }
__device__ __forceinline__ unsigned xb_xcc_id() { return (unsigned)__builtin_amdgcn_s_getreg((3 << 11) | 20) & 0xFu; }
#define XB_SPIN(cond, bar) do { unsigned _sp = 0; while (cond) { __builtin_amdgcn_s_sleep(1); \
    if ((++_sp & 255u) == 0u) { if (xb_ld(&(bar)[XB_TMO])) break; if (_sp > XB_SPIN_CAP) { atomicAdd(&(bar)[XB_TMO], 1u); break; } } } } while (0)
struct XcdBarrier { unsigned* bar; unsigned x; volatile LAS unsigned* st; };
__device__ __forceinline__ XcdBarrier xcd_barrier_post(unsigned* bar, volatile LAS unsigned* st) {
    XcdBarrier b; b.bar = bar; b.x = xb_xcc_id(); b.st = st;
    if (threadIdx.x == 0) (void)xb_add(&bar[XB_XCNT(b.x)], 1u);
    return b;
}
__device__ __forceinline__ void xcd_barrier_complete(unsigned* bar, unsigned x, unsigned& nloc, unsigned& nx) {
    const unsigned G = gridDim.x * gridDim.y * gridDim.z;
    unsigned sum, cnt, mine, sp = 0u;
    for (;;) {
        sum = 0u; cnt = 0u; mine = 0u;
#pragma unroll
        for (unsigned j = 0; j < 16; ++j) { const unsigned c = xb_ld(&bar[XB_XCNT(j)]); sum += c; cnt += (c > 0u) ? 1u : 0u; mine = (j == x) ? c : mine; }
        if (sum == G) break;
        __builtin_amdgcn_s_sleep(1);
        if ((++sp & 255u) == 0u) { if (xb_ld(&bar[XB_TMO])) break; if (sp > XB_SPIN_CAP) { atomicAdd(&bar[XB_TMO], 1u); break; } }
    }
    nloc = mine > 0u ? mine : 1u; nx = cnt > 0u ? cnt : 1u;
}
__device__ __forceinline__ void xcd_barrier(const XcdBarrier& b) {
    asm volatile("s_waitcnt vmcnt(0)" ::: "memory");
    __syncthreads();
    if (threadIdx.x == 0) {
        unsigned* bar = b.bar;
        __builtin_amdgcn_s_waitcnt(0);
        unsigned nloc = b.st[0], nx = b.st[1];
        if (nloc == 0u) { xcd_barrier_complete(bar, b.x, nloc, nx); b.st[0] = nloc; b.st[1] = nx; }
        const unsigned old = xb_add(&bar[XB_XSUB(b.x)], 1u);
        const unsigned gen = old / nloc;
        if (old + 1u == (gen + 1u) * nloc) {
            __builtin_amdgcn_fence(__ATOMIC_RELEASE, "agent");
            asm volatile("s_waitcnt vmcnt(0)" ::: "memory");
            const unsigned og = xb_add(&bar[XB_TOP], 1u);
            const unsigned tg = og / nx;
            if (og + 1u == (tg + 1u) * nx) xb_add(&bar[XB_TOPGEN], 1u);
            else XB_SPIN(xb_ld(&bar[XB_TOPGEN]) == tg, bar);
            __builtin_amdgcn_fence(__ATOMIC_ACQUIRE, "agent");
            xb_add(&bar[XB_XGEN(b.x)], 1u);
            asm volatile("s_waitcnt vmcnt(0)" ::: "memory");
        } else {
            XB_SPIN(xb_ld(&bar[XB_XGEN(b.x)]) == gen, bar);
            __builtin_amdgcn_fence(__ATOMIC_ACQUIRE, "agent");
            asm volatile("s_waitcnt vmcnt(0)" ::: "memory");
        }
    }
    __syncthreads();
}
__global__ void __launch_bounds__(NTHR) fwd_mega(Params p) {
    extern __shared__ __attribute__((aligned(16))) char smem[];
    cg::grid_group grid = cg::this_grid();
    const int bid = blockIdx.x, nb = gridDim.x;
    volatile LAS unsigned* xst = (volatile LAS unsigned*)(smem + LDS_BYTES - 16);
    if (threadIdx.x < 4) xst[threadIdx.x] = 0u;
    __syncthreads();
    const XcdBarrier xb = xcd_barrier_post((unsigned*)(p.ws + WS_BAR), xst);
#define GSYNC() xcd_barrier(xb)
#ifndef PROBE_REPEAT
#define PROBE_REPEAT 0
#endif
#define REP(n, call) if (PROBE_REPEAT & (1 << n)) { call; GSYNC(); }
    if (PROBE_REPEAT & 1) { phase0(p, smem, bid, nb); GSYNC(); }
#ifdef PROBE_XCC
    {
        unsigned* rec = (unsigned*)(p.ws + WS_A + 432 * MB);
        if (threadIdx.x == 0) rec[bid] = xb_xcc_id();
        grid.sync();
        int mism = 0, distinct = 0;
        for (int b = 0; b < nb; ++b) { if (rec[b] != rec[b & 7]) ++mism; }
        for (int a = 0; a < 8; ++a) { bool dup = false; for (int b2 = 0; b2 < a; ++b2) dup = dup || (rec[a] == rec[b2]); if (!dup) ++distinct; }
        const float v = sqrtf((float)(PROBE_XCC == 1 ? mism : distinct) + 1.0f);
        for (long i = (long)bid * NTHR + threadIdx.x; i < (long)T_TOK * 1024; i += (long)nb * NTHR) p.out[i] = v;
        return;
    }
#endif
    phase0(p, smem, bid, nb);  grid.sync();
    REP(1, phase1<1>(p, smem, bid, nb))
    phase1(p, smem, bid, nb);  GSYNC();
    REP(2, phase2(p, smem, bid, nb))
    phase2(p, smem, bid, nb);  GSYNC();
#ifndef PROBE_P3PARTS
#define PROBE_P3PARTS 7
#endif
#ifndef PROBE_NSAV
#define PROBE_NSAV 7
#endif
    REP(3, (phase3<PROBE_P3PARTS, PROBE_NSAV>(p, smem, bid, nb, 1)))
    phase3(p, smem, bid, nb);  GSYNC();
    REP(4, phase4(p, smem, bid, nb))
#ifdef PROBE_X
    phase_probe<PROBE_X>(p, smem, bid, nb); GSYNC();
#endif
    phase4(p, smem, bid, nb);  GSYNC();
    REP(5, phase5(p, smem, bid, nb))
    phase5(p, smem, bid, nb);  GSYNC();
    REP(6, phase6(p, smem, bid, nb))
    phase6(p, smem, bid, nb);  GSYNC();
    REP(7, phase7(p, smem, bid, nb))
    phase7(p, smem, bid, nb);  GSYNC();
    REP(8, phase8(p, smem, bid, nb, 1))
    phase8(p, smem, bid, nb);  GSYNC();
#ifndef PROBE_P9PARTS
#define PROBE_P9PARTS 3
#endif
    REP(9, phase9<PROBE_P9PARTS>(p, smem, bid, nb))
    phase9(p, smem, bid, nb);  GSYNC();
#ifndef PROBE_P10V
#define PROBE_P10V 0
#endif
    REP(10, phase10<PROBE_P10V>(p, smem, bid, nb))
    phase10(p, smem, bid, nb); GSYNC();
    REP(11, phase11(p, smem, bid, nb))
    phase11(p, smem, bid, nb);
}
#else
#define PHASE_KERNEL(n) __global__ void __launch_bounds__(NTHR) fwd_phase##n(Params p) { extern __shared__ __attribute__((aligned(16))) char smem[]; phase##n(p, smem, blockIdx.x, gridDim.x); }
PHASE_KERNEL(0) PHASE_KERNEL(1) PHASE_KERNEL(2) PHASE_KERNEL(3) PHASE_KERNEL(4) PHASE_KERNEL(5)
PHASE_KERNEL(6) PHASE_KERNEL(7) PHASE_KERNEL(8) PHASE_KERNEL(9) PHASE_KERNEL(10) PHASE_KERNEL(11)
typedef void (*phase_fn)(Params);
#endif

extern "C" void kernel_launch(void* const* d_in, const int* in_sizes, int n_in, void* d_out, int out_size, void* d_ws, size_t ws_size, hipStream_t stream) {
    Params p{};
    for (int i = 0; i < 32; ++i) p.in[i] = (const float*)d_in[i];
    p.out = (float*)d_out;
    p.ws = (char*)d_ws;
    if (n_in != 32 || ws_size < WS_END) { fprintf(stderr, "kernel_launch: unexpected inputs (n_in %d) or workspace too small (%zu < %zu)\n", n_in, ws_size, (size_t)WS_END); return; }
#if MEGA
    static int grid = 0;
    if (!grid) {
        int dev = 0, cus = 0, per_cu = 0;
        (void)hipGetDevice(&dev);
        (void)hipDeviceGetAttribute(&cus, hipDeviceAttributeMultiprocessorCount, dev);
        (void)hipFuncSetAttribute((const void*)fwd_mega, hipFuncAttributeMaxDynamicSharedMemorySize, LDS_BYTES);
        (void)hipOccupancyMaxActiveBlocksPerMultiprocessor(&per_cu, (const void*)fwd_mega, NTHR, LDS_BYTES);
        if (per_cu < 1) { fprintf(stderr, "kernel_launch: occupancy query says %d blocks/CU\n", per_cu); per_cu = 1; }
        grid = cus;
    }
    (void)hipMemsetAsync((char*)d_ws + WS_BAR, 0, 16384, stream);
    void* args[] = {&p};
    hipError_t e = hipLaunchCooperativeKernel((const void*)fwd_mega, dim3(grid), dim3(NTHR), args, LDS_BYTES, stream);
    if (e != hipSuccess) fprintf(stderr, "cooperative launch failed: %s (grid %d)\n", hipGetErrorString(e), grid);
#else
    static const phase_fn fns[12] = {fwd_phase0, fwd_phase1, fwd_phase2, fwd_phase3, fwd_phase4, fwd_phase5, fwd_phase6, fwd_phase7, fwd_phase8, fwd_phase9, fwd_phase10, fwd_phase11};
    static bool attr = false;
    if (!attr) { for (int i = 0; i < 12; ++i) (void)hipFuncSetAttribute((const void*)fns[i], hipFuncAttributeMaxDynamicSharedMemorySize, LDS_BYTES); attr = true; }
    for (int i = 0; i < 12; ++i) hipLaunchKernelGGL(fns[i], dim3(256), dim3(NTHR), LDS_BYTES, stream, p);
#endif
}
```

```cpp
#include <hip/hip_runtime.h>
#include <hip/hip_cooperative_groups.h>
#include <stdint.h>
#include <stdio.h>
namespace cg = cooperative_groups;

#ifndef MEGA
#define MEGA 1
#endif

typedef unsigned short bf16_t;
typedef short bf16x8 __attribute__((ext_vector_type(8)));
typedef short s16x4 __attribute__((ext_vector_type(4)));
typedef float f32x4 __attribute__((ext_vector_type(4)));
typedef float f32x2 __attribute__((ext_vector_type(2)));
typedef unsigned u32x4 __attribute__((ext_vector_type(4)));
typedef unsigned u32x2 __attribute__((ext_vector_type(2)));
typedef __bf16 bf16x2_t __attribute__((ext_vector_type(2)));

#ifndef INPROJ_F8
#define INPROJ_F8 0
#endif
constexpr int T_TOK = 32768, DM = 1024, NB = 16, SEQ = 2048;
constexpr int PW = 3328;
constexpr int PC_Q = 0, PC_KC = 512, PC_VC = 640, PC_KS = 768, PC_VS = 896, PC_KW = 1024, PC_VW = 1152;
constexpr int PC_MQ = 1280, PC_MK = 1792, PC_MV = 2304, PC_MO = 2816;
constexpr float ALPHA = 1.189207115002721f;
constexpr float LN_EPS = 1e-5f;
constexpr int NTHR = 512;
constexpr int LDS_BYTES = 160 * 1024;
constexpr int NEXP = 256, TOPK = 8;
constexpr float W8_SCALE = 64.0f, H8_SCALE = 16.0f, Y8_SCALE = 64.0f;
constexpr int LIST_CAP = 32768;

constexpr size_t al256(size_t x) { return (x + 255) & ~(size_t)255; }
constexpr size_t WS_WIN = 0;
constexpr size_t WS_WOUT = WS_WIN + al256((size_t)3360 * 1024 * 2);
constexpr size_t WS_WQ = WS_WOUT + (size_t)1024 * 1024 * 2;
constexpr size_t WS_WKV = WS_WQ + (size_t)1024 * 1024 * 2;
constexpr size_t WS_WO = WS_WKV + (size_t)2048 * 1024 * 2;
constexpr size_t WS_WR = WS_WO + (size_t)1024 * 1024 * 2;
constexpr size_t WS_WS13 = WS_WR + (size_t)256 * 1024 * 2;
constexpr size_t WS_WS2 = WS_WS13 + (size_t)512 * 1024 * 2;
constexpr size_t WS_CK1 = WS_WS2 + (size_t)1024 * 256 * 2;
constexpr size_t WS_CK2 = WS_CK1 + (size_t)64 * 2048 * 2;
constexpr size_t WS_CV1 = WS_CK2 + (size_t)64 * 64 * 2;
constexpr size_t WS_CV2 = WS_CV1 + (size_t)64 * 2048 * 2;
constexpr size_t MB = 1024 * 1024;
constexpr size_t WS_LNP = al256(WS_CV2 + (size_t)64 * 64 * 2);
constexpr size_t WS_LNF = WS_LNP + (size_t)2 * 16 * 1792 * 4;
constexpr size_t WS_A = al256(WS_LNF + (size_t)2 * 1792 * 4 + 65536);
constexpr size_t WS_P = WS_A;
constexpr size_t WS_R1 = WS_A;
constexpr size_t WS_XQ = WS_A + 128 * MB;
constexpr size_t WS_XO = WS_A + 192 * MB;
constexpr size_t WS_XB = WS_A + 208 * MB;
constexpr size_t WS_MEMB = WS_A + 272 * MB;
constexpr size_t WS_PSM = WS_A + 280 * MB;
constexpr size_t WS_KCMP = WS_A + 284 * MB;
constexpr size_t WS_VCMP = WS_KCMP + (size_t)16 * 2 * 128 * 64 * 2;
constexpr size_t WS_QK = WS_A + 285 * MB;
constexpr size_t WS_MIX = WS_A + 349 * MB;
constexpr size_t WS_KVX = WS_A + 413 * MB;
constexpr size_t WS_X2F8 = WS_A + 256 * MB;
constexpr size_t WS_X2 = WS_A + 256 * MB;
constexpr size_t WS_HS = WS_A + 320 * MB;
constexpr size_t WS_R1B = WS_A;
constexpr size_t WS_RSC = WS_A;
constexpr size_t WS_Y = WS_A;
constexpr size_t WS_B = WS_A + al256((size_t)(T_TOK * 8 + 256) * 1024 * 2);
constexpr size_t WS_R2B = WS_B;
constexpr size_t WS_R2 = WS_B;
constexpr size_t WS_ST1 = WS_R2 + (size_t)T_TOK * 1024 * 4;
constexpr size_t WS_ST2 = WS_ST1 + (size_t)T_TOK * 8 * 4;
constexpr size_t WS_SH = WS_ST2 + (size_t)T_TOK * 8 * 4;
constexpr size_t WS_SELE = WS_SH + (size_t)T_TOK * 1024 * 2;
constexpr size_t WS_SELP = WS_SELE + (size_t)T_TOK * 8 * 4;
constexpr size_t WS_SELW = WS_SELP + (size_t)T_TOK * 8 * 4;
constexpr size_t WS_CNT = WS_SELW + (size_t)T_TOK * 8 * 4;
constexpr size_t WS_TOKL = WS_CNT + 98304;
constexpr size_t WS_WL = WS_TOKL + (size_t)NEXP * LIST_CAP * 4;
constexpr size_t WS_H = WS_WL + (size_t)NEXP * LIST_CAP * 4;
constexpr size_t WS_HF8 = WS_H;
constexpr size_t WS_W2F8 = WS_H + (size_t)(T_TOK * 8 + 256) * 256;
constexpr size_t WS_BAR = WS_W2F8 + (size_t)256 * 1024 * 256;
constexpr size_t WS_END = WS_BAR + 16384;
static_assert((size_t)T_TOK * PW * 2 <= 208 * MB, "P region");
static_assert(WS_END <= (size_t)1024 * MB, "workspace must fit 1 GiB");

struct Params {
    const float* in[32];
    float* out;
    char* ws;
};

__device__ __forceinline__ unsigned pk_bf16(float lo, float hi) {
    f32x2 v = {lo, hi};
    bf16x2_t r = __builtin_convertvector(v, bf16x2_t);
    return __builtin_bit_cast(unsigned, r);
}
__device__ __forceinline__ float bf_lo(unsigned u) { return __uint_as_float(u << 16); }
__device__ __forceinline__ float bf_hi(unsigned u) { return __uint_as_float(u & 0xffff0000u); }
__device__ __forceinline__ float bf2f(bf16_t h) { return __uint_as_float(((unsigned)h) << 16); }
__device__ __forceinline__ float sigmoidf_(float x) { return 1.0f / (1.0f + __expf(-x)); }
__device__ __forceinline__ float siluf_(float x) { return x / (1.0f + __expf(-x)); }
__device__ __forceinline__ f32x4 mfma16(bf16x8 a, bf16x8 b, f32x4 c) { return __builtin_amdgcn_mfma_f32_16x16x32_bf16(a, b, c, 0, 0, 0); }
__device__ __forceinline__ bf16x8 as_bf16x8(u32x4 v) { return __builtin_bit_cast(bf16x8, v); }

__device__ __forceinline__ float fq_max(float x) {
    auto a = __builtin_amdgcn_permlane16_swap(__float_as_uint(x), __float_as_uint(x), false, false);
    x = __builtin_fmaxf(__uint_as_float(a[0]), __uint_as_float(a[1]));
    auto b = __builtin_amdgcn_permlane32_swap(__float_as_uint(x), __float_as_uint(x), false, false);
    return __builtin_fmaxf(__uint_as_float(b[0]), __uint_as_float(b[1]));
}
__device__ __forceinline__ float fq_sum(float x) {
    auto a = __builtin_amdgcn_permlane16_swap(__float_as_uint(x), __float_as_uint(x), false, false);
    x = __uint_as_float(a[0]) + __uint_as_float(a[1]);
    auto b = __builtin_amdgcn_permlane32_swap(__float_as_uint(x), __float_as_uint(x), false, false);
    return __uint_as_float(b[0]) + __uint_as_float(b[1]);
}
__device__ __forceinline__ int opaque_tid() { int t = threadIdx.x; asm volatile("" : "+v"(t)); return t; }

__device__ __forceinline__ int tile_off(int row, int chunk) { return row * 128 + ((chunk ^ (row & 7)) << 4); }

__device__ __forceinline__ int bperm(int rho) { return (rho & ~31) + 8 * ((rho >> 2) & 3) + 4 * ((rho >> 4) & 1) + (rho & 3); }

typedef __attribute__((address_space(3))) unsigned lds_u32;
typedef __attribute__((address_space(1))) const unsigned glb_u32;

struct LoadBf16Rows {
    const bf16_t* base;
    unsigned off[4];
    int ldst;
    struct Regs { int dummy; };
    __device__ __forceinline__ void init_contig(const bf16_t* b, int ld, int row0) {
        const int tid_ = opaque_tid();
        const int r8 = tid_ >> 3, kc = (tid_ & 7) ^ (r8 & 7);
        ldst = tid_ * 16;
        base = b + (long)row0 * ld;
#pragma unroll
        for (int i = 0; i < 4; ++i) off[i] = (unsigned)((r8 + 64 * i) * ld + kc * 8);
    }
    __device__ __forceinline__ void init_rows(const bf16_t* b, int ld, const int (&rows)[4]) {
        const int tid_ = opaque_tid();
        const int r8 = tid_ >> 3, kc = (tid_ & 7) ^ (r8 & 7);
        ldst = tid_ * 16;
        base = b;
#pragma unroll
        for (int i = 0; i < 4; ++i) off[i] = (unsigned)rows[i] * (unsigned)ld + (unsigned)(kc * 8);
    }
    __device__ __forceinline__ void issue(Regs&, char* s, int kt) const {
#pragma unroll
        for (int i = 0; i < 4; ++i)
            __builtin_amdgcn_global_load_lds((glb_u32*)(base + (size_t)(off[i] + (unsigned)(kt * 64))), (lds_u32*)(s + i * 8192 + ldst), 16, 0, 0);
    }
    __device__ __forceinline__ void commit(const Regs&, char*, int) const {}
};

struct LoadF32KN {
    const float* p;
    int ldn;
    int n, kh;
    struct Regs { float v[32]; };
    __device__ __forceinline__ void issue(Regs& r, char*, int kt) const {
        const float* q = p + (long)kt * 64 * ldn;
#pragma unroll
        for (int j = 0; j < 32; ++j) r.v[j] = q[(long)j * ldn];
    }
    __device__ __forceinline__ void commit(const Regs& r, char* s, int kt) const {
#pragma unroll
        for (int q = 0; q < 4; ++q) {
            u32x4 w;
            w.x = pk_bf16(r.v[8 * q + 0], r.v[8 * q + 1]); w.y = pk_bf16(r.v[8 * q + 2], r.v[8 * q + 3]);
            w.z = pk_bf16(r.v[8 * q + 4], r.v[8 * q + 5]); w.w = pk_bf16(r.v[8 * q + 6], r.v[8 * q + 7]);
            *(u32x4*)(s + tile_off(n, kh * 4 + q)) = w;
        }
    }
};

struct LoadLN {
    LoadBf16Rows raw;
    bf16_t* xbase;
    const float* st;
    const float* gb;
    typedef LoadBf16Rows::Regs Regs;
    __device__ __forceinline__ void issue(Regs& r, char* s, int kt) const { raw.issue(r, s, kt); }
    __device__ __forceinline__ void commit(const Regs&, char* s, int kt) const {
        asm volatile("s_waitcnt vmcnt(0)" ::: "memory");
        const int tid_ = opaque_tid();
        const int r8 = tid_ >> 3, kc = (tid_ & 7) ^ (r8 & 7);
        const f32x4 g0 = *(const f32x4*)(gb + kt * 64 + kc * 8), g1 = *(const f32x4*)(gb + kt * 64 + kc * 8 + 4);
        const f32x4 b0 = *(const f32x4*)(gb + 1024 + kt * 64 + kc * 8), b1 = *(const f32x4*)(gb + 1024 + kt * 64 + kc * 8 + 4);
#pragma unroll
        for (int i = 0; i < 4; ++i) {
            const int row = r8 + 64 * i;
            u32x4* cp = (u32x4*)(s + i * 8192 + tid_ * 16);
            const u32x4 v = *cp;
            const float mean = st[row * 2], rstd = st[row * 2 + 1];
            const f32x4 x0 = (f32x4){bf_lo(v.x), bf_hi(v.x), bf_lo(v.y), bf_hi(v.y)};
            const f32x4 x1 = (f32x4){bf_lo(v.z), bf_hi(v.z), bf_lo(v.w), bf_hi(v.w)};
            const f32x4 y0 = (x0 - mean) * rstd * g0 + b0, y1 = (x1 - mean) * rstd * g1 + b1;
            u32x4 w; w.x = pk_bf16(y0[0], y0[1]); w.y = pk_bf16(y0[2], y0[3]); w.z = pk_bf16(y1[0], y1[1]); w.w = pk_bf16(y1[2], y1[3]);
            *cp = w;
            if (xbase) *(u32x4*)(xbase + (size_t)(row * 1024 + kc * 8 + kt * 64)) = w;
        }
    }
};

constexpr int GEMM_LDS = 131072;
template <class AL, class BL>
__device__ __forceinline__ void gemm_mainloop(char* smem, const AL& al, const BL& bl, int nk, f32x4 (&acc)[8][4]) {
    const int tid_ = opaque_tid();
    const int lane = tid_ & 63, wid = tid_ >> 6;
    const int wr = wid >> 2, wc = wid & 3, fr = lane & 15, fq = lane >> 4;
#pragma unroll
    for (int mi = 0; mi < 8; ++mi)
#pragma unroll
        for (int ni = 0; ni < 4; ++ni) acc[mi][ni] = (f32x4){0.f, 0.f, 0.f, 0.f};
    typename AL::Regs ra; typename BL::Regs rb;
    al.issue(ra, smem, 0); bl.issue(rb, smem + 32768, 0);
    al.commit(ra, smem, 0); bl.commit(rb, smem + 32768, 0);
    __syncthreads();
    for (int kt = 0; kt < nk; ++kt) {
        char* sA = smem + (kt & 1) * 65536; char* sB = sA + 32768;
        char* nA = smem + ((kt + 1) & 1) * 65536; char* nB = nA + 32768;
        if (kt + 1 < nk) { al.issue(ra, nA, kt + 1); bl.issue(rb, nB, kt + 1); }
#pragma unroll
        for (int kk = 0; kk < 2; ++kk) {
            bf16x8 bfr[4];
#pragma unroll
            for (int ni = 0; ni < 4; ++ni) bfr[ni] = *(const bf16x8*)(sB + tile_off(wc * 64 + ni * 16 + fr, kk * 4 + fq));
#pragma unroll
            for (int mi = 0; mi < 8; ++mi) {
                const bf16x8 af = *(const bf16x8*)(sA + tile_off(wr * 128 + mi * 16 + fr, kk * 4 + fq));
#pragma unroll
                for (int ni = 0; ni < 4; ++ni) acc[mi][ni] = mfma16(bfr[ni], af, acc[mi][ni]);
            }
        }
        if (kt + 1 < nk) { al.commit(ra, nA, kt + 1); bl.commit(rb, nB, kt + 1); }
        __syncthreads();
    }
}

__device__ __forceinline__ int swz4(int row) { return (0x78 >> (((row >> 2) & 3) * 2)) & 3; }
struct RingRows {
    const bf16_t* base; unsigned off[2]; int ldst;
    __device__ __forceinline__ void init_contig(const bf16_t* b, int ld, int row0, bool perm = false) {
        const int tid_ = opaque_tid(); const int r = tid_ >> 2, kc = (tid_ & 3) ^ swz4(r);
        ldst = tid_ * 16; base = b + (long)row0 * ld;
#pragma unroll
        for (int i = 0; i < 2; ++i) { const int rr = r + 128 * i; off[i] = (unsigned)((perm ? bperm(rr) : rr) * ld + kc * 8); }
    }
    __device__ __forceinline__ void init_rows(const bf16_t* b, int ld, const int (&rows)[2]) {
        const int tid_ = opaque_tid(); const int r = tid_ >> 2, kc = (tid_ & 3) ^ swz4(r);
        ldst = tid_ * 16; base = b;
#pragma unroll
        for (int i = 0; i < 2; ++i) off[i] = (unsigned)rows[i] * (unsigned)ld + (unsigned)(kc * 8);
    }
    __device__ __forceinline__ void issue(char* s, int kt) const {
#pragma unroll
        for (int i = 0; i < 2; ++i)
            __builtin_amdgcn_global_load_lds((glb_u32*)(base + (size_t)(off[i] + (unsigned)(kt * 32))), (lds_u32*)(s + i * 8192 + ldst), 16, 0, 0);
    }
    __device__ __forceinline__ void commit(char*, int) const {}
};
struct RingLN {
    RingRows raw; bf16_t* xbase; const float* st; const float* gb;
    __device__ __forceinline__ void issue(char* s, int kt) const { raw.issue(s, kt); }
    __device__ __forceinline__ void commit(char* s, int kt) const {
        const int tid_ = opaque_tid(); const int r = tid_ >> 2, kc = (tid_ & 3) ^ swz4(r);
        const f32x4 g0 = *(const f32x4*)(gb + kt * 32 + kc * 8), g1 = *(const f32x4*)(gb + kt * 32 + kc * 8 + 4);
        const f32x4 b0 = *(const f32x4*)(gb + 1024 + kt * 32 + kc * 8), b1 = *(const f32x4*)(gb + 1024 + kt * 32 + kc * 8 + 4);
#pragma unroll
        for (int i = 0; i < 2; ++i) {
            const int row = r + 128 * i;
            u32x4* cp = (u32x4*)(s + i * 8192 + tid_ * 16);
            const u32x4 v = *cp;
            const float mean = st[row * 2], rstd = st[row * 2 + 1];
            const f32x4 x0 = (f32x4){bf_lo(v.x), bf_hi(v.x), bf_lo(v.y), bf_hi(v.y)};
            const f32x4 x1 = (f32x4){bf_lo(v.z), bf_hi(v.z), bf_lo(v.w), bf_hi(v.w)};
            const f32x4 y0 = (x0 - mean) * rstd * g0 + b0, y1 = (x1 - mean) * rstd * g1 + b1;
            u32x4 w; w.x = pk_bf16(y0[0], y0[1]); w.y = pk_bf16(y0[2], y0[3]); w.z = pk_bf16(y1[0], y1[1]); w.w = pk_bf16(y1[2], y1[3]);
            *cp = w;
            if (xbase) *(u32x4*)(xbase + (size_t)(row * 1024 + kc * 8 + kt * 32)) = w;
        }
    }
};
#define RING_WAIT(n) asm volatile("s_waitcnt vmcnt(" #n ")" ::: "memory")
#define RING_BAR() do { __builtin_amdgcn_sched_barrier(0); asm volatile("s_waitcnt lgkmcnt(0)" ::: "memory"); __builtin_amdgcn_s_barrier(); asm volatile("" ::: "memory"); __builtin_amdgcn_sched_barrier(0); } while (0)
template <class AL, class BL>
__device__ __forceinline__ void ring_issue3(char* smem, const AL& al, const BL& bl) {
    al.issue(smem, 0); bl.issue(smem + 16384, 0);
    al.issue(smem + 32768, 1); bl.issue(smem + 32768 + 16384, 1);
    al.issue(smem + 65536, 2); bl.issue(smem + 65536 + 16384, 2);
}
template <class AL, class BL, int XMODE = 0  , bool ISSUED = false  >
__device__ __forceinline__ void gemm_ring(char* smem, const AL& al, const BL& bl, int nk  , f32x4 (&acc)[8][4]) {
    const int tid_ = opaque_tid();
    const int lane = tid_ & 63, wid = __builtin_amdgcn_readfirstlane(tid_ >> 6);
    const int wr = wid >> 2, wc = wid & 3, fr = lane & 15, fq = lane >> 4;
#pragma unroll
    for (int mi = 0; mi < 8; ++mi)
#pragma unroll
        for (int ni = 0; ni < 4; ++ni) acc[mi][ni] = (f32x4){0.f, 0.f, 0.f, 0.f};
    const int aoff = (wr * 128 + fr) * 64 + ((fq ^ swz4(fr)) << 4);
    const int boff = 16384 + (wc * 64 + fr) * 64 + ((fq ^ swz4(fr)) << 4);
    if (XMODE != 1) {
    if (!ISSUED) ring_issue3(smem, al, bl);
    RING_WAIT(8);
    al.commit(smem, 0); bl.commit(smem + 16384, 0);
    }
    RING_BAR();
    if (wr == 1) RING_BAR();
    for (int kt = 0; kt < nk; ++kt) {
        const char* st = smem + (kt & 3) * 32768;
        if (XMODE != 1 && kt + 3 < nk) { char* s3 = smem + ((kt + 3) & 3) * 32768; al.issue(s3, kt + 3); bl.issue(s3 + 16384, kt + 3); }
        bf16x8 bfr[4], afr[8];
        if (XMODE != 2) {
#pragma unroll
        for (int ni = 0; ni < 4; ++ni) bfr[ni] = *(const bf16x8*)(st + boff + ni * 1024);
#pragma unroll
        for (int mi = 0; mi < 8; ++mi) afr[mi] = *(const bf16x8*)(st + aoff + mi * 1024);
        }
        if (XMODE != 1 && kt + 1 < nk) {
            if (kt + 3 < nk) RING_WAIT(8); else if (kt + 2 < nk) RING_WAIT(4); else RING_WAIT(0);
            char* s1 = smem + ((kt + 1) & 3) * 32768;
            al.commit(s1, kt + 1); bl.commit(s1 + 16384, kt + 1);
        }
        RING_BAR();
        if (XMODE != 2) {
        __builtin_amdgcn_s_setprio(1);
#pragma unroll
        for (int mi = 0; mi < 8; ++mi)
#pragma unroll
            for (int ni = 0; ni < 4; ++ni) acc[mi][ni] = mfma16(bfr[ni], afr[mi], acc[mi][ni]);
        __builtin_amdgcn_s_setprio(0);
        }
        RING_BAR();
    }
    if (wr == 0) RING_BAR();
}

constexpr int FB_PITCH = 1088, FB_STAGE = 16384 + 32 * FB_PITCH;
struct RingF32B {
    const float* p; int ldn; int ldst;
    __device__ __forceinline__ void init(const float* W, int ld, int srccol4, int tid_) { const int lane = tid_ & 63, wid = tid_ >> 6; p = W + (long)wid * ld + srccol4; ldn = ld; ldst = wid * FB_PITCH + lane * 16; }
    __device__ __forceinline__ void issue(char* sB, int kt) const {
#pragma unroll
        for (int i = 0; i < 4; ++i)
            __builtin_amdgcn_global_load_lds((glb_u32*)(p + (long)(kt * 32 + i * 8) * ldn), (lds_u32*)(sB + i * 8 * FB_PITCH + (i & 1) * 64 + ldst), 16, 0, 0);
    }
};
template <class AL>
__device__ __forceinline__ void gemm_ring_f32b(char* smem, const AL& al, const RingF32B& bl, int nk  , f32x4 (&acc)[8][4]) {
    const int tid_ = opaque_tid();
    const int lane = tid_ & 63, wid = __builtin_amdgcn_readfirstlane(tid_ >> 6);
    const int wr = wid >> 2, wc = wid & 3, fr = lane & 15, fq = lane >> 4;
#pragma unroll
    for (int mi = 0; mi < 8; ++mi)
#pragma unroll
        for (int ni = 0; ni < 4; ++ni) acc[mi][ni] = (f32x4){0.f, 0.f, 0.f, 0.f};
    const int aoff = (wr * 128 + fr) * 64 + ((fq ^ swz4(fr)) << 4);
    const int boff = 16384 + (8 * fq) * FB_PITCH + (fq & 1) * 64 + (wc * 64 + fr) * 4;
    al.issue(smem, 0); bl.issue(smem + 16384, 0);
    al.issue(smem + FB_STAGE, 1); bl.issue(smem + FB_STAGE + 16384, 1);
    RING_WAIT(6);
    RING_BAR();
    if (wr == 1) RING_BAR();
    int s0 = 0;
    for (int kt = 0; kt < nk; ++kt) {
        const char* st = smem + s0 * FB_STAGE;
        const int s1 = s0 == 2 ? 0 : s0 + 1, s2 = s1 == 2 ? 0 : s1 + 1;
        if (kt + 2 < nk) { char* sn = smem + s2 * FB_STAGE; al.issue(sn, kt + 2); bl.issue(sn + 16384, kt + 2); }
        bf16x8 bfr[4], afr[8];
#pragma unroll
        for (int ni = 0; ni < 4; ++ni) {
            float v[8];
#pragma unroll
            for (int j = 0; j < 8; ++j) v[j] = *(const float*)(st + boff + j * FB_PITCH + ni * 64);
            u32x4 w; w.x = pk_bf16(v[0], v[1]); w.y = pk_bf16(v[2], v[3]); w.z = pk_bf16(v[4], v[5]); w.w = pk_bf16(v[6], v[7]);
            bfr[ni] = as_bf16x8(w);
        }
#pragma unroll
        for (int mi = 0; mi < 8; ++mi) afr[mi] = *(const bf16x8*)(st + aoff + mi * 1024);
        if (kt + 1 < nk) { if (kt + 2 < nk) RING_WAIT(6); else RING_WAIT(0); }
        RING_BAR();
        __builtin_amdgcn_s_setprio(1);
#pragma unroll
        for (int mi = 0; mi < 8; ++mi)
#pragma unroll
            for (int ni = 0; ni < 4; ++ni) acc[mi][ni] = mfma16(bfr[ni], afr[mi], acc[mi][ni]);
        __builtin_amdgcn_s_setprio(0);
        RING_BAR();
        s0 = s1;
    }
    if (wr == 0) RING_BAR();
}

__device__ __forceinline__ int bperm32(int rho) { return (rho & ~31) + 16 * ((rho >> 2) & 1) + 4 * ((rho >> 3) & 3) + (rho & 3); }
__device__ __forceinline__ unsigned pk4_fp8(float a, float b, float c, float d) {
    int r = __builtin_amdgcn_cvt_pk_fp8_f32(a, b, 0, false);
    r = __builtin_amdgcn_cvt_pk_fp8_f32(c, d, r, true);
    return (unsigned)r;
}
struct RingF8 {
    const unsigned char* base; unsigned off[2]; int ldst;
    __device__ __forceinline__ void init_contig(const unsigned char* b, int ldb, long row0, bool perm = false) {
        const int tid_ = opaque_tid(); const int r = tid_ >> 2, kc = (tid_ & 3) ^ ((r >> 2) & 3);
        ldst = tid_ * 16; base = b + row0 * ldb;
#pragma unroll
        for (int i = 0; i < 2; ++i) { const int rr = r + 128 * i; off[i] = (unsigned)((perm ? bperm32(rr) : rr) * ldb + kc * 16); }
    }
    __device__ __forceinline__ void init_rows(const unsigned char* b, int ldb, const int (&rows)[2]) {
        const int tid_ = opaque_tid(); const int r = tid_ >> 2, kc = (tid_ & 3) ^ ((r >> 2) & 3);
        ldst = tid_ * 16; base = b;
#pragma unroll
        for (int i = 0; i < 2; ++i) off[i] = (unsigned)rows[i] * (unsigned)ldb + (unsigned)(kc * 16);
    }
    __device__ __forceinline__ void issue(char* s, int kt) const {
#pragma unroll
        for (int i = 0; i < 2; ++i)
            __builtin_amdgcn_global_load_lds((glb_u32*)(base + (size_t)(off[i] + (unsigned)(kt * 64))), (lds_u32*)(s + i * 8192 + ldst), 16, 0, 0);
    }
};
__device__ __forceinline__ void ring_f8_issue3(char* smem, const RingF8& al, const RingF8& bl) {
    al.issue(smem, 0); bl.issue(smem + 16384, 0);
    al.issue(smem + 32768, 1); bl.issue(smem + 32768 + 16384, 1);
    al.issue(smem + 65536, 2); bl.issue(smem + 65536 + 16384, 2);
}
__device__ __forceinline__ void gemm_ring_f8_main(char* smem, const RingF8& al, const RingF8& bl, int nk  , f32x4 (&acc)[8][4]) {
    const int tid_ = opaque_tid();
    const int lane = tid_ & 63, wid = __builtin_amdgcn_readfirstlane(tid_ >> 6);
    const int wr = wid >> 2, wc = wid & 3, fr = lane & 15, fq = lane >> 4;
#pragma unroll
    for (int mi = 0; mi < 8; ++mi)
#pragma unroll
        for (int ni = 0; ni < 4; ++ni) acc[mi][ni] = (f32x4){0.f, 0.f, 0.f, 0.f};
    const int g2 = ((fr >> 2) & 3) << 1;
    const int aoff0 = (wr * 128 + fr) * 64 + ((fq ^ g2) << 3), aoff1 = (wr * 128 + fr) * 64 + (((4 + fq) ^ g2) << 3);
    const int boff0 = 16384 + (wc * 64 + fr) * 64 + ((fq ^ g2) << 3), boff1 = 16384 + (wc * 64 + fr) * 64 + (((4 + fq) ^ g2) << 3);
    RING_WAIT(8);
    RING_BAR();
    if (wr == 1) RING_BAR();
    for (int kt = 0; kt < nk; ++kt) {
        const char* st = smem + (kt & 3) * 32768;
        if (kt + 3 < nk) { char* s3 = smem + ((kt + 3) & 3) * 32768; al.issue(s3, kt + 3); bl.issue(s3 + 16384, kt + 3); }
        long b0[4], b1[4], a0[8], a1[8];
#pragma unroll
        for (int ni = 0; ni < 4; ++ni) { b0[ni] = *(const long*)(st + boff0 + ni * 1024); b1[ni] = *(const long*)(st + boff1 + ni * 1024); }
#pragma unroll
        for (int mi = 0; mi < 8; ++mi) { a0[mi] = *(const long*)(st + aoff0 + mi * 1024); a1[mi] = *(const long*)(st + aoff1 + mi * 1024); }
        if (kt + 1 < nk) { if (kt + 3 < nk) RING_WAIT(8); else if (kt + 2 < nk) RING_WAIT(4); else RING_WAIT(0); }
        RING_BAR();
        __builtin_amdgcn_s_setprio(1);
#pragma unroll
        for (int mi = 0; mi < 8; ++mi)
#pragma unroll
            for (int ni = 0; ni < 4; ++ni) {
                acc[mi][ni] = __builtin_amdgcn_mfma_f32_16x16x32_fp8_fp8(b0[ni], a0[mi], acc[mi][ni], 0, 0, 0);
                acc[mi][ni] = __builtin_amdgcn_mfma_f32_16x16x32_fp8_fp8(b1[ni], a1[mi], acc[mi][ni], 0, 0, 0);
            }
        __builtin_amdgcn_s_setprio(0);
        RING_BAR();
    }
    if (wr == 0) RING_BAR();
}

typedef int i32x8 __attribute__((ext_vector_type(8)));
typedef float f32x16 __attribute__((ext_vector_type(16)));
constexpr int MX_ONE = 0x7f7f7f7f;
__device__ __forceinline__ f32x16 mfma_mx(i32x8 a, i32x8 b, f32x16 c) { return __builtin_amdgcn_mfma_scale_f32_32x32x64_f8f6f4(a, b, c, 0, 0, 0, MX_ONE, 0, MX_ONE); }
__device__ __forceinline__ i32x8 mx_frag(const char* rowp  , int c0off, int c1off) {
    const u32x4 lo = *(const u32x4*)(rowp + c0off), hi = *(const u32x4*)(rowp + c1off);
    return (i32x8){(int)lo.x, (int)lo.y, (int)lo.z, (int)lo.w, (int)hi.x, (int)hi.y, (int)hi.z, (int)hi.w};
}
__device__ __forceinline__ void gemm_ring_mx_main(char* smem, const RingF8& al, const RingF8& bl, int nk  , f32x16 (&acc)[4][2]) {
    const int tid_ = opaque_tid();
    const int lane = tid_ & 63, wid = __builtin_amdgcn_readfirstlane(tid_ >> 6);
    const int wr = wid >> 2, wc = wid & 3, r = lane & 31, h = lane >> 5;
#pragma unroll
    for (int mi = 0; mi < 4; ++mi)
#pragma unroll
        for (int nj = 0; nj < 2; ++nj)
#pragma unroll
            for (int q = 0; q < 16; ++q) acc[mi][nj][q] = 0.f;
    const int g = (r >> 2) & 3;
    const int c0 = ((2 * h) ^ g) << 4, c1 = ((2 * h + 1) ^ g) << 4;
    const int arow = (wr * 128 + r) * 64;
    const int brow = 16384 + (wc * 64 + r) * 64;
    RING_WAIT(8);
    RING_BAR();
    if (wr == 1) RING_BAR();
#pragma unroll 1
    for (int kt = 0; kt < nk; ++kt) {
        const char* st = smem + (kt & 3) * 32768;
        if (kt + 3 < nk) { char* s3 = smem + ((kt + 3) & 3) * 32768; al.issue(s3, kt + 3); bl.issue(s3 + 16384, kt + 3); }
        i32x8 bf[2], af[4];
#pragma unroll
        for (int nj = 0; nj < 2; ++nj) bf[nj] = mx_frag(st + brow + nj * 2048, c0, c1);
#pragma unroll
        for (int mi = 0; mi < 4; ++mi) af[mi] = mx_frag(st + arow + mi * 2048, c0, c1);
        if (kt + 1 < nk) { if (kt + 3 < nk) RING_WAIT(8); else if (kt + 2 < nk) RING_WAIT(4); else RING_WAIT(0); }
        RING_BAR();
        __builtin_amdgcn_s_setprio(1);
#pragma unroll
        for (int mi = 0; mi < 4; ++mi)
#pragma unroll
            for (int nj = 0; nj < 2; ++nj) acc[mi][nj] = mfma_mx(bf[nj], af[mi], acc[mi][nj]);
        __builtin_amdgcn_s_setprio(0);
        RING_BAR();
    }
    if (wr == 0) RING_BAR();
}

__device__ __forceinline__ int bperm16(int rho) { return (rho & ~63) + 16 * ((rho >> 2) & 3) + 4 * ((rho >> 4) & 3) + (rho & 3); }

__device__ __forceinline__ void epi_store_bf16(const f32x4 (&acc)[8][4], bf16_t* out, long ld, int row0, int col0) {
    const int tid_ = opaque_tid();
    const int lane = tid_ & 63, wid = tid_ >> 6;
    const int wr = wid >> 2, wc = wid & 3, fr = lane & 15, fq = lane >> 4;
#pragma unroll
    for (int mi = 0; mi < 8; ++mi) {
        bf16_t* rp = out + (long)(row0 + wr * 128 + mi * 16 + fr) * ld + col0 + wc * 64 + fq * 8;
#pragma unroll
        for (int q = 0; q < 2; ++q) {
            u32x4 w; w.x = pk_bf16(acc[mi][2 * q][0], acc[mi][2 * q][1]); w.y = pk_bf16(acc[mi][2 * q][2], acc[mi][2 * q][3]);
            w.z = pk_bf16(acc[mi][2 * q + 1][0], acc[mi][2 * q + 1][1]); w.w = pk_bf16(acc[mi][2 * q + 1][2], acc[mi][2 * q + 1][3]);
            *(u32x4*)(rp + q * 32) = w;
        }
    }
}

template <bool RES_LN>
__device__ __forceinline__ void epi_residual(f32x4 (&acc)[8][4], char* smem, const float* resid_f32, const bf16_t* resid_bf16, const float* rstats  ,
                                             const float* g, const float* b, bf16_t* rbout, float* stout  , int row0, int nt) {
    const int tid_ = opaque_tid();
    const int lane = tid_ & 63, wid = tid_ >> 6;
    const int wr = wid >> 2, wc = wid & 3, fr = lane & 15, fq = lane >> 4;
    float* sp = (float*)(smem + 139264);
    const int col0 = nt * 256 + wc * 64 + fq * 8;
#pragma unroll
    for (int mi = 0; mi < 8; ++mi) {
        const int rl = wr * 128 + mi * 16 + fr;
        const long row = row0 + rl;
        float mean = 0.f, rstd = 1.f;
        if (RES_LN) {
            const f32x4 p0 = *(const f32x4*)(rstats + row * 8), p1 = *(const f32x4*)(rstats + row * 8 + 4);
            const float s1 = (p0[0] + p0[2]) + (p1[0] + p1[2]), s2 = (p0[1] + p0[3]) + (p1[1] + p1[3]);
            mean = s1 * (1.0f / 1024.0f);
            const float var = fmaxf(s2 * (1.0f / 1024.0f) - mean * mean, 0.f);
            rstd = rsqrtf(var + LN_EPS);
        }
        float s1 = 0.f, s2 = 0.f;
#pragma unroll
        for (int q = 0; q < 2; ++q) {
            const long o = row * 1024 + col0 + q * 32;
            f32x4 x0, x1;
            if (RES_LN) {
                const u32x4 u = *(const u32x4*)(resid_bf16 + o);
                x0 = (f32x4){bf_lo(u.x), bf_hi(u.x), bf_lo(u.y), bf_hi(u.y)}; x1 = (f32x4){bf_lo(u.z), bf_hi(u.z), bf_lo(u.w), bf_hi(u.w)};
                x0 = (x0 - mean) * rstd * *(const f32x4*)(g + col0 + q * 32) + *(const f32x4*)(b + col0 + q * 32);
                x1 = (x1 - mean) * rstd * *(const f32x4*)(g + col0 + q * 32 + 4) + *(const f32x4*)(b + col0 + q * 32 + 4);
            } else { x0 = *(const f32x4*)(resid_f32 + o); x1 = *(const f32x4*)(resid_f32 + o + 4); }
            const f32x4 v0 = acc[mi][2 * q] + ALPHA * x0, v1 = acc[mi][2 * q + 1] + ALPHA * x1;
            { u32x4 w; w.x = pk_bf16(v0[0], v0[1]); w.y = pk_bf16(v0[2], v0[3]); w.z = pk_bf16(v1[0], v1[1]); w.w = pk_bf16(v1[2], v1[3]); *(u32x4*)(rbout + o) = w; }
            s1 += ((v0[0] + v0[1]) + (v0[2] + v0[3])) + ((v1[0] + v1[1]) + (v1[2] + v1[3]));
            s2 += ((v0[0] * v0[0] + v0[1] * v0[1]) + (v0[2] * v0[2] + v0[3] * v0[3])) + ((v1[0] * v1[0] + v1[1] * v1[1]) + (v1[2] * v1[2] + v1[3] * v1[3]));
        }
        s1 = fq_sum(s1); s2 = fq_sum(s2);
        if (fq == 0) { sp[(rl * 4 + wc) * 2] = s1; sp[(rl * 4 + wc) * 2 + 1] = s2; }
    }
    __syncthreads();
    if (tid_ < 256) {
        const int rl = tid_;
        const float a1 = (sp[rl * 8] + sp[rl * 8 + 2]) + (sp[rl * 8 + 4] + sp[rl * 8 + 6]);
        const float a2 = (sp[rl * 8 + 1] + sp[rl * 8 + 3]) + (sp[rl * 8 + 5] + sp[rl * 8 + 7]);
        *(f32x2*)(stout + ((long)(row0 + rl) * 4 + nt) * 2) = (f32x2){a1, a2};
    }
    __syncthreads();
}

__device__ __forceinline__ void ln_tile_stats(float* st, const float* rstats, int row0) {
    const int tid_ = opaque_tid();
    if (tid_ < 256) {
        const long row = row0 + tid_;
        const f32x4 p0 = *(const f32x4*)(rstats + row * 8), p1 = *(const f32x4*)(rstats + row * 8 + 4);
        const float s1 = (p0[0] + p0[2]) + (p1[0] + p1[2]), s2 = (p0[1] + p0[3]) + (p1[1] + p1[3]);
        const float mean = s1 * (1.0f / 1024.0f);
        const float var = fmaxf(s2 * (1.0f / 1024.0f) - mean * mean, 0.f);
        st[tid_ * 2] = mean; st[tid_ * 2 + 1] = rsqrtf(var + LN_EPS);
    }
}
__device__ __forceinline__ void ln_load_gb(float* gb, const float* g, const float* b) {
    for (int i = opaque_tid(); i < 1024; i += NTHR) { gb[i] = g[i]; gb[1024 + i] = b[i]; }
}


struct XcdSlab {
    int x, j, stride;
    __device__ __forceinline__ void init(int bid, int nb) { if ((nb & 7) == 0) { x = bid & 7; j = bid >> 3; stride = nb >> 3; } else { x = -1; j = bid; stride = nb; } }
    __device__ __forceinline__ int m_lo(int nM) const { return x < 0 ? 0 : (x * nM) >> 3; }
    __device__ __forceinline__ int m_hi(int nM) const { return x < 0 ? nM : ((x + 1) * nM) >> 3; }
};

template <int MAP>
__device__ __forceinline__ void ln_correct(f32x4 (&acc)[8][4], const float* rstats  , int row0, const float* cs, const float* bw, int nt) {
    const int tid_ = opaque_tid();
    const int lane = tid_ & 63, wid = tid_ >> 6;
    const int wr = wid >> 2, wc = wid & 3, fr = lane & 15, fq = lane >> 4;
    float mean[8], rstd[8];
#pragma unroll
    for (int mi = 0; mi < 8; ++mi) {
        const long row = row0 + wr * 128 + mi * 16 + fr;
        const f32x4 p0 = *(const f32x4*)(rstats + row * 8), p1 = *(const f32x4*)(rstats + row * 8 + 4);
        const float s1 = (p0[0] + p0[2]) + (p1[0] + p1[2]), s2 = (p0[1] + p0[3]) + (p1[1] + p1[3]);
        mean[mi] = s1 * (1.0f / 1024.0f);
        rstd[mi] = rsqrtf(fmaxf(s2 * (1.0f / 1024.0f) - mean[mi] * mean[mi], 0.f) + LN_EPS);
    }
#pragma unroll
    for (int ni = 0; ni < 4; ++ni) {
        const int col = MAP == 0 ? nt * 256 + wc * 64 + (ni >> 1) * 32 + fq * 8 + (ni & 1) * 4
                                 : (ni & 1) * 256 + nt * 128 + wc * 32 + fq * 8 + (ni >> 1) * 4;
        const f32x4 c4 = *(const f32x4*)(cs + col), b4 = *(const f32x4*)(bw + col);
#pragma unroll
        for (int mi = 0; mi < 8; ++mi) acc[mi][ni] = (acc[mi][ni] - mean[mi] * c4) * rstd[mi] + b4;
    }
}

__device__ __forceinline__ void epi_store_bf16_mx(const f32x16 (&acc)[4][2], float scale, bf16_t* out, long ld, int row0, int col0) {
    const int tid_ = opaque_tid();
    const int lane = tid_ & 63, wid = tid_ >> 6;
    const int wr = wid >> 2, wc = wid & 3, r = lane & 31, h = lane >> 5;
#pragma unroll
    for (int mi = 0; mi < 4; ++mi) {
        bf16_t* rp = out + (long)(row0 + wr * 128 + mi * 32 + r) * ld + col0 + wc * 64 + h * 16;
#pragma unroll
        for (int nj = 0; nj < 2; ++nj) {
            const f32x16 v = acc[mi][nj] * scale;
            u32x4 w0, w1;
            w0.x = pk_bf16(v[0], v[1]); w0.y = pk_bf16(v[2], v[3]); w0.z = pk_bf16(v[4], v[5]); w0.w = pk_bf16(v[6], v[7]);
            w1.x = pk_bf16(v[8], v[9]); w1.y = pk_bf16(v[10], v[11]); w1.z = pk_bf16(v[12], v[13]); w1.w = pk_bf16(v[14], v[15]);
            *(u32x4*)(rp + nj * 32) = w0; *(u32x4*)(rp + nj * 32 + 8) = w1;
        }
    }
}
struct TJob { const float* src; int ldsrc; int K; int col0; int ncols; bf16_t* dst; int mode; int rowoff; int f8;   const float* g; const float* b; float* part;   };
__device__ __forceinline__ int tjob_row(const TJob& j, int c) {
    if (j.mode == 0) return j.rowoff + c;
    const int oc = c & 127;
    return 256 * (c >> 7) + 64 * (oc >> 5) + 16 * (2 * ((oc >> 2) & 1) + j.rowoff) + 4 * ((oc >> 3) & 3) + (oc & 3);
}
__device__ __forceinline__ void transpose_tile(char* smem, const TJob& j, int kt, int ct) {
    float* tile = (float*)smem;
    float* red = tile + 64 * 65;
    const int tid = opaque_tid();
    float scs = 0.f, sbw = 0.f;
#pragma unroll
    for (int i = 0; i < 8; ++i) {
        const int e = tid + i * NTHR, kr = e >> 6, c = e & 63;
        const int cc = ct * 64 + c;
        float v = 0.f;
        if (cc < j.ncols) v = j.src[(long)(kt * 64 + kr) * j.ldsrc + j.col0 + cc];
        if (j.g) {
            const float gv = j.g[kt * 64 + kr], bv = j.b[kt * 64 + kr];
            sbw += bv * v;
            v *= gv;
            scs += __uint_as_float(pk_bf16(v, 0.f) << 16);
        }
        tile[kr * 65 + c] = v;
    }
    if (j.g) { red[(tid >> 6) * 64 + (tid & 63)] = scs; red[512 + (tid >> 6) * 64 + (tid & 63)] = sbw; }
    __syncthreads();
    if (j.f8) {
#pragma unroll
        for (int i = 0; i < 2; ++i) {
            const int e = tid + i * NTHR, c = e >> 4, k4 = (e & 15) * 4;
            const int cc = ct * 64 + c;
            if (cc < j.ncols) {
                const unsigned w = pk4_fp8(tile[k4 * 65 + c] * W8_SCALE, tile[(k4 + 1) * 65 + c] * W8_SCALE, tile[(k4 + 2) * 65 + c] * W8_SCALE, tile[(k4 + 3) * 65 + c] * W8_SCALE);
                *(unsigned*)((unsigned char*)j.dst + (long)tjob_row(j, cc) * j.K + kt * 64 + k4) = w;
            }
        }
    } else {
#pragma unroll
    for (int i = 0; i < 4; ++i) {
        const int e = tid + i * NTHR, c = e >> 5, k2 = (e & 31) * 2;
        const int cc = ct * 64 + c;
        if (cc < j.ncols) {
            const unsigned w = pk_bf16(tile[k2 * 65 + c], tile[(k2 + 1) * 65 + c]);
            *(unsigned*)(j.dst + (long)tjob_row(j, cc) * j.K + kt * 64 + k2) = w;
        }
    }
    }
    if (j.g && tid < 128) {
        const int which = tid >> 6, c = tid & 63;
        float s = 0.f;
#pragma unroll
        for (int w = 0; w < 8; ++w) s += red[which * 512 + w * 64 + c];
        if (ct * 64 + c < j.ncols) j.part[(long)(which * 16 + kt) * 1792 + ct * 64 + c] = s;
    }
    __syncthreads();
}

__device__ __forceinline__ void tjob_run(int& g_rot, char* smem, int bid, int nb, const float* src, int ld, int K, int col0, int ncols, bf16_t* dst, int mode, int rowoff,
                                         const float* g = nullptr, const float* b = nullptr, float* part = nullptr, int f8 = 0) {
    TJob j; j.f8 = f8; j.src = src; j.ldsrc = ld; j.K = K; j.col0 = col0; j.ncols = ncols; j.dst = dst; j.mode = mode; j.rowoff = rowoff; j.g = g; j.b = b; j.part = part;
    const int nkt = K / 64, nct = (ncols + 63) / 64, ntile = nkt * nct;
    const int first = (bid + nb - g_rot % nb) % nb;
    for (int t = first; t < ntile; t += nb) transpose_tile(smem, j, t % nkt, t / nkt);
    g_rot += ntile;
}

__device__ __forceinline__ void cvt_rows_bf16(const float* src, bf16_t* dst, long n8, int bid, int nb) {
    for (long i = (long)bid * NTHR + opaque_tid(); i < n8; i += (long)nb * NTHR) {
        const f32x4 a = *(const f32x4*)(src + i * 8), b = *(const f32x4*)(src + i * 8 + 4);
        u32x4 w; w.x = pk_bf16(a[0], a[1]); w.y = pk_bf16(a[2], a[3]); w.z = pk_bf16(b[0], b[1]); w.w = pk_bf16(b[2], b[3]);
        *(u32x4*)(dst + i * 8) = w;
    }
}

enum { I_X = 0, I_MEM, I_WIN, I_POSK, I_CKW1, I_CKW2, I_POSV, I_CVW1, I_CVW2, I_CONVW, I_IBIAS, I_FBIAS, I_NORMG, I_WOUT, I_LN1G, I_LN1B,
       I_XAWQ, I_XAWK, I_XAWV, I_XAWO, I_LN2G, I_LN2B, I_ROUTW, I_ROUTB, I_MW1, I_MW3, I_MW2, I_SW1, I_SW3, I_SW2, I_LN3G, I_LN3B };

__device__ __forceinline__ void phase0(const Params& p, char* smem, int bid, int nb) {
    char* ws = p.ws;
    int rot = 0;
    tjob_run(rot, smem, bid, nb, p.in[I_WIN], 3360, 1024, 0, 1280, (bf16_t*)(ws + WS_WIN), 0, 0, nullptr, nullptr, nullptr, INPROJ_F8);
    tjob_run(rot, smem, bid, nb, p.in[I_WIN], 3360, 1024, 1304, 2048, (bf16_t*)(ws + WS_WIN), 0, 1280, nullptr, nullptr, nullptr, INPROJ_F8);
    tjob_run(rot, smem, bid, nb, p.in[I_WIN], 3360, 1024, 1280, 24, (bf16_t*)(ws + WS_WIN), 0, 3328, nullptr, nullptr, nullptr, INPROJ_F8);
    tjob_run(rot, smem, bid, nb, p.in[I_WIN], 3360, 1024, 3352, 8, (bf16_t*)(ws + WS_WIN), 0, 3352, nullptr, nullptr, nullptr, INPROJ_F8);
    tjob_run(rot, smem, bid, nb, p.in[I_WOUT], 1024, 1024, 0, 1024, (bf16_t*)(ws + WS_WOUT), 0, 0);
    float* lnp = (float*)(ws + WS_LNP);
    tjob_run(rot, smem, bid, nb, p.in[I_XAWQ], 1024, 1024, 0, 1024, (bf16_t*)(ws + WS_WQ), 0, 0, p.in[I_LN1G], p.in[I_LN1B], lnp);
    tjob_run(rot, smem, bid, nb, p.in[I_XAWK], 1024, 1024, 0, 1024, (bf16_t*)(ws + WS_WKV), 0, 0);
    tjob_run(rot, smem, bid, nb, p.in[I_XAWV], 1024, 1024, 0, 1024, (bf16_t*)(ws + WS_WKV), 0, 1024);
    tjob_run(rot, smem, bid, nb, p.in[I_XAWO], 1024, 1024, 0, 1024, (bf16_t*)(ws + WS_WO), 0, 0);
    tjob_run(rot, smem, bid, nb, p.in[I_ROUTW], 256, 1024, 0, 256, (bf16_t*)(ws + WS_WR), 0, 0, p.in[I_LN2G], p.in[I_LN2B], lnp + 1024);
    tjob_run(rot, smem, bid, nb, p.in[I_SW1], 256, 1024, 0, 256, (bf16_t*)(ws + WS_WS13), 1, 0, p.in[I_LN2G], p.in[I_LN2B], lnp + 1280);
    tjob_run(rot, smem, bid, nb, p.in[I_SW3], 256, 1024, 0, 256, (bf16_t*)(ws + WS_WS13), 1, 1, p.in[I_LN2G], p.in[I_LN2B], lnp + 1536);
    tjob_run(rot, smem, bid, nb, p.in[I_SW2], 1024, 256, 0, 1024, (bf16_t*)(ws + WS_WS2), 0, 0);
    tjob_run(rot, smem, bid, nb, p.in[I_CKW1], 64, 2048, 0, 64, (bf16_t*)(ws + WS_CK1), 0, 0);
    tjob_run(rot, smem, bid, nb, p.in[I_CKW2], 64, 64, 0, 64, (bf16_t*)(ws + WS_CK2), 0, 0);
    tjob_run(rot, smem, bid, nb, p.in[I_CVW1], 64, 2048, 0, 64, (bf16_t*)(ws + WS_CV1), 0, 0);
    tjob_run(rot, smem, bid, nb, p.in[I_CVW2], 64, 64, 0, 64, (bf16_t*)(ws + WS_CV2), 0, 0);
#if INPROJ_F8
    for (long i = (long)bid * NTHR + opaque_tid(); i < (long)T_TOK * 1024 / 8; i += (long)nb * NTHR) {
        const f32x4 a = *(const f32x4*)(p.in[I_X] + i * 8), b = *(const f32x4*)(p.in[I_X] + i * 8 + 4);
        u32x2 w; w.x = pk4_fp8(a[0], a[1], a[2], a[3]); w.y = pk4_fp8(b[0], b[1], b[2], b[3]);
        *(u32x2*)((unsigned char*)(ws + WS_XB) + i * 8) = w;
    }
#else
    cvt_rows_bf16(p.in[I_X], (bf16_t*)(ws + WS_XB), (long)T_TOK * 1024 / 8, bid, nb);
#endif
    cvt_rows_bf16(p.in[I_MEM], (bf16_t*)(ws + WS_MEMB), (long)4096 * 1024 / 8, bid, nb);
    { int* c = (int*)(ws + WS_CNT); for (int i = bid * NTHR + opaque_tid(); i < 24576; i += nb * NTHR) c[i] = 0; }
}

__device__ __forceinline__ void small_cols_task(const Params& p, int task) {
    const bf16_t* xb = (const bf16_t*)(p.ws + WS_XB);
    const bf16_t* wt = (const bf16_t*)(p.ws + WS_WIN) + (long)3328 * 1024;
    float* psm = (float*)(p.ws + WS_PSM);
    const int tid_ = opaque_tid();
    const int lane = tid_ & 63, wid = tid_ >> 6, fr = lane & 15, fq = lane >> 4;
    const int r0 = task * 256 + wid * 32;
    f32x4 acc[2][2];
#pragma unroll
    for (int mi = 0; mi < 2; ++mi)
#pragma unroll
        for (int ni = 0; ni < 2; ++ni) acc[mi][ni] = (f32x4){0.f, 0.f, 0.f, 0.f};
    const bf16_t* ap0 = xb + (long)(r0 + fr) * 1024 + fq * 8;
    const bf16_t* ap1 = ap0 + 16 * 1024;
    const bf16_t* bp0 = wt + (long)fr * 1024 + fq * 8;
    const bf16_t* bp1 = bp0 + 16 * 1024;
#pragma unroll 4
    for (int ks = 0; ks < 32; ++ks) {
        const bf16x8 a0 = *(const bf16x8*)(ap0 + ks * 32), a1 = *(const bf16x8*)(ap1 + ks * 32);
        const bf16x8 b0 = *(const bf16x8*)(bp0 + ks * 32), b1 = *(const bf16x8*)(bp1 + ks * 32);
        acc[0][0] = mfma16(b0, a0, acc[0][0]); acc[0][1] = mfma16(b1, a0, acc[0][1]);
        acc[1][0] = mfma16(b0, a1, acc[1][0]); acc[1][1] = mfma16(b1, a1, acc[1][1]);
    }
#pragma unroll
    for (int mi = 0; mi < 2; ++mi)
#pragma unroll
        for (int ni = 0; ni < 2; ++ni) *(f32x4*)(psm + (long)(r0 + mi * 16 + fr) * 32 + ni * 16 + fq * 4) = acc[mi][ni];
}

template <int NOEPI = 0>
__device__ __forceinline__ void phase1(const Params& p, char* smem, int bid, int nb) {
    char* ws = p.ws;
    XcdSlab xs; xs.init(bid, nb);
    const int a_lo = xs.m_lo(128), a_nm = xs.m_hi(128) - a_lo, a_n = a_nm * 14;
    const int b_lo = xs.m_lo(16), b_nm = xs.m_hi(16) - b_lo, b_n = b_nm * 8;
#if INPROJ_F8
    {
        int mt = 0, nt = 0;
        RingF8 al, bl;
        auto setup = [&](int u) {
            mt = a_lo + u % a_nm; nt = u / a_nm;
            al.init_contig((const unsigned char*)(ws + WS_XB), 1024, (long)mt * 256);
            bl.init_contig((const unsigned char*)(ws + WS_WIN), 1024, (long)nt * 256, true);
        };
        int u = xs.j;
        if (u < a_n) { setup(u); ring_f8_issue3(smem, al, bl); }
        while (u < a_n) {
            const int cmt = mt, cnt_ = nt;
            f32x16 acc[4][2];
            gemm_ring_mx_main(smem, al, bl, 16, acc);
            u += xs.stride;
            if (u < a_n) { setup(u); ring_f8_issue3(smem, al, bl); }
            if (NOEPI) { float s = 0.f;
#pragma unroll
                for (int mi = 0; mi < 4; ++mi) s += acc[mi][0][0] + acc[mi][1][5];
                if (s == 123.456f) ((float*)(ws + WS_A + 432 * MB))[opaque_tid()] = s; continue; }
            if (cnt_ < 13) epi_store_bf16_mx(acc, 1.0f / W8_SCALE, (bf16_t*)(ws + WS_P), PW, cmt * 256, cnt_ * 256);
            else {
                const int tid_ = opaque_tid();
                const int lane = tid_ & 63, wid = tid_ >> 6, wr = wid >> 2, wc = wid & 3, r = lane & 31, h = lane >> 5;
                if (wc == 0) {
                    float* psm = (float*)(ws + WS_PSM);
#pragma unroll
                    for (int mi = 0; mi < 4; ++mi) {
                        const f32x16 v = acc[mi][0] * (1.0f / W8_SCALE);
                        float* rp = psm + (long)(cmt * 256 + wr * 128 + mi * 32 + r) * 32 + h * 16;
#pragma unroll
                        for (int q4 = 0; q4 < 4; ++q4) *(f32x4*)(rp + q4 * 4) = (f32x4){v[q4 * 4], v[q4 * 4 + 1], v[q4 * 4 + 2], v[q4 * 4 + 3]};
                    }
                }
            }
        }
        asm volatile("s_waitcnt vmcnt(0)" ::: "memory"); __syncthreads();
    }
    const int a_n2 = 0;
#else
    const int a_n2 = a_n;
#endif
    bool inp = false; int mt = 0, nt = 0;
    RingRows al, bl;
    auto setup = [&](int u) {
        inp = u < a_n2;
        const int uu = inp ? u : u - a_n2;
        const int nm = inp ? a_nm : b_nm;
        mt = (inp ? a_lo : b_lo) + uu % nm; nt = uu / nm;
        al.init_contig((const bf16_t*)(ws + (inp ? WS_XB : WS_MEMB)), 1024, mt * 256);
        bl.init_contig((const bf16_t*)(ws + (inp ? WS_WIN : WS_WKV)), 1024, nt * 256, true);
    };
    int u = xs.j;
    if (u < a_n2 + b_n) { setup(u); ring_issue3(smem, al, bl); }
    while (u < a_n2 + b_n) {
        const bool cinp = inp; const int cmt = mt, cnt_ = nt;
        f32x4 acc[8][4];
        gemm_ring<RingRows, RingRows, 0, true>(smem, al, bl, 32, acc);
        u += xs.stride;
        if (u < a_n2 + b_n) { setup(u); ring_issue3(smem, al, bl); }
        if (NOEPI) { float s = 0.f;
#pragma unroll
            for (int mi = 0; mi < 8; ++mi)
#pragma unroll
                for (int ni = 0; ni < 4; ++ni) s += acc[mi][ni][0] + acc[mi][ni][1] + acc[mi][ni][2] + acc[mi][ni][3];
            if (s == 123.456f) ((float*)(ws + WS_A + 432 * MB))[opaque_tid()] = s; continue; }
        if (!cinp) epi_store_bf16(acc, (bf16_t*)(ws + WS_KVX), 2048, cmt * 256, cnt_ * 256);
        else if (cnt_ < 13) epi_store_bf16(acc, (bf16_t*)(ws + WS_P), PW, cmt * 256, cnt_ * 256);
        else {
            const int tid_ = opaque_tid();
            const int lane = tid_ & 63, wid = tid_ >> 6, wr = wid >> 2, wc = wid & 3, fr = lane & 15, fq = lane >> 4;
            if (wc == 0) {
                float* psm = (float*)(ws + WS_PSM);
#pragma unroll
                for (int mi = 0; mi < 8; ++mi)
#pragma unroll
                    for (int ni = 0; ni < 2; ++ni) *(f32x4*)(psm + (long)(cmt * 256 + wr * 128 + mi * 16 + fr) * 32 + fq * 8 + ni * 4) = acc[mi][ni];
            }
        }
    }
    asm volatile("s_waitcnt vmcnt(0)" ::: "memory");
}

__device__ __forceinline__ void compress_task(const Params& p, char* smem, int which, int rb) {
    const char* ws = p.ws;
    const bf16_t* P = (const bf16_t*)(ws + WS_P);
    const float* pos = p.in[which ? I_POSV : I_POSK];
    const bf16_t* w1t = (const bf16_t*)(ws + (which ? WS_CV1 : WS_CK1));
    const bf16_t* w2t = (const bf16_t*)(ws + (which ? WS_CV2 : WS_CK2));
    bf16_t* outp = (bf16_t*)(p.ws + (which ? WS_VCMP : WS_KCMP));
    const int colbase = which ? PC_VC : PC_KC;
    const int tid_ = opaque_tid();
    const int lane = tid_ & 63, wid = tid_ >> 6, fr = lane & 15, fq = lane >> 4;
    f32x4 acc[2][4];
#pragma unroll
    for (int mi = 0; mi < 2; ++mi)
#pragma unroll
        for (int ni = 0; ni < 4; ++ni) acc[mi][ni] = (f32x4){0.f, 0.f, 0.f, 0.f};
    const bf16_t* arow[2];
#pragma unroll
    for (int mi = 0; mi < 2; ++mi) {
        const int r = rb * 32 + mi * 16 + fr;
        const int b = r / 254, rem = r - b * 254, c = rem >> 1, g = rem & 1;
        arow[mi] = P + (long)(b * 2048 + c * 16) * PW + colbase + g * 64 + fq * 8;
    }
    const bf16_t* brow = w1t + (long)fr * 2048 + fq * 8;
    const float* prow = pos + fq * 8;
#pragma unroll 2
    for (int s = 0; s < 8; ++s) {
        const int ks = wid * 8 + s;
        const int l = ks >> 1, d0 = (ks & 1) * 32;
        const f32x4 p0 = *(const f32x4*)(prow + l * 64 + d0), p1 = *(const f32x4*)(prow + l * 64 + d0 + 4);
        bf16x8 af[2];
#pragma unroll
        for (int mi = 0; mi < 2; ++mi) {
            const u32x4 av = *(const u32x4*)(arow[mi] + (long)l * PW + d0);
            u32x4 aw;
            aw.x = pk_bf16(bf_lo(av.x) + p0[0], bf_hi(av.x) + p0[1]); aw.y = pk_bf16(bf_lo(av.y) + p0[2], bf_hi(av.y) + p0[3]);
            aw.z = pk_bf16(bf_lo(av.z) + p1[0], bf_hi(av.z) + p1[1]); aw.w = pk_bf16(bf_lo(av.w) + p1[2], bf_hi(av.w) + p1[3]);
            af[mi] = as_bf16x8(aw);
        }
#pragma unroll
        for (int ni = 0; ni < 4; ++ni) {
            const bf16x8 bb = *(const bf16x8*)(brow + (long)(ni * 16) * 2048 + ks * 32);
            acc[0][ni] = mfma16(bb, af[0], acc[0][ni]);
            acc[1][ni] = mfma16(bb, af[1], acc[1][ni]);
        }
    }
    f32x4* part = (f32x4*)(smem + 8192);
#pragma unroll
    for (int mi = 0; mi < 2; ++mi)
#pragma unroll
        for (int ni = 0; ni < 4; ++ni) part[(wid * 8 + mi * 4 + ni) * 64 + lane] = acc[mi][ni];
    __syncthreads();
    const int mi = wid >> 2, ni = wid & 3;
    f32x4 a1 = (f32x4){0.f, 0.f, 0.f, 0.f};
#pragma unroll
    for (int w = 0; w < 8; ++w) a1 = a1 + part[(w * 8 + wid) * 64 + lane];
    bf16_t* h1 = (bf16_t*)smem;
    {
        u32x2 w; w.x = pk_bf16(siluf_(a1[0]), siluf_(a1[1])); w.y = pk_bf16(siluf_(a1[2]), siluf_(a1[3]));
        *(u32x2*)(h1 + (mi * 16 + fr) * 72 + ni * 16 + fq * 4) = w;
    }
    __syncthreads();
    f32x4 acc2 = (f32x4){0.f, 0.f, 0.f, 0.f};
#pragma unroll
    for (int ks = 0; ks < 2; ++ks) {
        const bf16x8 a = *(const bf16x8*)(h1 + (mi * 16 + fr) * 72 + ks * 32 + fq * 8);
        const bf16x8 bb = *(const bf16x8*)(w2t + (ni * 16 + fr) * 64 + ks * 32 + fq * 8);
        acc2 = mfma16(bb, a, acc2);
    }
    {
        const int r = rb * 32 + mi * 16 + fr;
        const int b = r / 254, rem = r - b * 254, c = rem >> 1, g = rem & 1;
        u32x2 w; w.x = pk_bf16(acc2[0], acc2[1]); w.y = pk_bf16(acc2[2], acc2[3]);
        *(u32x2*)(outp + ((long)(b * 2 + g) * 128 + c) * 64 + ni * 16 + fq * 4) = w;
    }
    __syncthreads();
}

__device__ __forceinline__ void phase2(const Params& p, char* smem, int bid, int nb) {
    char* ws = p.ws;
    {
        const int idx = bid * NTHR + opaque_tid();
        if (idx < 2 * 1792) {
            const float* pp = (const float*)(ws + WS_LNP) + (long)(idx / 1792) * 16 * 1792 + idx % 1792;
            float s = 0.f;
#pragma unroll
            for (int k = 0; k < 16; ++k) s += pp[k * 1792];
            ((float*)(ws + WS_LNF))[idx] = s;
        }
    }
    for (int t = bid; t < 254; t += nb) compress_task(p, smem, t / 127, t % 127);
    const int tid_ = opaque_tid();
    if (bid < 32 && tid_ < 32) {
        bf16_t* kc = (bf16_t*)(ws + WS_KCMP) + ((long)bid * 128 + 127) * 64;
        bf16_t* vc = (bf16_t*)(ws + WS_VCMP) + ((long)bid * 128 + 127) * 64;
        ((unsigned*)kc)[tid_] = 0u; ((unsigned*)vc)[tid_] = 0u;
    }
    const bf16_t* P = (const bf16_t*)(ws + WS_P);
    const float* cw = p.in[I_CONVW];
    bf16_t* qk = (bf16_t*)(ws + WS_QK);
    for (long it = (long)bid * NTHR + tid_; it < (long)T_TOK * 128; it += (long)nb * NTHR) {
        const int t = (int)(it >> 7), ch = (int)(it & 127);
        const int s = t & (SEQ - 1);
        float a[8];
#pragma unroll
        for (int e = 0; e < 8; ++e) a[e] = 0.f;
#pragma unroll
        for (int j = 0; j < 4; ++j) {
            if (s - 3 + j >= 0) {
                const u32x4 u = *(const u32x4*)(P + (long)(t - 3 + j) * PW + PC_MQ + ch * 8);
                const f32x4 w0 = *(const f32x4*)(cw + j * 1024 + ch * 8), w1 = *(const f32x4*)(cw + j * 1024 + ch * 8 + 4);
                a[0] += w0[0] * bf_lo(u.x); a[1] += w0[1] * bf_hi(u.x); a[2] += w0[2] * bf_lo(u.y); a[3] += w0[3] * bf_hi(u.y);
                a[4] += w1[0] * bf_lo(u.z); a[5] += w1[1] * bf_hi(u.z); a[6] += w1[2] * bf_lo(u.w); a[7] += w1[3] * bf_hi(u.w);
            }
        }
        const float sc = ch < 64 ? 0.08838834764831845f : 1.0f;
        u32x4 w;
        w.x = pk_bf16(siluf_(a[0]) * sc, siluf_(a[1]) * sc); w.y = pk_bf16(siluf_(a[2]) * sc, siluf_(a[3]) * sc);
        w.z = pk_bf16(siluf_(a[4]) * sc, siluf_(a[5]) * sc); w.w = pk_bf16(siluf_(a[6]) * sc, siluf_(a[7]) * sc);
        *(u32x4*)(qk + (long)t * 1024 + ch * 8) = w;
    }
}

typedef __attribute__((address_space(3))) s16x4 lds_s16x4;
__device__ __forceinline__ s16x4 lds_tr(const char* a) { return __builtin_amdgcn_ds_read_tr16_b64_v4i16((lds_s16x4*)a); }
__device__ __forceinline__ bf16x8 tr_frag_perm(const char* base, int pitch, int rbase, int cbase, int fr, int fq) {
    const char* a0 = base + (rbase + 4 * fq + (fr >> 2)) * pitch + (cbase + 4 * (fr & 3)) * 2;
    const s16x4 lo = lds_tr(a0), hi = lds_tr(a0 + 16 * pitch);
    return (bf16x8){lo[0], lo[1], lo[2], lo[3], hi[0], hi[1], hi[2], hi[3]};
}
__device__ __forceinline__ bf16x8 tr_frag_std(const char* base, int pitch, int rbase, int cbase, int fr, int fq) {
    const char* a0 = base + (rbase + 8 * fq + (fr >> 2)) * pitch + (cbase + 4 * (fr & 3)) * 2;
    const s16x4 lo = lds_tr(a0), hi = lds_tr(a0 + 4 * pitch);
    return (bf16x8){lo[0], lo[1], lo[2], lo[3], hi[0], hi[1], hi[2], hi[3]};
}
__device__ __forceinline__ bf16x8 pack_p(const f32x4 a, const f32x4 b) {
    u32x4 w; w.x = pk_bf16(a[0], a[1]); w.y = pk_bf16(a[2], a[3]); w.z = pk_bf16(b[0], b[1]); w.w = pk_bf16(b[2], b[3]);
    return as_bf16x8(w);
}

__device__ __forceinline__ float dpp_xor1(float v) { return __builtin_bit_cast(float, __builtin_amdgcn_mov_dpp(__builtin_bit_cast(int, v), 0xB1, 0xF, 0xF, true)); }
__device__ __forceinline__ float dpp_xor2(float v) { return __builtin_bit_cast(float, __builtin_amdgcn_mov_dpp(__builtin_bit_cast(int, v), 0x4E, 0xF, 0xF, true)); }

constexpr int NSA_PITCH = 160;
constexpr int NSA_KC = 0, NSA_VC = 20480, NSA_KT = 40960, NSA_VT = 61440, NSA_MISC = 81920, NSA_Y = 83968;

struct NsaState {
    bf16x8 qf[2][2];
    int tl[2];
    unsigned selm[2];
    unsigned wunion, bunion;
    unsigned tunion[2];
};

constexpr int NSA_STG = 16384;
__device__ __forceinline__ bf16x8 tr_frag_perm_swz(const char* base, int rbase, int dt, int fr, int fq) {
    const int R = rbase + 4 * fq + (fr >> 2), c = 2 * dt + ((fr & 3) >> 1);
    const char* a0 = base + R * 128 + ((c ^ (R & 7)) << 4) + 8 * (fr & 1);
    const s16x4 lo = lds_tr(a0), hi = lds_tr(a0 + 16 * 128);
    return (bf16x8){lo[0], lo[1], lo[2], lo[3], hi[0], hi[1], hi[2], hi[3]};
}

#define NSA_WAITV(n) asm volatile("s_waitcnt vmcnt(" #n ")" ::: "memory")
#define NSA_BAR() do { asm volatile("s_waitcnt lgkmcnt(0)" ::: "memory"); __builtin_amdgcn_s_barrier(); asm volatile("" ::: "memory"); } while (0)

template <int MODE>
__device__ __forceinline__ void nsa_stream(char* smem, const bf16_t* Pb  , int g, int i, NsaState& st, float gate0, float gate1, const int tid) {
    const int lane = tid & 63, fr = lane & 15, fq = lane >> 4;
    const int kcol = (MODE == 0 ? PC_KS : PC_KW) + g * 64, vcol = (MODE == 0 ? PC_VS : PC_VW) + g * 64;
    const int lrow = tid >> 3, lch = (tid & 7) ^ (lrow & 7);
    const bf16_t* ksrc = Pb + (long)lrow * PW + kcol + lch * 8;
    const bf16_t* vsrc = Pb + (long)lrow * PW + vcol + lch * 8;
    const int jlo = MODE == 0 ? 0 : (i - 8 > 0 ? i - 8 : 0);
    const unsigned range = (i >= 31 ? 0xffffffffu : ((1u << (i + 1)) - 1u)) & ~((1u << jlo) - 1u);
    const unsigned need = (unsigned)__builtin_amdgcn_readfirstlane((int)((MODE == 0 ? st.bunion : 0xffffffffu) & range));
    f32x4 O[2][4];
    float m[2], l[2];
    int tlq[2];
#pragma unroll
    for (int mt = 0; mt < 2; ++mt) { m[mt] = -1e30f; l[mt] = 0.f; tlq[mt] = st.tl[mt] - 4 * fq;
#pragma unroll
        for (int dt = 0; dt < 4; ++dt) O[mt][dt] = (f32x4){0.f, 0.f, 0.f, 0.f}; }
    unsigned pm = need;
    int nissued = 0;
    auto issue_next = [&]() {
        const int jj = __builtin_ctz(pm); pm &= pm - 1u;
        char* sb = smem + (nissued & 3) * NSA_STG;
        __builtin_amdgcn_global_load_lds((glb_u32*)(ksrc + (long)jj * 64 * PW), (lds_u32*)(sb + tid * 16), 16, 0, 0);
        __builtin_amdgcn_global_load_lds((glb_u32*)(vsrc + (long)jj * 64 * PW), (lds_u32*)(sb + 8192 + tid * 16), 16, 0, 0);
        ++nissued;
    };
    const int L = __builtin_popcount(need);
    if (L > 0) issue_next();
    if (L > 1) issue_next();
    if (L > 2) issue_next();
    if (L > 2) NSA_WAITV(4); else if (L > 1) NSA_WAITV(2); else NSA_WAITV(0);
    NSA_BAR();
    unsigned cm = need;
    for (int n = 0; n < L; ++n) {
        const int j = __builtin_ctz(cm); cm &= cm - 1u;
        if (n + 3 < L) issue_next();
        const char* KT = smem + (n & 3) * NSA_STG;
        const char* VT = KT + 8192;
        const bool on0 = MODE == 0 ? (((st.tunion[0] >> j) & 1u) != 0u) : true, on1 = MODE == 0 ? (((st.tunion[1] >> j) & 1u) != 0u) : true;
        if (on0 || on1) {
            f32x4 S[2][4];
            {
                bf16x8 kf[4][2];
#pragma unroll
                for (int nt = 0; nt < 4; ++nt)
#pragma unroll
                    for (int ks = 0; ks < 2; ++ks) kf[nt][ks] = *(const bf16x8*)(KT + (16 * nt + fr) * 128 + (((ks * 4 + fq) ^ (fr & 7)) << 4));
#pragma unroll
                for (int mt = 0; mt < 2; ++mt) {
                    if (MODE == 0 && !(mt == 0 ? on0 : on1)) continue;
#pragma unroll
                    for (int nt = 0; nt < 4; ++nt) {
                        f32x4 s = (f32x4){0.f, 0.f, 0.f, 0.f};
                        s = mfma16(kf[nt][0], st.qf[mt][0], s);
                        s = mfma16(kf[nt][1], st.qf[mt][1], s);
                        S[mt][nt] = s;
                    }
                }
            }
            bf16x8 pf[2][2];
            const bool edge = (j == i) || (MODE == 1 && j == i - 8);
            constexpr float CS = 0.125f * 1.4426950408889634f;
#pragma unroll
            for (int mt = 0; mt < 2; ++mt) {
                if (MODE == 0 && !(mt == 0 ? on0 : on1)) continue;
                const bool rowsel = MODE == 0 ? (((st.selm[mt] >> j) & 1u) != 0u) : true;
                if (edge) {
                    asm volatile("; boundary tile" ::: "memory");
#pragma unroll
                    for (int nt = 0; nt < 4; ++nt)
#pragma unroll
                        for (int e = 0; e < 4; ++e) {
                            const int kc = 16 * nt + e;
                            bool ok = true;
                            if (j == i) ok = ok && (kc <= tlq[mt]);
                            if (MODE == 1) { if (j == i - 8) ok = ok && (kc > tlq[mt]); }
                            S[mt][nt][e] = ok ? S[mt][nt][e] : -INFINITY;
                        }
                }
                float mx = -INFINITY;
#pragma unroll
                for (int nt = 0; nt < 4; ++nt)
#pragma unroll
                    for (int e = 0; e < 4; ++e) mx = __builtin_fmaxf(mx, S[mt][nt][e]);
                mx = fq_max(mx);
                if (MODE == 0) mx = rowsel ? mx : -INFINITY;
                const float mnew = __builtin_fmaxf(m[mt], mx * CS);
                const float alpha = __builtin_amdgcn_exp2f(m[mt] - mnew);
                const float msub = (MODE == 0 && !rowsel) ? INFINITY : mnew;
                float rs = 0.f;
#pragma unroll
                for (int nt = 0; nt < 4; ++nt)
#pragma unroll
                    for (int e = 0; e < 4; ++e) { const float pv = __builtin_amdgcn_exp2f(__builtin_fmaf(S[mt][nt][e], CS, -msub)); S[mt][nt][e] = pv; rs += pv; }
                rs = fq_sum(rs);
                l[mt] = l[mt] * alpha + rs; m[mt] = mnew;
#pragma unroll
                for (int dt = 0; dt < 4; ++dt) O[mt][dt] = O[mt][dt] * alpha;
                pf[mt][0] = pack_p(S[mt][0], S[mt][1]); pf[mt][1] = pack_p(S[mt][2], S[mt][3]);
            }
#pragma unroll
            for (int ks2 = 0; ks2 < 2; ++ks2)
#pragma unroll
                for (int dt = 0; dt < 4; ++dt) {
                    const bf16x8 vf = tr_frag_perm_swz(VT, 32 * ks2, dt, fr, fq);
                    if (MODE != 0 || on0) O[0][dt] = mfma16(vf, pf[0][ks2], O[0][dt]);
                    if (MODE != 0 || on1) O[1][dt] = mfma16(vf, pf[1][ks2], O[1][dt]);
                }
        }
        if (n + 1 < L) { if (n + 3 < L) NSA_WAITV(4); else if (n + 2 < L) NSA_WAITV(2); else NSA_WAITV(0); }
        NSA_BAR();
    }
#pragma unroll
    for (int mt = 0; mt < 2; ++mt) {
        const float gsc = (mt == 0 ? gate0 : gate1) * (l[mt] > 0.f ? 1.0f / l[mt] : 0.f);
#pragma unroll
        for (int dt = 0; dt < 4; ++dt) { f32x4* yp = (f32x4*)(smem + NSA_Y) + (mt * 4 + dt) * NTHR + tid; *yp = *yp + O[mt][dt] * gsc; }
    }
}

__device__ __forceinline__ void nsa_cmp_one(const char* smem, const bf16x8 qf0, const bf16x8 qf1, const int t, const int i, const float gate0, f32x4* yp  , unsigned& selm, const int lane) {
    const int fr = lane & 15, fq = lane >> 4;
        const int cl = (t >= 31 ? ((t - 31) >> 4) : -1) - 4 * fq;
        f32x4 S[8];
#pragma unroll
        for (int nt = 0; nt < 8; ++nt) {
            f32x4 s = (f32x4){0.f, 0.f, 0.f, 0.f};
#pragma unroll
            for (int ks = 0; ks < 2; ++ks) {
                const bf16x8 kf = *(const bf16x8*)(smem + NSA_KC + (16 * nt + fr) * NSA_PITCH + (ks * 4 + fq) * 16);
                s = mfma16(kf, (ks == 0 ? qf0 : qf1), s);
            }
            S[nt] = s;
        }
        float mx = -INFINITY;
#pragma unroll
        for (int nt = 0; nt < 8; ++nt)
#pragma unroll
            for (int e = 0; e < 4; ++e) {
                const float sv = (16 * nt + e <= cl) ? S[nt][e] * 0.125f : -INFINITY;
                S[nt][e] = sv; mx = fmaxf(mx, sv);
            }
        mx = fq_max(mx);
        const float mref = fmaxf(mx, -1e30f);
        float rs = 0.f;
#pragma unroll
        for (int nt = 0; nt < 8; ++nt)
#pragma unroll
            for (int e = 0; e < 4; ++e) { const float pv = __expf(S[nt][e] - mref); S[nt][e] = pv; rs += pv; }
        rs = fq_sum(rs);
        const float inv = rs > 0.f ? 1.0f / rs : 0.f;
#pragma unroll
        for (int nt = 0; nt < 8; ++nt) S[nt] = S[nt] * inv;
        {
            f32x4 O[4];
#pragma unroll
            for (int dt = 0; dt < 4; ++dt) O[dt] = (f32x4){0.f, 0.f, 0.f, 0.f};
#pragma unroll
            for (int ks2 = 0; ks2 < 4; ++ks2) {
                const bf16x8 pf = pack_p(S[2 * ks2], S[2 * ks2 + 1]);
#pragma unroll
                for (int dt = 0; dt < 4; ++dt) {
                    const bf16x8 vf = tr_frag_perm(smem + NSA_VC, NSA_PITCH, 32 * ks2, 16 * dt, fr, fq);
                    O[dt] = mfma16(vf, pf, O[dt]);
                }
            }
#pragma unroll
            for (int dt = 0; dt < 4; ++dt) yp[dt * NTHR] = O[dt] * gate0;
        }
        float imp[8];
        {
            float own[8], last[8];
#pragma unroll
            for (int nt = 0; nt < 8; ++nt) {
                f32x4 v = S[nt];
#pragma unroll
                for (int e = 0; e < 4; ++e) { v[e] += dpp_xor1(v[e]); v[e] += dpp_xor2(v[e]); }
                own[nt] = (v[0] + v[1]) + (v[2] + v[3]); last[nt] = v[3];
            }
            const int src = (lane + 48) & 63;
#pragma unroll
            for (int nt = 0; nt < 8; ++nt) {
                const float a = __shfl(last[nt], src);
                const float bsh = nt > 0 ? __shfl(last[nt > 0 ? nt - 1 : 0], src) : 0.f;
                const float prevc = fq > 0 ? a : bsh;
                const int n = 4 * nt + fq;
                const float pslc = own[nt] + prevc;
                const bool valid = n <= i;
                const bool forced = (n == 0) || (n == i) || (n == i - 1);
                imp[nt] = valid ? pslc + (forced ? 1e4f : 0.f) : -1e30f;
            }
        }
        unsigned mask = 0u;
#pragma unroll 1
        for (int r = 0; r < 8; ++r) {
            float bv = imp[0]; int bn = fq;
#pragma unroll
            for (int nt = 1; nt < 8; ++nt) { if (imp[nt] > bv) { bv = imp[nt]; bn = 4 * nt + fq; } }
#pragma unroll
            for (int off = 16; off <= 32; off <<= 1) {
                const float ov = __shfl_xor(bv, off); const int on = __shfl_xor(bn, off);
                if (ov > bv || (ov == bv && on < bn)) { bv = ov; bn = on; }
            }
            if (bv > -5e29f) mask |= 1u << bn;
#pragma unroll
            for (int nt = 0; nt < 8; ++nt) if (bn == 4 * nt + fq) imp[nt] = -3.0e38f;
        }
        selm = mask;
}

template <int NSAV = 7  >
__device__ __forceinline__ void nsa_task(const Params& p, char* smem, int b, int g, int i) {
    const char* ws = p.ws;
    const bf16_t* Pb = (const bf16_t*)(ws + WS_P) + (long)b * SEQ * PW;
    const float* psm = (const float*)(ws + WS_PSM) + (long)b * SEQ * 32;
    int tid = threadIdx.x;
    asm volatile("" : "+v"(tid));
    const int lane = tid & 63, wid = __builtin_amdgcn_readfirstlane(tid >> 6), fr = lane & 15, fq = lane >> 4;
    const int qs = i * 64;
    NsaState st;
    float gate[2][3];
#pragma unroll
    for (int mt = 0; mt < 2; ++mt) {
        st.tl[mt] = 8 * wid + 4 * mt + (fr >> 2);
        const int h = fr & 3;
        const bf16_t* qp = Pb + (long)(qs + st.tl[mt]) * PW + PC_Q + g * 256 + h * 64 + fq * 8;
        st.qf[mt][0] = *(const bf16x8*)(qp); st.qf[mt][1] = *(const bf16x8*)(qp + 32);
        const float* gp = psm + (long)(qs + st.tl[mt]) * 32 + (g * 4 + h) * 3;
        gate[mt][0] = sigmoidf_(gp[0]); gate[mt][1] = sigmoidf_(gp[1]); gate[mt][2] = sigmoidf_(gp[2]);
    }
    {
        const bf16_t* kc = (const bf16_t*)(ws + WS_KCMP) + (long)(b * 2 + g) * 128 * 64;
        const bf16_t* vc = (const bf16_t*)(ws + WS_VCMP) + (long)(b * 2 + g) * 128 * 64;
#pragma unroll
        for (int r = 0; r < 2; ++r) {
            const int e = tid + r * NTHR, row = e >> 3, ch = e & 7;
            *(u32x4*)(smem + NSA_KC + row * NSA_PITCH + ch * 16) = *(const u32x4*)(kc + row * 64 + ch * 8);
            *(u32x4*)(smem + NSA_VC + row * NSA_PITCH + ch * 16) = *(const u32x4*)(vc + row * 64 + ch * 8);
        }
    }
    __syncthreads();
    if (!(NSAV & 1)) { st.selm[0] = 0xffffffffu; st.selm[1] = 0xffffffffu;
#pragma unroll
        for (int d8 = 0; d8 < 8; ++d8) ((f32x4*)(smem + NSA_Y))[d8 * NTHR + tid] = (f32x4){0.f, 0.f, 0.f, 0.f}; }
    if (NSAV & 1) {
    nsa_cmp_one(smem, st.qf[0][0], st.qf[0][1], qs + st.tl[0], i, gate[0][0], (f32x4*)(smem + NSA_Y) + tid, st.selm[0], lane);
    asm volatile("" ::: "memory");
    __builtin_amdgcn_sched_barrier(0);
    nsa_cmp_one(smem, st.qf[1][0], st.qf[1][1], qs + st.tl[1], i, gate[1][0], (f32x4*)(smem + NSA_Y) + 4 * NTHR + tid, st.selm[1], lane);
    __builtin_amdgcn_sched_barrier(0);
    }
    {
        unsigned u0 = st.selm[0], u1 = st.selm[1];
        u0 |= __shfl_xor(u0, 4); u0 |= __shfl_xor(u0, 8); u1 |= __shfl_xor(u1, 4); u1 |= __shfl_xor(u1, 8);
        st.tunion[0] = (unsigned)__builtin_amdgcn_readfirstlane((int)u0); st.tunion[1] = (unsigned)__builtin_amdgcn_readfirstlane((int)u1);
        const unsigned u = st.tunion[0] | st.tunion[1];
        st.wunion = u;
        unsigned* misc = (unsigned*)(smem + NSA_MISC);
        if (lane == 0) misc[wid] = u;
        __syncthreads();
        unsigned bu = 0u;
#pragma unroll
        for (int w = 0; w < 8; ++w) bu |= misc[w];
        st.bunion = bu;
    }
    if (NSAV & 2) nsa_stream<0>(smem, Pb, g, i, st, gate[0][1], gate[1][1], tid);
    if (NSAV & 4) nsa_stream<1>(smem, Pb, g, i, st, gate[0][2], gate[1][2], tid);
    bf16_t* mix = (bf16_t*)(p.ws + WS_MIX) + (long)b * SEQ * 1024;
#pragma unroll
    for (int mt = 0; mt < 2; ++mt) {
        bf16_t* op = mix + (long)(qs + st.tl[mt]) * 1024 + g * 256 + (fr & 3) * 64 + fq * 4;
#pragma unroll
        for (int dt = 0; dt < 4; ++dt) {
            const f32x4 yv = *((const f32x4*)(smem + NSA_Y) + (mt * 4 + dt) * NTHR + tid);
            u32x2 w; w.x = pk_bf16(yv[0], yv[1]); w.y = pk_bf16(yv[2], yv[3]);
            *(u32x2*)(op + dt * 16) = w;
        }
    }
    __syncthreads();
}

constexpr int ML_PITCH = 288;
constexpr int ML_Q = 0, ML_K = 18432, ML_V = 36864, ML_VW = 55296, ML_C = 73728, ML_N = 110592, ML_GB = 111104, ML_GA = 119296, ML_GMQ = 127488,
              ML_GS = 135680, ML_ST = 136192;

__device__ __forceinline__ float wave_incl_scan_add(float v, int lane) {
#pragma unroll
    for (int off = 1; off < 64; off <<= 1) { const float o = __shfl_up(v, off); if (lane >= off) v += o; }
    return v;
}
__device__ __forceinline__ float wave_incl_scan_max(float v, int lane) {
#pragma unroll
    for (int off = 1; off < 64; off <<= 1) { const float o = __shfl_up(v, off); if (lane >= off) v = fmaxf(v, o); }
    return v;
}
__device__ __forceinline__ float wave_max(float v) {
#pragma unroll
    for (int off = 32; off >= 1; off >>= 1) v = fmaxf(v, __shfl_xor(v, off));
    return v;
}

__device__ __forceinline__ void mlstm_scan(const Params& p, char* smem, int b, int h) {
    const char* ws = p.ws;
    int tid = threadIdx.x;
    asm volatile("" : "+v"(tid));
    const int lane = tid & 63, wid = __builtin_amdgcn_readfirstlane(tid >> 6), fr = lane & 15, fq = lane >> 4;
    const bf16_t* QK = (const bf16_t*)(ws + WS_QK) + (long)b * SEQ * 1024 + h * 128;
    const bf16_t* Pb = (const bf16_t*)(ws + WS_P) + (long)b * SEQ * PW;
    const float* psm = (const float*)(ws + WS_PSM) + (long)b * SEQ * 32;
    bf16_t* mix = (bf16_t*)(p.ws + WS_MIX) + (long)b * SEQ * 1024 + 512 + h * 128;
    float* GB = (float*)(smem + ML_GB); float* GA = (float*)(smem + ML_GA); float* GMQ = (float*)(smem + ML_GMQ);
    float* GS = (float*)(smem + ML_GS);
    float* NV = (float*)(smem + ML_N);
    float* ST = (float*)(smem + ML_ST);
    {
        const float ib = p.in[I_IBIAS][h], fb = p.in[I_FBIAS][h];
        for (int c = wid; c < 32; c += 8) {
            const int t = c * 64 + lane;
            const float ipre = psm[(long)t * 32 + 24 + h], fpre = psm[(long)t * 32 + 28 + h];
            const float li = ipre + ib;
            const float x = fpre + fb;
            const float lf = fminf(x, 0.f) - log1pf(__expf(-fabsf(x)));
            const float bb = wave_incl_scan_add(lf, lane);
            const float aa = li - bb;
            const float g = __shfl(bb, 63);
            const float pm = wave_incl_scan_max(aa, lane);
            const float mloc = wave_max(g + aa);
            GB[t] = bb; GA[t] = aa; GMQ[t] = pm;
            if (lane == 0) { GS[64 + c] = g; GS[96 + c] = mloc; }
        }
    }
    for (int e = tid; e < 36864 / 16; e += NTHR) *(u32x4*)(smem + ML_C + e * 16) = (u32x4){0u, 0u, 0u, 0u};
    if (tid < 128) NV[tid] = 0.f;
    __syncthreads();
    if (tid == 0) {
        float m = 0.f;
        for (int c = 0; c < 32; ++c) { GS[c] = m; const float mn = fmaxf(GS[64 + c] + m, GS[96 + c]); GS[32 + c] = mn; m = mn; }
    }
    __syncthreads();
    for (int t = tid; t < SEQ; t += NTHR) GMQ[t] = GB[t] + fmaxf(GS[t >> 6], GMQ[t]);
    __syncthreads();

    f32x4 Cacc[9];
#pragma unroll
    for (int c9 = 0; c9 < 9; ++c9) Cacc[c9] = (f32x4){0.f, 0.f, 0.f, 0.f};
    const int lrow = tid >> 4, lch = tid & 15;
    u32x4 rq[2], rk[2], rv[2];
#pragma unroll
    for (int i2 = 0; i2 < 2; ++i2) {
        const int row = lrow + 32 * i2;
        rq[i2] = *(const u32x4*)(QK + (long)row * 1024 + lch * 8);
        rk[i2] = *(const u32x4*)(QK + (long)row * 1024 + 512 + lch * 8);
        rv[i2] = *(const u32x4*)(Pb + (long)row * PW + PC_MV + h * 128 + lch * 8);
    }
    const int mt = wid >> 1, half = wid & 1;
#pragma unroll 1
    for (int c = 0; c < 32; ++c) {
        const float m_old = GS[c], m_new = GS[32 + c], gch = GS[64 + c];
#pragma unroll
        for (int i2 = 0; i2 < 2; ++i2) {
            const int row = lrow + 32 * i2;
            *(u32x4*)(smem + ML_Q + row * ML_PITCH + lch * 16) = rq[i2];
            *(u32x4*)(smem + ML_K + row * ML_PITCH + lch * 16) = rk[i2];
            *(u32x4*)(smem + ML_V + row * ML_PITCH + lch * 16) = rv[i2];
            const float wk = __expf(gch + GA[c * 64 + row] - m_new);
            u32x4 w;
            w.x = pk_bf16(bf_lo(rv[i2].x) * wk, bf_hi(rv[i2].x) * wk); w.y = pk_bf16(bf_lo(rv[i2].y) * wk, bf_hi(rv[i2].y) * wk);
            w.z = pk_bf16(bf_lo(rv[i2].z) * wk, bf_hi(rv[i2].z) * wk); w.w = pk_bf16(bf_lo(rv[i2].w) * wk, bf_hi(rv[i2].w) * wk);
            *(u32x4*)(smem + ML_VW + row * ML_PITCH + lch * 16) = w;
        }
        if (tid < 128) {
            const int row = tid >> 1, hf = tid & 1;
            const float wk = __expf(gch + GA[c * 64 + row] - m_new);
            u32x4 w = (u32x4){0u, 0u, 0u, 0u};
            if (hf == 0) w.x = pk_bf16(wk, 0.f);
            *(u32x4*)(smem + ML_VW + row * ML_PITCH + 256 + hf * 16) = w;
        }
        __syncthreads();
        if (c + 1 < 32) {
#pragma unroll
            for (int i2 = 0; i2 < 2; ++i2) {
                const int row = (c + 1) * 64 + lrow + 32 * i2;
                rq[i2] = *(const u32x4*)(QK + (long)row * 1024 + lch * 8);
                rk[i2] = *(const u32x4*)(QK + (long)row * 1024 + 512 + lch * 8);
                rv[i2] = *(const u32x4*)(Pb + (long)row * PW + PC_MV + h * 128 + lch * 8);
            }
        }
        const int l = 16 * mt + fr;
        const float bl = GB[c * 64 + l], mq = GMQ[c * 64 + l];
        const float ul = bl - mq;
        f32x4 hv[4];
        float s1 = 0.f, s2 = 0.f;
        {
            bf16x8 qf[4];
#pragma unroll
            for (int ks = 0; ks < 4; ++ks) qf[ks] = *(const bf16x8*)(smem + ML_Q + l * ML_PITCH + (ks * 4 + fq) * 16);
            f32x4 S[4];
#pragma unroll
            for (int nt = 0; nt < 4; ++nt) {
                f32x4 s = (f32x4){0.f, 0.f, 0.f, 0.f};
#pragma unroll
                for (int ks = 0; ks < 4; ++ks) {
                    const bf16x8 kf = *(const bf16x8*)(smem + ML_K + (16 * nt + fr) * ML_PITCH + (ks * 4 + fq) * 16);
                    s = mfma16(kf, qf[ks], s);
                }
                S[nt] = s;
            }
            float dintra = 0.f;
            const int lq = l - 4 * fq;
#pragma unroll
            for (int nt = 0; nt < 4; ++nt) {
                const f32x4 av = *(const f32x4*)(GA + c * 64 + 16 * nt + 4 * fq);
#pragma unroll
                for (int e = 0; e < 4; ++e) {
                    const float w = (16 * nt + e <= lq) ? __expf(ul + av[e]) : 0.f;
                    const float sv = S[nt][e] * w;
                    S[nt][e] = sv; dintra += sv;
                }
            }
            dintra = fq_sum(dintra);
            float dinter = 0.f;
#pragma unroll
            for (int ks = 0; ks < 4; ++ks) {
                const f32x4 n0 = *(const f32x4*)(NV + ks * 32 + fq * 8), n1 = *(const f32x4*)(NV + ks * 32 + fq * 8 + 4);
                const u32x4 qu = __builtin_bit_cast(u32x4, qf[ks]);
                dinter += bf_lo(qu.x) * n0[0] + bf_hi(qu.x) * n0[1] + bf_lo(qu.y) * n0[2] + bf_hi(qu.y) * n0[3]
                        + bf_lo(qu.z) * n1[0] + bf_hi(qu.z) * n1[1] + bf_lo(qu.w) * n1[2] + bf_hi(qu.w) * n1[3];
            }
            dinter = fq_sum(dinter);
            const float winter = __expf(ul + m_old);
            const float den = winter * dinter + dintra;
            const float rden = 1.0f / fmaxf(fabsf(den), __expf(-mq));
            const bf16x8 pf0 = pack_p(S[0], S[1]), pf1 = pack_p(S[2], S[3]);
#pragma unroll
            for (int c4 = 0; c4 < 4; ++c4) {
                const int et = 4 * half + c4;
                f32x4 num = (f32x4){0.f, 0.f, 0.f, 0.f}, inter = (f32x4){0.f, 0.f, 0.f, 0.f};
                num = mfma16(tr_frag_perm(smem + ML_V, ML_PITCH, 0, 16 * et, fr, fq), pf0, num);
                num = mfma16(tr_frag_perm(smem + ML_V, ML_PITCH, 32, 16 * et, fr, fq), pf1, num);
#pragma unroll
                for (int ks = 0; ks < 4; ++ks) {
                    const bf16x8 cf = *(const bf16x8*)(smem + ML_C + (16 * et + fr) * ML_PITCH + (ks * 4 + fq) * 16);
                    inter = mfma16(cf, qf[ks], inter);
                }
                const f32x4 hh = (inter * winter + num) * rden;
                hv[c4] = hh;
                s1 += (hh[0] + hh[1]) + (hh[2] + hh[3]);
                s2 += (hh[0] * hh[0] + hh[1] * hh[1]) + (hh[2] * hh[2] + hh[3] * hh[3]);
            }
            s1 = fq_sum(s1); s2 = fq_sum(s2);
            if (fq == 0) { ST[(l * 2 + half) * 2] = s1; ST[(l * 2 + half) * 2 + 1] = s2; }
        }
        {
            const float decay = __expf(gch + m_old - m_new);
#pragma unroll
            for (int c9 = 0; c9 < 9; ++c9) Cacc[c9] = Cacc[c9] * decay;
#pragma unroll
            for (int ks2 = 0; ks2 < 2; ++ks2) {
                const bf16x8 kt = tr_frag_std(smem + ML_K, ML_PITCH, 32 * ks2, 16 * wid, fr, fq);
#pragma unroll
                for (int c9 = 0; c9 < 9; ++c9) {
                    const bf16x8 vw = tr_frag_std(smem + ML_VW, ML_PITCH, 32 * ks2, 16 * c9, fr, fq);
                    Cacc[c9] = mfma16(kt, vw, Cacc[c9]);
                }
            }
        }
        __syncthreads();
        {
            const float* sp = ST + l * 4;
            const float t1 = sp[0] + sp[2], t2 = sp[1] + sp[3];
            const float mean = t1 * (1.0f / 128.0f);
            const float var = fmaxf(t2 * (1.0f / 128.0f) - mean * mean, 0.f);
            const float rstd = rsqrtf(var + LN_EPS);
            const long tok = c * 64 + l;
#pragma unroll
            for (int c4 = 0; c4 < 4; ++c4) {
                const int col = 64 * half + 16 * c4 + 4 * fq;
                const u32x2 ou = *(const u32x2*)(Pb + tok * PW + PC_MO + h * 128 + col);
                const f32x4 ng = *(const f32x4*)(p.in[I_NORMG] + h * 128 + col);
                const f32x4 y = (hv[c4] - mean) * rstd * ng;
                u32x2 w;
                w.x = pk_bf16(y[0] * sigmoidf_(bf_lo(ou.x)), y[1] * sigmoidf_(bf_hi(ou.x)));
                w.y = pk_bf16(y[2] * sigmoidf_(bf_lo(ou.y)), y[3] * sigmoidf_(bf_hi(ou.y)));
                *(u32x2*)(mix + tok * 1024 + col) = w;
            }
        }
#pragma unroll
        for (int c9 = 0; c9 < 8; ++c9) {
            u32x2 w; w.x = pk_bf16(Cacc[c9][0], Cacc[c9][1]); w.y = pk_bf16(Cacc[c9][2], Cacc[c9][3]);
            *(u32x2*)(smem + ML_C + (16 * c9 + fr) * ML_PITCH + (16 * wid + 4 * fq) * 2) = w;
        }
        if (fr == 0) *(f32x4*)(NV + 16 * wid + 4 * fq) = Cacc[8];
        __syncthreads();
    }
}


constexpr int CV_PITCH = 144;
__device__ __forceinline__ void wconv_task(const Params& p, char* smem, int which, int e, int nt) {
    const int tid = opaque_tid();
    const int ng = tid & 63, kg = tid >> 6, n0 = 4 * ng;
    const float* src; int ld, K; unsigned char* dst;
    if (which == 0) {
        const int col = 128 * nt + 32 * (n0 >> 6) + bperm32(n0 & 31);
        src = (((n0 >> 5) & 1) ? p.in[I_MW3] : p.in[I_MW1]) + (long)e * 1024 * 256 + col; ld = 256; K = 1024;
        dst = (unsigned char*)p.out + ((long)(e * 2 + nt) * 256) * 1024;
    } else {
        src = p.in[I_MW2] + (long)e * 256 * 1024 + nt * 256 + bperm32(n0); ld = 1024; K = 256;
        dst = (unsigned char*)(p.ws + WS_W2F8) + ((long)(e * 4 + nt) * 256) * 256;
    }
    for (int kc = 0; kc < K / 128; ++kc) {
        f32x4 v[16];
#pragma unroll
        for (int j = 0; j < 16; ++j) v[j] = *(const f32x4*)(src + (long)(kc * 128 + kg * 16 + j) * ld);
#pragma unroll
        for (int cc = 0; cc < 4; ++cc) {
            u32x4 w;
            w.x = pk4_fp8(v[0][cc] * W8_SCALE, v[1][cc] * W8_SCALE, v[2][cc] * W8_SCALE, v[3][cc] * W8_SCALE);
            w.y = pk4_fp8(v[4][cc] * W8_SCALE, v[5][cc] * W8_SCALE, v[6][cc] * W8_SCALE, v[7][cc] * W8_SCALE);
            w.z = pk4_fp8(v[8][cc] * W8_SCALE, v[9][cc] * W8_SCALE, v[10][cc] * W8_SCALE, v[11][cc] * W8_SCALE);
            w.w = pk4_fp8(v[12][cc] * W8_SCALE, v[13][cc] * W8_SCALE, v[14][cc] * W8_SCALE, v[15][cc] * W8_SCALE);
            *(u32x4*)(smem + (n0 + cc) * CV_PITCH + kg * 16) = w;
        }
        __syncthreads();
#pragma unroll
        for (int i = 0; i < 4; ++i) {
            const int piece = tid + i * NTHR, row = piece >> 3, ch = piece & 7;
            *(u32x4*)(dst + (long)row * K + kc * 128 + ch * 16) = *(const u32x4*)(smem + row * CV_PITCH + ch * 16);
        }
        __syncthreads();
    }
}

template <int PARTS = 7  , int NSAV = 7>
__device__ __forceinline__ void phase3(const Params& p, char* smem, int bid, int nb, int rep = 0) {
    XcdSlab xs; xs.init(bid, nb);
    const int nq = xs.x >= 0 ? 320 : 1024 + 1536;
    int* qctr = (int*)(p.ws + WS_CNT) + 16384 + ((xs.x >= 0 ? xs.x : 0) + 8 * rep) * 32;
    if (PARTS & 1) for (int u = bid; u < 64; u += nb) mlstm_scan(p, smem, u >> 2, u & 3);
    if (!(PARTS & 2)) return;
    volatile int* slot = (volatile int*)(smem + NSA_MISC + 256);
    for (;;) {
        if (opaque_tid() == 0) *slot = atomicAdd(qctr, 1);
        __syncthreads();
        const int k = __builtin_amdgcn_readfirstlane(*slot);
        if (k >= nq) break;
        if (xs.x >= 0) {
            const int r5 = k % 5, q5 = k / 5;
            if (r5 < 2) { const int kk = q5 * 2 + r5; const int bg = 4 * xs.x + (kk & 3); nsa_task<NSAV>(p, smem, bg >> 1, bg & 1, 31 - (kk >> 2)); }
            else if (PARTS & 4) { const int cv = q5 * 3 + (r5 - 2); const int e = xs.x + 8 * (cv / 6), t6 = cv % 6; wconv_task(p, smem, t6 < 2 ? 0 : 1, e, t6 < 2 ? t6 : t6 - 2); }
        } else if (k < 1024) nsa_task<NSAV>(p, smem, (k & 31) >> 1, k & 1, 31 - (k >> 5));
        else if (PARTS & 4) { const int cv = k - 1024; const int e = cv / 6, t6 = cv % 6; wconv_task(p, smem, t6 < 2 ? 0 : 1, e, t6 < 2 ? t6 : t6 - 2); }
    }
}

constexpr int XA_PITCH = 544;
constexpr int XA_K = 0, XA_V = 69632;
__device__ __forceinline__ void xattn_task(const Params& p, char* smem, int b, int h, int qb) {
    const char* ws = p.ws;
    int tid = threadIdx.x;
    asm volatile("" : "+v"(tid));
    const int lane = tid & 63, wid = __builtin_amdgcn_readfirstlane(tid >> 6), fr = lane & 15, fq = lane >> 4;
    const bf16_t* XQ = (const bf16_t*)(ws + WS_XQ) + (long)(b * SEQ + qb * 128 + wid * 16 + fr) * 1024 + h * 256 + fq * 8;
    const bf16_t* KV = (const bf16_t*)(ws + WS_KVX) + (long)b * 256 * 2048 + h * 256;
    bf16x8 qf[8];
#pragma unroll
    for (int ks = 0; ks < 8; ++ks) qf[ks] = *(const bf16x8*)(XQ + ks * 32);
    f32x4 O[16];
#pragma unroll
    for (int dt = 0; dt < 16; ++dt) O[dt] = (f32x4){0.f, 0.f, 0.f, 0.f};
    float m = -1e30f, l = 0.f;
    const int lrow = tid >> 5, lch = tid & 31;
    u32x4 rk[4], rv[4];
#pragma unroll
    for (int i2 = 0; i2 < 4; ++i2) {
        const bf16_t* rp = KV + (long)(lrow + 16 * i2) * 2048 + lch * 8;
        rk[i2] = *(const u32x4*)rp; rv[i2] = *(const u32x4*)(rp + 1024);
    }
#pragma unroll
    for (int i2 = 0; i2 < 4; ++i2) {
        *(u32x4*)(smem + XA_K + (lrow + 16 * i2) * XA_PITCH + lch * 16) = rk[i2];
        *(u32x4*)(smem + XA_V + (lrow + 16 * i2) * XA_PITCH + lch * 16) = rv[i2];
    }
    __syncthreads();
#pragma unroll 1
    for (int j = 0; j < 4; ++j) {
        const int buf = j & 1;
        if (j + 1 < 4) {
#pragma unroll
            for (int i2 = 0; i2 < 4; ++i2) {
                const bf16_t* rp = KV + (long)((j + 1) * 64 + lrow + 16 * i2) * 2048 + lch * 8;
                rk[i2] = *(const u32x4*)rp; rv[i2] = *(const u32x4*)(rp + 1024);
            }
        }
        const char* KT = smem + XA_K + buf * 34816;
        const char* VT = smem + XA_V + buf * 34816;
        f32x4 S[4];
#pragma unroll
        for (int nt = 0; nt < 4; ++nt) {
            f32x4 s = (f32x4){0.f, 0.f, 0.f, 0.f};
#pragma unroll
            for (int ks = 0; ks < 8; ++ks) {
                const bf16x8 kf = *(const bf16x8*)(KT + (16 * nt + fr) * XA_PITCH + (ks * 4 + fq) * 16);
                s = mfma16(kf, qf[ks], s);
            }
            S[nt] = s * 0.0625f;
        }
        float mx = -INFINITY;
#pragma unroll
        for (int nt = 0; nt < 4; ++nt)
#pragma unroll
            for (int e = 0; e < 4; ++e) mx = fmaxf(mx, S[nt][e]);
        mx = fq_max(mx);
        const float mnew = fmaxf(m, mx);
        const float alpha = __expf(m - mnew);
        float rs = 0.f;
#pragma unroll
        for (int nt = 0; nt < 4; ++nt)
#pragma unroll
            for (int e = 0; e < 4; ++e) { const float pv = __expf(S[nt][e] - mnew); S[nt][e] = pv; rs += pv; }
        rs = fq_sum(rs);
        l = l * alpha + rs; m = mnew;
#pragma unroll
        for (int dt = 0; dt < 16; ++dt) O[dt] = O[dt] * alpha;
        const bf16x8 pf0 = pack_p(S[0], S[1]), pf1 = pack_p(S[2], S[3]);
#pragma unroll
        for (int dt = 0; dt < 16; ++dt) {
            O[dt] = mfma16(tr_frag_perm(VT, XA_PITCH, 0, 16 * dt, fr, fq), pf0, O[dt]);
            O[dt] = mfma16(tr_frag_perm(VT, XA_PITCH, 32, 16 * dt, fr, fq), pf1, O[dt]);
        }
        if (j + 1 < 4) {
            char* KTn = smem + XA_K + (buf ^ 1) * 34816; char* VTn = smem + XA_V + (buf ^ 1) * 34816;
#pragma unroll
            for (int i2 = 0; i2 < 4; ++i2) {
                *(u32x4*)(KTn + (lrow + 16 * i2) * XA_PITCH + lch * 16) = rk[i2];
                *(u32x4*)(VTn + (lrow + 16 * i2) * XA_PITCH + lch * 16) = rv[i2];
            }
        }
        __syncthreads();
    }
    const float inv = 1.0f / l;
    bf16_t* op = (bf16_t*)(p.ws + WS_XO) + (long)(b * SEQ + qb * 128 + wid * 16 + fr) * 1024 + h * 256 + fq * 4;
#pragma unroll
    for (int dt = 0; dt < 16; ++dt) {
        u32x2 w; w.x = pk_bf16(O[dt][0] * inv, O[dt][1] * inv); w.y = pk_bf16(O[dt][2] * inv, O[dt][3] * inv);
        *(u32x2*)(op + dt * 16) = w;
    }
}

__device__ __forceinline__ void phase6(const Params& p, char* smem, int bid, int nb) {
    XcdSlab xs; xs.init(bid, nb);
    const int p_lo = xs.m_lo(64), n_t = (xs.m_hi(64) - p_lo) * 16;
    for (int u = xs.j; u < n_t; u += xs.stride) { const int pr = p_lo + (u >> 4); xattn_task(p, smem, pr >> 2, pr & 3, u & 15); }
}

constexpr int LN_ST = 139264, LN_GB = 141312, MOE_TAB = 153600;

template <class EPI>
__device__ __forceinline__ void dense_loop(char* smem, int bid, int nb, const bf16_t* A, int lda, const bf16_t* Bt, int nk, const EPI& epi) {
    XcdSlab xs; xs.init(bid, nb);
    const int m_lo = xs.m_lo(128), n_t = (xs.m_hi(128) - m_lo) * 4;
    int mt = 0, nt = 0;
    RingRows al, bl;
    auto setup = [&](int u) { mt = m_lo + (u >> 2); nt = u & 3; al.init_contig(A, lda, mt * 256); bl.init_contig(Bt, lda, nt * 256, true); };
    int u = xs.j;
    if (u < n_t) { setup(u); ring_issue3(smem, al, bl); }
    while (u < n_t) {
        const int cmt = mt, cnt_ = nt;
        f32x4 acc[8][4];
        gemm_ring<RingRows, RingRows, 0, true>(smem, al, bl, nk, acc);
        u += xs.stride;
        if (u < n_t) { setup(u); ring_issue3(smem, al, bl); }
        epi(acc, cmt, cnt_);
    }
    asm volatile("s_waitcnt vmcnt(0)" ::: "memory");
}

__device__ __forceinline__ void phase4(const Params& p, char* smem, int bid, int nb) {
    char* ws = p.ws;
    dense_loop(smem, bid, nb, (const bf16_t*)(ws + WS_MIX), 1024, (const bf16_t*)(ws + WS_WOUT), 32, [&](f32x4 (&acc)[8][4], int mt, int nt) {
        epi_residual<false>(acc, smem, p.in[I_X], nullptr, nullptr, nullptr, nullptr, (bf16_t*)(ws + WS_R1B), (float*)(ws + WS_ST1), mt * 256, nt);
    });
}

__device__ __forceinline__ void phase5(const Params& p, char* smem, int bid, int nb) {
    char* ws = p.ws;
    const float* lnf = (const float*)(ws + WS_LNF);
    dense_loop(smem, bid, nb, (const bf16_t*)(ws + WS_R1B), 1024, (const bf16_t*)(ws + WS_WQ), 32, [&](f32x4 (&acc)[8][4], int mt, int nt) {
        ln_correct<0>(acc, (const float*)(ws + WS_ST1), mt * 256, lnf, lnf + 1792, nt);
        epi_store_bf16(acc, (bf16_t*)(ws + WS_XQ), 1024, mt * 256, nt * 256);
    });
}

__device__ __forceinline__ void phase7(const Params& p, char* smem, int bid, int nb) {
    char* ws = p.ws;
    dense_loop(smem, bid, nb, (const bf16_t*)(ws + WS_XO), 1024, (const bf16_t*)(ws + WS_WO), 32, [&](f32x4 (&acc)[8][4], int mt, int nt) {
        epi_residual<true>(acc, smem, nullptr, (const bf16_t*)(ws + WS_R1B), (const float*)(ws + WS_ST1), p.in[I_LN1G], p.in[I_LN1B],
                           (bf16_t*)(ws + WS_R2B), (float*)(ws + WS_ST2), mt * 256, nt);
    });
}

template <class RowMap>
__device__ __forceinline__ void epi_swiglu(const f32x4 (&acc)[8][4], bf16_t* out, int ld, int nt, const RowMap& rm) {
    const int tid_ = opaque_tid();
    const int lane = tid_ & 63, wid = tid_ >> 6;
    const int wr = wid >> 2, wc = wid & 3, fr = lane & 15, fq = lane >> 4;
#pragma unroll
    for (int mi = 0; mi < 8; ++mi) {
        const long orow = rm(wr * 128 + mi * 16 + fr);
        if (orow >= 0) {
            const f32x4 a0 = acc[mi][0], b0 = acc[mi][1], a1 = acc[mi][2], b1 = acc[mi][3];
            u32x4 w;
            w.x = pk_bf16(siluf_(a0[0]) * b0[0], siluf_(a0[1]) * b0[1]); w.y = pk_bf16(siluf_(a0[2]) * b0[2], siluf_(a0[3]) * b0[3]);
            w.z = pk_bf16(siluf_(a1[0]) * b1[0], siluf_(a1[1]) * b1[1]); w.w = pk_bf16(siluf_(a1[2]) * b1[2], siluf_(a1[3]) * b1[3]);
            *(u32x4*)(out + orow * ld + nt * 128 + wc * 32 + fq * 8) = w;
        }
    }
}
struct RowIdent { long row0; __device__ __forceinline__ long operator()(int rl) const { return row0 + rl; } };

__device__ __forceinline__ unsigned dpp_xor1_u(unsigned v) { return (unsigned)__builtin_amdgcn_mov_dpp((int)v, 0xB1, 0xF, 0xF, true); }
__device__ __forceinline__ void route_tile(const Params& p, char* smem, int tok0, int rep) {
    char* ws = p.ws;
    const float* bias = p.in[I_ROUTB];
    const int tid = opaque_tid(), tk = tid >> 1, hf = tid & 1;
    const float* row = (const float*)(ws + WS_RSC) + (long)(tok0 + tk) * 256;
    unsigned key[128];
    float gs[4];
    {
        float v[128];
#pragma unroll
        for (int i = 0; i < 32; ++i) { const f32x4 t = *(const f32x4*)(row + hf * 128 + i * 4); v[4 * i] = t[0]; v[4 * i + 1] = t[1]; v[4 * i + 2] = t[2]; v[4 * i + 3] = t[3]; }
#pragma unroll
        for (int gi = 0; gi < 4; ++gi) {
            float m1 = -INFINITY, m2 = -INFINITY;
#pragma unroll
            for (int i = 0; i < 32; ++i) { const float x = v[32 * gi + i]; m2 = __builtin_fmaxf(m2, __builtin_fminf(m1, x)); m1 = __builtin_fmaxf(m1, x); }
            gs[gi] = m1 + m2;
        }
        float g8[8];
#pragma unroll
        for (int gi = 0; gi < 4; ++gi) { const float o = dpp_xor1(gs[gi]); g8[gi] = hf ? o : gs[gi]; g8[4 + gi] = hf ? gs[gi] : o; }
        unsigned gsel = 0u;
#pragma unroll
        for (int a = 0; a < 8; ++a) {
            int rank = 0;
#pragma unroll
            for (int b = 0; b < 8; ++b) rank += (g8[b] > g8[a] || (g8[b] == g8[a] && b < a)) ? 1 : 0;
            if (rank < 4) gsel |= 1u << a;
        }
#pragma unroll
        for (int gi = 0; gi < 4; ++gi) {
            const bool on = ((gsel >> (4 * hf + gi)) & 1u) != 0u;
#pragma unroll
            for (int i = 0; i < 32; ++i) {
                const unsigned kb = (__float_as_uint(v[32 * gi + i] + 1.0f) & ~0xFFu) | (unsigned)(255 - (128 * hf + 32 * gi + i));
                key[32 * gi + i] = on ? kb : 0u;
            }
        }
    }
    unsigned win[8];
    unsigned prev = 0xFFFFFFFFu;
#pragma unroll
    for (int r = 0; r < 8; ++r) {
        unsigned m = 0u;
#pragma unroll
        for (int i = 0; i < 128; ++i) { const unsigned kk = key[i]; const unsigned c = kk < prev ? kk : 0u; m = m > c ? m : c; }
        const unsigned o = dpp_xor1_u(m);
        m = m > o ? m : o;
        prev = m;
        win[r] = m;
    }
    float sc8[8]; float wsum = 0.f;
#pragma unroll
    for (int r = 0; r < 8; ++r) { const int e = 255 - (int)(win[r] & 255u); sc8[r] = row[e] - bias[e]; wsum += sc8[r]; }
    int* lc = (int*)(smem + MOE_TAB); int* gbase = lc + 256;
    if (tid < 256) lc[tid] = 0;
    __syncthreads();
    int mye[4], myr[4];
    const unsigned hmask = 0u - (unsigned)hf;
#pragma unroll
    for (int u = 0; u < 4; ++u) {
        const unsigned w = win[u] ^ ((win[u] ^ win[4 + u]) & hmask);
        mye[u] = 255 - (int)(w & 255u); myr[u] = atomicAdd(lc + mye[u], 1);
    }
    __syncthreads();
    if (tid < 256) { const int n = lc[tid]; if (n > 0) gbase[tid] = atomicAdd((int*)(ws + WS_CNT) + 8192 * rep + tid * 32, n); }
    __syncthreads();
    {
        const long t = tok0 + tk;
        const float wn = 2.5f / wsum;
#pragma unroll
        for (int u = 0; u < 4; ++u) {
            const int k = 4 * hf + u;
            const int e = mye[u];
            const unsigned s0 = __float_as_uint(sc8[u]), s1 = __float_as_uint(sc8[4 + u]);
            const float w = __uint_as_float(s0 ^ ((s0 ^ s1) & hmask)) * wn;
            const int pos = gbase[e] + myr[u];
            ((int*)(ws + WS_SELE))[t * 8 + k] = e;
            ((int*)(ws + WS_SELP))[t * 8 + k] = pos;
            ((float*)(ws + WS_SELW))[t * 8 + k] = w;
            ((int*)(ws + WS_TOKL))[(long)e * LIST_CAP + pos] = (int)t;
            ((float*)(ws + WS_WL))[(long)e * LIST_CAP + pos] = w;
        }
    }
    __syncthreads();
}

__device__ __forceinline__ void phase8(const Params& p, char* smem, int bid, int nb, int rep = 0) {
    char* ws = p.ws;
    const float* lnf = (const float*)(ws + WS_LNF);
    XcdSlab xs; xs.init(bid, nb);
    const int m_lo = xs.m_lo(128), m_n = xs.m_hi(128) - m_lo;
    for (int u = xs.j; u < m_n; u += xs.stride) {
        const int mt = m_lo + u;
        float* gsc = (float*)(ws + WS_RSC);
        {
            RingRows al, bl;
            al.init_contig((const bf16_t*)(ws + WS_R2B), 1024, mt * 256);
            bl.init_contig((const bf16_t*)(ws + WS_WR), 1024, 0, true);
            f32x4 acc[8][4];
            gemm_ring(smem, al, bl, 32, acc);
            ln_correct<0>(acc, (const float*)(ws + WS_ST2), mt * 256, lnf + 1024, lnf + 1792 + 1024, 0);
            const int tid_ = opaque_tid();
            const int lane = tid_ & 63, wid = tid_ >> 6;
            const int wr = wid >> 2, wc = wid & 3, fr = lane & 15, fq = lane >> 4;
            const float* bias = p.in[I_ROUTB];
#pragma unroll
            for (int ni = 0; ni < 4; ++ni) {
                const int col = wc * 64 + (ni >> 1) * 32 + fq * 8 + (ni & 1) * 4;
                const f32x4 bv = *(const f32x4*)(bias + col);
#pragma unroll
                for (int mi = 0; mi < 8; ++mi) {
                    f32x4 v;
#pragma unroll
                    for (int e = 0; e < 4; ++e) v[e] = sigmoidf_(acc[mi][ni][e]) + bv[e];
                    *(f32x4*)(gsc + (long)(mt * 256 + wr * 128 + mi * 16 + fr) * 256 + col) = v;
                }
            }
        }
        __syncthreads();
        route_tile(p, smem, mt * 256, rep);
    }
    for (int u = (xs.j + xs.stride - m_n % xs.stride) % xs.stride; u < m_n * 2; u += xs.stride) {
        const int mt = m_lo + (u >> 1), nt = u & 1;
        RingRows al, bl;
        al.init_contig((const bf16_t*)(ws + WS_R2B), 1024, mt * 256);
        bl.init_contig((const bf16_t*)(ws + WS_WS13), 1024, nt * 256);
        f32x4 acc[8][4];
        gemm_ring(smem, al, bl, 32, acc);
        ln_correct<1>(acc, (const float*)(ws + WS_ST2), mt * 256, lnf + 1280, lnf + 1792 + 1280, nt);
        RowIdent rm; rm.row0 = (long)mt * 256;
        epi_swiglu(acc, (bf16_t*)(ws + WS_HS), 256, nt, rm);
    }
    {
        const int tid = opaque_tid(), lane = tid & 63, wid = tid >> 6;
        const bf16_t* r2 = (const bf16_t*)(ws + WS_R2B); const float* st2 = (const float*)(ws + WS_ST2);
        unsigned char* x2 = (unsigned char*)(ws + WS_X2F8);
        for (int t = bid * 8 + wid; t < T_TOK; t += nb * 8) {
            const f32x4 p0 = *(const f32x4*)(st2 + (long)t * 8), p1 = *(const f32x4*)(st2 + (long)t * 8 + 4);
            const float q1 = (p0[0] + p0[2]) + (p1[0] + p1[2]), q2 = (p0[1] + p0[3]) + (p1[1] + p1[3]);
            const float mean = q1 * (1.0f / 1024.0f);
            const float rstd = rsqrtf(fmaxf(q2 * (1.0f / 1024.0f) - mean * mean, 0.f) + LN_EPS);
#pragma unroll
            for (int hseg = 0; hseg < 2; ++hseg) {
                const int col = hseg * 512 + lane * 8;
                const u32x4 ru = *(const u32x4*)(r2 + (long)t * 1024 + col);
                const f32x4 a0 = (f32x4){bf_lo(ru.x), bf_hi(ru.x), bf_lo(ru.y), bf_hi(ru.y)}, a1 = (f32x4){bf_lo(ru.z), bf_hi(ru.z), bf_lo(ru.w), bf_hi(ru.w)};
                const f32x4 g0 = *(const f32x4*)(p.in[I_LN2G] + col), g1 = *(const f32x4*)(p.in[I_LN2G] + col + 4);
                const f32x4 b0 = *(const f32x4*)(p.in[I_LN2B] + col), b1 = *(const f32x4*)(p.in[I_LN2B] + col + 4);
                const f32x4 y0 = (a0 - mean) * rstd * g0 + b0, y1 = (a1 - mean) * rstd * g1 + b1;
                u32x2 w; w.x = pk4_fp8(y0[0], y0[1], y0[2], y0[3]); w.y = pk4_fp8(y1[0], y1[1], y1[2], y1[3]);
                *(u32x2*)(x2 + (long)t * 1024 + col) = w;
            }
        }
    }
}

template <int XMODE>
__device__ __forceinline__ void phase_probe(const Params& p, char* smem, int bid, int nb) {
    char* ws = p.ws;
    XcdSlab xs; xs.init(bid, nb);
    const int m_lo = xs.m_lo(128), n_t = (xs.m_hi(128) - m_lo) * 4;
    for (int u = xs.j; u < n_t; u += xs.stride) {
        const int mt = m_lo + (u >> 2), nt = u & 3;
        RingRows al, bl;
        al.init_contig((const bf16_t*)(ws + WS_MIX), 1024, mt * 256);
        bl.init_contig((const bf16_t*)(ws + WS_WOUT), 1024, nt * 256, true);
        f32x4 acc[8][4];
        gemm_ring<RingRows, RingRows, XMODE>(smem, al, bl, 32, acc);
        epi_store_bf16(acc, (bf16_t*)(ws + WS_A + 432 * MB), 1024, mt * 256, nt * 256);
    }
}

__device__ __forceinline__ void moe_tables(const Params& p, char* smem, const XcdSlab& xs) {
    int* off = (int*)(smem + MOE_TAB); int* tst = off + 256; int* cntl = tst + 260;
    const int* cnt = (const int*)(p.ws + WS_CNT);
    const int tid = opaque_tid();
    if (tid >= 256) cntl[tid - 256] = cnt[(tid - 256) * 32];
    if (tid < 64) {
        int c[4], cs = 0;
#pragma unroll
        for (int k = 0; k < 4; ++k) { c[k] = cnt[(tid * 4 + k) * 32]; cs += c[k]; }
        int ics = cs;
#pragma unroll
        for (int o = 1; o < 64; o <<= 1) { const int a = __shfl_up(ics, o); if (tid >= o) ics += a; }
        int eo = ics - cs;
#pragma unroll
        for (int k = 0; k < 4; ++k) { off[tid * 4 + k] = eo; eo += c[k]; }
    } else if (tid < 128) {
        const int l = tid - 64;
        if (xs.x >= 0) {
            const int tl = l < 32 ? ((cnt[(xs.x + 8 * l) * 32] + 255) >> 8) : 0;
            int it = tl;
#pragma unroll
            for (int o = 1; o < 64; o <<= 1) { const int a = __shfl_up(it, o); if (l >= o) it += a; }
            if (l < 32) tst[l] = it - tl;
            if (l == 31) tst[32] = it;
        } else {
            int c[4], ts = 0;
#pragma unroll
            for (int k = 0; k < 4; ++k) { c[k] = (cnt[(l * 4 + k) * 32] + 255) >> 8; ts += c[k]; }
            int its = ts;
#pragma unroll
            for (int o = 1; o < 64; o <<= 1) { const int a = __shfl_up(its, o); if (l >= o) its += a; }
            int et = its - ts;
#pragma unroll
            for (int k = 0; k < 4; ++k) { tst[l * 4 + k] = et; et += c[k]; }
            if (l == 63) tst[256] = its;
        }
    }
    __syncthreads();
}
__device__ __forceinline__ int moe_find(const int* tst, int nloc, int t) {
    int lo = 0, hi = nloc - 1;
#pragma unroll 1
    while (lo < hi) { const int mid = (lo + hi + 1) >> 1; if (tst[mid] <= t) lo = mid; else hi = mid - 1; }
    return lo;
}
struct RowMoe { long base; int nvalid; __device__ __forceinline__ long operator()(int rl) const { return rl < nvalid ? base + rl : -1; } };

template <int PARTS9 = 3>
__device__ __forceinline__ void phase9(const Params& p, char* smem, int bid, int nb) {
    char* ws = p.ws;
    XcdSlab xs; xs.init(bid, nb);
    moe_tables(p, smem, xs);
    const int* off = (const int*)(smem + MOE_TAB); const int* tst = off + 256;
    const int* cnt = (const int*)(ws + WS_CNT);
    const int nloc = xs.x >= 0 ? 32 : 256;
    const int ntile = tst[nloc];
    {
        const int* cntl = tst + 260;
        const int nT = ntile * 2;
        int t = xs.j;
        int e = 0, m0 = 0, ne = 0, nt = 0;
        RingF8 al, bl;
        auto setup = [&](int tt) {
            const int et = tt >> 1; nt = tt & 1;
            const int kl = moe_find(tst, nloc, et); e = xs.x >= 0 ? xs.x + 8 * kl : kl; m0 = (et - tst[kl]) * 256; ne = cntl[e];
            const int tid = opaque_tid();
            const int* tl = (const int*)(ws + WS_TOKL) + (long)e * LIST_CAP;
            int rows[2];
#pragma unroll
            for (int i = 0; i < 2; ++i) { const int r = m0 + (tid >> 2) + 128 * i; rows[i] = r < ne ? tl[r] : 0; }
            al.init_rows((const unsigned char*)(ws + WS_X2F8), 1024, rows);
            bl.init_contig((const unsigned char*)p.out, 1024, (long)(e * 2 + nt) * 256);
        };
        if (!(PARTS9 & 1)) t = nT;
        if (t < nT) { setup(t); ring_f8_issue3(smem, al, bl); }
        while (t < nT) {
            const int ce = e, cm0 = m0, cne = ne, cnt_ = nt;
            f32x16 acc[4][2];
            gemm_ring_mx_main(smem, al, bl, 16, acc);
            t += xs.stride;
            if (t < nT) { setup(t); ring_f8_issue3(smem, al, bl); }
            {
                const int tid2 = opaque_tid();
                const int lane = tid2 & 63, wid = tid2 >> 6;
                const int wr = wid >> 2, wc = wid & 3, r = lane & 31, h = lane >> 5;
                unsigned char* H = (unsigned char*)(ws + WS_HF8) + ((long)off[ce] + cm0) * 256 + cnt_ * 128 + wc * 32 + h * 16;
                constexpr float D = 1.0f / W8_SCALE, HS = H8_SCALE / W8_SCALE;
#pragma unroll
                for (int mi = 0; mi < 4; ++mi) {
                    const int rl = wr * 128 + mi * 32 + r;
                    if (cm0 + rl < cne) {
                        float o[16];
#pragma unroll
                        for (int q = 0; q < 16; ++q) o[q] = siluf_(acc[mi][0][q] * D) * (acc[mi][1][q] * HS);
                        u32x4 w; w.x = pk4_fp8(o[0], o[1], o[2], o[3]); w.y = pk4_fp8(o[4], o[5], o[6], o[7]); w.z = pk4_fp8(o[8], o[9], o[10], o[11]); w.w = pk4_fp8(o[12], o[13], o[14], o[15]);
                        *(u32x4*)(H + (long)rl * 256) = w;
                    }
                }
            }
        }
        asm volatile("s_waitcnt vmcnt(0)" ::: "memory"); __syncthreads();
    }
    const int m_lo = xs.m_lo(128), n_t = (PARTS9 & 2) ? (xs.m_hi(128) - m_lo) * 4 : 0;
    for (int u = (xs.j + xs.stride - (ntile * 2) % xs.stride) % xs.stride; u < n_t; u += xs.stride) {
        const int mt = m_lo + (u >> 2), nt = u & 3;
        RingRows al, bl;
        al.init_contig((const bf16_t*)(ws + WS_HS), 256, mt * 256);
        bl.init_contig((const bf16_t*)(ws + WS_WS2), 256, nt * 256, true);
        f32x4 acc[8][4];
        gemm_ring(smem, al, bl, 8, acc);
        __syncthreads();
        epi_store_bf16(acc, (bf16_t*)(ws + WS_SH), 1024, mt * 256, nt * 256);
    }
}

template <int P10V = 0  >
__device__ __forceinline__ void phase10(const Params& p, char* smem, int bid, int nb) {
    char* ws = p.ws;
    XcdSlab xs; xs.init(bid, nb);
    moe_tables(p, smem, xs);
    const int* off = (const int*)(smem + MOE_TAB); const int* tst = off + 256;
    const int* cnt = (const int*)(ws + WS_CNT);
    const int nloc = xs.x >= 0 ? 32 : 256;
    const int ntile = tst[nloc];
    {
        const int* cntl = tst + 260;
        const int nT = ntile;
        const int tid_ = opaque_tid();
        const int lane = tid_ & 63, wid = __builtin_amdgcn_readfirstlane(tid_ >> 6);
        const int wr = wid >> 2, wc = wid & 3, r = lane & 31, h = lane >> 5;
        const int g = (r >> 2) & 3;
        const int c0 = ((2 * h) ^ g) << 4, c1 = ((2 * h + 1) ^ g) << 4;
        const int arow = (wr * 128 + r) * 64;
        const int brow = (wc * 64 + r) * 64;
        char* ringB = smem + 65536;
        for (int t = xs.j; t < nT; t += xs.stride) {
            const int kl = moe_find(tst, nloc, t), e = xs.x >= 0 ? xs.x + 8 * kl : kl, m0 = (t - tst[kl]) * 256, ne = cntl[e];
            RingF8 al, bl;
            al.init_contig((const unsigned char*)(ws + WS_HF8), 256, (long)off[e] + m0);
            bl.init_contig((const unsigned char*)(ws + WS_W2F8), 256, (long)(e * 4) * 256);
            const float* wl = (const float*)(ws + WS_WL) + (long)e * LIST_CAP + m0;
            float* rwl = (float*)(smem + MOE_TAB + 4096);
            if (tid_ < 256) rwl[tid_] = (m0 + tid_ < ne) ? wl[tid_] * (Y8_SCALE / (W8_SCALE * H8_SCALE)) : 0.f;
            unsigned char* Yb = (unsigned char*)(ws + WS_Y) + ((long)off[e] + m0) * 1024 + wc * 64 + h * 16;
#pragma unroll
            for (int ks = 0; ks < 4; ++ks) al.issue(smem + ks * 16384, ks);
            auto issueB = [&](int bt, int stg) {
                const int nt_ = bt >> 2, ks_ = bt & 3;
                char* s = ringB + stg * 16384;
#pragma unroll
                for (int i = 0; i < 2; ++i)
                    __builtin_amdgcn_global_load_lds((glb_u32*)(bl.base + (size_t)(bl.off[i] + (unsigned)(nt_ * 65536 + ks_ * 64))), (lds_u32*)(s + i * 8192 + bl.ldst), 16, 0, 0);
            };
            issueB(0, 0); issueB(1, 1); issueB(2, 2); issueB(3, 3);
            RING_WAIT(6);
            RING_BAR();
            if (wr == 1) RING_BAR();
            f32x16 acc[4][2];
#pragma unroll
            for (int mi = 0; mi < 4; ++mi)
#pragma unroll
                for (int nj = 0; nj < 2; ++nj)
#pragma unroll
                    for (int q = 0; q < 16; ++q) acc[mi][nj][q] = 0.f;
            int sg = 0;
#pragma unroll 1
            for (int bt = 0; bt < 16; ++bt) {
                const char* sa = smem + (bt & 3) * 16384;
                const char* sb = ringB + sg * 16384;
                { const int s4 = sg == 0 ? 4 : sg - 1; if (bt + 4 < 16) issueB(bt + 4, s4); }
                i32x8 bf[2], af[4];
#pragma unroll
                for (int nj = 0; nj < 2; ++nj) bf[nj] = mx_frag(sb + brow + nj * 2048, c0, c1);
#pragma unroll
                for (int mi = 0; mi < 4; ++mi) af[mi] = mx_frag(sa + arow + mi * 2048, c0, c1);
                if (bt + 1 < 16) { if (bt + 4 < 16) RING_WAIT(6); else if (bt + 3 < 16) RING_WAIT(4); else if (bt + 2 < 16) RING_WAIT(2); else RING_WAIT(0); }
                RING_BAR();
                __builtin_amdgcn_s_setprio(1);
                if (P10V != 2) {
#pragma unroll
                for (int mi = 0; mi < 4; ++mi)
#pragma unroll
                    for (int nj = 0; nj < 2; ++nj) acc[mi][nj] = mfma_mx(bf[nj], af[mi], acc[mi][nj]);
                } else { acc[0][0][0] += (float)(af[0][0] + bf[0][0] + af[3][7] + bf[1][3]); }
                __builtin_amdgcn_s_setprio(0);
                if ((bt & 3) == 3) {
                    const int nt_ = bt >> 2;
#pragma unroll
                    for (int mi = 0; mi < 4; ++mi) {
                        const int rl = wr * 128 + mi * 32 + r;
                        if (m0 + rl < ne) {
                            const float w = rwl[rl];
#pragma unroll
                            for (int nj = 0; nj < 2; ++nj) {
                                const f32x16 u = acc[mi][nj] * w;
                                u32x4 v; v.x = pk4_fp8(u[0], u[1], u[2], u[3]); v.y = pk4_fp8(u[4], u[5], u[6], u[7]); v.z = pk4_fp8(u[8], u[9], u[10], u[11]); v.w = pk4_fp8(u[12], u[13], u[14], u[15]);
                                if (P10V != 1) *(u32x4*)(Yb + (long)rl * 1024 + nt_ * 256 + nj * 32) = v; else if (v.x == 0x12345678u) *(u32x4*)(Yb) = v;
                            }
                        }
#pragma unroll
                        for (int nj = 0; nj < 2; ++nj)
#pragma unroll
                            for (int q = 0; q < 16; ++q) acc[mi][nj][q] = 0.f;
                    }
                }
                RING_BAR();
                sg = sg == 4 ? 0 : sg + 1;
            }
            if (wr == 0) RING_BAR();
        }
    }
}

__device__ __forceinline__ void phase11(const Params& p, char* smem, int bid, int nb) {
    char* ws = p.ws;
    XcdSlab xs; xs.init(bid, nb);
    moe_tables(p, smem, xs);
    const int* off = (const int*)(smem + MOE_TAB);
    const int tid = opaque_tid(), lane = tid & 63, wid = tid >> 6;
    const bf16_t* r2 = (const bf16_t*)(ws + WS_R2B);
    const float* st2 = (const float*)(ws + WS_ST2);
    const bf16_t* SH = (const bf16_t*)(ws + WS_SH);
    const unsigned char* Y = (const unsigned char*)(ws + WS_Y);
    const int* sele = (const int*)(ws + WS_SELE); const int* selp = (const int*)(ws + WS_SELP);
    for (int t = bid * 8 + wid; t < T_TOK; t += nb * 8) {
        const f32x4 p0 = *(const f32x4*)(st2 + (long)t * 8), p1 = *(const f32x4*)(st2 + (long)t * 8 + 4);
        const float q1 = (p0[0] + p0[2]) + (p1[0] + p1[2]), q2 = (p0[1] + p0[3]) + (p1[1] + p1[3]);
        const float mean2 = q1 * (1.0f / 1024.0f);
        const float rstd2 = rsqrtf(fmaxf(q2 * (1.0f / 1024.0f) - mean2 * mean2, 0.f) + LN_EPS);
        int yrow[8];
#pragma unroll
        for (int k = 0; k < 8; ++k) yrow[k] = off[sele[(long)t * 8 + k]] + selp[(long)t * 8 + k];
        float v[16];
#pragma unroll
        for (int hseg = 0; hseg < 2; ++hseg) {
            const int col = hseg * 512 + lane * 8;
            const u32x4 ru = *(const u32x4*)(r2 + (long)t * 1024 + col);
            const f32x4 a0 = (f32x4){bf_lo(ru.x), bf_hi(ru.x), bf_lo(ru.y), bf_hi(ru.y)}, a1 = (f32x4){bf_lo(ru.z), bf_hi(ru.z), bf_lo(ru.w), bf_hi(ru.w)};
            const f32x4 g0 = *(const f32x4*)(p.in[I_LN2G] + col), g1 = *(const f32x4*)(p.in[I_LN2G] + col + 4);
            const f32x4 b0 = *(const f32x4*)(p.in[I_LN2B] + col), b1 = *(const f32x4*)(p.in[I_LN2B] + col + 4);
            const f32x4 x0 = ((a0 - mean2) * rstd2 * g0 + b0) * ALPHA, x1 = ((a1 - mean2) * rstd2 * g1 + b1) * ALPHA;
            float* vv = v + hseg * 8;
            vv[0] = x0[0]; vv[1] = x0[1]; vv[2] = x0[2]; vv[3] = x0[3]; vv[4] = x1[0]; vv[5] = x1[1]; vv[6] = x1[2]; vv[7] = x1[3];
            const u32x4 s = *(const u32x4*)(SH + (long)t * 1024 + col);
            vv[0] += bf_lo(s.x); vv[1] += bf_hi(s.x); vv[2] += bf_lo(s.y); vv[3] += bf_hi(s.y); vv[4] += bf_lo(s.z); vv[5] += bf_hi(s.z); vv[6] += bf_lo(s.w); vv[7] += bf_hi(s.w);
            f32x2 ys[4];
#pragma unroll
            for (int e2 = 0; e2 < 4; ++e2) ys[e2] = (f32x2){0.f, 0.f};
#pragma unroll
            for (int k = 0; k < 8; ++k) {
                const u32x2 y = *(const u32x2*)(Y + (long)yrow[k] * 1024 + col);
                ys[0] += __builtin_amdgcn_cvt_pk_f32_fp8((int)y.x, false); ys[1] += __builtin_amdgcn_cvt_pk_f32_fp8((int)y.x, true);
                ys[2] += __builtin_amdgcn_cvt_pk_f32_fp8((int)y.y, false); ys[3] += __builtin_amdgcn_cvt_pk_f32_fp8((int)y.y, true);
            }
#pragma unroll
            for (int e2 = 0; e2 < 4; ++e2) { vv[2 * e2] += ys[e2][0] * (1.0f / Y8_SCALE); vv[2 * e2 + 1] += ys[e2][1] * (1.0f / Y8_SCALE); }
        }
        float s1 = 0.f;
#pragma unroll
        for (int i = 0; i < 16; ++i) s1 += v[i];
#pragma unroll
        for (int o = 32; o >= 1; o >>= 1) s1 += __shfl_xor(s1, o);
        const float mean = s1 * (1.0f / 1024.0f);
        float s2 = 0.f;
#pragma unroll
        for (int i = 0; i < 16; ++i) { const float d = v[i] - mean; s2 += d * d; }
#pragma unroll
        for (int o = 32; o >= 1; o >>= 1) s2 += __shfl_xor(s2, o);
        const float rstd = rsqrtf(s2 * (1.0f / 1024.0f) + LN_EPS);
#pragma unroll
        for (int hseg = 0; hseg < 2; ++hseg) {
            const int col = hseg * 512 + lane * 8;
            const f32x4 g0 = *(const f32x4*)(p.in[I_LN3G] + col), g1 = *(const f32x4*)(p.in[I_LN3G] + col + 4);
            const f32x4 b0 = *(const f32x4*)(p.in[I_LN3B] + col), b1 = *(const f32x4*)(p.in[I_LN3B] + col + 4);
            const float* vv = v + hseg * 8;
            f32x4 o0, o1;
#pragma unroll
            for (int e = 0; e < 4; ++e) { o0[e] = (vv[e] - mean) * rstd * g0[e] + b0[e]; o1[e] = (vv[4 + e] - mean) * rstd * g1[e] + b1[e]; }
            *(f32x4*)(p.out + (long)t * 1024 + col) = o0; *(f32x4*)(p.out + (long)t * 1024 + col + 4) = o1;
        }
    }
}

#if MEGA
#define XB_TMO      128
#define XB_XCNT(j)  (256  + 64 * (j))
#define XB_XSUB(j)  (1280 + 64 * (j))
#define XB_XGEN(j)  (2304 + 64 * (j))
#define XB_TOP      3328
#define XB_TOPGEN   3392
#define XCD_BAR_WORDS 3456
#define XB_SPIN_CAP (1u << 22)
#define LAS __attribute__((address_space(3)))
__device__ __forceinline__ unsigned xb_ld(unsigned* p)              { return __hip_atomic_load(p, __ATOMIC_RELAXED, __HIP_MEMORY_SCOPE_AGENT); }
__device__ __forceinline__ unsigned xb_add(unsigned* p, unsigned v) { return __hip_atomic_fetch_add(p, v, __ATOMIC_RELAXED, __HIP_MEMORY_SCOPE_AGENT); }
__device__ __forceinline__ unsigned xb_xcc_id() { return (unsigned)__builtin_amdgcn_s_getreg((3 << 11) | 20) & 0xFu; }
#define XB_SPIN(cond, bar) do { unsigned _sp = 0; while (cond) { __builtin_amdgcn_s_sleep(1); \
    if ((++_sp & 255u) == 0u) { if (xb_ld(&(bar)[XB_TMO])) break; if (_sp > XB_SPIN_CAP) { atomicAdd(&(bar)[XB_TMO], 1u); break; } } } } while (0)
struct XcdBarrier { unsigned* bar; unsigned x; volatile LAS unsigned* st; };
__device__ __forceinline__ XcdBarrier xcd_barrier_post(unsigned* bar, volatile LAS unsigned* st) {
    XcdBarrier b; b.bar = bar; b.x = xb_xcc_id(); b.st = st;
    if (threadIdx.x == 0) (void)xb_add(&bar[XB_XCNT(b.x)], 1u);
    return b;
}
__device__ __forceinline__ void xcd_barrier_complete(unsigned* bar, unsigned x, unsigned& nloc, unsigned& nx) {
    const unsigned G = gridDim.x * gridDim.y * gridDim.z;
    unsigned sum, cnt, mine, sp = 0u;
    for (;;) {
        sum = 0u; cnt = 0u; mine = 0u;
#pragma unroll
        for (unsigned j = 0; j < 16; ++j) { const unsigned c = xb_ld(&bar[XB_XCNT(j)]); sum += c; cnt += (c > 0u) ? 1u : 0u; mine = (j == x) ? c : mine; }
        if (sum == G) break;
        __builtin_amdgcn_s_sleep(1);
        if ((++sp & 255u) == 0u) { if (xb_ld(&bar[XB_TMO])) break; if (sp > XB_SPIN_CAP) { atomicAdd(&bar[XB_TMO], 1u); break; } }
    }
    nloc = mine > 0u ? mine : 1u; nx = cnt > 0u ? cnt : 1u;
}
__device__ __forceinline__ void xcd_barrier(const XcdBarrier& b) {
    asm volatile("s_waitcnt vmcnt(0)" ::: "memory");
    __syncthreads();
    if (threadIdx.x == 0) {
        unsigned* bar = b.bar;
        __builtin_amdgcn_s_waitcnt(0);
        unsigned nloc = b.st[0], nx = b.st[1];
        if (nloc == 0u) { xcd_barrier_complete(bar, b.x, nloc, nx); b.st[0] = nloc; b.st[1] = nx; }
        const unsigned old = xb_add(&bar[XB_XSUB(b.x)], 1u);
        const unsigned gen = old / nloc;
        if (old + 1u == (gen + 1u) * nloc) {
            __builtin_amdgcn_fence(__ATOMIC_RELEASE, "agent");
            asm volatile("s_waitcnt vmcnt(0)" ::: "memory");
            const unsigned og = xb_add(&bar[XB_TOP], 1u);
            const unsigned tg = og / nx;
            if (og + 1u == (tg + 1u) * nx) xb_add(&bar[XB_TOPGEN], 1u);
            else XB_SPIN(xb_ld(&bar[XB_TOPGEN]) == tg, bar);
            __builtin_amdgcn_fence(__ATOMIC_ACQUIRE, "agent");
            xb_add(&bar[XB_XGEN(b.x)], 1u);
            asm volatile("s_waitcnt vmcnt(0)" ::: "memory");
        } else {
            XB_SPIN(xb_ld(&bar[XB_XGEN(b.x)]) == gen, bar);
            __builtin_amdgcn_fence(__ATOMIC_ACQUIRE, "agent");
            asm volatile("s_waitcnt vmcnt(0)" ::: "memory");
        }
    }
    __syncthreads();
}
__global__ void __launch_bounds__(NTHR) fwd_mega(Params p) {
    extern __shared__ __attribute__((aligned(16))) char smem[];
    cg::grid_group grid = cg::this_grid();
    const int bid = blockIdx.x, nb = gridDim.x;
    volatile LAS unsigned* xst = (volatile LAS unsigned*)(smem + LDS_BYTES - 16);
    if (threadIdx.x < 4) xst[threadIdx.x] = 0u;
    __syncthreads();
    const XcdBarrier xb = xcd_barrier_post((unsigned*)(p.ws + WS_BAR), xst);
#define GSYNC() xcd_barrier(xb)
#ifndef PROBE_REPEAT
#define PROBE_REPEAT 0
#endif
#define REP(n, call) if (PROBE_REPEAT & (1 << n)) { call; GSYNC(); }
    if (PROBE_REPEAT & 1) { phase0(p, smem, bid, nb); GSYNC(); }
#ifdef PROBE_XCC
    {
        unsigned* rec = (unsigned*)(p.ws + WS_A + 432 * MB);
        if (threadIdx.x == 0) rec[bid] = xb_xcc_id();
        grid.sync();
        int mism = 0, distinct = 0;
        for (int b = 0; b < nb; ++b) { if (rec[b] != rec[b & 7]) ++mism; }
        for (int a = 0; a < 8; ++a) { bool dup = false; for (int b2 = 0; b2 < a; ++b2) dup = dup || (rec[a] == rec[b2]); if (!dup) ++distinct; }
        const float v = sqrtf((float)(PROBE_XCC == 1 ? mism : distinct) + 1.0f);
        for (long i = (long)bid * NTHR + threadIdx.x; i < (long)T_TOK * 1024; i += (long)nb * NTHR) p.out[i] = v;
        return;
    }
#endif
    phase0(p, smem, bid, nb);  grid.sync();
    REP(1, phase1<1>(p, smem, bid, nb))
    phase1(p, smem, bid, nb);  GSYNC();
    REP(2, phase2(p, smem, bid, nb))
    phase2(p, smem, bid, nb);  GSYNC();
#ifndef PROBE_P3PARTS
#define PROBE_P3PARTS 7
#endif
#ifndef PROBE_NSAV
#define PROBE_NSAV 7
#endif
    REP(3, (phase3<PROBE_P3PARTS, PROBE_NSAV>(p, smem, bid, nb, 1)))
    phase3(p, smem, bid, nb);  GSYNC();
    REP(4, phase4(p, smem, bid, nb))
#ifdef PROBE_X
    phase_probe<PROBE_X>(p, smem, bid, nb); GSYNC();
#endif
    phase4(p, smem, bid, nb);  GSYNC();
    REP(5, phase5(p, smem, bid, nb))
    phase5(p, smem, bid, nb);  GSYNC();
    REP(6, phase6(p, smem, bid, nb))
    phase6(p, smem, bid, nb);  GSYNC();
    REP(7, phase7(p, smem, bid, nb))
    phase7(p, smem, bid, nb);  GSYNC();
    REP(8, phase8(p, smem, bid, nb, 1))
    phase8(p, smem, bid, nb);  GSYNC();
#ifndef PROBE_P9PARTS
#define PROBE_P9PARTS 3
#endif
    REP(9, phase9<PROBE_P9PARTS>(p, smem, bid, nb))
    phase9(p, smem, bid, nb);  GSYNC();
#ifndef PROBE_P10V
#define PROBE_P10V 0
#endif
    REP(10, phase10<PROBE_P10V>(p, smem, bid, nb))
    phase10(p, smem, bid, nb); GSYNC();
    REP(11, phase11(p, smem, bid, nb))
    phase11(p, smem, bid, nb);
}
#else
#define PHASE_KERNEL(n) __global__ void __launch_bounds__(NTHR) fwd_phase##n(Params p) { extern __shared__ __attribute__((aligned(16))) char smem[]; phase##n(p, smem, blockIdx.x, gridDim.x); }
PHASE_KERNEL(0) PHASE_KERNEL(1) PHASE_KERNEL(2) PHASE_KERNEL(3) PHASE_KERNEL(4) PHASE_KERNEL(5)
PHASE_KERNEL(6) PHASE_KERNEL(7) PHASE_KERNEL(8) PHASE_KERNEL(9) PHASE_KERNEL(10) PHASE_KERNEL(11)
typedef void (*phase_fn)(Params);
#endif

extern "C" void kernel_launch(void* const* d_in, const int* in_sizes, int n_in, void* d_out, int out_size, void* d_ws, size_t ws_size, hipStream_t stream) {
    Params p{};
    for (int i = 0; i < 32; ++i) p.in[i] = (const float*)d_in[i];
    p.out = (float*)d_out;
    p.ws = (char*)d_ws;
    if (n_in != 32 || ws_size < WS_END) { fprintf(stderr, "kernel_launch: unexpected inputs (n_in %d) or workspace too small (%zu < %zu)\n", n_in, ws_size, (size_t)WS_END); return; }
#if MEGA
    static int grid = 0;
    if (!grid) {
        int dev = 0, cus = 0, per_cu = 0;
        (void)hipGetDevice(&dev);
        (void)hipDeviceGetAttribute(&cus, hipDeviceAttributeMultiprocessorCount, dev);
        (void)hipFuncSetAttribute((const void*)fwd_mega, hipFuncAttributeMaxDynamicSharedMemorySize, LDS_BYTES);
        (void)hipOccupancyMaxActiveBlocksPerMultiprocessor(&per_cu, (const void*)fwd_mega, NTHR, LDS_BYTES);
        if (per_cu < 1) { fprintf(stderr, "kernel_launch: occupancy query says %d blocks/CU\n", per_cu); per_cu = 1; }
        grid = cus;
    }
    (void)hipMemsetAsync((char*)d_ws + WS_BAR, 0, 16384, stream);
    void* args[] = {&p};
    hipError_t e = hipLaunchCooperativeKernel((const void*)fwd_mega, dim3(grid), dim3(NTHR), args, LDS_BYTES, stream);
    if (e != hipSuccess) fprintf(stderr, "cooperative launch failed: %s (grid %d)\n", hipGetErrorString(e), grid);
#else
    static const phase_fn fns[12] = {fwd_phase0, fwd_phase1, fwd_phase2, fwd_phase3, fwd_phase4, fwd_phase5, fwd_phase6, fwd_phase7, fwd_phase8, fwd_phase9, fwd_phase10, fwd_phase11};
    static bool attr = false;
    if (!attr) { for (int i = 0; i < 12; ++i) (void)hipFuncSetAttribute((const void*)fns[i], hipFuncAttributeMaxDynamicSharedMemorySize, LDS_BYTES); attr = true; }
    for (int i = 0; i < 12; ++i) hipLaunchKernelGGL(fns[i], dim3(256), dim3(NTHR), LDS_BYTES, stream, p);
#endif
}
```

```cpp
#include <hip/hip_runtime.h>
#include <hip/hip_cooperative_groups.h>
#include <stdint.h>
#include <stdio.h>
namespace cg = cooperative_groups;

#ifndef MEGA
#define MEGA 1
#endif

typedef unsigned short bf16_t;
typedef short bf16x8 __attribute__((ext_vector_type(8)));
typedef short s16x4 __attribute__((ext_vector_type(4)));
typedef float f32x4 __attribute__((ext_vector_type(4)));
typedef float f32x2 __attribute__((ext_vector_type(2)));
typedef unsigned u32x4 __attribute__((ext_vector_type(4)));
typedef unsigned u32x2 __attribute__((ext_vector_type(2)));
typedef __bf16 bf16x2_t __attribute__((ext_vector_type(2)));

#ifndef INPROJ_F8
#define INPROJ_F8 0
#endif
constexpr int T_TOK = 32768, DM = 1024, NB = 16, SEQ = 2048;
constexpr int PW = 3328;
constexpr int PC_Q = 0, PC_KC = 512, PC_VC = 640, PC_KS = 768, PC_VS = 896, PC_KW = 1024, PC_VW = 1152;
constexpr int PC_MQ = 1280, PC_MK = 1792, PC_MV = 2304, PC_MO = 2816;
constexpr float ALPHA = 1.189207115002721f;
constexpr float LN_EPS = 1e-5f;
constexpr int NTHR = 512;
constexpr int LDS_BYTES = 160 * 1024;
constexpr int NEXP = 256, TOPK = 8;
constexpr float W8_SCALE = 64.0f, H8_SCALE = 16.0f, Y8_SCALE = 64.0f;
constexpr int LIST_CAP = 32768;

constexpr size_t al256(size_t x) { return (x + 255) & ~(size_t)255; }
constexpr size_t WS_WIN = 0;
constexpr size_t WS_WOUT = WS_WIN + al256((size_t)3360 * 1024 * 2);
constexpr size_t WS_WQ = WS_WOUT + (size_t)1024 * 1024 * 2;
constexpr size_t WS_WKV = WS_WQ + (size_t)1024 * 1024 * 2;
constexpr size_t WS_WO = WS_WKV + (size_t)2048 * 1024 * 2;
constexpr size_t WS_WR = WS_WO + (size_t)1024 * 1024 * 2;
constexpr size_t WS_WS13 = WS_WR + (size_t)256 * 1024 * 2;
constexpr size_t WS_WS2 = WS_WS13 + (size_t)512 * 1024 * 2;
constexpr size_t WS_CK1 = WS_WS2 + (size_t)1024 * 256 * 2;
constexpr size_t WS_CK2 = WS_CK1 + (size_t)64 * 2048 * 2;
constexpr size_t WS_CV1 = WS_CK2 + (size_t)64 * 64 * 2;
constexpr size_t WS_CV2 = WS_CV1 + (size_t)64 * 2048 * 2;
constexpr size_t MB = 1024 * 1024;
constexpr size_t WS_LNP = al256(WS_CV2 + (size_t)64 * 64 * 2);
constexpr size_t WS_LNF = WS_LNP + (size_t)2 * 16 * 1792 * 4;
constexpr size_t WS_A = al256(WS_LNF + (size_t)2 * 1792 * 4 + 65536);
constexpr size_t WS_P = WS_A;
constexpr size_t WS_R1 = WS_A;
constexpr size_t WS_XQ = WS_A + 128 * MB;
constexpr size_t WS_XO = WS_A + 192 * MB;
constexpr size_t WS_XB = WS_A + 208 * MB;
constexpr size_t WS_MEMB = WS_A + 272 * MB;
constexpr size_t WS_PSM = WS_A + 280 * MB;
constexpr size_t WS_KCMP = WS_A + 284 * MB;
constexpr size_t WS_VCMP = WS_KCMP + (size_t)16 * 2 * 128 * 64 * 2;
constexpr size_t WS_QK = WS_A + 285 * MB;
constexpr size_t WS_MIX = WS_A + 349 * MB;
constexpr size_t WS_KVX = WS_A + 413 * MB;
constexpr size_t WS_X2F8 = WS_A + 256 * MB;
constexpr size_t WS_X2 = WS_A + 256 * MB;
constexpr size_t WS_HS = WS_A + 320 * MB;
constexpr size_t WS_R1B = WS_A;
constexpr size_t WS_RSC = WS_A;
constexpr size_t WS_Y = WS_A;
constexpr size_t WS_B = WS_A + al256((size_t)(T_TOK * 8 + 256) * 1024 * 2);
constexpr size_t WS_R2B = WS_B;
constexpr size_t WS_R2 = WS_B;
constexpr size_t WS_ST1 = WS_R2 + (size_t)T_TOK * 1024 * 4;
constexpr size_t WS_ST2 = WS_ST1 + (size_t)T_TOK * 8 * 4;
constexpr size_t WS_SH = WS_ST2 + (size_t)T_TOK * 8 * 4;
constexpr size_t WS_SELE = WS_SH + (size_t)T_TOK * 1024 * 2;
constexpr size_t WS_SELP = WS_SELE + (size_t)T_TOK * 8 * 4;
constexpr size_t WS_SELW = WS_SELP + (size_t)T_TOK * 8 * 4;
constexpr size_t WS_CNT = WS_SELW + (size_t)T_TOK * 8 * 4;
constexpr size_t WS_TOKL = WS_CNT + 98304;
constexpr size_t WS_WL = WS_TOKL + (size_t)NEXP * LIST_CAP * 4;
constexpr size_t WS_H = WS_WL + (size_t)NEXP * LIST_CAP * 4;
constexpr size_t WS_HF8 = WS_H;
constexpr size_t WS_W2F8 = WS_H + (size_t)(T_TOK * 8 + 256) * 256;
constexpr size_t WS_BAR = WS_W2F8 + (size_t)256 * 1024 * 256;
constexpr size_t WS_END = WS_BAR + 16384;
static_assert((size_t)T_TOK * PW * 2 <= 208 * MB, "P region");
static_assert(WS_END <= (size_t)1024 * MB, "workspace must fit 1 GiB");

struct Params {
    const float* in[32];
    float* out;
    char* ws;
};

__device__ __forceinline__ unsigned pk_bf16(float lo, float hi) {
    f32x2 v = {lo, hi};
    bf16x2_t r = __builtin_convertvector(v, bf16x2_t);
    return __builtin_bit_cast(unsigned, r);
}
__device__ __forceinline__ float bf_lo(unsigned u) { return __uint_as_float(u << 16); }
__device__ __forceinline__ float bf_hi(unsigned u) { return __uint_as_float(u & 0xffff0000u); }
__device__ __forceinline__ float bf2f(bf16_t h) { return __uint_as_float(((unsigned)h) << 16); }
__device__ __forceinline__ float sigmoidf_(float x) { return 1.0f / (1.0f + __expf(-x)); }
__device__ __forceinline__ float siluf_(float x) { return x / (1.0f + __expf(-x)); }
__device__ __forceinline__ f32x4 mfma16(bf16x8 a, bf16x8 b, f32x4 c) { return __builtin_amdgcn_mfma_f32_16x16x32_bf16(a, b, c, 0, 0, 0); }
__device__ __forceinline__ bf16x8 as_bf16x8(u32x4 v) { return __builtin_bit_cast(bf16x8, v); }

__device__ __forceinline__ float fq_max(float x) {
    auto a = __builtin_amdgcn_permlane16_swap(__float_as_uint(x), __float_as_uint(x), false, false);
    x = __builtin_fmaxf(__uint_as_float(a[0]), __uint_as_float(a[1]));
    auto b = __builtin_amdgcn_permlane32_swap(__float_as_uint(x), __float_as_uint(x), false, false);
    return __builtin_fmaxf(__uint_as_float(b[0]), __uint_as_float(b[1]));
}
__device__ __forceinline__ float fq_sum(float x) {
    auto a = __builtin_amdgcn_permlane16_swap(__float_as_uint(x), __float_as_uint(x), false, false);
    x = __uint_as_float(a[0]) + __uint_as_float(a[1]);
    auto b = __builtin_amdgcn_permlane32_swap(__float_as_uint(x), __float_as_uint(x), false, false);
    return __uint_as_float(b[0]) + __uint_as_float(b[1]);
}
__device__ __forceinline__ int opaque_tid() { int t = threadIdx.x; asm volatile("" : "+v"(t)); return t; }

__device__ __forceinline__ int tile_off(int row, int chunk) { return row * 128 + ((chunk ^ (row & 7)) << 4); }

__device__ __forceinline__ int bperm(int rho) { return (rho & ~31) + 8 * ((rho >> 2) & 3) + 4 * ((rho >> 4) & 1) + (rho & 3); }

typedef __attribute__((address_space(3))) unsigned lds_u32;
typedef __attribute__((address_space(1))) const unsigned glb_u32;

struct LoadBf16Rows {
    const bf16_t* base;
    unsigned off[4];
    int ldst;
    struct Regs { int dummy; };
    __device__ __forceinline__ void init_contig(const bf16_t* b, int ld, int row0) {
        const int tid_ = opaque_tid();
        const int r8 = tid_ >> 3, kc = (tid_ & 7) ^ (r8 & 7);
        ldst = tid_ * 16;
        base = b + (long)row0 * ld;
#pragma unroll
        for (int i = 0; i < 4; ++i) off[i] = (unsigned)((r8 + 64 * i) * ld + kc * 8);
    }
    __device__ __forceinline__ void init_rows(const bf16_t* b, int ld, const int (&rows)[4]) {
        const int tid_ = opaque_tid();
        const int r8 = tid_ >> 3, kc = (tid_ & 7) ^ (r8 & 7);
        ldst = tid_ * 16;
        base = b;
#pragma unroll
        for (int i = 0; i < 4; ++i) off[i] = (unsigned)rows[i] * (unsigned)ld + (unsigned)(kc * 8);
    }
    __device__ __forceinline__ void issue(Regs&, char* s, int kt) const {
#pragma unroll
        for (int i = 0; i < 4; ++i)
            __builtin_amdgcn_global_load_lds((glb_u32*)(base + (size_t)(off[i] + (unsigned)(kt * 64))), (lds_u32*)(s + i * 8192 + ldst), 16, 0, 0);
    }
    __device__ __forceinline__ void commit(const Regs&, char*, int) const {}
};

struct LoadF32KN {
    const float* p;
    int ldn;
    int n, kh;
    struct Regs { float v[32]; };
    __device__ __forceinline__ void issue(Regs& r, char*, int kt) const {
        const float* q = p + (long)kt * 64 * ldn;
#pragma unroll
        for (int j = 0; j < 32; ++j) r.v[j] = q[(long)j * ldn];
    }
    __device__ __forceinline__ void commit(const Regs& r, char* s, int kt) const {
#pragma unroll
        for (int q = 0; q < 4; ++q) {
            u32x4 w;
            w.x = pk_bf16(r.v[8 * q + 0], r.v[8 * q + 1]); w.y = pk_bf16(r.v[8 * q + 2], r.v[8 * q + 3]);
            w.z = pk_bf16(r.v[8 * q + 4], r.v[8 * q + 5]); w.w = pk_bf16(r.v[8 * q + 6], r.v[8 * q + 7]);
            *(u32x4*)(s + tile_off(n, kh * 4 + q)) = w;
        }
    }
};

struct LoadLN {
    LoadBf16Rows raw;
    bf16_t* xbase;
    const float* st;
    const float* gb;
    typedef LoadBf16Rows::Regs Regs;
    __device__ __forceinline__ void issue(Regs& r, char* s, int kt) const { raw.issue(r, s, kt); }
    __device__ __forceinline__ void commit(const Regs&, char* s, int kt) const {
        asm volatile("s_waitcnt vmcnt(0)" ::: "memory");
        const int tid_ = opaque_tid();
        const int r8 = tid_ >> 3, kc = (tid_ & 7) ^ (r8 & 7);
        const f32x4 g0 = *(const f32x4*)(gb + kt * 64 + kc * 8), g1 = *(const f32x4*)(gb + kt * 64 + kc * 8 + 4);
        const f32x4 b0 = *(const f32x4*)(gb + 1024 + kt * 64 + kc * 8), b1 = *(const f32x4*)(gb + 1024 + kt * 64 + kc * 8 + 4);
#pragma unroll
        for (int i = 0; i < 4; ++i) {
            const int row = r8 + 64 * i;
            u32x4* cp = (u32x4*)(s + i * 8192 + tid_ * 16);
            const u32x4 v = *cp;
            const float mean = st[row * 2], rstd = st[row * 2 + 1];
            const f32x4 x0 = (f32x4){bf_lo(v.x), bf_hi(v.x), bf_lo(v.y), bf_hi(v.y)};
            const f32x4 x1 = (f32x4){bf_lo(v.z), bf_hi(v.z), bf_lo(v.w), bf_hi(v.w)};
            const f32x4 y0 = (x0 - mean) * rstd * g0 + b0, y1 = (x1 - mean) * rstd * g1 + b1;
            u32x4 w; w.x = pk_bf16(y0[0], y0[1]); w.y = pk_bf16(y0[2], y0[3]); w.z = pk_bf16(y1[0], y1[1]); w.w = pk_bf16(y1[2], y1[3]);
            *cp = w;
            if (xbase) *(u32x4*)(xbase + (size_t)(row * 1024 + kc * 8 + kt * 64)) = w;
        }
    }
};

constexpr int GEMM_LDS = 131072;
template <class AL, class BL>
__device__ __forceinline__ void gemm_mainloop(char* smem, const AL& al, const BL& bl, int nk, f32x4 (&acc)[8][4]) {
    const int tid_ = opaque_tid();
    const int lane = tid_ & 63, wid = tid_ >> 6;
    const int wr = wid >> 2, wc = wid & 3, fr = lane & 15, fq = lane >> 4;
#pragma unroll
    for (int mi = 0; mi < 8; ++mi)
#pragma unroll
        for (int ni = 0; ni < 4; ++ni) acc[mi][ni] = (f32x4){0.f, 0.f, 0.f, 0.f};
    typename AL::Regs ra; typename BL::Regs rb;
    al.issue(ra, smem, 0); bl.issue(rb, smem + 32768, 0);
    al.commit(ra, smem, 0); bl.commit(rb, smem + 32768, 0);
    __syncthreads();
    for (int kt = 0; kt < nk; ++kt) {
        char* sA = smem + (kt & 1) * 65536; char* sB = sA + 32768;
        char* nA = smem + ((kt + 1) & 1) * 65536; char* nB = nA + 32768;
        if (kt + 1 < nk) { al.issue(ra, nA, kt + 1); bl.issue(rb, nB, kt + 1); }
#pragma unroll
        for (int kk = 0; kk < 2; ++kk) {
            bf16x8 bfr[4];
#pragma unroll
            for (int ni = 0; ni < 4; ++ni) bfr[ni] = *(const bf16x8*)(sB + tile_off(wc * 64 + ni * 16 + fr, kk * 4 + fq));
#pragma unroll
            for (int mi = 0; mi < 8; ++mi) {
                const bf16x8 af = *(const bf16x8*)(sA + tile_off(wr * 128 + mi * 16 + fr, kk * 4 + fq));
#pragma unroll
                for (int ni = 0; ni < 4; ++ni) acc[mi][ni] = mfma16(bfr[ni], af, acc[mi][ni]);
            }
        }
        if (kt + 1 < nk) { al.commit(ra, nA, kt + 1); bl.commit(rb, nB, kt + 1); }
        __syncthreads();
    }
}

__device__ __forceinline__ int swz4(int row) { return (0x78 >> (((row >> 2) & 3) * 2)) & 3; }
struct RingRows {
    const bf16_t* base; unsigned off[2]; int ldst;
    __device__ __forceinline__ void init_contig(const bf16_t* b, int ld, int row0, bool perm = false) {
        const int tid_ = opaque_tid(); const int r = tid_ >> 2, kc = (tid_ & 3) ^ swz4(r);
        ldst = tid_ * 16; base = b + (long)row0 * ld;
#pragma unroll
        for (int i = 0; i < 2; ++i) { const int rr = r + 128 * i; off[i] = (unsigned)((perm ? bperm(rr) : rr) * ld + kc * 8); }
    }
    __device__ __forceinline__ void init_rows(const bf16_t* b, int ld, const int (&rows)[2]) {
        const int tid_ = opaque_tid(); const int r = tid_ >> 2, kc = (tid_ & 3) ^ swz4(r);
        ldst = tid_ * 16; base = b;
#pragma unroll
        for (int i = 0; i < 2; ++i) off[i] = (unsigned)rows[i] * (unsigned)ld + (unsigned)(kc * 8);
    }
    __device__ __forceinline__ void issue(char* s, int kt) const {
#pragma unroll
        for (int i = 0; i < 2; ++i)
            __builtin_amdgcn_global_load_lds((glb_u32*)(base + (size_t)(off[i] + (unsigned)(kt * 32))), (lds_u32*)(s + i * 8192 + ldst), 16, 0, 0);
    }
    __device__ __forceinline__ void commit(char*, int) const {}
};
struct RingLN {
    RingRows raw; bf16_t* xbase; const float* st; const float* gb;
    __device__ __forceinline__ void issue(char* s, int kt) const { raw.issue(s, kt); }
    __device__ __forceinline__ void commit(char* s, int kt) const {
        const int tid_ = opaque_tid(); const int r = tid_ >> 2, kc = (tid_ & 3) ^ swz4(r);
        const f32x4 g0 = *(const f32x4*)(gb + kt * 32 + kc * 8), g1 = *(const f32x4*)(gb + kt * 32 + kc * 8 + 4);
        const f32x4 b0 = *(const f32x4*)(gb + 1024 + kt * 32 + kc * 8), b1 = *(const f32x4*)(gb + 1024 + kt * 32 + kc * 8 + 4);
#pragma unroll
        for (int i = 0; i < 2; ++i) {
            const int row = r + 128 * i;
            u32x4* cp = (u32x4*)(s + i * 8192 + tid_ * 16);
            const u32x4 v = *cp;
            const float mean = st[row * 2], rstd = st[row * 2 + 1];
            const f32x4 x0 = (f32x4){bf_lo(v.x), bf_hi(v.x), bf_lo(v.y), bf_hi(v.y)};
            const f32x4 x1 = (f32x4){bf_lo(v.z), bf_hi(v.z), bf_lo(v.w), bf_hi(v.w)};
            const f32x4 y0 = (x0 - mean) * rstd * g0 + b0, y1 = (x1 - mean) * rstd * g1 + b1;
            u32x4 w; w.x = pk_bf16(y0[0], y0[1]); w.y = pk_bf16(y0[2], y0[3]); w.z = pk_bf16(y1[0], y1[1]); w.w = pk_bf16(y1[2], y1[3]);
            *cp = w;
            if (xbase) *(u32x4*)(xbase + (size_t)(row * 1024 + kc * 8 + kt * 32)) = w;
        }
    }
};
#define RING_WAIT(n) asm volatile("s_waitcnt vmcnt(" #n ")" ::: "memory")
#define RING_BAR() do { __builtin_amdgcn_sched_barrier(0); asm volatile("s_waitcnt lgkmcnt(0)" ::: "memory"); __builtin_amdgcn_s_barrier(); asm volatile("" ::: "memory"); __builtin_amdgcn_sched_barrier(0); } while (0)
template <class AL, class BL>
__device__ __forceinline__ void ring_issue3(char* smem, const AL& al, const BL& bl) {
    al.issue(smem, 0); bl.issue(smem + 16384, 0);
    al.issue(smem + 32768, 1); bl.issue(smem + 32768 + 16384, 1);
    al.issue(smem + 65536, 2); bl.issue(smem + 65536 + 16384, 2);
}
template <class AL, class BL, int XMODE = 0  , bool ISSUED = false  >
__device__ __forceinline__ void gemm_ring(char* smem, const AL& al, const BL& bl, int nk  , f32x4 (&acc)[8][4]) {
    const int tid_ = opaque_tid();
    const int lane = tid_ & 63, wid = __builtin_amdgcn_readfirstlane(tid_ >> 6);
    const int wr = wid >> 2, wc = wid & 3, fr = lane & 15, fq = lane >> 4;
#pragma unroll
    for (int mi = 0; mi < 8; ++mi)
#pragma unroll
        for (int ni = 0; ni < 4; ++ni) acc[mi][ni] = (f32x4){0.f, 0.f, 0.f, 0.f};
    const int aoff = (wr * 128 + fr) * 64 + ((fq ^ swz4(fr)) << 4);
    const int boff = 16384 + (wc * 64 + fr) * 64 + ((fq ^ swz4(fr)) << 4);
    if (XMODE != 1) {
    if (!ISSUED) ring_issue3(smem, al, bl);
    RING_WAIT(8);
    al.commit(smem, 0); bl.commit(smem + 16384, 0);
    }
    RING_BAR();
    if (wr == 1) RING_BAR();
    for (int kt = 0; kt < nk; ++kt) {
        const char* st = smem + (kt & 3) * 32768;
        if (XMODE != 1 && kt + 3 < nk) { char* s3 = smem + ((kt + 3) & 3) * 32768; al.issue(s3, kt + 3); bl.issue(s3 + 16384, kt + 3); }
        bf16x8 bfr[4], afr[8];
        if (XMODE != 2) {
#pragma unroll
        for (int ni = 0; ni < 4; ++ni) bfr[ni] = *(const bf16x8*)(st + boff + ni * 1024);
#pragma unroll
        for (int mi = 0; mi < 8; ++mi) afr[mi] = *(const bf16x8*)(st + aoff + mi * 1024);
        }
        if (XMODE != 1 && kt + 1 < nk) {
            if (kt + 3 < nk) RING_WAIT(8); else if (kt + 2 < nk) RING_WAIT(4); else RING_WAIT(0);
            char* s1 = smem + ((kt + 1) & 3) * 32768;
            al.commit(s1, kt + 1); bl.commit(s1 + 16384, kt + 1);
        }
        RING_BAR();
        if (XMODE != 2) {
        __builtin_amdgcn_s_setprio(1);
#pragma unroll
        for (int mi = 0; mi < 8; ++mi)
#pragma unroll
            for (int ni = 0; ni < 4; ++ni) acc[mi][ni] = mfma16(bfr[ni], afr[mi], acc[mi][ni]);
        __builtin_amdgcn_s_setprio(0);
        }
        RING_BAR();
    }
    if (wr == 0) RING_BAR();
}

constexpr int FB_PITCH = 1088, FB_STAGE = 16384 + 32 * FB_PITCH;
struct RingF32B {
    const float* p; int ldn; int ldst;
    __device__ __forceinline__ void init(const float* W, int ld, int srccol4, int tid_) { const int lane = tid_ & 63, wid = tid_ >> 6; p = W + (long)wid * ld + srccol4; ldn = ld; ldst = wid * FB_PITCH + lane * 16; }
    __device__ __forceinline__ void issue(char* sB, int kt) const {
#pragma unroll
        for (int i = 0; i < 4; ++i)
            __builtin_amdgcn_global_load_lds((glb_u32*)(p + (long)(kt * 32 + i * 8) * ldn), (lds_u32*)(sB + i * 8 * FB_PITCH + (i & 1) * 64 + ldst), 16, 0, 0);
    }
};
template <class AL>
__device__ __forceinline__ void gemm_ring_f32b(char* smem, const AL& al, const RingF32B& bl, int nk  , f32x4 (&acc)[8][4]) {
    const int tid_ = opaque_tid();
    const int lane = tid_ & 63, wid = __builtin_amdgcn_readfirstlane(tid_ >> 6);
    const int wr = wid >> 2, wc = wid & 3, fr = lane & 15, fq = lane >> 4;
#pragma unroll
    for (int mi = 0; mi < 8; ++mi)
#pragma unroll
        for (int ni = 0; ni < 4; ++ni) acc[mi][ni] = (f32x4){0.f, 0.f, 0.f, 0.f};
    const int aoff = (wr * 128 + fr) * 64 + ((fq ^ swz4(fr)) << 4);
    const int boff = 16384 + (8 * fq) * FB_PITCH + (fq & 1) * 64 + (wc * 64 + fr) * 4;
    al.issue(smem, 0); bl.issue(smem + 16384, 0);
    al.issue(smem + FB_STAGE, 1); bl.issue(smem + FB_STAGE + 16384, 1);
    RING_WAIT(6);
    RING_BAR();
    if (wr == 1) RING_BAR();
    int s0 = 0;
    for (int kt = 0; kt < nk; ++kt) {
        const char* st = smem + s0 * FB_STAGE;
        const int s1 = s0 == 2 ? 0 : s0 + 1, s2 = s1 == 2 ? 0 : s1 + 1;
        if (kt + 2 < nk) { char* sn = smem + s2 * FB_STAGE; al.issue(sn, kt + 2); bl.issue(sn + 16384, kt + 2); }
        bf16x8 bfr[4], afr[8];
#pragma unroll
        for (int ni = 0; ni < 4; ++ni) {
            float v[8];
#pragma unroll
            for (int j = 0; j < 8; ++j) v[j] = *(const float*)(st + boff + j * FB_PITCH + ni * 64);
            u32x4 w; w.x = pk_bf16(v[0], v[1]); w.y = pk_bf16(v[2], v[3]); w.z = pk_bf16(v[4], v[5]); w.w = pk_bf16(v[6], v[7]);
            bfr[ni] = as_bf16x8(w);
        }
#pragma unroll
        for (int mi = 0; mi < 8; ++mi) afr[mi] = *(const bf16x8*)(st + aoff + mi * 1024);
        if (kt + 1 < nk) { if (kt + 2 < nk) RING_WAIT(6); else RING_WAIT(0); }
        RING_BAR();
        __builtin_amdgcn_s_setprio(1);
#pragma unroll
        for (int mi = 0; mi < 8; ++mi)
#pragma unroll
            for (int ni = 0; ni < 4; ++ni) acc[mi][ni] = mfma16(bfr[ni], afr[mi], acc[mi][ni]);
        __builtin_amdgcn_s_setprio(0);
        RING_BAR();
        s0 = s1;
    }
    if (wr == 0) RING_BAR();
}

__device__ __forceinline__ int bperm32(int rho) { return (rho & ~31) + 16 * ((rho >> 2) & 1) + 4 * ((rho >> 3) & 3) + (rho & 3); }
__device__ __forceinline__ unsigned pk4_fp8(float a, float b, float c, float d) {
    int r = __builtin_amdgcn_cvt_pk_fp8_f32(a, b, 0, false);
    r = __builtin_amdgcn_cvt_pk_fp8_f32(c, d, r, true);
    return (unsigned)r;
}
struct RingF8 {
    const unsigned char* base; unsigned off[2]; int ldst;
    __device__ __forceinline__ void init_contig(const unsigned char* b, int ldb, long row0, bool perm = false) {
        const int tid_ = opaque_tid(); const int r = tid_ >> 2, kc = (tid_ & 3) ^ ((r >> 2) & 3);
        ldst = tid_ * 16; base = b + row0 * ldb;
#pragma unroll
        for (int i = 0; i < 2; ++i) { const int rr = r + 128 * i; off[i] = (unsigned)((perm ? bperm32(rr) : rr) * ldb + kc * 16); }
    }
    __device__ __forceinline__ void init_rows(const unsigned char* b, int ldb, const int (&rows)[2]) {
        const int tid_ = opaque_tid(); const int r = tid_ >> 2, kc = (tid_ & 3) ^ ((r >> 2) & 3);
        ldst = tid_ * 16; base = b;
#pragma unroll
        for (int i = 0; i < 2; ++i) off[i] = (unsigned)rows[i] * (unsigned)ldb + (unsigned)(kc * 16);
    }
    __device__ __forceinline__ void issue(char* s, int kt) const {
#pragma unroll
        for (int i = 0; i < 2; ++i)
            __builtin_amdgcn_global_load_lds((glb_u32*)(base + (size_t)(off[i] + (unsigned)(kt * 64))), (lds_u32*)(s + i * 8192 + ldst), 16, 0, 0);
    }
};
__device__ __forceinline__ void ring_f8_issue3(char* smem, const RingF8& al, const RingF8& bl) {
    al.issue(smem, 0); bl.issue(smem + 16384, 0);
    al.issue(smem + 32768, 1); bl.issue(smem + 32768 + 16384, 1);
    al.issue(smem + 65536, 2); bl.issue(smem + 65536 + 16384, 2);
}
__device__ __forceinline__ void gemm_ring_f8_main(char* smem, const RingF8& al, const RingF8& bl, int nk  , f32x4 (&acc)[8][4]) {
    const int tid_ = opaque_tid();
    const int lane = tid_ & 63, wid = __builtin_amdgcn_readfirstlane(tid_ >> 6);
    const int wr = wid >> 2, wc = wid & 3, fr = lane & 15, fq = lane >> 4;
#pragma unroll
    for (int mi = 0; mi < 8; ++mi)
#pragma unroll
        for (int ni = 0; ni < 4; ++ni) acc[mi][ni] = (f32x4){0.f, 0.f, 0.f, 0.f};
    const int g2 = ((fr >> 2) & 3) << 1;
    const int aoff0 = (wr * 128 + fr) * 64 + ((fq ^ g2) << 3), aoff1 = (wr * 128 + fr) * 64 + (((4 + fq) ^ g2) << 3);
    const int boff0 = 16384 + (wc * 64 + fr) * 64 + ((fq ^ g2) << 3), boff1 = 16384 + (wc * 64 + fr) * 64 + (((4 + fq) ^ g2) << 3);
    RING_WAIT(8);
    RING_BAR();
    if (wr == 1) RING_BAR();
    for (int kt = 0; kt < nk; ++kt) {
        const char* st = smem + (kt & 3) * 32768;
        if (kt + 3 < nk) { char* s3 = smem + ((kt + 3) & 3) * 32768; al.issue(s3, kt + 3); bl.issue(s3 + 16384, kt + 3); }
        long b0[4], b1[4], a0[8], a1[8];
#pragma unroll
        for (int ni = 0; ni < 4; ++ni) { b0[ni] = *(const long*)(st + boff0 + ni * 1024); b1[ni] = *(const long*)(st + boff1 + ni * 1024); }
#pragma unroll
        for (int mi = 0; mi < 8; ++mi) { a0[mi] = *(const long*)(st + aoff0 + mi * 1024); a1[mi] = *(const long*)(st + aoff1 + mi * 1024); }
        if (kt + 1 < nk) { if (kt + 3 < nk) RING_WAIT(8); else if (kt + 2 < nk) RING_WAIT(4); else RING_WAIT(0); }
        RING_BAR();
        __builtin_amdgcn_s_setprio(1);
#pragma unroll
        for (int mi = 0; mi < 8; ++mi)
#pragma unroll
            for (int ni = 0; ni < 4; ++ni) {
                acc[mi][ni] = __builtin_amdgcn_mfma_f32_16x16x32_fp8_fp8(b0[ni], a0[mi], acc[mi][ni], 0, 0, 0);
                acc[mi][ni] = __builtin_amdgcn_mfma_f32_16x16x32_fp8_fp8(b1[ni], a1[mi], acc[mi][ni], 0, 0, 0);
            }
        __builtin_amdgcn_s_setprio(0);
        RING_BAR();
    }
    if (wr == 0) RING_BAR();
}

typedef int i32x8 __attribute__((ext_vector_type(8)));
typedef float f32x16 __attribute__((ext_vector_type(16)));
constexpr int MX_ONE = 0x7f7f7f7f;
__device__ __forceinline__ f32x16 mfma_mx(i32x8 a, i32x8 b, f32x16 c) { return __builtin_amdgcn_mfma_scale_f32_32x32x64_f8f6f4(a, b, c, 0, 0, 0, MX_ONE, 0, MX_ONE); }
__device__ __forceinline__ i32x8 mx_frag(const char* rowp  , int c0off, int c1off) {
    const u32x4 lo = *(const u32x4*)(rowp + c0off), hi = *(const u32x4*)(rowp + c1off);
    return (i32x8){(int)lo.x, (int)lo.y, (int)lo.z, (int)lo.w, (int)hi.x, (int)hi.y, (int)hi.z, (int)hi.w};
}
__device__ __forceinline__ void gemm_ring_mx_main(char* smem, const RingF8& al, const RingF8& bl, int nk  , f32x16 (&acc)[4][2]) {
    const int tid_ = opaque_tid();
    const int lane = tid_ & 63, wid = __builtin_amdgcn_readfirstlane(tid_ >> 6);
    const int wr = wid >> 2, wc = wid & 3, r = lane & 31, h = lane >> 5;
#pragma unroll
    for (int mi = 0; mi < 4; ++mi)
#pragma unroll
        for (int nj = 0; nj < 2; ++nj)
#pragma unroll
            for (int q = 0; q < 16; ++q) acc[mi][nj][q] = 0.f;
    const int g = (r >> 2) & 3;
    const int c0 = ((2 * h) ^ g) << 4, c1 = ((2 * h + 1) ^ g) << 4;
    const int arow = (wr * 128 + r) * 64;
    const int brow = 16384 + (wc * 64 + r) * 64;
    RING_WAIT(8);
    RING_BAR();
    if (wr == 1) RING_BAR();
#pragma unroll 1
    for (int kt = 0; kt < nk; ++kt) {
        const char* st = smem + (kt & 3) * 32768;
        if (kt + 3 < nk) { char* s3 = smem + ((kt + 3) & 3) * 32768; al.issue(s3, kt + 3); bl.issue(s3 + 16384, kt + 3); }
        i32x8 bf[2], af[4];
#pragma unroll
        for (int nj = 0; nj < 2; ++nj) bf[nj] = mx_frag(st + brow + nj * 2048, c0, c1);
#pragma unroll
        for (int mi = 0; mi < 4; ++mi) af[mi] = mx_frag(st + arow + mi * 2048, c0, c1);
        if (kt + 1 < nk) { if (kt + 3 < nk) RING_WAIT(8); else if (kt + 2 < nk) RING_WAIT(4); else RING_WAIT(0); }
        RING_BAR();
        __builtin_amdgcn_s_setprio(1);
#pragma unroll
        for (int mi = 0; mi < 4; ++mi)
#pragma unroll
            for (int nj = 0; nj < 2; ++nj) acc[mi][nj] = mfma_mx(bf[nj], af[mi], acc[mi][nj]);
        __builtin_amdgcn_s_setprio(0);
        RING_BAR();
    }
    if (wr == 0) RING_BAR();
}

__device__ __forceinline__ int bperm16(int rho) { return (rho & ~63) + 16 * ((rho >> 2) & 3) + 4 * ((rho >> 4) & 3) + (rho & 3); }

__device__ __forceinline__ void epi_store_bf16(const f32x4 (&acc)[8][4], bf16_t* out, long ld, int row0, int col0) {
    const int tid_ = opaque_tid();
    const int lane = tid_ & 63, wid = tid_ >> 6;
    const int wr = wid >> 2, wc = wid & 3, fr = lane & 15, fq = lane >> 4;
#pragma unroll
    for (int mi = 0; mi < 8; ++mi) {
        bf16_t* rp = out + (long)(row0 + wr * 128 + mi * 16 + fr) * ld + col0 + wc * 64 + fq * 8;
#pragma unroll
        for (int q = 0; q < 2; ++q) {
            u32x4 w; w.x = pk_bf16(acc[mi][2 * q][0], acc[mi][2 * q][1]); w.y = pk_bf16(acc[mi][2 * q][2], acc[mi][2 * q][3]);
            w.z = pk_bf16(acc[mi][2 * q + 1][0], acc[mi][2 * q + 1][1]); w.w = pk_bf16(acc[mi][2 * q + 1][2], acc[mi][2 * q + 1][3]);
            *(u32x4*)(rp + q * 32) = w;
        }
    }
}

template <bool RES_LN>
__device__ __forceinline__ void epi_residual(f32x4 (&acc)[8][4], char* smem, const float* resid_f32, const bf16_t* resid_bf16, const float* rstats  ,
                                             const float* g, const float* b, bf16_t* rbout, float* stout  , int row0, int nt) {
    const int tid_ = opaque_tid();
    const int lane = tid_ & 63, wid = tid_ >> 6;
    const int wr = wid >> 2, wc = wid & 3, fr = lane & 15, fq = lane >> 4;
    float* sp = (float*)(smem + 139264);
    const int col0 = nt * 256 + wc * 64 + fq * 8;
#pragma unroll
    for (int mi = 0; mi < 8; ++mi) {
        const int rl = wr * 128 + mi * 16 + fr;
        const long row = row0 + rl;
        float mean = 0.f, rstd = 1.f;
        if (RES_LN) {
            const f32x4 p0 = *(const f32x4*)(rstats + row * 8), p1 = *(const f32x4*)(rstats + row * 8 + 4);
            const float s1 = (p0[0] + p0[2]) + (p1[0] + p1[2]), s2 = (p0[1] + p0[3]) + (p1[1] + p1[3]);
            mean = s1 * (1.0f / 1024.0f);
            const float var = fmaxf(s2 * (1.0f / 1024.0f) - mean * mean, 0.f);
            rstd = rsqrtf(var + LN_EPS);
        }
        float s1 = 0.f, s2 = 0.f;
#pragma unroll
        for (int q = 0; q < 2; ++q) {
            const long o = row * 1024 + col0 + q * 32;
            f32x4 x0, x1;
            if (RES_LN) {
                const u32x4 u = *(const u32x4*)(resid_bf16 + o);
                x0 = (f32x4){bf_lo(u.x), bf_hi(u.x), bf_lo(u.y), bf_hi(u.y)}; x1 = (f32x4){bf_lo(u.z), bf_hi(u.z), bf_lo(u.w), bf_hi(u.w)};
                x0 = (x0 - mean) * rstd * *(const f32x4*)(g + col0 + q * 32) + *(const f32x4*)(b + col0 + q * 32);
                x1 = (x1 - mean) * rstd * *(const f32x4*)(g + col0 + q * 32 + 4) + *(const f32x4*)(b + col0 + q * 32 + 4);
            } else { x0 = *(const f32x4*)(resid_f32 + o); x1 = *(const f32x4*)(resid_f32 + o + 4); }
            const f32x4 v0 = acc[mi][2 * q] + ALPHA * x0, v1 = acc[mi][2 * q + 1] + ALPHA * x1;
            { u32x4 w; w.x = pk_bf16(v0[0], v0[1]); w.y = pk_bf16(v0[2], v0[3]); w.z = pk_bf16(v1[0], v1[1]); w.w = pk_bf16(v1[2], v1[3]); *(u32x4*)(rbout + o) = w; }
            s1 += ((v0[0] + v0[1]) + (v0[2] + v0[3])) + ((v1[0] + v1[1]) + (v1[2] + v1[3]));
            s2 += ((v0[0] * v0[0] + v0[1] * v0[1]) + (v0[2] * v0[2] + v0[3] * v0[3])) + ((v1[0] * v1[0] + v1[1] * v1[1]) + (v1[2] * v1[2] + v1[3] * v1[3]));
        }
        s1 = fq_sum(s1); s2 = fq_sum(s2);
        if (fq == 0) { sp[(rl * 4 + wc) * 2] = s1; sp[(rl * 4 + wc) * 2 + 1] = s2; }
    }
    __syncthreads();
    if (tid_ < 256) {
        const int rl = tid_;
        const float a1 = (sp[rl * 8] + sp[rl * 8 + 2]) + (sp[rl * 8 + 4] + sp[rl * 8 + 6]);
        const float a2 = (sp[rl * 8 + 1] + sp[rl * 8 + 3]) + (sp[rl * 8 + 5] + sp[rl * 8 + 7]);
        *(f32x2*)(stout + ((long)(row0 + rl) * 4 + nt) * 2) = (f32x2){a1, a2};
    }
    __syncthreads();
}

__device__ __forceinline__ void ln_tile_stats(float* st, const float* rstats, int row0) {
    const int tid_ = opaque_tid();
    if (tid_ < 256) {
        const long row = row0 + tid_;
        const f32x4 p0 = *(const f32x4*)(rstats + row * 8), p1 = *(const f32x4*)(rstats + row * 8 + 4);
        const float s1 = (p0[0] + p0[2]) + (p1[0] + p1[2]), s2 = (p0[1] + p0[3]) + (p1[1] + p1[3]);
        const float mean = s1 * (1.0f / 1024.0f);
        const float var = fmaxf(s2 * (1.0f / 1024.0f) - mean * mean, 0.f);
        st[tid_ * 2] = mean; st[tid_ * 2 + 1] = rsqrtf(var + LN_EPS);
    }
}
__device__ __forceinline__ void ln_load_gb(float* gb, const float* g, const float* b) {
    for (int i = opaque_tid(); i < 1024; i += NTHR) { gb[i] = g[i]; gb[1024 + i] = b[i]; }
}


struct XcdSlab {
    int x, j, stride;
    __device__ __forceinline__ void init(int bid, int nb) { if ((nb & 7) == 0) { x = bid & 7; j = bid >> 3; stride = nb >> 3; } else { x = -1; j = bid; stride = nb; } }
    __device__ __forceinline__ int m_lo(int nM) const { return x < 0 ? 0 : (x * nM) >> 3; }
    __device__ __forceinline__ int m_hi(int nM) const { return x < 0 ? nM : ((x + 1) * nM) >> 3; }
};

template <int MAP>
__device__ __forceinline__ void ln_correct(f32x4 (&acc)[8][4], const float* rstats  , int row0, const float* cs, const float* bw, int nt) {
    const int tid_ = opaque_tid();
    const int lane = tid_ & 63, wid = tid_ >> 6;
    const int wr = wid >> 2, wc = wid & 3, fr = lane & 15, fq = lane >> 4;
    float mean[8], rstd[8];
#pragma unroll
    for (int mi = 0; mi < 8; ++mi) {
        const long row = row0 + wr * 128 + mi * 16 + fr;
        const f32x4 p0 = *(const f32x4*)(rstats + row * 8), p1 = *(const f32x4*)(rstats + row * 8 + 4);
        const float s1 = (p0[0] + p0[2]) + (p1[0] + p1[2]), s2 = (p0[1] + p0[3]) + (p1[1] + p1[3]);
        mean[mi] = s1 * (1.0f / 1024.0f);
        rstd[mi] = rsqrtf(fmaxf(s2 * (1.0f / 1024.0f) - mean[mi] * mean[mi], 0.f) + LN_EPS);
    }
#pragma unroll
    for (int ni = 0; ni < 4; ++ni) {
        const int col = MAP == 0 ? nt * 256 + wc * 64 + (ni >> 1) * 32 + fq * 8 + (ni & 1) * 4
                                 : (ni & 1) * 256 + nt * 128 + wc * 32 + fq * 8 + (ni >> 1) * 4;
        const f32x4 c4 = *(const f32x4*)(cs + col), b4 = *(const f32x4*)(bw + col);
#pragma unroll
        for (int mi = 0; mi < 8; ++mi) acc[mi][ni] = (acc[mi][ni] - mean[mi] * c4) * rstd[mi] + b4;
    }
}

__device__ __forceinline__ void epi_store_bf16_mx(const f32x16 (&acc)[4][2], float scale, bf16_t* out, long ld, int row0, int col0) {
    const int tid_ = opaque_tid();
    const int lane = tid_ & 63, wid = tid_ >> 6;
    const int wr = wid >> 2, wc = wid & 3, r = lane & 31, h = lane >> 5;
#pragma unroll
    for (int mi = 0; mi < 4; ++mi) {
        bf16_t* rp = out + (long)(row0 + wr * 128 + mi * 32 + r) * ld + col0 + wc * 64 + h * 16;
#pragma unroll
        for (int nj = 0; nj < 2; ++nj) {
            const f32x16 v = acc[mi][nj] * scale;
            u32x4 w0, w1;
            w0.x = pk_bf16(v[0], v[1]); w0.y = pk_bf16(v[2], v[3]); w0.z = pk_bf16(v[4], v[5]); w0.w = pk_bf16(v[6], v[7]);
            w1.x = pk_bf16(v[8], v[9]); w1.y = pk_bf16(v[10], v[11]); w1.z = pk_bf16(v[12], v[13]); w1.w = pk_bf16(v[14], v[15]);
            *(u32x4*)(rp + nj * 32) = w0; *(u32x4*)(rp + nj * 32 + 8) = w1;
        }
    }
}
struct TJob { const float* src; int ldsrc; int K; int col0; int ncols; bf16_t* dst; int mode; int rowoff; int f8;   const float* g; const float* b; float* part;   };
__device__ __forceinline__ int tjob_row(const TJob& j, int c) {
    if (j.mode == 0) return j.rowoff + c;
    const int oc = c & 127;
    return 256 * (c >> 7) + 64 * (oc >> 5) + 16 * (2 * ((oc >> 2) & 1) + j.rowoff) + 4 * ((oc >> 3) & 3) + (oc & 3);
}
__device__ __forceinline__ void transpose_tile(char* smem, const TJob& j, int kt, int ct) {
    float* tile = (float*)smem;
    float* red = tile + 64 * 65;
    const int tid = opaque_tid();
    float scs = 0.f, sbw = 0.f;
#pragma unroll
    for (int i = 0; i < 8; ++i) {
        const int e = tid + i * NTHR, kr = e >> 6, c = e & 63;
        const int cc = ct * 64 + c;
        float v = 0.f;
        if (cc < j.ncols) v = j.src[(long)(kt * 64 + kr) * j.ldsrc + j.col0 + cc];
        if (j.g) {
            const float gv = j.g[kt * 64 + kr], bv = j.b[kt * 64 + kr];
            sbw += bv * v;
            v *= gv;
            scs += __uint_as_float(pk_bf16(v, 0.f) << 16);
        }
        tile[kr * 65 + c] = v;
    }
    if (j.g) { red[(tid >> 6) * 64 + (tid & 63)] = scs; red[512 + (tid >> 6) * 64 + (tid & 63)] = sbw; }
    __syncthreads();
    if (j.f8) {
#pragma unroll
        for (int i = 0; i < 2; ++i) {
            const int e = tid + i * NTHR, c = e >> 4, k4 = (e & 15) * 4;
            const int cc = ct * 64 + c;
            if (cc < j.ncols) {
                const unsigned w = pk4_fp8(tile[k4 * 65 + c] * W8_SCALE, tile[(k4 + 1) * 65 + c] * W8_SCALE, tile[(k4 + 2) * 65 + c] * W8_SCALE, tile[(k4 + 3) * 65 + c] * W8_SCALE);
                *(unsigned*)((unsigned char*)j.dst + (long)tjob_row(j, cc) * j.K + kt * 64 + k4) = w;
            }
        }
    } else {
#pragma unroll
    for (int i = 0; i < 4; ++i) {
        const int e = tid + i * NTHR, c = e >> 5, k2 = (e & 31) * 2;
        const int cc = ct * 64 + c;
        if (cc < j.ncols) {
            const unsigned w = pk_bf16(tile[k2 * 65 + c], tile[(k2 + 1) * 65 + c]);
            *(unsigned*)(j.dst + (long)tjob_row(j, cc) * j.K + kt * 64 + k2) = w;
        }
    }
    }
    if (j.g && tid < 128) {
        const int which = tid >> 6, c = tid & 63;
        float s = 0.f;
#pragma unroll
        for (int w = 0; w < 8; ++w) s += red[which * 512 + w * 64 + c];
        if (ct * 64 + c < j.ncols) j.part[(long)(which * 16 + kt) * 1792 + ct * 64 + c] = s;
    }
    __syncthreads();
}

__device__ __forceinline__ void tjob_run(int& g_rot, char* smem, int bid, int nb, const float* src, int ld, int K, int col0, int ncols, bf16_t* dst, int mode, int rowoff,
                                         const float* g = nullptr, const float* b = nullptr, float* part = nullptr, int f8 = 0) {
    TJob j; j.f8 = f8; j.src = src; j.ldsrc = ld; j.K = K; j.col0 = col0; j.ncols = ncols; j.dst = dst; j.mode = mode; j.rowoff = rowoff; j.g = g; j.b = b; j.part = part;
    const int nkt = K / 64, nct = (ncols + 63) / 64, ntile = nkt * nct;
    const int first = (bid + nb - g_rot % nb) % nb;
    for (int t = first; t < ntile; t += nb) transpose_tile(smem, j, t % nkt, t / nkt);
    g_rot += ntile;
}

__device__ __forceinline__ void cvt_rows_bf16(const float* src, bf16_t* dst, long n8, int bid, int nb) {
    for (long i = (long)bid * NTHR + opaque_tid(); i < n8; i += (long)nb * NTHR) {
        const f32x4 a = *(const f32x4*)(src + i * 8), b = *(const f32x4*)(src + i * 8 + 4);
        u32x4 w; w.x = pk_bf16(a[0], a[1]); w.y = pk_bf16(a[2], a[3]); w.z = pk_bf16(b[0], b[1]); w.w = pk_bf16(b[2], b[3]);
        *(u32x4*)(dst + i * 8) = w;
    }
}

enum { I_X = 0, I_MEM, I_WIN, I_POSK, I_CKW1, I_CKW2, I_POSV, I_CVW1, I_CVW2, I_CONVW, I_IBIAS, I_FBIAS, I_NORMG, I_WOUT, I_LN1G, I_LN1B,
       I_XAWQ, I_XAWK, I_XAWV, I_XAWO, I_LN2G, I_LN2B, I_ROUTW, I_ROUTB, I_MW1, I_MW3, I_MW2, I_SW1, I_SW3, I_SW2, I_LN3G, I_LN3B };

__device__ __forceinline__ void phase0(const Params& p, char* smem, int bid, int nb) {
    char* ws = p.ws;
    int rot = 0;
    tjob_run(rot, smem, bid, nb, p.in[I_WIN], 3360, 1024, 0, 1280, (bf16_t*)(ws + WS_WIN), 0, 0, nullptr, nullptr, nullptr, INPROJ_F8);
    tjob_run(rot, smem, bid, nb, p.in[I_WIN], 3360, 1024, 1304, 2048, (bf16_t*)(ws + WS_WIN), 0, 1280, nullptr, nullptr, nullptr, INPROJ_F8);
    tjob_run(rot, smem, bid, nb, p.in[I_WIN], 3360, 1024, 1280, 24, (bf16_t*)(ws + WS_WIN), 0, 3328, nullptr, nullptr, nullptr, INPROJ_F8);
    tjob_run(rot, smem, bid, nb, p.in[I_WIN], 3360, 1024, 3352, 8, (bf16_t*)(ws + WS_WIN), 0, 3352, nullptr, nullptr, nullptr, INPROJ_F8);
    tjob_run(rot, smem, bid, nb, p.in[I_WOUT], 1024, 1024, 0, 1024, (bf16_t*)(ws + WS_WOUT), 0, 0);
    float* lnp = (float*)(ws + WS_LNP);
    tjob_run(rot, smem, bid, nb, p.in[I_XAWQ], 1024, 1024, 0, 1024, (bf16_t*)(ws + WS_WQ), 0, 0, p.in[I_LN1G], p.in[I_LN1B], lnp);
    tjob_run(rot, smem, bid, nb, p.in[I_XAWK], 1024, 1024, 0, 1024, (bf16_t*)(ws + WS_WKV), 0, 0);
    tjob_run(rot, smem, bid, nb, p.in[I_XAWV], 1024, 1024, 0, 1024, (bf16_t*)(ws + WS_WKV), 0, 1024);
    tjob_run(rot, smem, bid, nb, p.in[I_XAWO], 1024, 1024, 0, 1024, (bf16_t*)(ws + WS_WO), 0, 0);
    tjob_run(rot, smem, bid, nb, p.in[I_ROUTW], 256, 1024, 0, 256, (bf16_t*)(ws + WS_WR), 0, 0, p.in[I_LN2G], p.in[I_LN2B], lnp + 1024);
    tjob_run(rot, smem, bid, nb, p.in[I_SW1], 256, 1024, 0, 256, (bf16_t*)(ws + WS_WS13), 1, 0, p.in[I_LN2G], p.in[I_LN2B], lnp + 1280);
    tjob_run(rot, smem, bid, nb, p.in[I_SW3], 256, 1024, 0, 256, (bf16_t*)(ws + WS_WS13), 1, 1, p.in[I_LN2G], p.in[I_LN2B], lnp + 1536);
    tjob_run(rot, smem, bid, nb, p.in[I_SW2], 1024, 256, 0, 1024, (bf16_t*)(ws + WS_WS2), 0, 0);
    tjob_run(rot, smem, bid, nb, p.in[I_CKW1], 64, 2048, 0, 64, (bf16_t*)(ws + WS_CK1), 0, 0);
    tjob_run(rot, smem, bid, nb, p.in[I_CKW2], 64, 64, 0, 64, (bf16_t*)(ws + WS_CK2), 0, 0);
    tjob_run(rot, smem, bid, nb, p.in[I_CVW1], 64, 2048, 0, 64, (bf16_t*)(ws + WS_CV1), 0, 0);
    tjob_run(rot, smem, bid, nb, p.in[I_CVW2], 64, 64, 0, 64, (bf16_t*)(ws + WS_CV2), 0, 0);
#if INPROJ_F8
    for (long i = (long)bid * NTHR + opaque_tid(); i < (long)T_TOK * 1024 / 8; i += (long)nb * NTHR) {
        const f32x4 a = *(const f32x4*)(p.in[I_X] + i * 8), b = *(const f32x4*)(p.in[I_X] + i * 8 + 4);
        u32x2 w; w.x = pk4_fp8(a[0], a[1], a[2], a[3]); w.y = pk4_fp8(b[0], b[1], b[2], b[3]);
        *(u32x2*)((unsigned char*)(ws + WS_XB) + i * 8) = w;
    }
#else
    cvt_rows_bf16(p.in[I_X], (bf16_t*)(ws + WS_XB), (long)T_TOK * 1024 / 8, bid, nb);
#endif
    cvt_rows_bf16(p.in[I_MEM], (bf16_t*)(ws + WS_MEMB), (long)4096 * 1024 / 8, bid, nb);
    { int* c = (int*)(ws + WS_CNT); for (int i = bid * NTHR + opaque_tid(); i < 24576; i += nb * NTHR) c[i] = 0; }
}

__device__ __forceinline__ void small_cols_task(const Params& p, int task) {
    const bf16_t* xb = (const bf16_t*)(p.ws + WS_XB);
    const bf16_t* wt = (const bf16_t*)(p.ws + WS_WIN) + (long)3328 * 1024;
    float* psm = (float*)(p.ws + WS_PSM);
    const int tid_ = opaque_tid();
    const int lane = tid_ & 63, wid = tid_ >> 6, fr = lane & 15, fq = lane >> 4;
    const int r0 = task * 256 + wid * 32;
    f32x4 acc[2][2];
#pragma unroll
    for (int mi = 0; mi < 2; ++mi)
#pragma unroll
        for (int ni = 0; ni < 2; ++ni) acc[mi][ni] = (f32x4){0.f, 0.f, 0.f, 0.f};
    const bf16_t* ap0 = xb + (long)(r0 + fr) * 1024 + fq * 8;
    const bf16_t* ap1 = ap0 + 16 * 1024;
    const bf16_t* bp0 = wt + (long)fr * 1024 + fq * 8;
    const bf16_t* bp1 = bp0 + 16 * 1024;
#pragma unroll 4
    for (int ks = 0; ks < 32; ++ks) {
        const bf16x8 a0 = *(const bf16x8*)(ap0 + ks * 32), a1 = *(const bf16x8*)(ap1 + ks * 32);
        const bf16x8 b0 = *(const bf16x8*)(bp0 + ks * 32), b1 = *(const bf16x8*)(bp1 + ks * 32);
        acc[0][0] = mfma16(b0, a0, acc[0][0]); acc[0][1] = mfma16(b1, a0, acc[0][1]);
        acc[1][0] = mfma16(b0, a1, acc[1][0]); acc[1][1] = mfma16(b1, a1, acc[1][1]);
    }
#pragma unroll
    for (int mi = 0; mi < 2; ++mi)
#pragma unroll
        for (int ni = 0; ni < 2; ++ni) *(f32x4*)(psm + (long)(r0 + mi * 16 + fr) * 32 + ni * 16 + fq * 4) = acc[mi][ni];
}

template <int NOEPI = 0>
__device__ __forceinline__ void phase1(const Params& p, char* smem, int bid, int nb) {
    char* ws = p.ws;
    XcdSlab xs; xs.init(bid, nb);
    const int a_lo = xs.m_lo(128), a_nm = xs.m_hi(128) - a_lo, a_n = a_nm * 14;
    const int b_lo = xs.m_lo(16), b_nm = xs.m_hi(16) - b_lo, b_n = b_nm * 8;
#if INPROJ_F8
    {
        int mt = 0, nt = 0;
        RingF8 al, bl;
        auto setup = [&](int u) {
            mt = a_lo + u % a_nm; nt = u / a_nm;
            al.init_contig((const unsigned char*)(ws + WS_XB), 1024, (long)mt * 256);
            bl.init_contig((const unsigned char*)(ws + WS_WIN), 1024, (long)nt * 256, true);
        };
        int u = xs.j;
        if (u < a_n) { setup(u); ring_f8_issue3(smem, al, bl); }
        while (u < a_n) {
            const int cmt = mt, cnt_ = nt;
            f32x16 acc[4][2];
            gemm_ring_mx_main(smem, al, bl, 16, acc);
            u += xs.stride;
            if (u < a_n) { setup(u); ring_f8_issue3(smem, al, bl); }
            if (NOEPI) { float s = 0.f;
#pragma unroll
                for (int mi = 0; mi < 4; ++mi) s += acc[mi][0][0] + acc[mi][1][5];
                if (s == 123.456f) ((float*)(ws + WS_A + 432 * MB))[opaque_tid()] = s; continue; }
            if (cnt_ < 13) epi_store_bf16_mx(acc, 1.0f / W8_SCALE, (bf16_t*)(ws + WS_P), PW, cmt * 256, cnt_ * 256);
            else {
                const int tid_ = opaque_tid();
                const int lane = tid_ & 63, wid = tid_ >> 6, wr = wid >> 2, wc = wid & 3, r = lane & 31, h = lane >> 5;
                if (wc == 0) {
                    float* psm = (float*)(ws + WS_PSM);
#pragma unroll
                    for (int mi = 0; mi < 4; ++mi) {
                        const f32x16 v = acc[mi][0] * (1.0f / W8_SCALE);
                        float* rp = psm + (long)(cmt * 256 + wr * 128 + mi * 32 + r) * 32 + h * 16;
#pragma unroll
                        for (int q4 = 0; q4 < 4; ++q4) *(f32x4*)(rp + q4 * 4) = (f32x4){v[q4 * 4], v[q4 * 4 + 1], v[q4 * 4 + 2], v[q4 * 4 + 3]};
                    }
                }
            }
        }
        asm volatile("s_waitcnt vmcnt(0)" ::: "memory"); __syncthreads();
    }
    const int a_n2 = 0;
#else
    const int a_n2 = a_n;
#endif
    bool inp = false; int mt = 0, nt = 0;
    RingRows al, bl;
    auto setup = [&](int u) {
        inp = u < a_n2;
        const int uu = inp ? u : u - a_n2;
        const int nm = inp ? a_nm : b_nm;
        if (inp && (a_nm & 3) == 0) {
            const int per_mblk = 4 * 14, mblk = uu / per_mblk, rr = uu % per_mblk;
            const int ngrp = rr >> 5, r32 = rr & 31;
            mt = a_lo + mblk * 4 + (r32 & 3); nt = ngrp * 8 + (r32 >> 2);
        } else { mt = (inp ? a_lo : b_lo) + uu % nm; nt = uu / nm; }
        al.init_contig((const bf16_t*)(ws + (inp ? WS_XB : WS_MEMB)), 1024, mt * 256);
        bl.init_contig((const bf16_t*)(ws + (inp ? WS_WIN : WS_WKV)), 1024, nt * 256, true);
    };
    int u = xs.j;
    if (u < a_n2 + b_n) { setup(u); ring_issue3(smem, al, bl); }
    while (u < a_n2 + b_n) {
        const bool cinp = inp; const int cmt = mt, cnt_ = nt;
        f32x4 acc[8][4];
        gemm_ring<RingRows, RingRows, 0, true>(smem, al, bl, 32, acc);
        u += xs.stride;
        if (u < a_n2 + b_n) { setup(u); ring_issue3(smem, al, bl); }
        if (NOEPI) { float s = 0.f;
#pragma unroll
            for (int mi = 0; mi < 8; ++mi)
#pragma unroll
                for (int ni = 0; ni < 4; ++ni) s += acc[mi][ni][0] + acc[mi][ni][1] + acc[mi][ni][2] + acc[mi][ni][3];
            if (s == 123.456f) ((float*)(ws + WS_A + 432 * MB))[opaque_tid()] = s; continue; }
        if (!cinp) epi_store_bf16(acc, (bf16_t*)(ws + WS_KVX), 2048, cmt * 256, cnt_ * 256);
        else if (cnt_ < 13) epi_store_bf16(acc, (bf16_t*)(ws + WS_P), PW, cmt * 256, cnt_ * 256);
        else {
            const int tid_ = opaque_tid();
            const int lane = tid_ & 63, wid = tid_ >> 6, wr = wid >> 2, wc = wid & 3, fr = lane & 15, fq = lane >> 4;
            if (wc == 0) {
                float* psm = (float*)(ws + WS_PSM);
#pragma unroll
                for (int mi = 0; mi < 8; ++mi)
#pragma unroll
                    for (int ni = 0; ni < 2; ++ni) *(f32x4*)(psm + (long)(cmt * 256 + wr * 128 + mi * 16 + fr) * 32 + fq * 8 + ni * 4) = acc[mi][ni];
            }
        }
    }
    asm volatile("s_waitcnt vmcnt(0)" ::: "memory");
}

__device__ __forceinline__ void compress_task(const Params& p, char* smem, int which, int rb) {
    const char* ws = p.ws;
    const bf16_t* P = (const bf16_t*)(ws + WS_P);
    const float* pos = p.in[which ? I_POSV : I_POSK];
    const bf16_t* w1t = (const bf16_t*)(ws + (which ? WS_CV1 : WS_CK1));
    const bf16_t* w2t = (const bf16_t*)(ws + (which ? WS_CV2 : WS_CK2));
    bf16_t* outp = (bf16_t*)(p.ws + (which ? WS_VCMP : WS_KCMP));
    const int colbase = which ? PC_VC : PC_KC;
    const int tid_ = opaque_tid();
    const int lane = tid_ & 63, wid = tid_ >> 6, fr = lane & 15, fq = lane >> 4;
    f32x4 acc[2][4];
#pragma unroll
    for (int mi = 0; mi < 2; ++mi)
#pragma unroll
        for (int ni = 0; ni < 4; ++ni) acc[mi][ni] = (f32x4){0.f, 0.f, 0.f, 0.f};
    const bf16_t* arow[2];
#pragma unroll
    for (int mi = 0; mi < 2; ++mi) {
        const int r = rb * 32 + mi * 16 + fr;
        const int b = r / 254, rem = r - b * 254, c = rem >> 1, g = rem & 1;
        arow[mi] = P + (long)(b * 2048 + c * 16) * PW + colbase + g * 64 + fq * 8;
    }
    const bf16_t* brow = w1t + (long)fr * 2048 + fq * 8;
    const float* prow = pos + fq * 8;
#pragma unroll 2
    for (int s = 0; s < 8; ++s) {
        const int ks = wid * 8 + s;
        const int l = ks >> 1, d0 = (ks & 1) * 32;
        const f32x4 p0 = *(const f32x4*)(prow + l * 64 + d0), p1 = *(const f32x4*)(prow + l * 64 + d0 + 4);
        bf16x8 af[2];
#pragma unroll
        for (int mi = 0; mi < 2; ++mi) {
            const u32x4 av = *(const u32x4*)(arow[mi] + (long)l * PW + d0);
            u32x4 aw;
            aw.x = pk_bf16(bf_lo(av.x) + p0[0], bf_hi(av.x) + p0[1]); aw.y = pk_bf16(bf_lo(av.y) + p0[2], bf_hi(av.y) + p0[3]);
            aw.z = pk_bf16(bf_lo(av.z) + p1[0], bf_hi(av.z) + p1[1]); aw.w = pk_bf16(bf_lo(av.w) + p1[2], bf_hi(av.w) + p1[3]);
            af[mi] = as_bf16x8(aw);
        }
#pragma unroll
        for (int ni = 0; ni < 4; ++ni) {
            const bf16x8 bb = *(const bf16x8*)(brow + (long)(ni * 16) * 2048 + ks * 32);
            acc[0][ni] = mfma16(bb, af[0], acc[0][ni]);
            acc[1][ni] = mfma16(bb, af[1], acc[1][ni]);
        }
    }
    f32x4* part = (f32x4*)(smem + 8192);
#pragma unroll
    for (int mi = 0; mi < 2; ++mi)
#pragma unroll
        for (int ni = 0; ni < 4; ++ni) part[(wid * 8 + mi * 4 + ni) * 64 + lane] = acc[mi][ni];
    __syncthreads();
    const int mi = wid >> 2, ni = wid & 3;
    f32x4 a1 = (f32x4){0.f, 0.f, 0.f, 0.f};
#pragma unroll
    for (int w = 0; w < 8; ++w) a1 = a1 + part[(w * 8 + wid) * 64 + lane];
    bf16_t* h1 = (bf16_t*)smem;
    {
        u32x2 w; w.x = pk_bf16(siluf_(a1[0]), siluf_(a1[1])); w.y = pk_bf16(siluf_(a1[2]), siluf_(a1[3]));
        *(u32x2*)(h1 + (mi * 16 + fr) * 72 + ni * 16 + fq * 4) = w;
    }
    __syncthreads();
    f32x4 acc2 = (f32x4){0.f, 0.f, 0.f, 0.f};
#pragma unroll
    for (int ks = 0; ks < 2; ++ks) {
        const bf16x8 a = *(const bf16x8*)(h1 + (mi * 16 + fr) * 72 + ks * 32 + fq * 8);
        const bf16x8 bb = *(const bf16x8*)(w2t + (ni * 16 + fr) * 64 + ks * 32 + fq * 8);
        acc2 = mfma16(bb, a, acc2);
    }
    {
        const int r = rb * 32 + mi * 16 + fr;
        const int b = r / 254, rem = r - b * 254, c = rem >> 1, g = rem & 1;
        u32x2 w; w.x = pk_bf16(acc2[0], acc2[1]); w.y = pk_bf16(acc2[2], acc2[3]);
        *(u32x2*)(outp + ((long)(b * 2 + g) * 128 + c) * 64 + ni * 16 + fq * 4) = w;
    }
    __syncthreads();
}

__device__ __forceinline__ void phase2(const Params& p, char* smem, int bid, int nb) {
    char* ws = p.ws;
    {
        const int idx = bid * NTHR + opaque_tid();
        if (idx < 2 * 1792) {
            const float* pp = (const float*)(ws + WS_LNP) + (long)(idx / 1792) * 16 * 1792 + idx % 1792;
            float s = 0.f;
#pragma unroll
            for (int k = 0; k < 16; ++k) s += pp[k * 1792];
            ((float*)(ws + WS_LNF))[idx] = s;
        }
    }
    for (int t = bid; t < 254; t += nb) compress_task(p, smem, t / 127, t % 127);
    const int tid_ = opaque_tid();
    if (bid < 32 && tid_ < 32) {
        bf16_t* kc = (bf16_t*)(ws + WS_KCMP) + ((long)bid * 128 + 127) * 64;
        bf16_t* vc = (bf16_t*)(ws + WS_VCMP) + ((long)bid * 128 + 127) * 64;
        ((unsigned*)kc)[tid_] = 0u; ((unsigned*)vc)[tid_] = 0u;
    }
    const bf16_t* P = (const bf16_t*)(ws + WS_P);
    const float* cw = p.in[I_CONVW];
    bf16_t* qk = (bf16_t*)(ws + WS_QK);
    for (long it = (long)bid * NTHR + tid_; it < (long)T_TOK * 128; it += (long)nb * NTHR) {
        const int t = (int)(it >> 7), ch = (int)(it & 127);
        const int s = t & (SEQ - 1);
        float a[8];
#pragma unroll
        for (int e = 0; e < 8; ++e) a[e] = 0.f;
#pragma unroll
        for (int j = 0; j < 4; ++j) {
            if (s - 3 + j >= 0) {
                const u32x4 u = *(const u32x4*)(P + (long)(t - 3 + j) * PW + PC_MQ + ch * 8);
                const f32x4 w0 = *(const f32x4*)(cw + j * 1024 + ch * 8), w1 = *(const f32x4*)(cw + j * 1024 + ch * 8 + 4);
                a[0] += w0[0] * bf_lo(u.x); a[1] += w0[1] * bf_hi(u.x); a[2] += w0[2] * bf_lo(u.y); a[3] += w0[3] * bf_hi(u.y);
                a[4] += w1[0] * bf_lo(u.z); a[5] += w1[1] * bf_hi(u.z); a[6] += w1[2] * bf_lo(u.w); a[7] += w1[3] * bf_hi(u.w);
            }
        }
        const float sc = ch < 64 ? 0.08838834764831845f : 1.0f;
        u32x4 w;
        w.x = pk_bf16(siluf_(a[0]) * sc, siluf_(a[1]) * sc); w.y = pk_bf16(siluf_(a[2]) * sc, siluf_(a[3]) * sc);
        w.z = pk_bf16(siluf_(a[4]) * sc, siluf_(a[5]) * sc); w.w = pk_bf16(siluf_(a[6]) * sc, siluf_(a[7]) * sc);
        *(u32x4*)(qk + (long)t * 1024 + ch * 8) = w;
    }
}

typedef __attribute__((address_space(3))) s16x4 lds_s16x4;
__device__ __forceinline__ s16x4 lds_tr(const char* a) { return __builtin_amdgcn_ds_read_tr16_b64_v4i16((lds_s16x4*)a); }
__device__ __forceinline__ bf16x8 tr_frag_perm(const char* base, int pitch, int rbase, int cbase, int fr, int fq) {
    const char* a0 = base + (rbase + 4 * fq + (fr >> 2)) * pitch + (cbase + 4 * (fr & 3)) * 2;
    const s16x4 lo = lds_tr(a0), hi = lds_tr(a0 + 16 * pitch);
    return (bf16x8){lo[0], lo[1], lo[2], lo[3], hi[0], hi[1], hi[2], hi[3]};
}
__device__ __forceinline__ bf16x8 tr_frag_std(const char* base, int pitch, int rbase, int cbase, int fr, int fq) {
    const char* a0 = base + (rbase + 8 * fq + (fr >> 2)) * pitch + (cbase + 4 * (fr & 3)) * 2;
    const s16x4 lo = lds_tr(a0), hi = lds_tr(a0 + 4 * pitch);
    return (bf16x8){lo[0], lo[1], lo[2], lo[3], hi[0], hi[1], hi[2], hi[3]};
}
__device__ __forceinline__ bf16x8 pack_p(const f32x4 a, const f32x4 b) {
    u32x4 w; w.x = pk_bf16(a[0], a[1]); w.y = pk_bf16(a[2], a[3]); w.z = pk_bf16(b[0], b[1]); w.w = pk_bf16(b[2], b[3]);
    return as_bf16x8(w);
}

__device__ __forceinline__ float dpp_xor1(float v) { return __builtin_bit_cast(float, __builtin_amdgcn_mov_dpp(__builtin_bit_cast(int, v), 0xB1, 0xF, 0xF, true)); }
__device__ __forceinline__ float dpp_xor2(float v) { return __builtin_bit_cast(float, __builtin_amdgcn_mov_dpp(__builtin_bit_cast(int, v), 0x4E, 0xF, 0xF, true)); }

constexpr int NSA_PITCH = 160;
constexpr int NSA_KC = 0, NSA_VC = 20480, NSA_KT = 40960, NSA_VT = 61440, NSA_MISC = 81920, NSA_Y = 83968;

struct NsaState {
    bf16x8 qf[2][2];
    int tl[2];
    unsigned selm[2];
    unsigned wunion, bunion;
    unsigned tunion[2];
};

constexpr int NSA_STG = 16384;
__device__ __forceinline__ bf16x8 tr_frag_perm_swz(const char* base, int rbase, int dt, int fr, int fq) {
    const int R = rbase + 4 * fq + (fr >> 2), c = 2 * dt + ((fr & 3) >> 1);
    const char* a0 = base + R * 128 + ((c ^ (R & 7)) << 4) + 8 * (fr & 1);
    const s16x4 lo = lds_tr(a0), hi = lds_tr(a0 + 16 * 128);
    return (bf16x8){lo[0], lo[1], lo[2], lo[3], hi[0], hi[1], hi[2], hi[3]};
}

#define NSA_WAITV(n) asm volatile("s_waitcnt vmcnt(" #n ")" ::: "memory")
#define NSA_BAR() do { asm volatile("s_waitcnt lgkmcnt(0)" ::: "memory"); __builtin_amdgcn_s_barrier(); asm volatile("" ::: "memory"); } while (0)

template <int MODE>
__device__ __forceinline__ void nsa_stream(char* smem, const bf16_t* Pb  , int g, int i, NsaState& st, float gate0, float gate1, const int tid) {
    const int lane = tid & 63, fr = lane & 15, fq = lane >> 4;
    const int kcol = (MODE == 0 ? PC_KS : PC_KW) + g * 64, vcol = (MODE == 0 ? PC_VS : PC_VW) + g * 64;
    const int lrow = tid >> 3, lch = (tid & 7) ^ (lrow & 7);
    const bf16_t* ksrc = Pb + (long)lrow * PW + kcol + lch * 8;
    const bf16_t* vsrc = Pb + (long)lrow * PW + vcol + lch * 8;
    const int jlo = MODE == 0 ? 0 : (i - 8 > 0 ? i - 8 : 0);
    const unsigned range = (i >= 31 ? 0xffffffffu : ((1u << (i + 1)) - 1u)) & ~((1u << jlo) - 1u);
    const unsigned need = (unsigned)__builtin_amdgcn_readfirstlane((int)((MODE == 0 ? st.bunion : 0xffffffffu) & range));
    f32x4 O[2][4];
    float m[2], l[2];
    int tlq[2];
#pragma unroll
    for (int mt = 0; mt < 2; ++mt) { m[mt] = -1e30f; l[mt] = 0.f; tlq[mt] = st.tl[mt] - 4 * fq;
#pragma unroll
        for (int dt = 0; dt < 4; ++dt) O[mt][dt] = (f32x4){0.f, 0.f, 0.f, 0.f}; }
    unsigned pm = need;
    int nissued = 0;
    auto issue_next = [&]() {
        const int jj = __builtin_ctz(pm); pm &= pm - 1u;
        char* sb = smem + (nissued & 3) * NSA_STG;
        __builtin_amdgcn_global_load_lds((glb_u32*)(ksrc + (long)jj * 64 * PW), (lds_u32*)(sb + tid * 16), 16, 0, 0);
        __builtin_amdgcn_global_load_lds((glb_u32*)(vsrc + (long)jj * 64 * PW), (lds_u32*)(sb + 8192 + tid * 16), 16, 0, 0);
        ++nissued;
    };
    const int L = __builtin_popcount(need);
    if (L > 0) issue_next();
    if (L > 1) issue_next();
    if (L > 2) issue_next();
    if (L > 2) NSA_WAITV(4); else if (L > 1) NSA_WAITV(2); else NSA_WAITV(0);
    NSA_BAR();
    unsigned cm = need;
    for (int n = 0; n < L; ++n) {
        const int j = __builtin_ctz(cm); cm &= cm - 1u;
        if (n + 3 < L) issue_next();
        const char* KT = smem + (n & 3) * NSA_STG;
        const char* VT = KT + 8192;
        const bool on0 = MODE == 0 ? (((st.tunion[0] >> j) & 1u) != 0u) : true, on1 = MODE == 0 ? (((st.tunion[1] >> j) & 1u) != 0u) : true;
        if (on0 || on1) {
            f32x4 S[2][4];
            {
                bf16x8 kf[4][2];
#pragma unroll
                for (int nt = 0; nt < 4; ++nt)
#pragma unroll
                    for (int ks = 0; ks < 2; ++ks) kf[nt][ks] = *(const bf16x8*)(KT + (16 * nt + fr) * 128 + (((ks * 4 + fq) ^ (fr & 7)) << 4));
#pragma unroll
                for (int mt = 0; mt < 2; ++mt) {
                    if (MODE == 0 && !(mt == 0 ? on0 : on1)) continue;
#pragma unroll
                    for (int nt = 0; nt < 4; ++nt) {
                        f32x4 s = (f32x4){0.f, 0.f, 0.f, 0.f};
                        s = mfma16(kf[nt][0], st.qf[mt][0], s);
                        s = mfma16(kf[nt][1], st.qf[mt][1], s);
                        S[mt][nt] = s;
                    }
                }
            }
            bf16x8 pf[2][2];
            const bool edge = (j == i) || (MODE == 1 && j == i - 8);
            constexpr float CS = 0.125f * 1.4426950408889634f;
#pragma unroll
            for (int mt = 0; mt < 2; ++mt) {
                if (MODE == 0 && !(mt == 0 ? on0 : on1)) continue;
                const bool rowsel = MODE == 0 ? (((st.selm[mt] >> j) & 1u) != 0u) : true;
                if (edge) {
                    asm volatile("; boundary tile" ::: "memory");
#pragma unroll
                    for (int nt = 0; nt < 4; ++nt)
#pragma unroll
                        for (int e = 0; e < 4; ++e) {
                            const int kc = 16 * nt + e;
                            bool ok = true;
                            if (j == i) ok = ok && (kc <= tlq[mt]);
                            if (MODE == 1) { if (j == i - 8) ok = ok && (kc > tlq[mt]); }
                            S[mt][nt][e] = ok ? S[mt][nt][e] : -INFINITY;
                        }
                }
                float mx = -INFINITY;
#pragma unroll
                for (int nt = 0; nt < 4; ++nt)
#pragma unroll
                    for (int e = 0; e < 4; ++e) mx = __builtin_fmaxf(mx, S[mt][nt][e]);
                mx = fq_max(mx);
                if (MODE == 0) mx = rowsel ? mx : -INFINITY;
                const float mnew = __builtin_fmaxf(m[mt], mx * CS);
                const float alpha = __builtin_amdgcn_exp2f(m[mt] - mnew);
                const float msub = (MODE == 0 && !rowsel) ? INFINITY : mnew;
                float rs = 0.f;
#pragma unroll
                for (int nt = 0; nt < 4; ++nt)
#pragma unroll
                    for (int e = 0; e < 4; ++e) { const float pv = __builtin_amdgcn_exp2f(__builtin_fmaf(S[mt][nt][e], CS, -msub)); S[mt][nt][e] = pv; rs += pv; }
                rs = fq_sum(rs);
                l[mt] = l[mt] * alpha + rs; m[mt] = mnew;
#pragma unroll
                for (int dt = 0; dt < 4; ++dt) O[mt][dt] = O[mt][dt] * alpha;
                pf[mt][0] = pack_p(S[mt][0], S[mt][1]); pf[mt][1] = pack_p(S[mt][2], S[mt][3]);
            }
#pragma unroll
            for (int ks2 = 0; ks2 < 2; ++ks2)
#pragma unroll
                for (int dt = 0; dt < 4; ++dt) {
                    const bf16x8 vf = tr_frag_perm_swz(VT, 32 * ks2, dt, fr, fq);
                    if (MODE != 0 || on0) O[0][dt] = mfma16(vf, pf[0][ks2], O[0][dt]);
                    if (MODE != 0 || on1) O[1][dt] = mfma16(vf, pf[1][ks2], O[1][dt]);
                }
        }
        if (n + 1 < L) { if (n + 3 < L) NSA_WAITV(4); else if (n + 2 < L) NSA_WAITV(2); else NSA_WAITV(0); }
        NSA_BAR();
    }
#pragma unroll
    for (int mt = 0; mt < 2; ++mt) {
        const float gsc = (mt == 0 ? gate0 : gate1) * (l[mt] > 0.f ? 1.0f / l[mt] : 0.f);
#pragma unroll
        for (int dt = 0; dt < 4; ++dt) { f32x4* yp = (f32x4*)(smem + NSA_Y) + (mt * 4 + dt) * NTHR + tid; *yp = *yp + O[mt][dt] * gsc; }
    }
}

__device__ __forceinline__ void nsa_cmp_one(const char* smem, const bf16x8 qf0, const bf16x8 qf1, const int t, const int i, const float gate0, f32x4* yp  , unsigned& selm, const int lane) {
    const int fr = lane & 15, fq = lane >> 4;
        const int cl = (t >= 31 ? ((t - 31) >> 4) : -1) - 4 * fq;
        f32x4 S[8];
#pragma unroll
        for (int nt = 0; nt < 8; ++nt) {
            f32x4 s = (f32x4){0.f, 0.f, 0.f, 0.f};
#pragma unroll
            for (int ks = 0; ks < 2; ++ks) {
                const bf16x8 kf = *(const bf16x8*)(smem + NSA_KC + (16 * nt + fr) * NSA_PITCH + (ks * 4 + fq) * 16);
                s = mfma16(kf, (ks == 0 ? qf0 : qf1), s);
            }
            S[nt] = s;
        }
        float mx = -INFINITY;
#pragma unroll
        for (int nt = 0; nt < 8; ++nt)
#pragma unroll
            for (int e = 0; e < 4; ++e) {
                const float sv = (16 * nt + e <= cl) ? S[nt][e] * 0.125f : -INFINITY;
                S[nt][e] = sv; mx = fmaxf(mx, sv);
            }
        mx = fq_max(mx);
        const float mref = fmaxf(mx, -1e30f);
        float rs = 0.f;
#pragma unroll
        for (int nt = 0; nt < 8; ++nt)
#pragma unroll
            for (int e = 0; e < 4; ++e) { const float pv = __expf(S[nt][e] - mref); S[nt][e] = pv; rs += pv; }
        rs = fq_sum(rs);
        const float inv = rs > 0.f ? 1.0f / rs : 0.f;
#pragma unroll
        for (int nt = 0; nt < 8; ++nt) S[nt] = S[nt] * inv;
        {
            f32x4 O[4];
#pragma unroll
            for (int dt = 0; dt < 4; ++dt) O[dt] = (f32x4){0.f, 0.f, 0.f, 0.f};
#pragma unroll
            for (int ks2 = 0; ks2 < 4; ++ks2) {
                const bf16x8 pf = pack_p(S[2 * ks2], S[2 * ks2 + 1]);
#pragma unroll
                for (int dt = 0; dt < 4; ++dt) {
                    const bf16x8 vf = tr_frag_perm(smem + NSA_VC, NSA_PITCH, 32 * ks2, 16 * dt, fr, fq);
                    O[dt] = mfma16(vf, pf, O[dt]);
                }
            }
#pragma unroll
            for (int dt = 0; dt < 4; ++dt) yp[dt * NTHR] = O[dt] * gate0;
        }
        float imp[8];
        {
            float own[8], last[8];
#pragma unroll
            for (int nt = 0; nt < 8; ++nt) {
                f32x4 v = S[nt];
#pragma unroll
                for (int e = 0; e < 4; ++e) { v[e] += dpp_xor1(v[e]); v[e] += dpp_xor2(v[e]); }
                own[nt] = (v[0] + v[1]) + (v[2] + v[3]); last[nt] = v[3];
            }
            const int src = (lane + 48) & 63;
#pragma unroll
            for (int nt = 0; nt < 8; ++nt) {
                const float a = __shfl(last[nt], src);
                const float bsh = nt > 0 ? __shfl(last[nt > 0 ? nt - 1 : 0], src) : 0.f;
                const float prevc = fq > 0 ? a : bsh;
                const int n = 4 * nt + fq;
                const float pslc = own[nt] + prevc;
                const bool valid = n <= i;
                const bool forced = (n == 0) || (n == i) || (n == i - 1);
                imp[nt] = valid ? pslc + (forced ? 1e4f : 0.f) : -1e30f;
            }
        }
        unsigned mask = 0u;
#pragma unroll 1
        for (int r = 0; r < 8; ++r) {
            float bv = imp[0]; int bn = fq;
#pragma unroll
            for (int nt = 1; nt < 8; ++nt) { if (imp[nt] > bv) { bv = imp[nt]; bn = 4 * nt + fq; } }
#pragma unroll
            for (int off = 16; off <= 32; off <<= 1) {
                const float ov = __shfl_xor(bv, off); const int on = __shfl_xor(bn, off);
                if (ov > bv || (ov == bv && on < bn)) { bv = ov; bn = on; }
            }
            if (bv > -5e29f) mask |= 1u << bn;
#pragma unroll
            for (int nt = 0; nt < 8; ++nt) if (bn == 4 * nt + fq) imp[nt] = -3.0e38f;
        }
        selm = mask;
}

template <int NSAV = 7  >
__device__ __forceinline__ void nsa_task(const Params& p, char* smem, int b, int g, int i) {
    const char* ws = p.ws;
    const bf16_t* Pb = (const bf16_t*)(ws + WS_P) + (long)b * SEQ * PW;
    const float* psm = (const float*)(ws + WS_PSM) + (long)b * SEQ * 32;
    int tid = threadIdx.x;
    asm volatile("" : "+v"(tid));
    const int lane = tid & 63, wid = __builtin_amdgcn_readfirstlane(tid >> 6), fr = lane & 15, fq = lane >> 4;
    const int qs = i * 64;
    NsaState st;
    float gate[2][3];
#pragma unroll
    for (int mt = 0; mt < 2; ++mt) {
        st.tl[mt] = 8 * wid + 4 * mt + (fr >> 2);
        const int h = fr & 3;
        const bf16_t* qp = Pb + (long)(qs + st.tl[mt]) * PW + PC_Q + g * 256 + h * 64 + fq * 8;
        st.qf[mt][0] = *(const bf16x8*)(qp); st.qf[mt][1] = *(const bf16x8*)(qp + 32);
        const float* gp = psm + (long)(qs + st.tl[mt]) * 32 + (g * 4 + h) * 3;
        gate[mt][0] = sigmoidf_(gp[0]); gate[mt][1] = sigmoidf_(gp[1]); gate[mt][2] = sigmoidf_(gp[2]);
    }
    {
        const bf16_t* kc = (const bf16_t*)(ws + WS_KCMP) + (long)(b * 2 + g) * 128 * 64;
        const bf16_t* vc = (const bf16_t*)(ws + WS_VCMP) + (long)(b * 2 + g) * 128 * 64;
#pragma unroll
        for (int r = 0; r < 2; ++r) {
            const int e = tid + r * NTHR, row = e >> 3, ch = e & 7;
            *(u32x4*)(smem + NSA_KC + row * NSA_PITCH + ch * 16) = *(const u32x4*)(kc + row * 64 + ch * 8);
            *(u32x4*)(smem + NSA_VC + row * NSA_PITCH + ch * 16) = *(const u32x4*)(vc + row * 64 + ch * 8);
        }
    }
    __syncthreads();
    if (!(NSAV & 1)) { st.selm[0] = 0xffffffffu; st.selm[1] = 0xffffffffu;
#pragma unroll
        for (int d8 = 0; d8 < 8; ++d8) ((f32x4*)(smem + NSA_Y))[d8 * NTHR + tid] = (f32x4){0.f, 0.f, 0.f, 0.f}; }
    if (NSAV & 1) {
    nsa_cmp_one(smem, st.qf[0][0], st.qf[0][1], qs + st.tl[0], i, gate[0][0], (f32x4*)(smem + NSA_Y) + tid, st.selm[0], lane);
    asm volatile("" ::: "memory");
    __builtin_amdgcn_sched_barrier(0);
    nsa_cmp_one(smem, st.qf[1][0], st.qf[1][1], qs + st.tl[1], i, gate[1][0], (f32x4*)(smem + NSA_Y) + 4 * NTHR + tid, st.selm[1], lane);
    __builtin_amdgcn_sched_barrier(0);
    }
    {
        unsigned u0 = st.selm[0], u1 = st.selm[1];
        u0 |= __shfl_xor(u0, 4); u0 |= __shfl_xor(u0, 8); u1 |= __shfl_xor(u1, 4); u1 |= __shfl_xor(u1, 8);
        st.tunion[0] = (unsigned)__builtin_amdgcn_readfirstlane((int)u0); st.tunion[1] = (unsigned)__builtin_amdgcn_readfirstlane((int)u1);
        const unsigned u = st.tunion[0] | st.tunion[1];
        st.wunion = u;
        unsigned* misc = (unsigned*)(smem + NSA_MISC);
        if (lane == 0) misc[wid] = u;
        __syncthreads();
        unsigned bu = 0u;
#pragma unroll
        for (int w = 0; w < 8; ++w) bu |= misc[w];
        st.bunion = bu;
    }
    if (NSAV & 2) nsa_stream<0>(smem, Pb, g, i, st, gate[0][1], gate[1][1], tid);
    if (NSAV & 4) nsa_stream<1>(smem, Pb, g, i, st, gate[0][2], gate[1][2], tid);
    bf16_t* mix = (bf16_t*)(p.ws + WS_MIX) + (long)b * SEQ * 1024;
#pragma unroll
    for (int mt = 0; mt < 2; ++mt) {
        bf16_t* op = mix + (long)(qs + st.tl[mt]) * 1024 + g * 256 + (fr & 3) * 64 + fq * 4;
#pragma unroll
        for (int dt = 0; dt < 4; ++dt) {
            const f32x4 yv = *((const f32x4*)(smem + NSA_Y) + (mt * 4 + dt) * NTHR + tid);
            u32x2 w; w.x = pk_bf16(yv[0], yv[1]); w.y = pk_bf16(yv[2], yv[3]);
            *(u32x2*)(op + dt * 16) = w;
        }
    }
    __syncthreads();
}

constexpr int ML_PITCH = 288;
constexpr int ML_Q = 0, ML_K = 18432, ML_V = 36864, ML_VW = 55296, ML_C = 73728, ML_N = 110592, ML_GB = 111104, ML_GA = 119296, ML_GMQ = 127488,
              ML_GS = 135680, ML_ST = 136192;

__device__ __forceinline__ float wave_incl_scan_add(float v, int lane) {
#pragma unroll
    for (int off = 1; off < 64; off <<= 1) { const float o = __shfl_up(v, off); if (lane >= off) v += o; }
    return v;
}
__device__ __forceinline__ float wave_incl_scan_max(float v, int lane) {
#pragma unroll
    for (int off = 1; off < 64; off <<= 1) { const float o = __shfl_up(v, off); if (lane >= off) v = fmaxf(v, o); }
    return v;
}
__device__ __forceinline__ float wave_max(float v) {
#pragma unroll
    for (int off = 32; off >= 1; off >>= 1) v = fmaxf(v, __shfl_xor(v, off));
    return v;
}

__device__ __forceinline__ void mlstm_scan(const Params& p, char* smem, int b, int h) {
    const char* ws = p.ws;
    int tid = threadIdx.x;
    asm volatile("" : "+v"(tid));
    const int lane = tid & 63, wid = __builtin_amdgcn_readfirstlane(tid >> 6), fr = lane & 15, fq = lane >> 4;
    const bf16_t* QK = (const bf16_t*)(ws + WS_QK) + (long)b * SEQ * 1024 + h * 128;
    const bf16_t* Pb = (const bf16_t*)(ws + WS_P) + (long)b * SEQ * PW;
    const float* psm = (const float*)(ws + WS_PSM) + (long)b * SEQ * 32;
    bf16_t* mix = (bf16_t*)(p.ws + WS_MIX) + (long)b * SEQ * 1024 + 512 + h * 128;
    float* GB = (float*)(smem + ML_GB); float* GA = (float*)(smem + ML_GA); float* GMQ = (float*)(smem + ML_GMQ);
    float* GS = (float*)(smem + ML_GS);
    float* NV = (float*)(smem + ML_N);
    float* ST = (float*)(smem + ML_ST);
    {
        const float ib = p.in[I_IBIAS][h], fb = p.in[I_FBIAS][h];
        for (int c = wid; c < 32; c += 8) {
            const int t = c * 64 + lane;
            const float ipre = psm[(long)t * 32 + 24 + h], fpre = psm[(long)t * 32 + 28 + h];
            const float li = ipre + ib;
            const float x = fpre + fb;
            const float lf = fminf(x, 0.f) - log1pf(__expf(-fabsf(x)));
            const float bb = wave_incl_scan_add(lf, lane);
            const float aa = li - bb;
            const float g = __shfl(bb, 63);
            const float pm = wave_incl_scan_max(aa, lane);
            const float mloc = wave_max(g + aa);
            GB[t] = bb; GA[t] = aa; GMQ[t] = pm;
            if (lane == 0) { GS[64 + c] = g; GS[96 + c] = mloc; }
        }
    }
    for (int e = tid; e < 36864 / 16; e += NTHR) *(u32x4*)(smem + ML_C + e * 16) = (u32x4){0u, 0u, 0u, 0u};
    if (tid < 128) NV[tid] = 0.f;
    __syncthreads();
    if (tid == 0) {
        float m = 0.f;
        for (int c = 0; c < 32; ++c) { GS[c] = m; const float mn = fmaxf(GS[64 + c] + m, GS[96 + c]); GS[32 + c] = mn; m = mn; }
    }
    __syncthreads();
    for (int t = tid; t < SEQ; t += NTHR) GMQ[t] = GB[t] + fmaxf(GS[t >> 6], GMQ[t]);
    __syncthreads();

    f32x4 Cacc[9];
#pragma unroll
    for (int c9 = 0; c9 < 9; ++c9) Cacc[c9] = (f32x4){0.f, 0.f, 0.f, 0.f};
    const int lrow = tid >> 4, lch = tid & 15;
    u32x4 rq[2], rk[2], rv[2];
#pragma unroll
    for (int i2 = 0; i2 < 2; ++i2) {
        const int row = lrow + 32 * i2;
        rq[i2] = *(const u32x4*)(QK + (long)row * 1024 + lch * 8);
        rk[i2] = *(const u32x4*)(QK + (long)row * 1024 + 512 + lch * 8);
        rv[i2] = *(const u32x4*)(Pb + (long)row * PW + PC_MV + h * 128 + lch * 8);
    }
    const int mt = wid >> 1, half = wid & 1;
#pragma unroll 1
    for (int c = 0; c < 32; ++c) {
        const float m_old = GS[c], m_new = GS[32 + c], gch = GS[64 + c];
#pragma unroll
        for (int i2 = 0; i2 < 2; ++i2) {
            const int row = lrow + 32 * i2;
            *(u32x4*)(smem + ML_Q + row * ML_PITCH + lch * 16) = rq[i2];
            *(u32x4*)(smem + ML_K + row * ML_PITCH + lch * 16) = rk[i2];
            *(u32x4*)(smem + ML_V + row * ML_PITCH + lch * 16) = rv[i2];
            const float wk = __expf(gch + GA[c * 64 + row] - m_new);
            u32x4 w;
            w.x = pk_bf16(bf_lo(rv[i2].x) * wk, bf_hi(rv[i2].x) * wk); w.y = pk_bf16(bf_lo(rv[i2].y) * wk, bf_hi(rv[i2].y) * wk);
            w.z = pk_bf16(bf_lo(rv[i2].z) * wk, bf_hi(rv[i2].z) * wk); w.w = pk_bf16(bf_lo(rv[i2].w) * wk, bf_hi(rv[i2].w) * wk);
            *(u32x4*)(smem + ML_VW + row * ML_PITCH + lch * 16) = w;
        }
        if (tid < 128) {
            const int row = tid >> 1, hf = tid & 1;
            const float wk = __expf(gch + GA[c * 64 + row] - m_new);
            u32x4 w = (u32x4){0u, 0u, 0u, 0u};
            if (hf == 0) w.x = pk_bf16(wk, 0.f);
            *(u32x4*)(smem + ML_VW + row * ML_PITCH + 256 + hf * 16) = w;
        }
        __syncthreads();
        if (c + 1 < 32) {
#pragma unroll
            for (int i2 = 0; i2 < 2; ++i2) {
                const int row = (c + 1) * 64 + lrow + 32 * i2;
                rq[i2] = *(const u32x4*)(QK + (long)row * 1024 + lch * 8);
                rk[i2] = *(const u32x4*)(QK + (long)row * 1024 + 512 + lch * 8);
                rv[i2] = *(const u32x4*)(Pb + (long)row * PW + PC_MV + h * 128 + lch * 8);
            }
        }
        const int l = 16 * mt + fr;
        const float bl = GB[c * 64 + l], mq = GMQ[c * 64 + l];
        const float ul = bl - mq;
        f32x4 hv[4];
        float s1 = 0.f, s2 = 0.f;
        {
            bf16x8 qf[4];
#pragma unroll
            for (int ks = 0; ks < 4; ++ks) qf[ks] = *(const bf16x8*)(smem + ML_Q + l * ML_PITCH + (ks * 4 + fq) * 16);
            f32x4 S[4];
#pragma unroll
            for (int nt = 0; nt < 4; ++nt) {
                f32x4 s = (f32x4){0.f, 0.f, 0.f, 0.f};
#pragma unroll
                for (int ks = 0; ks < 4; ++ks) {
                    const bf16x8 kf = *(const bf16x8*)(smem + ML_K + (16 * nt + fr) * ML_PITCH + (ks * 4 + fq) * 16);
                    s = mfma16(kf, qf[ks], s);
                }
                S[nt] = s;
            }
            float dintra = 0.f;
            const int lq = l - 4 * fq;
#pragma unroll
            for (int nt = 0; nt < 4; ++nt) {
                const f32x4 av = *(const f32x4*)(GA + c * 64 + 16 * nt + 4 * fq);
#pragma unroll
                for (int e = 0; e < 4; ++e) {
                    const float w = (16 * nt + e <= lq) ? __expf(ul + av[e]) : 0.f;
                    const float sv = S[nt][e] * w;
                    S[nt][e] = sv; dintra += sv;
                }
            }
            dintra = fq_sum(dintra);
            float dinter = 0.f;
#pragma unroll
            for (int ks = 0; ks < 4; ++ks) {
                const f32x4 n0 = *(const f32x4*)(NV + ks * 32 + fq * 8), n1 = *(const f32x4*)(NV + ks * 32 + fq * 8 + 4);
                const u32x4 qu = __builtin_bit_cast(u32x4, qf[ks]);
                dinter += bf_lo(qu.x) * n0[0] + bf_hi(qu.x) * n0[1] + bf_lo(qu.y) * n0[2] + bf_hi(qu.y) * n0[3]
                        + bf_lo(qu.z) * n1[0] + bf_hi(qu.z) * n1[1] + bf_lo(qu.w) * n1[2] + bf_hi(qu.w) * n1[3];
            }
            dinter = fq_sum(dinter);
            const float winter = __expf(ul + m_old);
            const float den = winter * dinter + dintra;
            const float rden = 1.0f / fmaxf(fabsf(den), __expf(-mq));
            const bf16x8 pf0 = pack_p(S[0], S[1]), pf1 = pack_p(S[2], S[3]);
#pragma unroll
            for (int c4 = 0; c4 < 4; ++c4) {
                const int et = 4 * half + c4;
                f32x4 num = (f32x4){0.f, 0.f, 0.f, 0.f}, inter = (f32x4){0.f, 0.f, 0.f, 0.f};
                num = mfma16(tr_frag_perm(smem + ML_V, ML_PITCH, 0, 16 * et, fr, fq), pf0, num);
                num = mfma16(tr_frag_perm(smem + ML_V, ML_PITCH, 32, 16 * et, fr, fq), pf1, num);
#pragma unroll
                for (int ks = 0; ks < 4; ++ks) {
                    const bf16x8 cf = *(const bf16x8*)(smem + ML_C + (16 * et + fr) * ML_PITCH + (ks * 4 + fq) * 16);
                    inter = mfma16(cf, qf[ks], inter);
                }
                const f32x4 hh = (inter * winter + num) * rden;
                hv[c4] = hh;
                s1 += (hh[0] + hh[1]) + (hh[2] + hh[3]);
                s2 += (hh[0] * hh[0] + hh[1] * hh[1]) + (hh[2] * hh[2] + hh[3] * hh[3]);
            }
            s1 = fq_sum(s1); s2 = fq_sum(s2);
            if (fq == 0) { ST[(l * 2 + half) * 2] = s1; ST[(l * 2 + half) * 2 + 1] = s2; }
        }
        {
            const float decay = __expf(gch + m_old - m_new);
#pragma unroll
            for (int c9 = 0; c9 < 9; ++c9) Cacc[c9] = Cacc[c9] * decay;
#pragma unroll
            for (int ks2 = 0; ks2 < 2; ++ks2) {
                const bf16x8 kt = tr_frag_std(smem + ML_K, ML_PITCH, 32 * ks2, 16 * wid, fr, fq);
#pragma unroll
                for (int c9 = 0; c9 < 9; ++c9) {
                    const bf16x8 vw = tr_frag_std(smem + ML_VW, ML_PITCH, 32 * ks2, 16 * c9, fr, fq);
                    Cacc[c9] = mfma16(kt, vw, Cacc[c9]);
                }
            }
        }
        __syncthreads();
        {
            const float* sp = ST + l * 4;
            const float t1 = sp[0] + sp[2], t2 = sp[1] + sp[3];
            const float mean = t1 * (1.0f / 128.0f);
            const float var = fmaxf(t2 * (1.0f / 128.0f) - mean * mean, 0.f);
            const float rstd = rsqrtf(var + LN_EPS);
            const long tok = c * 64 + l;
#pragma unroll
            for (int c4 = 0; c4 < 4; ++c4) {
                const int col = 64 * half + 16 * c4 + 4 * fq;
                const u32x2 ou = *(const u32x2*)(Pb + tok * PW + PC_MO + h * 128 + col);
                const f32x4 ng = *(const f32x4*)(p.in[I_NORMG] + h * 128 + col);
                const f32x4 y = (hv[c4] - mean) * rstd * ng;
                u32x2 w;
                w.x = pk_bf16(y[0] * sigmoidf_(bf_lo(ou.x)), y[1] * sigmoidf_(bf_hi(ou.x)));
                w.y = pk_bf16(y[2] * sigmoidf_(bf_lo(ou.y)), y[3] * sigmoidf_(bf_hi(ou.y)));
                *(u32x2*)(mix + tok * 1024 + col) = w;
            }
        }
#pragma unroll
        for (int c9 = 0; c9 < 8; ++c9) {
            u32x2 w; w.x = pk_bf16(Cacc[c9][0], Cacc[c9][1]); w.y = pk_bf16(Cacc[c9][2], Cacc[c9][3]);
            *(u32x2*)(smem + ML_C + (16 * c9 + fr) * ML_PITCH + (16 * wid + 4 * fq) * 2) = w;
        }
        if (fr == 0) *(f32x4*)(NV + 16 * wid + 4 * fq) = Cacc[8];
        __syncthreads();
    }
}


constexpr int CV_PITCH = 144;
__device__ __forceinline__ void wconv_task(const Params& p, char* smem, int which, int e, int nt) {
    const int tid = opaque_tid();
    const int ng = tid & 63, kg = tid >> 6, n0 = 4 * ng;
    const float* src; int ld, K; unsigned char* dst;
    if (which == 0) {
        const int col = 128 * nt + 32 * (n0 >> 6) + bperm32(n0 & 31);
        src = (((n0 >> 5) & 1) ? p.in[I_MW3] : p.in[I_MW1]) + (long)e * 1024 * 256 + col; ld = 256; K = 1024;
        dst = (unsigned char*)p.out + ((long)(e * 2 + nt) * 256) * 1024;
    } else {
        src = p.in[I_MW2] + (long)e * 256 * 1024 + nt * 256 + bperm32(n0); ld = 1024; K = 256;
        dst = (unsigned char*)(p.ws + WS_W2F8) + ((long)(e * 4 + nt) * 256) * 256;
    }
    for (int kc = 0; kc < K / 128; ++kc) {
        f32x4 v[16];
#pragma unroll
        for (int j = 0; j < 16; ++j) v[j] = *(const f32x4*)(src + (long)(kc * 128 + kg * 16 + j) * ld);
#pragma unroll
        for (int cc = 0; cc < 4; ++cc) {
            u32x4 w;
            w.x = pk4_fp8(v[0][cc] * W8_SCALE, v[1][cc] * W8_SCALE, v[2][cc] * W8_SCALE, v[3][cc] * W8_SCALE);
            w.y = pk4_fp8(v[4][cc] * W8_SCALE, v[5][cc] * W8_SCALE, v[6][cc] * W8_SCALE, v[7][cc] * W8_SCALE);
            w.z = pk4_fp8(v[8][cc] * W8_SCALE, v[9][cc] * W8_SCALE, v[10][cc] * W8_SCALE, v[11][cc] * W8_SCALE);
            w.w = pk4_fp8(v[12][cc] * W8_SCALE, v[13][cc] * W8_SCALE, v[14][cc] * W8_SCALE, v[15][cc] * W8_SCALE);
            *(u32x4*)(smem + (n0 + cc) * CV_PITCH + kg * 16) = w;
        }
        __syncthreads();
#pragma unroll
        for (int i = 0; i < 4; ++i) {
            const int piece = tid + i * NTHR, row = piece >> 3, ch = piece & 7;
            *(u32x4*)(dst + (long)row * K + kc * 128 + ch * 16) = *(const u32x4*)(smem + row * CV_PITCH + ch * 16);
        }
        __syncthreads();
    }
}

template <int PARTS = 7  , int NSAV = 7>
__device__ __forceinline__ void phase3(const Params& p, char* smem, int bid, int nb, int rep = 0) {
    XcdSlab xs; xs.init(bid, nb);
    const int nq = xs.x >= 0 ? 320 : 1024 + 1536;
    int* qctr = (int*)(p.ws + WS_CNT) + 16384 + ((xs.x >= 0 ? xs.x : 0) + 8 * rep) * 32;
    if (PARTS & 1) for (int u = bid; u < 64; u += nb) mlstm_scan(p, smem, u >> 2, u & 3);
    if (!(PARTS & 2)) return;
    volatile int* slot = (volatile int*)(smem + NSA_MISC + 256);
    for (;;) {
        if (opaque_tid() == 0) *slot = atomicAdd(qctr, 1);
        __syncthreads();
        const int k = __builtin_amdgcn_readfirstlane(*slot);
        if (k >= nq) break;
        if (xs.x >= 0) {
            const int r5 = k % 5, q5 = k / 5;
            if (r5 < 2) { const int kk = q5 * 2 + r5; const int bg = 4 * xs.x + (kk & 3); nsa_task<NSAV>(p, smem, bg >> 1, bg & 1, 31 - (kk >> 2)); }
            else if (PARTS & 4) { const int cv = q5 * 3 + (r5 - 2); const int e = xs.x + 8 * (cv / 6), t6 = cv % 6; wconv_task(p, smem, t6 < 2 ? 0 : 1, e, t6 < 2 ? t6 : t6 - 2); }
        } else if (k < 1024) nsa_task<NSAV>(p, smem, (k & 31) >> 1, k & 1, 31 - (k >> 5));
        else if (PARTS & 4) { const int cv = k - 1024; const int e = cv / 6, t6 = cv % 6; wconv_task(p, smem, t6 < 2 ? 0 : 1, e, t6 < 2 ? t6 : t6 - 2); }
    }
}

constexpr int XA_PITCH = 544;
constexpr int XA_K = 0, XA_V = 69632;
__device__ __forceinline__ void xattn_task(const Params& p, char* smem, int b, int h, int qb) {
    const char* ws = p.ws;
    int tid = threadIdx.x;
    asm volatile("" : "+v"(tid));
    const int lane = tid & 63, wid = __builtin_amdgcn_readfirstlane(tid >> 6), fr = lane & 15, fq = lane >> 4;
    const bf16_t* XQ = (const bf16_t*)(ws + WS_XQ) + (long)(b * SEQ + qb * 128 + wid * 16 + fr) * 1024 + h * 256 + fq * 8;
    const bf16_t* KV = (const bf16_t*)(ws + WS_KVX) + (long)b * 256 * 2048 + h * 256;
    bf16x8 qf[8];
#pragma unroll
    for (int ks = 0; ks < 8; ++ks) qf[ks] = *(const bf16x8*)(XQ + ks * 32);
    f32x4 O[16];
#pragma unroll
    for (int dt = 0; dt < 16; ++dt) O[dt] = (f32x4){0.f, 0.f, 0.f, 0.f};
    float m = -1e30f, l = 0.f;
    const int lrow = tid >> 5, lch = tid & 31;
    u32x4 rk[4], rv[4];
#pragma unroll
    for (int i2 = 0; i2 < 4; ++i2) {
        const bf16_t* rp = KV + (long)(lrow + 16 * i2) * 2048 + lch * 8;
        rk[i2] = *(const u32x4*)rp; rv[i2] = *(const u32x4*)(rp + 1024);
    }
#pragma unroll
    for (int i2 = 0; i2 < 4; ++i2) {
        *(u32x4*)(smem + XA_K + (lrow + 16 * i2) * XA_PITCH + lch * 16) = rk[i2];
        *(u32x4*)(smem + XA_V + (lrow + 16 * i2) * XA_PITCH + lch * 16) = rv[i2];
    }
    __syncthreads();
#pragma unroll 1
    for (int j = 0; j < 4; ++j) {
        const int buf = j & 1;
        if (j + 1 < 4) {
#pragma unroll
            for (int i2 = 0; i2 < 4; ++i2) {
                const bf16_t* rp = KV + (long)((j + 1) * 64 + lrow + 16 * i2) * 2048 + lch * 8;
                rk[i2] = *(const u32x4*)rp; rv[i2] = *(const u32x4*)(rp + 1024);
            }
        }
        const char* KT = smem + XA_K + buf * 34816;
        const char* VT = smem + XA_V + buf * 34816;
        f32x4 S[4];
#pragma unroll
        for (int nt = 0; nt < 4; ++nt) {
            f32x4 s = (f32x4){0.f, 0.f, 0.f, 0.f};
#pragma unroll
            for (int ks = 0; ks < 8; ++ks) {
                const bf16x8 kf = *(const bf16x8*)(KT + (16 * nt + fr) * XA_PITCH + (ks * 4 + fq) * 16);
                s = mfma16(kf, qf[ks], s);
            }
            S[nt] = s * 0.0625f;
        }
        float mx = -INFINITY;
#pragma unroll
        for (int nt = 0; nt < 4; ++nt)
#pragma unroll
            for (int e = 0; e < 4; ++e) mx = fmaxf(mx, S[nt][e]);
        mx = fq_max(mx);
        const float mnew = fmaxf(m, mx);
        const float alpha = __expf(m - mnew);
        float rs = 0.f;
#pragma unroll
        for (int nt = 0; nt < 4; ++nt)
#pragma unroll
            for (int e = 0; e < 4; ++e) { const float pv = __expf(S[nt][e] - mnew); S[nt][e] = pv; rs += pv; }
        rs = fq_sum(rs);
        l = l * alpha + rs; m = mnew;
#pragma unroll
        for (int dt = 0; dt < 16; ++dt) O[dt] = O[dt] * alpha;
        const bf16x8 pf0 = pack_p(S[0], S[1]), pf1 = pack_p(S[2], S[3]);
#pragma unroll
        for (int dt = 0; dt < 16; ++dt) {
            O[dt] = mfma16(tr_frag_perm(VT, XA_PITCH, 0, 16 * dt, fr, fq), pf0, O[dt]);
            O[dt] = mfma16(tr_frag_perm(VT, XA_PITCH, 32, 16 * dt, fr, fq), pf1, O[dt]);
        }
        if (j + 1 < 4) {
            char* KTn = smem + XA_K + (buf ^ 1) * 34816; char* VTn = smem + XA_V + (buf ^ 1) * 34816;
#pragma unroll
            for (int i2 = 0; i2 < 4; ++i2) {
                *(u32x4*)(KTn + (lrow + 16 * i2) * XA_PITCH + lch * 16) = rk[i2];
                *(u32x4*)(VTn + (lrow + 16 * i2) * XA_PITCH + lch * 16) = rv[i2];
            }
        }
        __syncthreads();
    }
    const float inv = 1.0f / l;
    bf16_t* op = (bf16_t*)(p.ws + WS_XO) + (long)(b * SEQ + qb * 128 + wid * 16 + fr) * 1024 + h * 256 + fq * 4;
#pragma unroll
    for (int dt = 0; dt < 16; ++dt) {
        u32x2 w; w.x = pk_bf16(O[dt][0] * inv, O[dt][1] * inv); w.y = pk_bf16(O[dt][2] * inv, O[dt][3] * inv);
        *(u32x2*)(op + dt * 16) = w;
    }
}

__device__ __forceinline__ void phase6(const Params& p, char* smem, int bid, int nb) {
    XcdSlab xs; xs.init(bid, nb);
    const int p_lo = xs.m_lo(64), n_t = (xs.m_hi(64) - p_lo) * 16;
    for (int u = xs.j; u < n_t; u += xs.stride) { const int pr = p_lo + (u >> 4); xattn_task(p, smem, pr >> 2, pr & 3, u & 15); }
}

constexpr int LN_ST = 139264, LN_GB = 141312, MOE_TAB = 153600;

template <class EPI>
__device__ __forceinline__ void dense_loop(char* smem, int bid, int nb, const bf16_t* A, int lda, const bf16_t* Bt, int nk, const EPI& epi) {
    XcdSlab xs; xs.init(bid, nb);
    const int m_lo = xs.m_lo(128), n_t = (xs.m_hi(128) - m_lo) * 4;
    int mt = 0, nt = 0;
    RingRows al, bl;
    auto setup = [&](int u) { mt = m_lo + (u >> 2); nt = u & 3; al.init_contig(A, lda, mt * 256); bl.init_contig(Bt, lda, nt * 256, true); };
    int u = xs.j;
    if (u < n_t) { setup(u); ring_issue3(smem, al, bl); }
    while (u < n_t) {
        const int cmt = mt, cnt_ = nt;
        f32x4 acc[8][4];
        gemm_ring<RingRows, RingRows, 0, true>(smem, al, bl, nk, acc);
        u += xs.stride;
        if (u < n_t) { setup(u); ring_issue3(smem, al, bl); }
        epi(acc, cmt, cnt_);
    }
    asm volatile("s_waitcnt vmcnt(0)" ::: "memory");
}

__device__ __forceinline__ void phase4(const Params& p, char* smem, int bid, int nb) {
    char* ws = p.ws;
    dense_loop(smem, bid, nb, (const bf16_t*)(ws + WS_MIX), 1024, (const bf16_t*)(ws + WS_WOUT), 32, [&](f32x4 (&acc)[8][4], int mt, int nt) {
        epi_residual<false>(acc, smem, p.in[I_X], nullptr, nullptr, nullptr, nullptr, (bf16_t*)(ws + WS_R1B), (float*)(ws + WS_ST1), mt * 256, nt);
    });
}

__device__ __forceinline__ void phase5(const Params& p, char* smem, int bid, int nb) {
    char* ws = p.ws;
    const float* lnf = (const float*)(ws + WS_LNF);
    dense_loop(smem, bid, nb, (const bf16_t*)(ws + WS_R1B), 1024, (const bf16_t*)(ws + WS_WQ), 32, [&](f32x4 (&acc)[8][4], int mt, int nt) {
        ln_correct<0>(acc, (const float*)(ws + WS_ST1), mt * 256, lnf, lnf + 1792, nt);
        epi_store_bf16(acc, (bf16_t*)(ws + WS_XQ), 1024, mt * 256, nt * 256);
    });
}

__device__ __forceinline__ void phase7(const Params& p, char* smem, int bid, int nb) {
    char* ws = p.ws;
    dense_loop(smem, bid, nb, (const bf16_t*)(ws + WS_XO), 1024, (const bf16_t*)(ws + WS_WO), 32, [&](f32x4 (&acc)[8][4], int mt, int nt) {
        epi_residual<true>(acc, smem, nullptr, (const bf16_t*)(ws + WS_R1B), (const float*)(ws + WS_ST1), p.in[I_LN1G], p.in[I_LN1B],
                           (bf16_t*)(ws + WS_R2B), (float*)(ws + WS_ST2), mt * 256, nt);
    });
}

template <class RowMap>
__device__ __forceinline__ void epi_swiglu(const f32x4 (&acc)[8][4], bf16_t* out, int ld, int nt, const RowMap& rm) {
    const int tid_ = opaque_tid();
    const int lane = tid_ & 63, wid = tid_ >> 6;
    const int wr = wid >> 2, wc = wid & 3, fr = lane & 15, fq = lane >> 4;
#pragma unroll
    for (int mi = 0; mi < 8; ++mi) {
        const long orow = rm(wr * 128 + mi * 16 + fr);
        if (orow >= 0) {
            const f32x4 a0 = acc[mi][0], b0 = acc[mi][1], a1 = acc[mi][2], b1 = acc[mi][3];
            u32x4 w;
            w.x = pk_bf16(siluf_(a0[0]) * b0[0], siluf_(a0[1]) * b0[1]); w.y = pk_bf16(siluf_(a0[2]) * b0[2], siluf_(a0[3]) * b0[3]);
            w.z = pk_bf16(siluf_(a1[0]) * b1[0], siluf_(a1[1]) * b1[1]); w.w = pk_bf16(siluf_(a1[2]) * b1[2], siluf_(a1[3]) * b1[3]);
            *(u32x4*)(out + orow * ld + nt * 128 + wc * 32 + fq * 8) = w;
        }
    }
}
struct RowIdent { long row0; __device__ __forceinline__ long operator()(int rl) const { return row0 + rl; } };

__device__ __forceinline__ unsigned dpp_xor1_u(unsigned v) { return (unsigned)__builtin_amdgcn_mov_dpp((int)v, 0xB1, 0xF, 0xF, true); }
__device__ __forceinline__ void route_tile(const Params& p, char* smem, int tok0, int rep) {
    char* ws = p.ws;
    const float* bias = p.in[I_ROUTB];
    const int tid = opaque_tid(), tk = tid >> 1, hf = tid & 1;
    const float* row = (const float*)(ws + WS_RSC) + (long)(tok0 + tk) * 256;
    unsigned key[128];
    float gs[4];
    {
        float v[128];
#pragma unroll
        for (int i = 0; i < 32; ++i) { const f32x4 t = *(const f32x4*)(row + hf * 128 + i * 4); v[4 * i] = t[0]; v[4 * i + 1] = t[1]; v[4 * i + 2] = t[2]; v[4 * i + 3] = t[3]; }
#pragma unroll
        for (int gi = 0; gi < 4; ++gi) {
            float m1 = -INFINITY, m2 = -INFINITY;
#pragma unroll
            for (int i = 0; i < 32; ++i) { const float x = v[32 * gi + i]; m2 = __builtin_fmaxf(m2, __builtin_fminf(m1, x)); m1 = __builtin_fmaxf(m1, x); }
            gs[gi] = m1 + m2;
        }
        float g8[8];
#pragma unroll
        for (int gi = 0; gi < 4; ++gi) { const float o = dpp_xor1(gs[gi]); g8[gi] = hf ? o : gs[gi]; g8[4 + gi] = hf ? gs[gi] : o; }
        unsigned gsel = 0u;
#pragma unroll
        for (int a = 0; a < 8; ++a) {
            int rank = 0;
#pragma unroll
            for (int b = 0; b < 8; ++b) rank += (g8[b] > g8[a] || (g8[b] == g8[a] && b < a)) ? 1 : 0;
            if (rank < 4) gsel |= 1u << a;
        }
#pragma unroll
        for (int gi = 0; gi < 4; ++gi) {
            const bool on = ((gsel >> (4 * hf + gi)) & 1u) != 0u;
#pragma unroll
            for (int i = 0; i < 32; ++i) {
                const unsigned kb = (__float_as_uint(v[32 * gi + i] + 1.0f) & ~0xFFu) | (unsigned)(255 - (128 * hf + 32 * gi + i));
                key[32 * gi + i] = on ? kb : 0u;
            }
        }
    }
    unsigned win[8];
    unsigned prev = 0xFFFFFFFFu;
#pragma unroll
    for (int r = 0; r < 8; ++r) {
        unsigned m = 0u;
#pragma unroll
        for (int i = 0; i < 128; ++i) { const unsigned kk = key[i]; const unsigned c = kk < prev ? kk : 0u; m = m > c ? m : c; }
        const unsigned o = dpp_xor1_u(m);
        m = m > o ? m : o;
        prev = m;
        win[r] = m;
    }
    float sc8[8]; float wsum = 0.f;
#pragma unroll
    for (int r = 0; r < 8; ++r) { const int e = 255 - (int)(win[r] & 255u); sc8[r] = row[e] - bias[e]; wsum += sc8[r]; }
    int* lc = (int*)(smem + MOE_TAB); int* gbase = lc + 256;
    if (tid < 256) lc[tid] = 0;
    __syncthreads();
    int mye[4], myr[4];
    const unsigned hmask = 0u - (unsigned)hf;
#pragma unroll
    for (int u = 0; u < 4; ++u) {
        const unsigned w = win[u] ^ ((win[u] ^ win[4 + u]) & hmask);
        mye[u] = 255 - (int)(w & 255u); myr[u] = atomicAdd(lc + mye[u], 1);
    }
    __syncthreads();
    if (tid < 256) { const int n = lc[tid]; if (n > 0) gbase[tid] = atomicAdd((int*)(ws + WS_CNT) + 8192 * rep + tid * 32, n); }
    __syncthreads();
    {
        const long t = tok0 + tk;
        const float wn = 2.5f / wsum;
#pragma unroll
        for (int u = 0; u < 4; ++u) {
            const int k = 4 * hf + u;
            const int e = mye[u];
            const unsigned s0 = __float_as_uint(sc8[u]), s1 = __float_as_uint(sc8[4 + u]);
            const float w = __uint_as_float(s0 ^ ((s0 ^ s1) & hmask)) * wn;
            const int pos = gbase[e] + myr[u];
            ((int*)(ws + WS_SELE))[t * 8 + k] = e;
            ((int*)(ws + WS_SELP))[t * 8 + k] = pos;
            ((float*)(ws + WS_SELW))[t * 8 + k] = w;
            ((int*)(ws + WS_TOKL))[(long)e * LIST_CAP + pos] = (int)t;
            ((float*)(ws + WS_WL))[(long)e * LIST_CAP + pos] = w;
        }
    }
    __syncthreads();
}

__device__ __forceinline__ void phase8(const Params& p, char* smem, int bid, int nb, int rep = 0) {
    char* ws = p.ws;
    const float* lnf = (const float*)(ws + WS_LNF);
    XcdSlab xs; xs.init(bid, nb);
    const int m_lo = xs.m_lo(128), m_n = xs.m_hi(128) - m_lo;
    for (int u = xs.j; u < m_n; u += xs.stride) {
        const int mt = m_lo + u;
        float* gsc = (float*)(ws + WS_RSC);
        {
            RingRows al, bl;
            al.init_contig((const bf16_t*)(ws + WS_R2B), 1024, mt * 256);
            bl.init_contig((const bf16_t*)(ws + WS_WR), 1024, 0, true);
            f32x4 acc[8][4];
            gemm_ring(smem, al, bl, 32, acc);
            ln_correct<0>(acc, (const float*)(ws + WS_ST2), mt * 256, lnf + 1024, lnf + 1792 + 1024, 0);
            const int tid_ = opaque_tid();
            const int lane = tid_ & 63, wid = tid_ >> 6;
            const int wr = wid >> 2, wc = wid & 3, fr = lane & 15, fq = lane >> 4;
            const float* bias = p.in[I_ROUTB];
#pragma unroll
            for (int ni = 0; ni < 4; ++ni) {
                const int col = wc * 64 + (ni >> 1) * 32 + fq * 8 + (ni & 1) * 4;
                const f32x4 bv = *(const f32x4*)(bias + col);
#pragma unroll
                for (int mi = 0; mi < 8; ++mi) {
                    f32x4 v;
#pragma unroll
                    for (int e = 0; e < 4; ++e) v[e] = sigmoidf_(acc[mi][ni][e]) + bv[e];
                    *(f32x4*)(gsc + (long)(mt * 256 + wr * 128 + mi * 16 + fr) * 256 + col) = v;
                }
            }
        }
        __syncthreads();
        route_tile(p, smem, mt * 256, rep);
    }
    for (int u = (xs.j + xs.stride - m_n % xs.stride) % xs.stride; u < m_n * 2; u += xs.stride) {
        const int mt = m_lo + (u >> 1), nt = u & 1;
        RingRows al, bl;
        al.init_contig((const bf16_t*)(ws + WS_R2B), 1024, mt * 256);
        bl.init_contig((const bf16_t*)(ws + WS_WS13), 1024, nt * 256);
        f32x4 acc[8][4];
        gemm_ring(smem, al, bl, 32, acc);
        ln_correct<1>(acc, (const float*)(ws + WS_ST2), mt * 256, lnf + 1280, lnf + 1792 + 1280, nt);
        RowIdent rm; rm.row0 = (long)mt * 256;
        epi_swiglu(acc, (bf16_t*)(ws + WS_HS), 256, nt, rm);
    }
    {
        const int tid = opaque_tid(), lane = tid & 63, wid = tid >> 6;
        const bf16_t* r2 = (const bf16_t*)(ws + WS_R2B); const float* st2 = (const float*)(ws + WS_ST2);
        unsigned char* x2 = (unsigned char*)(ws + WS_X2F8);
        for (int t = bid * 8 + wid; t < T_TOK; t += nb * 8) {
            const f32x4 p0 = *(const f32x4*)(st2 + (long)t * 8), p1 = *(const f32x4*)(st2 + (long)t * 8 + 4);
            const float q1 = (p0[0] + p0[2]) + (p1[0] + p1[2]), q2 = (p0[1] + p0[3]) + (p1[1] + p1[3]);
            const float mean = q1 * (1.0f / 1024.0f);
            const float rstd = rsqrtf(fmaxf(q2 * (1.0f / 1024.0f) - mean * mean, 0.f) + LN_EPS);
#pragma unroll
            for (int hseg = 0; hseg < 2; ++hseg) {
                const int col = hseg * 512 + lane * 8;
                const u32x4 ru = *(const u32x4*)(r2 + (long)t * 1024 + col);
                const f32x4 a0 = (f32x4){bf_lo(ru.x), bf_hi(ru.x), bf_lo(ru.y), bf_hi(ru.y)}, a1 = (f32x4){bf_lo(ru.z), bf_hi(ru.z), bf_lo(ru.w), bf_hi(ru.w)};
                const f32x4 g0 = *(const f32x4*)(p.in[I_LN2G] + col), g1 = *(const f32x4*)(p.in[I_LN2G] + col + 4);
                const f32x4 b0 = *(const f32x4*)(p.in[I_LN2B] + col), b1 = *(const f32x4*)(p.in[I_LN2B] + col + 4);
                const f32x4 y0 = (a0 - mean) * rstd * g0 + b0, y1 = (a1 - mean) * rstd * g1 + b1;
                u32x2 w; w.x = pk4_fp8(y0[0], y0[1], y0[2], y0[3]); w.y = pk4_fp8(y1[0], y1[1], y1[2], y1[3]);
                *(u32x2*)(x2 + (long)t * 1024 + col) = w;
            }
        }
    }
}

template <int XMODE>
__device__ __forceinline__ void phase_probe(const Params& p, char* smem, int bid, int nb) {
    char* ws = p.ws;
    XcdSlab xs; xs.init(bid, nb);
    const int m_lo = xs.m_lo(128), n_t = (xs.m_hi(128) - m_lo) * 4;
    for (int u = xs.j; u < n_t; u += xs.stride) {
        const int mt = m_lo + (u >> 2), nt = u & 3;
        RingRows al, bl;
        al.init_contig((const bf16_t*)(ws + WS_MIX), 1024, mt * 256);
        bl.init_contig((const bf16_t*)(ws + WS_WOUT), 1024, nt * 256, true);
        f32x4 acc[8][4];
        gemm_ring<RingRows, RingRows, XMODE>(smem, al, bl, 32, acc);
        epi_store_bf16(acc, (bf16_t*)(ws + WS_A + 432 * MB), 1024, mt * 256, nt * 256);
    }
}

__device__ __forceinline__ void moe_tables(const Params& p, char* smem, const XcdSlab& xs) {
    int* off = (int*)(smem + MOE_TAB); int* tst = off + 256; int* cntl = tst + 260;
    const int* cnt = (const int*)(p.ws + WS_CNT);
    const int tid = opaque_tid();
    if (tid >= 256) cntl[tid - 256] = cnt[(tid - 256) * 32];
    if (tid < 64) {
        int c[4], cs = 0;
#pragma unroll
        for (int k = 0; k < 4; ++k) { c[k] = cnt[(tid * 4 + k) * 32]; cs += c[k]; }
        int ics = cs;
#pragma unroll
        for (int o = 1; o < 64; o <<= 1) { const int a = __shfl_up(ics, o); if (tid >= o) ics += a; }
        int eo = ics - cs;
#pragma unroll
        for (int k = 0; k < 4; ++k) { off[tid * 4 + k] = eo; eo += c[k]; }
    } else if (tid < 128) {
        const int l = tid - 64;
        if (xs.x >= 0) {
            const int tl = l < 32 ? ((cnt[(xs.x + 8 * l) * 32] + 255) >> 8) : 0;
            int it = tl;
#pragma unroll
            for (int o = 1; o < 64; o <<= 1) { const int a = __shfl_up(it, o); if (l >= o) it += a; }
            if (l < 32) tst[l] = it - tl;
            if (l == 31) tst[32] = it;
        } else {
            int c[4], ts = 0;
#pragma unroll
            for (int k = 0; k < 4; ++k) { c[k] = (cnt[(l * 4 + k) * 32] + 255) >> 8; ts += c[k]; }
            int its = ts;
#pragma unroll
            for (int o = 1; o < 64; o <<= 1) { const int a = __shfl_up(its, o); if (l >= o) its += a; }
            int et = its - ts;
#pragma unroll
            for (int k = 0; k < 4; ++k) { tst[l * 4 + k] = et; et += c[k]; }
            if (l == 63) tst[256] = its;
        }
    }
    __syncthreads();
}
__device__ __forceinline__ int moe_find(const int* tst, int nloc, int t) {
    int lo = 0, hi = nloc - 1;
#pragma unroll 1
    while (lo < hi) { const int mid = (lo + hi + 1) >> 1; if (tst[mid] <= t) lo = mid; else hi = mid - 1; }
    return lo;
}
struct RowMoe { long base; int nvalid; __device__ __forceinline__ long operator()(int rl) const { return rl < nvalid ? base + rl : -1; } };

template <int PARTS9 = 3>
__device__ __forceinline__ void phase9(const Params& p, char* smem, int bid, int nb) {
    char* ws = p.ws;
    XcdSlab xs; xs.init(bid, nb);
    moe_tables(p, smem, xs);
    const int* off = (const int*)(smem + MOE_TAB); const int* tst = off + 256;
    const int* cnt = (const int*)(ws + WS_CNT);
    const int nloc = xs.x >= 0 ? 32 : 256;
    const int ntile = tst[nloc];
    {
        const int* cntl = tst + 260;
        const int nT = ntile * 2;
        int t = xs.j;
        int e = 0, m0 = 0, ne = 0, nt = 0;
        RingF8 al, bl;
        auto setup = [&](int tt) {
            const int et = tt >> 1; nt = tt & 1;
            const int kl = moe_find(tst, nloc, et); e = xs.x >= 0 ? xs.x + 8 * kl : kl; m0 = (et - tst[kl]) * 256; ne = cntl[e];
            const int tid = opaque_tid();
            const int* tl = (const int*)(ws + WS_TOKL) + (long)e * LIST_CAP;
            int rows[2];
#pragma unroll
            for (int i = 0; i < 2; ++i) { const int r = m0 + (tid >> 2) + 128 * i; rows[i] = r < ne ? tl[r] : 0; }
            al.init_rows((const unsigned char*)(ws + WS_X2F8), 1024, rows);
            bl.init_contig((const unsigned char*)p.out, 1024, (long)(e * 2 + nt) * 256);
        };
        if (!(PARTS9 & 1)) t = nT;
        if (t < nT) { setup(t); ring_f8_issue3(smem, al, bl); }
        while (t < nT) {
            const int ce = e, cm0 = m0, cne = ne, cnt_ = nt;
            f32x16 acc[4][2];
            gemm_ring_mx_main(smem, al, bl, 16, acc);
            t += xs.stride;
            if (t < nT) { setup(t); ring_f8_issue3(smem, al, bl); }
            {
                const int tid2 = opaque_tid();
                const int lane = tid2 & 63, wid = tid2 >> 6;
                const int wr = wid >> 2, wc = wid & 3, r = lane & 31, h = lane >> 5;
                unsigned char* H = (unsigned char*)(ws + WS_HF8) + ((long)off[ce] + cm0) * 256 + cnt_ * 128 + wc * 32 + h * 16;
                constexpr float D = 1.0f / W8_SCALE, HS = H8_SCALE / W8_SCALE;
#pragma unroll
                for (int mi = 0; mi < 4; ++mi) {
                    const int rl = wr * 128 + mi * 32 + r;
                    if (cm0 + rl < cne) {
                        float o[16];
#pragma unroll
                        for (int q = 0; q < 16; ++q) o[q] = siluf_(acc[mi][0][q] * D) * (acc[mi][1][q] * HS);
                        u32x4 w; w.x = pk4_fp8(o[0], o[1], o[2], o[3]); w.y = pk4_fp8(o[4], o[5], o[6], o[7]); w.z = pk4_fp8(o[8], o[9], o[10], o[11]); w.w = pk4_fp8(o[12], o[13], o[14], o[15]);
                        *(u32x4*)(H + (long)rl * 256) = w;
                    }
                }
            }
        }
        asm volatile("s_waitcnt vmcnt(0)" ::: "memory"); __syncthreads();
    }
    const int m_lo = xs.m_lo(128), n_t = (PARTS9 & 2) ? (xs.m_hi(128) - m_lo) * 4 : 0;
    for (int u = (xs.j + xs.stride - (ntile * 2) % xs.stride) % xs.stride; u < n_t; u += xs.stride) {
        const int mt = m_lo + (u >> 2), nt = u & 3;
        RingRows al, bl;
        al.init_contig((const bf16_t*)(ws + WS_HS), 256, mt * 256);
        bl.init_contig((const bf16_t*)(ws + WS_WS2), 256, nt * 256, true);
        f32x4 acc[8][4];
        gemm_ring(smem, al, bl, 8, acc);
        __syncthreads();
        epi_store_bf16(acc, (bf16_t*)(ws + WS_SH), 1024, mt * 256, nt * 256);
    }
}

template <int P10V = 0  >
__device__ __forceinline__ void phase10(const Params& p, char* smem, int bid, int nb) {
    char* ws = p.ws;
    XcdSlab xs; xs.init(bid, nb);
    moe_tables(p, smem, xs);
    const int* off = (const int*)(smem + MOE_TAB); const int* tst = off + 256;
    const int* cnt = (const int*)(ws + WS_CNT);
    const int nloc = xs.x >= 0 ? 32 : 256;
    const int ntile = tst[nloc];
    {
        const int* cntl = tst + 260;
        const int nT = ntile;
        const int tid_ = opaque_tid();
        const int lane = tid_ & 63, wid = __builtin_amdgcn_readfirstlane(tid_ >> 6);
        const int wr = wid >> 2, wc = wid & 3, r = lane & 31, h = lane >> 5;
        const int g = (r >> 2) & 3;
        const int c0 = ((2 * h) ^ g) << 4, c1 = ((2 * h + 1) ^ g) << 4;
        const int arow = (wr * 128 + r) * 64;
        const int brow = (wc * 64 + r) * 64;
        char* ringB = smem + 65536;
        for (int t = xs.j; t < nT; t += xs.stride) {
            const int kl = moe_find(tst, nloc, t), e = xs.x >= 0 ? xs.x + 8 * kl : kl, m0 = (t - tst[kl]) * 256, ne = cntl[e];
            RingF8 al, bl;
            al.init_contig((const unsigned char*)(ws + WS_HF8), 256, (long)off[e] + m0);
            bl.init_contig((const unsigned char*)(ws + WS_W2F8), 256, (long)(e * 4) * 256);
            const float* wl = (const float*)(ws + WS_WL) + (long)e * LIST_CAP + m0;
            float* rwl = (float*)(smem + MOE_TAB + 4096);
            if (tid_ < 256) rwl[tid_] = (m0 + tid_ < ne) ? wl[tid_] * (Y8_SCALE / (W8_SCALE * H8_SCALE)) : 0.f;
            unsigned char* Yb = (unsigned char*)(ws + WS_Y) + ((long)off[e] + m0) * 1024 + wc * 64 + h * 16;
#pragma unroll
            for (int ks = 0; ks < 4; ++ks) al.issue(smem + ks * 16384, ks);
            auto issueB = [&](int bt, int stg) {
                const int nt_ = bt >> 2, ks_ = bt & 3;
                char* s = ringB + stg * 16384;
#pragma unroll
                for (int i = 0; i < 2; ++i)
                    __builtin_amdgcn_global_load_lds((glb_u32*)(bl.base + (size_t)(bl.off[i] + (unsigned)(nt_ * 65536 + ks_ * 64))), (lds_u32*)(s + i * 8192 + bl.ldst), 16, 0, 0);
            };
            issueB(0, 0); issueB(1, 1); issueB(2, 2); issueB(3, 3);
            RING_WAIT(6);
            RING_BAR();
            if (wr == 1) RING_BAR();
            f32x16 acc[4][2];
#pragma unroll
            for (int mi = 0; mi < 4; ++mi)
#pragma unroll
                for (int nj = 0; nj < 2; ++nj)
#pragma unroll
                    for (int q = 0; q < 16; ++q) acc[mi][nj][q] = 0.f;
            int sg = 0;
#pragma unroll 1
            for (int bt = 0; bt < 16; ++bt) {
                const char* sa = smem + (bt & 3) * 16384;
                const char* sb = ringB + sg * 16384;
                { const int s4 = sg == 0 ? 4 : sg - 1; if (bt + 4 < 16) issueB(bt + 4, s4); }
                i32x8 bf[2], af[4];
#pragma unroll
                for (int nj = 0; nj < 2; ++nj) bf[nj] = mx_frag(sb + brow + nj * 2048, c0, c1);
#pragma unroll
                for (int mi = 0; mi < 4; ++mi) af[mi] = mx_frag(sa + arow + mi * 2048, c0, c1);
                if (bt + 1 < 16) { if (bt + 4 < 16) RING_WAIT(6); else if (bt + 3 < 16) RING_WAIT(4); else if (bt + 2 < 16) RING_WAIT(2); else RING_WAIT(0); }
                RING_BAR();
                __builtin_amdgcn_s_setprio(1);
                if (P10V != 2) {
#pragma unroll
                for (int mi = 0; mi < 4; ++mi)
#pragma unroll
                    for (int nj = 0; nj < 2; ++nj) acc[mi][nj] = mfma_mx(bf[nj], af[mi], acc[mi][nj]);
                } else { acc[0][0][0] += (float)(af[0][0] + bf[0][0] + af[3][7] + bf[1][3]); }
                __builtin_amdgcn_s_setprio(0);
                if ((bt & 3) == 3) {
                    const int nt_ = bt >> 2;
#pragma unroll
                    for (int mi = 0; mi < 4; ++mi) {
                        const int rl = wr * 128 + mi * 32 + r;
                        if (m0 + rl < ne) {
                            const float w = rwl[rl];
#pragma unroll
                            for (int nj = 0; nj < 2; ++nj) {
                                const f32x16 u = acc[mi][nj] * w;
                                u32x4 v; v.x = pk4_fp8(u[0], u[1], u[2], u[3]); v.y = pk4_fp8(u[4], u[5], u[6], u[7]); v.z = pk4_fp8(u[8], u[9], u[10], u[11]); v.w = pk4_fp8(u[12], u[13], u[14], u[15]);
                                if (P10V != 1) *(u32x4*)(Yb + (long)rl * 1024 + nt_ * 256 + nj * 32) = v; else if (v.x == 0x12345678u) *(u32x4*)(Yb) = v;
                            }
                        }
#pragma unroll
                        for (int nj = 0; nj < 2; ++nj)
#pragma unroll
                            for (int q = 0; q < 16; ++q) acc[mi][nj][q] = 0.f;
                    }
                }
                RING_BAR();
                sg = sg == 4 ? 0 : sg + 1;
            }
            if (wr == 0) RING_BAR();
        }
    }
}

__device__ __forceinline__ void phase11(const Params& p, char* smem, int bid, int nb) {
    char* ws = p.ws;
    XcdSlab xs; xs.init(bid, nb);
    moe_tables(p, smem, xs);
    const int* off = (const int*)(smem + MOE_TAB);
    const int tid = opaque_tid(), lane = tid & 63, wid = tid >> 6;
    const bf16_t* r2 = (const bf16_t*)(ws + WS_R2B);
    const float* st2 = (const float*)(ws + WS_ST2);
    const bf16_t* SH = (const bf16_t*)(ws + WS_SH);
    const unsigned char* Y = (const unsigned char*)(ws + WS_Y);
    const int* sele = (const int*)(ws + WS_SELE); const int* selp = (const int*)(ws + WS_SELP);
    for (int t = bid * 8 + wid; t < T_TOK; t += nb * 8) {
        const f32x4 p0 = *(const f32x4*)(st2 + (long)t * 8), p1 = *(const f32x4*)(st2 + (long)t * 8 + 4);
        const float q1 = (p0[0] + p0[2]) + (p1[0] + p1[2]), q2 = (p0[1] + p0[3]) + (p1[1] + p1[3]);
        const float mean2 = q1 * (1.0f / 1024.0f);
        const float rstd2 = rsqrtf(fmaxf(q2 * (1.0f / 1024.0f) - mean2 * mean2, 0.f) + LN_EPS);
        int yrow[8];
#pragma unroll
        for (int k = 0; k < 8; ++k) yrow[k] = off[sele[(long)t * 8 + k]] + selp[(long)t * 8 + k];
        float v[16];
#pragma unroll
        for (int hseg = 0; hseg < 2; ++hseg) {
            const int col = hseg * 512 + lane * 8;
            const u32x4 ru = *(const u32x4*)(r2 + (long)t * 1024 + col);
            const f32x4 a0 = (f32x4){bf_lo(ru.x), bf_hi(ru.x), bf_lo(ru.y), bf_hi(ru.y)}, a1 = (f32x4){bf_lo(ru.z), bf_hi(ru.z), bf_lo(ru.w), bf_hi(ru.w)};
            const f32x4 g0 = *(const f32x4*)(p.in[I_LN2G] + col), g1 = *(const f32x4*)(p.in[I_LN2G] + col + 4);
            const f32x4 b0 = *(const f32x4*)(p.in[I_LN2B] + col), b1 = *(const f32x4*)(p.in[I_LN2B] + col + 4);
            const f32x4 x0 = ((a0 - mean2) * rstd2 * g0 + b0) * ALPHA, x1 = ((a1 - mean2) * rstd2 * g1 + b1) * ALPHA;
            float* vv = v + hseg * 8;
            vv[0] = x0[0]; vv[1] = x0[1]; vv[2] = x0[2]; vv[3] = x0[3]; vv[4] = x1[0]; vv[5] = x1[1]; vv[6] = x1[2]; vv[7] = x1[3];
            const u32x4 s = *(const u32x4*)(SH + (long)t * 1024 + col);
            vv[0] += bf_lo(s.x); vv[1] += bf_hi(s.x); vv[2] += bf_lo(s.y); vv[3] += bf_hi(s.y); vv[4] += bf_lo(s.z); vv[5] += bf_hi(s.z); vv[6] += bf_lo(s.w); vv[7] += bf_hi(s.w);
            f32x2 ys[4];
#pragma unroll
            for (int e2 = 0; e2 < 4; ++e2) ys[e2] = (f32x2){0.f, 0.f};
#pragma unroll
            for (int k = 0; k < 8; ++k) {
                const u32x2 y = *(const u32x2*)(Y + (long)yrow[k] * 1024 + col);
                ys[0] += __builtin_amdgcn_cvt_pk_f32_fp8((int)y.x, false); ys[1] += __builtin_amdgcn_cvt_pk_f32_fp8((int)y.x, true);
                ys[2] += __builtin_amdgcn_cvt_pk_f32_fp8((int)y.y, false); ys[3] += __builtin_amdgcn_cvt_pk_f32_fp8((int)y.y, true);
            }
#pragma unroll
            for (int e2 = 0; e2 < 4; ++e2) { vv[2 * e2] += ys[e2][0] * (1.0f / Y8_SCALE); vv[2 * e2 + 1] += ys[e2][1] * (1.0f / Y8_SCALE); }
        }
        float s1 = 0.f;
#pragma unroll
        for (int i = 0; i < 16; ++i) s1 += v[i];
#pragma unroll
        for (int o = 32; o >= 1; o >>= 1) s1 += __shfl_xor(s1, o);
        const float mean = s1 * (1.0f / 1024.0f);
        float s2 = 0.f;
#pragma unroll
        for (int i = 0; i < 16; ++i) { const float d = v[i] - mean; s2 += d * d; }
#pragma unroll
        for (int o = 32; o >= 1; o >>= 1) s2 += __shfl_xor(s2, o);
        const float rstd = rsqrtf(s2 * (1.0f / 1024.0f) + LN_EPS);
#pragma unroll
        for (int hseg = 0; hseg < 2; ++hseg) {
            const int col = hseg * 512 + lane * 8;
            const f32x4 g0 = *(const f32x4*)(p.in[I_LN3G] + col), g1 = *(const f32x4*)(p.in[I_LN3G] + col + 4);
            const f32x4 b0 = *(const f32x4*)(p.in[I_LN3B] + col), b1 = *(const f32x4*)(p.in[I_LN3B] + col + 4);
            const float* vv = v + hseg * 8;
            f32x4 o0, o1;
#pragma unroll
            for (int e = 0; e < 4; ++e) { o0[e] = (vv[e] - mean) * rstd * g0[e] + b0[e]; o1[e] = (vv[4 + e] - mean) * rstd * g1[e] + b1[e]; }
            *(f32x4*)(p.out + (long)t * 1024 + col) = o0; *(f32x4*)(p.out + (long)t * 1024 + col + 4) = o1;
        }
    }
}

#if MEGA
#define XB_TMO      128
#define XB_XCNT(j)  (256  + 64 * (j))
#define XB_XSUB(j)  (1280 + 64 * (j))
#define XB_XGEN(j)  (2304 + 64 * (j))
#define XB_TOP      3328
#define XB_TOPGEN   3392
#define XCD_BAR_WORDS 3456
#define XB_SPIN_CAP (1u << 22)
#define LAS __attribute__((address_space(3)))
__device__ __forceinline__ unsigned xb_ld(unsigned* p)              { return __hip_atomic_load(p, __ATOMIC_RELAXED, __HIP_MEMORY_SCOPE_AGENT); }
__device__ __forceinline__ unsigned xb_add(unsigned* p, unsigned v) { return __hip_atomic_fetch_add(p, v, __ATOMIC_RELAXED, __HIP_MEMORY_SCOPE_AGENT); }
__device__ __forceinline__ unsigned xb_xcc_id() { return (unsigned)__builtin_amdgcn_s_getreg((3 << 11) | 20) & 0xFu; }
#define XB_SPIN(cond, bar) do { unsigned _sp = 0; while (cond) { __builtin_amdgcn_s_sleep(1); \
    if ((++_sp & 255u) == 0u) { if (xb_ld(&(bar)[XB_TMO])) break; if (_sp > XB_SPIN_CAP) { atomicAdd(&(bar)[XB_TMO], 1u); break; } } } } while (0)
struct XcdBarrier { unsigned* bar; unsigned x; volatile LAS unsigned* st; };
__device__ __forceinline__ XcdBarrier xcd_barrier_post(unsigned* bar, volatile LAS unsigned* st) {
    XcdBarrier b; b.bar = bar; b.x = xb_xcc_id(); b.st = st;
    if (threadIdx.x == 0) (void)xb_add(&bar[XB_XCNT(b.x)], 1u);
    return b;
}
__device__ __forceinline__ void xcd_barrier_complete(unsigned* bar, unsigned x, unsigned& nloc, unsigned& nx) {
    const unsigned G = gridDim.x * gridDim.y * gridDim.z;
    unsigned sum, cnt, mine, sp = 0u;
    for (;;) {
        sum = 0u; cnt = 0u; mine = 0u;
#pragma unroll
        for (unsigned j = 0; j < 16; ++j) { const unsigned c = xb_ld(&bar[XB_XCNT(j)]); sum += c; cnt += (c > 0u) ? 1u : 0u; mine = (j == x) ? c : mine; }
        if (sum == G) break;
        __builtin_amdgcn_s_sleep(1);
        if ((++sp & 255u) == 0u) { if (xb_ld(&bar[XB_TMO])) break; if (sp > XB_SPIN_CAP) { atomicAdd(&bar[XB_TMO], 1u); break; } }
    }
    nloc = mine > 0u ? mine : 1u; nx = cnt > 0u ? cnt : 1u;
}
__device__ __forceinline__ void xcd_barrier(const XcdBarrier& b) {
    asm volatile("s_waitcnt vmcnt(0)" ::: "memory");
    __syncthreads();
    if (threadIdx.x == 0) {
        unsigned* bar = b.bar;
        __builtin_amdgcn_s_waitcnt(0);
        unsigned nloc = b.st[0], nx = b.st[1];
        if (nloc == 0u) { xcd_barrier_complete(bar, b.x, nloc, nx); b.st[0] = nloc; b.st[1] = nx; }
        const unsigned old = xb_add(&bar[XB_XSUB(b.x)], 1u);
        const unsigned gen = old / nloc;
        if (old + 1u == (gen + 1u) * nloc) {
            __builtin_amdgcn_fence(__ATOMIC_RELEASE, "agent");
            asm volatile("s_waitcnt vmcnt(0)" ::: "memory");
            const unsigned og = xb_add(&bar[XB_TOP], 1u);
            const unsigned tg = og / nx;
            if (og + 1u == (tg + 1u) * nx) xb_add(&bar[XB_TOPGEN], 1u);
            else XB_SPIN(xb_ld(&bar[XB_TOPGEN]) == tg, bar);
            __builtin_amdgcn_fence(__ATOMIC_ACQUIRE, "agent");
            xb_add(&bar[XB_XGEN(b.x)], 1u);
            asm volatile("s_waitcnt vmcnt(0)" ::: "memory");
        } else {
            XB_SPIN(xb_ld(&bar[XB_XGEN(b.x)]) == gen, bar);
            __builtin_amdgcn_fence(__ATOMIC_ACQUIRE, "agent");
            asm volatile("s_waitcnt vmcnt(0)" ::: "memory");
        }
    }
    __syncthreads();
}
__global__ void __launch_bounds__(NTHR) fwd_mega(Params p) {
    extern __shared__ __attribute__((aligned(16))) char smem[];
    cg::grid_group grid = cg::this_grid();
    const int bid = blockIdx.x, nb = gridDim.x;
    volatile LAS unsigned* xst = (volatile LAS unsigned*)(smem + LDS_BYTES - 16);
    if (threadIdx.x < 4) xst[threadIdx.x] = 0u;
    __syncthreads();
    const XcdBarrier xb = xcd_barrier_post((unsigned*)(p.ws + WS_BAR), xst);
#define GSYNC() xcd_barrier(xb)
#ifndef PROBE_REPEAT
#define PROBE_REPEAT 0
#endif
#define REP(n, call) if (PROBE_REPEAT & (1 << n)) { call; GSYNC(); }
    if (PROBE_REPEAT & 1) { phase0(p, smem, bid, nb); GSYNC(); }
#ifdef PROBE_XCC
    {
        unsigned* rec = (unsigned*)(p.ws + WS_A + 432 * MB);
        if (threadIdx.x == 0) rec[bid] = xb_xcc_id();
        grid.sync();
        int mism = 0, distinct = 0;
        for (int b = 0; b < nb; ++b) { if (rec[b] != rec[b & 7]) ++mism; }
        for (int a = 0; a < 8; ++a) { bool dup = false; for (int b2 = 0; b2 < a; ++b2) dup = dup || (rec[a] == rec[b2]); if (!dup) ++distinct; }
        const float v = sqrtf((float)(PROBE_XCC == 1 ? mism : distinct) + 1.0f);
        for (long i = (long)bid * NTHR + threadIdx.x; i < (long)T_TOK * 1024; i += (long)nb * NTHR) p.out[i] = v;
        return;
    }
#endif
    phase0(p, smem, bid, nb);  grid.sync();
    REP(1, phase1<1>(p, smem, bid, nb))
    phase1(p, smem, bid, nb);  GSYNC();
    REP(2, phase2(p, smem, bid, nb))
    phase2(p, smem, bid, nb);  GSYNC();
#ifndef PROBE_P3PARTS
#define PROBE_P3PARTS 7
#endif
#ifndef PROBE_NSAV
#define PROBE_NSAV 7
#endif
    REP(3, (phase3<PROBE_P3PARTS, PROBE_NSAV>(p, smem, bid, nb, 1)))
    phase3(p, smem, bid, nb);  GSYNC();
    REP(4, phase4(p, smem, bid, nb))
#ifdef PROBE_X
    phase_probe<PROBE_X>(p, smem, bid, nb); GSYNC();
#endif
    phase4(p, smem, bid, nb);  GSYNC();
    REP(5, phase5(p, smem, bid, nb))
    phase5(p, smem, bid, nb);  GSYNC();
    REP(6, phase6(p, smem, bid, nb))
    phase6(p, smem, bid, nb);  GSYNC();
    REP(7, phase7(p, smem, bid, nb))
    phase7(p, smem, bid, nb);  GSYNC();
    REP(8, phase8(p, smem, bid, nb, 1))
    phase8(p, smem, bid, nb);  GSYNC();
#ifndef PROBE_P9PARTS
#define PROBE_P9PARTS 3
#endif
    REP(9, phase9<PROBE_P9PARTS>(p, smem, bid, nb))
    phase9(p, smem, bid, nb);  GSYNC();
#ifndef PROBE_P10V
#define PROBE_P10V 0
#endif
    REP(10, phase10<PROBE_P10V>(p, smem, bid, nb))
    phase10(p, smem, bid, nb); GSYNC();
    REP(11, phase11(p, smem, bid, nb))
    phase11(p, smem, bid, nb);
}
#else
#define PHASE_KERNEL(n) __global__ void __launch_bounds__(NTHR) fwd_phase##n(Params p) { extern __shared__ __attribute__((aligned(16))) char smem[]; phase##n(p, smem, blockIdx.x, gridDim.x); }
PHASE_KERNEL(0) PHASE_KERNEL(1) PHASE_KERNEL(2) PHASE_KERNEL(3) PHASE_KERNEL(4) PHASE_KERNEL(5)
PHASE_KERNEL(6) PHASE_KERNEL(7) PHASE_KERNEL(8) PHASE_KERNEL(9) PHASE_KERNEL(10) PHASE_KERNEL(11)
typedef void (*phase_fn)(Params);
#endif

extern "C" void kernel_launch(void* const* d_in, const int* in_sizes, int n_in, void* d_out, int out_size, void* d_ws, size_t ws_size, hipStream_t stream) {
    Params p{};
    for (int i = 0; i < 32; ++i) p.in[i] = (const float*)d_in[i];
    p.out = (float*)d_out;
    p.ws = (char*)d_ws;
    if (n_in != 32 || ws_size < WS_END) { fprintf(stderr, "kernel_launch: unexpected inputs (n_in %d) or workspace too small (%zu < %zu)\n", n_in, ws_size, (size_t)WS_END); return; }
#if MEGA
    static int grid = 0;
    if (!grid) {
        int dev = 0, cus = 0, per_cu = 0;
        (void)hipGetDevice(&dev);
        (void)hipDeviceGetAttribute(&cus, hipDeviceAttributeMultiprocessorCount, dev);
        (void)hipFuncSetAttribute((const void*)fwd_mega, hipFuncAttributeMaxDynamicSharedMemorySize, LDS_BYTES);
        (void)hipOccupancyMaxActiveBlocksPerMultiprocessor(&per_cu, (const void*)fwd_mega, NTHR, LDS_BYTES);
        if (per_cu < 1) { fprintf(stderr, "kernel_launch: occupancy query says %d blocks/CU\n", per_cu); per_cu = 1; }
        grid = cus;
    }
    (void)hipMemsetAsync((char*)d_ws + WS_BAR, 0, 16384, stream);
    void* args[] = {&p};
    hipError_t e = hipLaunchCooperativeKernel((const void*)fwd_mega, dim3(grid), dim3(NTHR), args, LDS_BYTES, stream);
    if (e != hipSuccess) fprintf(stderr, "cooperative launch failed: %s (grid %d)\n", hipGetErrorString(e), grid);
#else
    static const phase_fn fns[12] = {fwd_phase0, fwd_phase1, fwd_phase2, fwd_phase3, fwd_phase4, fwd_phase5, fwd_phase6, fwd_phase7, fwd_phase8, fwd_phase9, fwd_phase10, fwd_phase11};
    static bool attr = false;
    if (!attr) { for (int i = 0; i < 12; ++i) (void)hipFuncSetAttribute((const void*)fns[i], hipFuncAttributeMaxDynamicSharedMemorySize, LDS_BYTES); attr = true; }
    for (int i = 0; i < 12; ++i) hipLaunchKernelGGL(fns[i], dim3(256), dim3(NTHR), LDS_BYTES, stream, p);
#endif
}
```

```cpp
#include <hip/hip_runtime.h>
#include <hip/hip_cooperative_groups.h>
#include <stdint.h>
#include <stdio.h>
namespace cg = cooperative_groups;

#ifndef MEGA
#define MEGA 1
#endif

typedef unsigned short bf16_t;
typedef short bf16x8 __attribute__((ext_vector_type(8)));
typedef short s16x4 __attribute__((ext_vector_type(4)));
typedef float f32x4 __attribute__((ext_vector_type(4)));
typedef float f32x2 __attribute__((ext_vector_type(2)));
typedef unsigned u32x4 __attribute__((ext_vector_type(4)));
typedef unsigned u32x2 __attribute__((ext_vector_type(2)));
typedef __bf16 bf16x2_t __attribute__((ext_vector_type(2)));

#ifndef INPROJ_F8
#define INPROJ_F8 0
#endif
constexpr int T_TOK = 32768, DM = 1024, NB = 16, SEQ = 2048;
constexpr int PW = 3328;
constexpr int PC_Q = 0, PC_KC = 512, PC_VC = 640, PC_KS = 768, PC_VS = 896, PC_KW = 1024, PC_VW = 1152;
constexpr int PC_MQ = 1280, PC_MK = 1792, PC_MV = 2304, PC_MO = 2816;
constexpr float ALPHA = 1.189207115002721f;
constexpr float LN_EPS = 1e-5f;
constexpr int NTHR = 512;
constexpr int LDS_BYTES = 160 * 1024;
constexpr int NEXP = 256, TOPK = 8;
constexpr float W8_SCALE = 64.0f, H8_SCALE = 16.0f, Y8_SCALE = 64.0f;
constexpr int LIST_CAP = 32768;

constexpr size_t al256(size_t x) { return (x + 255) & ~(size_t)255; }
constexpr size_t WS_WIN = 0;
constexpr size_t WS_WOUT = WS_WIN + al256((size_t)3360 * 1024 * 2);
constexpr size_t WS_WQ = WS_WOUT + (size_t)1024 * 1024 * 2;
constexpr size_t WS_WKV = WS_WQ + (size_t)1024 * 1024 * 2;
constexpr size_t WS_WO = WS_WKV + (size_t)2048 * 1024 * 2;
constexpr size_t WS_WR = WS_WO + (size_t)1024 * 1024 * 2;
constexpr size_t WS_WS13 = WS_WR + (size_t)256 * 1024 * 2;
constexpr size_t WS_WS2 = WS_WS13 + (size_t)512 * 1024 * 2;
constexpr size_t WS_CK1 = WS_WS2 + (size_t)1024 * 256 * 2;
constexpr size_t WS_CK2 = WS_CK1 + (size_t)64 * 2048 * 2;
constexpr size_t WS_CV1 = WS_CK2 + (size_t)64 * 64 * 2;
constexpr size_t WS_CV2 = WS_CV1 + (size_t)64 * 2048 * 2;
constexpr size_t MB = 1024 * 1024;
constexpr size_t WS_LNP = al256(WS_CV2 + (size_t)64 * 64 * 2);
constexpr size_t WS_LNF = WS_LNP + (size_t)2 * 16 * 1792 * 4;
constexpr size_t WS_A = al256(WS_LNF + (size_t)2 * 1792 * 4 + 65536);
constexpr size_t WS_P = WS_A;
constexpr size_t WS_R1 = WS_A;
constexpr size_t WS_XQ = WS_A + 128 * MB;
constexpr size_t WS_XO = WS_A + 192 * MB;
constexpr size_t WS_XB = WS_A + 208 * MB;
constexpr size_t WS_MEMB = WS_A + 272 * MB;
constexpr size_t WS_PSM = WS_A + 280 * MB;
constexpr size_t WS_KCMP = WS_A + 284 * MB;
constexpr size_t WS_VCMP = WS_KCMP + (size_t)16 * 2 * 128 * 64 * 2;
constexpr size_t WS_QK = WS_A + 285 * MB;
constexpr size_t WS_MIX = WS_A + 349 * MB;
constexpr size_t WS_KVX = WS_A + 413 * MB;
constexpr size_t WS_X2F8 = WS_A + 256 * MB;
constexpr size_t WS_X2 = WS_A + 256 * MB;
constexpr size_t WS_HS = WS_A + 320 * MB;
constexpr size_t WS_R1B = WS_A;
constexpr size_t WS_RSC = WS_A;
constexpr size_t WS_Y = WS_A;
constexpr size_t WS_B = WS_A + al256((size_t)(T_TOK * 8 + 256) * 1024 * 2);
constexpr size_t WS_R2B = WS_B;
constexpr size_t WS_R2 = WS_B;
constexpr size_t WS_ST1 = WS_R2 + (size_t)T_TOK * 1024 * 4;
constexpr size_t WS_ST2 = WS_ST1 + (size_t)T_TOK * 8 * 4;
constexpr size_t WS_SH = WS_ST2 + (size_t)T_TOK * 8 * 4;
constexpr size_t WS_SELE = WS_SH + (size_t)T_TOK * 1024 * 2;
constexpr size_t WS_SELP = WS_SELE + (size_t)T_TOK * 8 * 4;
constexpr size_t WS_SELW = WS_SELP + (size_t)T_TOK * 8 * 4;
constexpr size_t WS_CNT = WS_SELW + (size_t)T_TOK * 8 * 4;
constexpr size_t WS_TOKL = WS_CNT + 98304;
constexpr size_t WS_WL = WS_TOKL + (size_t)NEXP * LIST_CAP * 4;
constexpr size_t WS_H = WS_WL + (size_t)NEXP * LIST_CAP * 4;
constexpr size_t WS_HF8 = WS_H;
constexpr size_t WS_W2F8 = WS_H + (size_t)(T_TOK * 8 + 256) * 256;
constexpr size_t WS_BAR = WS_W2F8 + (size_t)256 * 1024 * 256;
constexpr size_t WS_END = WS_BAR + 16384;
static_assert((size_t)T_TOK * PW * 2 <= 208 * MB, "P region");
static_assert(WS_END <= (size_t)1024 * MB, "workspace must fit 1 GiB");

struct Params {
    const float* in[32];
    float* out;
    char* ws;
};

__device__ __forceinline__ unsigned pk_bf16(float lo, float hi) {
    f32x2 v = {lo, hi};
    bf16x2_t r = __builtin_convertvector(v, bf16x2_t);
    return __builtin_bit_cast(unsigned, r);
}
__device__ __forceinline__ float bf_lo(unsigned u) { return __uint_as_float(u << 16); }
__device__ __forceinline__ float bf_hi(unsigned u) { return __uint_as_float(u & 0xffff0000u); }
__device__ __forceinline__ float bf2f(bf16_t h) { return __uint_as_float(((unsigned)h) << 16); }
__device__ __forceinline__ float sigmoidf_(float x) { return 1.0f / (1.0f + __expf(-x)); }
__device__ __forceinline__ float siluf_(float x) { return x / (1.0f + __expf(-x)); }
__device__ __forceinline__ f32x4 mfma16(bf16x8 a, bf16x8 b, f32x4 c) { return __builtin_amdgcn_mfma_f32_16x16x32_bf16(a, b, c, 0, 0, 0); }
__device__ __forceinline__ bf16x8 as_bf16x8(u32x4 v) { return __builtin_bit_cast(bf16x8, v); }

__device__ __forceinline__ float fq_max(float x) {
    auto a = __builtin_amdgcn_permlane16_swap(__float_as_uint(x), __float_as_uint(x), false, false);
    x = __builtin_fmaxf(__uint_as_float(a[0]), __uint_as_float(a[1]));
    auto b = __builtin_amdgcn_permlane32_swap(__float_as_uint(x), __float_as_uint(x), false, false);
    return __builtin_fmaxf(__uint_as_float(b[0]), __uint_as_float(b[1]));
}
__device__ __forceinline__ float fq_sum(float x) {
    auto a = __builtin_amdgcn_permlane16_swap(__float_as_uint(x), __float_as_uint(x), false, false);
    x = __uint_as_float(a[0]) + __uint_as_float(a[1]);
    auto b = __builtin_amdgcn_permlane32_swap(__float_as_uint(x), __float_as_uint(x), false, false);
    return __uint_as_float(b[0]) + __uint_as_float(b[1]);
}
__device__ __forceinline__ int opaque_tid() { int t = threadIdx.x; asm volatile("" : "+v"(t)); return t; }

__device__ __forceinline__ int tile_off(int row, int chunk) { return row * 128 + ((chunk ^ (row & 7)) << 4); }

__device__ __forceinline__ int bperm(int rho) { return (rho & ~31) + 8 * ((rho >> 2) & 3) + 4 * ((rho >> 4) & 1) + (rho & 3); }

typedef __attribute__((address_space(3))) unsigned lds_u32;
typedef __attribute__((address_space(1))) const unsigned glb_u32;

struct LoadBf16Rows {
    const bf16_t* base;
    unsigned off[4];
    int ldst;
    struct Regs { int dummy; };
    __device__ __forceinline__ void init_contig(const bf16_t* b, int ld, int row0) {
        const int tid_ = opaque_tid();
        const int r8 = tid_ >> 3, kc = (tid_ & 7) ^ (r8 & 7);
        ldst = tid_ * 16;
        base = b + (long)row0 * ld;
#pragma unroll
        for (int i = 0; i < 4; ++i) off[i] = (unsigned)((r8 + 64 * i) * ld + kc * 8);
    }
    __device__ __forceinline__ void init_rows(const bf16_t* b, int ld, const int (&rows)[4]) {
        const int tid_ = opaque_tid();
        const int r8 = tid_ >> 3, kc = (tid_ & 7) ^ (r8 & 7);
        ldst = tid_ * 16;
        base = b;
#pragma unroll
        for (int i = 0; i < 4; ++i) off[i] = (unsigned)rows[i] * (unsigned)ld + (unsigned)(kc * 8);
    }
    __device__ __forceinline__ void issue(Regs&, char* s, int kt) const {
#pragma unroll
        for (int i = 0; i < 4; ++i)
            __builtin_amdgcn_global_load_lds((glb_u32*)(base + (size_t)(off[i] + (unsigned)(kt * 64))), (lds_u32*)(s + i * 8192 + ldst), 16, 0, 0);
    }
    __device__ __forceinline__ void commit(const Regs&, char*, int) const {}
};

struct LoadF32KN {
    const float* p;
    int ldn;
    int n, kh;
    struct Regs { float v[32]; };
    __device__ __forceinline__ void issue(Regs& r, char*, int kt) const {
        const float* q = p + (long)kt * 64 * ldn;
#pragma unroll
        for (int j = 0; j < 32; ++j) r.v[j] = q[(long)j * ldn];
    }
    __device__ __forceinline__ void commit(const Regs& r, char* s, int kt) const {
#pragma unroll
        for (int q = 0; q < 4; ++q) {
            u32x4 w;
            w.x = pk_bf16(r.v[8 * q + 0], r.v[8 * q + 1]); w.y = pk_bf16(r.v[8 * q + 2], r.v[8 * q + 3]);
            w.z = pk_bf16(r.v[8 * q + 4], r.v[8 * q + 5]); w.w = pk_bf16(r.v[8 * q + 6], r.v[8 * q + 7]);
            *(u32x4*)(s + tile_off(n, kh * 4 + q)) = w;
        }
    }
};

struct LoadLN {
    LoadBf16Rows raw;
    bf16_t* xbase;
    const float* st;
    const float* gb;
    typedef LoadBf16Rows::Regs Regs;
    __device__ __forceinline__ void issue(Regs& r, char* s, int kt) const { raw.issue(r, s, kt); }
    __device__ __forceinline__ void commit(const Regs&, char* s, int kt) const {
        asm volatile("s_waitcnt vmcnt(0)" ::: "memory");
        const int tid_ = opaque_tid();
        const int r8 = tid_ >> 3, kc = (tid_ & 7) ^ (r8 & 7);
        const f32x4 g0 = *(const f32x4*)(gb + kt * 64 + kc * 8), g1 = *(const f32x4*)(gb + kt * 64 + kc * 8 + 4);
        const f32x4 b0 = *(const f32x4*)(gb + 1024 + kt * 64 + kc * 8), b1 = *(const f32x4*)(gb + 1024 + kt * 64 + kc * 8 + 4);
#pragma unroll
        for (int i = 0; i < 4; ++i) {
            const int row = r8 + 64 * i;
            u32x4* cp = (u32x4*)(s + i * 8192 + tid_ * 16);
            const u32x4 v = *cp;
            const float mean = st[row * 2], rstd = st[row * 2 + 1];
            const f32x4 x0 = (f32x4){bf_lo(v.x), bf_hi(v.x), bf_lo(v.y), bf_hi(v.y)};
            const f32x4 x1 = (f32x4){bf_lo(v.z), bf_hi(v.z), bf_lo(v.w), bf_hi(v.w)};
            const f32x4 y0 = (x0 - mean) * rstd * g0 + b0, y1 = (x1 - mean) * rstd * g1 + b1;
            u32x4 w; w.x = pk_bf16(y0[0], y0[1]); w.y = pk_bf16(y0[2], y0[3]); w.z = pk_bf16(y1[0], y1[1]); w.w = pk_bf16(y1[2], y1[3]);
            *cp = w;
            if (xbase) *(u32x4*)(xbase + (size_t)(row * 1024 + kc * 8 + kt * 64)) = w;
        }
    }
};

constexpr int GEMM_LDS = 131072;
template <class AL, class BL>
__device__ __forceinline__ void gemm_mainloop(char* smem, const AL& al, const BL& bl, int nk, f32x4 (&acc)[8][4]) {
    const int tid_ = opaque_tid();
    const int lane = tid_ & 63, wid = tid_ >> 6;
    const int wr = wid >> 2, wc = wid & 3, fr = lane & 15, fq = lane >> 4;
#pragma unroll
    for (int mi = 0; mi < 8; ++mi)
#pragma unroll
        for (int ni = 0; ni < 4; ++ni) acc[mi][ni] = (f32x4){0.f, 0.f, 0.f, 0.f};
    typename AL::Regs ra; typename BL::Regs rb;
    al.issue(ra, smem, 0); bl.issue(rb, smem + 32768, 0);
    al.commit(ra, smem, 0); bl.commit(rb, smem + 32768, 0);
    __syncthreads();
    for (int kt = 0; kt < nk; ++kt) {
        char* sA = smem + (kt & 1) * 65536; char* sB = sA + 32768;
        char* nA = smem + ((kt + 1) & 1) * 65536; char* nB = nA + 32768;
        if (kt + 1 < nk) { al.issue(ra, nA, kt + 1); bl.issue(rb, nB, kt + 1); }
#pragma unroll
        for (int kk = 0; kk < 2; ++kk) {
            bf16x8 bfr[4];
#pragma unroll
            for (int ni = 0; ni < 4; ++ni) bfr[ni] = *(const bf16x8*)(sB + tile_off(wc * 64 + ni * 16 + fr, kk * 4 + fq));
#pragma unroll
            for (int mi = 0; mi < 8; ++mi) {
                const bf16x8 af = *(const bf16x8*)(sA + tile_off(wr * 128 + mi * 16 + fr, kk * 4 + fq));
#pragma unroll
                for (int ni = 0; ni < 4; ++ni) acc[mi][ni] = mfma16(bfr[ni], af, acc[mi][ni]);
            }
        }
        if (kt + 1 < nk) { al.commit(ra, nA, kt + 1); bl.commit(rb, nB, kt + 1); }
        __syncthreads();
    }
}

__device__ __forceinline__ int swz4(int row) { return (0x78 >> (((row >> 2) & 3) * 2)) & 3; }
struct RingRows {
    const bf16_t* base; unsigned off[2]; int ldst;
    __device__ __forceinline__ void init_contig(const bf16_t* b, int ld, int row0, bool perm = false) {
        const int tid_ = opaque_tid(); const int r = tid_ >> 2, kc = (tid_ & 3) ^ swz4(r);
        ldst = tid_ * 16; base = b + (long)row0 * ld;
#pragma unroll
        for (int i = 0; i < 2; ++i) { const int rr = r + 128 * i; off[i] = (unsigned)((perm ? bperm(rr) : rr) * ld + kc * 8); }
    }
    __device__ __forceinline__ void init_rows(const bf16_t* b, int ld, const int (&rows)[2]) {
        const int tid_ = opaque_tid(); const int r = tid_ >> 2, kc = (tid_ & 3) ^ swz4(r);
        ldst = tid_ * 16; base = b;
#pragma unroll
        for (int i = 0; i < 2; ++i) off[i] = (unsigned)rows[i] * (unsigned)ld + (unsigned)(kc * 8);
    }
    __device__ __forceinline__ void issue(char* s, int kt) const {
#pragma unroll
        for (int i = 0; i < 2; ++i)
            __builtin_amdgcn_global_load_lds((glb_u32*)(base + (size_t)(off[i] + (unsigned)(kt * 32))), (lds_u32*)(s + i * 8192 + ldst), 16, 0, 0);
    }
    __device__ __forceinline__ void commit(char*, int) const {}
};
struct RingLN {
    RingRows raw; bf16_t* xbase; const float* st; const float* gb;
    __device__ __forceinline__ void issue(char* s, int kt) const { raw.issue(s, kt); }
    __device__ __forceinline__ void commit(char* s, int kt) const {
        const int tid_ = opaque_tid(); const int r = tid_ >> 2, kc = (tid_ & 3) ^ swz4(r);
        const f32x4 g0 = *(const f32x4*)(gb + kt * 32 + kc * 8), g1 = *(const f32x4*)(gb + kt * 32 + kc * 8 + 4);
        const f32x4 b0 = *(const f32x4*)(gb + 1024 + kt * 32 + kc * 8), b1 = *(const f32x4*)(gb + 1024 + kt * 32 + kc * 8 + 4);
#pragma unroll
        for (int i = 0; i < 2; ++i) {
            const int row = r + 128 * i;
            u32x4* cp = (u32x4*)(s + i * 8192 + tid_ * 16);
            const u32x4 v = *cp;
            const float mean = st[row * 2], rstd = st[row * 2 + 1];
            const f32x4 x0 = (f32x4){bf_lo(v.x), bf_hi(v.x), bf_lo(v.y), bf_hi(v.y)};
            const f32x4 x1 = (f32x4){bf_lo(v.z), bf_hi(v.z), bf_lo(v.w), bf_hi(v.w)};
            const f32x4 y0 = (x0 - mean) * rstd * g0 + b0, y1 = (x1 - mean) * rstd * g1 + b1;
            u32x4 w; w.x = pk_bf16(y0[0], y0[1]); w.y = pk_bf16(y0[2], y0[3]); w.z = pk_bf16(y1[0], y1[1]); w.w = pk_bf16(y1[2], y1[3]);
            *cp = w;
            if (xbase) *(u32x4*)(xbase + (size_t)(row * 1024 + kc * 8 + kt * 32)) = w;
        }
    }
};
#define RING_WAIT(n) asm volatile("s_waitcnt vmcnt(" #n ")" ::: "memory")
#define RING_BAR() do { __builtin_amdgcn_sched_barrier(0); asm volatile("s_waitcnt lgkmcnt(0)" ::: "memory"); __builtin_amdgcn_s_barrier(); asm volatile("" ::: "memory"); __builtin_amdgcn_sched_barrier(0); } while (0)
template <class AL, class BL>
__device__ __forceinline__ void ring_issue3(char* smem, const AL& al, const BL& bl) {
    al.issue(smem, 0); bl.issue(smem + 16384, 0);
    al.issue(smem + 32768, 1); bl.issue(smem + 32768 + 16384, 1);
    al.issue(smem + 65536, 2); bl.issue(smem + 65536 + 16384, 2);
}
template <class AL, class BL, int XMODE = 0  , bool ISSUED = false  >
__device__ __forceinline__ void gemm_ring(char* smem, const AL& al, const BL& bl, int nk  , f32x4 (&acc)[8][4]) {
    const int tid_ = opaque_tid();
    const int lane = tid_ & 63, wid = __builtin_amdgcn_readfirstlane(tid_ >> 6);
    const int wr = wid >> 2, wc = wid & 3, fr = lane & 15, fq = lane >> 4;
#pragma unroll
    for (int mi = 0; mi < 8; ++mi)
#pragma unroll
        for (int ni = 0; ni < 4; ++ni) acc[mi][ni] = (f32x4){0.f, 0.f, 0.f, 0.f};
    const int aoff = (wr * 128 + fr) * 64 + ((fq ^ swz4(fr)) << 4);
    const int boff = 16384 + (wc * 64 + fr) * 64 + ((fq ^ swz4(fr)) << 4);
    if (XMODE != 1) {
    if (!ISSUED) ring_issue3(smem, al, bl);
    RING_WAIT(8);
    al.commit(smem, 0); bl.commit(smem + 16384, 0);
    }
    RING_BAR();
    if (wr == 1) RING_BAR();
    for (int kt = 0; kt < nk; ++kt) {
        const char* st = smem + (kt & 3) * 32768;
        if (XMODE != 1 && kt + 3 < nk) { char* s3 = smem + ((kt + 3) & 3) * 32768; al.issue(s3, kt + 3); bl.issue(s3 + 16384, kt + 3); }
        bf16x8 bfr[4], afr[8];
        if (XMODE != 2) {
#pragma unroll
        for (int ni = 0; ni < 4; ++ni) bfr[ni] = *(const bf16x8*)(st + boff + ni * 1024);
#pragma unroll
        for (int mi = 0; mi < 8; ++mi) afr[mi] = *(const bf16x8*)(st + aoff + mi * 1024);
        }
        if (XMODE != 1 && kt + 1 < nk) {
            if (kt + 3 < nk) RING_WAIT(8); else if (kt + 2 < nk) RING_WAIT(4); else RING_WAIT(0);
            char* s1 = smem + ((kt + 1) & 3) * 32768;
            al.commit(s1, kt + 1); bl.commit(s1 + 16384, kt + 1);
        }
        RING_BAR();
        if (XMODE != 2) {
        __builtin_amdgcn_s_setprio(1);
#pragma unroll
        for (int mi = 0; mi < 8; ++mi)
#pragma unroll
            for (int ni = 0; ni < 4; ++ni) acc[mi][ni] = mfma16(bfr[ni], afr[mi], acc[mi][ni]);
        __builtin_amdgcn_s_setprio(0);
        }
        RING_BAR();
    }
    if (wr == 0) RING_BAR();
}

constexpr int FB_PITCH = 1088, FB_STAGE = 16384 + 32 * FB_PITCH;
struct RingF32B {
    const float* p; int ldn; int ldst;
    __device__ __forceinline__ void init(const float* W, int ld, int srccol4, int tid_) { const int lane = tid_ & 63, wid = tid_ >> 6; p = W + (long)wid * ld + srccol4; ldn = ld; ldst = wid * FB_PITCH + lane * 16; }
    __device__ __forceinline__ void issue(char* sB, int kt) const {
#pragma unroll
        for (int i = 0; i < 4; ++i)
            __builtin_amdgcn_global_load_lds((glb_u32*)(p + (long)(kt * 32 + i * 8) * ldn), (lds_u32*)(sB + i * 8 * FB_PITCH + (i & 1) * 64 + ldst), 16, 0, 0);
    }
};
template <class AL>
__device__ __forceinline__ void gemm_ring_f32b(char* smem, const AL& al, const RingF32B& bl, int nk  , f32x4 (&acc)[8][4]) {
    const int tid_ = opaque_tid();
    const int lane = tid_ & 63, wid = __builtin_amdgcn_readfirstlane(tid_ >> 6);
    const int wr = wid >> 2, wc = wid & 3, fr = lane & 15, fq = lane >> 4;
#pragma unroll
    for (int mi = 0; mi < 8; ++mi)
#pragma unroll
        for (int ni = 0; ni < 4; ++ni) acc[mi][ni] = (f32x4){0.f, 0.f, 0.f, 0.f};
    const int aoff = (wr * 128 + fr) * 64 + ((fq ^ swz4(fr)) << 4);
    const int boff = 16384 + (8 * fq) * FB_PITCH + (fq & 1) * 64 + (wc * 64 + fr) * 4;
    al.issue(smem, 0); bl.issue(smem + 16384, 0);
    al.issue(smem + FB_STAGE, 1); bl.issue(smem + FB_STAGE + 16384, 1);
    RING_WAIT(6);
    RING_BAR();
    if (wr == 1) RING_BAR();
    int s0 = 0;
    for (int kt = 0; kt < nk; ++kt) {
        const char* st = smem + s0 * FB_STAGE;
        const int s1 = s0 == 2 ? 0 : s0 + 1, s2 = s1 == 2 ? 0 : s1 + 1;
        if (kt + 2 < nk) { char* sn = smem + s2 * FB_STAGE; al.issue(sn, kt + 2); bl.issue(sn + 16384, kt + 2); }
        bf16x8 bfr[4], afr[8];
#pragma unroll
        for (int ni = 0; ni < 4; ++ni) {
            float v[8];
#pragma unroll
            for (int j = 0; j < 8; ++j) v[j] = *(const float*)(st + boff + j * FB_PITCH + ni * 64);
            u32x4 w; w.x = pk_bf16(v[0], v[1]); w.y = pk_bf16(v[2], v[3]); w.z = pk_bf16(v[4], v[5]); w.w = pk_bf16(v[6], v[7]);
            bfr[ni] = as_bf16x8(w);
        }
#pragma unroll
        for (int mi = 0; mi < 8; ++mi) afr[mi] = *(const bf16x8*)(st + aoff + mi * 1024);
        if (kt + 1 < nk) { if (kt + 2 < nk) RING_WAIT(6); else RING_WAIT(0); }
        RING_BAR();
        __builtin_amdgcn_s_setprio(1);
#pragma unroll
        for (int mi = 0; mi < 8; ++mi)
#pragma unroll
            for (int ni = 0; ni < 4; ++ni) acc[mi][ni] = mfma16(bfr[ni], afr[mi], acc[mi][ni]);
        __builtin_amdgcn_s_setprio(0);
        RING_BAR();
        s0 = s1;
    }
    if (wr == 0) RING_BAR();
}

__device__ __forceinline__ int bperm32(int rho) { return (rho & ~31) + 16 * ((rho >> 2) & 1) + 4 * ((rho >> 3) & 3) + (rho & 3); }
__device__ __forceinline__ unsigned pk4_fp8(float a, float b, float c, float d) {
    int r = __builtin_amdgcn_cvt_pk_fp8_f32(a, b, 0, false);
    r = __builtin_amdgcn_cvt_pk_fp8_f32(c, d, r, true);
    return (unsigned)r;
}
struct RingF8 {
    const unsigned char* base; unsigned off[2]; int ldst;
    __device__ __forceinline__ void init_contig(const unsigned char* b, int ldb, long row0, bool perm = false) {
        const int tid_ = opaque_tid(); const int r = tid_ >> 2, kc = (tid_ & 3) ^ ((r >> 2) & 3);
        ldst = tid_ * 16; base = b + row0 * ldb;
#pragma unroll
        for (int i = 0; i < 2; ++i) { const int rr = r + 128 * i; off[i] = (unsigned)((perm ? bperm32(rr) : rr) * ldb + kc * 16); }
    }
    __device__ __forceinline__ void init_rows(const unsigned char* b, int ldb, const int (&rows)[2]) {
        const int tid_ = opaque_tid(); const int r = tid_ >> 2, kc = (tid_ & 3) ^ ((r >> 2) & 3);
        ldst = tid_ * 16; base = b;
#pragma unroll
        for (int i = 0; i < 2; ++i) off[i] = (unsigned)rows[i] * (unsigned)ldb + (unsigned)(kc * 16);
    }
    __device__ __forceinline__ void issue(char* s, int kt) const {
#pragma unroll
        for (int i = 0; i < 2; ++i)
            __builtin_amdgcn_global_load_lds((glb_u32*)(base + (size_t)(off[i] + (unsigned)(kt * 64))), (lds_u32*)(s + i * 8192 + ldst), 16, 0, 0);
    }
};
__device__ __forceinline__ void ring_f8_issue3(char* smem, const RingF8& al, const RingF8& bl) {
    al.issue(smem, 0); bl.issue(smem + 16384, 0);
    al.issue(smem + 32768, 1); bl.issue(smem + 32768 + 16384, 1);
    al.issue(smem + 65536, 2); bl.issue(smem + 65536 + 16384, 2);
}
__device__ __forceinline__ void gemm_ring_f8_main(char* smem, const RingF8& al, const RingF8& bl, int nk  , f32x4 (&acc)[8][4]) {
    const int tid_ = opaque_tid();
    const int lane = tid_ & 63, wid = __builtin_amdgcn_readfirstlane(tid_ >> 6);
    const int wr = wid >> 2, wc = wid & 3, fr = lane & 15, fq = lane >> 4;
#pragma unroll
    for (int mi = 0; mi < 8; ++mi)
#pragma unroll
        for (int ni = 0; ni < 4; ++ni) acc[mi][ni] = (f32x4){0.f, 0.f, 0.f, 0.f};
    const int g2 = ((fr >> 2) & 3) << 1;
    const int aoff0 = (wr * 128 + fr) * 64 + ((fq ^ g2) << 3), aoff1 = (wr * 128 + fr) * 64 + (((4 + fq) ^ g2) << 3);
    const int boff0 = 16384 + (wc * 64 + fr) * 64 + ((fq ^ g2) << 3), boff1 = 16384 + (wc * 64 + fr) * 64 + (((4 + fq) ^ g2) << 3);
    RING_WAIT(8);
    RING_BAR();
    if (wr == 1) RING_BAR();
    for (int kt = 0; kt < nk; ++kt) {
        const char* st = smem + (kt & 3) * 32768;
        if (kt + 3 < nk) { char* s3 = smem + ((kt + 3) & 3) * 32768; al.issue(s3, kt + 3); bl.issue(s3 + 16384, kt + 3); }
        long b0[4], b1[4], a0[8], a1[8];
#pragma unroll
        for (int ni = 0; ni < 4; ++ni) { b0[ni] = *(const long*)(st + boff0 + ni * 1024); b1[ni] = *(const long*)(st + boff1 + ni * 1024); }
#pragma unroll
        for (int mi = 0; mi < 8; ++mi) { a0[mi] = *(const long*)(st + aoff0 + mi * 1024); a1[mi] = *(const long*)(st + aoff1 + mi * 1024); }
        if (kt + 1 < nk) { if (kt + 3 < nk) RING_WAIT(8); else if (kt + 2 < nk) RING_WAIT(4); else RING_WAIT(0); }
        RING_BAR();
        __builtin_amdgcn_s_setprio(1);
#pragma unroll
        for (int mi = 0; mi < 8; ++mi)
#pragma unroll
            for (int ni = 0; ni < 4; ++ni) {
                acc[mi][ni] = __builtin_amdgcn_mfma_f32_16x16x32_fp8_fp8(b0[ni], a0[mi], acc[mi][ni], 0, 0, 0);
                acc[mi][ni] = __builtin_amdgcn_mfma_f32_16x16x32_fp8_fp8(b1[ni], a1[mi], acc[mi][ni], 0, 0, 0);
            }
        __builtin_amdgcn_s_setprio(0);
        RING_BAR();
    }
    if (wr == 0) RING_BAR();
}

typedef int i32x8 __attribute__((ext_vector_type(8)));
typedef float f32x16 __attribute__((ext_vector_type(16)));
constexpr int MX_ONE = 0x7f7f7f7f;
__device__ __forceinline__ f32x16 mfma_mx(i32x8 a, i32x8 b, f32x16 c) { return __builtin_amdgcn_mfma_scale_f32_32x32x64_f8f6f4(a, b, c, 0, 0, 0, MX_ONE, 0, MX_ONE); }
__device__ __forceinline__ i32x8 mx_frag(const char* rowp  , int c0off, int c1off) {
    const u32x4 lo = *(const u32x4*)(rowp + c0off), hi = *(const u32x4*)(rowp + c1off);
    return (i32x8){(int)lo.x, (int)lo.y, (int)lo.z, (int)lo.w, (int)hi.x, (int)hi.y, (int)hi.z, (int)hi.w};
}
__device__ __forceinline__ void gemm_ring_mx_main(char* smem, const RingF8& al, const RingF8& bl, int nk  , f32x16 (&acc)[4][2]) {
    const int tid_ = opaque_tid();
    const int lane = tid_ & 63, wid = __builtin_amdgcn_readfirstlane(tid_ >> 6);
    const int wr = wid >> 2, wc = wid & 3, r = lane & 31, h = lane >> 5;
#pragma unroll
    for (int mi = 0; mi < 4; ++mi)
#pragma unroll
        for (int nj = 0; nj < 2; ++nj)
#pragma unroll
            for (int q = 0; q < 16; ++q) acc[mi][nj][q] = 0.f;
    const int g = (r >> 2) & 3;
    const int c0 = ((2 * h) ^ g) << 4, c1 = ((2 * h + 1) ^ g) << 4;
    const int arow = (wr * 128 + r) * 64;
    const int brow = 16384 + (wc * 64 + r) * 64;
    RING_WAIT(8);
    RING_BAR();
    if (wr == 1) RING_BAR();
#pragma unroll 1
    for (int kt = 0; kt < nk; ++kt) {
        const char* st = smem + (kt & 3) * 32768;
        if (kt + 3 < nk) { char* s3 = smem + ((kt + 3) & 3) * 32768; al.issue(s3, kt + 3); bl.issue(s3 + 16384, kt + 3); }
        i32x8 bf[2], af[4];
#pragma unroll
        for (int nj = 0; nj < 2; ++nj) bf[nj] = mx_frag(st + brow + nj * 2048, c0, c1);
#pragma unroll
        for (int mi = 0; mi < 4; ++mi) af[mi] = mx_frag(st + arow + mi * 2048, c0, c1);
        if (kt + 1 < nk) { if (kt + 3 < nk) RING_WAIT(8); else if (kt + 2 < nk) RING_WAIT(4); else RING_WAIT(0); }
        RING_BAR();
        __builtin_amdgcn_s_setprio(1);
#pragma unroll
        for (int mi = 0; mi < 4; ++mi)
#pragma unroll
            for (int nj = 0; nj < 2; ++nj) acc[mi][nj] = mfma_mx(bf[nj], af[mi], acc[mi][nj]);
        __builtin_amdgcn_s_setprio(0);
        RING_BAR();
    }
    if (wr == 0) RING_BAR();
}

__device__ __forceinline__ int bperm16(int rho) { return (rho & ~63) + 16 * ((rho >> 2) & 3) + 4 * ((rho >> 4) & 3) + (rho & 3); }

__device__ __forceinline__ void epi_store_bf16(const f32x4 (&acc)[8][4], bf16_t* out, long ld, int row0, int col0) {
    const int tid_ = opaque_tid();
    const int lane = tid_ & 63, wid = tid_ >> 6;
    const int wr = wid >> 2, wc = wid & 3, fr = lane & 15, fq = lane >> 4;
#pragma unroll
    for (int mi = 0; mi < 8; ++mi) {
        bf16_t* rp = out + (long)(row0 + wr * 128 + mi * 16 + fr) * ld + col0 + wc * 64 + fq * 8;
#pragma unroll
        for (int q = 0; q < 2; ++q) {
            u32x4 w; w.x = pk_bf16(acc[mi][2 * q][0], acc[mi][2 * q][1]); w.y = pk_bf16(acc[mi][2 * q][2], acc[mi][2 * q][3]);
            w.z = pk_bf16(acc[mi][2 * q + 1][0], acc[mi][2 * q + 1][1]); w.w = pk_bf16(acc[mi][2 * q + 1][2], acc[mi][2 * q + 1][3]);
            *(u32x4*)(rp + q * 32) = w;
        }
    }
}

template <bool RES_LN>
__device__ __forceinline__ void epi_residual(f32x4 (&acc)[8][4], char* smem, const float* resid_f32, const bf16_t* resid_bf16, const float* rstats  ,
                                             const float* g, const float* b, bf16_t* rbout, float* stout  , int row0, int nt) {
    const int tid_ = opaque_tid();
    const int lane = tid_ & 63, wid = tid_ >> 6;
    const int wr = wid >> 2, wc = wid & 3, fr = lane & 15, fq = lane >> 4;
    float* sp = (float*)(smem + 139264);
    const int col0 = nt * 256 + wc * 64 + fq * 8;
#pragma unroll
    for (int mi = 0; mi < 8; ++mi) {
        const int rl = wr * 128 + mi * 16 + fr;
        const long row = row0 + rl;
        float mean = 0.f, rstd = 1.f;
        if (RES_LN) {
            const f32x4 p0 = *(const f32x4*)(rstats + row * 8), p1 = *(const f32x4*)(rstats + row * 8 + 4);
            const float s1 = (p0[0] + p0[2]) + (p1[0] + p1[2]), s2 = (p0[1] + p0[3]) + (p1[1] + p1[3]);
            mean = s1 * (1.0f / 1024.0f);
            const float var = fmaxf(s2 * (1.0f / 1024.0f) - mean * mean, 0.f);
            rstd = rsqrtf(var + LN_EPS);
        }
        float s1 = 0.f, s2 = 0.f;
#pragma unroll
        for (int q = 0; q < 2; ++q) {
            const long o = row * 1024 + col0 + q * 32;
            f32x4 x0, x1;
            if (RES_LN) {
                const u32x4 u = *(const u32x4*)(resid_bf16 + o);
                x0 = (f32x4){bf_lo(u.x), bf_hi(u.x), bf_lo(u.y), bf_hi(u.y)}; x1 = (f32x4){bf_lo(u.z), bf_hi(u.z), bf_lo(u.w), bf_hi(u.w)};
                x0 = (x0 - mean) * rstd * *(const f32x4*)(g + col0 + q * 32) + *(const f32x4*)(b + col0 + q * 32);
                x1 = (x1 - mean) * rstd * *(const f32x4*)(g + col0 + q * 32 + 4) + *(const f32x4*)(b + col0 + q * 32 + 4);
            } else { x0 = *(const f32x4*)(resid_f32 + o); x1 = *(const f32x4*)(resid_f32 + o + 4); }
            const f32x4 v0 = acc[mi][2 * q] + ALPHA * x0, v1 = acc[mi][2 * q + 1] + ALPHA * x1;
            { u32x4 w; w.x = pk_bf16(v0[0], v0[1]); w.y = pk_bf16(v0[2], v0[3]); w.z = pk_bf16(v1[0], v1[1]); w.w = pk_bf16(v1[2], v1[3]); *(u32x4*)(rbout + o) = w; }
            s1 += ((v0[0] + v0[1]) + (v0[2] + v0[3])) + ((v1[0] + v1[1]) + (v1[2] + v1[3]));
            s2 += ((v0[0] * v0[0] + v0[1] * v0[1]) + (v0[2] * v0[2] + v0[3] * v0[3])) + ((v1[0] * v1[0] + v1[1] * v1[1]) + (v1[2] * v1[2] + v1[3] * v1[3]));
        }
        s1 = fq_sum(s1); s2 = fq_sum(s2);
        if (fq == 0) { sp[(rl * 4 + wc) * 2] = s1; sp[(rl * 4 + wc) * 2 + 1] = s2; }
    }
    __syncthreads();
    if (tid_ < 256) {
        const int rl = tid_;
        const float a1 = (sp[rl * 8] + sp[rl * 8 + 2]) + (sp[rl * 8 + 4] + sp[rl * 8 + 6]);
        const float a2 = (sp[rl * 8 + 1] + sp[rl * 8 + 3]) + (sp[rl * 8 + 5] + sp[rl * 8 + 7]);
        *(f32x2*)(stout + ((long)(row0 + rl) * 4 + nt) * 2) = (f32x2){a1, a2};
    }
    __syncthreads();
}

__device__ __forceinline__ void ln_tile_stats(float* st, const float* rstats, int row0) {
    const int tid_ = opaque_tid();
    if (tid_ < 256) {
        const long row = row0 + tid_;
        const f32x4 p0 = *(const f32x4*)(rstats + row * 8), p1 = *(const f32x4*)(rstats + row * 8 + 4);
        const float s1 = (p0[0] + p0[2]) + (p1[0] + p1[2]), s2 = (p0[1] + p0[3]) + (p1[1] + p1[3]);
        const float mean = s1 * (1.0f / 1024.0f);
        const float var = fmaxf(s2 * (1.0f / 1024.0f) - mean * mean, 0.f);
        st[tid_ * 2] = mean; st[tid_ * 2 + 1] = rsqrtf(var + LN_EPS);
    }
}
__device__ __forceinline__ void ln_load_gb(float* gb, const float* g, const float* b) {
    for (int i = opaque_tid(); i < 1024; i += NTHR) { gb[i] = g[i]; gb[1024 + i] = b[i]; }
}


struct XcdSlab {
    int x, j, stride;
    __device__ __forceinline__ void init(int bid, int nb) { if ((nb & 7) == 0) { x = bid & 7; j = bid >> 3; stride = nb >> 3; } else { x = -1; j = bid; stride = nb; } }
    __device__ __forceinline__ int m_lo(int nM) const { return x < 0 ? 0 : (x * nM) >> 3; }
    __device__ __forceinline__ int m_hi(int nM) const { return x < 0 ? nM : ((x + 1) * nM) >> 3; }
};

template <int MAP>
__device__ __forceinline__ void ln_correct(f32x4 (&acc)[8][4], const float* rstats  , int row0, const float* cs, const float* bw, int nt) {
    const int tid_ = opaque_tid();
    const int lane = tid_ & 63, wid = tid_ >> 6;
    const int wr = wid >> 2, wc = wid & 3, fr = lane & 15, fq = lane >> 4;
    float mean[8], rstd[8];
#pragma unroll
    for (int mi = 0; mi < 8; ++mi) {
        const long row = row0 + wr * 128 + mi * 16 + fr;
        const f32x4 p0 = *(const f32x4*)(rstats + row * 8), p1 = *(const f32x4*)(rstats + row * 8 + 4);
        const float s1 = (p0[0] + p0[2]) + (p1[0] + p1[2]), s2 = (p0[1] + p0[3]) + (p1[1] + p1[3]);
        mean[mi] = s1 * (1.0f / 1024.0f);
        rstd[mi] = rsqrtf(fmaxf(s2 * (1.0f / 1024.0f) - mean[mi] * mean[mi], 0.f) + LN_EPS);
    }
#pragma unroll
    for (int ni = 0; ni < 4; ++ni) {
        const int col = MAP == 0 ? nt * 256 + wc * 64 + (ni >> 1) * 32 + fq * 8 + (ni & 1) * 4
                                 : (ni & 1) * 256 + nt * 128 + wc * 32 + fq * 8 + (ni >> 1) * 4;
        const f32x4 c4 = *(const f32x4*)(cs + col), b4 = *(const f32x4*)(bw + col);
#pragma unroll
        for (int mi = 0; mi < 8; ++mi) acc[mi][ni] = (acc[mi][ni] - mean[mi] * c4) * rstd[mi] + b4;
    }
}

__device__ __forceinline__ void epi_store_bf16_mx(const f32x16 (&acc)[4][2], float scale, bf16_t* out, long ld, int row0, int col0) {
    const int tid_ = opaque_tid();
    const int lane = tid_ & 63, wid = tid_ >> 6;
    const int wr = wid >> 2, wc = wid & 3, r = lane & 31, h = lane >> 5;
#pragma unroll
    for (int mi = 0; mi < 4; ++mi) {
        bf16_t* rp = out + (long)(row0 + wr * 128 + mi * 32 + r) * ld + col0 + wc * 64 + h * 16;
#pragma unroll
        for (int nj = 0; nj < 2; ++nj) {
            const f32x16 v = acc[mi][nj] * scale;
            u32x4 w0, w1;
            w0.x = pk_bf16(v[0], v[1]); w0.y = pk_bf16(v[2], v[3]); w0.z = pk_bf16(v[4], v[5]); w0.w = pk_bf16(v[6], v[7]);
            w1.x = pk_bf16(v[8], v[9]); w1.y = pk_bf16(v[10], v[11]); w1.z = pk_bf16(v[12], v[13]); w1.w = pk_bf16(v[14], v[15]);
            *(u32x4*)(rp + nj * 32) = w0; *(u32x4*)(rp + nj * 32 + 8) = w1;
        }
    }
}
struct TJob { const float* src; int ldsrc; int K; int col0; int ncols; bf16_t* dst; int mode; int rowoff; int f8;   const float* g; const float* b; float* part;   };
__device__ __forceinline__ int tjob_row(const TJob& j, int c) {
    if (j.mode == 0) return j.rowoff + c;
    const int oc = c & 127;
    return 256 * (c >> 7) + 64 * (oc >> 5) + 16 * (2 * ((oc >> 2) & 1) + j.rowoff) + 4 * ((oc >> 3) & 3) + (oc & 3);
}
__device__ __forceinline__ void transpose_tile(char* smem, const TJob& j, int kt, int ct) {
    float* tile = (float*)smem;
    float* red = tile + 64 * 65;
    const int tid = opaque_tid();
    float scs = 0.f, sbw = 0.f;
#pragma unroll
    for (int i = 0; i < 8; ++i) {
        const int e = tid + i * NTHR, kr = e >> 6, c = e & 63;
        const int cc = ct * 64 + c;
        float v = 0.f;
        if (cc < j.ncols) v = j.src[(long)(kt * 64 + kr) * j.ldsrc + j.col0 + cc];
        if (j.g) {
            const float gv = j.g[kt * 64 + kr], bv = j.b[kt * 64 + kr];
            sbw += bv * v;
            v *= gv;
            scs += __uint_as_float(pk_bf16(v, 0.f) << 16);
        }
        tile[kr * 65 + c] = v;
    }
    if (j.g) { red[(tid >> 6) * 64 + (tid & 63)] = scs; red[512 + (tid >> 6) * 64 + (tid & 63)] = sbw; }
    __syncthreads();
    if (j.f8) {
#pragma unroll
        for (int i = 0; i < 2; ++i) {
            const int e = tid + i * NTHR, c = e >> 4, k4 = (e & 15) * 4;
            const int cc = ct * 64 + c;
            if (cc < j.ncols) {
                const unsigned w = pk4_fp8(tile[k4 * 65 + c] * W8_SCALE, tile[(k4 + 1) * 65 + c] * W8_SCALE, tile[(k4 + 2) * 65 + c] * W8_SCALE, tile[(k4 + 3) * 65 + c] * W8_SCALE);
                *(unsigned*)((unsigned char*)j.dst + (long)tjob_row(j, cc) * j.K + kt * 64 + k4) = w;
            }
        }
    } else {
#pragma unroll
    for (int i = 0; i < 4; ++i) {
        const int e = tid + i * NTHR, c = e >> 5, k2 = (e & 31) * 2;
        const int cc = ct * 64 + c;
        if (cc < j.ncols) {
            const unsigned w = pk_bf16(tile[k2 * 65 + c], tile[(k2 + 1) * 65 + c]);
            *(unsigned*)(j.dst + (long)tjob_row(j, cc) * j.K + kt * 64 + k2) = w;
        }
    }
    }
    if (j.g && tid < 128) {
        const int which = tid >> 6, c = tid & 63;
        float s = 0.f;
#pragma unroll
        for (int w = 0; w < 8; ++w) s += red[which * 512 + w * 64 + c];
        if (ct * 64 + c < j.ncols) j.part[(long)(which * 16 + kt) * 1792 + ct * 64 + c] = s;
    }
    __syncthreads();
}

__device__ __forceinline__ void tjob_run(int& g_rot, char* smem, int bid, int nb, const float* src, int ld, int K, int col0, int ncols, bf16_t* dst, int mode, int rowoff,
                                         const float* g = nullptr, const float* b = nullptr, float* part = nullptr, int f8 = 0) {
    TJob j; j.f8 = f8; j.src = src; j.ldsrc = ld; j.K = K; j.col0 = col0; j.ncols = ncols; j.dst = dst; j.mode = mode; j.rowoff = rowoff; j.g = g; j.b = b; j.part = part;
    const int nkt = K / 64, nct = (ncols + 63) / 64, ntile = nkt * nct;
    const int first = (bid + nb - g_rot % nb) % nb;
    for (int t = first; t < ntile; t += nb) transpose_tile(smem, j, t % nkt, t / nkt);
    g_rot += ntile;
}

__device__ __forceinline__ void cvt_rows_bf16(const float* src, bf16_t* dst, long n8, int bid, int nb) {
    for (long i = (long)bid * NTHR + opaque_tid(); i < n8; i += (long)nb * NTHR) {
        const f32x4 a = __builtin_nontemporal_load((const f32x4*)(src + i * 8)), b = __builtin_nontemporal_load((const f32x4*)(src + i * 8 + 4));
        u32x4 w; w.x = pk_bf16(a[0], a[1]); w.y = pk_bf16(a[2], a[3]); w.z = pk_bf16(b[0], b[1]); w.w = pk_bf16(b[2], b[3]);
        *(u32x4*)(dst + i * 8) = w;
    }
}

enum { I_X = 0, I_MEM, I_WIN, I_POSK, I_CKW1, I_CKW2, I_POSV, I_CVW1, I_CVW2, I_CONVW, I_IBIAS, I_FBIAS, I_NORMG, I_WOUT, I_LN1G, I_LN1B,
       I_XAWQ, I_XAWK, I_XAWV, I_XAWO, I_LN2G, I_LN2B, I_ROUTW, I_ROUTB, I_MW1, I_MW3, I_MW2, I_SW1, I_SW3, I_SW2, I_LN3G, I_LN3B };

__device__ __forceinline__ void phase0(const Params& p, char* smem, int bid, int nb) {
    char* ws = p.ws;
    int rot = 0;
    tjob_run(rot, smem, bid, nb, p.in[I_WIN], 3360, 1024, 0, 1280, (bf16_t*)(ws + WS_WIN), 0, 0, nullptr, nullptr, nullptr, INPROJ_F8);
    tjob_run(rot, smem, bid, nb, p.in[I_WIN], 3360, 1024, 1304, 2048, (bf16_t*)(ws + WS_WIN), 0, 1280, nullptr, nullptr, nullptr, INPROJ_F8);
    tjob_run(rot, smem, bid, nb, p.in[I_WIN], 3360, 1024, 1280, 24, (bf16_t*)(ws + WS_WIN), 0, 3328, nullptr, nullptr, nullptr, INPROJ_F8);
    tjob_run(rot, smem, bid, nb, p.in[I_WIN], 3360, 1024, 3352, 8, (bf16_t*)(ws + WS_WIN), 0, 3352, nullptr, nullptr, nullptr, INPROJ_F8);
    tjob_run(rot, smem, bid, nb, p.in[I_WOUT], 1024, 1024, 0, 1024, (bf16_t*)(ws + WS_WOUT), 0, 0);
    float* lnp = (float*)(ws + WS_LNP);
    tjob_run(rot, smem, bid, nb, p.in[I_XAWQ], 1024, 1024, 0, 1024, (bf16_t*)(ws + WS_WQ), 0, 0, p.in[I_LN1G], p.in[I_LN1B], lnp);
    tjob_run(rot, smem, bid, nb, p.in[I_XAWK], 1024, 1024, 0, 1024, (bf16_t*)(ws + WS_WKV), 0, 0);
    tjob_run(rot, smem, bid, nb, p.in[I_XAWV], 1024, 1024, 0, 1024, (bf16_t*)(ws + WS_WKV), 0, 1024);
    tjob_run(rot, smem, bid, nb, p.in[I_XAWO], 1024, 1024, 0, 1024, (bf16_t*)(ws + WS_WO), 0, 0);
    tjob_run(rot, smem, bid, nb, p.in[I_ROUTW], 256, 1024, 0, 256, (bf16_t*)(ws + WS_WR), 0, 0, p.in[I_LN2G], p.in[I_LN2B], lnp + 1024);
    tjob_run(rot, smem, bid, nb, p.in[I_SW1], 256, 1024, 0, 256, (bf16_t*)(ws + WS_WS13), 1, 0, p.in[I_LN2G], p.in[I_LN2B], lnp + 1280);
    tjob_run(rot, smem, bid, nb, p.in[I_SW3], 256, 1024, 0, 256, (bf16_t*)(ws + WS_WS13), 1, 1, p.in[I_LN2G], p.in[I_LN2B], lnp + 1536);
    tjob_run(rot, smem, bid, nb, p.in[I_SW2], 1024, 256, 0, 1024, (bf16_t*)(ws + WS_WS2), 0, 0);
    tjob_run(rot, smem, bid, nb, p.in[I_CKW1], 64, 2048, 0, 64, (bf16_t*)(ws + WS_CK1), 0, 0);
    tjob_run(rot, smem, bid, nb, p.in[I_CKW2], 64, 64, 0, 64, (bf16_t*)(ws + WS_CK2), 0, 0);
    tjob_run(rot, smem, bid, nb, p.in[I_CVW1], 64, 2048, 0, 64, (bf16_t*)(ws + WS_CV1), 0, 0);
    tjob_run(rot, smem, bid, nb, p.in[I_CVW2], 64, 64, 0, 64, (bf16_t*)(ws + WS_CV2), 0, 0);
#if INPROJ_F8
    for (long i = (long)bid * NTHR + opaque_tid(); i < (long)T_TOK * 1024 / 8; i += (long)nb * NTHR) {
        const f32x4 a = *(const f32x4*)(p.in[I_X] + i * 8), b = *(const f32x4*)(p.in[I_X] + i * 8 + 4);
        u32x2 w; w.x = pk4_fp8(a[0], a[1], a[2], a[3]); w.y = pk4_fp8(b[0], b[1], b[2], b[3]);
        *(u32x2*)((unsigned char*)(ws + WS_XB) + i * 8) = w;
    }
#else
    cvt_rows_bf16(p.in[I_X], (bf16_t*)(ws + WS_XB), (long)T_TOK * 1024 / 8, bid, nb);
#endif
    cvt_rows_bf16(p.in[I_MEM], (bf16_t*)(ws + WS_MEMB), (long)4096 * 1024 / 8, bid, nb);
    { int* c = (int*)(ws + WS_CNT); for (int i = bid * NTHR + opaque_tid(); i < 24576; i += nb * NTHR) c[i] = 0; }
}

__device__ __forceinline__ void small_cols_task(const Params& p, int task) {
    const bf16_t* xb = (const bf16_t*)(p.ws + WS_XB);
    const bf16_t* wt = (const bf16_t*)(p.ws + WS_WIN) + (long)3328 * 1024;
    float* psm = (float*)(p.ws + WS_PSM);
    const int tid_ = opaque_tid();
    const int lane = tid_ & 63, wid = tid_ >> 6, fr = lane & 15, fq = lane >> 4;
    const int r0 = task * 256 + wid * 32;
    f32x4 acc[2][2];
#pragma unroll
    for (int mi = 0; mi < 2; ++mi)
#pragma unroll
        for (int ni = 0; ni < 2; ++ni) acc[mi][ni] = (f32x4){0.f, 0.f, 0.f, 0.f};
    const bf16_t* ap0 = xb + (long)(r0 + fr) * 1024 + fq * 8;
    const bf16_t* ap1 = ap0 + 16 * 1024;
    const bf16_t* bp0 = wt + (long)fr * 1024 + fq * 8;
    const bf16_t* bp1 = bp0 + 16 * 1024;
#pragma unroll 4
    for (int ks = 0; ks < 32; ++ks) {
        const bf16x8 a0 = *(const bf16x8*)(ap0 + ks * 32), a1 = *(const bf16x8*)(ap1 + ks * 32);
        const bf16x8 b0 = *(const bf16x8*)(bp0 + ks * 32), b1 = *(const bf16x8*)(bp1 + ks * 32);
        acc[0][0] = mfma16(b0, a0, acc[0][0]); acc[0][1] = mfma16(b1, a0, acc[0][1]);
        acc[1][0] = mfma16(b0, a1, acc[1][0]); acc[1][1] = mfma16(b1, a1, acc[1][1]);
    }
#pragma unroll
    for (int mi = 0; mi < 2; ++mi)
#pragma unroll
        for (int ni = 0; ni < 2; ++ni) *(f32x4*)(psm + (long)(r0 + mi * 16 + fr) * 32 + ni * 16 + fq * 4) = acc[mi][ni];
}

template <int NOEPI = 0>
__device__ __forceinline__ void phase1(const Params& p, char* smem, int bid, int nb) {
    char* ws = p.ws;
    XcdSlab xs; xs.init(bid, nb);
    const int a_lo = xs.m_lo(128), a_nm = xs.m_hi(128) - a_lo, a_n = a_nm * 14;
    const int b_lo = xs.m_lo(16), b_nm = xs.m_hi(16) - b_lo, b_n = b_nm * 8;
#if INPROJ_F8
    {
        int mt = 0, nt = 0;
        RingF8 al, bl;
        auto setup = [&](int u) {
            mt = a_lo + u % a_nm; nt = u / a_nm;
            al.init_contig((const unsigned char*)(ws + WS_XB), 1024, (long)mt * 256);
            bl.init_contig((const unsigned char*)(ws + WS_WIN), 1024, (long)nt * 256, true);
        };
        int u = xs.j;
        if (u < a_n) { setup(u); ring_f8_issue3(smem, al, bl); }
        while (u < a_n) {
            const int cmt = mt, cnt_ = nt;
            f32x16 acc[4][2];
            gemm_ring_mx_main(smem, al, bl, 16, acc);
            u += xs.stride;
            if (u < a_n) { setup(u); ring_f8_issue3(smem, al, bl); }
            if (NOEPI) { float s = 0.f;
#pragma unroll
                for (int mi = 0; mi < 4; ++mi) s += acc[mi][0][0] + acc[mi][1][5];
                if (s == 123.456f) ((float*)(ws + WS_A + 432 * MB))[opaque_tid()] = s; continue; }
            if (cnt_ < 13) epi_store_bf16_mx(acc, 1.0f / W8_SCALE, (bf16_t*)(ws + WS_P), PW, cmt * 256, cnt_ * 256);
            else {
                const int tid_ = opaque_tid();
                const int lane = tid_ & 63, wid = tid_ >> 6, wr = wid >> 2, wc = wid & 3, r = lane & 31, h = lane >> 5;
                if (wc == 0) {
                    float* psm = (float*)(ws + WS_PSM);
#pragma unroll
                    for (int mi = 0; mi < 4; ++mi) {
                        const f32x16 v = acc[mi][0] * (1.0f / W8_SCALE);
                        float* rp = psm + (long)(cmt * 256 + wr * 128 + mi * 32 + r) * 32 + h * 16;
#pragma unroll
                        for (int q4 = 0; q4 < 4; ++q4) *(f32x4*)(rp + q4 * 4) = (f32x4){v[q4 * 4], v[q4 * 4 + 1], v[q4 * 4 + 2], v[q4 * 4 + 3]};
                    }
                }
            }
        }
        asm volatile("s_waitcnt vmcnt(0)" ::: "memory"); __syncthreads();
    }
    const int a_n2 = 0;
#else
    const int a_n2 = a_n;
#endif
    bool inp = false; int mt = 0, nt = 0;
    RingRows al, bl;
    auto setup = [&](int u) {
        inp = u < a_n2;
        const int uu = inp ? u : u - a_n2;
        const int nm = inp ? a_nm : b_nm;
        if (inp && (a_nm & 3) == 0) {
            const int per_mblk = 4 * 14, mblk = uu / per_mblk, rr = uu % per_mblk;
            const int ngrp = rr >> 5, r32 = rr & 31;
            mt = a_lo + mblk * 4 + (r32 & 3); nt = ngrp * 8 + (r32 >> 2);
        } else { mt = (inp ? a_lo : b_lo) + uu % nm; nt = uu / nm; }
        al.init_contig((const bf16_t*)(ws + (inp ? WS_XB : WS_MEMB)), 1024, mt * 256);
        bl.init_contig((const bf16_t*)(ws + (inp ? WS_WIN : WS_WKV)), 1024, nt * 256, true);
    };
    int u = xs.j;
    if (u < a_n2 + b_n) { setup(u); ring_issue3(smem, al, bl); }
    while (u < a_n2 + b_n) {
        const bool cinp = inp; const int cmt = mt, cnt_ = nt;
        f32x4 acc[8][4];
        gemm_ring<RingRows, RingRows, 0, true>(smem, al, bl, 32, acc);
        u += xs.stride;
        if (u < a_n2 + b_n) { setup(u); ring_issue3(smem, al, bl); }
        if (NOEPI) { float s = 0.f;
#pragma unroll
            for (int mi = 0; mi < 8; ++mi)
#pragma unroll
                for (int ni = 0; ni < 4; ++ni) s += acc[mi][ni][0] + acc[mi][ni][1] + acc[mi][ni][2] + acc[mi][ni][3];
            if (s == 123.456f) ((float*)(ws + WS_A + 432 * MB))[opaque_tid()] = s; continue; }
        if (!cinp) epi_store_bf16(acc, (bf16_t*)(ws + WS_KVX), 2048, cmt * 256, cnt_ * 256);
        else if (cnt_ < 13) epi_store_bf16(acc, (bf16_t*)(ws + WS_P), PW, cmt * 256, cnt_ * 256);
        else {
            const int tid_ = opaque_tid();
            const int lane = tid_ & 63, wid = tid_ >> 6, wr = wid >> 2, wc = wid & 3, fr = lane & 15, fq = lane >> 4;
            if (wc == 0) {
                float* psm = (float*)(ws + WS_PSM);
#pragma unroll
                for (int mi = 0; mi < 8; ++mi)
#pragma unroll
                    for (int ni = 0; ni < 2; ++ni) *(f32x4*)(psm + (long)(cmt * 256 + wr * 128 + mi * 16 + fr) * 32 + fq * 8 + ni * 4) = acc[mi][ni];
            }
        }
    }
    asm volatile("s_waitcnt vmcnt(0)" ::: "memory");
}

__device__ __forceinline__ void compress_task(const Params& p, char* smem, int which, int rb) {
    const char* ws = p.ws;
    const bf16_t* P = (const bf16_t*)(ws + WS_P);
    const float* pos = p.in[which ? I_POSV : I_POSK];
    const bf16_t* w1t = (const bf16_t*)(ws + (which ? WS_CV1 : WS_CK1));
    const bf16_t* w2t = (const bf16_t*)(ws + (which ? WS_CV2 : WS_CK2));
    bf16_t* outp = (bf16_t*)(p.ws + (which ? WS_VCMP : WS_KCMP));
    const int colbase = which ? PC_VC : PC_KC;
    const int tid_ = opaque_tid();
    const int lane = tid_ & 63, wid = tid_ >> 6, fr = lane & 15, fq = lane >> 4;
    f32x4 acc[2][4];
#pragma unroll
    for (int mi = 0; mi < 2; ++mi)
#pragma unroll
        for (int ni = 0; ni < 4; ++ni) acc[mi][ni] = (f32x4){0.f, 0.f, 0.f, 0.f};
    const bf16_t* arow[2];
#pragma unroll
    for (int mi = 0; mi < 2; ++mi) {
        const int r = rb * 32 + mi * 16 + fr;
        const int b = r / 254, rem = r - b * 254, c = rem >> 1, g = rem & 1;
        arow[mi] = P + (long)(b * 2048 + c * 16) * PW + colbase + g * 64 + fq * 8;
    }
    const bf16_t* brow = w1t + (long)fr * 2048 + fq * 8;
    const float* prow = pos + fq * 8;
#pragma unroll 2
    for (int s = 0; s < 8; ++s) {
        const int ks = wid * 8 + s;
        const int l = ks >> 1, d0 = (ks & 1) * 32;
        const f32x4 p0 = *(const f32x4*)(prow + l * 64 + d0), p1 = *(const f32x4*)(prow + l * 64 + d0 + 4);
        bf16x8 af[2];
#pragma unroll
        for (int mi = 0; mi < 2; ++mi) {
            const u32x4 av = *(const u32x4*)(arow[mi] + (long)l * PW + d0);
            u32x4 aw;
            aw.x = pk_bf16(bf_lo(av.x) + p0[0], bf_hi(av.x) + p0[1]); aw.y = pk_bf16(bf_lo(av.y) + p0[2], bf_hi(av.y) + p0[3]);
            aw.z = pk_bf16(bf_lo(av.z) + p1[0], bf_hi(av.z) + p1[1]); aw.w = pk_bf16(bf_lo(av.w) + p1[2], bf_hi(av.w) + p1[3]);
            af[mi] = as_bf16x8(aw);
        }
#pragma unroll
        for (int ni = 0; ni < 4; ++ni) {
            const bf16x8 bb = *(const bf16x8*)(brow + (long)(ni * 16) * 2048 + ks * 32);
            acc[0][ni] = mfma16(bb, af[0], acc[0][ni]);
            acc[1][ni] = mfma16(bb, af[1], acc[1][ni]);
        }
    }
    f32x4* part = (f32x4*)(smem + 8192);
#pragma unroll
    for (int mi = 0; mi < 2; ++mi)
#pragma unroll
        for (int ni = 0; ni < 4; ++ni) part[(wid * 8 + mi * 4 + ni) * 64 + lane] = acc[mi][ni];
    __syncthreads();
    const int mi = wid >> 2, ni = wid & 3;
    f32x4 a1 = (f32x4){0.f, 0.f, 0.f, 0.f};
#pragma unroll
    for (int w = 0; w < 8; ++w) a1 = a1 + part[(w * 8 + wid) * 64 + lane];
    bf16_t* h1 = (bf16_t*)smem;
    {
        u32x2 w; w.x = pk_bf16(siluf_(a1[0]), siluf_(a1[1])); w.y = pk_bf16(siluf_(a1[2]), siluf_(a1[3]));
        *(u32x2*)(h1 + (mi * 16 + fr) * 72 + ni * 16 + fq * 4) = w;
    }
    __syncthreads();
    f32x4 acc2 = (f32x4){0.f, 0.f, 0.f, 0.f};
#pragma unroll
    for (int ks = 0; ks < 2; ++ks) {
        const bf16x8 a = *(const bf16x8*)(h1 + (mi * 16 + fr) * 72 + ks * 32 + fq * 8);
        const bf16x8 bb = *(const bf16x8*)(w2t + (ni * 16 + fr) * 64 + ks * 32 + fq * 8);
        acc2 = mfma16(bb, a, acc2);
    }
    {
        const int r = rb * 32 + mi * 16 + fr;
        const int b = r / 254, rem = r - b * 254, c = rem >> 1, g = rem & 1;
        u32x2 w; w.x = pk_bf16(acc2[0], acc2[1]); w.y = pk_bf16(acc2[2], acc2[3]);
        *(u32x2*)(outp + ((long)(b * 2 + g) * 128 + c) * 64 + ni * 16 + fq * 4) = w;
    }
    __syncthreads();
}

__device__ __forceinline__ void phase2(const Params& p, char* smem, int bid, int nb) {
    char* ws = p.ws;
    {
        const int idx = bid * NTHR + opaque_tid();
        if (idx < 2 * 1792) {
            const float* pp = (const float*)(ws + WS_LNP) + (long)(idx / 1792) * 16 * 1792 + idx % 1792;
            float s = 0.f;
#pragma unroll
            for (int k = 0; k < 16; ++k) s += pp[k * 1792];
            ((float*)(ws + WS_LNF))[idx] = s;
        }
    }
    for (int t = bid; t < 254; t += nb) compress_task(p, smem, t / 127, t % 127);
    const int tid_ = opaque_tid();
    if (bid < 32 && tid_ < 32) {
        bf16_t* kc = (bf16_t*)(ws + WS_KCMP) + ((long)bid * 128 + 127) * 64;
        bf16_t* vc = (bf16_t*)(ws + WS_VCMP) + ((long)bid * 128 + 127) * 64;
        ((unsigned*)kc)[tid_] = 0u; ((unsigned*)vc)[tid_] = 0u;
    }
    const bf16_t* P = (const bf16_t*)(ws + WS_P);
    const float* cw = p.in[I_CONVW];
    bf16_t* qk = (bf16_t*)(ws + WS_QK);
    for (long it = (long)bid * NTHR + tid_; it < (long)T_TOK * 128; it += (long)nb * NTHR) {
        const int t = (int)(it >> 7), ch = (int)(it & 127);
        const int s = t & (SEQ - 1);
        float a[8];
#pragma unroll
        for (int e = 0; e < 8; ++e) a[e] = 0.f;
#pragma unroll
        for (int j = 0; j < 4; ++j) {
            if (s - 3 + j >= 0) {
                const u32x4 u = *(const u32x4*)(P + (long)(t - 3 + j) * PW + PC_MQ + ch * 8);
                const f32x4 w0 = *(const f32x4*)(cw + j * 1024 + ch * 8), w1 = *(const f32x4*)(cw + j * 1024 + ch * 8 + 4);
                a[0] += w0[0] * bf_lo(u.x); a[1] += w0[1] * bf_hi(u.x); a[2] += w0[2] * bf_lo(u.y); a[3] += w0[3] * bf_hi(u.y);
                a[4] += w1[0] * bf_lo(u.z); a[5] += w1[1] * bf_hi(u.z); a[6] += w1[2] * bf_lo(u.w); a[7] += w1[3] * bf_hi(u.w);
            }
        }
        const float sc = ch < 64 ? 0.08838834764831845f : 1.0f;
        u32x4 w;
        w.x = pk_bf16(siluf_(a[0]) * sc, siluf_(a[1]) * sc); w.y = pk_bf16(siluf_(a[2]) * sc, siluf_(a[3]) * sc);
        w.z = pk_bf16(siluf_(a[4]) * sc, siluf_(a[5]) * sc); w.w = pk_bf16(siluf_(a[6]) * sc, siluf_(a[7]) * sc);
        *(u32x4*)(qk + (long)t * 1024 + ch * 8) = w;
    }
}

typedef __attribute__((address_space(3))) s16x4 lds_s16x4;
__device__ __forceinline__ s16x4 lds_tr(const char* a) { return __builtin_amdgcn_ds_read_tr16_b64_v4i16((lds_s16x4*)a); }
__device__ __forceinline__ bf16x8 tr_frag_perm(const char* base, int pitch, int rbase, int cbase, int fr, int fq) {
    const char* a0 = base + (rbase + 4 * fq + (fr >> 2)) * pitch + (cbase + 4 * (fr & 3)) * 2;
    const s16x4 lo = lds_tr(a0), hi = lds_tr(a0 + 16 * pitch);
    return (bf16x8){lo[0], lo[1], lo[2], lo[3], hi[0], hi[1], hi[2], hi[3]};
}
__device__ __forceinline__ bf16x8 tr_frag_std(const char* base, int pitch, int rbase, int cbase, int fr, int fq) {
    const char* a0 = base + (rbase + 8 * fq + (fr >> 2)) * pitch + (cbase + 4 * (fr & 3)) * 2;
    const s16x4 lo = lds_tr(a0), hi = lds_tr(a0 + 4 * pitch);
    return (bf16x8){lo[0], lo[1], lo[2], lo[3], hi[0], hi[1], hi[2], hi[3]};
}
__device__ __forceinline__ bf16x8 pack_p(const f32x4 a, const f32x4 b) {
    u32x4 w; w.x = pk_bf16(a[0], a[1]); w.y = pk_bf16(a[2], a[3]); w.z = pk_bf16(b[0], b[1]); w.w = pk_bf16(b[2], b[3]);
    return as_bf16x8(w);
}

__device__ __forceinline__ float dpp_xor1(float v) { return __builtin_bit_cast(float, __builtin_amdgcn_mov_dpp(__builtin_bit_cast(int, v), 0xB1, 0xF, 0xF, true)); }
__device__ __forceinline__ float dpp_xor2(float v) { return __builtin_bit_cast(float, __builtin_amdgcn_mov_dpp(__builtin_bit_cast(int, v), 0x4E, 0xF, 0xF, true)); }

constexpr int NSA_PITCH = 160;
constexpr int NSA_KC = 0, NSA_VC = 20480, NSA_KT = 40960, NSA_VT = 61440, NSA_MISC = 81920, NSA_Y = 83968;

struct NsaState {
    bf16x8 qf[2][2];
    int tl[2];
    unsigned selm[2];
    unsigned wunion, bunion;
    unsigned tunion[2];
};

constexpr int NSA_STG = 16384;
__device__ __forceinline__ bf16x8 tr_frag_perm_swz(const char* base, int rbase, int dt, int fr, int fq) {
    const int R = rbase + 4 * fq + (fr >> 2), c = 2 * dt + ((fr & 3) >> 1);
    const char* a0 = base + R * 128 + ((c ^ (R & 7)) << 4) + 8 * (fr & 1);
    const s16x4 lo = lds_tr(a0), hi = lds_tr(a0 + 16 * 128);
    return (bf16x8){lo[0], lo[1], lo[2], lo[3], hi[0], hi[1], hi[2], hi[3]};
}

#define NSA_WAITV(n) asm volatile("s_waitcnt vmcnt(" #n ")" ::: "memory")
#define NSA_BAR() do { asm volatile("s_waitcnt lgkmcnt(0)" ::: "memory"); __builtin_amdgcn_s_barrier(); asm volatile("" ::: "memory"); } while (0)

template <int MODE>
__device__ __forceinline__ void nsa_stream(char* smem, const bf16_t* Pb  , int g, int i, NsaState& st, float gate0, float gate1, const int tid) {
    const int lane = tid & 63, fr = lane & 15, fq = lane >> 4;
    const int kcol = (MODE == 0 ? PC_KS : PC_KW) + g * 64, vcol = (MODE == 0 ? PC_VS : PC_VW) + g * 64;
    const int lrow = tid >> 3, lch = (tid & 7) ^ (lrow & 7);
    const bf16_t* ksrc = Pb + (long)lrow * PW + kcol + lch * 8;
    const bf16_t* vsrc = Pb + (long)lrow * PW + vcol + lch * 8;
    const int jlo = MODE == 0 ? 0 : (i - 8 > 0 ? i - 8 : 0);
    const unsigned range = (i >= 31 ? 0xffffffffu : ((1u << (i + 1)) - 1u)) & ~((1u << jlo) - 1u);
    const unsigned need = (unsigned)__builtin_amdgcn_readfirstlane((int)((MODE == 0 ? st.bunion : 0xffffffffu) & range));
    f32x4 O[2][4];
    float m[2], l[2];
    int tlq[2];
#pragma unroll
    for (int mt = 0; mt < 2; ++mt) { m[mt] = -1e30f; l[mt] = 0.f; tlq[mt] = st.tl[mt] - 4 * fq;
#pragma unroll
        for (int dt = 0; dt < 4; ++dt) O[mt][dt] = (f32x4){0.f, 0.f, 0.f, 0.f}; }
    unsigned pm = need;
    int nissued = 0;
    auto issue_next = [&]() {
        const int jj = __builtin_ctz(pm); pm &= pm - 1u;
        char* sb = smem + (nissued & 3) * NSA_STG;
        __builtin_amdgcn_global_load_lds((glb_u32*)(ksrc + (long)jj * 64 * PW), (lds_u32*)(sb + tid * 16), 16, 0, 0);
        __builtin_amdgcn_global_load_lds((glb_u32*)(vsrc + (long)jj * 64 * PW), (lds_u32*)(sb + 8192 + tid * 16), 16, 0, 0);
        ++nissued;
    };
    const int L = __builtin_popcount(need);
    if (L > 0) issue_next();
    if (L > 1) issue_next();
    if (L > 2) issue_next();
    if (L > 2) NSA_WAITV(4); else if (L > 1) NSA_WAITV(2); else NSA_WAITV(0);
    NSA_BAR();
    unsigned cm = need;
    for (int n = 0; n < L; ++n) {
        const int j = __builtin_ctz(cm); cm &= cm - 1u;
        if (n + 3 < L) issue_next();
        const char* KT = smem + (n & 3) * NSA_STG;
        const char* VT = KT + 8192;
        const bool on0 = MODE == 0 ? (((st.tunion[0] >> j) & 1u) != 0u) : true, on1 = MODE == 0 ? (((st.tunion[1] >> j) & 1u) != 0u) : true;
        if (on0 || on1) {
            f32x4 S[2][4];
            {
                bf16x8 kf[4][2];
#pragma unroll
                for (int nt = 0; nt < 4; ++nt)
#pragma unroll
                    for (int ks = 0; ks < 2; ++ks) kf[nt][ks] = *(const bf16x8*)(KT + (16 * nt + fr) * 128 + (((ks * 4 + fq) ^ (fr & 7)) << 4));
#pragma unroll
                for (int mt = 0; mt < 2; ++mt) {
                    if (MODE == 0 && !(mt == 0 ? on0 : on1)) continue;
#pragma unroll
                    for (int nt = 0; nt < 4; ++nt) {
                        f32x4 s = (f32x4){0.f, 0.f, 0.f, 0.f};
                        s = mfma16(kf[nt][0], st.qf[mt][0], s);
                        s = mfma16(kf[nt][1], st.qf[mt][1], s);
                        S[mt][nt] = s;
                    }
                }
            }
            bf16x8 pf[2][2];
            const bool edge = (j == i) || (MODE == 1 && j == i - 8);
            constexpr float CS = 0.125f * 1.4426950408889634f;
#pragma unroll
            for (int mt = 0; mt < 2; ++mt) {
                if (MODE == 0 && !(mt == 0 ? on0 : on1)) continue;
                const bool rowsel = MODE == 0 ? (((st.selm[mt] >> j) & 1u) != 0u) : true;
                if (edge) {
                    asm volatile("; boundary tile" ::: "memory");
#pragma unroll
                    for (int nt = 0; nt < 4; ++nt)
#pragma unroll
                        for (int e = 0; e < 4; ++e) {
                            const int kc = 16 * nt + e;
                            bool ok = true;
                            if (j == i) ok = ok && (kc <= tlq[mt]);
                            if (MODE == 1) { if (j == i - 8) ok = ok && (kc > tlq[mt]); }
                            S[mt][nt][e] = ok ? S[mt][nt][e] : -INFINITY;
                        }
                }
                float mx = -INFINITY;
#pragma unroll
                for (int nt = 0; nt < 4; ++nt)
#pragma unroll
                    for (int e = 0; e < 4; ++e) mx = __builtin_fmaxf(mx, S[mt][nt][e]);
                mx = fq_max(mx);
                if (MODE == 0) mx = rowsel ? mx : -INFINITY;
                const float mnew = __builtin_fmaxf(m[mt], mx * CS);
                const float alpha = __builtin_amdgcn_exp2f(m[mt] - mnew);
                const float msub = (MODE == 0 && !rowsel) ? INFINITY : mnew;
                float rs = 0.f;
#pragma unroll
                for (int nt = 0; nt < 4; ++nt)
#pragma unroll
                    for (int e = 0; e < 4; ++e) { const float pv = __builtin_amdgcn_exp2f(__builtin_fmaf(S[mt][nt][e], CS, -msub)); S[mt][nt][e] = pv; rs += pv; }
                rs = fq_sum(rs);
                l[mt] = l[mt] * alpha + rs; m[mt] = mnew;
#pragma unroll
                for (int dt = 0; dt < 4; ++dt) O[mt][dt] = O[mt][dt] * alpha;
                pf[mt][0] = pack_p(S[mt][0], S[mt][1]); pf[mt][1] = pack_p(S[mt][2], S[mt][3]);
            }
#pragma unroll
            for (int ks2 = 0; ks2 < 2; ++ks2)
#pragma unroll
                for (int dt = 0; dt < 4; ++dt) {
                    const bf16x8 vf = tr_frag_perm_swz(VT, 32 * ks2, dt, fr, fq);
                    if (MODE != 0 || on0) O[0][dt] = mfma16(vf, pf[0][ks2], O[0][dt]);
                    if (MODE != 0 || on1) O[1][dt] = mfma16(vf, pf[1][ks2], O[1][dt]);
                }
        }
        if (n + 1 < L) { if (n + 3 < L) NSA_WAITV(4); else if (n + 2 < L) NSA_WAITV(2); else NSA_WAITV(0); }
        NSA_BAR();
    }
#pragma unroll
    for (int mt = 0; mt < 2; ++mt) {
        const float gsc = (mt == 0 ? gate0 : gate1) * (l[mt] > 0.f ? 1.0f / l[mt] : 0.f);
#pragma unroll
        for (int dt = 0; dt < 4; ++dt) { f32x4* yp = (f32x4*)(smem + NSA_Y) + (mt * 4 + dt) * NTHR + tid; *yp = *yp + O[mt][dt] * gsc; }
    }
}

__device__ __forceinline__ void nsa_cmp_one(const char* smem, const bf16x8 qf0, const bf16x8 qf1, const int t, const int i, const float gate0, f32x4* yp  , unsigned& selm, const int lane) {
    const int fr = lane & 15, fq = lane >> 4;
        const int cl = (t >= 31 ? ((t - 31) >> 4) : -1) - 4 * fq;
        f32x4 S[8];
#pragma unroll
        for (int nt = 0; nt < 8; ++nt) {
            f32x4 s = (f32x4){0.f, 0.f, 0.f, 0.f};
#pragma unroll
            for (int ks = 0; ks < 2; ++ks) {
                const bf16x8 kf = *(const bf16x8*)(smem + NSA_KC + (16 * nt + fr) * NSA_PITCH + (ks * 4 + fq) * 16);
                s = mfma16(kf, (ks == 0 ? qf0 : qf1), s);
            }
            S[nt] = s;
        }
        float mx = -INFINITY;
#pragma unroll
        for (int nt = 0; nt < 8; ++nt)
#pragma unroll
            for (int e = 0; e < 4; ++e) {
                const float sv = (16 * nt + e <= cl) ? S[nt][e] * 0.125f : -INFINITY;
                S[nt][e] = sv; mx = fmaxf(mx, sv);
            }
        mx = fq_max(mx);
        const float mref = fmaxf(mx, -1e30f);
        float rs = 0.f;
#pragma unroll
        for (int nt = 0; nt < 8; ++nt)
#pragma unroll
            for (int e = 0; e < 4; ++e) { const float pv = __expf(S[nt][e] - mref); S[nt][e] = pv; rs += pv; }
        rs = fq_sum(rs);
        const float inv = rs > 0.f ? 1.0f / rs : 0.f;
#pragma unroll
        for (int nt = 0; nt < 8; ++nt) S[nt] = S[nt] * inv;
        {
            f32x4 O[4];
#pragma unroll
            for (int dt = 0; dt < 4; ++dt) O[dt] = (f32x4){0.f, 0.f, 0.f, 0.f};
#pragma unroll
            for (int ks2 = 0; ks2 < 4; ++ks2) {
                const bf16x8 pf = pack_p(S[2 * ks2], S[2 * ks2 + 1]);
#pragma unroll
                for (int dt = 0; dt < 4; ++dt) {
                    const bf16x8 vf = tr_frag_perm(smem + NSA_VC, NSA_PITCH, 32 * ks2, 16 * dt, fr, fq);
                    O[dt] = mfma16(vf, pf, O[dt]);
                }
            }
#pragma unroll
            for (int dt = 0; dt < 4; ++dt) yp[dt * NTHR] = O[dt] * gate0;
        }
        float imp[8];
        {
            float own[8], last[8];
#pragma unroll
            for (int nt = 0; nt < 8; ++nt) {
                f32x4 v = S[nt];
#pragma unroll
                for (int e = 0; e < 4; ++e) { v[e] += dpp_xor1(v[e]); v[e] += dpp_xor2(v[e]); }
                own[nt] = (v[0] + v[1]) + (v[2] + v[3]); last[nt] = v[3];
            }
            const int src = (lane + 48) & 63;
#pragma unroll
            for (int nt = 0; nt < 8; ++nt) {
                const float a = __shfl(last[nt], src);
                const float bsh = nt > 0 ? __shfl(last[nt > 0 ? nt - 1 : 0], src) : 0.f;
                const float prevc = fq > 0 ? a : bsh;
                const int n = 4 * nt + fq;
                const float pslc = own[nt] + prevc;
                const bool valid = n <= i;
                const bool forced = (n == 0) || (n == i) || (n == i - 1);
                imp[nt] = valid ? pslc + (forced ? 1e4f : 0.f) : -1e30f;
            }
        }
        unsigned mask = 0u;
#pragma unroll 1
        for (int r = 0; r < 8; ++r) {
            float bv = imp[0]; int bn = fq;
#pragma unroll
            for (int nt = 1; nt < 8; ++nt) { if (imp[nt] > bv) { bv = imp[nt]; bn = 4 * nt + fq; } }
#pragma unroll
            for (int off = 16; off <= 32; off <<= 1) {
                const float ov = __shfl_xor(bv, off); const int on = __shfl_xor(bn, off);
                if (ov > bv || (ov == bv && on < bn)) { bv = ov; bn = on; }
            }
            if (bv > -5e29f) mask |= 1u << bn;
#pragma unroll
            for (int nt = 0; nt < 8; ++nt) if (bn == 4 * nt + fq) imp[nt] = -3.0e38f;
        }
        selm = mask;
}

template <int NSAV = 7  >
__device__ __forceinline__ void nsa_task(const Params& p, char* smem, int b, int g, int i) {
    const char* ws = p.ws;
    const bf16_t* Pb = (const bf16_t*)(ws + WS_P) + (long)b * SEQ * PW;
    const float* psm = (const float*)(ws + WS_PSM) + (long)b * SEQ * 32;
    int tid = threadIdx.x;
    asm volatile("" : "+v"(tid));
    const int lane = tid & 63, wid = __builtin_amdgcn_readfirstlane(tid >> 6), fr = lane & 15, fq = lane >> 4;
    const int qs = i * 64;
    NsaState st;
    float gate[2][3];
#pragma unroll
    for (int mt = 0; mt < 2; ++mt) {
        st.tl[mt] = 8 * wid + 4 * mt + (fr >> 2);
        const int h = fr & 3;
        const bf16_t* qp = Pb + (long)(qs + st.tl[mt]) * PW + PC_Q + g * 256 + h * 64 + fq * 8;
        st.qf[mt][0] = *(const bf16x8*)(qp); st.qf[mt][1] = *(const bf16x8*)(qp + 32);
        const float* gp = psm + (long)(qs + st.tl[mt]) * 32 + (g * 4 + h) * 3;
        gate[mt][0] = sigmoidf_(gp[0]); gate[mt][1] = sigmoidf_(gp[1]); gate[mt][2] = sigmoidf_(gp[2]);
    }
    {
        const bf16_t* kc = (const bf16_t*)(ws + WS_KCMP) + (long)(b * 2 + g) * 128 * 64;
        const bf16_t* vc = (const bf16_t*)(ws + WS_VCMP) + (long)(b * 2 + g) * 128 * 64;
#pragma unroll
        for (int r = 0; r < 2; ++r) {
            const int e = tid + r * NTHR, row = e >> 3, ch = e & 7;
            *(u32x4*)(smem + NSA_KC + row * NSA_PITCH + ch * 16) = *(const u32x4*)(kc + row * 64 + ch * 8);
            *(u32x4*)(smem + NSA_VC + row * NSA_PITCH + ch * 16) = *(const u32x4*)(vc + row * 64 + ch * 8);
        }
    }
    __syncthreads();
    if (!(NSAV & 1)) { st.selm[0] = 0xffffffffu; st.selm[1] = 0xffffffffu;
#pragma unroll
        for (int d8 = 0; d8 < 8; ++d8) ((f32x4*)(smem + NSA_Y))[d8 * NTHR + tid] = (f32x4){0.f, 0.f, 0.f, 0.f}; }
    if (NSAV & 1) {
    nsa_cmp_one(smem, st.qf[0][0], st.qf[0][1], qs + st.tl[0], i, gate[0][0], (f32x4*)(smem + NSA_Y) + tid, st.selm[0], lane);
    asm volatile("" ::: "memory");
    __builtin_amdgcn_sched_barrier(0);
    nsa_cmp_one(smem, st.qf[1][0], st.qf[1][1], qs + st.tl[1], i, gate[1][0], (f32x4*)(smem + NSA_Y) + 4 * NTHR + tid, st.selm[1], lane);
    __builtin_amdgcn_sched_barrier(0);
    }
    {
        unsigned u0 = st.selm[0], u1 = st.selm[1];
        u0 |= __shfl_xor(u0, 4); u0 |= __shfl_xor(u0, 8); u1 |= __shfl_xor(u1, 4); u1 |= __shfl_xor(u1, 8);
        st.tunion[0] = (unsigned)__builtin_amdgcn_readfirstlane((int)u0); st.tunion[1] = (unsigned)__builtin_amdgcn_readfirstlane((int)u1);
        const unsigned u = st.tunion[0] | st.tunion[1];
        st.wunion = u;
        unsigned* misc = (unsigned*)(smem + NSA_MISC);
        if (lane == 0) misc[wid] = u;
        __syncthreads();
        unsigned bu = 0u;
#pragma unroll
        for (int w = 0; w < 8; ++w) bu |= misc[w];
        st.bunion = bu;
    }
    if (NSAV & 2) nsa_stream<0>(smem, Pb, g, i, st, gate[0][1], gate[1][1], tid);
    if (NSAV & 4) nsa_stream<1>(smem, Pb, g, i, st, gate[0][2], gate[1][2], tid);
    bf16_t* mix = (bf16_t*)(p.ws + WS_MIX) + (long)b * SEQ * 1024;
#pragma unroll
    for (int mt = 0; mt < 2; ++mt) {
        bf16_t* op = mix + (long)(qs + st.tl[mt]) * 1024 + g * 256 + (fr & 3) * 64 + fq * 4;
#pragma unroll
        for (int dt = 0; dt < 4; ++dt) {
            const f32x4 yv = *((const f32x4*)(smem + NSA_Y) + (mt * 4 + dt) * NTHR + tid);
            u32x2 w; w.x = pk_bf16(yv[0], yv[1]); w.y = pk_bf16(yv[2], yv[3]);
            *(u32x2*)(op + dt * 16) = w;
        }
    }
    __syncthreads();
}

constexpr int ML_PITCH = 288;
constexpr int ML_Q = 0, ML_K = 18432, ML_V = 36864, ML_VW = 55296, ML_C = 73728, ML_N = 110592, ML_GB = 111104, ML_GA = 119296, ML_GMQ = 127488,
              ML_GS = 135680, ML_ST = 136192;

__device__ __forceinline__ float wave_incl_scan_add(float v, int lane) {
#pragma unroll
    for (int off = 1; off < 64; off <<= 1) { const float o = __shfl_up(v, off); if (lane >= off) v += o; }
    return v;
}
__device__ __forceinline__ float wave_incl_scan_max(float v, int lane) {
#pragma unroll
    for (int off = 1; off < 64; off <<= 1) { const float o = __shfl_up(v, off); if (lane >= off) v = fmaxf(v, o); }
    return v;
}
__device__ __forceinline__ float wave_max(float v) {
#pragma unroll
    for (int off = 32; off >= 1; off >>= 1) v = fmaxf(v, __shfl_xor(v, off));
    return v;
}

__device__ __forceinline__ void mlstm_scan(const Params& p, char* smem, int b, int h) {
    const char* ws = p.ws;
    int tid = threadIdx.x;
    asm volatile("" : "+v"(tid));
    const int lane = tid & 63, wid = __builtin_amdgcn_readfirstlane(tid >> 6), fr = lane & 15, fq = lane >> 4;
    const bf16_t* QK = (const bf16_t*)(ws + WS_QK) + (long)b * SEQ * 1024 + h * 128;
    const bf16_t* Pb = (const bf16_t*)(ws + WS_P) + (long)b * SEQ * PW;
    const float* psm = (const float*)(ws + WS_PSM) + (long)b * SEQ * 32;
    bf16_t* mix = (bf16_t*)(p.ws + WS_MIX) + (long)b * SEQ * 1024 + 512 + h * 128;
    float* GB = (float*)(smem + ML_GB); float* GA = (float*)(smem + ML_GA); float* GMQ = (float*)(smem + ML_GMQ);
    float* GS = (float*)(smem + ML_GS);
    float* NV = (float*)(smem + ML_N);
    float* ST = (float*)(smem + ML_ST);
    {
        const float ib = p.in[I_IBIAS][h], fb = p.in[I_FBIAS][h];
        for (int c = wid; c < 32; c += 8) {
            const int t = c * 64 + lane;
            const float ipre = psm[(long)t * 32 + 24 + h], fpre = psm[(long)t * 32 + 28 + h];
            const float li = ipre + ib;
            const float x = fpre + fb;
            const float lf = fminf(x, 0.f) - log1pf(__expf(-fabsf(x)));
            const float bb = wave_incl_scan_add(lf, lane);
            const float aa = li - bb;
            const float g = __shfl(bb, 63);
            const float pm = wave_incl_scan_max(aa, lane);
            const float mloc = wave_max(g + aa);
            GB[t] = bb; GA[t] = aa; GMQ[t] = pm;
            if (lane == 0) { GS[64 + c] = g; GS[96 + c] = mloc; }
        }
    }
    for (int e = tid; e < 36864 / 16; e += NTHR) *(u32x4*)(smem + ML_C + e * 16) = (u32x4){0u, 0u, 0u, 0u};
    if (tid < 128) NV[tid] = 0.f;
    __syncthreads();
    if (tid == 0) {
        float m = 0.f;
        for (int c = 0; c < 32; ++c) { GS[c] = m; const float mn = fmaxf(GS[64 + c] + m, GS[96 + c]); GS[32 + c] = mn; m = mn; }
    }
    __syncthreads();
    for (int t = tid; t < SEQ; t += NTHR) GMQ[t] = GB[t] + fmaxf(GS[t >> 6], GMQ[t]);
    __syncthreads();

    f32x4 Cacc[9];
#pragma unroll
    for (int c9 = 0; c9 < 9; ++c9) Cacc[c9] = (f32x4){0.f, 0.f, 0.f, 0.f};
    const int lrow = tid >> 4, lch = tid & 15;
    u32x4 rq[2], rk[2], rv[2];
#pragma unroll
    for (int i2 = 0; i2 < 2; ++i2) {
        const int row = lrow + 32 * i2;
        rq[i2] = *(const u32x4*)(QK + (long)row * 1024 + lch * 8);
        rk[i2] = *(const u32x4*)(QK + (long)row * 1024 + 512 + lch * 8);
        rv[i2] = *(const u32x4*)(Pb + (long)row * PW + PC_MV + h * 128 + lch * 8);
    }
    const int mt = wid >> 1, half = wid & 1;
#pragma unroll 1
    for (int c = 0; c < 32; ++c) {
        const float m_old = GS[c], m_new = GS[32 + c], gch = GS[64 + c];
#pragma unroll
        for (int i2 = 0; i2 < 2; ++i2) {
            const int row = lrow + 32 * i2;
            *(u32x4*)(smem + ML_Q + row * ML_PITCH + lch * 16) = rq[i2];
            *(u32x4*)(smem + ML_K + row * ML_PITCH + lch * 16) = rk[i2];
            *(u32x4*)(smem + ML_V + row * ML_PITCH + lch * 16) = rv[i2];
            const float wk = __expf(gch + GA[c * 64 + row] - m_new);
            u32x4 w;
            w.x = pk_bf16(bf_lo(rv[i2].x) * wk, bf_hi(rv[i2].x) * wk); w.y = pk_bf16(bf_lo(rv[i2].y) * wk, bf_hi(rv[i2].y) * wk);
            w.z = pk_bf16(bf_lo(rv[i2].z) * wk, bf_hi(rv[i2].z) * wk); w.w = pk_bf16(bf_lo(rv[i2].w) * wk, bf_hi(rv[i2].w) * wk);
            *(u32x4*)(smem + ML_VW + row * ML_PITCH + lch * 16) = w;
        }
        if (tid < 128) {
            const int row = tid >> 1, hf = tid & 1;
            const float wk = __expf(gch + GA[c * 64 + row] - m_new);
            u32x4 w = (u32x4){0u, 0u, 0u, 0u};
            if (hf == 0) w.x = pk_bf16(wk, 0.f);
            *(u32x4*)(smem + ML_VW + row * ML_PITCH + 256 + hf * 16) = w;
        }
        __syncthreads();
        if (c + 1 < 32) {
#pragma unroll
            for (int i2 = 0; i2 < 2; ++i2) {
                const int row = (c + 1) * 64 + lrow + 32 * i2;
                rq[i2] = *(const u32x4*)(QK + (long)row * 1024 + lch * 8);
                rk[i2] = *(const u32x4*)(QK + (long)row * 1024 + 512 + lch * 8);
                rv[i2] = *(const u32x4*)(Pb + (long)row * PW + PC_MV + h * 128 + lch * 8);
            }
        }
        const int l = 16 * mt + fr;
        const float bl = GB[c * 64 + l], mq = GMQ[c * 64 + l];
        const float ul = bl - mq;
        f32x4 hv[4];
        float s1 = 0.f, s2 = 0.f;
        {
            bf16x8 qf[4];
#pragma unroll
            for (int ks = 0; ks < 4; ++ks) qf[ks] = *(const bf16x8*)(smem + ML_Q + l * ML_PITCH + (ks * 4 + fq) * 16);
            f32x4 S[4];
#pragma unroll
            for (int nt = 0; nt < 4; ++nt) {
                f32x4 s = (f32x4){0.f, 0.f, 0.f, 0.f};
#pragma unroll
                for (int ks = 0; ks < 4; ++ks) {
                    const bf16x8 kf = *(const bf16x8*)(smem + ML_K + (16 * nt + fr) * ML_PITCH + (ks * 4 + fq) * 16);
                    s = mfma16(kf, qf[ks], s);
                }
                S[nt] = s;
            }
            float dintra = 0.f;
            const int lq = l - 4 * fq;
#pragma unroll
            for (int nt = 0; nt < 4; ++nt) {
                const f32x4 av = *(const f32x4*)(GA + c * 64 + 16 * nt + 4 * fq);
#pragma unroll
                for (int e = 0; e < 4; ++e) {
                    const float w = (16 * nt + e <= lq) ? __expf(ul + av[e]) : 0.f;
                    const float sv = S[nt][e] * w;
                    S[nt][e] = sv; dintra += sv;
                }
            }
            dintra = fq_sum(dintra);
            float dinter = 0.f;
#pragma unroll
            for (int ks = 0; ks < 4; ++ks) {
                const f32x4 n0 = *(const f32x4*)(NV + ks * 32 + fq * 8), n1 = *(const f32x4*)(NV + ks * 32 + fq * 8 + 4);
                const u32x4 qu = __builtin_bit_cast(u32x4, qf[ks]);
                dinter += bf_lo(qu.x) * n0[0] + bf_hi(qu.x) * n0[1] + bf_lo(qu.y) * n0[2] + bf_hi(qu.y) * n0[3]
                        + bf_lo(qu.z) * n1[0] + bf_hi(qu.z) * n1[1] + bf_lo(qu.w) * n1[2] + bf_hi(qu.w) * n1[3];
            }
            dinter = fq_sum(dinter);
            const float winter = __expf(ul + m_old);
            const float den = winter * dinter + dintra;
            const float rden = 1.0f / fmaxf(fabsf(den), __expf(-mq));
            const bf16x8 pf0 = pack_p(S[0], S[1]), pf1 = pack_p(S[2], S[3]);
#pragma unroll
            for (int c4 = 0; c4 < 4; ++c4) {
                const int et = 4 * half + c4;
                f32x4 num = (f32x4){0.f, 0.f, 0.f, 0.f}, inter = (f32x4){0.f, 0.f, 0.f, 0.f};
                num = mfma16(tr_frag_perm(smem + ML_V, ML_PITCH, 0, 16 * et, fr, fq), pf0, num);
                num = mfma16(tr_frag_perm(smem + ML_V, ML_PITCH, 32, 16 * et, fr, fq), pf1, num);
#pragma unroll
                for (int ks = 0; ks < 4; ++ks) {
                    const bf16x8 cf = *(const bf16x8*)(smem + ML_C + (16 * et + fr) * ML_PITCH + (ks * 4 + fq) * 16);
                    inter = mfma16(cf, qf[ks], inter);
                }
                const f32x4 hh = (inter * winter + num) * rden;
                hv[c4] = hh;
                s1 += (hh[0] + hh[1]) + (hh[2] + hh[3]);
                s2 += (hh[0] * hh[0] + hh[1] * hh[1]) + (hh[2] * hh[2] + hh[3] * hh[3]);
            }
            s1 = fq_sum(s1); s2 = fq_sum(s2);
            if (fq == 0) { ST[(l * 2 + half) * 2] = s1; ST[(l * 2 + half) * 2 + 1] = s2; }
        }
        {
            const float decay = __expf(gch + m_old - m_new);
#pragma unroll
            for (int c9 = 0; c9 < 9; ++c9) Cacc[c9] = Cacc[c9] * decay;
#pragma unroll
            for (int ks2 = 0; ks2 < 2; ++ks2) {
                const bf16x8 kt = tr_frag_std(smem + ML_K, ML_PITCH, 32 * ks2, 16 * wid, fr, fq);
#pragma unroll
                for (int c9 = 0; c9 < 9; ++c9) {
                    const bf16x8 vw = tr_frag_std(smem + ML_VW, ML_PITCH, 32 * ks2, 16 * c9, fr, fq);
                    Cacc[c9] = mfma16(kt, vw, Cacc[c9]);
                }
            }
        }
        __syncthreads();
        {
            const float* sp = ST + l * 4;
            const float t1 = sp[0] + sp[2], t2 = sp[1] + sp[3];
            const float mean = t1 * (1.0f / 128.0f);
            const float var = fmaxf(t2 * (1.0f / 128.0f) - mean * mean, 0.f);
            const float rstd = rsqrtf(var + LN_EPS);
            const long tok = c * 64 + l;
#pragma unroll
            for (int c4 = 0; c4 < 4; ++c4) {
                const int col = 64 * half + 16 * c4 + 4 * fq;
                const u32x2 ou = *(const u32x2*)(Pb + tok * PW + PC_MO + h * 128 + col);
                const f32x4 ng = *(const f32x4*)(p.in[I_NORMG] + h * 128 + col);
                const f32x4 y = (hv[c4] - mean) * rstd * ng;
                u32x2 w;
                w.x = pk_bf16(y[0] * sigmoidf_(bf_lo(ou.x)), y[1] * sigmoidf_(bf_hi(ou.x)));
                w.y = pk_bf16(y[2] * sigmoidf_(bf_lo(ou.y)), y[3] * sigmoidf_(bf_hi(ou.y)));
                *(u32x2*)(mix + tok * 1024 + col) = w;
            }
        }
#pragma unroll
        for (int c9 = 0; c9 < 8; ++c9) {
            u32x2 w; w.x = pk_bf16(Cacc[c9][0], Cacc[c9][1]); w.y = pk_bf16(Cacc[c9][2], Cacc[c9][3]);
            *(u32x2*)(smem + ML_C + (16 * c9 + fr) * ML_PITCH + (16 * wid + 4 * fq) * 2) = w;
        }
        if (fr == 0) *(f32x4*)(NV + 16 * wid + 4 * fq) = Cacc[8];
        __syncthreads();
    }
}


constexpr int CV_PITCH = 144;
__device__ __forceinline__ void wconv_task(const Params& p, char* smem, int which, int e, int nt) {
    const int tid = opaque_tid();
    const int ng = tid & 63, kg = tid >> 6, n0 = 4 * ng;
    const float* src; int ld, K; unsigned char* dst;
    if (which == 0) {
        const int col = 128 * nt + 32 * (n0 >> 6) + bperm32(n0 & 31);
        src = (((n0 >> 5) & 1) ? p.in[I_MW3] : p.in[I_MW1]) + (long)e * 1024 * 256 + col; ld = 256; K = 1024;
        dst = (unsigned char*)p.out + ((long)(e * 2 + nt) * 256) * 1024;
    } else {
        src = p.in[I_MW2] + (long)e * 256 * 1024 + nt * 256 + bperm32(n0); ld = 1024; K = 256;
        dst = (unsigned char*)(p.ws + WS_W2F8) + ((long)(e * 4 + nt) * 256) * 256;
    }
    for (int kc = 0; kc < K / 128; ++kc) {
        f32x4 v[16];
#pragma unroll
        for (int j = 0; j < 16; ++j) v[j] = __builtin_nontemporal_load((const f32x4*)(src + (long)(kc * 128 + kg * 16 + j) * ld));
#pragma unroll
        for (int cc = 0; cc < 4; ++cc) {
            u32x4 w;
            w.x = pk4_fp8(v[0][cc] * W8_SCALE, v[1][cc] * W8_SCALE, v[2][cc] * W8_SCALE, v[3][cc] * W8_SCALE);
            w.y = pk4_fp8(v[4][cc] * W8_SCALE, v[5][cc] * W8_SCALE, v[6][cc] * W8_SCALE, v[7][cc] * W8_SCALE);
            w.z = pk4_fp8(v[8][cc] * W8_SCALE, v[9][cc] * W8_SCALE, v[10][cc] * W8_SCALE, v[11][cc] * W8_SCALE);
            w.w = pk4_fp8(v[12][cc] * W8_SCALE, v[13][cc] * W8_SCALE, v[14][cc] * W8_SCALE, v[15][cc] * W8_SCALE);
            *(u32x4*)(smem + (n0 + cc) * CV_PITCH + kg * 16) = w;
        }
        __syncthreads();
#pragma unroll
        for (int i = 0; i < 4; ++i) {
            const int piece = tid + i * NTHR, row = piece >> 3, ch = piece & 7;
            *(u32x4*)(dst + (long)row * K + kc * 128 + ch * 16) = *(const u32x4*)(smem + row * CV_PITCH + ch * 16);
        }
        __syncthreads();
    }
}

template <int PARTS = 7  , int NSAV = 7>
__device__ __forceinline__ void phase3(const Params& p, char* smem, int bid, int nb, int rep = 0) {
    XcdSlab xs; xs.init(bid, nb);
    const int nq = xs.x >= 0 ? 320 : 1024 + 1536;
    int* qctr = (int*)(p.ws + WS_CNT) + 16384 + ((xs.x >= 0 ? xs.x : 0) + 8 * rep) * 32;
    if (PARTS & 1) for (int u = bid; u < 64; u += nb) mlstm_scan(p, smem, u >> 2, u & 3);
    if (!(PARTS & 2)) return;
    volatile int* slot = (volatile int*)(smem + NSA_MISC + 256);
    for (;;) {
        if (opaque_tid() == 0) *slot = atomicAdd(qctr, 1);
        __syncthreads();
        const int k = __builtin_amdgcn_readfirstlane(*slot);
        if (k >= nq) break;
        if (xs.x >= 0) {
            const int r5 = k % 5, q5 = k / 5;
            if (r5 < 2) { const int kk = q5 * 2 + r5; const int bg = 4 * xs.x + (kk & 3); nsa_task<NSAV>(p, smem, bg >> 1, bg & 1, 31 - (kk >> 2)); }
            else if (PARTS & 4) { const int cv = q5 * 3 + (r5 - 2); const int e = xs.x + 8 * (cv / 6), t6 = cv % 6; wconv_task(p, smem, t6 < 2 ? 0 : 1, e, t6 < 2 ? t6 : t6 - 2); }
        } else if (k < 1024) nsa_task<NSAV>(p, smem, (k & 31) >> 1, k & 1, 31 - (k >> 5));
        else if (PARTS & 4) { const int cv = k - 1024; const int e = cv / 6, t6 = cv % 6; wconv_task(p, smem, t6 < 2 ? 0 : 1, e, t6 < 2 ? t6 : t6 - 2); }
    }
}

constexpr int XA_PITCH = 544;
constexpr int XA_K = 0, XA_V = 69632;
__device__ __forceinline__ void xattn_task(const Params& p, char* smem, int b, int h, int qb) {
    const char* ws = p.ws;
    int tid = threadIdx.x;
    asm volatile("" : "+v"(tid));
    const int lane = tid & 63, wid = __builtin_amdgcn_readfirstlane(tid >> 6), fr = lane & 15, fq = lane >> 4;
    const bf16_t* XQ = (const bf16_t*)(ws + WS_XQ) + (long)(b * SEQ + qb * 128 + wid * 16 + fr) * 1024 + h * 256 + fq * 8;
    const bf16_t* KV = (const bf16_t*)(ws + WS_KVX) + (long)b * 256 * 2048 + h * 256;
    bf16x8 qf[8];
#pragma unroll
    for (int ks = 0; ks < 8; ++ks) qf[ks] = *(const bf16x8*)(XQ + ks * 32);
    f32x4 O[16];
#pragma unroll
    for (int dt = 0; dt < 16; ++dt) O[dt] = (f32x4){0.f, 0.f, 0.f, 0.f};
    float m = -1e30f, l = 0.f;
    const int lrow = tid >> 5, lch = tid & 31;
    u32x4 rk[4], rv[4];
#pragma unroll
    for (int i2 = 0; i2 < 4; ++i2) {
        const bf16_t* rp = KV + (long)(lrow + 16 * i2) * 2048 + lch * 8;
        rk[i2] = *(const u32x4*)rp; rv[i2] = *(const u32x4*)(rp + 1024);
    }
#pragma unroll
    for (int i2 = 0; i2 < 4; ++i2) {
        *(u32x4*)(smem + XA_K + (lrow + 16 * i2) * XA_PITCH + lch * 16) = rk[i2];
        *(u32x4*)(smem + XA_V + (lrow + 16 * i2) * XA_PITCH + lch * 16) = rv[i2];
    }
    __syncthreads();
#pragma unroll 1
    for (int j = 0; j < 4; ++j) {
        const int buf = j & 1;
        if (j + 1 < 4) {
#pragma unroll
            for (int i2 = 0; i2 < 4; ++i2) {
                const bf16_t* rp = KV + (long)((j + 1) * 64 + lrow + 16 * i2) * 2048 + lch * 8;
                rk[i2] = *(const u32x4*)rp; rv[i2] = *(const u32x4*)(rp + 1024);
            }
        }
        const char* KT = smem + XA_K + buf * 34816;
        const char* VT = smem + XA_V + buf * 34816;
        f32x4 S[4];
#pragma unroll
        for (int nt = 0; nt < 4; ++nt) {
            f32x4 s = (f32x4){0.f, 0.f, 0.f, 0.f};
#pragma unroll
            for (int ks = 0; ks < 8; ++ks) {
                const bf16x8 kf = *(const bf16x8*)(KT + (16 * nt + fr) * XA_PITCH + (ks * 4 + fq) * 16);
                s = mfma16(kf, qf[ks], s);
            }
            S[nt] = s * 0.0625f;
        }
        float mx = -INFINITY;
#pragma unroll
        for (int nt = 0; nt < 4; ++nt)
#pragma unroll
            for (int e = 0; e < 4; ++e) mx = fmaxf(mx, S[nt][e]);
        mx = fq_max(mx);
        const float mnew = fmaxf(m, mx);
        const float alpha = __expf(m - mnew);
        float rs = 0.f;
#pragma unroll
        for (int nt = 0; nt < 4; ++nt)
#pragma unroll
            for (int e = 0; e < 4; ++e) { const float pv = __expf(S[nt][e] - mnew); S[nt][e] = pv; rs += pv; }
        rs = fq_sum(rs);
        l = l * alpha + rs; m = mnew;
#pragma unroll
        for (int dt = 0; dt < 16; ++dt) O[dt] = O[dt] * alpha;
        const bf16x8 pf0 = pack_p(S[0], S[1]), pf1 = pack_p(S[2], S[3]);
#pragma unroll
        for (int dt = 0; dt < 16; ++dt) {
            O[dt] = mfma16(tr_frag_perm(VT, XA_PITCH, 0, 16 * dt, fr, fq), pf0, O[dt]);
            O[dt] = mfma16(tr_frag_perm(VT, XA_PITCH, 32, 16 * dt, fr, fq), pf1, O[dt]);
        }
        if (j + 1 < 4) {
            char* KTn = smem + XA_K + (buf ^ 1) * 34816; char* VTn = smem + XA_V + (buf ^ 1) * 34816;
#pragma unroll
            for (int i2 = 0; i2 < 4; ++i2) {
                *(u32x4*)(KTn + (lrow + 16 * i2) * XA_PITCH + lch * 16) = rk[i2];
                *(u32x4*)(VTn + (lrow + 16 * i2) * XA_PITCH + lch * 16) = rv[i2];
            }
        }
        __syncthreads();
    }
    const float inv = 1.0f / l;
    bf16_t* op = (bf16_t*)(p.ws + WS_XO) + (long)(b * SEQ + qb * 128 + wid * 16 + fr) * 1024 + h * 256 + fq * 4;
#pragma unroll
    for (int dt = 0; dt < 16; ++dt) {
        u32x2 w; w.x = pk_bf16(O[dt][0] * inv, O[dt][1] * inv); w.y = pk_bf16(O[dt][2] * inv, O[dt][3] * inv);
        *(u32x2*)(op + dt * 16) = w;
    }
}

__device__ __forceinline__ void phase6(const Params& p, char* smem, int bid, int nb) {
    XcdSlab xs; xs.init(bid, nb);
    const int p_lo = xs.m_lo(64), n_t = (xs.m_hi(64) - p_lo) * 16;
    for (int u = xs.j; u < n_t; u += xs.stride) { const int pr = p_lo + (u >> 4); xattn_task(p, smem, pr >> 2, pr & 3, u & 15); }
}

constexpr int LN_ST = 139264, LN_GB = 141312, MOE_TAB = 153600;

template <class EPI>
__device__ __forceinline__ void dense_loop(char* smem, int bid, int nb, const bf16_t* A, int lda, const bf16_t* Bt, int nk, const EPI& epi) {
    XcdSlab xs; xs.init(bid, nb);
    const int m_lo = xs.m_lo(128), n_t = (xs.m_hi(128) - m_lo) * 4;
    int mt = 0, nt = 0;
    RingRows al, bl;
    auto setup = [&](int u) { mt = m_lo + (u >> 2); nt = u & 3; al.init_contig(A, lda, mt * 256); bl.init_contig(Bt, lda, nt * 256, true); };
    int u = xs.j;
    if (u < n_t) { setup(u); ring_issue3(smem, al, bl); }
    while (u < n_t) {
        const int cmt = mt, cnt_ = nt;
        f32x4 acc[8][4];
        gemm_ring<RingRows, RingRows, 0, true>(smem, al, bl, nk, acc);
        u += xs.stride;
        if (u < n_t) { setup(u); ring_issue3(smem, al, bl); }
        epi(acc, cmt, cnt_);
    }
    asm volatile("s_waitcnt vmcnt(0)" ::: "memory");
}

__device__ __forceinline__ void phase4(const Params& p, char* smem, int bid, int nb) {
    char* ws = p.ws;
    dense_loop(smem, bid, nb, (const bf16_t*)(ws + WS_MIX), 1024, (const bf16_t*)(ws + WS_WOUT), 32, [&](f32x4 (&acc)[8][4], int mt, int nt) {
        epi_residual<false>(acc, smem, p.in[I_X], nullptr, nullptr, nullptr, nullptr, (bf16_t*)(ws + WS_R1B), (float*)(ws + WS_ST1), mt * 256, nt);
    });
}

__device__ __forceinline__ void phase5(const Params& p, char* smem, int bid, int nb) {
    char* ws = p.ws;
    const float* lnf = (const float*)(ws + WS_LNF);
    dense_loop(smem, bid, nb, (const bf16_t*)(ws + WS_R1B), 1024, (const bf16_t*)(ws + WS_WQ), 32, [&](f32x4 (&acc)[8][4], int mt, int nt) {
        ln_correct<0>(acc, (const float*)(ws + WS_ST1), mt * 256, lnf, lnf + 1792, nt);
        epi_store_bf16(acc, (bf16_t*)(ws + WS_XQ), 1024, mt * 256, nt * 256);
    });
}

__device__ __forceinline__ void phase7(const Params& p, char* smem, int bid, int nb) {
    char* ws = p.ws;
    dense_loop(smem, bid, nb, (const bf16_t*)(ws + WS_XO), 1024, (const bf16_t*)(ws + WS_WO), 32, [&](f32x4 (&acc)[8][4], int mt, int nt) {
        epi_residual<true>(acc, smem, nullptr, (const bf16_t*)(ws + WS_R1B), (const float*)(ws + WS_ST1), p.in[I_LN1G], p.in[I_LN1B],
                           (bf16_t*)(ws + WS_R2B), (float*)(ws + WS_ST2), mt * 256, nt);
    });
}

template <class RowMap>
__device__ __forceinline__ void epi_swiglu(const f32x4 (&acc)[8][4], bf16_t* out, int ld, int nt, const RowMap& rm) {
    const int tid_ = opaque_tid();
    const int lane = tid_ & 63, wid = tid_ >> 6;
    const int wr = wid >> 2, wc = wid & 3, fr = lane & 15, fq = lane >> 4;
#pragma unroll
    for (int mi = 0; mi < 8; ++mi) {
        const long orow = rm(wr * 128 + mi * 16 + fr);
        if (orow >= 0) {
            const f32x4 a0 = acc[mi][0], b0 = acc[mi][1], a1 = acc[mi][2], b1 = acc[mi][3];
            u32x4 w;
            w.x = pk_bf16(siluf_(a0[0]) * b0[0], siluf_(a0[1]) * b0[1]); w.y = pk_bf16(siluf_(a0[2]) * b0[2], siluf_(a0[3]) * b0[3]);
            w.z = pk_bf16(siluf_(a1[0]) * b1[0], siluf_(a1[1]) * b1[1]); w.w = pk_bf16(siluf_(a1[2]) * b1[2], siluf_(a1[3]) * b1[3]);
            *(u32x4*)(out + orow * ld + nt * 128 + wc * 32 + fq * 8) = w;
        }
    }
}
struct RowIdent { long row0; __device__ __forceinline__ long operator()(int rl) const { return row0 + rl; } };

__device__ __forceinline__ unsigned dpp_xor1_u(unsigned v) { return (unsigned)__builtin_amdgcn_mov_dpp((int)v, 0xB1, 0xF, 0xF, true); }
__device__ __forceinline__ void route_tile(const Params& p, char* smem, int tok0, int rep) {
    char* ws = p.ws;
    const float* bias = p.in[I_ROUTB];
    const int tid = opaque_tid(), tk = tid >> 1, hf = tid & 1;
    const float* row = (const float*)(ws + WS_RSC) + (long)(tok0 + tk) * 256;
    unsigned key[128];
    float gs[4];
    {
        float v[128];
#pragma unroll
        for (int i = 0; i < 32; ++i) { const f32x4 t = *(const f32x4*)(row + hf * 128 + i * 4); v[4 * i] = t[0]; v[4 * i + 1] = t[1]; v[4 * i + 2] = t[2]; v[4 * i + 3] = t[3]; }
#pragma unroll
        for (int gi = 0; gi < 4; ++gi) {
            float m1 = -INFINITY, m2 = -INFINITY;
#pragma unroll
            for (int i = 0; i < 32; ++i) { const float x = v[32 * gi + i]; m2 = __builtin_fmaxf(m2, __builtin_fminf(m1, x)); m1 = __builtin_fmaxf(m1, x); }
            gs[gi] = m1 + m2;
        }
        float g8[8];
#pragma unroll
        for (int gi = 0; gi < 4; ++gi) { const float o = dpp_xor1(gs[gi]); g8[gi] = hf ? o : gs[gi]; g8[4 + gi] = hf ? gs[gi] : o; }
        unsigned gsel = 0u;
#pragma unroll
        for (int a = 0; a < 8; ++a) {
            int rank = 0;
#pragma unroll
            for (int b = 0; b < 8; ++b) rank += (g8[b] > g8[a] || (g8[b] == g8[a] && b < a)) ? 1 : 0;
            if (rank < 4) gsel |= 1u << a;
        }
#pragma unroll
        for (int gi = 0; gi < 4; ++gi) {
            const bool on = ((gsel >> (4 * hf + gi)) & 1u) != 0u;
#pragma unroll
            for (int i = 0; i < 32; ++i) {
                const unsigned kb = (__float_as_uint(v[32 * gi + i] + 1.0f) & ~0xFFu) | (unsigned)(255 - (128 * hf + 32 * gi + i));
                key[32 * gi + i] = on ? kb : 0u;
            }
        }
    }
    unsigned win[8];
    unsigned prev = 0xFFFFFFFFu;
#pragma unroll
    for (int r = 0; r < 8; ++r) {
        unsigned m = 0u;
#pragma unroll
        for (int i = 0; i < 128; ++i) { const unsigned kk = key[i]; const unsigned c = kk < prev ? kk : 0u; m = m > c ? m : c; }
        const unsigned o = dpp_xor1_u(m);
        m = m > o ? m : o;
        prev = m;
        win[r] = m;
    }
    float sc8[8]; float wsum = 0.f;
#pragma unroll
    for (int r = 0; r < 8; ++r) { const int e = 255 - (int)(win[r] & 255u); sc8[r] = row[e] - bias[e]; wsum += sc8[r]; }
    int* lc = (int*)(smem + MOE_TAB); int* gbase = lc + 256;
    if (tid < 256) lc[tid] = 0;
    __syncthreads();
    int mye[4], myr[4];
    const unsigned hmask = 0u - (unsigned)hf;
#pragma unroll
    for (int u = 0; u < 4; ++u) {
        const unsigned w = win[u] ^ ((win[u] ^ win[4 + u]) & hmask);
        mye[u] = 255 - (int)(w & 255u); myr[u] = atomicAdd(lc + mye[u], 1);
    }
    __syncthreads();
    if (tid < 256) { const int n = lc[tid]; if (n > 0) gbase[tid] = atomicAdd((int*)(ws + WS_CNT) + 8192 * rep + tid * 32, n); }
    __syncthreads();
    {
        const long t = tok0 + tk;
        const float wn = 2.5f / wsum;
#pragma unroll
        for (int u = 0; u < 4; ++u) {
            const int k = 4 * hf + u;
            const int e = mye[u];
            const unsigned s0 = __float_as_uint(sc8[u]), s1 = __float_as_uint(sc8[4 + u]);
            const float w = __uint_as_float(s0 ^ ((s0 ^ s1) & hmask)) * wn;
            const int pos = gbase[e] + myr[u];
            ((int*)(ws + WS_SELE))[t * 8 + k] = e;
            ((int*)(ws + WS_SELP))[t * 8 + k] = pos;
            ((float*)(ws + WS_SELW))[t * 8 + k] = w;
            ((int*)(ws + WS_TOKL))[(long)e * LIST_CAP + pos] = (int)t;
            ((float*)(ws + WS_WL))[(long)e * LIST_CAP + pos] = w;
        }
    }
    __syncthreads();
}

__device__ __forceinline__ void phase8(const Params& p, char* smem, int bid, int nb, int rep = 0) {
    char* ws = p.ws;
    const float* lnf = (const float*)(ws + WS_LNF);
    XcdSlab xs; xs.init(bid, nb);
    const int m_lo = xs.m_lo(128), m_n = xs.m_hi(128) - m_lo;
    for (int u = xs.j; u < m_n; u += xs.stride) {
        const int mt = m_lo + u;
        float* gsc = (float*)(ws + WS_RSC);
        {
            RingRows al, bl;
            al.init_contig((const bf16_t*)(ws + WS_R2B), 1024, mt * 256);
            bl.init_contig((const bf16_t*)(ws + WS_WR), 1024, 0, true);
            f32x4 acc[8][4];
            gemm_ring(smem, al, bl, 32, acc);
            ln_correct<0>(acc, (const float*)(ws + WS_ST2), mt * 256, lnf + 1024, lnf + 1792 + 1024, 0);
            const int tid_ = opaque_tid();
            const int lane = tid_ & 63, wid = tid_ >> 6;
            const int wr = wid >> 2, wc = wid & 3, fr = lane & 15, fq = lane >> 4;
            const float* bias = p.in[I_ROUTB];
#pragma unroll
            for (int ni = 0; ni < 4; ++ni) {
                const int col = wc * 64 + (ni >> 1) * 32 + fq * 8 + (ni & 1) * 4;
                const f32x4 bv = *(const f32x4*)(bias + col);
#pragma unroll
                for (int mi = 0; mi < 8; ++mi) {
                    f32x4 v;
#pragma unroll
                    for (int e = 0; e < 4; ++e) v[e] = sigmoidf_(acc[mi][ni][e]) + bv[e];
                    *(f32x4*)(gsc + (long)(mt * 256 + wr * 128 + mi * 16 + fr) * 256 + col) = v;
                }
            }
        }
        __syncthreads();
        route_tile(p, smem, mt * 256, rep);
    }
    for (int u = (xs.j + xs.stride - m_n % xs.stride) % xs.stride; u < m_n * 2; u += xs.stride) {
        const int mt = m_lo + (u >> 1), nt = u & 1;
        RingRows al, bl;
        al.init_contig((const bf16_t*)(ws + WS_R2B), 1024, mt * 256);
        bl.init_contig((const bf16_t*)(ws + WS_WS13), 1024, nt * 256);
        f32x4 acc[8][4];
        gemm_ring(smem, al, bl, 32, acc);
        ln_correct<1>(acc, (const float*)(ws + WS_ST2), mt * 256, lnf + 1280, lnf + 1792 + 1280, nt);
        RowIdent rm; rm.row0 = (long)mt * 256;
        epi_swiglu(acc, (bf16_t*)(ws + WS_HS), 256, nt, rm);
    }
    {
        const int tid = opaque_tid(), lane = tid & 63, wid = tid >> 6;
        const bf16_t* r2 = (const bf16_t*)(ws + WS_R2B); const float* st2 = (const float*)(ws + WS_ST2);
        unsigned char* x2 = (unsigned char*)(ws + WS_X2F8);
        for (int t = bid * 8 + wid; t < T_TOK; t += nb * 8) {
            const f32x4 p0 = *(const f32x4*)(st2 + (long)t * 8), p1 = *(const f32x4*)(st2 + (long)t * 8 + 4);
            const float q1 = (p0[0] + p0[2]) + (p1[0] + p1[2]), q2 = (p0[1] + p0[3]) + (p1[1] + p1[3]);
            const float mean = q1 * (1.0f / 1024.0f);
            const float rstd = rsqrtf(fmaxf(q2 * (1.0f / 1024.0f) - mean * mean, 0.f) + LN_EPS);
#pragma unroll
            for (int hseg = 0; hseg < 2; ++hseg) {
                const int col = hseg * 512 + lane * 8;
                const u32x4 ru = *(const u32x4*)(r2 + (long)t * 1024 + col);
                const f32x4 a0 = (f32x4){bf_lo(ru.x), bf_hi(ru.x), bf_lo(ru.y), bf_hi(ru.y)}, a1 = (f32x4){bf_lo(ru.z), bf_hi(ru.z), bf_lo(ru.w), bf_hi(ru.w)};
                const f32x4 g0 = *(const f32x4*)(p.in[I_LN2G] + col), g1 = *(const f32x4*)(p.in[I_LN2G] + col + 4);
                const f32x4 b0 = *(const f32x4*)(p.in[I_LN2B] + col), b1 = *(const f32x4*)(p.in[I_LN2B] + col + 4);
                const f32x4 y0 = (a0 - mean) * rstd * g0 + b0, y1 = (a1 - mean) * rstd * g1 + b1;
                u32x2 w; w.x = pk4_fp8(y0[0], y0[1], y0[2], y0[3]); w.y = pk4_fp8(y1[0], y1[1], y1[2], y1[3]);
                *(u32x2*)(x2 + (long)t * 1024 + col) = w;
            }
        }
    }
}

template <int XMODE>
__device__ __forceinline__ void phase_probe(const Params& p, char* smem, int bid, int nb) {
    char* ws = p.ws;
    XcdSlab xs; xs.init(bid, nb);
    const int m_lo = xs.m_lo(128), n_t = (xs.m_hi(128) - m_lo) * 4;
    for (int u = xs.j; u < n_t; u += xs.stride) {
        const int mt = m_lo + (u >> 2), nt = u & 3;
        RingRows al, bl;
        al.init_contig((const bf16_t*)(ws + WS_MIX), 1024, mt * 256);
        bl.init_contig((const bf16_t*)(ws + WS_WOUT), 1024, nt * 256, true);
        f32x4 acc[8][4];
        gemm_ring<RingRows, RingRows, XMODE>(smem, al, bl, 32, acc);
        epi_store_bf16(acc, (bf16_t*)(ws + WS_A + 432 * MB), 1024, mt * 256, nt * 256);
    }
}

__device__ __forceinline__ void moe_tables(const Params& p, char* smem, const XcdSlab& xs) {
    int* off = (int*)(smem + MOE_TAB); int* tst = off + 256; int* cntl = tst + 260;
    const int* cnt = (const int*)(p.ws + WS_CNT);
    const int tid = opaque_tid();
    if (tid >= 256) cntl[tid - 256] = cnt[(tid - 256) * 32];
    if (tid < 64) {
        int c[4], cs = 0;
#pragma unroll
        for (int k = 0; k < 4; ++k) { c[k] = cnt[(tid * 4 + k) * 32]; cs += c[k]; }
        int ics = cs;
#pragma unroll
        for (int o = 1; o < 64; o <<= 1) { const int a = __shfl_up(ics, o); if (tid >= o) ics += a; }
        int eo = ics - cs;
#pragma unroll
        for (int k = 0; k < 4; ++k) { off[tid * 4 + k] = eo; eo += c[k]; }
    } else if (tid < 128) {
        const int l = tid - 64;
        if (xs.x >= 0) {
            const int tl = l < 32 ? ((cnt[(xs.x + 8 * l) * 32] + 255) >> 8) : 0;
            int it = tl;
#pragma unroll
            for (int o = 1; o < 64; o <<= 1) { const int a = __shfl_up(it, o); if (l >= o) it += a; }
            if (l < 32) tst[l] = it - tl;
            if (l == 31) tst[32] = it;
        } else {
            int c[4], ts = 0;
#pragma unroll
            for (int k = 0; k < 4; ++k) { c[k] = (cnt[(l * 4 + k) * 32] + 255) >> 8; ts += c[k]; }
            int its = ts;
#pragma unroll
            for (int o = 1; o < 64; o <<= 1) { const int a = __shfl_up(its, o); if (l >= o) its += a; }
            int et = its - ts;
#pragma unroll
            for (int k = 0; k < 4; ++k) { tst[l * 4 + k] = et; et += c[k]; }
            if (l == 63) tst[256] = its;
        }
    }
    __syncthreads();
}
__device__ __forceinline__ int moe_find(const int* tst, int nloc, int t) {
    int lo = 0, hi = nloc - 1;
#pragma unroll 1
    while (lo < hi) { const int mid = (lo + hi + 1) >> 1; if (tst[mid] <= t) lo = mid; else hi = mid - 1; }
    return lo;
}
struct RowMoe { long base; int nvalid; __device__ __forceinline__ long operator()(int rl) const { return rl < nvalid ? base + rl : -1; } };

template <int PARTS9 = 3>
__device__ __forceinline__ void phase9(const Params& p, char* smem, int bid, int nb) {
    char* ws = p.ws;
    XcdSlab xs; xs.init(bid, nb);
    moe_tables(p, smem, xs);
    const int* off = (const int*)(smem + MOE_TAB); const int* tst = off + 256;
    const int* cnt = (const int*)(ws + WS_CNT);
    const int nloc = xs.x >= 0 ? 32 : 256;
    const int ntile = tst[nloc];
    {
        const int* cntl = tst + 260;
        const int nT = ntile * 2;
        int t = xs.j;
        int e = 0, m0 = 0, ne = 0, nt = 0;
        RingF8 al, bl;
        auto setup = [&](int tt) {
            const int et = tt >> 1; nt = tt & 1;
            const int kl = moe_find(tst, nloc, et); e = xs.x >= 0 ? xs.x + 8 * kl : kl; m0 = (et - tst[kl]) * 256; ne = cntl[e];
            const int tid = opaque_tid();
            const int* tl = (const int*)(ws + WS_TOKL) + (long)e * LIST_CAP;
            int rows[2];
#pragma unroll
            for (int i = 0; i < 2; ++i) { const int r = m0 + (tid >> 2) + 128 * i; rows[i] = r < ne ? tl[r] : 0; }
            al.init_rows((const unsigned char*)(ws + WS_X2F8), 1024, rows);
            bl.init_contig((const unsigned char*)p.out, 1024, (long)(e * 2 + nt) * 256);
        };
        if (!(PARTS9 & 1)) t = nT;
        if (t < nT) { setup(t); ring_f8_issue3(smem, al, bl); }
        while (t < nT) {
            const int ce = e, cm0 = m0, cne = ne, cnt_ = nt;
            f32x16 acc[4][2];
            gemm_ring_mx_main(smem, al, bl, 16, acc);
            t += xs.stride;
            if (t < nT) { setup(t); ring_f8_issue3(smem, al, bl); }
            {
                const int tid2 = opaque_tid();
                const int lane = tid2 & 63, wid = tid2 >> 6;
                const int wr = wid >> 2, wc = wid & 3, r = lane & 31, h = lane >> 5;
                unsigned char* H = (unsigned char*)(ws + WS_HF8) + ((long)off[ce] + cm0) * 256 + cnt_ * 128 + wc * 32 + h * 16;
                constexpr float D = 1.0f / W8_SCALE, HS = H8_SCALE / W8_SCALE;
#pragma unroll
                for (int mi = 0; mi < 4; ++mi) {
                    const int rl = wr * 128 + mi * 32 + r;
                    if (cm0 + rl < cne) {
                        float o[16];
#pragma unroll
                        for (int q = 0; q < 16; ++q) o[q] = siluf_(acc[mi][0][q] * D) * (acc[mi][1][q] * HS);
                        u32x4 w; w.x = pk4_fp8(o[0], o[1], o[2], o[3]); w.y = pk4_fp8(o[4], o[5], o[6], o[7]); w.z = pk4_fp8(o[8], o[9], o[10], o[11]); w.w = pk4_fp8(o[12], o[13], o[14], o[15]);
                        *(u32x4*)(H + (long)rl * 256) = w;
                    }
                }
            }
        }
        asm volatile("s_waitcnt vmcnt(0)" ::: "memory"); __syncthreads();
    }
    const int m_lo = xs.m_lo(128), n_t = (PARTS9 & 2) ? (xs.m_hi(128) - m_lo) * 4 : 0;
    for (int u = (xs.j + xs.stride - (ntile * 2) % xs.stride) % xs.stride; u < n_t; u += xs.stride) {
        const int mt = m_lo + (u >> 2), nt = u & 3;
        RingRows al, bl;
        al.init_contig((const bf16_t*)(ws + WS_HS), 256, mt * 256);
        bl.init_contig((const bf16_t*)(ws + WS_WS2), 256, nt * 256, true);
        f32x4 acc[8][4];
        gemm_ring(smem, al, bl, 8, acc);
        __syncthreads();
        epi_store_bf16(acc, (bf16_t*)(ws + WS_SH), 1024, mt * 256, nt * 256);
    }
}

template <int P10V = 0  >
__device__ __forceinline__ void phase10(const Params& p, char* smem, int bid, int nb) {
    char* ws = p.ws;
    XcdSlab xs; xs.init(bid, nb);
    moe_tables(p, smem, xs);
    const int* off = (const int*)(smem + MOE_TAB); const int* tst = off + 256;
    const int* cnt = (const int*)(ws + WS_CNT);
    const int nloc = xs.x >= 0 ? 32 : 256;
    const int ntile = tst[nloc];
    {
        const int* cntl = tst + 260;
        const int nT = ntile;
        const int tid_ = opaque_tid();
        const int lane = tid_ & 63, wid = __builtin_amdgcn_readfirstlane(tid_ >> 6);
        const int wr = wid >> 2, wc = wid & 3, r = lane & 31, h = lane >> 5;
        const int g = (r >> 2) & 3;
        const int c0 = ((2 * h) ^ g) << 4, c1 = ((2 * h + 1) ^ g) << 4;
        const int arow = (wr * 128 + r) * 64;
        const int brow = (wc * 64 + r) * 64;
        char* ringB = smem + 65536;
        for (int t = xs.j; t < nT; t += xs.stride) {
            const int kl = moe_find(tst, nloc, t), e = xs.x >= 0 ? xs.x + 8 * kl : kl, m0 = (t - tst[kl]) * 256, ne = cntl[e];
            RingF8 al, bl;
            al.init_contig((const unsigned char*)(ws + WS_HF8), 256, (long)off[e] + m0);
            bl.init_contig((const unsigned char*)(ws + WS_W2F8), 256, (long)(e * 4) * 256);
            const float* wl = (const float*)(ws + WS_WL) + (long)e * LIST_CAP + m0;
            float* rwl = (float*)(smem + MOE_TAB + 4096);
            if (tid_ < 256) rwl[tid_] = (m0 + tid_ < ne) ? wl[tid_] * (Y8_SCALE / (W8_SCALE * H8_SCALE)) : 0.f;
            unsigned char* Yb = (unsigned char*)(ws + WS_Y) + ((long)off[e] + m0) * 1024 + wc * 64 + h * 16;
#pragma unroll
            for (int ks = 0; ks < 4; ++ks) al.issue(smem + ks * 16384, ks);
            auto issueB = [&](int bt, int stg) {
                const int nt_ = bt >> 2, ks_ = bt & 3;
                char* s = ringB + stg * 16384;
#pragma unroll
                for (int i = 0; i < 2; ++i)
                    __builtin_amdgcn_global_load_lds((glb_u32*)(bl.base + (size_t)(bl.off[i] + (unsigned)(nt_ * 65536 + ks_ * 64))), (lds_u32*)(s + i * 8192 + bl.ldst), 16, 0, 0);
            };
            issueB(0, 0); issueB(1, 1); issueB(2, 2); issueB(3, 3);
            RING_WAIT(6);
            RING_BAR();
            if (wr == 1) RING_BAR();
            f32x16 acc[4][2];
#pragma unroll
            for (int mi = 0; mi < 4; ++mi)
#pragma unroll
                for (int nj = 0; nj < 2; ++nj)
#pragma unroll
                    for (int q = 0; q < 16; ++q) acc[mi][nj][q] = 0.f;
            int sg = 0;
#pragma unroll 1
            for (int bt = 0; bt < 16; ++bt) {
                const char* sa = smem + (bt & 3) * 16384;
                const char* sb = ringB + sg * 16384;
                { const int s4 = sg == 0 ? 4 : sg - 1; if (bt + 4 < 16) issueB(bt + 4, s4); }
                i32x8 bf[2], af[4];
#pragma unroll
                for (int nj = 0; nj < 2; ++nj) bf[nj] = mx_frag(sb + brow + nj * 2048, c0, c1);
#pragma unroll
                for (int mi = 0; mi < 4; ++mi) af[mi] = mx_frag(sa + arow + mi * 2048, c0, c1);
                if (bt + 1 < 16) { if (bt + 4 < 16) RING_WAIT(6); else if (bt + 3 < 16) RING_WAIT(4); else if (bt + 2 < 16) RING_WAIT(2); else RING_WAIT(0); }
                RING_BAR();
                __builtin_amdgcn_s_setprio(1);
                if (P10V != 2) {
#pragma unroll
                for (int mi = 0; mi < 4; ++mi)
#pragma unroll
                    for (int nj = 0; nj < 2; ++nj) acc[mi][nj] = mfma_mx(bf[nj], af[mi], acc[mi][nj]);
                } else { acc[0][0][0] += (float)(af[0][0] + bf[0][0] + af[3][7] + bf[1][3]); }
                __builtin_amdgcn_s_setprio(0);
                if ((bt & 3) == 3) {
                    const int nt_ = bt >> 2;
#pragma unroll
                    for (int mi = 0; mi < 4; ++mi) {
                        const int rl = wr * 128 + mi * 32 + r;
                        if (m0 + rl < ne) {
                            const float w = rwl[rl];
#pragma unroll
                            for (int nj = 0; nj < 2; ++nj) {
                                const f32x16 u = acc[mi][nj] * w;
                                u32x4 v; v.x = pk4_fp8(u[0], u[1], u[2], u[3]); v.y = pk4_fp8(u[4], u[5], u[6], u[7]); v.z = pk4_fp8(u[8], u[9], u[10], u[11]); v.w = pk4_fp8(u[12], u[13], u[14], u[15]);
                                if (P10V != 1) *(u32x4*)(Yb + (long)rl * 1024 + nt_ * 256 + nj * 32) = v; else if (v.x == 0x12345678u) *(u32x4*)(Yb) = v;
                            }
                        }
#pragma unroll
                        for (int nj = 0; nj < 2; ++nj)
#pragma unroll
                            for (int q = 0; q < 16; ++q) acc[mi][nj][q] = 0.f;
                    }
                }
                RING_BAR();
                sg = sg == 4 ? 0 : sg + 1;
            }
            if (wr == 0) RING_BAR();
        }
    }
}

__device__ __forceinline__ void phase11(const Params& p, char* smem, int bid, int nb) {
    char* ws = p.ws;
    XcdSlab xs; xs.init(bid, nb);
    moe_tables(p, smem, xs);
    const int* off = (const int*)(smem + MOE_TAB);
    const int tid = opaque_tid(), lane = tid & 63, wid = tid >> 6;
    const bf16_t* r2 = (const bf16_t*)(ws + WS_R2B);
    const float* st2 = (const float*)(ws + WS_ST2);
    const bf16_t* SH = (const bf16_t*)(ws + WS_SH);
    const unsigned char* Y = (const unsigned char*)(ws + WS_Y);
    const int* sele = (const int*)(ws + WS_SELE); const int* selp = (const int*)(ws + WS_SELP);
    for (int t = bid * 8 + wid; t < T_TOK; t += nb * 8) {
        const f32x4 p0 = *(const f32x4*)(st2 + (long)t * 8), p1 = *(const f32x4*)(st2 + (long)t * 8 + 4);
        const float q1 = (p0[0] + p0[2]) + (p1[0] + p1[2]), q2 = (p0[1] + p0[3]) + (p1[1] + p1[3]);
        const float mean2 = q1 * (1.0f / 1024.0f);
        const float rstd2 = rsqrtf(fmaxf(q2 * (1.0f / 1024.0f) - mean2 * mean2, 0.f) + LN_EPS);
        int yrow[8];
#pragma unroll
        for (int k = 0; k < 8; ++k) yrow[k] = off[sele[(long)t * 8 + k]] + selp[(long)t * 8 + k];
        float v[16];
#pragma unroll
        for (int hseg = 0; hseg < 2; ++hseg) {
            const int col = hseg * 512 + lane * 8;
            const u32x4 ru = *(const u32x4*)(r2 + (long)t * 1024 + col);
            const f32x4 a0 = (f32x4){bf_lo(ru.x), bf_hi(ru.x), bf_lo(ru.y), bf_hi(ru.y)}, a1 = (f32x4){bf_lo(ru.z), bf_hi(ru.z), bf_lo(ru.w), bf_hi(ru.w)};
            const f32x4 g0 = *(const f32x4*)(p.in[I_LN2G] + col), g1 = *(const f32x4*)(p.in[I_LN2G] + col + 4);
            const f32x4 b0 = *(const f32x4*)(p.in[I_LN2B] + col), b1 = *(const f32x4*)(p.in[I_LN2B] + col + 4);
            const f32x4 x0 = ((a0 - mean2) * rstd2 * g0 + b0) * ALPHA, x1 = ((a1 - mean2) * rstd2 * g1 + b1) * ALPHA;
            float* vv = v + hseg * 8;
            vv[0] = x0[0]; vv[1] = x0[1]; vv[2] = x0[2]; vv[3] = x0[3]; vv[4] = x1[0]; vv[5] = x1[1]; vv[6] = x1[2]; vv[7] = x1[3];
            const u32x4 s = __builtin_nontemporal_load((const u32x4*)(SH + (long)t * 1024 + col));
            vv[0] += bf_lo(s.x); vv[1] += bf_hi(s.x); vv[2] += bf_lo(s.y); vv[3] += bf_hi(s.y); vv[4] += bf_lo(s.z); vv[5] += bf_hi(s.z); vv[6] += bf_lo(s.w); vv[7] += bf_hi(s.w);
            f32x2 ys[4];
#pragma unroll
            for (int e2 = 0; e2 < 4; ++e2) ys[e2] = (f32x2){0.f, 0.f};
#pragma unroll
            for (int k = 0; k < 8; ++k) {
                const u32x2 y = __builtin_nontemporal_load((const u32x2*)(Y + (long)yrow[k] * 1024 + col));
                ys[0] += __builtin_amdgcn_cvt_pk_f32_fp8((int)y.x, false); ys[1] += __builtin_amdgcn_cvt_pk_f32_fp8((int)y.x, true);
                ys[2] += __builtin_amdgcn_cvt_pk_f32_fp8((int)y.y, false); ys[3] += __builtin_amdgcn_cvt_pk_f32_fp8((int)y.y, true);
            }
#pragma unroll
            for (int e2 = 0; e2 < 4; ++e2) { vv[2 * e2] += ys[e2][0] * (1.0f / Y8_SCALE); vv[2 * e2 + 1] += ys[e2][1] * (1.0f / Y8_SCALE); }
        }
        float s1 = 0.f;
#pragma unroll
        for (int i = 0; i < 16; ++i) s1 += v[i];
#pragma unroll
        for (int o = 32; o >= 1; o >>= 1) s1 += __shfl_xor(s1, o);
        const float mean = s1 * (1.0f / 1024.0f);
        float s2 = 0.f;
#pragma unroll
        for (int i = 0; i < 16; ++i) { const float d = v[i] - mean; s2 += d * d; }
#pragma unroll
        for (int o = 32; o >= 1; o >>= 1) s2 += __shfl_xor(s2, o);
        const float rstd = rsqrtf(s2 * (1.0f / 1024.0f) + LN_EPS);
#pragma unroll
        for (int hseg = 0; hseg < 2; ++hseg) {
            const int col = hseg * 512 + lane * 8;
            const f32x4 g0 = *(const f32x4*)(p.in[I_LN3G] + col), g1 = *(const f32x4*)(p.in[I_LN3G] + col + 4);
            const f32x4 b0 = *(const f32x4*)(p.in[I_LN3B] + col), b1 = *(const f32x4*)(p.in[I_LN3B] + col + 4);
            const float* vv = v + hseg * 8;
            f32x4 o0, o1;
#pragma unroll
            for (int e = 0; e < 4; ++e) { o0[e] = (vv[e] - mean) * rstd * g0[e] + b0[e]; o1[e] = (vv[4 + e] - mean) * rstd * g1[e] + b1[e]; }
            *(f32x4*)(p.out + (long)t * 1024 + col) = o0; *(f32x4*)(p.out + (long)t * 1024 + col + 4) = o1;
        }
    }
}

#if MEGA
#define XB_TMO      128
#define XB_XCNT(j)  (256  + 64 * (j))
#define XB_XSUB(j)  (1280 + 64 * (j))
#define XB_XGEN(j)  (2304 + 64 * (j))
#define XB_TOP      3328
#define XB_TOPGEN   3392
#define XCD_BAR_WORDS 3456
#define XB_SPIN_CAP (1u << 22)
#define LAS __attribute__((address_space(3)))
__device__ __forceinline__ unsigned xb_ld(unsigned* p)              { return __hip_atomic_load(p, __ATOMIC_RELAXED, __HIP_MEMORY_SCOPE_AGENT); }
__device__ __forceinline__ unsigned xb_add(unsigned* p, unsigned v) { return __hip_atomic_fetch_add(p, v, __ATOMIC_RELAXED, __HIP_MEMORY_SCOPE_AGENT); }
__device__ __forceinline__ unsigned xb_xcc_id() { return (unsigned)__builtin_amdgcn_s_getreg((3 << 11) | 20) & 0xFu; }
#define XB_SPIN(cond, bar) do { unsigned _sp = 0; while (cond) { __builtin_amdgcn_s_sleep(1); \
    if ((++_sp & 255u) == 0u) { if (xb_ld(&(bar)[XB_TMO])) break; if (_sp > XB_SPIN_CAP) { atomicAdd(&(bar)[XB_TMO], 1u); break; } } } } while (0)
struct XcdBarrier { unsigned* bar; unsigned x; volatile LAS unsigned* st; };
__device__ __forceinline__ XcdBarrier xcd_barrier_post(unsigned* bar, volatile LAS unsigned* st) {
    XcdBarrier b; b.bar = bar; b.x = xb_xcc_id(); b.st = st;
    if (threadIdx.x == 0) (void)xb_add(&bar[XB_XCNT(b.x)], 1u);
    return b;
}
__device__ __forceinline__ void xcd_barrier_complete(unsigned* bar, unsigned x, unsigned& nloc, unsigned& nx) {
    const unsigned G = gridDim.x * gridDim.y * gridDim.z;
    unsigned sum, cnt, mine, sp = 0u;
    for (;;) {
        sum = 0u; cnt = 0u; mine = 0u;
#pragma unroll
        for (unsigned j = 0; j < 16; ++j) { const unsigned c = xb_ld(&bar[XB_XCNT(j)]); sum += c; cnt += (c > 0u) ? 1u : 0u; mine = (j == x) ? c : mine; }
        if (sum == G) break;
        __builtin_amdgcn_s_sleep(1);
        if ((++sp & 255u) == 0u) { if (xb_ld(&bar[XB_TMO])) break; if (sp > XB_SPIN_CAP) { atomicAdd(&bar[XB_TMO], 1u); break; } }
    }
    nloc = mine > 0u ? mine : 1u; nx = cnt > 0u ? cnt : 1u;
}
__device__ __forceinline__ void xcd_barrier(const XcdBarrier& b) {
    asm volatile("s_waitcnt vmcnt(0)" ::: "memory");
    __syncthreads();
    if (threadIdx.x == 0) {
        unsigned* bar = b.bar;
        __builtin_amdgcn_s_waitcnt(0);
        unsigned nloc = b.st[0], nx = b.st[1];
        if (nloc == 0u) { xcd_barrier_complete(bar, b.x, nloc, nx); b.st[0] = nloc; b.st[1] = nx; }
        const unsigned old = xb_add(&bar[XB_XSUB(b.x)], 1u);
        const unsigned gen = old / nloc;
        if (old + 1u == (gen + 1u) * nloc) {
            __builtin_amdgcn_fence(__ATOMIC_RELEASE, "agent");
            asm volatile("s_waitcnt vmcnt(0)" ::: "memory");
            const unsigned og = xb_add(&bar[XB_TOP], 1u);
            const unsigned tg = og / nx;
            if (og + 1u == (tg + 1u) * nx) xb_add(&bar[XB_TOPGEN], 1u);
            else XB_SPIN(xb_ld(&bar[XB_TOPGEN]) == tg, bar);
            __builtin_amdgcn_fence(__ATOMIC_ACQUIRE, "agent");
            xb_add(&bar[XB_XGEN(b.x)], 1u);
            asm volatile("s_waitcnt vmcnt(0)" ::: "memory");
        } else {
            XB_SPIN(xb_ld(&bar[XB_XGEN(b.x)]) == gen, bar);
            __builtin_amdgcn_fence(__ATOMIC_ACQUIRE, "agent");
            asm volatile("s_waitcnt vmcnt(0)" ::: "memory");
        }
    }
    __syncthreads();
}
__global__ void __launch_bounds__(NTHR) fwd_mega(Params p) {
    extern __shared__ __attribute__((aligned(16))) char smem[];
    cg::grid_group grid = cg::this_grid();
    const int bid = blockIdx.x, nb = gridDim.x;
    volatile LAS unsigned* xst = (volatile LAS unsigned*)(smem + LDS_BYTES - 16);
    if (threadIdx.x < 4) xst[threadIdx.x] = 0u;
    __syncthreads();
    const XcdBarrier xb = xcd_barrier_post((unsigned*)(p.ws + WS_BAR), xst);
#define GSYNC() xcd_barrier(xb)
#ifndef PROBE_REPEAT
#define PROBE_REPEAT 0
#endif
#define REP(n, call) if (PROBE_REPEAT & (1 << n)) { call; GSYNC(); }
    if (PROBE_REPEAT & 1) { phase0(p, smem, bid, nb); GSYNC(); }
#ifdef PROBE_XCC
    {
        unsigned* rec = (unsigned*)(p.ws + WS_A + 432 * MB);
        if (threadIdx.x == 0) rec[bid] = xb_xcc_id();
        grid.sync();
        int mism = 0, distinct = 0;
        for (int b = 0; b < nb; ++b) { if (rec[b] != rec[b & 7]) ++mism; }
        for (int a = 0; a < 8; ++a) { bool dup = false; for (int b2 = 0; b2 < a; ++b2) dup = dup || (rec[a] == rec[b2]); if (!dup) ++distinct; }
        const float v = sqrtf((float)(PROBE_XCC == 1 ? mism : distinct) + 1.0f);
        for (long i = (long)bid * NTHR + threadIdx.x; i < (long)T_TOK * 1024; i += (long)nb * NTHR) p.out[i] = v;
        return;
    }
#endif
    phase0(p, smem, bid, nb);  grid.sync();
    REP(1, phase1<1>(p, smem, bid, nb))
    phase1(p, smem, bid, nb);  GSYNC();
    REP(2, phase2(p, smem, bid, nb))
    phase2(p, smem, bid, nb);  GSYNC();
#ifndef PROBE_P3PARTS
#define PROBE_P3PARTS 7
#endif
#ifndef PROBE_NSAV
#define PROBE_NSAV 7
#endif
    REP(3, (phase3<PROBE_P3PARTS, PROBE_NSAV>(p, smem, bid, nb, 1)))
    phase3(p, smem, bid, nb);  GSYNC();
    REP(4, phase4(p, smem, bid, nb))
#ifdef PROBE_X
    phase_probe<PROBE_X>(p, smem, bid, nb); GSYNC();
#endif
    phase4(p, smem, bid, nb);  GSYNC();
    REP(5, phase5(p, smem, bid, nb))
    phase5(p, smem, bid, nb);  GSYNC();
    REP(6, phase6(p, smem, bid, nb))
    phase6(p, smem, bid, nb);  GSYNC();
    REP(7, phase7(p, smem, bid, nb))
    phase7(p, smem, bid, nb);  GSYNC();
    REP(8, phase8(p, smem, bid, nb, 1))
    phase8(p, smem, bid, nb);  GSYNC();
#ifndef PROBE_P9PARTS
#define PROBE_P9PARTS 3
#endif
    REP(9, phase9<PROBE_P9PARTS>(p, smem, bid, nb))
    phase9(p, smem, bid, nb);  GSYNC();
#ifndef PROBE_P10V
#define PROBE_P10V 0
#endif
    REP(10, phase10<PROBE_P10V>(p, smem, bid, nb))
    phase10(p, smem, bid, nb); GSYNC();
    REP(11, phase11(p, smem, bid, nb))
    phase11(p, smem, bid, nb);
}
#else
#define PHASE_KERNEL(n) __global__ void __launch_bounds__(NTHR) fwd_phase##n(Params p) { extern __shared__ __attribute__((aligned(16))) char smem[]; phase##n(p, smem, blockIdx.x, gridDim.x); }
PHASE_KERNEL(0) PHASE_KERNEL(1) PHASE_KERNEL(2) PHASE_KERNEL(3) PHASE_KERNEL(4) PHASE_KERNEL(5)
PHASE_KERNEL(6) PHASE_KERNEL(7) PHASE_KERNEL(8) PHASE_KERNEL(9) PHASE_KERNEL(10) PHASE_KERNEL(11)
typedef void (*phase_fn)(Params);
#endif

extern "C" void kernel_launch(void* const* d_in, const int* in_sizes, int n_in, void* d_out, int out_size, void* d_ws, size_t ws_size, hipStream_t stream) {
    Params p{};
    for (int i = 0; i < 32; ++i) p.in[i] = (const float*)d_in[i];
    p.out = (float*)d_out;
    p.ws = (char*)d_ws;
    if (n_in != 32 || ws_size < WS_END) { fprintf(stderr, "kernel_launch: unexpected inputs (n_in %d) or workspace too small (%zu < %zu)\n", n_in, ws_size, (size_t)WS_END); return; }
#if MEGA
    static int grid = 0;
    if (!grid) {
        int dev = 0, cus = 0, per_cu = 0;
        (void)hipGetDevice(&dev);
        (void)hipDeviceGetAttribute(&cus, hipDeviceAttributeMultiprocessorCount, dev);
        (void)hipFuncSetAttribute((const void*)fwd_mega, hipFuncAttributeMaxDynamicSharedMemorySize, LDS_BYTES);
        (void)hipOccupancyMaxActiveBlocksPerMultiprocessor(&per_cu, (const void*)fwd_mega, NTHR, LDS_BYTES);
        if (per_cu < 1) { fprintf(stderr, "kernel_launch: occupancy query says %d blocks/CU\n", per_cu); per_cu = 1; }
        grid = cus;
    }
    (void)hipMemsetAsync((char*)d_ws + WS_BAR, 0, 16384, stream);
    void* args[] = {&p};
    hipError_t e = hipLaunchCooperativeKernel((const void*)fwd_mega, dim3(grid), dim3(NTHR), args, LDS_BYTES, stream);
    if (e != hipSuccess) fprintf(stderr, "cooperative launch failed: %s (grid %d)\n", hipGetErrorString(e), grid);
#else
    static const phase_fn fns[12] = {fwd_phase0, fwd_phase1, fwd_phase2, fwd_phase3, fwd_phase4, fwd_phase5, fwd_phase6, fwd_phase7, fwd_phase8, fwd_phase9, fwd_phase10, fwd_phase11};
    static bool attr = false;
    if (!attr) { for (int i = 0; i < 12; ++i) (void)hipFuncSetAttribute((const void*)fns[i], hipFuncAttributeMaxDynamicSharedMemorySize, LDS_BYTES); attr = true; }
    for (int i = 0; i < 12; ++i) hipLaunchKernelGGL(fns[i], dim3(256), dim3(NTHR), LDS_BYTES, stream, p);
#endif
}
```

```cpp
#include <hip/hip_runtime.h>
#include <hip/hip_cooperative_groups.h>
#include <stdint.h>
#include <stdio.h>
namespace cg = cooperative_groups;

#ifndef MEGA
#define MEGA 1
#endif

typedef unsigned short bf16_t;
typedef short bf16x8 __attribute__((ext_vector_type(8)));
typedef short s16x4 __attribute__((ext_vector_type(4)));
typedef float f32x4 __attribute__((ext_vector_type(4)));
typedef float f32x2 __attribute__((ext_vector_type(2)));
typedef unsigned u32x4 __attribute__((ext_vector_type(4)));
typedef unsigned u32x2 __attribute__((ext_vector_type(2)));
typedef __bf16 bf16x2_t __attribute__((ext_vector_type(2)));

#ifndef INPROJ_F8
#define INPROJ_F8 0
#endif
constexpr int T_TOK = 32768, DM = 1024, NB = 16, SEQ = 2048;
constexpr int PW = 3328;
constexpr int PC_Q = 0, PC_KC = 512, PC_VC = 640, PC_KS = 768, PC_VS = 896, PC_KW = 1024, PC_VW = 1152;
constexpr int PC_MQ = 1280, PC_MK = 1792, PC_MV = 2304, PC_MO = 2816;
constexpr float ALPHA = 1.189207115002721f;
constexpr float LN_EPS = 1e-5f;
constexpr int NTHR = 512;
constexpr int LDS_BYTES = 160 * 1024;
constexpr int NEXP = 256, TOPK = 8;
constexpr float W8_SCALE = 64.0f, H8_SCALE = 16.0f, Y8_SCALE = 64.0f;
constexpr int LIST_CAP = 32768;

constexpr size_t al256(size_t x) { return (x + 255) & ~(size_t)255; }
constexpr size_t WS_WIN = 0;
constexpr size_t WS_WOUT = WS_WIN + al256((size_t)3584 * 1024 * 2);
constexpr size_t WS_WQ = WS_WOUT + (size_t)1024 * 1024 * 2;
constexpr size_t WS_WKV = WS_WQ + (size_t)1024 * 1024 * 2;
constexpr size_t WS_WO = WS_WKV + (size_t)2048 * 1024 * 2;
constexpr size_t WS_WR = WS_WO + (size_t)1024 * 1024 * 2;
constexpr size_t WS_WS13 = WS_WR + (size_t)256 * 1024 * 2;
constexpr size_t WS_WS2 = WS_WS13 + (size_t)512 * 1024 * 2;
constexpr size_t WS_CK1 = WS_WS2 + (size_t)1024 * 256 * 2;
constexpr size_t WS_CK2 = WS_CK1 + (size_t)64 * 2048 * 2;
constexpr size_t WS_CV1 = WS_CK2 + (size_t)64 * 64 * 2;
constexpr size_t WS_CV2 = WS_CV1 + (size_t)64 * 2048 * 2;
constexpr size_t MB = 1024 * 1024;
constexpr size_t WS_LNP = al256(WS_CV2 + (size_t)64 * 64 * 2);
constexpr size_t WS_LNF = WS_LNP + (size_t)2 * 16 * 1792 * 4;
constexpr size_t WS_A = al256(WS_LNF + (size_t)2 * 1792 * 4 + 65536);
constexpr size_t WS_P = WS_A;
constexpr size_t WS_R1 = WS_A;
constexpr size_t WS_XQ = WS_A + 128 * MB;
constexpr size_t WS_XO = WS_A + 192 * MB;
constexpr size_t WS_XB = WS_A + 208 * MB;
constexpr size_t WS_MEMB = WS_A + 272 * MB;
constexpr size_t WS_PSM = WS_A + 280 * MB;
constexpr size_t WS_KCMP = WS_A + 284 * MB;
constexpr size_t WS_VCMP = WS_KCMP + (size_t)16 * 2 * 128 * 64 * 2;
constexpr size_t WS_QK = WS_A + 285 * MB;
constexpr size_t WS_MIX = WS_A + 349 * MB;
constexpr size_t WS_KVX = WS_A + 413 * MB;
constexpr size_t WS_X2F8 = WS_A + 256 * MB;
constexpr size_t WS_X2 = WS_A + 256 * MB;
constexpr size_t WS_HS = WS_A + 320 * MB;
constexpr size_t WS_R1B = WS_A;
constexpr size_t WS_RSC = WS_A;
constexpr size_t WS_Y = WS_A;
constexpr size_t WS_B = WS_A + al256((size_t)(T_TOK * 8 + 256) * 1024 * 2);
constexpr size_t WS_R2B = WS_B;
constexpr size_t WS_R2 = WS_B;
constexpr size_t WS_ST1 = WS_R2 + (size_t)T_TOK * 1024 * 4;
constexpr size_t WS_ST2 = WS_ST1 + (size_t)T_TOK * 8 * 4;
constexpr size_t WS_SH = WS_ST2 + (size_t)T_TOK * 8 * 4;
constexpr size_t WS_SELE = WS_SH + (size_t)T_TOK * 1024 * 2;
constexpr size_t WS_SELP = WS_SELE + (size_t)T_TOK * 8 * 4;
constexpr size_t WS_SELW = WS_SELP + (size_t)T_TOK * 8 * 4;
constexpr size_t WS_CNT = WS_SELW + (size_t)T_TOK * 8 * 4;
constexpr size_t WS_TOKL = WS_CNT + 98304;
constexpr size_t WS_WL = WS_TOKL + (size_t)NEXP * LIST_CAP * 4;
constexpr size_t WS_H = WS_WL + (size_t)NEXP * LIST_CAP * 4;
constexpr size_t WS_HF8 = WS_H;
constexpr size_t WS_W2F8 = WS_H + (size_t)(T_TOK * 8 + 256) * 256;
constexpr size_t WS_BAR = WS_W2F8 + (size_t)256 * 1024 * 256;
constexpr size_t WS_END = WS_BAR + 16384;
static_assert((size_t)T_TOK * PW * 2 <= 208 * MB, "P region");
static_assert(WS_END <= (size_t)1024 * MB, "workspace must fit 1 GiB");

struct Params {
    const float* in[32];
    float* out;
    char* ws;
};

__device__ __forceinline__ unsigned pk_bf16(float lo, float hi) {
    f32x2 v = {lo, hi};
    bf16x2_t r = __builtin_convertvector(v, bf16x2_t);
    return __builtin_bit_cast(unsigned, r);
}
__device__ __forceinline__ float bf_lo(unsigned u) { return __uint_as_float(u << 16); }
__device__ __forceinline__ float bf_hi(unsigned u) { return __uint_as_float(u & 0xffff0000u); }
__device__ __forceinline__ float bf2f(bf16_t h) { return __uint_as_float(((unsigned)h) << 16); }
__device__ __forceinline__ float sigmoidf_(float x) { return __builtin_amdgcn_rcpf(1.0f + __expf(-x)); }
__device__ __forceinline__ float siluf_(float x) { return x * __builtin_amdgcn_rcpf(1.0f + __expf(-x)); }
__device__ __forceinline__ f32x4 mfma16(bf16x8 a, bf16x8 b, f32x4 c) { return __builtin_amdgcn_mfma_f32_16x16x32_bf16(a, b, c, 0, 0, 0); }
__device__ __forceinline__ bf16x8 as_bf16x8(u32x4 v) { return __builtin_bit_cast(bf16x8, v); }

__device__ __forceinline__ float fq_max(float x) {
    auto a = __builtin_amdgcn_permlane16_swap(__float_as_uint(x), __float_as_uint(x), false, false);
    x = __builtin_fmaxf(__uint_as_float(a[0]), __uint_as_float(a[1]));
    auto b = __builtin_amdgcn_permlane32_swap(__float_as_uint(x), __float_as_uint(x), false, false);
    return __builtin_fmaxf(__uint_as_float(b[0]), __uint_as_float(b[1]));
}
__device__ __forceinline__ float fq_sum(float x) {
    auto a = __builtin_amdgcn_permlane16_swap(__float_as_uint(x), __float_as_uint(x), false, false);
    x = __uint_as_float(a[0]) + __uint_as_float(a[1]);
    auto b = __builtin_amdgcn_permlane32_swap(__float_as_uint(x), __float_as_uint(x), false, false);
    return __uint_as_float(b[0]) + __uint_as_float(b[1]);
}
__device__ __forceinline__ int opaque_tid() { int t = threadIdx.x; asm volatile("" : "+v"(t)); return t; }

__device__ __forceinline__ int tile_off(int row, int chunk) { return row * 128 + ((chunk ^ (row & 7)) << 4); }

__device__ __forceinline__ int bperm(int rho) { return (rho & ~31) + 8 * ((rho >> 2) & 3) + 4 * ((rho >> 4) & 1) + (rho & 3); }

typedef __attribute__((address_space(3))) unsigned lds_u32;
typedef __attribute__((address_space(1))) const unsigned glb_u32;

#ifdef PROBE_T
#define TS(i) do { if (threadIdx.x == 0) ((volatile long*)(smem + 163760))[i] = (long)wall_clock64(); } while (0)
#else
#define TS(i) do { } while (0)
#endif
__device__ __forceinline__ long blk_off(int row, int col, int K) { return ((long)(row >> 8) * (K >> 5) + (col >> 5)) * 8192 + (row & 255) * 32 + (col & 31); }
struct LoadBf16Rows {
    const bf16_t* base;
    unsigned off[4];
    int ldst;
    struct Regs { int dummy; };
    __device__ __forceinline__ void init_contig(const bf16_t* b, int ld, int row0) {
        const int tid_ = opaque_tid();
        const int r8 = tid_ >> 3, kc = (tid_ & 7) ^ (r8 & 7);
        ldst = tid_ * 16;
        base = b + (long)row0 * ld;
#pragma unroll
        for (int i = 0; i < 4; ++i) off[i] = (unsigned)((r8 + 64 * i) * ld + kc * 8);
    }
    __device__ __forceinline__ void init_rows(const bf16_t* b, int ld, const int (&rows)[4]) {
        const int tid_ = opaque_tid();
        const int r8 = tid_ >> 3, kc = (tid_ & 7) ^ (r8 & 7);
        ldst = tid_ * 16;
        base = b;
#pragma unroll
        for (int i = 0; i < 4; ++i) off[i] = (unsigned)rows[i] * (unsigned)ld + (unsigned)(kc * 8);
    }
    __device__ __forceinline__ void issue(Regs&, char* s, int kt) const {
#pragma unroll
        for (int i = 0; i < 4; ++i)
            __builtin_amdgcn_global_load_lds((glb_u32*)(base + (size_t)(off[i] + (unsigned)(kt * 64))), (lds_u32*)(s + i * 8192 + ldst), 16, 0, 0);
    }
    __device__ __forceinline__ void commit(const Regs&, char*, int) const {}
};

struct LoadF32KN {
    const float* p;
    int ldn;
    int n, kh;
    struct Regs { float v[32]; };
    __device__ __forceinline__ void issue(Regs& r, char*, int kt) const {
        const float* q = p + (long)kt * 64 * ldn;
#pragma unroll
        for (int j = 0; j < 32; ++j) r.v[j] = q[(long)j * ldn];
    }
    __device__ __forceinline__ void commit(const Regs& r, char* s, int kt) const {
#pragma unroll
        for (int q = 0; q < 4; ++q) {
            u32x4 w;
            w.x = pk_bf16(r.v[8 * q + 0], r.v[8 * q + 1]); w.y = pk_bf16(r.v[8 * q + 2], r.v[8 * q + 3]);
            w.z = pk_bf16(r.v[8 * q + 4], r.v[8 * q + 5]); w.w = pk_bf16(r.v[8 * q + 6], r.v[8 * q + 7]);
            *(u32x4*)(s + tile_off(n, kh * 4 + q)) = w;
        }
    }
};

struct LoadLN {
    LoadBf16Rows raw;
    bf16_t* xbase;
    const float* st;
    const float* gb;
    typedef LoadBf16Rows::Regs Regs;
    __device__ __forceinline__ void issue(Regs& r, char* s, int kt) const { raw.issue(r, s, kt); }
    __device__ __forceinline__ void commit(const Regs&, char* s, int kt) const {
        asm volatile("s_waitcnt vmcnt(0)" ::: "memory");
        const int tid_ = opaque_tid();
        const int r8 = tid_ >> 3, kc = (tid_ & 7) ^ (r8 & 7);
        const f32x4 g0 = *(const f32x4*)(gb + kt * 64 + kc * 8), g1 = *(const f32x4*)(gb + kt * 64 + kc * 8 + 4);
        const f32x4 b0 = *(const f32x4*)(gb + 1024 + kt * 64 + kc * 8), b1 = *(const f32x4*)(gb + 1024 + kt * 64 + kc * 8 + 4);
#pragma unroll
        for (int i = 0; i < 4; ++i) {
            const int row = r8 + 64 * i;
            u32x4* cp = (u32x4*)(s + i * 8192 + tid_ * 16);
            const u32x4 v = *cp;
            const float mean = st[row * 2], rstd = st[row * 2 + 1];
            const f32x4 x0 = (f32x4){bf_lo(v.x), bf_hi(v.x), bf_lo(v.y), bf_hi(v.y)};
            const f32x4 x1 = (f32x4){bf_lo(v.z), bf_hi(v.z), bf_lo(v.w), bf_hi(v.w)};
            const f32x4 y0 = (x0 - mean) * rstd * g0 + b0, y1 = (x1 - mean) * rstd * g1 + b1;
            u32x4 w; w.x = pk_bf16(y0[0], y0[1]); w.y = pk_bf16(y0[2], y0[3]); w.z = pk_bf16(y1[0], y1[1]); w.w = pk_bf16(y1[2], y1[3]);
            *cp = w;
            if (xbase) *(u32x4*)(xbase + (size_t)(row * 1024 + kc * 8 + kt * 64)) = w;
        }
    }
};

constexpr int GEMM_LDS = 131072;
template <class AL, class BL>
__device__ __forceinline__ void gemm_mainloop(char* smem, const AL& al, const BL& bl, int nk, f32x4 (&acc)[8][4]) {
    const int tid_ = opaque_tid();
    const int lane = tid_ & 63, wid = tid_ >> 6;
    const int wr = wid >> 2, wc = wid & 3, fr = lane & 15, fq = lane >> 4;
#pragma unroll
    for (int mi = 0; mi < 8; ++mi)
#pragma unroll
        for (int ni = 0; ni < 4; ++ni) acc[mi][ni] = (f32x4){0.f, 0.f, 0.f, 0.f};
    typename AL::Regs ra; typename BL::Regs rb;
    al.issue(ra, smem, 0); bl.issue(rb, smem + 32768, 0);
    al.commit(ra, smem, 0); bl.commit(rb, smem + 32768, 0);
    __syncthreads();
    for (int kt = 0; kt < nk; ++kt) {
        char* sA = smem + (kt & 1) * 65536; char* sB = sA + 32768;
        char* nA = smem + ((kt + 1) & 1) * 65536; char* nB = nA + 32768;
        if (kt + 1 < nk) { al.issue(ra, nA, kt + 1); bl.issue(rb, nB, kt + 1); }
#pragma unroll
        for (int kk = 0; kk < 2; ++kk) {
            bf16x8 bfr[4];
#pragma unroll
            for (int ni = 0; ni < 4; ++ni) bfr[ni] = *(const bf16x8*)(sB + tile_off(wc * 64 + ni * 16 + fr, kk * 4 + fq));
#pragma unroll
            for (int mi = 0; mi < 8; ++mi) {
                const bf16x8 af = *(const bf16x8*)(sA + tile_off(wr * 128 + mi * 16 + fr, kk * 4 + fq));
#pragma unroll
                for (int ni = 0; ni < 4; ++ni) acc[mi][ni] = mfma16(bfr[ni], af, acc[mi][ni]);
            }
        }
        if (kt + 1 < nk) { al.commit(ra, nA, kt + 1); bl.commit(rb, nB, kt + 1); }
        __syncthreads();
    }
}

__device__ __forceinline__ int swz4(int row) { return (0x78 >> (((row >> 2) & 3) * 2)) & 3; }
struct RingRows {
    const bf16_t* base; unsigned off[2]; int ldst;
    int kstep;
    __device__ __forceinline__ void init_blocked(const bf16_t* b, int K, int row0, bool perm = false) {
        const int tid_ = opaque_tid(); const int r = tid_ >> 2, kc = (tid_ & 3) ^ swz4(r);
        ldst = tid_ * 16; base = b + (long)row0 * K; kstep = 8192;
#pragma unroll
        for (int i = 0; i < 2; ++i) { const int rr = r + 128 * i; off[i] = (unsigned)((perm ? bperm(rr) : rr) * 32 + kc * 8); }
    }
    __device__ __forceinline__ void init_contig(const bf16_t* b, int ld, int row0, bool perm = false) {
        const int tid_ = opaque_tid(); const int r = tid_ >> 2, kc = (tid_ & 3) ^ swz4(r);
        ldst = tid_ * 16; base = b + (long)row0 * ld;
        kstep = 32;
#pragma unroll
        for (int i = 0; i < 2; ++i) { const int rr = r + 128 * i; off[i] = (unsigned)((perm ? bperm(rr) : rr) * ld + kc * 8); }
    }
    __device__ __forceinline__ void init_rows(const bf16_t* b, int ld, const int (&rows)[2]) {
        const int tid_ = opaque_tid(); const int r = tid_ >> 2, kc = (tid_ & 3) ^ swz4(r);
        ldst = tid_ * 16; base = b;
        kstep = 32;
#pragma unroll
        for (int i = 0; i < 2; ++i) off[i] = (unsigned)rows[i] * (unsigned)ld + (unsigned)(kc * 8);
    }
    __device__ __forceinline__ void issue(char* s, int kt) const {
#pragma unroll
        for (int i = 0; i < 2; ++i)
            __builtin_amdgcn_global_load_lds((glb_u32*)(base + (size_t)(off[i] + (unsigned)(kt * kstep))), (lds_u32*)(s + i * 8192 + ldst), 16, 0, 0);
    }
    __device__ __forceinline__ void commit(char*, int) const {}
};
struct RingLN {
    RingRows raw; bf16_t* xbase; const float* st; const float* gb;
    __device__ __forceinline__ void issue(char* s, int kt) const { raw.issue(s, kt); }
    __device__ __forceinline__ void commit(char* s, int kt) const {
        const int tid_ = opaque_tid(); const int r = tid_ >> 2, kc = (tid_ & 3) ^ swz4(r);
        const f32x4 g0 = *(const f32x4*)(gb + kt * 32 + kc * 8), g1 = *(const f32x4*)(gb + kt * 32 + kc * 8 + 4);
        const f32x4 b0 = *(const f32x4*)(gb + 1024 + kt * 32 + kc * 8), b1 = *(const f32x4*)(gb + 1024 + kt * 32 + kc * 8 + 4);
#pragma unroll
        for (int i = 0; i < 2; ++i) {
            const int row = r + 128 * i;
            u32x4* cp = (u32x4*)(s + i * 8192 + tid_ * 16);
            const u32x4 v = *cp;
            const float mean = st[row * 2], rstd = st[row * 2 + 1];
            const f32x4 x0 = (f32x4){bf_lo(v.x), bf_hi(v.x), bf_lo(v.y), bf_hi(v.y)};
            const f32x4 x1 = (f32x4){bf_lo(v.z), bf_hi(v.z), bf_lo(v.w), bf_hi(v.w)};
            const f32x4 y0 = (x0 - mean) * rstd * g0 + b0, y1 = (x1 - mean) * rstd * g1 + b1;
            u32x4 w; w.x = pk_bf16(y0[0], y0[1]); w.y = pk_bf16(y0[2], y0[3]); w.z = pk_bf16(y1[0], y1[1]); w.w = pk_bf16(y1[2], y1[3]);
            *cp = w;
            if (xbase) *(u32x4*)(xbase + (size_t)(row * 1024 + kc * 8 + kt * 32)) = w;
        }
    }
};
#define RING_WAIT(n) asm volatile("s_waitcnt vmcnt(" #n ")" ::: "memory")
#define RING_BAR() do { __builtin_amdgcn_sched_barrier(0); asm volatile("s_waitcnt lgkmcnt(0)" ::: "memory"); __builtin_amdgcn_s_barrier(); asm volatile("" ::: "memory"); __builtin_amdgcn_sched_barrier(0); } while (0)
template <class AL, class BL>
__device__ __forceinline__ void ring_issue3(char* smem, const AL& al, const BL& bl) {
    al.issue(smem, 0); bl.issue(smem + 16384, 0);
    al.issue(smem + 32768, 1); bl.issue(smem + 32768 + 16384, 1);
    al.issue(smem + 65536, 2); bl.issue(smem + 65536 + 16384, 2);
}
template <class AL, class BL, int XMODE = 0  , bool ISSUED = false  >
__device__ __forceinline__ void gemm_ring(char* smem, const AL& al, const BL& bl, int nk  , f32x4 (&acc)[8][4]) {
    const int tid_ = opaque_tid();
    const int lane = tid_ & 63, wid = __builtin_amdgcn_readfirstlane(tid_ >> 6);
    const int wr = wid >> 2, wc = wid & 3, fr = lane & 15, fq = lane >> 4;
#pragma unroll
    for (int mi = 0; mi < 8; ++mi)
#pragma unroll
        for (int ni = 0; ni < 4; ++ni) acc[mi][ni] = (f32x4){0.f, 0.f, 0.f, 0.f};
    const int aoff = (wr * 128 + fr) * 64 + ((fq ^ swz4(fr)) << 4);
    const int boff = 16384 + (wc * 64 + fr) * 64 + ((fq ^ swz4(fr)) << 4);
    if (XMODE != 1) {
    if (!ISSUED) ring_issue3(smem, al, bl);
    RING_WAIT(8);
    al.commit(smem, 0); bl.commit(smem + 16384, 0);
    }
    RING_BAR();
    if (wr == 1) RING_BAR();
    for (int kt = 0; kt < nk; ++kt) {
        const char* st = smem + (kt & 3) * 32768;
        if (XMODE != 1 && kt + 3 < nk) { char* s3 = smem + ((kt + 3) & 3) * 32768; al.issue(s3, kt + 3); bl.issue(s3 + 16384, kt + 3); }
        bf16x8 bfr[4], afr[8];
        if (XMODE != 2) {
#pragma unroll
        for (int ni = 0; ni < 4; ++ni) bfr[ni] = *(const bf16x8*)(st + boff + ni * 1024);
#pragma unroll
        for (int mi = 0; mi < 8; ++mi) afr[mi] = *(const bf16x8*)(st + aoff + mi * 1024);
        }
        if (XMODE != 1 && kt + 1 < nk) {
            if (kt + 3 < nk) RING_WAIT(8); else if (kt + 2 < nk) RING_WAIT(4); else RING_WAIT(0);
            char* s1 = smem + ((kt + 1) & 3) * 32768;
            al.commit(s1, kt + 1); bl.commit(s1 + 16384, kt + 1);
        }
        RING_BAR();
        if (XMODE != 2) {
        __builtin_amdgcn_s_setprio(1);
#pragma unroll
        for (int mi = 0; mi < 8; ++mi)
#pragma unroll
            for (int ni = 0; ni < 4; ++ni) acc[mi][ni] = mfma16(bfr[ni], afr[mi], acc[mi][ni]);
        __builtin_amdgcn_s_setprio(0);
        }
        RING_BAR();
    }
    if (wr == 0) RING_BAR();
}

constexpr int FB_PITCH = 1088, FB_STAGE = 16384 + 32 * FB_PITCH;
struct RingF32B {
    const float* p; int ldn; int ldst;
    __device__ __forceinline__ void init(const float* W, int ld, int srccol4, int tid_) { const int lane = tid_ & 63, wid = tid_ >> 6; p = W + (long)wid * ld + srccol4; ldn = ld; ldst = wid * FB_PITCH + lane * 16; }
    __device__ __forceinline__ void issue(char* sB, int kt) const {
#pragma unroll
        for (int i = 0; i < 4; ++i)
            __builtin_amdgcn_global_load_lds((glb_u32*)(p + (long)(kt * 32 + i * 8) * ldn), (lds_u32*)(sB + i * 8 * FB_PITCH + (i & 1) * 64 + ldst), 16, 0, 0);
    }
};
template <class AL>
__device__ __forceinline__ void gemm_ring_f32b(char* smem, const AL& al, const RingF32B& bl, int nk  , f32x4 (&acc)[8][4]) {
    const int tid_ = opaque_tid();
    const int lane = tid_ & 63, wid = __builtin_amdgcn_readfirstlane(tid_ >> 6);
    const int wr = wid >> 2, wc = wid & 3, fr = lane & 15, fq = lane >> 4;
#pragma unroll
    for (int mi = 0; mi < 8; ++mi)
#pragma unroll
        for (int ni = 0; ni < 4; ++ni) acc[mi][ni] = (f32x4){0.f, 0.f, 0.f, 0.f};
    const int aoff = (wr * 128 + fr) * 64 + ((fq ^ swz4(fr)) << 4);
    const int boff = 16384 + (8 * fq) * FB_PITCH + (fq & 1) * 64 + (wc * 64 + fr) * 4;
    al.issue(smem, 0); bl.issue(smem + 16384, 0);
    al.issue(smem + FB_STAGE, 1); bl.issue(smem + FB_STAGE + 16384, 1);
    RING_WAIT(6);
    RING_BAR();
    if (wr == 1) RING_BAR();
    int s0 = 0;
    for (int kt = 0; kt < nk; ++kt) {
        const char* st = smem + s0 * FB_STAGE;
        const int s1 = s0 == 2 ? 0 : s0 + 1, s2 = s1 == 2 ? 0 : s1 + 1;
        if (kt + 2 < nk) { char* sn = smem + s2 * FB_STAGE; al.issue(sn, kt + 2); bl.issue(sn + 16384, kt + 2); }
        bf16x8 bfr[4], afr[8];
#pragma unroll
        for (int ni = 0; ni < 4; ++ni) {
            float v[8];
#pragma unroll
            for (int j = 0; j < 8; ++j) v[j] = *(const float*)(st + boff + j * FB_PITCH + ni * 64);
            u32x4 w; w.x = pk_bf16(v[0], v[1]); w.y = pk_bf16(v[2], v[3]); w.z = pk_bf16(v[4], v[5]); w.w = pk_bf16(v[6], v[7]);
            bfr[ni] = as_bf16x8(w);
        }
#pragma unroll
        for (int mi = 0; mi < 8; ++mi) afr[mi] = *(const bf16x8*)(st + aoff + mi * 1024);
        if (kt + 1 < nk) { if (kt + 2 < nk) RING_WAIT(6); else RING_WAIT(0); }
        RING_BAR();
        __builtin_amdgcn_s_setprio(1);
#pragma unroll
        for (int mi = 0; mi < 8; ++mi)
#pragma unroll
            for (int ni = 0; ni < 4; ++ni) acc[mi][ni] = mfma16(bfr[ni], afr[mi], acc[mi][ni]);
        __builtin_amdgcn_s_setprio(0);
        RING_BAR();
        s0 = s1;
    }
    if (wr == 0) RING_BAR();
}

__device__ __forceinline__ int bperm32(int rho) { return (rho & ~31) + 16 * ((rho >> 2) & 1) + 4 * ((rho >> 3) & 3) + (rho & 3); }
__device__ __forceinline__ unsigned pk4_fp8(float a, float b, float c, float d) {
    int r = __builtin_amdgcn_cvt_pk_fp8_f32(a, b, 0, false);
    r = __builtin_amdgcn_cvt_pk_fp8_f32(c, d, r, true);
    return (unsigned)r;
}
struct RingF8 {
    const unsigned char* base; unsigned off[2]; int ldst;
    __device__ __forceinline__ void init_contig(const unsigned char* b, int ldb, long row0, bool perm = false) {
        const int tid_ = opaque_tid(); const int r = tid_ >> 2, kc = (tid_ & 3) ^ ((r >> 2) & 3);
        ldst = tid_ * 16; base = b + row0 * ldb;
#pragma unroll
        for (int i = 0; i < 2; ++i) { const int rr = r + 128 * i; off[i] = (unsigned)((perm ? bperm32(rr) : rr) * ldb + kc * 16); }
    }
    __device__ __forceinline__ void init_rows(const unsigned char* b, int ldb, const int (&rows)[2]) {
        const int tid_ = opaque_tid(); const int r = tid_ >> 2, kc = (tid_ & 3) ^ ((r >> 2) & 3);
        ldst = tid_ * 16; base = b;
#pragma unroll
        for (int i = 0; i < 2; ++i) off[i] = (unsigned)rows[i] * (unsigned)ldb + (unsigned)(kc * 16);
    }
    __device__ __forceinline__ void issue(char* s, int kt) const {
#pragma unroll
        for (int i = 0; i < 2; ++i)
            __builtin_amdgcn_global_load_lds((glb_u32*)(base + (size_t)(off[i] + (unsigned)(kt * 64))), (lds_u32*)(s + i * 8192 + ldst), 16, 0, 0);
    }
};
__device__ __forceinline__ void ring_f8_issue3(char* smem, const RingF8& al, const RingF8& bl) {
    al.issue(smem, 0); bl.issue(smem + 16384, 0);
    al.issue(smem + 32768, 1); bl.issue(smem + 32768 + 16384, 1);
    al.issue(smem + 65536, 2); bl.issue(smem + 65536 + 16384, 2);
}
__device__ __forceinline__ void gemm_ring_f8_main(char* smem, const RingF8& al, const RingF8& bl, int nk  , f32x4 (&acc)[8][4]) {
    const int tid_ = opaque_tid();
    const int lane = tid_ & 63, wid = __builtin_amdgcn_readfirstlane(tid_ >> 6);
    const int wr = wid >> 2, wc = wid & 3, fr = lane & 15, fq = lane >> 4;
#pragma unroll
    for (int mi = 0; mi < 8; ++mi)
#pragma unroll
        for (int ni = 0; ni < 4; ++ni) acc[mi][ni] = (f32x4){0.f, 0.f, 0.f, 0.f};
    const int g2 = ((fr >> 2) & 3) << 1;
    const int aoff0 = (wr * 128 + fr) * 64 + ((fq ^ g2) << 3), aoff1 = (wr * 128 + fr) * 64 + (((4 + fq) ^ g2) << 3);
    const int boff0 = 16384 + (wc * 64 + fr) * 64 + ((fq ^ g2) << 3), boff1 = 16384 + (wc * 64 + fr) * 64 + (((4 + fq) ^ g2) << 3);
    RING_WAIT(8);
    RING_BAR();
    if (wr == 1) RING_BAR();
    for (int kt = 0; kt < nk; ++kt) {
        const char* st = smem + (kt & 3) * 32768;
        if (kt + 3 < nk) { char* s3 = smem + ((kt + 3) & 3) * 32768; al.issue(s3, kt + 3); bl.issue(s3 + 16384, kt + 3); }
        long b0[4], b1[4], a0[8], a1[8];
#pragma unroll
        for (int ni = 0; ni < 4; ++ni) { b0[ni] = *(const long*)(st + boff0 + ni * 1024); b1[ni] = *(const long*)(st + boff1 + ni * 1024); }
#pragma unroll
        for (int mi = 0; mi < 8; ++mi) { a0[mi] = *(const long*)(st + aoff0 + mi * 1024); a1[mi] = *(const long*)(st + aoff1 + mi * 1024); }
        if (kt + 1 < nk) { if (kt + 3 < nk) RING_WAIT(8); else if (kt + 2 < nk) RING_WAIT(4); else RING_WAIT(0); }
        RING_BAR();
        __builtin_amdgcn_s_setprio(1);
#pragma unroll
        for (int mi = 0; mi < 8; ++mi)
#pragma unroll
            for (int ni = 0; ni < 4; ++ni) {
                acc[mi][ni] = __builtin_amdgcn_mfma_f32_16x16x32_fp8_fp8(b0[ni], a0[mi], acc[mi][ni], 0, 0, 0);
                acc[mi][ni] = __builtin_amdgcn_mfma_f32_16x16x32_fp8_fp8(b1[ni], a1[mi], acc[mi][ni], 0, 0, 0);
            }
        __builtin_amdgcn_s_setprio(0);
        RING_BAR();
    }
    if (wr == 0) RING_BAR();
}

typedef int i32x8 __attribute__((ext_vector_type(8)));
typedef float f32x16 __attribute__((ext_vector_type(16)));
constexpr int MX_ONE = 0x7f7f7f7f;
__device__ __forceinline__ f32x16 mfma_mx(i32x8 a, i32x8 b, f32x16 c) { return __builtin_amdgcn_mfma_scale_f32_32x32x64_f8f6f4(a, b, c, 0, 0, 0, MX_ONE, 0, MX_ONE); }
__device__ __forceinline__ i32x8 mx_frag(const char* rowp  , int c0off, int c1off) {
    const u32x4 lo = *(const u32x4*)(rowp + c0off), hi = *(const u32x4*)(rowp + c1off);
    return (i32x8){(int)lo.x, (int)lo.y, (int)lo.z, (int)lo.w, (int)hi.x, (int)hi.y, (int)hi.z, (int)hi.w};
}
__device__ __forceinline__ void gemm_ring_mx_main(char* smem, const RingF8& al, const RingF8& bl, int nk  , f32x16 (&acc)[4][2]) {
    const int tid_ = opaque_tid();
    const int lane = tid_ & 63, wid = __builtin_amdgcn_readfirstlane(tid_ >> 6);
    const int wr = wid >> 2, wc = wid & 3, r = lane & 31, h = lane >> 5;
#pragma unroll
    for (int mi = 0; mi < 4; ++mi)
#pragma unroll
        for (int nj = 0; nj < 2; ++nj)
#pragma unroll
            for (int q = 0; q < 16; ++q) acc[mi][nj][q] = 0.f;
    const int g = (r >> 2) & 3;
    const int c0 = ((2 * h) ^ g) << 4, c1 = ((2 * h + 1) ^ g) << 4;
    const int arow = (wr * 128 + r) * 64;
    const int brow = 16384 + (wc * 64 + r) * 64;
    RING_WAIT(8);
    RING_BAR();
    if (wr == 1) RING_BAR();
#pragma unroll 1
    for (int kt = 0; kt < nk; ++kt) {
        const char* st = smem + (kt & 3) * 32768;
        if (kt + 3 < nk) { char* s3 = smem + ((kt + 3) & 3) * 32768; al.issue(s3, kt + 3); bl.issue(s3 + 16384, kt + 3); }
        i32x8 bf[2], af[4];
#pragma unroll
        for (int nj = 0; nj < 2; ++nj) bf[nj] = mx_frag(st + brow + nj * 2048, c0, c1);
#pragma unroll
        for (int mi = 0; mi < 4; ++mi) af[mi] = mx_frag(st + arow + mi * 2048, c0, c1);
        if (kt + 1 < nk) { if (kt + 3 < nk) RING_WAIT(8); else if (kt + 2 < nk) RING_WAIT(4); else RING_WAIT(0); }
        RING_BAR();
        __builtin_amdgcn_s_setprio(1);
#pragma unroll
        for (int mi = 0; mi < 4; ++mi)
#pragma unroll
            for (int nj = 0; nj < 2; ++nj) acc[mi][nj] = mfma_mx(bf[nj], af[mi], acc[mi][nj]);
        __builtin_amdgcn_s_setprio(0);
        RING_BAR();
    }
    if (wr == 0) RING_BAR();
}

__device__ __forceinline__ int bperm16(int rho) { return (rho & ~63) + 16 * ((rho >> 2) & 3) + 4 * ((rho >> 4) & 3) + (rho & 3); }

__device__ __forceinline__ void epi_store_bf16(const f32x4 (&acc)[8][4], bf16_t* out, long ld, int row0, int col0) {
    const int tid_ = opaque_tid();
    const int lane = tid_ & 63, wid = tid_ >> 6;
    const int wr = wid >> 2, wc = wid & 3, fr = lane & 15, fq = lane >> 4;
#pragma unroll
    for (int mi = 0; mi < 8; ++mi) {
        bf16_t* rp = out + (long)(row0 + wr * 128 + mi * 16 + fr) * ld + col0 + wc * 64 + fq * 8;
#pragma unroll
        for (int q = 0; q < 2; ++q) {
            u32x4 w; w.x = pk_bf16(acc[mi][2 * q][0], acc[mi][2 * q][1]); w.y = pk_bf16(acc[mi][2 * q][2], acc[mi][2 * q][3]);
            w.z = pk_bf16(acc[mi][2 * q + 1][0], acc[mi][2 * q + 1][1]); w.w = pk_bf16(acc[mi][2 * q + 1][2], acc[mi][2 * q + 1][3]);
            *(u32x4*)(rp + q * 32) = w;
        }
    }
}

template <bool RES_LN, bool RES_BLK = false  , bool OUT_BLK = false  >
__device__ __forceinline__ void epi_residual(f32x4 (&acc)[8][4], char* smem, const float* resid_f32, const bf16_t* resid_bf16, const float* rstats  ,
                                             const float* g, const float* b, bf16_t* rbout, float* stout  , int row0, int nt) {
    const int tid_ = opaque_tid();
    const int lane = tid_ & 63, wid = tid_ >> 6;
    const int wr = wid >> 2, wc = wid & 3, fr = lane & 15, fq = lane >> 4;
    float* sp = (float*)(smem + 139264);
    const int col0 = nt * 256 + wc * 64 + fq * 8;
#pragma unroll
    for (int mi = 0; mi < 8; ++mi) {
        const int rl = wr * 128 + mi * 16 + fr;
        const long row = row0 + rl;
        float mean = 0.f, rstd = 1.f;
        if (RES_LN) {
            const f32x4 p0 = *(const f32x4*)(rstats + row * 8), p1 = *(const f32x4*)(rstats + row * 8 + 4);
            const float s1 = (p0[0] + p0[2]) + (p1[0] + p1[2]), s2 = (p0[1] + p0[3]) + (p1[1] + p1[3]);
            mean = s1 * (1.0f / 1024.0f);
            const float var = fmaxf(s2 * (1.0f / 1024.0f) - mean * mean, 0.f);
            rstd = rsqrtf(var + LN_EPS);
        }
        float s1 = 0.f, s2 = 0.f;
#pragma unroll
        for (int q = 0; q < 2; ++q) {
            const long o = row * 1024 + col0 + q * 32;
            const long ob = (long)row0 * 1024 + (nt * 8 + wc * 2 + q) * 8192 + rl * 32 + fq * 8;
            f32x4 x0, x1;
            if (RES_LN) {
                const u32x4 u = *(const u32x4*)(resid_bf16 + (RES_BLK ? ob : o));
                x0 = (f32x4){bf_lo(u.x), bf_hi(u.x), bf_lo(u.y), bf_hi(u.y)}; x1 = (f32x4){bf_lo(u.z), bf_hi(u.z), bf_lo(u.w), bf_hi(u.w)};
                x0 = (x0 - mean) * rstd * *(const f32x4*)(g + col0 + q * 32) + *(const f32x4*)(b + col0 + q * 32);
                x1 = (x1 - mean) * rstd * *(const f32x4*)(g + col0 + q * 32 + 4) + *(const f32x4*)(b + col0 + q * 32 + 4);
            } else { x0 = *(const f32x4*)(resid_f32 + o); x1 = *(const f32x4*)(resid_f32 + o + 4); }
            const f32x4 v0 = acc[mi][2 * q] + ALPHA * x0, v1 = acc[mi][2 * q + 1] + ALPHA * x1;
            { u32x4 w; w.x = pk_bf16(v0[0], v0[1]); w.y = pk_bf16(v0[2], v0[3]); w.z = pk_bf16(v1[0], v1[1]); w.w = pk_bf16(v1[2], v1[3]); *(u32x4*)(rbout + (OUT_BLK ? ob : o)) = w; }
            s1 += ((v0[0] + v0[1]) + (v0[2] + v0[3])) + ((v1[0] + v1[1]) + (v1[2] + v1[3]));
            s2 += ((v0[0] * v0[0] + v0[1] * v0[1]) + (v0[2] * v0[2] + v0[3] * v0[3])) + ((v1[0] * v1[0] + v1[1] * v1[1]) + (v1[2] * v1[2] + v1[3] * v1[3]));
        }
        s1 = fq_sum(s1); s2 = fq_sum(s2);
        if (fq == 0) { sp[(rl * 4 + wc) * 2] = s1; sp[(rl * 4 + wc) * 2 + 1] = s2; }
    }
    __syncthreads();
    if (tid_ < 256) {
        const int rl = tid_;
        const float a1 = (sp[rl * 8] + sp[rl * 8 + 2]) + (sp[rl * 8 + 4] + sp[rl * 8 + 6]);
        const float a2 = (sp[rl * 8 + 1] + sp[rl * 8 + 3]) + (sp[rl * 8 + 5] + sp[rl * 8 + 7]);
        *(f32x2*)(stout + ((long)(row0 + rl) * 4 + nt) * 2) = (f32x2){a1, a2};
    }
    __syncthreads();
}

__device__ __forceinline__ void ln_tile_stats(float* st, const float* rstats, int row0) {
    const int tid_ = opaque_tid();
    if (tid_ < 256) {
        const long row = row0 + tid_;
        const f32x4 p0 = *(const f32x4*)(rstats + row * 8), p1 = *(const f32x4*)(rstats + row * 8 + 4);
        const float s1 = (p0[0] + p0[2]) + (p1[0] + p1[2]), s2 = (p0[1] + p0[3]) + (p1[1] + p1[3]);
        const float mean = s1 * (1.0f / 1024.0f);
        const float var = fmaxf(s2 * (1.0f / 1024.0f) - mean * mean, 0.f);
        st[tid_ * 2] = mean; st[tid_ * 2 + 1] = rsqrtf(var + LN_EPS);
    }
}
__device__ __forceinline__ void ln_load_gb(float* gb, const float* g, const float* b) {
    for (int i = opaque_tid(); i < 1024; i += NTHR) { gb[i] = g[i]; gb[1024 + i] = b[i]; }
}


struct XcdSlab {
    int x, j, stride;
    __device__ __forceinline__ void init(int bid, int nb) { if ((nb & 7) == 0) { x = bid & 7; j = bid >> 3; stride = nb >> 3; } else { x = -1; j = bid; stride = nb; } }
    __device__ __forceinline__ int m_lo(int nM) const { return x < 0 ? 0 : (x * nM) >> 3; }
    __device__ __forceinline__ int m_hi(int nM) const { return x < 0 ? nM : ((x + 1) * nM) >> 3; }
};

template <int MAP>
__device__ __forceinline__ void ln_correct(f32x4 (&acc)[8][4], const float* rstats  , int row0, const float* cs, const float* bw, int nt) {
    const int tid_ = opaque_tid();
    const int lane = tid_ & 63, wid = tid_ >> 6;
    const int wr = wid >> 2, wc = wid & 3, fr = lane & 15, fq = lane >> 4;
    float mean[8], rstd[8];
#pragma unroll
    for (int mi = 0; mi < 8; ++mi) {
        const long row = row0 + wr * 128 + mi * 16 + fr;
        const f32x4 p0 = *(const f32x4*)(rstats + row * 8), p1 = *(const f32x4*)(rstats + row * 8 + 4);
        const float s1 = (p0[0] + p0[2]) + (p1[0] + p1[2]), s2 = (p0[1] + p0[3]) + (p1[1] + p1[3]);
        mean[mi] = s1 * (1.0f / 1024.0f);
        rstd[mi] = rsqrtf(fmaxf(s2 * (1.0f / 1024.0f) - mean[mi] * mean[mi], 0.f) + LN_EPS);
    }
#pragma unroll
    for (int ni = 0; ni < 4; ++ni) {
        const int col = MAP == 0 ? nt * 256 + wc * 64 + (ni >> 1) * 32 + fq * 8 + (ni & 1) * 4
                                 : (ni & 1) * 256 + nt * 128 + wc * 32 + fq * 8 + (ni >> 1) * 4;
        const f32x4 c4 = *(const f32x4*)(cs + col), b4 = *(const f32x4*)(bw + col);
#pragma unroll
        for (int mi = 0; mi < 8; ++mi) acc[mi][ni] = (acc[mi][ni] - mean[mi] * c4) * rstd[mi] + b4;
    }
}

__device__ __forceinline__ void epi_store_bf16_mx(const f32x16 (&acc)[4][2], float scale, bf16_t* out, long ld, int row0, int col0) {
    const int tid_ = opaque_tid();
    const int lane = tid_ & 63, wid = tid_ >> 6;
    const int wr = wid >> 2, wc = wid & 3, r = lane & 31, h = lane >> 5;
#pragma unroll
    for (int mi = 0; mi < 4; ++mi) {
        bf16_t* rp = out + (long)(row0 + wr * 128 + mi * 32 + r) * ld + col0 + wc * 64 + h * 16;
#pragma unroll
        for (int nj = 0; nj < 2; ++nj) {
            const f32x16 v = acc[mi][nj] * scale;
            u32x4 w0, w1;
            w0.x = pk_bf16(v[0], v[1]); w0.y = pk_bf16(v[2], v[3]); w0.z = pk_bf16(v[4], v[5]); w0.w = pk_bf16(v[6], v[7]);
            w1.x = pk_bf16(v[8], v[9]); w1.y = pk_bf16(v[10], v[11]); w1.z = pk_bf16(v[12], v[13]); w1.w = pk_bf16(v[14], v[15]);
            *(u32x4*)(rp + nj * 32) = w0; *(u32x4*)(rp + nj * 32 + 8) = w1;
        }
    }
}
struct TJob { const float* src; int ldsrc; int K; int col0; int ncols; bf16_t* dst; int mode; int rowoff; int f8;   int blk;   const float* g; const float* b; float* part;   };
__device__ __forceinline__ int tjob_row(const TJob& j, int c) {
    if (j.mode == 0) return j.rowoff + c;
    const int oc = c & 127;
    return 256 * (c >> 7) + 64 * (oc >> 5) + 16 * (2 * ((oc >> 2) & 1) + j.rowoff) + 4 * ((oc >> 3) & 3) + (oc & 3);
}
__device__ __forceinline__ void transpose_tile(char* smem, const TJob& j, int kt, int ct) {
    float* tile = (float*)smem;
    float* red = tile + 64 * 65;
    const int tid = opaque_tid();
    float scs = 0.f, sbw = 0.f;
#pragma unroll
    for (int i = 0; i < 8; ++i) {
        const int e = tid + i * NTHR, kr = e >> 6, c = e & 63;
        const int cc = ct * 64 + c;
        float v = 0.f;
        if (cc < j.ncols) v = j.src[(long)(kt * 64 + kr) * j.ldsrc + j.col0 + cc];
        if (j.g) {
            const float gv = j.g[kt * 64 + kr], bv = j.b[kt * 64 + kr];
            sbw += bv * v;
            v *= gv;
            scs += __uint_as_float(pk_bf16(v, 0.f) << 16);
        }
        tile[kr * 65 + c] = v;
    }
    if (j.g) { red[(tid >> 6) * 64 + (tid & 63)] = scs; red[512 + (tid >> 6) * 64 + (tid & 63)] = sbw; }
    __syncthreads();
    if (j.f8) {
#pragma unroll
        for (int i = 0; i < 2; ++i) {
            const int e = tid + i * NTHR, c = e >> 4, k4 = (e & 15) * 4;
            const int cc = ct * 64 + c;
            if (cc < j.ncols) {
                const unsigned w = pk4_fp8(tile[k4 * 65 + c] * W8_SCALE, tile[(k4 + 1) * 65 + c] * W8_SCALE, tile[(k4 + 2) * 65 + c] * W8_SCALE, tile[(k4 + 3) * 65 + c] * W8_SCALE);
                *(unsigned*)((unsigned char*)j.dst + (long)tjob_row(j, cc) * j.K + kt * 64 + k4) = w;
            }
        }
    } else {
#pragma unroll
    for (int i = 0; i < 4; ++i) {
        const int e = tid + i * NTHR, c = e >> 5, k2 = (e & 31) * 2;
        const int cc = ct * 64 + c;
        if (cc < j.ncols) {
            const unsigned w = pk_bf16(tile[k2 * 65 + c], tile[(k2 + 1) * 65 + c]);
            const int rr = tjob_row(j, cc);
            *(unsigned*)(j.dst + (j.blk ? blk_off(rr, kt * 64 + k2, j.K) : (long)rr * j.K + kt * 64 + k2)) = w;
        }
    }
    }
    if (j.g && tid < 128) {
        const int which = tid >> 6, c = tid & 63;
        float s = 0.f;
#pragma unroll
        for (int w = 0; w < 8; ++w) s += red[which * 512 + w * 64 + c];
        if (ct * 64 + c < j.ncols) j.part[(long)(which * 16 + kt) * 1792 + ct * 64 + c] = s;
    }
    __syncthreads();
}

__device__ __forceinline__ void tjob_run(int& g_rot, char* smem, int bid, int nb, const float* src, int ld, int K, int col0, int ncols, bf16_t* dst, int mode, int rowoff,
                                         const float* g = nullptr, const float* b = nullptr, float* part = nullptr, int f8 = 0, int blk = 0) {
    TJob j; j.f8 = f8; j.blk = blk; j.src = src; j.ldsrc = ld; j.K = K; j.col0 = col0; j.ncols = ncols; j.dst = dst; j.mode = mode; j.rowoff = rowoff; j.g = g; j.b = b; j.part = part;
    const int nkt = K / 64, nct = (ncols + 63) / 64, ntile = nkt * nct;
    const int first = (bid + nb - g_rot % nb) % nb;
    for (int t = first; t < ntile; t += nb) transpose_tile(smem, j, t % nkt, t / nkt);
    g_rot += ntile;
}

__device__ __forceinline__ void cvt_rows_bf16(const float* src, bf16_t* dst, long n8, int bid, int nb) {
    for (long i = (long)bid * NTHR + opaque_tid(); i < n8; i += (long)nb * NTHR) {
        const f32x4 a = __builtin_nontemporal_load((const f32x4*)(src + i * 8)), b = __builtin_nontemporal_load((const f32x4*)(src + i * 8 + 4));
        u32x4 w; w.x = pk_bf16(a[0], a[1]); w.y = pk_bf16(a[2], a[3]); w.z = pk_bf16(b[0], b[1]); w.w = pk_bf16(b[2], b[3]);
        *(u32x4*)(dst + i * 8) = w;
    }
}

__device__ __forceinline__ void cvt_rows_bf16_blk(const float* src, bf16_t* dst, long n8, int bid, int nb) {
    for (long d = (long)bid * NTHR + opaque_tid(); d < n8; d += (long)nb * NTHR) {
        const long tile = d >> 15; const int kb = (int)(d >> 10) & 31, r = (int)(d >> 2) & 255, c8 = (int)d & 3;
        const float* s = src + ((tile * 256 + r) * 1024 + kb * 32 + c8 * 8);
        const f32x4 a = __builtin_nontemporal_load((const f32x4*)s), b = __builtin_nontemporal_load((const f32x4*)(s + 4));
        u32x4 w; w.x = pk_bf16(a[0], a[1]); w.y = pk_bf16(a[2], a[3]); w.z = pk_bf16(b[0], b[1]); w.w = pk_bf16(b[2], b[3]);
        *(u32x4*)(dst + d * 8) = w;
    }
}

enum { I_X = 0, I_MEM, I_WIN, I_POSK, I_CKW1, I_CKW2, I_POSV, I_CVW1, I_CVW2, I_CONVW, I_IBIAS, I_FBIAS, I_NORMG, I_WOUT, I_LN1G, I_LN1B,
       I_XAWQ, I_XAWK, I_XAWV, I_XAWO, I_LN2G, I_LN2B, I_ROUTW, I_ROUTB, I_MW1, I_MW3, I_MW2, I_SW1, I_SW3, I_SW2, I_LN3G, I_LN3B };

__device__ __forceinline__ void phase0(const Params& p, char* smem, int bid, int nb) {
    char* ws = p.ws;
    int rot = 0;
    tjob_run(rot, smem, bid, nb, p.in[I_WIN], 3360, 1024, 0, 1280, (bf16_t*)(ws + WS_WIN), 0, 0, nullptr, nullptr, nullptr, INPROJ_F8, !INPROJ_F8);
    tjob_run(rot, smem, bid, nb, p.in[I_WIN], 3360, 1024, 1304, 2048, (bf16_t*)(ws + WS_WIN), 0, 1280, nullptr, nullptr, nullptr, INPROJ_F8, !INPROJ_F8);
    tjob_run(rot, smem, bid, nb, p.in[I_WIN], 3360, 1024, 1280, 24, (bf16_t*)(ws + WS_WIN), 0, 3328, nullptr, nullptr, nullptr, INPROJ_F8, !INPROJ_F8);
    tjob_run(rot, smem, bid, nb, p.in[I_WIN], 3360, 1024, 3352, 8, (bf16_t*)(ws + WS_WIN), 0, 3352, nullptr, nullptr, nullptr, INPROJ_F8, !INPROJ_F8);
    tjob_run(rot, smem, bid, nb, p.in[I_WOUT], 1024, 1024, 0, 1024, (bf16_t*)(ws + WS_WOUT), 0, 0, nullptr, nullptr, nullptr, 0, 1);
    float* lnp = (float*)(ws + WS_LNP);
    tjob_run(rot, smem, bid, nb, p.in[I_XAWQ], 1024, 1024, 0, 1024, (bf16_t*)(ws + WS_WQ), 0, 0, p.in[I_LN1G], p.in[I_LN1B], lnp, 0, 1);
    tjob_run(rot, smem, bid, nb, p.in[I_XAWK], 1024, 1024, 0, 1024, (bf16_t*)(ws + WS_WKV), 0, 0, nullptr, nullptr, nullptr, 0, 1);
    tjob_run(rot, smem, bid, nb, p.in[I_XAWV], 1024, 1024, 0, 1024, (bf16_t*)(ws + WS_WKV), 0, 1024, nullptr, nullptr, nullptr, 0, 1);
    tjob_run(rot, smem, bid, nb, p.in[I_XAWO], 1024, 1024, 0, 1024, (bf16_t*)(ws + WS_WO), 0, 0);
    tjob_run(rot, smem, bid, nb, p.in[I_ROUTW], 256, 1024, 0, 256, (bf16_t*)(ws + WS_WR), 0, 0, p.in[I_LN2G], p.in[I_LN2B], lnp + 1024);
    tjob_run(rot, smem, bid, nb, p.in[I_SW1], 256, 1024, 0, 256, (bf16_t*)(ws + WS_WS13), 1, 0, p.in[I_LN2G], p.in[I_LN2B], lnp + 1280);
    tjob_run(rot, smem, bid, nb, p.in[I_SW3], 256, 1024, 0, 256, (bf16_t*)(ws + WS_WS13), 1, 1, p.in[I_LN2G], p.in[I_LN2B], lnp + 1536);
    tjob_run(rot, smem, bid, nb, p.in[I_SW2], 1024, 256, 0, 1024, (bf16_t*)(ws + WS_WS2), 0, 0);
    tjob_run(rot, smem, bid, nb, p.in[I_CKW1], 64, 2048, 0, 64, (bf16_t*)(ws + WS_CK1), 0, 0);
    tjob_run(rot, smem, bid, nb, p.in[I_CKW2], 64, 64, 0, 64, (bf16_t*)(ws + WS_CK2), 0, 0);
    tjob_run(rot, smem, bid, nb, p.in[I_CVW1], 64, 2048, 0, 64, (bf16_t*)(ws + WS_CV1), 0, 0);
    tjob_run(rot, smem, bid, nb, p.in[I_CVW2], 64, 64, 0, 64, (bf16_t*)(ws + WS_CV2), 0, 0);
#if INPROJ_F8
    for (long i = (long)bid * NTHR + opaque_tid(); i < (long)T_TOK * 1024 / 8; i += (long)nb * NTHR) {
        const f32x4 a = *(const f32x4*)(p.in[I_X] + i * 8), b = *(const f32x4*)(p.in[I_X] + i * 8 + 4);
        u32x2 w; w.x = pk4_fp8(a[0], a[1], a[2], a[3]); w.y = pk4_fp8(b[0], b[1], b[2], b[3]);
        *(u32x2*)((unsigned char*)(ws + WS_XB) + i * 8) = w;
    }
#else
    cvt_rows_bf16_blk(p.in[I_X], (bf16_t*)(ws + WS_XB), (long)T_TOK * 1024 / 8, bid, nb);
#endif
    cvt_rows_bf16_blk(p.in[I_MEM], (bf16_t*)(ws + WS_MEMB), (long)4096 * 1024 / 8, bid, nb);
    { int* c = (int*)(ws + WS_CNT); for (int i = bid * NTHR + opaque_tid(); i < 24576; i += nb * NTHR) c[i] = 0; }
}

__device__ __forceinline__ void small_cols_task(const Params& p, int task) {
    const bf16_t* xb = (const bf16_t*)(p.ws + WS_XB);
    const bf16_t* wt = (const bf16_t*)(p.ws + WS_WIN) + (long)3328 * 1024;
    float* psm = (float*)(p.ws + WS_PSM);
    const int tid_ = opaque_tid();
    const int lane = tid_ & 63, wid = tid_ >> 6, fr = lane & 15, fq = lane >> 4;
    const int r0 = task * 256 + wid * 32;
    f32x4 acc[2][2];
#pragma unroll
    for (int mi = 0; mi < 2; ++mi)
#pragma unroll
        for (int ni = 0; ni < 2; ++ni) acc[mi][ni] = (f32x4){0.f, 0.f, 0.f, 0.f};
    const bf16_t* ap0 = xb + (long)(r0 + fr) * 1024 + fq * 8;
    const bf16_t* ap1 = ap0 + 16 * 1024;
    const bf16_t* bp0 = wt + (long)fr * 1024 + fq * 8;
    const bf16_t* bp1 = bp0 + 16 * 1024;
#pragma unroll 4
    for (int ks = 0; ks < 32; ++ks) {
        const bf16x8 a0 = *(const bf16x8*)(ap0 + ks * 32), a1 = *(const bf16x8*)(ap1 + ks * 32);
        const bf16x8 b0 = *(const bf16x8*)(bp0 + ks * 32), b1 = *(const bf16x8*)(bp1 + ks * 32);
        acc[0][0] = mfma16(b0, a0, acc[0][0]); acc[0][1] = mfma16(b1, a0, acc[0][1]);
        acc[1][0] = mfma16(b0, a1, acc[1][0]); acc[1][1] = mfma16(b1, a1, acc[1][1]);
    }
#pragma unroll
    for (int mi = 0; mi < 2; ++mi)
#pragma unroll
        for (int ni = 0; ni < 2; ++ni) *(f32x4*)(psm + (long)(r0 + mi * 16 + fr) * 32 + ni * 16 + fq * 4) = acc[mi][ni];
}

template <int NOEPI = 0>
__device__ __forceinline__ void phase1(const Params& p, char* smem, int bid, int nb) {
    char* ws = p.ws;
    XcdSlab xs; xs.init(bid, nb);
    const int a_lo = xs.m_lo(128), a_nm = xs.m_hi(128) - a_lo, a_n = a_nm * 14;
    const int b_lo = xs.m_lo(16), b_nm = xs.m_hi(16) - b_lo, b_n = b_nm * 8;
#if INPROJ_F8
    {
        int mt = 0, nt = 0;
        RingF8 al, bl;
        auto setup = [&](int u) {
            mt = a_lo + u % a_nm; nt = u / a_nm;
            al.init_contig((const unsigned char*)(ws + WS_XB), 1024, (long)mt * 256);
            bl.init_contig((const unsigned char*)(ws + WS_WIN), 1024, (long)nt * 256, true);
        };
        int u = xs.j;
        if (u < a_n) { setup(u); ring_f8_issue3(smem, al, bl); }
        while (u < a_n) {
            const int cmt = mt, cnt_ = nt;
            f32x16 acc[4][2];
            gemm_ring_mx_main(smem, al, bl, 16, acc);
            u += xs.stride;
            if (u < a_n) { setup(u); ring_f8_issue3(smem, al, bl); }
            if (NOEPI) { float s = 0.f;
#pragma unroll
                for (int mi = 0; mi < 4; ++mi) s += acc[mi][0][0] + acc[mi][1][5];
                if (s == 123.456f) ((float*)(ws + WS_A + 432 * MB))[opaque_tid()] = s; continue; }
            if (cnt_ < 13) epi_store_bf16_mx(acc, 1.0f / W8_SCALE, (bf16_t*)(ws + WS_P), PW, cmt * 256, cnt_ * 256);
            else {
                const int tid_ = opaque_tid();
                const int lane = tid_ & 63, wid = tid_ >> 6, wr = wid >> 2, wc = wid & 3, r = lane & 31, h = lane >> 5;
                if (wc == 0) {
                    float* psm = (float*)(ws + WS_PSM);
#pragma unroll
                    for (int mi = 0; mi < 4; ++mi) {
                        const f32x16 v = acc[mi][0] * (1.0f / W8_SCALE);
                        float* rp = psm + (long)(cmt * 256 + wr * 128 + mi * 32 + r) * 32 + h * 16;
#pragma unroll
                        for (int q4 = 0; q4 < 4; ++q4) *(f32x4*)(rp + q4 * 4) = (f32x4){v[q4 * 4], v[q4 * 4 + 1], v[q4 * 4 + 2], v[q4 * 4 + 3]};
                    }
                }
            }
        }
        asm volatile("s_waitcnt vmcnt(0)" ::: "memory"); __syncthreads();
    }
    const int a_n2 = 0;
#else
    const int a_n2 = a_n;
#endif
    bool inp = false; int mt = 0, nt = 0;
    RingRows al, bl;
    auto setup = [&](int u) {
        inp = u < a_n2;
        const int uu = inp ? u : u - a_n2;
        const int nm = inp ? a_nm : b_nm;
        if (inp && (a_nm & 3) == 0) {
            const int per_mblk = 4 * 14, mblk = uu / per_mblk, rr = uu % per_mblk;
            const int ngrp = rr >> 5, r32 = rr & 31;
            mt = a_lo + mblk * 4 + (r32 & 3); nt = ngrp * 8 + (r32 >> 2);
        } else { mt = (inp ? a_lo : b_lo) + uu % nm; nt = uu / nm; }
        al.init_blocked((const bf16_t*)(ws + (inp ? WS_XB : WS_MEMB)), 1024, mt * 256);
        bl.init_blocked((const bf16_t*)(ws + (inp ? WS_WIN : WS_WKV)), 1024, nt * 256, true);
    };
    int u = xs.j;
    if (u < a_n2 + b_n) { setup(u); ring_issue3(smem, al, bl); }
    while (u < a_n2 + b_n) {
        const bool cinp = inp; const int cmt = mt, cnt_ = nt;
        f32x4 acc[8][4];
        gemm_ring<RingRows, RingRows, 0, true>(smem, al, bl, 32, acc);
        u += xs.stride;
        if (u < a_n2 + b_n) { setup(u); ring_issue3(smem, al, bl); }
        if (NOEPI) { float s = 0.f;
#pragma unroll
            for (int mi = 0; mi < 8; ++mi)
#pragma unroll
                for (int ni = 0; ni < 4; ++ni) s += acc[mi][ni][0] + acc[mi][ni][1] + acc[mi][ni][2] + acc[mi][ni][3];
            if (s == 123.456f) ((float*)(ws + WS_A + 432 * MB))[opaque_tid()] = s; continue; }
        if (!cinp) epi_store_bf16(acc, (bf16_t*)(ws + WS_KVX), 2048, cmt * 256, cnt_ * 256);
        else if (cnt_ < 13) epi_store_bf16(acc, (bf16_t*)(ws + WS_P), PW, cmt * 256, cnt_ * 256);
        else {
            const int tid_ = opaque_tid();
            const int lane = tid_ & 63, wid = tid_ >> 6, wr = wid >> 2, wc = wid & 3, fr = lane & 15, fq = lane >> 4;
            if (wc == 0) {
                float* psm = (float*)(ws + WS_PSM);
#pragma unroll
                for (int mi = 0; mi < 8; ++mi)
#pragma unroll
                    for (int ni = 0; ni < 2; ++ni) *(f32x4*)(psm + (long)(cmt * 256 + wr * 128 + mi * 16 + fr) * 32 + fq * 8 + ni * 4) = acc[mi][ni];
            }
        }
    }
    asm volatile("s_waitcnt vmcnt(0)" ::: "memory");
}

__device__ __forceinline__ void compress_task(const Params& p, char* smem, int which, int rb) {
    const char* ws = p.ws;
    const bf16_t* P = (const bf16_t*)(ws + WS_P);
    const float* pos = p.in[which ? I_POSV : I_POSK];
    const bf16_t* w1t = (const bf16_t*)(ws + (which ? WS_CV1 : WS_CK1));
    const bf16_t* w2t = (const bf16_t*)(ws + (which ? WS_CV2 : WS_CK2));
    bf16_t* outp = (bf16_t*)(p.ws + (which ? WS_VCMP : WS_KCMP));
    const int colbase = which ? PC_VC : PC_KC;
    const int tid_ = opaque_tid();
    const int lane = tid_ & 63, wid = tid_ >> 6, fr = lane & 15, fq = lane >> 4;
    f32x4 acc[2][4];
#pragma unroll
    for (int mi = 0; mi < 2; ++mi)
#pragma unroll
        for (int ni = 0; ni < 4; ++ni) acc[mi][ni] = (f32x4){0.f, 0.f, 0.f, 0.f};
    const bf16_t* arow[2];
#pragma unroll
    for (int mi = 0; mi < 2; ++mi) {
        const int r = rb * 32 + mi * 16 + fr;
        const int b = r / 254, rem = r - b * 254, c = rem >> 1, g = rem & 1;
        arow[mi] = P + (long)(b * 2048 + c * 16) * PW + colbase + g * 64 + fq * 8;
    }
    const bf16_t* brow = w1t + (long)fr * 2048 + fq * 8;
    const float* prow = pos + fq * 8;
#pragma unroll 2
    for (int s = 0; s < 8; ++s) {
        const int ks = wid * 8 + s;
        const int l = ks >> 1, d0 = (ks & 1) * 32;
        const f32x4 p0 = *(const f32x4*)(prow + l * 64 + d0), p1 = *(const f32x4*)(prow + l * 64 + d0 + 4);
        bf16x8 af[2];
#pragma unroll
        for (int mi = 0; mi < 2; ++mi) {
            const u32x4 av = *(const u32x4*)(arow[mi] + (long)l * PW + d0);
            u32x4 aw;
            aw.x = pk_bf16(bf_lo(av.x) + p0[0], bf_hi(av.x) + p0[1]); aw.y = pk_bf16(bf_lo(av.y) + p0[2], bf_hi(av.y) + p0[3]);
            aw.z = pk_bf16(bf_lo(av.z) + p1[0], bf_hi(av.z) + p1[1]); aw.w = pk_bf16(bf_lo(av.w) + p1[2], bf_hi(av.w) + p1[3]);
            af[mi] = as_bf16x8(aw);
        }
#pragma unroll
        for (int ni = 0; ni < 4; ++ni) {
            const bf16x8 bb = *(const bf16x8*)(brow + (long)(ni * 16) * 2048 + ks * 32);
            acc[0][ni] = mfma16(bb, af[0], acc[0][ni]);
            acc[1][ni] = mfma16(bb, af[1], acc[1][ni]);
        }
    }
    f32x4* part = (f32x4*)(smem + 8192);
#pragma unroll
    for (int mi = 0; mi < 2; ++mi)
#pragma unroll
        for (int ni = 0; ni < 4; ++ni) part[(wid * 8 + mi * 4 + ni) * 64 + lane] = acc[mi][ni];
    __syncthreads();
    const int mi = wid >> 2, ni = wid & 3;
    f32x4 a1 = (f32x4){0.f, 0.f, 0.f, 0.f};
#pragma unroll
    for (int w = 0; w < 8; ++w) a1 = a1 + part[(w * 8 + wid) * 64 + lane];
    bf16_t* h1 = (bf16_t*)smem;
    {
        u32x2 w; w.x = pk_bf16(siluf_(a1[0]), siluf_(a1[1])); w.y = pk_bf16(siluf_(a1[2]), siluf_(a1[3]));
        *(u32x2*)(h1 + (mi * 16 + fr) * 72 + ni * 16 + fq * 4) = w;
    }
    __syncthreads();
    f32x4 acc2 = (f32x4){0.f, 0.f, 0.f, 0.f};
#pragma unroll
    for (int ks = 0; ks < 2; ++ks) {
        const bf16x8 a = *(const bf16x8*)(h1 + (mi * 16 + fr) * 72 + ks * 32 + fq * 8);
        const bf16x8 bb = *(const bf16x8*)(w2t + (ni * 16 + fr) * 64 + ks * 32 + fq * 8);
        acc2 = mfma16(bb, a, acc2);
    }
    {
        const int r = rb * 32 + mi * 16 + fr;
        const int b = r / 254, rem = r - b * 254, c = rem >> 1, g = rem & 1;
        u32x2 w; w.x = pk_bf16(acc2[0], acc2[1]); w.y = pk_bf16(acc2[2], acc2[3]);
        *(u32x2*)(outp + ((long)(b * 2 + g) * 128 + c) * 64 + ni * 16 + fq * 4) = w;
    }
    __syncthreads();
}

__device__ __forceinline__ void phase2(const Params& p, char* smem, int bid, int nb) {
    char* ws = p.ws;
    {
        const int idx = bid * NTHR + opaque_tid();
        if (idx < 2 * 1792) {
            const float* pp = (const float*)(ws + WS_LNP) + (long)(idx / 1792) * 16 * 1792 + idx % 1792;
            float s = 0.f;
#pragma unroll
            for (int k = 0; k < 16; ++k) s += pp[k * 1792];
            ((float*)(ws + WS_LNF))[idx] = s;
        }
    }
    for (int t = bid; t < 254; t += nb) compress_task(p, smem, t / 127, t % 127);
    const int tid_ = opaque_tid();
    if (bid < 32 && tid_ < 32) {
        bf16_t* kc = (bf16_t*)(ws + WS_KCMP) + ((long)bid * 128 + 127) * 64;
        bf16_t* vc = (bf16_t*)(ws + WS_VCMP) + ((long)bid * 128 + 127) * 64;
        ((unsigned*)kc)[tid_] = 0u; ((unsigned*)vc)[tid_] = 0u;
    }
    const bf16_t* P = (const bf16_t*)(ws + WS_P);
    const float* cw = p.in[I_CONVW];
    bf16_t* qk = (bf16_t*)(ws + WS_QK);
    for (long it = (long)bid * NTHR + tid_; it < (long)T_TOK * 128; it += (long)nb * NTHR) {
        const int t = (int)(it >> 7), ch = (int)(it & 127);
        const int s = t & (SEQ - 1);
        float a[8];
#pragma unroll
        for (int e = 0; e < 8; ++e) a[e] = 0.f;
#pragma unroll
        for (int j = 0; j < 4; ++j) {
            if (s - 3 + j >= 0) {
                const u32x4 u = *(const u32x4*)(P + (long)(t - 3 + j) * PW + PC_MQ + ch * 8);
                const f32x4 w0 = *(const f32x4*)(cw + j * 1024 + ch * 8), w1 = *(const f32x4*)(cw + j * 1024 + ch * 8 + 4);
                a[0] += w0[0] * bf_lo(u.x); a[1] += w0[1] * bf_hi(u.x); a[2] += w0[2] * bf_lo(u.y); a[3] += w0[3] * bf_hi(u.y);
                a[4] += w1[0] * bf_lo(u.z); a[5] += w1[1] * bf_hi(u.z); a[6] += w1[2] * bf_lo(u.w); a[7] += w1[3] * bf_hi(u.w);
            }
        }
        const float sc = ch < 64 ? 0.08838834764831845f : 1.0f;
        u32x4 w;
        w.x = pk_bf16(siluf_(a[0]) * sc, siluf_(a[1]) * sc); w.y = pk_bf16(siluf_(a[2]) * sc, siluf_(a[3]) * sc);
        w.z = pk_bf16(siluf_(a[4]) * sc, siluf_(a[5]) * sc); w.w = pk_bf16(siluf_(a[6]) * sc, siluf_(a[7]) * sc);
        *(u32x4*)(qk + (long)t * 1024 + ch * 8) = w;
    }
}

typedef __attribute__((address_space(3))) s16x4 lds_s16x4;
__device__ __forceinline__ s16x4 lds_tr(const char* a) { return __builtin_amdgcn_ds_read_tr16_b64_v4i16((lds_s16x4*)a); }
__device__ __forceinline__ bf16x8 tr_frag_perm(const char* base, int pitch, int rbase, int cbase, int fr, int fq) {
    const char* a0 = base + (rbase + 4 * fq + (fr >> 2)) * pitch + (cbase + 4 * (fr & 3)) * 2;
    const s16x4 lo = lds_tr(a0), hi = lds_tr(a0 + 16 * pitch);
    return (bf16x8){lo[0], lo[1], lo[2], lo[3], hi[0], hi[1], hi[2], hi[3]};
}
__device__ __forceinline__ bf16x8 tr_frag_std(const char* base, int pitch, int rbase, int cbase, int fr, int fq) {
    const char* a0 = base + (rbase + 8 * fq + (fr >> 2)) * pitch + (cbase + 4 * (fr & 3)) * 2;
    const s16x4 lo = lds_tr(a0), hi = lds_tr(a0 + 4 * pitch);
    return (bf16x8){lo[0], lo[1], lo[2], lo[3], hi[0], hi[1], hi[2], hi[3]};
}
__device__ __forceinline__ bf16x8 pack_p(const f32x4 a, const f32x4 b) {
    u32x4 w; w.x = pk_bf16(a[0], a[1]); w.y = pk_bf16(a[2], a[3]); w.z = pk_bf16(b[0], b[1]); w.w = pk_bf16(b[2], b[3]);
    return as_bf16x8(w);
}

__device__ __forceinline__ float dpp_xor1(float v) { return __builtin_bit_cast(float, __builtin_amdgcn_mov_dpp(__builtin_bit_cast(int, v), 0xB1, 0xF, 0xF, true)); }
__device__ __forceinline__ float dpp_xor2(float v) { return __builtin_bit_cast(float, __builtin_amdgcn_mov_dpp(__builtin_bit_cast(int, v), 0x4E, 0xF, 0xF, true)); }

constexpr int NSA_PITCH = 160;
constexpr int NSA_KC = 0, NSA_VC = 20480, NSA_KT = 40960, NSA_VT = 61440, NSA_MISC = 81920, NSA_Y = 83968;

struct NsaState {
    bf16x8 qf[2][2];
    int tl[2];
    unsigned selm[2];
    unsigned wunion, bunion;
    unsigned tunion[2];
};

constexpr int NSA_STG = 16384;
__device__ __forceinline__ bf16x8 tr_frag_perm_swz(const char* base, int rbase, int dt, int fr, int fq) {
    const int R = rbase + 4 * fq + (fr >> 2), c = 2 * dt + ((fr & 3) >> 1);
    const char* a0 = base + R * 128 + ((c ^ (R & 7)) << 4) + 8 * (fr & 1);
    const s16x4 lo = lds_tr(a0), hi = lds_tr(a0 + 16 * 128);
    return (bf16x8){lo[0], lo[1], lo[2], lo[3], hi[0], hi[1], hi[2], hi[3]};
}

#define NSA_WAITV(n) asm volatile("s_waitcnt vmcnt(" #n ")" ::: "memory")
#define NSA_BAR() do { asm volatile("s_waitcnt lgkmcnt(0)" ::: "memory"); __builtin_amdgcn_s_barrier(); asm volatile("" ::: "memory"); } while (0)

template <int MODE>
__device__ __forceinline__ void nsa_stream(char* smem, const bf16_t* Pb  , int g, int i, NsaState& st, float gate0, float gate1, const int tid) {
    const int lane = tid & 63, fr = lane & 15, fq = lane >> 4;
    const int kcol = (MODE == 0 ? PC_KS : PC_KW) + g * 64, vcol = (MODE == 0 ? PC_VS : PC_VW) + g * 64;
    const int lrow = tid >> 3, lch = (tid & 7) ^ (lrow & 7);
    const bf16_t* ksrc = Pb + (long)lrow * PW + kcol + lch * 8;
    const bf16_t* vsrc = Pb + (long)lrow * PW + vcol + lch * 8;
    const int jlo = MODE == 0 ? 0 : (i - 8 > 0 ? i - 8 : 0);
    const unsigned range = (i >= 31 ? 0xffffffffu : ((1u << (i + 1)) - 1u)) & ~((1u << jlo) - 1u);
    const unsigned need = (unsigned)__builtin_amdgcn_readfirstlane((int)((MODE == 0 ? st.bunion : 0xffffffffu) & range));
    f32x4 O[2][4];
    float m[2], l[2];
    int tlq[2];
#pragma unroll
    for (int mt = 0; mt < 2; ++mt) { m[mt] = -1e30f; l[mt] = 0.f; tlq[mt] = st.tl[mt] - 4 * fq;
#pragma unroll
        for (int dt = 0; dt < 4; ++dt) O[mt][dt] = (f32x4){0.f, 0.f, 0.f, 0.f}; }
    unsigned pm = need;
    int nissued = 0;
    auto issue_next = [&]() {
        const int jj = __builtin_ctz(pm); pm &= pm - 1u;
        char* sb = smem + (nissued & 3) * NSA_STG;
        __builtin_amdgcn_global_load_lds((glb_u32*)(ksrc + (long)jj * 64 * PW), (lds_u32*)(sb + tid * 16), 16, 0, 0);
        __builtin_amdgcn_global_load_lds((glb_u32*)(vsrc + (long)jj * 64 * PW), (lds_u32*)(sb + 8192 + tid * 16), 16, 0, 0);
        ++nissued;
    };
    const int L = __builtin_popcount(need);
    if (L > 0) issue_next();
    if (L > 1) issue_next();
    if (L > 2) issue_next();
    if (L > 2) NSA_WAITV(4); else if (L > 1) NSA_WAITV(2); else NSA_WAITV(0);
    NSA_BAR();
    unsigned cm = need;
    for (int n = 0; n < L; ++n) {
        const int j = __builtin_ctz(cm); cm &= cm - 1u;
        if (n + 3 < L) issue_next();
        const char* KT = smem + (n & 3) * NSA_STG;
        const char* VT = KT + 8192;
        const bool on0 = MODE == 0 ? (((st.tunion[0] >> j) & 1u) != 0u) : true, on1 = MODE == 0 ? (((st.tunion[1] >> j) & 1u) != 0u) : true;
        if (on0 || on1) {
            f32x4 S[2][4];
            {
                bf16x8 kf[4][2];
#pragma unroll
                for (int nt = 0; nt < 4; ++nt)
#pragma unroll
                    for (int ks = 0; ks < 2; ++ks) kf[nt][ks] = *(const bf16x8*)(KT + (16 * nt + fr) * 128 + (((ks * 4 + fq) ^ (fr & 7)) << 4));
#pragma unroll
                for (int mt = 0; mt < 2; ++mt) {
                    if (MODE == 0 && !(mt == 0 ? on0 : on1)) continue;
#pragma unroll
                    for (int nt = 0; nt < 4; ++nt) {
                        f32x4 s = (f32x4){0.f, 0.f, 0.f, 0.f};
                        s = mfma16(kf[nt][0], st.qf[mt][0], s);
                        s = mfma16(kf[nt][1], st.qf[mt][1], s);
                        S[mt][nt] = s;
                    }
                }
            }
            bf16x8 pf[2][2];
            const bool edge = (j == i) || (MODE == 1 && j == i - 8);
            constexpr float CS = 0.125f * 1.4426950408889634f;
#pragma unroll
            for (int mt = 0; mt < 2; ++mt) {
                if (MODE == 0 && !(mt == 0 ? on0 : on1)) continue;
                const bool rowsel = MODE == 0 ? (((st.selm[mt] >> j) & 1u) != 0u) : true;
                if (edge) {
                    asm volatile("; boundary tile" ::: "memory");
#pragma unroll
                    for (int nt = 0; nt < 4; ++nt)
#pragma unroll
                        for (int e = 0; e < 4; ++e) {
                            const int kc = 16 * nt + e;
                            bool ok = true;
                            if (j == i) ok = ok && (kc <= tlq[mt]);
                            if (MODE == 1) { if (j == i - 8) ok = ok && (kc > tlq[mt]); }
                            S[mt][nt][e] = ok ? S[mt][nt][e] : -INFINITY;
                        }
                }
                float mx = -INFINITY;
#pragma unroll
                for (int nt = 0; nt < 4; ++nt)
#pragma unroll
                    for (int e = 0; e < 4; ++e) mx = __builtin_fmaxf(mx, S[mt][nt][e]);
                mx = fq_max(mx);
                if (MODE == 0) mx = rowsel ? mx : -INFINITY;
                const float mnew = __builtin_fmaxf(m[mt], mx * CS);
                const float alpha = __builtin_amdgcn_exp2f(m[mt] - mnew);
                const float msub = (MODE == 0 && !rowsel) ? INFINITY : mnew;
                float rs = 0.f;
#pragma unroll
                for (int nt = 0; nt < 4; ++nt)
#pragma unroll
                    for (int e = 0; e < 4; ++e) { const float pv = __builtin_amdgcn_exp2f(__builtin_fmaf(S[mt][nt][e], CS, -msub)); S[mt][nt][e] = pv; rs += pv; }
                rs = fq_sum(rs);
                l[mt] = l[mt] * alpha + rs; m[mt] = mnew;
#pragma unroll
                for (int dt = 0; dt < 4; ++dt) O[mt][dt] = O[mt][dt] * alpha;
                pf[mt][0] = pack_p(S[mt][0], S[mt][1]); pf[mt][1] = pack_p(S[mt][2], S[mt][3]);
            }
#pragma unroll
            for (int ks2 = 0; ks2 < 2; ++ks2)
#pragma unroll
                for (int dt = 0; dt < 4; ++dt) {
                    const bf16x8 vf = tr_frag_perm_swz(VT, 32 * ks2, dt, fr, fq);
                    if (MODE != 0 || on0) O[0][dt] = mfma16(vf, pf[0][ks2], O[0][dt]);
                    if (MODE != 0 || on1) O[1][dt] = mfma16(vf, pf[1][ks2], O[1][dt]);
                }
        }
        if (n + 1 < L) { if (n + 3 < L) NSA_WAITV(4); else if (n + 2 < L) NSA_WAITV(2); else NSA_WAITV(0); }
        NSA_BAR();
    }
#pragma unroll
    for (int mt = 0; mt < 2; ++mt) {
        const float gsc = (mt == 0 ? gate0 : gate1) * (l[mt] > 0.f ? 1.0f / l[mt] : 0.f);
#pragma unroll
        for (int dt = 0; dt < 4; ++dt) { f32x4* yp = (f32x4*)(smem + NSA_Y) + (mt * 4 + dt) * NTHR + tid; *yp = *yp + O[mt][dt] * gsc; }
    }
}

__device__ __forceinline__ void nsa_cmp_one(const char* smem, const bf16x8 qf0, const bf16x8 qf1, const int t, const int i, const float gate0, f32x4* yp  , unsigned& selm, const int lane) {
    const int fr = lane & 15, fq = lane >> 4;
        const int cl = (t >= 31 ? ((t - 31) >> 4) : -1) - 4 * fq;
        f32x4 S[8];
#pragma unroll
        for (int nt = 0; nt < 8; ++nt) {
            f32x4 s = (f32x4){0.f, 0.f, 0.f, 0.f};
#pragma unroll
            for (int ks = 0; ks < 2; ++ks) {
                const bf16x8 kf = *(const bf16x8*)(smem + NSA_KC + (16 * nt + fr) * NSA_PITCH + (ks * 4 + fq) * 16);
                s = mfma16(kf, (ks == 0 ? qf0 : qf1), s);
            }
            S[nt] = s;
        }
        float mx = -INFINITY;
#pragma unroll
        for (int nt = 0; nt < 8; ++nt)
#pragma unroll
            for (int e = 0; e < 4; ++e) {
                const float sv = (16 * nt + e <= cl) ? S[nt][e] * 0.125f : -INFINITY;
                S[nt][e] = sv; mx = fmaxf(mx, sv);
            }
        mx = fq_max(mx);
        const float mref = fmaxf(mx, -1e30f);
        float rs = 0.f;
#pragma unroll
        for (int nt = 0; nt < 8; ++nt)
#pragma unroll
            for (int e = 0; e < 4; ++e) { const float pv = __expf(S[nt][e] - mref); S[nt][e] = pv; rs += pv; }
        rs = fq_sum(rs);
        const float inv = rs > 0.f ? 1.0f / rs : 0.f;
#pragma unroll
        for (int nt = 0; nt < 8; ++nt) S[nt] = S[nt] * inv;
        {
            f32x4 O[4];
#pragma unroll
            for (int dt = 0; dt < 4; ++dt) O[dt] = (f32x4){0.f, 0.f, 0.f, 0.f};
#pragma unroll
            for (int ks2 = 0; ks2 < 4; ++ks2) {
                const bf16x8 pf = pack_p(S[2 * ks2], S[2 * ks2 + 1]);
#pragma unroll
                for (int dt = 0; dt < 4; ++dt) {
                    const bf16x8 vf = tr_frag_perm(smem + NSA_VC, NSA_PITCH, 32 * ks2, 16 * dt, fr, fq);
                    O[dt] = mfma16(vf, pf, O[dt]);
                }
            }
#pragma unroll
            for (int dt = 0; dt < 4; ++dt) yp[dt * NTHR] = O[dt] * gate0;
        }
        float imp[8];
        {
            float own[8], last[8];
#pragma unroll
            for (int nt = 0; nt < 8; ++nt) {
                f32x4 v = S[nt];
#pragma unroll
                for (int e = 0; e < 4; ++e) { v[e] += dpp_xor1(v[e]); v[e] += dpp_xor2(v[e]); }
                own[nt] = (v[0] + v[1]) + (v[2] + v[3]); last[nt] = v[3];
            }
            const int src = (lane + 48) & 63;
#pragma unroll
            for (int nt = 0; nt < 8; ++nt) {
                const float a = __shfl(last[nt], src);
                const float bsh = nt > 0 ? __shfl(last[nt > 0 ? nt - 1 : 0], src) : 0.f;
                const float prevc = fq > 0 ? a : bsh;
                const int n = 4 * nt + fq;
                const float pslc = own[nt] + prevc;
                const bool valid = n <= i;
                const bool forced = (n == 0) || (n == i) || (n == i - 1);
                imp[nt] = valid ? pslc + (forced ? 1e4f : 0.f) : -1e30f;
            }
        }
        unsigned mask = 0u;
#pragma unroll 1
        for (int r = 0; r < 8; ++r) {
            float bv = imp[0]; int bn = fq;
#pragma unroll
            for (int nt = 1; nt < 8; ++nt) { if (imp[nt] > bv) { bv = imp[nt]; bn = 4 * nt + fq; } }
#pragma unroll
            for (int off = 16; off <= 32; off <<= 1) {
                const float ov = __shfl_xor(bv, off); const int on = __shfl_xor(bn, off);
                if (ov > bv || (ov == bv && on < bn)) { bv = ov; bn = on; }
            }
            if (bv > -5e29f) mask |= 1u << bn;
#pragma unroll
            for (int nt = 0; nt < 8; ++nt) if (bn == 4 * nt + fq) imp[nt] = -3.0e38f;
        }
        selm = mask;
}

template <int NSAV = 7  >
__device__ __forceinline__ void nsa_task(const Params& p, char* smem, int b, int g, int i) {
    const char* ws = p.ws;
    const bf16_t* Pb = (const bf16_t*)(ws + WS_P) + (long)b * SEQ * PW;
    const float* psm = (const float*)(ws + WS_PSM) + (long)b * SEQ * 32;
    int tid = threadIdx.x;
    asm volatile("" : "+v"(tid));
    const int lane = tid & 63, wid = __builtin_amdgcn_readfirstlane(tid >> 6), fr = lane & 15, fq = lane >> 4;
    const int qs = i * 64;
    NsaState st;
    float gate[2][3];
#pragma unroll
    for (int mt = 0; mt < 2; ++mt) {
        st.tl[mt] = 8 * wid + 4 * mt + (fr >> 2);
        const int h = fr & 3;
        const bf16_t* qp = Pb + (long)(qs + st.tl[mt]) * PW + PC_Q + g * 256 + h * 64 + fq * 8;
        st.qf[mt][0] = *(const bf16x8*)(qp); st.qf[mt][1] = *(const bf16x8*)(qp + 32);
        const float* gp = psm + (long)(qs + st.tl[mt]) * 32 + (g * 4 + h) * 3;
        gate[mt][0] = sigmoidf_(gp[0]); gate[mt][1] = sigmoidf_(gp[1]); gate[mt][2] = sigmoidf_(gp[2]);
    }
    {
        const bf16_t* kc = (const bf16_t*)(ws + WS_KCMP) + (long)(b * 2 + g) * 128 * 64;
        const bf16_t* vc = (const bf16_t*)(ws + WS_VCMP) + (long)(b * 2 + g) * 128 * 64;
#pragma unroll
        for (int r = 0; r < 2; ++r) {
            const int e = tid + r * NTHR, row = e >> 3, ch = e & 7;
            *(u32x4*)(smem + NSA_KC + row * NSA_PITCH + ch * 16) = *(const u32x4*)(kc + row * 64 + ch * 8);
            *(u32x4*)(smem + NSA_VC + row * NSA_PITCH + ch * 16) = *(const u32x4*)(vc + row * 64 + ch * 8);
        }
    }
    __syncthreads();
    if (!(NSAV & 1)) { st.selm[0] = 0xffffffffu; st.selm[1] = 0xffffffffu;
#pragma unroll
        for (int d8 = 0; d8 < 8; ++d8) ((f32x4*)(smem + NSA_Y))[d8 * NTHR + tid] = (f32x4){0.f, 0.f, 0.f, 0.f}; }
    if (NSAV & 1) {
    nsa_cmp_one(smem, st.qf[0][0], st.qf[0][1], qs + st.tl[0], i, gate[0][0], (f32x4*)(smem + NSA_Y) + tid, st.selm[0], lane);
    asm volatile("" ::: "memory");
    __builtin_amdgcn_sched_barrier(0);
    nsa_cmp_one(smem, st.qf[1][0], st.qf[1][1], qs + st.tl[1], i, gate[1][0], (f32x4*)(smem + NSA_Y) + 4 * NTHR + tid, st.selm[1], lane);
    __builtin_amdgcn_sched_barrier(0);
    }
    {
        unsigned u0 = st.selm[0], u1 = st.selm[1];
        u0 |= __shfl_xor(u0, 4); u0 |= __shfl_xor(u0, 8); u1 |= __shfl_xor(u1, 4); u1 |= __shfl_xor(u1, 8);
        st.tunion[0] = (unsigned)__builtin_amdgcn_readfirstlane((int)u0); st.tunion[1] = (unsigned)__builtin_amdgcn_readfirstlane((int)u1);
        const unsigned u = st.tunion[0] | st.tunion[1];
        st.wunion = u;
        unsigned* misc = (unsigned*)(smem + NSA_MISC);
        if (lane == 0) misc[wid] = u;
        __syncthreads();
        unsigned bu = 0u;
#pragma unroll
        for (int w = 0; w < 8; ++w) bu |= misc[w];
        st.bunion = bu;
    }
    if (NSAV & 2) nsa_stream<0>(smem, Pb, g, i, st, gate[0][1], gate[1][1], tid);
    if (NSAV & 4) nsa_stream<1>(smem, Pb, g, i, st, gate[0][2], gate[1][2], tid);
    bf16_t* mix = (bf16_t*)(p.ws + WS_MIX) + (long)b * SEQ * 1024;
#pragma unroll
    for (int mt = 0; mt < 2; ++mt) {
        const int orow = qs + st.tl[mt], ocol = g * 256 + (fr & 3) * 64 + fq * 4;
#pragma unroll
        for (int dt = 0; dt < 4; ++dt) {
            const f32x4 yv = *((const f32x4*)(smem + NSA_Y) + (mt * 4 + dt) * NTHR + tid);
            u32x2 w; w.x = pk_bf16(yv[0], yv[1]); w.y = pk_bf16(yv[2], yv[3]);
            *(u32x2*)(mix + blk_off(orow, ocol + dt * 16, 1024)) = w;
        }
    }
    __syncthreads();
}

constexpr int ML_PITCH = 288;
constexpr int ML_Q = 0, ML_K = 18432, ML_V = 36864, ML_VW = 55296, ML_C = 73728, ML_N = 110592, ML_GB = 111104, ML_GA = 119296, ML_GMQ = 127488,
              ML_GS = 135680, ML_ST = 136192;

__device__ __forceinline__ float wave_incl_scan_add(float v, int lane) {
#pragma unroll
    for (int off = 1; off < 64; off <<= 1) { const float o = __shfl_up(v, off); if (lane >= off) v += o; }
    return v;
}
__device__ __forceinline__ float wave_incl_scan_max(float v, int lane) {
#pragma unroll
    for (int off = 1; off < 64; off <<= 1) { const float o = __shfl_up(v, off); if (lane >= off) v = fmaxf(v, o); }
    return v;
}
__device__ __forceinline__ float wave_max(float v) {
#pragma unroll
    for (int off = 32; off >= 1; off >>= 1) v = fmaxf(v, __shfl_xor(v, off));
    return v;
}

__device__ __forceinline__ void mlstm_scan(const Params& p, char* smem, int b, int h) {
    const char* ws = p.ws;
    int tid = threadIdx.x;
    asm volatile("" : "+v"(tid));
    const int lane = tid & 63, wid = __builtin_amdgcn_readfirstlane(tid >> 6), fr = lane & 15, fq = lane >> 4;
    const bf16_t* QK = (const bf16_t*)(ws + WS_QK) + (long)b * SEQ * 1024 + h * 128;
    const bf16_t* Pb = (const bf16_t*)(ws + WS_P) + (long)b * SEQ * PW;
    const float* psm = (const float*)(ws + WS_PSM) + (long)b * SEQ * 32;
    bf16_t* mix = (bf16_t*)(p.ws + WS_MIX) + (long)b * SEQ * 1024;
    float* GB = (float*)(smem + ML_GB); float* GA = (float*)(smem + ML_GA); float* GMQ = (float*)(smem + ML_GMQ);
    float* GS = (float*)(smem + ML_GS);
    float* NV = (float*)(smem + ML_N);
    float* ST = (float*)(smem + ML_ST);
    {
        const float ib = p.in[I_IBIAS][h], fb = p.in[I_FBIAS][h];
        for (int c = wid; c < 32; c += 8) {
            const int t = c * 64 + lane;
            const float ipre = psm[(long)t * 32 + 24 + h], fpre = psm[(long)t * 32 + 28 + h];
            const float li = ipre + ib;
            const float x = fpre + fb;
            const float lf = fminf(x, 0.f) - log1pf(__expf(-fabsf(x)));
            const float bb = wave_incl_scan_add(lf, lane);
            const float aa = li - bb;
            const float g = __shfl(bb, 63);
            const float pm = wave_incl_scan_max(aa, lane);
            const float mloc = wave_max(g + aa);
            GB[t] = bb; GA[t] = aa; GMQ[t] = pm;
            if (lane == 0) { GS[64 + c] = g; GS[96 + c] = mloc; }
        }
    }
    for (int e = tid; e < 36864 / 16; e += NTHR) *(u32x4*)(smem + ML_C + e * 16) = (u32x4){0u, 0u, 0u, 0u};
    if (tid < 128) NV[tid] = 0.f;
    __syncthreads();
    if (tid == 0) {
        float m = 0.f;
        for (int c = 0; c < 32; ++c) { GS[c] = m; const float mn = fmaxf(GS[64 + c] + m, GS[96 + c]); GS[32 + c] = mn; m = mn; }
    }
    __syncthreads();
    for (int t = tid; t < SEQ; t += NTHR) GMQ[t] = GB[t] + fmaxf(GS[t >> 6], GMQ[t]);
    __syncthreads();

    f32x4 Cacc[9];
#pragma unroll
    for (int c9 = 0; c9 < 9; ++c9) Cacc[c9] = (f32x4){0.f, 0.f, 0.f, 0.f};
    const int lrow = tid >> 4, lch = tid & 15;
    u32x4 rq[2], rk[2], rv[2];
#pragma unroll
    for (int i2 = 0; i2 < 2; ++i2) {
        const int row = lrow + 32 * i2;
        rq[i2] = *(const u32x4*)(QK + (long)row * 1024 + lch * 8);
        rk[i2] = *(const u32x4*)(QK + (long)row * 1024 + 512 + lch * 8);
        rv[i2] = *(const u32x4*)(Pb + (long)row * PW + PC_MV + h * 128 + lch * 8);
    }
    const int mt = wid >> 1, half = wid & 1;
#pragma unroll 1
    for (int c = 0; c < 32; ++c) {
        const float m_old = GS[c], m_new = GS[32 + c], gch = GS[64 + c];
#pragma unroll
        for (int i2 = 0; i2 < 2; ++i2) {
            const int row = lrow + 32 * i2;
            *(u32x4*)(smem + ML_Q + row * ML_PITCH + lch * 16) = rq[i2];
            *(u32x4*)(smem + ML_K + row * ML_PITCH + lch * 16) = rk[i2];
            *(u32x4*)(smem + ML_V + row * ML_PITCH + lch * 16) = rv[i2];
            const float wk = __expf(gch + GA[c * 64 + row] - m_new);
            u32x4 w;
            w.x = pk_bf16(bf_lo(rv[i2].x) * wk, bf_hi(rv[i2].x) * wk); w.y = pk_bf16(bf_lo(rv[i2].y) * wk, bf_hi(rv[i2].y) * wk);
            w.z = pk_bf16(bf_lo(rv[i2].z) * wk, bf_hi(rv[i2].z) * wk); w.w = pk_bf16(bf_lo(rv[i2].w) * wk, bf_hi(rv[i2].w) * wk);
            *(u32x4*)(smem + ML_VW + row * ML_PITCH + lch * 16) = w;
        }
        if (tid < 128) {
            const int row = tid >> 1, hf = tid & 1;
            const float wk = __expf(gch + GA[c * 64 + row] - m_new);
            u32x4 w = (u32x4){0u, 0u, 0u, 0u};
            if (hf == 0) w.x = pk_bf16(wk, 0.f);
            *(u32x4*)(smem + ML_VW + row * ML_PITCH + 256 + hf * 16) = w;
        }
        __syncthreads();
        if (c + 1 < 32) {
#pragma unroll
            for (int i2 = 0; i2 < 2; ++i2) {
                const int row = (c + 1) * 64 + lrow + 32 * i2;
                rq[i2] = *(const u32x4*)(QK + (long)row * 1024 + lch * 8);
                rk[i2] = *(const u32x4*)(QK + (long)row * 1024 + 512 + lch * 8);
                rv[i2] = *(const u32x4*)(Pb + (long)row * PW + PC_MV + h * 128 + lch * 8);
            }
        }
        const int l = 16 * mt + fr;
        const float bl = GB[c * 64 + l], mq = GMQ[c * 64 + l];
        const float ul = bl - mq;
        f32x4 hv[4];
        float s1 = 0.f, s2 = 0.f;
        {
            bf16x8 qf[4];
#pragma unroll
            for (int ks = 0; ks < 4; ++ks) qf[ks] = *(const bf16x8*)(smem + ML_Q + l * ML_PITCH + (ks * 4 + fq) * 16);
            f32x4 S[4];
#pragma unroll
            for (int nt = 0; nt < 4; ++nt) {
                f32x4 s = (f32x4){0.f, 0.f, 0.f, 0.f};
#pragma unroll
                for (int ks = 0; ks < 4; ++ks) {
                    const bf16x8 kf = *(const bf16x8*)(smem + ML_K + (16 * nt + fr) * ML_PITCH + (ks * 4 + fq) * 16);
                    s = mfma16(kf, qf[ks], s);
                }
                S[nt] = s;
            }
            float dintra = 0.f;
            const int lq = l - 4 * fq;
#pragma unroll
            for (int nt = 0; nt < 4; ++nt) {
                const f32x4 av = *(const f32x4*)(GA + c * 64 + 16 * nt + 4 * fq);
#pragma unroll
                for (int e = 0; e < 4; ++e) {
                    const float w = (16 * nt + e <= lq) ? __expf(ul + av[e]) : 0.f;
                    const float sv = S[nt][e] * w;
                    S[nt][e] = sv; dintra += sv;
                }
            }
            dintra = fq_sum(dintra);
            float dinter = 0.f;
#pragma unroll
            for (int ks = 0; ks < 4; ++ks) {
                const f32x4 n0 = *(const f32x4*)(NV + ks * 32 + fq * 8), n1 = *(const f32x4*)(NV + ks * 32 + fq * 8 + 4);
                const u32x4 qu = __builtin_bit_cast(u32x4, qf[ks]);
                dinter += bf_lo(qu.x) * n0[0] + bf_hi(qu.x) * n0[1] + bf_lo(qu.y) * n0[2] + bf_hi(qu.y) * n0[3]
                        + bf_lo(qu.z) * n1[0] + bf_hi(qu.z) * n1[1] + bf_lo(qu.w) * n1[2] + bf_hi(qu.w) * n1[3];
            }
            dinter = fq_sum(dinter);
            const float winter = __expf(ul + m_old);
            const float den = winter * dinter + dintra;
            const float rden = 1.0f / fmaxf(fabsf(den), __expf(-mq));
            const bf16x8 pf0 = pack_p(S[0], S[1]), pf1 = pack_p(S[2], S[3]);
#pragma unroll
            for (int c4 = 0; c4 < 4; ++c4) {
                const int et = 4 * half + c4;
                f32x4 num = (f32x4){0.f, 0.f, 0.f, 0.f}, inter = (f32x4){0.f, 0.f, 0.f, 0.f};
                num = mfma16(tr_frag_perm(smem + ML_V, ML_PITCH, 0, 16 * et, fr, fq), pf0, num);
                num = mfma16(tr_frag_perm(smem + ML_V, ML_PITCH, 32, 16 * et, fr, fq), pf1, num);
#pragma unroll
                for (int ks = 0; ks < 4; ++ks) {
                    const bf16x8 cf = *(const bf16x8*)(smem + ML_C + (16 * et + fr) * ML_PITCH + (ks * 4 + fq) * 16);
                    inter = mfma16(cf, qf[ks], inter);
                }
                const f32x4 hh = (inter * winter + num) * rden;
                hv[c4] = hh;
                s1 += (hh[0] + hh[1]) + (hh[2] + hh[3]);
                s2 += (hh[0] * hh[0] + hh[1] * hh[1]) + (hh[2] * hh[2] + hh[3] * hh[3]);
            }
            s1 = fq_sum(s1); s2 = fq_sum(s2);
            if (fq == 0) { ST[(l * 2 + half) * 2] = s1; ST[(l * 2 + half) * 2 + 1] = s2; }
        }
        {
            const float decay = __expf(gch + m_old - m_new);
#pragma unroll
            for (int c9 = 0; c9 < 9; ++c9) Cacc[c9] = Cacc[c9] * decay;
#pragma unroll
            for (int ks2 = 0; ks2 < 2; ++ks2) {
                const bf16x8 kt = tr_frag_std(smem + ML_K, ML_PITCH, 32 * ks2, 16 * wid, fr, fq);
#pragma unroll
                for (int c9 = 0; c9 < 9; ++c9) {
                    const bf16x8 vw = tr_frag_std(smem + ML_VW, ML_PITCH, 32 * ks2, 16 * c9, fr, fq);
                    Cacc[c9] = mfma16(kt, vw, Cacc[c9]);
                }
            }
        }
        __syncthreads();
        {
            const float* sp = ST + l * 4;
            const float t1 = sp[0] + sp[2], t2 = sp[1] + sp[3];
            const float mean = t1 * (1.0f / 128.0f);
            const float var = fmaxf(t2 * (1.0f / 128.0f) - mean * mean, 0.f);
            const float rstd = rsqrtf(var + LN_EPS);
            const long tok = c * 64 + l;
#pragma unroll
            for (int c4 = 0; c4 < 4; ++c4) {
                const int col = 64 * half + 16 * c4 + 4 * fq;
                const u32x2 ou = *(const u32x2*)(Pb + tok * PW + PC_MO + h * 128 + col);
                const f32x4 ng = *(const f32x4*)(p.in[I_NORMG] + h * 128 + col);
                const f32x4 y = (hv[c4] - mean) * rstd * ng;
                u32x2 w;
                w.x = pk_bf16(y[0] * sigmoidf_(bf_lo(ou.x)), y[1] * sigmoidf_(bf_hi(ou.x)));
                w.y = pk_bf16(y[2] * sigmoidf_(bf_lo(ou.y)), y[3] * sigmoidf_(bf_hi(ou.y)));
                *(u32x2*)(mix + blk_off((int)tok, 512 + h * 128 + col, 1024)) = w;
            }
        }
#pragma unroll
        for (int c9 = 0; c9 < 8; ++c9) {
            u32x2 w; w.x = pk_bf16(Cacc[c9][0], Cacc[c9][1]); w.y = pk_bf16(Cacc[c9][2], Cacc[c9][3]);
            *(u32x2*)(smem + ML_C + (16 * c9 + fr) * ML_PITCH + (16 * wid + 4 * fq) * 2) = w;
        }
        if (fr == 0) *(f32x4*)(NV + 16 * wid + 4 * fq) = Cacc[8];
        __syncthreads();
    }
}


constexpr int CV_PITCH = 144;
__device__ __forceinline__ void wconv_task(const Params& p, char* smem, int which, int e, int nt) {
    const int tid = opaque_tid();
    const int ng = tid & 63, kg = tid >> 6, n0 = 4 * ng;
    const float* src; int ld, K; unsigned char* dst;
    if (which == 0) {
        const int col = 128 * nt + 32 * (n0 >> 6) + bperm32(n0 & 31);
        src = (((n0 >> 5) & 1) ? p.in[I_MW3] : p.in[I_MW1]) + (long)e * 1024 * 256 + col; ld = 256; K = 1024;
        dst = (unsigned char*)p.out + ((long)(e * 2 + nt) * 256) * 1024;
    } else {
        src = p.in[I_MW2] + (long)e * 256 * 1024 + nt * 256 + bperm32(n0); ld = 1024; K = 256;
        dst = (unsigned char*)(p.ws + WS_W2F8) + ((long)(e * 4 + nt) * 256) * 256;
    }
    for (int kc = 0; kc < K / 128; ++kc) {
        f32x4 v[16];
#pragma unroll
        for (int j = 0; j < 16; ++j) v[j] = __builtin_nontemporal_load((const f32x4*)(src + (long)(kc * 128 + kg * 16 + j) * ld));
#pragma unroll
        for (int cc = 0; cc < 4; ++cc) {
            u32x4 w;
            w.x = pk4_fp8(v[0][cc] * W8_SCALE, v[1][cc] * W8_SCALE, v[2][cc] * W8_SCALE, v[3][cc] * W8_SCALE);
            w.y = pk4_fp8(v[4][cc] * W8_SCALE, v[5][cc] * W8_SCALE, v[6][cc] * W8_SCALE, v[7][cc] * W8_SCALE);
            w.z = pk4_fp8(v[8][cc] * W8_SCALE, v[9][cc] * W8_SCALE, v[10][cc] * W8_SCALE, v[11][cc] * W8_SCALE);
            w.w = pk4_fp8(v[12][cc] * W8_SCALE, v[13][cc] * W8_SCALE, v[14][cc] * W8_SCALE, v[15][cc] * W8_SCALE);
            *(u32x4*)(smem + (n0 + cc) * CV_PITCH + kg * 16) = w;
        }
        __syncthreads();
#pragma unroll
        for (int i = 0; i < 4; ++i) {
            const int piece = tid + i * NTHR, row = piece >> 3, ch = piece & 7;
            *(u32x4*)(dst + (long)row * K + kc * 128 + ch * 16) = *(const u32x4*)(smem + row * CV_PITCH + ch * 16);
        }
        __syncthreads();
    }
}

template <int PARTS = 7  , int NSAV = 7>
__device__ __forceinline__ void phase3(const Params& p, char* smem, int bid, int nb, int rep = 0) {
    XcdSlab xs; xs.init(bid, nb);
    const int nq = xs.x >= 0 ? 320 : 1024 + 1536;
    int* qctr = (int*)(p.ws + WS_CNT) + 16384 + ((xs.x >= 0 ? xs.x : 0) + 8 * rep) * 32;
    if (PARTS & 1) for (int u = bid; u < 64; u += nb) mlstm_scan(p, smem, u >> 2, u & 3);
    if (!(PARTS & 2)) return;
    volatile int* slot = (volatile int*)(smem + NSA_MISC + 256);
    for (;;) {
        if (opaque_tid() == 0) *slot = atomicAdd(qctr, 1);
        __syncthreads();
        const int k = __builtin_amdgcn_readfirstlane(*slot);
        if (k >= nq) break;
        if (xs.x >= 0) {
            const int r5 = k % 5, q5 = k / 5;
            if (r5 < 2) { const int kk = q5 * 2 + r5; const int bg = 4 * xs.x + (kk & 3); nsa_task<NSAV>(p, smem, bg >> 1, bg & 1, 31 - (kk >> 2)); }
            else if (PARTS & 4) { const int cv = q5 * 3 + (r5 - 2); const int e = xs.x + 8 * (cv / 6), t6 = cv % 6; wconv_task(p, smem, t6 < 2 ? 0 : 1, e, t6 < 2 ? t6 : t6 - 2); }
        } else if (k < 1024) nsa_task<NSAV>(p, smem, (k & 31) >> 1, k & 1, 31 - (k >> 5));
        else if (PARTS & 4) { const int cv = k - 1024; const int e = cv / 6, t6 = cv % 6; wconv_task(p, smem, t6 < 2 ? 0 : 1, e, t6 < 2 ? t6 : t6 - 2); }
    }
}

constexpr int XA_PITCH = 544;
constexpr int XA_K = 0, XA_V = 69632;
__device__ __forceinline__ void xattn_task(const Params& p, char* smem, int b, int h, int qb) {
    const char* ws = p.ws;
    int tid = threadIdx.x;
    asm volatile("" : "+v"(tid));
    const int lane = tid & 63, wid = __builtin_amdgcn_readfirstlane(tid >> 6), fr = lane & 15, fq = lane >> 4;
    const bf16_t* XQ = (const bf16_t*)(ws + WS_XQ) + (long)(b * SEQ + qb * 128 + wid * 16 + fr) * 1024 + h * 256 + fq * 8;
    const bf16_t* KV = (const bf16_t*)(ws + WS_KVX) + (long)b * 256 * 2048 + h * 256;
    bf16x8 qf[8];
#pragma unroll
    for (int ks = 0; ks < 8; ++ks) qf[ks] = *(const bf16x8*)(XQ + ks * 32);
    f32x4 O[16];
#pragma unroll
    for (int dt = 0; dt < 16; ++dt) O[dt] = (f32x4){0.f, 0.f, 0.f, 0.f};
    float m = -1e30f, l = 0.f;
    const int lrow = tid >> 5, lch = tid & 31;
    u32x4 rk[4], rv[4];
#pragma unroll
    for (int i2 = 0; i2 < 4; ++i2) {
        const bf16_t* rp = KV + (long)(lrow + 16 * i2) * 2048 + lch * 8;
        rk[i2] = *(const u32x4*)rp; rv[i2] = *(const u32x4*)(rp + 1024);
    }
#pragma unroll
    for (int i2 = 0; i2 < 4; ++i2) {
        *(u32x4*)(smem + XA_K + (lrow + 16 * i2) * XA_PITCH + lch * 16) = rk[i2];
        *(u32x4*)(smem + XA_V + (lrow + 16 * i2) * XA_PITCH + lch * 16) = rv[i2];
    }
    __syncthreads();
#pragma unroll 1
    for (int j = 0; j < 4; ++j) {
        const int buf = j & 1;
        if (j + 1 < 4) {
#pragma unroll
            for (int i2 = 0; i2 < 4; ++i2) {
                const bf16_t* rp = KV + (long)((j + 1) * 64 + lrow + 16 * i2) * 2048 + lch * 8;
                rk[i2] = *(const u32x4*)rp; rv[i2] = *(const u32x4*)(rp + 1024);
            }
        }
        const char* KT = smem + XA_K + buf * 34816;
        const char* VT = smem + XA_V + buf * 34816;
        f32x4 S[4];
#pragma unroll
        for (int nt = 0; nt < 4; ++nt) {
            f32x4 s = (f32x4){0.f, 0.f, 0.f, 0.f};
#pragma unroll
            for (int ks = 0; ks < 8; ++ks) {
                const bf16x8 kf = *(const bf16x8*)(KT + (16 * nt + fr) * XA_PITCH + (ks * 4 + fq) * 16);
                s = mfma16(kf, qf[ks], s);
            }
            S[nt] = s * 0.0625f;
        }
        float mx = -INFINITY;
#pragma unroll
        for (int nt = 0; nt < 4; ++nt)
#pragma unroll
            for (int e = 0; e < 4; ++e) mx = fmaxf(mx, S[nt][e]);
        mx = fq_max(mx);
        const float mnew = fmaxf(m, mx);
        const float alpha = __expf(m - mnew);
        float rs = 0.f;
#pragma unroll
        for (int nt = 0; nt < 4; ++nt)
#pragma unroll
            for (int e = 0; e < 4; ++e) { const float pv = __expf(S[nt][e] - mnew); S[nt][e] = pv; rs += pv; }
        rs = fq_sum(rs);
        l = l * alpha + rs; m = mnew;
#pragma unroll
        for (int dt = 0; dt < 16; ++dt) O[dt] = O[dt] * alpha;
        const bf16x8 pf0 = pack_p(S[0], S[1]), pf1 = pack_p(S[2], S[3]);
#pragma unroll
        for (int dt = 0; dt < 16; ++dt) {
            O[dt] = mfma16(tr_frag_perm(VT, XA_PITCH, 0, 16 * dt, fr, fq), pf0, O[dt]);
            O[dt] = mfma16(tr_frag_perm(VT, XA_PITCH, 32, 16 * dt, fr, fq), pf1, O[dt]);
        }
        if (j + 1 < 4) {
            char* KTn = smem + XA_K + (buf ^ 1) * 34816; char* VTn = smem + XA_V + (buf ^ 1) * 34816;
#pragma unroll
            for (int i2 = 0; i2 < 4; ++i2) {
                *(u32x4*)(KTn + (lrow + 16 * i2) * XA_PITCH + lch * 16) = rk[i2];
                *(u32x4*)(VTn + (lrow + 16 * i2) * XA_PITCH + lch * 16) = rv[i2];
            }
        }
        __syncthreads();
    }
    const float inv = 1.0f / l;
    bf16_t* op = (bf16_t*)(p.ws + WS_XO) + (long)(b * SEQ + qb * 128 + wid * 16 + fr) * 1024 + h * 256 + fq * 4;
#pragma unroll
    for (int dt = 0; dt < 16; ++dt) {
        u32x2 w; w.x = pk_bf16(O[dt][0] * inv, O[dt][1] * inv); w.y = pk_bf16(O[dt][2] * inv, O[dt][3] * inv);
        *(u32x2*)(op + dt * 16) = w;
    }
}

__device__ __forceinline__ void phase6(const Params& p, char* smem, int bid, int nb) {
    XcdSlab xs; xs.init(bid, nb);
    const int p_lo = xs.m_lo(64), n_t = (xs.m_hi(64) - p_lo) * 16;
    for (int u = xs.j; u < n_t; u += xs.stride) { const int pr = p_lo + (u >> 4); xattn_task(p, smem, pr >> 2, pr & 3, u & 15); }
}

constexpr int LN_ST = 139264, LN_GB = 141312, MOE_TAB = 153600;

template <bool ABLK, bool BBLK, class EPI>
__device__ __forceinline__ void dense_loop(char* smem, int bid, int nb, const bf16_t* A, int lda, const bf16_t* Bt, int nk, const EPI& epi) {
    XcdSlab xs; xs.init(bid, nb);
    const int m_lo = xs.m_lo(128), n_t = (xs.m_hi(128) - m_lo) * 4;
    int mt = 0, nt = 0;
    RingRows al, bl;
    auto setup = [&](int u) {
        mt = m_lo + (u >> 2); nt = u & 3;
        if (ABLK) al.init_blocked(A, lda, mt * 256); else al.init_contig(A, lda, mt * 256);
        if (BBLK) bl.init_blocked(Bt, lda, nt * 256, true); else bl.init_contig(Bt, lda, nt * 256, true);
    };
    int u = xs.j;
    TS(0);
    if (u < n_t) { setup(u); ring_issue3(smem, al, bl); }
    int tsi = 1;
    while (u < n_t) {
        const int cmt = mt, cnt_ = nt;
        f32x4 acc[8][4];
        gemm_ring<RingRows, RingRows, 0, true>(smem, al, bl, nk, acc);
        TS(tsi); ++tsi;
        u += xs.stride;
        if (u < n_t) { setup(u); ring_issue3(smem, al, bl); }
        epi(acc, cmt, cnt_);
        TS(tsi); ++tsi;
    }
    asm volatile("s_waitcnt vmcnt(0)" ::: "memory");
    TS(5);
}

__device__ __forceinline__ void phase4(const Params& p, char* smem, int bid, int nb) {
    char* ws = p.ws;
    dense_loop<true, true>(smem, bid, nb, (const bf16_t*)(ws + WS_MIX), 1024, (const bf16_t*)(ws + WS_WOUT), 32, [&](f32x4 (&acc)[8][4], int mt, int nt) {
        epi_residual<false, false, true>(acc, smem, p.in[I_X], nullptr, nullptr, nullptr, nullptr, (bf16_t*)(ws + WS_R1B), (float*)(ws + WS_ST1), mt * 256, nt);
    });
}

__device__ __forceinline__ void phase5(const Params& p, char* smem, int bid, int nb) {
    char* ws = p.ws;
    const float* lnf = (const float*)(ws + WS_LNF);
    dense_loop<true, true>(smem, bid, nb, (const bf16_t*)(ws + WS_R1B), 1024, (const bf16_t*)(ws + WS_WQ), 32, [&](f32x4 (&acc)[8][4], int mt, int nt) {
        ln_correct<0>(acc, (const float*)(ws + WS_ST1), mt * 256, lnf, lnf + 1792, nt);
        epi_store_bf16(acc, (bf16_t*)(ws + WS_XQ), 1024, mt * 256, nt * 256);
    });
}

__device__ __forceinline__ void phase7(const Params& p, char* smem, int bid, int nb) {
    char* ws = p.ws;
    dense_loop<false, false>(smem, bid, nb, (const bf16_t*)(ws + WS_XO), 1024, (const bf16_t*)(ws + WS_WO), 32, [&](f32x4 (&acc)[8][4], int mt, int nt) {
        epi_residual<true, true, false>(acc, smem, nullptr, (const bf16_t*)(ws + WS_R1B), (const float*)(ws + WS_ST1), p.in[I_LN1G], p.in[I_LN1B],
                           (bf16_t*)(ws + WS_R2B), (float*)(ws + WS_ST2), mt * 256, nt);
    });
}

template <class RowMap>
__device__ __forceinline__ void epi_swiglu(const f32x4 (&acc)[8][4], bf16_t* out, int ld, int nt, const RowMap& rm) {
    const int tid_ = opaque_tid();
    const int lane = tid_ & 63, wid = tid_ >> 6;
    const int wr = wid >> 2, wc = wid & 3, fr = lane & 15, fq = lane >> 4;
#pragma unroll
    for (int mi = 0; mi < 8; ++mi) {
        const long orow = rm(wr * 128 + mi * 16 + fr);
        if (orow >= 0) {
            const f32x4 a0 = acc[mi][0], b0 = acc[mi][1], a1 = acc[mi][2], b1 = acc[mi][3];
            u32x4 w;
            w.x = pk_bf16(siluf_(a0[0]) * b0[0], siluf_(a0[1]) * b0[1]); w.y = pk_bf16(siluf_(a0[2]) * b0[2], siluf_(a0[3]) * b0[3]);
            w.z = pk_bf16(siluf_(a1[0]) * b1[0], siluf_(a1[1]) * b1[1]); w.w = pk_bf16(siluf_(a1[2]) * b1[2], siluf_(a1[3]) * b1[3]);
            *(u32x4*)(out + orow * ld + nt * 128 + wc * 32 + fq * 8) = w;
        }
    }
}
struct RowIdent { long row0; __device__ __forceinline__ long operator()(int rl) const { return row0 + rl; } };

__device__ __forceinline__ unsigned dpp_xor1_u(unsigned v) { return (unsigned)__builtin_amdgcn_mov_dpp((int)v, 0xB1, 0xF, 0xF, true); }
__device__ __forceinline__ void route_tile(const Params& p, char* smem, int tok0, int rep) {
    char* ws = p.ws;
    const float* bias = p.in[I_ROUTB];
    const int tid = opaque_tid(), tk = tid >> 1, hf = tid & 1;
    const float* row = (const float*)(ws + WS_RSC) + (long)(tok0 + tk) * 256;
    unsigned key[128];
    float gs[4];
    {
        float v[128];
#pragma unroll
        for (int i = 0; i < 32; ++i) { const f32x4 t = *(const f32x4*)(row + hf * 128 + i * 4); v[4 * i] = t[0]; v[4 * i + 1] = t[1]; v[4 * i + 2] = t[2]; v[4 * i + 3] = t[3]; }
#pragma unroll
        for (int gi = 0; gi < 4; ++gi) {
            float m1 = -INFINITY, m2 = -INFINITY;
#pragma unroll
            for (int i = 0; i < 32; ++i) { const float x = v[32 * gi + i]; m2 = __builtin_fmaxf(m2, __builtin_fminf(m1, x)); m1 = __builtin_fmaxf(m1, x); }
            gs[gi] = m1 + m2;
        }
        float g8[8];
#pragma unroll
        for (int gi = 0; gi < 4; ++gi) { const float o = dpp_xor1(gs[gi]); g8[gi] = hf ? o : gs[gi]; g8[4 + gi] = hf ? gs[gi] : o; }
        unsigned gsel = 0u;
#pragma unroll
        for (int a = 0; a < 8; ++a) {
            int rank = 0;
#pragma unroll
            for (int b = 0; b < 8; ++b) rank += (g8[b] > g8[a] || (g8[b] == g8[a] && b < a)) ? 1 : 0;
            if (rank < 4) gsel |= 1u << a;
        }
#pragma unroll
        for (int gi = 0; gi < 4; ++gi) {
            const bool on = ((gsel >> (4 * hf + gi)) & 1u) != 0u;
#pragma unroll
            for (int i = 0; i < 32; ++i) {
                const unsigned kb = (__float_as_uint(v[32 * gi + i] + 1.0f) & ~0xFFu) | (unsigned)(255 - (128 * hf + 32 * gi + i));
                key[32 * gi + i] = on ? kb : 0u;
            }
        }
    }
    unsigned win[8];
    unsigned prev = 0xFFFFFFFFu;
#pragma unroll
    for (int r = 0; r < 8; ++r) {
        unsigned m = 0u;
#pragma unroll
        for (int i = 0; i < 128; ++i) { const unsigned kk = key[i]; const unsigned c = kk < prev ? kk : 0u; m = m > c ? m : c; }
        const unsigned o = dpp_xor1_u(m);
        m = m > o ? m : o;
        prev = m;
        win[r] = m;
    }
    float sc8[8]; float wsum = 0.f;
#pragma unroll
    for (int r = 0; r < 8; ++r) { const int e = 255 - (int)(win[r] & 255u); sc8[r] = row[e] - bias[e]; wsum += sc8[r]; }
    int* lc = (int*)(smem + MOE_TAB); int* gbase = lc + 256;
    if (tid < 256) lc[tid] = 0;
    __syncthreads();
    int mye[4], myr[4];
    const unsigned hmask = 0u - (unsigned)hf;
#pragma unroll
    for (int u = 0; u < 4; ++u) {
        const unsigned w = win[u] ^ ((win[u] ^ win[4 + u]) & hmask);
        mye[u] = 255 - (int)(w & 255u); myr[u] = atomicAdd(lc + mye[u], 1);
    }
    __syncthreads();
    if (tid < 256) { const int n = lc[tid]; if (n > 0) gbase[tid] = atomicAdd((int*)(ws + WS_CNT) + 8192 * rep + tid * 32, n); }
    __syncthreads();
    {
        const long t = tok0 + tk;
        const float wn = 2.5f / wsum;
#pragma unroll
        for (int u = 0; u < 4; ++u) {
            const int k = 4 * hf + u;
            const int e = mye[u];
            const unsigned s0 = __float_as_uint(sc8[u]), s1 = __float_as_uint(sc8[4 + u]);
            const float w = __uint_as_float(s0 ^ ((s0 ^ s1) & hmask)) * wn;
            const int pos = gbase[e] + myr[u];
            ((int*)(ws + WS_SELE))[t * 8 + k] = e;
            ((int*)(ws + WS_SELP))[t * 8 + k] = pos;
            ((float*)(ws + WS_SELW))[t * 8 + k] = w;
            ((int*)(ws + WS_TOKL))[(long)e * LIST_CAP + pos] = (int)t;
            ((float*)(ws + WS_WL))[(long)e * LIST_CAP + pos] = w;
        }
    }
    __syncthreads();
}

__device__ __forceinline__ void phase8(const Params& p, char* smem, int bid, int nb, int rep = 0) {
    char* ws = p.ws;
    const float* lnf = (const float*)(ws + WS_LNF);
    XcdSlab xs; xs.init(bid, nb);
    const int m_lo = xs.m_lo(128), m_n = xs.m_hi(128) - m_lo;
    for (int u = xs.j; u < m_n; u += xs.stride) {
        const int mt = m_lo + u;
        float* gsc = (float*)(ws + WS_RSC);
        {
            RingRows al, bl;
            al.init_contig((const bf16_t*)(ws + WS_R2B), 1024, mt * 256);
            bl.init_contig((const bf16_t*)(ws + WS_WR), 1024, 0, true);
            f32x4 acc[8][4];
            gemm_ring(smem, al, bl, 32, acc);
            ln_correct<0>(acc, (const float*)(ws + WS_ST2), mt * 256, lnf + 1024, lnf + 1792 + 1024, 0);
            const int tid_ = opaque_tid();
            const int lane = tid_ & 63, wid = tid_ >> 6;
            const int wr = wid >> 2, wc = wid & 3, fr = lane & 15, fq = lane >> 4;
            const float* bias = p.in[I_ROUTB];
#pragma unroll
            for (int ni = 0; ni < 4; ++ni) {
                const int col = wc * 64 + (ni >> 1) * 32 + fq * 8 + (ni & 1) * 4;
                const f32x4 bv = *(const f32x4*)(bias + col);
#pragma unroll
                for (int mi = 0; mi < 8; ++mi) {
                    f32x4 v;
#pragma unroll
                    for (int e = 0; e < 4; ++e) v[e] = sigmoidf_(acc[mi][ni][e]) + bv[e];
                    *(f32x4*)(gsc + (long)(mt * 256 + wr * 128 + mi * 16 + fr) * 256 + col) = v;
                }
            }
        }
        __syncthreads();
        route_tile(p, smem, mt * 256, rep);
    }
    for (int u = (xs.j + xs.stride - m_n % xs.stride) % xs.stride; u < m_n * 2; u += xs.stride) {
        const int mt = m_lo + (u >> 1), nt = u & 1;
        RingRows al, bl;
        al.init_contig((const bf16_t*)(ws + WS_R2B), 1024, mt * 256);
        bl.init_contig((const bf16_t*)(ws + WS_WS13), 1024, nt * 256);
        f32x4 acc[8][4];
        gemm_ring(smem, al, bl, 32, acc);
        ln_correct<1>(acc, (const float*)(ws + WS_ST2), mt * 256, lnf + 1280, lnf + 1792 + 1280, nt);
        RowIdent rm; rm.row0 = (long)mt * 256;
        epi_swiglu(acc, (bf16_t*)(ws + WS_HS), 256, nt, rm);
    }
    {
        const int tid = opaque_tid(), lane = tid & 63, wid = tid >> 6;
        const bf16_t* r2 = (const bf16_t*)(ws + WS_R2B); const float* st2 = (const float*)(ws + WS_ST2);
        unsigned char* x2 = (unsigned char*)(ws + WS_X2F8);
        for (int t = bid * 8 + wid; t < T_TOK; t += nb * 8) {
            const f32x4 p0 = *(const f32x4*)(st2 + (long)t * 8), p1 = *(const f32x4*)(st2 + (long)t * 8 + 4);
            const float q1 = (p0[0] + p0[2]) + (p1[0] + p1[2]), q2 = (p0[1] + p0[3]) + (p1[1] + p1[3]);
            const float mean = q1 * (1.0f / 1024.0f);
            const float rstd = rsqrtf(fmaxf(q2 * (1.0f / 1024.0f) - mean * mean, 0.f) + LN_EPS);
#pragma unroll
            for (int hseg = 0; hseg < 2; ++hseg) {
                const int col = hseg * 512 + lane * 8;
                const u32x4 ru = *(const u32x4*)(r2 + (long)t * 1024 + col);
                const f32x4 a0 = (f32x4){bf_lo(ru.x), bf_hi(ru.x), bf_lo(ru.y), bf_hi(ru.y)}, a1 = (f32x4){bf_lo(ru.z), bf_hi(ru.z), bf_lo(ru.w), bf_hi(ru.w)};
                const f32x4 g0 = *(const f32x4*)(p.in[I_LN2G] + col), g1 = *(const f32x4*)(p.in[I_LN2G] + col + 4);
                const f32x4 b0 = *(const f32x4*)(p.in[I_LN2B] + col), b1 = *(const f32x4*)(p.in[I_LN2B] + col + 4);
                const f32x4 y0 = (a0 - mean) * rstd * g0 + b0, y1 = (a1 - mean) * rstd * g1 + b1;
                u32x2 w; w.x = pk4_fp8(y0[0], y0[1], y0[2], y0[3]); w.y = pk4_fp8(y1[0], y1[1], y1[2], y1[3]);
                *(u32x2*)(x2 + (long)t * 1024 + col) = w;
            }
        }
    }
}

template <int XMODE>
__device__ __forceinline__ void phase_probe(const Params& p, char* smem, int bid, int nb) {
    char* ws = p.ws;
    XcdSlab xs; xs.init(bid, nb);
    const int m_lo = xs.m_lo(128), n_t = (xs.m_hi(128) - m_lo) * 4;
    for (int u = xs.j; u < n_t; u += xs.stride) {
        const int mt = m_lo + (u >> 2), nt = u & 3;
        RingRows al, bl;
        al.init_blocked((const bf16_t*)(ws + WS_MIX), 1024, mt * 256);
        bl.init_blocked((const bf16_t*)(ws + WS_WOUT), 1024, nt * 256, true);
        f32x4 acc[8][4];
        gemm_ring<RingRows, RingRows, XMODE>(smem, al, bl, 32, acc);
        epi_store_bf16(acc, (bf16_t*)(ws + WS_A + 432 * MB), 1024, mt * 256, nt * 256);
    }
}

__device__ __forceinline__ void moe_tables(const Params& p, char* smem, const XcdSlab& xs) {
    int* off = (int*)(smem + MOE_TAB); int* tst = off + 256; int* cntl = tst + 260;
    const int* cnt = (const int*)(p.ws + WS_CNT);
    const int tid = opaque_tid();
    if (tid >= 256) cntl[tid - 256] = cnt[(tid - 256) * 32];
    if (tid < 64) {
        int c[4], cs = 0;
#pragma unroll
        for (int k = 0; k < 4; ++k) { c[k] = cnt[(tid * 4 + k) * 32]; cs += c[k]; }
        int ics = cs;
#pragma unroll
        for (int o = 1; o < 64; o <<= 1) { const int a = __shfl_up(ics, o); if (tid >= o) ics += a; }
        int eo = ics - cs;
#pragma unroll
        for (int k = 0; k < 4; ++k) { off[tid * 4 + k] = eo; eo += c[k]; }
    } else if (tid < 128) {
        const int l = tid - 64;
        if (xs.x >= 0) {
            const int tl = l < 32 ? ((cnt[(xs.x + 8 * l) * 32] + 255) >> 8) : 0;
            int it = tl;
#pragma unroll
            for (int o = 1; o < 64; o <<= 1) { const int a = __shfl_up(it, o); if (l >= o) it += a; }
            if (l < 32) tst[l] = it - tl;
            if (l == 31) tst[32] = it;
        } else {
            int c[4], ts = 0;
#pragma unroll
            for (int k = 0; k < 4; ++k) { c[k] = (cnt[(l * 4 + k) * 32] + 255) >> 8; ts += c[k]; }
            int its = ts;
#pragma unroll
            for (int o = 1; o < 64; o <<= 1) { const int a = __shfl_up(its, o); if (l >= o) its += a; }
            int et = its - ts;
#pragma unroll
            for (int k = 0; k < 4; ++k) { tst[l * 4 + k] = et; et += c[k]; }
            if (l == 63) tst[256] = its;
        }
    }
    __syncthreads();
}
__device__ __forceinline__ int moe_find(const int* tst, int nloc, int t) {
    int lo = 0, hi = nloc - 1;
#pragma unroll 1
    while (lo < hi) { const int mid = (lo + hi + 1) >> 1; if (tst[mid] <= t) lo = mid; else hi = mid - 1; }
    return lo;
}
struct RowMoe { long base; int nvalid; __device__ __forceinline__ long operator()(int rl) const { return rl < nvalid ? base + rl : -1; } };

template <int PARTS9 = 3>
__device__ __forceinline__ void phase9(const Params& p, char* smem, int bid, int nb) {
    char* ws = p.ws;
    XcdSlab xs; xs.init(bid, nb);
    moe_tables(p, smem, xs);
    const int* off = (const int*)(smem + MOE_TAB); const int* tst = off + 256;
    const int* cnt = (const int*)(ws + WS_CNT);
    const int nloc = xs.x >= 0 ? 32 : 256;
    const int ntile = tst[nloc];
    {
        const int* cntl = tst + 260;
        const int nT = ntile * 2;
        int t = xs.j;
        int e = 0, m0 = 0, ne = 0, nt = 0;
        RingF8 al, bl;
        auto setup = [&](int tt) {
            const int et = tt >> 1; nt = tt & 1;
            const int kl = moe_find(tst, nloc, et); e = xs.x >= 0 ? xs.x + 8 * kl : kl; m0 = (et - tst[kl]) * 256; ne = cntl[e];
            const int tid = opaque_tid();
            const int* tl = (const int*)(ws + WS_TOKL) + (long)e * LIST_CAP;
            int rows[2];
#pragma unroll
            for (int i = 0; i < 2; ++i) { const int r = m0 + (tid >> 2) + 128 * i; rows[i] = r < ne ? tl[r] : 0; }
            al.init_rows((const unsigned char*)(ws + WS_X2F8), 1024, rows);
            bl.init_contig((const unsigned char*)p.out, 1024, (long)(e * 2 + nt) * 256);
        };
        if (!(PARTS9 & 1)) t = nT;
        TS(0);
        if (t < nT) { setup(t); ring_f8_issue3(smem, al, bl); }
        int tsi = 1;
        while (t < nT) {
            const int ce = e, cm0 = m0, cne = ne, cnt_ = nt;
            f32x16 acc[4][2];
            gemm_ring_mx_main(smem, al, bl, 16, acc);
            if (tsi < 3) { TS(tsi); }
            t += xs.stride;
            if (t < nT) { setup(t); ring_f8_issue3(smem, al, bl); }
            {
                const int tid2 = opaque_tid();
                const int lane = tid2 & 63, wid = tid2 >> 6;
                const int wr = wid >> 2, wc = wid & 3, r = lane & 31, h = lane >> 5;
                unsigned char* H = (unsigned char*)(ws + WS_HF8) + ((long)off[ce] + cm0) * 256 + cnt_ * 128 + wc * 32 + h * 16;
                constexpr float D = 1.0f / W8_SCALE, HS = H8_SCALE / W8_SCALE;
#pragma unroll
                for (int mi = 0; mi < 4; ++mi) {
                    const int rl = wr * 128 + mi * 32 + r;
                    if (cm0 + rl < cne) {
                        float o[16];
#pragma unroll
                        for (int q = 0; q < 16; ++q) o[q] = siluf_(acc[mi][0][q] * D) * (acc[mi][1][q] * HS);
                        u32x4 w; w.x = pk4_fp8(o[0], o[1], o[2], o[3]); w.y = pk4_fp8(o[4], o[5], o[6], o[7]); w.z = pk4_fp8(o[8], o[9], o[10], o[11]); w.w = pk4_fp8(o[12], o[13], o[14], o[15]);
                        *(u32x4*)(H + (long)rl * 256) = w;
                    }
                }
            }
            if (tsi < 3) { TS(tsi + 2); } ++tsi;
        }
        asm volatile("s_waitcnt vmcnt(0)" ::: "memory"); __syncthreads();
        TS(5);
    }
    const int m_lo = xs.m_lo(128), n_t = (PARTS9 & 2) ? (xs.m_hi(128) - m_lo) * 4 : 0;
    for (int u = (xs.j + xs.stride - (ntile * 2) % xs.stride) % xs.stride; u < n_t; u += xs.stride) {
        const int mt = m_lo + (u >> 2), nt = u & 3;
        RingRows al, bl;
        al.init_contig((const bf16_t*)(ws + WS_HS), 256, mt * 256);
        bl.init_contig((const bf16_t*)(ws + WS_WS2), 256, nt * 256, true);
        f32x4 acc[8][4];
        gemm_ring(smem, al, bl, 8, acc);
        __syncthreads();
        epi_store_bf16(acc, (bf16_t*)(ws + WS_SH), 1024, mt * 256, nt * 256);
    }
    TS(6);
}

template <int P10V = 0  >
__device__ __forceinline__ void phase10(const Params& p, char* smem, int bid, int nb) {
    char* ws = p.ws;
    XcdSlab xs; xs.init(bid, nb);
    moe_tables(p, smem, xs);
    const int* off = (const int*)(smem + MOE_TAB); const int* tst = off + 256;
    const int* cnt = (const int*)(ws + WS_CNT);
    const int nloc = xs.x >= 0 ? 32 : 256;
    const int ntile = tst[nloc];
    {
        const int* cntl = tst + 260;
        const int nT = ntile;
        const int tid_ = opaque_tid();
        const int lane = tid_ & 63, wid = __builtin_amdgcn_readfirstlane(tid_ >> 6);
        const int wr = wid >> 2, wc = wid & 3, r = lane & 31, h = lane >> 5;
        const int g = (r >> 2) & 3;
        const int c0 = ((2 * h) ^ g) << 4, c1 = ((2 * h + 1) ^ g) << 4;
        const int arow = (wr * 128 + r) * 64;
        const int brow = (wc * 64 + r) * 64;
        char* ringB = smem + 65536;
        for (int t = xs.j; t < nT; t += xs.stride) {
            const int kl = moe_find(tst, nloc, t), e = xs.x >= 0 ? xs.x + 8 * kl : kl, m0 = (t - tst[kl]) * 256, ne = cntl[e];
            RingF8 al, bl;
            al.init_contig((const unsigned char*)(ws + WS_HF8), 256, (long)off[e] + m0);
            bl.init_contig((const unsigned char*)(ws + WS_W2F8), 256, (long)(e * 4) * 256);
            const float* wl = (const float*)(ws + WS_WL) + (long)e * LIST_CAP + m0;
            float* rwl = (float*)(smem + MOE_TAB + 4096);
            if (tid_ < 256) rwl[tid_] = (m0 + tid_ < ne) ? wl[tid_] * (Y8_SCALE / (W8_SCALE * H8_SCALE)) : 0.f;
            unsigned char* Yb = (unsigned char*)(ws + WS_Y) + ((long)off[e] + m0) * 1024 + wc * 64 + h * 16;
#pragma unroll
            for (int ks = 0; ks < 4; ++ks) al.issue(smem + ks * 16384, ks);
            auto issueB = [&](int bt, int stg) {
                const int nt_ = bt >> 2, ks_ = bt & 3;
                char* s = ringB + stg * 16384;
#pragma unroll
                for (int i = 0; i < 2; ++i)
                    __builtin_amdgcn_global_load_lds((glb_u32*)(bl.base + (size_t)(bl.off[i] + (unsigned)(nt_ * 65536 + ks_ * 64))), (lds_u32*)(s + i * 8192 + bl.ldst), 16, 0, 0);
            };
            issueB(0, 0); issueB(1, 1); issueB(2, 2); issueB(3, 3);
            RING_WAIT(6);
            RING_BAR();
            if (wr == 1) RING_BAR();
            f32x16 acc[4][2];
#pragma unroll
            for (int mi = 0; mi < 4; ++mi)
#pragma unroll
                for (int nj = 0; nj < 2; ++nj)
#pragma unroll
                    for (int q = 0; q < 16; ++q) acc[mi][nj][q] = 0.f;
            int sg = 0;
#pragma unroll 1
            for (int bt = 0; bt < 16; ++bt) {
                const char* sa = smem + (bt & 3) * 16384;
                const char* sb = ringB + sg * 16384;
                { const int s4 = sg == 0 ? 4 : sg - 1; if (bt + 4 < 16) issueB(bt + 4, s4); }
                i32x8 bf[2], af[4];
#pragma unroll
                for (int nj = 0; nj < 2; ++nj) bf[nj] = mx_frag(sb + brow + nj * 2048, c0, c1);
#pragma unroll
                for (int mi = 0; mi < 4; ++mi) af[mi] = mx_frag(sa + arow + mi * 2048, c0, c1);
                if (bt + 1 < 16) { if (bt + 4 < 16) RING_WAIT(6); else if (bt + 3 < 16) RING_WAIT(4); else if (bt + 2 < 16) RING_WAIT(2); else RING_WAIT(0); }
                RING_BAR();
                __builtin_amdgcn_s_setprio(1);
                if (P10V != 2) {
#pragma unroll
                for (int mi = 0; mi < 4; ++mi)
#pragma unroll
                    for (int nj = 0; nj < 2; ++nj) acc[mi][nj] = mfma_mx(bf[nj], af[mi], acc[mi][nj]);
                } else { acc[0][0][0] += (float)(af[0][0] + bf[0][0] + af[3][7] + bf[1][3]); }
                __builtin_amdgcn_s_setprio(0);
                if ((bt & 3) == 3) {
                    const int nt_ = bt >> 2;
#pragma unroll
                    for (int mi = 0; mi < 4; ++mi) {
                        const int rl = wr * 128 + mi * 32 + r;
                        if (m0 + rl < ne) {
                            const float w = rwl[rl];
#pragma unroll
                            for (int nj = 0; nj < 2; ++nj) {
                                const f32x16 u = acc[mi][nj] * w;
                                u32x4 v; v.x = pk4_fp8(u[0], u[1], u[2], u[3]); v.y = pk4_fp8(u[4], u[5], u[6], u[7]); v.z = pk4_fp8(u[8], u[9], u[10], u[11]); v.w = pk4_fp8(u[12], u[13], u[14], u[15]);
                                if (P10V != 1) *(u32x4*)(Yb + (long)rl * 1024 + nt_ * 256 + nj * 32) = v; else if (v.x == 0x12345678u) *(u32x4*)(Yb) = v;
                            }
                        }
#pragma unroll
                        for (int nj = 0; nj < 2; ++nj)
#pragma unroll
                            for (int q = 0; q < 16; ++q) acc[mi][nj][q] = 0.f;
                    }
                }
                RING_BAR();
                sg = sg == 4 ? 0 : sg + 1;
            }
            if (wr == 0) RING_BAR();
        }
    }
}

__device__ __forceinline__ void phase11(const Params& p, char* smem, int bid, int nb) {
    char* ws = p.ws;
    XcdSlab xs; xs.init(bid, nb);
    moe_tables(p, smem, xs);
    const int* off = (const int*)(smem + MOE_TAB);
    const int tid = opaque_tid(), lane = tid & 63, wid = tid >> 6;
    const bf16_t* r2 = (const bf16_t*)(ws + WS_R2B);
    const float* st2 = (const float*)(ws + WS_ST2);
    const bf16_t* SH = (const bf16_t*)(ws + WS_SH);
    const unsigned char* Y = (const unsigned char*)(ws + WS_Y);
    const int* sele = (const int*)(ws + WS_SELE); const int* selp = (const int*)(ws + WS_SELP);
    for (int t = bid * 8 + wid; t < T_TOK; t += nb * 8) {
        const f32x4 p0 = *(const f32x4*)(st2 + (long)t * 8), p1 = *(const f32x4*)(st2 + (long)t * 8 + 4);
        const float q1 = (p0[0] + p0[2]) + (p1[0] + p1[2]), q2 = (p0[1] + p0[3]) + (p1[1] + p1[3]);
        const float mean2 = q1 * (1.0f / 1024.0f);
        const float rstd2 = rsqrtf(fmaxf(q2 * (1.0f / 1024.0f) - mean2 * mean2, 0.f) + LN_EPS);
        int yrow[8];
#pragma unroll
        for (int k = 0; k < 8; ++k) yrow[k] = off[sele[(long)t * 8 + k]] + selp[(long)t * 8 + k];
        float v[16];
#pragma unroll
        for (int hseg = 0; hseg < 2; ++hseg) {
            const int col = hseg * 512 + lane * 8;
            const u32x4 ru = *(const u32x4*)(r2 + (long)t * 1024 + col);
            const f32x4 a0 = (f32x4){bf_lo(ru.x), bf_hi(ru.x), bf_lo(ru.y), bf_hi(ru.y)}, a1 = (f32x4){bf_lo(ru.z), bf_hi(ru.z), bf_lo(ru.w), bf_hi(ru.w)};
            const f32x4 g0 = *(const f32x4*)(p.in[I_LN2G] + col), g1 = *(const f32x4*)(p.in[I_LN2G] + col + 4);
            const f32x4 b0 = *(const f32x4*)(p.in[I_LN2B] + col), b1 = *(const f32x4*)(p.in[I_LN2B] + col + 4);
            const f32x4 x0 = ((a0 - mean2) * rstd2 * g0 + b0) * ALPHA, x1 = ((a1 - mean2) * rstd2 * g1 + b1) * ALPHA;
            float* vv = v + hseg * 8;
            vv[0] = x0[0]; vv[1] = x0[1]; vv[2] = x0[2]; vv[3] = x0[3]; vv[4] = x1[0]; vv[5] = x1[1]; vv[6] = x1[2]; vv[7] = x1[3];
            const u32x4 s = __builtin_nontemporal_load((const u32x4*)(SH + (long)t * 1024 + col));
            vv[0] += bf_lo(s.x); vv[1] += bf_hi(s.x); vv[2] += bf_lo(s.y); vv[3] += bf_hi(s.y); vv[4] += bf_lo(s.z); vv[5] += bf_hi(s.z); vv[6] += bf_lo(s.w); vv[7] += bf_hi(s.w);
            f32x2 ys[4];
#pragma unroll
            for (int e2 = 0; e2 < 4; ++e2) ys[e2] = (f32x2){0.f, 0.f};
#pragma unroll
            for (int k = 0; k < 8; ++k) {
                const u32x2 y = __builtin_nontemporal_load((const u32x2*)(Y + (long)yrow[k] * 1024 + col));
                ys[0] += __builtin_amdgcn_cvt_pk_f32_fp8((int)y.x, false); ys[1] += __builtin_amdgcn_cvt_pk_f32_fp8((int)y.x, true);
                ys[2] += __builtin_amdgcn_cvt_pk_f32_fp8((int)y.y, false); ys[3] += __builtin_amdgcn_cvt_pk_f32_fp8((int)y.y, true);
            }
#pragma unroll
            for (int e2 = 0; e2 < 4; ++e2) { vv[2 * e2] += ys[e2][0] * (1.0f / Y8_SCALE); vv[2 * e2 + 1] += ys[e2][1] * (1.0f / Y8_SCALE); }
        }
        float s1 = 0.f;
#pragma unroll
        for (int i = 0; i < 16; ++i) s1 += v[i];
#pragma unroll
        for (int o = 32; o >= 1; o >>= 1) s1 += __shfl_xor(s1, o);
        const float mean = s1 * (1.0f / 1024.0f);
        float s2 = 0.f;
#pragma unroll
        for (int i = 0; i < 16; ++i) { const float d = v[i] - mean; s2 += d * d; }
#pragma unroll
        for (int o = 32; o >= 1; o >>= 1) s2 += __shfl_xor(s2, o);
        const float rstd = rsqrtf(s2 * (1.0f / 1024.0f) + LN_EPS);
#pragma unroll
        for (int hseg = 0; hseg < 2; ++hseg) {
            const int col = hseg * 512 + lane * 8;
            const f32x4 g0 = *(const f32x4*)(p.in[I_LN3G] + col), g1 = *(const f32x4*)(p.in[I_LN3G] + col + 4);
            const f32x4 b0 = *(const f32x4*)(p.in[I_LN3B] + col), b1 = *(const f32x4*)(p.in[I_LN3B] + col + 4);
            const float* vv = v + hseg * 8;
            f32x4 o0, o1;
#pragma unroll
            for (int e = 0; e < 4; ++e) { o0[e] = (vv[e] - mean) * rstd * g0[e] + b0[e]; o1[e] = (vv[4 + e] - mean) * rstd * g1[e] + b1[e]; }
            *(f32x4*)(p.out + (long)t * 1024 + col) = o0; *(f32x4*)(p.out + (long)t * 1024 + col + 4) = o1;
        }
    }
}

#if MEGA
#define XB_TMO      128
#define XB_XCNT(j)  (256  + 64 * (j))
#define XB_XSUB(j)  (1280 + 64 * (j))
#define XB_XGEN(j)  (2304 + 64 * (j))
#define XB_TOP      3328
#define XB_TOPGEN   3392
#define XCD_BAR_WORDS 3456
#define XB_SPIN_CAP (1u << 22)
#define LAS __attribute__((address_space(3)))
__device__ __forceinline__ unsigned xb_ld(unsigned* p)              { return __hip_atomic_load(p, __ATOMIC_RELAXED, __HIP_MEMORY_SCOPE_AGENT); }
__device__ __forceinline__ unsigned xb_add(unsigned* p, unsigned v) { return __hip_atomic_fetch_add(p, v, __ATOMIC_RELAXED, __HIP_MEMORY_SCOPE_AGENT); }
__device__ __forceinline__ unsigned xb_xcc_id() { return (unsigned)__builtin_amdgcn_s_getreg((3 << 11) | 20) & 0xFu; }
#define XB_SPIN(cond, bar) do { unsigned _sp = 0; while (cond) { __builtin_amdgcn_s_sleep(1); \
    if ((++_sp & 255u) == 0u) { if (xb_ld(&(bar)[XB_TMO])) break; if (_sp > XB_SPIN_CAP) { atomicAdd(&(bar)[XB_TMO], 1u); break; } } } } while (0)
struct XcdBarrier { unsigned* bar; unsigned x; volatile LAS unsigned* st; };
__device__ __forceinline__ XcdBarrier xcd_barrier_post(unsigned* bar, volatile LAS unsigned* st) {
    XcdBarrier b; b.bar = bar; b.x = xb_xcc_id(); b.st = st;
    if (threadIdx.x == 0) (void)xb_add(&bar[XB_XCNT(b.x)], 1u);
    return b;
}
__device__ __forceinline__ void xcd_barrier_complete(unsigned* bar, unsigned x, unsigned& nloc, unsigned& nx) {
    const unsigned G = gridDim.x * gridDim.y * gridDim.z;
    unsigned sum, cnt, mine, sp = 0u;
    for (;;) {
        sum = 0u; cnt = 0u; mine = 0u;
#pragma unroll
        for (unsigned j = 0; j < 16; ++j) { const unsigned c = xb_ld(&bar[XB_XCNT(j)]); sum += c; cnt += (c > 0u) ? 1u : 0u; mine = (j == x) ? c : mine; }
        if (sum == G) break;
        __builtin_amdgcn_s_sleep(1);
        if ((++sp & 255u) == 0u) { if (xb_ld(&bar[XB_TMO])) break; if (sp > XB_SPIN_CAP) { atomicAdd(&bar[XB_TMO], 1u); break; } }
    }
    nloc = mine > 0u ? mine : 1u; nx = cnt > 0u ? cnt : 1u;
}
__device__ __forceinline__ void xcd_barrier(const XcdBarrier& b) {
    asm volatile("s_waitcnt vmcnt(0)" ::: "memory");
    __syncthreads();
    if (threadIdx.x == 0) {
        unsigned* bar = b.bar;
        __builtin_amdgcn_s_waitcnt(0);
        unsigned nloc = b.st[0], nx = b.st[1];
        if (nloc == 0u) { xcd_barrier_complete(bar, b.x, nloc, nx); b.st[0] = nloc; b.st[1] = nx; }
        const unsigned old = xb_add(&bar[XB_XSUB(b.x)], 1u);
        const unsigned gen = old / nloc;
        if (old + 1u == (gen + 1u) * nloc) {
            __builtin_amdgcn_fence(__ATOMIC_RELEASE, "agent");
            asm volatile("s_waitcnt vmcnt(0)" ::: "memory");
            const unsigned og = xb_add(&bar[XB_TOP], 1u);
            const unsigned tg = og / nx;
            if (og + 1u == (tg + 1u) * nx) xb_add(&bar[XB_TOPGEN], 1u);
            else XB_SPIN(xb_ld(&bar[XB_TOPGEN]) == tg, bar);
            __builtin_amdgcn_fence(__ATOMIC_ACQUIRE, "agent");
            xb_add(&bar[XB_XGEN(b.x)], 1u);
            asm volatile("s_waitcnt vmcnt(0)" ::: "memory");
        } else {
            XB_SPIN(xb_ld(&bar[XB_XGEN(b.x)]) == gen, bar);
            __builtin_amdgcn_fence(__ATOMIC_ACQUIRE, "agent");
            asm volatile("s_waitcnt vmcnt(0)" ::: "memory");
        }
    }
    __syncthreads();
}
__global__ void __launch_bounds__(NTHR) fwd_mega(Params p) {
    extern __shared__ __attribute__((aligned(16))) char smem[];
    cg::grid_group grid = cg::this_grid();
    const int bid = blockIdx.x, nb = gridDim.x;
    volatile LAS unsigned* xst = (volatile LAS unsigned*)(smem + LDS_BYTES - 16);
    if (threadIdx.x < 4) xst[threadIdx.x] = 0u;
    __syncthreads();
    const XcdBarrier xb = xcd_barrier_post((unsigned*)(p.ws + WS_BAR), xst);
#define GSYNC() xcd_barrier(xb)
#ifndef PROBE_REPEAT
#define PROBE_REPEAT 0
#endif
#define REP(n, call) if (PROBE_REPEAT & (1 << n)) { call; GSYNC(); }
#ifdef PROBE_T
#define TSPIN(n) if (PROBE_TP == n && bid == PROBE_TB && threadIdx.x == 0) { volatile long* tsv = (volatile long*)(smem + 163760); \
        const long d = tsv[PROBE_T1] - tsv[PROBE_T]; const long te = (long)wall_clock64() + d * 50; while ((long)wall_clock64() < te) __builtin_amdgcn_s_sleep(8); }
#else
#define TSPIN(n)
#endif
    if (PROBE_REPEAT & 1) { phase0(p, smem, bid, nb); GSYNC(); }
#ifdef PROBE_XCC
    {
        unsigned* rec = (unsigned*)(p.ws + WS_A + 432 * MB);
        if (threadIdx.x == 0) rec[bid] = xb_xcc_id();
        grid.sync();
        int mism = 0, distinct = 0;
        for (int b = 0; b < nb; ++b) { if (rec[b] != rec[b & 7]) ++mism; }
        for (int a = 0; a < 8; ++a) { bool dup = false; for (int b2 = 0; b2 < a; ++b2) dup = dup || (rec[a] == rec[b2]); if (!dup) ++distinct; }
        const float v = sqrtf((float)(PROBE_XCC == 1 ? mism : distinct) + 1.0f);
        for (long i = (long)bid * NTHR + threadIdx.x; i < (long)T_TOK * 1024; i += (long)nb * NTHR) p.out[i] = v;
        return;
    }
#endif
    phase0(p, smem, bid, nb);  grid.sync();
    REP(1, phase1<1>(p, smem, bid, nb))
    phase1(p, smem, bid, nb);  GSYNC();
    REP(2, phase2(p, smem, bid, nb))
    phase2(p, smem, bid, nb);  GSYNC();
#ifndef PROBE_P3PARTS
#define PROBE_P3PARTS 7
#endif
#ifndef PROBE_NSAV
#define PROBE_NSAV 7
#endif
    REP(3, (phase3<PROBE_P3PARTS, PROBE_NSAV>(p, smem, bid, nb, 1)))
    phase3(p, smem, bid, nb);  GSYNC();
    REP(4, phase4(p, smem, bid, nb))
#ifdef PROBE_X
    phase_probe<PROBE_X>(p, smem, bid, nb); GSYNC();
#endif
    phase4(p, smem, bid, nb);  TSPIN(4) GSYNC();
    REP(5, phase5(p, smem, bid, nb))
    phase5(p, smem, bid, nb);  TSPIN(5) GSYNC();
    REP(6, phase6(p, smem, bid, nb))
    phase6(p, smem, bid, nb);  GSYNC();
    REP(7, phase7(p, smem, bid, nb))
    phase7(p, smem, bid, nb);  TSPIN(7) GSYNC();
    REP(8, phase8(p, smem, bid, nb, 1))
    phase8(p, smem, bid, nb);  GSYNC();
#ifndef PROBE_P9PARTS
#define PROBE_P9PARTS 3
#endif
    REP(9, phase9<PROBE_P9PARTS>(p, smem, bid, nb))
    phase9(p, smem, bid, nb);  TSPIN(9) GSYNC();
#ifndef PROBE_P10V
#define PROBE_P10V 0
#endif
    REP(10, phase10<PROBE_P10V>(p, smem, bid, nb))
    phase10(p, smem, bid, nb); GSYNC();
    REP(11, phase11(p, smem, bid, nb))
    phase11(p, smem, bid, nb);
}
#else
#define PHASE_KERNEL(n) __global__ void __launch_bounds__(NTHR) fwd_phase##n(Params p) { extern __shared__ __attribute__((aligned(16))) char smem[]; phase##n(p, smem, blockIdx.x, gridDim.x); }
PHASE_KERNEL(0) PHASE_KERNEL(1) PHASE_KERNEL(2) PHASE_KERNEL(3) PHASE_KERNEL(4) PHASE_KERNEL(5)
PHASE_KERNEL(6) PHASE_KERNEL(7) PHASE_KERNEL(8) PHASE_KERNEL(9) PHASE_KERNEL(10) PHASE_KERNEL(11)
typedef void (*phase_fn)(Params);
#endif

extern "C" void kernel_launch(void* const* d_in, const int* in_sizes, int n_in, void* d_out, int out_size, void* d_ws, size_t ws_size, hipStream_t stream) {
    Params p{};
    for (int i = 0; i < 32; ++i) p.in[i] = (const float*)d_in[i];
    p.out = (float*)d_out;
    p.ws = (char*)d_ws;
    if (n_in != 32 || ws_size < WS_END) { fprintf(stderr, "kernel_launch: unexpected inputs (n_in %d) or workspace too small (%zu < %zu)\n", n_in, ws_size, (size_t)WS_END); return; }
#if MEGA
    static int grid = 0;
    if (!grid) {
        int dev = 0, cus = 0, per_cu = 0;
        (void)hipGetDevice(&dev);
        (void)hipDeviceGetAttribute(&cus, hipDeviceAttributeMultiprocessorCount, dev);
        (void)hipFuncSetAttribute((const void*)fwd_mega, hipFuncAttributeMaxDynamicSharedMemorySize, LDS_BYTES);
        (void)hipOccupancyMaxActiveBlocksPerMultiprocessor(&per_cu, (const void*)fwd_mega, NTHR, LDS_BYTES);
        if (per_cu < 1) { fprintf(stderr, "kernel_launch: occupancy query says %d blocks/CU\n", per_cu); per_cu = 1; }
        grid = cus;
    }
    (void)hipMemsetAsync((char*)d_ws + WS_BAR, 0, 16384, stream);
    void* args[] = {&p};
    hipError_t e = hipLaunchCooperativeKernel((const void*)fwd_mega, dim3(grid), dim3(NTHR), args, LDS_BYTES, stream);
    if (e != hipSuccess) fprintf(stderr, "cooperative launch failed: %s (grid %d)\n", hipGetErrorString(e), grid);
#else
    static const phase_fn fns[12] = {fwd_phase0, fwd_phase1, fwd_phase2, fwd_phase3, fwd_phase4, fwd_phase5, fwd_phase6, fwd_phase7, fwd_phase8, fwd_phase9, fwd_phase10, fwd_phase11};
    static bool attr = false;
    if (!attr) { for (int i = 0; i < 12; ++i) (void)hipFuncSetAttribute((const void*)fns[i], hipFuncAttributeMaxDynamicSharedMemorySize, LDS_BYTES); attr = true; }
    for (int i = 0; i < 12; ++i) hipLaunchKernelGGL(fns[i], dim3(256), dim3(NTHR), LDS_BYTES, stream, p);
#endif
}
```

```cpp
#include <hip/hip_runtime.h>
#include <hip/hip_cooperative_groups.h>
#include <stdint.h>
#include <stdio.h>
namespace cg = cooperative_groups;

#ifndef MEGA
#define MEGA 1
#endif

typedef unsigned short bf16_t;
typedef short bf16x8 __attribute__((ext_vector_type(8)));
typedef short s16x4 __attribute__((ext_vector_type(4)));
typedef float f32x4 __attribute__((ext_vector_type(4)));
typedef float f32x2 __attribute__((ext_vector_type(2)));
typedef unsigned u32x4 __attribute__((ext_vector_type(4)));
typedef unsigned u32x2 __attribute__((ext_vector_type(2)));
typedef __bf16 bf16x2_t __attribute__((ext_vector_type(2)));

#ifndef INPROJ_F8
#define INPROJ_F8 1
#endif
constexpr int T_TOK = 32768, DM = 1024, NB = 16, SEQ = 2048;
constexpr int PW = 3328;
constexpr int PC_Q = 0, PC_KC = 512, PC_VC = 640, PC_KS = 768, PC_VS = 896, PC_KW = 1024, PC_VW = 1152;
constexpr int PC_MQ = 1280, PC_MK = 1792, PC_MV = 2304, PC_MO = 2816;
constexpr float ALPHA = 1.189207115002721f;
constexpr float LN_EPS = 1e-5f;
constexpr int NTHR = 512;
constexpr int LDS_BYTES = 160 * 1024;
constexpr int NEXP = 256, TOPK = 8;
constexpr float MIX8_SCALE = 16.0f;
constexpr float W8_SCALE = 64.0f, H8_SCALE = 16.0f, Y8_SCALE = 64.0f;
constexpr int LIST_CAP = 32768;

constexpr size_t al256(size_t x) { return (x + 255) & ~(size_t)255; }
constexpr size_t WS_WIN = 0;
constexpr size_t WS_WOUT = WS_WIN + al256((size_t)3584 * 1024 * 2);
constexpr size_t WS_WQ = WS_WOUT + (size_t)1024 * 1024 * 2;
constexpr size_t WS_WKV = WS_WQ + (size_t)1024 * 1024 * 2;
constexpr size_t WS_WO = WS_WKV + (size_t)2048 * 1024 * 2;
constexpr size_t WS_WR = WS_WO + (size_t)1024 * 1024 * 2;
constexpr size_t WS_WS13 = WS_WR + (size_t)256 * 1024 * 2;
constexpr size_t WS_WS2 = WS_WS13 + (size_t)512 * 1024 * 2;
constexpr size_t WS_CK1 = WS_WS2 + (size_t)1024 * 256 * 2;
constexpr size_t WS_CK2 = WS_CK1 + (size_t)64 * 2048 * 2;
constexpr size_t WS_CV1 = WS_CK2 + (size_t)64 * 64 * 2;
constexpr size_t WS_CV2 = WS_CV1 + (size_t)64 * 2048 * 2;
constexpr size_t MB = 1024 * 1024;
constexpr size_t WS_LNP = al256(WS_CV2 + (size_t)64 * 64 * 2);
constexpr size_t WS_LNF = WS_LNP + (size_t)2 * 16 * 1792 * 4;
constexpr size_t WS_A = al256(WS_LNF + (size_t)2 * 1792 * 4 + 65536);
constexpr size_t WS_P = WS_A;
constexpr size_t WS_R1 = WS_A;
constexpr size_t WS_XQ = WS_A + 128 * MB;
constexpr size_t WS_XO = WS_A + 192 * MB;
constexpr size_t WS_XB = WS_A + 208 * MB;
constexpr size_t WS_MEMB = WS_A + 272 * MB;
constexpr size_t WS_PSM = WS_A + 280 * MB;
constexpr size_t WS_KCMP = WS_A + 284 * MB;
constexpr size_t WS_VCMP = WS_KCMP + (size_t)16 * 2 * 128 * 64 * 2;
constexpr size_t WS_XF8 = WS_A + 285 * MB;
constexpr size_t WS_MEMF8 = WS_A + 317 * MB;
constexpr size_t WS_QK = WS_A + 285 * MB;
constexpr size_t WS_MIX = WS_A + 349 * MB;
constexpr size_t WS_KVX = WS_A + 413 * MB;
constexpr size_t WS_X2F8 = WS_A + 256 * MB;
constexpr size_t WS_X2 = WS_A + 256 * MB;
constexpr size_t WS_HS = WS_A + 320 * MB;
constexpr size_t WS_R1B = WS_A;
constexpr size_t WS_RSC = WS_A;
constexpr size_t WS_Y = WS_A;
constexpr size_t WS_B = WS_A + al256((size_t)(T_TOK * 8 + 256) * 1024 * 2);
constexpr size_t WS_R2B = WS_B;
constexpr size_t WS_R2 = WS_B;
constexpr size_t WS_ST1 = WS_R2 + (size_t)T_TOK * 1024 * 4;
constexpr size_t WS_ST2 = WS_ST1 + (size_t)T_TOK * 8 * 4;
constexpr size_t WS_SH = WS_ST2 + (size_t)T_TOK * 8 * 4;
constexpr size_t WS_SELE = WS_SH + (size_t)T_TOK * 1024 * 2;
constexpr size_t WS_SELP = WS_SELE + (size_t)T_TOK * 8 * 4;
constexpr size_t WS_SELW = WS_SELP + (size_t)T_TOK * 8 * 4;
constexpr size_t WS_CNT = WS_SELW + (size_t)T_TOK * 8 * 4;
constexpr size_t WS_TOKL = WS_CNT + 98304;
constexpr size_t WS_WL = WS_TOKL + (size_t)NEXP * LIST_CAP * 4;
constexpr size_t WS_H = WS_WL + (size_t)NEXP * LIST_CAP * 4;
constexpr size_t WS_HF8 = WS_H;
constexpr size_t WS_W2F8 = WS_H + (size_t)(T_TOK * 8 + 256) * 256;
constexpr size_t WS_BAR = WS_W2F8 + (size_t)256 * 1024 * 256;
constexpr size_t WS_END = WS_BAR + 16384;
static_assert((size_t)T_TOK * PW * 2 <= 208 * MB, "P region");
static_assert(WS_END <= (size_t)1024 * MB, "workspace must fit 1 GiB");

struct Params {
    const float* in[32];
    float* out;
    char* ws;
};

__device__ __forceinline__ unsigned pk_bf16(float lo, float hi) {
    f32x2 v = {lo, hi};
    bf16x2_t r = __builtin_convertvector(v, bf16x2_t);
    return __builtin_bit_cast(unsigned, r);
}
__device__ __forceinline__ float bf_lo(unsigned u) { return __uint_as_float(u << 16); }
__device__ __forceinline__ float bf_hi(unsigned u) { return __uint_as_float(u & 0xffff0000u); }
__device__ __forceinline__ float bf2f(bf16_t h) { return __uint_as_float(((unsigned)h) << 16); }
__device__ __forceinline__ float sigmoidf_(float x) { return __builtin_amdgcn_rcpf(1.0f + __expf(-x)); }
__device__ __forceinline__ float siluf_(float x) { return x * __builtin_amdgcn_rcpf(1.0f + __expf(-x)); }
__device__ __forceinline__ f32x4 mfma16(bf16x8 a, bf16x8 b, f32x4 c) { return __builtin_amdgcn_mfma_f32_16x16x32_bf16(a, b, c, 0, 0, 0); }
__device__ __forceinline__ bf16x8 as_bf16x8(u32x4 v) { return __builtin_bit_cast(bf16x8, v); }

__device__ __forceinline__ float fq_max(float x) {
    auto a = __builtin_amdgcn_permlane16_swap(__float_as_uint(x), __float_as_uint(x), false, false);
    x = __builtin_fmaxf(__uint_as_float(a[0]), __uint_as_float(a[1]));
    auto b = __builtin_amdgcn_permlane32_swap(__float_as_uint(x), __float_as_uint(x), false, false);
    return __builtin_fmaxf(__uint_as_float(b[0]), __uint_as_float(b[1]));
}
__device__ __forceinline__ float fq_sum(float x) {
    auto a = __builtin_amdgcn_permlane16_swap(__float_as_uint(x), __float_as_uint(x), false, false);
    x = __uint_as_float(a[0]) + __uint_as_float(a[1]);
    auto b = __builtin_amdgcn_permlane32_swap(__float_as_uint(x), __float_as_uint(x), false, false);
    return __uint_as_float(b[0]) + __uint_as_float(b[1]);
}
__device__ __forceinline__ int opaque_tid() { int t = threadIdx.x; asm volatile("" : "+v"(t)); return t; }

__device__ __forceinline__ int tile_off(int row, int chunk) { return row * 128 + ((chunk ^ (row & 7)) << 4); }

__device__ __forceinline__ int bperm(int rho) { return (rho & ~31) + 8 * ((rho >> 2) & 3) + 4 * ((rho >> 4) & 1) + (rho & 3); }

typedef __attribute__((address_space(3))) unsigned lds_u32;
typedef __attribute__((address_space(1))) const unsigned glb_u32;

#ifdef PROBE_T
#define TS(i) do { if (threadIdx.x == 0) ((volatile long*)(smem + 163760))[i] = (long)wall_clock64(); } while (0)
#else
#define TS(i) do { } while (0)
#endif
__device__ __forceinline__ long blk_off(int row, int col, int K) { return ((long)(row >> 8) * (K >> 5) + (col >> 5)) * 8192 + (row & 255) * 32 + (col & 31); }
struct LoadBf16Rows {
    const bf16_t* base;
    unsigned off[4];
    int ldst;
    struct Regs { int dummy; };
    __device__ __forceinline__ void init_contig(const bf16_t* b, int ld, int row0) {
        const int tid_ = opaque_tid();
        const int r8 = tid_ >> 3, kc = (tid_ & 7) ^ (r8 & 7);
        ldst = tid_ * 16;
        base = b + (long)row0 * ld;
#pragma unroll
        for (int i = 0; i < 4; ++i) off[i] = (unsigned)((r8 + 64 * i) * ld + kc * 8);
    }
    __device__ __forceinline__ void init_rows(const bf16_t* b, int ld, const int (&rows)[4]) {
        const int tid_ = opaque_tid();
        const int r8 = tid_ >> 3, kc = (tid_ & 7) ^ (r8 & 7);
        ldst = tid_ * 16;
        base = b;
#pragma unroll
        for (int i = 0; i < 4; ++i) off[i] = (unsigned)rows[i] * (unsigned)ld + (unsigned)(kc * 8);
    }
    __device__ __forceinline__ void issue(Regs&, char* s, int kt) const {
#pragma unroll
        for (int i = 0; i < 4; ++i)
            __builtin_amdgcn_global_load_lds((glb_u32*)(base + (size_t)(off[i] + (unsigned)(kt * 64))), (lds_u32*)(s + i * 8192 + ldst), 16, 0, 0);
    }
    __device__ __forceinline__ void commit(const Regs&, char*, int) const {}
};

struct LoadF32KN {
    const float* p;
    int ldn;
    int n, kh;
    struct Regs { float v[32]; };
    __device__ __forceinline__ void issue(Regs& r, char*, int kt) const {
        const float* q = p + (long)kt * 64 * ldn;
#pragma unroll
        for (int j = 0; j < 32; ++j) r.v[j] = q[(long)j * ldn];
    }
    __device__ __forceinline__ void commit(const Regs& r, char* s, int kt) const {
#pragma unroll
        for (int q = 0; q < 4; ++q) {
            u32x4 w;
            w.x = pk_bf16(r.v[8 * q + 0], r.v[8 * q + 1]); w.y = pk_bf16(r.v[8 * q + 2], r.v[8 * q + 3]);
            w.z = pk_bf16(r.v[8 * q + 4], r.v[8 * q + 5]); w.w = pk_bf16(r.v[8 * q + 6], r.v[8 * q + 7]);
            *(u32x4*)(s + tile_off(n, kh * 4 + q)) = w;
        }
    }
};

struct LoadLN {
    LoadBf16Rows raw;
    bf16_t* xbase;
    const float* st;
    const float* gb;
    typedef LoadBf16Rows::Regs Regs;
    __device__ __forceinline__ void issue(Regs& r, char* s, int kt) const { raw.issue(r, s, kt); }
    __device__ __forceinline__ void commit(const Regs&, char* s, int kt) const {
        asm volatile("s_waitcnt vmcnt(0)" ::: "memory");
        const int tid_ = opaque_tid();
        const int r8 = tid_ >> 3, kc = (tid_ & 7) ^ (r8 & 7);
        const f32x4 g0 = *(const f32x4*)(gb + kt * 64 + kc * 8), g1 = *(const f32x4*)(gb + kt * 64 + kc * 8 + 4);
        const f32x4 b0 = *(const f32x4*)(gb + 1024 + kt * 64 + kc * 8), b1 = *(const f32x4*)(gb + 1024 + kt * 64 + kc * 8 + 4);
#pragma unroll
        for (int i = 0; i < 4; ++i) {
            const int row = r8 + 64 * i;
            u32x4* cp = (u32x4*)(s + i * 8192 + tid_ * 16);
            const u32x4 v = *cp;
            const float mean = st[row * 2], rstd = st[row * 2 + 1];
            const f32x4 x0 = (f32x4){bf_lo(v.x), bf_hi(v.x), bf_lo(v.y), bf_hi(v.y)};
            const f32x4 x1 = (f32x4){bf_lo(v.z), bf_hi(v.z), bf_lo(v.w), bf_hi(v.w)};
            const f32x4 y0 = (x0 - mean) * rstd * g0 + b0, y1 = (x1 - mean) * rstd * g1 + b1;
            u32x4 w; w.x = pk_bf16(y0[0], y0[1]); w.y = pk_bf16(y0[2], y0[3]); w.z = pk_bf16(y1[0], y1[1]); w.w = pk_bf16(y1[2], y1[3]);
            *cp = w;
            if (xbase) *(u32x4*)(xbase + (size_t)(row * 1024 + kc * 8 + kt * 64)) = w;
        }
    }
};

constexpr int GEMM_LDS = 131072;
template <class AL, class BL>
__device__ __forceinline__ void gemm_mainloop(char* smem, const AL& al, const BL& bl, int nk, f32x4 (&acc)[8][4]) {
    const int tid_ = opaque_tid();
    const int lane = tid_ & 63, wid = tid_ >> 6;
    const int wr = wid >> 2, wc = wid & 3, fr = lane & 15, fq = lane >> 4;
#pragma unroll
    for (int mi = 0; mi < 8; ++mi)
#pragma unroll
        for (int ni = 0; ni < 4; ++ni) acc[mi][ni] = (f32x4){0.f, 0.f, 0.f, 0.f};
    typename AL::Regs ra; typename BL::Regs rb;
    al.issue(ra, smem, 0); bl.issue(rb, smem + 32768, 0);
    al.commit(ra, smem, 0); bl.commit(rb, smem + 32768, 0);
    __syncthreads();
    for (int kt = 0; kt < nk; ++kt) {
        char* sA = smem + (kt & 1) * 65536; char* sB = sA + 32768;
        char* nA = smem + ((kt + 1) & 1) * 65536; char* nB = nA + 32768;
        if (kt + 1 < nk) { al.issue(ra, nA, kt + 1); bl.issue(rb, nB, kt + 1); }
#pragma unroll
        for (int kk = 0; kk < 2; ++kk) {
            bf16x8 bfr[4];
#pragma unroll
            for (int ni = 0; ni < 4; ++ni) bfr[ni] = *(const bf16x8*)(sB + tile_off(wc * 64 + ni * 16 + fr, kk * 4 + fq));
#pragma unroll
            for (int mi = 0; mi < 8; ++mi) {
                const bf16x8 af = *(const bf16x8*)(sA + tile_off(wr * 128 + mi * 16 + fr, kk * 4 + fq));
#pragma unroll
                for (int ni = 0; ni < 4; ++ni) acc[mi][ni] = mfma16(bfr[ni], af, acc[mi][ni]);
            }
        }
        if (kt + 1 < nk) { al.commit(ra, nA, kt + 1); bl.commit(rb, nB, kt + 1); }
        __syncthreads();
    }
}

__device__ __forceinline__ int swz4(int row) { return (0x78 >> (((row >> 2) & 3) * 2)) & 3; }
struct RingRows {
    const bf16_t* base; unsigned off[2]; int ldst;
    int kstep;
    __device__ __forceinline__ void init_blocked(const bf16_t* b, int K, int row0, bool perm = false) {
        const int tid_ = opaque_tid(); const int r = tid_ >> 2, kc = (tid_ & 3) ^ swz4(r);
        ldst = tid_ * 16; base = b + (long)row0 * K; kstep = 8192;
#pragma unroll
        for (int i = 0; i < 2; ++i) { const int rr = r + 128 * i; off[i] = (unsigned)((perm ? bperm(rr) : rr) * 32 + kc * 8); }
    }
    __device__ __forceinline__ void init_contig(const bf16_t* b, int ld, int row0, bool perm = false) {
        const int tid_ = opaque_tid(); const int r = tid_ >> 2, kc = (tid_ & 3) ^ swz4(r);
        ldst = tid_ * 16; base = b + (long)row0 * ld;
        kstep = 32;
#pragma unroll
        for (int i = 0; i < 2; ++i) { const int rr = r + 128 * i; off[i] = (unsigned)((perm ? bperm(rr) : rr) * ld + kc * 8); }
    }
    __device__ __forceinline__ void init_rows(const bf16_t* b, int ld, const int (&rows)[2]) {
        const int tid_ = opaque_tid(); const int r = tid_ >> 2, kc = (tid_ & 3) ^ swz4(r);
        ldst = tid_ * 16; base = b;
        kstep = 32;
#pragma unroll
        for (int i = 0; i < 2; ++i) off[i] = (unsigned)rows[i] * (unsigned)ld + (unsigned)(kc * 8);
    }
    __device__ __forceinline__ void issue(char* s, int kt) const {
#pragma unroll
        for (int i = 0; i < 2; ++i)
            __builtin_amdgcn_global_load_lds((glb_u32*)(base + (size_t)(off[i] + (unsigned)(kt * kstep))), (lds_u32*)(s + i * 8192 + ldst), 16, 0, 0);
    }
    __device__ __forceinline__ void commit(char*, int) const {}
};
struct RingLN {
    RingRows raw; bf16_t* xbase; const float* st; const float* gb;
    __device__ __forceinline__ void issue(char* s, int kt) const { raw.issue(s, kt); }
    __device__ __forceinline__ void commit(char* s, int kt) const {
        const int tid_ = opaque_tid(); const int r = tid_ >> 2, kc = (tid_ & 3) ^ swz4(r);
        const f32x4 g0 = *(const f32x4*)(gb + kt * 32 + kc * 8), g1 = *(const f32x4*)(gb + kt * 32 + kc * 8 + 4);
        const f32x4 b0 = *(const f32x4*)(gb + 1024 + kt * 32 + kc * 8), b1 = *(const f32x4*)(gb + 1024 + kt * 32 + kc * 8 + 4);
#pragma unroll
        for (int i = 0; i < 2; ++i) {
            const int row = r + 128 * i;
            u32x4* cp = (u32x4*)(s + i * 8192 + tid_ * 16);
            const u32x4 v = *cp;
            const float mean = st[row * 2], rstd = st[row * 2 + 1];
            const f32x4 x0 = (f32x4){bf_lo(v.x), bf_hi(v.x), bf_lo(v.y), bf_hi(v.y)};
            const f32x4 x1 = (f32x4){bf_lo(v.z), bf_hi(v.z), bf_lo(v.w), bf_hi(v.w)};
            const f32x4 y0 = (x0 - mean) * rstd * g0 + b0, y1 = (x1 - mean) * rstd * g1 + b1;
            u32x4 w; w.x = pk_bf16(y0[0], y0[1]); w.y = pk_bf16(y0[2], y0[3]); w.z = pk_bf16(y1[0], y1[1]); w.w = pk_bf16(y1[2], y1[3]);
            *cp = w;
            if (xbase) *(u32x4*)(xbase + (size_t)(row * 1024 + kc * 8 + kt * 32)) = w;
        }
    }
};
#define RING_WAIT(n) asm volatile("s_waitcnt vmcnt(" #n ")" ::: "memory")
#define RING_BAR() do { __builtin_amdgcn_sched_barrier(0); asm volatile("s_waitcnt lgkmcnt(0)" ::: "memory"); __builtin_amdgcn_s_barrier(); asm volatile("" ::: "memory"); __builtin_amdgcn_sched_barrier(0); } while (0)
template <class AL, class BL>
__device__ __forceinline__ void ring_issue3(char* smem, const AL& al, const BL& bl) {
    al.issue(smem, 0); bl.issue(smem + 16384, 0);
    al.issue(smem + 32768, 1); bl.issue(smem + 32768 + 16384, 1);
    al.issue(smem + 65536, 2); bl.issue(smem + 65536 + 16384, 2);
}
template <class AL, class BL, int XMODE = 0  , bool ISSUED = false  >
__device__ __forceinline__ void gemm_ring(char* smem, const AL& al, const BL& bl, int nk  , f32x4 (&acc)[8][4]) {
    const int tid_ = opaque_tid();
    const int lane = tid_ & 63, wid = __builtin_amdgcn_readfirstlane(tid_ >> 6);
    const int wr = wid >> 2, wc = wid & 3, fr = lane & 15, fq = lane >> 4;
#pragma unroll
    for (int mi = 0; mi < 8; ++mi)
#pragma unroll
        for (int ni = 0; ni < 4; ++ni) acc[mi][ni] = (f32x4){0.f, 0.f, 0.f, 0.f};
    const int aoff = (wr * 128 + fr) * 64 + ((fq ^ swz4(fr)) << 4);
    const int boff = 16384 + (wc * 64 + fr) * 64 + ((fq ^ swz4(fr)) << 4);
    if (XMODE != 1) {
    if (!ISSUED) ring_issue3(smem, al, bl);
    RING_WAIT(8);
    al.commit(smem, 0); bl.commit(smem + 16384, 0);
    }
    RING_BAR();
    if (wr == 1) RING_BAR();
    for (int kt = 0; kt < nk; ++kt) {
        const char* st = smem + (kt & 3) * 32768;
        if (XMODE != 1 && kt + 3 < nk) { char* s3 = smem + ((kt + 3) & 3) * 32768; al.issue(s3, kt + 3); bl.issue(s3 + 16384, kt + 3); }
        bf16x8 bfr[4], afr[8];
        if (XMODE != 2) {
#pragma unroll
        for (int ni = 0; ni < 4; ++ni) bfr[ni] = *(const bf16x8*)(st + boff + ni * 1024);
#pragma unroll
        for (int mi = 0; mi < 8; ++mi) afr[mi] = *(const bf16x8*)(st + aoff + mi * 1024);
        }
        if (XMODE != 1 && kt + 1 < nk) {
            if (kt + 3 < nk) RING_WAIT(8); else if (kt + 2 < nk) RING_WAIT(4); else RING_WAIT(0);
            char* s1 = smem + ((kt + 1) & 3) * 32768;
            al.commit(s1, kt + 1); bl.commit(s1 + 16384, kt + 1);
        }
        RING_BAR();
        if (XMODE != 2) {
        __builtin_amdgcn_s_setprio(1);
#pragma unroll
        for (int mi = 0; mi < 8; ++mi)
#pragma unroll
            for (int ni = 0; ni < 4; ++ni) acc[mi][ni] = mfma16(bfr[ni], afr[mi], acc[mi][ni]);
        __builtin_amdgcn_s_setprio(0);
        }
        RING_BAR();
    }
    if (wr == 0) RING_BAR();
}

constexpr int FB_PITCH = 1088, FB_STAGE = 16384 + 32 * FB_PITCH;
struct RingF32B {
    const float* p; int ldn; int ldst;
    __device__ __forceinline__ void init(const float* W, int ld, int srccol4, int tid_) { const int lane = tid_ & 63, wid = tid_ >> 6; p = W + (long)wid * ld + srccol4; ldn = ld; ldst = wid * FB_PITCH + lane * 16; }
    __device__ __forceinline__ void issue(char* sB, int kt) const {
#pragma unroll
        for (int i = 0; i < 4; ++i)
            __builtin_amdgcn_global_load_lds((glb_u32*)(p + (long)(kt * 32 + i * 8) * ldn), (lds_u32*)(sB + i * 8 * FB_PITCH + (i & 1) * 64 + ldst), 16, 0, 0);
    }
};
template <class AL>
__device__ __forceinline__ void gemm_ring_f32b(char* smem, const AL& al, const RingF32B& bl, int nk  , f32x4 (&acc)[8][4]) {
    const int tid_ = opaque_tid();
    const int lane = tid_ & 63, wid = __builtin_amdgcn_readfirstlane(tid_ >> 6);
    const int wr = wid >> 2, wc = wid & 3, fr = lane & 15, fq = lane >> 4;
#pragma unroll
    for (int mi = 0; mi < 8; ++mi)
#pragma unroll
        for (int ni = 0; ni < 4; ++ni) acc[mi][ni] = (f32x4){0.f, 0.f, 0.f, 0.f};
    const int aoff = (wr * 128 + fr) * 64 + ((fq ^ swz4(fr)) << 4);
    const int boff = 16384 + (8 * fq) * FB_PITCH + (fq & 1) * 64 + (wc * 64 + fr) * 4;
    al.issue(smem, 0); bl.issue(smem + 16384, 0);
    al.issue(smem + FB_STAGE, 1); bl.issue(smem + FB_STAGE + 16384, 1);
    RING_WAIT(6);
    RING_BAR();
    if (wr == 1) RING_BAR();
    int s0 = 0;
    for (int kt = 0; kt < nk; ++kt) {
        const char* st = smem + s0 * FB_STAGE;
        const int s1 = s0 == 2 ? 0 : s0 + 1, s2 = s1 == 2 ? 0 : s1 + 1;
        if (kt + 2 < nk) { char* sn = smem + s2 * FB_STAGE; al.issue(sn, kt + 2); bl.issue(sn + 16384, kt + 2); }
        bf16x8 bfr[4], afr[8];
#pragma unroll
        for (int ni = 0; ni < 4; ++ni) {
            float v[8];
#pragma unroll
            for (int j = 0; j < 8; ++j) v[j] = *(const float*)(st + boff + j * FB_PITCH + ni * 64);
            u32x4 w; w.x = pk_bf16(v[0], v[1]); w.y = pk_bf16(v[2], v[3]); w.z = pk_bf16(v[4], v[5]); w.w = pk_bf16(v[6], v[7]);
            bfr[ni] = as_bf16x8(w);
        }
#pragma unroll
        for (int mi = 0; mi < 8; ++mi) afr[mi] = *(const bf16x8*)(st + aoff + mi * 1024);
        if (kt + 1 < nk) { if (kt + 2 < nk) RING_WAIT(6); else RING_WAIT(0); }
        RING_BAR();
        __builtin_amdgcn_s_setprio(1);
#pragma unroll
        for (int mi = 0; mi < 8; ++mi)
#pragma unroll
            for (int ni = 0; ni < 4; ++ni) acc[mi][ni] = mfma16(bfr[ni], afr[mi], acc[mi][ni]);
        __builtin_amdgcn_s_setprio(0);
        RING_BAR();
        s0 = s1;
    }
    if (wr == 0) RING_BAR();
}

__device__ __forceinline__ int bperm32(int rho) { return (rho & ~31) + 16 * ((rho >> 2) & 1) + 4 * ((rho >> 3) & 3) + (rho & 3); }
__device__ __forceinline__ unsigned pk4_fp8(float a, float b, float c, float d) {
    int r = __builtin_amdgcn_cvt_pk_fp8_f32(a, b, 0, false);
    r = __builtin_amdgcn_cvt_pk_fp8_f32(c, d, r, true);
    return (unsigned)r;
}
struct RingF8 {
    const unsigned char* base; unsigned off[2]; int ldst;
    __device__ __forceinline__ void init_contig(const unsigned char* b, int ldb, long row0, bool perm = false) {
        const int tid_ = opaque_tid(); const int r = tid_ >> 2, kc = (tid_ & 3) ^ ((r >> 2) & 3);
        ldst = tid_ * 16; base = b + row0 * ldb;
#pragma unroll
        for (int i = 0; i < 2; ++i) { const int rr = r + 128 * i; off[i] = (unsigned)((perm ? bperm32(rr) : rr) * ldb + kc * 16); }
    }
    __device__ __forceinline__ void init_rows(const unsigned char* b, int ldb, const int (&rows)[2]) {
        const int tid_ = opaque_tid(); const int r = tid_ >> 2, kc = (tid_ & 3) ^ ((r >> 2) & 3);
        ldst = tid_ * 16; base = b;
#pragma unroll
        for (int i = 0; i < 2; ++i) off[i] = (unsigned)rows[i] * (unsigned)ldb + (unsigned)(kc * 16);
    }
    __device__ __forceinline__ void issue(char* s, int kt) const {
#pragma unroll
        for (int i = 0; i < 2; ++i)
            __builtin_amdgcn_global_load_lds((glb_u32*)(base + (size_t)(off[i] + (unsigned)(kt * 64))), (lds_u32*)(s + i * 8192 + ldst), 16, 0, 0);
    }
};
struct RingF8B {
    const unsigned char* base; unsigned off[2]; int ldst;
    __device__ __forceinline__ void init(const unsigned char* b, int K, long row0) {
        const int tid_ = opaque_tid(); const int r = tid_ >> 2, kc = (tid_ & 3) ^ ((r >> 2) & 3);
        ldst = tid_ * 16; base = b + row0 * K;
#pragma unroll
        for (int i = 0; i < 2; ++i) off[i] = (unsigned)((r + 128 * i) * 64 + kc * 16);
    }
    __device__ __forceinline__ void issue(char* s, int kt) const {
#pragma unroll
        for (int i = 0; i < 2; ++i)
            __builtin_amdgcn_global_load_lds((glb_u32*)(base + (size_t)(off[i] + (unsigned)(kt * 16384))), (lds_u32*)(s + i * 8192 + ldst), 16, 0, 0);
    }
};
template <class AL>
__device__ __forceinline__ void ring_f8_issue3(char* smem, const AL& al, const RingF8& bl) {
    al.issue(smem, 0); bl.issue(smem + 16384, 0);
    al.issue(smem + 32768, 1); bl.issue(smem + 32768 + 16384, 1);
    al.issue(smem + 65536, 2); bl.issue(smem + 65536 + 16384, 2);
}
__device__ __forceinline__ void gemm_ring_f8_main(char* smem, const RingF8& al, const RingF8& bl, int nk  , f32x4 (&acc)[8][4]) {
    const int tid_ = opaque_tid();
    const int lane = tid_ & 63, wid = __builtin_amdgcn_readfirstlane(tid_ >> 6);
    const int wr = wid >> 2, wc = wid & 3, fr = lane & 15, fq = lane >> 4;
#pragma unroll
    for (int mi = 0; mi < 8; ++mi)
#pragma unroll
        for (int ni = 0; ni < 4; ++ni) acc[mi][ni] = (f32x4){0.f, 0.f, 0.f, 0.f};
    const int g2 = ((fr >> 2) & 3) << 1;
    const int aoff0 = (wr * 128 + fr) * 64 + ((fq ^ g2) << 3), aoff1 = (wr * 128 + fr) * 64 + (((4 + fq) ^ g2) << 3);
    const int boff0 = 16384 + (wc * 64 + fr) * 64 + ((fq ^ g2) << 3), boff1 = 16384 + (wc * 64 + fr) * 64 + (((4 + fq) ^ g2) << 3);
    RING_WAIT(8);
    RING_BAR();
    if (wr == 1) RING_BAR();
    for (int kt = 0; kt < nk; ++kt) {
        const char* st = smem + (kt & 3) * 32768;
        if (kt + 3 < nk) { char* s3 = smem + ((kt + 3) & 3) * 32768; al.issue(s3, kt + 3); bl.issue(s3 + 16384, kt + 3); }
        long b0[4], b1[4], a0[8], a1[8];
#pragma unroll
        for (int ni = 0; ni < 4; ++ni) { b0[ni] = *(const long*)(st + boff0 + ni * 1024); b1[ni] = *(const long*)(st + boff1 + ni * 1024); }
#pragma unroll
        for (int mi = 0; mi < 8; ++mi) { a0[mi] = *(const long*)(st + aoff0 + mi * 1024); a1[mi] = *(const long*)(st + aoff1 + mi * 1024); }
        if (kt + 1 < nk) { if (kt + 3 < nk) RING_WAIT(8); else if (kt + 2 < nk) RING_WAIT(4); else RING_WAIT(0); }
        RING_BAR();
        __builtin_amdgcn_s_setprio(1);
#pragma unroll
        for (int mi = 0; mi < 8; ++mi)
#pragma unroll
            for (int ni = 0; ni < 4; ++ni) {
                acc[mi][ni] = __builtin_amdgcn_mfma_f32_16x16x32_fp8_fp8(b0[ni], a0[mi], acc[mi][ni], 0, 0, 0);
                acc[mi][ni] = __builtin_amdgcn_mfma_f32_16x16x32_fp8_fp8(b1[ni], a1[mi], acc[mi][ni], 0, 0, 0);
            }
        __builtin_amdgcn_s_setprio(0);
        RING_BAR();
    }
    if (wr == 0) RING_BAR();
}

typedef int i32x8 __attribute__((ext_vector_type(8)));
typedef float f32x16 __attribute__((ext_vector_type(16)));
constexpr int MX_ONE = 0x7f7f7f7f;
__device__ __forceinline__ f32x16 mfma_mx(i32x8 a, i32x8 b, f32x16 c) { return __builtin_amdgcn_mfma_scale_f32_32x32x64_f8f6f4(a, b, c, 0, 0, 0, MX_ONE, 0, MX_ONE); }
__device__ __forceinline__ i32x8 mx_frag(const char* rowp  , int c0off, int c1off) {
    const u32x4 lo = *(const u32x4*)(rowp + c0off), hi = *(const u32x4*)(rowp + c1off);
    return (i32x8){(int)lo.x, (int)lo.y, (int)lo.z, (int)lo.w, (int)hi.x, (int)hi.y, (int)hi.z, (int)hi.w};
}
template <class AL>
__device__ __forceinline__ void gemm_ring_mx_main(char* smem, const AL& al, const RingF8& bl, int nk  , f32x16 (&acc)[4][2]) {
    const int tid_ = opaque_tid();
    const int lane = tid_ & 63, wid = __builtin_amdgcn_readfirstlane(tid_ >> 6);
    const int wr = wid >> 2, wc = wid & 3, r = lane & 31, h = lane >> 5;
#pragma unroll
    for (int mi = 0; mi < 4; ++mi)
#pragma unroll
        for (int nj = 0; nj < 2; ++nj)
#pragma unroll
            for (int q = 0; q < 16; ++q) acc[mi][nj][q] = 0.f;
    const int g = (r >> 2) & 3;
    const int c0 = ((2 * h) ^ g) << 4, c1 = ((2 * h + 1) ^ g) << 4;
    const int arow = (wr * 128 + r) * 64;
    const int brow = 16384 + (wc * 64 + r) * 64;
    RING_WAIT(8);
    RING_BAR();
    if (wr == 1) RING_BAR();
#pragma unroll 1
    for (int kt = 0; kt < nk; ++kt) {
        const char* st = smem + (kt & 3) * 32768;
        if (kt + 3 < nk) { char* s3 = smem + ((kt + 3) & 3) * 32768; al.issue(s3, kt + 3); bl.issue(s3 + 16384, kt + 3); }
        i32x8 bf[2], af[4];
#pragma unroll
        for (int nj = 0; nj < 2; ++nj) bf[nj] = mx_frag(st + brow + nj * 2048, c0, c1);
#pragma unroll
        for (int mi = 0; mi < 4; ++mi) af[mi] = mx_frag(st + arow + mi * 2048, c0, c1);
        if (kt + 1 < nk) { if (kt + 3 < nk) RING_WAIT(8); else if (kt + 2 < nk) RING_WAIT(4); else RING_WAIT(0); }
        RING_BAR();
        __builtin_amdgcn_s_setprio(1);
#pragma unroll
        for (int mi = 0; mi < 4; ++mi)
#pragma unroll
            for (int nj = 0; nj < 2; ++nj) acc[mi][nj] = mfma_mx(bf[nj], af[mi], acc[mi][nj]);
        __builtin_amdgcn_s_setprio(0);
        RING_BAR();
    }
    if (wr == 0) RING_BAR();
}

__device__ __forceinline__ int bperm16(int rho) { return (rho & ~63) + 16 * ((rho >> 2) & 3) + 4 * ((rho >> 4) & 3) + (rho & 3); }

__device__ __forceinline__ void epi_store_bf16(const f32x4 (&acc)[8][4], bf16_t* out, long ld, int row0, int col0) {
    const int tid_ = opaque_tid();
    const int lane = tid_ & 63, wid = tid_ >> 6;
    const int wr = wid >> 2, wc = wid & 3, fr = lane & 15, fq = lane >> 4;
#pragma unroll
    for (int mi = 0; mi < 8; ++mi) {
        bf16_t* rp = out + (long)(row0 + wr * 128 + mi * 16 + fr) * ld + col0 + wc * 64 + fq * 8;
#pragma unroll
        for (int q = 0; q < 2; ++q) {
            u32x4 w; w.x = pk_bf16(acc[mi][2 * q][0], acc[mi][2 * q][1]); w.y = pk_bf16(acc[mi][2 * q][2], acc[mi][2 * q][3]);
            w.z = pk_bf16(acc[mi][2 * q + 1][0], acc[mi][2 * q + 1][1]); w.w = pk_bf16(acc[mi][2 * q + 1][2], acc[mi][2 * q + 1][3]);
            *(u32x4*)(rp + q * 32) = w;
        }
    }
}

template <bool RES_LN, bool RES_BLK = false  , bool OUT_BLK = false  , bool RES_BF16 = RES_LN  >
__device__ __forceinline__ void epi_residual(f32x4 (&acc)[8][4], char* smem, const float* resid_f32, const bf16_t* resid_bf16, const float* rstats  ,
                                             const float* g, const float* b, bf16_t* rbout, float* stout  , int row0, int nt) {
    const int tid_ = opaque_tid();
    const int lane = tid_ & 63, wid = tid_ >> 6;
    const int wr = wid >> 2, wc = wid & 3, fr = lane & 15, fq = lane >> 4;
    float* sp = (float*)(smem + 139264);
    const int col0 = nt * 256 + wc * 64 + fq * 8;
#pragma unroll
    for (int mi = 0; mi < 8; ++mi) {
        const int rl = wr * 128 + mi * 16 + fr;
        const long row = row0 + rl;
        float mean = 0.f, rstd = 1.f;
        if (RES_LN) {
            const f32x4 p0 = *(const f32x4*)(rstats + row * 8), p1 = *(const f32x4*)(rstats + row * 8 + 4);
            const float s1 = (p0[0] + p0[2]) + (p1[0] + p1[2]), s2 = (p0[1] + p0[3]) + (p1[1] + p1[3]);
            mean = s1 * (1.0f / 1024.0f);
            const float var = fmaxf(s2 * (1.0f / 1024.0f) - mean * mean, 0.f);
            rstd = rsqrtf(var + LN_EPS);
        }
        float s1 = 0.f, s2 = 0.f;
#pragma unroll
        for (int q = 0; q < 2; ++q) {
            const long o = row * 1024 + col0 + q * 32;
            const long ob = (long)row0 * 1024 + (nt * 8 + wc * 2 + q) * 8192 + rl * 32 + fq * 8;
            f32x4 x0, x1;
            if (RES_BF16) {
                const u32x4 u = *(const u32x4*)(resid_bf16 + (RES_BLK ? ob : o));
                x0 = (f32x4){bf_lo(u.x), bf_hi(u.x), bf_lo(u.y), bf_hi(u.y)}; x1 = (f32x4){bf_lo(u.z), bf_hi(u.z), bf_lo(u.w), bf_hi(u.w)};
                if (RES_LN) {
                x0 = (x0 - mean) * rstd * *(const f32x4*)(g + col0 + q * 32) + *(const f32x4*)(b + col0 + q * 32);
                x1 = (x1 - mean) * rstd * *(const f32x4*)(g + col0 + q * 32 + 4) + *(const f32x4*)(b + col0 + q * 32 + 4);
                }
            } else { x0 = *(const f32x4*)(resid_f32 + o); x1 = *(const f32x4*)(resid_f32 + o + 4); }
            const f32x4 v0 = acc[mi][2 * q] + ALPHA * x0, v1 = acc[mi][2 * q + 1] + ALPHA * x1;
            { u32x4 w; w.x = pk_bf16(v0[0], v0[1]); w.y = pk_bf16(v0[2], v0[3]); w.z = pk_bf16(v1[0], v1[1]); w.w = pk_bf16(v1[2], v1[3]); *(u32x4*)(rbout + (OUT_BLK ? ob : o)) = w; }
            s1 += ((v0[0] + v0[1]) + (v0[2] + v0[3])) + ((v1[0] + v1[1]) + (v1[2] + v1[3]));
            s2 += ((v0[0] * v0[0] + v0[1] * v0[1]) + (v0[2] * v0[2] + v0[3] * v0[3])) + ((v1[0] * v1[0] + v1[1] * v1[1]) + (v1[2] * v1[2] + v1[3] * v1[3]));
        }
        s1 = fq_sum(s1); s2 = fq_sum(s2);
        if (fq == 0) { sp[(rl * 4 + wc) * 2] = s1; sp[(rl * 4 + wc) * 2 + 1] = s2; }
    }
    __syncthreads();
    if (tid_ < 256) {
        const int rl = tid_;
        const float a1 = (sp[rl * 8] + sp[rl * 8 + 2]) + (sp[rl * 8 + 4] + sp[rl * 8 + 6]);
        const float a2 = (sp[rl * 8 + 1] + sp[rl * 8 + 3]) + (sp[rl * 8 + 5] + sp[rl * 8 + 7]);
        *(f32x2*)(stout + ((long)(row0 + rl) * 4 + nt) * 2) = (f32x2){a1, a2};
    }
    __syncthreads();
}

template <bool RES_LN = true  , bool OUT_BLK = false  >
__device__ __forceinline__ void epi_residual_mx(const f32x16 (&acc)[4][2], char* smem, const bf16_t* resid_blk, const float* rstats  , const float* g, const float* b,
                                                bf16_t* rbout, float* stout  , int row0, int nt, const float ascale = 1.0f / W8_SCALE) {
    const int tid_ = opaque_tid();
    const int lane = tid_ & 63, wid = tid_ >> 6;
    const int wr = wid >> 2, wc = wid & 3, r = lane & 31, h = lane >> 5;
    float* sp = (float*)(smem + 139264);
#pragma unroll
    for (int mi = 0; mi < 4; ++mi) {
        const int rl = wr * 128 + mi * 32 + r;
        const long row = row0 + rl;
        float mean = 0.f, rstd = 1.f;
        if (RES_LN) {
            const f32x4 p0 = *(const f32x4*)(rstats + row * 8), p1 = *(const f32x4*)(rstats + row * 8 + 4);
            const float t1 = (p0[0] + p0[2]) + (p1[0] + p1[2]), t2 = (p0[1] + p0[3]) + (p1[1] + p1[3]);
            mean = t1 * (1.0f / 1024.0f);
            rstd = rsqrtf(fmaxf(t2 * (1.0f / 1024.0f) - mean * mean, 0.f) + LN_EPS);
        }
        float s1 = 0.f, s2 = 0.f;
#pragma unroll
        for (int nj = 0; nj < 2; ++nj) {
            const int col = nt * 256 + wc * 64 + nj * 32 + h * 16;
            const bf16_t* rp = resid_blk + (long)row0 * 1024 + (nt * 8 + wc * 2 + nj) * 8192 + rl * 32 + h * 16;
            const u32x4 u0 = *(const u32x4*)rp, u1 = *(const u32x4*)(rp + 8);
            const unsigned uu[8] = {u0.x, u0.y, u0.z, u0.w, u1.x, u1.y, u1.z, u1.w};
            float v[16];
#pragma unroll
            for (int q4 = 0; q4 < 4; ++q4) {
                float x0 = bf_lo(uu[2 * q4]), x1 = bf_hi(uu[2 * q4]), x2 = bf_lo(uu[2 * q4 + 1]), x3 = bf_hi(uu[2 * q4 + 1]);
                if (RES_LN) {
                    const f32x4 g4 = *(const f32x4*)(g + col + q4 * 4), b4 = *(const f32x4*)(b + col + q4 * 4);
                    x0 = (x0 - mean) * rstd * g4[0] + b4[0]; x1 = (x1 - mean) * rstd * g4[1] + b4[1]; x2 = (x2 - mean) * rstd * g4[2] + b4[2]; x3 = (x3 - mean) * rstd * g4[3] + b4[3];
                }
                v[q4 * 4 + 0] = acc[mi][nj][q4 * 4 + 0] * ascale + ALPHA * x0;
                v[q4 * 4 + 1] = acc[mi][nj][q4 * 4 + 1] * ascale + ALPHA * x1;
                v[q4 * 4 + 2] = acc[mi][nj][q4 * 4 + 2] * ascale + ALPHA * x2;
                v[q4 * 4 + 3] = acc[mi][nj][q4 * 4 + 3] * ascale + ALPHA * x3;
            }
            u32x4 w0, w1;
            w0.x = pk_bf16(v[0], v[1]); w0.y = pk_bf16(v[2], v[3]); w0.z = pk_bf16(v[4], v[5]); w0.w = pk_bf16(v[6], v[7]);
            w1.x = pk_bf16(v[8], v[9]); w1.y = pk_bf16(v[10], v[11]); w1.z = pk_bf16(v[12], v[13]); w1.w = pk_bf16(v[14], v[15]);
            bf16_t* op = OUT_BLK ? rbout + (long)row0 * 1024 + (nt * 8 + wc * 2 + nj) * 8192 + rl * 32 + h * 16 : rbout + row * 1024 + col;
            *(u32x4*)op = w0; *(u32x4*)(op + 8) = w1;
#pragma unroll
            for (int q = 0; q < 16; ++q) { s1 += v[q]; s2 += v[q] * v[q]; }
        }
        s1 += __shfl_xor(s1, 32); s2 += __shfl_xor(s2, 32);
        if (h == 0) { sp[(rl * 4 + wc) * 2] = s1; sp[(rl * 4 + wc) * 2 + 1] = s2; }
    }
    __syncthreads();
    if (tid_ < 256) {
        const int rl = tid_;
        const float a1 = (sp[rl * 8] + sp[rl * 8 + 2]) + (sp[rl * 8 + 4] + sp[rl * 8 + 6]);
        const float a2 = (sp[rl * 8 + 1] + sp[rl * 8 + 3]) + (sp[rl * 8 + 5] + sp[rl * 8 + 7]);
        *(f32x2*)(stout + ((long)(row0 + rl) * 4 + nt) * 2) = (f32x2){a1, a2};
    }
    __syncthreads();
}

__device__ __forceinline__ void ln_tile_stats(float* st, const float* rstats, int row0) {
    const int tid_ = opaque_tid();
    if (tid_ < 256) {
        const long row = row0 + tid_;
        const f32x4 p0 = *(const f32x4*)(rstats + row * 8), p1 = *(const f32x4*)(rstats + row * 8 + 4);
        const float s1 = (p0[0] + p0[2]) + (p1[0] + p1[2]), s2 = (p0[1] + p0[3]) + (p1[1] + p1[3]);
        const float mean = s1 * (1.0f / 1024.0f);
        const float var = fmaxf(s2 * (1.0f / 1024.0f) - mean * mean, 0.f);
        st[tid_ * 2] = mean; st[tid_ * 2 + 1] = rsqrtf(var + LN_EPS);
    }
}
__device__ __forceinline__ void ln_load_gb(float* gb, const float* g, const float* b) {
    for (int i = opaque_tid(); i < 1024; i += NTHR) { gb[i] = g[i]; gb[1024 + i] = b[i]; }
}


struct XcdSlab {
    int x, j, stride;
    __device__ __forceinline__ void init(int bid, int nb) { if ((nb & 7) == 0) { x = bid & 7; j = bid >> 3; stride = nb >> 3; } else { x = -1; j = bid; stride = nb; } }
    __device__ __forceinline__ int m_lo(int nM) const { return x < 0 ? 0 : (x * nM) >> 3; }
    __device__ __forceinline__ int m_hi(int nM) const { return x < 0 ? nM : ((x + 1) * nM) >> 3; }
};

template <int MAP>
__device__ __forceinline__ void ln_correct(f32x4 (&acc)[8][4], const float* rstats  , int row0, const float* cs, const float* bw, int nt) {
    const int tid_ = opaque_tid();
    const int lane = tid_ & 63, wid = tid_ >> 6;
    const int wr = wid >> 2, wc = wid & 3, fr = lane & 15, fq = lane >> 4;
    float mean[8], rstd[8];
#pragma unroll
    for (int mi = 0; mi < 8; ++mi) {
        const long row = row0 + wr * 128 + mi * 16 + fr;
        const f32x4 p0 = *(const f32x4*)(rstats + row * 8), p1 = *(const f32x4*)(rstats + row * 8 + 4);
        const float s1 = (p0[0] + p0[2]) + (p1[0] + p1[2]), s2 = (p0[1] + p0[3]) + (p1[1] + p1[3]);
        mean[mi] = s1 * (1.0f / 1024.0f);
        rstd[mi] = rsqrtf(fmaxf(s2 * (1.0f / 1024.0f) - mean[mi] * mean[mi], 0.f) + LN_EPS);
    }
#pragma unroll
    for (int ni = 0; ni < 4; ++ni) {
        const int col = MAP == 0 ? nt * 256 + wc * 64 + (ni >> 1) * 32 + fq * 8 + (ni & 1) * 4
                                 : (ni & 1) * 256 + nt * 128 + wc * 32 + fq * 8 + (ni >> 1) * 4;
        const f32x4 c4 = *(const f32x4*)(cs + col), b4 = *(const f32x4*)(bw + col);
#pragma unroll
        for (int mi = 0; mi < 8; ++mi) acc[mi][ni] = (acc[mi][ni] - mean[mi] * c4) * rstd[mi] + b4;
    }
}

__device__ __forceinline__ void epi_store_bf16_mx(const f32x16 (&acc)[4][2], float scale, bf16_t* out, long ld, int row0, int col0) {
    const int tid_ = opaque_tid();
    const int lane = tid_ & 63, wid = tid_ >> 6;
    const int wr = wid >> 2, wc = wid & 3, r = lane & 31, h = lane >> 5;
#pragma unroll
    for (int mi = 0; mi < 4; ++mi) {
        bf16_t* rp = out + (long)(row0 + wr * 128 + mi * 32 + r) * ld + col0 + wc * 64 + h * 16;
#pragma unroll
        for (int nj = 0; nj < 2; ++nj) {
            const f32x16 v = acc[mi][nj] * scale;
            u32x4 w0, w1;
            w0.x = pk_bf16(v[0], v[1]); w0.y = pk_bf16(v[2], v[3]); w0.z = pk_bf16(v[4], v[5]); w0.w = pk_bf16(v[6], v[7]);
            w1.x = pk_bf16(v[8], v[9]); w1.y = pk_bf16(v[10], v[11]); w1.z = pk_bf16(v[12], v[13]); w1.w = pk_bf16(v[14], v[15]);
            *(u32x4*)(rp + nj * 32) = w0; *(u32x4*)(rp + nj * 32 + 8) = w1;
        }
    }
}
struct TJob { const float* src; int ldsrc; int K; int col0; int ncols; bf16_t* dst; int mode; int rowoff; int f8;   int blk;   const float* g; const float* b; float* part;   };
__device__ __forceinline__ int tjob_row(const TJob& j, int c) {
    if (j.mode == 0) return j.rowoff + c;
    if (j.mode == 2) {
        const int q = c & 31;
        return 256 * (c >> 7) + 64 * ((c >> 5) & 3) + 32 * j.rowoff + ((q >> 2) & 3) * 8 + ((q >> 4) & 1) * 4 + (q & 3);
    }
    const int oc = c & 127;
    return 256 * (c >> 7) + 64 * (oc >> 5) + 16 * (2 * ((oc >> 2) & 1) + j.rowoff) + 4 * ((oc >> 3) & 3) + (oc & 3);
}
__device__ __forceinline__ void tt_load(const TJob& j, int kt, int ct, float (&v)[8], float (&gv)[8], float (&bv)[8]) {
    const int tid = opaque_tid();
#pragma unroll
    for (int i = 0; i < 8; ++i) {
        const int e = tid + i * NTHR, kr = e >> 6, c = e & 63;
        const int cc = ct * 64 + c;
        v[i] = 0.f; gv[i] = 1.f; bv[i] = 0.f;
        if (cc < j.ncols) v[i] = j.src[(long)(kt * 64 + kr) * j.ldsrc + j.col0 + cc];
        if (j.g) { gv[i] = j.g[kt * 64 + kr]; bv[i] = j.b[kt * 64 + kr]; }
    }
}
__device__ __forceinline__ void tt_finish(char* smem, const TJob& j, int kt, int ct, const float (&v)[8], const float (&gv)[8], const float (&bv)[8]) {
    float* tile = (float*)smem;
    float* red = tile + 64 * 65;
    const int tid = opaque_tid();
    float scs = 0.f, sbw = 0.f;
#pragma unroll
    for (int i = 0; i < 8; ++i) {
        const int e = tid + i * NTHR, kr = e >> 6, c = e & 63;
        float x = v[i];
        if (j.g) {
            sbw += bv[i] * x;
            x *= gv[i];
            scs += __uint_as_float(pk_bf16(x, 0.f) << 16);
        }
        tile[kr * 65 + c] = x;
    }
    if (j.g) { red[(tid >> 6) * 64 + (tid & 63)] = scs; red[512 + (tid >> 6) * 64 + (tid & 63)] = sbw; }
    __syncthreads();
    if (j.f8) {
#pragma unroll
        for (int i = 0; i < 2; ++i) {
            const int e = tid + i * NTHR, c = e >> 4, k4 = (e & 15) * 4;
            const int cc = ct * 64 + c;
            if (cc < j.ncols) {
                const unsigned w = pk4_fp8(tile[k4 * 65 + c] * W8_SCALE, tile[(k4 + 1) * 65 + c] * W8_SCALE, tile[(k4 + 2) * 65 + c] * W8_SCALE, tile[(k4 + 3) * 65 + c] * W8_SCALE);
                *(unsigned*)((unsigned char*)j.dst + (long)tjob_row(j, cc) * j.K + kt * 64 + k4) = w;
            }
        }
    } else {
#pragma unroll
    for (int i = 0; i < 4; ++i) {
        const int e = tid + i * NTHR, c = e >> 5, k2 = (e & 31) * 2;
        const int cc = ct * 64 + c;
        if (cc < j.ncols) {
            const unsigned w = pk_bf16(tile[k2 * 65 + c], tile[(k2 + 1) * 65 + c]);
            const int rr = tjob_row(j, cc);
            *(unsigned*)(j.dst + (j.blk ? blk_off(rr, kt * 64 + k2, j.K) : (long)rr * j.K + kt * 64 + k2)) = w;
        }
    }
    }
    if (j.g && tid < 128) {
        const int which = tid >> 6, c = tid & 63;
        float s = 0.f;
#pragma unroll
        for (int w = 0; w < 8; ++w) s += red[which * 512 + w * 64 + c];
        if (ct * 64 + c < j.ncols) j.part[(long)(which * 16 + kt) * 1792 + ct * 64 + c] = s;
    }
    __syncthreads();
}

__device__ __forceinline__ TJob tjob_mk(const float* src, int ld, int K, int col0, int ncols, bf16_t* dst, int mode, int rowoff,
                                        const float* g = nullptr, const float* b = nullptr, float* part = nullptr, int f8 = 0, int blk = 0) {
    TJob j; j.f8 = f8; j.blk = blk; j.src = src; j.ldsrc = ld; j.K = K; j.col0 = col0; j.ncols = ncols; j.dst = dst; j.mode = mode; j.rowoff = rowoff; j.g = g; j.b = b; j.part = part;
    return j;
}
constexpr int N_TJOBS = 17;

__device__ __forceinline__ void cvt_rows_bf16(const float* src, bf16_t* dst, long n8, int bid, int nb) {
    for (long i = (long)bid * NTHR + opaque_tid(); i < n8; i += (long)nb * NTHR) {
        const f32x4 a = __builtin_nontemporal_load((const f32x4*)(src + i * 8)), b = __builtin_nontemporal_load((const f32x4*)(src + i * 8 + 4));
        u32x4 w; w.x = pk_bf16(a[0], a[1]); w.y = pk_bf16(a[2], a[3]); w.z = pk_bf16(b[0], b[1]); w.w = pk_bf16(b[2], b[3]);
        *(u32x4*)(dst + i * 8) = w;
    }
}

__device__ __forceinline__ void cvt_rows_bf16_blk(const float* src, bf16_t* dst, long n8, int bid, int nb, unsigned char* f8dst = nullptr  ) {
    const long stride = (long)nb * NTHR;
    for (long d0 = (long)bid * NTHR + opaque_tid(); d0 < n8; d0 += 4 * stride) {
        f32x4 a[4], b[4];
#pragma unroll
        for (int u = 0; u < 4; ++u) {
            const long d = d0 + u * stride;
            if (d < n8) {
                const long tile = d >> 15; const int kb = (int)(d >> 10) & 31, r = (int)(d >> 2) & 255, c8 = (int)d & 3;
                const float* s = src + ((tile * 256 + r) * 1024 + kb * 32 + c8 * 8);
                a[u] = __builtin_nontemporal_load((const f32x4*)s); b[u] = __builtin_nontemporal_load((const f32x4*)(s + 4));
            }
        }
#pragma unroll
        for (int u = 0; u < 4; ++u) {
            const long d = d0 + u * stride;
            if (d < n8) {
                u32x4 w; w.x = pk_bf16(a[u][0], a[u][1]); w.y = pk_bf16(a[u][2], a[u][3]); w.z = pk_bf16(b[u][0], b[u][1]); w.w = pk_bf16(b[u][2], b[u][3]);
                if (dst) *(u32x4*)(dst + d * 8) = w;
                if (f8dst) {
                    const long tile = d >> 15; const int kb = (int)(d >> 10) & 31, r = (int)(d >> 2) & 255, c8 = (int)d & 3;
                    u32x2 w8; w8.x = pk4_fp8(a[u][0], a[u][1], a[u][2], a[u][3]); w8.y = pk4_fp8(b[u][0], b[u][1], b[u][2], b[u][3]);
                    *(u32x2*)(f8dst + (tile * 262144 + (kb >> 1) * 16384 + r * 64 + (kb & 1) * 32 + c8 * 8)) = w8;
                }
            }
        }
    }
}

enum { I_X = 0, I_MEM, I_WIN, I_POSK, I_CKW1, I_CKW2, I_POSV, I_CVW1, I_CVW2, I_CONVW, I_IBIAS, I_FBIAS, I_NORMG, I_WOUT, I_LN1G, I_LN1B,
       I_XAWQ, I_XAWK, I_XAWV, I_XAWO, I_LN2G, I_LN2B, I_ROUTW, I_ROUTB, I_MW1, I_MW3, I_MW2, I_SW1, I_SW3, I_SW2, I_LN3G, I_LN3B };

__device__ __forceinline__ void phase0(const Params& p, char* smem, int bid, int nb) {
    char* ws = p.ws;
    float* lnp = (float*)(ws + WS_LNP);
    auto job = [&](int k) -> TJob {
        switch (k) {
        case 0: return tjob_mk(p.in[I_WIN], 3360, 1024, 0, 1280, (bf16_t*)(ws + WS_WIN), 0, 0, nullptr, nullptr, nullptr, INPROJ_F8, !INPROJ_F8);
        case 1: return tjob_mk(p.in[I_WIN], 3360, 1024, 1304, 2048, (bf16_t*)(ws + WS_WIN), 0, 1280, nullptr, nullptr, nullptr, INPROJ_F8, !INPROJ_F8);
        case 2: return tjob_mk(p.in[I_WIN], 3360, 1024, 1280, 24, (bf16_t*)(ws + WS_WIN), 0, 3328, nullptr, nullptr, nullptr, 0, 1);
        case 3: return tjob_mk(p.in[I_WIN], 3360, 1024, 3352, 8, (bf16_t*)(ws + WS_WIN), 0, 3352, nullptr, nullptr, nullptr, 0, 1);
        case 4: return tjob_mk(p.in[I_WOUT], 1024, 1024, 0, 1024, (bf16_t*)(ws + WS_WOUT), 0, 0, nullptr, nullptr, nullptr, 1, 0);
        case 5: return tjob_mk(p.in[I_XAWQ], 1024, 1024, 0, 1024, (bf16_t*)(ws + WS_WQ), 0, 0, p.in[I_LN1G], p.in[I_LN1B], lnp, 0, 1);
        case 6: return tjob_mk(p.in[I_XAWK], 1024, 1024, 0, 1024, (bf16_t*)(ws + WS_WKV), 0, 0, nullptr, nullptr, nullptr, INPROJ_F8, !INPROJ_F8);
        case 7: return tjob_mk(p.in[I_XAWV], 1024, 1024, 0, 1024, (bf16_t*)(ws + WS_WKV), 0, 1024, nullptr, nullptr, nullptr, INPROJ_F8, !INPROJ_F8);
        case 8: return tjob_mk(p.in[I_XAWO], 1024, 1024, 0, 1024, (bf16_t*)(ws + WS_WO), 0, 0, nullptr, nullptr, nullptr, 1, 0);
        case 9: return tjob_mk(p.in[I_ROUTW], 256, 1024, 0, 256, (bf16_t*)(ws + WS_WR), 0, 0, p.in[I_LN2G], p.in[I_LN2B], lnp + 1024);
        case 10: return tjob_mk(p.in[I_SW1], 256, 1024, 0, 256, (bf16_t*)(ws + WS_WS13), 2, 0, nullptr, nullptr, nullptr, 1, 0);
        case 11: return tjob_mk(p.in[I_SW3], 256, 1024, 0, 256, (bf16_t*)(ws + WS_WS13), 2, 1, nullptr, nullptr, nullptr, 1, 0);
        case 12: return tjob_mk(p.in[I_SW2], 1024, 256, 0, 1024, (bf16_t*)(ws + WS_WS2), 0, 0, nullptr, nullptr, nullptr, 1, 0);
        case 13: return tjob_mk(p.in[I_CKW1], 64, 2048, 0, 64, (bf16_t*)(ws + WS_CK1), 0, 0);
        case 14: return tjob_mk(p.in[I_CKW2], 64, 64, 0, 64, (bf16_t*)(ws + WS_CK2), 0, 0);
        case 15: return tjob_mk(p.in[I_CVW1], 64, 2048, 0, 64, (bf16_t*)(ws + WS_CV1), 0, 0);
        default: return tjob_mk(p.in[I_CVW2], 64, 64, 0, 64, (bf16_t*)(ws + WS_CV2), 0, 0);
        }
    };
    auto decode = [&](int t, TJob& j, int& kt, int& ct) -> bool {
        int base = 0; bool found = false;
#pragma unroll
        for (int k = 0; k < N_TJOBS; ++k) {
            const TJob c = job(k);
            const int nkt = c.K / 64, n = nkt * ((c.ncols + 63) / 64);
            if (t >= base && t < base + n) { j = c; const int tl = t - base; kt = tl % nkt; ct = tl / nkt; found = true; }
            base += n;
        }
        return found;
    };
    cvt_rows_bf16_blk(p.in[I_X], (bf16_t*)(ws + WS_XB), (long)T_TOK * 1024 / 8, bid, nb, INPROJ_F8 ? (unsigned char*)(ws + WS_XF8) : nullptr);
    cvt_rows_bf16_blk(p.in[I_MEM], INPROJ_F8 ? (bf16_t*)nullptr : (bf16_t*)(ws + WS_MEMB), (long)4096 * 1024 / 8, bid, nb, INPROJ_F8 ? (unsigned char*)(ws + WS_MEMF8) : nullptr);
    {
        int NT = 0;
#pragma unroll
        for (int k = 0; k < N_TJOBS; ++k) { const TJob c = job(k); NT += (c.K / 64) * ((c.ncols + 63) / 64); }
        const int qx = (nb & 7) == 0 ? (bid & 7) : 0, nq = (nb & 7) == 0 ? 8 : 1;
        unsigned* q = (unsigned*)(ws + WS_BAR) + 3584 + 32 * qx;
        volatile int* slot = (volatile int*)(smem + 32768);
        const int tid0 = opaque_tid();
        unsigned pend = 0u;
        auto issue = [&]() { if (tid0 == 0) pend = atomicAdd(q, 1u); };
        auto publish = [&]() -> int { if (tid0 == 0) *slot = (int)pend; __syncthreads(); const int t = qx + nq * (*slot); return t < NT ? t : -1; };
        TJob ja, jb; int kta = 0, cta = 0, ktb = 0, ctb = 0;
        float va[8], ga[8], ba[8], vb[8], gb[8], bb[8];
        issue();
        int cur = publish();
        issue();
        if (cur >= 0) { decode(cur, ja, kta, cta); tt_load(ja, kta, cta, va, ga, ba); }
        __syncthreads();
        int nxt = publish();
        while (cur >= 0) {
            issue();
            if (nxt >= 0) { decode(nxt, jb, ktb, ctb); tt_load(jb, ktb, ctb, vb, gb, bb); }
            tt_finish(smem, ja, kta, cta, va, ga, ba);
            const int nn = publish();
            cur = nxt; nxt = nn;
            ja = jb; kta = ktb; cta = ctb;
#pragma unroll
            for (int i = 0; i < 8; ++i) { va[i] = vb[i]; ga[i] = gb[i]; ba[i] = bb[i]; }
        }
    }
    { int* c = (int*)(ws + WS_CNT); for (int i = bid * NTHR + opaque_tid(); i < 24576; i += nb * NTHR) c[i] = 0; }
}

__device__ __forceinline__ void small_cols_task(const Params& p, int task) {
    const bf16_t* xb = (const bf16_t*)(p.ws + WS_XB);
    const bf16_t* wt = (const bf16_t*)(p.ws + WS_WIN) + (long)3328 * 1024;
    float* psm = (float*)(p.ws + WS_PSM);
    const int tid_ = opaque_tid();
    const int lane = tid_ & 63, wid = tid_ >> 6, fr = lane & 15, fq = lane >> 4;
    const int rl = (task & 1) * 128 + wid * 16 + fr;
    f32x4 acc[2];
    acc[0] = (f32x4){0.f, 0.f, 0.f, 0.f}; acc[1] = (f32x4){0.f, 0.f, 0.f, 0.f};
    const bf16_t* ap0 = xb + (long)(task >> 1) * 256 * 1024 + rl * 32 + fq * 8;
    const bf16_t* bp0 = wt + fr * 32 + fq * 8;
    const bf16_t* bp1 = bp0 + 16 * 32;
#pragma unroll 8
    for (int ks = 0; ks < 32; ++ks) {
        const bf16x8 a0 = *(const bf16x8*)(ap0 + ks * 8192);
        const bf16x8 b0 = *(const bf16x8*)(bp0 + ks * 8192), b1 = *(const bf16x8*)(bp1 + ks * 8192);
        acc[0] = mfma16(b0, a0, acc[0]); acc[1] = mfma16(b1, a0, acc[1]);
    }
#pragma unroll
    for (int ni = 0; ni < 2; ++ni) *(f32x4*)(psm + ((long)(task >> 1) * 256 + rl) * 32 + ni * 16 + fq * 4) = acc[ni];
}

template <int NOEPI = 0>
__device__ __forceinline__ void phase1(const Params& p, char* smem, int bid, int nb) {
    char* ws = p.ws;
    XcdSlab xs; xs.init(bid, nb);
    const int a_lo = xs.m_lo(128), a_nm = xs.m_hi(128) - a_lo, a_n = a_nm * 13;
    const int b_lo = xs.m_lo(16), b_nm = xs.m_hi(16) - b_lo, b_n = b_nm * 8;
#if INPROJ_F8
    {
        int mt = 0, nt = 0; bool kv = false;
        RingF8B al; RingF8 bl;
        auto setup = [&](int u) {
            if ((a_nm & 3) == 0) {
                const int per_mblk = 4 * 13, mblk = u / per_mblk, rr = u % per_mblk;
                const int ngrp = rr >> 5, r32 = rr & 31;
                mt = a_lo + mblk * 4 + (r32 & 3); nt = ngrp * 8 + (r32 >> 2);
            } else { mt = a_lo + u % a_nm; nt = u / a_nm; }
            kv = u >= a_n;
            if (kv) { const int uu = u - a_n; mt = b_lo + uu % b_nm; nt = uu / b_nm; }
            al.init((const unsigned char*)(ws + (kv ? WS_MEMF8 : WS_XF8)), 1024, (long)mt * 256);
            bl.init_contig((const unsigned char*)(ws + (kv ? WS_WKV : WS_WIN)), 1024, (long)nt * 256, true);
        };
        const int ab_n = a_n + b_n;
        int u = xs.j;
        if (u < ab_n) { setup(u); ring_f8_issue3(smem, al, bl); }
        while (u < ab_n) {
            const int cmt = mt, cnt_ = nt; const bool ckv = kv;
            f32x16 acc[4][2];
            gemm_ring_mx_main(smem, al, bl, 16, acc);
            u += xs.stride;
            if (u < ab_n) { setup(u); ring_f8_issue3(smem, al, bl); }
            if (NOEPI) { float s = 0.f;
#pragma unroll
                for (int mi = 0; mi < 4; ++mi) s += acc[mi][0][0] + acc[mi][1][5];
                if (s == 123.456f) ((float*)(ws + WS_A + 432 * MB))[opaque_tid()] = s; continue; }
            if (ckv) epi_store_bf16_mx(acc, 1.0f / W8_SCALE, (bf16_t*)(ws + WS_KVX), 2048, cmt * 256, cnt_ * 256);
            else epi_store_bf16_mx(acc, 1.0f / W8_SCALE, (bf16_t*)(ws + WS_P), PW, cmt * 256, cnt_ * 256);
        }
        asm volatile("s_waitcnt vmcnt(0)" ::: "memory"); __syncthreads();
    }
    const int a_n2 = 0;
#else
    const int a_n2 = a_n;
#endif
    bool inp = false; int mt = 0, nt = 0;
    RingRows al, bl;
    auto setup = [&](int u) {
        inp = u < a_n2;
        const int uu = inp ? u : u - a_n2;
        const int nm = inp ? a_nm : b_nm;
        if (inp && (a_nm & 3) == 0) {
            const int per_mblk = 4 * 13, mblk = uu / per_mblk, rr = uu % per_mblk;
            const int ngrp = rr >> 5, r32 = rr & 31;
            mt = a_lo + mblk * 4 + (r32 & 3); nt = ngrp * 8 + (r32 >> 2);
        } else { mt = (inp ? a_lo : b_lo) + uu % nm; nt = uu / nm; }
        al.init_blocked((const bf16_t*)(ws + (inp ? WS_XB : WS_MEMB)), 1024, mt * 256);
        bl.init_blocked((const bf16_t*)(ws + (inp ? WS_WIN : WS_WKV)), 1024, nt * 256, true);
    };
    const int ab_n2 = INPROJ_F8 ? 0 : a_n2 + b_n;
    int u = xs.j;
    if (u < ab_n2) { setup(u); ring_issue3(smem, al, bl); }
    while (u < ab_n2) {
        const bool cinp = inp; const int cmt = mt, cnt_ = nt;
        f32x4 acc[8][4];
        gemm_ring<RingRows, RingRows, 0, true>(smem, al, bl, 32, acc);
        u += xs.stride;
        if (u < ab_n2) { setup(u); ring_issue3(smem, al, bl); }
        if (NOEPI) { float s = 0.f;
#pragma unroll
            for (int mi = 0; mi < 8; ++mi)
#pragma unroll
                for (int ni = 0; ni < 4; ++ni) s += acc[mi][ni][0] + acc[mi][ni][1] + acc[mi][ni][2] + acc[mi][ni][3];
            if (s == 123.456f) ((float*)(ws + WS_A + 432 * MB))[opaque_tid()] = s; continue; }
        if (!cinp) epi_store_bf16(acc, (bf16_t*)(ws + WS_KVX), 2048, cmt * 256, cnt_ * 256);
        else epi_store_bf16(acc, (bf16_t*)(ws + WS_P), PW, cmt * 256, cnt_ * 256);
    }
    asm volatile("s_waitcnt vmcnt(0)" ::: "memory");
    if (!NOEPI) for (int s = xs.j; s < a_nm * 2; s += xs.stride) small_cols_task(p, a_lo * 2 + s);
}

__device__ __forceinline__ void compress_task(const Params& p, char* smem, int which, int rb) {
    const char* ws = p.ws;
    const bf16_t* P = (const bf16_t*)(ws + WS_P);
    const float* pos = p.in[which ? I_POSV : I_POSK];
    const bf16_t* w1t = (const bf16_t*)(ws + (which ? WS_CV1 : WS_CK1));
    const bf16_t* w2t = (const bf16_t*)(ws + (which ? WS_CV2 : WS_CK2));
    bf16_t* outp = (bf16_t*)(p.ws + (which ? WS_VCMP : WS_KCMP));
    const int colbase = which ? PC_VC : PC_KC;
    const int tid_ = opaque_tid();
    const int lane = tid_ & 63, wid = tid_ >> 6, fr = lane & 15, fq = lane >> 4;
    f32x4 acc[2][4];
#pragma unroll
    for (int mi = 0; mi < 2; ++mi)
#pragma unroll
        for (int ni = 0; ni < 4; ++ni) acc[mi][ni] = (f32x4){0.f, 0.f, 0.f, 0.f};
    const bf16_t* arow[2];
#pragma unroll
    for (int mi = 0; mi < 2; ++mi) {
        const int r = rb * 32 + mi * 16 + fr;
        const int b = r / 254, rem = r - b * 254, c = rem >> 1, g = rem & 1;
        arow[mi] = P + (long)(b * 2048 + c * 16) * PW + colbase + g * 64 + fq * 8;
    }
    const bf16_t* brow = w1t + (long)fr * 2048 + fq * 8;
    const float* prow = pos + fq * 8;
#pragma unroll 4
    for (int s = 0; s < 8; ++s) {
        const int ks = wid * 8 + s;
        const int l = ks >> 1, d0 = (ks & 1) * 32;
        const f32x4 p0 = *(const f32x4*)(prow + l * 64 + d0), p1 = *(const f32x4*)(prow + l * 64 + d0 + 4);
        bf16x8 af[2];
#pragma unroll
        for (int mi = 0; mi < 2; ++mi) {
            const u32x4 av = *(const u32x4*)(arow[mi] + (long)l * PW + d0);
            u32x4 aw;
            aw.x = pk_bf16(bf_lo(av.x) + p0[0], bf_hi(av.x) + p0[1]); aw.y = pk_bf16(bf_lo(av.y) + p0[2], bf_hi(av.y) + p0[3]);
            aw.z = pk_bf16(bf_lo(av.z) + p1[0], bf_hi(av.z) + p1[1]); aw.w = pk_bf16(bf_lo(av.w) + p1[2], bf_hi(av.w) + p1[3]);
            af[mi] = as_bf16x8(aw);
        }
#pragma unroll
        for (int ni = 0; ni < 4; ++ni) {
            const bf16x8 bb = *(const bf16x8*)(brow + (long)(ni * 16) * 2048 + ks * 32);
            acc[0][ni] = mfma16(bb, af[0], acc[0][ni]);
            acc[1][ni] = mfma16(bb, af[1], acc[1][ni]);
        }
    }
    f32x4* part = (f32x4*)(smem + 8192);
#pragma unroll
    for (int mi = 0; mi < 2; ++mi)
#pragma unroll
        for (int ni = 0; ni < 4; ++ni) part[(wid * 8 + mi * 4 + ni) * 64 + lane] = acc[mi][ni];
    __syncthreads();
    const int mi = wid >> 2, ni = wid & 3;
    f32x4 a1 = (f32x4){0.f, 0.f, 0.f, 0.f};
#pragma unroll
    for (int w = 0; w < 8; ++w) a1 = a1 + part[(w * 8 + wid) * 64 + lane];
    bf16_t* h1 = (bf16_t*)smem;
    {
        u32x2 w; w.x = pk_bf16(siluf_(a1[0]), siluf_(a1[1])); w.y = pk_bf16(siluf_(a1[2]), siluf_(a1[3]));
        *(u32x2*)(h1 + (mi * 16 + fr) * 72 + ni * 16 + fq * 4) = w;
    }
    __syncthreads();
    f32x4 acc2 = (f32x4){0.f, 0.f, 0.f, 0.f};
#pragma unroll
    for (int ks = 0; ks < 2; ++ks) {
        const bf16x8 a = *(const bf16x8*)(h1 + (mi * 16 + fr) * 72 + ks * 32 + fq * 8);
        const bf16x8 bb = *(const bf16x8*)(w2t + (ni * 16 + fr) * 64 + ks * 32 + fq * 8);
        acc2 = mfma16(bb, a, acc2);
    }
    {
        const int r = rb * 32 + mi * 16 + fr;
        const int b = r / 254, rem = r - b * 254, c = rem >> 1, g = rem & 1;
        u32x2 w; w.x = pk_bf16(acc2[0], acc2[1]); w.y = pk_bf16(acc2[2], acc2[3]);
        *(u32x2*)(outp + ((long)(b * 2 + g) * 128 + c) * 64 + ni * 16 + fq * 4) = w;
    }
    __syncthreads();
}

__device__ __forceinline__ void phase2(const Params& p, char* smem, int bid, int nb) {
    char* ws = p.ws;
    {
        const int idx = bid * NTHR + opaque_tid();
        if (idx < 2 * 1792) {
            const float* pp = (const float*)(ws + WS_LNP) + (long)(idx / 1792) * 16 * 1792 + idx % 1792;
            float s = 0.f;
#pragma unroll
            for (int k = 0; k < 16; ++k) s += pp[k * 1792];
            ((float*)(ws + WS_LNF))[idx] = s;
        }
    }
    for (int t = bid; t < 254; t += nb) compress_task(p, smem, t / 127, t % 127);
    const int tid_ = opaque_tid();
    if (bid < 32 && tid_ < 32) {
        bf16_t* kc = (bf16_t*)(ws + WS_KCMP) + ((long)bid * 128 + 127) * 64;
        bf16_t* vc = (bf16_t*)(ws + WS_VCMP) + ((long)bid * 128 + 127) * 64;
        ((unsigned*)kc)[tid_] = 0u; ((unsigned*)vc)[tid_] = 0u;
    }
    const bf16_t* P = (const bf16_t*)(ws + WS_P);
    const float* cw = p.in[I_CONVW];
    bf16_t* qk = (bf16_t*)(ws + WS_QK);
    const int ch = tid_ & 127, sub = tid_ >> 7;
    const float sc = ch < 64 ? 0.08838834764831845f : 1.0f;
    f32x4 w0[4], w1[4];
#pragma unroll
    for (int j = 0; j < 4; ++j) { w0[j] = *(const f32x4*)(cw + j * 1024 + ch * 8); w1[j] = *(const f32x4*)(cw + j * 1024 + ch * 8 + 4); }
    for (int blk = bid; blk < T_TOK / 128; blk += nb) {
        const int t0 = blk * 128 + sub * 32;
        const bf16_t* src = P + (long)t0 * PW + PC_MQ + ch * 8;
        u32x4 r0 = (u32x4){0u, 0u, 0u, 0u}, r1 = r0, r2 = r0;
        if ((t0 & (SEQ - 1)) != 0) { r0 = *(const u32x4*)(src - 3 * PW); r1 = *(const u32x4*)(src - 2 * PW); r2 = *(const u32x4*)(src - PW); }
#pragma unroll 1
        for (int i8 = 0; i8 < 32; i8 += 8) {
            u32x4 cur[8];
#pragma unroll
            for (int k = 0; k < 8; ++k) cur[k] = *(const u32x4*)(src + (long)(i8 + k) * PW);
#pragma unroll
            for (int k = 0; k < 8; ++k) {
                const u32x4 rr[4] = {r0, r1, r2, cur[k]};
                float a[8];
#pragma unroll
                for (int e = 0; e < 8; ++e) a[e] = 0.f;
#pragma unroll
                for (int j = 0; j < 4; ++j) {
                    const u32x4 u = rr[j];
                    a[0] += w0[j][0] * bf_lo(u.x); a[1] += w0[j][1] * bf_hi(u.x); a[2] += w0[j][2] * bf_lo(u.y); a[3] += w0[j][3] * bf_hi(u.y);
                    a[4] += w1[j][0] * bf_lo(u.z); a[5] += w1[j][1] * bf_hi(u.z); a[6] += w1[j][2] * bf_lo(u.w); a[7] += w1[j][3] * bf_hi(u.w);
                }
                u32x4 w;
                w.x = pk_bf16(siluf_(a[0]) * sc, siluf_(a[1]) * sc); w.y = pk_bf16(siluf_(a[2]) * sc, siluf_(a[3]) * sc);
                w.z = pk_bf16(siluf_(a[4]) * sc, siluf_(a[5]) * sc); w.w = pk_bf16(siluf_(a[6]) * sc, siluf_(a[7]) * sc);
                *(u32x4*)(qk + (long)(t0 + i8 + k) * 1024 + ch * 8) = w;
                r0 = r1; r1 = r2; r2 = cur[k];
            }
        }
    }
}

typedef __attribute__((address_space(3))) s16x4 lds_s16x4;
__device__ __forceinline__ s16x4 lds_tr(const char* a) { return __builtin_amdgcn_ds_read_tr16_b64_v4i16((lds_s16x4*)a); }
__device__ __forceinline__ bf16x8 tr_frag_perm(const char* base, int pitch, int rbase, int cbase, int fr, int fq) {
    const char* a0 = base + (rbase + 4 * fq + (fr >> 2)) * pitch + (cbase + 4 * (fr & 3)) * 2;
    const s16x4 lo = lds_tr(a0), hi = lds_tr(a0 + 16 * pitch);
    return (bf16x8){lo[0], lo[1], lo[2], lo[3], hi[0], hi[1], hi[2], hi[3]};
}
__device__ __forceinline__ bf16x8 tr_frag_std(const char* base, int pitch, int rbase, int cbase, int fr, int fq) {
    const char* a0 = base + (rbase + 8 * fq + (fr >> 2)) * pitch + (cbase + 4 * (fr & 3)) * 2;
    const s16x4 lo = lds_tr(a0), hi = lds_tr(a0 + 4 * pitch);
    return (bf16x8){lo[0], lo[1], lo[2], lo[3], hi[0], hi[1], hi[2], hi[3]};
}
__device__ __forceinline__ bf16x8 pack_p(const f32x4 a, const f32x4 b) {
    u32x4 w; w.x = pk_bf16(a[0], a[1]); w.y = pk_bf16(a[2], a[3]); w.z = pk_bf16(b[0], b[1]); w.w = pk_bf16(b[2], b[3]);
    return as_bf16x8(w);
}

__device__ __forceinline__ float dpp_xor1(float v) { return __builtin_bit_cast(float, __builtin_amdgcn_mov_dpp(__builtin_bit_cast(int, v), 0xB1, 0xF, 0xF, true)); }
__device__ __forceinline__ float dpp_xor2(float v) { return __builtin_bit_cast(float, __builtin_amdgcn_mov_dpp(__builtin_bit_cast(int, v), 0x4E, 0xF, 0xF, true)); }

constexpr int NSA_PITCH = 160;
constexpr int NSA_KC = 0, NSA_VC = 20480, NSA_KT = 40960, NSA_VT = 61440, NSA_MISC = 81920, NSA_Y = 83968;

struct NsaState {
    bf16x8 qf[2][2];
    int tl[2];
    unsigned selm[2];
    unsigned wunion, bunion;
    unsigned tunion[2];
};

constexpr int NSA_STG = 16384;
__device__ __forceinline__ bf16x8 tr_frag_perm_swz(const char* base, int rbase, int dt, int fr, int fq) {
    const int R = rbase + 4 * fq + (fr >> 2), c = 2 * dt + ((fr & 3) >> 1);
    const char* a0 = base + R * 128 + ((c ^ (R & 7)) << 4) + 8 * (fr & 1);
    const s16x4 lo = lds_tr(a0), hi = lds_tr(a0 + 16 * 128);
    return (bf16x8){lo[0], lo[1], lo[2], lo[3], hi[0], hi[1], hi[2], hi[3]};
}

#define NSA_WAITV(n) asm volatile("s_waitcnt vmcnt(" #n ")" ::: "memory")
#define NSA_BAR() do { asm volatile("s_waitcnt lgkmcnt(0)" ::: "memory"); __builtin_amdgcn_s_barrier(); asm volatile("" ::: "memory"); } while (0)

template <int MODE>
__device__ __forceinline__ void nsa_stream(char* smem, const bf16_t* Pb  , int g, int i, NsaState& st, float gate0, float gate1, const int tid) {
    const int lane = tid & 63, fr = lane & 15, fq = lane >> 4;
    const int kcol = (MODE == 0 ? PC_KS : PC_KW) + g * 64, vcol = (MODE == 0 ? PC_VS : PC_VW) + g * 64;
    const int lrow = tid >> 3, lch = (tid & 7) ^ (lrow & 7);
    const bf16_t* ksrc = Pb + (long)lrow * PW + kcol + lch * 8;
    const bf16_t* vsrc = Pb + (long)lrow * PW + vcol + lch * 8;
    const int jlo = MODE == 0 ? 0 : (i - 8 > 0 ? i - 8 : 0);
    const unsigned range = (i >= 31 ? 0xffffffffu : ((1u << (i + 1)) - 1u)) & ~((1u << jlo) - 1u);
    const unsigned need = (unsigned)__builtin_amdgcn_readfirstlane((int)((MODE == 0 ? st.bunion : 0xffffffffu) & range));
    f32x4 O[2][4];
    float m[2], l[2];
    int tlq[2];
#pragma unroll
    for (int mt = 0; mt < 2; ++mt) { m[mt] = -1e30f; l[mt] = 0.f; tlq[mt] = st.tl[mt] - 4 * fq;
#pragma unroll
        for (int dt = 0; dt < 4; ++dt) O[mt][dt] = (f32x4){0.f, 0.f, 0.f, 0.f}; }
    unsigned pm = need;
    int nissued = 0;
    auto issue_next = [&]() {
        const int jj = __builtin_ctz(pm); pm &= pm - 1u;
        char* sb = smem + (nissued & 3) * NSA_STG;
        __builtin_amdgcn_global_load_lds((glb_u32*)(ksrc + (long)jj * 64 * PW), (lds_u32*)(sb + tid * 16), 16, 0, 0);
        __builtin_amdgcn_global_load_lds((glb_u32*)(vsrc + (long)jj * 64 * PW), (lds_u32*)(sb + 8192 + tid * 16), 16, 0, 0);
        ++nissued;
    };
    const int L = __builtin_popcount(need);
    if (L > 0) issue_next();
    if (L > 1) issue_next();
    if (L > 2) issue_next();
    if (L > 2) NSA_WAITV(4); else if (L > 1) NSA_WAITV(2); else NSA_WAITV(0);
    NSA_BAR();
    unsigned cm = need;
    for (int n = 0; n < L; ++n) {
        const int j = __builtin_ctz(cm); cm &= cm - 1u;
        if (n + 3 < L) issue_next();
        const char* KT = smem + (n & 3) * NSA_STG;
        const char* VT = KT + 8192;
        const bool on0 = MODE == 0 ? (((st.tunion[0] >> j) & 1u) != 0u) : true, on1 = MODE == 0 ? (((st.tunion[1] >> j) & 1u) != 0u) : true;
        if (on0 || on1) {
            f32x4 S[2][4];
            {
                bf16x8 kf[4][2];
#pragma unroll
                for (int nt = 0; nt < 4; ++nt)
#pragma unroll
                    for (int ks = 0; ks < 2; ++ks) kf[nt][ks] = *(const bf16x8*)(KT + (16 * nt + fr) * 128 + (((ks * 4 + fq) ^ (fr & 7)) << 4));
#pragma unroll
                for (int mt = 0; mt < 2; ++mt) {
                    if (MODE == 0 && !(mt == 0 ? on0 : on1)) continue;
#pragma unroll
                    for (int nt = 0; nt < 4; ++nt) {
                        f32x4 s = (f32x4){0.f, 0.f, 0.f, 0.f};
                        s = mfma16(kf[nt][0], st.qf[mt][0], s);
                        s = mfma16(kf[nt][1], st.qf[mt][1], s);
                        S[mt][nt] = s;
                    }
                }
            }
            bf16x8 pf[2][2];
            const bool edge = (j == i) || (MODE == 1 && j == i - 8);
            constexpr float CS = 0.125f * 1.4426950408889634f;
#pragma unroll
            for (int mt = 0; mt < 2; ++mt) {
                if (MODE == 0 && !(mt == 0 ? on0 : on1)) continue;
                const bool rowsel = MODE == 0 ? (((st.selm[mt] >> j) & 1u) != 0u) : true;
                if (edge) {
                    asm volatile("; boundary tile" ::: "memory");
#pragma unroll
                    for (int nt = 0; nt < 4; ++nt)
#pragma unroll
                        for (int e = 0; e < 4; ++e) {
                            const int kc = 16 * nt + e;
                            bool ok = true;
                            if (j == i) ok = ok && (kc <= tlq[mt]);
                            if (MODE == 1) { if (j == i - 8) ok = ok && (kc > tlq[mt]); }
                            S[mt][nt][e] = ok ? S[mt][nt][e] : -INFINITY;
                        }
                }
                float mx = -INFINITY;
#pragma unroll
                for (int nt = 0; nt < 4; ++nt)
#pragma unroll
                    for (int e = 0; e < 4; ++e) mx = __builtin_fmaxf(mx, S[mt][nt][e]);
                mx = fq_max(mx);
                if (MODE == 0) mx = rowsel ? mx : -INFINITY;
                const float mnew = __builtin_fmaxf(m[mt], mx * CS);
                const float alpha = __builtin_amdgcn_exp2f(m[mt] - mnew);
                const float msub = (MODE == 0 && !rowsel) ? INFINITY : mnew;
                float rs = 0.f;
#pragma unroll
                for (int nt = 0; nt < 4; ++nt)
#pragma unroll
                    for (int e = 0; e < 4; ++e) { const float pv = __builtin_amdgcn_exp2f(__builtin_fmaf(S[mt][nt][e], CS, -msub)); S[mt][nt][e] = pv; rs += pv; }
                rs = fq_sum(rs);
                l[mt] = l[mt] * alpha + rs; m[mt] = mnew;
#pragma unroll
                for (int dt = 0; dt < 4; ++dt) O[mt][dt] = O[mt][dt] * alpha;
                pf[mt][0] = pack_p(S[mt][0], S[mt][1]); pf[mt][1] = pack_p(S[mt][2], S[mt][3]);
            }
#pragma unroll
            for (int ks2 = 0; ks2 < 2; ++ks2)
#pragma unroll
                for (int dt = 0; dt < 4; ++dt) {
                    const bf16x8 vf = tr_frag_perm_swz(VT, 32 * ks2, dt, fr, fq);
                    if (MODE != 0 || on0) O[0][dt] = mfma16(vf, pf[0][ks2], O[0][dt]);
                    if (MODE != 0 || on1) O[1][dt] = mfma16(vf, pf[1][ks2], O[1][dt]);
                }
        }
        if (n + 1 < L) { if (n + 3 < L) NSA_WAITV(4); else if (n + 2 < L) NSA_WAITV(2); else NSA_WAITV(0); }
        NSA_BAR();
    }
#pragma unroll
    for (int mt = 0; mt < 2; ++mt) {
        const float gsc = (mt == 0 ? gate0 : gate1) * (l[mt] > 0.f ? 1.0f / l[mt] : 0.f);
#pragma unroll
        for (int dt = 0; dt < 4; ++dt) { f32x4* yp = (f32x4*)(smem + NSA_Y) + (mt * 4 + dt) * NTHR + tid; *yp = *yp + O[mt][dt] * gsc; }
    }
}

__device__ __forceinline__ void nsa_cmp_one(const char* smem, const bf16x8 qf0, const bf16x8 qf1, const int t, const int i, const float gate0, f32x4* yp  , unsigned& selm, const int lane) {
    const int fr = lane & 15, fq = lane >> 4;
        const int cl = (t >= 31 ? ((t - 31) >> 4) : -1) - 4 * fq;
        f32x4 S[8];
#pragma unroll
        for (int nt = 0; nt < 8; ++nt) {
            f32x4 s = (f32x4){0.f, 0.f, 0.f, 0.f};
#pragma unroll
            for (int ks = 0; ks < 2; ++ks) {
                const bf16x8 kf = *(const bf16x8*)(smem + NSA_KC + (16 * nt + fr) * NSA_PITCH + (ks * 4 + fq) * 16);
                s = mfma16(kf, (ks == 0 ? qf0 : qf1), s);
            }
            S[nt] = s;
        }
        float mx = -INFINITY;
#pragma unroll
        for (int nt = 0; nt < 8; ++nt)
#pragma unroll
            for (int e = 0; e < 4; ++e) {
                const float sv = (16 * nt + e <= cl) ? S[nt][e] * 0.125f : -INFINITY;
                S[nt][e] = sv; mx = fmaxf(mx, sv);
            }
        mx = fq_max(mx);
        const float mref = fmaxf(mx, -1e30f);
        float rs = 0.f;
#pragma unroll
        for (int nt = 0; nt < 8; ++nt)
#pragma unroll
            for (int e = 0; e < 4; ++e) { const float pv = __expf(S[nt][e] - mref); S[nt][e] = pv; rs += pv; }
        rs = fq_sum(rs);
        const float inv = rs > 0.f ? 1.0f / rs : 0.f;
#pragma unroll
        for (int nt = 0; nt < 8; ++nt) S[nt] = S[nt] * inv;
        {
            f32x4 O[4];
#pragma unroll
            for (int dt = 0; dt < 4; ++dt) O[dt] = (f32x4){0.f, 0.f, 0.f, 0.f};
#pragma unroll
            for (int ks2 = 0; ks2 < 4; ++ks2) {
                const bf16x8 pf = pack_p(S[2 * ks2], S[2 * ks2 + 1]);
#pragma unroll
                for (int dt = 0; dt < 4; ++dt) {
                    const bf16x8 vf = tr_frag_perm(smem + NSA_VC, NSA_PITCH, 32 * ks2, 16 * dt, fr, fq);
                    O[dt] = mfma16(vf, pf, O[dt]);
                }
            }
#pragma unroll
            for (int dt = 0; dt < 4; ++dt) yp[dt * NTHR] = O[dt] * gate0;
        }
        float imp[8];
        {
            float own[8], last[8];
#pragma unroll
            for (int nt = 0; nt < 8; ++nt) {
                f32x4 v = S[nt];
#pragma unroll
                for (int e = 0; e < 4; ++e) { v[e] += dpp_xor1(v[e]); v[e] += dpp_xor2(v[e]); }
                own[nt] = (v[0] + v[1]) + (v[2] + v[3]); last[nt] = v[3];
            }
            const int src = (lane + 48) & 63;
#pragma unroll
            for (int nt = 0; nt < 8; ++nt) {
                const float a = __shfl(last[nt], src);
                const float bsh = nt > 0 ? __shfl(last[nt > 0 ? nt - 1 : 0], src) : 0.f;
                const float prevc = fq > 0 ? a : bsh;
                const int n = 4 * nt + fq;
                const float pslc = own[nt] + prevc;
                const bool valid = n <= i;
                const bool forced = (n == 0) || (n == i) || (n == i - 1);
                imp[nt] = valid ? pslc + (forced ? 1e4f : 0.f) : -1e30f;
            }
        }
        unsigned mask = 0u;
#pragma unroll 1
        for (int r = 0; r < 8; ++r) {
            float bv = imp[0]; int bn = fq;
#pragma unroll
            for (int nt = 1; nt < 8; ++nt) { if (imp[nt] > bv) { bv = imp[nt]; bn = 4 * nt + fq; } }
#pragma unroll
            for (int off = 16; off <= 32; off <<= 1) {
                const float ov = __shfl_xor(bv, off); const int on = __shfl_xor(bn, off);
                if (ov > bv || (ov == bv && on < bn)) { bv = ov; bn = on; }
            }
            if (bv > -5e29f) mask |= 1u << bn;
#pragma unroll
            for (int nt = 0; nt < 8; ++nt) if (bn == 4 * nt + fq) imp[nt] = -3.0e38f;
        }
        selm = mask;
}

template <int NSAV = 7  >
__device__ __forceinline__ void nsa_task(const Params& p, char* smem, int b, int g, int i) {
    const char* ws = p.ws;
    const bf16_t* Pb = (const bf16_t*)(ws + WS_P) + (long)b * SEQ * PW;
    const float* psm = (const float*)(ws + WS_PSM) + (long)b * SEQ * 32;
    int tid = threadIdx.x;
    asm volatile("" : "+v"(tid));
    const int lane = tid & 63, wid = __builtin_amdgcn_readfirstlane(tid >> 6), fr = lane & 15, fq = lane >> 4;
    const int qs = i * 64;
    NsaState st;
    float gate[2][3];
#pragma unroll
    for (int mt = 0; mt < 2; ++mt) {
        st.tl[mt] = 8 * wid + 4 * mt + (fr >> 2);
        const int h = fr & 3;
        const bf16_t* qp = Pb + (long)(qs + st.tl[mt]) * PW + PC_Q + g * 256 + h * 64 + fq * 8;
        st.qf[mt][0] = *(const bf16x8*)(qp); st.qf[mt][1] = *(const bf16x8*)(qp + 32);
        const float* gp = psm + (long)(qs + st.tl[mt]) * 32 + (g * 4 + h) * 3;
        gate[mt][0] = sigmoidf_(gp[0]); gate[mt][1] = sigmoidf_(gp[1]); gate[mt][2] = sigmoidf_(gp[2]);
    }
    {
        const bf16_t* kc = (const bf16_t*)(ws + WS_KCMP) + (long)(b * 2 + g) * 128 * 64;
        const bf16_t* vc = (const bf16_t*)(ws + WS_VCMP) + (long)(b * 2 + g) * 128 * 64;
#pragma unroll
        for (int r = 0; r < 2; ++r) {
            const int e = tid + r * NTHR, row = e >> 3, ch = e & 7;
            *(u32x4*)(smem + NSA_KC + row * NSA_PITCH + ch * 16) = *(const u32x4*)(kc + row * 64 + ch * 8);
            *(u32x4*)(smem + NSA_VC + row * NSA_PITCH + ch * 16) = *(const u32x4*)(vc + row * 64 + ch * 8);
        }
    }
    __syncthreads();
    if (!(NSAV & 1)) { st.selm[0] = 0xffffffffu; st.selm[1] = 0xffffffffu;
#pragma unroll
        for (int d8 = 0; d8 < 8; ++d8) ((f32x4*)(smem + NSA_Y))[d8 * NTHR + tid] = (f32x4){0.f, 0.f, 0.f, 0.f}; }
    if (NSAV & 1) {
    nsa_cmp_one(smem, st.qf[0][0], st.qf[0][1], qs + st.tl[0], i, gate[0][0], (f32x4*)(smem + NSA_Y) + tid, st.selm[0], lane);
    asm volatile("" ::: "memory");
    __builtin_amdgcn_sched_barrier(0);
    nsa_cmp_one(smem, st.qf[1][0], st.qf[1][1], qs + st.tl[1], i, gate[1][0], (f32x4*)(smem + NSA_Y) + 4 * NTHR + tid, st.selm[1], lane);
    __builtin_amdgcn_sched_barrier(0);
    }
    {
        unsigned u0 = st.selm[0], u1 = st.selm[1];
        u0 |= __shfl_xor(u0, 4); u0 |= __shfl_xor(u0, 8); u1 |= __shfl_xor(u1, 4); u1 |= __shfl_xor(u1, 8);
        st.tunion[0] = (unsigned)__builtin_amdgcn_readfirstlane((int)u0); st.tunion[1] = (unsigned)__builtin_amdgcn_readfirstlane((int)u1);
        const unsigned u = st.tunion[0] | st.tunion[1];
        st.wunion = u;
        unsigned* misc = (unsigned*)(smem + NSA_MISC);
        if (lane == 0) misc[wid] = u;
        __syncthreads();
        unsigned bu = 0u;
#pragma unroll
        for (int w = 0; w < 8; ++w) bu |= misc[w];
        st.bunion = bu;
    }
    if (NSAV & 2) nsa_stream<0>(smem, Pb, g, i, st, gate[0][1], gate[1][1], tid);
    if (NSAV & 4) nsa_stream<1>(smem, Pb, g, i, st, gate[0][2], gate[1][2], tid);
    unsigned char* mix = (unsigned char*)(p.ws + WS_MIX) + (long)b * SEQ * 1024;
#pragma unroll
    for (int mt = 0; mt < 2; ++mt) {
        const int orow = qs + st.tl[mt], ocol = g * 256 + (fr & 3) * 64 + fq * 4;
#pragma unroll
        for (int dt = 0; dt < 4; ++dt) {
            const f32x4 yv = *((const f32x4*)(smem + NSA_Y) + (mt * 4 + dt) * NTHR + tid) * MIX8_SCALE;
            *(unsigned*)(mix + (long)orow * 1024 + ocol + dt * 16) = pk4_fp8(yv[0], yv[1], yv[2], yv[3]);
        }
    }
    __syncthreads();
}

constexpr int ML_PITCH = 288;
constexpr int ML_Q = 0, ML_K = 18432, ML_V = 36864, ML_VW = 55296, ML_C = 73728, ML_N = 110592, ML_GB = 111104, ML_GA = 119296, ML_GMQ = 127488,
              ML_GS = 135680, ML_ST = 136192;

__device__ __forceinline__ float wave_incl_scan_add(float v, int lane) {
#pragma unroll
    for (int off = 1; off < 64; off <<= 1) { const float o = __shfl_up(v, off); if (lane >= off) v += o; }
    return v;
}
__device__ __forceinline__ float wave_incl_scan_max(float v, int lane) {
#pragma unroll
    for (int off = 1; off < 64; off <<= 1) { const float o = __shfl_up(v, off); if (lane >= off) v = fmaxf(v, o); }
    return v;
}
__device__ __forceinline__ float wave_max(float v) {
#pragma unroll
    for (int off = 32; off >= 1; off >>= 1) v = fmaxf(v, __shfl_xor(v, off));
    return v;
}

__device__ __forceinline__ void mlstm_scan(const Params& p, char* smem, int b, int h) {
    const char* ws = p.ws;
    int tid = threadIdx.x;
    asm volatile("" : "+v"(tid));
    const int lane = tid & 63, wid = __builtin_amdgcn_readfirstlane(tid >> 6), fr = lane & 15, fq = lane >> 4;
    const bf16_t* QK = (const bf16_t*)(ws + WS_QK) + (long)b * SEQ * 1024 + h * 128;
    const bf16_t* Pb = (const bf16_t*)(ws + WS_P) + (long)b * SEQ * PW;
    const float* psm = (const float*)(ws + WS_PSM) + (long)b * SEQ * 32;
    unsigned char* mix = (unsigned char*)(p.ws + WS_MIX) + (long)b * SEQ * 1024;
    float* GB = (float*)(smem + ML_GB); float* GA = (float*)(smem + ML_GA); float* GMQ = (float*)(smem + ML_GMQ);
    float* GS = (float*)(smem + ML_GS);
    float* NV = (float*)(smem + ML_N);
    float* ST = (float*)(smem + ML_ST);
    {
        const float ib = p.in[I_IBIAS][h], fb = p.in[I_FBIAS][h];
        for (int c = wid; c < 32; c += 8) {
            const int t = c * 64 + lane;
            const float ipre = psm[(long)t * 32 + 24 + h], fpre = psm[(long)t * 32 + 28 + h];
            const float li = ipre + ib;
            const float x = fpre + fb;
            const float lf = fminf(x, 0.f) - log1pf(__expf(-fabsf(x)));
            const float bb = wave_incl_scan_add(lf, lane);
            const float aa = li - bb;
            const float g = __shfl(bb, 63);
            const float pm = wave_incl_scan_max(aa, lane);
            const float mloc = wave_max(g + aa);
            GB[t] = bb; GA[t] = aa; GMQ[t] = pm;
            if (lane == 0) { GS[64 + c] = g; GS[96 + c] = mloc; }
        }
    }
    for (int e = tid; e < 36864 / 16; e += NTHR) *(u32x4*)(smem + ML_C + e * 16) = (u32x4){0u, 0u, 0u, 0u};
    if (tid < 128) NV[tid] = 0.f;
    __syncthreads();
    if (tid == 0) {
        float m = 0.f;
        for (int c = 0; c < 32; ++c) { GS[c] = m; const float mn = fmaxf(GS[64 + c] + m, GS[96 + c]); GS[32 + c] = mn; m = mn; }
    }
    __syncthreads();
    for (int t = tid; t < SEQ; t += NTHR) GMQ[t] = GB[t] + fmaxf(GS[t >> 6], GMQ[t]);
    __syncthreads();

    f32x4 Cacc[9];
#pragma unroll
    for (int c9 = 0; c9 < 9; ++c9) Cacc[c9] = (f32x4){0.f, 0.f, 0.f, 0.f};
    const int lrow = tid >> 4, lch = tid & 15;
    u32x4 rq[2], rk[2], rv[2];
#pragma unroll
    for (int i2 = 0; i2 < 2; ++i2) {
        const int row = lrow + 32 * i2;
        rq[i2] = *(const u32x4*)(QK + (long)row * 1024 + lch * 8);
        rk[i2] = *(const u32x4*)(QK + (long)row * 1024 + 512 + lch * 8);
        rv[i2] = *(const u32x4*)(Pb + (long)row * PW + PC_MV + h * 128 + lch * 8);
    }
    const int mt = wid >> 1, half = wid & 1;
#pragma unroll 1
    for (int c = 0; c < 32; ++c) {
        const float m_old = GS[c], m_new = GS[32 + c], gch = GS[64 + c];
#pragma unroll
        for (int i2 = 0; i2 < 2; ++i2) {
            const int row = lrow + 32 * i2;
            *(u32x4*)(smem + ML_Q + row * ML_PITCH + lch * 16) = rq[i2];
            *(u32x4*)(smem + ML_K + row * ML_PITCH + lch * 16) = rk[i2];
            *(u32x4*)(smem + ML_V + row * ML_PITCH + lch * 16) = rv[i2];
            const float wk = __expf(gch + GA[c * 64 + row] - m_new);
            u32x4 w;
            w.x = pk_bf16(bf_lo(rv[i2].x) * wk, bf_hi(rv[i2].x) * wk); w.y = pk_bf16(bf_lo(rv[i2].y) * wk, bf_hi(rv[i2].y) * wk);
            w.z = pk_bf16(bf_lo(rv[i2].z) * wk, bf_hi(rv[i2].z) * wk); w.w = pk_bf16(bf_lo(rv[i2].w) * wk, bf_hi(rv[i2].w) * wk);
            *(u32x4*)(smem + ML_VW + row * ML_PITCH + lch * 16) = w;
        }
        if (tid < 128) {
            const int row = tid >> 1, hf = tid & 1;
            const float wk = __expf(gch + GA[c * 64 + row] - m_new);
            u32x4 w = (u32x4){0u, 0u, 0u, 0u};
            if (hf == 0) w.x = pk_bf16(wk, 0.f);
            *(u32x4*)(smem + ML_VW + row * ML_PITCH + 256 + hf * 16) = w;
        }
        __syncthreads();
        if (c + 1 < 32) {
#pragma unroll
            for (int i2 = 0; i2 < 2; ++i2) {
                const int row = (c + 1) * 64 + lrow + 32 * i2;
                rq[i2] = *(const u32x4*)(QK + (long)row * 1024 + lch * 8);
                rk[i2] = *(const u32x4*)(QK + (long)row * 1024 + 512 + lch * 8);
                rv[i2] = *(const u32x4*)(Pb + (long)row * PW + PC_MV + h * 128 + lch * 8);
            }
        }
        const int l = 16 * mt + fr;
        const float bl = GB[c * 64 + l], mq = GMQ[c * 64 + l];
        const float ul = bl - mq;
        f32x4 hv[4];
        float s1 = 0.f, s2 = 0.f;
        {
            bf16x8 qf[4];
#pragma unroll
            for (int ks = 0; ks < 4; ++ks) qf[ks] = *(const bf16x8*)(smem + ML_Q + l * ML_PITCH + (ks * 4 + fq) * 16);
            f32x4 S[4];
#pragma unroll
            for (int nt = 0; nt < 4; ++nt) {
                f32x4 s = (f32x4){0.f, 0.f, 0.f, 0.f};
#pragma unroll
                for (int ks = 0; ks < 4; ++ks) {
                    const bf16x8 kf = *(const bf16x8*)(smem + ML_K + (16 * nt + fr) * ML_PITCH + (ks * 4 + fq) * 16);
                    s = mfma16(kf, qf[ks], s);
                }
                S[nt] = s;
            }
            float dintra = 0.f;
            const int lq = l - 4 * fq;
#pragma unroll
            for (int nt = 0; nt < 4; ++nt) {
                const f32x4 av = *(const f32x4*)(GA + c * 64 + 16 * nt + 4 * fq);
#pragma unroll
                for (int e = 0; e < 4; ++e) {
                    const float w = (16 * nt + e <= lq) ? __expf(ul + av[e]) : 0.f;
                    const float sv = S[nt][e] * w;
                    S[nt][e] = sv; dintra += sv;
                }
            }
            dintra = fq_sum(dintra);
            float dinter = 0.f;
#pragma unroll
            for (int ks = 0; ks < 4; ++ks) {
                const f32x4 n0 = *(const f32x4*)(NV + ks * 32 + fq * 8), n1 = *(const f32x4*)(NV + ks * 32 + fq * 8 + 4);
                const u32x4 qu = __builtin_bit_cast(u32x4, qf[ks]);
                dinter += bf_lo(qu.x) * n0[0] + bf_hi(qu.x) * n0[1] + bf_lo(qu.y) * n0[2] + bf_hi(qu.y) * n0[3]
                        + bf_lo(qu.z) * n1[0] + bf_hi(qu.z) * n1[1] + bf_lo(qu.w) * n1[2] + bf_hi(qu.w) * n1[3];
            }
            dinter = fq_sum(dinter);
            const float winter = __expf(ul + m_old);
            const float den = winter * dinter + dintra;
            const float rden = 1.0f / fmaxf(fabsf(den), __expf(-mq));
            const bf16x8 pf0 = pack_p(S[0], S[1]), pf1 = pack_p(S[2], S[3]);
#pragma unroll
            for (int c4 = 0; c4 < 4; ++c4) {
                const int et = 4 * half + c4;
                f32x4 num = (f32x4){0.f, 0.f, 0.f, 0.f}, inter = (f32x4){0.f, 0.f, 0.f, 0.f};
                num = mfma16(tr_frag_perm(smem + ML_V, ML_PITCH, 0, 16 * et, fr, fq), pf0, num);
                num = mfma16(tr_frag_perm(smem + ML_V, ML_PITCH, 32, 16 * et, fr, fq), pf1, num);
#pragma unroll
                for (int ks = 0; ks < 4; ++ks) {
                    const bf16x8 cf = *(const bf16x8*)(smem + ML_C + (16 * et + fr) * ML_PITCH + (ks * 4 + fq) * 16);
                    inter = mfma16(cf, qf[ks], inter);
                }
                const f32x4 hh = (inter * winter + num) * rden;
                hv[c4] = hh;
                s1 += (hh[0] + hh[1]) + (hh[2] + hh[3]);
                s2 += (hh[0] * hh[0] + hh[1] * hh[1]) + (hh[2] * hh[2] + hh[3] * hh[3]);
            }
            s1 = fq_sum(s1); s2 = fq_sum(s2);
            if (fq == 0) { ST[(l * 2 + half) * 2] = s1; ST[(l * 2 + half) * 2 + 1] = s2; }
        }
        {
            const float decay = __expf(gch + m_old - m_new);
#pragma unroll
            for (int c9 = 0; c9 < 9; ++c9) Cacc[c9] = Cacc[c9] * decay;
#pragma unroll
            for (int ks2 = 0; ks2 < 2; ++ks2) {
                const bf16x8 kt = tr_frag_std(smem + ML_K, ML_PITCH, 32 * ks2, 16 * wid, fr, fq);
#pragma unroll
                for (int c9 = 0; c9 < 9; ++c9) {
                    const bf16x8 vw = tr_frag_std(smem + ML_VW, ML_PITCH, 32 * ks2, 16 * c9, fr, fq);
                    Cacc[c9] = mfma16(kt, vw, Cacc[c9]);
                }
            }
        }
        __syncthreads();
        {
            const float* sp = ST + l * 4;
            const float t1 = sp[0] + sp[2], t2 = sp[1] + sp[3];
            const float mean = t1 * (1.0f / 128.0f);
            const float var = fmaxf(t2 * (1.0f / 128.0f) - mean * mean, 0.f);
            const float rstd = rsqrtf(var + LN_EPS);
            const long tok = c * 64 + l;
#pragma unroll
            for (int c4 = 0; c4 < 4; ++c4) {
                const int col = 64 * half + 16 * c4 + 4 * fq;
                const u32x2 ou = *(const u32x2*)(Pb + tok * PW + PC_MO + h * 128 + col);
                const f32x4 ng = *(const f32x4*)(p.in[I_NORMG] + h * 128 + col);
                const f32x4 y = (hv[c4] - mean) * rstd * ng;
                *(unsigned*)(mix + tok * 1024 + 512 + h * 128 + col) = pk4_fp8(y[0] * sigmoidf_(bf_lo(ou.x)) * MIX8_SCALE, y[1] * sigmoidf_(bf_hi(ou.x)) * MIX8_SCALE,
                                                                                   y[2] * sigmoidf_(bf_lo(ou.y)) * MIX8_SCALE, y[3] * sigmoidf_(bf_hi(ou.y)) * MIX8_SCALE);
            }
        }
#pragma unroll
        for (int c9 = 0; c9 < 8; ++c9) {
            u32x2 w; w.x = pk_bf16(Cacc[c9][0], Cacc[c9][1]); w.y = pk_bf16(Cacc[c9][2], Cacc[c9][3]);
            *(u32x2*)(smem + ML_C + (16 * c9 + fr) * ML_PITCH + (16 * wid + 4 * fq) * 2) = w;
        }
        if (fr == 0) *(f32x4*)(NV + 16 * wid + 4 * fq) = Cacc[8];
        __syncthreads();
    }
}


constexpr int CV_PITCH = 144;
__device__ __forceinline__ void wconv_task(const Params& p, char* smem, int which, int e, int nt) {
    const int tid = opaque_tid();
    const int ng = tid & 63, kg = tid >> 6, n0 = 4 * ng;
    const float* src; int ld, K; unsigned char* dst;
    if (which == 0) {
        const int col = 128 * nt + 32 * (n0 >> 6) + bperm32(n0 & 31);
        src = (((n0 >> 5) & 1) ? p.in[I_MW3] : p.in[I_MW1]) + (long)e * 1024 * 256 + col; ld = 256; K = 1024;
        dst = (unsigned char*)p.out + ((long)(e * 2 + nt) * 256) * 1024;
    } else {
        src = p.in[I_MW2] + (long)e * 256 * 1024 + nt * 256 + bperm32(n0); ld = 1024; K = 256;
        dst = (unsigned char*)(p.ws + WS_W2F8) + ((long)(e * 4 + nt) * 256) * 256;
    }
    for (int kc = 0; kc < K / 128; ++kc) {
        f32x4 v[16];
#pragma unroll
        for (int j = 0; j < 16; ++j) v[j] = __builtin_nontemporal_load((const f32x4*)(src + (long)(kc * 128 + kg * 16 + j) * ld));
#pragma unroll
        for (int cc = 0; cc < 4; ++cc) {
            u32x4 w;
            w.x = pk4_fp8(v[0][cc] * W8_SCALE, v[1][cc] * W8_SCALE, v[2][cc] * W8_SCALE, v[3][cc] * W8_SCALE);
            w.y = pk4_fp8(v[4][cc] * W8_SCALE, v[5][cc] * W8_SCALE, v[6][cc] * W8_SCALE, v[7][cc] * W8_SCALE);
            w.z = pk4_fp8(v[8][cc] * W8_SCALE, v[9][cc] * W8_SCALE, v[10][cc] * W8_SCALE, v[11][cc] * W8_SCALE);
            w.w = pk4_fp8(v[12][cc] * W8_SCALE, v[13][cc] * W8_SCALE, v[14][cc] * W8_SCALE, v[15][cc] * W8_SCALE);
            *(u32x4*)(smem + (n0 + cc) * CV_PITCH + kg * 16) = w;
        }
        __syncthreads();
#pragma unroll
        for (int i = 0; i < 4; ++i) {
            const int piece = tid + i * NTHR, row = piece >> 3, ch = piece & 7;
            *(u32x4*)(dst + (long)row * K + kc * 128 + ch * 16) = *(const u32x4*)(smem + row * CV_PITCH + ch * 16);
        }
        __syncthreads();
    }
}

template <int PARTS = 7  , int NSAV = 7>
__device__ __forceinline__ void phase3(const Params& p, char* smem, int bid, int nb, int rep = 0) {
    XcdSlab xs; xs.init(bid, nb);
    const int nq = xs.x >= 0 ? 320 : 1024 + 1536;
    int* qctr = (int*)(p.ws + WS_CNT) + 16384 + ((xs.x >= 0 ? xs.x : 0) + 8 * rep) * 32;
    if (PARTS & 1) for (int u = bid; u < 64; u += nb) mlstm_scan(p, smem, u >> 2, u & 3);
    if (!(PARTS & 2)) return;
    volatile int* slot = (volatile int*)(smem + NSA_MISC + 256);
    for (;;) {
        if (opaque_tid() == 0) *slot = atomicAdd(qctr, 1);
        __syncthreads();
        const int k = __builtin_amdgcn_readfirstlane(*slot);
        if (k >= nq) break;
        if (xs.x >= 0) {
            const int r5 = k % 5, q5 = k / 5;
            if (r5 < 2) { const int kk = q5 * 2 + r5; const int bg = 4 * xs.x + (kk & 3); nsa_task<NSAV>(p, smem, bg >> 1, bg & 1, 31 - (kk >> 2)); }
            else if (PARTS & 4) { const int cv = q5 * 3 + (r5 - 2); const int e = xs.x + 8 * (cv / 6), t6 = cv % 6; wconv_task(p, smem, t6 < 2 ? 0 : 1, e, t6 < 2 ? t6 : t6 - 2); }
        } else if (k < 1024) nsa_task<NSAV>(p, smem, (k & 31) >> 1, k & 1, 31 - (k >> 5));
        else if (PARTS & 4) { const int cv = k - 1024; const int e = cv / 6, t6 = cv % 6; wconv_task(p, smem, t6 < 2 ? 0 : 1, e, t6 < 2 ? t6 : t6 - 2); }
    }
}

constexpr int XA_PITCH = 544;
constexpr int XA_K = 0, XA_V = 69632;
__device__ __forceinline__ void xattn_task(const Params& p, char* smem, int b, int h, int qb) {
    const char* ws = p.ws;
    int tid = threadIdx.x;
    asm volatile("" : "+v"(tid));
    const int lane = tid & 63, wid = __builtin_amdgcn_readfirstlane(tid >> 6), fr = lane & 15, fq = lane >> 4;
    const bf16_t* XQ = (const bf16_t*)(ws + WS_XQ) + (long)(b * SEQ + qb * 128 + wid * 16 + fr) * 1024 + h * 256 + fq * 8;
    const bf16_t* KV = (const bf16_t*)(ws + WS_KVX) + (long)b * 256 * 2048 + h * 256;
    TS(0);
    bf16x8 qf[8];
#pragma unroll
    for (int ks = 0; ks < 8; ++ks) qf[ks] = *(const bf16x8*)(XQ + ks * 32);
    f32x4 O[16];
#pragma unroll
    for (int dt = 0; dt < 16; ++dt) O[dt] = (f32x4){0.f, 0.f, 0.f, 0.f};
    float m = -1e30f, l = 0.f;
    const int lrow = tid >> 5, lch = tid & 31;
    u32x4 rk[4], rv[4];
#pragma unroll
    for (int i2 = 0; i2 < 4; ++i2) {
        const bf16_t* rp = KV + (long)(lrow + 16 * i2) * 2048 + lch * 8;
        rk[i2] = *(const u32x4*)rp; rv[i2] = *(const u32x4*)(rp + 1024);
    }
#pragma unroll
    for (int i2 = 0; i2 < 4; ++i2) {
        *(u32x4*)(smem + XA_K + (lrow + 16 * i2) * XA_PITCH + lch * 16) = rk[i2];
        *(u32x4*)(smem + XA_V + (lrow + 16 * i2) * XA_PITCH + lch * 16) = rv[i2];
    }
    __syncthreads();
    TS(1);
#pragma unroll 1
    for (int j = 0; j < 4; ++j) {
        const int buf = j & 1;
        if (j + 1 < 4) {
#pragma unroll
            for (int i2 = 0; i2 < 4; ++i2) {
                const bf16_t* rp = KV + (long)((j + 1) * 64 + lrow + 16 * i2) * 2048 + lch * 8;
                rk[i2] = *(const u32x4*)rp; rv[i2] = *(const u32x4*)(rp + 1024);
            }
        }
        const char* KT = smem + XA_K + buf * 34816;
        const char* VT = smem + XA_V + buf * 34816;
        f32x4 S[4];
#pragma unroll
        for (int nt = 0; nt < 4; ++nt) {
            f32x4 s = (f32x4){0.f, 0.f, 0.f, 0.f};
#pragma unroll
            for (int ks = 0; ks < 8; ++ks) {
                const bf16x8 kf = *(const bf16x8*)(KT + (16 * nt + fr) * XA_PITCH + (ks * 4 + fq) * 16);
                s = mfma16(kf, qf[ks], s);
            }
            S[nt] = s * 0.0625f;
        }
        float mx = -INFINITY;
#pragma unroll
        for (int nt = 0; nt < 4; ++nt)
#pragma unroll
            for (int e = 0; e < 4; ++e) mx = fmaxf(mx, S[nt][e]);
        mx = fq_max(mx);
        const float mnew = fmaxf(m, mx);
        const float alpha = __expf(m - mnew);
        float rs = 0.f;
#pragma unroll
        for (int nt = 0; nt < 4; ++nt)
#pragma unroll
            for (int e = 0; e < 4; ++e) { const float pv = __expf(S[nt][e] - mnew); S[nt][e] = pv; rs += pv; }
        rs = fq_sum(rs);
        l = l * alpha + rs; m = mnew;
#pragma unroll
        for (int dt = 0; dt < 16; ++dt) O[dt] = O[dt] * alpha;
        const bf16x8 pf0 = pack_p(S[0], S[1]), pf1 = pack_p(S[2], S[3]);
#pragma unroll
        for (int dt = 0; dt < 16; ++dt) {
            O[dt] = mfma16(tr_frag_perm(VT, XA_PITCH, 0, 16 * dt, fr, fq), pf0, O[dt]);
            O[dt] = mfma16(tr_frag_perm(VT, XA_PITCH, 32, 16 * dt, fr, fq), pf1, O[dt]);
        }
        if (j + 1 < 4) {
            char* KTn = smem + XA_K + (buf ^ 1) * 34816; char* VTn = smem + XA_V + (buf ^ 1) * 34816;
#pragma unroll
            for (int i2 = 0; i2 < 4; ++i2) {
                *(u32x4*)(KTn + (lrow + 16 * i2) * XA_PITCH + lch * 16) = rk[i2];
                *(u32x4*)(VTn + (lrow + 16 * i2) * XA_PITCH + lch * 16) = rv[i2];
            }
        }
        __syncthreads();
    }
    TS(2);
    const float inv = 1.0f / l;
    unsigned char* op = (unsigned char*)(p.ws + WS_XO) + (long)(b * SEQ + qb * 128 + wid * 16 + fr) * 1024 + h * 256 + fq * 4;
#pragma unroll
    for (int dt = 0; dt < 16; ++dt) *(unsigned*)(op + dt * 16) = pk4_fp8(O[dt][0] * inv, O[dt][1] * inv, O[dt][2] * inv, O[dt][3] * inv);
    TS(3);
}

__device__ __forceinline__ void phase6(const Params& p, char* smem, int bid, int nb) {
    XcdSlab xs; xs.init(bid, nb);
    const int p_lo = xs.m_lo(64), n_t = (xs.m_hi(64) - p_lo) * 16;
    for (int u = xs.j; u < n_t; u += xs.stride) { const int pr = p_lo + (u >> 4); xattn_task(p, smem, pr >> 2, pr & 3, u & 15); }
}

constexpr int LN_ST = 139264, LN_GB = 141312, MOE_TAB = 153600;

template <bool ABLK, bool BBLK, class EPI>
__device__ __forceinline__ void dense_loop(char* smem, int bid, int nb, const bf16_t* A, int lda, const bf16_t* Bt, int nk, const EPI& epi) {
    XcdSlab xs; xs.init(bid, nb);
    const int m_lo = xs.m_lo(128), n_t = (xs.m_hi(128) - m_lo) * 4;
    int mt = 0, nt = 0;
    RingRows al, bl;
    auto setup = [&](int u) {
        mt = m_lo + (u >> 2); nt = u & 3;
        if (ABLK) al.init_blocked(A, lda, mt * 256); else al.init_contig(A, lda, mt * 256);
        if (BBLK) bl.init_blocked(Bt, lda, nt * 256, true); else bl.init_contig(Bt, lda, nt * 256, true);
    };
    int u = xs.j;
    TS(0);
    if (u < n_t) { setup(u); ring_issue3(smem, al, bl); }
    int tsi = 1;
    while (u < n_t) {
        const int cmt = mt, cnt_ = nt;
        f32x4 acc[8][4];
        gemm_ring<RingRows, RingRows, 0, true>(smem, al, bl, nk, acc);
        TS(tsi); ++tsi;
        u += xs.stride;
        if (u < n_t) { setup(u); ring_issue3(smem, al, bl); }
        epi(acc, cmt, cnt_);
        TS(tsi); ++tsi;
    }
    asm volatile("s_waitcnt vmcnt(0)" ::: "memory");
    TS(5);
}

__device__ __forceinline__ void phase4(const Params& p, char* smem, int bid, int nb) {
    char* ws = p.ws;
    XcdSlab xs; xs.init(bid, nb);
    const int m_lo = xs.m_lo(128), n_t = (xs.m_hi(128) - m_lo) * 4;
    int mt = 0, nt = 0;
    RingF8 al, bl;
    auto setup = [&](int u) {
        mt = m_lo + (u >> 2); nt = u & 3;
        al.init_contig((const unsigned char*)(ws + WS_MIX), 1024, (long)mt * 256);
        bl.init_contig((const unsigned char*)(ws + WS_WOUT), 1024, (long)nt * 256, true);
    };
    int u = xs.j;
    if (u < n_t) { setup(u); ring_f8_issue3(smem, al, bl); }
    while (u < n_t) {
        const int cmt = mt, cnt_ = nt;
        f32x16 acc[4][2];
        gemm_ring_mx_main(smem, al, bl, 16, acc);
        u += xs.stride;
        if (u < n_t) { setup(u); ring_f8_issue3(smem, al, bl); }
        epi_residual_mx<false, true>(acc, smem, (const bf16_t*)(ws + WS_XB), nullptr, nullptr, nullptr, (bf16_t*)(ws + WS_R1B), (float*)(ws + WS_ST1), cmt * 256, cnt_, 1.0f / (W8_SCALE * MIX8_SCALE));
    }
    asm volatile("s_waitcnt vmcnt(0)" ::: "memory");
}

__device__ __forceinline__ void phase5(const Params& p, char* smem, int bid, int nb) {
    char* ws = p.ws;
    const float* lnf = (const float*)(ws + WS_LNF);
    dense_loop<true, true>(smem, bid, nb, (const bf16_t*)(ws + WS_R1B), 1024, (const bf16_t*)(ws + WS_WQ), 32, [&](f32x4 (&acc)[8][4], int mt, int nt) {
        ln_correct<0>(acc, (const float*)(ws + WS_ST1), mt * 256, lnf, lnf + 1792, nt);
        epi_store_bf16(acc, (bf16_t*)(ws + WS_XQ), 1024, mt * 256, nt * 256);
    });
}

__device__ __forceinline__ void phase7(const Params& p, char* smem, int bid, int nb) {
    char* ws = p.ws;
    ln_load_gb((float*)(smem + 149504), p.in[I_LN1G], p.in[I_LN1B]);
    XcdSlab xs; xs.init(bid, nb);
    const int m_lo = xs.m_lo(128), n_t = (xs.m_hi(128) - m_lo) * 4;
    int mt = 0, nt = 0;
    RingF8 al, bl;
    auto setup = [&](int u) {
        mt = m_lo + (u >> 2); nt = u & 3;
        al.init_contig((const unsigned char*)(ws + WS_XO), 1024, (long)mt * 256);
        bl.init_contig((const unsigned char*)(ws + WS_WO), 1024, (long)nt * 256, true);
    };
    int u = xs.j;
    if (u < n_t) { setup(u); ring_f8_issue3(smem, al, bl); }
    while (u < n_t) {
        const int cmt = mt, cnt_ = nt;
        f32x16 acc[4][2];
        gemm_ring_mx_main(smem, al, bl, 16, acc);
        u += xs.stride;
        if (u < n_t) { setup(u); ring_f8_issue3(smem, al, bl); }
        epi_residual_mx(acc, smem, (const bf16_t*)(ws + WS_R1B), (const float*)(ws + WS_ST1), (const float*)(smem + 149504), (const float*)(smem + 149504) + 1024, (bf16_t*)(ws + WS_R2B), (float*)(ws + WS_ST2), cmt * 256, cnt_);
    }
    asm volatile("s_waitcnt vmcnt(0)" ::: "memory");
}

template <class RowMap>
__device__ __forceinline__ void epi_swiglu(const f32x4 (&acc)[8][4], bf16_t* out, int ld, int nt, const RowMap& rm) {
    const int tid_ = opaque_tid();
    const int lane = tid_ & 63, wid = tid_ >> 6;
    const int wr = wid >> 2, wc = wid & 3, fr = lane & 15, fq = lane >> 4;
#pragma unroll
    for (int mi = 0; mi < 8; ++mi) {
        const long orow = rm(wr * 128 + mi * 16 + fr);
        if (orow >= 0) {
            const f32x4 a0 = acc[mi][0], b0 = acc[mi][1], a1 = acc[mi][2], b1 = acc[mi][3];
            u32x4 w;
            w.x = pk_bf16(siluf_(a0[0]) * b0[0], siluf_(a0[1]) * b0[1]); w.y = pk_bf16(siluf_(a0[2]) * b0[2], siluf_(a0[3]) * b0[3]);
            w.z = pk_bf16(siluf_(a1[0]) * b1[0], siluf_(a1[1]) * b1[1]); w.w = pk_bf16(siluf_(a1[2]) * b1[2], siluf_(a1[3]) * b1[3]);
            *(u32x4*)(out + orow * ld + nt * 128 + wc * 32 + fq * 8) = w;
        }
    }
}
struct RowIdent { long row0; __device__ __forceinline__ long operator()(int rl) const { return row0 + rl; } };
__device__ __forceinline__ void epi_swiglu_f8blk(const f32x4 (&acc)[8][4], unsigned char* out, int mt, int nt) {
    const int tid_ = opaque_tid();
    const int lane = tid_ & 63, wid = tid_ >> 6;
    const int wr = wid >> 2, wc = wid & 3, fr = lane & 15, fq = lane >> 4;
    unsigned char* base = out + (long)mt * 65536 + (2 * nt + (wc >> 1)) * 16384 + (wc & 1) * 32 + fq * 8;
#pragma unroll
    for (int mi = 0; mi < 8; ++mi) {
        const int rl = wr * 128 + mi * 16 + fr;
        const f32x4 a0 = acc[mi][0], b0 = acc[mi][1], a1 = acc[mi][2], b1 = acc[mi][3];
        u32x2 w;
        w.x = pk4_fp8(siluf_(a0[0]) * b0[0] * H8_SCALE, siluf_(a0[1]) * b0[1] * H8_SCALE, siluf_(a0[2]) * b0[2] * H8_SCALE, siluf_(a0[3]) * b0[3] * H8_SCALE);
        w.y = pk4_fp8(siluf_(a1[0]) * b1[0] * H8_SCALE, siluf_(a1[1]) * b1[1] * H8_SCALE, siluf_(a1[2]) * b1[2] * H8_SCALE, siluf_(a1[3]) * b1[3] * H8_SCALE);
        *(u32x2*)(base + rl * 64) = w;
    }
}

__device__ __forceinline__ unsigned dpp_xor1_u(unsigned v) { return (unsigned)__builtin_amdgcn_mov_dpp((int)v, 0xB1, 0xF, 0xF, true); }
__device__ __forceinline__ void route_tile(const Params& p, char* smem, int tok0, int rep) {
    char* ws = p.ws;
    const float* bias = p.in[I_ROUTB];
    const int tid = opaque_tid(), tk = tid >> 1, hf = tid & 1;
    const float* row = (const float*)(ws + WS_RSC) + (long)(tok0 + tk) * 256;
    unsigned key[128];
    float gs[4];
    {
        float v[128];
        {
            const int lane_ = tid & 63, wv = tid >> 6;
            const float* gsc = (const float*)(ws + WS_RSC) + (long)tok0 * 256;
#pragma unroll 1
            for (int half = 0; half < 2; ++half) {
                f32x4 tmp[16];
#pragma unroll
                for (int rr = 0; rr < 16; ++rr) tmp[rr] = *(const f32x4*)(gsc + (long)(half * 128 + wv * 16 + rr) * 256 + lane_ * 4);
#pragma unroll
                for (int rr = 0; rr < 16; ++rr) *(f32x4*)(smem + (wv * 16 + rr) * 1056 + (lane_ < 32 ? lane_ * 16 : 528 + (lane_ - 32) * 16)) = tmp[rr];
                __syncthreads();
                if ((tid >> 8) == half) {
                    const char* lp = smem + (tk & 127) * 1056 + hf * 528;
#pragma unroll
                    for (int i = 0; i < 32; ++i) { const f32x4 t = *(const f32x4*)(lp + i * 16); v[4 * i] = t[0]; v[4 * i + 1] = t[1]; v[4 * i + 2] = t[2]; v[4 * i + 3] = t[3]; }
                }
                __syncthreads();
            }
        }
#pragma unroll
        for (int gi = 0; gi < 4; ++gi) {
            float m1 = -INFINITY, m2 = -INFINITY;
#pragma unroll
            for (int i = 0; i < 32; ++i) { const float x = v[32 * gi + i]; m2 = __builtin_fmaxf(m2, __builtin_fminf(m1, x)); m1 = __builtin_fmaxf(m1, x); }
            gs[gi] = m1 + m2;
        }
        float g8[8];
#pragma unroll
        for (int gi = 0; gi < 4; ++gi) { const float o = dpp_xor1(gs[gi]); g8[gi] = hf ? o : gs[gi]; g8[4 + gi] = hf ? gs[gi] : o; }
        unsigned gsel = 0u;
#pragma unroll
        for (int a = 0; a < 8; ++a) {
            int rank = 0;
#pragma unroll
            for (int b = 0; b < 8; ++b) rank += (g8[b] > g8[a] || (g8[b] == g8[a] && b < a)) ? 1 : 0;
            if (rank < 4) gsel |= 1u << a;
        }
#pragma unroll
        for (int gi = 0; gi < 4; ++gi) {
            const bool on = ((gsel >> (4 * hf + gi)) & 1u) != 0u;
#pragma unroll
            for (int i = 0; i < 32; ++i) {
                const unsigned kb = (__float_as_uint(v[32 * gi + i] + 1.0f) & ~0xFFu) | (unsigned)(255 - (128 * hf + 32 * gi + i));
                key[32 * gi + i] = on ? kb : 0u;
            }
        }
    }
    unsigned win[8];
    unsigned prev = 0xFFFFFFFFu;
#pragma unroll
    for (int r = 0; r < 8; ++r) {
        unsigned m = 0u;
#pragma unroll
        for (int i = 0; i < 128; ++i) { const unsigned kk = key[i]; const unsigned c = kk < prev ? kk : 0u; m = m > c ? m : c; }
        const unsigned o = dpp_xor1_u(m);
        m = m > o ? m : o;
        prev = m;
        win[r] = m;
    }
    float sc8[8]; float wsum = 0.f;
#pragma unroll
    for (int r = 0; r < 8; ++r) { const int e = 255 - (int)(win[r] & 255u); sc8[r] = row[e] - bias[e]; wsum += sc8[r]; }
    int* lc = (int*)(smem + MOE_TAB); int* gbase = lc + 256;
    if (tid < 256) lc[tid] = 0;
    __syncthreads();
    int mye[4], myr[4];
    const unsigned hmask = 0u - (unsigned)hf;
#pragma unroll
    for (int u = 0; u < 4; ++u) {
        const unsigned w = win[u] ^ ((win[u] ^ win[4 + u]) & hmask);
        mye[u] = 255 - (int)(w & 255u); myr[u] = atomicAdd(lc + mye[u], 1);
    }
    __syncthreads();
    if (tid < 256) { const int n = lc[tid]; if (n > 0) gbase[tid] = atomicAdd((int*)(ws + WS_CNT) + 8192 * rep + tid * 32, n); }
    __syncthreads();
    {
        const long t = tok0 + tk;
        const float wn = 2.5f / wsum;
#pragma unroll
        for (int u = 0; u < 4; ++u) {
            const int k = 4 * hf + u;
            const int e = mye[u];
            const unsigned s0 = __float_as_uint(sc8[u]), s1 = __float_as_uint(sc8[4 + u]);
            const float w = __uint_as_float(s0 ^ ((s0 ^ s1) & hmask)) * wn;
            const int pos = gbase[e] + myr[u];
            ((int*)(ws + WS_SELE))[t * 8 + k] = e | (pos << 8);
            ((int*)(ws + WS_TOKL))[(long)e * LIST_CAP + pos] = (int)t;
            ((float*)(ws + WS_WL))[(long)e * LIST_CAP + pos] = w;
        }
    }
    __syncthreads();
}

__device__ __forceinline__ void phase8(const Params& p, char* smem, int bid, int nb, int rep = 0) {
    char* ws = p.ws;
    const float* lnf = (const float*)(ws + WS_LNF);
    XcdSlab xs; xs.init(bid, nb);
    const int m_lo = xs.m_lo(128), m_n = xs.m_hi(128) - m_lo;
    TS(0); TS(1); TS(2); TS(3);
    for (int u = xs.j; u < m_n; u += xs.stride) {
        const int mt = m_lo + u;
        float* gsc = (float*)(ws + WS_RSC);
        {
            RingRows al, bl;
            al.init_contig((const bf16_t*)(ws + WS_R2B), 1024, mt * 256);
            bl.init_contig((const bf16_t*)(ws + WS_WR), 1024, 0, true);
            f32x4 acc[8][4];
            gemm_ring(smem, al, bl, 32, acc);
            TS(1);
            ln_correct<0>(acc, (const float*)(ws + WS_ST2), mt * 256, lnf + 1024, lnf + 1792 + 1024, 0);
            const int tid_ = opaque_tid();
            const int lane = tid_ & 63, wid = tid_ >> 6;
            const int wr = wid >> 2, wc = wid & 3, fr = lane & 15, fq = lane >> 4;
            const float* bias = p.in[I_ROUTB];
#pragma unroll
            for (int ni = 0; ni < 4; ++ni) {
                const int col = wc * 64 + (ni >> 1) * 32 + fq * 8 + (ni & 1) * 4;
                const f32x4 bv = *(const f32x4*)(bias + col);
#pragma unroll
                for (int mi = 0; mi < 8; ++mi) {
                    f32x4 v;
#pragma unroll
                    for (int e = 0; e < 4; ++e) v[e] = sigmoidf_(acc[mi][ni][e]) + bv[e];
                    *(f32x4*)(gsc + (long)(mt * 256 + wr * 128 + mi * 16 + fr) * 256 + col) = v;
                }
            }
        }
        __syncthreads();
        TS(2);
        route_tile(p, smem, mt * 256, rep);
        TS(3);
    }
    {
        const bool split = xs.stride == 2 * m_n;
        const int tid = opaque_tid(), lane = tid & 63, wid = tid >> 6;
        const int wr = wid >> 2, wc = wid & 3, r = lane & 31, h = lane >> 5;
        const bf16_t* r2 = (const bf16_t*)(ws + WS_R2B); const float* st2 = (const float*)(ws + WS_ST2);
        unsigned char* x2 = (unsigned char*)(ws + WS_X2F8);
        for (int um = split ? (xs.j < m_n ? m_n : xs.j - m_n) : xs.j; um < m_n; um += split ? m_n : xs.stride) {
            const int mt = m_lo + um;
            {
                f32x4 g0[2], g1[2], b0[2], b1[2];
#pragma unroll
                for (int hseg = 0; hseg < 2; ++hseg) {
                    const int col = hseg * 512 + lane * 8;
                    g0[hseg] = *(const f32x4*)(p.in[I_LN2G] + col); g1[hseg] = *(const f32x4*)(p.in[I_LN2G] + col + 4);
                    b0[hseg] = *(const f32x4*)(p.in[I_LN2B] + col); b1[hseg] = *(const f32x4*)(p.in[I_LN2B] + col + 4);
                }
#pragma unroll 1
                for (int i4 = 0; i4 < 32; i4 += 4) {
                    const long tb = (long)mt * 256 + wid * 32 + i4;
                    f32x4 p0[4], p1[4]; u32x4 ru[4][2];
#pragma unroll
                    for (int k = 0; k < 4; ++k) {
                        p0[k] = *(const f32x4*)(st2 + (tb + k) * 8); p1[k] = *(const f32x4*)(st2 + (tb + k) * 8 + 4);
#pragma unroll
                        for (int hseg = 0; hseg < 2; ++hseg) ru[k][hseg] = *(const u32x4*)(r2 + (tb + k) * 1024 + hseg * 512 + lane * 8);
                    }
#pragma unroll
                    for (int k = 0; k < 4; ++k) {
                        const float q1 = (p0[k][0] + p0[k][2]) + (p1[k][0] + p1[k][2]), q2 = (p0[k][1] + p0[k][3]) + (p1[k][1] + p1[k][3]);
                        const float mean = q1 * (1.0f / 1024.0f);
                        const float rstd = rsqrtf(fmaxf(q2 * (1.0f / 1024.0f) - mean * mean, 0.f) + LN_EPS);
#pragma unroll
                        for (int hseg = 0; hseg < 2; ++hseg) {
                            const u32x4 u = ru[k][hseg];
                            const f32x4 a0 = (f32x4){bf_lo(u.x), bf_hi(u.x), bf_lo(u.y), bf_hi(u.y)}, a1 = (f32x4){bf_lo(u.z), bf_hi(u.z), bf_lo(u.w), bf_hi(u.w)};
                            const f32x4 y0 = (a0 - mean) * rstd * g0[hseg] + b0[hseg], y1 = (a1 - mean) * rstd * g1[hseg] + b1[hseg];
                            u32x2 w; w.x = pk4_fp8(y0[0], y0[1], y0[2], y0[3]); w.y = pk4_fp8(y1[0], y1[1], y1[2], y1[3]);
                            *(u32x2*)(x2 + (tb + k) * 1024 + hseg * 512 + lane * 8) = w;
                        }
                    }
                }
            }
            asm volatile("s_waitcnt vmcnt(0)" ::: "memory");
            __syncthreads();
#pragma unroll 1
            for (int nt = 0; nt < 2; ++nt) {
                RingF8 al, bl;
                al.init_contig((const unsigned char*)(ws + WS_X2F8), 1024, (long)mt * 256);
                bl.init_contig((const unsigned char*)(ws + WS_WS13), 1024, (long)nt * 256);
                ring_f8_issue3(smem, al, bl);
                f32x16 acc[4][2];
                gemm_ring_mx_main(smem, al, bl, 16, acc);
                unsigned char* hb = (unsigned char*)(ws + WS_HS) + (long)mt * 65536 + (2 * nt + (wc >> 1)) * 16384 + (wc & 1) * 32 + h * 16;
                constexpr float D = 1.0f / W8_SCALE, HSC = H8_SCALE / W8_SCALE;
#pragma unroll
                for (int mi = 0; mi < 4; ++mi) {
                    const int rl = wr * 128 + mi * 32 + r;
                    float o[16];
#pragma unroll
                    for (int q = 0; q < 16; ++q) o[q] = siluf_(acc[mi][0][q] * D) * (acc[mi][1][q] * HSC);
                    u32x4 w; w.x = pk4_fp8(o[0], o[1], o[2], o[3]); w.y = pk4_fp8(o[4], o[5], o[6], o[7]); w.z = pk4_fp8(o[8], o[9], o[10], o[11]); w.w = pk4_fp8(o[12], o[13], o[14], o[15]);
                    *(u32x4*)(hb + rl * 64) = w;
                }
            }
        }
    }
    TS(4);
    TS(5);
}

template <int XMODE>
__device__ __forceinline__ void phase_probe(const Params& p, char* smem, int bid, int nb) {
    char* ws = p.ws;
    XcdSlab xs; xs.init(bid, nb);
    const int m_lo = xs.m_lo(128), n_t = (xs.m_hi(128) - m_lo) * 4;
    for (int u = xs.j; u < n_t; u += xs.stride) {
        const int mt = m_lo + (u >> 2), nt = u & 3;
        RingRows al, bl;
        al.init_blocked((const bf16_t*)(ws + WS_MIX), 1024, mt * 256);
        bl.init_blocked((const bf16_t*)(ws + WS_WOUT), 1024, nt * 256, true);
        f32x4 acc[8][4];
        gemm_ring<RingRows, RingRows, XMODE>(smem, al, bl, 32, acc);
        epi_store_bf16(acc, (bf16_t*)(ws + WS_A + 432 * MB), 1024, mt * 256, nt * 256);
    }
}

__device__ __forceinline__ void moe_tables(const Params& p, char* smem, const XcdSlab& xs) {
    int* off = (int*)(smem + MOE_TAB); int* tst = off + 256; int* cntl = tst + 260;
    const int* cnt = (const int*)(p.ws + WS_CNT);
    const int tid = opaque_tid();
    if (tid >= 256) cntl[tid - 256] = cnt[(tid - 256) * 32];
    if (tid < 64) {
        int c[4], cs = 0;
#pragma unroll
        for (int k = 0; k < 4; ++k) { c[k] = cnt[(tid * 4 + k) * 32]; cs += c[k]; }
        int ics = cs;
#pragma unroll
        for (int o = 1; o < 64; o <<= 1) { const int a = __shfl_up(ics, o); if (tid >= o) ics += a; }
        int eo = ics - cs;
#pragma unroll
        for (int k = 0; k < 4; ++k) { off[tid * 4 + k] = eo; eo += c[k]; }
    } else if (tid < 128) {
        const int l = tid - 64;
        if (xs.x >= 0) {
            const int tl = l < 32 ? ((cnt[(xs.x + 8 * l) * 32] + 255) >> 8) : 0;
            int it = tl;
#pragma unroll
            for (int o = 1; o < 64; o <<= 1) { const int a = __shfl_up(it, o); if (l >= o) it += a; }
            if (l < 32) tst[l] = it - tl;
            if (l == 31) tst[32] = it;
        } else {
            int c[4], ts = 0;
#pragma unroll
            for (int k = 0; k < 4; ++k) { c[k] = (cnt[(l * 4 + k) * 32] + 255) >> 8; ts += c[k]; }
            int its = ts;
#pragma unroll
            for (int o = 1; o < 64; o <<= 1) { const int a = __shfl_up(its, o); if (l >= o) its += a; }
            int et = its - ts;
#pragma unroll
            for (int k = 0; k < 4; ++k) { tst[l * 4 + k] = et; et += c[k]; }
            if (l == 63) tst[256] = its;
        }
    }
    __syncthreads();
}
__device__ __forceinline__ int moe_find(const int* tst, int nloc, int t) {
    int lo = 0, hi = nloc - 1;
#pragma unroll 1
    while (lo < hi) { const int mid = (lo + hi + 1) >> 1; if (tst[mid] <= t) lo = mid; else hi = mid - 1; }
    return lo;
}
struct RowMoe { long base; int nvalid; __device__ __forceinline__ long operator()(int rl) const { return rl < nvalid ? base + rl : -1; } };

template <int PARTS9 = 3>
__device__ __forceinline__ void phase9(const Params& p, char* smem, int bid, int nb) {
    char* ws = p.ws;
    XcdSlab xs; xs.init(bid, nb);
    moe_tables(p, smem, xs);
    const int* off = (const int*)(smem + MOE_TAB); const int* tst = off + 256;
    const int* cnt = (const int*)(ws + WS_CNT);
    const int nloc = xs.x >= 0 ? 32 : 256;
    const int ntile = tst[nloc];
    {
        const int* cntl = tst + 260;
        const int nT = ntile * 2;
        int t = xs.j;
        int e = 0, m0 = 0, ne = 0, nt = 0;
        RingF8 al, bl;
        auto setup = [&](int tt) {
            const int et = tt >> 1; nt = tt & 1;
            const int kl = moe_find(tst, nloc, et); e = xs.x >= 0 ? xs.x + 8 * kl : kl; m0 = (et - tst[kl]) * 256; ne = cntl[e];
            const int tid = opaque_tid();
            const int* tl = (const int*)(ws + WS_TOKL) + (long)e * LIST_CAP;
            int rows[2];
#pragma unroll
            for (int i = 0; i < 2; ++i) { const int r = m0 + (tid >> 2) + 128 * i; rows[i] = r < ne ? tl[r] : 0; }
            al.init_rows((const unsigned char*)(ws + WS_X2F8), 1024, rows);
            bl.init_contig((const unsigned char*)p.out, 1024, (long)(e * 2 + nt) * 256);
        };
        if (!(PARTS9 & 1)) t = nT;
        TS(0);
        if (t < nT) { setup(t); ring_f8_issue3(smem, al, bl); }
        int tsi = 1;
        while (t < nT) {
            const int ce = e, cm0 = m0, cne = ne, cnt_ = nt;
            f32x16 acc[4][2];
            gemm_ring_mx_main(smem, al, bl, 16, acc);
            if (tsi < 3) { TS(tsi); }
            t += xs.stride;
            if (t < nT) { setup(t); ring_f8_issue3(smem, al, bl); }
            {
                const int tid2 = opaque_tid();
                const int lane = tid2 & 63, wid = tid2 >> 6;
                const int wr = wid >> 2, wc = wid & 3, r = lane & 31, h = lane >> 5;
                unsigned char* H = (unsigned char*)(ws + WS_HF8) + ((long)off[ce] + cm0) * 256 + cnt_ * 128 + wc * 32 + h * 16;
                constexpr float D = 1.0f / W8_SCALE, HS = H8_SCALE / W8_SCALE;
#pragma unroll
                for (int mi = 0; mi < 4; ++mi) {
                    const int rl = wr * 128 + mi * 32 + r;
                    if (cm0 + rl < cne) {
                        float o[16];
#pragma unroll
                        for (int q = 0; q < 16; ++q) o[q] = siluf_(acc[mi][0][q] * D) * (acc[mi][1][q] * HS);
                        u32x4 w; w.x = pk4_fp8(o[0], o[1], o[2], o[3]); w.y = pk4_fp8(o[4], o[5], o[6], o[7]); w.z = pk4_fp8(o[8], o[9], o[10], o[11]); w.w = pk4_fp8(o[12], o[13], o[14], o[15]);
                        *(u32x4*)(H + (long)rl * 256) = w;
                    }
                }
            }
            if (tsi < 3) { TS(tsi + 2); } ++tsi;
        }
        asm volatile("s_waitcnt vmcnt(0)" ::: "memory"); __syncthreads();
        TS(5);
    }
    const int m_lo = xs.m_lo(128), n_t = (PARTS9 & 2) ? (xs.m_hi(128) - m_lo) * 4 : 0;
    for (int u = (xs.j + xs.stride - (ntile * 2) % xs.stride) % xs.stride; u < n_t; u += xs.stride) {
        const int mt = m_lo + (u >> 2), nt = u & 3;
        RingF8B al; RingF8 bl;
        al.init((const unsigned char*)(ws + WS_HS), 256, (long)mt * 256);
        bl.init_contig((const unsigned char*)(ws + WS_WS2), 256, (long)nt * 256, true);
        ring_f8_issue3(smem, al, bl);
        f32x16 acc[4][2];
        gemm_ring_mx_main(smem, al, bl, 4, acc);
        __syncthreads();
        epi_store_bf16_mx(acc, 1.0f / (W8_SCALE * H8_SCALE), (bf16_t*)(ws + WS_SH), 1024, mt * 256, nt * 256);
    }
    TS(6);
}

template <int P10V = 0  >
__device__ __forceinline__ void phase10(const Params& p, char* smem, int bid, int nb) {
    char* ws = p.ws;
    XcdSlab xs; xs.init(bid, nb);
    moe_tables(p, smem, xs);
    const int* off = (const int*)(smem + MOE_TAB); const int* tst = off + 256;
    const int* cnt = (const int*)(ws + WS_CNT);
    const int nloc = xs.x >= 0 ? 32 : 256;
    const int ntile = tst[nloc];
    {
        const int* cntl = tst + 260;
        const int nT = ntile;
        const int tid_ = opaque_tid();
        const int lane = tid_ & 63, wid = __builtin_amdgcn_readfirstlane(tid_ >> 6);
        const int wr = wid >> 2, wc = wid & 3, r = lane & 31, h = lane >> 5;
        const int g = (r >> 2) & 3;
        const int c0 = ((2 * h) ^ g) << 4, c1 = ((2 * h + 1) ^ g) << 4;
        const int arow = (wr * 128 + r) * 64;
        const int brow = (wc * 64 + r) * 64;
        char* ringB = smem + 65536;
        for (int t = xs.j; t < nT; t += xs.stride) {
            const int kl = moe_find(tst, nloc, t), e = xs.x >= 0 ? xs.x + 8 * kl : kl, m0 = (t - tst[kl]) * 256, ne = cntl[e];
            RingF8 al, bl;
            al.init_contig((const unsigned char*)(ws + WS_HF8), 256, (long)off[e] + m0);
            bl.init_contig((const unsigned char*)(ws + WS_W2F8), 256, (long)(e * 4) * 256);
            const float* wl = (const float*)(ws + WS_WL) + (long)e * LIST_CAP + m0;
            float* rwl = (float*)(smem + MOE_TAB + 4096);
            if (tid_ < 256) rwl[tid_] = (m0 + tid_ < ne) ? wl[tid_] * (Y8_SCALE / (W8_SCALE * H8_SCALE)) : 0.f;
            unsigned char* Yb = (unsigned char*)(ws + WS_Y) + ((long)off[e] + m0) * 1024 + wc * 64 + h * 16;
#pragma unroll
            for (int ks = 0; ks < 4; ++ks) al.issue(smem + ks * 16384, ks);
            auto issueB = [&](int bt, int stg) {
                const int nt_ = bt >> 2, ks_ = bt & 3;
                char* s = ringB + stg * 16384;
#pragma unroll
                for (int i = 0; i < 2; ++i)
                    __builtin_amdgcn_global_load_lds((glb_u32*)(bl.base + (size_t)(bl.off[i] + (unsigned)(nt_ * 65536 + ks_ * 64))), (lds_u32*)(s + i * 8192 + bl.ldst), 16, 0, 0);
            };
            issueB(0, 0); issueB(1, 1); issueB(2, 2); issueB(3, 3);
            RING_WAIT(6);
            RING_BAR();
            if (wr == 1) RING_BAR();
            f32x16 acc[4][2];
#pragma unroll
            for (int mi = 0; mi < 4; ++mi)
#pragma unroll
                for (int nj = 0; nj < 2; ++nj)
#pragma unroll
                    for (int q = 0; q < 16; ++q) acc[mi][nj][q] = 0.f;
            int sg = 0;
#pragma unroll 1
            for (int bt = 0; bt < 16; ++bt) {
                const char* sa = smem + (bt & 3) * 16384;
                const char* sb = ringB + sg * 16384;
                { const int s4 = sg == 0 ? 4 : sg - 1; if (bt + 4 < 16) issueB(bt + 4, s4); }
                i32x8 bf[2], af[4];
#pragma unroll
                for (int nj = 0; nj < 2; ++nj) bf[nj] = mx_frag(sb + brow + nj * 2048, c0, c1);
#pragma unroll
                for (int mi = 0; mi < 4; ++mi) af[mi] = mx_frag(sa + arow + mi * 2048, c0, c1);
                if (bt + 1 < 16) { if (bt + 4 < 16) RING_WAIT(6); else if (bt + 3 < 16) RING_WAIT(4); else if (bt + 2 < 16) RING_WAIT(2); else RING_WAIT(0); }
                RING_BAR();
                __builtin_amdgcn_s_setprio(1);
                if (P10V != 2) {
#pragma unroll
                for (int mi = 0; mi < 4; ++mi)
#pragma unroll
                    for (int nj = 0; nj < 2; ++nj) acc[mi][nj] = mfma_mx(bf[nj], af[mi], acc[mi][nj]);
                } else { acc[0][0][0] += (float)(af[0][0] + bf[0][0] + af[3][7] + bf[1][3]); }
                __builtin_amdgcn_s_setprio(0);
                if ((bt & 3) == 3) {
                    const int nt_ = bt >> 2;
#pragma unroll
                    for (int mi = 0; mi < 4; ++mi) {
                        const int rl = wr * 128 + mi * 32 + r;
                        if (m0 + rl < ne) {
                            const float w = rwl[rl];
#pragma unroll
                            for (int nj = 0; nj < 2; ++nj) {
                                const f32x16 u = acc[mi][nj] * w;
                                u32x4 v; v.x = pk4_fp8(u[0], u[1], u[2], u[3]); v.y = pk4_fp8(u[4], u[5], u[6], u[7]); v.z = pk4_fp8(u[8], u[9], u[10], u[11]); v.w = pk4_fp8(u[12], u[13], u[14], u[15]);
                                if (P10V != 1) *(u32x4*)(Yb + (long)rl * 1024 + nt_ * 256 + nj * 32) = v; else if (v.x == 0x12345678u) *(u32x4*)(Yb) = v;
                            }
                        }
#pragma unroll
                        for (int nj = 0; nj < 2; ++nj)
#pragma unroll
                            for (int q = 0; q < 16; ++q) acc[mi][nj][q] = 0.f;
                    }
                }
                RING_BAR();
                sg = sg == 4 ? 0 : sg + 1;
            }
            if (wr == 0) RING_BAR();
        }
    }
}

__device__ __forceinline__ void phase11(const Params& p, char* smem, int bid, int nb) {
    char* ws = p.ws;
    XcdSlab xs; xs.init(bid, nb);
    moe_tables(p, smem, xs);
    const int* off = (const int*)(smem + MOE_TAB);
    const int tid = opaque_tid(), lane = tid & 63, wid = tid >> 6;
    const bf16_t* r2 = (const bf16_t*)(ws + WS_R2B);
    const float* st2 = (const float*)(ws + WS_ST2);
    const bf16_t* SH = (const bf16_t*)(ws + WS_SH);
    const unsigned char* Y = (const unsigned char*)(ws + WS_Y);
    const int* sele = (const int*)(ws + WS_SELE);
    f32x4 g2a[2], g2b[2], b2a[2], b2b[2], g3a[2], g3b[2], b3a[2], b3b[2];
#pragma unroll
    for (int hseg = 0; hseg < 2; ++hseg) {
        const int col = hseg * 512 + lane * 8;
        g2a[hseg] = *(const f32x4*)(p.in[I_LN2G] + col); g2b[hseg] = *(const f32x4*)(p.in[I_LN2G] + col + 4);
        b2a[hseg] = *(const f32x4*)(p.in[I_LN2B] + col); b2b[hseg] = *(const f32x4*)(p.in[I_LN2B] + col + 4);
        g3a[hseg] = *(const f32x4*)(p.in[I_LN3G] + col); g3b[hseg] = *(const f32x4*)(p.in[I_LN3G] + col + 4);
        b3a[hseg] = *(const f32x4*)(p.in[I_LN3B] + col); b3b[hseg] = *(const f32x4*)(p.in[I_LN3B] + col + 4);
    }
    for (int t = bid * 8 + wid; t < T_TOK; t += nb * 8) {
        const f32x4 p0 = *(const f32x4*)(st2 + (long)t * 8), p1 = *(const f32x4*)(st2 + (long)t * 8 + 4);
        const float q1 = (p0[0] + p0[2]) + (p1[0] + p1[2]), q2 = (p0[1] + p0[3]) + (p1[1] + p1[3]);
        const float mean2 = q1 * (1.0f / 1024.0f);
        const float rstd2 = rsqrtf(fmaxf(q2 * (1.0f / 1024.0f) - mean2 * mean2, 0.f) + LN_EPS);
        int yrow[8];
#pragma unroll
        for (int k = 0; k < 8; ++k) { const int ep = sele[(long)t * 8 + k]; yrow[k] = off[ep & 255] + (ep >> 8); }
        float v[16];
#pragma unroll
        for (int hseg = 0; hseg < 2; ++hseg) {
            const int col = hseg * 512 + lane * 8;
            const u32x4 ru = *(const u32x4*)(r2 + (long)t * 1024 + col);
            const f32x4 a0 = (f32x4){bf_lo(ru.x), bf_hi(ru.x), bf_lo(ru.y), bf_hi(ru.y)}, a1 = (f32x4){bf_lo(ru.z), bf_hi(ru.z), bf_lo(ru.w), bf_hi(ru.w)};
            const f32x4 g0 = g2a[hseg], g1 = g2b[hseg], b0 = b2a[hseg], b1 = b2b[hseg];
            const f32x4 x0 = ((a0 - mean2) * rstd2 * g0 + b0) * ALPHA, x1 = ((a1 - mean2) * rstd2 * g1 + b1) * ALPHA;
            float* vv = v + hseg * 8;
            vv[0] = x0[0]; vv[1] = x0[1]; vv[2] = x0[2]; vv[3] = x0[3]; vv[4] = x1[0]; vv[5] = x1[1]; vv[6] = x1[2]; vv[7] = x1[3];
            const u32x4 s = __builtin_nontemporal_load((const u32x4*)(SH + (long)t * 1024 + col));
            vv[0] += bf_lo(s.x); vv[1] += bf_hi(s.x); vv[2] += bf_lo(s.y); vv[3] += bf_hi(s.y); vv[4] += bf_lo(s.z); vv[5] += bf_hi(s.z); vv[6] += bf_lo(s.w); vv[7] += bf_hi(s.w);
            f32x2 ys[4];
#pragma unroll
            for (int e2 = 0; e2 < 4; ++e2) ys[e2] = (f32x2){0.f, 0.f};
#pragma unroll
            for (int k = 0; k < 8; ++k) {
                const u32x2 y = __builtin_nontemporal_load((const u32x2*)(Y + (long)yrow[k] * 1024 + col));
                ys[0] += __builtin_amdgcn_cvt_pk_f32_fp8((int)y.x, false); ys[1] += __builtin_amdgcn_cvt_pk_f32_fp8((int)y.x, true);
                ys[2] += __builtin_amdgcn_cvt_pk_f32_fp8((int)y.y, false); ys[3] += __builtin_amdgcn_cvt_pk_f32_fp8((int)y.y, true);
            }
#pragma unroll
            for (int e2 = 0; e2 < 4; ++e2) { vv[2 * e2] += ys[e2][0] * (1.0f / Y8_SCALE); vv[2 * e2 + 1] += ys[e2][1] * (1.0f / Y8_SCALE); }
        }
        float s1 = 0.f;
#pragma unroll
        for (int i = 0; i < 16; ++i) s1 += v[i];
#pragma unroll
        for (int o = 32; o >= 1; o >>= 1) s1 += __shfl_xor(s1, o);
        const float mean = s1 * (1.0f / 1024.0f);
        float s2 = 0.f;
#pragma unroll
        for (int i = 0; i < 16; ++i) { const float d = v[i] - mean; s2 += d * d; }
#pragma unroll
        for (int o = 32; o >= 1; o >>= 1) s2 += __shfl_xor(s2, o);
        const float rstd = rsqrtf(s2 * (1.0f / 1024.0f) + LN_EPS);
#pragma unroll
        for (int hseg = 0; hseg < 2; ++hseg) {
            const int col = hseg * 512 + lane * 8;
            const f32x4 g0 = g3a[hseg], g1 = g3b[hseg], b0 = b3a[hseg], b1 = b3b[hseg];
            const float* vv = v + hseg * 8;
            f32x4 o0, o1;
#pragma unroll
            for (int e = 0; e < 4; ++e) { o0[e] = (vv[e] - mean) * rstd * g0[e] + b0[e]; o1[e] = (vv[4 + e] - mean) * rstd * g1[e] + b1[e]; }
            *(f32x4*)(p.out + (long)t * 1024 + col) = o0; *(f32x4*)(p.out + (long)t * 1024 + col + 4) = o1;
        }
    }
}

#if MEGA
#define XB_TMO      128
#define XB_XCNT(j)  (256  + 64 * (j))
#define XB_XSUB(j)  (1280 + 64 * (j))
#define XB_XGEN(j)  (2304 + 64 * (j))
#define XB_TOP      3328
#define XB_TOPGEN   3392
#define XCD_BAR_WORDS 3456
#define XB_SPIN_CAP (1u << 22)
#define LAS __attribute__((address_space(3)))
__device__ __forceinline__ unsigned xb_ld(unsigned* p)              { return __hip_atomic_load(p, __ATOMIC_RELAXED, __HIP_MEMORY_SCOPE_AGENT); }
__device__ __forceinline__ unsigned xb_add(unsigned* p, unsigned v) { return __hip_atomic_fetch_add(p, v, __ATOMIC_RELAXED, __HIP_MEMORY_SCOPE_AGENT); }
__device__ __forceinline__ unsigned xb_xcc_id() { return (unsigned)__builtin_amdgcn_s_getreg((3 << 11) | 20) & 0xFu; }
#define XB_SPIN(cond, bar) do { unsigned _sp = 0; while (cond) { __builtin_amdgcn_s_sleep(1); \
    if ((++_sp & 255u) == 0u) { if (xb_ld(&(bar)[XB_TMO])) break; if (_sp > XB_SPIN_CAP) { atomicAdd(&(bar)[XB_TMO], 1u); break; } } } } while (0)
struct XcdBarrier { unsigned* bar; unsigned x; volatile LAS unsigned* st; };
__device__ __forceinline__ XcdBarrier xcd_barrier_post(unsigned* bar, volatile LAS unsigned* st) {
    XcdBarrier b; b.bar = bar; b.x = xb_xcc_id(); b.st = st;
    if (threadIdx.x == 0) (void)xb_add(&bar[XB_XCNT(b.x)], 1u);
    return b;
}
__device__ __forceinline__ void xcd_barrier_complete(unsigned* bar, unsigned x, unsigned& nloc, unsigned& nx) {
    const unsigned G = gridDim.x * gridDim.y * gridDim.z;
    unsigned sum, cnt, mine, sp = 0u;
    for (;;) {
        sum = 0u; cnt = 0u; mine = 0u;
#pragma unroll
        for (unsigned j = 0; j < 16; ++j) { const unsigned c = xb_ld(&bar[XB_XCNT(j)]); sum += c; cnt += (c > 0u) ? 1u : 0u; mine = (j == x) ? c : mine; }
        if (sum == G) break;
        __builtin_amdgcn_s_sleep(1);
        if ((++sp & 255u) == 0u) { if (xb_ld(&bar[XB_TMO])) break; if (sp > XB_SPIN_CAP) { atomicAdd(&bar[XB_TMO], 1u); break; } }
    }
    nloc = mine > 0u ? mine : 1u; nx = cnt > 0u ? cnt : 1u;
}
__device__ __forceinline__ void xcd_barrier(const XcdBarrier& b) {
    asm volatile("s_waitcnt vmcnt(0)" ::: "memory");
    __syncthreads();
    if (threadIdx.x == 0) {
        unsigned* bar = b.bar;
        __builtin_amdgcn_s_waitcnt(0);
        unsigned nloc = b.st[0], nx = b.st[1];
        if (nloc == 0u) { xcd_barrier_complete(bar, b.x, nloc, nx); b.st[0] = nloc; b.st[1] = nx; }
        const unsigned old = xb_add(&bar[XB_XSUB(b.x)], 1u);
        const unsigned gen = old / nloc;
        if (old + 1u == (gen + 1u) * nloc) {
            __builtin_amdgcn_fence(__ATOMIC_RELEASE, "agent");
            asm volatile("s_waitcnt vmcnt(0)" ::: "memory");
            const unsigned og = xb_add(&bar[XB_TOP], 1u);
            const unsigned tg = og / nx;
            if (og + 1u == (tg + 1u) * nx) xb_add(&bar[XB_TOPGEN], 1u);
            else XB_SPIN(xb_ld(&bar[XB_TOPGEN]) == tg, bar);
            __builtin_amdgcn_fence(__ATOMIC_ACQUIRE, "agent");
            xb_add(&bar[XB_XGEN(b.x)], 1u);
            asm volatile("s_waitcnt vmcnt(0)" ::: "memory");
        } else {
            XB_SPIN(xb_ld(&bar[XB_XGEN(b.x)]) == gen, bar);
            __builtin_amdgcn_fence(__ATOMIC_ACQUIRE, "agent");
            asm volatile("s_waitcnt vmcnt(0)" ::: "memory");
        }
    }
    __syncthreads();
}
__global__ void __launch_bounds__(NTHR) fwd_mega(Params p) {
    extern __shared__ __attribute__((aligned(16))) char smem[];
    cg::grid_group grid = cg::this_grid();
    const int bid = blockIdx.x, nb = gridDim.x;
    volatile LAS unsigned* xst = (volatile LAS unsigned*)(smem + LDS_BYTES - 16);
    if (threadIdx.x < 4) xst[threadIdx.x] = 0u;
    __syncthreads();
    const XcdBarrier xb = xcd_barrier_post((unsigned*)(p.ws + WS_BAR), xst);
#ifdef PROBE_W
    long* wrec = (long*)(p.ws + WS_A + 432 * MB);
    int wphase = 0;
#define GSYNC() do { const long t0_ = (long)wall_clock64(); xcd_barrier(xb); if (threadIdx.x == 0) wrec[wphase * 256 + bid] = (long)wall_clock64() - t0_; ++wphase; } while (0)
#elif defined(PROBE_PH)
    volatile long* pst = (volatile long*)(smem + 163712);
    int wphase = 2;
    if (threadIdx.x == 0) pst[0] = (long)wall_clock64();
#define GSYNC() do { xcd_barrier(xb); if (threadIdx.x == 0) pst[wphase] = (long)wall_clock64(); ++wphase; } while (0)
#else
#define GSYNC() xcd_barrier(xb)
#endif
#ifndef PROBE_REPEAT
#define PROBE_REPEAT 0
#endif
#define REP(n, call) if (PROBE_REPEAT & (1 << n)) { call; GSYNC(); }
#ifdef PROBE_T
#define TSPIN(n) if (PROBE_TP == n && bid == PROBE_TB && threadIdx.x == 0) { volatile long* tsv = (volatile long*)(smem + 163760); \
        const long d = tsv[PROBE_T1] - tsv[PROBE_T]; const long te = (long)wall_clock64() + d * 50; while ((long)wall_clock64() < te) __builtin_amdgcn_s_sleep(8); }
#else
#define TSPIN(n)
#endif
    if (PROBE_REPEAT & 1) { phase0(p, smem, bid, nb); GSYNC(); }
#ifdef PROBE_XCC
    {
        unsigned* rec = (unsigned*)(p.ws + WS_A + 432 * MB);
        if (threadIdx.x == 0) rec[bid] = xb_xcc_id();
        grid.sync();
        int mism = 0, distinct = 0;
        for (int b = 0; b < nb; ++b) { if (rec[b] != rec[b & 7]) ++mism; }
        for (int a = 0; a < 8; ++a) { bool dup = false; for (int b2 = 0; b2 < a; ++b2) dup = dup || (rec[a] == rec[b2]); if (!dup) ++distinct; }
        const float v = sqrtf((float)(PROBE_XCC == 1 ? mism : distinct) + 1.0f);
        for (long i = (long)bid * NTHR + threadIdx.x; i < (long)T_TOK * 1024; i += (long)nb * NTHR) p.out[i] = v;
        return;
    }
#endif
#ifdef PROBE_W
    phase0(p, smem, bid, nb);  { const long t0_ = (long)wall_clock64(); grid.sync(); if (threadIdx.x == 0) wrec[11 * 256 + bid] = (long)wall_clock64() - t0_; }
#elif defined(PROBE_PH)
    phase0(p, smem, bid, nb);
#ifdef PROBE_P0MAX
    if (threadIdx.x == 0) { ((long*)(p.ws + WS_A + 432 * MB))[bid] = (long)wall_clock64(); ((long*)(p.ws + WS_A + 432 * MB))[256 + bid] = pst[0]; }
#endif
    grid.sync(); if (threadIdx.x == 0) pst[1] = (long)wall_clock64();
#ifdef PROBE_P0MAX
    if (bid == 0 && threadIdx.x == 0) {
        const long* wr = (const long*)(p.ws + WS_A + 432 * MB);
        long mx = wr[0], mn = wr[0], sm = 0;
        for (int b = 0; b < nb; ++b) { const long v = __hip_atomic_load(&wr[b], __ATOMIC_RELAXED, __HIP_MEMORY_SCOPE_AGENT); mx = v > mx ? v : mx; mn = v < mn ? v : mn; sm += v - pst[0]; }
        long smx = wr[256], dmx = 0; int bmx = 0;
        for (int b = 0; b < nb; ++b) { const long s0 = __hip_atomic_load(&wr[256 + b], __ATOMIC_RELAXED, __HIP_MEMORY_SCOPE_AGENT), v = __hip_atomic_load(&wr[b], __ATOMIC_RELAXED, __HIP_MEMORY_SCOPE_AGENT);
            smx = s0 > smx ? s0 : smx; if (v - s0 > dmx) { dmx = v - s0; bmx = b; } }
        int scnt = 0, sminb = 1000, smaxb = -1;
        for (int b = 0; b < nb; ++b) { const long d = wr[b] - wr[256 + b]; if (d > 8500) { ++scnt; sminb = b < sminb ? b : sminb; smaxb = b > smaxb ? b : smaxb; } }
        if (PROBE_P0MAX >= 8 && PROBE_P0MAX <= 10) pst[1] = pst[0] + (PROBE_P0MAX == 8 ? scnt : PROBE_P0MAX == 9 ? sminb : smaxb) * 100; else
        pst[1] = PROBE_P0MAX == 1 ? mx : PROBE_P0MAX == 2 ? mn : PROBE_P0MAX == 3 ? pst[0] + sm / nb : PROBE_P0MAX == 4 ? smx : PROBE_P0MAX == 5 ? pst[0] + dmx : PROBE_P0MAX == 6 ? pst[0] + bmx * 100 : pst[0] + (wr[PROBE_P0MAX - 1000] - wr[256 + PROBE_P0MAX - 1000]);
    }
#endif
#elif defined(PROBE_T)
    phase0(p, smem, bid, nb);  TSPIN(0) grid.sync();
#else
    phase0(p, smem, bid, nb);  grid.sync();
#endif
    REP(1, phase1<1>(p, smem, bid, nb))
    phase1(p, smem, bid, nb);  GSYNC();
    REP(2, phase2(p, smem, bid, nb))
    phase2(p, smem, bid, nb);  GSYNC();
#ifndef PROBE_P3PARTS
#define PROBE_P3PARTS 7
#endif
#ifndef PROBE_NSAV
#define PROBE_NSAV 7
#endif
    REP(3, (phase3<PROBE_P3PARTS, PROBE_NSAV>(p, smem, bid, nb, 1)))
    phase3(p, smem, bid, nb);  GSYNC();
    REP(4, phase4(p, smem, bid, nb))
#ifdef PROBE_X
    phase_probe<PROBE_X>(p, smem, bid, nb); GSYNC();
#endif
    phase4(p, smem, bid, nb);  TSPIN(4) GSYNC();
    REP(5, phase5(p, smem, bid, nb))
    phase5(p, smem, bid, nb);  TSPIN(5) GSYNC();
    REP(6, phase6(p, smem, bid, nb))
    phase6(p, smem, bid, nb);  TSPIN(6) GSYNC();
    REP(7, phase7(p, smem, bid, nb))
    phase7(p, smem, bid, nb);  TSPIN(7) GSYNC();
    REP(8, phase8(p, smem, bid, nb, 1))
    phase8(p, smem, bid, nb);  TSPIN(8) GSYNC();
#ifndef PROBE_P9PARTS
#define PROBE_P9PARTS 3
#endif
    REP(9, phase9<PROBE_P9PARTS>(p, smem, bid, nb))
    phase9(p, smem, bid, nb);  TSPIN(9) GSYNC();
#ifndef PROBE_P10V
#define PROBE_P10V 0
#endif
    REP(10, phase10<PROBE_P10V>(p, smem, bid, nb))
    phase10(p, smem, bid, nb); GSYNC();
    REP(11, phase11(p, smem, bid, nb))
    phase11(p, smem, bid, nb);
#ifdef PROBE_NT
    if (bid == 0 && threadIdx.x == 0) {
        const long* wr = (const long*)(p.ws + WS_A + 432 * MB) + 600;
        long mx = 0, sm = 0;
        for (int x = 0; x < 8; ++x) { const long v = __hip_atomic_load(&wr[x], __ATOMIC_RELAXED, __HIP_MEMORY_SCOPE_AGENT); mx = v > mx ? v : mx; sm += v; }
        const long val = PROBE_NT == 1 ? mx : sm / 8;
        const long te = (long)wall_clock64() + val * 1000; while ((long)wall_clock64() < te) __builtin_amdgcn_s_sleep(8);
    }
#endif
#ifdef PROBE_PH
    if (bid == 0 && threadIdx.x == 0) {
        pst[12] = (long)wall_clock64();
        const long te = pst[12] + (pst[PROBE_PH + 1] - pst[PROBE_PH]) * 20; while ((long)wall_clock64() < te) __builtin_amdgcn_s_sleep(8);
    }
#endif
#ifdef PROBE_W
    GSYNC();
    if (bid == 0 && threadIdx.x == 0) {
        long s = 0;
        for (int b = 0; b < nb; ++b) s += __hip_atomic_load(&wrec[PROBE_W * 256 + b], __ATOMIC_RELAXED, __HIP_MEMORY_SCOPE_AGENT);
        const long te = (long)wall_clock64() + (s / nb) * 50; while ((long)wall_clock64() < te) __builtin_amdgcn_s_sleep(8);
    }
#endif
}
#else
#define PHASE_KERNEL(n) __global__ void __launch_bounds__(NTHR) fwd_phase##n(Params p) { extern __shared__ __attribute__((aligned(16))) char smem[]; phase##n(p, smem, blockIdx.x, gridDim.x); }
PHASE_KERNEL(0) PHASE_KERNEL(1) PHASE_KERNEL(2) PHASE_KERNEL(3) PHASE_KERNEL(4) PHASE_KERNEL(5)
PHASE_KERNEL(6) PHASE_KERNEL(7) PHASE_KERNEL(8) PHASE_KERNEL(9) PHASE_KERNEL(10) PHASE_KERNEL(11)
typedef void (*phase_fn)(Params);
#endif

extern "C" void kernel_launch(void* const* d_in, const int* in_sizes, int n_in, void* d_out, int out_size, void* d_ws, size_t ws_size, hipStream_t stream) {
    Params p{};
    for (int i = 0; i < 32; ++i) p.in[i] = (const float*)d_in[i];
    p.out = (float*)d_out;
    p.ws = (char*)d_ws;
    if (n_in != 32 || ws_size < WS_END) { fprintf(stderr, "kernel_launch: unexpected inputs (n_in %d) or workspace too small (%zu < %zu)\n", n_in, ws_size, (size_t)WS_END); return; }
#if MEGA
    static int grid = 0;
    if (!grid) {
        int dev = 0, cus = 0, per_cu = 0;
        (void)hipGetDevice(&dev);
        (void)hipDeviceGetAttribute(&cus, hipDeviceAttributeMultiprocessorCount, dev);
        (void)hipFuncSetAttribute((const void*)fwd_mega, hipFuncAttributeMaxDynamicSharedMemorySize, LDS_BYTES);
        (void)hipOccupancyMaxActiveBlocksPerMultiprocessor(&per_cu, (const void*)fwd_mega, NTHR, LDS_BYTES);
        if (per_cu < 1) { fprintf(stderr, "kernel_launch: occupancy query says %d blocks/CU\n", per_cu); per_cu = 1; }
        grid = cus;
    }
    (void)hipMemsetAsync((char*)d_ws + WS_BAR, 0, 16384, stream);
    void* args[] = {&p};
    hipError_t e = hipLaunchCooperativeKernel((const void*)fwd_mega, dim3(grid), dim3(NTHR), args, LDS_BYTES, stream);
    if (e != hipSuccess) fprintf(stderr, "cooperative launch failed: %s (grid %d)\n", hipGetErrorString(e), grid);
#else
    static const phase_fn fns[12] = {fwd_phase0, fwd_phase1, fwd_phase2, fwd_phase3, fwd_phase4, fwd_phase5, fwd_phase6, fwd_phase7, fwd_phase8, fwd_phase9, fwd_phase10, fwd_phase11};
    static bool attr = false;
    if (!attr) { for (int i = 0; i < 12; ++i) (void)hipFuncSetAttribute((const void*)fns[i], hipFuncAttributeMaxDynamicSharedMemorySize, LDS_BYTES); attr = true; }
    for (int i = 0; i < 12; ++i) hipLaunchKernelGGL(fns[i], dim3(256), dim3(NTHR), LDS_BYTES, stream, p);
#endif
}
```
